# Optimizing an MI355X kernel written in HIP

```python
import jax, jax.numpy as jnp
from jax import lax
import numpy as np

D_MODEL = 2048
BATCH = 4
SEQ = 4096
DEPTH = 2

GRID_W = 64
CTX_LEN = 256
HEAD_DIM = 128
BLOCK = 128
WINDOW = 128
A_HEADS = 6
A_KV = 2
B_GROUPS = 4
B_CHUNK = 128
C_HEADS = 6
C_KV = 2
A_WIDTH = A_HEADS * HEAD_DIM
B_WIDTH = B_GROUPS * HEAD_DIM
C_WIDTH = C_HEADS * HEAD_DIM
MIX_WIDTH = A_WIDTH + B_WIDTH + C_WIDTH
IN_SPLITS = (A_WIDTH, A_KV * HEAD_DIM, A_KV * HEAD_DIM, B_WIDTH, B_WIDTH, C_WIDTH, C_KV * HEAD_DIM, C_KV * HEAD_DIM)
IN_WIDTH = A_WIDTH + 2 * A_KV * HEAD_DIM + 2 * B_WIDTH + C_WIDTH + 2 * C_KV * HEAD_DIM
OUT_SPLITS = (A_WIDTH, B_WIDTH, C_WIDTH)
N_EXPERTS = 16
EC_CAPACITY = 2
D_EXPERT = 2048
N_MOD = 6
ROPE_THETA = 10000.0
EPS = 1e-6
NEG_INF = -1e30

kernel_name = "hymba_style_diffusion_trunk_ec_moe"


def _split(x, sizes):
    idx = [int(i) for i in np.cumsum(sizes)[:-1]]
    return jnp.split(x, idx, axis=-1)


def rms_norm(x, g):
    xf = x.astype(jnp.float32)
    y = xf * lax.rsqrt(jnp.mean(xf * xf, axis=-1, keepdims=True) + EPS)
    return (y * g.astype(jnp.float32)).astype(x.dtype)


def modulate(h, shift, scale):
    return h * (1 + scale) + shift


def axial_angles(n):
    rows = n // GRID_W
    row = jnp.repeat(jnp.arange(rows, dtype=jnp.float32), GRID_W)
    col = (jnp.arange(n) % GRID_W).astype(jnp.float32)
    n_freq = HEAD_DIM // 4
    inv = ROPE_THETA ** (-jnp.arange(n_freq, dtype=jnp.float32) / n_freq)
    return row[:, None] * inv, col[:, None] * inv


def rope_half(x, ang):
    f = ang.shape[-1]
    cos = jnp.cos(ang)[None, :, None, :].astype(x.dtype)
    sin = jnp.sin(ang)[None, :, None, :].astype(x.dtype)
    x1, x2 = x[..., :f], x[..., f:]
    return jnp.concatenate([x1 * cos - x2 * sin, x2 * cos + x1 * sin], axis=-1)


def rope_2d(x, ang_r, ang_c):
    h = x.shape[-1] // 2
    return jnp.concatenate([rope_half(x[..., :h], ang_r), rope_half(x[..., h:], ang_c)], axis=-1)


def attn_heads(p_q, p_k, p_v, n_q, n_kv, qn, kn, ang):
    b, n = p_q.shape[:2]
    q = rms_norm(p_q.reshape(b, n, n_q, HEAD_DIM), qn)
    k = rms_norm(p_k.reshape(b, n, n_kv, HEAD_DIM), kn)
    if ang is not None:
        q = rope_2d(q, *ang)
        k = rope_2d(k, *ang)
    v = p_v.reshape(b, n, n_kv, HEAD_DIM)
    return q.reshape(b, n, n_kv, n_q // n_kv, HEAD_DIM), k, v


def dense_attn(q, k, v, sink):
    s = jnp.einsum('bqkgd,bskd->bkgqs', q, k).astype(jnp.float32) * (HEAD_DIM ** -0.5)
    if sink is not None:
        sk = jnp.broadcast_to(sink[None, :, :, None, None].astype(jnp.float32), s.shape[:-1] + (1,))
        s = jnp.concatenate([sk, s], axis=-1)
    p = jax.nn.softmax(s, axis=-1)
    if sink is not None:
        p = p[..., 1:]
    return jnp.einsum('bkgqs,bskd->bqkgd', p.astype(v.dtype), v)


def window_attn_latent(q, k, v, k_ctx, v_ctx, sink):
    b, n, kv, g, dh = q.shape
    nb = n // BLOCK
    L = k_ctx.shape[1]
    qb = q.reshape(b, nb, BLOCK, kv, g, dh)
    pad = ((0, 0), (BLOCK, BLOCK), (0, 0), (0, 0))
    kp, vp = jnp.pad(k, pad), jnp.pad(v, pad)
    kb = jnp.concatenate([kp[:, j * BLOCK:j * BLOCK + n].reshape(b, nb, BLOCK, kv, dh) for j in range(3)], axis=2)
    vb = jnp.concatenate([vp[:, j * BLOCK:j * BLOCK + n].reshape(b, nb, BLOCK, kv, dh) for j in range(3)], axis=2)
    scale = HEAD_DIM ** -0.5
    s_band = jnp.einsum('bnqkgd,bnskd->bnkgqs', qb, kb).astype(jnp.float32) * scale
    s_ctx = jnp.einsum('bnqkgd,bskd->bnkgqs', qb, k_ctx).astype(jnp.float32) * scale
    blk = jnp.arange(nb)[:, None, None]
    qpos = blk * BLOCK + jnp.arange(BLOCK)[None, :, None]
    kpos = (blk - 1) * BLOCK + jnp.arange(3 * BLOCK)[None, None, :]
    valid = (jnp.abs(kpos - qpos) <= WINDOW) & (kpos >= 0) & (kpos < n)
    s_band = jnp.where(valid[None, :, None, None], s_band, NEG_INF)
    sk = jnp.broadcast_to(sink[None, None, :, :, None, None].astype(jnp.float32), s_band.shape[:-1] + (1,))
    p = jax.nn.softmax(jnp.concatenate([sk, s_ctx, s_band], axis=-1), axis=-1).astype(v.dtype)
    o = (jnp.einsum('bnkgqs,bskd->bnqkgd', p[..., 1:1 + L], v_ctx)
         + jnp.einsum('bnkgqs,bnskd->bnqkgd', p[..., 1 + L:], vb))
    return o.reshape(b, n, kv * g * dh)


def global_attn_latent(q, k_all, v_all):
    b, n, kv, g, dh = q.shape
    nb = n // BLOCK
    qb = q.reshape(b, nb, BLOCK, kv, g, dh).transpose(1, 0, 2, 3, 4, 5)
    o = lax.map(lambda qi: dense_attn(qi, k_all, v_all, None), qb)
    return o.transpose(1, 0, 2, 3, 4, 5).reshape(b, n, kv * g * dh)


def chunk_mlp(u, v, vn_g, w_s, b_s):
    b, n, _ = u.shape
    nc = n // B_CHUNK
    u = jax.nn.gelu(u).reshape(b, nc, B_CHUNK, B_GROUPS, HEAD_DIM)
    v = rms_norm(jax.nn.gelu(v).reshape(b, n, B_GROUPS, HEAD_DIM), vn_g.reshape(B_GROUPS, HEAD_DIM))
    v = v.reshape(b, nc, B_CHUNK, B_GROUPS, HEAD_DIM)
    mixed = jnp.einsum('gpq,bnqgd->bnpgd', w_s, v) + b_s.T[None, None, :, :, None]
    return (u * mixed).reshape(b, n, B_WIDTH)


def merge_heads(o_a, o_b, o_c, out_g, w_out):
    g_a, g_b, g_c = _split(out_g, OUT_SPLITS)
    y = jnp.concatenate([rms_norm(o_a, g_a), rms_norm(o_b, g_b), rms_norm(o_c, g_c)], axis=-1)
    return y @ w_out


def token_mixers(hx, hc, ang, w_in, qn_a, kn_a, sink_a, vn_b, w_s, b_s, qn_c, kn_c, out_g, w_out, need_ctx):
    qa_x, ka_x, va_x, ub_x, vb_x, qc_x, kc_x, vc_x = _split(hx @ w_in, IN_SPLITS)
    qa_c, ka_c, va_c, ub_c, vb_c, qc_c, kc_c, vc_c = _split(hc @ w_in, IN_SPLITS)
    sink = sink_a.reshape(A_KV, A_HEADS // A_KV)
    q_a, k_a, v_a = attn_heads(qa_x, ka_x, va_x, A_HEADS, A_KV, qn_a, kn_a, ang)
    q_ac, k_ac, v_ac = attn_heads(qa_c, ka_c, va_c, A_HEADS, A_KV, qn_a, kn_a, None)
    o_a = window_attn_latent(q_a, k_a, v_a, k_ac, v_ac, sink)
    o_b = chunk_mlp(ub_x, vb_x, vn_b, w_s, b_s)
    q_c, k_c, v_c = attn_heads(qc_x, kc_x, vc_x, C_HEADS, C_KV, qn_c, kn_c, ang)
    q_cc, k_cc, v_cc = attn_heads(qc_c, kc_c, vc_c, C_HEADS, C_KV, qn_c, kn_c, None)
    k_all = jnp.concatenate([k_cc, k_c], axis=1)
    v_all = jnp.concatenate([v_cc, v_c], axis=1)
    o_c = global_attn_latent(q_c, k_all, v_all)
    y_x = merge_heads(o_a, o_b, o_c, out_g, w_out)
    y_c = None
    if need_ctx:
        bsz, L = hc.shape[:2]
        o_ac = dense_attn(q_ac, k_ac, v_ac, sink).reshape(bsz, L, A_WIDTH)
        o_bc = chunk_mlp(ub_c, vb_c, vn_b, w_s, b_s)
        o_cc = dense_attn(q_cc, k_cc, v_cc, None).reshape(bsz, L, C_WIDTH)
        y_c = merge_heads(o_ac, o_bc, o_cc, out_g, w_out)
    return y_x, y_c


def expert_choice_ffn(h, w_router, w_gate, w_up, w_down):
    n, d = h.shape[1], h.shape[2]
    cap = EC_CAPACITY * n // N_EXPERTS

    def per_sample(hs):
        aff = jax.nn.softmax((hs @ w_router).astype(jnp.float32), axis=-1)
        gate, idx = lax.top_k(aff.T, cap)
        xg = hs[idx]
        a = jnp.einsum('ecd,edf->ecf', xg, w_gate)
        u = jnp.einsum('ecd,edf->ecf', xg, w_up)
        y = jnp.einsum('ecf,efd->ecd', jax.nn.silu(a) * u, w_down)
        y = y * gate[..., None].astype(y.dtype)
        return jnp.zeros_like(hs).at[idx.reshape(-1)].add(y.reshape(-1, d))

    return jax.vmap(per_sample)(h)


def setup_inputs(seed: int = 0) -> dict:
    key = jax.random.key(seed)
    ks = jax.random.split(key, 24)
    f32 = jnp.float32
    nrm = lambda k, shape, s: (jax.random.normal(k, shape, f32) * s)
    gain = lambda k, shape: 1.0 + 0.02 * jax.random.normal(k, shape, f32)
    return {
        "x": nrm(ks[0], (BATCH, SEQ, D_MODEL), 1.0),
        "c": nrm(ks[1], (BATCH, D_MODEL), 1.0),
        "ctx": nrm(ks[2], (BATCH, CTX_LEN, D_MODEL), 1.0),
        "c_ctx": nrm(ks[3], (D_MODEL,), 1.0),
        "w_mod": nrm(ks[4], (DEPTH, D_MODEL, N_MOD * D_MODEL), 0.5 * D_MODEL ** -0.5),
        "b_mod": nrm(ks[5], (DEPTH, N_MOD * D_MODEL), 0.01),
        "norm1_g": gain(ks[6], (DEPTH, D_MODEL)),
        "norm2_g": gain(ks[7], (DEPTH, D_MODEL)),
        "w_in": nrm(ks[8], (DEPTH, D_MODEL, IN_WIDTH), D_MODEL ** -0.5),
        "qn_a": gain(ks[9], (DEPTH, HEAD_DIM)),
        "kn_a": gain(ks[10], (DEPTH, HEAD_DIM)),
        "sink_a": nrm(ks[11], (DEPTH, A_HEADS), 0.5),
        "vn_b": gain(ks[12], (DEPTH, B_WIDTH)),
        "w_s": nrm(ks[13], (DEPTH, B_GROUPS, B_CHUNK, B_CHUNK), 0.5 * B_CHUNK ** -0.5),
        "b_s": 1.0 + nrm(ks[14], (DEPTH, B_GROUPS, B_CHUNK), 0.1),
        "qn_c": gain(ks[15], (DEPTH, HEAD_DIM)),
        "kn_c": gain(ks[16], (DEPTH, HEAD_DIM)),
        "out_g": gain(ks[17], (DEPTH, MIX_WIDTH)),
        "w_out": nrm(ks[18], (DEPTH, MIX_WIDTH, D_MODEL), MIX_WIDTH ** -0.5),
        "w_router": nrm(ks[19], (DEPTH, D_MODEL, N_EXPERTS), D_MODEL ** -0.5),
        "w_gate": nrm(ks[20], (DEPTH, N_EXPERTS, D_MODEL, D_EXPERT), D_MODEL ** -0.5),
        "w_up": nrm(ks[21], (DEPTH, N_EXPERTS, D_MODEL, D_EXPERT), D_MODEL ** -0.5),
        "w_down": nrm(ks[22], (DEPTH, N_EXPERTS, D_EXPERT, D_MODEL), D_EXPERT ** -0.5),
    }


def reference(x, c, ctx, c_ctx, w_mod, b_mod, norm1_g, norm2_g, w_in, qn_a, kn_a, sink_a, vn_b,
              w_s, b_s, qn_c, kn_c, out_g, w_out, w_router, w_gate, w_up, w_down):
    ang = axial_angles(x.shape[1])
    xc = ctx
    for i in range(DEPTH):
        last = i == DEPTH - 1
        mod_x = (jax.nn.silu(c) @ w_mod[i] + b_mod[i])[:, None, :]
        mod_c = (jax.nn.silu(c_ctx) @ w_mod[i] + b_mod[i])[None, None, :]
        sh1, sc1, g1, sh2, sc2, g2 = jnp.split(mod_x, N_MOD, axis=-1)
        sh1c, sc1c, g1c, sh2c, sc2c, g2c = jnp.split(mod_c, N_MOD, axis=-1)
        hx = modulate(rms_norm(x, norm1_g[i]), sh1, sc1)
        hc = modulate(rms_norm(xc, norm1_g[i]), sh1c, sc1c)
        y_x, y_c = token_mixers(hx, hc, ang, w_in[i], qn_a[i], kn_a[i], sink_a[i], vn_b[i], w_s[i], b_s[i],
                                qn_c[i], kn_c[i], out_g[i], w_out[i], not last)
        x = x + g1 * y_x
        hx = modulate(rms_norm(x, norm2_g[i]), sh2, sc2)
        x = x + g2 * expert_choice_ffn(hx, w_router[i], w_gate[i], w_up[i], w_down[i])
        if not last:
            xc = xc + g1c * y_c
            hc = modulate(rms_norm(xc, norm2_g[i]), sh2c, sc2c)
            xc = xc + g2c * expert_choice_ffn(hc, w_router[i], w_gate[i], w_up[i], w_down[i])
    return x
```

```cpp
#include <hip/hip_runtime.h>
#include <cstdio>
#include <cstdint>

#define LAS __attribute__((address_space(3)))
#define GAS __attribute__((address_space(1)))
typedef unsigned short bf16_t;
typedef short bf16x8 __attribute__((ext_vector_type(8)));
typedef short s16x4 __attribute__((ext_vector_type(4)));
typedef float f32x2 __attribute__((ext_vector_type(2)));
typedef float f32x4 __attribute__((ext_vector_type(4)));
typedef float f32x16 __attribute__((ext_vector_type(16)));
typedef unsigned u32x2 __attribute__((ext_vector_type(2)));
typedef unsigned u32x4 __attribute__((ext_vector_type(4)));

#ifndef MK_PER_PHASE
#define MK_PER_PHASE 0
#endif
#ifndef PHASE_MASK
#define PHASE_MASK 0x1fff
#endif
#define PH_ON(k) (((PHASE_MASK) >> (k)) & 1)
#ifndef DBG_STOP
#define DBG_STOP 0
#endif

constexpr int DM = 2048, NB = 4, SEQ = 4096, CTXL = 256, TPB = SEQ + CTXL, NTOK = NB * TPB;
constexpr int INW = 3584, NE = 16, NLAYER = 2, NMOD = 6 * DM;
constexpr int C_QA = 0, C_KA = 768, C_VA = 1024, C_UB = 1280, C_VB = 1792, C_QC = 2304, C_KC = 3072, C_VC = 3328;
constexpr int O_A = 0, O_B = 768, O_C = 1280;
constexpr int CAP_L = 512, CAP_C = 32, ROWS_E = 2304;
constexpr float EPS = 1e-6f;

constexpr size_t MiB = 1u << 20;
constexpr size_t WS_CTL = 0, CTL_ZERO_BYTES = 65536;
constexpr size_t WS_MOD = 1 * MiB;
constexpr size_t WS_ROPE = 2 * MiB;
constexpr size_t WS_AFFL = 3 * MiB;
constexpr size_t WS_AFFC = 4 * MiB;
constexpr size_t WS_POSL = 5 * MiB;
constexpr size_t WS_POSC = 6 * MiB;
constexpr size_t WS_RSRC = 7 * MiB;
constexpr size_t WS_GATE = 8 * MiB;
constexpr size_t WS_WIN = 16 * MiB;
constexpr size_t WS_WOUT = WS_WIN + (size_t)2 * INW * DM * 2;
constexpr size_t WS_WGU = WS_WOUT + (size_t)2 * DM * DM * 2;
constexpr size_t WS_WD = WS_WGU + (size_t)2 * NE * 4096 * DM * 2;
constexpr size_t WS_HN = WS_WD + (size_t)2 * NE * DM * DM * 2;
constexpr size_t WS_P = WS_HN + (size_t)NTOK * DM * 2;
constexpr size_t WS_O = WS_P + (size_t)NTOK * INW * 2;
constexpr size_t WS_XB = WS_O + (size_t)NTOK * DM * 2;
constexpr size_t WS_XG = WS_XB + (size_t)NTOK * DM * 4;
constexpr size_t WS_H = WS_XG + (size_t)NE * ROWS_E * DM * 2;
constexpr size_t WS_END = WS_H + (size_t)NE * ROWS_E * DM * 2;
constexpr int CW_BAR = 4096, CW_QUEUE = 8192;

constexpr int RING_BYTES = 131072, LDSCTL_OFF = RING_BYTES, MISC_OFF = LDSCTL_OFF + 320, LDS_BYTES = 147456;

#define LDS_WAIT() asm volatile("s_waitcnt lgkmcnt(0)" ::: "memory")
#define VM_WAIT() asm volatile("s_waitcnt vmcnt(0)" ::: "memory")
__device__ __forceinline__ unsigned f2bf(float f) { unsigned u = __builtin_bit_cast(unsigned, f); return (u + 0x7fffu + ((u >> 16) & 1u)) >> 16; }
__device__ __forceinline__ unsigned pk2(float lo, float hi) { return f2bf(lo) | (f2bf(hi) << 16); }
__device__ __forceinline__ float bf2f(unsigned short b) { return __builtin_bit_cast(float, ((unsigned)b) << 16); }
__device__ __forceinline__ float bflo(unsigned w) { return __builtin_bit_cast(float, w << 16); }
__device__ __forceinline__ float bfhi(unsigned w) { return __builtin_bit_cast(float, w & 0xffff0000u); }
__device__ __forceinline__ int opaque_tid() { int t = threadIdx.x; asm volatile("" : "+v"(t)); return t; }
__device__ __forceinline__ float wave_sum(float v) {
#pragma unroll
    for (int o = 1; o < 64; o <<= 1) v += __shfl_xor(v, o);
    return v;
}
__device__ __forceinline__ float gelu_tanh(float x) {
    const float u = 0.7978845608028654f * (x + 0.044715f * x * x * x);
    const float e = __expf(2.f * u);
    const float th = 1.f - 2.f / (e + 1.f);
    return 0.5f * x * (1.f + th);
}

#define XB_TMO      128
#define XB_XCNT(j)  (256  + 64 * (j))
#define XB_XSUB(j)  (1280 + 64 * (j))
#define XB_XGEN(j)  (2304 + 64 * (j))
#define XB_TOP      3328
#define XB_TOPGEN   3392
#define XCD_BAR_WORDS 3456
#define XB_SPIN_CAP (1u << 18)
__device__ __forceinline__ unsigned xb_ld(unsigned* p)              { return __hip_atomic_load(p, __ATOMIC_RELAXED, __HIP_MEMORY_SCOPE_AGENT); }
__device__ __forceinline__ unsigned xb_add(unsigned* p, unsigned v) { return __hip_atomic_fetch_add(p, v, __ATOMIC_RELAXED, __HIP_MEMORY_SCOPE_AGENT); }
__device__ __forceinline__ unsigned xb_xcc_id() { return (unsigned)__builtin_amdgcn_s_getreg((3 << 11) | 20) & 0xFu; }
#define XB_SPIN(cond, bar) do { unsigned _sp = 0; while (cond) { __builtin_amdgcn_s_sleep(1); \
    if ((++_sp & 255u) == 0u) { if (xb_ld(&(bar)[XB_TMO])) break; if (_sp > XB_SPIN_CAP) { atomicAdd(&(bar)[XB_TMO], 1u); break; } } } } while (0)
struct XcdBarrier { unsigned* bar; unsigned x; volatile LAS unsigned* st; };
__device__ __forceinline__ XcdBarrier xcd_barrier_post(unsigned* bar, volatile LAS unsigned* st) {
    XcdBarrier b; b.bar = bar; b.x = xb_xcc_id(); b.st = st;
    if (threadIdx.x == 0) (void)xb_add(&bar[XB_XCNT(b.x)], 1u);
    return b;
}
__device__ __forceinline__ void xcd_barrier_complete(unsigned* bar, unsigned x, unsigned& nloc, unsigned& nx) {
    const unsigned G = gridDim.x * gridDim.y * gridDim.z;
    unsigned sum, cnt, mine, sp = 0u;
    for (;;) {
        sum = 0u; cnt = 0u; mine = 0u;
#pragma unroll
        for (unsigned j = 0; j < 16; ++j) { const unsigned c = xb_ld(&bar[XB_XCNT(j)]); sum += c; cnt += (c > 0u) ? 1u : 0u; mine = (j == x) ? c : mine; }
        if (sum == G) break;
        __builtin_amdgcn_s_sleep(1);
        if ((++sp & 255u) == 0u) { if (xb_ld(&bar[XB_TMO])) break; if (sp > XB_SPIN_CAP) { atomicAdd(&bar[XB_TMO], 1u); break; } }
    }
    nloc = mine > 0u ? mine : 1u; nx = cnt > 0u ? cnt : 1u;
}
__device__ __forceinline__ void xcd_barrier(const XcdBarrier& b) {
    asm volatile("s_waitcnt vmcnt(0)" ::: "memory");
    __syncthreads();
    if (threadIdx.x == 0) {
        unsigned* bar = b.bar;
        __builtin_amdgcn_s_waitcnt(0);
        unsigned nloc = b.st[0], nx = b.st[1];
        if (nloc == 0u) { xcd_barrier_complete(bar, b.x, nloc, nx); b.st[0] = nloc; b.st[1] = nx; }
        const unsigned old = xb_add(&bar[XB_XSUB(b.x)], 1u);
        const unsigned gen = old / nloc;
        if (old + 1u == (gen + 1u) * nloc) {
            __builtin_amdgcn_fence(__ATOMIC_RELEASE, "agent");
            asm volatile("s_waitcnt vmcnt(0)" ::: "memory");
            const unsigned og = xb_add(&bar[XB_TOP], 1u);
            const unsigned tg = og / nx;
            if (og + 1u == (tg + 1u) * nx) xb_add(&bar[XB_TOPGEN], 1u);
            else XB_SPIN(xb_ld(&bar[XB_TOPGEN]) == tg, bar);
            __builtin_amdgcn_fence(__ATOMIC_ACQUIRE, "agent");
            xb_add(&bar[XB_XGEN(b.x)], 1u);
            asm volatile("s_waitcnt vmcnt(0)" ::: "memory");
        } else {
            XB_SPIN(xb_ld(&bar[XB_XGEN(b.x)]) == gen, bar);
            __builtin_amdgcn_fence(__ATOMIC_ACQUIRE, "agent");
            asm volatile("s_waitcnt vmcnt(0)" ::: "memory");
        }
    }
    __syncthreads();
}

namespace pg8 {
constexpr int BM = 256, BK = 64, HALF = 128, HTB = HALF * BK * 2, STAGE_BYTES = 8 * HTB, NXCD = 8, WGM = 8;
constexpr int GK = 2048;
__host__ __device__ __forceinline__ int lds_byte(int r, int c) { const int st = (r >> 4) * 2 + (c >> 5), rr = r & 15, cc = c & 31, ob = rr * 64 + cc * 2; return st * 1024 + (ob ^ (((ob >> 9) & 1) << 5)); }
__host__ __device__ __forceinline__ void stage_rc(int b, int& R, int& C) { const int st = b / 1024, sb = b % 1024, swz = sb ^ (((sb >> 9) & 1) << 5); R = (st >> 1) * 16 + swz / 64; C = (st & 1) * 32 + (swz % 64) / 2; }
__host__ __device__ __forceinline__ int perm32(int rho) { const int n = rho >> 4, i = rho & 15; return 8 * (i >> 2) + 4 * n + (i & 3); }

struct Unit { int pm, pn, e, rowbase, colbase; const char* a; const char* b; };

struct SchedDense {
    const char* A; const char* Bt; int nM, nN, nwg, G, c, skipctx;
    __device__ void init(const void* A_, const void* Bt_, int nM_, int nN_, int G_, int c_, int skipctx_) { A = (const char*)A_; Bt = (const char*)Bt_; nM = nM_; nN = nN_; nwg = nM * nN; G = G_; c = c_; skipctx = skipctx_; }
    __device__ bool next(int i, Unit& u) const {
        const long L = (long)i * G + c; if (L >= nwg) return false;
        int wgid = (int)L; { const int q = nwg / NXCD, r = nwg % NXCD, xcd = wgid % NXCD, off = wgid / NXCD; wgid = (xcd < r ? xcd * (q + 1) : r * (q + 1) + (xcd - r) * q) + off; }
        const int nig = WGM * nN, gid = wgid / nig, fm = gid * WGM, gsz = (nM - fm) < WGM ? (nM - fm) : WGM;
        int pm = fm + ((wgid % nig) % gsz); const int pn = (wgid % nig) / gsz;
        if (skipctx) pm = (pm >> 4) * 17 + 1 + (pm & 15);
        u.pm = pm; u.pn = pn; u.e = 0; u.rowbase = pm * BM; u.colbase = pn * BM;
        u.a = A + (size_t)pm * (BM * GK * 2); u.b = Bt + (size_t)pn * (BM * GK * 2); return true;
    }
};
struct SchedGrouped {
    const char* A; const char* Bt; int nMe, nNe, nwg, G, c;
    __device__ void init(const void* A_, const void* Bt_, int nMe_, int nNe_, int G_, int c_) { A = (const char*)A_; Bt = (const char*)Bt_; nMe = nMe_; nNe = nNe_; nwg = NE * nMe * nNe; G = G_; c = c_; }
    __device__ bool next(int i, Unit& u) const {
        const long L = (long)i * G + c; if (L >= nwg) return false;
        const int per = nMe * nNe, e = (int)L / per, rem = (int)L % per, pm = rem % nMe, pn = rem / nMe;
        u.pm = pm; u.pn = pn; u.e = e; u.rowbase = e * ROWS_E + pm * BM; u.colbase = pn * BM;
        u.a = A + (size_t)(e * ROWS_E + pm * BM) * (GK * 2); u.b = Bt + ((size_t)e * nNe + pn) * (BM * GK * 2); return true;
    }
};

__device__ __forceinline__ unsigned cvt_pk_bf16(float lo, float hi) { unsigned r; asm volatile("v_cvt_pk_bf16_f32 %0, %1, %2" : "=v"(r) : "v"(lo), "v"(hi)); return r; }

struct EpiStoreBf16 {
    static constexpr bool PERM = true;
    bf16_t* O; int ldc;
    __device__ __forceinline__ void operator()(const f32x4 (&acc)[2][2][4][2], const Unit& u, int wr, int wc, int fr, int fq) const {
        const int row0 = u.rowbase + wr * 64 + fr, col0 = u.colbase + wc * 32 + 8 * fq;
#pragma unroll
        for (int ai = 0; ai < 2; ++ai)
#pragma unroll
            for (int m = 0; m < 4; ++m) { bf16_t* rowp = O + (size_t)(row0 + ai * HALF + m * 16) * ldc + col0;
#pragma unroll
                for (int bj = 0; bj < 2; ++bj) { const f32x4 v0 = acc[ai][bj][m][0], v1 = acc[ai][bj][m][1];
                    u32x4 w; w.x = cvt_pk_bf16(v0[0], v0[1]); w.y = cvt_pk_bf16(v0[2], v0[3]); w.z = cvt_pk_bf16(v1[0], v1[1]); w.w = cvt_pk_bf16(v1[2], v1[3]);
                    *(u32x4*)(rowp + bj * HALF) = w; } }
    }
};
struct EpiResid {
    static constexpr bool PERM = false;
    const float* ctxbase; const float* latbase; int cbs, lbs;
    float* xout; const float* modl;
    __device__ __forceinline__ void operator()(const f32x4 (&acc)[2][2][4][2], const Unit& u, int wr, int wc, int fr, int fq) const {
        const int b = u.pm / 17, tb = u.pm % 17;
        const float* src = (tb == 0) ? ctxbase + (size_t)b * cbs * DM : latbase + ((size_t)b * lbs + (size_t)(tb - 1) * 256) * DM;
        const float* g1 = modl + (size_t)((tb == 0) ? 4 : b) * NMOD + 2 * DM;
        const int rl0 = wr * 64 + fr, col0 = u.colbase + wc * 32 + 4 * fq;
        f32x4 gv[2][2];
#pragma unroll
        for (int bj = 0; bj < 2; ++bj)
#pragma unroll
            for (int n = 0; n < 2; ++n) gv[bj][n] = *(const f32x4*)(g1 + col0 + bj * HALF + n * 16);
#pragma unroll
        for (int ai = 0; ai < 2; ++ai)
#pragma unroll
            for (int m = 0; m < 4; ++m) { const int rl = rl0 + ai * HALF + m * 16; const float* sp = src + (size_t)rl * DM + col0; float* dp = xout + (size_t)(u.rowbase + rl) * DM + col0;
#pragma unroll
                for (int bj = 0; bj < 2; ++bj)
#pragma unroll
                    for (int n = 0; n < 2; ++n) { const f32x4 xv = *(const f32x4*)(sp + bj * HALF + n * 16); *(f32x4*)(dp + bj * HALF + n * 16) = xv + gv[bj][n] * acc[ai][bj][m][n]; } }
    }
};
struct EpiSwiGLU {
    static constexpr bool PERM = true;
    bf16_t* Hout;
    __device__ __forceinline__ void operator()(const f32x4 (&acc)[2][2][4][2], const Unit& u, int wr, int wc, int fr, int fq) const {
        const int row0 = u.rowbase + wr * 64 + fr, col0 = u.pn * HALF + wc * 32 + 8 * fq;
#pragma unroll
        for (int ai = 0; ai < 2; ++ai)
#pragma unroll
            for (int m = 0; m < 4; ++m) { bf16_t* rowp = Hout + (size_t)(row0 + ai * HALF + m * 16) * DM + col0; float h[8];
#pragma unroll
                for (int n = 0; n < 2; ++n)
#pragma unroll
                    for (int j = 0; j < 4; ++j) { const float g = acc[ai][0][m][n][j], up = acc[ai][1][m][n][j]; h[n * 4 + j] = g * __builtin_amdgcn_rcpf(1.f + __expf(-g)) * up; }
                u32x4 w; w.x = cvt_pk_bf16(h[0], h[1]); w.y = cvt_pk_bf16(h[2], h[3]); w.z = cvt_pk_bf16(h[4], h[5]); w.w = cvt_pk_bf16(h[6], h[7]);
                *(u32x4*)rowp = w; }
    }
};
struct EpiDown {
    static constexpr bool PERM = true;
    bf16_t* Y; const float* gatev;
    __device__ __forceinline__ void operator()(const f32x4 (&acc)[2][2][4][2], const Unit& u, int wr, int wc, int fr, int fq) const {
        const int row0 = u.rowbase + wr * 64 + fr, col0 = u.colbase + wc * 32 + 8 * fq;
#pragma unroll
        for (int ai = 0; ai < 2; ++ai)
#pragma unroll
            for (int m = 0; m < 4; ++m) { const int row = row0 + ai * HALF + m * 16; const float gt = gatev[row]; bf16_t* rowp = Y + (size_t)row * DM + col0;
#pragma unroll
                for (int bj = 0; bj < 2; ++bj) { const f32x4 v0 = acc[ai][bj][m][0] * gt, v1 = acc[ai][bj][m][1] * gt;
                    u32x4 w; w.x = cvt_pk_bf16(v0[0], v0[1]); w.y = cvt_pk_bf16(v0[2], v0[3]); w.z = cvt_pk_bf16(v1[0], v1[1]); w.w = cvt_pk_bf16(v1[2], v1[3]);
                    *(u32x4*)(rowp + bj * HALF) = w; } }
    }
};

template <class Epi, class Sched, bool ALIGN_EPI = true, bool SP2 = true>
__device__ __forceinline__ void gemm_phase(LAS unsigned char* lds, const Sched& S, const Epi& E) {
    const int tid = opaque_tid(), wid = __builtin_amdgcn_readfirstlane(tid >> 6), lane = tid & 63, wr = wid >> 2, wc = wid & 3, fr = lane & 15, fq = lane >> 4;
    constexpr int K = GK, nt = K / BK;
    unsigned voffA[2], voffB[2];
#pragma unroll
    for (int i = 0; i < 2; ++i) { int R, C; stage_rc(tid * 16 + i * 8192, R, C); const int Rb = Epi::PERM ? ((R & ~31) + perm32(R & 31)) : R;
        voffA[i] = (unsigned)(R * K + C) * 2u; voffB[i] = (unsigned)(Rb * K + C) * 2u; }
    const size_t kstep = (size_t)(BK * 2);
    const size_t hstep = (size_t)HALF * K * 2;
    const unsigned ldsw = (unsigned)wid * 1024u;
    const int aoff = lds_byte(wr * 64 + fr, fq * 8), boff = lds_byte(wc * 32 + fr, fq * 8);
#define PG8_SA(b, h) (((b) * 2 + (h)) * HTB)
#define PG8_SB(b, h) ((4 + (b) * 2 + (h)) * HTB)
#define PG8_STAGE(bufoff, gbase, voff) do { _Pragma("unroll") for (int _i = 0; _i < 2; ++_i) \
        __builtin_amdgcn_global_load_lds((const unsigned*)((const char*)(gbase) + (voff)[_i]), (LAS unsigned*)(lds + (bufoff) + ldsw + _i * 8192), 16, 0, 0); } while (0)
#define PG8_LDA(dst, b, h) do { _Pragma("unroll") for (int m = 0; m < 4; ++m) _Pragma("unroll") for (int k = 0; k < 2; ++k) dst[m][k] = *(const LAS bf16x8*)(lds + PG8_SA(b, h) + aoff + m * 2048 + k * 1024); } while (0)
#define PG8_LDB(dst, b, h) do { _Pragma("unroll") for (int n = 0; n < 2; ++n) _Pragma("unroll") for (int k = 0; k < 2; ++k) dst[n][k] = *(const LAS bf16x8*)(lds + PG8_SB(b, h) + boff + n * 2048 + k * 1024); } while (0)
#define PG8_MMA(ai, bj, At, Bt) do { __builtin_amdgcn_s_setprio(1); _Pragma("unroll") for (int m = 0; m < 4; ++m) _Pragma("unroll") for (int n = 0; n < 2; ++n) _Pragma("unroll") for (int k = 0; k < 2; ++k) \
        acc[ai][bj][m][n] = __builtin_amdgcn_mfma_f32_16x16x32_bf16(Bt[n][k], At[m][k], acc[ai][bj][m][n], 0, 0, 0); __builtin_amdgcn_s_setprio(0); } while (0)
#define PG8_WAIT_V(n) asm volatile("s_waitcnt vmcnt(" #n ")" ::: "memory")
#define PG8_WAIT_L(n) asm volatile("s_waitcnt lgkmcnt(" #n ")" ::: "memory")
#define PG8_BAR __builtin_amdgcn_s_barrier()
#define PG8_SCHED __builtin_amdgcn_sched_barrier(0)
    Unit cur, nxt; int ui = 0;
    if (!S.next(0, cur)) return;
    f32x4 acc[2][2][4][2];
#pragma unroll
    for (int a = 0; a < 2; ++a)
#pragma unroll
        for (int b = 0; b < 2; ++b)
#pragma unroll
            for (int m = 0; m < 4; ++m)
#pragma unroll
                for (int n = 0; n < 2; ++n) acc[a][b][m][n] = (f32x4){0.f, 0.f, 0.f, 0.f};
    bf16x8 At[4][2], B0[2][2], B1[2][2];
    const char* cA = cur.a; const char* cB = cur.b;
    if constexpr (SP2) {
        PG8_STAGE(PG8_SB(0, 0), cB, voffB); PG8_STAGE(PG8_SB(0, 1), cB + hstep, voffB); PG8_STAGE(PG8_SA(0, 0), cA, voffA); PG8_STAGE(PG8_SA(0, 1), cA + hstep, voffA);
        if (wr == 1) PG8_BAR;
        PG8_WAIT_V(2); PG8_BAR;
        PG8_STAGE(PG8_SB(1, 0), cB + kstep, voffB); PG8_STAGE(PG8_SA(1, 0), cA + kstep, voffA); PG8_STAGE(PG8_SB(1, 1), cB + hstep + kstep, voffB);
        PG8_WAIT_V(6); PG8_BAR;
    } else {
        PG8_STAGE(PG8_SB(0, 0), cB, voffB); PG8_STAGE(PG8_SA(0, 0), cA, voffA); PG8_STAGE(PG8_SB(0, 1), cB + hstep, voffB); PG8_STAGE(PG8_SA(0, 1), cA + hstep, voffA);
        if (wr == 1) PG8_BAR;
        PG8_WAIT_V(4); PG8_BAR;
        PG8_STAGE(PG8_SB(1, 0), cB + kstep, voffB); PG8_STAGE(PG8_SA(1, 0), cA + kstep, voffA); PG8_STAGE(PG8_SB(1, 1), cB + hstep + kstep, voffB);
        PG8_WAIT_V(6); PG8_BAR;
    }
    for (;;) {
        const bool has_next = S.next(ui + 1, nxt);
        const char* nA = has_next ? nxt.a : cA; const char* nB = has_next ? nxt.b : cB;
        for (int t = 0; t < nt; t += 2) {
            const bool last = (t == nt - 2);
            const char* a1 = cA + (size_t)(t + 1) * kstep;
            const char* a2 = last ? nA : cA + (size_t)(t + 2) * kstep; const char* b2 = last ? nB : cB + (size_t)(t + 2) * kstep;
            const char* a3 = a2 + kstep; const char* b3 = b2 + kstep;
            if constexpr (SP2) {
            PG8_LDB(B0, 0, 0); PG8_LDB(B1, 0, 1); PG8_SCHED; PG8_LDA(At, 0, 0); PG8_STAGE(PG8_SA(1, 1), a1 + hstep, voffA);
            PG8_WAIT_V(8); PG8_WAIT_L(0); PG8_BAR; PG8_MMA(0, 0, At, B0); PG8_MMA(0, 1, At, B1); PG8_BAR; PG8_SCHED;
            PG8_LDA(At, 0, 1); PG8_STAGE(PG8_SB(0, 0), b2, voffB); PG8_STAGE(PG8_SB(0, 1), b2 + hstep, voffB); PG8_STAGE(PG8_SA(0, 0), a2, voffA);
            PG8_WAIT_V(8); PG8_WAIT_L(0); PG8_BAR; PG8_MMA(1, 0, At, B0); PG8_MMA(1, 1, At, B1); PG8_BAR; PG8_SCHED;
            PG8_LDB(B0, 1, 0); PG8_LDB(B1, 1, 1); PG8_SCHED; PG8_LDA(At, 1, 0); PG8_STAGE(PG8_SA(0, 1), a2 + hstep, voffA);
            PG8_WAIT_V(8); PG8_WAIT_L(0); PG8_BAR; PG8_MMA(0, 0, At, B0); PG8_MMA(0, 1, At, B1); PG8_BAR; PG8_SCHED;
            PG8_LDA(At, 1, 1); PG8_STAGE(PG8_SB(1, 0), b3, voffB); PG8_STAGE(PG8_SB(1, 1), b3 + hstep, voffB); PG8_STAGE(PG8_SA(1, 0), a3, voffA);
            PG8_WAIT_V(8); PG8_WAIT_L(0); PG8_BAR; PG8_MMA(1, 0, At, B0); PG8_MMA(1, 1, At, B1); PG8_BAR; PG8_SCHED;
            } else {
            PG8_LDB(B0, 0, 0); PG8_SCHED; PG8_LDA(At, 0, 0); PG8_STAGE(PG8_SA(1, 1), a1 + hstep, voffA);
            PG8_WAIT_L(8); PG8_BAR; PG8_WAIT_L(0); PG8_MMA(0, 0, At, B0); PG8_BAR; PG8_SCHED;
            PG8_LDB(B1, 0, 1); PG8_STAGE(PG8_SB(0, 0), b2, voffB);
            PG8_BAR; PG8_WAIT_L(0); PG8_MMA(0, 1, At, B1); PG8_BAR;
            PG8_LDA(At, 0, 1); PG8_STAGE(PG8_SA(0, 0), a2, voffA);
            PG8_BAR; PG8_WAIT_L(0); PG8_MMA(1, 0, At, B0); PG8_BAR; PG8_SCHED;
            PG8_STAGE(PG8_SB(0, 1), b2 + hstep, voffB);
            PG8_WAIT_V(6); PG8_BAR; PG8_MMA(1, 1, At, B1); PG8_BAR;
            PG8_LDB(B0, 1, 0); PG8_SCHED; PG8_LDA(At, 1, 0); PG8_STAGE(PG8_SA(0, 1), a2 + hstep, voffA);
            PG8_WAIT_L(8); PG8_BAR; PG8_WAIT_L(0); PG8_MMA(0, 0, At, B0); PG8_BAR; PG8_SCHED;
            PG8_LDB(B1, 1, 1); PG8_STAGE(PG8_SB(1, 0), b3, voffB);
            PG8_BAR; PG8_WAIT_L(0); PG8_MMA(0, 1, At, B1); PG8_BAR;
            PG8_LDA(At, 1, 1); PG8_STAGE(PG8_SA(1, 0), a3, voffA);
            PG8_BAR; PG8_WAIT_L(0); PG8_MMA(1, 0, At, B0); PG8_BAR; PG8_SCHED;
            PG8_STAGE(PG8_SB(1, 1), b3 + hstep, voffB);
            PG8_WAIT_V(6); PG8_BAR; PG8_MMA(1, 1, At, B1); PG8_BAR;
            }
        }
        if constexpr (ALIGN_EPI) { if (wr == 0) PG8_BAR; }
        E(acc, cur, wr, wc, fr, fq);
        if (!has_next) break;
#pragma unroll
        for (int a = 0; a < 2; ++a)
#pragma unroll
            for (int b = 0; b < 2; ++b)
#pragma unroll
                for (int m = 0; m < 4; ++m)
#pragma unroll
                    for (int n = 0; n < 2; ++n) acc[a][b][m][n] = (f32x4){0.f, 0.f, 0.f, 0.f};
        cur = nxt; cA = nA; cB = nB; ++ui;
        if constexpr (ALIGN_EPI) { if (wr == 1) PG8_BAR; }
    }
    PG8_WAIT_V(0);
    if constexpr (!ALIGN_EPI) { if (wr == 0) PG8_BAR; }
    PG8_BAR;
#undef PG8_SA
#undef PG8_SB
#undef PG8_STAGE
#undef PG8_LDA
#undef PG8_LDB
#undef PG8_MMA
#undef PG8_WAIT_V
#undef PG8_WAIT_L
#undef PG8_BAR
#undef PG8_SCHED
}
}

namespace at {
constexpr int D = 128, NW = 8, QBLK = 32, KVBLK = 64;
constexpr float SCALE = 0.088388347648318440f;
constexpr float THR = 8.f;
constexpr int LDQ = INW, LDK = INW, LDO = DM;
constexpr size_t SHM_V = KVBLK * D * 2, SHM_K = KVBLK * D * 2, SHM_ATTN = 2 * SHM_V + 2 * SHM_K + NW * 64 * 4;
#define KSWZ(row, colB) ((row) * 256 + ((colB) ^ (((row) & 7) << 4)))
#define SBAR() __builtin_amdgcn_sched_barrier(0)
__device__ __forceinline__ int crow(int r, int hi) { return (r & 3) + 8 * (r >> 2) + 4 * hi; }
__device__ __forceinline__ unsigned cvtpk(float lo, float hi) { unsigned r; asm volatile("v_cvt_pk_bf16_f32 %0, %1, %2" : "=v"(r) : "v"(lo), "v"(hi)); return r; }

__device__ __forceinline__ void partialSM(f32x16& p0, f32x16& p1, float& m_reg, float& mn, float& alpha, bool domask, int dq, int hi) {
  constexpr float C = SCALE * 1.4426950408889634f;
  {
    if (domask) {
#pragma unroll
      for (int r = 0; r < 16; ++r) { const int d0 = dq + crow(r, hi), d1 = d0 + 32;
        if (d0 > 128 || d0 < -128) p0[r] = -1e30f;
        if (d1 > 128 || d1 < -128) p1[r] = -1e30f; }
    }
  }
  float pmax = p0[0]; for (int r = 1; r < 16; ++r) pmax = fmaxf(pmax, p0[r]); for (int r = 0; r < 16; ++r) pmax = fmaxf(pmax, p1[r]);
  { auto rr = __builtin_amdgcn_permlane32_swap(__float_as_uint(pmax), __float_as_uint(pmax), false, false);
    pmax = fmaxf(__uint_as_float(rr[0]), __uint_as_float(rr[1])); }
  if (__builtin_expect(__all(pmax - m_reg <= THR / SCALE), 1)) { mn = m_reg; alpha = 1.f; }
  else { mn = fmaxf(m_reg, pmax); alpha = __builtin_amdgcn_exp2f((m_reg - mn) * C); m_reg = mn; }
  float mnC = -mn * C;
  for (int r = 0; r < 16; ++r) p0[r] = fmaf(p0[r], C, mnC); for (int r = 0; r < 16; ++r) p1[r] = fmaf(p1[r], C, mnC);
  for (int r = 0; r < 16; ++r) p0[r] = __builtin_amdgcn_exp2f(p0[r]);
}
__device__ __forceinline__ void finishSM(f32x16& p0, f32x16& p1, float alpha, float& l_reg, bf16x8& pa0, bf16x8& pa1, bf16x8& pa2, bf16x8& pa3) {
  for (int r = 0; r < 16; ++r) p1[r] = __builtin_amdgcn_exp2f(p1[r]);
  float ps = 0; for (int r = 0; r < 16; ++r) ps += p0[r]; for (int r = 0; r < 16; ++r) ps += p1[r];
  { auto rr = __builtin_amdgcn_permlane32_swap(__float_as_uint(ps), __float_as_uint(ps), false, false);
    ps = __uint_as_float(rr[0]) + __uint_as_float(rr[1]); }
  l_reg = l_reg * alpha + ps;
#define PK4(P, BASE, OUT) do { unsigned a0 = cvtpk(P[BASE + 0], P[BASE + 1]), a1 = cvtpk(P[BASE + 2], P[BASE + 3]);   \
    unsigned b0 = cvtpk(P[BASE + 4], P[BASE + 5]), b1 = cvtpk(P[BASE + 6], P[BASE + 7]);                              \
    auto r0 = __builtin_amdgcn_permlane32_swap(a0, b0, false, false); auto r1 = __builtin_amdgcn_permlane32_swap(a1, b1, false, false); \
    u32x4 w = {r0[0], r1[0], r0[1], r1[1]}; OUT = *reinterpret_cast<bf16x8*>(&w); } while (0)
  PK4(p0, 0, pa0); PK4(p0, 8, pa1); PK4(p1, 0, pa2); PK4(p1, 8, pa3);
#undef PK4
}
__device__ __forceinline__ void qkt(f32x16& p0, f32x16& p1, const char* Ks, const bf16x8* qr, int r32, int hi) {
  p0 = f32x16{}; p1 = f32x16{};
#pragma unroll
  for (int d0 = 0; d0 < 8; ++d0) { int cb = (d0 * 16 + hi * 8) * 2;
    bf16x8 b0 = *reinterpret_cast<const bf16x8*>(Ks + KSWZ(r32, cb));
    bf16x8 b1 = *reinterpret_cast<const bf16x8*>(Ks + KSWZ(32 + r32, cb));
    p0 = __builtin_amdgcn_mfma_f32_32x32x16_bf16(b0, qr[d0], p0, 0, 0, 0);
    p1 = __builtin_amdgcn_mfma_f32_32x32x16_bf16(b1, qr[d0], p1, 0, 0, 0); }
}
__device__ __forceinline__ int v_st(int k, int c) { const int kk = (k & ~0xC) | ((k & 4) << 1) | ((k & 8) >> 1); return ((kk >> 3) * 4 + (c >> 5)) * 512 + ((kk & 7) * 32 + (c & 31)) * 2; }
__device__ __forceinline__ int v_rd_base(int lane) { return ((lane & 3) << 3) | (((lane >> 2) & 3) << 6) | (((lane >> 4) & 1) << 5) | (((lane >> 5) & 1) << 8); }
constexpr int v_rd_off(int d0, int ks, int half) { return d0 * 512 + ks * 4096 + half * 2048; }
template <int OFF> __device__ __forceinline__ s16x4 tr_read(int vb) {
  s16x4 r; asm volatile("ds_read_b64_tr_b16 %0, %1 offset:%2" : "=&v"(r) : "v"(vb), "i"(OFF) : "memory"); return r;
}
template <int D0> __device__ __forceinline__ void pv_one(f32x16& od, int vb, bf16x8 pa0, bf16x8 pa1, bf16x8 pa2, bf16x8 pa3) {
  const s16x4 l0 = tr_read<v_rd_off(D0, 0, 0)>(vb), h0 = tr_read<v_rd_off(D0, 0, 1)>(vb), l1 = tr_read<v_rd_off(D0, 1, 0)>(vb), h1 = tr_read<v_rd_off(D0, 1, 1)>(vb);
  const s16x4 l2 = tr_read<v_rd_off(D0, 2, 0)>(vb), h2 = tr_read<v_rd_off(D0, 2, 1)>(vb), l3 = tr_read<v_rd_off(D0, 3, 0)>(vb), h3 = tr_read<v_rd_off(D0, 3, 1)>(vb);
  asm volatile("s_waitcnt lgkmcnt(0)" ::: "memory"); SBAR();
#define PK(L, H) (bf16x8){L[0], L[1], L[2], L[3], H[0], H[1], H[2], H[3]}
  od = __builtin_amdgcn_mfma_f32_32x32x16_bf16(pa0, PK(l0, h0), od, 0, 0, 0);
  od = __builtin_amdgcn_mfma_f32_32x32x16_bf16(pa1, PK(l1, h1), od, 0, 0, 0);
  od = __builtin_amdgcn_mfma_f32_32x32x16_bf16(pa2, PK(l2, h2), od, 0, 0, 0);
  od = __builtin_amdgcn_mfma_f32_32x32x16_bf16(pa3, PK(l3, h3), od, 0, 0, 0);
#undef PK
}
__device__ __forceinline__ void pv_d0(f32x16* o, int vb, bf16x8 pa0, bf16x8 pa1, bf16x8 pa2, bf16x8 pa3) {
  pv_one<0>(o[0], vb, pa0, pa1, pa2, pa3); pv_one<1>(o[1], vb, pa0, pa1, pa2, pa3); pv_one<2>(o[2], vb, pa0, pa1, pa2, pa3); pv_one<3>(o[3], vb, pa0, pa1, pa2, pa3);
}

__device__ __forceinline__ void attn_body(const bf16_t* __restrict__ Qb, const bf16_t* __restrict__ Kb, const bf16_t* __restrict__ Vb, bf16_t* __restrict__ Ob,
                                          int NT, int kskip, int qpos0, float m0, float l0, bool maskon, char* lds) {
  const int tid = opaque_tid(), wid = tid >> 6, lane = tid & 63, r32 = lane & 31, hi = lane >> 5;
  char* V_lds = lds; char* K_lds = lds + 2 * SHM_V;
  float* ws = (float*)(lds + 2 * SHM_V + 2 * SHM_K) + wid * 64; float* li_l = ws; float* al_l = ws + 32;
  float m_reg = m0, l_reg = l0; f32x16 o[4] = {}; bf16x8 qr[8];
  const bf16_t* Qw = Qb + (long)(wid * QBLK + r32) * LDQ + hi * 8;
#pragma unroll
  for (int d0 = 0; d0 < 8; ++d0) qr[d0] = *reinterpret_cast<const bf16x8*>(Qw + d0 * 16);
  const int sr = tid >> 4, sc = (tid & 15) * 8, vst0 = v_st(sr, sc), vst1 = v_st(32 + sr, sc);
  const int vb0 = (int)(uintptr_t)V_lds + v_rd_base(lane);
  const int qpos = qpos0 + wid * QBLK + r32;
  const unsigned goff0 = (unsigned)(sr * LDK + sc) * 2u, goff1 = goff0 + 32u * LDK * 2u;
  struct { bf16x8 vs0, vs1, ks0, ks1; } sr_[2];
#define TROW(jt) ((long)(jt) * KVBLK + ((jt) >= 4 ? kskip : 0))
#define SLOAD(i, jt) do { const long _k0 = TROW(jt) * (LDK * 2); const char* _kp = (const char*)Kb + _k0; const char* _vp = (const char*)Vb + _k0; \
    sr_[i].vs0 = *reinterpret_cast<const bf16x8*>(_vp + goff0); sr_[i].vs1 = *reinterpret_cast<const bf16x8*>(_vp + goff1); \
    sr_[i].ks0 = *reinterpret_cast<const bf16x8*>(_kp + goff0); sr_[i].ks1 = *reinterpret_cast<const bf16x8*>(_kp + goff1); } while (0)
#define SWRITE(b, i) do { *(bf16x8*)(V_lds + (b) * SHM_V + vst0) = sr_[i].vs0;          \
    *(bf16x8*)(V_lds + (b) * SHM_V + vst1) = sr_[i].vs1; int kc = sc * 2;               \
    *(bf16x8*)(K_lds + (b) * SHM_K + KSWZ(sr, kc)) = sr_[i].ks0;                       \
    *(bf16x8*)(K_lds + (b) * SHM_K + KSWZ(32 + sr, kc)) = sr_[i].ks1; } while (0)
#define SWAIT() asm volatile("s_waitcnt vmcnt(4)" ::: "memory")
#define RESC(a) do { if (__any((a) < 1.f)) { if (hi == 0) al_l[r32] = (a); asm volatile("s_waitcnt lgkmcnt(0)" ::: "memory"); \
    for (int d = 0; d < 4; ++d) for (int r = 0; r < 16; ++r) o[d][r] *= al_l[crow(r, hi)]; } } while (0)
#define DQ(jt) (kskip + ((jt) - 4) * KVBLK - qpos)
  f32x16 pA0, pA1, pB0, pB1; float mnA, mnB, alA, alB; bf16x8 pa0, pa1, pa2, pa3;
  constexpr int SE = 0, SO = 1;
  SLOAD(SE, 0); asm volatile("s_waitcnt vmcnt(0)" ::: "memory"); SWRITE(0, SE); __syncthreads();
  qkt(pA0, pA1, K_lds, qr, r32, hi); partialSM(pA0, pA1, m_reg, mnA, alA, false, 0, hi);
  SLOAD(SO, 1); if (2 < NT) SLOAD(SE, 2);
  SWAIT(); SWRITE(1, SO); __syncthreads();
  for (int j = 1; j + 1 < NT; j += 2) {
    SBAR(); qkt(pB0, pB1, K_lds + SHM_K, qr, r32, hi);
    finishSM(pA0, pA1, alA, l_reg, pa0, pa1, pa2, pa3); SBAR();
    SLOAD(SO, j + 2); SBAR();
    pv_d0(o, vb0, pa0, pa1, pa2, pa3); partialSM(pB0, pB1, m_reg, mnB, alB, maskon && j >= 4, DQ(j), hi);
    __syncthreads(); SWAIT(); SWRITE(0, SE);
    RESC(alB); __syncthreads();
    SBAR(); qkt(pA0, pA1, K_lds, qr, r32, hi);
    finishSM(pB0, pB1, alB, l_reg, pa0, pa1, pa2, pa3); SBAR();
    if (j + 3 < NT) SLOAD(SE, j + 3); SBAR();
    pv_d0(o, vb0 + (int)SHM_V, pa0, pa1, pa2, pa3); partialSM(pA0, pA1, m_reg, mnA, alA, maskon && j + 1 >= 4, DQ(j + 1), hi);
    __syncthreads(); SWAIT(); SWRITE(1, SO);
    RESC(alA); __syncthreads();
  }
  SBAR(); qkt(pB0, pB1, K_lds + SHM_K, qr, r32, hi);
  finishSM(pA0, pA1, alA, l_reg, pa0, pa1, pa2, pa3); SBAR();
  pv_d0(o, vb0, pa0, pa1, pa2, pa3); partialSM(pB0, pB1, m_reg, mnB, alB, maskon && NT - 1 >= 4, DQ(NT - 1), hi);
  __syncthreads(); RESC(alB);
  finishSM(pB0, pB1, alB, l_reg, pa0, pa1, pa2, pa3); SBAR();
  pv_d0(o, vb0 + (int)SHM_V, pa0, pa1, pa2, pa3);
  if (hi == 0) li_l[r32] = l_reg; asm volatile("s_waitcnt lgkmcnt(0)" ::: "memory");
  float rli[16];
#pragma unroll
  for (int r = 0; r < 16; ++r) rli[r] = __builtin_amdgcn_rcpf(li_l[crow(r, hi)]);
  bf16_t* Ow = Ob + (long)(wid * QBLK) * LDO;
#pragma unroll
  for (int r = 0; r < 16; ++r) { int orow = crow(r, hi);
    for (int d0 = 0; d0 < 4; ++d0) Ow[(long)orow * LDO + d0 * 32 + r32] = (bf16_t)f2bf(o[d0][r] * rli[r]); }
#undef TROW
#undef SLOAD
#undef SWRITE
#undef SWAIT
#undef RESC
#undef DQ
}
}

struct Args { const float* in[23]; float* out; unsigned char* ws; int ph_lo, ph_hi; };
enum { IN_X = 0, IN_C, IN_CTX, IN_CCTX, IN_WMOD, IN_BMOD, IN_N1G, IN_N2G, IN_WIN, IN_QNA, IN_KNA, IN_SINK, IN_VNB, IN_WS, IN_BS, IN_QNC, IN_KNC, IN_OUTG, IN_WOUT, IN_WR, IN_WG, IN_WU, IN_WDN };

#define PHASE_IDS(F) const int tid = opaque_tid(), lane = tid & 63, wave = __builtin_amdgcn_readfirstlane(tid >> 6), gw = (int)blockIdx.x * 8 + wave, NGW = (F).G * 8; (void)lane; (void)wave; (void)gw; (void)NGW
struct Frame {
    LAS unsigned char* lds; char* ldsg;
    volatile LAS unsigned* MISC;
    unsigned* ctl;
    int G;
    const float* const* in; float* out; unsigned char* ws;
};

__device__ __forceinline__ void transpose_item(const float* W, int N, bf16_t* WT, int k0, int n0, int drow0, LAS float* scr, int lane) {
#pragma unroll 8
    for (int i = 0; i < 32; ++i) { const int kk = 2 * i + (lane >> 5); scr[kk * 33 + (lane & 31)] = W[(size_t)(k0 + kk) * N + n0 + (lane & 31)]; }
    LDS_WAIT(); asm volatile("" ::: "memory");
    const int c = lane & 7;
#pragma unroll
    for (int j = 0; j < 4; ++j) { const int n = (lane >> 3) + 8 * j; const LAS float* s = scr + (8 * c) * 33 + n;
        u32x4 o; o.x = pk2(s[0 * 33], s[1 * 33]); o.y = pk2(s[2 * 33], s[3 * 33]); o.z = pk2(s[4 * 33], s[5 * 33]); o.w = pk2(s[6 * 33], s[7 * 33]);
        *(u32x4*)(WT + (size_t)(drow0 + n) * DM + k0 + 8 * c) = o; }
    LDS_WAIT(); asm volatile("" ::: "memory");
}

__device__ __forceinline__ void phase_prologue(Frame& F) {
    PHASE_IDS(F);
    LAS float* scr = (LAS float*)(F.lds + wave * 16384);
    constexpr int I_IN = 32 * (INW / 32), I_SQ = 32 * (DM / 32);
    constexpr int NIT = 2 * I_IN + 2 * I_SQ + 2 * NE * 3 * I_SQ;
    for (int it = gw; it < NIT; it += NGW) {
        int r = it;
        if (r < 2 * I_IN) { const int l = r / I_IN; r %= I_IN; const int nblk = INW / 32, kb = r / nblk, nb = r % nblk;
            transpose_item(F.in[IN_WIN] + (size_t)l * DM * INW, INW, (bf16_t*)(F.ws + WS_WIN) + (size_t)l * INW * DM, 64 * kb, 32 * nb, 32 * nb, scr, lane); continue; }
        r -= 2 * I_IN;
        if (r < 2 * I_SQ) { const int l = r / I_SQ; r %= I_SQ; const int kb = r / 64, nb = r % 64;
            transpose_item(F.in[IN_WOUT] + (size_t)l * DM * DM, DM, (bf16_t*)(F.ws + WS_WOUT) + (size_t)l * DM * DM, 64 * kb, 32 * nb, 32 * nb, scr, lane); continue; }
        r -= 2 * I_SQ;
        const int mat = r / I_SQ; r %= I_SQ; const int kb = r / 64, nb = r % 64;
        const int le = mat / 3, which = mat % 3;
        if (which < 2) {
            const float* W = F.in[which == 0 ? IN_WG : IN_WU] + (size_t)le * DM * DM; const int n0 = 32 * nb;
            transpose_item(W, DM, (bf16_t*)(F.ws + WS_WGU) + (size_t)le * 4096 * DM, 64 * kb, n0, (n0 >> 7) * 256 + which * 128 + (n0 & 127), scr, lane);
        } else {
            transpose_item(F.in[IN_WDN] + (size_t)le * DM * DM, DM, (bf16_t*)(F.ws + WS_WD) + (size_t)le * DM * DM, 64 * kb, 32 * nb, 32 * nb, scr, lane);
        }
    }
    __syncthreads();
    {
        LAS float* sil = (LAS float*)F.lds;
        LAS float* red = (LAS float*)(F.lds + 40960);
        bool have = false;
        for (int it = blockIdx.x; it < 2 * 96; it += F.G) {
            if (!have) {
                for (int i = tid; i < 5 * DM; i += 512) { const int s = i / DM, k = i % DM; const float cv = (s < 4) ? F.in[IN_C][s * DM + k] : F.in[IN_CCTX][k]; sil[i] = cv / (1.f + __expf(-cv)); }
                have = true; __syncthreads();
            }
            const int l = it / 96, cb = it % 96, c4 = tid & 31, kr = tid >> 5;
            const float* wp = F.in[IN_WMOD] + (size_t)l * DM * NMOD + (size_t)cb * 128 + c4 * 4;
            f32x4 a[5];
#pragma unroll
            for (int s = 0; s < 5; ++s) a[s] = (f32x4){0.f, 0.f, 0.f, 0.f};
#pragma unroll 8
            for (int k = kr; k < DM; k += 16) { const f32x4 w = *(const f32x4*)(wp + (size_t)k * NMOD);
#pragma unroll
                for (int s = 0; s < 5; ++s) a[s] += w * sil[s * DM + k]; }
#pragma unroll
            for (int s = 0; s < 5; ++s) *(LAS f32x4*)(red + (kr * 5 + s) * 128 + c4 * 4) = a[s];
            __syncthreads();
            for (int i = tid; i < 5 * 128; i += 512) { const int s = i / 128, cc = i % 128; float sum = 0.f;
#pragma unroll
                for (int q = 0; q < 16; ++q) sum += red[(q * 5 + s) * 128 + cc];
                ((float*)(F.ws + WS_MOD))[(size_t)(l * 5 + s) * NMOD + cb * 128 + cc] = sum + F.in[IN_BMOD][l * NMOD + cb * 128 + cc]; }
            __syncthreads();
        }
    }
    if (blockIdx.x == F.G - 1) {
        for (int i = tid; i < 64 * 32; i += 512) {
            const int pos = i >> 5, f = i & 31;
            double inv = 1.0; for (int q = 0; q < f; ++q) inv *= 0.7498942093324559;
            const double a = (double)pos * inv;
            const double n = __builtin_rint(a * 0.6366197723675814);
            const double r = (a - n * 1.5707963267948966) - n * 6.123233995736766e-17;
            const double r2 = r * r;
            double sn = r * (1.0 + r2 * (-1.0 / 6 + r2 * (1.0 / 120 + r2 * (-1.0 / 5040 + r2 * (1.0 / 362880 + r2 * (-1.0 / 39916800 + r2 * (1.0 / 6227020800.0)))))));
            double cn = 1.0 + r2 * (-0.5 + r2 * (1.0 / 24 + r2 * (-1.0 / 720 + r2 * (1.0 / 40320 + r2 * (-1.0 / 3628800 + r2 * (1.0 / 479001600 + r2 * (-1.0 / 87178291200.0)))))));
            const int q = ((int)n) & 3; double cs, ss;
            if (q == 0) { cs = cn; ss = sn; } else if (q == 1) { cs = -sn; ss = cn; } else if (q == 2) { cs = -cn; ss = -sn; } else { cs = sn; ss = -cn; }
            ((float*)(F.ws + WS_ROPE))[2 * i] = (float)cs; ((float*)(F.ws + WS_ROPE))[2 * i + 1] = (float)ss;
        }
    }
}

__device__ __forceinline__ void load_row(const float* row, int lane, f32x4 (&v)[8]) {
#pragma unroll
    for (int j = 0; j < 8; ++j) v[j] = *(const f32x4*)(row + 4 * lane + 256 * j);
}
__device__ __forceinline__ void norm_mod_store(const f32x4 (&v)[8], const float* g, const float* shift, const float* scale, bf16_t* dst, int lane) {
    float ss = 0.f;
#pragma unroll
    for (int j = 0; j < 8; ++j) ss += (v[j].x * v[j].x + v[j].y * v[j].y) + (v[j].z * v[j].z + v[j].w * v[j].w);
    const float rinv = 1.0f / sqrtf(wave_sum(ss) * (1.f / DM) + EPS);
#pragma unroll
    for (int j = 0; j < 8; ++j) { const int c = 4 * lane + 256 * j;
        const f32x4 gg = *(const f32x4*)(g + c), sh = *(const f32x4*)(shift + c), sc = *(const f32x4*)(scale + c);
        const f32x4 y = (v[j] * rinv) * gg * (sc + 1.f) + sh;
        u32x2 w; w.x = pk2(y.x, y.y); w.y = pk2(y.z, y.w); *(u32x2*)(dst + c) = w; }
}

__device__ __forceinline__ void phase_rowpass1_l0(Frame& F) {
    PHASE_IDS(F);
    const float* mod = (const float*)(F.ws + WS_MOD);
    for (int r = gw; r < NTOK; r += NGW) {
        const int b = r / TPB, t = r % TPB, s = (t < CTXL) ? 4 : b;
        const float* src = (t < CTXL) ? F.in[IN_CTX] + ((size_t)b * CTXL + t) * DM : F.in[IN_X] + ((size_t)b * SEQ + (t - CTXL)) * DM;
        f32x4 v[8]; load_row(src, lane, v);
        norm_mod_store(v, F.in[IN_N1G], mod + (size_t)s * NMOD, mod + (size_t)s * NMOD + DM, (bf16_t*)(F.ws + WS_HN) + (size_t)r * DM, lane);
    }
}

__device__ __forceinline__ void phase_post(Frame& F, int l) {
    PHASE_IDS(F);
    bf16_t* P = (bf16_t*)(F.ws + WS_P);
    const float* rope = (const float*)(F.ws + WS_ROPE);
    for (long it = gw; it < (long)NTOK * 28; it += NGW) {
        const int r = (int)(it / 28), slot = (int)(it % 28), t = r % TPB;
        if (slot == 8 || slot == 9 || slot >= 26) continue;
        bf16_t* p = P + (size_t)r * INW + slot * 128;
        float v0 = bf2f(p[lane]), v1 = bf2f(p[lane + 64]);
        if (slot >= 10 && slot < 14) { v0 = gelu_tanh(v0); v1 = gelu_tanh(v1); }
        else if (slot >= 14 && slot < 18) {
            v0 = gelu_tanh(v0); v1 = gelu_tanh(v1);
            const float rinv = 1.0f / sqrtf(wave_sum(v0 * v0 + v1 * v1) * (1.f / 128) + EPS);
            const float* g = F.in[IN_VNB] + l * 512 + (slot - 14) * 128;
            v0 = v0 * rinv * g[lane]; v1 = v1 * rinv * g[lane + 64];
        } else {
            const float* g = (slot < 6) ? F.in[IN_QNA] + l * 128 : (slot < 8) ? F.in[IN_KNA] + l * 128 : (slot < 24) ? F.in[IN_QNC] + l * 128 : F.in[IN_KNC] + l * 128;
            const float rinv = 1.0f / sqrtf(wave_sum(v0 * v0 + v1 * v1) * (1.f / 128) + EPS);
            v0 = v0 * rinv * g[lane]; v1 = v1 * rinv * g[lane + 64];
            if (t >= CTXL) {
                const int pos = t - CTXL, prow = pos >> 6, pcol = pos & 63, f = lane & 31;
                const f32x2 cr = *(const f32x2*)(rope + 2 * (prow * 32 + f)), cc = *(const f32x2*)(rope + 2 * (pcol * 32 + f));
                const float o0 = __shfl_xor(v0, 32), o1 = __shfl_xor(v1, 32);
                if (lane < 32) { v0 = v0 * cr.x - o0 * cr.y; v1 = v1 * cc.x - o1 * cc.y; }
                else           { v0 = v0 * cr.x + o0 * cr.y; v1 = v1 * cc.x + o1 * cc.y; }
            }
        }
        p[lane] = (bf16_t)f2bf(v0); p[lane + 64] = (bf16_t)f2bf(v1);
    }
}

__device__ __forceinline__ void mixer_b_unit(Frame& F, int l, int b, int ch, int g) {
    PHASE_IDS(F);
    const bf16_t* P = (const bf16_t*)(F.ws + WS_P); bf16_t* O = (bf16_t*)(F.ws + WS_O);
    const int row0 = b * TPB + ch * 128, w = wave;
    LAS bf16_t* VT = (LAS bf16_t*)F.lds;
    { const int q = tid >> 2, dp = (tid & 3) * 32; const bf16_t* src = P + (size_t)(row0 + q) * INW + C_VB + g * 128 + dp;
#pragma unroll
      for (int i = 0; i < 4; ++i) { const u32x4 x = *(const u32x4*)(src + 8 * i); const unsigned xs[4] = {x.x, x.y, x.z, x.w};
#pragma unroll
          for (int j = 0; j < 4; ++j) { VT[(dp + 8 * i + 2 * j) * 136 + q] = (bf16_t)(xs[j] & 0xffffu); VT[(dp + 8 * i + 2 * j + 1) * 136 + q] = (bf16_t)(xs[j] >> 16); } } }
    __syncthreads();
    const int i15 = lane & 15, kq = lane >> 4;
    f32x4 acc[8];
#pragma unroll
    for (int n = 0; n < 8; ++n) acc[n] = (f32x4){0.f, 0.f, 0.f, 0.f};
    const float* wsr = F.in[IN_WS] + ((size_t)(l * 4 + g) * 128 + 16 * w + i15) * 128;
#pragma unroll
    for (int s = 0; s < 4; ++s) {
        const f32x4 a0 = *(const f32x4*)(wsr + 32 * s + 8 * kq), a1 = *(const f32x4*)(wsr + 32 * s + 8 * kq + 4);
        u32x4 aw; aw.x = pk2(a0.x, a0.y); aw.y = pk2(a0.z, a0.w); aw.z = pk2(a1.x, a1.y); aw.w = pk2(a1.z, a1.w);
        const bf16x8 af = *reinterpret_cast<bf16x8*>(&aw);
#pragma unroll
        for (int n = 0; n < 8; ++n) { const bf16x8 bfr = *(const LAS bf16x8*)(VT + (16 * n + i15) * 136 + 32 * s + 8 * kq);
            acc[n] = __builtin_amdgcn_mfma_f32_16x16x32_bf16(af, bfr, acc[n], 0, 0, 0); }
    }
#pragma unroll
    for (int j = 0; j < 4; ++j) { const int p = 16 * w + kq * 4 + j; const float bias = F.in[IN_BS][(l * 4 + g) * 128 + p];
        const bf16_t* up = P + (size_t)(row0 + p) * INW + C_UB + g * 128; bf16_t* op = O + (size_t)(row0 + p) * DM + O_B + g * 128;
#pragma unroll
        for (int n = 0; n < 8; ++n) { const int d = 16 * n + i15; op[d] = (bf16_t)f2bf(bf2f(up[d]) * (acc[n][j] + bias)); } }
    __syncthreads();
}
__device__ __forceinline__ void phase_mixers(Frame& F, int l) {
    PHASE_IDS(F);
    const bf16_t* P = (const bf16_t*)(F.ws + WS_P); bf16_t* O = (bf16_t*)(F.ws + WS_O);
    const bool ctx = (l == 0);
    const int nC = 384, nA = 384, nCc = ctx ? 24 : 0, nAc = ctx ? 24 : 0, nB = 4 * 4 * 34;
    const int total = nC + nA + nCc + nAc + nB;
    unsigned* qctr = F.ctl + CW_QUEUE + 64 * l;
    for (;;) {
        if (tid == 0) F.MISC[0] = xb_add(qctr, 1u);
        __syncthreads();
        int u = (int)F.MISC[0];
        __syncthreads();
        if (u >= total) break;
        if (u < nC + nA + nCc + nAc) {
            int kind, b, h, qb = 0;
            if (u < nC) { kind = 0; b = u / 96; h = (u % 96) / 16; qb = u % 16; }
            else if (u < nC + nA) { const int v = u - nC; kind = 1; b = v / 96; h = (v % 96) / 16; qb = v % 16; }
            else if (u < nC + nA + nCc) { const int v = u - nC - nA; kind = 2; b = v / 6; h = v % 6; }
            else { const int v = u - nC - nA - nCc; kind = 3; b = v / 6; h = v % 6; }
            const int kv = h / 3, isA = kind & 1, lat = (kind < 2);
            const size_t r0 = (size_t)b * TPB, rq = r0 + (lat ? CTXL + qb * 256 : 0);
            const int q0 = qb * 256, ks = (kind == 1) ? ((q0 - 128 < 0) ? 0 : q0 - 128) : 0, ke = (q0 + 384 > SEQ) ? SEQ : q0 + 384;
            const int NT = (kind == 0) ? 68 : (kind == 1) ? 4 + (ke - ks) / 64 : 4;
            const float sink = F.in[IN_SINK][l * 6 + h];
            const int cq = (isA ? C_QA : C_QC) + h * 128, ck = (isA ? C_KA : C_KC) + kv * 128, cv = (isA ? C_VA : C_VC) + kv * 128, co = (isA ? O_A : O_C) + h * 128;
            at::attn_body(P + rq * INW + cq, P + r0 * INW + ck, P + r0 * INW + cv, O + rq * DM + co, NT, ks, q0, isA ? sink / at::SCALE : -1e30f, isA ? 1.f : 0.f, kind == 1, F.ldsg);
            continue; }
        u -= nC + nA + nCc;
        u -= nAc;
        { const int b = u / 136, ch = (u % 136) / 4, g = u % 4;
          if (!ctx && ch < 2) continue;
          mixer_b_unit(F, l, b, ch, g); }
    }
}

__device__ __forceinline__ void phase_groupnorm(Frame& F, int l) {
    PHASE_IDS(F);
    bf16_t* O = (bf16_t*)(F.ws + WS_O); const float* og = F.in[IN_OUTG] + l * DM;
    for (int r = gw; r < NTOK; r += NGW) {
        if (l == 1 && (r % TPB) < CTXL) continue;
        bf16_t* row = O + (size_t)r * DM;
#pragma unroll
        for (int grp = 0; grp < 3; ++grp) {
            const int c0 = (grp == 0) ? O_A : (grp == 1) ? O_B : O_C, wdt = (grp == 1) ? 512 : 768, per = wdt / 64;
            float v[12]; float ss = 0.f;
            bf16_t* p = row + c0 + lane * per;
#pragma unroll
            for (int i = 0; i < 12; i += 4) if (i < per) { const u32x2 x = *(const u32x2*)(p + i); v[i] = bflo(x.x); v[i + 1] = bfhi(x.x); v[i + 2] = bflo(x.y); v[i + 3] = bfhi(x.y);
                ss += (v[i] * v[i] + v[i + 1] * v[i + 1]) + (v[i + 2] * v[i + 2] + v[i + 3] * v[i + 3]); }
            const float rinv = 1.0f / sqrtf(wave_sum(ss) / (float)wdt + EPS);
            const float* gp = og + c0 + lane * per;
#pragma unroll
            for (int i = 0; i < 12; i += 4) if (i < per) { const f32x4 gg = *(const f32x4*)(gp + i);
                u32x2 w; w.x = pk2(v[i] * rinv * gg.x, v[i + 1] * rinv * gg.y); w.y = pk2(v[i + 2] * rinv * gg.z, v[i + 3] * rinv * gg.w); *(u32x2*)(p + i) = w; }
        }
    }
}

__device__ __forceinline__ void phase_rowpass2(Frame& F, int l) {
    PHASE_IDS(F);
    const float* mod = (const float*)(F.ws + WS_MOD) + (size_t)l * 5 * NMOD;
    const float* xb = (const float*)(F.ws + WS_XB);
    LAS float* wl = (LAS float*)F.lds;
    const float* wr = F.in[IN_WR] + (size_t)l * DM * NE;
    for (int i = tid; i < DM * NE; i += 512) wl[(i & 15) * DM + (i >> 4)] = wr[i];
    __syncthreads();
    const float* g = F.in[IN_N2G] + l * DM;
    for (int r = gw; r < NTOK; r += NGW) {
        const int b = r / TPB, t = r % TPB, s = (t < CTXL) ? 4 : b;
        if (l == 1 && t < CTXL) continue;
        f32x4 v[8]; load_row(xb + (size_t)r * DM, lane, v);
        float ss = 0.f;
#pragma unroll
        for (int j = 0; j < 8; ++j) ss += (v[j].x * v[j].x + v[j].y * v[j].y) + (v[j].z * v[j].z + v[j].w * v[j].w);
        const float rinv = 1.0f / sqrtf(wave_sum(ss) * (1.f / DM) + EPS);
        const float* shift = mod + (size_t)s * NMOD + 3 * DM; const float* scale = shift + DM;
        bf16_t* dst = (bf16_t*)(F.ws + WS_HN) + (size_t)r * DM;
#pragma unroll
        for (int j = 0; j < 8; ++j) { const int c = 4 * lane + 256 * j;
            const f32x4 gg = *(const f32x4*)(g + c), sh = *(const f32x4*)(shift + c), sc = *(const f32x4*)(scale + c);
            v[j] = (v[j] * rinv) * gg * (sc + 1.f) + sh;
            u32x2 w; w.x = pk2(v[j].x, v[j].y); w.y = pk2(v[j].z, v[j].w); *(u32x2*)(dst + c) = w; }
        float lg[16];
#pragma unroll
        for (int e = 0; e < 16; ++e) { float a = 0.f;
#pragma unroll
            for (int j = 0; j < 8; ++j) { const f32x4 w = *(const LAS f32x4*)(wl + e * DM + 4 * lane + 256 * j); a += (v[j].x * w.x + v[j].y * w.y) + (v[j].z * w.z + v[j].w * w.w); }
            lg[e] = wave_sum(a); }
        float mx = lg[0];
#pragma unroll
        for (int e = 1; e < 16; ++e) mx = fmaxf(mx, lg[e]);
        float den = 0.f, mine = 0.f;
#pragma unroll
        for (int e = 0; e < 16; ++e) { const float ex = __expf(lg[e] - mx); den += ex; mine = (lane == e) ? ex : mine; }
        if (lane < 16) {
            const float a = mine / den;
            if (t < CTXL) ((float*)(F.ws + WS_AFFC))[((size_t)b * NE + lane) * CTXL + t] = a;
            else ((float*)(F.ws + WS_AFFL))[((size_t)b * NE + lane) * SEQ + (t - CTXL)] = a;
        }
    }
    __syncthreads();
}

__device__ __forceinline__ void phase_topk(Frame& F, int l) {
    PHASE_IDS(F);
    LAS unsigned long long* key = (LAS unsigned long long*)F.lds;
    const int nunits = (l == 0) ? 128 : 64;
    for (int u = blockIdx.x; u < nunits; u += F.G) {
        const bool isc = u >= 64; const int uu = isc ? u - 64 : u, b = uu / NE, e = uu % NE;
        const int N = isc ? CTXL : SEQ, cap = isc ? CAP_C : CAP_L;
        const float* src = isc ? (const float*)(F.ws + WS_AFFC) + (size_t)uu * CTXL : (const float*)(F.ws + WS_AFFL) + (size_t)uu * SEQ;
        int* pos = isc ? (int*)(F.ws + WS_POSC) + (size_t)uu * CTXL : (int*)(F.ws + WS_POSL) + (size_t)uu * SEQ;
        for (int i = tid; i < N; i += 512) key[i] = ((unsigned long long)(~__float_as_uint(src[i])) << 32) | (unsigned)i;
        __syncthreads();
        for (int k = 2; k <= N; k <<= 1)
            for (int j = k >> 1; j > 0; j >>= 1) {
                for (int tt = tid; tt < N / 2; tt += 512) {
                    const int i = ((tt & ~(j - 1)) << 1) | (tt & (j - 1)), ij = i | j;
                    const bool up = ((i & k) == 0);
                    const unsigned long long a = key[i], c = key[ij];
                    if ((a > c) == up) { key[i] = c; key[ij] = a; }
                }
                __syncthreads();
            }
        const int slotbase = e * ROWS_E + (isc ? 2048 + b * CAP_C : b * CAP_L);
        for (int i = tid; i < N; i += 512) {
            const unsigned long long kk = key[i]; const int tok = (int)(unsigned)kk;
            pos[tok] = (i < cap) ? i : -1;
            if (i < cap) { ((int*)(F.ws + WS_RSRC))[slotbase + i] = b * TPB + (isc ? tok : CTXL + tok); ((float*)(F.ws + WS_GATE))[slotbase + i] = __uint_as_float(~(unsigned)(kk >> 32)); }
        }
        __syncthreads();
    }
}

__device__ __forceinline__ void phase_gather(Frame& F, int l) {
    PHASE_IDS(F);
    const int rows_e = (l == 0) ? 2176 : 2048;
    const bf16_t* hn = (const bf16_t*)(F.ws + WS_HN); bf16_t* xg = (bf16_t*)(F.ws + WS_XG); const int* rsrc = (const int*)(F.ws + WS_RSRC);
    for (int it = gw; it < NE * rows_e; it += NGW) {
        const int e = it / rows_e, sl = it % rows_e, row = e * ROWS_E + sl;
        const int src = __builtin_amdgcn_readfirstlane(rsrc[row]);
        const u32x4* sp = (const u32x4*)(hn + (size_t)src * DM) + lane; u32x4* dp = (u32x4*)(xg + (size_t)row * DM) + lane;
        u32x4 x[4];
#pragma unroll
        for (int j = 0; j < 4; ++j) x[j] = sp[64 * j];
#pragma unroll
        for (int j = 0; j < 4; ++j) dp[64 * j] = x[j];
    }
}

__device__ __forceinline__ void phase_combine(Frame& F, int l) {
    PHASE_IDS(F);
    const float* mod = (const float*)(F.ws + WS_MOD);
    float* xb = (float*)(F.ws + WS_XB); const bf16_t* Y = (const bf16_t*)(F.ws + WS_XG);
    for (int r = gw; r < NTOK; r += NGW) {
        const int b = r / TPB, t = r % TPB, s = (t < CTXL) ? 4 : b;
        if (l == 1 && t < CTXL) continue;
        f32x4 v[8]; load_row(xb + (size_t)r * DM, lane, v);
        f32x4 a[8];
#pragma unroll
        for (int j = 0; j < 8; ++j) a[j] = (f32x4){0.f, 0.f, 0.f, 0.f};
        for (int e = 0; e < NE; ++e) {
            int p, yrow;
            if (t < CTXL) { p = ((const int*)(F.ws + WS_POSC))[((size_t)b * NE + e) * CTXL + t]; yrow = e * ROWS_E + 2048 + b * CAP_C + p; }
            else { p = ((const int*)(F.ws + WS_POSL))[((size_t)b * NE + e) * SEQ + (t - CTXL)]; yrow = e * ROWS_E + b * CAP_L + p; }
            p = __builtin_amdgcn_readfirstlane(p);
            if (p >= 0) { const bf16_t* yr = Y + (size_t)yrow * DM + 4 * lane;
#pragma unroll
                for (int j = 0; j < 8; ++j) { const u32x2 y = *(const u32x2*)(yr + 256 * j); a[j] += (f32x4){bflo(y.x), bfhi(y.x), bflo(y.y), bfhi(y.y)}; } }
        }
        const float* g2 = mod + (size_t)(l * 5 + s) * NMOD + 5 * DM;
#pragma unroll
        for (int j = 0; j < 8; ++j) v[j] += *(const f32x4*)(g2 + 4 * lane + 256 * j) * a[j];
        if (l == 0) {
#pragma unroll
            for (int j = 0; j < 8; ++j) *(f32x4*)(xb + (size_t)r * DM + 4 * lane + 256 * j) = v[j];
            const float* m1 = mod + (size_t)(5 + s) * NMOD;
            norm_mod_store(v, F.in[IN_N1G] + DM, m1, m1 + DM, (bf16_t*)(F.ws + WS_HN) + (size_t)r * DM, lane);
        } else {
            float* op = F.out + ((size_t)b * SEQ + (t - CTXL)) * DM;
#pragma unroll
            for (int j = 0; j < 8; ++j) *(f32x4*)(op + 4 * lane + 256 * j) = v[j];
        }
    }
}

__device__ __forceinline__ void phase_dump_x(Frame& F, bool from_input) {
    PHASE_IDS(F);
    const float* xb = (const float*)(F.ws + WS_XB);
    for (int r = gw; r < NTOK; r += NGW) {
        const int b = r / TPB, t = r % TPB; if (t < CTXL) continue;
        const float* src = from_input ? F.in[IN_X] + ((size_t)b * SEQ + (t - CTXL)) * DM : xb + (size_t)r * DM;
        f32x4 v[8]; load_row(src, lane, v);
        float* op = F.out + ((size_t)b * SEQ + (t - CTXL)) * DM;
#pragma unroll
        for (int j = 0; j < 8; ++j) *(f32x4*)(op + 4 * lane + 256 * j) = v[j];
    }
}

constexpr int N_PHASES = 2 + 11 * NLAYER;
__global__ void __launch_bounds__(512, 2) fwd_kernel(Args args) {
    extern __shared__ __attribute__((aligned(16))) unsigned char lds[];
    Frame F;
    F.lds = (LAS unsigned char*)lds; F.ldsg = (char*)lds;
    F.MISC = (volatile LAS unsigned*)(F.lds + MISC_OFF);
    F.G = gridDim.x;
    F.in = args.in; F.out = args.out; F.ws = args.ws; F.ctl = (unsigned*)(args.ws + WS_CTL);
    for (int u = threadIdx.x; u < (LDS_BYTES - LDSCTL_OFF) / 4; u += 512) ((LAS unsigned*)(F.lds + LDSCTL_OFF))[u] = 0u;
    __syncthreads();
    XcdBarrier bar; bar.bar = F.ctl + CW_BAR; bar.x = 0; bar.st = nullptr;
    if (!MK_PER_PHASE) bar = xcd_barrier_post(F.ctl + CW_BAR, F.MISC + 8);
    const int lo = args.ph_lo, hi = args.ph_hi;
#define IN(k) (lo <= (k) && (k) < hi)
#define SEAM(k) do { if (IN(k) && IN((k) + 1)) xcd_barrier(bar); } while (0)

    if (IN(0)) { if (PH_ON(0)) phase_prologue(F); SEAM(0); }
    if (IN(1)) { if (PH_ON(1)) phase_rowpass1_l0(F); SEAM(1); }
    for (int l = 0; l < NLAYER; ++l) {
        const int pb = 2 + 11 * l;
        const bool ctx = (l == 0);
        if (IN(pb + 0)) { if (PH_ON(2)) {
            pg8::SchedDense S; S.init(F.ws + WS_HN, F.ws + WS_WIN + (size_t)l * INW * DM * 2, NTOK / 256, INW / 256, F.G, (int)blockIdx.x, 0);
            pg8::EpiStoreBf16 E{(bf16_t*)(F.ws + WS_P), INW};
            pg8::gemm_phase<pg8::EpiStoreBf16, pg8::SchedDense>(F.lds, S, E); }
            SEAM(pb + 0); }
        if (IN(pb + 1)) { if (PH_ON(3)) phase_post(F, l); SEAM(pb + 1); }
        if (IN(pb + 2)) { if (PH_ON(4)) phase_mixers(F, l); SEAM(pb + 2); }
        if (IN(pb + 3)) { if (PH_ON(5)) phase_groupnorm(F, l); SEAM(pb + 3); }
        if (IN(pb + 4)) { if (PH_ON(6)) {
            pg8::SchedDense S; S.init(F.ws + WS_O, F.ws + WS_WOUT + (size_t)l * DM * DM * 2, ctx ? NTOK / 256 : 64, DM / 256, F.G, (int)blockIdx.x, ctx ? 0 : 1);
            float* xb = (float*)(F.ws + WS_XB);
            pg8::EpiResid E;
            if (l == 0) { E.ctxbase = F.in[IN_CTX]; E.latbase = F.in[IN_X]; E.cbs = CTXL; E.lbs = SEQ; }
            else { E.ctxbase = xb; E.latbase = xb + (size_t)CTXL * DM; E.cbs = TPB; E.lbs = TPB; }
            E.xout = xb; E.modl = (const float*)(F.ws + WS_MOD) + (size_t)l * 5 * NMOD;
            pg8::gemm_phase<pg8::EpiResid, pg8::SchedDense>(F.lds, S, E); }
            SEAM(pb + 4); }
        if (IN(pb + 5)) { if (PH_ON(7)) phase_rowpass2(F, l); SEAM(pb + 5); }
        if (IN(pb + 6)) { if (PH_ON(8)) phase_topk(F, l); SEAM(pb + 6); }
        if (IN(pb + 7)) { if (PH_ON(9)) phase_gather(F, l); SEAM(pb + 7); }
        if (IN(pb + 8)) { if (PH_ON(10)) {
            pg8::SchedGrouped S; S.init(F.ws + WS_XG, F.ws + WS_WGU + (size_t)l * NE * 4096 * DM * 2, ctx ? 9 : 8, 16, F.G, (int)blockIdx.x);
            pg8::EpiSwiGLU E{(bf16_t*)(F.ws + WS_H)};
            pg8::gemm_phase<pg8::EpiSwiGLU, pg8::SchedGrouped>(F.lds, S, E); }
            SEAM(pb + 8); }
        if (IN(pb + 9)) { if (PH_ON(11)) {
            pg8::SchedGrouped S; S.init(F.ws + WS_H, F.ws + WS_WD + (size_t)l * NE * DM * DM * 2, ctx ? 9 : 8, 8, F.G, (int)blockIdx.x);
            pg8::EpiDown E{(bf16_t*)(F.ws + WS_XG), (const float*)(F.ws + WS_GATE)};
            pg8::gemm_phase<pg8::EpiDown, pg8::SchedGrouped>(F.lds, S, E); }
            SEAM(pb + 9); }
        if (IN(pb + 10)) { if (PH_ON(12)) phase_combine(F, l); if (l + 1 < NLAYER) SEAM(pb + 10); }
    }
#undef IN
#undef SEAM
}

extern "C" void kernel_launch(void* const* d_in, const int* in_sizes, int n_in, void* d_out, int out_size, void* d_ws, size_t ws_size, hipStream_t stream) {
    static int grid = 0;
    if (grid == 0) {
        if (n_in != 23 || out_size != NB * SEQ * DM || ws_size < WS_END) { fprintf(stderr, "kernel_launch: shape mismatch: n_in %d out %d ws %zu (need %zu)\n", n_in, out_size, ws_size, (size_t)WS_END); grid = -1; return; }
        int dev = 0, cus = 0, per_cu = 0;
        if (hipGetDevice(&dev) != hipSuccess || hipDeviceGetAttribute(&cus, hipDeviceAttributeMultiprocessorCount, dev) != hipSuccess) { grid = -1; return; }
        if (hipFuncSetAttribute((const void*)fwd_kernel, hipFuncAttributeMaxDynamicSharedMemorySize, LDS_BYTES) != hipSuccess) { fprintf(stderr, "kernel_launch: hipFuncSetAttribute failed\n"); grid = -1; return; }
        if (hipOccupancyMaxActiveBlocksPerMultiprocessor(&per_cu, (const void*)fwd_kernel, 512, LDS_BYTES) != hipSuccess || per_cu < 1) { fprintf(stderr, "kernel_launch: occupancy query says %d\n", per_cu); }
        (void)hipGetLastError();
        grid = cus;
    }
    if (grid < 0) return;
    if (hipMemsetAsync((char*)d_ws + WS_CTL, 0, CTL_ZERO_BYTES, stream) != hipSuccess) return;
    Args a{};
    for (int i = 0; i < 23; ++i) a.in[i] = (const float*)d_in[i];
    a.out = (float*)d_out; a.ws = (unsigned char*)d_ws;
#if MK_PER_PHASE
    for (int p = 0; p < N_PHASES; ++p) { a.ph_lo = p; a.ph_hi = p + 1; hipLaunchKernelGGL(fwd_kernel, dim3(grid), dim3(512), LDS_BYTES, stream, a); }
#else
    a.ph_lo = 0; a.ph_hi = N_PHASES;
    hipLaunchKernelGGL(fwd_kernel, dim3(grid), dim3(512), LDS_BYTES, stream, a);
#endif
    const hipError_t le = hipPeekAtLastError();
    if (le != hipSuccess) fprintf(stderr, "kernel_launch: launch failed: %s\n", hipGetErrorName(le));
}
```

```cpp
#include <hip/hip_runtime.h>
#include <cstdio>
#include <cstdint>

#define LAS __attribute__((address_space(3)))
#define GAS __attribute__((address_space(1)))
typedef unsigned short bf16_t;
typedef short bf16x8 __attribute__((ext_vector_type(8)));
typedef short s16x4 __attribute__((ext_vector_type(4)));
typedef float f32x2 __attribute__((ext_vector_type(2)));
typedef float f32x4 __attribute__((ext_vector_type(4)));
typedef float f32x16 __attribute__((ext_vector_type(16)));
typedef unsigned u32x2 __attribute__((ext_vector_type(2)));
typedef unsigned u32x4 __attribute__((ext_vector_type(4)));

#ifndef MK_PER_PHASE
#define MK_PER_PHASE 0
#endif
#ifndef PHASE_MASK
#define PHASE_MASK 0x1fff
#endif
#define PH_ON(k) (((PHASE_MASK) >> (k)) & 1)
#ifndef PROBE_MASK
#define PROBE_MASK 0u
#endif
#ifndef DBG_STOP
#define DBG_STOP 0
#endif

constexpr int DM = 2048, NB = 4, SEQ = 4096, CTXL = 256, TPB = SEQ + CTXL, NTOK = NB * TPB;
constexpr int INW = 3584, NE = 16, NLAYER = 2, NMOD = 6 * DM;
constexpr int C_QA = 0, C_KA = 768, C_VA = 1024, C_UB = 1280, C_VB = 1792, C_QC = 2304, C_KC = 3072, C_VC = 3328;
constexpr int O_A = 0, O_B = 768, O_C = 1280;
constexpr int CAP_L = 512, CAP_C = 32, ROWS_E = 2304;
constexpr float EPS = 1e-6f;

constexpr size_t MiB = 1u << 20;
constexpr size_t WS_CTL = 0, CTL_ZERO_BYTES = 65536;
constexpr size_t WS_MOD = 1 * MiB;
constexpr size_t WS_ROPE = 2 * MiB;
constexpr size_t WS_AFFL = 3 * MiB;
constexpr size_t WS_AFFC = 4 * MiB;
constexpr size_t WS_POSL = 5 * MiB;
constexpr size_t WS_POSC = 6 * MiB;
constexpr size_t WS_RSRC = 7 * MiB;
constexpr size_t WS_GATE = 8 * MiB;
constexpr size_t WS_WIN = 16 * MiB;
constexpr size_t WS_WOUT = WS_WIN + (size_t)2 * INW * DM * 2;
constexpr size_t WS_WGU = WS_WOUT + (size_t)2 * DM * DM * 2;
constexpr size_t WS_WD = WS_WGU + (size_t)2 * NE * 4096 * DM * 2;
constexpr size_t WS_HN = WS_WD + (size_t)2 * NE * DM * DM * 2;
constexpr size_t WS_P = WS_HN + (size_t)NTOK * DM * 2;
constexpr size_t WS_O = WS_P + (size_t)NTOK * INW * 2;
constexpr size_t WS_XB = WS_O + (size_t)NTOK * DM * 2;
constexpr size_t WS_XG = WS_XB + (size_t)NTOK * DM * 4;
constexpr size_t WS_H = WS_XG + (size_t)NE * ROWS_E * DM * 2;
constexpr size_t WS_END = WS_H + (size_t)NE * ROWS_E * DM * 2;
constexpr int CW_BAR = 4096, CW_QUEUE = 8192;

constexpr int RING_BYTES = 131072, LDSCTL_OFF = RING_BYTES, MISC_OFF = LDSCTL_OFF + 320, LDS_BYTES = 147456;

#define LDS_WAIT() asm volatile("s_waitcnt lgkmcnt(0)" ::: "memory")
#define VM_WAIT() asm volatile("s_waitcnt vmcnt(0)" ::: "memory")
__device__ __forceinline__ unsigned f2bf(float f) { unsigned u = __builtin_bit_cast(unsigned, f); return (u + 0x7fffu + ((u >> 16) & 1u)) >> 16; }
__device__ __forceinline__ unsigned pk2(float lo, float hi) { return f2bf(lo) | (f2bf(hi) << 16); }
__device__ __forceinline__ float bf2f(unsigned short b) { return __builtin_bit_cast(float, ((unsigned)b) << 16); }
__device__ __forceinline__ float bflo(unsigned w) { return __builtin_bit_cast(float, w << 16); }
__device__ __forceinline__ float bfhi(unsigned w) { return __builtin_bit_cast(float, w & 0xffff0000u); }
__device__ __forceinline__ int opaque_tid() { int t = threadIdx.x; asm volatile("" : "+v"(t)); return t; }
__device__ __forceinline__ float wave_sum(float v) {
#pragma unroll
    for (int o = 1; o < 64; o <<= 1) v += __shfl_xor(v, o);
    return v;
}
__device__ __forceinline__ float gelu_tanh(float x) {
    const float u = 0.7978845608028654f * (x + 0.044715f * x * x * x);
    const float e = __expf(2.f * u);
    const float th = 1.f - 2.f / (e + 1.f);
    return 0.5f * x * (1.f + th);
}

#define XB_TMO      128
#define XB_XCNT(j)  (256  + 64 * (j))
#define XB_XSUB(j)  (1280 + 64 * (j))
#define XB_XGEN(j)  (2304 + 64 * (j))
#define XB_TOP      3328
#define XB_TOPGEN   3392
#define XCD_BAR_WORDS 3456
#define XB_SPIN_CAP (1u << 18)
__device__ __forceinline__ unsigned xb_ld(unsigned* p)              { return __hip_atomic_load(p, __ATOMIC_RELAXED, __HIP_MEMORY_SCOPE_AGENT); }
__device__ __forceinline__ unsigned xb_add(unsigned* p, unsigned v) { return __hip_atomic_fetch_add(p, v, __ATOMIC_RELAXED, __HIP_MEMORY_SCOPE_AGENT); }
__device__ __forceinline__ unsigned xb_xcc_id() { return (unsigned)__builtin_amdgcn_s_getreg((3 << 11) | 20) & 0xFu; }
#define XB_SPIN(cond, bar) do { unsigned _sp = 0; while (cond) { __builtin_amdgcn_s_sleep(1); \
    if ((++_sp & 255u) == 0u) { if (xb_ld(&(bar)[XB_TMO])) break; if (_sp > XB_SPIN_CAP) { atomicAdd(&(bar)[XB_TMO], 1u); break; } } } } while (0)
struct XcdBarrier { unsigned* bar; unsigned x; volatile LAS unsigned* st; };
__device__ __forceinline__ XcdBarrier xcd_barrier_post(unsigned* bar, volatile LAS unsigned* st) {
    XcdBarrier b; b.bar = bar; b.x = xb_xcc_id(); b.st = st;
    if (threadIdx.x == 0) (void)xb_add(&bar[XB_XCNT(b.x)], 1u);
    return b;
}
__device__ __forceinline__ void xcd_barrier_complete(unsigned* bar, unsigned x, unsigned& nloc, unsigned& nx) {
    const unsigned G = gridDim.x * gridDim.y * gridDim.z;
    unsigned sum, cnt, mine, sp = 0u;
    for (;;) {
        sum = 0u; cnt = 0u; mine = 0u;
#pragma unroll
        for (unsigned j = 0; j < 16; ++j) { const unsigned c = xb_ld(&bar[XB_XCNT(j)]); sum += c; cnt += (c > 0u) ? 1u : 0u; mine = (j == x) ? c : mine; }
        if (sum == G) break;
        __builtin_amdgcn_s_sleep(1);
        if ((++sp & 255u) == 0u) { if (xb_ld(&bar[XB_TMO])) break; if (sp > XB_SPIN_CAP) { atomicAdd(&bar[XB_TMO], 1u); break; } }
    }
    nloc = mine > 0u ? mine : 1u; nx = cnt > 0u ? cnt : 1u;
}
__device__ __forceinline__ void xcd_barrier(const XcdBarrier& b) {
    asm volatile("s_waitcnt vmcnt(0)" ::: "memory");
    __syncthreads();
    if (threadIdx.x == 0) {
        unsigned* bar = b.bar;
        __builtin_amdgcn_s_waitcnt(0);
        unsigned nloc = b.st[0], nx = b.st[1];
        if (nloc == 0u) { xcd_barrier_complete(bar, b.x, nloc, nx); b.st[0] = nloc; b.st[1] = nx; }
        const unsigned old = xb_add(&bar[XB_XSUB(b.x)], 1u);
        const unsigned gen = old / nloc;
        if (old + 1u == (gen + 1u) * nloc) {
            __builtin_amdgcn_fence(__ATOMIC_RELEASE, "agent");
            asm volatile("s_waitcnt vmcnt(0)" ::: "memory");
            const unsigned og = xb_add(&bar[XB_TOP], 1u);
            const unsigned tg = og / nx;
            if (og + 1u == (tg + 1u) * nx) xb_add(&bar[XB_TOPGEN], 1u);
            else XB_SPIN(xb_ld(&bar[XB_TOPGEN]) == tg, bar);
            __builtin_amdgcn_fence(__ATOMIC_ACQUIRE, "agent");
            xb_add(&bar[XB_XGEN(b.x)], 1u);
            asm volatile("s_waitcnt vmcnt(0)" ::: "memory");
        } else {
            XB_SPIN(xb_ld(&bar[XB_XGEN(b.x)]) == gen, bar);
            __builtin_amdgcn_fence(__ATOMIC_ACQUIRE, "agent");
            asm volatile("s_waitcnt vmcnt(0)" ::: "memory");
        }
    }
    __syncthreads();
}

namespace pg8 {
constexpr int BM = 256, BK = 64, HALF = 128, HTB = HALF * BK * 2, STAGE_BYTES = 8 * HTB, NXCD = 8, WGM = 8;
constexpr int GK = 2048;
__host__ __device__ __forceinline__ int lds_byte(int r, int c) { const int st = (r >> 4) * 2 + (c >> 5), rr = r & 15, cc = c & 31, ob = rr * 64 + cc * 2; return st * 1024 + (ob ^ (((ob >> 9) & 1) << 5)); }
__host__ __device__ __forceinline__ void stage_rc(int b, int& R, int& C) { const int st = b / 1024, sb = b % 1024, swz = sb ^ (((sb >> 9) & 1) << 5); R = (st >> 1) * 16 + swz / 64; C = (st & 1) * 32 + (swz % 64) / 2; }
__host__ __device__ __forceinline__ int perm32(int rho) { const int n = rho >> 4, i = rho & 15; return 8 * (i >> 2) + 4 * n + (i & 3); }

struct Unit { int pm, pn, e, rowbase, colbase; const char* a; const char* b; };

struct SchedDense {
    const char* A; const char* Bt; int nM, nN, nwg, G, c, skipctx;
    __device__ void init(const void* A_, const void* Bt_, int nM_, int nN_, int G_, int c_, int skipctx_) { A = (const char*)A_; Bt = (const char*)Bt_; nM = nM_; nN = nN_; nwg = nM * nN; G = G_; c = c_; skipctx = skipctx_; }
    __device__ bool next(int i, Unit& u) const {
        const long L = (long)i * G + c; if (L >= nwg) return false;
        int wgid = (int)L; { const int q = nwg / NXCD, r = nwg % NXCD, xcd = wgid % NXCD, off = wgid / NXCD; wgid = (xcd < r ? xcd * (q + 1) : r * (q + 1) + (xcd - r) * q) + off; }
        const int nig = WGM * nN, gid = wgid / nig, fm = gid * WGM, gsz = (nM - fm) < WGM ? (nM - fm) : WGM;
        int pm = fm + ((wgid % nig) % gsz); const int pn = (wgid % nig) / gsz;
        if (skipctx) pm = (pm >> 4) * 17 + 1 + (pm & 15);
        u.pm = pm; u.pn = pn; u.e = 0; u.rowbase = pm * BM; u.colbase = pn * BM;
        u.a = A + (size_t)pm * (BM * GK * 2); u.b = Bt + (size_t)pn * (BM * GK * 2); return true;
    }
};
struct SchedGrouped {
    const char* A; const char* Bt; int nMe, nNe, nwg, G, c;
    __device__ void init(const void* A_, const void* Bt_, int nMe_, int nNe_, int G_, int c_) { A = (const char*)A_; Bt = (const char*)Bt_; nMe = nMe_; nNe = nNe_; nwg = NE * nMe * nNe; G = G_; c = c_; }
    __device__ bool next(int i, Unit& u) const {
        const long L = (long)i * G + c; if (L >= nwg) return false;
        const int per = nMe * nNe, e = (int)L / per, rem = (int)L % per, pm = rem % nMe, pn = rem / nMe;
        u.pm = pm; u.pn = pn; u.e = e; u.rowbase = e * ROWS_E + pm * BM; u.colbase = pn * BM;
        u.a = A + (size_t)(e * ROWS_E + pm * BM) * (GK * 2); u.b = Bt + ((size_t)e * nNe + pn) * (BM * GK * 2); return true;
    }
};

__device__ __forceinline__ unsigned cvt_pk_bf16(float lo, float hi) { unsigned r; asm volatile("v_cvt_pk_bf16_f32 %0, %1, %2" : "=v"(r) : "v"(lo), "v"(hi)); return r; }

struct EpiStoreBf16 {
    static constexpr bool PERM = true;
    bf16_t* O; int ldc;
    __device__ __forceinline__ void operator()(const f32x4 (&acc)[2][2][4][2], const Unit& u, int wr, int wc, int fr, int fq) const {
        const int row0 = u.rowbase + wr * 64 + fr, col0 = u.colbase + wc * 32 + 8 * fq;
#pragma unroll
        for (int ai = 0; ai < 2; ++ai)
#pragma unroll
            for (int m = 0; m < 4; ++m) { bf16_t* rowp = O + (size_t)(row0 + ai * HALF + m * 16) * ldc + col0;
#pragma unroll
                for (int bj = 0; bj < 2; ++bj) { const f32x4 v0 = acc[ai][bj][m][0], v1 = acc[ai][bj][m][1];
                    u32x4 w; w.x = cvt_pk_bf16(v0[0], v0[1]); w.y = cvt_pk_bf16(v0[2], v0[3]); w.z = cvt_pk_bf16(v1[0], v1[1]); w.w = cvt_pk_bf16(v1[2], v1[3]);
                    *(u32x4*)(rowp + bj * HALF) = w; } }
    }
};
struct EpiResid {
    static constexpr bool PERM = false;
    const float* ctxbase; const float* latbase; int cbs, lbs;
    float* xout; const float* modl;
    __device__ __forceinline__ void operator()(const f32x4 (&acc)[2][2][4][2], const Unit& u, int wr, int wc, int fr, int fq) const {
        const int b = u.pm / 17, tb = u.pm % 17;
        const float* src = (tb == 0) ? ctxbase + (size_t)b * cbs * DM : latbase + ((size_t)b * lbs + (size_t)(tb - 1) * 256) * DM;
        const float* g1 = modl + (size_t)((tb == 0) ? 4 : b) * NMOD + 2 * DM;
        const int rl0 = wr * 64 + fr, col0 = u.colbase + wc * 32 + 4 * fq;
        f32x4 gv[2][2];
#pragma unroll
        for (int bj = 0; bj < 2; ++bj)
#pragma unroll
            for (int n = 0; n < 2; ++n) gv[bj][n] = *(const f32x4*)(g1 + col0 + bj * HALF + n * 16);
#pragma unroll
        for (int ai = 0; ai < 2; ++ai)
#pragma unroll
            for (int m = 0; m < 4; ++m) { const int rl = rl0 + ai * HALF + m * 16; const float* sp = src + (size_t)rl * DM + col0; float* dp = xout + (size_t)(u.rowbase + rl) * DM + col0;
#pragma unroll
                for (int bj = 0; bj < 2; ++bj)
#pragma unroll
                    for (int n = 0; n < 2; ++n) { const f32x4 xv = *(const f32x4*)(sp + bj * HALF + n * 16); *(f32x4*)(dp + bj * HALF + n * 16) = xv + gv[bj][n] * acc[ai][bj][m][n]; } }
    }
};
struct EpiSwiGLU {
    static constexpr bool PERM = true;
    bf16_t* Hout;
    __device__ __forceinline__ void operator()(const f32x4 (&acc)[2][2][4][2], const Unit& u, int wr, int wc, int fr, int fq) const {
        const int row0 = u.rowbase + wr * 64 + fr, col0 = u.pn * HALF + wc * 32 + 8 * fq;
#pragma unroll
        for (int ai = 0; ai < 2; ++ai)
#pragma unroll
            for (int m = 0; m < 4; ++m) { bf16_t* rowp = Hout + (size_t)(row0 + ai * HALF + m * 16) * DM + col0; float h[8];
#pragma unroll
                for (int n = 0; n < 2; ++n)
#pragma unroll
                    for (int j = 0; j < 4; ++j) { const float g = acc[ai][0][m][n][j], up = acc[ai][1][m][n][j]; h[n * 4 + j] = g * __builtin_amdgcn_rcpf(1.f + __expf(-g)) * up; }
                u32x4 w; w.x = cvt_pk_bf16(h[0], h[1]); w.y = cvt_pk_bf16(h[2], h[3]); w.z = cvt_pk_bf16(h[4], h[5]); w.w = cvt_pk_bf16(h[6], h[7]);
                *(u32x4*)rowp = w; }
    }
};
struct EpiDown {
    static constexpr bool PERM = true;
    bf16_t* Y; const float* gatev;
    __device__ __forceinline__ void operator()(const f32x4 (&acc)[2][2][4][2], const Unit& u, int wr, int wc, int fr, int fq) const {
        const int row0 = u.rowbase + wr * 64 + fr, col0 = u.colbase + wc * 32 + 8 * fq;
#pragma unroll
        for (int ai = 0; ai < 2; ++ai)
#pragma unroll
            for (int m = 0; m < 4; ++m) { const int row = row0 + ai * HALF + m * 16; const float gt = gatev[row]; bf16_t* rowp = Y + (size_t)row * DM + col0;
#pragma unroll
                for (int bj = 0; bj < 2; ++bj) { const f32x4 v0 = acc[ai][bj][m][0] * gt, v1 = acc[ai][bj][m][1] * gt;
                    u32x4 w; w.x = cvt_pk_bf16(v0[0], v0[1]); w.y = cvt_pk_bf16(v0[2], v0[3]); w.z = cvt_pk_bf16(v1[0], v1[1]); w.w = cvt_pk_bf16(v1[2], v1[3]);
                    *(u32x4*)(rowp + bj * HALF) = w; } }
    }
};

template <class Epi, class Sched, bool ALIGN_EPI = true, bool SP2 = true>
__device__ __forceinline__ void gemm_phase(LAS unsigned char* lds, const Sched& S, const Epi& E) {
    const int tid = opaque_tid(), wid = __builtin_amdgcn_readfirstlane(tid >> 6), lane = tid & 63, wr = wid >> 2, wc = wid & 3, fr = lane & 15, fq = lane >> 4;
    constexpr int K = GK, nt = K / BK;
    unsigned voffA[2], voffB[2];
#pragma unroll
    for (int i = 0; i < 2; ++i) { int R, C; stage_rc(tid * 16 + i * 8192, R, C); const int Rb = Epi::PERM ? ((R & ~31) + perm32(R & 31)) : R;
        voffA[i] = (unsigned)(R * K + C) * 2u; voffB[i] = (unsigned)(Rb * K + C) * 2u; }
    const size_t kstep = (size_t)(BK * 2);
    const size_t hstep = (size_t)HALF * K * 2;
    const unsigned ldsw = (unsigned)wid * 1024u;
    const int aoff = lds_byte(wr * 64 + fr, fq * 8), boff = lds_byte(wc * 32 + fr, fq * 8);
#define PG8_SA(b, h) (((b) * 2 + (h)) * HTB)
#define PG8_SB(b, h) ((4 + (b) * 2 + (h)) * HTB)
#define PG8_STAGE(bufoff, gbase, voff) do { _Pragma("unroll") for (int _i = 0; _i < 2; ++_i) \
        __builtin_amdgcn_global_load_lds((const unsigned*)((const char*)(gbase) + (voff)[_i]), (LAS unsigned*)(lds + (bufoff) + ldsw + _i * 8192), 16, 0, 0); } while (0)
#define PG8_LDA(dst, b, h) do { _Pragma("unroll") for (int m = 0; m < 4; ++m) _Pragma("unroll") for (int k = 0; k < 2; ++k) dst[m][k] = *(const LAS bf16x8*)(lds + PG8_SA(b, h) + aoff + m * 2048 + k * 1024); } while (0)
#define PG8_LDB(dst, b, h) do { _Pragma("unroll") for (int n = 0; n < 2; ++n) _Pragma("unroll") for (int k = 0; k < 2; ++k) dst[n][k] = *(const LAS bf16x8*)(lds + PG8_SB(b, h) + boff + n * 2048 + k * 1024); } while (0)
#define PG8_MMA(ai, bj, At, Bt) do { __builtin_amdgcn_s_setprio(1); _Pragma("unroll") for (int m = 0; m < 4; ++m) _Pragma("unroll") for (int n = 0; n < 2; ++n) _Pragma("unroll") for (int k = 0; k < 2; ++k) \
        acc[ai][bj][m][n] = __builtin_amdgcn_mfma_f32_16x16x32_bf16(Bt[n][k], At[m][k], acc[ai][bj][m][n], 0, 0, 0); __builtin_amdgcn_s_setprio(0); } while (0)
#define PG8_WAIT_V(n) asm volatile("s_waitcnt vmcnt(" #n ")" ::: "memory")
#define PG8_WAIT_L(n) asm volatile("s_waitcnt lgkmcnt(" #n ")" ::: "memory")
#define PG8_BAR __builtin_amdgcn_s_barrier()
#define PG8_SCHED __builtin_amdgcn_sched_barrier(0)
    Unit cur, nxt; int ui = 0;
    if (!S.next(0, cur)) return;
    f32x4 acc[2][2][4][2];
#pragma unroll
    for (int a = 0; a < 2; ++a)
#pragma unroll
        for (int b = 0; b < 2; ++b)
#pragma unroll
            for (int m = 0; m < 4; ++m)
#pragma unroll
                for (int n = 0; n < 2; ++n) acc[a][b][m][n] = (f32x4){0.f, 0.f, 0.f, 0.f};
    bf16x8 At[4][2], B0[2][2], B1[2][2];
    const char* cA = cur.a; const char* cB = cur.b;
    if constexpr (SP2) {
        PG8_STAGE(PG8_SB(0, 0), cB, voffB); PG8_STAGE(PG8_SB(0, 1), cB + hstep, voffB); PG8_STAGE(PG8_SA(0, 0), cA, voffA); PG8_STAGE(PG8_SA(0, 1), cA + hstep, voffA);
        if (wr == 1) PG8_BAR;
        PG8_WAIT_V(2); PG8_BAR;
        PG8_STAGE(PG8_SB(1, 0), cB + kstep, voffB); PG8_STAGE(PG8_SA(1, 0), cA + kstep, voffA); PG8_STAGE(PG8_SB(1, 1), cB + hstep + kstep, voffB);
        PG8_WAIT_V(6); PG8_BAR;
    } else {
        PG8_STAGE(PG8_SB(0, 0), cB, voffB); PG8_STAGE(PG8_SA(0, 0), cA, voffA); PG8_STAGE(PG8_SB(0, 1), cB + hstep, voffB); PG8_STAGE(PG8_SA(0, 1), cA + hstep, voffA);
        if (wr == 1) PG8_BAR;
        PG8_WAIT_V(4); PG8_BAR;
        PG8_STAGE(PG8_SB(1, 0), cB + kstep, voffB); PG8_STAGE(PG8_SA(1, 0), cA + kstep, voffA); PG8_STAGE(PG8_SB(1, 1), cB + hstep + kstep, voffB);
        PG8_WAIT_V(6); PG8_BAR;
    }
    for (;;) {
        const bool has_next = S.next(ui + 1, nxt);
        const char* nA = has_next ? nxt.a : cA; const char* nB = has_next ? nxt.b : cB;
        for (int t = 0; t < nt; t += 2) {
            const bool last = (t == nt - 2);
            const char* a1 = cA + (size_t)(t + 1) * kstep;
            const char* a2 = last ? nA : cA + (size_t)(t + 2) * kstep; const char* b2 = last ? nB : cB + (size_t)(t + 2) * kstep;
            const char* a3 = a2 + kstep; const char* b3 = b2 + kstep;
            if constexpr (SP2) {
            PG8_LDB(B0, 0, 0); PG8_LDB(B1, 0, 1); PG8_SCHED; PG8_LDA(At, 0, 0); PG8_STAGE(PG8_SA(1, 1), a1 + hstep, voffA);
            PG8_WAIT_V(8); PG8_WAIT_L(0); PG8_BAR; PG8_MMA(0, 0, At, B0); PG8_MMA(0, 1, At, B1); PG8_BAR; PG8_SCHED;
            PG8_LDA(At, 0, 1); PG8_STAGE(PG8_SB(0, 0), b2, voffB); PG8_STAGE(PG8_SB(0, 1), b2 + hstep, voffB); PG8_STAGE(PG8_SA(0, 0), a2, voffA);
            PG8_WAIT_V(8); PG8_WAIT_L(0); PG8_BAR; PG8_MMA(1, 0, At, B0); PG8_MMA(1, 1, At, B1); PG8_BAR; PG8_SCHED;
            PG8_LDB(B0, 1, 0); PG8_LDB(B1, 1, 1); PG8_SCHED; PG8_LDA(At, 1, 0); PG8_STAGE(PG8_SA(0, 1), a2 + hstep, voffA);
            PG8_WAIT_V(8); PG8_WAIT_L(0); PG8_BAR; PG8_MMA(0, 0, At, B0); PG8_MMA(0, 1, At, B1); PG8_BAR; PG8_SCHED;
            PG8_LDA(At, 1, 1); PG8_STAGE(PG8_SB(1, 0), b3, voffB); PG8_STAGE(PG8_SB(1, 1), b3 + hstep, voffB); PG8_STAGE(PG8_SA(1, 0), a3, voffA);
            PG8_WAIT_V(8); PG8_WAIT_L(0); PG8_BAR; PG8_MMA(1, 0, At, B0); PG8_MMA(1, 1, At, B1); PG8_BAR; PG8_SCHED;
            } else {
            PG8_LDB(B0, 0, 0); PG8_SCHED; PG8_LDA(At, 0, 0); PG8_STAGE(PG8_SA(1, 1), a1 + hstep, voffA);
            PG8_WAIT_L(8); PG8_BAR; PG8_WAIT_L(0); PG8_MMA(0, 0, At, B0); PG8_BAR; PG8_SCHED;
            PG8_LDB(B1, 0, 1); PG8_STAGE(PG8_SB(0, 0), b2, voffB);
            PG8_BAR; PG8_WAIT_L(0); PG8_MMA(0, 1, At, B1); PG8_BAR;
            PG8_LDA(At, 0, 1); PG8_STAGE(PG8_SA(0, 0), a2, voffA);
            PG8_BAR; PG8_WAIT_L(0); PG8_MMA(1, 0, At, B0); PG8_BAR; PG8_SCHED;
            PG8_STAGE(PG8_SB(0, 1), b2 + hstep, voffB);
            PG8_WAIT_V(6); PG8_BAR; PG8_MMA(1, 1, At, B1); PG8_BAR;
            PG8_LDB(B0, 1, 0); PG8_SCHED; PG8_LDA(At, 1, 0); PG8_STAGE(PG8_SA(0, 1), a2 + hstep, voffA);
            PG8_WAIT_L(8); PG8_BAR; PG8_WAIT_L(0); PG8_MMA(0, 0, At, B0); PG8_BAR; PG8_SCHED;
            PG8_LDB(B1, 1, 1); PG8_STAGE(PG8_SB(1, 0), b3, voffB);
            PG8_BAR; PG8_WAIT_L(0); PG8_MMA(0, 1, At, B1); PG8_BAR;
            PG8_LDA(At, 1, 1); PG8_STAGE(PG8_SA(1, 0), a3, voffA);
            PG8_BAR; PG8_WAIT_L(0); PG8_MMA(1, 0, At, B0); PG8_BAR; PG8_SCHED;
            PG8_STAGE(PG8_SB(1, 1), b3 + hstep, voffB);
            PG8_WAIT_V(6); PG8_BAR; PG8_MMA(1, 1, At, B1); PG8_BAR;
            }
        }
        if constexpr (ALIGN_EPI) { if (wr == 0) PG8_BAR; }
        E(acc, cur, wr, wc, fr, fq);
        if (!has_next) break;
#pragma unroll
        for (int a = 0; a < 2; ++a)
#pragma unroll
            for (int b = 0; b < 2; ++b)
#pragma unroll
                for (int m = 0; m < 4; ++m)
#pragma unroll
                    for (int n = 0; n < 2; ++n) acc[a][b][m][n] = (f32x4){0.f, 0.f, 0.f, 0.f};
        cur = nxt; cA = nA; cB = nB; ++ui;
        if constexpr (ALIGN_EPI) { if (wr == 1) PG8_BAR; }
    }
    PG8_WAIT_V(0);
    if constexpr (!ALIGN_EPI) { if (wr == 0) PG8_BAR; }
    PG8_BAR;
#undef PG8_SA
#undef PG8_SB
#undef PG8_STAGE
#undef PG8_LDA
#undef PG8_LDB
#undef PG8_MMA
#undef PG8_WAIT_V
#undef PG8_WAIT_L
#undef PG8_BAR
#undef PG8_SCHED
}
}

namespace at {
constexpr int D = 128, NW = 8, QBLK = 32, KVBLK = 64;
constexpr float SCALE = 0.088388347648318440f;
constexpr float THR = 8.f;
constexpr int LDQ = INW, LDK = INW, LDO = DM;
constexpr size_t SHM_V = KVBLK * D * 2, SHM_K = KVBLK * D * 2, SHM_ATTN = 2 * SHM_V + 2 * SHM_K + NW * 64 * 4;
#define KSWZ(row, colB) ((row) * 256 + ((colB) ^ (((row) & 7) << 4)))
#define SBAR() __builtin_amdgcn_sched_barrier(0)
__device__ __forceinline__ int crow(int r, int hi) { return (r & 3) + 8 * (r >> 2) + 4 * hi; }
__device__ __forceinline__ unsigned cvtpk(float lo, float hi) { unsigned r; asm volatile("v_cvt_pk_bf16_f32 %0, %1, %2" : "=v"(r) : "v"(lo), "v"(hi)); return r; }

__device__ __forceinline__ void partialSM(f32x16& p0, f32x16& p1, float& m_reg, float& mn, float& alpha, bool domask, int dq, int hi) {
  constexpr float C = SCALE * 1.4426950408889634f;
  {
    if (domask) {
#pragma unroll
      for (int r = 0; r < 16; ++r) { const int d0 = dq + crow(r, hi), d1 = d0 + 32;
        if (d0 > 128 || d0 < -128) p0[r] = -1e30f;
        if (d1 > 128 || d1 < -128) p1[r] = -1e30f; }
    }
  }
  float pmax = p0[0]; for (int r = 1; r < 16; ++r) pmax = fmaxf(pmax, p0[r]); for (int r = 0; r < 16; ++r) pmax = fmaxf(pmax, p1[r]);
  { auto rr = __builtin_amdgcn_permlane32_swap(__float_as_uint(pmax), __float_as_uint(pmax), false, false);
    pmax = fmaxf(__uint_as_float(rr[0]), __uint_as_float(rr[1])); }
  if (__builtin_expect(__all(pmax - m_reg <= THR / SCALE), 1)) { mn = m_reg; alpha = 1.f; }
  else { mn = fmaxf(m_reg, pmax); alpha = __builtin_amdgcn_exp2f((m_reg - mn) * C); m_reg = mn; }
  float mnC = -mn * C;
  for (int r = 0; r < 16; ++r) p0[r] = fmaf(p0[r], C, mnC); for (int r = 0; r < 16; ++r) p1[r] = fmaf(p1[r], C, mnC);
  for (int r = 0; r < 16; ++r) p0[r] = __builtin_amdgcn_exp2f(p0[r]);
}
__device__ __forceinline__ void finishSM(f32x16& p0, f32x16& p1, float alpha, float& l_reg, bf16x8& pa0, bf16x8& pa1, bf16x8& pa2, bf16x8& pa3) {
  for (int r = 0; r < 16; ++r) p1[r] = __builtin_amdgcn_exp2f(p1[r]);
  float ps = 0; for (int r = 0; r < 16; ++r) ps += p0[r]; for (int r = 0; r < 16; ++r) ps += p1[r];
  { auto rr = __builtin_amdgcn_permlane32_swap(__float_as_uint(ps), __float_as_uint(ps), false, false);
    ps = __uint_as_float(rr[0]) + __uint_as_float(rr[1]); }
  l_reg = l_reg * alpha + ps;
#define PK4(P, BASE, OUT) do { unsigned a0 = cvtpk(P[BASE + 0], P[BASE + 1]), a1 = cvtpk(P[BASE + 2], P[BASE + 3]);   \
    unsigned b0 = cvtpk(P[BASE + 4], P[BASE + 5]), b1 = cvtpk(P[BASE + 6], P[BASE + 7]);                              \
    auto r0 = __builtin_amdgcn_permlane32_swap(a0, b0, false, false); auto r1 = __builtin_amdgcn_permlane32_swap(a1, b1, false, false); \
    u32x4 w = {r0[0], r1[0], r0[1], r1[1]}; OUT = *reinterpret_cast<bf16x8*>(&w); } while (0)
  PK4(p0, 0, pa0); PK4(p0, 8, pa1); PK4(p1, 0, pa2); PK4(p1, 8, pa3);
#undef PK4
}
__device__ __forceinline__ void qkt(f32x16& p0, f32x16& p1, const char* Ks, const bf16x8* qr, int r32, int hi) {
  p0 = f32x16{}; p1 = f32x16{};
#pragma unroll
  for (int d0 = 0; d0 < 8; ++d0) { int cb = (d0 * 16 + hi * 8) * 2;
    bf16x8 b0 = *reinterpret_cast<const bf16x8*>(Ks + KSWZ(r32, cb));
    bf16x8 b1 = *reinterpret_cast<const bf16x8*>(Ks + KSWZ(32 + r32, cb));
    p0 = __builtin_amdgcn_mfma_f32_32x32x16_bf16(b0, qr[d0], p0, 0, 0, 0);
    p1 = __builtin_amdgcn_mfma_f32_32x32x16_bf16(b1, qr[d0], p1, 0, 0, 0); }
}
__device__ __forceinline__ int v_st(int k, int c) { const int kk = (k & ~0xC) | ((k & 4) << 1) | ((k & 8) >> 1); return ((kk >> 3) * 4 + (c >> 5)) * 512 + ((kk & 7) * 32 + (c & 31)) * 2; }
__device__ __forceinline__ int v_rd_base(int lane) { return ((lane & 3) << 3) | (((lane >> 2) & 3) << 6) | (((lane >> 4) & 1) << 5) | (((lane >> 5) & 1) << 8); }
constexpr int v_rd_off(int d0, int ks, int half) { return d0 * 512 + ks * 4096 + half * 2048; }
template <int OFF> __device__ __forceinline__ s16x4 tr_read(int vb) {
  s16x4 r; asm volatile("ds_read_b64_tr_b16 %0, %1 offset:%2" : "=&v"(r) : "v"(vb), "i"(OFF) : "memory"); return r;
}
template <int D0> __device__ __forceinline__ void pv_one(f32x16& od, int vb, bf16x8 pa0, bf16x8 pa1, bf16x8 pa2, bf16x8 pa3) {
  const s16x4 l0 = tr_read<v_rd_off(D0, 0, 0)>(vb), h0 = tr_read<v_rd_off(D0, 0, 1)>(vb), l1 = tr_read<v_rd_off(D0, 1, 0)>(vb), h1 = tr_read<v_rd_off(D0, 1, 1)>(vb);
  const s16x4 l2 = tr_read<v_rd_off(D0, 2, 0)>(vb), h2 = tr_read<v_rd_off(D0, 2, 1)>(vb), l3 = tr_read<v_rd_off(D0, 3, 0)>(vb), h3 = tr_read<v_rd_off(D0, 3, 1)>(vb);
  asm volatile("s_waitcnt lgkmcnt(0)" ::: "memory"); SBAR();
#define PK(L, H) (bf16x8){L[0], L[1], L[2], L[3], H[0], H[1], H[2], H[3]}
  od = __builtin_amdgcn_mfma_f32_32x32x16_bf16(pa0, PK(l0, h0), od, 0, 0, 0);
  od = __builtin_amdgcn_mfma_f32_32x32x16_bf16(pa1, PK(l1, h1), od, 0, 0, 0);
  od = __builtin_amdgcn_mfma_f32_32x32x16_bf16(pa2, PK(l2, h2), od, 0, 0, 0);
  od = __builtin_amdgcn_mfma_f32_32x32x16_bf16(pa3, PK(l3, h3), od, 0, 0, 0);
#undef PK
}
__device__ __forceinline__ void pv_d0(f32x16* o, int vb, bf16x8 pa0, bf16x8 pa1, bf16x8 pa2, bf16x8 pa3) {
  pv_one<0>(o[0], vb, pa0, pa1, pa2, pa3); pv_one<1>(o[1], vb, pa0, pa1, pa2, pa3); pv_one<2>(o[2], vb, pa0, pa1, pa2, pa3); pv_one<3>(o[3], vb, pa0, pa1, pa2, pa3);
}

__device__ __forceinline__ void attn_body(const bf16_t* __restrict__ Qb, const bf16_t* __restrict__ Kb, const bf16_t* __restrict__ Vb, bf16_t* __restrict__ Ob,
                                          int NT, int kskip, int qpos0, float m0, float l0, bool maskon, char* lds) {
  const int tid = opaque_tid(), wid = tid >> 6, lane = tid & 63, r32 = lane & 31, hi = lane >> 5;
  char* V_lds = lds; char* K_lds = lds + 2 * SHM_V;
  float* ws = (float*)(lds + 2 * SHM_V + 2 * SHM_K) + wid * 64; float* li_l = ws; float* al_l = ws + 32;
  float m_reg = m0, l_reg = l0; f32x16 o[4] = {}; bf16x8 qr[8];
  const bf16_t* Qw = Qb + (long)(wid * QBLK + r32) * LDQ + hi * 8;
#pragma unroll
  for (int d0 = 0; d0 < 8; ++d0) qr[d0] = *reinterpret_cast<const bf16x8*>(Qw + d0 * 16);
  const int sr = tid >> 4, sc = (tid & 15) * 8, vst0 = v_st(sr, sc), vst1 = v_st(32 + sr, sc);
  const int vb0 = (int)(uintptr_t)V_lds + v_rd_base(lane);
  const int qpos = qpos0 + wid * QBLK + r32;
  const unsigned goff0 = (unsigned)(sr * LDK + sc) * 2u, goff1 = goff0 + 32u * LDK * 2u;
  struct { bf16x8 vs0, vs1, ks0, ks1; } sr_[2];
#define TROW(jt) ((long)(jt) * KVBLK + ((jt) >= 4 ? kskip : 0))
#define SLOAD(i, jt) do { const long _k0 = TROW(jt) * (LDK * 2); const char* _kp = (const char*)Kb + _k0; const char* _vp = (const char*)Vb + _k0; \
    sr_[i].vs0 = *reinterpret_cast<const bf16x8*>(_vp + goff0); sr_[i].vs1 = *reinterpret_cast<const bf16x8*>(_vp + goff1); \
    sr_[i].ks0 = *reinterpret_cast<const bf16x8*>(_kp + goff0); sr_[i].ks1 = *reinterpret_cast<const bf16x8*>(_kp + goff1); } while (0)
#define SWRITE(b, i) do { *(bf16x8*)(V_lds + (b) * SHM_V + vst0) = sr_[i].vs0;          \
    *(bf16x8*)(V_lds + (b) * SHM_V + vst1) = sr_[i].vs1; int kc = sc * 2;               \
    *(bf16x8*)(K_lds + (b) * SHM_K + KSWZ(sr, kc)) = sr_[i].ks0;                       \
    *(bf16x8*)(K_lds + (b) * SHM_K + KSWZ(32 + sr, kc)) = sr_[i].ks1; } while (0)
#define SWAIT() asm volatile("s_waitcnt vmcnt(4)" ::: "memory")
#define RESC(a) do { if (__any((a) < 1.f)) { if (hi == 0) al_l[r32] = (a); asm volatile("s_waitcnt lgkmcnt(0)" ::: "memory"); \
    for (int d = 0; d < 4; ++d) for (int r = 0; r < 16; ++r) o[d][r] *= al_l[crow(r, hi)]; } } while (0)
#define DQ(jt) (kskip + ((jt) - 4) * KVBLK - qpos)
  f32x16 pA0, pA1, pB0, pB1; float mnA, mnB, alA, alB; bf16x8 pa0, pa1, pa2, pa3;
  constexpr int SE = 0, SO = 1;
  SLOAD(SE, 0); asm volatile("s_waitcnt vmcnt(0)" ::: "memory"); SWRITE(0, SE); __syncthreads();
  qkt(pA0, pA1, K_lds, qr, r32, hi); partialSM(pA0, pA1, m_reg, mnA, alA, false, 0, hi);
  SLOAD(SO, 1); if (2 < NT) SLOAD(SE, 2);
  SWAIT(); SWRITE(1, SO); __syncthreads();
  for (int j = 1; j + 1 < NT; j += 2) {
    SBAR(); qkt(pB0, pB1, K_lds + SHM_K, qr, r32, hi);
    finishSM(pA0, pA1, alA, l_reg, pa0, pa1, pa2, pa3); SBAR();
    SLOAD(SO, j + 2); SBAR();
    pv_d0(o, vb0, pa0, pa1, pa2, pa3); partialSM(pB0, pB1, m_reg, mnB, alB, maskon && j >= 4, DQ(j), hi);
    __syncthreads(); SWAIT(); SWRITE(0, SE);
    RESC(alB); __syncthreads();
    SBAR(); qkt(pA0, pA1, K_lds, qr, r32, hi);
    finishSM(pB0, pB1, alB, l_reg, pa0, pa1, pa2, pa3); SBAR();
    if (j + 3 < NT) SLOAD(SE, j + 3); SBAR();
    pv_d0(o, vb0 + (int)SHM_V, pa0, pa1, pa2, pa3); partialSM(pA0, pA1, m_reg, mnA, alA, maskon && j + 1 >= 4, DQ(j + 1), hi);
    __syncthreads(); SWAIT(); SWRITE(1, SO);
    RESC(alA); __syncthreads();
  }
  SBAR(); qkt(pB0, pB1, K_lds + SHM_K, qr, r32, hi);
  finishSM(pA0, pA1, alA, l_reg, pa0, pa1, pa2, pa3); SBAR();
  pv_d0(o, vb0, pa0, pa1, pa2, pa3); partialSM(pB0, pB1, m_reg, mnB, alB, maskon && NT - 1 >= 4, DQ(NT - 1), hi);
  __syncthreads(); RESC(alB);
  finishSM(pB0, pB1, alB, l_reg, pa0, pa1, pa2, pa3); SBAR();
  pv_d0(o, vb0 + (int)SHM_V, pa0, pa1, pa2, pa3);
  if (hi == 0) li_l[r32] = l_reg; asm volatile("s_waitcnt lgkmcnt(0)" ::: "memory");
  float rli[16];
#pragma unroll
  for (int r = 0; r < 16; ++r) rli[r] = __builtin_amdgcn_rcpf(li_l[crow(r, hi)]);
  bf16_t* Ow = Ob + (long)(wid * QBLK) * LDO;
#pragma unroll
  for (int r = 0; r < 16; ++r) { int orow = crow(r, hi);
    for (int d0 = 0; d0 < 4; ++d0) Ow[(long)orow * LDO + d0 * 32 + r32] = (bf16_t)f2bf(o[d0][r] * rli[r]); }
#undef TROW
#undef SLOAD
#undef SWRITE
#undef SWAIT
#undef RESC
#undef DQ
}
}

struct Args { const float* in[23]; float* out; unsigned char* ws; int ph_lo, ph_hi; };
enum { IN_X = 0, IN_C, IN_CTX, IN_CCTX, IN_WMOD, IN_BMOD, IN_N1G, IN_N2G, IN_WIN, IN_QNA, IN_KNA, IN_SINK, IN_VNB, IN_WS, IN_BS, IN_QNC, IN_KNC, IN_OUTG, IN_WOUT, IN_WR, IN_WG, IN_WU, IN_WDN };

#define PHASE_IDS(F) const int tid = opaque_tid(), lane = tid & 63, wave = __builtin_amdgcn_readfirstlane(tid >> 6), gw = (int)blockIdx.x * 8 + wave, NGW = (F).G * 8; (void)lane; (void)wave; (void)gw; (void)NGW
constexpr int ARGTAB_OFF = LDSCTL_OFF + 1024;
#define INP(F, i) ld_inp((F).lds, (i))
__device__ __forceinline__ const float* ld_inp(LAS unsigned char* lds, int i) {
    const volatile LAS unsigned* t = (const volatile LAS unsigned*)(lds + ARGTAB_OFF) + 2 * i;
    const unsigned lo = __builtin_amdgcn_readfirstlane(t[0]), hi = __builtin_amdgcn_readfirstlane(t[1]);
    return (const float*)(const GAS float*)(((unsigned long long)hi << 32) | lo);
}
struct Frame {
    LAS unsigned char* lds; char* ldsg;
    volatile LAS unsigned* MISC;
    unsigned* ctl;
    int G;
    float* out; unsigned char* ws;
};

__device__ __forceinline__ void transpose_item(const float* W, int N, bf16_t* WT, int k0, int n0, int drow0, LAS float* scr, int lane) {
#pragma unroll 8
    for (int i = 0; i < 32; ++i) { const int kk = 2 * i + (lane >> 5); scr[kk * 33 + (lane & 31)] = W[(size_t)(k0 + kk) * N + n0 + (lane & 31)]; }
    LDS_WAIT(); asm volatile("" ::: "memory");
    const int c = lane & 7;
#pragma unroll
    for (int j = 0; j < 4; ++j) { const int n = (lane >> 3) + 8 * j; const LAS float* s = scr + (8 * c) * 33 + n;
        u32x4 o; o.x = pk2(s[0 * 33], s[1 * 33]); o.y = pk2(s[2 * 33], s[3 * 33]); o.z = pk2(s[4 * 33], s[5 * 33]); o.w = pk2(s[6 * 33], s[7 * 33]);
        *(u32x4*)(WT + (size_t)(drow0 + n) * DM + k0 + 8 * c) = o; }
    LDS_WAIT(); asm volatile("" ::: "memory");
}

__device__ __forceinline__ void phase_prologue(Frame& F) {
    PHASE_IDS(F);
    LAS float* scr = (LAS float*)(F.lds + wave * 16384);
    constexpr int I_IN = 32 * (INW / 32), I_SQ = 32 * (DM / 32);
    constexpr int NIT = 2 * I_IN + 2 * I_SQ + 2 * NE * 3 * I_SQ;
    for (int it = gw; it < NIT; it += NGW) {
        int r = it;
        if (r < 2 * I_IN) { const int l = r / I_IN; r %= I_IN; const int nblk = INW / 32, kb = r / nblk, nb = r % nblk;
            transpose_item(INP(F, IN_WIN) + (size_t)l * DM * INW, INW, (bf16_t*)(F.ws + WS_WIN) + (size_t)l * INW * DM, 64 * kb, 32 * nb, 32 * nb, scr, lane); continue; }
        r -= 2 * I_IN;
        if (r < 2 * I_SQ) { const int l = r / I_SQ; r %= I_SQ; const int kb = r / 64, nb = r % 64;
            transpose_item(INP(F, IN_WOUT) + (size_t)l * DM * DM, DM, (bf16_t*)(F.ws + WS_WOUT) + (size_t)l * DM * DM, 64 * kb, 32 * nb, 32 * nb, scr, lane); continue; }
        r -= 2 * I_SQ;
        const int mat = r / I_SQ; r %= I_SQ; const int kb = r / 64, nb = r % 64;
        const int le = mat / 3, which = mat % 3;
        if (which < 2) {
            const float* W = INP(F, which == 0 ? IN_WG : IN_WU) + (size_t)le * DM * DM; const int n0 = 32 * nb;
            transpose_item(W, DM, (bf16_t*)(F.ws + WS_WGU) + (size_t)le * 4096 * DM, 64 * kb, n0, (n0 >> 7) * 256 + which * 128 + (n0 & 127), scr, lane);
        } else {
            transpose_item(INP(F, IN_WDN) + (size_t)le * DM * DM, DM, (bf16_t*)(F.ws + WS_WD) + (size_t)le * DM * DM, 64 * kb, 32 * nb, 32 * nb, scr, lane);
        }
    }
    __syncthreads();
    {
        LAS float* sil = (LAS float*)F.lds;
        LAS float* red = (LAS float*)(F.lds + 40960);
        bool have = false;
        for (int it = blockIdx.x; it < 2 * 96; it += F.G) {
            if (!have) {
                { const float* cp = INP(F, IN_C); const float* ccp = INP(F, IN_CCTX);
                for (int i = tid; i < 5 * DM; i += 512) { const int s = i / DM, k = i % DM; const float cv = (s < 4) ? cp[s * DM + k] : ccp[k]; sil[i] = cv / (1.f + __expf(-cv)); } }
                have = true; __syncthreads();
            }
            const int l = it / 96, cb = it % 96, c4 = tid & 31, kr = tid >> 5;
            const float* wp = INP(F, IN_WMOD) + (size_t)l * DM * NMOD + (size_t)cb * 128 + c4 * 4;
            f32x4 a[5];
#pragma unroll
            for (int s = 0; s < 5; ++s) a[s] = (f32x4){0.f, 0.f, 0.f, 0.f};
#pragma unroll 8
            for (int k = kr; k < DM; k += 16) { const f32x4 w = *(const f32x4*)(wp + (size_t)k * NMOD);
#pragma unroll
                for (int s = 0; s < 5; ++s) a[s] += w * sil[s * DM + k]; }
#pragma unroll
            for (int s = 0; s < 5; ++s) *(LAS f32x4*)(red + (kr * 5 + s) * 128 + c4 * 4) = a[s];
            __syncthreads();
            const float* bmod = INP(F, IN_BMOD);
            for (int i = tid; i < 5 * 128; i += 512) { const int s = i / 128, cc = i % 128; float sum = 0.f;
#pragma unroll
                for (int q = 0; q < 16; ++q) sum += red[(q * 5 + s) * 128 + cc];
                ((float*)(F.ws + WS_MOD))[(size_t)(l * 5 + s) * NMOD + cb * 128 + cc] = sum + bmod[l * NMOD + cb * 128 + cc]; }
            __syncthreads();
        }
    }
    if (blockIdx.x == F.G - 1) {
        for (int i = tid; i < 64 * 32; i += 512) {
            const int pos = i >> 5, f = i & 31;
            double inv = 1.0; for (int q = 0; q < f; ++q) inv *= 0.7498942093324559;
            const double a = (double)pos * inv;
            const double n = __builtin_rint(a * 0.6366197723675814);
            const double r = (a - n * 1.5707963267948966) - n * 6.123233995736766e-17;
            const double r2 = r * r;
            double sn = r * (1.0 + r2 * (-1.0 / 6 + r2 * (1.0 / 120 + r2 * (-1.0 / 5040 + r2 * (1.0 / 362880 + r2 * (-1.0 / 39916800 + r2 * (1.0 / 6227020800.0)))))));
            double cn = 1.0 + r2 * (-0.5 + r2 * (1.0 / 24 + r2 * (-1.0 / 720 + r2 * (1.0 / 40320 + r2 * (-1.0 / 3628800 + r2 * (1.0 / 479001600 + r2 * (-1.0 / 87178291200.0)))))));
            const int q = ((int)n) & 3; double cs, ss;
            if (q == 0) { cs = cn; ss = sn; } else if (q == 1) { cs = -sn; ss = cn; } else if (q == 2) { cs = -cn; ss = -sn; } else { cs = sn; ss = -cn; }
            ((float*)(F.ws + WS_ROPE))[2 * i] = (float)cs; ((float*)(F.ws + WS_ROPE))[2 * i + 1] = (float)ss;
        }
    }
}

__device__ __forceinline__ void load_row(const float* row, int lane, f32x4 (&v)[8]) {
#pragma unroll
    for (int j = 0; j < 8; ++j) v[j] = *(const f32x4*)(row + 4 * lane + 256 * j);
}
__device__ __forceinline__ void norm_mod_store(const f32x4 (&v)[8], const float* g, const float* shift, const float* scale, bf16_t* dst, int lane) {
    float ss = 0.f;
#pragma unroll
    for (int j = 0; j < 8; ++j) ss += (v[j].x * v[j].x + v[j].y * v[j].y) + (v[j].z * v[j].z + v[j].w * v[j].w);
    const float rinv = 1.0f / sqrtf(wave_sum(ss) * (1.f / DM) + EPS);
#pragma unroll
    for (int j = 0; j < 8; ++j) { const int c = 4 * lane + 256 * j;
        const f32x4 gg = *(const f32x4*)(g + c), sh = *(const f32x4*)(shift + c), sc = *(const f32x4*)(scale + c);
        const f32x4 y = (v[j] * rinv) * gg * (sc + 1.f) + sh;
        u32x2 w; w.x = pk2(y.x, y.y); w.y = pk2(y.z, y.w); *(u32x2*)(dst + c) = w; }
}

__device__ __forceinline__ void phase_rowpass1_l0(Frame& F) {
    PHASE_IDS(F);
    const float* mod = (const float*)(F.ws + WS_MOD);
    for (int r = gw; r < NTOK; r += NGW) {
        const int b = r / TPB, t = r % TPB, s = (t < CTXL) ? 4 : b;
        const float* src = (t < CTXL) ? INP(F, IN_CTX) + ((size_t)b * CTXL + t) * DM : INP(F, IN_X) + ((size_t)b * SEQ + (t - CTXL)) * DM;
        f32x4 v[8]; load_row(src, lane, v);
        norm_mod_store(v, INP(F, IN_N1G), mod + (size_t)s * NMOD, mod + (size_t)s * NMOD + DM, (bf16_t*)(F.ws + WS_HN) + (size_t)r * DM, lane);
    }
}

__device__ __forceinline__ void post_unpack(const u32x4 x, float (&v)[8]) {
    v[0] = bflo(x.x); v[1] = bfhi(x.x); v[2] = bflo(x.y); v[3] = bfhi(x.y); v[4] = bflo(x.z); v[5] = bfhi(x.z); v[6] = bflo(x.w); v[7] = bfhi(x.w); }
__device__ __forceinline__ float sum16(float v) { v += __shfl_xor(v, 1); v += __shfl_xor(v, 2); v += __shfl_xor(v, 4); v += __shfl_xor(v, 8); return v; }
__device__ __forceinline__ void phase_post(Frame& F, int l) {
    PHASE_IDS(F);
    bf16_t* P = (bf16_t*)(F.ws + WS_P);
    const float* rope = (const float*)(F.ws + WS_ROPE);
    const int i16 = lane & 15, hq = lane >> 4; const bool hi2 = hq >= 2;
    const float* qna = INP(F, IN_QNA) + l * 128 + 8 * i16; const float* kna = INP(F, IN_KNA) + l * 128 + 8 * i16;
    const float* qnc = INP(F, IN_QNC) + l * 128 + 8 * i16; const float* knc = INP(F, IN_KNC) + l * 128 + 8 * i16;
    const float* vnb = INP(F, IN_VNB) + l * 512 + 8 * i16;
    for (int r = gw; r < NTOK; r += NGW) {
        const int t = r % TPB; const bool lat = t >= CTXL;
        u32x4* rp = (u32x4*)(P + (size_t)r * INW) + lane;
        u32x4 x[7];
#pragma unroll
        for (int j = 0; j < 7; ++j) x[j] = rp[64 * j];
        const int pos = lat ? t - CTXL : 0, pp = (i16 < 8) ? (pos >> 6) : (pos & 63);
        const f32x4* cs = (const f32x4*)(rope + 2 * (pp * 32 + 8 * (i16 & 3)));
        const f32x4 c0 = cs[0], c1 = cs[1], c2 = cs[2], c3 = cs[3];
        const float cosv[8] = {c0.x, c0.z, c1.x, c1.z, c2.x, c2.z, c3.x, c3.z}, sinv[8] = {c0.y, c0.w, c1.y, c1.w, c2.y, c2.w, c3.y, c3.w};
        const float sgn = (i16 & 4) ? 1.f : -1.f;
#pragma unroll
        for (int j = 0; j < 7; ++j) {
            const bool gelu_lo = (j == 3 || j == 4), gelu_hi = (j == 2 || j == 3);
            const bool norm_lo = (j != 2 && j != 3), norm_hi = (j != 2 && j != 6);
            const bool rope_lo = (j == 0 || j == 1 || j == 5 || j == 6), rope_hi = (j == 0 || j == 1 || j == 4 || j == 5);
            const bool dg = hi2 ? gelu_hi : gelu_lo, dn = hi2 ? norm_hi : norm_lo, dr = (hi2 ? rope_hi : rope_lo) && lat;
            if (!(gelu_lo || gelu_hi || norm_lo || norm_hi)) continue;
            float v[8]; post_unpack(x[j], v);
            if (gelu_lo || gelu_hi) {
#pragma unroll
                for (int e = 0; e < 8; ++e) { const float gv = gelu_tanh(v[e]); v[e] = dg ? gv : v[e]; } }
            if (norm_lo || norm_hi) {
                float ss = 0.f;
#pragma unroll
                for (int e = 0; e < 8; ++e) ss += v[e] * v[e];
                const float rinv = 1.0f / sqrtf(sum16(ss) * (1.f / 128) + EPS);
                const float* gp;
                if (j == 0) gp = qna; else if (j == 1) gp = hi2 ? kna : qna; else if (j == 3) gp = vnb + (hi2 ? hq - 2 : 0) * 128; else if (j == 4) gp = hi2 ? qnc : vnb + (2 + hq) * 128;
                else if (j == 5) gp = qnc; else gp = knc;
                const f32x4 g0 = *(const f32x4*)gp, g1 = *(const f32x4*)(gp + 4);
                const float gg[8] = {g0.x, g0.y, g0.z, g0.w, g1.x, g1.y, g1.z, g1.w};
#pragma unroll
                for (int e = 0; e < 8; ++e) v[e] = dn ? v[e] * rinv * gg[e] : v[e];
            }
            if (rope_lo || rope_hi) {
#pragma unroll
                for (int e = 0; e < 8; ++e) { const float o = __shfl_xor(v[e], 4); const float rv = v[e] * cosv[e] + sgn * o * sinv[e]; v[e] = dr ? rv : v[e]; } }
            u32x4 w; w.x = pk2(v[0], v[1]); w.y = pk2(v[2], v[3]); w.z = pk2(v[4], v[5]); w.w = pk2(v[6], v[7]);
            rp[64 * j] = w;
        }
    }
}

__device__ __forceinline__ void mixer_b_unit(Frame& F, int l, int b, int ch, int g) {
    PHASE_IDS(F);
    const bf16_t* P = (const bf16_t*)(F.ws + WS_P); bf16_t* O = (bf16_t*)(F.ws + WS_O);
    const int row0 = b * TPB + ch * 128, w = wave;
    LAS bf16_t* VT = (LAS bf16_t*)F.lds;
    { const int q = tid >> 2, dp = (tid & 3) * 32; const bf16_t* src = P + (size_t)(row0 + q) * INW + C_VB + g * 128 + dp;
#pragma unroll
      for (int i = 0; i < 4; ++i) { const u32x4 x = *(const u32x4*)(src + 8 * i); const unsigned xs[4] = {x.x, x.y, x.z, x.w};
#pragma unroll
          for (int j = 0; j < 4; ++j) { VT[(dp + 8 * i + 2 * j) * 136 + q] = (bf16_t)(xs[j] & 0xffffu); VT[(dp + 8 * i + 2 * j + 1) * 136 + q] = (bf16_t)(xs[j] >> 16); } } }
    __syncthreads();
    const int i15 = lane & 15, kq = lane >> 4;
    f32x4 acc[8];
#pragma unroll
    for (int n = 0; n < 8; ++n) acc[n] = (f32x4){0.f, 0.f, 0.f, 0.f};
    const float* wsr = INP(F, IN_WS) + ((size_t)(l * 4 + g) * 128 + 16 * w + i15) * 128;
#pragma unroll
    for (int s = 0; s < 4; ++s) {
        const f32x4 a0 = *(const f32x4*)(wsr + 32 * s + 8 * kq), a1 = *(const f32x4*)(wsr + 32 * s + 8 * kq + 4);
        u32x4 aw; aw.x = pk2(a0.x, a0.y); aw.y = pk2(a0.z, a0.w); aw.z = pk2(a1.x, a1.y); aw.w = pk2(a1.z, a1.w);
        const bf16x8 af = *reinterpret_cast<bf16x8*>(&aw);
#pragma unroll
        for (int n = 0; n < 8; ++n) { const bf16x8 bfr = *(const LAS bf16x8*)(VT + (16 * n + i15) * 136 + 32 * s + 8 * kq);
            acc[n] = __builtin_amdgcn_mfma_f32_16x16x32_bf16(af, bfr, acc[n], 0, 0, 0); }
    }
#pragma unroll
    for (int j = 0; j < 4; ++j) { const int p = 16 * w + kq * 4 + j; const float bias = INP(F, IN_BS)[(l * 4 + g) * 128 + p];
        const bf16_t* up = P + (size_t)(row0 + p) * INW + C_UB + g * 128; bf16_t* op = O + (size_t)(row0 + p) * DM + O_B + g * 128;
#pragma unroll
        for (int n = 0; n < 8; ++n) { const int d = 16 * n + i15; op[d] = (bf16_t)f2bf(bf2f(up[d]) * (acc[n][j] + bias)); } }
    __syncthreads();
}
__device__ __forceinline__ void phase_mixers(Frame& F, int l) {
    PHASE_IDS(F);
    const bf16_t* P = (const bf16_t*)(F.ws + WS_P); bf16_t* O = (bf16_t*)(F.ws + WS_O);
    const bool ctx = (l == 0);
    const int nC = 384, nA = 384, nCc = ctx ? 24 : 0, nAc = ctx ? 24 : 0, nB = 4 * 4 * 34;
    const int total = nC + nA + nCc + nAc + nB;
    unsigned* qctr = F.ctl + CW_QUEUE + 64 * l;
    for (;;) {
        if (tid == 0) F.MISC[0] = xb_add(qctr, 1u);
        __syncthreads();
        int u = (int)F.MISC[0];
        __syncthreads();
        if (u >= total) break;
        if (u < nC + nA + nCc + nAc) {
            int kind, b, h, qb = 0;
            if (u < nC) { kind = 0; b = u / 96; h = (u % 96) / 16; qb = u % 16; }
            else if (u < nC + nA) { const int v = u - nC; kind = 1; b = v / 96; h = (v % 96) / 16; qb = v % 16; }
            else if (u < nC + nA + nCc) { const int v = u - nC - nA; kind = 2; b = v / 6; h = v % 6; }
            else { const int v = u - nC - nA - nCc; kind = 3; b = v / 6; h = v % 6; }
            const int kv = h / 3, isA = kind & 1, lat = (kind < 2);
            const size_t r0 = (size_t)b * TPB, rq = r0 + (lat ? CTXL + qb * 256 : 0);
            const int q0 = qb * 256, ks = (kind == 1) ? ((q0 - 128 < 0) ? 0 : q0 - 128) : 0, ke = (q0 + 384 > SEQ) ? SEQ : q0 + 384;
            const int NT = (kind == 0) ? 68 : (kind == 1) ? 4 + (ke - ks) / 64 : 4;
            const float sink = INP(F, IN_SINK)[l * 6 + h];
            const int cq = (isA ? C_QA : C_QC) + h * 128, ck = (isA ? C_KA : C_KC) + kv * 128, cv = (isA ? C_VA : C_VC) + kv * 128, co = (isA ? O_A : O_C) + h * 128;
            at::attn_body(P + rq * INW + cq, P + r0 * INW + ck, P + r0 * INW + cv, O + rq * DM + co, NT, ks, q0, isA ? sink / at::SCALE : -1e30f, isA ? 1.f : 0.f, kind == 1, F.ldsg);
            continue; }
        u -= nC + nA + nCc;
        u -= nAc;
        { const int b = u / 136, ch = (u % 136) / 4, g = u % 4;
          if (!ctx && ch < 2) continue;
          mixer_b_unit(F, l, b, ch, g); }
    }
}

__device__ __forceinline__ void phase_groupnorm(Frame& F, int l) {
    PHASE_IDS(F);
    bf16_t* O = (bf16_t*)(F.ws + WS_O); const float* og = INP(F, IN_OUTG) + l * DM;
    for (int r = gw; r < NTOK; r += NGW) {
        if (l == 1 && (r % TPB) < CTXL) continue;
        bf16_t* row = O + (size_t)r * DM;
        u32x2 x[8];
#pragma unroll
        for (int i = 0; i < 3; ++i) { x[i] = *(const u32x2*)(row + O_A + 12 * lane + 4 * i); x[5 + i] = *(const u32x2*)(row + O_C + 12 * lane + 4 * i); }
#pragma unroll
        for (int i = 0; i < 2; ++i) x[3 + i] = *(const u32x2*)(row + O_B + 8 * lane + 4 * i);
        float v[8][4]; float ss[3] = {0.f, 0.f, 0.f};
#pragma unroll
        for (int i = 0; i < 8; ++i) { v[i][0] = bflo(x[i].x); v[i][1] = bfhi(x[i].x); v[i][2] = bflo(x[i].y); v[i][3] = bfhi(x[i].y);
            const int grp = (i < 3) ? 0 : (i < 5) ? 1 : 2; ss[grp] += (v[i][0] * v[i][0] + v[i][1] * v[i][1]) + (v[i][2] * v[i][2] + v[i][3] * v[i][3]); }
        float rinv[3];
        rinv[0] = 1.0f / sqrtf(wave_sum(ss[0]) * (1.f / 768) + EPS); rinv[1] = 1.0f / sqrtf(wave_sum(ss[1]) * (1.f / 512) + EPS); rinv[2] = 1.0f / sqrtf(wave_sum(ss[2]) * (1.f / 768) + EPS);
#pragma unroll
        for (int i = 0; i < 8; ++i) { const int grp = (i < 3) ? 0 : (i < 5) ? 1 : 2;
            const int c = (grp == 0) ? O_A + 12 * lane + 4 * i : (grp == 1) ? O_B + 8 * lane + 4 * (i - 3) : O_C + 12 * lane + 4 * (i - 5);
            const f32x4 gg = *(const f32x4*)(og + c); const float ri = rinv[grp];
            u32x2 w; w.x = pk2(v[i][0] * ri * gg.x, v[i][1] * ri * gg.y); w.y = pk2(v[i][2] * ri * gg.z, v[i][3] * ri * gg.w); *(u32x2*)(row + c) = w; }
    }
}

__device__ __forceinline__ void phase_rowpass2(Frame& F, int l) {
    PHASE_IDS(F);
    const float* mod = (const float*)(F.ws + WS_MOD) + (size_t)l * 5 * NMOD;
    const float* xb = (const float*)(F.ws + WS_XB);
    LAS float* wl = (LAS float*)F.lds;
    const float* wr = INP(F, IN_WR) + (size_t)l * DM * NE;
    for (int i = tid; i < DM * NE; i += 512) wl[(i & 15) * DM + (i >> 4)] = wr[i];
    __syncthreads();
    const float* g = INP(F, IN_N2G) + l * DM;
    for (int r = gw; r < NTOK; r += NGW) {
        const int b = r / TPB, t = r % TPB, s = (t < CTXL) ? 4 : b;
        if (l == 1 && t < CTXL) continue;
        f32x4 v[8]; load_row(xb + (size_t)r * DM, lane, v);
        float ss = 0.f;
#pragma unroll
        for (int j = 0; j < 8; ++j) ss += (v[j].x * v[j].x + v[j].y * v[j].y) + (v[j].z * v[j].z + v[j].w * v[j].w);
        const float rinv = 1.0f / sqrtf(wave_sum(ss) * (1.f / DM) + EPS);
        const float* shift = mod + (size_t)s * NMOD + 3 * DM; const float* scale = shift + DM;
        bf16_t* dst = (bf16_t*)(F.ws + WS_HN) + (size_t)r * DM;
#pragma unroll
        for (int j = 0; j < 8; ++j) { const int c = 4 * lane + 256 * j;
            const f32x4 gg = *(const f32x4*)(g + c), sh = *(const f32x4*)(shift + c), sc = *(const f32x4*)(scale + c);
            v[j] = (v[j] * rinv) * gg * (sc + 1.f) + sh;
            u32x2 w; w.x = pk2(v[j].x, v[j].y); w.y = pk2(v[j].z, v[j].w); *(u32x2*)(dst + c) = w; }
        float lg[16];
#pragma unroll
        for (int e = 0; e < 16; ++e) { float a = 0.f;
#pragma unroll
            for (int j = 0; j < 8; ++j) { const f32x4 w = *(const LAS f32x4*)(wl + e * DM + 4 * lane + 256 * j); a += (v[j].x * w.x + v[j].y * w.y) + (v[j].z * w.z + v[j].w * w.w); }
            lg[e] = wave_sum(a); }
        float mx = lg[0];
#pragma unroll
        for (int e = 1; e < 16; ++e) mx = fmaxf(mx, lg[e]);
        float den = 0.f, mine = 0.f;
#pragma unroll
        for (int e = 0; e < 16; ++e) { const float ex = __expf(lg[e] - mx); den += ex; mine = (lane == e) ? ex : mine; }
        if (lane < 16) {
            const float a = mine / den;
            if (t < CTXL) ((float*)(F.ws + WS_AFFC))[((size_t)b * NE + lane) * CTXL + t] = a;
            else ((float*)(F.ws + WS_AFFL))[((size_t)b * NE + lane) * SEQ + (t - CTXL)] = a;
        }
    }
    __syncthreads();
}

__device__ __forceinline__ void phase_topk(Frame& F, int l) {
    PHASE_IDS(F);
    LAS unsigned long long* key = (LAS unsigned long long*)F.lds;
    const int nunits = (l == 0) ? 128 : 64;
    for (int u = blockIdx.x; u < nunits; u += F.G) {
        const bool isc = u >= 64; const int uu = isc ? u - 64 : u, b = uu / NE, e = uu % NE;
        const int N = isc ? CTXL : SEQ, cap = isc ? CAP_C : CAP_L;
        const float* src = isc ? (const float*)(F.ws + WS_AFFC) + (size_t)uu * CTXL : (const float*)(F.ws + WS_AFFL) + (size_t)uu * SEQ;
        int* pos = isc ? (int*)(F.ws + WS_POSC) + (size_t)uu * CTXL : (int*)(F.ws + WS_POSL) + (size_t)uu * SEQ;
        for (int i = tid; i < N; i += 512) key[i] = ((unsigned long long)(~__float_as_uint(src[i])) << 32) | (unsigned)i;
        __syncthreads();
        for (int k = 2; k <= N; k <<= 1)
            for (int j = k >> 1; j > 0; j >>= 1) {
                for (int tt = tid; tt < N / 2; tt += 512) {
                    const int i = ((tt & ~(j - 1)) << 1) | (tt & (j - 1)), ij = i | j;
                    const bool up = ((i & k) == 0);
                    const unsigned long long a = key[i], c = key[ij];
                    if ((a > c) == up) { key[i] = c; key[ij] = a; }
                }
                __syncthreads();
            }
        const int slotbase = e * ROWS_E + (isc ? 2048 + b * CAP_C : b * CAP_L);
        for (int i = tid; i < N; i += 512) {
            const unsigned long long kk = key[i]; const int tok = (int)(unsigned)kk;
            pos[tok] = (i < cap) ? i : -1;
            if (i < cap) { ((int*)(F.ws + WS_RSRC))[slotbase + i] = b * TPB + (isc ? tok : CTXL + tok); ((float*)(F.ws + WS_GATE))[slotbase + i] = __uint_as_float(~(unsigned)(kk >> 32)); }
        }
        __syncthreads();
    }
}

__device__ __forceinline__ void phase_gather(Frame& F, int l) {
    PHASE_IDS(F);
    const int rows_e = (l == 0) ? 2176 : 2048;
    const bf16_t* hn = (const bf16_t*)(F.ws + WS_HN); bf16_t* xg = (bf16_t*)(F.ws + WS_XG); const int* rsrc = (const int*)(F.ws + WS_RSRC);
    for (int it = gw * 4; it < NE * rows_e; it += NGW * 4) {
        const int e = it / rows_e, sl = it % rows_e, row = e * ROWS_E + sl;
        const int my = (lane < 4) ? rsrc[row + lane] : 0;
        u32x4 x[4][4];
#pragma unroll
        for (int q = 0; q < 4; ++q) { const int src = __builtin_amdgcn_readlane(my, q); const u32x4* sp = (const u32x4*)(hn + (size_t)src * DM) + lane;
#pragma unroll
            for (int j = 0; j < 4; ++j) x[q][j] = sp[64 * j]; }
#pragma unroll
        for (int q = 0; q < 4; ++q) { u32x4* dp = (u32x4*)(xg + (size_t)(row + q) * DM) + lane;
#pragma unroll
            for (int j = 0; j < 4; ++j) dp[64 * j] = x[q][j]; }
    }
}

__device__ __forceinline__ void phase_combine(Frame& F, int l) {
    PHASE_IDS(F);
    const float* mod = (const float*)(F.ws + WS_MOD);
    float* xb = (float*)(F.ws + WS_XB); const bf16_t* Y = (const bf16_t*)(F.ws + WS_XG);
    for (int r = gw; r < NTOK; r += NGW) {
        const int b = r / TPB, t = r % TPB, s = (t < CTXL) ? 4 : b;
        if (l == 1 && t < CTXL) continue;
        int p = -1;
        if (lane < NE) p = (t < CTXL) ? ((const int*)(F.ws + WS_POSC))[((size_t)b * NE + lane) * CTXL + t] : ((const int*)(F.ws + WS_POSL))[((size_t)b * NE + lane) * SEQ + (t - CTXL)];
        f32x4 v[8]; load_row(xb + (size_t)r * DM, lane, v);
        const float* g2 = mod + (size_t)(l * 5 + s) * NMOD + 5 * DM;
        f32x4 gv[8];
#pragma unroll
        for (int j = 0; j < 8; ++j) gv[j] = *(const f32x4*)(g2 + 4 * lane + 256 * j);
        f32x4 a[8];
#pragma unroll
        for (int j = 0; j < 8; ++j) a[j] = (f32x4){0.f, 0.f, 0.f, 0.f};
        unsigned long long m = __ballot(p >= 0);
        const int ybase = (t < CTXL) ? 2048 + b * CAP_C : b * CAP_L;
        while (m) {
            const int e0 = __builtin_ctzll(m); m &= m - 1;
            const bool two = (m != 0ull); const int e1 = two ? __builtin_ctzll(m) : e0; if (two) m &= m - 1;
            const int p0 = __builtin_amdgcn_readlane(p, e0), p1 = __builtin_amdgcn_readlane(p, e1);
            const bf16_t* y0 = Y + (size_t)(e0 * ROWS_E + ybase + p0) * DM + 4 * lane; const bf16_t* y1 = Y + (size_t)(e1 * ROWS_E + ybase + p1) * DM + 4 * lane;
            u32x2 w0[8], w1[8];
#pragma unroll
            for (int j = 0; j < 8; ++j) w0[j] = *(const u32x2*)(y0 + 256 * j);
            if (two) {
#pragma unroll
                for (int j = 0; j < 8; ++j) w1[j] = *(const u32x2*)(y1 + 256 * j); }
#pragma unroll
            for (int j = 0; j < 8; ++j) a[j] += (f32x4){bflo(w0[j].x), bfhi(w0[j].x), bflo(w0[j].y), bfhi(w0[j].y)};
            if (two) {
#pragma unroll
                for (int j = 0; j < 8; ++j) a[j] += (f32x4){bflo(w1[j].x), bfhi(w1[j].x), bflo(w1[j].y), bfhi(w1[j].y)}; }
        }
#pragma unroll
        for (int j = 0; j < 8; ++j) v[j] += gv[j] * a[j];
        if (l == 0) {
#pragma unroll
            for (int j = 0; j < 8; ++j) *(f32x4*)(xb + (size_t)r * DM + 4 * lane + 256 * j) = v[j];
            const float* m1 = mod + (size_t)(5 + s) * NMOD;
            norm_mod_store(v, INP(F, IN_N1G) + DM, m1, m1 + DM, (bf16_t*)(F.ws + WS_HN) + (size_t)r * DM, lane);
        } else {
            float* op = F.out + ((size_t)b * SEQ + (t - CTXL)) * DM;
#pragma unroll
            for (int j = 0; j < 8; ++j) *(f32x4*)(op + 4 * lane + 256 * j) = v[j];
        }
    }
}

__device__ __forceinline__ void phase_dump_x(Frame& F, bool from_input) {
    PHASE_IDS(F);
    const float* xb = (const float*)(F.ws + WS_XB);
    for (int r = gw; r < NTOK; r += NGW) {
        const int b = r / TPB, t = r % TPB; if (t < CTXL) continue;
        const float* src = from_input ? INP(F, IN_X) + ((size_t)b * SEQ + (t - CTXL)) * DM : xb + (size_t)r * DM;
        f32x4 v[8]; load_row(src, lane, v);
        float* op = F.out + ((size_t)b * SEQ + (t - CTXL)) * DM;
#pragma unroll
        for (int j = 0; j < 8; ++j) *(f32x4*)(op + 4 * lane + 256 * j) = v[j];
    }
}

constexpr int N_PHASES = 2 + 11 * NLAYER;
__global__ void __launch_bounds__(512, 2) fwd_kernel(Args args) {
    extern __shared__ __attribute__((aligned(16))) unsigned char lds[];
    Frame F;
    F.lds = (LAS unsigned char*)lds; F.ldsg = (char*)lds;
    F.MISC = (volatile LAS unsigned*)(F.lds + MISC_OFF);
    F.G = gridDim.x;
    F.out = args.out; F.ws = args.ws; F.ctl = (unsigned*)(args.ws + WS_CTL);
    for (int u = threadIdx.x; u < (LDS_BYTES - LDSCTL_OFF) / 4; u += 512) ((LAS unsigned*)(F.lds + LDSCTL_OFF))[u] = 0u;
    __syncthreads();
    if (threadIdx.x < 23) { const unsigned long long pv = (unsigned long long)args.in[threadIdx.x]; LAS unsigned* t = (LAS unsigned*)(F.lds + ARGTAB_OFF) + 2 * threadIdx.x; t[0] = (unsigned)pv; t[1] = (unsigned)(pv >> 32); }
    __syncthreads();
    XcdBarrier bar; bar.bar = F.ctl + CW_BAR; bar.x = 0; bar.st = nullptr;
    if (!MK_PER_PHASE) bar = xcd_barrier_post(F.ctl + CW_BAR, F.MISC + 8);
    const int lo = args.ph_lo, hi = args.ph_hi;
#define IN(k) (lo <= (k) && (k) < hi)
    unsigned long long probe_t0 = 0ull, probe_acc = 0ull;
#define PROBE_BEGIN(k) do { if (PROBE_MASK & (1u << (k))) probe_t0 = __builtin_amdgcn_s_memrealtime(); } while (0)
#define SEAM(k) do { if (IN(k) && IN((k) + 1)) xcd_barrier(bar); if (PROBE_MASK & (1u << (k))) probe_acc += __builtin_amdgcn_s_memrealtime() - probe_t0; } while (0)

    if (IN(0)) { PROBE_BEGIN(0); if (PH_ON(0)) phase_prologue(F); SEAM(0); }
    if (IN(1)) { PROBE_BEGIN(1); if (PH_ON(1)) phase_rowpass1_l0(F); SEAM(1); }
    for (int l = 0; l < NLAYER; ++l) {
        const int pb = 2 + 11 * l;
        const bool ctx = (l == 0);
        if (IN(pb + 0)) { PROBE_BEGIN(pb + 0); if (PH_ON(2)) {
            pg8::SchedDense S; S.init(F.ws + WS_HN, F.ws + WS_WIN + (size_t)l * INW * DM * 2, NTOK / 256, INW / 256, F.G, (int)blockIdx.x, 0);
            pg8::EpiStoreBf16 E{(bf16_t*)(F.ws + WS_P), INW};
            pg8::gemm_phase<pg8::EpiStoreBf16, pg8::SchedDense>(F.lds, S, E); }
            SEAM(pb + 0); }
        if (IN(pb + 1)) { PROBE_BEGIN(pb + 1); if (PH_ON(3)) phase_post(F, l); SEAM(pb + 1); }
        if (IN(pb + 2)) { PROBE_BEGIN(pb + 2); if (PH_ON(4)) phase_mixers(F, l); SEAM(pb + 2); }
        if (IN(pb + 3)) { PROBE_BEGIN(pb + 3); if (PH_ON(5)) phase_groupnorm(F, l); SEAM(pb + 3); }
        if (IN(pb + 4)) { PROBE_BEGIN(pb + 4); if (PH_ON(6)) {
            pg8::SchedDense S; S.init(F.ws + WS_O, F.ws + WS_WOUT + (size_t)l * DM * DM * 2, ctx ? NTOK / 256 : 64, DM / 256, F.G, (int)blockIdx.x, ctx ? 0 : 1);
            float* xb = (float*)(F.ws + WS_XB);
            pg8::EpiResid E;
            if (l == 0) { E.ctxbase = INP(F, IN_CTX); E.latbase = INP(F, IN_X); E.cbs = CTXL; E.lbs = SEQ; }
            else { E.ctxbase = xb; E.latbase = xb + (size_t)CTXL * DM; E.cbs = TPB; E.lbs = TPB; }
            E.xout = xb; E.modl = (const float*)(F.ws + WS_MOD) + (size_t)l * 5 * NMOD;
            pg8::gemm_phase<pg8::EpiResid, pg8::SchedDense>(F.lds, S, E); }
            SEAM(pb + 4); }
        if (IN(pb + 5)) { PROBE_BEGIN(pb + 5); if (PH_ON(7)) phase_rowpass2(F, l); SEAM(pb + 5); }
        if (IN(pb + 6)) { PROBE_BEGIN(pb + 6); if (PH_ON(8)) phase_topk(F, l); SEAM(pb + 6); }
        if (IN(pb + 7)) { PROBE_BEGIN(pb + 7); if (PH_ON(9)) phase_gather(F, l); SEAM(pb + 7); }
        if (IN(pb + 8)) { PROBE_BEGIN(pb + 8); if (PH_ON(10)) {
            pg8::SchedGrouped S; S.init(F.ws + WS_XG, F.ws + WS_WGU + (size_t)l * NE * 4096 * DM * 2, ctx ? 9 : 8, 16, F.G, (int)blockIdx.x);
            pg8::EpiSwiGLU E{(bf16_t*)(F.ws + WS_H)};
            pg8::gemm_phase<pg8::EpiSwiGLU, pg8::SchedGrouped>(F.lds, S, E); }
            SEAM(pb + 8); }
        if (IN(pb + 9)) { PROBE_BEGIN(pb + 9); if (PH_ON(11)) {
            pg8::SchedGrouped S; S.init(F.ws + WS_H, F.ws + WS_WD + (size_t)l * NE * DM * DM * 2, ctx ? 9 : 8, 8, F.G, (int)blockIdx.x);
            pg8::EpiDown E{(bf16_t*)(F.ws + WS_XG), (const float*)(F.ws + WS_GATE)};
            pg8::gemm_phase<pg8::EpiDown, pg8::SchedGrouped>(F.lds, S, E); }
            SEAM(pb + 9); }
        if (IN(pb + 10)) { PROBE_BEGIN(pb + 10); if (PH_ON(12)) phase_combine(F, l); if (l + 1 < NLAYER) SEAM(pb + 10); else if (PROBE_MASK & (1u << (pb + 10))) probe_acc += __builtin_amdgcn_s_memrealtime() - probe_t0; }
    }
    if (PROBE_MASK) { const unsigned long long te = __builtin_amdgcn_s_memrealtime(); while (__builtin_amdgcn_s_memrealtime() - te < probe_acc) __builtin_amdgcn_s_sleep(8); }
#undef IN
#undef SEAM
}

extern "C" void kernel_launch(void* const* d_in, const int* in_sizes, int n_in, void* d_out, int out_size, void* d_ws, size_t ws_size, hipStream_t stream) {
    static int grid = 0;
    if (grid == 0) {
        if (n_in != 23 || out_size != NB * SEQ * DM || ws_size < WS_END) { fprintf(stderr, "kernel_launch: shape mismatch: n_in %d out %d ws %zu (need %zu)\n", n_in, out_size, ws_size, (size_t)WS_END); grid = -1; return; }
        int dev = 0, cus = 0, per_cu = 0;
        if (hipGetDevice(&dev) != hipSuccess || hipDeviceGetAttribute(&cus, hipDeviceAttributeMultiprocessorCount, dev) != hipSuccess) { grid = -1; return; }
        if (hipFuncSetAttribute((const void*)fwd_kernel, hipFuncAttributeMaxDynamicSharedMemorySize, LDS_BYTES) != hipSuccess) { fprintf(stderr, "kernel_launch: hipFuncSetAttribute failed\n"); grid = -1; return; }
        if (hipOccupancyMaxActiveBlocksPerMultiprocessor(&per_cu, (const void*)fwd_kernel, 512, LDS_BYTES) != hipSuccess || per_cu < 1) { fprintf(stderr, "kernel_launch: occupancy query says %d\n", per_cu); }
        (void)hipGetLastError();
        grid = cus;
    }
    if (grid < 0) return;
    if (hipMemsetAsync((char*)d_ws + WS_CTL, 0, CTL_ZERO_BYTES, stream) != hipSuccess) return;
    Args a{};
    for (int i = 0; i < 23; ++i) a.in[i] = (const float*)d_in[i];
    a.out = (float*)d_out; a.ws = (unsigned char*)d_ws;
#if MK_PER_PHASE
    for (int p = 0; p < N_PHASES; ++p) { a.ph_lo = p; a.ph_hi = p + 1; hipLaunchKernelGGL(fwd_kernel, dim3(grid), dim3(512), LDS_BYTES, stream, a); }
#else
    a.ph_lo = 0; a.ph_hi = N_PHASES;
    hipLaunchKernelGGL(fwd_kernel, dim3(grid), dim3(512), LDS_BYTES, stream, a);
#endif
    const hipError_t le = hipPeekAtLastError();
    if (le != hipSuccess) fprintf(stderr, "kernel_launch: launch failed: %s\n", hipGetErrorName(le));
}
```

```cpp
#include <hip/hip_runtime.h>
#include <cstdio>
#include <cstdint>

#define LAS __attribute__((address_space(3)))
#define GAS __attribute__((address_space(1)))
typedef unsigned short bf16_t;
typedef short bf16x8 __attribute__((ext_vector_type(8)));
typedef short s16x4 __attribute__((ext_vector_type(4)));
typedef float f32x2 __attribute__((ext_vector_type(2)));
typedef float f32x4 __attribute__((ext_vector_type(4)));
typedef float f32x16 __attribute__((ext_vector_type(16)));
typedef unsigned u32x2 __attribute__((ext_vector_type(2)));
typedef unsigned u32x4 __attribute__((ext_vector_type(4)));
typedef int i32x4 __attribute__((ext_vector_type(4)));
typedef int i32x8 __attribute__((ext_vector_type(8)));

#ifndef MK_PER_PHASE
#define MK_PER_PHASE 0
#endif
#ifndef PHASE_MASK
#define PHASE_MASK 0x1fff
#endif
#define PH_ON(k) (((PHASE_MASK) >> (k)) & 1)
#ifndef FP8_L0
#define FP8_L0 0
#endif
#ifndef FP8_L1
#define FP8_L1 1
#endif
#ifndef PROBE_MASK
#define PROBE_MASK 0u
#endif
#ifndef DBG_STOP
#define DBG_STOP 0
#endif

constexpr int DM = 2048, NB = 4, SEQ = 4096, CTXL = 256, TPB = SEQ + CTXL, NTOK = NB * TPB;
constexpr int INW = 3584, NE = 16, NLAYER = 2, NMOD = 6 * DM;
constexpr int C_QA = 0, C_KA = 768, C_VA = 1024, C_UB = 1280, C_VB = 1792, C_QC = 2304, C_KC = 3072, C_VC = 3328;
constexpr int O_A = 0, O_B = 768, O_C = 1280;
constexpr int CAP_L = 512, CAP_C = 32, ROWS_E = 2304;
constexpr float EPS = 1e-6f;

constexpr size_t MiB = 1u << 20;
constexpr size_t WS_CTL = 0, CTL_ZERO_BYTES = 65536;
constexpr size_t WS_MOD = 1 * MiB;
constexpr size_t WS_ROPE = 2 * MiB;
constexpr size_t WS_AFFL = 3 * MiB;
constexpr size_t WS_AFFC = 4 * MiB;
constexpr size_t WS_POSL = 5 * MiB;
constexpr size_t WS_POSC = 6 * MiB;
constexpr size_t WS_RSRC = 7 * MiB;
constexpr size_t WS_GATE = 8 * MiB;
constexpr size_t WS_WIN = 16 * MiB;
constexpr size_t WS_WOUT = WS_WIN + (size_t)2 * INW * DM * 2;
constexpr size_t WS_WGU = WS_WOUT + (size_t)2 * DM * DM * 2;
constexpr size_t WS_WD = WS_WGU + (size_t)2 * NE * 4096 * DM * 2;
constexpr size_t WS_HN = WS_WD + (size_t)2 * NE * DM * DM * 2;
constexpr size_t WS_P = WS_HN + (size_t)NTOK * DM * 2;
constexpr size_t WS_O = WS_P + (size_t)NTOK * INW * 2;
constexpr size_t WS_XB = WS_O + (size_t)NTOK * DM * 2;
constexpr size_t WS_XG = WS_XB + (size_t)NTOK * DM * 4;
constexpr size_t WS_H = WS_XG + (size_t)NE * ROWS_E * DM * 2;
constexpr size_t WS_HN8 = WS_H + (size_t)NE * ROWS_E * DM * 2;
constexpr size_t WS_END = WS_HN8 + (size_t)NTOK * DM;
constexpr float W8_SCALE = 32.f; constexpr int W8_SCALE_E8M0 = 127 - 5;
constexpr int CW_BAR = 4096, CW_QUEUE = 8192;

constexpr int RING_BYTES = 131072, LDSCTL_OFF = RING_BYTES, MISC_OFF = LDSCTL_OFF + 320, LDS_BYTES = 147456;

#define LDS_WAIT() asm volatile("s_waitcnt lgkmcnt(0)" ::: "memory")
#define VM_WAIT() asm volatile("s_waitcnt vmcnt(0)" ::: "memory")
__device__ __forceinline__ unsigned f2bf(float f) { unsigned u = __builtin_bit_cast(unsigned, f); return (u + 0x7fffu + ((u >> 16) & 1u)) >> 16; }
__device__ __forceinline__ unsigned pk2(float lo, float hi) { return f2bf(lo) | (f2bf(hi) << 16); }
__device__ __forceinline__ float bf2f(unsigned short b) { return __builtin_bit_cast(float, ((unsigned)b) << 16); }
__device__ __forceinline__ float bflo(unsigned w) { return __builtin_bit_cast(float, w << 16); }
__device__ __forceinline__ float bfhi(unsigned w) { return __builtin_bit_cast(float, w & 0xffff0000u); }
__device__ __forceinline__ float clamp448(float x) { return __builtin_fminf(__builtin_fmaxf(x, -448.f), 448.f); }
__device__ __forceinline__ unsigned pk4_fp8(float a, float b, float c, float d) {
    int r = __builtin_amdgcn_cvt_pk_fp8_f32(clamp448(a), clamp448(b), 0, false); r = __builtin_amdgcn_cvt_pk_fp8_f32(clamp448(c), clamp448(d), r, true); return (unsigned)r; }
__device__ __forceinline__ int opaque_tid() { int t = threadIdx.x; asm volatile("" : "+v"(t)); return t; }
__device__ __forceinline__ float wave_sum(float v) {
#pragma unroll
    for (int o = 1; o < 64; o <<= 1) v += __shfl_xor(v, o);
    return v;
}
__device__ __forceinline__ float gelu_tanh(float x) {
    const float u = 0.7978845608028654f * (x + 0.044715f * x * x * x);
    const float e = __expf(2.f * u);
    const float th = 1.f - 2.f / (e + 1.f);
    return 0.5f * x * (1.f + th);
}

#define XB_TMO      128
#define XB_XCNT(j)  (256  + 64 * (j))
#define XB_XSUB(j)  (1280 + 64 * (j))
#define XB_XGEN(j)  (2304 + 64 * (j))
#define XB_TOP      3328
#define XB_TOPGEN   3392
#define XCD_BAR_WORDS 3456
#define XB_SPIN_CAP (1u << 18)
__device__ __forceinline__ unsigned xb_ld(unsigned* p)              { return __hip_atomic_load(p, __ATOMIC_RELAXED, __HIP_MEMORY_SCOPE_AGENT); }
__device__ __forceinline__ unsigned xb_add(unsigned* p, unsigned v) { return __hip_atomic_fetch_add(p, v, __ATOMIC_RELAXED, __HIP_MEMORY_SCOPE_AGENT); }
__device__ __forceinline__ unsigned xb_xcc_id() { return (unsigned)__builtin_amdgcn_s_getreg((3 << 11) | 20) & 0xFu; }
#define XB_SPIN(cond, bar) do { unsigned _sp = 0; while (cond) { __builtin_amdgcn_s_sleep(1); \
    if ((++_sp & 255u) == 0u) { if (xb_ld(&(bar)[XB_TMO])) break; if (_sp > XB_SPIN_CAP) { atomicAdd(&(bar)[XB_TMO], 1u); break; } } } } while (0)
struct XcdBarrier { unsigned* bar; unsigned x; volatile LAS unsigned* st; };
__device__ __forceinline__ XcdBarrier xcd_barrier_post(unsigned* bar, volatile LAS unsigned* st) {
    XcdBarrier b; b.bar = bar; b.x = xb_xcc_id(); b.st = st;
    if (threadIdx.x == 0) (void)xb_add(&bar[XB_XCNT(b.x)], 1u);
    return b;
}
__device__ __forceinline__ void xcd_barrier_complete(unsigned* bar, unsigned x, unsigned& nloc, unsigned& nx) {
    const unsigned G = gridDim.x * gridDim.y * gridDim.z;
    unsigned sum, cnt, mine, sp = 0u;
    for (;;) {
        sum = 0u; cnt = 0u; mine = 0u;
#pragma unroll
        for (unsigned j = 0; j < 16; ++j) { const unsigned c = xb_ld(&bar[XB_XCNT(j)]); sum += c; cnt += (c > 0u) ? 1u : 0u; mine = (j == x) ? c : mine; }
        if (sum == G) break;
        __builtin_amdgcn_s_sleep(1);
        if ((++sp & 255u) == 0u) { if (xb_ld(&bar[XB_TMO])) break; if (sp > XB_SPIN_CAP) { atomicAdd(&bar[XB_TMO], 1u); break; } }
    }
    nloc = mine > 0u ? mine : 1u; nx = cnt > 0u ? cnt : 1u;
}
__device__ __forceinline__ void xcd_barrier(const XcdBarrier& b) {
    asm volatile("s_waitcnt vmcnt(0)" ::: "memory");
    __syncthreads();
    if (threadIdx.x == 0) {
        unsigned* bar = b.bar;
        __builtin_amdgcn_s_waitcnt(0);
        unsigned nloc = b.st[0], nx = b.st[1];
        if (nloc == 0u) { xcd_barrier_complete(bar, b.x, nloc, nx); b.st[0] = nloc; b.st[1] = nx; }
        const unsigned old = xb_add(&bar[XB_XSUB(b.x)], 1u);
        const unsigned gen = old / nloc;
        if (old + 1u == (gen + 1u) * nloc) {
            __builtin_amdgcn_fence(__ATOMIC_RELEASE, "agent");
            asm volatile("s_waitcnt vmcnt(0)" ::: "memory");
            const unsigned og = xb_add(&bar[XB_TOP], 1u);
            const unsigned tg = og / nx;
            if (og + 1u == (tg + 1u) * nx) xb_add(&bar[XB_TOPGEN], 1u);
            else XB_SPIN(xb_ld(&bar[XB_TOPGEN]) == tg, bar);
            __builtin_amdgcn_fence(__ATOMIC_ACQUIRE, "agent");
            xb_add(&bar[XB_XGEN(b.x)], 1u);
            asm volatile("s_waitcnt vmcnt(0)" ::: "memory");
        } else {
            XB_SPIN(xb_ld(&bar[XB_XGEN(b.x)]) == gen, bar);
            __builtin_amdgcn_fence(__ATOMIC_ACQUIRE, "agent");
            asm volatile("s_waitcnt vmcnt(0)" ::: "memory");
        }
    }
    __syncthreads();
}

namespace pg8 {
constexpr int BM = 256, BK = 64, HALF = 128, HTB = HALF * BK * 2, STAGE_BYTES = 8 * HTB, NXCD = 8, WGM = 8;
constexpr int GK = 2048;
__host__ __device__ __forceinline__ int lds_byte(int r, int c) { const int st = (r >> 4) * 2 + (c >> 5), rr = r & 15, cc = c & 31, ob = rr * 64 + cc * 2; return st * 1024 + (ob ^ (((ob >> 9) & 1) << 5)); }
__host__ __device__ __forceinline__ void stage_rc(int b, int& R, int& C) { const int st = b / 1024, sb = b % 1024, swz = sb ^ (((sb >> 9) & 1) << 5); R = (st >> 1) * 16 + swz / 64; C = (st & 1) * 32 + (swz % 64) / 2; }
__host__ __device__ __forceinline__ int perm32(int rho) { const int n = rho >> 4, i = rho & 15; return 8 * (i >> 2) + 4 * n + (i & 3); }

struct Unit { int pm, pn, e, rowbase, colbase; const char* a; const char* b; };

struct SchedDense {
    static constexpr int RB = GK * 2;
    const char* A; const char* Bt; int nM, nN, nwg, G, c, skipctx;
    __device__ void init(const void* A_, const void* Bt_, int nM_, int nN_, int G_, int c_, int skipctx_) { A = (const char*)A_; Bt = (const char*)Bt_; nM = nM_; nN = nN_; nwg = nM * nN; G = G_; c = c_; skipctx = skipctx_; }
    __device__ bool next(int i, Unit& u) const {
        const long L = (long)i * G + c; if (L >= nwg) return false;
        int wgid = (int)L; { const int q = nwg / NXCD, r = nwg % NXCD, xcd = wgid % NXCD, off = wgid / NXCD; wgid = (xcd < r ? xcd * (q + 1) : r * (q + 1) + (xcd - r) * q) + off; }
        const int nig = WGM * nN, gid = wgid / nig, fm = gid * WGM, gsz = (nM - fm) < WGM ? (nM - fm) : WGM;
        int pm = fm + ((wgid % nig) % gsz); const int pn = (wgid % nig) / gsz;
        if (skipctx) pm = (pm >> 4) * 17 + 1 + (pm & 15);
        u.pm = pm; u.pn = pn; u.e = 0; u.rowbase = pm * BM; u.colbase = pn * BM;
        u.a = A + (size_t)pm * (BM * GK * 2); u.b = Bt + (size_t)pn * (BM * GK * 2); return true;
    }
};
template <int RB_> struct SchedGrouped {
    static constexpr int RB = RB_;
    const char* A; const char* Bt; int nMe, nNe, nwg, G, c;
    __device__ void init(const void* A_, const void* Bt_, int nMe_, int nNe_, int G_, int c_) { A = (const char*)A_; Bt = (const char*)Bt_; nMe = nMe_; nNe = nNe_; nwg = NE * nMe * nNe; G = G_; c = c_; }
    __device__ bool next(int i, Unit& u) const {
        const long L = (long)i * G + c; if (L >= nwg) return false;
        const int per = nMe * nNe, e = (int)L / per, rem = (int)L % per, pm = rem % nMe, pn = rem / nMe;
        u.pm = pm; u.pn = pn; u.e = e; u.rowbase = e * ROWS_E + pm * BM; u.colbase = pn * BM;
        u.a = A + (size_t)(e * ROWS_E + pm * BM) * RB; u.b = Bt + ((size_t)e * nNe + pn) * (BM * RB); return true;
    }
};

__device__ __forceinline__ unsigned cvt_pk_bf16(float lo, float hi) { unsigned r; asm volatile("v_cvt_pk_bf16_f32 %0, %1, %2" : "=v"(r) : "v"(lo), "v"(hi)); return r; }

struct EpiStoreBf16 {
    static constexpr bool PERM = true;
    bf16_t* O; int ldc;
    __device__ __forceinline__ void operator()(const f32x4 (&acc)[2][2][4][2], const Unit& u, int wr, int wc, int fr, int fq) const {
        const int row0 = u.rowbase + wr * 64 + fr, col0 = u.colbase + wc * 32 + 8 * fq;
#pragma unroll
        for (int ai = 0; ai < 2; ++ai)
#pragma unroll
            for (int m = 0; m < 4; ++m) { bf16_t* rowp = O + (size_t)(row0 + ai * HALF + m * 16) * ldc + col0;
#pragma unroll
                for (int bj = 0; bj < 2; ++bj) { const f32x4 v0 = acc[ai][bj][m][0], v1 = acc[ai][bj][m][1];
                    u32x4 w; w.x = cvt_pk_bf16(v0[0], v0[1]); w.y = cvt_pk_bf16(v0[2], v0[3]); w.z = cvt_pk_bf16(v1[0], v1[1]); w.w = cvt_pk_bf16(v1[2], v1[3]);
                    *(u32x4*)(rowp + bj * HALF) = w; } }
    }
};
struct EpiResid {
    static constexpr bool PERM = false;
    const float* ctxbase; const float* latbase; int cbs, lbs;
    float* xout; const float* modl;
    __device__ __forceinline__ void operator()(const f32x4 (&acc)[2][2][4][2], const Unit& u, int wr, int wc, int fr, int fq) const {
        const int b = u.pm / 17, tb = u.pm % 17;
        const float* src = (tb == 0) ? ctxbase + (size_t)b * cbs * DM : latbase + ((size_t)b * lbs + (size_t)(tb - 1) * 256) * DM;
        const float* g1 = modl + (size_t)((tb == 0) ? 4 : b) * NMOD + 2 * DM;
        const int rl0 = wr * 64 + fr, col0 = u.colbase + wc * 32 + 4 * fq;
        f32x4 gv[2][2];
#pragma unroll
        for (int bj = 0; bj < 2; ++bj)
#pragma unroll
            for (int n = 0; n < 2; ++n) gv[bj][n] = *(const f32x4*)(g1 + col0 + bj * HALF + n * 16);
#pragma unroll
        for (int ai = 0; ai < 2; ++ai)
#pragma unroll
            for (int m = 0; m < 4; ++m) { const int rl = rl0 + ai * HALF + m * 16; const float* sp = src + (size_t)rl * DM + col0; float* dp = xout + (size_t)(u.rowbase + rl) * DM + col0;
#pragma unroll
                for (int bj = 0; bj < 2; ++bj)
#pragma unroll
                    for (int n = 0; n < 2; ++n) { const f32x4 xv = *(const f32x4*)(sp + bj * HALF + n * 16); *(f32x4*)(dp + bj * HALF + n * 16) = xv + gv[bj][n] * acc[ai][bj][m][n]; }
                if (m & 1) asm volatile("" ::: "memory"); }
    }
};
struct EpiSwiGLU {
    static constexpr bool PERM = true;
    bf16_t* Hout;
    __device__ __forceinline__ void operator()(const f32x4 (&acc)[2][2][4][2], const Unit& u, int wr, int wc, int fr, int fq) const {
        const int row0 = u.rowbase + wr * 64 + fr, col0 = u.pn * HALF + wc * 32 + 8 * fq;
#pragma unroll
        for (int ai = 0; ai < 2; ++ai)
#pragma unroll
            for (int m = 0; m < 4; ++m) { bf16_t* rowp = Hout + (size_t)(row0 + ai * HALF + m * 16) * DM + col0; float h[8];
#pragma unroll
                for (int n = 0; n < 2; ++n)
#pragma unroll
                    for (int j = 0; j < 4; ++j) { const float g = acc[ai][0][m][n][j], up = acc[ai][1][m][n][j]; h[n * 4 + j] = g * __builtin_amdgcn_rcpf(1.f + __expf(-g)) * up; }
                u32x4 w; w.x = cvt_pk_bf16(h[0], h[1]); w.y = cvt_pk_bf16(h[2], h[3]); w.z = cvt_pk_bf16(h[4], h[5]); w.w = cvt_pk_bf16(h[6], h[7]);
                *(u32x4*)rowp = w; }
    }
};
struct EpiSwiGLU8 {
    static constexpr bool PERM = true;
    unsigned char* Hout;
    __device__ __forceinline__ void operator()(const f32x4 (&acc)[2][2][4][2], const Unit& u, int wr, int wc, int fr, int fq) const {
        const int row0 = u.rowbase + wr * 64 + fr, col0 = u.pn * HALF + wc * 32 + 8 * fq;
#pragma unroll
        for (int ai = 0; ai < 2; ++ai)
#pragma unroll
            for (int m = 0; m < 4; ++m) { unsigned char* rowp = Hout + (size_t)(row0 + ai * HALF + m * 16) * DM + col0; float h[8];
#pragma unroll
                for (int n = 0; n < 2; ++n)
#pragma unroll
                    for (int j = 0; j < 4; ++j) { const float g = acc[ai][0][m][n][j], up = acc[ai][1][m][n][j]; h[n * 4 + j] = g * __builtin_amdgcn_rcpf(1.f + __expf(-g)) * up; }
                u32x2 w; w.x = pk4_fp8(h[0], h[1], h[2], h[3]); w.y = pk4_fp8(h[4], h[5], h[6], h[7]);
                *(u32x2*)rowp = w; }
    }
};
struct EpiDown {
    static constexpr bool PERM = true;
    bf16_t* Y; const float* gatev;
    __device__ __forceinline__ void operator()(const f32x4 (&acc)[2][2][4][2], const Unit& u, int wr, int wc, int fr, int fq) const {
        const int row0 = u.rowbase + wr * 64 + fr, col0 = u.colbase + wc * 32 + 8 * fq;
#pragma unroll
        for (int ai = 0; ai < 2; ++ai)
#pragma unroll
            for (int m = 0; m < 4; ++m) { const int row = row0 + ai * HALF + m * 16; const float gt = gatev[row]; bf16_t* rowp = Y + (size_t)row * DM + col0;
#pragma unroll
                for (int bj = 0; bj < 2; ++bj) { const f32x4 v0 = acc[ai][bj][m][0] * gt, v1 = acc[ai][bj][m][1] * gt;
                    u32x4 w; w.x = cvt_pk_bf16(v0[0], v0[1]); w.y = cvt_pk_bf16(v0[2], v0[3]); w.z = cvt_pk_bf16(v1[0], v1[1]); w.w = cvt_pk_bf16(v1[2], v1[3]);
                    *(u32x4*)(rowp + bj * HALF) = w; } }
    }
};

template <class Epi, class Sched, bool FP8 = false, bool ALIGN_EPI = true, bool SP2 = true>
__device__ __forceinline__ void gemm_phase(LAS unsigned char* lds, const Sched& S, const Epi& E) {
    static_assert(Sched::RB == (FP8 ? GK : GK * 2), "operand row bytes");
    const int tid = opaque_tid(), wid = __builtin_amdgcn_readfirstlane(tid >> 6), lane = tid & 63, wr = wid >> 2, wc = wid & 3, fr = lane & 15, fq = lane >> 4;
    constexpr int RB = Sched::RB, nt = RB / 128;
    unsigned voffA[2], voffB[2];
#pragma unroll
    for (int i = 0; i < 2; ++i) { int R, C; stage_rc(tid * 16 + i * 8192, R, C); const int Rb = Epi::PERM ? ((R & ~31) + perm32(R & 31)) : R;
        voffA[i] = (unsigned)(R * RB + C * 2); voffB[i] = (unsigned)(Rb * RB + C * 2); }
    const size_t kstep = (size_t)(BK * 2);
    const size_t hstep = (size_t)HALF * RB;
    const unsigned ldsw = (unsigned)wid * 1024u;
    const int aoff = lds_byte(wr * 64 + fr, fq * 8), boff = lds_byte(wc * 32 + fr, fq * 8);
#define PG8_SA(b, h) (((b) * 2 + (h)) * HTB)
#define PG8_SB(b, h) ((4 + (b) * 2 + (h)) * HTB)
#define PG8_STAGE(bufoff, gbase, voff) do { _Pragma("unroll") for (int _i = 0; _i < 2; ++_i) \
        __builtin_amdgcn_global_load_lds((const unsigned*)((const char*)(gbase) + (voff)[_i]), (LAS unsigned*)(lds + (bufoff) + ldsw + _i * 8192), 16, 0, 0); } while (0)
#define PG8_RD8(p) __builtin_shufflevector(*(const LAS i32x4*)(p), *(const LAS i32x4*)((p) + 1024), 0, 1, 2, 3, 4, 5, 6, 7)
#define PG8_LDA(dst, b, h) do { _Pragma("unroll") for (int m = 0; m < 4; ++m) { if constexpr (FP8) dst##8[m] = PG8_RD8(lds + PG8_SA(b, h) + aoff + m * 2048); \
        else { _Pragma("unroll") for (int k = 0; k < 2; ++k) dst[m][k] = *(const LAS bf16x8*)(lds + PG8_SA(b, h) + aoff + m * 2048 + k * 1024); } } } while (0)
#define PG8_LDB(dst, b, h) do { _Pragma("unroll") for (int n = 0; n < 2; ++n) { if constexpr (FP8) dst##8[n] = PG8_RD8(lds + PG8_SB(b, h) + boff + n * 2048); \
        else { _Pragma("unroll") for (int k = 0; k < 2; ++k) dst[n][k] = *(const LAS bf16x8*)(lds + PG8_SB(b, h) + boff + n * 2048 + k * 1024); } } } while (0)
#define PG8_MMA(ai, bj, At, Bt) do { __builtin_amdgcn_s_setprio(1); _Pragma("unroll") for (int m = 0; m < 4; ++m) _Pragma("unroll") for (int n = 0; n < 2; ++n) { \
        if constexpr (FP8) asm volatile("v_mfma_scale_f32_16x16x128_f8f6f4 %0, %1, %2, %0, %3, %4 op_sel_hi:[0,0,0]" : "+v"(acc[ai][bj][m][n]) : "v"(Bt##8[n]), "v"(At##8[m]), "v"(sclW), "v"(sclX)); \
        else { _Pragma("unroll") for (int k = 0; k < 2; ++k) acc[ai][bj][m][n] = __builtin_amdgcn_mfma_f32_16x16x32_bf16(Bt[n][k], At[m][k], acc[ai][bj][m][n], 0, 0, 0); } } \
        __builtin_amdgcn_s_setprio(0); } while (0)
#define PG8_WAIT_V(n) asm volatile("s_waitcnt vmcnt(" #n ")" ::: "memory")
#define PG8_WAIT_L(n) asm volatile("s_waitcnt lgkmcnt(" #n ")" ::: "memory")
#define PG8_BAR __builtin_amdgcn_s_barrier()
#define PG8_SCHED __builtin_amdgcn_sched_barrier(0)
    Unit cur, nxt; int ui = 0;
    if (!S.next(0, cur)) return;
    f32x4 acc[2][2][4][2];
#pragma unroll
    for (int a = 0; a < 2; ++a)
#pragma unroll
        for (int b = 0; b < 2; ++b)
#pragma unroll
            for (int m = 0; m < 4; ++m)
#pragma unroll
                for (int n = 0; n < 2; ++n) acc[a][b][m][n] = (f32x4){0.f, 0.f, 0.f, 0.f};
    const int sclW = W8_SCALE_E8M0 * 0x01010101, sclX = 0x7f7f7f7f; (void)sclW; (void)sclX;
    bf16x8 At[4][2], B0[2][2], B1[2][2]; i32x8 At8[4], B08[2], B18[2];
    const char* cA = cur.a; const char* cB = cur.b;
    if constexpr (SP2) {
        PG8_STAGE(PG8_SB(0, 0), cB, voffB); PG8_STAGE(PG8_SB(0, 1), cB + hstep, voffB); PG8_STAGE(PG8_SA(0, 0), cA, voffA); PG8_STAGE(PG8_SA(0, 1), cA + hstep, voffA);
        if (wr == 1) PG8_BAR;
        PG8_WAIT_V(2); PG8_BAR;
        PG8_STAGE(PG8_SB(1, 0), cB + kstep, voffB); PG8_STAGE(PG8_SA(1, 0), cA + kstep, voffA); PG8_STAGE(PG8_SB(1, 1), cB + hstep + kstep, voffB);
        PG8_WAIT_V(6); PG8_BAR;
    } else {
        PG8_STAGE(PG8_SB(0, 0), cB, voffB); PG8_STAGE(PG8_SA(0, 0), cA, voffA); PG8_STAGE(PG8_SB(0, 1), cB + hstep, voffB); PG8_STAGE(PG8_SA(0, 1), cA + hstep, voffA);
        if (wr == 1) PG8_BAR;
        PG8_WAIT_V(4); PG8_BAR;
        PG8_STAGE(PG8_SB(1, 0), cB + kstep, voffB); PG8_STAGE(PG8_SA(1, 0), cA + kstep, voffA); PG8_STAGE(PG8_SB(1, 1), cB + hstep + kstep, voffB);
        PG8_WAIT_V(6); PG8_BAR;
    }
    for (;;) {
        const bool has_next = S.next(ui + 1, nxt);
        const char* nA = has_next ? nxt.a : cA; const char* nB = has_next ? nxt.b : cB;
        for (int t = 0; t < nt; t += 2) {
            const bool last = (t == nt - 2);
            const char* a1 = cA + (size_t)(t + 1) * kstep;
            const char* a2 = last ? nA : cA + (size_t)(t + 2) * kstep; const char* b2 = last ? nB : cB + (size_t)(t + 2) * kstep;
            const char* a3 = a2 + kstep; const char* b3 = b2 + kstep;
            if constexpr (SP2) {
            PG8_LDB(B0, 0, 0); PG8_LDB(B1, 0, 1); PG8_SCHED; PG8_LDA(At, 0, 0); PG8_STAGE(PG8_SA(1, 1), a1 + hstep, voffA);
            PG8_WAIT_V(8); PG8_WAIT_L(0); PG8_BAR; PG8_MMA(0, 0, At, B0); PG8_MMA(0, 1, At, B1); PG8_BAR; PG8_SCHED;
            PG8_LDA(At, 0, 1); PG8_STAGE(PG8_SB(0, 0), b2, voffB); PG8_STAGE(PG8_SB(0, 1), b2 + hstep, voffB); PG8_STAGE(PG8_SA(0, 0), a2, voffA);
            PG8_WAIT_V(8); PG8_WAIT_L(0); PG8_BAR; PG8_MMA(1, 0, At, B0); PG8_MMA(1, 1, At, B1); PG8_BAR; PG8_SCHED;
            PG8_LDB(B0, 1, 0); PG8_LDB(B1, 1, 1); PG8_SCHED; PG8_LDA(At, 1, 0); PG8_STAGE(PG8_SA(0, 1), a2 + hstep, voffA);
            PG8_WAIT_V(8); PG8_WAIT_L(0); PG8_BAR; PG8_MMA(0, 0, At, B0); PG8_MMA(0, 1, At, B1); PG8_BAR; PG8_SCHED;
            PG8_LDA(At, 1, 1); PG8_STAGE(PG8_SB(1, 0), b3, voffB); PG8_STAGE(PG8_SB(1, 1), b3 + hstep, voffB); PG8_STAGE(PG8_SA(1, 0), a3, voffA);
            PG8_WAIT_V(8); PG8_WAIT_L(0); PG8_BAR; PG8_MMA(1, 0, At, B0); PG8_MMA(1, 1, At, B1); PG8_BAR; PG8_SCHED;
            } else {
            PG8_LDB(B0, 0, 0); PG8_SCHED; PG8_LDA(At, 0, 0); PG8_STAGE(PG8_SA(1, 1), a1 + hstep, voffA);
            PG8_WAIT_L(8); PG8_BAR; PG8_WAIT_L(0); PG8_MMA(0, 0, At, B0); PG8_BAR; PG8_SCHED;
            PG8_LDB(B1, 0, 1); PG8_STAGE(PG8_SB(0, 0), b2, voffB);
            PG8_BAR; PG8_WAIT_L(0); PG8_MMA(0, 1, At, B1); PG8_BAR;
            PG8_LDA(At, 0, 1); PG8_STAGE(PG8_SA(0, 0), a2, voffA);
            PG8_BAR; PG8_WAIT_L(0); PG8_MMA(1, 0, At, B0); PG8_BAR; PG8_SCHED;
            PG8_STAGE(PG8_SB(0, 1), b2 + hstep, voffB);
            PG8_WAIT_V(6); PG8_BAR; PG8_MMA(1, 1, At, B1); PG8_BAR;
            PG8_LDB(B0, 1, 0); PG8_SCHED; PG8_LDA(At, 1, 0); PG8_STAGE(PG8_SA(0, 1), a2 + hstep, voffA);
            PG8_WAIT_L(8); PG8_BAR; PG8_WAIT_L(0); PG8_MMA(0, 0, At, B0); PG8_BAR; PG8_SCHED;
            PG8_LDB(B1, 1, 1); PG8_STAGE(PG8_SB(1, 0), b3, voffB);
            PG8_BAR; PG8_WAIT_L(0); PG8_MMA(0, 1, At, B1); PG8_BAR;
            PG8_LDA(At, 1, 1); PG8_STAGE(PG8_SA(1, 0), a3, voffA);
            PG8_BAR; PG8_WAIT_L(0); PG8_MMA(1, 0, At, B0); PG8_BAR; PG8_SCHED;
            PG8_STAGE(PG8_SB(1, 1), b3 + hstep, voffB);
            PG8_WAIT_V(6); PG8_BAR; PG8_MMA(1, 1, At, B1); PG8_BAR;
            }
        }
        if constexpr (ALIGN_EPI) { if (wr == 0) PG8_BAR; }
        if constexpr (FP8) asm volatile("s_nop 15\n\ts_nop 15\n\ts_nop 7" ::: "memory");
        E(acc, cur, wr, wc, fr, fq);
        if (!has_next) break;
#pragma unroll
        for (int a = 0; a < 2; ++a)
#pragma unroll
            for (int b = 0; b < 2; ++b)
#pragma unroll
                for (int m = 0; m < 4; ++m)
#pragma unroll
                    for (int n = 0; n < 2; ++n) acc[a][b][m][n] = (f32x4){0.f, 0.f, 0.f, 0.f};
        cur = nxt; cA = nA; cB = nB; ++ui;
        if constexpr (ALIGN_EPI) { if (wr == 1) PG8_BAR; }
    }
    PG8_WAIT_V(0);
    if constexpr (!ALIGN_EPI) { if (wr == 0) PG8_BAR; }
    PG8_BAR;
#undef PG8_SA
#undef PG8_SB
#undef PG8_STAGE
#undef PG8_LDA
#undef PG8_LDB
#undef PG8_MMA
#undef PG8_RD8
#undef PG8_WAIT_V
#undef PG8_WAIT_L
#undef PG8_BAR
#undef PG8_SCHED
}
}

namespace at {
constexpr int D = 128, NW = 8, QBLK = 32, KVBLK = 64;
constexpr float SCALE = 0.088388347648318440f;
constexpr float THR = 8.f;
constexpr int LDQ = INW, LDK = INW, LDO = DM;
constexpr size_t SHM_V = KVBLK * D * 2, SHM_K = KVBLK * D * 2, SHM_ATTN = 2 * SHM_V + 2 * SHM_K + NW * 64 * 4;
#define KSWZ(row, colB) ((row) * 256 + ((colB) ^ (((row) & 7) << 4)))
#define SBAR() __builtin_amdgcn_sched_barrier(0)
__device__ __forceinline__ int crow(int r, int hi) { return (r & 3) + 8 * (r >> 2) + 4 * hi; }
__device__ __forceinline__ unsigned cvtpk(float lo, float hi) { unsigned r; asm volatile("v_cvt_pk_bf16_f32 %0, %1, %2" : "=v"(r) : "v"(lo), "v"(hi)); return r; }

__device__ __forceinline__ void partialSM(f32x16& p0, f32x16& p1, float& m_reg, float& mn, float& alpha, bool domask, int dq, int hi) {
  constexpr float C = SCALE * 1.4426950408889634f;
  {
    if (domask) {
#pragma unroll
      for (int r = 0; r < 16; ++r) { const int d0 = dq + crow(r, hi), d1 = d0 + 32;
        if (d0 > 128 || d0 < -128) p0[r] = -1e30f;
        if (d1 > 128 || d1 < -128) p1[r] = -1e30f; }
    }
  }
  float pmax = p0[0]; for (int r = 1; r < 16; ++r) pmax = fmaxf(pmax, p0[r]); for (int r = 0; r < 16; ++r) pmax = fmaxf(pmax, p1[r]);
  { auto rr = __builtin_amdgcn_permlane32_swap(__float_as_uint(pmax), __float_as_uint(pmax), false, false);
    pmax = fmaxf(__uint_as_float(rr[0]), __uint_as_float(rr[1])); }
  if (__builtin_expect(__all(pmax - m_reg <= THR / SCALE), 1)) { mn = m_reg; alpha = 1.f; }
  else { mn = fmaxf(m_reg, pmax); alpha = __builtin_amdgcn_exp2f((m_reg - mn) * C); m_reg = mn; }
  float mnC = -mn * C;
  for (int r = 0; r < 16; ++r) p0[r] = fmaf(p0[r], C, mnC); for (int r = 0; r < 16; ++r) p1[r] = fmaf(p1[r], C, mnC);
  for (int r = 0; r < 16; ++r) p0[r] = __builtin_amdgcn_exp2f(p0[r]);
}
__device__ __forceinline__ void finishSM(f32x16& p0, f32x16& p1, float alpha, float& l_reg, bf16x8& pa0, bf16x8& pa1, bf16x8& pa2, bf16x8& pa3) {
  for (int r = 0; r < 16; ++r) p1[r] = __builtin_amdgcn_exp2f(p1[r]);
  float ps = 0; for (int r = 0; r < 16; ++r) ps += p0[r]; for (int r = 0; r < 16; ++r) ps += p1[r];
  { auto rr = __builtin_amdgcn_permlane32_swap(__float_as_uint(ps), __float_as_uint(ps), false, false);
    ps = __uint_as_float(rr[0]) + __uint_as_float(rr[1]); }
  l_reg = l_reg * alpha + ps;
#define PK4(P, BASE, OUT) do { unsigned a0 = cvtpk(P[BASE + 0], P[BASE + 1]), a1 = cvtpk(P[BASE + 2], P[BASE + 3]);   \
    unsigned b0 = cvtpk(P[BASE + 4], P[BASE + 5]), b1 = cvtpk(P[BASE + 6], P[BASE + 7]);                              \
    auto r0 = __builtin_amdgcn_permlane32_swap(a0, b0, false, false); auto r1 = __builtin_amdgcn_permlane32_swap(a1, b1, false, false); \
    u32x4 w = {r0[0], r1[0], r0[1], r1[1]}; OUT = *reinterpret_cast<bf16x8*>(&w); } while (0)
  PK4(p0, 0, pa0); PK4(p0, 8, pa1); PK4(p1, 0, pa2); PK4(p1, 8, pa3);
#undef PK4
}
__device__ __forceinline__ void qkt(f32x16& p0, f32x16& p1, const char* Ks, const bf16x8* qr, int ka0) {
  p0 = f32x16{}; p1 = f32x16{};
  asm volatile("" : "+v"(ka0));
#pragma unroll
  for (int d0 = 0; d0 < 8; ++d0) { const int off = ka0 ^ (d0 * 32);
    bf16x8 b0 = *reinterpret_cast<const bf16x8*>(Ks + off);
    bf16x8 b1 = *reinterpret_cast<const bf16x8*>(Ks + off + 32 * 256);
    p0 = __builtin_amdgcn_mfma_f32_32x32x16_bf16(b0, qr[d0], p0, 0, 0, 0);
    p1 = __builtin_amdgcn_mfma_f32_32x32x16_bf16(b1, qr[d0], p1, 0, 0, 0); }
}
__device__ __forceinline__ int v_st(int k, int c) { const int kk = (k & ~0xC) | ((k & 4) << 1) | ((k & 8) >> 1); return ((kk >> 3) * 4 + (c >> 5)) * 512 + ((kk & 7) * 32 + (c & 31)) * 2; }
__device__ __forceinline__ int v_rd_base(int lane) { return ((lane & 3) << 3) | (((lane >> 2) & 3) << 6) | (((lane >> 4) & 1) << 5) | (((lane >> 5) & 1) << 8); }
constexpr int v_rd_off(int d0, int ks, int half) { return d0 * 512 + ks * 4096 + half * 2048; }
template <int OFF> __device__ __forceinline__ s16x4 tr_read(int vb) {
  s16x4 r; asm volatile("ds_read_b64_tr_b16 %0, %1 offset:%2" : "=&v"(r) : "v"(vb), "i"(OFF) : "memory"); return r;
}
template <int D0> __device__ __forceinline__ void pv_one(f32x16& od, int vb, bf16x8 pa0, bf16x8 pa1, bf16x8 pa2, bf16x8 pa3) {
  const s16x4 l0 = tr_read<v_rd_off(D0, 0, 0)>(vb), h0 = tr_read<v_rd_off(D0, 0, 1)>(vb), l1 = tr_read<v_rd_off(D0, 1, 0)>(vb), h1 = tr_read<v_rd_off(D0, 1, 1)>(vb);
  const s16x4 l2 = tr_read<v_rd_off(D0, 2, 0)>(vb), h2 = tr_read<v_rd_off(D0, 2, 1)>(vb), l3 = tr_read<v_rd_off(D0, 3, 0)>(vb), h3 = tr_read<v_rd_off(D0, 3, 1)>(vb);
  asm volatile("s_waitcnt lgkmcnt(0)" ::: "memory"); SBAR();
#define PK(L, H) (bf16x8){L[0], L[1], L[2], L[3], H[0], H[1], H[2], H[3]}
  od = __builtin_amdgcn_mfma_f32_32x32x16_bf16(pa0, PK(l0, h0), od, 0, 0, 0);
  od = __builtin_amdgcn_mfma_f32_32x32x16_bf16(pa1, PK(l1, h1), od, 0, 0, 0);
  od = __builtin_amdgcn_mfma_f32_32x32x16_bf16(pa2, PK(l2, h2), od, 0, 0, 0);
  od = __builtin_amdgcn_mfma_f32_32x32x16_bf16(pa3, PK(l3, h3), od, 0, 0, 0);
#undef PK
}
__device__ __forceinline__ void pv_d0(f32x16* o, int vb, bf16x8 pa0, bf16x8 pa1, bf16x8 pa2, bf16x8 pa3) {
  pv_one<0>(o[0], vb, pa0, pa1, pa2, pa3); pv_one<1>(o[1], vb, pa0, pa1, pa2, pa3); pv_one<2>(o[2], vb, pa0, pa1, pa2, pa3); pv_one<3>(o[3], vb, pa0, pa1, pa2, pa3);
}

__device__ __forceinline__ void attn_body(const bf16_t* __restrict__ Qb, const bf16_t* __restrict__ Kb, const bf16_t* __restrict__ Vb, bf16_t* __restrict__ Ob,
                                          int NT, int kskip, int qpos0, float m0, float l0, bool maskon, char* lds) {
  const int tid = opaque_tid(), wid = tid >> 6, lane = tid & 63, r32 = lane & 31, hi = lane >> 5;
  char* V_lds = lds; char* K_lds = lds + 2 * SHM_V;
  float* ws = (float*)(lds + 2 * SHM_V + 2 * SHM_K) + wid * 64; float* li_l = ws; float* al_l = ws + 32;
  float m_reg = m0, l_reg = l0; f32x16 o[4] = {}; bf16x8 qr[8];
  const bf16_t* Qw = Qb + (long)(wid * QBLK + r32) * LDQ + hi * 8;
#pragma unroll
  for (int d0 = 0; d0 < 8; ++d0) qr[d0] = *reinterpret_cast<const bf16x8*>(Qw + d0 * 16);
  const int sr = tid >> 4, sc = (tid & 15) * 8, vst0 = v_st(sr, sc), vst1 = v_st(32 + sr, sc);
  const int vb0 = (int)(uintptr_t)V_lds + v_rd_base(lane);
  const int qpos = qpos0 + wid * QBLK + r32;
  const int ka0 = r32 * 256 + ((hi * 16) ^ ((r32 & 7) << 4));
  const unsigned goff0 = (unsigned)(sr * LDK + sc) * 2u, goff1 = goff0 + 32u * LDK * 2u;
  struct { bf16x8 vs0, vs1, ks0, ks1; } sr_[2];
#define TROW(jt) ((long)(jt) * KVBLK + ((jt) >= 4 ? kskip : 0))
#define SLOAD(i, jt) do { const long _k0 = TROW(jt) * (LDK * 2); const char* _kp = (const char*)Kb + _k0; const char* _vp = (const char*)Vb + _k0; \
    sr_[i].vs0 = *reinterpret_cast<const bf16x8*>(_vp + goff0); sr_[i].vs1 = *reinterpret_cast<const bf16x8*>(_vp + goff1); \
    sr_[i].ks0 = *reinterpret_cast<const bf16x8*>(_kp + goff0); sr_[i].ks1 = *reinterpret_cast<const bf16x8*>(_kp + goff1); } while (0)
#define SWRITE(b, i) do { *(bf16x8*)(V_lds + (b) * SHM_V + vst0) = sr_[i].vs0;          \
    *(bf16x8*)(V_lds + (b) * SHM_V + vst1) = sr_[i].vs1; int kc = sc * 2;               \
    *(bf16x8*)(K_lds + (b) * SHM_K + KSWZ(sr, kc)) = sr_[i].ks0;                       \
    *(bf16x8*)(K_lds + (b) * SHM_K + KSWZ(32 + sr, kc)) = sr_[i].ks1; } while (0)
#define SWAIT() asm volatile("s_waitcnt vmcnt(4)" ::: "memory")
#define RESC(a) do { if (__any((a) < 1.f)) { if (hi == 0) al_l[r32] = (a); asm volatile("s_waitcnt lgkmcnt(0)" ::: "memory"); \
    for (int d = 0; d < 4; ++d) for (int r = 0; r < 16; ++r) o[d][r] *= al_l[crow(r, hi)]; } } while (0)
#define DQ(jt) (kskip + ((jt) - 4) * KVBLK - qpos)
  f32x16 pA0, pA1, pB0, pB1; float mnA, mnB, alA, alB; bf16x8 pa0, pa1, pa2, pa3;
  constexpr int SE = 0, SO = 1;
  SLOAD(SE, 0); asm volatile("s_waitcnt vmcnt(0)" ::: "memory"); SWRITE(0, SE); __syncthreads();
  qkt(pA0, pA1, K_lds, qr, ka0); partialSM(pA0, pA1, m_reg, mnA, alA, false, 0, hi);
  SLOAD(SO, 1); if (2 < NT) SLOAD(SE, 2);
  SWAIT(); SWRITE(1, SO); __syncthreads();
  for (int j = 1; j + 1 < NT; j += 2) {
    SBAR(); qkt(pB0, pB1, K_lds + SHM_K, qr, ka0);
    finishSM(pA0, pA1, alA, l_reg, pa0, pa1, pa2, pa3); SBAR();
    SLOAD(SO, j + 2); SBAR();
    pv_d0(o, vb0, pa0, pa1, pa2, pa3); partialSM(pB0, pB1, m_reg, mnB, alB, maskon && j >= 4, DQ(j), hi);
    __syncthreads(); SWAIT(); SWRITE(0, SE);
    RESC(alB); __syncthreads();
    SBAR(); qkt(pA0, pA1, K_lds, qr, ka0);
    finishSM(pB0, pB1, alB, l_reg, pa0, pa1, pa2, pa3); SBAR();
    if (j + 3 < NT) SLOAD(SE, j + 3); SBAR();
    pv_d0(o, vb0 + (int)SHM_V, pa0, pa1, pa2, pa3); partialSM(pA0, pA1, m_reg, mnA, alA, maskon && j + 1 >= 4, DQ(j + 1), hi);
    __syncthreads(); SWAIT(); SWRITE(1, SO);
    RESC(alA); __syncthreads();
  }
  SBAR(); qkt(pB0, pB1, K_lds + SHM_K, qr, ka0);
  finishSM(pA0, pA1, alA, l_reg, pa0, pa1, pa2, pa3); SBAR();
  pv_d0(o, vb0, pa0, pa1, pa2, pa3); partialSM(pB0, pB1, m_reg, mnB, alB, maskon && NT - 1 >= 4, DQ(NT - 1), hi);
  __syncthreads(); RESC(alB);
  finishSM(pB0, pB1, alB, l_reg, pa0, pa1, pa2, pa3); SBAR();
  pv_d0(o, vb0 + (int)SHM_V, pa0, pa1, pa2, pa3);
  if (hi == 0) li_l[r32] = l_reg; asm volatile("s_waitcnt lgkmcnt(0)" ::: "memory");
  float rli[16];
#pragma unroll
  for (int r = 0; r < 16; ++r) rli[r] = __builtin_amdgcn_rcpf(li_l[crow(r, hi)]);
  bf16_t* Ow = Ob + (long)(wid * QBLK) * LDO;
#pragma unroll
  for (int r = 0; r < 16; ++r) { int orow = crow(r, hi);
    for (int d0 = 0; d0 < 4; ++d0) Ow[(long)orow * LDO + d0 * 32 + r32] = (bf16_t)f2bf(o[d0][r] * rli[r]); }
#undef TROW
#undef SLOAD
#undef SWRITE
#undef SWAIT
#undef RESC
#undef DQ
}
}

struct Args { const float* in[23]; float* out; unsigned char* ws; int ph_lo, ph_hi; };
enum { IN_X = 0, IN_C, IN_CTX, IN_CCTX, IN_WMOD, IN_BMOD, IN_N1G, IN_N2G, IN_WIN, IN_QNA, IN_KNA, IN_SINK, IN_VNB, IN_WS, IN_BS, IN_QNC, IN_KNC, IN_OUTG, IN_WOUT, IN_WR, IN_WG, IN_WU, IN_WDN };

#define PHASE_IDS(F) const int tid = opaque_tid(), lane = tid & 63, wave = __builtin_amdgcn_readfirstlane(tid >> 6), gw = (int)blockIdx.x * 8 + wave, NGW = (F).G * 8; (void)lane; (void)wave; (void)gw; (void)NGW
constexpr int ARGTAB_OFF = LDSCTL_OFF + 1024;
#define INP(F, i) ld_inp((F).lds, (i))
__device__ __forceinline__ const float* ld_inp(LAS unsigned char* lds, int i) {
    const volatile LAS unsigned* t = (const volatile LAS unsigned*)(lds + ARGTAB_OFF) + 2 * i;
    const unsigned lo = __builtin_amdgcn_readfirstlane(t[0]), hi = __builtin_amdgcn_readfirstlane(t[1]);
    return (const float*)(const GAS float*)(((unsigned long long)hi << 32) | lo);
}
struct Frame {
    LAS unsigned char* lds; char* ldsg;
    volatile LAS unsigned* MISC;
    unsigned* ctl;
    int G;
    float* out; unsigned char* ws;
};

__device__ __forceinline__ void transpose_item(const float* W, int N, bf16_t* WT, int k0, int n0, int drow0, LAS float* scr, int lane) {
#pragma unroll 8
    for (int i = 0; i < 32; ++i) { const int kk = 2 * i + (lane >> 5); scr[kk * 33 + (lane & 31)] = W[(size_t)(k0 + kk) * N + n0 + (lane & 31)]; }
    LDS_WAIT(); asm volatile("" ::: "memory");
    const int c = lane & 7;
#pragma unroll
    for (int j = 0; j < 4; ++j) { const int n = (lane >> 3) + 8 * j; const LAS float* s = scr + (8 * c) * 33 + n;
        u32x4 o; o.x = pk2(s[0 * 33], s[1 * 33]); o.y = pk2(s[2 * 33], s[3 * 33]); o.z = pk2(s[4 * 33], s[5 * 33]); o.w = pk2(s[6 * 33], s[7 * 33]);
        *(u32x4*)(WT + (size_t)(drow0 + n) * DM + k0 + 8 * c) = o; }
    LDS_WAIT(); asm volatile("" ::: "memory");
}

__device__ __forceinline__ void transpose_item8(const float* W, int N, unsigned char* WT, int k0, int n0, int drow0, LAS float* scr, int lane) {
#pragma unroll 8
    for (int i = 0; i < 32; ++i) { const int kk = 2 * i + (lane >> 5); scr[kk * 33 + (lane & 31)] = W[(size_t)(k0 + kk) * N + n0 + (lane & 31)]; }
    LDS_WAIT(); asm volatile("" ::: "memory");
    const int c = lane & 7;
#pragma unroll
    for (int j = 0; j < 4; ++j) { const int n = (lane >> 3) + 8 * j; const LAS float* s = scr + (8 * c) * 33 + n;
        u32x2 o; o.x = pk4_fp8(s[0 * 33] * W8_SCALE, s[1 * 33] * W8_SCALE, s[2 * 33] * W8_SCALE, s[3 * 33] * W8_SCALE); o.y = pk4_fp8(s[4 * 33] * W8_SCALE, s[5 * 33] * W8_SCALE, s[6 * 33] * W8_SCALE, s[7 * 33] * W8_SCALE);
        *(u32x2*)(WT + (size_t)(drow0 + n) * DM + k0 + 8 * c) = o; }
    LDS_WAIT(); asm volatile("" ::: "memory");
}
__device__ __forceinline__ void phase_prologue(Frame& F) {
    PHASE_IDS(F);
    LAS float* scr = (LAS float*)(F.lds + wave * 16384);
    constexpr int I_IN = 32 * (INW / 32), I_SQ = 32 * (DM / 32);
    constexpr int NIT = 2 * I_IN + 2 * I_SQ + 2 * NE * 3 * I_SQ;
    for (int it = gw; it < NIT; it += NGW) {
        int r = it;
        if (r < 2 * I_IN) { const int l = r / I_IN; r %= I_IN; const int nblk = INW / 32, kb = r / nblk, nb = r % nblk;
            transpose_item(INP(F, IN_WIN) + (size_t)l * DM * INW, INW, (bf16_t*)(F.ws + WS_WIN) + (size_t)l * INW * DM, 64 * kb, 32 * nb, 32 * nb, scr, lane); continue; }
        r -= 2 * I_IN;
        if (r < 2 * I_SQ) { const int l = r / I_SQ; r %= I_SQ; const int kb = r / 64, nb = r % 64;
            transpose_item(INP(F, IN_WOUT) + (size_t)l * DM * DM, DM, (bf16_t*)(F.ws + WS_WOUT) + (size_t)l * DM * DM, 64 * kb, 32 * nb, 32 * nb, scr, lane); continue; }
        r -= 2 * I_SQ;
        const int mat = r / I_SQ; r %= I_SQ; const int kb = r / 64, nb = r % 64;
        const int le = mat / 3, which = mat % 3;
        const bool f8 = (le < NE) ? (FP8_L0 != 0) : (FP8_L1 != 0);
        if (which < 2) {
            const float* W = INP(F, which == 0 ? IN_WG : IN_WU) + (size_t)le * DM * DM; const int n0 = 32 * nb, dr = (n0 >> 7) * 256 + which * 128 + (n0 & 127);
            if (f8) transpose_item8(W, DM, (unsigned char*)(F.ws + WS_WGU) + (size_t)(le / NE) * NE * 4096 * DM * 2 + (size_t)(le % NE) * 4096 * DM, 64 * kb, n0, dr, scr, lane);
            else transpose_item(W, DM, (bf16_t*)(F.ws + WS_WGU) + (size_t)le * 4096 * DM, 64 * kb, n0, dr, scr, lane);
        } else {
            if (f8) transpose_item8(INP(F, IN_WDN) + (size_t)le * DM * DM, DM, (unsigned char*)(F.ws + WS_WD) + (size_t)(le / NE) * NE * DM * DM * 2 + (size_t)(le % NE) * DM * DM, 64 * kb, 32 * nb, 32 * nb, scr, lane);
            else transpose_item(INP(F, IN_WDN) + (size_t)le * DM * DM, DM, (bf16_t*)(F.ws + WS_WD) + (size_t)le * DM * DM, 64 * kb, 32 * nb, 32 * nb, scr, lane);
        }
    }
    __syncthreads();
    {
        LAS float* sil = (LAS float*)F.lds;
        LAS float* red = (LAS float*)(F.lds + 40960);
        bool have = false;
        for (int it = blockIdx.x; it < 2 * 96; it += F.G) {
            if (!have) {
                { const float* cp = INP(F, IN_C); const float* ccp = INP(F, IN_CCTX);
                for (int i = tid; i < 5 * DM; i += 512) { const int s = i / DM, k = i % DM; const float cv = (s < 4) ? cp[s * DM + k] : ccp[k]; sil[i] = cv / (1.f + __expf(-cv)); } }
                have = true; __syncthreads();
            }
            const int l = it / 96, cb = it % 96, c4 = tid & 31, kr = tid >> 5;
            const float* wp = INP(F, IN_WMOD) + (size_t)l * DM * NMOD + (size_t)cb * 128 + c4 * 4;
            f32x4 a[5];
#pragma unroll
            for (int s = 0; s < 5; ++s) a[s] = (f32x4){0.f, 0.f, 0.f, 0.f};
#pragma unroll 8
            for (int k = kr; k < DM; k += 16) { const f32x4 w = *(const f32x4*)(wp + (size_t)k * NMOD);
#pragma unroll
                for (int s = 0; s < 5; ++s) a[s] += w * sil[s * DM + k]; }
#pragma unroll
            for (int s = 0; s < 5; ++s) *(LAS f32x4*)(red + (kr * 5 + s) * 128 + c4 * 4) = a[s];
            __syncthreads();
            const float* bmod = INP(F, IN_BMOD);
            for (int i = tid; i < 5 * 128; i += 512) { const int s = i / 128, cc = i % 128; float sum = 0.f;
#pragma unroll
                for (int q = 0; q < 16; ++q) sum += red[(q * 5 + s) * 128 + cc];
                ((float*)(F.ws + WS_MOD))[(size_t)(l * 5 + s) * NMOD + cb * 128 + cc] = sum + bmod[l * NMOD + cb * 128 + cc]; }
            __syncthreads();
        }
    }
    if (blockIdx.x == F.G - 1) {
        for (int i = tid; i < 64 * 32; i += 512) {
            const int pos = i >> 5, f = i & 31;
            double inv = 1.0; for (int q = 0; q < f; ++q) inv *= 0.7498942093324559;
            const double a = (double)pos * inv;
            const double n = __builtin_rint(a * 0.6366197723675814);
            const double r = (a - n * 1.5707963267948966) - n * 6.123233995736766e-17;
            const double r2 = r * r;
            double sn = r * (1.0 + r2 * (-1.0 / 6 + r2 * (1.0 / 120 + r2 * (-1.0 / 5040 + r2 * (1.0 / 362880 + r2 * (-1.0 / 39916800 + r2 * (1.0 / 6227020800.0)))))));
            double cn = 1.0 + r2 * (-0.5 + r2 * (1.0 / 24 + r2 * (-1.0 / 720 + r2 * (1.0 / 40320 + r2 * (-1.0 / 3628800 + r2 * (1.0 / 479001600 + r2 * (-1.0 / 87178291200.0)))))));
            const int q = ((int)n) & 3; double cs, ss;
            if (q == 0) { cs = cn; ss = sn; } else if (q == 1) { cs = -sn; ss = cn; } else if (q == 2) { cs = -cn; ss = -sn; } else { cs = sn; ss = -cn; }
            ((float*)(F.ws + WS_ROPE))[2 * i] = (float)cs; ((float*)(F.ws + WS_ROPE))[2 * i + 1] = (float)ss;
        }
    }
}

__device__ __forceinline__ void load_row(const float* row, int lane, f32x4 (&v)[8]) {
#pragma unroll
    for (int j = 0; j < 8; ++j) v[j] = *(const f32x4*)(row + 4 * lane + 256 * j);
}
__device__ __forceinline__ void norm_mod_store(const f32x4 (&v)[8], const float* g, const float* shift, const float* scale, bf16_t* dst, int lane) {
    float ss = 0.f;
#pragma unroll
    for (int j = 0; j < 8; ++j) ss += (v[j].x * v[j].x + v[j].y * v[j].y) + (v[j].z * v[j].z + v[j].w * v[j].w);
    const float rinv = 1.0f / sqrtf(wave_sum(ss) * (1.f / DM) + EPS);
#pragma unroll
    for (int j = 0; j < 8; ++j) { const int c = 4 * lane + 256 * j;
        const f32x4 gg = *(const f32x4*)(g + c), sh = *(const f32x4*)(shift + c), sc = *(const f32x4*)(scale + c);
        const f32x4 y = (v[j] * rinv) * gg * (sc + 1.f) + sh;
        u32x2 w; w.x = pk2(y.x, y.y); w.y = pk2(y.z, y.w); *(u32x2*)(dst + c) = w; }
}

__device__ __forceinline__ void phase_rowpass1_l0(Frame& F) {
    PHASE_IDS(F);
    const float* mod = (const float*)(F.ws + WS_MOD);
    for (int r = gw; r < NTOK; r += NGW) {
        const int b = r / TPB, t = r % TPB, s = (t < CTXL) ? 4 : b;
        const float* src = (t < CTXL) ? INP(F, IN_CTX) + ((size_t)b * CTXL + t) * DM : INP(F, IN_X) + ((size_t)b * SEQ + (t - CTXL)) * DM;
        f32x4 v[8]; load_row(src, lane, v);
        norm_mod_store(v, INP(F, IN_N1G), mod + (size_t)s * NMOD, mod + (size_t)s * NMOD + DM, (bf16_t*)(F.ws + WS_HN) + (size_t)r * DM, lane);
    }
}

__device__ __forceinline__ void post_unpack(const u32x4 x, float (&v)[8]) {
    v[0] = bflo(x.x); v[1] = bfhi(x.x); v[2] = bflo(x.y); v[3] = bfhi(x.y); v[4] = bflo(x.z); v[5] = bfhi(x.z); v[6] = bflo(x.w); v[7] = bfhi(x.w); }
__device__ __forceinline__ float sum16(float v) { v += __shfl_xor(v, 1); v += __shfl_xor(v, 2); v += __shfl_xor(v, 4); v += __shfl_xor(v, 8); return v; }
__device__ __forceinline__ void phase_post(Frame& F, int l) {
    PHASE_IDS(F);
    bf16_t* P = (bf16_t*)(F.ws + WS_P);
    const float* rope = (const float*)(F.ws + WS_ROPE);
    const int i16 = lane & 15, hq = lane >> 4; const bool hi2 = hq >= 2;
    const float* qna = INP(F, IN_QNA) + l * 128 + 8 * i16; const float* kna = INP(F, IN_KNA) + l * 128 + 8 * i16;
    const float* qnc = INP(F, IN_QNC) + l * 128 + 8 * i16; const float* knc = INP(F, IN_KNC) + l * 128 + 8 * i16;
    const float* vnb = INP(F, IN_VNB) + l * 512 + 8 * i16;
    for (int r = gw; r < NTOK; r += NGW) {
        const int t = r % TPB; const bool lat = t >= CTXL;
        u32x4* rp = (u32x4*)(P + (size_t)r * INW) + lane;
        u32x4 x[7];
#pragma unroll
        for (int j = 0; j < 7; ++j) x[j] = rp[64 * j];
        const int pos = lat ? t - CTXL : 0, pp = (i16 < 8) ? (pos >> 6) : (pos & 63);
        const f32x4* cs = (const f32x4*)(rope + 2 * (pp * 32 + 8 * (i16 & 3)));
        const f32x4 c0 = cs[0], c1 = cs[1], c2 = cs[2], c3 = cs[3];
        const float cosv[8] = {c0.x, c0.z, c1.x, c1.z, c2.x, c2.z, c3.x, c3.z}, sinv[8] = {c0.y, c0.w, c1.y, c1.w, c2.y, c2.w, c3.y, c3.w};
        const float sgn = (i16 & 4) ? 1.f : -1.f;
#pragma unroll
        for (int j = 0; j < 7; ++j) {
            const bool gelu_lo = (j == 3 || j == 4), gelu_hi = (j == 2 || j == 3);
            const bool norm_lo = (j != 2 && j != 3), norm_hi = (j != 2 && j != 6);
            const bool rope_lo = (j == 0 || j == 1 || j == 5 || j == 6), rope_hi = (j == 0 || j == 1 || j == 4 || j == 5);
            const bool dg = hi2 ? gelu_hi : gelu_lo, dn = hi2 ? norm_hi : norm_lo, dr = (hi2 ? rope_hi : rope_lo) && lat;
            if (!(gelu_lo || gelu_hi || norm_lo || norm_hi)) continue;
            float v[8]; post_unpack(x[j], v);
            if (gelu_lo || gelu_hi) {
#pragma unroll
                for (int e = 0; e < 8; ++e) { const float gv = gelu_tanh(v[e]); v[e] = dg ? gv : v[e]; } }
            if (norm_lo || norm_hi) {
                float ss = 0.f;
#pragma unroll
                for (int e = 0; e < 8; ++e) ss += v[e] * v[e];
                const float rinv = 1.0f / sqrtf(sum16(ss) * (1.f / 128) + EPS);
                const float* gp;
                if (j == 0) gp = qna; else if (j == 1) gp = hi2 ? kna : qna; else if (j == 3) gp = vnb + (hi2 ? hq - 2 : 0) * 128; else if (j == 4) gp = hi2 ? qnc : vnb + (2 + hq) * 128;
                else if (j == 5) gp = qnc; else gp = knc;
                const f32x4 g0 = *(const f32x4*)gp, g1 = *(const f32x4*)(gp + 4);
                const float gg[8] = {g0.x, g0.y, g0.z, g0.w, g1.x, g1.y, g1.z, g1.w};
#pragma unroll
                for (int e = 0; e < 8; ++e) v[e] = dn ? v[e] * rinv * gg[e] : v[e];
            }
            if (rope_lo || rope_hi) {
#pragma unroll
                for (int e = 0; e < 8; ++e) { const float o = __shfl_xor(v[e], 4); const float rv = v[e] * cosv[e] + sgn * o * sinv[e]; v[e] = dr ? rv : v[e]; } }
            u32x4 w; w.x = pk2(v[0], v[1]); w.y = pk2(v[2], v[3]); w.z = pk2(v[4], v[5]); w.w = pk2(v[6], v[7]);
            rp[64 * j] = w;
        }
    }
}

__device__ __forceinline__ void mixer_b_unit(Frame& F, int l, int b, int ch, int g) {
    PHASE_IDS(F);
    const bf16_t* P = (const bf16_t*)(F.ws + WS_P); bf16_t* O = (bf16_t*)(F.ws + WS_O);
    const int row0 = b * TPB + ch * 128, w = wave;
    LAS bf16_t* VT = (LAS bf16_t*)F.lds;
    { const int q = tid >> 2, dp = (tid & 3) * 32; const bf16_t* src = P + (size_t)(row0 + q) * INW + C_VB + g * 128 + dp;
#pragma unroll
      for (int i = 0; i < 4; ++i) { const u32x4 x = *(const u32x4*)(src + 8 * i); const unsigned xs[4] = {x.x, x.y, x.z, x.w};
#pragma unroll
          for (int j = 0; j < 4; ++j) { VT[(dp + 8 * i + 2 * j) * 136 + q] = (bf16_t)(xs[j] & 0xffffu); VT[(dp + 8 * i + 2 * j + 1) * 136 + q] = (bf16_t)(xs[j] >> 16); } } }
    __syncthreads();
    const int i15 = lane & 15, kq = lane >> 4;
    f32x4 acc[8];
#pragma unroll
    for (int n = 0; n < 8; ++n) acc[n] = (f32x4){0.f, 0.f, 0.f, 0.f};
    const float* wsr = INP(F, IN_WS) + ((size_t)(l * 4 + g) * 128 + 16 * w + i15) * 128;
#pragma unroll
    for (int s = 0; s < 4; ++s) {
        const f32x4 a0 = *(const f32x4*)(wsr + 32 * s + 8 * kq), a1 = *(const f32x4*)(wsr + 32 * s + 8 * kq + 4);
        u32x4 aw; aw.x = pk2(a0.x, a0.y); aw.y = pk2(a0.z, a0.w); aw.z = pk2(a1.x, a1.y); aw.w = pk2(a1.z, a1.w);
        const bf16x8 af = *reinterpret_cast<bf16x8*>(&aw);
#pragma unroll
        for (int n = 0; n < 8; ++n) { const bf16x8 bfr = *(const LAS bf16x8*)(VT + (16 * n + i15) * 136 + 32 * s + 8 * kq);
            acc[n] = __builtin_amdgcn_mfma_f32_16x16x32_bf16(af, bfr, acc[n], 0, 0, 0); }
    }
#pragma unroll
    for (int j = 0; j < 4; ++j) { const int p = 16 * w + kq * 4 + j; const float bias = INP(F, IN_BS)[(l * 4 + g) * 128 + p];
        const bf16_t* up = P + (size_t)(row0 + p) * INW + C_UB + g * 128; bf16_t* op = O + (size_t)(row0 + p) * DM + O_B + g * 128;
#pragma unroll
        for (int n = 0; n < 8; ++n) { const int d = 16 * n + i15; op[d] = (bf16_t)f2bf(bf2f(up[d]) * (acc[n][j] + bias)); } }
    __syncthreads();
}
__device__ __forceinline__ void phase_mixers(Frame& F, int l) {
    PHASE_IDS(F);
    const bf16_t* P = (const bf16_t*)(F.ws + WS_P); bf16_t* O = (bf16_t*)(F.ws + WS_O);
    const bool ctx = (l == 0);
    const int nC = 384, nA = 384, nCc = ctx ? 24 : 0, nAc = ctx ? 24 : 0, nB = 4 * 4 * 34;
    const int total = nC + nA + nCc + nAc + nB;
    unsigned* qctr = F.ctl + CW_QUEUE + 64 * l;
    for (;;) {
        if (tid == 0) F.MISC[0] = xb_add(qctr, 1u);
        __syncthreads();
        int u = (int)F.MISC[0];
        __syncthreads();
        if (u >= total) break;
        if (u < nC + nA + nCc + nAc) {
            int kind, b, h, qb = 0;
            if (u < nC) { kind = 0; b = u / 96; h = (u % 96) / 16; qb = u % 16; }
            else if (u < nC + nA) { const int v = u - nC; kind = 1; b = v / 96; h = (v % 96) / 16; qb = v % 16; }
            else if (u < nC + nA + nCc) { const int v = u - nC - nA; kind = 2; b = v / 6; h = v % 6; }
            else { const int v = u - nC - nA - nCc; kind = 3; b = v / 6; h = v % 6; }
            const int kv = h / 3, isA = kind & 1, lat = (kind < 2);
            const size_t r0 = (size_t)b * TPB, rq = r0 + (lat ? CTXL + qb * 256 : 0);
            const int q0 = qb * 256, ks = (kind == 1) ? ((q0 - 128 < 0) ? 0 : q0 - 128) : 0, ke = (q0 + 384 > SEQ) ? SEQ : q0 + 384;
            const int NT = (kind == 0) ? 68 : (kind == 1) ? 4 + (ke - ks) / 64 : 4;
            const float sink = INP(F, IN_SINK)[l * 6 + h];
            const int cq = (isA ? C_QA : C_QC) + h * 128, ck = (isA ? C_KA : C_KC) + kv * 128, cv = (isA ? C_VA : C_VC) + kv * 128, co = (isA ? O_A : O_C) + h * 128;
            at::attn_body(P + rq * INW + cq, P + r0 * INW + ck, P + r0 * INW + cv, O + rq * DM + co, NT, ks, q0, isA ? sink / at::SCALE : -1e30f, isA ? 1.f : 0.f, kind == 1, F.ldsg);
            continue; }
        u -= nC + nA + nCc;
        u -= nAc;
        { const int b = u / 136, ch = (u % 136) / 4, g = u % 4;
          if (!ctx && ch < 2) continue;
          mixer_b_unit(F, l, b, ch, g); }
    }
}

__device__ __forceinline__ void phase_groupnorm(Frame& F, int l) {
    PHASE_IDS(F);
    bf16_t* O = (bf16_t*)(F.ws + WS_O); const float* og = INP(F, IN_OUTG) + l * DM;
    for (int r = gw; r < NTOK; r += NGW) {
        if (l == 1 && (r % TPB) < CTXL) continue;
        bf16_t* row = O + (size_t)r * DM;
        u32x2 x[8];
#pragma unroll
        for (int i = 0; i < 3; ++i) { x[i] = *(const u32x2*)(row + O_A + 12 * lane + 4 * i); x[5 + i] = *(const u32x2*)(row + O_C + 12 * lane + 4 * i); }
#pragma unroll
        for (int i = 0; i < 2; ++i) x[3 + i] = *(const u32x2*)(row + O_B + 8 * lane + 4 * i);
        float v[8][4]; float ss[3] = {0.f, 0.f, 0.f};
#pragma unroll
        for (int i = 0; i < 8; ++i) { v[i][0] = bflo(x[i].x); v[i][1] = bfhi(x[i].x); v[i][2] = bflo(x[i].y); v[i][3] = bfhi(x[i].y);
            const int grp = (i < 3) ? 0 : (i < 5) ? 1 : 2; ss[grp] += (v[i][0] * v[i][0] + v[i][1] * v[i][1]) + (v[i][2] * v[i][2] + v[i][3] * v[i][3]); }
        float rinv[3];
        rinv[0] = 1.0f / sqrtf(wave_sum(ss[0]) * (1.f / 768) + EPS); rinv[1] = 1.0f / sqrtf(wave_sum(ss[1]) * (1.f / 512) + EPS); rinv[2] = 1.0f / sqrtf(wave_sum(ss[2]) * (1.f / 768) + EPS);
#pragma unroll
        for (int i = 0; i < 8; ++i) { const int grp = (i < 3) ? 0 : (i < 5) ? 1 : 2;
            const int c = (grp == 0) ? O_A + 12 * lane + 4 * i : (grp == 1) ? O_B + 8 * lane + 4 * (i - 3) : O_C + 12 * lane + 4 * (i - 5);
            const f32x4 gg = *(const f32x4*)(og + c); const float ri = rinv[grp];
            u32x2 w; w.x = pk2(v[i][0] * ri * gg.x, v[i][1] * ri * gg.y); w.y = pk2(v[i][2] * ri * gg.z, v[i][3] * ri * gg.w); *(u32x2*)(row + c) = w; }
    }
}

__device__ __forceinline__ void phase_rowpass2(Frame& F, int l) {
    PHASE_IDS(F);
    const float* mod = (const float*)(F.ws + WS_MOD) + (size_t)l * 5 * NMOD;
    const float* xb = (const float*)(F.ws + WS_XB);
    LAS float* wl = (LAS float*)F.lds;
    const float* wr = INP(F, IN_WR) + (size_t)l * DM * NE;
    for (int i = tid; i < DM * NE; i += 512) wl[(i & 15) * DM + (i >> 4)] = wr[i];
    __syncthreads();
    const float* g = INP(F, IN_N2G) + l * DM;
    const bool f8 = (l == 0) ? (FP8_L0 != 0) : (FP8_L1 != 0);
    for (int r = gw; r < NTOK; r += NGW) {
        const int b = r / TPB, t = r % TPB, s = (t < CTXL) ? 4 : b;
        if (l == 1 && t < CTXL) continue;
        f32x4 v[8]; load_row(xb + (size_t)r * DM, lane, v);
        float ss = 0.f;
#pragma unroll
        for (int j = 0; j < 8; ++j) ss += (v[j].x * v[j].x + v[j].y * v[j].y) + (v[j].z * v[j].z + v[j].w * v[j].w);
        const float rinv = 1.0f / sqrtf(wave_sum(ss) * (1.f / DM) + EPS);
        const float* shift = mod + (size_t)s * NMOD + 3 * DM; const float* scale = shift + DM;
        bf16_t* dst = (bf16_t*)(F.ws + WS_HN) + (size_t)r * DM;
#pragma unroll
        for (int j = 0; j < 8; ++j) { const int c = 4 * lane + 256 * j;
            const f32x4 gg = *(const f32x4*)(g + c), sh = *(const f32x4*)(shift + c), sc = *(const f32x4*)(scale + c);
            v[j] = (v[j] * rinv) * gg * (sc + 1.f) + sh;
            if (f8) *(unsigned*)((unsigned char*)(F.ws + WS_HN8) + (size_t)r * DM + c) = pk4_fp8(v[j].x, v[j].y, v[j].z, v[j].w);
            else { u32x2 w; w.x = pk2(v[j].x, v[j].y); w.y = pk2(v[j].z, v[j].w); *(u32x2*)(dst + c) = w; } }
        float lg[16];
#pragma unroll
        for (int e = 0; e < 16; ++e) { float a = 0.f;
#pragma unroll
            for (int j = 0; j < 8; ++j) { const f32x4 w = *(const LAS f32x4*)(wl + e * DM + 4 * lane + 256 * j); a += (v[j].x * w.x + v[j].y * w.y) + (v[j].z * w.z + v[j].w * w.w); }
            lg[e] = wave_sum(a); }
        float mx = lg[0];
#pragma unroll
        for (int e = 1; e < 16; ++e) mx = fmaxf(mx, lg[e]);
        float den = 0.f, mine = 0.f;
#pragma unroll
        for (int e = 0; e < 16; ++e) { const float ex = __expf(lg[e] - mx); den += ex; mine = (lane == e) ? ex : mine; }
        if (lane < 16) {
            const float a = mine / den;
            if (t < CTXL) ((float*)(F.ws + WS_AFFC))[((size_t)b * NE + lane) * CTXL + t] = a;
            else ((float*)(F.ws + WS_AFFL))[((size_t)b * NE + lane) * SEQ + (t - CTXL)] = a;
        }
    }
    __syncthreads();
}

__device__ __forceinline__ void phase_topk(Frame& F, int l) {
    PHASE_IDS(F);
    LAS unsigned long long* key = (LAS unsigned long long*)F.lds;
    const int nunits = (l == 0) ? 128 : 64;
    for (int u = blockIdx.x; u < nunits; u += F.G) {
        const bool isc = u >= 64; const int uu = isc ? u - 64 : u, b = uu / NE, e = uu % NE;
        const int N = isc ? CTXL : SEQ, cap = isc ? CAP_C : CAP_L;
        const float* src = isc ? (const float*)(F.ws + WS_AFFC) + (size_t)uu * CTXL : (const float*)(F.ws + WS_AFFL) + (size_t)uu * SEQ;
        int* pos = isc ? (int*)(F.ws + WS_POSC) + (size_t)uu * CTXL : (int*)(F.ws + WS_POSL) + (size_t)uu * SEQ;
        for (int i = tid; i < N; i += 512) key[i] = ((unsigned long long)(~__float_as_uint(src[i])) << 32) | (unsigned)i;
        __syncthreads();
        for (int k = 2; k <= N; k <<= 1)
            for (int j = k >> 1; j > 0; j >>= 1) {
                for (int tt = tid; tt < N / 2; tt += 512) {
                    const int i = ((tt & ~(j - 1)) << 1) | (tt & (j - 1)), ij = i | j;
                    const bool up = ((i & k) == 0);
                    const unsigned long long a = key[i], c = key[ij];
                    if ((a > c) == up) { key[i] = c; key[ij] = a; }
                }
                __syncthreads();
            }
        const int slotbase = e * ROWS_E + (isc ? 2048 + b * CAP_C : b * CAP_L);
        for (int i = tid; i < N; i += 512) {
            const unsigned long long kk = key[i]; const int tok = (int)(unsigned)kk;
            pos[tok] = (i < cap) ? i : -1;
            if (i < cap) { ((int*)(F.ws + WS_RSRC))[slotbase + i] = b * TPB + (isc ? tok : CTXL + tok); ((float*)(F.ws + WS_GATE))[slotbase + i] = __uint_as_float(~(unsigned)(kk >> 32)); }
        }
        __syncthreads();
    }
}

__device__ __forceinline__ void phase_gather(Frame& F, int l) {
    PHASE_IDS(F);
    const int rows_e = (l == 0) ? 2176 : 2048;
    const bf16_t* hn = (const bf16_t*)(F.ws + WS_HN); bf16_t* xg = (bf16_t*)(F.ws + WS_XG); const int* rsrc = (const int*)(F.ws + WS_RSRC);
    const bool f8 = (l == 0) ? (FP8_L0 != 0) : (FP8_L1 != 0);
    if (f8) {
        const unsigned char* hn8 = (const unsigned char*)(F.ws + WS_HN8); unsigned char* xg8 = (unsigned char*)(F.ws + WS_XG);
        for (int it = gw * 8; it < NE * rows_e; it += NGW * 8) {
            const int e = it / rows_e, sl = it % rows_e, row = e * ROWS_E + sl;
            const int my = (lane < 8) ? rsrc[row + lane] : 0;
            u32x4 x[8][2];
#pragma unroll
            for (int q = 0; q < 8; ++q) { const int src = __builtin_amdgcn_readlane(my, q); const u32x4* sp = (const u32x4*)(hn8 + (size_t)src * DM) + lane; x[q][0] = sp[0]; x[q][1] = sp[64]; }
#pragma unroll
            for (int q = 0; q < 8; ++q) { u32x4* dp = (u32x4*)(xg8 + (size_t)(row + q) * DM) + lane; dp[0] = x[q][0]; dp[64] = x[q][1]; }
        }
        return;
    }
    for (int it = gw * 4; it < NE * rows_e; it += NGW * 4) {
        const int e = it / rows_e, sl = it % rows_e, row = e * ROWS_E + sl;
        const int my = (lane < 4) ? rsrc[row + lane] : 0;
        u32x4 x[4][4];
#pragma unroll
        for (int q = 0; q < 4; ++q) { const int src = __builtin_amdgcn_readlane(my, q); const u32x4* sp = (const u32x4*)(hn + (size_t)src * DM) + lane;
#pragma unroll
            for (int j = 0; j < 4; ++j) x[q][j] = sp[64 * j]; }
#pragma unroll
        for (int q = 0; q < 4; ++q) { u32x4* dp = (u32x4*)(xg + (size_t)(row + q) * DM) + lane;
#pragma unroll
            for (int j = 0; j < 4; ++j) dp[64 * j] = x[q][j]; }
    }
}

__device__ __forceinline__ void phase_combine(Frame& F, int l) {
    PHASE_IDS(F);
    const float* mod = (const float*)(F.ws + WS_MOD);
    float* xb = (float*)(F.ws + WS_XB); const bf16_t* Y = (const bf16_t*)(F.ws + WS_XG);
    for (int r = gw; r < NTOK; r += NGW) {
        const int b = r / TPB, t = r % TPB, s = (t < CTXL) ? 4 : b;
        if (l == 1 && t < CTXL) continue;
        int p = -1;
        if (lane < NE) p = (t < CTXL) ? ((const int*)(F.ws + WS_POSC))[((size_t)b * NE + lane) * CTXL + t] : ((const int*)(F.ws + WS_POSL))[((size_t)b * NE + lane) * SEQ + (t - CTXL)];
        f32x4 v[8]; load_row(xb + (size_t)r * DM, lane, v);
        const float* g2 = mod + (size_t)(l * 5 + s) * NMOD + 5 * DM;
        f32x4 gv[8];
#pragma unroll
        for (int j = 0; j < 8; ++j) gv[j] = *(const f32x4*)(g2 + 4 * lane + 256 * j);
        f32x4 a[8];
#pragma unroll
        for (int j = 0; j < 8; ++j) a[j] = (f32x4){0.f, 0.f, 0.f, 0.f};
        unsigned long long m = __ballot(p >= 0);
        const int ybase = (t < CTXL) ? 2048 + b * CAP_C : b * CAP_L;
        while (m) {
            const int e0 = __builtin_ctzll(m); m &= m - 1;
            const bool two = (m != 0ull); const int e1 = two ? __builtin_ctzll(m) : e0; if (two) m &= m - 1;
            const int p0 = __builtin_amdgcn_readlane(p, e0), p1 = __builtin_amdgcn_readlane(p, e1);
            const bf16_t* y0 = Y + (size_t)(e0 * ROWS_E + ybase + p0) * DM + 4 * lane; const bf16_t* y1 = Y + (size_t)(e1 * ROWS_E + ybase + p1) * DM + 4 * lane;
            u32x2 w0[8], w1[8];
#pragma unroll
            for (int j = 0; j < 8; ++j) w0[j] = *(const u32x2*)(y0 + 256 * j);
            if (two) {
#pragma unroll
                for (int j = 0; j < 8; ++j) w1[j] = *(const u32x2*)(y1 + 256 * j); }
#pragma unroll
            for (int j = 0; j < 8; ++j) a[j] += (f32x4){bflo(w0[j].x), bfhi(w0[j].x), bflo(w0[j].y), bfhi(w0[j].y)};
            if (two) {
#pragma unroll
                for (int j = 0; j < 8; ++j) a[j] += (f32x4){bflo(w1[j].x), bfhi(w1[j].x), bflo(w1[j].y), bfhi(w1[j].y)}; }
        }
#pragma unroll
        for (int j = 0; j < 8; ++j) v[j] += gv[j] * a[j];
        if (l == 0) {
#pragma unroll
            for (int j = 0; j < 8; ++j) *(f32x4*)(xb + (size_t)r * DM + 4 * lane + 256 * j) = v[j];
            const float* m1 = mod + (size_t)(5 + s) * NMOD;
            norm_mod_store(v, INP(F, IN_N1G) + DM, m1, m1 + DM, (bf16_t*)(F.ws + WS_HN) + (size_t)r * DM, lane);
        } else {
            float* op = F.out + ((size_t)b * SEQ + (t - CTXL)) * DM;
#pragma unroll
            for (int j = 0; j < 8; ++j) *(f32x4*)(op + 4 * lane + 256 * j) = v[j];
        }
    }
}

__device__ __forceinline__ void phase_dump_x(Frame& F, bool from_input) {
    PHASE_IDS(F);
    const float* xb = (const float*)(F.ws + WS_XB);
    for (int r = gw; r < NTOK; r += NGW) {
        const int b = r / TPB, t = r % TPB; if (t < CTXL) continue;
        const float* src = from_input ? INP(F, IN_X) + ((size_t)b * SEQ + (t - CTXL)) * DM : xb + (size_t)r * DM;
        f32x4 v[8]; load_row(src, lane, v);
        float* op = F.out + ((size_t)b * SEQ + (t - CTXL)) * DM;
#pragma unroll
        for (int j = 0; j < 8; ++j) *(f32x4*)(op + 4 * lane + 256 * j) = v[j];
    }
}

constexpr int N_PHASES = 2 + 11 * NLAYER;
__global__ void __launch_bounds__(512, 2) fwd_kernel(Args args) {
    extern __shared__ __attribute__((aligned(16))) unsigned char lds[];
    Frame F;
    F.lds = (LAS unsigned char*)lds; F.ldsg = (char*)lds;
    F.MISC = (volatile LAS unsigned*)(F.lds + MISC_OFF);
    F.G = gridDim.x;
    F.out = args.out; F.ws = args.ws; F.ctl = (unsigned*)(args.ws + WS_CTL);
    for (int u = threadIdx.x; u < (LDS_BYTES - LDSCTL_OFF) / 4; u += 512) ((LAS unsigned*)(F.lds + LDSCTL_OFF))[u] = 0u;
    __syncthreads();
    if (threadIdx.x < 23) { const unsigned long long pv = (unsigned long long)args.in[threadIdx.x]; LAS unsigned* t = (LAS unsigned*)(F.lds + ARGTAB_OFF) + 2 * threadIdx.x; t[0] = (unsigned)pv; t[1] = (unsigned)(pv >> 32); }
    __syncthreads();
    XcdBarrier bar; bar.bar = F.ctl + CW_BAR; bar.x = 0; bar.st = nullptr;
    if (!MK_PER_PHASE) bar = xcd_barrier_post(F.ctl + CW_BAR, F.MISC + 8);
    const int lo = args.ph_lo, hi = args.ph_hi;
#define IN(k) (lo <= (k) && (k) < hi)
    unsigned long long probe_t0 = 0ull, probe_acc = 0ull;
#define PROBE_BEGIN(k) do { if (PROBE_MASK & (1u << (k))) probe_t0 = __builtin_amdgcn_s_memrealtime(); } while (0)
#define SEAM(k) do { if (IN(k) && IN((k) + 1)) xcd_barrier(bar); if (PROBE_MASK & (1u << (k))) probe_acc += __builtin_amdgcn_s_memrealtime() - probe_t0; } while (0)

    if (IN(0)) { PROBE_BEGIN(0); if (PH_ON(0)) phase_prologue(F); SEAM(0); }
    if (IN(1)) { PROBE_BEGIN(1); if (PH_ON(1)) phase_rowpass1_l0(F); SEAM(1); }
    for (int l = 0; l < NLAYER; ++l) {
        const int pb = 2 + 11 * l;
        const bool ctx = (l == 0);
        if (IN(pb + 0)) { PROBE_BEGIN(pb + 0); if (PH_ON(2)) {
            pg8::SchedDense S; S.init(F.ws + WS_HN, F.ws + WS_WIN + (size_t)l * INW * DM * 2, NTOK / 256, INW / 256, F.G, (int)blockIdx.x, 0);
            pg8::EpiStoreBf16 E{(bf16_t*)(F.ws + WS_P), INW};
            pg8::gemm_phase<pg8::EpiStoreBf16, pg8::SchedDense>(F.lds, S, E); }
            SEAM(pb + 0); }
        if (IN(pb + 1)) { PROBE_BEGIN(pb + 1); if (PH_ON(3)) phase_post(F, l); SEAM(pb + 1); }
        if (IN(pb + 2)) { PROBE_BEGIN(pb + 2); if (PH_ON(4)) phase_mixers(F, l); SEAM(pb + 2); }
        if (IN(pb + 3)) { PROBE_BEGIN(pb + 3); if (PH_ON(5)) phase_groupnorm(F, l); SEAM(pb + 3); }
        if (IN(pb + 4)) { PROBE_BEGIN(pb + 4); if (PH_ON(6)) {
            pg8::SchedDense S; S.init(F.ws + WS_O, F.ws + WS_WOUT + (size_t)l * DM * DM * 2, ctx ? NTOK / 256 : 64, DM / 256, F.G, (int)blockIdx.x, ctx ? 0 : 1);
            float* xb = (float*)(F.ws + WS_XB);
            pg8::EpiResid E;
            if (l == 0) { E.ctxbase = INP(F, IN_CTX); E.latbase = INP(F, IN_X); E.cbs = CTXL; E.lbs = SEQ; }
            else { E.ctxbase = xb; E.latbase = xb + (size_t)CTXL * DM; E.cbs = TPB; E.lbs = TPB; }
            E.xout = xb; E.modl = (const float*)(F.ws + WS_MOD) + (size_t)l * 5 * NMOD;
            pg8::gemm_phase<pg8::EpiResid, pg8::SchedDense>(F.lds, S, E); }
            SEAM(pb + 4); }
        if (IN(pb + 5)) { PROBE_BEGIN(pb + 5); if (PH_ON(7)) phase_rowpass2(F, l); SEAM(pb + 5); }
        if (IN(pb + 6)) { PROBE_BEGIN(pb + 6); if (PH_ON(8)) phase_topk(F, l); SEAM(pb + 6); }
        if (IN(pb + 7)) { PROBE_BEGIN(pb + 7); if (PH_ON(9)) phase_gather(F, l); SEAM(pb + 7); }
        if (IN(pb + 8)) { PROBE_BEGIN(pb + 8); if (PH_ON(10)) {
            if ((l == 0) ? (FP8_L0 != 0) : (FP8_L1 != 0)) {
                pg8::SchedGrouped<pg8::GK> S; S.init(F.ws + WS_XG, F.ws + WS_WGU + (size_t)l * NE * 4096 * DM * 2, ctx ? 9 : 8, 16, F.G, (int)blockIdx.x);
                pg8::EpiSwiGLU8 E{(unsigned char*)(F.ws + WS_H)};
                pg8::gemm_phase<pg8::EpiSwiGLU8, pg8::SchedGrouped<pg8::GK>, true>(F.lds, S, E);
            } else {
                pg8::SchedGrouped<2 * pg8::GK> S; S.init(F.ws + WS_XG, F.ws + WS_WGU + (size_t)l * NE * 4096 * DM * 2, ctx ? 9 : 8, 16, F.G, (int)blockIdx.x);
                pg8::EpiSwiGLU E{(bf16_t*)(F.ws + WS_H)};
                pg8::gemm_phase<pg8::EpiSwiGLU, pg8::SchedGrouped<2 * pg8::GK>, false>(F.lds, S, E);
            } }
            SEAM(pb + 8); }
        if (IN(pb + 9)) { PROBE_BEGIN(pb + 9); if (PH_ON(11)) {
            pg8::EpiDown E{(bf16_t*)(F.ws + WS_XG), (const float*)(F.ws + WS_GATE)};
            if ((l == 0) ? (FP8_L0 != 0) : (FP8_L1 != 0)) {
                pg8::SchedGrouped<pg8::GK> S; S.init(F.ws + WS_H, F.ws + WS_WD + (size_t)l * NE * DM * DM * 2, ctx ? 9 : 8, 8, F.G, (int)blockIdx.x);
                pg8::gemm_phase<pg8::EpiDown, pg8::SchedGrouped<pg8::GK>, true>(F.lds, S, E);
            } else {
                pg8::SchedGrouped<2 * pg8::GK> S; S.init(F.ws + WS_H, F.ws + WS_WD + (size_t)l * NE * DM * DM * 2, ctx ? 9 : 8, 8, F.G, (int)blockIdx.x);
                pg8::gemm_phase<pg8::EpiDown, pg8::SchedGrouped<2 * pg8::GK>, false>(F.lds, S, E);
            } }
            SEAM(pb + 9); }
        if (IN(pb + 10)) { PROBE_BEGIN(pb + 10); if (PH_ON(12)) phase_combine(F, l); if (l + 1 < NLAYER) SEAM(pb + 10); else if (PROBE_MASK & (1u << (pb + 10))) probe_acc += __builtin_amdgcn_s_memrealtime() - probe_t0; }
    }
    if (PROBE_MASK) { const unsigned long long te = __builtin_amdgcn_s_memrealtime(); while (__builtin_amdgcn_s_memrealtime() - te < probe_acc) __builtin_amdgcn_s_sleep(8); }
#undef IN
#undef SEAM
}

extern "C" void kernel_launch(void* const* d_in, const int* in_sizes, int n_in, void* d_out, int out_size, void* d_ws, size_t ws_size, hipStream_t stream) {
    static int grid = 0;
    if (grid == 0) {
        if (n_in != 23 || out_size != NB * SEQ * DM || ws_size < WS_END) { fprintf(stderr, "kernel_launch: shape mismatch: n_in %d out %d ws %zu (need %zu)\n", n_in, out_size, ws_size, (size_t)WS_END); grid = -1; return; }
        int dev = 0, cus = 0, per_cu = 0;
        if (hipGetDevice(&dev) != hipSuccess || hipDeviceGetAttribute(&cus, hipDeviceAttributeMultiprocessorCount, dev) != hipSuccess) { grid = -1; return; }
        if (hipFuncSetAttribute((const void*)fwd_kernel, hipFuncAttributeMaxDynamicSharedMemorySize, LDS_BYTES) != hipSuccess) { fprintf(stderr, "kernel_launch: hipFuncSetAttribute failed\n"); grid = -1; return; }
        if (hipOccupancyMaxActiveBlocksPerMultiprocessor(&per_cu, (const void*)fwd_kernel, 512, LDS_BYTES) != hipSuccess || per_cu < 1) { fprintf(stderr, "kernel_launch: occupancy query says %d\n", per_cu); }
        (void)hipGetLastError();
        grid = cus;
    }
    if (grid < 0) return;
    if (hipMemsetAsync((char*)d_ws + WS_CTL, 0, CTL_ZERO_BYTES, stream) != hipSuccess) return;
    Args a{};
    for (int i = 0; i < 23; ++i) a.in[i] = (const float*)d_in[i];
    a.out = (float*)d_out; a.ws = (unsigned char*)d_ws;
#if MK_PER_PHASE
    for (int p = 0; p < N_PHASES; ++p) { a.ph_lo = p; a.ph_hi = p + 1; hipLaunchKernelGGL(fwd_kernel, dim3(grid), dim3(512), LDS_BYTES, stream, a); }
#else
    a.ph_lo = 0; a.ph_hi = N_PHASES;
    hipLaunchKernelGGL(fwd_kernel, dim3(grid), dim3(512), LDS_BYTES, stream, a);
#endif
    const hipError_t le = hipPeekAtLastError();
    if (le != hipSuccess) fprintf(stderr, "kernel_launch: launch failed: %s\n", hipGetErrorName(le));
}
```

```cpp
#include <hip/hip_runtime.h>
#include <cstdio>
#include <cstdint>

#define LAS __attribute__((address_space(3)))
#define GAS __attribute__((address_space(1)))
typedef unsigned short bf16_t;
typedef short bf16x8 __attribute__((ext_vector_type(8)));
typedef short s16x4 __attribute__((ext_vector_type(4)));
typedef float f32x2 __attribute__((ext_vector_type(2)));
typedef float f32x4 __attribute__((ext_vector_type(4)));
typedef float f32x16 __attribute__((ext_vector_type(16)));
typedef unsigned u32x2 __attribute__((ext_vector_type(2)));
typedef unsigned u32x4 __attribute__((ext_vector_type(4)));
typedef int i32x4 __attribute__((ext_vector_type(4)));
typedef int i32x8 __attribute__((ext_vector_type(8)));

#ifndef MK_PER_PHASE
#define MK_PER_PHASE 0
#endif
#ifndef PHASE_MASK
#define PHASE_MASK 0x1fff
#endif
#define PH_ON(k) (((PHASE_MASK) >> (k)) & 1)
#ifndef FP8_L0
#define FP8_L0 1
#endif
#ifndef FP8_L1
#define FP8_L1 1
#endif
#ifndef PROBE_MASK
#define PROBE_MASK 0u
#endif
#ifndef DBG_STOP
#define DBG_STOP 0
#endif

constexpr int DM = 2048, NB = 4, SEQ = 4096, CTXL = 256, TPB = SEQ + CTXL, NTOK = NB * TPB;
constexpr int INW = 3584, NE = 16, NLAYER = 2, NMOD = 6 * DM;
constexpr int C_QA = 0, C_KA = 768, C_VA = 1024, C_UB = 1280, C_VB = 1792, C_QC = 2304, C_KC = 3072, C_VC = 3328;
constexpr int O_A = 0, O_B = 768, O_C = 1280;
constexpr int CAP_L = 512, CAP_C = 32, ROWS_E = 2304;
constexpr float EPS = 1e-6f;

constexpr size_t MiB = 1u << 20;
constexpr size_t WS_CTL = 0, CTL_ZERO_BYTES = 65536;
constexpr size_t WS_MOD = 1 * MiB;
constexpr size_t WS_ROPE = 2 * MiB;
constexpr size_t WS_AFFL = 3 * MiB;
constexpr size_t WS_AFFC = 4 * MiB;
constexpr size_t WS_POSL = 5 * MiB;
constexpr size_t WS_POSC = 6 * MiB;
constexpr size_t WS_RSRC = 7 * MiB;
constexpr size_t WS_GATE = 8 * MiB;
constexpr size_t WS_WIN = 16 * MiB;
constexpr size_t WS_WOUT = WS_WIN + (size_t)2 * INW * DM * 2;
constexpr size_t WS_WGU = WS_WOUT + (size_t)2 * DM * DM * 2;
constexpr size_t WS_WD = WS_WGU + (size_t)2 * NE * 4096 * DM * 2;
constexpr size_t WS_HN = WS_WD + (size_t)2 * NE * DM * DM * 2;
constexpr size_t WS_P = WS_HN + (size_t)NTOK * DM * 2;
constexpr size_t WS_O = WS_P + (size_t)NTOK * INW * 2;
constexpr size_t WS_XB = WS_O + (size_t)NTOK * DM * 2;
constexpr size_t WS_XG = WS_XB + (size_t)NTOK * DM * 4;
constexpr size_t WS_H = WS_XG + (size_t)NE * ROWS_E * DM * 2;
constexpr size_t WS_HN8 = WS_H + (size_t)NE * ROWS_E * DM * 2;
constexpr size_t WS_END = WS_HN8 + (size_t)NTOK * DM;
constexpr float W8_SCALE = 32.f; constexpr int W8_SCALE_E8M0 = 127 - 5;
constexpr int CW_BAR = 4096, CW_QUEUE = 8192;

constexpr int RING_BYTES = 131072, LDSCTL_OFF = RING_BYTES, MISC_OFF = LDSCTL_OFF + 320, LDS_BYTES = 147456;

#define LDS_WAIT() asm volatile("s_waitcnt lgkmcnt(0)" ::: "memory")
#define VM_WAIT() asm volatile("s_waitcnt vmcnt(0)" ::: "memory")
__device__ __forceinline__ unsigned f2bf(float f) { unsigned u = __builtin_bit_cast(unsigned, f); return (u + 0x7fffu + ((u >> 16) & 1u)) >> 16; }
__device__ __forceinline__ unsigned pk2(float lo, float hi) { return f2bf(lo) | (f2bf(hi) << 16); }
__device__ __forceinline__ float bf2f(unsigned short b) { return __builtin_bit_cast(float, ((unsigned)b) << 16); }
__device__ __forceinline__ float bflo(unsigned w) { return __builtin_bit_cast(float, w << 16); }
__device__ __forceinline__ float bfhi(unsigned w) { return __builtin_bit_cast(float, w & 0xffff0000u); }
__device__ __forceinline__ float clamp448(float x) { return __builtin_fminf(__builtin_fmaxf(x, -448.f), 448.f); }
__device__ __forceinline__ unsigned pk4_fp8(float a, float b, float c, float d) {
    int r = __builtin_amdgcn_cvt_pk_fp8_f32(clamp448(a), clamp448(b), 0, false); r = __builtin_amdgcn_cvt_pk_fp8_f32(clamp448(c), clamp448(d), r, true); return (unsigned)r; }
__device__ __forceinline__ int opaque_tid() { int t = threadIdx.x; asm volatile("" : "+v"(t)); return t; }
__device__ __forceinline__ float wave_sum(float v) {
#pragma unroll
    for (int o = 1; o < 64; o <<= 1) v += __shfl_xor(v, o);
    return v;
}
__device__ __forceinline__ float gelu_tanh(float x) {
    const float u = 0.7978845608028654f * (x + 0.044715f * x * x * x);
    const float e = __expf(2.f * u);
    const float th = 1.f - 2.f / (e + 1.f);
    return 0.5f * x * (1.f + th);
}

#define XB_TMO      128
#define XB_XCNT(j)  (256  + 64 * (j))
#define XB_XSUB(j)  (1280 + 64 * (j))
#define XB_XGEN(j)  (2304 + 64 * (j))
#define XB_TOP      3328
#define XB_TOPGEN   3392
#define XCD_BAR_WORDS 3456
#define XB_SPIN_CAP (1u << 18)
__device__ __forceinline__ unsigned xb_ld(unsigned* p)              { return __hip_atomic_load(p, __ATOMIC_RELAXED, __HIP_MEMORY_SCOPE_AGENT); }
__device__ __forceinline__ unsigned xb_add(unsigned* p, unsigned v) { return __hip_atomic_fetch_add(p, v, __ATOMIC_RELAXED, __HIP_MEMORY_SCOPE_AGENT); }
__device__ __forceinline__ unsigned xb_xcc_id() { return (unsigned)__builtin_amdgcn_s_getreg((3 << 11) | 20) & 0xFu; }
#define XB_SPIN(cond, bar) do { unsigned _sp = 0; while (cond) { __builtin_amdgcn_s_sleep(1); \
    if ((++_sp & 255u) == 0u) { if (xb_ld(&(bar)[XB_TMO])) break; if (_sp > XB_SPIN_CAP) { atomicAdd(&(bar)[XB_TMO], 1u); break; } } } } while (0)
struct XcdBarrier { unsigned* bar; unsigned x; volatile LAS unsigned* st; };
__device__ __forceinline__ XcdBarrier xcd_barrier_post(unsigned* bar, volatile LAS unsigned* st) {
    XcdBarrier b; b.bar = bar; b.x = xb_xcc_id(); b.st = st;
    if (threadIdx.x == 0) (void)xb_add(&bar[XB_XCNT(b.x)], 1u);
    return b;
}
__device__ __forceinline__ void xcd_barrier_complete(unsigned* bar, unsigned x, unsigned& nloc, unsigned& nx) {
    const unsigned G = gridDim.x * gridDim.y * gridDim.z;
    unsigned sum, cnt, mine, sp = 0u;
    for (;;) {
        sum = 0u; cnt = 0u; mine = 0u;
#pragma unroll
        for (unsigned j = 0; j < 16; ++j) { const unsigned c = xb_ld(&bar[XB_XCNT(j)]); sum += c; cnt += (c > 0u) ? 1u : 0u; mine = (j == x) ? c : mine; }
        if (sum == G) break;
        __builtin_amdgcn_s_sleep(1);
        if ((++sp & 255u) == 0u) { if (xb_ld(&bar[XB_TMO])) break; if (sp > XB_SPIN_CAP) { atomicAdd(&bar[XB_TMO], 1u); break; } }
    }
    nloc = mine > 0u ? mine : 1u; nx = cnt > 0u ? cnt : 1u;
}
template <bool FIRST>
__device__ __forceinline__ void xcd_barrier_t(const XcdBarrier& b) {
    asm volatile("s_waitcnt vmcnt(0)" ::: "memory");
    __syncthreads();
    if (threadIdx.x == 0) {
        unsigned* bar = b.bar;
        asm volatile("" : "+s"(bar));
        __builtin_amdgcn_s_waitcnt(0);
        unsigned nloc = b.st[0], nx = b.st[1];
        if constexpr (FIRST) { if (nloc == 0u) { xcd_barrier_complete(bar, b.x, nloc, nx); b.st[0] = nloc; b.st[1] = nx; } }
        const unsigned old = xb_add(&bar[XB_XSUB(b.x)], 1u);
        const unsigned gen = old / nloc;
        if (old + 1u == (gen + 1u) * nloc) {
            __builtin_amdgcn_fence(__ATOMIC_RELEASE, "agent");
            asm volatile("s_waitcnt vmcnt(0)" ::: "memory");
            const unsigned og = xb_add(&bar[XB_TOP], 1u);
            const unsigned tg = og / nx;
            if (og + 1u == (tg + 1u) * nx) xb_add(&bar[XB_TOPGEN], 1u);
            else XB_SPIN(xb_ld(&bar[XB_TOPGEN]) == tg, bar);
            __builtin_amdgcn_fence(__ATOMIC_ACQUIRE, "agent");
            xb_add(&bar[XB_XGEN(b.x)], 1u);
            asm volatile("s_waitcnt vmcnt(0)" ::: "memory");
        } else {
            XB_SPIN(xb_ld(&bar[XB_XGEN(b.x)]) == gen, bar);
            __builtin_amdgcn_fence(__ATOMIC_ACQUIRE, "agent");
            asm volatile("s_waitcnt vmcnt(0)" ::: "memory");
        }
    }
    __syncthreads();
}
__device__ __forceinline__ void xcd_barrier(const XcdBarrier& b) { xcd_barrier_t<false>(b); }
__device__ __forceinline__ void xcd_barrier_first(const XcdBarrier& b) { xcd_barrier_t<true>(b); }

namespace pg8 {
constexpr int BM = 256, BK = 64, HALF = 128, HTB = HALF * BK * 2, STAGE_BYTES = 8 * HTB, NXCD = 8, WGM = 8;
constexpr int GK = 2048;
__host__ __device__ __forceinline__ int lds_byte(int r, int c) { const int st = (r >> 4) * 2 + (c >> 5), rr = r & 15, cc = c & 31, ob = rr * 64 + cc * 2; return st * 1024 + (ob ^ (((ob >> 9) & 1) << 5)); }
__host__ __device__ __forceinline__ void stage_rc(int b, int& R, int& C) { const int st = b / 1024, sb = b % 1024, swz = sb ^ (((sb >> 9) & 1) << 5); R = (st >> 1) * 16 + swz / 64; C = (st & 1) * 32 + (swz % 64) / 2; }
__host__ __device__ __forceinline__ int perm32(int rho) { const int n = rho >> 4, i = rho & 15; return 8 * (i >> 2) + 4 * n + (i & 3); }

struct Unit { int pm, pn, e, rowbase, colbase; const char* a; const char* b; };

struct SchedDense {
    static constexpr int RB = GK * 2;
    const char* A; const char* Bt; int nM, nN, nwg, G, c, skipctx;
    __device__ void init(const void* A_, const void* Bt_, int nM_, int nN_, int G_, int c_, int skipctx_) { A = (const char*)A_; Bt = (const char*)Bt_; nM = nM_; nN = nN_; nwg = nM * nN; G = G_; c = c_; skipctx = skipctx_; }
    __device__ bool next(int i, Unit& u) const {
        const long L = (long)i * G + c; if (L >= nwg) return false;
        int wgid = (int)L; { const int q = nwg / NXCD, r = nwg % NXCD, xcd = wgid % NXCD, off = wgid / NXCD; wgid = (xcd < r ? xcd * (q + 1) : r * (q + 1) + (xcd - r) * q) + off; }
        const int nig = WGM * nN, gid = wgid / nig, fm = gid * WGM, gsz = (nM - fm) < WGM ? (nM - fm) : WGM;
        int pm = fm + ((wgid % nig) % gsz); const int pn = (wgid % nig) / gsz;
        if (skipctx) pm = (pm >> 4) * 17 + 1 + (pm & 15);
        u.pm = pm; u.pn = pn; u.e = 0; u.rowbase = pm * BM; u.colbase = pn * BM;
        u.a = A + (size_t)pm * (BM * GK * 2); u.b = Bt + (size_t)pn * (BM * GK * 2); return true;
    }
};
template <int RB_> struct SchedGrouped {
    static constexpr int RB = RB_;
    const char* A; const char* Bt; int nMe, nNe, nwg, G, c;
    __device__ void init(const void* A_, const void* Bt_, int nMe_, int nNe_, int G_, int c_) { A = (const char*)A_; Bt = (const char*)Bt_; nMe = nMe_; nNe = nNe_; nwg = NE * nMe * nNe; G = G_; c = c_; }
    __device__ bool next(int i, Unit& u) const {
        const long L = (long)i * G + c; if (L >= nwg) return false;
        const int per = nMe * nNe, e = (int)L / per, rem = (int)L % per, pm = rem % nMe, pn = rem / nMe;
        u.pm = pm; u.pn = pn; u.e = e; u.rowbase = e * ROWS_E + pm * BM; u.colbase = pn * BM;
        u.a = A + (size_t)(e * ROWS_E + pm * BM) * RB; u.b = Bt + ((size_t)e * nNe + pn) * (BM * RB); return true;
    }
};

__device__ __forceinline__ unsigned cvt_pk_bf16(float lo, float hi) { unsigned r; asm volatile("v_cvt_pk_bf16_f32 %0, %1, %2" : "=v"(r) : "v"(lo), "v"(hi)); return r; }

struct EpiStoreBf16 {
    static constexpr bool PERM = true;
    bf16_t* O; int ldc;
    __device__ __forceinline__ void operator()(const f32x4 (&acc)[2][2][4][2], const Unit& u, int wr, int wc, int fr, int fq) const {
        const int row0 = u.rowbase + wr * 64 + fr, col0 = u.colbase + wc * 32 + 8 * fq;
#pragma unroll
        for (int ai = 0; ai < 2; ++ai)
#pragma unroll
            for (int m = 0; m < 4; ++m) { bf16_t* rowp = O + (size_t)(row0 + ai * HALF + m * 16) * ldc + col0;
#pragma unroll
                for (int bj = 0; bj < 2; ++bj) { const f32x4 v0 = acc[ai][bj][m][0], v1 = acc[ai][bj][m][1];
                    u32x4 w; w.x = cvt_pk_bf16(v0[0], v0[1]); w.y = cvt_pk_bf16(v0[2], v0[3]); w.z = cvt_pk_bf16(v1[0], v1[1]); w.w = cvt_pk_bf16(v1[2], v1[3]);
                    *(u32x4*)(rowp + bj * HALF) = w; } }
    }
};
struct EpiResid {
    static constexpr bool PERM = false;
    const float* ctxbase; const float* latbase; int cbs, lbs;
    float* xout; const float* modl;
    __device__ __forceinline__ void operator()(const f32x4 (&acc)[2][2][4][2], const Unit& u, int wr, int wc, int fr, int fq) const {
        const int b = u.pm / 17, tb = u.pm % 17;
        const float* src = (tb == 0) ? ctxbase + (size_t)b * cbs * DM : latbase + ((size_t)b * lbs + (size_t)(tb - 1) * 256) * DM;
        const float* g1 = modl + (size_t)((tb == 0) ? 4 : b) * NMOD + 2 * DM;
        const int rl0 = wr * 64 + fr, col0 = u.colbase + wc * 32 + 4 * fq;
        f32x4 gv[2][2];
#pragma unroll
        for (int bj = 0; bj < 2; ++bj)
#pragma unroll
            for (int n = 0; n < 2; ++n) gv[bj][n] = *(const f32x4*)(g1 + col0 + bj * HALF + n * 16);
#pragma unroll
        for (int ai = 0; ai < 2; ++ai)
#pragma unroll
            for (int m = 0; m < 4; ++m) { const int rl = rl0 + ai * HALF + m * 16; const float* sp = src + (size_t)rl * DM + col0; float* dp = xout + (size_t)(u.rowbase + rl) * DM + col0;
#pragma unroll
                for (int bj = 0; bj < 2; ++bj)
#pragma unroll
                    for (int n = 0; n < 2; ++n) { const f32x4 xv = *(const f32x4*)(sp + bj * HALF + n * 16); *(f32x4*)(dp + bj * HALF + n * 16) = xv + gv[bj][n] * acc[ai][bj][m][n]; }
                if (m & 1) asm volatile("" ::: "memory"); }
    }
};
struct EpiSwiGLU {
    static constexpr bool PERM = true;
    bf16_t* Hout;
    __device__ __forceinline__ void operator()(const f32x4 (&acc)[2][2][4][2], const Unit& u, int wr, int wc, int fr, int fq) const {
        const int row0 = u.rowbase + wr * 64 + fr, col0 = u.pn * HALF + wc * 32 + 8 * fq;
#pragma unroll
        for (int ai = 0; ai < 2; ++ai)
#pragma unroll
            for (int m = 0; m < 4; ++m) { bf16_t* rowp = Hout + (size_t)(row0 + ai * HALF + m * 16) * DM + col0; float h[8];
#pragma unroll
                for (int n = 0; n < 2; ++n)
#pragma unroll
                    for (int j = 0; j < 4; ++j) { const float g = acc[ai][0][m][n][j], up = acc[ai][1][m][n][j]; h[n * 4 + j] = g * __builtin_amdgcn_rcpf(1.f + __expf(-g)) * up; }
                u32x4 w; w.x = cvt_pk_bf16(h[0], h[1]); w.y = cvt_pk_bf16(h[2], h[3]); w.z = cvt_pk_bf16(h[4], h[5]); w.w = cvt_pk_bf16(h[6], h[7]);
                *(u32x4*)rowp = w; }
    }
};
struct EpiSwiGLU8 {
    static constexpr bool PERM = true;
    unsigned char* Hout;
    __device__ __forceinline__ void operator()(const f32x4 (&acc)[2][2][4][2], const Unit& u, int wr, int wc, int fr, int fq) const {
        const int row0 = u.rowbase + wr * 64 + fr, col0 = u.pn * HALF + wc * 32 + 8 * fq;
#pragma unroll
        for (int ai = 0; ai < 2; ++ai)
#pragma unroll
            for (int m = 0; m < 4; ++m) { unsigned char* rowp = Hout + (size_t)(row0 + ai * HALF + m * 16) * DM + col0; float h[8];
#pragma unroll
                for (int n = 0; n < 2; ++n)
#pragma unroll
                    for (int j = 0; j < 4; ++j) { const float g = acc[ai][0][m][n][j], up = acc[ai][1][m][n][j]; h[n * 4 + j] = g * __builtin_amdgcn_rcpf(1.f + __expf(-g)) * up; }
                u32x2 w; w.x = pk4_fp8(h[0], h[1], h[2], h[3]); w.y = pk4_fp8(h[4], h[5], h[6], h[7]);
                *(u32x2*)rowp = w; }
    }
};
struct EpiDown {
    static constexpr bool PERM = true;
    bf16_t* Y; const float* gatev;
    __device__ __forceinline__ void operator()(const f32x4 (&acc)[2][2][4][2], const Unit& u, int wr, int wc, int fr, int fq) const {
        const int row0 = u.rowbase + wr * 64 + fr, col0 = u.colbase + wc * 32 + 8 * fq;
#pragma unroll
        for (int ai = 0; ai < 2; ++ai)
#pragma unroll
            for (int m = 0; m < 4; ++m) { const int row = row0 + ai * HALF + m * 16; const float gt = gatev[row]; bf16_t* rowp = Y + (size_t)row * DM + col0;
#pragma unroll
                for (int bj = 0; bj < 2; ++bj) { const f32x4 v0 = acc[ai][bj][m][0] * gt, v1 = acc[ai][bj][m][1] * gt;
                    u32x4 w; w.x = cvt_pk_bf16(v0[0], v0[1]); w.y = cvt_pk_bf16(v0[2], v0[3]); w.z = cvt_pk_bf16(v1[0], v1[1]); w.w = cvt_pk_bf16(v1[2], v1[3]);
                    *(u32x4*)(rowp + bj * HALF) = w; } }
    }
};

template <class Epi, class Sched, bool FP8 = false, bool ALIGN_EPI = true, bool SP2 = true>
__device__ __forceinline__ void gemm_phase(LAS unsigned char* lds, const Sched& S, const Epi& E) {
    static_assert(Sched::RB == (FP8 ? GK : GK * 2), "operand row bytes");
    const int tid = opaque_tid(), wid = __builtin_amdgcn_readfirstlane(tid >> 6), lane = tid & 63, wr = wid >> 2, wc = wid & 3, fr = lane & 15, fq = lane >> 4;
    constexpr int RB = Sched::RB, nt = RB / 128;
    unsigned voffA[2], voffB[2];
#pragma unroll
    for (int i = 0; i < 2; ++i) { int R, C; stage_rc(tid * 16 + i * 8192, R, C); const int Rb = Epi::PERM ? ((R & ~31) + perm32(R & 31)) : R;
        voffA[i] = (unsigned)(R * RB + C * 2); voffB[i] = (unsigned)(Rb * RB + C * 2); }
    const size_t kstep = (size_t)(BK * 2);
    const size_t hstep = (size_t)HALF * RB;
    const unsigned ldsw = (unsigned)wid * 1024u;
    const int aoff = lds_byte(wr * 64 + fr, fq * 8), boff = lds_byte(wc * 32 + fr, fq * 8);
#define PG8_SA(b, h) (((b) * 2 + (h)) * HTB)
#define PG8_SB(b, h) ((4 + (b) * 2 + (h)) * HTB)
#define PG8_STAGE(bufoff, gbase, voff) do { _Pragma("unroll") for (int _i = 0; _i < 2; ++_i) \
        __builtin_amdgcn_global_load_lds((const unsigned*)((const char*)(gbase) + (voff)[_i]), (LAS unsigned*)(lds + (bufoff) + ldsw + _i * 8192), 16, 0, 0); } while (0)
#define PG8_RD8(p) __builtin_shufflevector(*(const LAS i32x4*)(p), *(const LAS i32x4*)((p) + 1024), 0, 1, 2, 3, 4, 5, 6, 7)
#define PG8_LDA(dst, b, h) do { _Pragma("unroll") for (int m = 0; m < 4; ++m) { if constexpr (FP8) dst##8[m] = PG8_RD8(lds + PG8_SA(b, h) + aoff + m * 2048); \
        else { _Pragma("unroll") for (int k = 0; k < 2; ++k) dst[m][k] = *(const LAS bf16x8*)(lds + PG8_SA(b, h) + aoff + m * 2048 + k * 1024); } } } while (0)
#define PG8_LDB(dst, b, h) do { _Pragma("unroll") for (int n = 0; n < 2; ++n) { if constexpr (FP8) dst##8[n] = PG8_RD8(lds + PG8_SB(b, h) + boff + n * 2048); \
        else { _Pragma("unroll") for (int k = 0; k < 2; ++k) dst[n][k] = *(const LAS bf16x8*)(lds + PG8_SB(b, h) + boff + n * 2048 + k * 1024); } } } while (0)
#define PG8_MMA(ai, bj, At, Bt) do { __builtin_amdgcn_s_setprio(1); _Pragma("unroll") for (int m = 0; m < 4; ++m) _Pragma("unroll") for (int n = 0; n < 2; ++n) { \
        if constexpr (FP8) asm volatile("v_mfma_scale_f32_16x16x128_f8f6f4 %0, %1, %2, %0, %3, %4 op_sel_hi:[0,0,0]" : "+v"(acc[ai][bj][m][n]) : "v"(Bt##8[n]), "v"(At##8[m]), "v"(sclW), "v"(sclX)); \
        else { _Pragma("unroll") for (int k = 0; k < 2; ++k) acc[ai][bj][m][n] = __builtin_amdgcn_mfma_f32_16x16x32_bf16(Bt[n][k], At[m][k], acc[ai][bj][m][n], 0, 0, 0); } } \
        __builtin_amdgcn_s_setprio(0); } while (0)
#define PG8_WAIT_V(n) asm volatile("s_waitcnt vmcnt(" #n ")" ::: "memory")
#define PG8_WAIT_L(n) asm volatile("s_waitcnt lgkmcnt(" #n ")" ::: "memory")
#define PG8_BAR __builtin_amdgcn_s_barrier()
#define PG8_SCHED __builtin_amdgcn_sched_barrier(0)
    Unit cur, nxt; int ui = 0;
    if (!S.next(0, cur)) return;
    f32x4 acc[2][2][4][2];
#pragma unroll
    for (int a = 0; a < 2; ++a)
#pragma unroll
        for (int b = 0; b < 2; ++b)
#pragma unroll
            for (int m = 0; m < 4; ++m)
#pragma unroll
                for (int n = 0; n < 2; ++n) acc[a][b][m][n] = (f32x4){0.f, 0.f, 0.f, 0.f};
    const int sclW = W8_SCALE_E8M0 * 0x01010101, sclX = 0x7f7f7f7f; (void)sclW; (void)sclX;
    bf16x8 At[4][2], B0[2][2], B1[2][2]; i32x8 At8[4], B08[2], B18[2];
    const char* cA = cur.a; const char* cB = cur.b;
    if constexpr (SP2) {
        PG8_STAGE(PG8_SB(0, 0), cB, voffB); PG8_STAGE(PG8_SB(0, 1), cB + hstep, voffB); PG8_STAGE(PG8_SA(0, 0), cA, voffA); PG8_STAGE(PG8_SA(0, 1), cA + hstep, voffA);
        if (wr == 1) PG8_BAR;
        PG8_WAIT_V(2); PG8_BAR;
        PG8_STAGE(PG8_SB(1, 0), cB + kstep, voffB); PG8_STAGE(PG8_SA(1, 0), cA + kstep, voffA); PG8_STAGE(PG8_SB(1, 1), cB + hstep + kstep, voffB);
        PG8_WAIT_V(6); PG8_BAR;
    } else {
        PG8_STAGE(PG8_SB(0, 0), cB, voffB); PG8_STAGE(PG8_SA(0, 0), cA, voffA); PG8_STAGE(PG8_SB(0, 1), cB + hstep, voffB); PG8_STAGE(PG8_SA(0, 1), cA + hstep, voffA);
        if (wr == 1) PG8_BAR;
        PG8_WAIT_V(4); PG8_BAR;
        PG8_STAGE(PG8_SB(1, 0), cB + kstep, voffB); PG8_STAGE(PG8_SA(1, 0), cA + kstep, voffA); PG8_STAGE(PG8_SB(1, 1), cB + hstep + kstep, voffB);
        PG8_WAIT_V(6); PG8_BAR;
    }
    for (;;) {
        const bool has_next = S.next(ui + 1, nxt);
        const char* nA = has_next ? nxt.a : cA; const char* nB = has_next ? nxt.b : cB;
        for (int t = 0; t < nt; t += 2) {
            const bool last = (t == nt - 2);
            const char* a1 = cA + (size_t)(t + 1) * kstep;
            const char* a2 = last ? nA : cA + (size_t)(t + 2) * kstep; const char* b2 = last ? nB : cB + (size_t)(t + 2) * kstep;
            const char* a3 = a2 + kstep; const char* b3 = b2 + kstep;
            if constexpr (SP2) {
            PG8_LDB(B0, 0, 0); PG8_LDB(B1, 0, 1); PG8_SCHED; PG8_LDA(At, 0, 0); PG8_STAGE(PG8_SA(1, 1), a1 + hstep, voffA);
            PG8_WAIT_V(8); PG8_WAIT_L(0); PG8_BAR; PG8_MMA(0, 0, At, B0); PG8_MMA(0, 1, At, B1); PG8_BAR; PG8_SCHED;
            PG8_LDA(At, 0, 1); PG8_STAGE(PG8_SB(0, 0), b2, voffB); PG8_STAGE(PG8_SB(0, 1), b2 + hstep, voffB); PG8_STAGE(PG8_SA(0, 0), a2, voffA);
            PG8_WAIT_V(8); PG8_WAIT_L(0); PG8_BAR; PG8_MMA(1, 0, At, B0); PG8_MMA(1, 1, At, B1); PG8_BAR; PG8_SCHED;
            PG8_LDB(B0, 1, 0); PG8_LDB(B1, 1, 1); PG8_SCHED; PG8_LDA(At, 1, 0); PG8_STAGE(PG8_SA(0, 1), a2 + hstep, voffA);
            PG8_WAIT_V(8); PG8_WAIT_L(0); PG8_BAR; PG8_MMA(0, 0, At, B0); PG8_MMA(0, 1, At, B1); PG8_BAR; PG8_SCHED;
            PG8_LDA(At, 1, 1); PG8_STAGE(PG8_SB(1, 0), b3, voffB); PG8_STAGE(PG8_SB(1, 1), b3 + hstep, voffB); PG8_STAGE(PG8_SA(1, 0), a3, voffA);
            PG8_WAIT_V(8); PG8_WAIT_L(0); PG8_BAR; PG8_MMA(1, 0, At, B0); PG8_MMA(1, 1, At, B1); PG8_BAR; PG8_SCHED;
            } else {
            PG8_LDB(B0, 0, 0); PG8_SCHED; PG8_LDA(At, 0, 0); PG8_STAGE(PG8_SA(1, 1), a1 + hstep, voffA);
            PG8_WAIT_L(8); PG8_BAR; PG8_WAIT_L(0); PG8_MMA(0, 0, At, B0); PG8_BAR; PG8_SCHED;
            PG8_LDB(B1, 0, 1); PG8_STAGE(PG8_SB(0, 0), b2, voffB);
            PG8_BAR; PG8_WAIT_L(0); PG8_MMA(0, 1, At, B1); PG8_BAR;
            PG8_LDA(At, 0, 1); PG8_STAGE(PG8_SA(0, 0), a2, voffA);
            PG8_BAR; PG8_WAIT_L(0); PG8_MMA(1, 0, At, B0); PG8_BAR; PG8_SCHED;
            PG8_STAGE(PG8_SB(0, 1), b2 + hstep, voffB);
            PG8_WAIT_V(6); PG8_BAR; PG8_MMA(1, 1, At, B1); PG8_BAR;
            PG8_LDB(B0, 1, 0); PG8_SCHED; PG8_LDA(At, 1, 0); PG8_STAGE(PG8_SA(0, 1), a2 + hstep, voffA);
            PG8_WAIT_L(8); PG8_BAR; PG8_WAIT_L(0); PG8_MMA(0, 0, At, B0); PG8_BAR; PG8_SCHED;
            PG8_LDB(B1, 1, 1); PG8_STAGE(PG8_SB(1, 0), b3, voffB);
            PG8_BAR; PG8_WAIT_L(0); PG8_MMA(0, 1, At, B1); PG8_BAR;
            PG8_LDA(At, 1, 1); PG8_STAGE(PG8_SA(1, 0), a3, voffA);
            PG8_BAR; PG8_WAIT_L(0); PG8_MMA(1, 0, At, B0); PG8_BAR; PG8_SCHED;
            PG8_STAGE(PG8_SB(1, 1), b3 + hstep, voffB);
            PG8_WAIT_V(6); PG8_BAR; PG8_MMA(1, 1, At, B1); PG8_BAR;
            }
        }
        if constexpr (ALIGN_EPI) { if (wr == 0) PG8_BAR; }
        if constexpr (FP8) asm volatile("s_nop 15\n\ts_nop 15\n\ts_nop 7" ::: "memory");
        E(acc, cur, wr, wc, fr, fq);
        if (!has_next) break;
#pragma unroll
        for (int a = 0; a < 2; ++a)
#pragma unroll
            for (int b = 0; b < 2; ++b)
#pragma unroll
                for (int m = 0; m < 4; ++m)
#pragma unroll
                    for (int n = 0; n < 2; ++n) acc[a][b][m][n] = (f32x4){0.f, 0.f, 0.f, 0.f};
        cur = nxt; cA = nA; cB = nB; ++ui;
        if constexpr (ALIGN_EPI) { if (wr == 1) PG8_BAR; }
    }
    PG8_WAIT_V(0);
    if constexpr (!ALIGN_EPI) { if (wr == 0) PG8_BAR; }
    PG8_BAR;
#undef PG8_SA
#undef PG8_SB
#undef PG8_STAGE
#undef PG8_LDA
#undef PG8_LDB
#undef PG8_MMA
#undef PG8_RD8
#undef PG8_WAIT_V
#undef PG8_WAIT_L
#undef PG8_BAR
#undef PG8_SCHED
}
}

namespace at {
constexpr int D = 128, NW = 8, QBLK = 32, KVBLK = 64;
constexpr float SCALE = 0.088388347648318440f;
constexpr float THR = 8.f;
constexpr int LDQ = INW, LDK = INW, LDO = DM;
constexpr size_t SHM_V = KVBLK * D * 2, SHM_K = KVBLK * D * 2, SHM_ATTN = 2 * SHM_V + 2 * SHM_K + NW * 64 * 4;
#define KSWZ(row, colB) ((row) * 256 + ((colB) ^ (((row) & 7) << 4)))
#define SBAR() __builtin_amdgcn_sched_barrier(0)
__device__ __forceinline__ int crow(int r, int hi) { return (r & 3) + 8 * (r >> 2) + 4 * hi; }
__device__ __forceinline__ unsigned cvtpk(float lo, float hi) { unsigned r; asm volatile("v_cvt_pk_bf16_f32 %0, %1, %2" : "=v"(r) : "v"(lo), "v"(hi)); return r; }

__device__ __forceinline__ void partialSM(f32x16& p0, f32x16& p1, float& m_reg, float& mn, float& alpha, bool domask, int dq, int hi) {
  constexpr float C = SCALE * 1.4426950408889634f;
  {
    if (domask) {
#pragma unroll
      for (int r = 0; r < 16; ++r) { const int d0 = dq + crow(r, hi), d1 = d0 + 32;
        if (d0 > 128 || d0 < -128) p0[r] = -1e30f;
        if (d1 > 128 || d1 < -128) p1[r] = -1e30f; }
    }
  }
  float pmax = p0[0]; for (int r = 1; r < 16; ++r) pmax = fmaxf(pmax, p0[r]); for (int r = 0; r < 16; ++r) pmax = fmaxf(pmax, p1[r]);
  { auto rr = __builtin_amdgcn_permlane32_swap(__float_as_uint(pmax), __float_as_uint(pmax), false, false);
    pmax = fmaxf(__uint_as_float(rr[0]), __uint_as_float(rr[1])); }
  if (__builtin_expect(__all(pmax - m_reg <= THR / SCALE), 1)) { mn = m_reg; alpha = 1.f; }
  else { mn = fmaxf(m_reg, pmax); alpha = __builtin_amdgcn_exp2f((m_reg - mn) * C); m_reg = mn; }
  float mnC = -mn * C;
  for (int r = 0; r < 16; ++r) p0[r] = fmaf(p0[r], C, mnC); for (int r = 0; r < 16; ++r) p1[r] = fmaf(p1[r], C, mnC);
  for (int r = 0; r < 16; ++r) p0[r] = __builtin_amdgcn_exp2f(p0[r]);
}
__device__ __forceinline__ void finishSM(f32x16& p0, f32x16& p1, float alpha, float& l_reg, bf16x8& pa0, bf16x8& pa1, bf16x8& pa2, bf16x8& pa3) {
  for (int r = 0; r < 16; ++r) p1[r] = __builtin_amdgcn_exp2f(p1[r]);
  float ps = 0; for (int r = 0; r < 16; ++r) ps += p0[r]; for (int r = 0; r < 16; ++r) ps += p1[r];
  { auto rr = __builtin_amdgcn_permlane32_swap(__float_as_uint(ps), __float_as_uint(ps), false, false);
    ps = __uint_as_float(rr[0]) + __uint_as_float(rr[1]); }
  l_reg = l_reg * alpha + ps;
#define PK4(P, BASE, OUT) do { unsigned a0 = cvtpk(P[BASE + 0], P[BASE + 1]), a1 = cvtpk(P[BASE + 2], P[BASE + 3]);   \
    unsigned b0 = cvtpk(P[BASE + 4], P[BASE + 5]), b1 = cvtpk(P[BASE + 6], P[BASE + 7]);                              \
    auto r0 = __builtin_amdgcn_permlane32_swap(a0, b0, false, false); auto r1 = __builtin_amdgcn_permlane32_swap(a1, b1, false, false); \
    u32x4 w = {r0[0], r1[0], r0[1], r1[1]}; OUT = *reinterpret_cast<bf16x8*>(&w); } while (0)
  PK4(p0, 0, pa0); PK4(p0, 8, pa1); PK4(p1, 0, pa2); PK4(p1, 8, pa3);
#undef PK4
}
__device__ __forceinline__ void qkt(f32x16& p0, f32x16& p1, const char* Ks, const bf16x8* qr, int ka0) {
  p0 = f32x16{}; p1 = f32x16{};
  asm volatile("" : "+v"(ka0));
#pragma unroll
  for (int d0 = 0; d0 < 8; ++d0) { const int off = ka0 ^ (d0 * 32);
    bf16x8 b0 = *reinterpret_cast<const bf16x8*>(Ks + off);
    bf16x8 b1 = *reinterpret_cast<const bf16x8*>(Ks + off + 32 * 256);
    p0 = __builtin_amdgcn_mfma_f32_32x32x16_bf16(b0, qr[d0], p0, 0, 0, 0);
    p1 = __builtin_amdgcn_mfma_f32_32x32x16_bf16(b1, qr[d0], p1, 0, 0, 0); }
}
__device__ __forceinline__ int v_st(int k, int c) { const int kk = (k & ~0xC) | ((k & 4) << 1) | ((k & 8) >> 1); return ((kk >> 3) * 4 + (c >> 5)) * 512 + ((kk & 7) * 32 + (c & 31)) * 2; }
__device__ __forceinline__ int v_rd_base(int lane) { return ((lane & 3) << 3) | (((lane >> 2) & 3) << 6) | (((lane >> 4) & 1) << 5) | (((lane >> 5) & 1) << 8); }
constexpr int v_rd_off(int d0, int ks, int half) { return d0 * 512 + ks * 4096 + half * 2048; }
template <int OFF> __device__ __forceinline__ s16x4 tr_read(int vb) {
  s16x4 r; asm volatile("ds_read_b64_tr_b16 %0, %1 offset:%2" : "=&v"(r) : "v"(vb), "i"(OFF) : "memory"); return r;
}
template <int D0> __device__ __forceinline__ void pv_one(f32x16& od, int vb, bf16x8 pa0, bf16x8 pa1, bf16x8 pa2, bf16x8 pa3) {
  const s16x4 l0 = tr_read<v_rd_off(D0, 0, 0)>(vb), h0 = tr_read<v_rd_off(D0, 0, 1)>(vb), l1 = tr_read<v_rd_off(D0, 1, 0)>(vb), h1 = tr_read<v_rd_off(D0, 1, 1)>(vb);
  const s16x4 l2 = tr_read<v_rd_off(D0, 2, 0)>(vb), h2 = tr_read<v_rd_off(D0, 2, 1)>(vb), l3 = tr_read<v_rd_off(D0, 3, 0)>(vb), h3 = tr_read<v_rd_off(D0, 3, 1)>(vb);
  asm volatile("s_waitcnt lgkmcnt(0)" ::: "memory"); SBAR();
#define PK(L, H) (bf16x8){L[0], L[1], L[2], L[3], H[0], H[1], H[2], H[3]}
  od = __builtin_amdgcn_mfma_f32_32x32x16_bf16(pa0, PK(l0, h0), od, 0, 0, 0);
  od = __builtin_amdgcn_mfma_f32_32x32x16_bf16(pa1, PK(l1, h1), od, 0, 0, 0);
  od = __builtin_amdgcn_mfma_f32_32x32x16_bf16(pa2, PK(l2, h2), od, 0, 0, 0);
  od = __builtin_amdgcn_mfma_f32_32x32x16_bf16(pa3, PK(l3, h3), od, 0, 0, 0);
#undef PK
}
__device__ __forceinline__ void pv_d0(f32x16* o, int vb, bf16x8 pa0, bf16x8 pa1, bf16x8 pa2, bf16x8 pa3) {
  pv_one<0>(o[0], vb, pa0, pa1, pa2, pa3); pv_one<1>(o[1], vb, pa0, pa1, pa2, pa3); pv_one<2>(o[2], vb, pa0, pa1, pa2, pa3); pv_one<3>(o[3], vb, pa0, pa1, pa2, pa3);
}

__device__ __forceinline__ void attn_body(const bf16_t* __restrict__ Qb, const bf16_t* __restrict__ Kb, const bf16_t* __restrict__ Vb, bf16_t* __restrict__ Ob,
                                          int NT, int kskip, int qpos0, float m0, float l0, bool maskon, char* lds) {
  const int tid = opaque_tid(), wid = tid >> 6, lane = tid & 63, r32 = lane & 31, hi = lane >> 5;
  char* V_lds = lds; char* K_lds = lds + 2 * SHM_V;
  float* ws = (float*)(lds + 2 * SHM_V + 2 * SHM_K) + wid * 64; float* li_l = ws; float* al_l = ws + 32;
  float m_reg = m0, l_reg = l0; f32x16 o[4] = {}; bf16x8 qr[8];
  const bf16_t* Qw = Qb + (long)(wid * QBLK + r32) * LDQ + hi * 8;
#pragma unroll
  for (int d0 = 0; d0 < 8; ++d0) qr[d0] = *reinterpret_cast<const bf16x8*>(Qw + d0 * 16);
  const int sr = tid >> 4, sc = (tid & 15) * 8, vst0 = v_st(sr, sc), vst1 = v_st(32 + sr, sc);
  const int vb0 = (int)(uintptr_t)V_lds + v_rd_base(lane);
  const int qpos = qpos0 + wid * QBLK + r32;
  const int ka0 = r32 * 256 + ((hi * 16) ^ ((r32 & 7) << 4));
  const unsigned goff0 = (unsigned)(sr * LDK + sc) * 2u, goff1 = goff0 + 32u * LDK * 2u;
  struct { bf16x8 vs0, vs1, ks0, ks1; } sr_[2];
#define TROW(jt) ((long)(jt) * KVBLK + ((jt) >= 4 ? kskip : 0))
#define SLOAD(i, jt) do { const long _k0 = TROW(jt) * (LDK * 2); const char* _kp = (const char*)Kb + _k0; const char* _vp = (const char*)Vb + _k0; \
    sr_[i].vs0 = *reinterpret_cast<const bf16x8*>(_vp + goff0); sr_[i].vs1 = *reinterpret_cast<const bf16x8*>(_vp + goff1); \
    sr_[i].ks0 = *reinterpret_cast<const bf16x8*>(_kp + goff0); sr_[i].ks1 = *reinterpret_cast<const bf16x8*>(_kp + goff1); } while (0)
#define SWRITE(b, i) do { *(bf16x8*)(V_lds + (b) * SHM_V + vst0) = sr_[i].vs0;          \
    *(bf16x8*)(V_lds + (b) * SHM_V + vst1) = sr_[i].vs1; int kc = sc * 2;               \
    *(bf16x8*)(K_lds + (b) * SHM_K + KSWZ(sr, kc)) = sr_[i].ks0;                       \
    *(bf16x8*)(K_lds + (b) * SHM_K + KSWZ(32 + sr, kc)) = sr_[i].ks1; } while (0)
#define SWAIT() asm volatile("s_waitcnt vmcnt(4)" ::: "memory")
#define RESC(a) do { if (__any((a) < 1.f)) { if (hi == 0) al_l[r32] = (a); asm volatile("s_waitcnt lgkmcnt(0)" ::: "memory"); \
    for (int d = 0; d < 4; ++d) for (int r = 0; r < 16; ++r) o[d][r] *= al_l[crow(r, hi)]; } } while (0)
#define DQ(jt) (kskip + ((jt) - 4) * KVBLK - qpos)
  f32x16 pA0, pA1, pB0, pB1; float mnA, mnB, alA, alB; bf16x8 pa0, pa1, pa2, pa3;
  constexpr int SE = 0, SO = 1;
  SLOAD(SE, 0); asm volatile("s_waitcnt vmcnt(0)" ::: "memory"); SWRITE(0, SE); __syncthreads();
  qkt(pA0, pA1, K_lds, qr, ka0); partialSM(pA0, pA1, m_reg, mnA, alA, false, 0, hi);
  SLOAD(SO, 1); if (2 < NT) SLOAD(SE, 2);
  SWAIT(); SWRITE(1, SO); __syncthreads();
  for (int j = 1; j + 1 < NT; j += 2) {
    SBAR(); qkt(pB0, pB1, K_lds + SHM_K, qr, ka0);
    finishSM(pA0, pA1, alA, l_reg, pa0, pa1, pa2, pa3); SBAR();
    SLOAD(SO, j + 2); SBAR();
    pv_d0(o, vb0, pa0, pa1, pa2, pa3); partialSM(pB0, pB1, m_reg, mnB, alB, maskon && j >= 4, DQ(j), hi);
    __syncthreads(); SWAIT(); SWRITE(0, SE);
    RESC(alB); __syncthreads();
    SBAR(); qkt(pA0, pA1, K_lds, qr, ka0);
    finishSM(pB0, pB1, alB, l_reg, pa0, pa1, pa2, pa3); SBAR();
    if (j + 3 < NT) SLOAD(SE, j + 3); SBAR();
    pv_d0(o, vb0 + (int)SHM_V, pa0, pa1, pa2, pa3); partialSM(pA0, pA1, m_reg, mnA, alA, maskon && j + 1 >= 4, DQ(j + 1), hi);
    __syncthreads(); SWAIT(); SWRITE(1, SO);
    RESC(alA); __syncthreads();
  }
  SBAR(); qkt(pB0, pB1, K_lds + SHM_K, qr, ka0);
  finishSM(pA0, pA1, alA, l_reg, pa0, pa1, pa2, pa3); SBAR();
  pv_d0(o, vb0, pa0, pa1, pa2, pa3); partialSM(pB0, pB1, m_reg, mnB, alB, maskon && NT - 1 >= 4, DQ(NT - 1), hi);
  __syncthreads(); RESC(alB);
  finishSM(pB0, pB1, alB, l_reg, pa0, pa1, pa2, pa3); SBAR();
  pv_d0(o, vb0 + (int)SHM_V, pa0, pa1, pa2, pa3);
  if (hi == 0) li_l[r32] = l_reg; asm volatile("s_waitcnt lgkmcnt(0)" ::: "memory");
  float rli[16];
#pragma unroll
  for (int r = 0; r < 16; ++r) rli[r] = __builtin_amdgcn_rcpf(li_l[crow(r, hi)]);
  bf16_t* Ow = Ob + (long)(wid * QBLK) * LDO;
#pragma unroll
  for (int r = 0; r < 16; ++r) { int orow = crow(r, hi);
    for (int d0 = 0; d0 < 4; ++d0) Ow[(long)orow * LDO + d0 * 32 + r32] = (bf16_t)f2bf(o[d0][r] * rli[r]); }
#undef TROW
#undef SLOAD
#undef SWRITE
#undef SWAIT
#undef RESC
#undef DQ
}
}

struct Args { const float* in[23]; float* out; unsigned char* ws; int ph_lo, ph_hi; };
enum { IN_X = 0, IN_C, IN_CTX, IN_CCTX, IN_WMOD, IN_BMOD, IN_N1G, IN_N2G, IN_WIN, IN_QNA, IN_KNA, IN_SINK, IN_VNB, IN_WS, IN_BS, IN_QNC, IN_KNC, IN_OUTG, IN_WOUT, IN_WR, IN_WG, IN_WU, IN_WDN };

#define PHASE_IDS(F) const int tid = opaque_tid(), lane = tid & 63, wave = __builtin_amdgcn_readfirstlane(tid >> 6), gw = (int)blockIdx.x * 8 + wave, NGW = (F).G * 8; (void)lane; (void)wave; (void)gw; (void)NGW
constexpr int ARGTAB_OFF = LDSCTL_OFF + 1024;
#define INP(F, i) ld_inp((F).lds, (i))
__device__ __forceinline__ const float* ld_inp(LAS unsigned char* lds, int i) {
    const volatile LAS unsigned* t = (const volatile LAS unsigned*)(lds + ARGTAB_OFF) + 2 * i;
    const unsigned lo = __builtin_amdgcn_readfirstlane(t[0]), hi = __builtin_amdgcn_readfirstlane(t[1]);
    return (const float*)(const GAS float*)(((unsigned long long)hi << 32) | lo);
}
struct Frame {
    LAS unsigned char* lds; char* ldsg;
    volatile LAS unsigned* MISC;
    unsigned* ctl;
    int G;
    float* out; unsigned char* ws;
};

__device__ __forceinline__ void transpose_item(const float* W, int N, bf16_t* WT, int k0, int n0, int drow0, LAS float* scr, int lane) {
#pragma unroll 8
    for (int i = 0; i < 32; ++i) { const int kk = 2 * i + (lane >> 5); scr[kk * 33 + (lane & 31)] = W[(size_t)(k0 + kk) * N + n0 + (lane & 31)]; }
    LDS_WAIT(); asm volatile("" ::: "memory");
    const int c = lane & 7;
#pragma unroll
    for (int j = 0; j < 4; ++j) { const int n = (lane >> 3) + 8 * j; const LAS float* s = scr + (8 * c) * 33 + n;
        u32x4 o; o.x = pk2(s[0 * 33], s[1 * 33]); o.y = pk2(s[2 * 33], s[3 * 33]); o.z = pk2(s[4 * 33], s[5 * 33]); o.w = pk2(s[6 * 33], s[7 * 33]);
        *(u32x4*)(WT + (size_t)(drow0 + n) * DM + k0 + 8 * c) = o; }
    LDS_WAIT(); asm volatile("" ::: "memory");
}

__device__ __forceinline__ void transpose_item8(const float* W, int N, unsigned char* WT, int k0, int n0, int drow0, LAS float* scr, int lane) {
#pragma unroll 8
    for (int i = 0; i < 32; ++i) { const int kk = 2 * i + (lane >> 5); scr[kk * 33 + (lane & 31)] = W[(size_t)(k0 + kk) * N + n0 + (lane & 31)]; }
    LDS_WAIT(); asm volatile("" ::: "memory");
    const int c = lane & 7;
#pragma unroll
    for (int j = 0; j < 4; ++j) { const int n = (lane >> 3) + 8 * j; const LAS float* s = scr + (8 * c) * 33 + n;
        u32x2 o; o.x = pk4_fp8(s[0 * 33] * W8_SCALE, s[1 * 33] * W8_SCALE, s[2 * 33] * W8_SCALE, s[3 * 33] * W8_SCALE); o.y = pk4_fp8(s[4 * 33] * W8_SCALE, s[5 * 33] * W8_SCALE, s[6 * 33] * W8_SCALE, s[7 * 33] * W8_SCALE);
        *(u32x2*)(WT + (size_t)(drow0 + n) * DM + k0 + 8 * c) = o; }
    LDS_WAIT(); asm volatile("" ::: "memory");
}
__device__ __forceinline__ void phase_prologue(Frame& F) {
    PHASE_IDS(F);
    LAS float* scr = (LAS float*)(F.lds + wave * 16384);
    constexpr int I_IN = 32 * (INW / 32), I_SQ = 32 * (DM / 32);
    constexpr int NIT = 2 * I_IN + 2 * I_SQ + 2 * NE * 3 * I_SQ;
    for (int it = gw; it < NIT; it += NGW) {
        int r = it;
        if (r < 2 * I_IN) { const int l = r / I_IN; r %= I_IN; const int nblk = INW / 32, kb = r / nblk, nb = r % nblk;
            transpose_item(INP(F, IN_WIN) + (size_t)l * DM * INW, INW, (bf16_t*)(F.ws + WS_WIN) + (size_t)l * INW * DM, 64 * kb, 32 * nb, 32 * nb, scr, lane); continue; }
        r -= 2 * I_IN;
        if (r < 2 * I_SQ) { const int l = r / I_SQ; r %= I_SQ; const int kb = r / 64, nb = r % 64;
            transpose_item(INP(F, IN_WOUT) + (size_t)l * DM * DM, DM, (bf16_t*)(F.ws + WS_WOUT) + (size_t)l * DM * DM, 64 * kb, 32 * nb, 32 * nb, scr, lane); continue; }
        r -= 2 * I_SQ;
        const int mat = r / I_SQ; r %= I_SQ; const int kb = r / 64, nb = r % 64;
        const int le = mat / 3, which = mat % 3;
        const bool f8 = (le < NE) ? (FP8_L0 != 0) : (FP8_L1 != 0);
        if (which < 2) {
            const float* W = INP(F, which == 0 ? IN_WG : IN_WU) + (size_t)le * DM * DM; const int n0 = 32 * nb, dr = (n0 >> 7) * 256 + which * 128 + (n0 & 127);
            if (f8) transpose_item8(W, DM, (unsigned char*)(F.ws + WS_WGU) + (size_t)(le / NE) * NE * 4096 * DM * 2 + (size_t)(le % NE) * 4096 * DM, 64 * kb, n0, dr, scr, lane);
            else transpose_item(W, DM, (bf16_t*)(F.ws + WS_WGU) + (size_t)le * 4096 * DM, 64 * kb, n0, dr, scr, lane);
        } else {
            if (f8) transpose_item8(INP(F, IN_WDN) + (size_t)le * DM * DM, DM, (unsigned char*)(F.ws + WS_WD) + (size_t)(le / NE) * NE * DM * DM * 2 + (size_t)(le % NE) * DM * DM, 64 * kb, 32 * nb, 32 * nb, scr, lane);
            else transpose_item(INP(F, IN_WDN) + (size_t)le * DM * DM, DM, (bf16_t*)(F.ws + WS_WD) + (size_t)le * DM * DM, 64 * kb, 32 * nb, 32 * nb, scr, lane);
        }
    }
    __syncthreads();
    {
        LAS float* sil = (LAS float*)F.lds;
        LAS float* red = (LAS float*)(F.lds + 40960);
        bool have = false;
        for (int it = blockIdx.x; it < 2 * 96; it += F.G) {
            if (!have) {
                { const float* cp = INP(F, IN_C); const float* ccp = INP(F, IN_CCTX);
                for (int i = tid; i < 5 * DM; i += 512) { const int s = i / DM, k = i % DM; const float cv = (s < 4) ? cp[s * DM + k] : ccp[k]; sil[i] = cv / (1.f + __expf(-cv)); } }
                have = true; __syncthreads();
            }
            const int l = it / 96, cb = it % 96, c4 = tid & 31, kr = tid >> 5;
            const float* wp = INP(F, IN_WMOD) + (size_t)l * DM * NMOD + (size_t)cb * 128 + c4 * 4;
            f32x4 a[5];
#pragma unroll
            for (int s = 0; s < 5; ++s) a[s] = (f32x4){0.f, 0.f, 0.f, 0.f};
#pragma unroll 8
            for (int k = kr; k < DM; k += 16) { const f32x4 w = *(const f32x4*)(wp + (size_t)k * NMOD);
#pragma unroll
                for (int s = 0; s < 5; ++s) a[s] += w * sil[s * DM + k]; }
#pragma unroll
            for (int s = 0; s < 5; ++s) *(LAS f32x4*)(red + (kr * 5 + s) * 128 + c4 * 4) = a[s];
            __syncthreads();
            const float* bmod = INP(F, IN_BMOD);
            for (int i = tid; i < 5 * 128; i += 512) { const int s = i / 128, cc = i % 128; float sum = 0.f;
#pragma unroll
                for (int q = 0; q < 16; ++q) sum += red[(q * 5 + s) * 128 + cc];
                ((float*)(F.ws + WS_MOD))[(size_t)(l * 5 + s) * NMOD + cb * 128 + cc] = sum + bmod[l * NMOD + cb * 128 + cc]; }
            __syncthreads();
        }
    }
    if (blockIdx.x == F.G - 1) {
        for (int i = tid; i < 64 * 32; i += 512) {
            const int pos = i >> 5, f = i & 31;
            double inv = 1.0; for (int q = 0; q < f; ++q) inv *= 0.7498942093324559;
            const double a = (double)pos * inv;
            const double n = __builtin_rint(a * 0.6366197723675814);
            const double r = (a - n * 1.5707963267948966) - n * 6.123233995736766e-17;
            const double r2 = r * r;
            double sn = r * (1.0 + r2 * (-1.0 / 6 + r2 * (1.0 / 120 + r2 * (-1.0 / 5040 + r2 * (1.0 / 362880 + r2 * (-1.0 / 39916800 + r2 * (1.0 / 6227020800.0)))))));
            double cn = 1.0 + r2 * (-0.5 + r2 * (1.0 / 24 + r2 * (-1.0 / 720 + r2 * (1.0 / 40320 + r2 * (-1.0 / 3628800 + r2 * (1.0 / 479001600 + r2 * (-1.0 / 87178291200.0)))))));
            const int q = ((int)n) & 3; double cs, ss;
            if (q == 0) { cs = cn; ss = sn; } else if (q == 1) { cs = -sn; ss = cn; } else if (q == 2) { cs = -cn; ss = -sn; } else { cs = sn; ss = -cn; }
            ((float*)(F.ws + WS_ROPE))[2 * i] = (float)cs; ((float*)(F.ws + WS_ROPE))[2 * i + 1] = (float)ss;
        }
    }
}

__device__ __forceinline__ void load_row(const float* row, int lane, f32x4 (&v)[8]) {
#pragma unroll
    for (int j = 0; j < 8; ++j) v[j] = *(const f32x4*)(row + 4 * lane + 256 * j);
}
__device__ __forceinline__ void norm_mod_store(const f32x4 (&v)[8], const float* g, const float* shift, const float* scale, bf16_t* dst, int lane) {
    float ss = 0.f;
#pragma unroll
    for (int j = 0; j < 8; ++j) ss += (v[j].x * v[j].x + v[j].y * v[j].y) + (v[j].z * v[j].z + v[j].w * v[j].w);
    const float rinv = 1.0f / sqrtf(wave_sum(ss) * (1.f / DM) + EPS);
#pragma unroll
    for (int j = 0; j < 8; ++j) { const int c = 4 * lane + 256 * j;
        const f32x4 gg = *(const f32x4*)(g + c), sh = *(const f32x4*)(shift + c), sc = *(const f32x4*)(scale + c);
        const f32x4 y = (v[j] * rinv) * gg * (sc + 1.f) + sh;
        u32x2 w; w.x = pk2(y.x, y.y); w.y = pk2(y.z, y.w); *(u32x2*)(dst + c) = w; }
}

__device__ __forceinline__ void phase_rowpass1_l0(Frame& F) {
    PHASE_IDS(F);
    const float* mod = (const float*)(F.ws + WS_MOD);
    for (int r = gw; r < NTOK; r += NGW) {
        const int b = r / TPB, t = r % TPB, s = (t < CTXL) ? 4 : b;
        const float* src = (t < CTXL) ? INP(F, IN_CTX) + ((size_t)b * CTXL + t) * DM : INP(F, IN_X) + ((size_t)b * SEQ + (t - CTXL)) * DM;
        f32x4 v[8]; load_row(src, lane, v);
        norm_mod_store(v, INP(F, IN_N1G), mod + (size_t)s * NMOD, mod + (size_t)s * NMOD + DM, (bf16_t*)(F.ws + WS_HN) + (size_t)r * DM, lane);
    }
}

__device__ __forceinline__ void post_unpack(const u32x4 x, float (&v)[8]) {
    v[0] = bflo(x.x); v[1] = bfhi(x.x); v[2] = bflo(x.y); v[3] = bfhi(x.y); v[4] = bflo(x.z); v[5] = bfhi(x.z); v[6] = bflo(x.w); v[7] = bfhi(x.w); }
__device__ __forceinline__ float sum16(float v) { v += __shfl_xor(v, 1); v += __shfl_xor(v, 2); v += __shfl_xor(v, 4); v += __shfl_xor(v, 8); return v; }
__device__ __forceinline__ void phase_post(Frame& F, int l) {
    PHASE_IDS(F);
    bf16_t* P = (bf16_t*)(F.ws + WS_P);
    const float* rope = (const float*)(F.ws + WS_ROPE);
    const int i16 = lane & 15, hq = lane >> 4; const bool hi2 = hq >= 2;
    const float* qna = INP(F, IN_QNA) + l * 128 + 8 * i16; const float* kna = INP(F, IN_KNA) + l * 128 + 8 * i16;
    const float* qnc = INP(F, IN_QNC) + l * 128 + 8 * i16; const float* knc = INP(F, IN_KNC) + l * 128 + 8 * i16;
    const float* vnb = INP(F, IN_VNB) + l * 512 + 8 * i16;
    for (int r = gw; r < NTOK; r += NGW) {
        const int t = r % TPB; const bool lat = t >= CTXL;
        u32x4* rp = (u32x4*)(P + (size_t)r * INW) + lane;
        u32x4 x[7];
#pragma unroll
        for (int j = 0; j < 7; ++j) x[j] = rp[64 * j];
        const int pos = lat ? t - CTXL : 0, pp = (i16 < 8) ? (pos >> 6) : (pos & 63);
        const f32x4* cs = (const f32x4*)(rope + 2 * (pp * 32 + 8 * (i16 & 3)));
        const f32x4 c0 = cs[0], c1 = cs[1], c2 = cs[2], c3 = cs[3];
        const float cosv[8] = {c0.x, c0.z, c1.x, c1.z, c2.x, c2.z, c3.x, c3.z}, sinv[8] = {c0.y, c0.w, c1.y, c1.w, c2.y, c2.w, c3.y, c3.w};
        const float sgn = (i16 & 4) ? 1.f : -1.f;
#pragma unroll
        for (int j = 0; j < 7; ++j) {
            const bool gelu_lo = (j == 3 || j == 4), gelu_hi = (j == 2 || j == 3);
            const bool norm_lo = (j != 2 && j != 3), norm_hi = (j != 2 && j != 6);
            const bool rope_lo = (j == 0 || j == 1 || j == 5 || j == 6), rope_hi = (j == 0 || j == 1 || j == 4 || j == 5);
            const bool dg = hi2 ? gelu_hi : gelu_lo, dn = hi2 ? norm_hi : norm_lo, dr = (hi2 ? rope_hi : rope_lo) && lat;
            if (!(gelu_lo || gelu_hi || norm_lo || norm_hi)) continue;
            float v[8]; post_unpack(x[j], v);
            if (gelu_lo || gelu_hi) {
#pragma unroll
                for (int e = 0; e < 8; ++e) { const float gv = gelu_tanh(v[e]); v[e] = dg ? gv : v[e]; } }
            if (norm_lo || norm_hi) {
                float ss = 0.f;
#pragma unroll
                for (int e = 0; e < 8; ++e) ss += v[e] * v[e];
                const float rinv = 1.0f / sqrtf(sum16(ss) * (1.f / 128) + EPS);
                const float* gp;
                if (j == 0) gp = qna; else if (j == 1) gp = hi2 ? kna : qna; else if (j == 3) gp = vnb + (hi2 ? hq - 2 : 0) * 128; else if (j == 4) gp = hi2 ? qnc : vnb + (2 + hq) * 128;
                else if (j == 5) gp = qnc; else gp = knc;
                const f32x4 g0 = *(const f32x4*)gp, g1 = *(const f32x4*)(gp + 4);
                const float gg[8] = {g0.x, g0.y, g0.z, g0.w, g1.x, g1.y, g1.z, g1.w};
#pragma unroll
                for (int e = 0; e < 8; ++e) v[e] = dn ? v[e] * rinv * gg[e] : v[e];
            }
            if (rope_lo || rope_hi) {
#pragma unroll
                for (int e = 0; e < 8; ++e) { const float o = __shfl_xor(v[e], 4); const float rv = v[e] * cosv[e] + sgn * o * sinv[e]; v[e] = dr ? rv : v[e]; } }
            u32x4 w; w.x = pk2(v[0], v[1]); w.y = pk2(v[2], v[3]); w.z = pk2(v[4], v[5]); w.w = pk2(v[6], v[7]);
            rp[64 * j] = w;
        }
    }
}

__device__ __forceinline__ void mixer_b_unit(Frame& F, int l, int b, int ch, int g) {
    PHASE_IDS(F);
    const bf16_t* P = (const bf16_t*)(F.ws + WS_P); bf16_t* O = (bf16_t*)(F.ws + WS_O);
    const int row0 = b * TPB + ch * 128, w = wave;
    LAS bf16_t* VT = (LAS bf16_t*)F.lds;
    { const int q = tid >> 2, dp = (tid & 3) * 32; const bf16_t* src = P + (size_t)(row0 + q) * INW + C_VB + g * 128 + dp;
#pragma unroll
      for (int i = 0; i < 4; ++i) { const u32x4 x = *(const u32x4*)(src + 8 * i); const unsigned xs[4] = {x.x, x.y, x.z, x.w};
#pragma unroll
          for (int j = 0; j < 4; ++j) { VT[(dp + 8 * i + 2 * j) * 136 + q] = (bf16_t)(xs[j] & 0xffffu); VT[(dp + 8 * i + 2 * j + 1) * 136 + q] = (bf16_t)(xs[j] >> 16); } } }
    __syncthreads();
    const int i15 = lane & 15, kq = lane >> 4;
    f32x4 acc[8];
#pragma unroll
    for (int n = 0; n < 8; ++n) acc[n] = (f32x4){0.f, 0.f, 0.f, 0.f};
    const float* wsr = INP(F, IN_WS) + ((size_t)(l * 4 + g) * 128 + 16 * w + i15) * 128;
#pragma unroll
    for (int s = 0; s < 4; ++s) {
        const f32x4 a0 = *(const f32x4*)(wsr + 32 * s + 8 * kq), a1 = *(const f32x4*)(wsr + 32 * s + 8 * kq + 4);
        u32x4 aw; aw.x = pk2(a0.x, a0.y); aw.y = pk2(a0.z, a0.w); aw.z = pk2(a1.x, a1.y); aw.w = pk2(a1.z, a1.w);
        const bf16x8 af = *reinterpret_cast<bf16x8*>(&aw);
#pragma unroll
        for (int n = 0; n < 8; ++n) { const bf16x8 bfr = *(const LAS bf16x8*)(VT + (16 * n + i15) * 136 + 32 * s + 8 * kq);
            acc[n] = __builtin_amdgcn_mfma_f32_16x16x32_bf16(af, bfr, acc[n], 0, 0, 0); }
    }
#pragma unroll
    for (int j = 0; j < 4; ++j) { const int p = 16 * w + kq * 4 + j; const float bias = INP(F, IN_BS)[(l * 4 + g) * 128 + p];
        const bf16_t* up = P + (size_t)(row0 + p) * INW + C_UB + g * 128; bf16_t* op = O + (size_t)(row0 + p) * DM + O_B + g * 128;
#pragma unroll
        for (int n = 0; n < 8; ++n) { const int d = 16 * n + i15; op[d] = (bf16_t)f2bf(bf2f(up[d]) * (acc[n][j] + bias)); } }
    __syncthreads();
}
__device__ __forceinline__ void phase_mixers(Frame& F, int l) {
    PHASE_IDS(F);
    const bf16_t* P = (const bf16_t*)(F.ws + WS_P); bf16_t* O = (bf16_t*)(F.ws + WS_O);
    const bool ctx = (l == 0);
    const int nC = 384, nA = 384, nCc = ctx ? 24 : 0, nAc = ctx ? 24 : 0, nB = 4 * 4 * 34;
    const int total = nC + nA + nCc + nAc + nB;
    unsigned* qctr = F.ctl + CW_QUEUE + 64 * l;
    for (;;) {
        if (tid == 0) F.MISC[0] = xb_add(qctr, 1u);
        __syncthreads();
        int u = (int)F.MISC[0];
        __syncthreads();
        if (u >= total) break;
        if (u < nC + nA + nCc + nAc) {
            int kind, b, h, qb = 0;
            if (u < nC) { kind = 0; b = u / 96; h = (u % 96) / 16; qb = u % 16; }
            else if (u < nC + nA) { const int v = u - nC; kind = 1; b = v / 96; h = (v % 96) / 16; qb = v % 16; }
            else if (u < nC + nA + nCc) { const int v = u - nC - nA; kind = 2; b = v / 6; h = v % 6; }
            else { const int v = u - nC - nA - nCc; kind = 3; b = v / 6; h = v % 6; }
            const int kv = h / 3, isA = kind & 1, lat = (kind < 2);
            const size_t r0 = (size_t)b * TPB, rq = r0 + (lat ? CTXL + qb * 256 : 0);
            const int q0 = qb * 256, ks = (kind == 1) ? ((q0 - 128 < 0) ? 0 : q0 - 128) : 0, ke = (q0 + 384 > SEQ) ? SEQ : q0 + 384;
            const int NT = (kind == 0) ? 68 : (kind == 1) ? 4 + (ke - ks) / 64 : 4;
            const float sink = INP(F, IN_SINK)[l * 6 + h];
            const int cq = (isA ? C_QA : C_QC) + h * 128, ck = (isA ? C_KA : C_KC) + kv * 128, cv = (isA ? C_VA : C_VC) + kv * 128, co = (isA ? O_A : O_C) + h * 128;
            at::attn_body(P + rq * INW + cq, P + r0 * INW + ck, P + r0 * INW + cv, O + rq * DM + co, NT, ks, q0, isA ? sink / at::SCALE : -1e30f, isA ? 1.f : 0.f, kind == 1, F.ldsg);
            continue; }
        u -= nC + nA + nCc;
        u -= nAc;
        { const int b = u / 136, ch = (u % 136) / 4, g = u % 4;
          if (!ctx && ch < 2) continue;
          mixer_b_unit(F, l, b, ch, g); }
    }
}

__device__ __forceinline__ void phase_groupnorm(Frame& F, int l) {
    PHASE_IDS(F);
    bf16_t* O = (bf16_t*)(F.ws + WS_O); const float* og = INP(F, IN_OUTG) + l * DM;
    for (int r = gw; r < NTOK; r += NGW) {
        if (l == 1 && (r % TPB) < CTXL) continue;
        bf16_t* row = O + (size_t)r * DM;
        u32x2 x[8];
#pragma unroll
        for (int i = 0; i < 3; ++i) { x[i] = *(const u32x2*)(row + O_A + 12 * lane + 4 * i); x[5 + i] = *(const u32x2*)(row + O_C + 12 * lane + 4 * i); }
#pragma unroll
        for (int i = 0; i < 2; ++i) x[3 + i] = *(const u32x2*)(row + O_B + 8 * lane + 4 * i);
        float v[8][4]; float ss[3] = {0.f, 0.f, 0.f};
#pragma unroll
        for (int i = 0; i < 8; ++i) { v[i][0] = bflo(x[i].x); v[i][1] = bfhi(x[i].x); v[i][2] = bflo(x[i].y); v[i][3] = bfhi(x[i].y);
            const int grp = (i < 3) ? 0 : (i < 5) ? 1 : 2; ss[grp] += (v[i][0] * v[i][0] + v[i][1] * v[i][1]) + (v[i][2] * v[i][2] + v[i][3] * v[i][3]); }
        float rinv[3];
        rinv[0] = 1.0f / sqrtf(wave_sum(ss[0]) * (1.f / 768) + EPS); rinv[1] = 1.0f / sqrtf(wave_sum(ss[1]) * (1.f / 512) + EPS); rinv[2] = 1.0f / sqrtf(wave_sum(ss[2]) * (1.f / 768) + EPS);
#pragma unroll
        for (int i = 0; i < 8; ++i) { const int grp = (i < 3) ? 0 : (i < 5) ? 1 : 2;
            const int c = (grp == 0) ? O_A + 12 * lane + 4 * i : (grp == 1) ? O_B + 8 * lane + 4 * (i - 3) : O_C + 12 * lane + 4 * (i - 5);
            const f32x4 gg = *(const f32x4*)(og + c); const float ri = rinv[grp];
            u32x2 w; w.x = pk2(v[i][0] * ri * gg.x, v[i][1] * ri * gg.y); w.y = pk2(v[i][2] * ri * gg.z, v[i][3] * ri * gg.w); *(u32x2*)(row + c) = w; }
    }
}

__device__ __forceinline__ void phase_rowpass2(Frame& F, int l) {
    PHASE_IDS(F);
    const float* mod = (const float*)(F.ws + WS_MOD) + (size_t)l * 5 * NMOD;
    const float* xb = (const float*)(F.ws + WS_XB);
    LAS float* wl = (LAS float*)F.lds;
    const float* wr = INP(F, IN_WR) + (size_t)l * DM * NE;
    for (int i = tid; i < DM * NE; i += 512) wl[(i & 15) * DM + (i >> 4)] = wr[i];
    __syncthreads();
    const float* g = INP(F, IN_N2G) + l * DM;
    const bool f8 = (l == 0) ? (FP8_L0 != 0) : (FP8_L1 != 0);
    for (int r = gw; r < NTOK; r += NGW) {
        const int b = r / TPB, t = r % TPB, s = (t < CTXL) ? 4 : b;
        if (l == 1 && t < CTXL) continue;
        f32x4 v[8]; load_row(xb + (size_t)r * DM, lane, v);
        float ss = 0.f;
#pragma unroll
        for (int j = 0; j < 8; ++j) ss += (v[j].x * v[j].x + v[j].y * v[j].y) + (v[j].z * v[j].z + v[j].w * v[j].w);
        const float rinv = 1.0f / sqrtf(wave_sum(ss) * (1.f / DM) + EPS);
        const float* shift = mod + (size_t)s * NMOD + 3 * DM; const float* scale = shift + DM;
        bf16_t* dst = (bf16_t*)(F.ws + WS_HN) + (size_t)r * DM;
#pragma unroll
        for (int j = 0; j < 8; ++j) { const int c = 4 * lane + 256 * j;
            const f32x4 gg = *(const f32x4*)(g + c), sh = *(const f32x4*)(shift + c), sc = *(const f32x4*)(scale + c);
            v[j] = (v[j] * rinv) * gg * (sc + 1.f) + sh;
            if (f8) *(unsigned*)((unsigned char*)(F.ws + WS_HN8) + (size_t)r * DM + c) = pk4_fp8(v[j].x, v[j].y, v[j].z, v[j].w);
            else { u32x2 w; w.x = pk2(v[j].x, v[j].y); w.y = pk2(v[j].z, v[j].w); *(u32x2*)(dst + c) = w; } }
        float lg[16];
#pragma unroll
        for (int e = 0; e < 16; ++e) { float a = 0.f;
#pragma unroll
            for (int j = 0; j < 8; ++j) { const f32x4 w = *(const LAS f32x4*)(wl + e * DM + 4 * lane + 256 * j); a += (v[j].x * w.x + v[j].y * w.y) + (v[j].z * w.z + v[j].w * w.w); }
            lg[e] = wave_sum(a); }
        float mx = lg[0];
#pragma unroll
        for (int e = 1; e < 16; ++e) mx = fmaxf(mx, lg[e]);
        float den = 0.f, mine = 0.f;
#pragma unroll
        for (int e = 0; e < 16; ++e) { const float ex = __expf(lg[e] - mx); den += ex; mine = (lane == e) ? ex : mine; }
        if (lane < 16) {
            const float a = mine / den;
            if (t < CTXL) ((float*)(F.ws + WS_AFFC))[((size_t)b * NE + lane) * CTXL + t] = a;
            else ((float*)(F.ws + WS_AFFL))[((size_t)b * NE + lane) * SEQ + (t - CTXL)] = a;
        }
    }
    __syncthreads();
}

__device__ __forceinline__ void phase_topk(Frame& F, int l) {
    PHASE_IDS(F);
    LAS unsigned long long* key = (LAS unsigned long long*)F.lds;
    const int nunits = (l == 0) ? 128 : 64;
    for (int u = blockIdx.x; u < nunits; u += F.G) {
        const bool isc = u >= 64; const int uu = isc ? u - 64 : u, b = uu / NE, e = uu % NE;
        const int N = isc ? CTXL : SEQ, cap = isc ? CAP_C : CAP_L;
        const float* src = isc ? (const float*)(F.ws + WS_AFFC) + (size_t)uu * CTXL : (const float*)(F.ws + WS_AFFL) + (size_t)uu * SEQ;
        int* pos = isc ? (int*)(F.ws + WS_POSC) + (size_t)uu * CTXL : (int*)(F.ws + WS_POSL) + (size_t)uu * SEQ;
        for (int i = tid; i < N; i += 512) key[i] = ((unsigned long long)(~__float_as_uint(src[i])) << 32) | (unsigned)i;
        __syncthreads();
        for (int k = 2; k <= N; k <<= 1)
            for (int j = k >> 1; j > 0; j >>= 1) {
                for (int tt = tid; tt < N / 2; tt += 512) {
                    const int i = ((tt & ~(j - 1)) << 1) | (tt & (j - 1)), ij = i | j;
                    const bool up = ((i & k) == 0);
                    const unsigned long long a = key[i], c = key[ij];
                    if ((a > c) == up) { key[i] = c; key[ij] = a; }
                }
                __syncthreads();
            }
        const int slotbase = e * ROWS_E + (isc ? 2048 + b * CAP_C : b * CAP_L);
        for (int i = tid; i < N; i += 512) {
            const unsigned long long kk = key[i]; const int tok = (int)(unsigned)kk;
            pos[tok] = (i < cap) ? i : -1;
            if (i < cap) { ((int*)(F.ws + WS_RSRC))[slotbase + i] = b * TPB + (isc ? tok : CTXL + tok); ((float*)(F.ws + WS_GATE))[slotbase + i] = __uint_as_float(~(unsigned)(kk >> 32)); }
        }
        __syncthreads();
    }
}

__device__ __forceinline__ void phase_gather(Frame& F, int l) {
    PHASE_IDS(F);
    const int rows_e = (l == 0) ? 2176 : 2048;
    const bf16_t* hn = (const bf16_t*)(F.ws + WS_HN); bf16_t* xg = (bf16_t*)(F.ws + WS_XG); const int* rsrc = (const int*)(F.ws + WS_RSRC);
    const bool f8 = (l == 0) ? (FP8_L0 != 0) : (FP8_L1 != 0);
    if (f8) {
        const unsigned char* hn8 = (const unsigned char*)(F.ws + WS_HN8); unsigned char* xg8 = (unsigned char*)(F.ws + WS_XG);
        for (int it = gw * 8; it < NE * rows_e; it += NGW * 8) {
            const int e = it / rows_e, sl = it % rows_e, row = e * ROWS_E + sl;
            const int my = (lane < 8) ? rsrc[row + lane] : 0;
            u32x4 x[8][2];
#pragma unroll
            for (int q = 0; q < 8; ++q) { const int src = __builtin_amdgcn_readlane(my, q); const u32x4* sp = (const u32x4*)(hn8 + (size_t)src * DM) + lane; x[q][0] = sp[0]; x[q][1] = sp[64]; }
#pragma unroll
            for (int q = 0; q < 8; ++q) { u32x4* dp = (u32x4*)(xg8 + (size_t)(row + q) * DM) + lane; dp[0] = x[q][0]; dp[64] = x[q][1]; }
        }
        return;
    }
    for (int it = gw * 4; it < NE * rows_e; it += NGW * 4) {
        const int e = it / rows_e, sl = it % rows_e, row = e * ROWS_E + sl;
        const int my = (lane < 4) ? rsrc[row + lane] : 0;
        u32x4 x[4][4];
#pragma unroll
        for (int q = 0; q < 4; ++q) { const int src = __builtin_amdgcn_readlane(my, q); const u32x4* sp = (const u32x4*)(hn + (size_t)src * DM) + lane;
#pragma unroll
            for (int j = 0; j < 4; ++j) x[q][j] = sp[64 * j]; }
#pragma unroll
        for (int q = 0; q < 4; ++q) { u32x4* dp = (u32x4*)(xg + (size_t)(row + q) * DM) + lane;
#pragma unroll
            for (int j = 0; j < 4; ++j) dp[64 * j] = x[q][j]; }
    }
}

__device__ __forceinline__ void phase_combine(Frame& F, int l) {
    PHASE_IDS(F);
    const float* mod = (const float*)(F.ws + WS_MOD);
    float* xb = (float*)(F.ws + WS_XB); const bf16_t* Y = (const bf16_t*)(F.ws + WS_XG);
    for (int r = gw; r < NTOK; r += NGW) {
        const int b = r / TPB, t = r % TPB, s = (t < CTXL) ? 4 : b;
        if (l == 1 && t < CTXL) continue;
        int p = -1;
        if (lane < NE) p = (t < CTXL) ? ((const int*)(F.ws + WS_POSC))[((size_t)b * NE + lane) * CTXL + t] : ((const int*)(F.ws + WS_POSL))[((size_t)b * NE + lane) * SEQ + (t - CTXL)];
        f32x4 v[8]; load_row(xb + (size_t)r * DM, lane, v);
        const float* g2 = mod + (size_t)(l * 5 + s) * NMOD + 5 * DM;
        f32x4 gv[8];
#pragma unroll
        for (int j = 0; j < 8; ++j) gv[j] = *(const f32x4*)(g2 + 4 * lane + 256 * j);
        f32x4 a[8];
#pragma unroll
        for (int j = 0; j < 8; ++j) a[j] = (f32x4){0.f, 0.f, 0.f, 0.f};
        unsigned long long m = __ballot(p >= 0);
        const int ybase = (t < CTXL) ? 2048 + b * CAP_C : b * CAP_L;
        while (m) {
            const int e0 = __builtin_ctzll(m); m &= m - 1;
            const bool two = (m != 0ull); const int e1 = two ? __builtin_ctzll(m) : e0; if (two) m &= m - 1;
            const int p0 = __builtin_amdgcn_readlane(p, e0), p1 = __builtin_amdgcn_readlane(p, e1);
            const bf16_t* y0 = Y + (size_t)(e0 * ROWS_E + ybase + p0) * DM + 4 * lane; const bf16_t* y1 = Y + (size_t)(e1 * ROWS_E + ybase + p1) * DM + 4 * lane;
            u32x2 w0[8], w1[8];
#pragma unroll
            for (int j = 0; j < 8; ++j) w0[j] = *(const u32x2*)(y0 + 256 * j);
            if (two) {
#pragma unroll
                for (int j = 0; j < 8; ++j) w1[j] = *(const u32x2*)(y1 + 256 * j); }
#pragma unroll
            for (int j = 0; j < 8; ++j) a[j] += (f32x4){bflo(w0[j].x), bfhi(w0[j].x), bflo(w0[j].y), bfhi(w0[j].y)};
            if (two) {
#pragma unroll
                for (int j = 0; j < 8; ++j) a[j] += (f32x4){bflo(w1[j].x), bfhi(w1[j].x), bflo(w1[j].y), bfhi(w1[j].y)}; }
        }
#pragma unroll
        for (int j = 0; j < 8; ++j) v[j] += gv[j] * a[j];
        if (l == 0) {
#pragma unroll
            for (int j = 0; j < 8; ++j) *(f32x4*)(xb + (size_t)r * DM + 4 * lane + 256 * j) = v[j];
            const float* m1 = mod + (size_t)(5 + s) * NMOD;
            norm_mod_store(v, INP(F, IN_N1G) + DM, m1, m1 + DM, (bf16_t*)(F.ws + WS_HN) + (size_t)r * DM, lane);
        } else {
            float* op = F.out + ((size_t)b * SEQ + (t - CTXL)) * DM;
#pragma unroll
            for (int j = 0; j < 8; ++j) *(f32x4*)(op + 4 * lane + 256 * j) = v[j];
        }
    }
}

__device__ __forceinline__ void phase_dump_x(Frame& F, bool from_input) {
    PHASE_IDS(F);
    const float* xb = (const float*)(F.ws + WS_XB);
    for (int r = gw; r < NTOK; r += NGW) {
        const int b = r / TPB, t = r % TPB; if (t < CTXL) continue;
        const float* src = from_input ? INP(F, IN_X) + ((size_t)b * SEQ + (t - CTXL)) * DM : xb + (size_t)r * DM;
        f32x4 v[8]; load_row(src, lane, v);
        float* op = F.out + ((size_t)b * SEQ + (t - CTXL)) * DM;
#pragma unroll
        for (int j = 0; j < 8; ++j) *(f32x4*)(op + 4 * lane + 256 * j) = v[j];
    }
}

constexpr int N_PHASES = 2 + 11 * NLAYER;
__global__ void __launch_bounds__(512, 2) fwd_kernel(Args args) {
    extern __shared__ __attribute__((aligned(16))) unsigned char lds[];
    Frame F;
    F.lds = (LAS unsigned char*)lds; F.ldsg = (char*)lds;
    F.MISC = (volatile LAS unsigned*)(F.lds + MISC_OFF);
    F.G = gridDim.x;
    F.out = args.out; F.ws = args.ws; F.ctl = (unsigned*)(args.ws + WS_CTL);
    for (int u = threadIdx.x; u < (LDS_BYTES - LDSCTL_OFF) / 4; u += 512) ((LAS unsigned*)(F.lds + LDSCTL_OFF))[u] = 0u;
    __syncthreads();
    if (threadIdx.x < 23) { const unsigned long long pv = (unsigned long long)args.in[threadIdx.x]; LAS unsigned* t = (LAS unsigned*)(F.lds + ARGTAB_OFF) + 2 * threadIdx.x; t[0] = (unsigned)pv; t[1] = (unsigned)(pv >> 32); }
    __syncthreads();
    XcdBarrier bar; bar.bar = F.ctl + CW_BAR; bar.x = 0; bar.st = nullptr;
    if (!MK_PER_PHASE) bar = xcd_barrier_post(F.ctl + CW_BAR, F.MISC + 8);
    const int lo = args.ph_lo, hi = args.ph_hi;
#define IN(k) (lo <= (k) && (k) < hi)
    unsigned long long probe_t0 = 0ull, probe_acc = 0ull;
#define PROBE_BEGIN(k) do { if (PROBE_MASK & (1u << (k))) probe_t0 = __builtin_amdgcn_s_memrealtime(); } while (0)
#define SEAM(k) do { if (IN(k) && IN((k) + 1)) xcd_barrier(bar); if (PROBE_MASK & (1u << (k))) probe_acc += __builtin_amdgcn_s_memrealtime() - probe_t0; } while (0)

    if (IN(0)) { PROBE_BEGIN(0); if (PH_ON(0)) phase_prologue(F); if (IN(1)) xcd_barrier_first(bar); if (PROBE_MASK & 1u) probe_acc += __builtin_amdgcn_s_memrealtime() - probe_t0; }
    if (IN(1)) { PROBE_BEGIN(1); if (PH_ON(1)) phase_rowpass1_l0(F); SEAM(1); }
    for (int l = 0; l < NLAYER; ++l) {
        const int pb = 2 + 11 * l;
        const bool ctx = (l == 0);
        if (IN(pb + 0)) { PROBE_BEGIN(pb + 0); if (PH_ON(2)) {
            pg8::SchedDense S; S.init(F.ws + WS_HN, F.ws + WS_WIN + (size_t)l * INW * DM * 2, NTOK / 256, INW / 256, F.G, (int)blockIdx.x, 0);
            pg8::EpiStoreBf16 E{(bf16_t*)(F.ws + WS_P), INW};
            pg8::gemm_phase<pg8::EpiStoreBf16, pg8::SchedDense>(F.lds, S, E); }
            SEAM(pb + 0); }
        if (IN(pb + 1)) { PROBE_BEGIN(pb + 1); if (PH_ON(3)) phase_post(F, l); SEAM(pb + 1); }
        if (IN(pb + 2)) { PROBE_BEGIN(pb + 2); if (PH_ON(4)) phase_mixers(F, l); SEAM(pb + 2); }
        if (IN(pb + 3)) { PROBE_BEGIN(pb + 3); if (PH_ON(5)) phase_groupnorm(F, l); SEAM(pb + 3); }
        if (IN(pb + 4)) { PROBE_BEGIN(pb + 4); if (PH_ON(6)) {
            pg8::SchedDense S; S.init(F.ws + WS_O, F.ws + WS_WOUT + (size_t)l * DM * DM * 2, ctx ? NTOK / 256 : 64, DM / 256, F.G, (int)blockIdx.x, ctx ? 0 : 1);
            float* xb = (float*)(F.ws + WS_XB);
            pg8::EpiResid E;
            if (l == 0) { E.ctxbase = INP(F, IN_CTX); E.latbase = INP(F, IN_X); E.cbs = CTXL; E.lbs = SEQ; }
            else { E.ctxbase = xb; E.latbase = xb + (size_t)CTXL * DM; E.cbs = TPB; E.lbs = TPB; }
            E.xout = xb; E.modl = (const float*)(F.ws + WS_MOD) + (size_t)l * 5 * NMOD;
            pg8::gemm_phase<pg8::EpiResid, pg8::SchedDense>(F.lds, S, E); }
            SEAM(pb + 4); }
        if (IN(pb + 5)) { PROBE_BEGIN(pb + 5); if (PH_ON(7)) phase_rowpass2(F, l); SEAM(pb + 5); }
        if (IN(pb + 6)) { PROBE_BEGIN(pb + 6); if (PH_ON(8)) phase_topk(F, l); SEAM(pb + 6); }
        if (IN(pb + 7)) { PROBE_BEGIN(pb + 7); if (PH_ON(9)) phase_gather(F, l); SEAM(pb + 7); }
        if (IN(pb + 8)) { PROBE_BEGIN(pb + 8); if (PH_ON(10)) {
            if ((l == 0) ? (FP8_L0 != 0) : (FP8_L1 != 0)) {
                pg8::SchedGrouped<pg8::GK> S; S.init(F.ws + WS_XG, F.ws + WS_WGU + (size_t)l * NE * 4096 * DM * 2, ctx ? 9 : 8, 16, F.G, (int)blockIdx.x);
                pg8::EpiSwiGLU8 E{(unsigned char*)(F.ws + WS_H)};
                pg8::gemm_phase<pg8::EpiSwiGLU8, pg8::SchedGrouped<pg8::GK>, true>(F.lds, S, E);
            } else {
                pg8::SchedGrouped<2 * pg8::GK> S; S.init(F.ws + WS_XG, F.ws + WS_WGU + (size_t)l * NE * 4096 * DM * 2, ctx ? 9 : 8, 16, F.G, (int)blockIdx.x);
                pg8::EpiSwiGLU E{(bf16_t*)(F.ws + WS_H)};
                pg8::gemm_phase<pg8::EpiSwiGLU, pg8::SchedGrouped<2 * pg8::GK>, false>(F.lds, S, E);
            } }
            SEAM(pb + 8); }
        if (IN(pb + 9)) { PROBE_BEGIN(pb + 9); if (PH_ON(11)) {
            pg8::EpiDown E{(bf16_t*)(F.ws + WS_XG), (const float*)(F.ws + WS_GATE)};
            if ((l == 0) ? (FP8_L0 != 0) : (FP8_L1 != 0)) {
                pg8::SchedGrouped<pg8::GK> S; S.init(F.ws + WS_H, F.ws + WS_WD + (size_t)l * NE * DM * DM * 2, ctx ? 9 : 8, 8, F.G, (int)blockIdx.x);
                pg8::gemm_phase<pg8::EpiDown, pg8::SchedGrouped<pg8::GK>, true>(F.lds, S, E);
            } else {
                pg8::SchedGrouped<2 * pg8::GK> S; S.init(F.ws + WS_H, F.ws + WS_WD + (size_t)l * NE * DM * DM * 2, ctx ? 9 : 8, 8, F.G, (int)blockIdx.x);
                pg8::gemm_phase<pg8::EpiDown, pg8::SchedGrouped<2 * pg8::GK>, false>(F.lds, S, E);
            } }
            SEAM(pb + 9); }
        if (IN(pb + 10)) { PROBE_BEGIN(pb + 10); if (PH_ON(12)) phase_combine(F, l); if (l + 1 < NLAYER) SEAM(pb + 10); else if (PROBE_MASK & (1u << (pb + 10))) probe_acc += __builtin_amdgcn_s_memrealtime() - probe_t0; }
    }
    if (PROBE_MASK) { const unsigned long long te = __builtin_amdgcn_s_memrealtime(); while (__builtin_amdgcn_s_memrealtime() - te < probe_acc) __builtin_amdgcn_s_sleep(8); }
#undef IN
#undef SEAM
}

extern "C" void kernel_launch(void* const* d_in, const int* in_sizes, int n_in, void* d_out, int out_size, void* d_ws, size_t ws_size, hipStream_t stream) {
    static int grid = 0;
    if (grid == 0) {
        if (n_in != 23 || out_size != NB * SEQ * DM || ws_size < WS_END) { fprintf(stderr, "kernel_launch: shape mismatch: n_in %d out %d ws %zu (need %zu)\n", n_in, out_size, ws_size, (size_t)WS_END); grid = -1; return; }
        int dev = 0, cus = 0, per_cu = 0;
        if (hipGetDevice(&dev) != hipSuccess || hipDeviceGetAttribute(&cus, hipDeviceAttributeMultiprocessorCount, dev) != hipSuccess) { grid = -1; return; }
        if (hipFuncSetAttribute((const void*)fwd_kernel, hipFuncAttributeMaxDynamicSharedMemorySize, LDS_BYTES) != hipSuccess) { fprintf(stderr, "kernel_launch: hipFuncSetAttribute failed\n"); grid = -1; return; }
        if (hipOccupancyMaxActiveBlocksPerMultiprocessor(&per_cu, (const void*)fwd_kernel, 512, LDS_BYTES) != hipSuccess || per_cu < 1) { fprintf(stderr, "kernel_launch: occupancy query says %d\n", per_cu); }
        (void)hipGetLastError();
        grid = cus;
    }
    if (grid < 0) return;
    if (hipMemsetAsync((char*)d_ws + WS_CTL, 0, CTL_ZERO_BYTES, stream) != hipSuccess) return;
    Args a{};
    for (int i = 0; i < 23; ++i) a.in[i] = (const float*)d_in[i];
    a.out = (float*)d_out; a.ws = (unsigned char*)d_ws;
#if MK_PER_PHASE
    for (int p = 0; p < N_PHASES; ++p) { a.ph_lo = p; a.ph_hi = p + 1; hipLaunchKernelGGL(fwd_kernel, dim3(grid), dim3(512), LDS_BYTES, stream, a); }
#else
    a.ph_lo = 0; a.ph_hi = N_PHASES;
    hipLaunchKernelGGL(fwd_kernel, dim3(grid), dim3(512), LDS_BYTES, stream, a);
#endif
    const hipError_t le = hipPeekAtLastError();
    if (le != hipSuccess) fprintf(stderr, "kernel_launch: launch failed: %s\n", hipGetErrorName(le));
}
```

```cpp
#include <hip/hip_runtime.h>
#include <cstdio>
#include <cstdint>

#define LAS __attribute__((address_space(3)))
#define GAS __attribute__((address_space(1)))
typedef unsigned short bf16_t;
typedef short bf16x8 __attribute__((ext_vector_type(8)));
typedef short s16x4 __attribute__((ext_vector_type(4)));
typedef float f32x2 __attribute__((ext_vector_type(2)));
typedef float f32x4 __attribute__((ext_vector_type(4)));
typedef float f32x16 __attribute__((ext_vector_type(16)));
typedef unsigned u32x2 __attribute__((ext_vector_type(2)));
typedef unsigned u32x4 __attribute__((ext_vector_type(4)));
typedef int i32x4 __attribute__((ext_vector_type(4)));
typedef int i32x8 __attribute__((ext_vector_type(8)));

#ifndef MK_PER_PHASE
#define MK_PER_PHASE 0
#endif
#ifndef PHASE_MASK
#define PHASE_MASK 0x1fff
#endif
#define PH_ON(k) (((PHASE_MASK) >> (k)) & 1)
#ifndef FP8_L0
#define FP8_L0 1
#endif
#ifndef FP8_L1
#define FP8_L1 1
#endif
#ifndef PROBE_MASK
#define PROBE_MASK 0u
#endif
#ifndef DBG_STOP
#define DBG_STOP 0
#endif

constexpr int DM = 2048, NB = 4, SEQ = 4096, CTXL = 256, TPB = SEQ + CTXL, NTOK = NB * TPB;
constexpr int INW = 3584, NE = 16, NLAYER = 2, NMOD = 6 * DM;
constexpr int C_QA = 0, C_KA = 768, C_VA = 1024, C_UB = 1280, C_VB = 1792, C_QC = 2304, C_KC = 3072, C_VC = 3328;
constexpr int O_A = 0, O_B = 768, O_C = 1280;
constexpr int CAP_L = 512, CAP_C = 32, ROWS_E = 2304;
constexpr float EPS = 1e-6f;

constexpr size_t MiB = 1u << 20;
constexpr size_t WS_CTL = 0, CTL_ZERO_BYTES = 65536;
constexpr size_t WS_MOD = 1 * MiB;
constexpr size_t WS_ROPE = 2 * MiB;
constexpr size_t WS_AFFL = 3 * MiB;
constexpr size_t WS_AFFC = 4 * MiB;
constexpr size_t WS_POSL = 5 * MiB;
constexpr size_t WS_POSC = 6 * MiB;
constexpr size_t WS_OFFS = 10 * MiB;
constexpr size_t WS_GATE = 8 * MiB;
constexpr size_t WS_WRT = 9 * MiB;
constexpr size_t WS_WIN = 16 * MiB;
constexpr size_t WS_WOUT = WS_WIN + (size_t)2 * INW * DM * 2;
constexpr size_t WS_WGU = WS_WOUT + (size_t)2 * DM * DM * 2;
constexpr size_t WS_WD = WS_WGU + (size_t)2 * NE * 4096 * DM * 2;
constexpr size_t WS_HN = WS_WD + (size_t)2 * NE * DM * DM * 2;
constexpr size_t WS_P = WS_HN + (size_t)NTOK * DM * 2;
constexpr size_t WS_O = WS_P + (size_t)NTOK * INW * 2;
constexpr size_t WS_XB = WS_O + (size_t)NTOK * DM * 2;
constexpr size_t WS_XG = WS_XB + (size_t)NTOK * DM * 4;
constexpr size_t WS_H = WS_XG + (size_t)NE * ROWS_E * DM * 2;
constexpr size_t WS_HN8 = WS_H + (size_t)NE * ROWS_E * DM * 2;
constexpr size_t WS_END = WS_HN8 + (size_t)NTOK * DM;
constexpr float W8_SCALE = 32.f; constexpr int W8_SCALE_E8M0 = 127 - 5;
constexpr int CW_BAR = 4096, CW_QUEUE = 8192;

constexpr int RING_BYTES = 131072, LDSCTL_OFF = RING_BYTES, MISC_OFF = LDSCTL_OFF + 320, LDS_BYTES = 147456;

#define LDS_WAIT() asm volatile("s_waitcnt lgkmcnt(0)" ::: "memory")
#define VM_WAIT() asm volatile("s_waitcnt vmcnt(0)" ::: "memory")
__device__ __forceinline__ unsigned f2bf(float f) { unsigned u = __builtin_bit_cast(unsigned, f); return (u + 0x7fffu + ((u >> 16) & 1u)) >> 16; }
__device__ __forceinline__ unsigned pk2(float lo, float hi) { return f2bf(lo) | (f2bf(hi) << 16); }
__device__ __forceinline__ float bf2f(unsigned short b) { return __builtin_bit_cast(float, ((unsigned)b) << 16); }
__device__ __forceinline__ float bflo(unsigned w) { return __builtin_bit_cast(float, w << 16); }
__device__ __forceinline__ float bfhi(unsigned w) { return __builtin_bit_cast(float, w & 0xffff0000u); }
__device__ __forceinline__ float clamp448(float x) { return __builtin_fminf(__builtin_fmaxf(x, -448.f), 448.f); }
__device__ __forceinline__ unsigned pk4_fp8(float a, float b, float c, float d) {
    int r = __builtin_amdgcn_cvt_pk_fp8_f32(clamp448(a), clamp448(b), 0, false); r = __builtin_amdgcn_cvt_pk_fp8_f32(clamp448(c), clamp448(d), r, true); return (unsigned)r; }
__device__ __forceinline__ int opaque_tid() { int t = threadIdx.x; asm volatile("" : "+v"(t)); return t; }
__device__ __forceinline__ float row16_sum(float v) {
    v += __builtin_bit_cast(float, __builtin_amdgcn_update_dpp(0, __builtin_bit_cast(int, v), 0xB1, 0xF, 0xF, true));
    v += __builtin_bit_cast(float, __builtin_amdgcn_update_dpp(0, __builtin_bit_cast(int, v), 0x4E, 0xF, 0xF, true));
    v += __builtin_bit_cast(float, __builtin_amdgcn_update_dpp(0, __builtin_bit_cast(int, v), 0x141, 0xF, 0xF, true));
    v += __builtin_bit_cast(float, __builtin_amdgcn_update_dpp(0, __builtin_bit_cast(int, v), 0x140, 0xF, 0xF, true));
    return v;
}
__device__ __forceinline__ float wave_sum(float v) {
    v = row16_sum(v);
    const int iv = __builtin_bit_cast(int, v);
    const float a = __builtin_bit_cast(float, __builtin_amdgcn_readlane(iv, 0)), b = __builtin_bit_cast(float, __builtin_amdgcn_readlane(iv, 16));
    const float c = __builtin_bit_cast(float, __builtin_amdgcn_readlane(iv, 32)), d = __builtin_bit_cast(float, __builtin_amdgcn_readlane(iv, 48));
    return (a + b) + (c + d);
}
__device__ __forceinline__ float rsqrt_fast(float x) { return __builtin_amdgcn_rsqf(x); }
__device__ __forceinline__ float gelu_tanh(float x) {
    const float u = 0.7978845608028654f * (x + 0.044715f * x * x * x);
    const float e = __expf(2.f * u);
    const float th = 1.f - 2.f / (e + 1.f);
    return 0.5f * x * (1.f + th);
}

#define XB_TMO      128
#define XB_XCNT(j)  (256  + 64 * (j))
#define XB_XSUB(j)  (1280 + 64 * (j))
#define XB_XGEN(j)  (2304 + 64 * (j))
#define XB_TOP      3328
#define XB_TOPGEN   3392
#define XCD_BAR_WORDS 3456
#define XB_SPIN_CAP (1u << 18)
__device__ __forceinline__ unsigned xb_ld(unsigned* p)              { return __hip_atomic_load(p, __ATOMIC_RELAXED, __HIP_MEMORY_SCOPE_AGENT); }
__device__ __forceinline__ unsigned xb_add(unsigned* p, unsigned v) { return __hip_atomic_fetch_add(p, v, __ATOMIC_RELAXED, __HIP_MEMORY_SCOPE_AGENT); }
__device__ __forceinline__ unsigned xb_xcc_id() { return (unsigned)__builtin_amdgcn_s_getreg((3 << 11) | 20) & 0xFu; }
#define XB_SPIN(cond, bar) do { unsigned _sp = 0; while (cond) { __builtin_amdgcn_s_sleep(1); \
    if ((++_sp & 255u) == 0u) { if (xb_ld(&(bar)[XB_TMO])) break; if (_sp > XB_SPIN_CAP) { atomicAdd(&(bar)[XB_TMO], 1u); break; } } } } while (0)
struct XcdBarrier { unsigned* bar; unsigned x; volatile LAS unsigned* st; };
__device__ __forceinline__ XcdBarrier xcd_barrier_post(unsigned* bar, volatile LAS unsigned* st) {
    XcdBarrier b; b.bar = bar; b.x = xb_xcc_id(); b.st = st;
    if (threadIdx.x == 0) (void)xb_add(&bar[XB_XCNT(b.x)], 1u);
    return b;
}
__device__ __forceinline__ void xcd_barrier_complete(unsigned* bar, unsigned x, unsigned& nloc, unsigned& nx) {
    const unsigned G = gridDim.x * gridDim.y * gridDim.z;
    unsigned sum, cnt, mine, sp = 0u;
    for (;;) {
        sum = 0u; cnt = 0u; mine = 0u;
#pragma unroll
        for (unsigned j = 0; j < 16; ++j) { const unsigned c = xb_ld(&bar[XB_XCNT(j)]); sum += c; cnt += (c > 0u) ? 1u : 0u; mine = (j == x) ? c : mine; }
        if (sum == G) break;
        __builtin_amdgcn_s_sleep(1);
        if ((++sp & 255u) == 0u) { if (xb_ld(&bar[XB_TMO])) break; if (sp > XB_SPIN_CAP) { atomicAdd(&bar[XB_TMO], 1u); break; } }
    }
    nloc = mine > 0u ? mine : 1u; nx = cnt > 0u ? cnt : 1u;
}
template <bool FIRST>
__device__ __forceinline__ void xcd_barrier_t(const XcdBarrier& b) {
    asm volatile("s_waitcnt vmcnt(0)" ::: "memory");
    __syncthreads();
    if (threadIdx.x == 0) {
        unsigned* bar = b.bar;
        asm volatile("" : "+s"(bar));
        __builtin_amdgcn_s_waitcnt(0);
        unsigned nloc = b.st[0], nx = b.st[1];
        if constexpr (FIRST) { if (nloc == 0u) { xcd_barrier_complete(bar, b.x, nloc, nx); b.st[0] = nloc; b.st[1] = nx; } }
        const unsigned old = xb_add(&bar[XB_XSUB(b.x)], 1u);
        const unsigned gen = old / nloc;
        if (old + 1u == (gen + 1u) * nloc) {
            __builtin_amdgcn_fence(__ATOMIC_RELEASE, "agent");
            asm volatile("s_waitcnt vmcnt(0)" ::: "memory");
            const unsigned og = xb_add(&bar[XB_TOP], 1u);
            const unsigned tg = og / nx;
            if (og + 1u == (tg + 1u) * nx) xb_add(&bar[XB_TOPGEN], 1u);
            else XB_SPIN(xb_ld(&bar[XB_TOPGEN]) == tg, bar);
            __builtin_amdgcn_fence(__ATOMIC_ACQUIRE, "agent");
            xb_add(&bar[XB_XGEN(b.x)], 1u);
            asm volatile("s_waitcnt vmcnt(0)" ::: "memory");
        } else {
            XB_SPIN(xb_ld(&bar[XB_XGEN(b.x)]) == gen, bar);
            __builtin_amdgcn_fence(__ATOMIC_ACQUIRE, "agent");
            asm volatile("s_waitcnt vmcnt(0)" ::: "memory");
        }
    }
    __syncthreads();
}
__device__ __forceinline__ void xcd_barrier(const XcdBarrier& b) { xcd_barrier_t<false>(b); }
__device__ __forceinline__ void xcd_barrier_first(const XcdBarrier& b) { xcd_barrier_t<true>(b); }

namespace pg8 {
constexpr int BM = 256, BK = 64, HALF = 128, HTB = HALF * BK * 2, STAGE_BYTES = 8 * HTB, NXCD = 8, WGM = 8;
constexpr int GK = 2048;
__host__ __device__ __forceinline__ int lds_byte(int r, int c) { const int st = (r >> 4) * 2 + (c >> 5), rr = r & 15, cc = c & 31, ob = rr * 64 + cc * 2; return st * 1024 + (ob ^ (((ob >> 9) & 1) << 5)); }
__host__ __device__ __forceinline__ void stage_rc(int b, int& R, int& C) { const int st = b / 1024, sb = b % 1024, swz = sb ^ (((sb >> 9) & 1) << 5); R = (st >> 1) * 16 + swz / 64; C = (st & 1) * 32 + (swz % 64) / 2; }
__host__ __device__ __forceinline__ int perm32(int rho) { const int n = rho >> 4, i = rho & 15; return 8 * (i >> 2) + 4 * n + (i & 3); }

struct Unit { int pm, pn, e, rowbase, colbase, oidx; const char* a; const char* b; };

struct SchedDense {
    static constexpr int RB = GK * 2;
    const char* A; const char* Bt; int nM, nN, nwg, G, c, skipctx;
    __device__ void init(const void* A_, const void* Bt_, int nM_, int nN_, int G_, int c_, int skipctx_) { A = (const char*)A_; Bt = (const char*)Bt_; nM = nM_; nN = nN_; nwg = nM * nN; G = G_; c = c_; skipctx = skipctx_; }
    __device__ bool next(int i, Unit& u) const {
        const long L = (long)i * G + c; if (L >= nwg) return false;
        int wgid = (int)L; { const int q = nwg / NXCD, r = nwg % NXCD, xcd = wgid % NXCD, off = wgid / NXCD; wgid = (xcd < r ? xcd * (q + 1) : r * (q + 1) + (xcd - r) * q) + off; }
        const int nig = WGM * nN, gid = wgid / nig, fm = gid * WGM, gsz = (nM - fm) < WGM ? (nM - fm) : WGM;
        int pm = fm + ((wgid % nig) % gsz); const int pn = (wgid % nig) / gsz;
        if (skipctx) pm = (pm >> 4) * 17 + 1 + (pm & 15);
        u.pm = pm; u.pn = pn; u.e = 0; u.rowbase = pm * BM; u.colbase = pn * BM; u.oidx = 0;
        u.a = A + (size_t)pm * (BM * GK * 2); u.b = Bt + (size_t)pn * (BM * GK * 2); return true;
    }
};
template <int RB_> struct SchedGrouped {
    static constexpr int RB = RB_;
    const char* A; const char* Bt; int nMe, nNe, nwg, G, c;
    __device__ void init(const void* A_, const void* Bt_, int nMe_, int nNe_, int G_, int c_) { A = (const char*)A_; Bt = (const char*)Bt_; nMe = nMe_; nNe = nNe_; nwg = NE * nMe * nNe; G = G_; c = c_; }
    __device__ bool next(int i, Unit& u) const {
        const long L = (long)i * G + c; if (L >= nwg) return false;
        const int per = nMe * nNe, e = (int)L / per, rem = (int)L % per, pm = rem % nMe, pn = rem / nMe;
        u.pm = pm; u.pn = pn; u.e = e; u.rowbase = e * ROWS_E + pm * BM; u.colbase = pn * BM; u.oidx = e * 9 + pm;
        u.a = A + (size_t)(e * ROWS_E + pm * BM) * RB; u.b = Bt + ((size_t)e * nNe + pn) * (BM * RB); return true;
    }
};

__device__ __forceinline__ unsigned cvt_pk_bf16(float lo, float hi) { unsigned r; asm volatile("v_cvt_pk_bf16_f32 %0, %1, %2" : "=v"(r) : "v"(lo), "v"(hi)); return r; }

struct EpiStoreBf16 {
    static constexpr bool PERM = true;
    bf16_t* O; int ldc;
    __device__ __forceinline__ void operator()(const f32x4 (&acc)[2][2][4][2], const Unit& u, int wr, int wc, int fr, int fq) const {
        const int row0 = u.rowbase + wr * 64 + fr, col0 = u.colbase + wc * 32 + 8 * fq;
#pragma unroll
        for (int ai = 0; ai < 2; ++ai)
#pragma unroll
            for (int m = 0; m < 4; ++m) { bf16_t* rowp = O + (size_t)(row0 + ai * HALF + m * 16) * ldc + col0;
#pragma unroll
                for (int bj = 0; bj < 2; ++bj) { const f32x4 v0 = acc[ai][bj][m][0], v1 = acc[ai][bj][m][1];
                    u32x4 w; w.x = cvt_pk_bf16(v0[0], v0[1]); w.y = cvt_pk_bf16(v0[2], v0[3]); w.z = cvt_pk_bf16(v1[0], v1[1]); w.w = cvt_pk_bf16(v1[2], v1[3]);
                    *(u32x4*)(rowp + bj * HALF) = w; } }
    }
};
struct EpiPost {
    static constexpr bool PERM = true;
    bf16_t* P; const float* rope; const float* qna; const float* kna; const float* qnc; const float* knc; const float* vnb; LAS unsigned char* tab;
    __device__ __forceinline__ void operator()(f32x4 (&acc)[2][2][4][2], const Unit& u, int wr, int wc, int fr, int fq) const {
        const int tb = u.pm % 17; const bool lat = tb != 0;
        const int d0 = 64 * (wc >> 1) + 16 * (wc & 1) + 4 * fq, rl0 = wr * 64 + fr;
        int typ[2]; const float* gain[2];
#pragma unroll
        for (int bj = 0; bj < 2; ++bj) { const int slot = 2 * u.pn + bj;
            typ[bj] = (slot < 8) ? 3 : (slot < 10) ? 0 : (slot < 14) ? 1 : (slot < 18) ? 2 : (slot < 26) ? 3 : 0;
            gain[bj] = (slot < 6) ? qna : (slot < 8) ? kna : (slot < 18) ? vnb + ((slot - 14) & 3) * 128 : (slot < 24) ? qnc : knc; }
        const bool anynorm = typ[0] >= 2 || typ[1] >= 2;
#pragma unroll
        for (int bj = 0; bj < 2; ++bj) if (typ[bj] == 1 || typ[bj] == 2) {
#pragma unroll
            for (int ai = 0; ai < 2; ++ai)
#pragma unroll
                for (int m = 0; m < 4; ++m)
#pragma unroll
                    for (int n = 0; n < 2; ++n)
#pragma unroll
                        for (int j = 0; j < 4; ++j) acc[ai][bj][m][n][j] = gelu_tanh(acc[ai][bj][m][n][j]); }
        if (anynorm) {
#pragma unroll
            for (int bj = 0; bj < 2; ++bj) if (typ[bj] >= 2) {
#pragma unroll
                for (int ai = 0; ai < 2; ++ai)
#pragma unroll
                    for (int m = 0; m < 4; ++m) { const f32x4 a = acc[ai][bj][m][0], b = acc[ai][bj][m][1];
                        float ss = ((a.x * a.x + a.y * a.y) + (a.z * a.z + a.w * a.w)) + ((b.x * b.x + b.y * b.y) + (b.z * b.z + b.w * b.w));
                        ss += __builtin_bit_cast(float, __builtin_amdgcn_ds_swizzle(__builtin_bit_cast(int, ss), 0x401F));
                        { auto rr = __builtin_amdgcn_permlane32_swap(__float_as_uint(ss), __float_as_uint(ss), false, false); ss = __uint_as_float(rr[0]) + __uint_as_float(rr[1]); }
                        if (fq == 0) *(LAS float*)(tab + (((rl0 + ai * HALF + m * 16) * 2 + bj) * 4 + wc) * 4) = ss; } }
            asm volatile("s_waitcnt lgkmcnt(0)" ::: "memory"); __builtin_amdgcn_s_barrier(); asm volatile("" ::: "memory");
        }
#pragma unroll
        for (int bj = 0; bj < 2; ++bj) {
            const int slot = 2 * u.pn + bj;
            f32x4 g0 = (f32x4){1.f, 1.f, 1.f, 1.f}, g1 = g0;
            if (typ[bj] >= 2) { g0 = *(const f32x4*)(gain[bj] + d0); g1 = *(const f32x4*)(gain[bj] + d0 + 32); }
#pragma unroll
            for (int ai = 0; ai < 2; ++ai)
#pragma unroll
                for (int m = 0; m < 4; ++m) { const int rl = rl0 + ai * HALF + m * 16;
                    f32x4 a = acc[ai][bj][m][0], b = acc[ai][bj][m][1];
                    if (typ[bj] >= 2) { const f32x4 t = *(const LAS f32x4*)(tab + ((rl * 2 + bj) * 4) * 4);
                        const float rinv = rsqrt_fast(((t.x + t.y) + (t.z + t.w)) * (1.f / 128) + EPS);
                        a = a * rinv * g0; b = b * rinv * g1; }
                    if (typ[bj] == 3 && lat) { const int pos = (tb - 1) * 256 + rl, pp = (wc >> 1) ? (pos & 63) : (pos >> 6);
                        const f32x4* cs = (const f32x4*)(rope + 2 * (pp * 32 + 16 * (wc & 1) + 4 * fq)); const f32x4 c0 = cs[0], c1 = cs[1];
                        const f32x4 cv = (f32x4){c0.x, c0.z, c1.x, c1.z}, sv = (f32x4){c0.y, c0.w, c1.y, c1.w};
                        const f32x4 ra = a * cv - b * sv, rb = b * cv + a * sv; a = ra; b = rb; }
                    bf16_t* rowp = P + (size_t)(u.rowbase + rl) * INW + slot * 128 + d0;
                    u32x2 w0, w1; w0.x = cvt_pk_bf16(a.x, a.y); w0.y = cvt_pk_bf16(a.z, a.w); w1.x = cvt_pk_bf16(b.x, b.y); w1.y = cvt_pk_bf16(b.z, b.w);
                    *(u32x2*)rowp = w0; *(u32x2*)(rowp + 32) = w1; }
        }
    }
};
struct EpiResid {
    static constexpr bool PERM = false;
    const float* ctxbase; const float* latbase; int cbs, lbs;
    float* xout; const float* modl;
    __device__ __forceinline__ void operator()(const f32x4 (&acc)[2][2][4][2], const Unit& u, int wr, int wc, int fr, int fq) const {
        const int b = u.pm / 17, tb = u.pm % 17;
        const float* src = (tb == 0) ? ctxbase + (size_t)b * cbs * DM : latbase + ((size_t)b * lbs + (size_t)(tb - 1) * 256) * DM;
        const float* g1 = modl + (size_t)((tb == 0) ? 4 : b) * NMOD + 2 * DM;
        const int rl0 = wr * 64 + fr, col0 = u.colbase + wc * 32 + 4 * fq;
        f32x4 gv[2][2];
#pragma unroll
        for (int bj = 0; bj < 2; ++bj)
#pragma unroll
            for (int n = 0; n < 2; ++n) gv[bj][n] = *(const f32x4*)(g1 + col0 + bj * HALF + n * 16);
#pragma unroll
        for (int ai = 0; ai < 2; ++ai)
#pragma unroll
            for (int m = 0; m < 4; ++m) { const int rl = rl0 + ai * HALF + m * 16; const float* sp = src + (size_t)rl * DM + col0; float* dp = xout + (size_t)(u.rowbase + rl) * DM + col0;
#pragma unroll
                for (int bj = 0; bj < 2; ++bj)
#pragma unroll
                    for (int n = 0; n < 2; ++n) { const f32x4 xv = *(const f32x4*)(sp + bj * HALF + n * 16); *(f32x4*)(dp + bj * HALF + n * 16) = xv + gv[bj][n] * acc[ai][bj][m][n]; }
                if (m & 1) asm volatile("" ::: "memory"); }
    }
};
struct EpiSwiGLU {
    static constexpr bool PERM = true;
    bf16_t* Hout;
    __device__ __forceinline__ void operator()(const f32x4 (&acc)[2][2][4][2], const Unit& u, int wr, int wc, int fr, int fq) const {
        const int row0 = u.rowbase + wr * 64 + fr, col0 = u.pn * HALF + wc * 32 + 8 * fq;
#pragma unroll
        for (int ai = 0; ai < 2; ++ai)
#pragma unroll
            for (int m = 0; m < 4; ++m) { bf16_t* rowp = Hout + (size_t)(row0 + ai * HALF + m * 16) * DM + col0; float h[8];
#pragma unroll
                for (int n = 0; n < 2; ++n)
#pragma unroll
                    for (int j = 0; j < 4; ++j) { const float g = acc[ai][0][m][n][j], up = acc[ai][1][m][n][j]; h[n * 4 + j] = g * __builtin_amdgcn_rcpf(1.f + __expf(-g)) * up; }
                u32x4 w; w.x = cvt_pk_bf16(h[0], h[1]); w.y = cvt_pk_bf16(h[2], h[3]); w.z = cvt_pk_bf16(h[4], h[5]); w.w = cvt_pk_bf16(h[6], h[7]);
                *(u32x4*)rowp = w; }
    }
};
struct EpiSwiGLU8 {
    static constexpr bool PERM = true;
    unsigned char* Hout;
    __device__ __forceinline__ void operator()(const f32x4 (&acc)[2][2][4][2], const Unit& u, int wr, int wc, int fr, int fq) const {
        const int row0 = u.rowbase + wr * 64 + fr, col0 = u.pn * HALF + wc * 32 + 8 * fq;
#pragma unroll
        for (int ai = 0; ai < 2; ++ai)
#pragma unroll
            for (int m = 0; m < 4; ++m) { unsigned char* rowp = Hout + (size_t)(row0 + ai * HALF + m * 16) * DM + col0; float h[8];
#pragma unroll
                for (int n = 0; n < 2; ++n)
#pragma unroll
                    for (int j = 0; j < 4; ++j) { const float g = acc[ai][0][m][n][j], up = acc[ai][1][m][n][j]; h[n * 4 + j] = g * __builtin_amdgcn_rcpf(1.f + __expf(-g)) * up; }
                u32x2 w; w.x = pk4_fp8(h[0], h[1], h[2], h[3]); w.y = pk4_fp8(h[4], h[5], h[6], h[7]);
                *(u32x2*)rowp = w; }
    }
};
struct EpiDown {
    static constexpr bool PERM = true;
    bf16_t* Y; const float* gatev;
    __device__ __forceinline__ void operator()(const f32x4 (&acc)[2][2][4][2], const Unit& u, int wr, int wc, int fr, int fq) const {
        const int row0 = u.rowbase + wr * 64 + fr, col0 = u.colbase + wc * 32 + 8 * fq;
#pragma unroll
        for (int ai = 0; ai < 2; ++ai)
#pragma unroll
            for (int m = 0; m < 4; ++m) { const int row = row0 + ai * HALF + m * 16; const float gt = gatev[row]; bf16_t* rowp = Y + (size_t)row * DM + col0;
#pragma unroll
                for (int bj = 0; bj < 2; ++bj) { const f32x4 v0 = acc[ai][bj][m][0] * gt, v1 = acc[ai][bj][m][1] * gt;
                    u32x4 w; w.x = cvt_pk_bf16(v0[0], v0[1]); w.y = cvt_pk_bf16(v0[2], v0[3]); w.z = cvt_pk_bf16(v1[0], v1[1]); w.w = cvt_pk_bf16(v1[2], v1[3]);
                    *(u32x4*)(rowp + bj * HALF) = w; } }
    }
};

template <class Epi, class Sched, bool FP8 = false, bool GATHER = false, bool ALIGN_EPI = true, bool SP2 = true>
__device__ __forceinline__ void gemm_phase(LAS unsigned char* lds, const Sched& S, const Epi& E, const unsigned* goffs = nullptr, LAS unsigned char* goffs_lds = nullptr) {
    static_assert(!GATHER || SP2, "gather mode is written for the SP2 loop");
    static_assert(Sched::RB == (FP8 ? GK : GK * 2), "operand row bytes");
    const int tid = opaque_tid(), wid = __builtin_amdgcn_readfirstlane(tid >> 6), lane = tid & 63, wr = wid >> 2, wc = wid & 3, fr = lane & 15, fq = lane >> 4;
    constexpr int RB = Sched::RB, nt = RB / 128;
    unsigned voffA[2], voffB[2];
#pragma unroll
    for (int i = 0; i < 2; ++i) { int R, C; stage_rc(tid * 16 + i * 8192, R, C); const int Rb = Epi::PERM ? ((R & ~31) + perm32(R & 31)) : R;
        voffA[i] = (unsigned)(R * RB + C * 2); voffB[i] = (unsigned)(Rb * RB + C * 2); }
    const size_t kstep = (size_t)(BK * 2);
    const size_t hstep = (size_t)HALF * RB;
    const unsigned ldsw = (unsigned)wid * 1024u;
    const int aoff = lds_byte(wr * 64 + fr, fq * 8), boff = lds_byte(wc * 32 + fr, fq * 8);
#define PG8_SA(b, h) (((b) * 2 + (h)) * HTB)
#define PG8_SB(b, h) ((4 + (b) * 2 + (h)) * HTB)
#define PG8_STAGE(bufoff, gbase, voff) do { _Pragma("unroll") for (int _i = 0; _i < 2; ++_i) \
        __builtin_amdgcn_global_load_lds((const unsigned*)((const char*)(gbase) + (voff)[_i]), (LAS unsigned*)(lds + (bufoff) + ldsw + _i * 8192), 16, 0, 0); } while (0)
#define PG8_RD8(p) __builtin_shufflevector(*(const LAS i32x4*)(p), *(const LAS i32x4*)((p) + 1024), 0, 1, 2, 3, 4, 5, 6, 7)
#define PG8_LDA(dst, b, h) do { _Pragma("unroll") for (int m = 0; m < 4; ++m) { if constexpr (FP8) dst##8[m] = PG8_RD8(lds + PG8_SA(b, h) + aoff + m * 2048); \
        else { _Pragma("unroll") for (int k = 0; k < 2; ++k) dst[m][k] = *(const LAS bf16x8*)(lds + PG8_SA(b, h) + aoff + m * 2048 + k * 1024); } } } while (0)
#define PG8_LDB(dst, b, h) do { _Pragma("unroll") for (int n = 0; n < 2; ++n) { if constexpr (FP8) dst##8[n] = PG8_RD8(lds + PG8_SB(b, h) + boff + n * 2048); \
        else { _Pragma("unroll") for (int k = 0; k < 2; ++k) dst[n][k] = *(const LAS bf16x8*)(lds + PG8_SB(b, h) + boff + n * 2048 + k * 1024); } } } while (0)
#define PG8_MMA(ai, bj, At, Bt) do { __builtin_amdgcn_s_setprio(1); _Pragma("unroll") for (int m = 0; m < 4; ++m) _Pragma("unroll") for (int n = 0; n < 2; ++n) { \
        if constexpr (FP8) asm volatile("v_mfma_scale_f32_16x16x128_f8f6f4 %0, %1, %2, %0, %3, %4 op_sel_hi:[0,0,0]" : "+v"(acc[ai][bj][m][n]) : "v"(Bt##8[n]), "v"(At##8[m]), "v"(sclW), "v"(sclX)); \
        else { _Pragma("unroll") for (int k = 0; k < 2; ++k) acc[ai][bj][m][n] = __builtin_amdgcn_mfma_f32_16x16x32_bf16(Bt[n][k], At[m][k], acc[ai][bj][m][n], 0, 0, 0); } } \
        __builtin_amdgcn_s_setprio(0); } while (0)
#define PG8_WAIT_V(n) asm volatile("s_waitcnt vmcnt(" #n ")" ::: "memory")
#define PG8_WAIT_L(n) asm volatile("s_waitcnt lgkmcnt(" #n ")" ::: "memory")
#define PG8_BAR __builtin_amdgcn_s_barrier()
#define PG8_SCHED __builtin_amdgcn_sched_barrier(0)
    Unit cur, nxt; int ui = 0;
    if (!S.next(0, cur)) return;
    u32x4 gC = (u32x4){0u, 0u, 0u, 0u}, gN = gC;
    if constexpr (GATHER) gC = *(const u32x4*)(goffs + ((size_t)cur.oidx * 512 + tid) * 4);
#define PG8_GSTAGE(bufoff, gbase, o0, o1) do { \
        __builtin_amdgcn_global_load_lds((const unsigned*)((const char*)(gbase) + (o0)), (LAS unsigned*)(lds + (bufoff) + ldsw), 16, 0, 0); \
        __builtin_amdgcn_global_load_lds((const unsigned*)((const char*)(gbase) + (o1)), (LAS unsigned*)(lds + (bufoff) + ldsw + 8192), 16, 0, 0); } while (0)
    f32x4 acc[2][2][4][2];
#pragma unroll
    for (int a = 0; a < 2; ++a)
#pragma unroll
        for (int b = 0; b < 2; ++b)
#pragma unroll
            for (int m = 0; m < 4; ++m)
#pragma unroll
                for (int n = 0; n < 2; ++n) acc[a][b][m][n] = (f32x4){0.f, 0.f, 0.f, 0.f};
    const int sclW = W8_SCALE_E8M0 * 0x01010101, sclX = 0x7f7f7f7f; (void)sclW; (void)sclX;
    bf16x8 At[4][2], B0[2][2], B1[2][2]; i32x8 At8[4], B08[2], B18[2];
    const char* cA = cur.a; const char* cB = cur.b;
    if constexpr (SP2) {
        PG8_STAGE(PG8_SB(0, 0), cB, voffB); PG8_STAGE(PG8_SB(0, 1), cB + hstep, voffB);
        if constexpr (GATHER) { PG8_GSTAGE(PG8_SA(0, 0), S.A, gC.x, gC.y); PG8_GSTAGE(PG8_SA(0, 1), S.A, gC.z, gC.w); }
        else { PG8_STAGE(PG8_SA(0, 0), cA, voffA); PG8_STAGE(PG8_SA(0, 1), cA + hstep, voffA); }
        if (wr == 1) PG8_BAR;
        PG8_WAIT_V(2); PG8_BAR;
        PG8_STAGE(PG8_SB(1, 0), cB + kstep, voffB);
        if constexpr (GATHER) PG8_GSTAGE(PG8_SA(1, 0), S.A + kstep, gC.x, gC.y); else PG8_STAGE(PG8_SA(1, 0), cA + kstep, voffA);
        PG8_STAGE(PG8_SB(1, 1), cB + hstep + kstep, voffB);
        PG8_WAIT_V(6); PG8_BAR;
    } else {
        PG8_STAGE(PG8_SB(0, 0), cB, voffB); PG8_STAGE(PG8_SA(0, 0), cA, voffA); PG8_STAGE(PG8_SB(0, 1), cB + hstep, voffB); PG8_STAGE(PG8_SA(0, 1), cA + hstep, voffA);
        if (wr == 1) PG8_BAR;
        PG8_WAIT_V(4); PG8_BAR;
        PG8_STAGE(PG8_SB(1, 0), cB + kstep, voffB); PG8_STAGE(PG8_SA(1, 0), cA + kstep, voffA); PG8_STAGE(PG8_SB(1, 1), cB + hstep + kstep, voffB);
        PG8_WAIT_V(6); PG8_BAR;
    }
    for (;;) {
        const bool has_next = S.next(ui + 1, nxt);
        const char* nA = has_next ? nxt.a : cA; const char* nB = has_next ? nxt.b : cB;
        if constexpr (GATHER) { if (has_next)
            __builtin_amdgcn_global_load_lds((const unsigned*)(goffs + ((size_t)nxt.oidx * 512 + tid) * 4), (LAS unsigned*)(goffs_lds + ldsw), 16, 0, 0); }
        for (int t = 0; t < nt; t += 2) {
            const bool last = (t == nt - 2);
            const char* a1 = cA + (size_t)(t + 1) * kstep;
            const char* a2 = last ? nA : cA + (size_t)(t + 2) * kstep; const char* b2 = last ? nB : cB + (size_t)(t + 2) * kstep;
            const char* a3 = a2 + kstep; const char* b3 = b2 + kstep;
            const char* g1 = S.A + (size_t)(t + 1) * kstep; const char* g2 = S.A + (last ? (size_t)0 : (size_t)(t + 2) * kstep); const char* g3 = g2 + kstep;
            u32x4 gX = gC;
            if constexpr (GATHER) { if (last) { if (has_next) gN = *(const LAS u32x4*)(goffs_lds + (size_t)tid * 16); else gN = gC; gX = gN; } }
            if constexpr (SP2) {
            PG8_LDB(B0, 0, 0); PG8_LDB(B1, 0, 1); PG8_SCHED; PG8_LDA(At, 0, 0);
            if constexpr (GATHER) PG8_GSTAGE(PG8_SA(1, 1), g1, gC.z, gC.w); else PG8_STAGE(PG8_SA(1, 1), a1 + hstep, voffA);
            PG8_WAIT_V(8); PG8_WAIT_L(0); PG8_BAR; PG8_MMA(0, 0, At, B0); PG8_MMA(0, 1, At, B1); PG8_BAR; PG8_SCHED;
            PG8_LDA(At, 0, 1); PG8_STAGE(PG8_SB(0, 0), b2, voffB); PG8_STAGE(PG8_SB(0, 1), b2 + hstep, voffB);
            if constexpr (GATHER) PG8_GSTAGE(PG8_SA(0, 0), g2, gX.x, gX.y); else PG8_STAGE(PG8_SA(0, 0), a2, voffA);
            PG8_WAIT_V(8); PG8_WAIT_L(0); PG8_BAR; PG8_MMA(1, 0, At, B0); PG8_MMA(1, 1, At, B1); PG8_BAR; PG8_SCHED;
            PG8_LDB(B0, 1, 0); PG8_LDB(B1, 1, 1); PG8_SCHED; PG8_LDA(At, 1, 0);
            if constexpr (GATHER) PG8_GSTAGE(PG8_SA(0, 1), g2, gX.z, gX.w); else PG8_STAGE(PG8_SA(0, 1), a2 + hstep, voffA);
            PG8_WAIT_V(8); PG8_WAIT_L(0); PG8_BAR; PG8_MMA(0, 0, At, B0); PG8_MMA(0, 1, At, B1); PG8_BAR; PG8_SCHED;
            PG8_LDA(At, 1, 1); PG8_STAGE(PG8_SB(1, 0), b3, voffB); PG8_STAGE(PG8_SB(1, 1), b3 + hstep, voffB);
            if constexpr (GATHER) PG8_GSTAGE(PG8_SA(1, 0), g3, gX.x, gX.y); else PG8_STAGE(PG8_SA(1, 0), a3, voffA);
            PG8_WAIT_V(8); PG8_WAIT_L(0); PG8_BAR; PG8_MMA(1, 0, At, B0); PG8_MMA(1, 1, At, B1); PG8_BAR; PG8_SCHED;
            } else {
            PG8_LDB(B0, 0, 0); PG8_SCHED; PG8_LDA(At, 0, 0); PG8_STAGE(PG8_SA(1, 1), a1 + hstep, voffA);
            PG8_WAIT_L(8); PG8_BAR; PG8_WAIT_L(0); PG8_MMA(0, 0, At, B0); PG8_BAR; PG8_SCHED;
            PG8_LDB(B1, 0, 1); PG8_STAGE(PG8_SB(0, 0), b2, voffB);
            PG8_BAR; PG8_WAIT_L(0); PG8_MMA(0, 1, At, B1); PG8_BAR;
            PG8_LDA(At, 0, 1); PG8_STAGE(PG8_SA(0, 0), a2, voffA);
            PG8_BAR; PG8_WAIT_L(0); PG8_MMA(1, 0, At, B0); PG8_BAR; PG8_SCHED;
            PG8_STAGE(PG8_SB(0, 1), b2 + hstep, voffB);
            PG8_WAIT_V(6); PG8_BAR; PG8_MMA(1, 1, At, B1); PG8_BAR;
            PG8_LDB(B0, 1, 0); PG8_SCHED; PG8_LDA(At, 1, 0); PG8_STAGE(PG8_SA(0, 1), a2 + hstep, voffA);
            PG8_WAIT_L(8); PG8_BAR; PG8_WAIT_L(0); PG8_MMA(0, 0, At, B0); PG8_BAR; PG8_SCHED;
            PG8_LDB(B1, 1, 1); PG8_STAGE(PG8_SB(1, 0), b3, voffB);
            PG8_BAR; PG8_WAIT_L(0); PG8_MMA(0, 1, At, B1); PG8_BAR;
            PG8_LDA(At, 1, 1); PG8_STAGE(PG8_SA(1, 0), a3, voffA);
            PG8_BAR; PG8_WAIT_L(0); PG8_MMA(1, 0, At, B0); PG8_BAR; PG8_SCHED;
            PG8_STAGE(PG8_SB(1, 1), b3 + hstep, voffB);
            PG8_WAIT_V(6); PG8_BAR; PG8_MMA(1, 1, At, B1); PG8_BAR;
            }
        }
        if constexpr (ALIGN_EPI) { if (wr == 0) PG8_BAR; }
        if constexpr (FP8) asm volatile("s_nop 15\n\ts_nop 15\n\ts_nop 7" ::: "memory");
        E(acc, cur, wr, wc, fr, fq);
        if (!has_next) break;
#pragma unroll
        for (int a = 0; a < 2; ++a)
#pragma unroll
            for (int b = 0; b < 2; ++b)
#pragma unroll
                for (int m = 0; m < 4; ++m)
#pragma unroll
                    for (int n = 0; n < 2; ++n) acc[a][b][m][n] = (f32x4){0.f, 0.f, 0.f, 0.f};
        cur = nxt; cA = nA; cB = nB; ++ui; gC = gN;
        if constexpr (ALIGN_EPI) { if (wr == 1) PG8_BAR; }
    }
    PG8_WAIT_V(0);
    if constexpr (!ALIGN_EPI) { if (wr == 0) PG8_BAR; }
    PG8_BAR;
#undef PG8_SA
#undef PG8_SB
#undef PG8_STAGE
#undef PG8_GSTAGE
#undef PG8_LDA
#undef PG8_LDB
#undef PG8_MMA
#undef PG8_RD8
#undef PG8_WAIT_V
#undef PG8_WAIT_L
#undef PG8_BAR
#undef PG8_SCHED
}
}

namespace at {
constexpr int D = 128, NW = 8, QBLK = 32, KVBLK = 64;
constexpr float SCALE = 0.088388347648318440f;
constexpr float THR = 8.f;
constexpr int LDQ = INW, LDK = INW, LDO = DM;
constexpr size_t SHM_V = KVBLK * D * 2, SHM_K = KVBLK * D * 2, SHM_ATTN = 2 * SHM_V + 2 * SHM_K + NW * 64 * 4;
#define KSWZ(row, colB) ((row) * 256 + ((colB) ^ (((row) & 7) << 4)))
#define SBAR() __builtin_amdgcn_sched_barrier(0)
__device__ __forceinline__ int crow(int r, int hi) { return (r & 3) + 8 * (r >> 2) + 4 * hi; }
__device__ __forceinline__ unsigned cvtpk(float lo, float hi) { unsigned r; asm volatile("v_cvt_pk_bf16_f32 %0, %1, %2" : "=v"(r) : "v"(lo), "v"(hi)); return r; }

__device__ __forceinline__ void partialSM(f32x16& p0, f32x16& p1, float& m_reg, float& mn, float& alpha, bool domask, int dq, int hi) {
  constexpr float C = SCALE * 1.4426950408889634f;
  {
    if (domask) {
#pragma unroll
      for (int r = 0; r < 16; ++r) { const int d0 = dq + crow(r, hi), d1 = d0 + 32;
        if (d0 > 128 || d0 < -128) p0[r] = -1e30f;
        if (d1 > 128 || d1 < -128) p1[r] = -1e30f; }
    }
  }
  float pmax = p0[0]; for (int r = 1; r < 16; ++r) pmax = fmaxf(pmax, p0[r]); for (int r = 0; r < 16; ++r) pmax = fmaxf(pmax, p1[r]);
  { auto rr = __builtin_amdgcn_permlane32_swap(__float_as_uint(pmax), __float_as_uint(pmax), false, false);
    pmax = fmaxf(__uint_as_float(rr[0]), __uint_as_float(rr[1])); }
  if (__builtin_expect(__all(pmax - m_reg <= THR / SCALE), 1)) { mn = m_reg; alpha = 1.f; }
  else { mn = fmaxf(m_reg, pmax); alpha = __builtin_amdgcn_exp2f((m_reg - mn) * C); m_reg = mn; }
  float mnC = -mn * C;
  for (int r = 0; r < 16; ++r) p0[r] = fmaf(p0[r], C, mnC); for (int r = 0; r < 16; ++r) p1[r] = fmaf(p1[r], C, mnC);
  for (int r = 0; r < 16; ++r) p0[r] = __builtin_amdgcn_exp2f(p0[r]);
}
__device__ __forceinline__ void finishSM(f32x16& p0, f32x16& p1, float alpha, float& l_reg, bf16x8& pa0, bf16x8& pa1, bf16x8& pa2, bf16x8& pa3) {
  for (int r = 0; r < 16; ++r) p1[r] = __builtin_amdgcn_exp2f(p1[r]);
  float ps = 0; for (int r = 0; r < 16; ++r) ps += p0[r]; for (int r = 0; r < 16; ++r) ps += p1[r];
  { auto rr = __builtin_amdgcn_permlane32_swap(__float_as_uint(ps), __float_as_uint(ps), false, false);
    ps = __uint_as_float(rr[0]) + __uint_as_float(rr[1]); }
  l_reg = l_reg * alpha + ps;
#define PK4(P, BASE, OUT) do { unsigned a0 = cvtpk(P[BASE + 0], P[BASE + 1]), a1 = cvtpk(P[BASE + 2], P[BASE + 3]);   \
    unsigned b0 = cvtpk(P[BASE + 4], P[BASE + 5]), b1 = cvtpk(P[BASE + 6], P[BASE + 7]);                              \
    auto r0 = __builtin_amdgcn_permlane32_swap(a0, b0, false, false); auto r1 = __builtin_amdgcn_permlane32_swap(a1, b1, false, false); \
    u32x4 w = {r0[0], r1[0], r0[1], r1[1]}; OUT = *reinterpret_cast<bf16x8*>(&w); } while (0)
  PK4(p0, 0, pa0); PK4(p0, 8, pa1); PK4(p1, 0, pa2); PK4(p1, 8, pa3);
#undef PK4
}
__device__ __forceinline__ void qkt(f32x16& p0, f32x16& p1, const char* Ks, const bf16x8* qr, int ka0) {
  p0 = f32x16{}; p1 = f32x16{};
  asm volatile("" : "+v"(ka0));
#pragma unroll
  for (int d0 = 0; d0 < 8; ++d0) { const int off = ka0 ^ (d0 * 32);
    bf16x8 b0 = *reinterpret_cast<const bf16x8*>(Ks + off);
    bf16x8 b1 = *reinterpret_cast<const bf16x8*>(Ks + off + 32 * 256);
    p0 = __builtin_amdgcn_mfma_f32_32x32x16_bf16(b0, qr[d0], p0, 0, 0, 0);
    p1 = __builtin_amdgcn_mfma_f32_32x32x16_bf16(b1, qr[d0], p1, 0, 0, 0); }
}
__device__ __forceinline__ int v_st(int k, int c) { const int kk = (k & ~0xC) | ((k & 4) << 1) | ((k & 8) >> 1); return ((kk >> 3) * 4 + (c >> 5)) * 512 + ((kk & 7) * 32 + (c & 31)) * 2; }
__device__ __forceinline__ int v_rd_base(int lane) { return ((lane & 3) << 3) | (((lane >> 2) & 3) << 6) | (((lane >> 4) & 1) << 5) | (((lane >> 5) & 1) << 8); }
constexpr int v_rd_off(int d0, int ks, int half) { return d0 * 512 + ks * 4096 + half * 2048; }
template <int OFF> __device__ __forceinline__ s16x4 tr_read(int vb) {
  s16x4 r; asm volatile("ds_read_b64_tr_b16 %0, %1 offset:%2" : "=&v"(r) : "v"(vb), "i"(OFF) : "memory"); return r;
}
template <int D0> __device__ __forceinline__ void pv_one(f32x16& od, int vb, bf16x8 pa0, bf16x8 pa1, bf16x8 pa2, bf16x8 pa3) {
  const s16x4 l0 = tr_read<v_rd_off(D0, 0, 0)>(vb), h0 = tr_read<v_rd_off(D0, 0, 1)>(vb), l1 = tr_read<v_rd_off(D0, 1, 0)>(vb), h1 = tr_read<v_rd_off(D0, 1, 1)>(vb);
  const s16x4 l2 = tr_read<v_rd_off(D0, 2, 0)>(vb), h2 = tr_read<v_rd_off(D0, 2, 1)>(vb), l3 = tr_read<v_rd_off(D0, 3, 0)>(vb), h3 = tr_read<v_rd_off(D0, 3, 1)>(vb);
  asm volatile("s_waitcnt lgkmcnt(0)" ::: "memory"); SBAR();
#define PK(L, H) (bf16x8){L[0], L[1], L[2], L[3], H[0], H[1], H[2], H[3]}
  od = __builtin_amdgcn_mfma_f32_32x32x16_bf16(pa0, PK(l0, h0), od, 0, 0, 0);
  od = __builtin_amdgcn_mfma_f32_32x32x16_bf16(pa1, PK(l1, h1), od, 0, 0, 0);
  od = __builtin_amdgcn_mfma_f32_32x32x16_bf16(pa2, PK(l2, h2), od, 0, 0, 0);
  od = __builtin_amdgcn_mfma_f32_32x32x16_bf16(pa3, PK(l3, h3), od, 0, 0, 0);
#undef PK
}
__device__ __forceinline__ void pv_d0(f32x16* o, int vb, bf16x8 pa0, bf16x8 pa1, bf16x8 pa2, bf16x8 pa3) {
  pv_one<0>(o[0], vb, pa0, pa1, pa2, pa3); pv_one<1>(o[1], vb, pa0, pa1, pa2, pa3); pv_one<2>(o[2], vb, pa0, pa1, pa2, pa3); pv_one<3>(o[3], vb, pa0, pa1, pa2, pa3);
}

__device__ __forceinline__ void attn_body(const bf16_t* __restrict__ Qb, const bf16_t* __restrict__ Kb, const bf16_t* __restrict__ Vb, bf16_t* __restrict__ Ob,
                                          int NT, int kskip, int qpos0, float m0, float l0, bool maskon, char* lds) {
  const int tid = opaque_tid(), wid = tid >> 6, lane = tid & 63, r32 = lane & 31, hi = lane >> 5;
  char* V_lds = lds; char* K_lds = lds + 2 * SHM_V;
  float* ws = (float*)(lds + 2 * SHM_V + 2 * SHM_K) + wid * 64; float* li_l = ws; float* al_l = ws + 32;
  float m_reg = m0, l_reg = l0; f32x16 o[4] = {}; bf16x8 qr[8];
  const bf16_t* Qw = Qb + (long)(wid * QBLK + r32) * LDQ + hi * 8;
#pragma unroll
  for (int d0 = 0; d0 < 8; ++d0) qr[d0] = *reinterpret_cast<const bf16x8*>(Qw + d0 * 16);
  const int sr = tid >> 4, sc = (tid & 15) * 8, vst0 = v_st(sr, sc), vst1 = v_st(32 + sr, sc);
  const int vb0 = (int)(uintptr_t)V_lds + v_rd_base(lane);
  const int qpos = qpos0 + wid * QBLK + r32;
  const int ka0 = r32 * 256 + ((hi * 16) ^ ((r32 & 7) << 4));
  const unsigned goff0 = (unsigned)(sr * LDK + sc) * 2u, goff1 = goff0 + 32u * LDK * 2u;
  struct { bf16x8 vs0, vs1, ks0, ks1; } sr_[2];
#define TROW(jt) ((long)(jt) * KVBLK + ((jt) >= 4 ? kskip : 0))
#define SLOAD(i, jt) do { const long _k0 = TROW(jt) * (LDK * 2); const char* _kp = (const char*)Kb + _k0; const char* _vp = (const char*)Vb + _k0; \
    sr_[i].vs0 = *reinterpret_cast<const bf16x8*>(_vp + goff0); sr_[i].vs1 = *reinterpret_cast<const bf16x8*>(_vp + goff1); \
    sr_[i].ks0 = *reinterpret_cast<const bf16x8*>(_kp + goff0); sr_[i].ks1 = *reinterpret_cast<const bf16x8*>(_kp + goff1); } while (0)
#define SWRITE(b, i) do { *(bf16x8*)(V_lds + (b) * SHM_V + vst0) = sr_[i].vs0;          \
    *(bf16x8*)(V_lds + (b) * SHM_V + vst1) = sr_[i].vs1; int kc = sc * 2;               \
    *(bf16x8*)(K_lds + (b) * SHM_K + KSWZ(sr, kc)) = sr_[i].ks0;                       \
    *(bf16x8*)(K_lds + (b) * SHM_K + KSWZ(32 + sr, kc)) = sr_[i].ks1; } while (0)
#define SWAIT() asm volatile("s_waitcnt vmcnt(4)" ::: "memory")
#define RESC(a) do { if (__any((a) < 1.f)) { if (hi == 0) al_l[r32] = (a); asm volatile("s_waitcnt lgkmcnt(0)" ::: "memory"); \
    for (int d = 0; d < 4; ++d) for (int r = 0; r < 16; ++r) o[d][r] *= al_l[crow(r, hi)]; } } while (0)
#define DQ(jt) (kskip + ((jt) - 4) * KVBLK - qpos)
  f32x16 pA0, pA1, pB0, pB1; float mnA, mnB, alA, alB; bf16x8 pa0, pa1, pa2, pa3;
  constexpr int SE = 0, SO = 1;
  SLOAD(SE, 0); asm volatile("s_waitcnt vmcnt(0)" ::: "memory"); SWRITE(0, SE); __syncthreads();
  qkt(pA0, pA1, K_lds, qr, ka0); partialSM(pA0, pA1, m_reg, mnA, alA, false, 0, hi);
  SLOAD(SO, 1); if (2 < NT) SLOAD(SE, 2);
  SWAIT(); SWRITE(1, SO); __syncthreads();
  for (int j = 1; j + 1 < NT; j += 2) {
    SBAR(); qkt(pB0, pB1, K_lds + SHM_K, qr, ka0);
    finishSM(pA0, pA1, alA, l_reg, pa0, pa1, pa2, pa3); SBAR();
    SLOAD(SO, j + 2); SBAR();
    pv_d0(o, vb0, pa0, pa1, pa2, pa3); partialSM(pB0, pB1, m_reg, mnB, alB, maskon && j >= 4, DQ(j), hi);
    __syncthreads(); SWAIT(); SWRITE(0, SE);
    RESC(alB); __syncthreads();
    SBAR(); qkt(pA0, pA1, K_lds, qr, ka0);
    finishSM(pB0, pB1, alB, l_reg, pa0, pa1, pa2, pa3); SBAR();
    if (j + 3 < NT) SLOAD(SE, j + 3); SBAR();
    pv_d0(o, vb0 + (int)SHM_V, pa0, pa1, pa2, pa3); partialSM(pA0, pA1, m_reg, mnA, alA, maskon && j + 1 >= 4, DQ(j + 1), hi);
    __syncthreads(); SWAIT(); SWRITE(1, SO);
    RESC(alA); __syncthreads();
  }
  SBAR(); qkt(pB0, pB1, K_lds + SHM_K, qr, ka0);
  finishSM(pA0, pA1, alA, l_reg, pa0, pa1, pa2, pa3); SBAR();
  pv_d0(o, vb0, pa0, pa1, pa2, pa3); partialSM(pB0, pB1, m_reg, mnB, alB, maskon && NT - 1 >= 4, DQ(NT - 1), hi);
  __syncthreads(); RESC(alB);
  finishSM(pB0, pB1, alB, l_reg, pa0, pa1, pa2, pa3); SBAR();
  pv_d0(o, vb0 + (int)SHM_V, pa0, pa1, pa2, pa3);
  if (hi == 0) li_l[r32] = l_reg; asm volatile("s_waitcnt lgkmcnt(0)" ::: "memory");
  float rli[16];
#pragma unroll
  for (int r = 0; r < 16; ++r) rli[r] = __builtin_amdgcn_rcpf(li_l[crow(r, hi)]);
  bf16_t* Ow = Ob + (long)(wid * QBLK) * LDO;
#pragma unroll
  for (int r = 0; r < 16; ++r) { int orow = crow(r, hi);
    for (int d0 = 0; d0 < 4; ++d0) Ow[(long)orow * LDO + d0 * 32 + r32] = (bf16_t)f2bf(o[d0][r] * rli[r]); }
#undef TROW
#undef SLOAD
#undef SWRITE
#undef SWAIT
#undef RESC
#undef DQ
}
}

struct Args { const float* in[23]; float* out; unsigned char* ws; int ph_lo, ph_hi; };
enum { IN_X = 0, IN_C, IN_CTX, IN_CCTX, IN_WMOD, IN_BMOD, IN_N1G, IN_N2G, IN_WIN, IN_QNA, IN_KNA, IN_SINK, IN_VNB, IN_WS, IN_BS, IN_QNC, IN_KNC, IN_OUTG, IN_WOUT, IN_WR, IN_WG, IN_WU, IN_WDN };

#define PHASE_IDS(F) const int tid = opaque_tid(), lane = tid & 63, wave = __builtin_amdgcn_readfirstlane(tid >> 6), gw = (int)blockIdx.x * 8 + wave, NGW = (F).G * 8; (void)lane; (void)wave; (void)gw; (void)NGW
constexpr int ARGTAB_OFF = LDSCTL_OFF + 1024;
#define INP(F, i) ld_inp((F).lds, (i))
__device__ __forceinline__ const float* ld_inp(LAS unsigned char* lds, int i) {
    const volatile LAS unsigned* t = (const volatile LAS unsigned*)(lds + ARGTAB_OFF) + 2 * i;
    const unsigned lo = __builtin_amdgcn_readfirstlane(t[0]), hi = __builtin_amdgcn_readfirstlane(t[1]);
    return (const float*)(const GAS float*)(((unsigned long long)hi << 32) | lo);
}
struct Frame {
    LAS unsigned char* lds; char* ldsg;
    volatile LAS unsigned* MISC;
    unsigned* ctl;
    int G;
    float* out; unsigned char* ws;
};

__host__ __device__ __forceinline__ int headpos(int d) { return 32 * (2 * (d >> 6) + ((d >> 4) & 1)) + 8 * ((d >> 2) & 3) + 4 * ((d >> 5) & 1) + (d & 3); }
template <bool HEADPERM = false>
__device__ __forceinline__ void transpose_item(const float* W, int N, bf16_t* WT, int k0, int n0, int drow0, LAS float* scr, int lane) {
    { float t[32]; const float* wp = W + (size_t)(k0 + (lane >> 5)) * N + n0 + (lane & 31);
#pragma unroll
      for (int i = 0; i < 32; ++i) t[i] = wp[(size_t)(2 * i) * N];
#pragma unroll
      for (int i = 0; i < 32; ++i) scr[(2 * i + (lane >> 5)) * 33 + (lane & 31)] = t[i]; }
    LDS_WAIT(); asm volatile("" ::: "memory");
    const int c = lane & 7;
#pragma unroll
    for (int j = 0; j < 4; ++j) { const int n = (lane >> 3) + 8 * j; const LAS float* s = scr + (8 * c) * 33 + n;
        u32x4 o; o.x = pk2(s[0 * 33], s[1 * 33]); o.y = pk2(s[2 * 33], s[3 * 33]); o.z = pk2(s[4 * 33], s[5 * 33]); o.w = pk2(s[6 * 33], s[7 * 33]);
        const int drow = HEADPERM ? ((drow0 + n) & ~127) + headpos((drow0 + n) & 127) : drow0 + n;
        *(u32x4*)(WT + (size_t)drow * DM + k0 + 8 * c) = o; }
    LDS_WAIT(); asm volatile("" ::: "memory");
}

__device__ __forceinline__ void transpose_item8(const float* W, int N, unsigned char* WT, int k0, int n0, int drow0, LAS float* scr, int lane) {
    { float t[32]; const float* wp = W + (size_t)(k0 + (lane >> 5)) * N + n0 + (lane & 31);
#pragma unroll
      for (int i = 0; i < 32; ++i) t[i] = wp[(size_t)(2 * i) * N];
#pragma unroll
      for (int i = 0; i < 32; ++i) scr[(2 * i + (lane >> 5)) * 33 + (lane & 31)] = t[i]; }
    LDS_WAIT(); asm volatile("" ::: "memory");
    const int c = lane & 7;
#pragma unroll
    for (int j = 0; j < 4; ++j) { const int n = (lane >> 3) + 8 * j; const LAS float* s = scr + (8 * c) * 33 + n;
        u32x2 o; o.x = pk4_fp8(s[0 * 33] * W8_SCALE, s[1 * 33] * W8_SCALE, s[2 * 33] * W8_SCALE, s[3 * 33] * W8_SCALE); o.y = pk4_fp8(s[4 * 33] * W8_SCALE, s[5 * 33] * W8_SCALE, s[6 * 33] * W8_SCALE, s[7 * 33] * W8_SCALE);
        *(u32x2*)(WT + (size_t)(drow0 + n) * DM + k0 + 8 * c) = o; }
    LDS_WAIT(); asm volatile("" ::: "memory");
}
__device__ __forceinline__ void phase_prologue(Frame& F) {
    PHASE_IDS(F);
    LAS float* scr = (LAS float*)(F.lds + wave * 16384);
    constexpr int I_IN = 32 * (INW / 32), I_SQ = 32 * (DM / 32);
    constexpr int NIT = 2 * I_IN + 2 * I_SQ + 2 * NE * 3 * I_SQ;
    for (int it = gw; it < NIT; it += NGW) {
        int r = it;
        if (r < 2 * I_IN) { const int l = r / I_IN; r %= I_IN; const int nblk = INW / 32, kb = r / nblk, nb = r % nblk;
            transpose_item<true>(INP(F, IN_WIN) + (size_t)l * DM * INW, INW, (bf16_t*)(F.ws + WS_WIN) + (size_t)l * INW * DM, 64 * kb, 32 * nb, 32 * nb, scr, lane); continue; }
        r -= 2 * I_IN;
        if (r < 2 * I_SQ) { const int l = r / I_SQ; r %= I_SQ; const int kb = r / 64, nb = r % 64;
            transpose_item(INP(F, IN_WOUT) + (size_t)l * DM * DM, DM, (bf16_t*)(F.ws + WS_WOUT) + (size_t)l * DM * DM, 64 * kb, 32 * nb, 32 * nb, scr, lane); continue; }
        r -= 2 * I_SQ;
        const int mat = r / I_SQ; r %= I_SQ; const int kb = r / 64, nb = r % 64;
        const int le = mat / 3, which = mat % 3;
        const bool f8 = (le < NE) ? (FP8_L0 != 0) : (FP8_L1 != 0);
        if (which < 2) {
            const float* W = INP(F, which == 0 ? IN_WG : IN_WU) + (size_t)le * DM * DM; const int n0 = 32 * nb, dr = (n0 >> 7) * 256 + which * 128 + (n0 & 127);
            if (f8) transpose_item8(W, DM, (unsigned char*)(F.ws + WS_WGU) + (size_t)(le / NE) * NE * 4096 * DM * 2 + (size_t)(le % NE) * 4096 * DM, 64 * kb, n0, dr, scr, lane);
            else transpose_item(W, DM, (bf16_t*)(F.ws + WS_WGU) + (size_t)le * 4096 * DM, 64 * kb, n0, dr, scr, lane);
        } else {
            if (f8) transpose_item8(INP(F, IN_WDN) + (size_t)le * DM * DM, DM, (unsigned char*)(F.ws + WS_WD) + (size_t)(le / NE) * NE * DM * DM * 2 + (size_t)(le % NE) * DM * DM, 64 * kb, 32 * nb, 32 * nb, scr, lane);
            else transpose_item(INP(F, IN_WDN) + (size_t)le * DM * DM, DM, (bf16_t*)(F.ws + WS_WD) + (size_t)le * DM * DM, 64 * kb, 32 * nb, 32 * nb, scr, lane);
        }
    }
    __syncthreads();
    {
        LAS float* sil = (LAS float*)F.lds;
        LAS float* red = (LAS float*)(F.lds + 40960);
        bool have = false;
        for (int it = blockIdx.x; it < 2 * 96; it += F.G) {
            if (!have) {
                { const float* cp = INP(F, IN_C); const float* ccp = INP(F, IN_CCTX);
                for (int i = tid; i < 5 * DM; i += 512) { const int s = i / DM, k = i % DM; const float cv = (s < 4) ? cp[s * DM + k] : ccp[k]; sil[i] = cv / (1.f + __expf(-cv)); } }
                have = true; __syncthreads();
            }
            const int l = it / 96, cb = it % 96, c4 = tid & 31, kr = tid >> 5;
            const float* wp = INP(F, IN_WMOD) + (size_t)l * DM * NMOD + (size_t)cb * 128 + c4 * 4;
            f32x4 a[5];
#pragma unroll
            for (int s = 0; s < 5; ++s) a[s] = (f32x4){0.f, 0.f, 0.f, 0.f};
#pragma unroll 8
            for (int k = kr; k < DM; k += 16) { const f32x4 w = *(const f32x4*)(wp + (size_t)k * NMOD);
#pragma unroll
                for (int s = 0; s < 5; ++s) a[s] += w * sil[s * DM + k]; }
#pragma unroll
            for (int s = 0; s < 5; ++s) *(LAS f32x4*)(red + (kr * 5 + s) * 128 + c4 * 4) = a[s];
            __syncthreads();
            const float* bmod = INP(F, IN_BMOD);
            for (int i = tid; i < 5 * 128; i += 512) { const int s = i / 128, cc = i % 128; float sum = 0.f;
#pragma unroll
                for (int q = 0; q < 16; ++q) sum += red[(q * 5 + s) * 128 + cc];
                ((float*)(F.ws + WS_MOD))[(size_t)(l * 5 + s) * NMOD + cb * 128 + cc] = sum + bmod[l * NMOD + cb * 128 + cc]; }
            __syncthreads();
        }
    }
    if ((int)blockIdx.x >= F.G - 9 && (int)blockIdx.x < F.G - 1) {
        const float* wr = INP(F, IN_WR); float* wt = (float*)(F.ws + WS_WRT); const int part = (int)blockIdx.x - (F.G - 9);
        for (int i = part * 512 + tid; i < 2 * DM * NE; i += 8 * 512) { const int l = i / (DM * NE), rem = i % (DM * NE), k = rem >> 4, e = rem & 15; wt[(size_t)l * DM * NE + e * DM + k] = wr[i]; }
    }
    if (blockIdx.x == F.G - 1) {
        for (int i = tid; i < 64 * 32; i += 512) {
            const int pos = i >> 5, f = i & 31;
            double inv = 1.0; for (int q = 0; q < f; ++q) inv *= 0.7498942093324559;
            const double a = (double)pos * inv;
            const double n = __builtin_rint(a * 0.6366197723675814);
            const double r = (a - n * 1.5707963267948966) - n * 6.123233995736766e-17;
            const double r2 = r * r;
            double sn = r * (1.0 + r2 * (-1.0 / 6 + r2 * (1.0 / 120 + r2 * (-1.0 / 5040 + r2 * (1.0 / 362880 + r2 * (-1.0 / 39916800 + r2 * (1.0 / 6227020800.0)))))));
            double cn = 1.0 + r2 * (-0.5 + r2 * (1.0 / 24 + r2 * (-1.0 / 720 + r2 * (1.0 / 40320 + r2 * (-1.0 / 3628800 + r2 * (1.0 / 479001600 + r2 * (-1.0 / 87178291200.0)))))));
            const int q = ((int)n) & 3; double cs, ss;
            if (q == 0) { cs = cn; ss = sn; } else if (q == 1) { cs = -sn; ss = cn; } else if (q == 2) { cs = -cn; ss = -sn; } else { cs = sn; ss = -cn; }
            ((float*)(F.ws + WS_ROPE))[2 * i] = (float)cs; ((float*)(F.ws + WS_ROPE))[2 * i + 1] = (float)ss;
        }
    }
}

__device__ __forceinline__ void load_row(const float* row, int lane, f32x4 (&v)[8]) {
#pragma unroll
    for (int j = 0; j < 8; ++j) v[j] = *(const f32x4*)(row + 4 * lane + 256 * j);
}
__device__ __forceinline__ void norm_mod_store(const f32x4 (&v)[8], const float* g, const float* shift, const float* scale, bf16_t* dst, int lane) {
    float ss = 0.f;
#pragma unroll
    for (int j = 0; j < 8; ++j) ss += (v[j].x * v[j].x + v[j].y * v[j].y) + (v[j].z * v[j].z + v[j].w * v[j].w);
    const float rinv = rsqrt_fast(wave_sum(ss) * (1.f / DM) + EPS);
#pragma unroll
    for (int j = 0; j < 8; ++j) { const int c = 4 * lane + 256 * j;
        const f32x4 gg = *(const f32x4*)(g + c), sh = *(const f32x4*)(shift + c), sc = *(const f32x4*)(scale + c);
        const f32x4 y = (v[j] * rinv) * gg * (sc + 1.f) + sh;
        u32x2 w; w.x = pk2(y.x, y.y); w.y = pk2(y.z, y.w); *(u32x2*)(dst + c) = w; }
}

__device__ __forceinline__ void phase_rowpass1_l0(Frame& F) {
    PHASE_IDS(F);
    const float* mod = (const float*)(F.ws + WS_MOD);
    for (int r = gw; r < NTOK; r += NGW) {
        const int b = r / TPB, t = r % TPB, s = (t < CTXL) ? 4 : b;
        const float* src = (t < CTXL) ? INP(F, IN_CTX) + ((size_t)b * CTXL + t) * DM : INP(F, IN_X) + ((size_t)b * SEQ + (t - CTXL)) * DM;
        f32x4 v[8]; load_row(src, lane, v);
        norm_mod_store(v, INP(F, IN_N1G), mod + (size_t)s * NMOD, mod + (size_t)s * NMOD + DM, (bf16_t*)(F.ws + WS_HN) + (size_t)r * DM, lane);
    }
}

__device__ __forceinline__ void post_unpack(const u32x4 x, float (&v)[8]) {
    v[0] = bflo(x.x); v[1] = bfhi(x.x); v[2] = bflo(x.y); v[3] = bfhi(x.y); v[4] = bflo(x.z); v[5] = bfhi(x.z); v[6] = bflo(x.w); v[7] = bfhi(x.w); }
__device__ __forceinline__ float sum16(float v) { return row16_sum(v); }
__device__ __forceinline__ void phase_post(Frame& F, int l) {
    PHASE_IDS(F);
    bf16_t* P = (bf16_t*)(F.ws + WS_P);
    const float* rope = (const float*)(F.ws + WS_ROPE);
    const int i16 = lane & 15, hq = lane >> 4; const bool hi2 = hq >= 2;
    const float* qna = INP(F, IN_QNA) + l * 128 + 8 * i16; const float* kna = INP(F, IN_KNA) + l * 128 + 8 * i16;
    const float* qnc = INP(F, IN_QNC) + l * 128 + 8 * i16; const float* knc = INP(F, IN_KNC) + l * 128 + 8 * i16;
    const float* vnb = INP(F, IN_VNB) + l * 512 + 8 * i16;
    for (int r = gw; r < NTOK; r += NGW) {
        const int t = r % TPB; const bool lat = t >= CTXL;
        u32x4* rp = (u32x4*)(P + (size_t)r * INW) + lane;
        u32x4 x[7];
#pragma unroll
        for (int j = 0; j < 7; ++j) x[j] = rp[64 * j];
        const int pos = lat ? t - CTXL : 0, pp = (i16 < 8) ? (pos >> 6) : (pos & 63);
        const f32x4* cs = (const f32x4*)(rope + 2 * (pp * 32 + 8 * (i16 & 3)));
        const f32x4 c0 = cs[0], c1 = cs[1], c2 = cs[2], c3 = cs[3];
        const float cosv[8] = {c0.x, c0.z, c1.x, c1.z, c2.x, c2.z, c3.x, c3.z}, sinv[8] = {c0.y, c0.w, c1.y, c1.w, c2.y, c2.w, c3.y, c3.w};
        const float sgn = (i16 & 4) ? 1.f : -1.f;
#pragma unroll
        for (int j = 0; j < 7; ++j) {
            const bool gelu_lo = (j == 3 || j == 4), gelu_hi = (j == 2 || j == 3);
            const bool norm_lo = (j != 2 && j != 3), norm_hi = (j != 2 && j != 6);
            const bool rope_lo = (j == 0 || j == 1 || j == 5 || j == 6), rope_hi = (j == 0 || j == 1 || j == 4 || j == 5);
            const bool dg = hi2 ? gelu_hi : gelu_lo, dn = hi2 ? norm_hi : norm_lo, dr = (hi2 ? rope_hi : rope_lo) && lat;
            if (!(gelu_lo || gelu_hi || norm_lo || norm_hi)) continue;
            float v[8]; post_unpack(x[j], v);
            if (gelu_lo || gelu_hi) {
#pragma unroll
                for (int e = 0; e < 8; ++e) { const float gv = gelu_tanh(v[e]); v[e] = dg ? gv : v[e]; } }
            if (norm_lo || norm_hi) {
                float ss = 0.f;
#pragma unroll
                for (int e = 0; e < 8; ++e) ss += v[e] * v[e];
                const float rinv = rsqrt_fast(sum16(ss) * (1.f / 128) + EPS);
                const float* gp;
                if (j == 0) gp = qna; else if (j == 1) gp = hi2 ? kna : qna; else if (j == 3) gp = vnb + (hi2 ? hq - 2 : 0) * 128; else if (j == 4) gp = hi2 ? qnc : vnb + (2 + hq) * 128;
                else if (j == 5) gp = qnc; else gp = knc;
                const f32x4 g0 = *(const f32x4*)gp, g1 = *(const f32x4*)(gp + 4);
                const float gg[8] = {g0.x, g0.y, g0.z, g0.w, g1.x, g1.y, g1.z, g1.w};
#pragma unroll
                for (int e = 0; e < 8; ++e) v[e] = dn ? v[e] * rinv * gg[e] : v[e];
            }
            if (rope_lo || rope_hi) {
#pragma unroll
                for (int e = 0; e < 8; ++e) { const float o = __builtin_bit_cast(float, __builtin_amdgcn_ds_swizzle(__builtin_bit_cast(int, v[e]), 0x101F)); const float rv = v[e] * cosv[e] + sgn * o * sinv[e]; v[e] = dr ? rv : v[e]; } }
            u32x4 w; w.x = pk2(v[0], v[1]); w.y = pk2(v[2], v[3]); w.z = pk2(v[4], v[5]); w.w = pk2(v[6], v[7]);
            rp[64 * j] = w;
        }
    }
}

__device__ __forceinline__ void mixer_b_unit(Frame& F, int l, int b, int ch, int g) {
    PHASE_IDS(F);
    const bf16_t* P = (const bf16_t*)(F.ws + WS_P); bf16_t* O = (bf16_t*)(F.ws + WS_O);
    const int row0 = b * TPB + ch * 128, w = wave;
    LAS bf16_t* VT = (LAS bf16_t*)F.lds;
    { const int q = tid >> 2, dp = (tid & 3) * 32; const bf16_t* src = P + (size_t)(row0 + q) * INW + C_VB + g * 128 + dp;
#pragma unroll
      for (int i = 0; i < 4; ++i) { const u32x4 x = *(const u32x4*)(src + 8 * i); const unsigned xs[4] = {x.x, x.y, x.z, x.w};
#pragma unroll
          for (int j = 0; j < 4; ++j) { VT[(dp + 8 * i + 2 * j) * 136 + q] = (bf16_t)(xs[j] & 0xffffu); VT[(dp + 8 * i + 2 * j + 1) * 136 + q] = (bf16_t)(xs[j] >> 16); } } }
    __syncthreads();
    const int i15 = lane & 15, kq = lane >> 4;
    f32x4 acc[8];
#pragma unroll
    for (int n = 0; n < 8; ++n) acc[n] = (f32x4){0.f, 0.f, 0.f, 0.f};
    const float* wsr = INP(F, IN_WS) + ((size_t)(l * 4 + g) * 128 + 16 * w + i15) * 128;
#pragma unroll
    for (int s = 0; s < 4; ++s) {
        const f32x4 a0 = *(const f32x4*)(wsr + 32 * s + 8 * kq), a1 = *(const f32x4*)(wsr + 32 * s + 8 * kq + 4);
        u32x4 aw; aw.x = pk2(a0.x, a0.y); aw.y = pk2(a0.z, a0.w); aw.z = pk2(a1.x, a1.y); aw.w = pk2(a1.z, a1.w);
        const bf16x8 af = *reinterpret_cast<bf16x8*>(&aw);
#pragma unroll
        for (int n = 0; n < 8; ++n) { const bf16x8 bfr = *(const LAS bf16x8*)(VT + (16 * n + i15) * 136 + 32 * s + 8 * kq);
            acc[n] = __builtin_amdgcn_mfma_f32_16x16x32_bf16(af, bfr, acc[n], 0, 0, 0); }
    }
#pragma unroll
    for (int j = 0; j < 4; ++j) { const int p = 16 * w + kq * 4 + j; const float bias = INP(F, IN_BS)[(l * 4 + g) * 128 + p];
        const bf16_t* up = P + (size_t)(row0 + p) * INW + C_UB + g * 128; bf16_t* op = O + (size_t)(row0 + p) * DM + O_B + g * 128;
#pragma unroll
        for (int n = 0; n < 8; ++n) { const int d = 16 * n + i15; op[d] = (bf16_t)f2bf(bf2f(up[d]) * (acc[n][j] + bias)); } }
    __syncthreads();
}
__device__ __forceinline__ void phase_mixers(Frame& F, int l) {
    PHASE_IDS(F);
    const bf16_t* P = (const bf16_t*)(F.ws + WS_P); bf16_t* O = (bf16_t*)(F.ws + WS_O);
    const bool ctx = (l == 0);
    const int nC = 384, nA = 384, nCc = ctx ? 24 : 0, nAc = ctx ? 24 : 0, nB = 4 * 4 * 34;
    const int total = nC + nA + nCc + nAc + nB;
    unsigned* qctr = F.ctl + CW_QUEUE + 64 * l;
    for (;;) {
        if (tid == 0) F.MISC[0] = xb_add(qctr, 1u);
        __syncthreads();
        int u = (int)F.MISC[0];
        __syncthreads();
        if (u >= total) break;
        if (u < nC + nA + nCc + nAc) {
            int kind, b, h, qb = 0;
            if (u < nC) { kind = 0; b = u / 96; h = (u % 96) / 16; qb = u % 16; }
            else if (u < nC + nA) { const int v = u - nC; kind = 1; b = v / 96; h = (v % 96) / 16; qb = v % 16; }
            else if (u < nC + nA + nCc) { const int v = u - nC - nA; kind = 2; b = v / 6; h = v % 6; }
            else { const int v = u - nC - nA - nCc; kind = 3; b = v / 6; h = v % 6; }
            const int kv = h / 3, isA = kind & 1, lat = (kind < 2);
            const size_t r0 = (size_t)b * TPB, rq = r0 + (lat ? CTXL + qb * 256 : 0);
            const int q0 = qb * 256, ks = (kind == 1) ? ((q0 - 128 < 0) ? 0 : q0 - 128) : 0, ke = (q0 + 384 > SEQ) ? SEQ : q0 + 384;
            const int NT = (kind == 0) ? 68 : (kind == 1) ? 4 + (ke - ks) / 64 : 4;
            const float sink = INP(F, IN_SINK)[l * 6 + h];
            const int cq = (isA ? C_QA : C_QC) + h * 128, ck = (isA ? C_KA : C_KC) + kv * 128, cv = (isA ? C_VA : C_VC) + kv * 128, co = (isA ? O_A : O_C) + h * 128;
            at::attn_body(P + rq * INW + cq, P + r0 * INW + ck, P + r0 * INW + cv, O + rq * DM + co, NT, ks, q0, isA ? sink / at::SCALE : -1e30f, isA ? 1.f : 0.f, kind == 1, F.ldsg);
            continue; }
        u -= nC + nA + nCc;
        u -= nAc;
        { const int b = u / 136, ch = (u % 136) / 4, g = u % 4;
          if (!ctx && ch < 2) continue;
          mixer_b_unit(F, l, b, ch, g); }
    }
}

__device__ __forceinline__ void phase_groupnorm(Frame& F, int l) {
    PHASE_IDS(F);
    bf16_t* O = (bf16_t*)(F.ws + WS_O); const float* og = INP(F, IN_OUTG) + l * DM;
    for (int r = gw; r < NTOK; r += NGW) {
        if (l == 1 && (r % TPB) < CTXL) continue;
        bf16_t* row = O + (size_t)r * DM;
        u32x2 x[8];
#pragma unroll
        for (int i = 0; i < 3; ++i) { x[i] = *(const u32x2*)(row + O_A + 12 * lane + 4 * i); x[5 + i] = *(const u32x2*)(row + O_C + 12 * lane + 4 * i); }
#pragma unroll
        for (int i = 0; i < 2; ++i) x[3 + i] = *(const u32x2*)(row + O_B + 8 * lane + 4 * i);
        float v[8][4]; float ss[3] = {0.f, 0.f, 0.f};
#pragma unroll
        for (int i = 0; i < 8; ++i) { v[i][0] = bflo(x[i].x); v[i][1] = bfhi(x[i].x); v[i][2] = bflo(x[i].y); v[i][3] = bfhi(x[i].y);
            const int grp = (i < 3) ? 0 : (i < 5) ? 1 : 2; ss[grp] += (v[i][0] * v[i][0] + v[i][1] * v[i][1]) + (v[i][2] * v[i][2] + v[i][3] * v[i][3]); }
        float rinv[3];
        rinv[0] = rsqrt_fast(wave_sum(ss[0]) * (1.f / 768) + EPS); rinv[1] = rsqrt_fast(wave_sum(ss[1]) * (1.f / 512) + EPS); rinv[2] = rsqrt_fast(wave_sum(ss[2]) * (1.f / 768) + EPS);
#pragma unroll
        for (int i = 0; i < 8; ++i) { const int grp = (i < 3) ? 0 : (i < 5) ? 1 : 2;
            const int c = (grp == 0) ? O_A + 12 * lane + 4 * i : (grp == 1) ? O_B + 8 * lane + 4 * (i - 3) : O_C + 12 * lane + 4 * (i - 5);
            const f32x4 gg = *(const f32x4*)(og + c); const float ri = rinv[grp];
            u32x2 w; w.x = pk2(v[i][0] * ri * gg.x, v[i][1] * ri * gg.y); w.y = pk2(v[i][2] * ri * gg.z, v[i][3] * ri * gg.w); *(u32x2*)(row + c) = w; }
    }
}

__device__ __forceinline__ void phase_rowpass2(Frame& F, int l) {
    PHASE_IDS(F);
    const float* mod = (const float*)(F.ws + WS_MOD) + (size_t)l * 5 * NMOD;
    const float* xb = (const float*)(F.ws + WS_XB);
    LAS float* wl = (LAS float*)F.lds;
    { const u32x4* wt = (const u32x4*)((const float*)(F.ws + WS_WRT) + (size_t)l * DM * NE) + tid; u32x4 t[16];
#pragma unroll
      for (int i = 0; i < 16; ++i) t[i] = wt[512 * i];
#pragma unroll
      for (int i = 0; i < 16; ++i) ((LAS u32x4*)wl)[tid + 512 * i] = t[i]; }
    __syncthreads();
    const float* g = INP(F, IN_N2G) + l * DM;
    const bool f8 = (l == 0) ? (FP8_L0 != 0) : (FP8_L1 != 0);
    for (int r = gw; r < NTOK; r += NGW) {
        const int b = r / TPB, t = r % TPB, s = (t < CTXL) ? 4 : b;
        if (l == 1 && t < CTXL) continue;
        f32x4 v[8]; load_row(xb + (size_t)r * DM, lane, v);
        float ss = 0.f;
#pragma unroll
        for (int j = 0; j < 8; ++j) ss += (v[j].x * v[j].x + v[j].y * v[j].y) + (v[j].z * v[j].z + v[j].w * v[j].w);
        const float rinv = rsqrt_fast(wave_sum(ss) * (1.f / DM) + EPS);
        const float* shift = mod + (size_t)s * NMOD + 3 * DM; const float* scale = shift + DM;
        bf16_t* dst = (bf16_t*)(F.ws + WS_HN) + (size_t)r * DM;
#pragma unroll
        for (int j = 0; j < 8; ++j) { const int c = 4 * lane + 256 * j;
            const f32x4 gg = *(const f32x4*)(g + c), sh = *(const f32x4*)(shift + c), sc = *(const f32x4*)(scale + c);
            v[j] = (v[j] * rinv) * gg * (sc + 1.f) + sh;
            if (f8) *(unsigned*)((unsigned char*)(F.ws + WS_HN8) + (size_t)r * DM + c) = pk4_fp8(v[j].x, v[j].y, v[j].z, v[j].w);
            else { u32x2 w; w.x = pk2(v[j].x, v[j].y); w.y = pk2(v[j].z, v[j].w); *(u32x2*)(dst + c) = w; } }
        float lg[16];
#pragma unroll
        for (int e = 0; e < 16; ++e) { float a = 0.f;
#pragma unroll
            for (int j = 0; j < 8; ++j) { const f32x4 w = *(const LAS f32x4*)(wl + e * DM + 4 * lane + 256 * j); a += (v[j].x * w.x + v[j].y * w.y) + (v[j].z * w.z + v[j].w * w.w); }
            lg[e] = wave_sum(a); }
        float mx = lg[0];
#pragma unroll
        for (int e = 1; e < 16; ++e) mx = fmaxf(mx, lg[e]);
        float den = 0.f, mine = 0.f;
#pragma unroll
        for (int e = 0; e < 16; ++e) { const float ex = __expf(lg[e] - mx); den += ex; mine = (lane == e) ? ex : mine; }
        if (lane < 16) {
            const float a = mine / den;
            if (t < CTXL) ((float*)(F.ws + WS_AFFC))[((size_t)b * NE + lane) * CTXL + t] = a;
            else ((float*)(F.ws + WS_AFFL))[((size_t)b * NE + lane) * SEQ + (t - CTXL)] = a;
        }
    }
    __syncthreads();
}

__device__ __forceinline__ unsigned block_excl_scan(unsigned v, LAS unsigned* scr, int lane, int wave, unsigned& total) {
    unsigned inc = v;
#pragma unroll
    for (int o = 1; o < 64; o <<= 1) { const unsigned t = __shfl_up(inc, o); if (lane >= o) inc += t; }
    if (lane == 63) scr[wave] = inc;
    __syncthreads();
    unsigned base = 0, tot = 0;
#pragma unroll
    for (int w = 0; w < 8; ++w) { const unsigned x = scr[w]; base += (w < wave) ? x : 0u; tot += x; }
    __syncthreads();
    total = tot;
    return base + inc - v;
}
__device__ __forceinline__ void phase_topk(Frame& F, int l) {
    PHASE_IDS(F);
    LAS unsigned* hist = (LAS unsigned*)F.lds;
    LAS unsigned* scr = (LAS unsigned*)(F.lds + 8192);
    LAS int* rowsrc = (LAS int*)(F.lds + 8192 + 128);
    const int nunits = (l == 0) ? 128 : 64;
    const bool f8 = (l == 0) ? (FP8_L0 != 0) : (FP8_L1 != 0); const int RBg = f8 ? DM : 2 * DM;
    for (int u = blockIdx.x; u < nunits; u += F.G) {
        const bool isc = u >= 64; const int uu = isc ? u - 64 : u, b = uu / NE, e = uu % NE;
        const int N = isc ? CTXL : SEQ; const unsigned cap = isc ? CAP_C : CAP_L;
        const float* src = isc ? (const float*)(F.ws + WS_AFFC) + (size_t)uu * CTXL : (const float*)(F.ws + WS_AFFL) + (size_t)uu * SEQ;
        int* pos = isc ? (int*)(F.ws + WS_POSC) + (size_t)uu * CTXL : (int*)(F.ws + WS_POSL) + (size_t)uu * SEQ;
        const bool own = tid * 8 < N;
        unsigned key[8];
        { u32x4 k0 = (u32x4){0u, 0u, 0u, 0u}, k1 = k0; if (own) { k0 = *(const u32x4*)(src + tid * 8); k1 = *(const u32x4*)(src + tid * 8 + 4); }
          key[0] = k0.x; key[1] = k0.y; key[2] = k0.z; key[3] = k0.w; key[4] = k1.x; key[5] = k1.y; key[6] = k1.z; key[7] = k1.w; }
        unsigned prefix = 0u, remaining = cap;
#pragma unroll
        for (int p = 0; p < 3; ++p) {
            const int shift = (p == 0) ? 21 : (p == 1) ? 10 : 0, bits = (p == 2) ? 10 : 11, nb = 1 << bits;
            for (int i = tid; i < nb; i += 512) hist[i] = 0u;
            __syncthreads();
            if (own) {
#pragma unroll
                for (int q = 0; q < 8; ++q) { const bool cand = (p == 0) ? true : ((key[q] >> (shift + bits)) == prefix);
                    if (cand) (void)__hip_atomic_fetch_add(&hist[(key[q] >> shift) & (nb - 1)], 1u, __ATOMIC_RELAXED, __HIP_MEMORY_SCOPE_WORKGROUP); } }
            __syncthreads();
            unsigned c[4];
#pragma unroll
            for (int q = 0; q < 4; ++q) c[q] = (4 * tid + q < nb) ? hist[4 * tid + q] : 0u;
            const unsigned sm = (c[0] + c[1]) + (c[2] + c[3]);
            unsigned total; const unsigned ex = block_excl_scan(sm, scr, lane, wave, total);
            unsigned above = total - (ex + sm);
#pragma unroll
            for (int q = 3; q >= 0; --q) { if (above < remaining && remaining <= above + c[q]) { scr[16] = (unsigned)(4 * tid + q); scr[17] = above; } above += c[q]; }
            __syncthreads();
            const unsigned B = scr[16], ca = scr[17];
            remaining -= ca; prefix = (prefix << bits) | B;
            __syncthreads();
        }
        const unsigned T = prefix;
        unsigned ce = 0u;
#pragma unroll
        for (int q = 0; q < 8; ++q) ce += (own && key[q] == T) ? 1u : 0u;
        unsigned tot; unsigned er = block_excl_scan(ce, scr, lane, wave, tot);
        bool sel[8]; unsigned cs = 0u;
#pragma unroll
        for (int q = 0; q < 8; ++q) { const bool eq = own && key[q] == T; sel[q] = own && (key[q] > T || (eq && er < remaining)); er += eq ? 1u : 0u; cs += sel[q] ? 1u : 0u; }
        unsigned sl = block_excl_scan(cs, scr, lane, wave, tot);
        const int slotbase = e * ROWS_E + (isc ? 2048 + b * CAP_C : b * CAP_L);
        int pv[8];
#pragma unroll
        for (int q = 0; q < 8; ++q) { pv[q] = sel[q] ? (int)sl : -1;
            if (sel[q]) { rowsrc[sl] = b * TPB + (isc ? 0 : CTXL) + tid * 8 + q; ((float*)(F.ws + WS_GATE))[slotbase + sl] = __uint_as_float(key[q]); ++sl; } }
        if (own) { *(i32x4*)(pos + tid * 8) = (i32x4){pv[0], pv[1], pv[2], pv[3]}; *(i32x4*)(pos + tid * 8 + 4) = (i32x4){pv[4], pv[5], pv[6], pv[7]}; }
        __syncthreads();
        unsigned* offs = (unsigned*)(F.ws + WS_OFFS);
        int R[2], C[2];
#pragma unroll
        for (int i = 0; i < 2; ++i) pg8::stage_rc(tid * 16 + i * 8192, R[i], C[i]);
        if (!isc) {
#pragma unroll
            for (int th = 0; th < 2; ++th) { u32x4 o;
                o.x = (unsigned)rowsrc[th * 256 + R[0]] * RBg + 2 * C[0]; o.y = (unsigned)rowsrc[th * 256 + R[1]] * RBg + 2 * C[1];
                o.z = (unsigned)rowsrc[th * 256 + 128 + R[0]] * RBg + 2 * C[0]; o.w = (unsigned)rowsrc[th * 256 + 128 + R[1]] * RBg + 2 * C[1];
                *(u32x4*)(offs + ((size_t)(e * 9 + 2 * b + th) * 512 + tid) * 4) = o; }
        } else {
            unsigned* o = offs + ((size_t)(e * 9 + 8) * 512 + tid) * 4;
#pragma unroll
            for (int i = 0; i < 2; ++i) { if (R[i] >= 32 * b && R[i] < 32 * b + 32) o[i] = (unsigned)rowsrc[R[i] - 32 * b] * RBg + 2 * C[i]; if (b == 0) o[2 + i] = 2 * C[i]; }
        }
        __syncthreads();
    }
}

__device__ __forceinline__ void phase_combine(Frame& F, int l) {
    PHASE_IDS(F);
    const float* mod = (const float*)(F.ws + WS_MOD);
    float* xb = (float*)(F.ws + WS_XB); const bf16_t* Y = (const bf16_t*)(F.ws + WS_XG);
    for (int r = gw; r < NTOK; r += NGW) {
        const int b = r / TPB, t = r % TPB, s = (t < CTXL) ? 4 : b;
        if (l == 1 && t < CTXL) continue;
        int p = -1;
        if (lane < NE) p = (t < CTXL) ? ((const int*)(F.ws + WS_POSC))[((size_t)b * NE + lane) * CTXL + t] : ((const int*)(F.ws + WS_POSL))[((size_t)b * NE + lane) * SEQ + (t - CTXL)];
        f32x4 v[8]; load_row(xb + (size_t)r * DM, lane, v);
        const float* g2 = mod + (size_t)(l * 5 + s) * NMOD + 5 * DM;
        f32x4 gv[8];
#pragma unroll
        for (int j = 0; j < 8; ++j) gv[j] = *(const f32x4*)(g2 + 4 * lane + 256 * j);
        f32x4 a[8];
#pragma unroll
        for (int j = 0; j < 8; ++j) a[j] = (f32x4){0.f, 0.f, 0.f, 0.f};
        unsigned long long m = __ballot(p >= 0);
        const int ybase = (t < CTXL) ? 2048 + b * CAP_C : b * CAP_L;
        while (m) {
            const int e0 = __builtin_ctzll(m); m &= m - 1;
            const bool two = (m != 0ull); const int e1 = two ? __builtin_ctzll(m) : e0; if (two) m &= m - 1;
            const int p0 = __builtin_amdgcn_readlane(p, e0), p1 = __builtin_amdgcn_readlane(p, e1);
            const bf16_t* y0 = Y + (size_t)(e0 * ROWS_E + ybase + p0) * DM + 4 * lane; const bf16_t* y1 = Y + (size_t)(e1 * ROWS_E + ybase + p1) * DM + 4 * lane;
            u32x2 w0[8], w1[8];
#pragma unroll
            for (int j = 0; j < 8; ++j) w0[j] = *(const u32x2*)(y0 + 256 * j);
            if (two) {
#pragma unroll
                for (int j = 0; j < 8; ++j) w1[j] = *(const u32x2*)(y1 + 256 * j); }
#pragma unroll
            for (int j = 0; j < 8; ++j) a[j] += (f32x4){bflo(w0[j].x), bfhi(w0[j].x), bflo(w0[j].y), bfhi(w0[j].y)};
            if (two) {
#pragma unroll
                for (int j = 0; j < 8; ++j) a[j] += (f32x4){bflo(w1[j].x), bfhi(w1[j].x), bflo(w1[j].y), bfhi(w1[j].y)}; }
        }
#pragma unroll
        for (int j = 0; j < 8; ++j) v[j] += gv[j] * a[j];
        if (l == 0) {
#pragma unroll
            for (int j = 0; j < 8; ++j) *(f32x4*)(xb + (size_t)r * DM + 4 * lane + 256 * j) = v[j];
            const float* m1 = mod + (size_t)(5 + s) * NMOD;
            norm_mod_store(v, INP(F, IN_N1G) + DM, m1, m1 + DM, (bf16_t*)(F.ws + WS_HN) + (size_t)r * DM, lane);
        } else {
            float* op = F.out + ((size_t)b * SEQ + (t - CTXL)) * DM;
#pragma unroll
            for (int j = 0; j < 8; ++j) *(f32x4*)(op + 4 * lane + 256 * j) = v[j];
        }
    }
}

__device__ __forceinline__ void phase_dump_x(Frame& F, bool from_input) {
    PHASE_IDS(F);
    const float* xb = (const float*)(F.ws + WS_XB);
    for (int r = gw; r < NTOK; r += NGW) {
        const int b = r / TPB, t = r % TPB; if (t < CTXL) continue;
        const float* src = from_input ? INP(F, IN_X) + ((size_t)b * SEQ + (t - CTXL)) * DM : xb + (size_t)r * DM;
        f32x4 v[8]; load_row(src, lane, v);
        float* op = F.out + ((size_t)b * SEQ + (t - CTXL)) * DM;
#pragma unroll
        for (int j = 0; j < 8; ++j) *(f32x4*)(op + 4 * lane + 256 * j) = v[j];
    }
}

constexpr int N_PHASES = 2 + 11 * NLAYER;
__global__ void __launch_bounds__(512, 2) fwd_kernel(Args args) {
    extern __shared__ __attribute__((aligned(16))) unsigned char lds[];
    Frame F;
    F.lds = (LAS unsigned char*)lds; F.ldsg = (char*)lds;
    F.MISC = (volatile LAS unsigned*)(F.lds + MISC_OFF);
    F.G = gridDim.x;
    F.out = args.out; F.ws = args.ws; F.ctl = (unsigned*)(args.ws + WS_CTL);
    for (int u = threadIdx.x; u < (LDS_BYTES - LDSCTL_OFF) / 4; u += 512) ((LAS unsigned*)(F.lds + LDSCTL_OFF))[u] = 0u;
    __syncthreads();
    if (threadIdx.x < 23) { const unsigned long long pv = (unsigned long long)args.in[threadIdx.x]; LAS unsigned* t = (LAS unsigned*)(F.lds + ARGTAB_OFF) + 2 * threadIdx.x; t[0] = (unsigned)pv; t[1] = (unsigned)(pv >> 32); }
    __syncthreads();
    XcdBarrier bar; bar.bar = F.ctl + CW_BAR; bar.x = 0; bar.st = nullptr;
    if (!MK_PER_PHASE) bar = xcd_barrier_post(F.ctl + CW_BAR, F.MISC + 8);
    const int lo = args.ph_lo, hi = args.ph_hi;
#define IN(k) (lo <= (k) && (k) < hi)
    unsigned long long probe_t0 = 0ull, probe_acc = 0ull;
#define PROBE_BEGIN(k) do { if (PROBE_MASK & (1u << (k))) probe_t0 = __builtin_amdgcn_s_memrealtime(); } while (0)
#define SEAM(k) do { if (IN(k) && IN((k) + 1)) xcd_barrier(bar); if (PROBE_MASK & (1u << (k))) probe_acc += __builtin_amdgcn_s_memrealtime() - probe_t0; } while (0)

    if (IN(0)) { PROBE_BEGIN(0); if (PH_ON(0)) phase_prologue(F); if (IN(1)) xcd_barrier_first(bar); if (PROBE_MASK & 1u) probe_acc += __builtin_amdgcn_s_memrealtime() - probe_t0; }
    if (IN(1)) { PROBE_BEGIN(1); if (PH_ON(1)) phase_rowpass1_l0(F); SEAM(1); }
    for (int l = 0; l < NLAYER; ++l) {
        const int pb = 2 + 11 * l;
        const bool ctx = (l == 0);
        if (IN(pb + 0)) { PROBE_BEGIN(pb + 0); if (PH_ON(2)) {
            pg8::SchedDense S; S.init(F.ws + WS_HN, F.ws + WS_WIN + (size_t)l * INW * DM * 2, NTOK / 256, INW / 256, F.G, (int)blockIdx.x, 0);
            pg8::EpiPost E{(bf16_t*)(F.ws + WS_P), (const float*)(F.ws + WS_ROPE), INP(F, IN_QNA) + l * 128, INP(F, IN_KNA) + l * 128, INP(F, IN_QNC) + l * 128, INP(F, IN_KNC) + l * 128, INP(F, IN_VNB) + l * 512, F.lds + LDSCTL_OFF + 2048};
            pg8::gemm_phase<pg8::EpiPost, pg8::SchedDense>(F.lds, S, E); }
            SEAM(pb + 0); }
        if (IN(pb + 2)) { PROBE_BEGIN(pb + 2); if (PH_ON(4)) phase_mixers(F, l); SEAM(pb + 2); }
        if (IN(pb + 3)) { PROBE_BEGIN(pb + 3); if (PH_ON(5)) phase_groupnorm(F, l); SEAM(pb + 3); }
        if (IN(pb + 4)) { PROBE_BEGIN(pb + 4); if (PH_ON(6)) {
            pg8::SchedDense S; S.init(F.ws + WS_O, F.ws + WS_WOUT + (size_t)l * DM * DM * 2, ctx ? NTOK / 256 : 64, DM / 256, F.G, (int)blockIdx.x, ctx ? 0 : 1);
            float* xb = (float*)(F.ws + WS_XB);
            pg8::EpiResid E;
            if (l == 0) { E.ctxbase = INP(F, IN_CTX); E.latbase = INP(F, IN_X); E.cbs = CTXL; E.lbs = SEQ; }
            else { E.ctxbase = xb; E.latbase = xb + (size_t)CTXL * DM; E.cbs = TPB; E.lbs = TPB; }
            E.xout = xb; E.modl = (const float*)(F.ws + WS_MOD) + (size_t)l * 5 * NMOD;
            pg8::gemm_phase<pg8::EpiResid, pg8::SchedDense>(F.lds, S, E); }
            SEAM(pb + 4); }
        if (IN(pb + 5)) { PROBE_BEGIN(pb + 5); if (PH_ON(7)) phase_rowpass2(F, l); SEAM(pb + 5); }
        if (IN(pb + 6)) { PROBE_BEGIN(pb + 6); if (PH_ON(8)) phase_topk(F, l); SEAM(pb + 6); }
        if (IN(pb + 8)) { PROBE_BEGIN(pb + 8); if (PH_ON(10)) {
            if ((l == 0) ? (FP8_L0 != 0) : (FP8_L1 != 0)) {
                pg8::SchedGrouped<pg8::GK> S; S.init(F.ws + WS_HN8, F.ws + WS_WGU + (size_t)l * NE * 4096 * DM * 2, ctx ? 9 : 8, 16, F.G, (int)blockIdx.x);
                pg8::EpiSwiGLU8 E{(unsigned char*)(F.ws + WS_H)};
                pg8::gemm_phase<pg8::EpiSwiGLU8, pg8::SchedGrouped<pg8::GK>, true, true>(F.lds, S, E, (const unsigned*)(F.ws + WS_OFFS), F.lds + LDSCTL_OFF + 2048);
            } else {
                pg8::SchedGrouped<2 * pg8::GK> S; S.init(F.ws + WS_HN, F.ws + WS_WGU + (size_t)l * NE * 4096 * DM * 2, ctx ? 9 : 8, 16, F.G, (int)blockIdx.x);
                pg8::EpiSwiGLU E{(bf16_t*)(F.ws + WS_H)};
                pg8::gemm_phase<pg8::EpiSwiGLU, pg8::SchedGrouped<2 * pg8::GK>, false, true>(F.lds, S, E, (const unsigned*)(F.ws + WS_OFFS), F.lds + LDSCTL_OFF + 2048);
            } }
            SEAM(pb + 8); }
        if (IN(pb + 9)) { PROBE_BEGIN(pb + 9); if (PH_ON(11)) {
            pg8::EpiDown E{(bf16_t*)(F.ws + WS_XG), (const float*)(F.ws + WS_GATE)};
            if ((l == 0) ? (FP8_L0 != 0) : (FP8_L1 != 0)) {
                pg8::SchedGrouped<pg8::GK> S; S.init(F.ws + WS_H, F.ws + WS_WD + (size_t)l * NE * DM * DM * 2, ctx ? 9 : 8, 8, F.G, (int)blockIdx.x);
                pg8::gemm_phase<pg8::EpiDown, pg8::SchedGrouped<pg8::GK>, true>(F.lds, S, E);
            } else {
                pg8::SchedGrouped<2 * pg8::GK> S; S.init(F.ws + WS_H, F.ws + WS_WD + (size_t)l * NE * DM * DM * 2, ctx ? 9 : 8, 8, F.G, (int)blockIdx.x);
                pg8::gemm_phase<pg8::EpiDown, pg8::SchedGrouped<2 * pg8::GK>, false>(F.lds, S, E);
            } }
            SEAM(pb + 9); }
        if (IN(pb + 10)) { PROBE_BEGIN(pb + 10); if (PH_ON(12)) phase_combine(F, l); if (l + 1 < NLAYER) SEAM(pb + 10); else if (PROBE_MASK & (1u << (pb + 10))) probe_acc += __builtin_amdgcn_s_memrealtime() - probe_t0; }
    }
    if (PROBE_MASK) { const unsigned long long te = __builtin_amdgcn_s_memrealtime(); while (__builtin_amdgcn_s_memrealtime() - te < probe_acc) __builtin_amdgcn_s_sleep(8); }
#undef IN
#undef SEAM
}

extern "C" void kernel_launch(void* const* d_in, const int* in_sizes, int n_in, void* d_out, int out_size, void* d_ws, size_t ws_size, hipStream_t stream) {
    static int grid = 0;
    if (grid == 0) {
        if (n_in != 23 || out_size != NB * SEQ * DM || ws_size < WS_END) { fprintf(stderr, "kernel_launch: shape mismatch: n_in %d out %d ws %zu (need %zu)\n", n_in, out_size, ws_size, (size_t)WS_END); grid = -1; return; }
        int dev = 0, cus = 0, per_cu = 0;
        if (hipGetDevice(&dev) != hipSuccess || hipDeviceGetAttribute(&cus, hipDeviceAttributeMultiprocessorCount, dev) != hipSuccess) { grid = -1; return; }
        if (hipFuncSetAttribute((const void*)fwd_kernel, hipFuncAttributeMaxDynamicSharedMemorySize, LDS_BYTES) != hipSuccess) { fprintf(stderr, "kernel_launch: hipFuncSetAttribute failed\n"); grid = -1; return; }
        if (hipOccupancyMaxActiveBlocksPerMultiprocessor(&per_cu, (const void*)fwd_kernel, 512, LDS_BYTES) != hipSuccess || per_cu < 1) { fprintf(stderr, "kernel_launch: occupancy query says %d\n", per_cu); }
        (void)hipGetLastError();
        grid = cus;
    }
    if (grid < 0) return;
    if (hipMemsetAsync((char*)d_ws + WS_CTL, 0, CTL_ZERO_BYTES, stream) != hipSuccess) return;
    Args a{};
    for (int i = 0; i < 23; ++i) a.in[i] = (const float*)d_in[i];
    a.out = (float*)d_out; a.ws = (unsigned char*)d_ws;
#if MK_PER_PHASE
    for (int p = 0; p < N_PHASES; ++p) { a.ph_lo = p; a.ph_hi = p + 1; hipLaunchKernelGGL(fwd_kernel, dim3(grid), dim3(512), LDS_BYTES, stream, a); }
#else
    a.ph_lo = 0; a.ph_hi = N_PHASES;
    hipLaunchKernelGGL(fwd_kernel, dim3(grid), dim3(512), LDS_BYTES, stream, a);
#endif
    const hipError_t le = hipPeekAtLastError();
    if (le != hipSuccess) fprintf(stderr, "kernel_launch: launch failed: %s\n", hipGetErrorName(le));
}
```

```cpp
#include <hip/hip_runtime.h>
#include <cstdio>
#include <cstdint>

#define LAS __attribute__((address_space(3)))
#define GAS __attribute__((address_space(1)))
typedef unsigned short bf16_t;
typedef short bf16x8 __attribute__((ext_vector_type(8)));
typedef short s16x4 __attribute__((ext_vector_type(4)));
typedef float f32x2 __attribute__((ext_vector_type(2)));
typedef float f32x4 __attribute__((ext_vector_type(4)));
typedef float f32x16 __attribute__((ext_vector_type(16)));
typedef unsigned u32x2 __attribute__((ext_vector_type(2)));
typedef unsigned u32x4 __attribute__((ext_vector_type(4)));
typedef int i32x4 __attribute__((ext_vector_type(4)));
typedef int i32x8 __attribute__((ext_vector_type(8)));

#ifndef MK_PER_PHASE
#define MK_PER_PHASE 0
#endif
#ifndef PHASE_MASK
#define PHASE_MASK 0x1fff
#endif
#define PH_ON(k) (((PHASE_MASK) >> (k)) & 1)
#ifndef FP8_L0
#define FP8_L0 1
#endif
#ifndef FP8_L1
#define FP8_L1 1
#endif
#ifndef PROBE_MASK
#define PROBE_MASK 0u
#endif
#ifndef DBG_STOP
#define DBG_STOP 0
#endif

constexpr int DM = 2048, NB = 4, SEQ = 4096, CTXL = 256, TPB = SEQ + CTXL, NTOK = NB * TPB;
constexpr int INW = 3584, NE = 16, NLAYER = 2, NMOD = 6 * DM;
constexpr int C_QA = 0, C_KA = 768, C_VA = 1024, C_UB = 1280, C_VB = 1792, C_QC = 2304, C_KC = 3072, C_VC = 3328;
constexpr int O_A = 0, O_B = 768, O_C = 1280;
constexpr int CAP_L = 512, CAP_C = 32, ROWS_E = 2304;
constexpr float EPS = 1e-6f;

constexpr size_t MiB = 1u << 20;
constexpr size_t WS_CTL = 0, CTL_ZERO_BYTES = 65536;
constexpr size_t WS_MOD = 1 * MiB;
constexpr size_t WS_ROPE = 2 * MiB;
constexpr size_t WS_AFFL = 3 * MiB;
constexpr size_t WS_AFFC = 4 * MiB;
constexpr size_t WS_POSL = 5 * MiB;
constexpr size_t WS_POSC = 6 * MiB;
constexpr size_t WS_OFFS = 10 * MiB;
constexpr size_t WS_GATE = 8 * MiB;
constexpr size_t WS_WRT = 9 * MiB;
constexpr size_t WS_WRS = 11 * MiB;
constexpr size_t WS_GS2 = 12 * MiB;
constexpr size_t WS_PART = 13 * MiB;
constexpr size_t WS_WIN = 16 * MiB;
constexpr size_t WS_WOUT = WS_WIN + (size_t)2 * INW * DM * 2;
constexpr size_t WS_WGU = WS_WOUT + (size_t)2 * DM * DM * 2;
constexpr size_t WS_WD = WS_WGU + (size_t)2 * NE * 4096 * DM * 2;
constexpr size_t WS_HN = WS_WD + (size_t)2 * NE * DM * DM * 2;
constexpr size_t WS_P = WS_HN + (size_t)NTOK * DM * 2;
constexpr size_t WS_O = WS_P + (size_t)NTOK * INW * 2;
constexpr size_t WS_XB = WS_O + (size_t)NTOK * DM * 2;
constexpr size_t WS_XG = WS_XB + (size_t)NTOK * DM * 4;
constexpr size_t WS_H = WS_XG + (size_t)NE * ROWS_E * DM * 2;
constexpr size_t WS_HN8 = WS_H + (size_t)NE * ROWS_E * DM * 2;
constexpr size_t WS_END = WS_HN8 + (size_t)NTOK * DM;
constexpr float W8_SCALE = 32.f; constexpr int W8_SCALE_E8M0 = 127 - 5;
constexpr int CW_BAR = 4096, CW_QUEUE = 8192;

constexpr int RING_BYTES = 131072, LDSCTL_OFF = RING_BYTES, MISC_OFF = LDSCTL_OFF + 320, LDS_BYTES = 147456;

#define LDS_WAIT() asm volatile("s_waitcnt lgkmcnt(0)" ::: "memory")
#define VM_WAIT() asm volatile("s_waitcnt vmcnt(0)" ::: "memory")
__device__ __forceinline__ unsigned f2bf(float f) { unsigned u = __builtin_bit_cast(unsigned, f); return (u + 0x7fffu + ((u >> 16) & 1u)) >> 16; }
__device__ __forceinline__ unsigned pk2(float lo, float hi) { return f2bf(lo) | (f2bf(hi) << 16); }
__device__ __forceinline__ float bf2f(unsigned short b) { return __builtin_bit_cast(float, ((unsigned)b) << 16); }
__device__ __forceinline__ float bflo(unsigned w) { return __builtin_bit_cast(float, w << 16); }
__device__ __forceinline__ float bfhi(unsigned w) { return __builtin_bit_cast(float, w & 0xffff0000u); }
__device__ __forceinline__ unsigned pk4_fp8(float a, float b, float c, float d) {
    int r = __builtin_amdgcn_cvt_pk_fp8_f32(a, b, 0, false); r = __builtin_amdgcn_cvt_pk_fp8_f32(c, d, r, true); return (unsigned)r; }
__device__ __forceinline__ int opaque_tid() { int t = threadIdx.x; asm volatile("" : "+v"(t)); return t; }
__device__ __forceinline__ float row16_sum(float v) {
    v += __builtin_bit_cast(float, __builtin_amdgcn_update_dpp(0, __builtin_bit_cast(int, v), 0xB1, 0xF, 0xF, true));
    v += __builtin_bit_cast(float, __builtin_amdgcn_update_dpp(0, __builtin_bit_cast(int, v), 0x4E, 0xF, 0xF, true));
    v += __builtin_bit_cast(float, __builtin_amdgcn_update_dpp(0, __builtin_bit_cast(int, v), 0x141, 0xF, 0xF, true));
    v += __builtin_bit_cast(float, __builtin_amdgcn_update_dpp(0, __builtin_bit_cast(int, v), 0x140, 0xF, 0xF, true));
    return v;
}
__device__ __forceinline__ float wave_sum(float v) {
    v = row16_sum(v);
    const int iv = __builtin_bit_cast(int, v);
    const float a = __builtin_bit_cast(float, __builtin_amdgcn_readlane(iv, 0)), b = __builtin_bit_cast(float, __builtin_amdgcn_readlane(iv, 16));
    const float c = __builtin_bit_cast(float, __builtin_amdgcn_readlane(iv, 32)), d = __builtin_bit_cast(float, __builtin_amdgcn_readlane(iv, 48));
    return (a + b) + (c + d);
}
__device__ __forceinline__ float rsqrt_fast(float x) { return __builtin_amdgcn_rsqf(x); }
__device__ __forceinline__ float gelu_tanh(float x) {
    const float u = 0.7978845608028654f * (x + 0.044715f * x * x * x);
    const float e = __expf(2.f * u);
    const float th = 1.f - 2.f / (e + 1.f);
    return 0.5f * x * (1.f + th);
}

#define XB_TMO      128
#define XB_XCNT(j)  (256  + 64 * (j))
#define XB_XSUB(j)  (1280 + 64 * (j))
#define XB_XGEN(j)  (2304 + 64 * (j))
#define XB_TOP      3328
#define XB_TOPGEN   3392
#define XCD_BAR_WORDS 3456
#define XB_SPIN_CAP (1u << 18)
__device__ __forceinline__ unsigned xb_ld(unsigned* p)              { return __hip_atomic_load(p, __ATOMIC_RELAXED, __HIP_MEMORY_SCOPE_AGENT); }
__device__ __forceinline__ unsigned xb_add(unsigned* p, unsigned v) { return __hip_atomic_fetch_add(p, v, __ATOMIC_RELAXED, __HIP_MEMORY_SCOPE_AGENT); }
__device__ __forceinline__ unsigned xb_xcc_id() { return (unsigned)__builtin_amdgcn_s_getreg((3 << 11) | 20) & 0xFu; }
#define XB_SPIN(cond, bar) do { unsigned _sp = 0; while (cond) { __builtin_amdgcn_s_sleep(1); \
    if ((++_sp & 255u) == 0u) { if (xb_ld(&(bar)[XB_TMO])) break; if (_sp > XB_SPIN_CAP) { atomicAdd(&(bar)[XB_TMO], 1u); break; } } } } while (0)
struct XcdBarrier { unsigned* bar; unsigned x; volatile LAS unsigned* st; };
__device__ __forceinline__ XcdBarrier xcd_barrier_post(unsigned* bar, volatile LAS unsigned* st) {
    XcdBarrier b; b.bar = bar; b.x = xb_xcc_id(); b.st = st;
    if (threadIdx.x == 0) (void)xb_add(&bar[XB_XCNT(b.x)], 1u);
    return b;
}
__device__ __forceinline__ void xcd_barrier_complete(unsigned* bar, unsigned x, unsigned& nloc, unsigned& nx) {
    const unsigned G = gridDim.x * gridDim.y * gridDim.z;
    unsigned sum, cnt, mine, sp = 0u;
    for (;;) {
        sum = 0u; cnt = 0u; mine = 0u;
#pragma unroll
        for (unsigned j = 0; j < 16; ++j) { const unsigned c = xb_ld(&bar[XB_XCNT(j)]); sum += c; cnt += (c > 0u) ? 1u : 0u; mine = (j == x) ? c : mine; }
        if (sum == G) break;
        __builtin_amdgcn_s_sleep(1);
        if ((++sp & 255u) == 0u) { if (xb_ld(&bar[XB_TMO])) break; if (sp > XB_SPIN_CAP) { atomicAdd(&bar[XB_TMO], 1u); break; } }
    }
    nloc = mine > 0u ? mine : 1u; nx = cnt > 0u ? cnt : 1u;
}
template <bool FIRST>
__device__ __forceinline__ void xcd_barrier_t(const XcdBarrier& b) {
    asm volatile("s_waitcnt vmcnt(0)" ::: "memory");
    __syncthreads();
    if (threadIdx.x == 0) {
        unsigned* bar = b.bar;
        asm volatile("" : "+s"(bar));
        __builtin_amdgcn_s_waitcnt(0);
        unsigned nloc = b.st[0], nx = b.st[1];
        if constexpr (FIRST) { if (nloc == 0u) { xcd_barrier_complete(bar, b.x, nloc, nx); b.st[0] = nloc; b.st[1] = nx; } }
        const unsigned old = xb_add(&bar[XB_XSUB(b.x)], 1u);
        const unsigned gen = old / nloc;
        if (old + 1u == (gen + 1u) * nloc) {
            __builtin_amdgcn_fence(__ATOMIC_RELEASE, "agent");
            asm volatile("s_waitcnt vmcnt(0)" ::: "memory");
            const unsigned og = xb_add(&bar[XB_TOP], 1u);
            const unsigned tg = og / nx;
            if (og + 1u == (tg + 1u) * nx) xb_add(&bar[XB_TOPGEN], 1u);
            else XB_SPIN(xb_ld(&bar[XB_TOPGEN]) == tg, bar);
            __builtin_amdgcn_fence(__ATOMIC_ACQUIRE, "agent");
            xb_add(&bar[XB_XGEN(b.x)], 1u);
            asm volatile("s_waitcnt vmcnt(0)" ::: "memory");
        } else {
            XB_SPIN(xb_ld(&bar[XB_XGEN(b.x)]) == gen, bar);
            __builtin_amdgcn_fence(__ATOMIC_ACQUIRE, "agent");
            asm volatile("s_waitcnt vmcnt(0)" ::: "memory");
        }
    }
    __syncthreads();
}
__device__ __forceinline__ void xcd_barrier(const XcdBarrier& b) { xcd_barrier_t<false>(b); }
__device__ __forceinline__ void xcd_barrier_first(const XcdBarrier& b) { xcd_barrier_t<true>(b); }

namespace pg8 {
constexpr int BM = 256, BK = 64, HALF = 128, HTB = HALF * BK * 2, STAGE_BYTES = 8 * HTB, NXCD = 8, WGM = 8;
constexpr int GK = 2048;
__host__ __device__ __forceinline__ int lds_byte(int r, int c) { const int st = (r >> 4) * 2 + (c >> 5), rr = r & 15, cc = c & 31, ob = rr * 64 + cc * 2; return st * 1024 + (ob ^ (((ob >> 9) & 1) << 5)); }
__host__ __device__ __forceinline__ void stage_rc(int b, int& R, int& C) { const int st = b / 1024, sb = b % 1024, swz = sb ^ (((sb >> 9) & 1) << 5); R = (st >> 1) * 16 + swz / 64; C = (st & 1) * 32 + (swz % 64) / 2; }
__host__ __device__ __forceinline__ int perm32(int rho) { const int n = rho >> 4, i = rho & 15; return 8 * (i >> 2) + 4 * n + (i & 3); }

struct Unit { int pm, pn, e, rowbase, colbase, oidx; const char* a; const char* b; };

struct SchedDense {
    static constexpr int RB = GK * 2;
    const char* A; const char* Bt; int nM, nN, nwg, G, c, skipctx;
    __device__ void init(const void* A_, const void* Bt_, int nM_, int nN_, int G_, int c_, int skipctx_) { A = (const char*)A_; Bt = (const char*)Bt_; nM = nM_; nN = nN_; nwg = nM * nN; G = G_; c = c_; skipctx = skipctx_; }
    __device__ bool next(int i, Unit& u) const {
        const long L = (long)i * G + c; if (L >= nwg) return false;
        int wgid = (int)L; { const int q = nwg / NXCD, r = nwg % NXCD, xcd = wgid % NXCD, off = wgid / NXCD; wgid = (xcd < r ? xcd * (q + 1) : r * (q + 1) + (xcd - r) * q) + off; }
        const int nig = WGM * nN, gid = wgid / nig, fm = gid * WGM, gsz = (nM - fm) < WGM ? (nM - fm) : WGM;
        int pm = fm + ((wgid % nig) % gsz); const int pn = (wgid % nig) / gsz;
        if (skipctx) pm = (pm >> 4) * 17 + 1 + (pm & 15);
        u.pm = pm; u.pn = pn; u.e = 0; u.rowbase = pm * BM; u.colbase = pn * BM; u.oidx = 0;
        u.a = A + (size_t)pm * (BM * GK * 2); u.b = Bt + (size_t)pn * (BM * GK * 2); return true;
    }
};
template <int RB_> struct SchedGrouped {
    static constexpr int RB = RB_;
    const char* A; const char* Bt; int nMe, nNe, nwg, G, c;
    __device__ void init(const void* A_, const void* Bt_, int nMe_, int nNe_, int G_, int c_) { A = (const char*)A_; Bt = (const char*)Bt_; nMe = nMe_; nNe = nNe_; nwg = NE * nMe * nNe; G = G_; c = c_; }
    __device__ bool next(int i, Unit& u) const {
        const long L = (long)i * G + c; if (L >= nwg) return false;
        const int per = nMe * nNe, e = (int)L / per, rem = (int)L % per, pm = rem % nMe, pn = rem / nMe;
        u.pm = pm; u.pn = pn; u.e = e; u.rowbase = e * ROWS_E + pm * BM; u.colbase = pn * BM; u.oidx = e * 9 + pm;
        u.a = A + (size_t)(e * ROWS_E + pm * BM) * RB; u.b = Bt + ((size_t)e * nNe + pn) * (BM * RB); return true;
    }
};

__device__ __forceinline__ unsigned cvt_pk_bf16(float lo, float hi) { unsigned r; asm volatile("v_cvt_pk_bf16_f32 %0, %1, %2" : "=v"(r) : "v"(lo), "v"(hi)); return r; }

struct EpiStoreBf16 {
    static constexpr bool PERM = true;
    bf16_t* O; int ldc;
    __device__ __forceinline__ void operator()(const f32x4 (&acc)[2][2][4][2], const Unit& u, int wr, int wc, int fr, int fq) const {
        const int row0 = u.rowbase + wr * 64 + fr, col0 = u.colbase + wc * 32 + 8 * fq;
#pragma unroll
        for (int ai = 0; ai < 2; ++ai)
#pragma unroll
            for (int m = 0; m < 4; ++m) { bf16_t* rowp = O + (size_t)(row0 + ai * HALF + m * 16) * ldc + col0;
#pragma unroll
                for (int bj = 0; bj < 2; ++bj) { const f32x4 v0 = acc[ai][bj][m][0], v1 = acc[ai][bj][m][1];
                    u32x4 w; w.x = cvt_pk_bf16(v0[0], v0[1]); w.y = cvt_pk_bf16(v0[2], v0[3]); w.z = cvt_pk_bf16(v1[0], v1[1]); w.w = cvt_pk_bf16(v1[2], v1[3]);
                    *(u32x4*)(rowp + bj * HALF) = w; } }
    }
};
struct EpiPost {
    static constexpr bool PERM = true;
    bf16_t* P; const float* rope; const float* qna; const float* kna; const float* qnc; const float* knc; const float* vnb; LAS unsigned char* tab;
    __device__ __forceinline__ void operator()(f32x4 (&acc)[2][2][4][2], const Unit& u, int wr, int wc, int fr, int fq) const {
        const int tb = u.pm % 17; const bool lat = tb != 0;
        const int d0 = 64 * (wc >> 1) + 16 * (wc & 1) + 4 * fq, rl0 = wr * 64 + fr;
        int typ[2]; const float* gain[2];
#pragma unroll
        for (int bj = 0; bj < 2; ++bj) { const int slot = 2 * u.pn + bj;
            typ[bj] = (slot < 8) ? 3 : (slot < 10) ? 0 : (slot < 14) ? 1 : (slot < 18) ? 2 : (slot < 26) ? 3 : 0;
            gain[bj] = (slot < 6) ? qna : (slot < 8) ? kna : (slot < 18) ? vnb + ((slot - 14) & 3) * 128 : (slot < 24) ? qnc : knc; }
        const bool anynorm = typ[0] >= 2 || typ[1] >= 2;
#pragma unroll
        for (int bj = 0; bj < 2; ++bj) if (typ[bj] == 1 || typ[bj] == 2) {
#pragma unroll
            for (int ai = 0; ai < 2; ++ai)
#pragma unroll
                for (int m = 0; m < 4; ++m)
#pragma unroll
                    for (int n = 0; n < 2; ++n)
#pragma unroll
                        for (int j = 0; j < 4; ++j) acc[ai][bj][m][n][j] = gelu_tanh(acc[ai][bj][m][n][j]); }
        if (anynorm) {
#pragma unroll
            for (int bj = 0; bj < 2; ++bj) if (typ[bj] >= 2) {
#pragma unroll
                for (int ai = 0; ai < 2; ++ai)
#pragma unroll
                    for (int m = 0; m < 4; ++m) { const f32x4 a = acc[ai][bj][m][0], b = acc[ai][bj][m][1];
                        float ss = ((a.x * a.x + a.y * a.y) + (a.z * a.z + a.w * a.w)) + ((b.x * b.x + b.y * b.y) + (b.z * b.z + b.w * b.w));
                        ss += __builtin_bit_cast(float, __builtin_amdgcn_ds_swizzle(__builtin_bit_cast(int, ss), 0x401F));
                        { auto rr = __builtin_amdgcn_permlane32_swap(__float_as_uint(ss), __float_as_uint(ss), false, false); ss = __uint_as_float(rr[0]) + __uint_as_float(rr[1]); }
                        if (fq == 0) *(LAS float*)(tab + (((rl0 + ai * HALF + m * 16) * 2 + bj) * 4 + wc) * 4) = ss; } }
            asm volatile("s_waitcnt lgkmcnt(0)" ::: "memory"); __builtin_amdgcn_s_barrier(); asm volatile("" ::: "memory");
        }
#pragma unroll
        for (int bj = 0; bj < 2; ++bj) {
            const int slot = 2 * u.pn + bj;
            f32x4 g0 = (f32x4){1.f, 1.f, 1.f, 1.f}, g1 = g0;
            if (typ[bj] >= 2) { g0 = *(const f32x4*)(gain[bj] + d0); g1 = *(const f32x4*)(gain[bj] + d0 + 32); }
#pragma unroll
            for (int ai = 0; ai < 2; ++ai)
#pragma unroll
                for (int m = 0; m < 4; ++m) { const int rl = rl0 + ai * HALF + m * 16;
                    f32x4 a = acc[ai][bj][m][0], b = acc[ai][bj][m][1];
                    if (typ[bj] >= 2) { const f32x4 t = *(const LAS f32x4*)(tab + ((rl * 2 + bj) * 4) * 4);
                        const float rinv = rsqrt_fast(((t.x + t.y) + (t.z + t.w)) * (1.f / 128) + EPS);
                        a = a * rinv * g0; b = b * rinv * g1; }
                    if (typ[bj] == 3 && lat) { const int pos = (tb - 1) * 256 + rl, pp = (wc >> 1) ? (pos & 63) : (pos >> 6);
                        const f32x4* cs = (const f32x4*)(rope + 2 * (pp * 32 + 16 * (wc & 1) + 4 * fq)); const f32x4 c0 = cs[0], c1 = cs[1];
                        const f32x4 cv = (f32x4){c0.x, c0.z, c1.x, c1.z}, sv = (f32x4){c0.y, c0.w, c1.y, c1.w};
                        const f32x4 ra = a * cv - b * sv, rb = b * cv + a * sv; a = ra; b = rb; }
                    bf16_t* rowp = P + (size_t)(u.rowbase + rl) * INW + slot * 128 + d0;
                    u32x2 w0, w1; w0.x = cvt_pk_bf16(a.x, a.y); w0.y = cvt_pk_bf16(a.z, a.w); w1.x = cvt_pk_bf16(b.x, b.y); w1.y = cvt_pk_bf16(b.z, b.w);
                    *(u32x2*)rowp = w0; *(u32x2*)(rowp + 32) = w1;
                    asm volatile("" ::: "memory"); }
        }
    }
};
struct EpiResid {
    static constexpr bool PERM = false;
    const float* ctxbase; const float* latbase; int cbs, lbs;
    float* xout; const float* modl;
    float* parts;
    __device__ __forceinline__ void operator()(const f32x4 (&acc)[2][2][4][2], const Unit& u, int wr, int wc, int fr, int fq) const {
        const int b = u.pm / 17, tb = u.pm % 17;
        const float* src = (tb == 0) ? ctxbase + (size_t)b * cbs * DM : latbase + ((size_t)b * lbs + (size_t)(tb - 1) * 256) * DM;
        const float* g1 = modl + (size_t)((tb == 0) ? 4 : b) * NMOD + 2 * DM;
        const int rl0 = wr * 64 + fr, col0 = u.colbase + wc * 32 + 4 * fq;
#pragma unroll
        for (int ai = 0; ai < 2; ++ai)
#pragma unroll
            for (int m = 0; m < 4; ++m) { const int rl = rl0 + ai * HALF + m * 16; const float* sp = src + (size_t)rl * DM + col0; float* dp = xout + (size_t)(u.rowbase + rl) * DM + col0; float ss = 0.f;
#pragma unroll
                for (int bj = 0; bj < 2; ++bj)
#pragma unroll
                    for (int n = 0; n < 2; ++n) { const f32x4 xv = *(const f32x4*)(sp + bj * HALF + n * 16), gv = *(const f32x4*)(g1 + col0 + bj * HALF + n * 16);
                        const f32x4 y = xv + gv * acc[ai][bj][m][n]; *(f32x4*)(dp + bj * HALF + n * 16) = y;
                        ss += (y.x * y.x + y.y * y.y) + (y.z * y.z + y.w * y.w); }
                ss += __builtin_bit_cast(float, __builtin_amdgcn_ds_swizzle(__builtin_bit_cast(int, ss), 0x401F));
                { auto rr = __builtin_amdgcn_permlane32_swap(__float_as_uint(ss), __float_as_uint(ss), false, false); ss = __uint_as_float(rr[0]) + __uint_as_float(rr[1]); }
                if (fq == 0) parts[(size_t)(u.rowbase + rl) * 32 + u.pn * 4 + wc] = ss;
                asm volatile("" ::: "memory"); }
    }
};
struct EpiSwiGLU {
    static constexpr bool PERM = true;
    bf16_t* Hout;
    __device__ __forceinline__ void operator()(const f32x4 (&acc)[2][2][4][2], const Unit& u, int wr, int wc, int fr, int fq) const {
        const int row0 = u.rowbase + wr * 64 + fr, col0 = u.pn * HALF + wc * 32 + 8 * fq;
#pragma unroll
        for (int ai = 0; ai < 2; ++ai)
#pragma unroll
            for (int m = 0; m < 4; ++m) { bf16_t* rowp = Hout + (size_t)(row0 + ai * HALF + m * 16) * DM + col0; float h[8];
#pragma unroll
                for (int n = 0; n < 2; ++n)
#pragma unroll
                    for (int j = 0; j < 4; ++j) { const float g = acc[ai][0][m][n][j], up = acc[ai][1][m][n][j]; h[n * 4 + j] = g * __builtin_amdgcn_rcpf(1.f + __expf(-g)) * up; }
                u32x4 w; w.x = cvt_pk_bf16(h[0], h[1]); w.y = cvt_pk_bf16(h[2], h[3]); w.z = cvt_pk_bf16(h[4], h[5]); w.w = cvt_pk_bf16(h[6], h[7]);
                *(u32x4*)rowp = w; }
    }
};
struct EpiSwiGLU8 {
    static constexpr bool PERM = true;
    unsigned char* Hout;
    __device__ __forceinline__ void operator()(const f32x4 (&acc)[2][2][4][2], const Unit& u, int wr, int wc, int fr, int fq) const {
        const int row0 = u.rowbase + wr * 64 + fr, col0 = u.pn * HALF + wc * 32 + 8 * fq;
#pragma unroll
        for (int ai = 0; ai < 2; ++ai)
#pragma unroll
            for (int m = 0; m < 4; ++m) { unsigned char* rowp = Hout + (size_t)(row0 + ai * HALF + m * 16) * DM + col0; float h[8];
#pragma unroll
                for (int n = 0; n < 2; ++n)
#pragma unroll
                    for (int j = 0; j < 4; ++j) { const float g = acc[ai][0][m][n][j], up = acc[ai][1][m][n][j]; h[n * 4 + j] = g * __builtin_amdgcn_rcpf(1.f + __expf(-g)) * up; }
                u32x2 w; w.x = pk4_fp8(h[0], h[1], h[2], h[3]); w.y = pk4_fp8(h[4], h[5], h[6], h[7]);
                *(u32x2*)rowp = w; }
    }
};
struct EpiDown {
    static constexpr bool PERM = true;
    bf16_t* Y; const float* gatev;
    __device__ __forceinline__ void operator()(const f32x4 (&acc)[2][2][4][2], const Unit& u, int wr, int wc, int fr, int fq) const {
        const int row0 = u.rowbase + wr * 64 + fr, col0 = u.colbase + wc * 32 + 8 * fq;
#pragma unroll
        for (int ai = 0; ai < 2; ++ai)
#pragma unroll
            for (int m = 0; m < 4; ++m) { const int row = row0 + ai * HALF + m * 16; const float gt = gatev[row]; bf16_t* rowp = Y + (size_t)row * DM + col0;
#pragma unroll
                for (int bj = 0; bj < 2; ++bj) { const f32x4 v0 = acc[ai][bj][m][0] * gt, v1 = acc[ai][bj][m][1] * gt;
                    u32x4 w; w.x = cvt_pk_bf16(v0[0], v0[1]); w.y = cvt_pk_bf16(v0[2], v0[3]); w.z = cvt_pk_bf16(v1[0], v1[1]); w.w = cvt_pk_bf16(v1[2], v1[3]);
                    *(u32x4*)(rowp + bj * HALF) = w; } }
    }
};

template <class Epi, class Sched, bool FP8 = false, bool GATHER = false, bool ALIGN_EPI = true, bool SP2 = true>
__device__ __forceinline__ void gemm_phase(LAS unsigned char* lds, const Sched& S, const Epi& E, const unsigned* goffs = nullptr, LAS unsigned char* goffs_lds = nullptr) {
    static_assert(!GATHER || SP2, "gather mode is written for the SP2 loop");
    static_assert(Sched::RB == (FP8 ? GK : GK * 2), "operand row bytes");
    const int tid = opaque_tid(), wid = __builtin_amdgcn_readfirstlane(tid >> 6), lane = tid & 63, wr = wid >> 2, wc = wid & 3, fr = lane & 15, fq = lane >> 4;
    constexpr int RB = Sched::RB, nt = RB / 128;
    unsigned voffA[2], voffB[2];
#pragma unroll
    for (int i = 0; i < 2; ++i) { int R, C; stage_rc(tid * 16 + i * 8192, R, C); const int Rb = Epi::PERM ? ((R & ~31) + perm32(R & 31)) : R;
        voffA[i] = (unsigned)(R * RB + C * 2); voffB[i] = (unsigned)(Rb * RB + C * 2); }
    const size_t kstep = (size_t)(BK * 2);
    const size_t hstep = (size_t)HALF * RB;
    const unsigned ldsw = (unsigned)wid * 1024u;
    const int aoff = lds_byte(wr * 64 + fr, fq * 8), boff = lds_byte(wc * 32 + fr, fq * 8);
#define PG8_SA(b, h) (((b) * 2 + (h)) * HTB)
#define PG8_SB(b, h) ((4 + (b) * 2 + (h)) * HTB)
#define PG8_STAGE(bufoff, gbase, voff) do { _Pragma("unroll") for (int _i = 0; _i < 2; ++_i) \
        __builtin_amdgcn_global_load_lds((const unsigned*)((const char*)(gbase) + (voff)[_i]), (LAS unsigned*)(lds + (bufoff) + ldsw + _i * 8192), 16, 0, 0); } while (0)
#define PG8_RD8(p) __builtin_shufflevector(*(const LAS i32x4*)(p), *(const LAS i32x4*)((p) + 1024), 0, 1, 2, 3, 4, 5, 6, 7)
#define PG8_LDA(dst, b, h) do { _Pragma("unroll") for (int m = 0; m < 4; ++m) { if constexpr (FP8) dst##8[m] = PG8_RD8(lds + PG8_SA(b, h) + aoff + m * 2048); \
        else { _Pragma("unroll") for (int k = 0; k < 2; ++k) dst[m][k] = *(const LAS bf16x8*)(lds + PG8_SA(b, h) + aoff + m * 2048 + k * 1024); } } } while (0)
#define PG8_LDB(dst, b, h) do { _Pragma("unroll") for (int n = 0; n < 2; ++n) { if constexpr (FP8) dst##8[n] = PG8_RD8(lds + PG8_SB(b, h) + boff + n * 2048); \
        else { _Pragma("unroll") for (int k = 0; k < 2; ++k) dst[n][k] = *(const LAS bf16x8*)(lds + PG8_SB(b, h) + boff + n * 2048 + k * 1024); } } } while (0)
#define PG8_MMA(ai, bj, At, Bt) do { __builtin_amdgcn_s_setprio(1); _Pragma("unroll") for (int m = 0; m < 4; ++m) _Pragma("unroll") for (int n = 0; n < 2; ++n) { \
        if constexpr (FP8) asm volatile("v_mfma_scale_f32_16x16x128_f8f6f4 %0, %1, %2, %0, %3, %4 op_sel_hi:[0,0,0]" : "+v"(acc[ai][bj][m][n]) : "v"(Bt##8[n]), "v"(At##8[m]), "v"(sclW), "v"(sclX)); \
        else { _Pragma("unroll") for (int k = 0; k < 2; ++k) acc[ai][bj][m][n] = __builtin_amdgcn_mfma_f32_16x16x32_bf16(Bt[n][k], At[m][k], acc[ai][bj][m][n], 0, 0, 0); } } \
        __builtin_amdgcn_s_setprio(0); } while (0)
#define PG8_WAIT_V(n) asm volatile("s_waitcnt vmcnt(" #n ")" ::: "memory")
#define PG8_WAIT_L(n) asm volatile("s_waitcnt lgkmcnt(" #n ")" ::: "memory")
#define PG8_BAR __builtin_amdgcn_s_barrier()
#define PG8_SCHED __builtin_amdgcn_sched_barrier(0)
    Unit cur, nxt; int ui = 0;
    if (!S.next(0, cur)) return;
    u32x4 gC = (u32x4){0u, 0u, 0u, 0u}, gN = gC;
    if constexpr (GATHER) gC = *(const u32x4*)(goffs + ((size_t)cur.oidx * 512 + tid) * 4);
#define PG8_GSTAGE(bufoff, gbase, o0, o1) do { \
        __builtin_amdgcn_global_load_lds((const unsigned*)((const char*)(gbase) + (o0)), (LAS unsigned*)(lds + (bufoff) + ldsw), 16, 0, 0); \
        __builtin_amdgcn_global_load_lds((const unsigned*)((const char*)(gbase) + (o1)), (LAS unsigned*)(lds + (bufoff) + ldsw + 8192), 16, 0, 0); } while (0)
    f32x4 acc[2][2][4][2];
#pragma unroll
    for (int a = 0; a < 2; ++a)
#pragma unroll
        for (int b = 0; b < 2; ++b)
#pragma unroll
            for (int m = 0; m < 4; ++m)
#pragma unroll
                for (int n = 0; n < 2; ++n) acc[a][b][m][n] = (f32x4){0.f, 0.f, 0.f, 0.f};
    int sclW = W8_SCALE_E8M0 * 0x01010101, sclX = 0x7f7f7f7f; if constexpr (FP8) asm volatile("" : "+v"(sclW), "+v"(sclX)); (void)sclW; (void)sclX;
    bf16x8 At[4][2], B0[2][2], B1[2][2]; i32x8 At8[4], B08[2], B18[2];
    const char* cA = cur.a; const char* cB = cur.b;
    if constexpr (SP2) {
        PG8_STAGE(PG8_SB(0, 0), cB, voffB); PG8_STAGE(PG8_SB(0, 1), cB + hstep, voffB);
        if constexpr (GATHER) { PG8_GSTAGE(PG8_SA(0, 0), S.A, gC.x, gC.y); PG8_GSTAGE(PG8_SA(0, 1), S.A, gC.z, gC.w); }
        else { PG8_STAGE(PG8_SA(0, 0), cA, voffA); PG8_STAGE(PG8_SA(0, 1), cA + hstep, voffA); }
        if (wr == 1) PG8_BAR;
        PG8_WAIT_V(2); PG8_BAR;
        PG8_STAGE(PG8_SB(1, 0), cB + kstep, voffB);
        if constexpr (GATHER) PG8_GSTAGE(PG8_SA(1, 0), S.A + kstep, gC.x, gC.y); else PG8_STAGE(PG8_SA(1, 0), cA + kstep, voffA);
        PG8_STAGE(PG8_SB(1, 1), cB + hstep + kstep, voffB);
        PG8_WAIT_V(6); PG8_BAR;
    } else {
        PG8_STAGE(PG8_SB(0, 0), cB, voffB); PG8_STAGE(PG8_SA(0, 0), cA, voffA); PG8_STAGE(PG8_SB(0, 1), cB + hstep, voffB); PG8_STAGE(PG8_SA(0, 1), cA + hstep, voffA);
        if (wr == 1) PG8_BAR;
        PG8_WAIT_V(4); PG8_BAR;
        PG8_STAGE(PG8_SB(1, 0), cB + kstep, voffB); PG8_STAGE(PG8_SA(1, 0), cA + kstep, voffA); PG8_STAGE(PG8_SB(1, 1), cB + hstep + kstep, voffB);
        PG8_WAIT_V(6); PG8_BAR;
    }
    for (;;) {
        const bool has_next = S.next(ui + 1, nxt);
        const char* nA = has_next ? nxt.a : cA; const char* nB = has_next ? nxt.b : cB;
        if constexpr (GATHER) { if (has_next)
            __builtin_amdgcn_global_load_lds((const unsigned*)(goffs + ((size_t)nxt.oidx * 512 + tid) * 4), (LAS unsigned*)(goffs_lds + ldsw), 16, 0, 0); }
        for (int t = 0; t < nt; t += 2) {
            const bool last = (t == nt - 2);
            const char* a1 = cA + (size_t)(t + 1) * kstep;
            const char* a2 = last ? nA : cA + (size_t)(t + 2) * kstep; const char* b2 = last ? nB : cB + (size_t)(t + 2) * kstep;
            const char* a3 = a2 + kstep; const char* b3 = b2 + kstep;
            const char* g1 = S.A + (size_t)(t + 1) * kstep; const char* g2 = S.A + (last ? (size_t)0 : (size_t)(t + 2) * kstep); const char* g3 = g2 + kstep;
            u32x4 gX = gC;
            if constexpr (GATHER) { if (last) { if (has_next) gN = *(const LAS u32x4*)(goffs_lds + (size_t)tid * 16); else gN = gC; gX = gN; } }
            if constexpr (SP2) {
            PG8_LDB(B0, 0, 0); PG8_LDB(B1, 0, 1); PG8_SCHED; PG8_LDA(At, 0, 0);
            if constexpr (GATHER) PG8_GSTAGE(PG8_SA(1, 1), g1, gC.z, gC.w); else PG8_STAGE(PG8_SA(1, 1), a1 + hstep, voffA);
            PG8_WAIT_V(8); PG8_WAIT_L(0); PG8_BAR; PG8_MMA(0, 0, At, B0); PG8_MMA(0, 1, At, B1); PG8_BAR; PG8_SCHED;
            PG8_LDA(At, 0, 1); PG8_STAGE(PG8_SB(0, 0), b2, voffB); PG8_STAGE(PG8_SB(0, 1), b2 + hstep, voffB);
            if constexpr (GATHER) PG8_GSTAGE(PG8_SA(0, 0), g2, gX.x, gX.y); else PG8_STAGE(PG8_SA(0, 0), a2, voffA);
            PG8_WAIT_V(8); PG8_WAIT_L(0); PG8_BAR; PG8_MMA(1, 0, At, B0); PG8_MMA(1, 1, At, B1); PG8_BAR; PG8_SCHED;
            PG8_LDB(B0, 1, 0); PG8_LDB(B1, 1, 1); PG8_SCHED; PG8_LDA(At, 1, 0);
            if constexpr (GATHER) PG8_GSTAGE(PG8_SA(0, 1), g2, gX.z, gX.w); else PG8_STAGE(PG8_SA(0, 1), a2 + hstep, voffA);
            PG8_WAIT_V(8); PG8_WAIT_L(0); PG8_BAR; PG8_MMA(0, 0, At, B0); PG8_MMA(0, 1, At, B1); PG8_BAR; PG8_SCHED;
            PG8_LDA(At, 1, 1); PG8_STAGE(PG8_SB(1, 0), b3, voffB); PG8_STAGE(PG8_SB(1, 1), b3 + hstep, voffB);
            if constexpr (GATHER) PG8_GSTAGE(PG8_SA(1, 0), g3, gX.x, gX.y); else PG8_STAGE(PG8_SA(1, 0), a3, voffA);
            PG8_WAIT_V(8); PG8_WAIT_L(0); PG8_BAR; PG8_MMA(1, 0, At, B0); PG8_MMA(1, 1, At, B1); PG8_BAR; PG8_SCHED;
            } else {
            PG8_LDB(B0, 0, 0); PG8_SCHED; PG8_LDA(At, 0, 0); PG8_STAGE(PG8_SA(1, 1), a1 + hstep, voffA);
            PG8_WAIT_L(8); PG8_BAR; PG8_WAIT_L(0); PG8_MMA(0, 0, At, B0); PG8_BAR; PG8_SCHED;
            PG8_LDB(B1, 0, 1); PG8_STAGE(PG8_SB(0, 0), b2, voffB);
            PG8_BAR; PG8_WAIT_L(0); PG8_MMA(0, 1, At, B1); PG8_BAR;
            PG8_LDA(At, 0, 1); PG8_STAGE(PG8_SA(0, 0), a2, voffA);
            PG8_BAR; PG8_WAIT_L(0); PG8_MMA(1, 0, At, B0); PG8_BAR; PG8_SCHED;
            PG8_STAGE(PG8_SB(0, 1), b2 + hstep, voffB);
            PG8_WAIT_V(6); PG8_BAR; PG8_MMA(1, 1, At, B1); PG8_BAR;
            PG8_LDB(B0, 1, 0); PG8_SCHED; PG8_LDA(At, 1, 0); PG8_STAGE(PG8_SA(0, 1), a2 + hstep, voffA);
            PG8_WAIT_L(8); PG8_BAR; PG8_WAIT_L(0); PG8_MMA(0, 0, At, B0); PG8_BAR; PG8_SCHED;
            PG8_LDB(B1, 1, 1); PG8_STAGE(PG8_SB(1, 0), b3, voffB);
            PG8_BAR; PG8_WAIT_L(0); PG8_MMA(0, 1, At, B1); PG8_BAR;
            PG8_LDA(At, 1, 1); PG8_STAGE(PG8_SA(1, 0), a3, voffA);
            PG8_BAR; PG8_WAIT_L(0); PG8_MMA(1, 0, At, B0); PG8_BAR; PG8_SCHED;
            PG8_STAGE(PG8_SB(1, 1), b3 + hstep, voffB);
            PG8_WAIT_V(6); PG8_BAR; PG8_MMA(1, 1, At, B1); PG8_BAR;
            }
        }
        if constexpr (ALIGN_EPI) { if (wr == 0) PG8_BAR; }
        if constexpr (FP8) asm volatile("s_nop 15\n\ts_nop 15\n\ts_nop 7" ::: "memory");
        E(acc, cur, wr, wc, fr, fq);
        if (!has_next) break;
#pragma unroll
        for (int a = 0; a < 2; ++a)
#pragma unroll
            for (int b = 0; b < 2; ++b)
#pragma unroll
                for (int m = 0; m < 4; ++m)
#pragma unroll
                    for (int n = 0; n < 2; ++n) acc[a][b][m][n] = (f32x4){0.f, 0.f, 0.f, 0.f};
        cur = nxt; cA = nA; cB = nB; ++ui; gC = gN;
        if constexpr (ALIGN_EPI) { if (wr == 1) PG8_BAR; }
    }
    PG8_WAIT_V(0);
    if constexpr (!ALIGN_EPI) { if (wr == 0) PG8_BAR; }
    PG8_BAR;
#undef PG8_SA
#undef PG8_SB
#undef PG8_STAGE
#undef PG8_GSTAGE
#undef PG8_LDA
#undef PG8_LDB
#undef PG8_MMA
#undef PG8_RD8
#undef PG8_WAIT_V
#undef PG8_WAIT_L
#undef PG8_BAR
#undef PG8_SCHED
}
}

namespace at {
constexpr int D = 128, NW = 8, QBLK = 32, KVBLK = 64;
constexpr float SCALE = 0.088388347648318440f;
constexpr float THR = 8.f;
constexpr int LDQ = INW, LDK = INW, LDO = DM;
constexpr size_t SHM_V = KVBLK * D * 2, SHM_K = KVBLK * D * 2, SHM_ATTN = 2 * SHM_V + 2 * SHM_K + NW * 64 * 4;
#define KSWZ(row, colB) ((row) * 256 + ((colB) ^ (((row) & 7) << 4)))
#define SBAR() __builtin_amdgcn_sched_barrier(0)
__device__ __forceinline__ int crow(int r, int hi) { return (r & 3) + 8 * (r >> 2) + 4 * hi; }
__device__ __forceinline__ unsigned cvtpk(float lo, float hi) { unsigned r; asm volatile("v_cvt_pk_bf16_f32 %0, %1, %2" : "=v"(r) : "v"(lo), "v"(hi)); return r; }

__device__ __forceinline__ void partialSM(f32x16& p0, f32x16& p1, float& m_reg, float& mn, float& alpha, bool domask, int dq, int hi) {
  constexpr float C = SCALE * 1.4426950408889634f;
  {
    if (domask) {
#pragma unroll
      for (int r = 0; r < 16; ++r) { const int d0 = dq + crow(r, hi), d1 = d0 + 32;
        if (d0 > 128 || d0 < -128) p0[r] = -1e30f;
        if (d1 > 128 || d1 < -128) p1[r] = -1e30f; }
    }
  }
  float pmax = p0[0]; for (int r = 1; r < 16; ++r) pmax = fmaxf(pmax, p0[r]); for (int r = 0; r < 16; ++r) pmax = fmaxf(pmax, p1[r]);
  { auto rr = __builtin_amdgcn_permlane32_swap(__float_as_uint(pmax), __float_as_uint(pmax), false, false);
    pmax = fmaxf(__uint_as_float(rr[0]), __uint_as_float(rr[1])); }
  if (__builtin_expect(__all(pmax - m_reg <= THR / SCALE), 1)) { mn = m_reg; alpha = 1.f; }
  else { mn = fmaxf(m_reg, pmax); alpha = __builtin_amdgcn_exp2f((m_reg - mn) * C); m_reg = mn; }
  float mnC = -mn * C;
  for (int r = 0; r < 16; ++r) p0[r] = fmaf(p0[r], C, mnC); for (int r = 0; r < 16; ++r) p1[r] = fmaf(p1[r], C, mnC);
  for (int r = 0; r < 16; ++r) p0[r] = __builtin_amdgcn_exp2f(p0[r]);
}
__device__ __forceinline__ void finishSM(f32x16& p0, f32x16& p1, float alpha, float& l_reg, bf16x8& pa0, bf16x8& pa1, bf16x8& pa2, bf16x8& pa3) {
  for (int r = 0; r < 16; ++r) p1[r] = __builtin_amdgcn_exp2f(p1[r]);
  float ps = 0; for (int r = 0; r < 16; ++r) ps += p0[r]; for (int r = 0; r < 16; ++r) ps += p1[r];
  { auto rr = __builtin_amdgcn_permlane32_swap(__float_as_uint(ps), __float_as_uint(ps), false, false);
    ps = __uint_as_float(rr[0]) + __uint_as_float(rr[1]); }
  l_reg = l_reg * alpha + ps;
#define PK4(P, BASE, OUT) do { unsigned a0 = cvtpk(P[BASE + 0], P[BASE + 1]), a1 = cvtpk(P[BASE + 2], P[BASE + 3]);   \
    unsigned b0 = cvtpk(P[BASE + 4], P[BASE + 5]), b1 = cvtpk(P[BASE + 6], P[BASE + 7]);                              \
    auto r0 = __builtin_amdgcn_permlane32_swap(a0, b0, false, false); auto r1 = __builtin_amdgcn_permlane32_swap(a1, b1, false, false); \
    u32x4 w = {r0[0], r1[0], r0[1], r1[1]}; OUT = *reinterpret_cast<bf16x8*>(&w); } while (0)
  PK4(p0, 0, pa0); PK4(p0, 8, pa1); PK4(p1, 0, pa2); PK4(p1, 8, pa3);
#undef PK4
}
__device__ __forceinline__ void qkt(f32x16& p0, f32x16& p1, const char* Ks, const bf16x8* qr, int ka0) {
  p0 = f32x16{}; p1 = f32x16{};
  asm volatile("" : "+v"(ka0));
#pragma unroll
  for (int d0 = 0; d0 < 8; ++d0) { const int off = ka0 ^ (d0 * 32);
    bf16x8 b0 = *reinterpret_cast<const bf16x8*>(Ks + off);
    bf16x8 b1 = *reinterpret_cast<const bf16x8*>(Ks + off + 32 * 256);
    p0 = __builtin_amdgcn_mfma_f32_32x32x16_bf16(b0, qr[d0], p0, 0, 0, 0);
    p1 = __builtin_amdgcn_mfma_f32_32x32x16_bf16(b1, qr[d0], p1, 0, 0, 0); }
}
__device__ __forceinline__ int v_st(int k, int c) { const int kk = (k & ~0xC) | ((k & 4) << 1) | ((k & 8) >> 1); return ((kk >> 3) * 4 + (c >> 5)) * 512 + ((kk & 7) * 32 + (c & 31)) * 2; }
__device__ __forceinline__ int v_rd_base(int lane) { return ((lane & 3) << 3) | (((lane >> 2) & 3) << 6) | (((lane >> 4) & 1) << 5) | (((lane >> 5) & 1) << 8); }
constexpr int v_rd_off(int d0, int ks, int half) { return d0 * 512 + ks * 4096 + half * 2048; }
template <int OFF> __device__ __forceinline__ s16x4 tr_read(int vb) {
  s16x4 r; asm volatile("ds_read_b64_tr_b16 %0, %1 offset:%2" : "=&v"(r) : "v"(vb), "i"(OFF) : "memory"); return r;
}
template <int D0> __device__ __forceinline__ void pv_one(f32x16& od, int vb, bf16x8 pa0, bf16x8 pa1, bf16x8 pa2, bf16x8 pa3) {
  const s16x4 l0 = tr_read<v_rd_off(D0, 0, 0)>(vb), h0 = tr_read<v_rd_off(D0, 0, 1)>(vb), l1 = tr_read<v_rd_off(D0, 1, 0)>(vb), h1 = tr_read<v_rd_off(D0, 1, 1)>(vb);
  const s16x4 l2 = tr_read<v_rd_off(D0, 2, 0)>(vb), h2 = tr_read<v_rd_off(D0, 2, 1)>(vb), l3 = tr_read<v_rd_off(D0, 3, 0)>(vb), h3 = tr_read<v_rd_off(D0, 3, 1)>(vb);
  asm volatile("s_waitcnt lgkmcnt(0)" ::: "memory"); SBAR();
#define PK(L, H) (bf16x8){L[0], L[1], L[2], L[3], H[0], H[1], H[2], H[3]}
  od = __builtin_amdgcn_mfma_f32_32x32x16_bf16(pa0, PK(l0, h0), od, 0, 0, 0);
  od = __builtin_amdgcn_mfma_f32_32x32x16_bf16(pa1, PK(l1, h1), od, 0, 0, 0);
  od = __builtin_amdgcn_mfma_f32_32x32x16_bf16(pa2, PK(l2, h2), od, 0, 0, 0);
  od = __builtin_amdgcn_mfma_f32_32x32x16_bf16(pa3, PK(l3, h3), od, 0, 0, 0);
#undef PK
}
__device__ __forceinline__ void pv_d0(f32x16* o, int vb, bf16x8 pa0, bf16x8 pa1, bf16x8 pa2, bf16x8 pa3) {
  pv_one<0>(o[0], vb, pa0, pa1, pa2, pa3); pv_one<1>(o[1], vb, pa0, pa1, pa2, pa3); pv_one<2>(o[2], vb, pa0, pa1, pa2, pa3); pv_one<3>(o[3], vb, pa0, pa1, pa2, pa3);
}

__device__ __forceinline__ void attn_body(const bf16_t* __restrict__ Qb, const bf16_t* __restrict__ Kb, const bf16_t* __restrict__ Vb, bf16_t* __restrict__ Ob,
                                          int NT, int kskip, int qpos0, float m0, float l0, bool maskon, char* lds) {
  const int tid = opaque_tid(), wid = tid >> 6, lane = tid & 63, r32 = lane & 31, hi = lane >> 5;
  char* V_lds = lds; char* K_lds = lds + 2 * SHM_V;
  float* ws = (float*)(lds + 2 * SHM_V + 2 * SHM_K) + wid * 64; float* li_l = ws; float* al_l = ws + 32;
  float m_reg = m0, l_reg = l0; f32x16 o[4] = {}; bf16x8 qr[8];
  const bf16_t* Qw = Qb + (long)(wid * QBLK + r32) * LDQ + hi * 8;
#pragma unroll
  for (int d0 = 0; d0 < 8; ++d0) qr[d0] = *reinterpret_cast<const bf16x8*>(Qw + d0 * 16);
  const int sr = tid >> 4, sc = (tid & 15) * 8, vst0 = v_st(sr, sc), kst0 = KSWZ(sr, sc * 2);
  const int vb0 = (int)(uintptr_t)V_lds + v_rd_base(lane);
  const int qpos = qpos0 + wid * QBLK + r32;
  const int ka0 = r32 * 256 + ((hi * 16) ^ ((r32 & 7) << 4));
  const unsigned goff0 = (unsigned)(sr * LDK + sc) * 2u, goff1 = goff0 + 32u * LDK * 2u;
  struct { bf16x8 vs0, vs1, ks0, ks1; } sr_[1];
#define TROW(jt) ((long)(jt) * KVBLK + ((jt) >= 4 ? kskip : 0))
#define SLOAD(i, jt) do { const long _k0 = TROW(jt) * (LDK * 2); const char* _kp = (const char*)Kb + _k0; const char* _vp = (const char*)Vb + _k0; \
    sr_[i].vs0 = *reinterpret_cast<const bf16x8*>(_vp + goff0); sr_[i].vs1 = *reinterpret_cast<const bf16x8*>(_vp + goff1); \
    sr_[i].ks0 = *reinterpret_cast<const bf16x8*>(_kp + goff0); sr_[i].ks1 = *reinterpret_cast<const bf16x8*>(_kp + goff1); } while (0)
#define SWRITE(b, i) do { *(bf16x8*)(V_lds + (b) * SHM_V + vst0) = sr_[i].vs0;          \
    *(bf16x8*)(V_lds + (b) * SHM_V + vst0 + 8192) = sr_[i].vs1;                         \
    *(bf16x8*)(K_lds + (b) * SHM_K + kst0) = sr_[i].ks0;                               \
    *(bf16x8*)(K_lds + (b) * SHM_K + kst0 + 8192) = sr_[i].ks1; } while (0)
#define SWAIT() asm volatile("s_waitcnt vmcnt(0)" ::: "memory")
#define RESC(a) do { if (__any((a) < 1.f)) { if (hi == 0) al_l[r32] = (a); asm volatile("s_waitcnt lgkmcnt(0)" ::: "memory"); \
    for (int d = 0; d < 4; ++d) for (int r = 0; r < 16; ++r) o[d][r] *= al_l[crow(r, hi)]; } } while (0)
#define DQ(jt) (kskip + ((jt) - 4) * KVBLK - qpos)
  f32x16 pA0, pA1, pB0, pB1; float mnA, mnB, alA, alB; bf16x8 pa0, pa1, pa2, pa3;
  constexpr int SE = 0, SO = 0;
  SLOAD(SE, 0); asm volatile("s_waitcnt vmcnt(0)" ::: "memory"); SWRITE(0, SE); __syncthreads();
  qkt(pA0, pA1, K_lds, qr, ka0); partialSM(pA0, pA1, m_reg, mnA, alA, false, 0, hi);
  SLOAD(SO, 1);
  SWAIT(); SWRITE(1, SO); __syncthreads();
  for (int j = 1; j + 1 < NT; j += 2) {
    SBAR(); qkt(pB0, pB1, K_lds + SHM_K, qr, ka0);
    finishSM(pA0, pA1, alA, l_reg, pa0, pa1, pa2, pa3); SBAR();
    SLOAD(SO, j + 1); SBAR();
    pv_d0(o, vb0, pa0, pa1, pa2, pa3); partialSM(pB0, pB1, m_reg, mnB, alB, maskon && j >= 4, DQ(j), hi);
    __syncthreads(); SWAIT(); SWRITE(0, SE);
    RESC(alB); __syncthreads();
    SBAR(); qkt(pA0, pA1, K_lds, qr, ka0);
    finishSM(pB0, pB1, alB, l_reg, pa0, pa1, pa2, pa3); SBAR();
    SLOAD(SE, j + 2); SBAR();
    pv_d0(o, vb0 + (int)SHM_V, pa0, pa1, pa2, pa3); partialSM(pA0, pA1, m_reg, mnA, alA, maskon && j + 1 >= 4, DQ(j + 1), hi);
    __syncthreads(); SWAIT(); SWRITE(1, SO);
    RESC(alA); __syncthreads();
  }
  SBAR(); qkt(pB0, pB1, K_lds + SHM_K, qr, ka0);
  finishSM(pA0, pA1, alA, l_reg, pa0, pa1, pa2, pa3); SBAR();
  pv_d0(o, vb0, pa0, pa1, pa2, pa3); partialSM(pB0, pB1, m_reg, mnB, alB, maskon && NT - 1 >= 4, DQ(NT - 1), hi);
  __syncthreads(); RESC(alB);
  finishSM(pB0, pB1, alB, l_reg, pa0, pa1, pa2, pa3); SBAR();
  pv_d0(o, vb0 + (int)SHM_V, pa0, pa1, pa2, pa3);
  if (hi == 0) li_l[r32] = l_reg; asm volatile("s_waitcnt lgkmcnt(0)" ::: "memory");
  float rli[16];
#pragma unroll
  for (int r = 0; r < 16; ++r) rli[r] = __builtin_amdgcn_rcpf(li_l[crow(r, hi)]);
  bf16_t* Ow = Ob + (long)(wid * QBLK) * LDO;
#pragma unroll
  for (int r = 0; r < 16; ++r) { int orow = crow(r, hi);
    for (int d0 = 0; d0 < 4; ++d0) Ow[(long)orow * LDO + d0 * 32 + r32] = (bf16_t)f2bf(o[d0][r] * rli[r]); }
#undef TROW
#undef SLOAD
#undef SWRITE
#undef SWAIT
#undef RESC
#undef DQ
}
}

struct Args { const float* in[23]; float* out; unsigned char* ws; int ph_lo, ph_hi; };
enum { IN_X = 0, IN_C, IN_CTX, IN_CCTX, IN_WMOD, IN_BMOD, IN_N1G, IN_N2G, IN_WIN, IN_QNA, IN_KNA, IN_SINK, IN_VNB, IN_WS, IN_BS, IN_QNC, IN_KNC, IN_OUTG, IN_WOUT, IN_WR, IN_WG, IN_WU, IN_WDN };

#define PHASE_IDS(F) const int tid = opaque_tid(), lane = tid & 63, wave = __builtin_amdgcn_readfirstlane(tid >> 6), gw = (int)blockIdx.x * 8 + wave, NGW = (F).G * 8; (void)lane; (void)wave; (void)gw; (void)NGW
constexpr int ARGTAB_OFF = LDSCTL_OFF + 1024;
#define INP(F, i) ld_inp((F).lds, (i))
__device__ __forceinline__ const float* ld_inp(LAS unsigned char* lds, int i) {
    unsigned a = (unsigned)(uintptr_t)(lds + ARGTAB_OFF) + 8u * (unsigned)i;
    asm volatile("" : "+v"(a));
    const volatile LAS unsigned* t = (const volatile LAS unsigned*)(uintptr_t)a;
    const unsigned lo = __builtin_amdgcn_readfirstlane(t[0]), hi = __builtin_amdgcn_readfirstlane(t[1]);
    return (const float*)(const GAS float*)(((unsigned long long)hi << 32) | lo);
}
struct Frame {
    LAS unsigned char* lds; char* ldsg;
    volatile LAS unsigned* MISC;
    unsigned* ctl;
    int G;
    float* out; unsigned char* ws;
};

__host__ __device__ __forceinline__ int headpos(int d) { return 32 * (2 * (d >> 6) + ((d >> 4) & 1)) + 8 * ((d >> 2) & 3) + 4 * ((d >> 5) & 1) + (d & 3); }
template <bool HEADPERM = false>
__device__ __forceinline__ void transpose_item(const float* W, int N, bf16_t* WT, int k0, int n0, int drow0, LAS float* scr, int lane) {
    { float t[32]; const float* wp = W + (size_t)(k0 + (lane >> 5)) * N + n0 + (lane & 31);
#pragma unroll
      for (int i = 0; i < 32; ++i) t[i] = wp[(size_t)(2 * i) * N];
#pragma unroll
      for (int i = 0; i < 32; ++i) scr[(2 * i + (lane >> 5)) * 33 + (lane & 31)] = t[i]; }
    LDS_WAIT(); asm volatile("" ::: "memory");
    const int c = lane & 7;
#pragma unroll
    for (int j = 0; j < 4; ++j) { const int n = (lane >> 3) + 8 * j; const LAS float* s = scr + (8 * c) * 33 + n;
        u32x4 o; o.x = pk2(s[0 * 33], s[1 * 33]); o.y = pk2(s[2 * 33], s[3 * 33]); o.z = pk2(s[4 * 33], s[5 * 33]); o.w = pk2(s[6 * 33], s[7 * 33]);
        const int drow = HEADPERM ? ((drow0 + n) & ~127) + headpos((drow0 + n) & 127) : drow0 + n;
        *(u32x4*)(WT + (size_t)drow * DM + k0 + 8 * c) = o; }
    LDS_WAIT(); asm volatile("" ::: "memory");
}

__device__ __forceinline__ void transpose_item8(const float* W, int N, unsigned char* WT, int k0, int n0, int drow0, LAS float* scr, int lane) {
    { float t[32]; const float* wp = W + (size_t)(k0 + (lane >> 5)) * N + n0 + (lane & 31);
#pragma unroll
      for (int i = 0; i < 32; ++i) t[i] = wp[(size_t)(2 * i) * N];
#pragma unroll
      for (int i = 0; i < 32; ++i) scr[(2 * i + (lane >> 5)) * 33 + (lane & 31)] = t[i]; }
    LDS_WAIT(); asm volatile("" ::: "memory");
    const int c = lane & 7;
#pragma unroll
    for (int j = 0; j < 4; ++j) { const int n = (lane >> 3) + 8 * j; const LAS float* s = scr + (8 * c) * 33 + n;
        u32x2 o; o.x = pk4_fp8(s[0 * 33] * W8_SCALE, s[1 * 33] * W8_SCALE, s[2 * 33] * W8_SCALE, s[3 * 33] * W8_SCALE); o.y = pk4_fp8(s[4 * 33] * W8_SCALE, s[5 * 33] * W8_SCALE, s[6 * 33] * W8_SCALE, s[7 * 33] * W8_SCALE);
        *(u32x2*)(WT + (size_t)(drow0 + n) * DM + k0 + 8 * c) = o; }
    LDS_WAIT(); asm volatile("" ::: "memory");
}
__device__ __forceinline__ void phase_prologue(Frame& F) {
    PHASE_IDS(F);
    LAS float* scr = (LAS float*)(F.lds + wave * 16384);
    constexpr int I_IN = 32 * (INW / 32), I_SQ = 32 * (DM / 32);
    constexpr int NIT = 2 * I_IN + 2 * I_SQ + 2 * NE * 3 * I_SQ;
    for (int it = gw; it < NIT; it += NGW) {
        int r = it;
        if (r < 2 * I_IN) { const int l = r / I_IN; r %= I_IN; const int nblk = INW / 32, kb = r / nblk, nb = r % nblk;
            transpose_item<true>(INP(F, IN_WIN) + (size_t)l * DM * INW, INW, (bf16_t*)(F.ws + WS_WIN) + (size_t)l * INW * DM, 64 * kb, 32 * nb, 32 * nb, scr, lane); continue; }
        r -= 2 * I_IN;
        if (r < 2 * I_SQ) { const int l = r / I_SQ; r %= I_SQ; const int kb = r / 64, nb = r % 64;
            transpose_item(INP(F, IN_WOUT) + (size_t)l * DM * DM, DM, (bf16_t*)(F.ws + WS_WOUT) + (size_t)l * DM * DM, 64 * kb, 32 * nb, 32 * nb, scr, lane); continue; }
        r -= 2 * I_SQ;
        const int mat = r / I_SQ; r %= I_SQ; const int kb = r / 64, nb = r % 64;
        const int le = mat / 3, which = mat % 3;
        const bool f8 = (le < NE) ? (FP8_L0 != 0) : (FP8_L1 != 0);
        if (which < 2) {
            const float* W = INP(F, which == 0 ? IN_WG : IN_WU) + (size_t)le * DM * DM; const int n0 = 32 * nb, dr = (n0 >> 7) * 256 + which * 128 + (n0 & 127);
            if (f8) transpose_item8(W, DM, (unsigned char*)(F.ws + WS_WGU) + (size_t)(le / NE) * NE * 4096 * DM * 2 + (size_t)(le % NE) * 4096 * DM, 64 * kb, n0, dr, scr, lane);
            else transpose_item(W, DM, (bf16_t*)(F.ws + WS_WGU) + (size_t)le * 4096 * DM, 64 * kb, n0, dr, scr, lane);
        } else {
            if (f8) transpose_item8(INP(F, IN_WDN) + (size_t)le * DM * DM, DM, (unsigned char*)(F.ws + WS_WD) + (size_t)(le / NE) * NE * DM * DM * 2 + (size_t)(le % NE) * DM * DM, 64 * kb, 32 * nb, 32 * nb, scr, lane);
            else transpose_item(INP(F, IN_WDN) + (size_t)le * DM * DM, DM, (bf16_t*)(F.ws + WS_WD) + (size_t)le * DM * DM, 64 * kb, 32 * nb, 32 * nb, scr, lane);
        }
    }
    __syncthreads();
    {
        LAS float* sil = (LAS float*)F.lds;
        LAS float* red = (LAS float*)(F.lds + 40960);
        bool have = false;
        for (int it = blockIdx.x; it < 2 * 96; it += F.G) {
            if (!have) {
                { const float* cp = INP(F, IN_C); const float* ccp = INP(F, IN_CCTX);
                for (int i = tid; i < 5 * DM; i += 512) { const int s = i / DM, k = i % DM; const float cv = (s < 4) ? cp[s * DM + k] : ccp[k]; sil[i] = cv / (1.f + __expf(-cv)); } }
                have = true; __syncthreads();
            }
            const int l = it / 96, cb = it % 96, c4 = tid & 31, kr = tid >> 5;
            const float* wp = INP(F, IN_WMOD) + (size_t)l * DM * NMOD + (size_t)cb * 128 + c4 * 4;
            f32x4 a[5];
#pragma unroll
            for (int s = 0; s < 5; ++s) a[s] = (f32x4){0.f, 0.f, 0.f, 0.f};
#pragma unroll 8
            for (int k = kr; k < DM; k += 16) { const f32x4 w = *(const f32x4*)(wp + (size_t)k * NMOD);
#pragma unroll
                for (int s = 0; s < 5; ++s) a[s] += w * sil[s * DM + k]; }
#pragma unroll
            for (int s = 0; s < 5; ++s) *(LAS f32x4*)(red + (kr * 5 + s) * 128 + c4 * 4) = a[s];
            __syncthreads();
            const float* bmod = INP(F, IN_BMOD);
            for (int i = tid; i < 5 * 128; i += 512) { const int s = i / 128, cc = i % 128; float sum = 0.f;
#pragma unroll
                for (int q = 0; q < 16; ++q) sum += red[(q * 5 + s) * 128 + cc];
                ((float*)(F.ws + WS_MOD))[(size_t)(l * 5 + s) * NMOD + cb * 128 + cc] = sum + bmod[l * NMOD + cb * 128 + cc]; }
            __syncthreads();
        }
    }
    if ((int)blockIdx.x >= F.G - 9 && (int)blockIdx.x < F.G - 1) {
        const float* wr = INP(F, IN_WR); bf16_t* wf = (bf16_t*)(F.ws + WS_WRS); const int part = (int)blockIdx.x - (F.G - 9);
        for (int i = part * 512 + tid; i < 2 * DM * NE; i += 8 * 512) { const int l = i / (DM * NE), rem = i % (DM * NE), k = rem >> 4, e = rem & 15;
            const float w = wr[i]; const unsigned hi = f2bf(w); const unsigned lo = f2bf(w - __builtin_bit_cast(float, hi << 16));
            const int sidx = k >> 5, q = (k >> 3) & 3, j = k & 7; bf16_t* dst = wf + ((size_t)(l * 64 + sidx) * 2 * 64 + (q * 16 + e)) * 8 + j;
            dst[0] = (bf16_t)hi; dst[64 * 8] = (bf16_t)lo; }
    }
    if (blockIdx.x == F.G - 1) {
        for (int i = tid; i < 64 * 32; i += 512) {
            const int pos = i >> 5, f = i & 31;
            double inv = 1.0; for (int q = 0; q < f; ++q) inv *= 0.7498942093324559;
            const double a = (double)pos * inv;
            const double n = __builtin_rint(a * 0.6366197723675814);
            const double r = (a - n * 1.5707963267948966) - n * 6.123233995736766e-17;
            const double r2 = r * r;
            double sn = r * (1.0 + r2 * (-1.0 / 6 + r2 * (1.0 / 120 + r2 * (-1.0 / 5040 + r2 * (1.0 / 362880 + r2 * (-1.0 / 39916800 + r2 * (1.0 / 6227020800.0)))))));
            double cn = 1.0 + r2 * (-0.5 + r2 * (1.0 / 24 + r2 * (-1.0 / 720 + r2 * (1.0 / 40320 + r2 * (-1.0 / 3628800 + r2 * (1.0 / 479001600 + r2 * (-1.0 / 87178291200.0)))))));
            const int q = ((int)n) & 3; double cs, ss;
            if (q == 0) { cs = cn; ss = sn; } else if (q == 1) { cs = -sn; ss = cn; } else if (q == 2) { cs = -cn; ss = -sn; } else { cs = sn; ss = -cn; }
            ((float*)(F.ws + WS_ROPE))[2 * i] = (float)cs; ((float*)(F.ws + WS_ROPE))[2 * i + 1] = (float)ss;
        }
    }
}

__device__ __forceinline__ void load_row(const float* row, int lane, f32x4 (&v)[8]) {
#pragma unroll
    for (int j = 0; j < 8; ++j) v[j] = *(const f32x4*)(row + 4 * lane + 256 * j);
}
__device__ __forceinline__ void norm_mod_store(const f32x4 (&v)[8], const float* g, const float* shift, const float* scale, bf16_t* dst, int lane) {
    float ss = 0.f;
#pragma unroll
    for (int j = 0; j < 8; ++j) ss += (v[j].x * v[j].x + v[j].y * v[j].y) + (v[j].z * v[j].z + v[j].w * v[j].w);
    const float rinv = rsqrt_fast(wave_sum(ss) * (1.f / DM) + EPS);
#pragma unroll
    for (int j = 0; j < 8; ++j) { const int c = 4 * lane + 256 * j;
        const f32x4 gg = *(const f32x4*)(g + c), sh = *(const f32x4*)(shift + c), sc = *(const f32x4*)(scale + c);
        const f32x4 y = (v[j] * rinv) * gg * (sc + 1.f) + sh;
        u32x2 w; w.x = pk2(y.x, y.y); w.y = pk2(y.z, y.w); *(u32x2*)(dst + c) = w; }
}

__device__ __forceinline__ void phase_rowpass1_l0(Frame& F) {
    PHASE_IDS(F);
    const float* mod = (const float*)(F.ws + WS_MOD);
    { const float* n2 = INP(F, IN_N2G); float* gs = (float*)(F.ws + WS_GS2);
      for (int i = (int)blockIdx.x * 512 + tid; i < 2 * 5 * DM; i += F.G * 512) { const int l = i / (5 * DM), sv = (i / DM) % 5, k = i % DM;
          const float* m = mod + (size_t)(l * 5 + sv) * NMOD; gs[2 * i] = n2[l * DM + k] * (1.f + m[4 * DM + k]); gs[2 * i + 1] = m[3 * DM + k]; } }
    for (int r = gw; r < NTOK; r += NGW) {
        const int b = r / TPB, t = r % TPB, s = (t < CTXL) ? 4 : b;
        const float* src = (t < CTXL) ? INP(F, IN_CTX) + ((size_t)b * CTXL + t) * DM : INP(F, IN_X) + ((size_t)b * SEQ + (t - CTXL)) * DM;
        f32x4 v[8]; load_row(src, lane, v);
        norm_mod_store(v, INP(F, IN_N1G), mod + (size_t)s * NMOD, mod + (size_t)s * NMOD + DM, (bf16_t*)(F.ws + WS_HN) + (size_t)r * DM, lane);
    }
}

__device__ __forceinline__ void post_unpack(const u32x4 x, float (&v)[8]) {
    v[0] = bflo(x.x); v[1] = bfhi(x.x); v[2] = bflo(x.y); v[3] = bfhi(x.y); v[4] = bflo(x.z); v[5] = bfhi(x.z); v[6] = bflo(x.w); v[7] = bfhi(x.w); }
__device__ __forceinline__ float sum16(float v) { return row16_sum(v); }
__device__ __forceinline__ void phase_post(Frame& F, int l) {
    PHASE_IDS(F);
    bf16_t* P = (bf16_t*)(F.ws + WS_P);
    const float* rope = (const float*)(F.ws + WS_ROPE);
    const int i16 = lane & 15, hq = lane >> 4; const bool hi2 = hq >= 2;
    const float* qna = INP(F, IN_QNA) + l * 128 + 8 * i16; const float* kna = INP(F, IN_KNA) + l * 128 + 8 * i16;
    const float* qnc = INP(F, IN_QNC) + l * 128 + 8 * i16; const float* knc = INP(F, IN_KNC) + l * 128 + 8 * i16;
    const float* vnb = INP(F, IN_VNB) + l * 512 + 8 * i16;
    for (int r = gw; r < NTOK; r += NGW) {
        const int t = r % TPB; const bool lat = t >= CTXL;
        u32x4* rp = (u32x4*)(P + (size_t)r * INW) + lane;
        u32x4 x[7];
#pragma unroll
        for (int j = 0; j < 7; ++j) x[j] = rp[64 * j];
        const int pos = lat ? t - CTXL : 0, pp = (i16 < 8) ? (pos >> 6) : (pos & 63);
        const f32x4* cs = (const f32x4*)(rope + 2 * (pp * 32 + 8 * (i16 & 3)));
        const f32x4 c0 = cs[0], c1 = cs[1], c2 = cs[2], c3 = cs[3];
        const float cosv[8] = {c0.x, c0.z, c1.x, c1.z, c2.x, c2.z, c3.x, c3.z}, sinv[8] = {c0.y, c0.w, c1.y, c1.w, c2.y, c2.w, c3.y, c3.w};
        const float sgn = (i16 & 4) ? 1.f : -1.f;
#pragma unroll
        for (int j = 0; j < 7; ++j) {
            const bool gelu_lo = (j == 3 || j == 4), gelu_hi = (j == 2 || j == 3);
            const bool norm_lo = (j != 2 && j != 3), norm_hi = (j != 2 && j != 6);
            const bool rope_lo = (j == 0 || j == 1 || j == 5 || j == 6), rope_hi = (j == 0 || j == 1 || j == 4 || j == 5);
            const bool dg = hi2 ? gelu_hi : gelu_lo, dn = hi2 ? norm_hi : norm_lo, dr = (hi2 ? rope_hi : rope_lo) && lat;
            if (!(gelu_lo || gelu_hi || norm_lo || norm_hi)) continue;
            float v[8]; post_unpack(x[j], v);
            if (gelu_lo || gelu_hi) {
#pragma unroll
                for (int e = 0; e < 8; ++e) { const float gv = gelu_tanh(v[e]); v[e] = dg ? gv : v[e]; } }
            if (norm_lo || norm_hi) {
                float ss = 0.f;
#pragma unroll
                for (int e = 0; e < 8; ++e) ss += v[e] * v[e];
                const float rinv = rsqrt_fast(sum16(ss) * (1.f / 128) + EPS);
                const float* gp;
                if (j == 0) gp = qna; else if (j == 1) gp = hi2 ? kna : qna; else if (j == 3) gp = vnb + (hi2 ? hq - 2 : 0) * 128; else if (j == 4) gp = hi2 ? qnc : vnb + (2 + hq) * 128;
                else if (j == 5) gp = qnc; else gp = knc;
                const f32x4 g0 = *(const f32x4*)gp, g1 = *(const f32x4*)(gp + 4);
                const float gg[8] = {g0.x, g0.y, g0.z, g0.w, g1.x, g1.y, g1.z, g1.w};
#pragma unroll
                for (int e = 0; e < 8; ++e) v[e] = dn ? v[e] * rinv * gg[e] : v[e];
            }
            if (rope_lo || rope_hi) {
#pragma unroll
                for (int e = 0; e < 8; ++e) { const float o = __builtin_bit_cast(float, __builtin_amdgcn_ds_swizzle(__builtin_bit_cast(int, v[e]), 0x101F)); const float rv = v[e] * cosv[e] + sgn * o * sinv[e]; v[e] = dr ? rv : v[e]; } }
            u32x4 w; w.x = pk2(v[0], v[1]); w.y = pk2(v[2], v[3]); w.z = pk2(v[4], v[5]); w.w = pk2(v[6], v[7]);
            rp[64 * j] = w;
        }
    }
}

__device__ __forceinline__ void mixer_b_unit(Frame& F, int l, int b, int ch, int g) {
    PHASE_IDS(F);
    const bf16_t* P = (const bf16_t*)(F.ws + WS_P); bf16_t* O = (bf16_t*)(F.ws + WS_O);
    const int row0 = b * TPB + ch * 128, w = wave;
    LAS bf16_t* VT = (LAS bf16_t*)F.lds;
    { const int q = tid >> 2, dp = (tid & 3) * 32; const bf16_t* src = P + (size_t)(row0 + q) * INW + C_VB + g * 128 + dp;
#pragma unroll
      for (int i = 0; i < 4; ++i) { const u32x4 x = *(const u32x4*)(src + 8 * i); const unsigned xs[4] = {x.x, x.y, x.z, x.w};
#pragma unroll
          for (int j = 0; j < 4; ++j) { VT[(dp + 8 * i + 2 * j) * 136 + q] = (bf16_t)(xs[j] & 0xffffu); VT[(dp + 8 * i + 2 * j + 1) * 136 + q] = (bf16_t)(xs[j] >> 16); } } }
    __syncthreads();
    const int i15 = lane & 15, kq = lane >> 4;
    f32x4 acc[8];
#pragma unroll
    for (int n = 0; n < 8; ++n) acc[n] = (f32x4){0.f, 0.f, 0.f, 0.f};
    const float* wsr = INP(F, IN_WS) + ((size_t)(l * 4 + g) * 128 + 16 * w + i15) * 128;
#pragma unroll
    for (int s = 0; s < 4; ++s) {
        const f32x4 a0 = *(const f32x4*)(wsr + 32 * s + 8 * kq), a1 = *(const f32x4*)(wsr + 32 * s + 8 * kq + 4);
        u32x4 aw; aw.x = pk2(a0.x, a0.y); aw.y = pk2(a0.z, a0.w); aw.z = pk2(a1.x, a1.y); aw.w = pk2(a1.z, a1.w);
        const bf16x8 af = *reinterpret_cast<bf16x8*>(&aw);
#pragma unroll
        for (int n = 0; n < 8; ++n) { const bf16x8 bfr = *(const LAS bf16x8*)(VT + (16 * n + i15) * 136 + 32 * s + 8 * kq);
            acc[n] = __builtin_amdgcn_mfma_f32_16x16x32_bf16(af, bfr, acc[n], 0, 0, 0); }
    }
#pragma unroll
    for (int j = 0; j < 4; ++j) { const int p = 16 * w + kq * 4 + j; const float bias = INP(F, IN_BS)[(l * 4 + g) * 128 + p];
        const bf16_t* up = P + (size_t)(row0 + p) * INW + C_UB + g * 128; bf16_t* op = O + (size_t)(row0 + p) * DM + O_B + g * 128;
#pragma unroll
        for (int n = 0; n < 8; ++n) { const int d = 16 * n + i15; op[d] = (bf16_t)f2bf(bf2f(up[d]) * (acc[n][j] + bias)); } }
    __syncthreads();
}
__device__ __forceinline__ void phase_mixers(Frame& F, int l) {
    PHASE_IDS(F);
    const bf16_t* P = (const bf16_t*)(F.ws + WS_P); bf16_t* O = (bf16_t*)(F.ws + WS_O);
    const bool ctx = (l == 0);
    const int nC = 384, nA = 384, nCc = ctx ? 24 : 0, nAc = ctx ? 24 : 0, nB = 4 * 4 * 34;
    const int total = nC + nA + nCc + nAc + nB;
    unsigned* qctr = F.ctl + CW_QUEUE + 64 * l;
    for (;;) {
        if (tid == 0) F.MISC[0] = xb_add(qctr, 1u);
        __syncthreads();
        int u = (int)F.MISC[0];
        __syncthreads();
        if (u >= total) break;
        if (u < nC + nA + nCc + nAc) {
            int kind, b, h, qb = 0;
            if (u < nC) { kind = 0; b = u / 96; h = (u % 96) / 16; qb = u % 16; }
            else if (u < nC + nA) { const int v = u - nC; kind = 1; b = v / 96; h = (v % 96) / 16; qb = v % 16; }
            else if (u < nC + nA + nCc) { const int v = u - nC - nA; kind = 2; b = v / 6; h = v % 6; }
            else { const int v = u - nC - nA - nCc; kind = 3; b = v / 6; h = v % 6; }
            const int kv = h / 3, isA = kind & 1, lat = (kind < 2);
            const size_t r0 = (size_t)b * TPB, rq = r0 + (lat ? CTXL + qb * 256 : 0);
            const int q0 = qb * 256, ks = (kind == 1) ? ((q0 - 128 < 0) ? 0 : q0 - 128) : 0, ke = (q0 + 384 > SEQ) ? SEQ : q0 + 384;
            const int NT = (kind == 0) ? 68 : (kind == 1) ? 4 + (ke - ks) / 64 : 4;
            const float sink = INP(F, IN_SINK)[l * 6 + h];
            const int cq = (isA ? C_QA : C_QC) + h * 128, ck = (isA ? C_KA : C_KC) + kv * 128, cv = (isA ? C_VA : C_VC) + kv * 128, co = (isA ? O_A : O_C) + h * 128;
            at::attn_body(P + rq * INW + cq, P + r0 * INW + ck, P + r0 * INW + cv, O + rq * DM + co, NT, ks, q0, isA ? sink / at::SCALE : -1e30f, isA ? 1.f : 0.f, kind == 1, F.ldsg);
            continue; }
        u -= nC + nA + nCc;
        u -= nAc;
        { const int b = u / 136, ch = (u % 136) / 4, g = u % 4;
          if (!ctx && ch < 2) continue;
          mixer_b_unit(F, l, b, ch, g); }
    }
}

__device__ __forceinline__ void phase_groupnorm(Frame& F, int l) {
    PHASE_IDS(F);
    bf16_t* O = (bf16_t*)(F.ws + WS_O); const float* og = INP(F, IN_OUTG) + l * DM;
    for (int r = gw; r < NTOK; r += NGW) {
        if (l == 1 && (r % TPB) < CTXL) continue;
        bf16_t* row = O + (size_t)r * DM;
        u32x2 x[8];
#pragma unroll
        for (int i = 0; i < 3; ++i) { x[i] = *(const u32x2*)(row + O_A + 12 * lane + 4 * i); x[5 + i] = *(const u32x2*)(row + O_C + 12 * lane + 4 * i); }
#pragma unroll
        for (int i = 0; i < 2; ++i) x[3 + i] = *(const u32x2*)(row + O_B + 8 * lane + 4 * i);
        float v[8][4]; float ss[3] = {0.f, 0.f, 0.f};
#pragma unroll
        for (int i = 0; i < 8; ++i) { v[i][0] = bflo(x[i].x); v[i][1] = bfhi(x[i].x); v[i][2] = bflo(x[i].y); v[i][3] = bfhi(x[i].y);
            const int grp = (i < 3) ? 0 : (i < 5) ? 1 : 2; ss[grp] += (v[i][0] * v[i][0] + v[i][1] * v[i][1]) + (v[i][2] * v[i][2] + v[i][3] * v[i][3]); }
        float rinv[3];
        rinv[0] = rsqrt_fast(wave_sum(ss[0]) * (1.f / 768) + EPS); rinv[1] = rsqrt_fast(wave_sum(ss[1]) * (1.f / 512) + EPS); rinv[2] = rsqrt_fast(wave_sum(ss[2]) * (1.f / 768) + EPS);
#pragma unroll
        for (int i = 0; i < 8; ++i) { const int grp = (i < 3) ? 0 : (i < 5) ? 1 : 2;
            const int c = (grp == 0) ? O_A + 12 * lane + 4 * i : (grp == 1) ? O_B + 8 * lane + 4 * (i - 3) : O_C + 12 * lane + 4 * (i - 5);
            const f32x4 gg = *(const f32x4*)(og + c); const float ri = rinv[grp];
            u32x2 w; w.x = pk2(v[i][0] * ri * gg.x, v[i][1] * ri * gg.y); w.y = pk2(v[i][2] * ri * gg.z, v[i][3] * ri * gg.w); *(u32x2*)(row + c) = w; }
    }
}

__device__ __forceinline__ float row16_max(float v) {
    v = fmaxf(v, __builtin_bit_cast(float, __builtin_amdgcn_update_dpp(0, __builtin_bit_cast(int, v), 0xB1, 0xF, 0xF, true)));
    v = fmaxf(v, __builtin_bit_cast(float, __builtin_amdgcn_update_dpp(0, __builtin_bit_cast(int, v), 0x4E, 0xF, 0xF, true)));
    v = fmaxf(v, __builtin_bit_cast(float, __builtin_amdgcn_update_dpp(0, __builtin_bit_cast(int, v), 0x141, 0xF, 0xF, true)));
    v = fmaxf(v, __builtin_bit_cast(float, __builtin_amdgcn_update_dpp(0, __builtin_bit_cast(int, v), 0x140, 0xF, 0xF, true)));
    return v;
}
__device__ __forceinline__ void phase_rowpass2(Frame& F, int l) {
    PHASE_IDS(F);
    const float* xb = (const float*)(F.ws + WS_XB); const float* parts = (const float*)(F.ws + WS_PART);
    const bool f8 = (l == 0) ? (FP8_L0 != 0) : (FP8_L1 != 0);
    { const u32x4* wf = (const u32x4*)((const bf16_t*)(F.ws + WS_WRS) + (size_t)l * 64 * 2 * 64 * 8) + tid; u32x4 t[16];
#pragma unroll
      for (int i = 0; i < 16; ++i) t[i] = wf[512 * i];
#pragma unroll
      for (int i = 0; i < 16; ++i) ((LAS u32x4*)F.lds)[tid + 512 * i] = t[i]; }
    LAS f32x4* red = (LAS f32x4*)(F.lds + LDSCTL_OFF + 2048);
    __syncthreads();
    const int i16 = lane & 15, q = lane >> 4;
    for (int tile = blockIdx.x; tile < NTOK / 16; tile += F.G) {
        const int r0 = tile * 16, b = r0 / TPB, t0 = r0 % TPB, sv = (t0 < CTXL) ? 4 : b;
        if (l == 1 && t0 < CTXL) continue;
        const int row = r0 + i16;
        const float* xr = xb + (size_t)row * DM + 256 * wave + 8 * q;
        f32x4 x[8][2];
#pragma unroll
        for (int sidx = 0; sidx < 8; ++sidx) { x[sidx][0] = *(const f32x4*)(xr + 32 * sidx); x[sidx][1] = *(const f32x4*)(xr + 32 * sidx + 4); }
        const f32x4 p0 = *(const f32x4*)(parts + (size_t)row * 32 + 8 * q), p1 = *(const f32x4*)(parts + (size_t)row * 32 + 8 * q + 4);
        float ss = ((p0.x + p0.y) + (p0.z + p0.w)) + ((p1.x + p1.y) + (p1.z + p1.w));
        ss += __builtin_bit_cast(float, __builtin_amdgcn_ds_swizzle(__builtin_bit_cast(int, ss), 0x401F));
        { auto rr = __builtin_amdgcn_permlane32_swap(__float_as_uint(ss), __float_as_uint(ss), false, false); ss = __uint_as_float(rr[0]) + __uint_as_float(rr[1]); }
        const float rinv = rsqrt_fast(ss * (1.f / DM) + EPS);
        const float* gs = (const float*)(F.ws + WS_GS2) + ((size_t)(l * 5 + sv) * DM + 256 * wave + 8 * q) * 2;
        f32x4 acc = (f32x4){0.f, 0.f, 0.f, 0.f};
#pragma unroll
        for (int sidx = 0; sidx < 8; ++sidx) {
            const f32x4 g0 = *(const f32x4*)(gs + 64 * sidx), g1 = *(const f32x4*)(gs + 64 * sidx + 4), g2 = *(const f32x4*)(gs + 64 * sidx + 8), g3 = *(const f32x4*)(gs + 64 * sidx + 12);
            float h[8];
            h[0] = x[sidx][0].x * rinv * g0.x + g0.y; h[1] = x[sidx][0].y * rinv * g0.z + g0.w; h[2] = x[sidx][0].z * rinv * g1.x + g1.y; h[3] = x[sidx][0].w * rinv * g1.z + g1.w;
            h[4] = x[sidx][1].x * rinv * g2.x + g2.y; h[5] = x[sidx][1].y * rinv * g2.z + g2.w; h[6] = x[sidx][1].z * rinv * g3.x + g3.y; h[7] = x[sidx][1].w * rinv * g3.z + g3.w;
            const int col = 256 * wave + 32 * sidx + 8 * q;
            if (f8) { u32x2 w8; w8.x = pk4_fp8(h[0], h[1], h[2], h[3]); w8.y = pk4_fp8(h[4], h[5], h[6], h[7]); *(u32x2*)((unsigned char*)(F.ws + WS_HN8) + (size_t)row * DM + col) = w8; }
            else { u32x4 w16; w16.x = pk2(h[0], h[1]); w16.y = pk2(h[2], h[3]); w16.z = pk2(h[4], h[5]); w16.w = pk2(h[6], h[7]); *(u32x4*)((bf16_t*)(F.ws + WS_HN) + (size_t)row * DM + col) = w16; }
            unsigned hh[8], hl[8];
#pragma unroll
            for (int j = 0; j < 8; ++j) { hh[j] = f2bf(h[j]); hl[j] = f2bf(h[j] - __builtin_bit_cast(float, hh[j] << 16)); }
            u32x4 ah, al; ah.x = hh[0] | (hh[1] << 16); ah.y = hh[2] | (hh[3] << 16); ah.z = hh[4] | (hh[5] << 16); ah.w = hh[6] | (hh[7] << 16);
            al.x = hl[0] | (hl[1] << 16); al.y = hl[2] | (hl[3] << 16); al.z = hl[4] | (hl[5] << 16); al.w = hl[6] | (hl[7] << 16);
            const LAS unsigned char* bp = F.lds + (size_t)((wave * 8 + sidx) * 2) * 1024 + lane * 16;
            const bf16x8 bh = *(const LAS bf16x8*)bp, bl = *(const LAS bf16x8*)(bp + 1024);
            const bf16x8 fah = __builtin_bit_cast(bf16x8, ah), fal = __builtin_bit_cast(bf16x8, al);
            acc = __builtin_amdgcn_mfma_f32_16x16x32_bf16(fah, bh, acc, 0, 0, 0);
            acc = __builtin_amdgcn_mfma_f32_16x16x32_bf16(fah, bl, acc, 0, 0, 0);
            acc = __builtin_amdgcn_mfma_f32_16x16x32_bf16(fal, bh, acc, 0, 0, 0);
        }
        red[wave * 64 + lane] = acc;
        __syncthreads();
        if (wave == 0) {
            f32x4 lg = red[lane];
#pragma unroll
            for (int w = 1; w < 8; ++w) lg += red[w * 64 + lane];
#pragma unroll
            for (int reg = 0; reg < 4; ++reg) { const float mx = row16_max(lg[reg]); const float ex = __expf(lg[reg] - mx); const float a = ex / row16_sum(ex);
                const int t = t0 + 4 * q + reg;
                if (t < CTXL) ((float*)(F.ws + WS_AFFC))[((size_t)b * NE + i16) * CTXL + t] = a;
                else ((float*)(F.ws + WS_AFFL))[((size_t)b * NE + i16) * SEQ + (t - CTXL)] = a; }
        }
        __syncthreads();
    }
    __syncthreads();
}

__device__ __forceinline__ unsigned block_excl_scan(unsigned v, LAS unsigned* scr, int lane, int wave, unsigned& total) {
    unsigned inc = v;
#pragma unroll
    for (int o = 1; o < 64; o <<= 1) { const unsigned t = __shfl_up(inc, o); if (lane >= o) inc += t; }
    if (lane == 63) scr[wave] = inc;
    __syncthreads();
    unsigned base = 0, tot = 0;
#pragma unroll
    for (int w = 0; w < 8; ++w) { const unsigned x = scr[w]; base += (w < wave) ? x : 0u; tot += x; }
    __syncthreads();
    total = tot;
    return base + inc - v;
}
__device__ __forceinline__ void phase_topk(Frame& F, int l) {
    PHASE_IDS(F);
    LAS unsigned* hist = (LAS unsigned*)F.lds;
    LAS unsigned* scr = (LAS unsigned*)(F.lds + 8192);
    LAS int* rowsrc = (LAS int*)(F.lds + 8192 + 128);
    const int nunits = (l == 0) ? 128 : 64;
    const bool f8 = (l == 0) ? (FP8_L0 != 0) : (FP8_L1 != 0); const int RBg = f8 ? DM : 2 * DM;
    for (int u = blockIdx.x; u < nunits; u += F.G) {
        const bool isc = u >= 64; const int uu = isc ? u - 64 : u, b = uu / NE, e = uu % NE;
        const int N = isc ? CTXL : SEQ; const unsigned cap = isc ? CAP_C : CAP_L;
        const float* src = isc ? (const float*)(F.ws + WS_AFFC) + (size_t)uu * CTXL : (const float*)(F.ws + WS_AFFL) + (size_t)uu * SEQ;
        int* pos = isc ? (int*)(F.ws + WS_POSC) + (size_t)uu * CTXL : (int*)(F.ws + WS_POSL) + (size_t)uu * SEQ;
        const bool own = tid * 8 < N;
        unsigned key[8];
        { u32x4 k0 = (u32x4){0u, 0u, 0u, 0u}, k1 = k0; if (own) { k0 = *(const u32x4*)(src + tid * 8); k1 = *(const u32x4*)(src + tid * 8 + 4); }
          key[0] = k0.x; key[1] = k0.y; key[2] = k0.z; key[3] = k0.w; key[4] = k1.x; key[5] = k1.y; key[6] = k1.z; key[7] = k1.w; }
        unsigned prefix = 0u, remaining = cap;
#pragma unroll
        for (int p = 0; p < 3; ++p) {
            const int shift = (p == 0) ? 21 : (p == 1) ? 10 : 0, bits = (p == 2) ? 10 : 11, nb = 1 << bits;
            for (int i = tid; i < nb; i += 512) hist[i] = 0u;
            __syncthreads();
            if (own) {
#pragma unroll
                for (int q = 0; q < 8; ++q) { const bool cand = (p == 0) ? true : ((key[q] >> (shift + bits)) == prefix);
                    if (cand) (void)__hip_atomic_fetch_add(&hist[(key[q] >> shift) & (nb - 1)], 1u, __ATOMIC_RELAXED, __HIP_MEMORY_SCOPE_WORKGROUP); } }
            __syncthreads();
            unsigned c[4];
#pragma unroll
            for (int q = 0; q < 4; ++q) c[q] = (4 * tid + q < nb) ? hist[4 * tid + q] : 0u;
            const unsigned sm = (c[0] + c[1]) + (c[2] + c[3]);
            unsigned total; const unsigned ex = block_excl_scan(sm, scr, lane, wave, total);
            unsigned above = total - (ex + sm);
#pragma unroll
            for (int q = 3; q >= 0; --q) { if (above < remaining && remaining <= above + c[q]) { scr[16] = (unsigned)(4 * tid + q); scr[17] = above; } above += c[q]; }
            __syncthreads();
            const unsigned B = scr[16], ca = scr[17];
            remaining -= ca; prefix = (prefix << bits) | B;
            __syncthreads();
        }
        const unsigned T = prefix;
        unsigned ce = 0u;
#pragma unroll
        for (int q = 0; q < 8; ++q) ce += (own && key[q] == T) ? 1u : 0u;
        unsigned tot; unsigned er = block_excl_scan(ce, scr, lane, wave, tot);
        bool sel[8]; unsigned cs = 0u;
#pragma unroll
        for (int q = 0; q < 8; ++q) { const bool eq = own && key[q] == T; sel[q] = own && (key[q] > T || (eq && er < remaining)); er += eq ? 1u : 0u; cs += sel[q] ? 1u : 0u; }
        unsigned sl = block_excl_scan(cs, scr, lane, wave, tot);
        const int slotbase = e * ROWS_E + (isc ? 2048 + b * CAP_C : b * CAP_L);
        int pv[8];
#pragma unroll
        for (int q = 0; q < 8; ++q) { pv[q] = sel[q] ? (int)sl : -1;
            if (sel[q]) { rowsrc[sl] = b * TPB + (isc ? 0 : CTXL) + tid * 8 + q; ((float*)(F.ws + WS_GATE))[slotbase + sl] = __uint_as_float(key[q]); ++sl; } }
        if (own) { *(i32x4*)(pos + tid * 8) = (i32x4){pv[0], pv[1], pv[2], pv[3]}; *(i32x4*)(pos + tid * 8 + 4) = (i32x4){pv[4], pv[5], pv[6], pv[7]}; }
        __syncthreads();
        unsigned* offs = (unsigned*)(F.ws + WS_OFFS);
        int R[2], C[2];
#pragma unroll
        for (int i = 0; i < 2; ++i) pg8::stage_rc(tid * 16 + i * 8192, R[i], C[i]);
        if (!isc) {
#pragma unroll
            for (int th = 0; th < 2; ++th) { u32x4 o;
                o.x = (unsigned)rowsrc[th * 256 + R[0]] * RBg + 2 * C[0]; o.y = (unsigned)rowsrc[th * 256 + R[1]] * RBg + 2 * C[1];
                o.z = (unsigned)rowsrc[th * 256 + 128 + R[0]] * RBg + 2 * C[0]; o.w = (unsigned)rowsrc[th * 256 + 128 + R[1]] * RBg + 2 * C[1];
                *(u32x4*)(offs + ((size_t)(e * 9 + 2 * b + th) * 512 + tid) * 4) = o; }
        } else {
            unsigned* o = offs + ((size_t)(e * 9 + 8) * 512 + tid) * 4;
#pragma unroll
            for (int i = 0; i < 2; ++i) { if (R[i] >= 32 * b && R[i] < 32 * b + 32) o[i] = (unsigned)rowsrc[R[i] - 32 * b] * RBg + 2 * C[i]; if (b == 0) o[2 + i] = 2 * C[i]; }
        }
        __syncthreads();
    }
}

__device__ __forceinline__ void phase_combine(Frame& F, int l) {
    PHASE_IDS(F);
    const float* mod = (const float*)(F.ws + WS_MOD);
    float* xb = (float*)(F.ws + WS_XB); const bf16_t* Y = (const bf16_t*)(F.ws + WS_XG);
    for (int r = gw; r < NTOK; r += NGW) {
        const int b = r / TPB, t = r % TPB, s = (t < CTXL) ? 4 : b;
        if (l == 1 && t < CTXL) continue;
        int p = -1;
        if (lane < NE) p = (t < CTXL) ? ((const int*)(F.ws + WS_POSC))[((size_t)b * NE + lane) * CTXL + t] : ((const int*)(F.ws + WS_POSL))[((size_t)b * NE + lane) * SEQ + (t - CTXL)];
        f32x4 v[8]; load_row(xb + (size_t)r * DM, lane, v);
        const float* g2 = mod + (size_t)(l * 5 + s) * NMOD + 5 * DM;
        f32x4 gv[8];
#pragma unroll
        for (int j = 0; j < 8; ++j) gv[j] = *(const f32x4*)(g2 + 4 * lane + 256 * j);
        f32x4 a[8];
#pragma unroll
        for (int j = 0; j < 8; ++j) a[j] = (f32x4){0.f, 0.f, 0.f, 0.f};
        unsigned long long m = __ballot(p >= 0);
        const int ybase = (t < CTXL) ? 2048 + b * CAP_C : b * CAP_L;
        while (m) {
            const int e0 = __builtin_ctzll(m); m &= m - 1;
            const bool two = (m != 0ull); const int e1 = two ? __builtin_ctzll(m) : e0; if (two) m &= m - 1;
            const int p0 = __builtin_amdgcn_readlane(p, e0), p1 = __builtin_amdgcn_readlane(p, e1);
            const bf16_t* y0 = Y + (size_t)(e0 * ROWS_E + ybase + p0) * DM + 4 * lane; const bf16_t* y1 = Y + (size_t)(e1 * ROWS_E + ybase + p1) * DM + 4 * lane;
            u32x2 w0[8], w1[8];
#pragma unroll
            for (int j = 0; j < 8; ++j) w0[j] = *(const u32x2*)(y0 + 256 * j);
            if (two) {
#pragma unroll
                for (int j = 0; j < 8; ++j) w1[j] = *(const u32x2*)(y1 + 256 * j); }
#pragma unroll
            for (int j = 0; j < 8; ++j) a[j] += (f32x4){bflo(w0[j].x), bfhi(w0[j].x), bflo(w0[j].y), bfhi(w0[j].y)};
            if (two) {
#pragma unroll
                for (int j = 0; j < 8; ++j) a[j] += (f32x4){bflo(w1[j].x), bfhi(w1[j].x), bflo(w1[j].y), bfhi(w1[j].y)}; }
        }
#pragma unroll
        for (int j = 0; j < 8; ++j) v[j] += gv[j] * a[j];
        if (l == 0) {
#pragma unroll
            for (int j = 0; j < 8; ++j) *(f32x4*)(xb + (size_t)r * DM + 4 * lane + 256 * j) = v[j];
            const float* m1 = mod + (size_t)(5 + s) * NMOD;
            norm_mod_store(v, INP(F, IN_N1G) + DM, m1, m1 + DM, (bf16_t*)(F.ws + WS_HN) + (size_t)r * DM, lane);
        } else {
            float* op = F.out + ((size_t)b * SEQ + (t - CTXL)) * DM;
#pragma unroll
            for (int j = 0; j < 8; ++j) *(f32x4*)(op + 4 * lane + 256 * j) = v[j];
        }
    }
}

__device__ __forceinline__ void phase_dump_x(Frame& F, bool from_input) {
    PHASE_IDS(F);
    const float* xb = (const float*)(F.ws + WS_XB);
    for (int r = gw; r < NTOK; r += NGW) {
        const int b = r / TPB, t = r % TPB; if (t < CTXL) continue;
        const float* src = from_input ? INP(F, IN_X) + ((size_t)b * SEQ + (t - CTXL)) * DM : xb + (size_t)r * DM;
        f32x4 v[8]; load_row(src, lane, v);
        float* op = F.out + ((size_t)b * SEQ + (t - CTXL)) * DM;
#pragma unroll
        for (int j = 0; j < 8; ++j) *(f32x4*)(op + 4 * lane + 256 * j) = v[j];
    }
}

constexpr int N_PHASES = 2 + 11 * NLAYER;
__global__ void __launch_bounds__(512, 2) fwd_kernel(Args args) {
    extern __shared__ __attribute__((aligned(16))) unsigned char lds[];
    Frame F;
    F.lds = (LAS unsigned char*)lds; F.ldsg = (char*)lds;
    F.MISC = (volatile LAS unsigned*)(F.lds + MISC_OFF);
    F.G = gridDim.x;
    F.out = args.out; F.ws = args.ws; F.ctl = (unsigned*)(args.ws + WS_CTL);
    for (int u = threadIdx.x; u < (LDS_BYTES - LDSCTL_OFF) / 4; u += 512) ((LAS unsigned*)(F.lds + LDSCTL_OFF))[u] = 0u;
    __syncthreads();
    if (threadIdx.x < 23) { const unsigned long long pv = (unsigned long long)args.in[threadIdx.x]; LAS unsigned* t = (LAS unsigned*)(F.lds + ARGTAB_OFF) + 2 * threadIdx.x; t[0] = (unsigned)pv; t[1] = (unsigned)(pv >> 32); }
    __syncthreads();
    XcdBarrier bar; bar.bar = F.ctl + CW_BAR; bar.x = 0; bar.st = nullptr;
    if (!MK_PER_PHASE) bar = xcd_barrier_post(F.ctl + CW_BAR, F.MISC + 8);
    const int lo = args.ph_lo, hi = args.ph_hi;
#define IN(k) (lo <= (k) && (k) < hi)
    unsigned long long probe_t0 = 0ull, probe_acc = 0ull;
#define PROBE_BEGIN(k) do { if (PROBE_MASK & (1u << (k))) probe_t0 = __builtin_amdgcn_s_memrealtime(); } while (0)
#define SEAM(k) do { if (IN(k) && IN((k) + 1)) xcd_barrier(bar); if (PROBE_MASK & (1u << (k))) probe_acc += __builtin_amdgcn_s_memrealtime() - probe_t0; } while (0)

    if (IN(0)) { PROBE_BEGIN(0); if (PH_ON(0)) phase_prologue(F); if (IN(1)) xcd_barrier_first(bar); if (PROBE_MASK & 1u) probe_acc += __builtin_amdgcn_s_memrealtime() - probe_t0; }
    if (IN(1)) { PROBE_BEGIN(1); if (PH_ON(1)) phase_rowpass1_l0(F); SEAM(1); }
    for (int l = 0; l < NLAYER; ++l) {
        const int pb = 2 + 11 * l;
        const bool ctx = (l == 0);
        if (IN(pb + 0)) { PROBE_BEGIN(pb + 0); if (PH_ON(2)) {
            pg8::SchedDense S; S.init(F.ws + WS_HN, F.ws + WS_WIN + (size_t)l * INW * DM * 2, NTOK / 256, INW / 256, F.G, (int)blockIdx.x, 0);
            pg8::EpiPost E{(bf16_t*)(F.ws + WS_P), (const float*)(F.ws + WS_ROPE), INP(F, IN_QNA) + l * 128, INP(F, IN_KNA) + l * 128, INP(F, IN_QNC) + l * 128, INP(F, IN_KNC) + l * 128, INP(F, IN_VNB) + l * 512, F.lds + LDSCTL_OFF + 2048};
            pg8::gemm_phase<pg8::EpiPost, pg8::SchedDense>(F.lds, S, E); }
            SEAM(pb + 0); }
        if (IN(pb + 2)) { PROBE_BEGIN(pb + 2); if (PH_ON(4)) phase_mixers(F, l); SEAM(pb + 2); }
        if (IN(pb + 3)) { PROBE_BEGIN(pb + 3); if (PH_ON(5)) phase_groupnorm(F, l); SEAM(pb + 3); }
        if (IN(pb + 4)) { PROBE_BEGIN(pb + 4); if (PH_ON(6)) {
            pg8::SchedDense S; S.init(F.ws + WS_O, F.ws + WS_WOUT + (size_t)l * DM * DM * 2, ctx ? NTOK / 256 : 64, DM / 256, F.G, (int)blockIdx.x, ctx ? 0 : 1);
            float* xb = (float*)(F.ws + WS_XB);
            pg8::EpiResid E;
            if (l == 0) { E.ctxbase = INP(F, IN_CTX); E.latbase = INP(F, IN_X); E.cbs = CTXL; E.lbs = SEQ; }
            else { E.ctxbase = xb; E.latbase = xb + (size_t)CTXL * DM; E.cbs = TPB; E.lbs = TPB; }
            E.xout = xb; E.modl = (const float*)(F.ws + WS_MOD) + (size_t)l * 5 * NMOD; E.parts = (float*)(F.ws + WS_PART);
            pg8::gemm_phase<pg8::EpiResid, pg8::SchedDense>(F.lds, S, E); }
            SEAM(pb + 4); }
        if (IN(pb + 5)) { PROBE_BEGIN(pb + 5); if (PH_ON(7)) phase_rowpass2(F, l); SEAM(pb + 5); }
        if (IN(pb + 6)) { PROBE_BEGIN(pb + 6); if (PH_ON(8)) phase_topk(F, l); SEAM(pb + 6); }
        if (IN(pb + 8)) { PROBE_BEGIN(pb + 8); if (PH_ON(10)) {
            if ((l == 0) ? (FP8_L0 != 0) : (FP8_L1 != 0)) {
                pg8::SchedGrouped<pg8::GK> S; S.init(F.ws + WS_HN8, F.ws + WS_WGU + (size_t)l * NE * 4096 * DM * 2, ctx ? 9 : 8, 16, F.G, (int)blockIdx.x);
                pg8::EpiSwiGLU8 E{(unsigned char*)(F.ws + WS_H)};
                pg8::gemm_phase<pg8::EpiSwiGLU8, pg8::SchedGrouped<pg8::GK>, true, true>(F.lds, S, E, (const unsigned*)(F.ws + WS_OFFS), F.lds + LDSCTL_OFF + 2048);
            } else {
                pg8::SchedGrouped<2 * pg8::GK> S; S.init(F.ws + WS_HN, F.ws + WS_WGU + (size_t)l * NE * 4096 * DM * 2, ctx ? 9 : 8, 16, F.G, (int)blockIdx.x);
                pg8::EpiSwiGLU E{(bf16_t*)(F.ws + WS_H)};
                pg8::gemm_phase<pg8::EpiSwiGLU, pg8::SchedGrouped<2 * pg8::GK>, false, true>(F.lds, S, E, (const unsigned*)(F.ws + WS_OFFS), F.lds + LDSCTL_OFF + 2048);
            } }
            SEAM(pb + 8); }
        if (IN(pb + 9)) { PROBE_BEGIN(pb + 9); if (PH_ON(11)) {
            pg8::EpiDown E{(bf16_t*)(F.ws + WS_XG), (const float*)(F.ws + WS_GATE)};
            if ((l == 0) ? (FP8_L0 != 0) : (FP8_L1 != 0)) {
                pg8::SchedGrouped<pg8::GK> S; S.init(F.ws + WS_H, F.ws + WS_WD + (size_t)l * NE * DM * DM * 2, ctx ? 9 : 8, 8, F.G, (int)blockIdx.x);
                pg8::gemm_phase<pg8::EpiDown, pg8::SchedGrouped<pg8::GK>, true>(F.lds, S, E);
            } else {
                pg8::SchedGrouped<2 * pg8::GK> S; S.init(F.ws + WS_H, F.ws + WS_WD + (size_t)l * NE * DM * DM * 2, ctx ? 9 : 8, 8, F.G, (int)blockIdx.x);
                pg8::gemm_phase<pg8::EpiDown, pg8::SchedGrouped<2 * pg8::GK>, false>(F.lds, S, E);
            } }
            SEAM(pb + 9); }
        if (IN(pb + 10)) { PROBE_BEGIN(pb + 10); if (PH_ON(12)) phase_combine(F, l); if (l + 1 < NLAYER) SEAM(pb + 10); else if (PROBE_MASK & (1u << (pb + 10))) probe_acc += __builtin_amdgcn_s_memrealtime() - probe_t0; }
    }
    if (PROBE_MASK) { const unsigned long long te = __builtin_amdgcn_s_memrealtime(); while (__builtin_amdgcn_s_memrealtime() - te < probe_acc) __builtin_amdgcn_s_sleep(8); }
#undef IN
#undef SEAM
}

extern "C" void kernel_launch(void* const* d_in, const int* in_sizes, int n_in, void* d_out, int out_size, void* d_ws, size_t ws_size, hipStream_t stream) {
    static int grid = 0;
    if (grid == 0) {
        if (n_in != 23 || out_size != NB * SEQ * DM || ws_size < WS_END) { fprintf(stderr, "kernel_launch: shape mismatch: n_in %d out %d ws %zu (need %zu)\n", n_in, out_size, ws_size, (size_t)WS_END); grid = -1; return; }
        int dev = 0, cus = 0, per_cu = 0;
        if (hipGetDevice(&dev) != hipSuccess || hipDeviceGetAttribute(&cus, hipDeviceAttributeMultiprocessorCount, dev) != hipSuccess) { grid = -1; return; }
        if (hipFuncSetAttribute((const void*)fwd_kernel, hipFuncAttributeMaxDynamicSharedMemorySize, LDS_BYTES) != hipSuccess) { fprintf(stderr, "kernel_launch: hipFuncSetAttribute failed\n"); grid = -1; return; }
        if (hipOccupancyMaxActiveBlocksPerMultiprocessor(&per_cu, (const void*)fwd_kernel, 512, LDS_BYTES) != hipSuccess || per_cu < 1) { fprintf(stderr, "kernel_launch: occupancy query says %d\n", per_cu); }
        (void)hipGetLastError();
        grid = cus;
    }
    if (grid < 0) return;
    if (hipMemsetAsync((char*)d_ws + WS_CTL, 0, CTL_ZERO_BYTES, stream) != hipSuccess) return;
    Args a{};
    for (int i = 0; i < 23; ++i) a.in[i] = (const float*)d_in[i];
    a.out = (float*)d_out; a.ws = (unsigned char*)d_ws;
#if MK_PER_PHASE
    for (int p = 0; p < N_PHASES; ++p) { a.ph_lo = p; a.ph_hi = p + 1; hipLaunchKernelGGL(fwd_kernel, dim3(grid), dim3(512), LDS_BYTES, stream, a); }
#else
    a.ph_lo = 0; a.ph_hi = N_PHASES;
    hipLaunchKernelGGL(fwd_kernel, dim3(grid), dim3(512), LDS_BYTES, stream, a);
#endif
    const hipError_t le = hipPeekAtLastError();
    if (le != hipSuccess) fprintf(stderr, "kernel_launch: launch failed: %s\n", hipGetErrorName(le));
}
```

```cpp
#include <hip/hip_runtime.h>
#include <cstdio>
#include <cstdint>

#define LAS __attribute__((address_space(3)))
#define GAS __attribute__((address_space(1)))
typedef unsigned short bf16_t;
typedef short bf16x8 __attribute__((ext_vector_type(8)));
typedef short s16x4 __attribute__((ext_vector_type(4)));
typedef float f32x2 __attribute__((ext_vector_type(2)));
typedef float f32x4 __attribute__((ext_vector_type(4)));
typedef float f32x16 __attribute__((ext_vector_type(16)));
typedef unsigned u32x2 __attribute__((ext_vector_type(2)));
typedef unsigned u32x4 __attribute__((ext_vector_type(4)));
typedef int i32x4 __attribute__((ext_vector_type(4)));
typedef int i32x8 __attribute__((ext_vector_type(8)));

#ifndef MK_PER_PHASE
#define MK_PER_PHASE 0
#endif
#ifndef PHASE_MASK
#define PHASE_MASK 0x1fff
#endif
#define PH_ON(k) (((PHASE_MASK) >> (k)) & 1)
#ifndef FP8_L0
#define FP8_L0 1
#endif
#ifndef FP8_L1
#define FP8_L1 1
#endif
#ifndef PROBE_MASK
#define PROBE_MASK 0u
#endif
#ifndef DBG_STOP
#define DBG_STOP 0
#endif

constexpr int DM = 2048, NB = 4, SEQ = 4096, CTXL = 256, TPB = SEQ + CTXL, NTOK = NB * TPB;
constexpr int INW = 3584, NE = 16, NLAYER = 2, NMOD = 6 * DM;
constexpr int C_QA = 0, C_KA = 768, C_VA = 1024, C_UB = 1280, C_VB = 1792, C_QC = 2304, C_KC = 3072, C_VC = 3328;
constexpr int O_A = 0, O_B = 768, O_C = 1280;
constexpr int CAP_L = 512, CAP_C = 32, ROWS_E = 2304;
constexpr float EPS = 1e-6f;

constexpr size_t MiB = 1u << 20;
constexpr size_t WS_CTL = 0, CTL_ZERO_BYTES = 65536;
constexpr size_t WS_MOD = 1 * MiB;
constexpr size_t WS_ROPE = 2 * MiB;
constexpr size_t WS_AFFL = 3 * MiB;
constexpr size_t WS_AFFC = 4 * MiB;
constexpr size_t WS_POSL = 5 * MiB;
constexpr size_t WS_POSC = 6 * MiB;
constexpr size_t WS_OFFS = 10 * MiB;
constexpr size_t WS_GATE = 8 * MiB;
constexpr size_t WS_WRT = 9 * MiB;
constexpr size_t WS_WRS = 11 * MiB;
constexpr size_t WS_GS2 = 12 * MiB;
constexpr size_t WS_PART = 13 * MiB;
constexpr size_t WS_WIN = 16 * MiB;
constexpr size_t WS_WOUT = WS_WIN + (size_t)2 * INW * DM * 2;
constexpr size_t WS_WGU = WS_WOUT + (size_t)2 * DM * DM * 2;
constexpr size_t WS_WD = WS_WGU + (size_t)2 * NE * 4096 * DM * 2;
constexpr size_t WS_HN = WS_WD + (size_t)2 * NE * DM * DM * 2;
constexpr size_t WS_P = WS_HN + (size_t)NTOK * DM * 2;
constexpr size_t WS_O = WS_P + (size_t)NTOK * INW * 2;
constexpr size_t WS_XB = WS_O + (size_t)NTOK * DM * 2;
constexpr size_t WS_XG = WS_XB + (size_t)NTOK * DM * 4;
constexpr size_t WS_H = WS_XG + (size_t)NE * ROWS_E * DM * 2;
constexpr size_t WS_HN8 = WS_H + (size_t)NE * ROWS_E * DM * 2;
constexpr size_t WS_END = WS_HN8 + (size_t)NTOK * DM;
constexpr float W8_SCALE = 32.f; constexpr int W8_SCALE_E8M0 = 127 - 5;
constexpr int CW_BAR = 4096, CW_QUEUE = 8192;

constexpr int RING_BYTES = 131072, LDSCTL_OFF = RING_BYTES, MISC_OFF = LDSCTL_OFF + 320, LDS_BYTES = 147456;

#define LDS_WAIT() asm volatile("s_waitcnt lgkmcnt(0)" ::: "memory")
#define VM_WAIT() asm volatile("s_waitcnt vmcnt(0)" ::: "memory")
__device__ __forceinline__ unsigned f2bf(float f) { unsigned u = __builtin_bit_cast(unsigned, f); return (u + 0x7fffu + ((u >> 16) & 1u)) >> 16; }
__device__ __forceinline__ unsigned pk2(float lo, float hi) { return f2bf(lo) | (f2bf(hi) << 16); }
__device__ __forceinline__ float bf2f(unsigned short b) { return __builtin_bit_cast(float, ((unsigned)b) << 16); }
__device__ __forceinline__ float bflo(unsigned w) { return __builtin_bit_cast(float, w << 16); }
__device__ __forceinline__ float bfhi(unsigned w) { return __builtin_bit_cast(float, w & 0xffff0000u); }
__device__ __forceinline__ unsigned pk4_fp8(float a, float b, float c, float d) {
    int r = __builtin_amdgcn_cvt_pk_fp8_f32(a, b, 0, false); r = __builtin_amdgcn_cvt_pk_fp8_f32(c, d, r, true); return (unsigned)r; }
__device__ __forceinline__ int opaque_tid() { int t = threadIdx.x; asm volatile("" : "+v"(t)); return t; }
__device__ __forceinline__ float row16_sum(float v) {
    v += __builtin_bit_cast(float, __builtin_amdgcn_update_dpp(0, __builtin_bit_cast(int, v), 0xB1, 0xF, 0xF, true));
    v += __builtin_bit_cast(float, __builtin_amdgcn_update_dpp(0, __builtin_bit_cast(int, v), 0x4E, 0xF, 0xF, true));
    v += __builtin_bit_cast(float, __builtin_amdgcn_update_dpp(0, __builtin_bit_cast(int, v), 0x141, 0xF, 0xF, true));
    v += __builtin_bit_cast(float, __builtin_amdgcn_update_dpp(0, __builtin_bit_cast(int, v), 0x140, 0xF, 0xF, true));
    return v;
}
__device__ __forceinline__ float wave_sum(float v) {
    v = row16_sum(v);
    const int iv = __builtin_bit_cast(int, v);
    const float a = __builtin_bit_cast(float, __builtin_amdgcn_readlane(iv, 0)), b = __builtin_bit_cast(float, __builtin_amdgcn_readlane(iv, 16));
    const float c = __builtin_bit_cast(float, __builtin_amdgcn_readlane(iv, 32)), d = __builtin_bit_cast(float, __builtin_amdgcn_readlane(iv, 48));
    return (a + b) + (c + d);
}
__device__ __forceinline__ float rsqrt_fast(float x) { return __builtin_amdgcn_rsqf(x); }
__device__ __forceinline__ float gelu_tanh(float x) {
    const float u = 0.7978845608028654f * (x + 0.044715f * x * x * x);
    const float e = __expf(2.f * u);
    const float th = 1.f - 2.f / (e + 1.f);
    return 0.5f * x * (1.f + th);
}

#define XB_TMO      128
#define XB_XCNT(j)  (256  + 64 * (j))
#define XB_XSUB(j)  (1280 + 64 * (j))
#define XB_XGEN(j)  (2304 + 64 * (j))
#define XB_TOP      3328
#define XB_TOPGEN   3392
#define XCD_BAR_WORDS 3456
#define XB_SPIN_CAP (1u << 18)
__device__ __forceinline__ unsigned xb_ld(unsigned* p)              { return __hip_atomic_load(p, __ATOMIC_RELAXED, __HIP_MEMORY_SCOPE_AGENT); }
__device__ __forceinline__ unsigned xb_add(unsigned* p, unsigned v) { return __hip_atomic_fetch_add(p, v, __ATOMIC_RELAXED, __HIP_MEMORY_SCOPE_AGENT); }
__device__ __forceinline__ unsigned xb_xcc_id() { return (unsigned)__builtin_amdgcn_s_getreg((3 << 11) | 20) & 0xFu; }
#define XB_SPIN(cond, bar) do { unsigned _sp = 0; while (cond) { __builtin_amdgcn_s_sleep(1); \
    if ((++_sp & 255u) == 0u) { if (xb_ld(&(bar)[XB_TMO])) break; if (_sp > XB_SPIN_CAP) { atomicAdd(&(bar)[XB_TMO], 1u); break; } } } } while (0)
struct XcdBarrier { unsigned* bar; unsigned x; volatile LAS unsigned* st; };
__device__ __forceinline__ XcdBarrier xcd_barrier_post(unsigned* bar, volatile LAS unsigned* st) {
    XcdBarrier b; b.bar = bar; b.x = xb_xcc_id(); b.st = st;
    if (threadIdx.x == 0) (void)xb_add(&bar[XB_XCNT(b.x)], 1u);
    return b;
}
__device__ __forceinline__ void xcd_barrier_complete(unsigned* bar, unsigned x, unsigned& nloc, unsigned& nx) {
    const unsigned G = gridDim.x * gridDim.y * gridDim.z;
    unsigned sum, cnt, mine, sp = 0u;
    for (;;) {
        sum = 0u; cnt = 0u; mine = 0u;
#pragma unroll
        for (unsigned j = 0; j < 16; ++j) { const unsigned c = xb_ld(&bar[XB_XCNT(j)]); sum += c; cnt += (c > 0u) ? 1u : 0u; mine = (j == x) ? c : mine; }
        if (sum == G) break;
        __builtin_amdgcn_s_sleep(1);
        if ((++sp & 255u) == 0u) { if (xb_ld(&bar[XB_TMO])) break; if (sp > XB_SPIN_CAP) { atomicAdd(&bar[XB_TMO], 1u); break; } }
    }
    nloc = mine > 0u ? mine : 1u; nx = cnt > 0u ? cnt : 1u;
}
template <bool FIRST>
__device__ __forceinline__ void xcd_barrier_t(const XcdBarrier& b) {
    asm volatile("s_waitcnt vmcnt(0)" ::: "memory");
    __syncthreads();
    if (threadIdx.x == 0) {
        unsigned* bar = b.bar;
        asm volatile("" : "+s"(bar));
        __builtin_amdgcn_s_waitcnt(0);
        unsigned nloc = b.st[0], nx = b.st[1];
        if constexpr (FIRST) { if (nloc == 0u) { xcd_barrier_complete(bar, b.x, nloc, nx); b.st[0] = nloc; b.st[1] = nx; } }
        const unsigned old = xb_add(&bar[XB_XSUB(b.x)], 1u);
        const unsigned gen = old / nloc;
        if (old + 1u == (gen + 1u) * nloc) {
            __builtin_amdgcn_fence(__ATOMIC_RELEASE, "agent");
            asm volatile("s_waitcnt vmcnt(0)" ::: "memory");
            const unsigned og = xb_add(&bar[XB_TOP], 1u);
            const unsigned tg = og / nx;
            if (og + 1u == (tg + 1u) * nx) xb_add(&bar[XB_TOPGEN], 1u);
            else XB_SPIN(xb_ld(&bar[XB_TOPGEN]) == tg, bar);
            __builtin_amdgcn_fence(__ATOMIC_ACQUIRE, "agent");
            xb_add(&bar[XB_XGEN(b.x)], 1u);
            asm volatile("s_waitcnt vmcnt(0)" ::: "memory");
        } else {
            XB_SPIN(xb_ld(&bar[XB_XGEN(b.x)]) == gen, bar);
            __builtin_amdgcn_fence(__ATOMIC_ACQUIRE, "agent");
            asm volatile("s_waitcnt vmcnt(0)" ::: "memory");
        }
    }
    __syncthreads();
}
__device__ __forceinline__ void xcd_barrier(const XcdBarrier& b) { xcd_barrier_t<false>(b); }
__device__ __forceinline__ void xcd_barrier_first(const XcdBarrier& b) { xcd_barrier_t<true>(b); }

namespace pg8 {
constexpr int BM = 256, BK = 64, HALF = 128, HTB = HALF * BK * 2, STAGE_BYTES = 8 * HTB, NXCD = 8, WGM = 8;
constexpr int GK = 2048;
__host__ __device__ __forceinline__ int lds_byte(int r, int c) { const int st = (r >> 4) * 2 + (c >> 5), rr = r & 15, cc = c & 31, ob = rr * 64 + cc * 2; return st * 1024 + (ob ^ (((ob >> 9) & 1) << 5)); }
__host__ __device__ __forceinline__ void stage_rc(int b, int& R, int& C) { const int st = b / 1024, sb = b % 1024, swz = sb ^ (((sb >> 9) & 1) << 5); R = (st >> 1) * 16 + swz / 64; C = (st & 1) * 32 + (swz % 64) / 2; }
__host__ __device__ __forceinline__ int perm32(int rho) { const int n = rho >> 4, i = rho & 15; return 8 * (i >> 2) + 4 * n + (i & 3); }

struct Unit { int pm, pn, e, rowbase, colbase, oidx; const char* a; const char* b; };

struct SchedDense {
    static constexpr int RB = GK * 2;
    const char* A; const char* Bt; int nM, nN, nwg, G, c, skipctx;
    __device__ void init(const void* A_, const void* Bt_, int nM_, int nN_, int G_, int c_, int skipctx_) { A = (const char*)A_; Bt = (const char*)Bt_; nM = nM_; nN = nN_; nwg = nM * nN; G = G_; c = c_; skipctx = skipctx_; }
    __device__ bool next(int i, Unit& u) const {
        const long L = (long)i * G + c; if (L >= nwg) return false;
        int wgid = (int)L; { const int q = nwg / NXCD, r = nwg % NXCD, xcd = wgid % NXCD, off = wgid / NXCD; wgid = (xcd < r ? xcd * (q + 1) : r * (q + 1) + (xcd - r) * q) + off; }
        const int nig = WGM * nN, gid = wgid / nig, fm = gid * WGM, gsz = (nM - fm) < WGM ? (nM - fm) : WGM;
        int pm = fm + ((wgid % nig) % gsz); const int pn = (wgid % nig) / gsz;
        if (skipctx) pm = (pm >> 4) * 17 + 1 + (pm & 15);
        u.pm = pm; u.pn = pn; u.e = 0; u.rowbase = pm * BM; u.colbase = pn * BM; u.oidx = 0;
        u.a = A + (size_t)pm * (BM * GK * 2); u.b = Bt + (size_t)pn * (BM * GK * 2); return true;
    }
};
template <int RB_> struct SchedGrouped {
    static constexpr int RB = RB_;
    const char* A; const char* Bt; int nMe, nNe, nwg, G, c;
    __device__ void init(const void* A_, const void* Bt_, int nMe_, int nNe_, int G_, int c_) { A = (const char*)A_; Bt = (const char*)Bt_; nMe = nMe_; nNe = nNe_; nwg = NE * nMe * nNe; G = G_; c = c_; }
    __device__ bool next(int i, Unit& u) const {
        const long L = (long)i * G + c; if (L >= nwg) return false;
        const int per = nMe * nNe, e = (int)L / per, rem = (int)L % per, pm = rem % nMe, pn = rem / nMe;
        u.pm = pm; u.pn = pn; u.e = e; u.rowbase = e * ROWS_E + pm * BM; u.colbase = pn * BM; u.oidx = e * 9 + pm;
        u.a = A + (size_t)(e * ROWS_E + pm * BM) * RB; u.b = Bt + ((size_t)e * nNe + pn) * (BM * RB); return true;
    }
};

__device__ __forceinline__ unsigned cvt_pk_bf16(float lo, float hi) { unsigned r; asm volatile("v_cvt_pk_bf16_f32 %0, %1, %2" : "=v"(r) : "v"(lo), "v"(hi)); return r; }

struct EpiStoreBf16 {
    static constexpr bool PERM = true;
    bf16_t* O; int ldc;
    __device__ __forceinline__ void operator()(const f32x4 (&acc)[2][2][4][2], const Unit& u, int wr, int wc, int fr, int fq) const {
        const int row0 = u.rowbase + wr * 64 + fr, col0 = u.colbase + wc * 32 + 8 * fq;
#pragma unroll
        for (int ai = 0; ai < 2; ++ai)
#pragma unroll
            for (int m = 0; m < 4; ++m) { bf16_t* rowp = O + (size_t)(row0 + ai * HALF + m * 16) * ldc + col0;
#pragma unroll
                for (int bj = 0; bj < 2; ++bj) { const f32x4 v0 = acc[ai][bj][m][0], v1 = acc[ai][bj][m][1];
                    u32x4 w; w.x = cvt_pk_bf16(v0[0], v0[1]); w.y = cvt_pk_bf16(v0[2], v0[3]); w.z = cvt_pk_bf16(v1[0], v1[1]); w.w = cvt_pk_bf16(v1[2], v1[3]);
                    *(u32x4*)(rowp + bj * HALF) = w; } }
    }
};
struct EpiPost {
    static constexpr bool PERM = true;
    bf16_t* P; const float* rope; const float* qna; const float* kna; const float* qnc; const float* knc; const float* vnb; LAS unsigned char* tab;
    __device__ __forceinline__ void operator()(f32x4 (&acc)[2][2][4][2], const Unit& u, int wr, int wc, int fr, int fq) const {
        const int tb = u.pm % 17; const bool lat = tb != 0;
        const int d0 = 64 * (wc >> 1) + 16 * (wc & 1) + 4 * fq, rl0 = wr * 64 + fr;
        int typ[2]; const float* gain[2];
#pragma unroll
        for (int bj = 0; bj < 2; ++bj) { const int slot = 2 * u.pn + bj;
            typ[bj] = (slot < 8) ? 3 : (slot < 10) ? 0 : (slot < 14) ? 1 : (slot < 18) ? 2 : (slot < 26) ? 3 : 0;
            gain[bj] = (slot < 6) ? qna : (slot < 8) ? kna : (slot < 18) ? vnb + ((slot - 14) & 3) * 128 : (slot < 24) ? qnc : knc; }
        const bool anynorm = typ[0] >= 2 || typ[1] >= 2;
#pragma unroll
        for (int bj = 0; bj < 2; ++bj) if (typ[bj] == 1 || typ[bj] == 2) {
#pragma unroll
            for (int ai = 0; ai < 2; ++ai)
#pragma unroll
                for (int m = 0; m < 4; ++m)
#pragma unroll
                    for (int n = 0; n < 2; ++n)
#pragma unroll
                        for (int j = 0; j < 4; ++j) acc[ai][bj][m][n][j] = gelu_tanh(acc[ai][bj][m][n][j]); }
        if (anynorm) {
#pragma unroll
            for (int bj = 0; bj < 2; ++bj) if (typ[bj] >= 2) {
#pragma unroll
                for (int ai = 0; ai < 2; ++ai)
#pragma unroll
                    for (int m = 0; m < 4; ++m) { const f32x4 a = acc[ai][bj][m][0], b = acc[ai][bj][m][1];
                        float ss = ((a.x * a.x + a.y * a.y) + (a.z * a.z + a.w * a.w)) + ((b.x * b.x + b.y * b.y) + (b.z * b.z + b.w * b.w));
                        ss += __builtin_bit_cast(float, __builtin_amdgcn_ds_swizzle(__builtin_bit_cast(int, ss), 0x401F));
                        { auto rr = __builtin_amdgcn_permlane32_swap(__float_as_uint(ss), __float_as_uint(ss), false, false); ss = __uint_as_float(rr[0]) + __uint_as_float(rr[1]); }
                        if (fq == 0) *(LAS float*)(tab + (((rl0 + ai * HALF + m * 16) * 2 + bj) * 4 + wc) * 4) = ss; } }
            asm volatile("s_waitcnt lgkmcnt(0)" ::: "memory"); __builtin_amdgcn_s_barrier(); asm volatile("" ::: "memory");
        }
#pragma unroll
        for (int bj = 0; bj < 2; ++bj) {
            const int slot = 2 * u.pn + bj;
            f32x4 g0 = (f32x4){1.f, 1.f, 1.f, 1.f}, g1 = g0;
            if (typ[bj] >= 2) { g0 = *(const f32x4*)(gain[bj] + d0); g1 = *(const f32x4*)(gain[bj] + d0 + 32); }
#pragma unroll
            for (int ai = 0; ai < 2; ++ai)
#pragma unroll
                for (int m = 0; m < 4; ++m) { const int rl = rl0 + ai * HALF + m * 16;
                    f32x4 a = acc[ai][bj][m][0], b = acc[ai][bj][m][1];
                    if (typ[bj] >= 2) { const f32x4 t = *(const LAS f32x4*)(tab + ((rl * 2 + bj) * 4) * 4);
                        const float rinv = rsqrt_fast(((t.x + t.y) + (t.z + t.w)) * (1.f / 128) + EPS);
                        a = a * rinv * g0; b = b * rinv * g1; }
                    if (typ[bj] == 3 && lat) { const int pos = (tb - 1) * 256 + rl, pp = (wc >> 1) ? (pos & 63) : (pos >> 6);
                        const f32x4* cs = (const f32x4*)(rope + 2 * (pp * 32 + 16 * (wc & 1) + 4 * fq)); const f32x4 c0 = cs[0], c1 = cs[1];
                        const f32x4 cv = (f32x4){c0.x, c0.z, c1.x, c1.z}, sv = (f32x4){c0.y, c0.w, c1.y, c1.w};
                        const f32x4 ra = a * cv - b * sv, rb = b * cv + a * sv; a = ra; b = rb; }
                    bf16_t* rowp = P + (size_t)(u.rowbase + rl) * INW + slot * 128 + d0;
                    u32x2 w0, w1; w0.x = cvt_pk_bf16(a.x, a.y); w0.y = cvt_pk_bf16(a.z, a.w); w1.x = cvt_pk_bf16(b.x, b.y); w1.y = cvt_pk_bf16(b.z, b.w);
                    *(u32x2*)rowp = w0; *(u32x2*)(rowp + 32) = w1; }
        }
    }
};
struct EpiResid {
    static constexpr bool PERM = false;
    const float* ctxbase; const float* latbase; int cbs, lbs;
    float* xout; const float* modl;
    float* parts;
    __device__ __forceinline__ void operator()(const f32x4 (&acc)[2][2][4][2], const Unit& u, int wr, int wc, int fr, int fq) const {
        const int b = u.pm / 17, tb = u.pm % 17;
        const float* src = (tb == 0) ? ctxbase + (size_t)b * cbs * DM : latbase + ((size_t)b * lbs + (size_t)(tb - 1) * 256) * DM;
        const float* g1 = modl + (size_t)((tb == 0) ? 4 : b) * NMOD + 2 * DM;
        const int rl0 = wr * 64 + fr, col0 = u.colbase + wc * 32 + 4 * fq;
        f32x4 gv[2][2];
#pragma unroll
        for (int bj = 0; bj < 2; ++bj)
#pragma unroll
            for (int n = 0; n < 2; ++n) gv[bj][n] = *(const f32x4*)(g1 + col0 + bj * HALF + n * 16);
#pragma unroll
        for (int ai = 0; ai < 2; ++ai)
#pragma unroll
        for (int mh = 0; mh < 2; ++mh) {
            f32x4 xv[2][2][2];
#pragma unroll
            for (int mm = 0; mm < 2; ++mm) { const float* sp = src + (size_t)(rl0 + ai * HALF + (2 * mh + mm) * 16) * DM + col0;
#pragma unroll
                for (int bj = 0; bj < 2; ++bj)
#pragma unroll
                    for (int n = 0; n < 2; ++n) xv[mm][bj][n] = *(const f32x4*)(sp + bj * HALF + n * 16); }
#pragma unroll
            for (int mm = 0; mm < 2; ++mm) { const int m = 2 * mh + mm, rl = rl0 + ai * HALF + m * 16; float* dp = xout + (size_t)(u.rowbase + rl) * DM + col0; float ss = 0.f;
#pragma unroll
                for (int bj = 0; bj < 2; ++bj)
#pragma unroll
                    for (int n = 0; n < 2; ++n) { const f32x4 y = xv[mm][bj][n] + gv[bj][n] * acc[ai][bj][m][n]; *(f32x4*)(dp + bj * HALF + n * 16) = y;
                        ss += (y.x * y.x + y.y * y.y) + (y.z * y.z + y.w * y.w); }
                ss += __builtin_bit_cast(float, __builtin_amdgcn_ds_swizzle(__builtin_bit_cast(int, ss), 0x401F));
                { auto rr = __builtin_amdgcn_permlane32_swap(__float_as_uint(ss), __float_as_uint(ss), false, false); ss = __uint_as_float(rr[0]) + __uint_as_float(rr[1]); }
                if (fq == 0) parts[(size_t)(u.rowbase + rl) * 32 + u.pn * 4 + wc] = ss; }
            asm volatile("" ::: "memory");
        }
    }
};
struct EpiSwiGLU {
    static constexpr bool PERM = true;
    bf16_t* Hout;
    __device__ __forceinline__ void operator()(const f32x4 (&acc)[2][2][4][2], const Unit& u, int wr, int wc, int fr, int fq) const {
        const int row0 = u.rowbase + wr * 64 + fr, col0 = u.pn * HALF + wc * 32 + 8 * fq;
#pragma unroll
        for (int ai = 0; ai < 2; ++ai)
#pragma unroll
            for (int m = 0; m < 4; ++m) { bf16_t* rowp = Hout + (size_t)(row0 + ai * HALF + m * 16) * DM + col0; float h[8];
#pragma unroll
                for (int n = 0; n < 2; ++n)
#pragma unroll
                    for (int j = 0; j < 4; ++j) { const float g = acc[ai][0][m][n][j], up = acc[ai][1][m][n][j]; h[n * 4 + j] = g * __builtin_amdgcn_rcpf(1.f + __expf(-g)) * up; }
                u32x4 w; w.x = cvt_pk_bf16(h[0], h[1]); w.y = cvt_pk_bf16(h[2], h[3]); w.z = cvt_pk_bf16(h[4], h[5]); w.w = cvt_pk_bf16(h[6], h[7]);
                *(u32x4*)rowp = w; }
    }
};
struct EpiSwiGLU8 {
    static constexpr bool PERM = true;
    unsigned char* Hout;
    __device__ __forceinline__ void operator()(const f32x4 (&acc)[2][2][4][2], const Unit& u, int wr, int wc, int fr, int fq) const {
        const int row0 = u.rowbase + wr * 64 + fr, col0 = u.pn * HALF + wc * 32 + 8 * fq;
#pragma unroll
        for (int ai = 0; ai < 2; ++ai)
#pragma unroll
            for (int m = 0; m < 4; ++m) { unsigned char* rowp = Hout + (size_t)(row0 + ai * HALF + m * 16) * DM + col0; float h[8];
#pragma unroll
                for (int n = 0; n < 2; ++n)
#pragma unroll
                    for (int j = 0; j < 4; ++j) { const float g = acc[ai][0][m][n][j], up = acc[ai][1][m][n][j]; h[n * 4 + j] = g * __builtin_amdgcn_rcpf(1.f + __expf(-g)) * up; }
                u32x2 w; w.x = pk4_fp8(h[0], h[1], h[2], h[3]); w.y = pk4_fp8(h[4], h[5], h[6], h[7]);
                *(u32x2*)rowp = w; }
    }
};
struct EpiDown {
    static constexpr bool PERM = true;
    bf16_t* Y; const float* gatev;
    __device__ __forceinline__ void operator()(const f32x4 (&acc)[2][2][4][2], const Unit& u, int wr, int wc, int fr, int fq) const {
        const int row0 = u.rowbase + wr * 64 + fr, col0 = u.colbase + wc * 32 + 8 * fq;
#pragma unroll
        for (int ai = 0; ai < 2; ++ai)
#pragma unroll
            for (int m = 0; m < 4; ++m) { const int row = row0 + ai * HALF + m * 16; const float gt = gatev[row]; bf16_t* rowp = Y + (size_t)row * DM + col0;
#pragma unroll
                for (int bj = 0; bj < 2; ++bj) { const f32x4 v0 = acc[ai][bj][m][0] * gt, v1 = acc[ai][bj][m][1] * gt;
                    u32x4 w; w.x = cvt_pk_bf16(v0[0], v0[1]); w.y = cvt_pk_bf16(v0[2], v0[3]); w.z = cvt_pk_bf16(v1[0], v1[1]); w.w = cvt_pk_bf16(v1[2], v1[3]);
                    *(u32x4*)(rowp + bj * HALF) = w; } }
    }
};

template <class Epi, class Sched, bool FP8 = false, bool GATHER = false, bool ALIGN_EPI = true, bool SP2 = true>
__device__ __forceinline__ void gemm_phase(LAS unsigned char* lds, const Sched& S, const Epi& E, const unsigned* goffs = nullptr, LAS unsigned char* goffs_lds = nullptr) {
    static_assert(!GATHER || SP2, "gather mode is written for the SP2 loop");
    static_assert(Sched::RB == (FP8 ? GK : GK * 2), "operand row bytes");
    const int tid = opaque_tid(), wid = __builtin_amdgcn_readfirstlane(tid >> 6), lane = tid & 63, wr = wid >> 2, wc = wid & 3, fr = lane & 15, fq = lane >> 4;
    constexpr int RB = Sched::RB, nt = RB / 128;
    unsigned voffA[2], voffB[2];
#pragma unroll
    for (int i = 0; i < 2; ++i) { int R, C; stage_rc(tid * 16 + i * 8192, R, C); const int Rb = Epi::PERM ? ((R & ~31) + perm32(R & 31)) : R;
        voffA[i] = (unsigned)(R * RB + C * 2); voffB[i] = (unsigned)(Rb * RB + C * 2); }
    const size_t kstep = (size_t)(BK * 2);
    const size_t hstep = (size_t)HALF * RB;
    const unsigned ldsw = (unsigned)wid * 1024u;
    const int aoff = lds_byte(wr * 64 + fr, fq * 8), boff = lds_byte(wc * 32 + fr, fq * 8);
#define PG8_SA(b, h) (((b) * 2 + (h)) * HTB)
#define PG8_SB(b, h) ((4 + (b) * 2 + (h)) * HTB)
#define PG8_STAGE(bufoff, gbase, voff) do { _Pragma("unroll") for (int _i = 0; _i < 2; ++_i) \
        __builtin_amdgcn_global_load_lds((const unsigned*)((const char*)(gbase) + (voff)[_i]), (LAS unsigned*)(lds + (bufoff) + ldsw + _i * 8192), 16, 0, 0); } while (0)
#define PG8_RD8(p) __builtin_shufflevector(*(const LAS i32x4*)(p), *(const LAS i32x4*)((p) + 1024), 0, 1, 2, 3, 4, 5, 6, 7)
#define PG8_LDA(dst, b, h) do { _Pragma("unroll") for (int m = 0; m < 4; ++m) { if constexpr (FP8) dst##8[m] = PG8_RD8(lds + PG8_SA(b, h) + aoff + m * 2048); \
        else { _Pragma("unroll") for (int k = 0; k < 2; ++k) dst[m][k] = *(const LAS bf16x8*)(lds + PG8_SA(b, h) + aoff + m * 2048 + k * 1024); } } } while (0)
#define PG8_LDB(dst, b, h) do { _Pragma("unroll") for (int n = 0; n < 2; ++n) { if constexpr (FP8) dst##8[n] = PG8_RD8(lds + PG8_SB(b, h) + boff + n * 2048); \
        else { _Pragma("unroll") for (int k = 0; k < 2; ++k) dst[n][k] = *(const LAS bf16x8*)(lds + PG8_SB(b, h) + boff + n * 2048 + k * 1024); } } } while (0)
#define PG8_MMA(ai, bj, At, Bt) do { __builtin_amdgcn_s_setprio(1); _Pragma("unroll") for (int m = 0; m < 4; ++m) _Pragma("unroll") for (int n = 0; n < 2; ++n) { \
        if constexpr (FP8) asm volatile("v_mfma_scale_f32_16x16x128_f8f6f4 %0, %1, %2, %0, %3, %4 op_sel_hi:[0,0,0]" : "+v"(acc[ai][bj][m][n]) : "v"(Bt##8[n]), "v"(At##8[m]), "v"(sclW), "v"(sclX)); \
        else { _Pragma("unroll") for (int k = 0; k < 2; ++k) acc[ai][bj][m][n] = __builtin_amdgcn_mfma_f32_16x16x32_bf16(Bt[n][k], At[m][k], acc[ai][bj][m][n], 0, 0, 0); } } \
        __builtin_amdgcn_s_setprio(0); } while (0)
#define PG8_WAIT_V(n) asm volatile("s_waitcnt vmcnt(" #n ")" ::: "memory")
#define PG8_WAIT_L(n) asm volatile("s_waitcnt lgkmcnt(" #n ")" ::: "memory")
#define PG8_BAR __builtin_amdgcn_s_barrier()
#define PG8_SCHED __builtin_amdgcn_sched_barrier(0)
    Unit cur, nxt; int ui = 0;
    if (!S.next(0, cur)) return;
    u32x4 gC = (u32x4){0u, 0u, 0u, 0u}, gN = gC;
    if constexpr (GATHER) gC = *(const u32x4*)(goffs + ((size_t)cur.oidx * 512 + tid) * 4);
#define PG8_GSTAGE(bufoff, gbase, o0, o1) do { \
        __builtin_amdgcn_global_load_lds((const unsigned*)((const char*)(gbase) + (o0)), (LAS unsigned*)(lds + (bufoff) + ldsw), 16, 0, 0); \
        __builtin_amdgcn_global_load_lds((const unsigned*)((const char*)(gbase) + (o1)), (LAS unsigned*)(lds + (bufoff) + ldsw + 8192), 16, 0, 0); } while (0)
    f32x4 acc[2][2][4][2];
#pragma unroll
    for (int a = 0; a < 2; ++a)
#pragma unroll
        for (int b = 0; b < 2; ++b)
#pragma unroll
            for (int m = 0; m < 4; ++m)
#pragma unroll
                for (int n = 0; n < 2; ++n) acc[a][b][m][n] = (f32x4){0.f, 0.f, 0.f, 0.f};
    int sclW = W8_SCALE_E8M0 * 0x01010101, sclX = 0x7f7f7f7f; if constexpr (FP8) asm volatile("" : "+v"(sclW), "+v"(sclX)); (void)sclW; (void)sclX;
    bf16x8 At[4][2], B0[2][2], B1[2][2]; i32x8 At8[4], B08[2], B18[2];
    const char* cA = cur.a; const char* cB = cur.b;
    if constexpr (SP2) {
        PG8_STAGE(PG8_SB(0, 0), cB, voffB); PG8_STAGE(PG8_SB(0, 1), cB + hstep, voffB);
        if constexpr (GATHER) { PG8_GSTAGE(PG8_SA(0, 0), S.A, gC.x, gC.y); PG8_GSTAGE(PG8_SA(0, 1), S.A, gC.z, gC.w); }
        else { PG8_STAGE(PG8_SA(0, 0), cA, voffA); PG8_STAGE(PG8_SA(0, 1), cA + hstep, voffA); }
        if (wr == 1) PG8_BAR;
        PG8_WAIT_V(2); PG8_BAR;
        PG8_STAGE(PG8_SB(1, 0), cB + kstep, voffB);
        if constexpr (GATHER) PG8_GSTAGE(PG8_SA(1, 0), S.A + kstep, gC.x, gC.y); else PG8_STAGE(PG8_SA(1, 0), cA + kstep, voffA);
        PG8_STAGE(PG8_SB(1, 1), cB + hstep + kstep, voffB);
        PG8_WAIT_V(6); PG8_BAR;
    } else {
        PG8_STAGE(PG8_SB(0, 0), cB, voffB); PG8_STAGE(PG8_SA(0, 0), cA, voffA); PG8_STAGE(PG8_SB(0, 1), cB + hstep, voffB); PG8_STAGE(PG8_SA(0, 1), cA + hstep, voffA);
        if (wr == 1) PG8_BAR;
        PG8_WAIT_V(4); PG8_BAR;
        PG8_STAGE(PG8_SB(1, 0), cB + kstep, voffB); PG8_STAGE(PG8_SA(1, 0), cA + kstep, voffA); PG8_STAGE(PG8_SB(1, 1), cB + hstep + kstep, voffB);
        PG8_WAIT_V(6); PG8_BAR;
    }
    for (;;) {
        const bool has_next = S.next(ui + 1, nxt);
        const char* nA = has_next ? nxt.a : cA; const char* nB = has_next ? nxt.b : cB;
        if constexpr (GATHER) { if (has_next)
            __builtin_amdgcn_global_load_lds((const unsigned*)(goffs + ((size_t)nxt.oidx * 512 + tid) * 4), (LAS unsigned*)(goffs_lds + ldsw), 16, 0, 0); }
        for (int t = 0; t < nt; t += 2) {
            const bool last = (t == nt - 2);
            const char* a1 = cA + (size_t)(t + 1) * kstep;
            const char* a2 = last ? nA : cA + (size_t)(t + 2) * kstep; const char* b2 = last ? nB : cB + (size_t)(t + 2) * kstep;
            const char* a3 = a2 + kstep; const char* b3 = b2 + kstep;
            const char* g1 = S.A + (size_t)(t + 1) * kstep; const char* g2 = S.A + (last ? (size_t)0 : (size_t)(t + 2) * kstep); const char* g3 = g2 + kstep;
            u32x4 gX = gC;
            if constexpr (GATHER) { if (last) { if (has_next) gN = *(const LAS u32x4*)(goffs_lds + (size_t)tid * 16); else gN = gC; gX = gN; } }
            if constexpr (SP2) {
            PG8_LDB(B0, 0, 0); PG8_LDB(B1, 0, 1); PG8_SCHED; PG8_LDA(At, 0, 0);
            if constexpr (GATHER) PG8_GSTAGE(PG8_SA(1, 1), g1, gC.z, gC.w); else PG8_STAGE(PG8_SA(1, 1), a1 + hstep, voffA);
            PG8_WAIT_V(8); PG8_WAIT_L(0); PG8_BAR; PG8_MMA(0, 0, At, B0); PG8_MMA(0, 1, At, B1); PG8_BAR; PG8_SCHED;
            PG8_LDA(At, 0, 1); PG8_STAGE(PG8_SB(0, 0), b2, voffB); PG8_STAGE(PG8_SB(0, 1), b2 + hstep, voffB);
            if constexpr (GATHER) PG8_GSTAGE(PG8_SA(0, 0), g2, gX.x, gX.y); else PG8_STAGE(PG8_SA(0, 0), a2, voffA);
            PG8_WAIT_V(8); PG8_WAIT_L(0); PG8_BAR; PG8_MMA(1, 0, At, B0); PG8_MMA(1, 1, At, B1); PG8_BAR; PG8_SCHED;
            PG8_LDB(B0, 1, 0); PG8_LDB(B1, 1, 1); PG8_SCHED; PG8_LDA(At, 1, 0);
            if constexpr (GATHER) PG8_GSTAGE(PG8_SA(0, 1), g2, gX.z, gX.w); else PG8_STAGE(PG8_SA(0, 1), a2 + hstep, voffA);
            PG8_WAIT_V(8); PG8_WAIT_L(0); PG8_BAR; PG8_MMA(0, 0, At, B0); PG8_MMA(0, 1, At, B1); PG8_BAR; PG8_SCHED;
            PG8_LDA(At, 1, 1); PG8_STAGE(PG8_SB(1, 0), b3, voffB); PG8_STAGE(PG8_SB(1, 1), b3 + hstep, voffB);
            if constexpr (GATHER) PG8_GSTAGE(PG8_SA(1, 0), g3, gX.x, gX.y); else PG8_STAGE(PG8_SA(1, 0), a3, voffA);
            PG8_WAIT_V(8); PG8_WAIT_L(0); PG8_BAR; PG8_MMA(1, 0, At, B0); PG8_MMA(1, 1, At, B1); PG8_BAR; PG8_SCHED;
            } else {
            PG8_LDB(B0, 0, 0); PG8_SCHED; PG8_LDA(At, 0, 0); PG8_STAGE(PG8_SA(1, 1), a1 + hstep, voffA);
            PG8_WAIT_L(8); PG8_BAR; PG8_WAIT_L(0); PG8_MMA(0, 0, At, B0); PG8_BAR; PG8_SCHED;
            PG8_LDB(B1, 0, 1); PG8_STAGE(PG8_SB(0, 0), b2, voffB);
            PG8_BAR; PG8_WAIT_L(0); PG8_MMA(0, 1, At, B1); PG8_BAR;
            PG8_LDA(At, 0, 1); PG8_STAGE(PG8_SA(0, 0), a2, voffA);
            PG8_BAR; PG8_WAIT_L(0); PG8_MMA(1, 0, At, B0); PG8_BAR; PG8_SCHED;
            PG8_STAGE(PG8_SB(0, 1), b2 + hstep, voffB);
            PG8_WAIT_V(6); PG8_BAR; PG8_MMA(1, 1, At, B1); PG8_BAR;
            PG8_LDB(B0, 1, 0); PG8_SCHED; PG8_LDA(At, 1, 0); PG8_STAGE(PG8_SA(0, 1), a2 + hstep, voffA);
            PG8_WAIT_L(8); PG8_BAR; PG8_WAIT_L(0); PG8_MMA(0, 0, At, B0); PG8_BAR; PG8_SCHED;
            PG8_LDB(B1, 1, 1); PG8_STAGE(PG8_SB(1, 0), b3, voffB);
            PG8_BAR; PG8_WAIT_L(0); PG8_MMA(0, 1, At, B1); PG8_BAR;
            PG8_LDA(At, 1, 1); PG8_STAGE(PG8_SA(1, 0), a3, voffA);
            PG8_BAR; PG8_WAIT_L(0); PG8_MMA(1, 0, At, B0); PG8_BAR; PG8_SCHED;
            PG8_STAGE(PG8_SB(1, 1), b3 + hstep, voffB);
            PG8_WAIT_V(6); PG8_BAR; PG8_MMA(1, 1, At, B1); PG8_BAR;
            }
        }
        if constexpr (ALIGN_EPI) { if (wr == 0) PG8_BAR; }
        if constexpr (FP8) asm volatile("s_nop 15\n\ts_nop 15\n\ts_nop 7" ::: "memory");
        E(acc, cur, wr, wc, fr, fq);
        if (!has_next) break;
#pragma unroll
        for (int a = 0; a < 2; ++a)
#pragma unroll
            for (int b = 0; b < 2; ++b)
#pragma unroll
                for (int m = 0; m < 4; ++m)
#pragma unroll
                    for (int n = 0; n < 2; ++n) acc[a][b][m][n] = (f32x4){0.f, 0.f, 0.f, 0.f};
        cur = nxt; cA = nA; cB = nB; ++ui; gC = gN;
        if constexpr (ALIGN_EPI) { if (wr == 1) PG8_BAR; }
    }
    PG8_WAIT_V(0);
    if constexpr (!ALIGN_EPI) { if (wr == 0) PG8_BAR; }
    PG8_BAR;
#undef PG8_SA
#undef PG8_SB
#undef PG8_STAGE
#undef PG8_GSTAGE
#undef PG8_LDA
#undef PG8_LDB
#undef PG8_MMA
#undef PG8_RD8
#undef PG8_WAIT_V
#undef PG8_WAIT_L
#undef PG8_BAR
#undef PG8_SCHED
}
}

namespace at {
constexpr int D = 128, NW = 8, QBLK = 32, KVBLK = 64;
constexpr float SCALE = 0.088388347648318440f;
constexpr float THR = 8.f;
constexpr int LDQ = INW, LDK = INW, LDO = DM;
constexpr size_t SHM_V = KVBLK * D * 2, SHM_K = KVBLK * D * 2, SHM_ATTN = 2 * SHM_V + 2 * SHM_K + NW * 64 * 4;
#define KSWZ(row, colB) ((row) * 256 + ((colB) ^ (((row) & 7) << 4)))
#define SBAR() __builtin_amdgcn_sched_barrier(0)
__device__ __forceinline__ int crow(int r, int hi) { return (r & 3) + 8 * (r >> 2) + 4 * hi; }
__device__ __forceinline__ unsigned cvtpk(float lo, float hi) { unsigned r; asm volatile("v_cvt_pk_bf16_f32 %0, %1, %2" : "=v"(r) : "v"(lo), "v"(hi)); return r; }

__device__ __forceinline__ void partialSM(f32x16& p0, f32x16& p1, float& m_reg, float& mn, float& alpha, bool domask, int dq, int hi) {
  constexpr float C = SCALE * 1.4426950408889634f;
  {
    if (domask) {
#pragma unroll
      for (int r = 0; r < 16; ++r) { const int d0 = dq + crow(r, hi), d1 = d0 + 32;
        if (d0 > 128 || d0 < -128) p0[r] = -1e30f;
        if (d1 > 128 || d1 < -128) p1[r] = -1e30f; }
    }
  }
  float pmax = p0[0]; for (int r = 1; r < 16; ++r) pmax = fmaxf(pmax, p0[r]); for (int r = 0; r < 16; ++r) pmax = fmaxf(pmax, p1[r]);
  { auto rr = __builtin_amdgcn_permlane32_swap(__float_as_uint(pmax), __float_as_uint(pmax), false, false);
    pmax = fmaxf(__uint_as_float(rr[0]), __uint_as_float(rr[1])); }
  if (__builtin_expect(__all(pmax - m_reg <= THR / SCALE), 1)) { mn = m_reg; alpha = 1.f; }
  else { mn = fmaxf(m_reg, pmax); alpha = __builtin_amdgcn_exp2f((m_reg - mn) * C); m_reg = mn; }
  float mnC = -mn * C;
  for (int r = 0; r < 16; ++r) p0[r] = fmaf(p0[r], C, mnC); for (int r = 0; r < 16; ++r) p1[r] = fmaf(p1[r], C, mnC);
  for (int r = 0; r < 16; ++r) p0[r] = __builtin_amdgcn_exp2f(p0[r]);
}
__device__ __forceinline__ void finishSM(f32x16& p0, f32x16& p1, float alpha, float& l_reg, bf16x8& pa0, bf16x8& pa1, bf16x8& pa2, bf16x8& pa3) {
  for (int r = 0; r < 16; ++r) p1[r] = __builtin_amdgcn_exp2f(p1[r]);
  float ps = 0; for (int r = 0; r < 16; ++r) ps += p0[r]; for (int r = 0; r < 16; ++r) ps += p1[r];
  { auto rr = __builtin_amdgcn_permlane32_swap(__float_as_uint(ps), __float_as_uint(ps), false, false);
    ps = __uint_as_float(rr[0]) + __uint_as_float(rr[1]); }
  l_reg = l_reg * alpha + ps;
#define PK4(P, BASE, OUT) do { unsigned a0 = cvtpk(P[BASE + 0], P[BASE + 1]), a1 = cvtpk(P[BASE + 2], P[BASE + 3]);   \
    unsigned b0 = cvtpk(P[BASE + 4], P[BASE + 5]), b1 = cvtpk(P[BASE + 6], P[BASE + 7]);                              \
    auto r0 = __builtin_amdgcn_permlane32_swap(a0, b0, false, false); auto r1 = __builtin_amdgcn_permlane32_swap(a1, b1, false, false); \
    u32x4 w = {r0[0], r1[0], r0[1], r1[1]}; OUT = *reinterpret_cast<bf16x8*>(&w); } while (0)
  PK4(p0, 0, pa0); PK4(p0, 8, pa1); PK4(p1, 0, pa2); PK4(p1, 8, pa3);
#undef PK4
}
__device__ __forceinline__ void qkt(f32x16& p0, f32x16& p1, const char* Ks, const bf16x8* qr, int ka0) {
  p0 = f32x16{}; p1 = f32x16{};
  asm volatile("" : "+v"(ka0));
#pragma unroll
  for (int d0 = 0; d0 < 8; ++d0) { const int off = ka0 ^ (d0 * 32);
    bf16x8 b0 = *reinterpret_cast<const bf16x8*>(Ks + off);
    bf16x8 b1 = *reinterpret_cast<const bf16x8*>(Ks + off + 32 * 256);
    p0 = __builtin_amdgcn_mfma_f32_32x32x16_bf16(b0, qr[d0], p0, 0, 0, 0);
    p1 = __builtin_amdgcn_mfma_f32_32x32x16_bf16(b1, qr[d0], p1, 0, 0, 0); }
}
__device__ __forceinline__ int v_st(int k, int c) { const int kk = (k & ~0xC) | ((k & 4) << 1) | ((k & 8) >> 1); return ((kk >> 3) * 4 + (c >> 5)) * 512 + ((kk & 7) * 32 + (c & 31)) * 2; }
__device__ __forceinline__ int v_rd_base(int lane) { return ((lane & 3) << 3) | (((lane >> 2) & 3) << 6) | (((lane >> 4) & 1) << 5) | (((lane >> 5) & 1) << 8); }
constexpr int v_rd_off(int d0, int ks, int half) { return d0 * 512 + ks * 4096 + half * 2048; }
template <int OFF> __device__ __forceinline__ s16x4 tr_read(int vb) {
  s16x4 r; asm volatile("ds_read_b64_tr_b16 %0, %1 offset:%2" : "=&v"(r) : "v"(vb), "i"(OFF) : "memory"); return r;
}
template <int D0> __device__ __forceinline__ void pv_one(f32x16& od, int vb, bf16x8 pa0, bf16x8 pa1, bf16x8 pa2, bf16x8 pa3) {
  const s16x4 l0 = tr_read<v_rd_off(D0, 0, 0)>(vb), h0 = tr_read<v_rd_off(D0, 0, 1)>(vb), l1 = tr_read<v_rd_off(D0, 1, 0)>(vb), h1 = tr_read<v_rd_off(D0, 1, 1)>(vb);
  const s16x4 l2 = tr_read<v_rd_off(D0, 2, 0)>(vb), h2 = tr_read<v_rd_off(D0, 2, 1)>(vb), l3 = tr_read<v_rd_off(D0, 3, 0)>(vb), h3 = tr_read<v_rd_off(D0, 3, 1)>(vb);
  asm volatile("s_waitcnt lgkmcnt(0)" ::: "memory"); SBAR();
#define PK(L, H) (bf16x8){L[0], L[1], L[2], L[3], H[0], H[1], H[2], H[3]}
  od = __builtin_amdgcn_mfma_f32_32x32x16_bf16(pa0, PK(l0, h0), od, 0, 0, 0);
  od = __builtin_amdgcn_mfma_f32_32x32x16_bf16(pa1, PK(l1, h1), od, 0, 0, 0);
  od = __builtin_amdgcn_mfma_f32_32x32x16_bf16(pa2, PK(l2, h2), od, 0, 0, 0);
  od = __builtin_amdgcn_mfma_f32_32x32x16_bf16(pa3, PK(l3, h3), od, 0, 0, 0);
#undef PK
}
__device__ __forceinline__ void pv_d0(f32x16* o, int vb, bf16x8 pa0, bf16x8 pa1, bf16x8 pa2, bf16x8 pa3) {
  pv_one<0>(o[0], vb, pa0, pa1, pa2, pa3); pv_one<1>(o[1], vb, pa0, pa1, pa2, pa3); pv_one<2>(o[2], vb, pa0, pa1, pa2, pa3); pv_one<3>(o[3], vb, pa0, pa1, pa2, pa3);
}

__device__ __forceinline__ void attn_body(const bf16_t* __restrict__ Qb, const bf16_t* __restrict__ Kb, const bf16_t* __restrict__ Vb, bf16_t* __restrict__ Ob,
                                          int NT, int kskip, int qpos0, float m0, float l0, bool maskon, char* lds) {
  const int tid = opaque_tid(), wid = tid >> 6, lane = tid & 63, r32 = lane & 31, hi = lane >> 5;
  char* V_lds = lds; char* K_lds = lds + 2 * SHM_V;
  float* ws = (float*)(lds + 2 * SHM_V + 2 * SHM_K) + wid * 64; float* li_l = ws; float* al_l = ws + 32;
  float m_reg = m0, l_reg = l0; f32x16 o[4] = {}; bf16x8 qr[8];
  const bf16_t* Qw = Qb + (long)(wid * QBLK + r32) * LDQ + hi * 8;
#pragma unroll
  for (int d0 = 0; d0 < 8; ++d0) qr[d0] = *reinterpret_cast<const bf16x8*>(Qw + d0 * 16);
  const int sr = tid >> 4, sc = (tid & 15) * 8, vst0 = v_st(sr, sc), kst0 = KSWZ(sr, sc * 2);
  const int vb0 = (int)(uintptr_t)V_lds + v_rd_base(lane);
  const int qpos = qpos0 + wid * QBLK + r32;
  const int ka0 = r32 * 256 + ((hi * 16) ^ ((r32 & 7) << 4));
  const unsigned goff0 = (unsigned)(sr * LDK + sc) * 2u, goff1 = goff0 + 32u * LDK * 2u;
  struct { bf16x8 vs0, vs1, ks0, ks1; } sr_[1];
#define TROW(jt) ((long)(jt) * KVBLK + ((jt) >= 4 ? kskip : 0))
#define SLOAD(i, jt) do { const long _k0 = TROW(jt) * (LDK * 2); const char* _kp = (const char*)Kb + _k0; const char* _vp = (const char*)Vb + _k0; \
    sr_[i].vs0 = *reinterpret_cast<const bf16x8*>(_vp + goff0); sr_[i].vs1 = *reinterpret_cast<const bf16x8*>(_vp + goff1); \
    sr_[i].ks0 = *reinterpret_cast<const bf16x8*>(_kp + goff0); sr_[i].ks1 = *reinterpret_cast<const bf16x8*>(_kp + goff1); } while (0)
#define SWRITE(b, i) do { *(bf16x8*)(V_lds + (b) * SHM_V + vst0) = sr_[i].vs0;          \
    *(bf16x8*)(V_lds + (b) * SHM_V + vst0 + 8192) = sr_[i].vs1;                         \
    *(bf16x8*)(K_lds + (b) * SHM_K + kst0) = sr_[i].ks0;                               \
    *(bf16x8*)(K_lds + (b) * SHM_K + kst0 + 8192) = sr_[i].ks1; } while (0)
#define SWAIT() asm volatile("s_waitcnt vmcnt(0)" ::: "memory")
#define RESC(a) do { if (__any((a) < 1.f)) { if (hi == 0) al_l[r32] = (a); asm volatile("s_waitcnt lgkmcnt(0)" ::: "memory"); \
    for (int d = 0; d < 4; ++d) for (int r = 0; r < 16; ++r) o[d][r] *= al_l[crow(r, hi)]; } } while (0)
#define DQ(jt) (kskip + ((jt) - 4) * KVBLK - qpos)
  f32x16 pA0, pA1, pB0, pB1; float mnA, mnB, alA, alB; bf16x8 pa0, pa1, pa2, pa3;
  constexpr int SE = 0, SO = 0;
  SLOAD(SE, 0); asm volatile("s_waitcnt vmcnt(0)" ::: "memory"); SWRITE(0, SE); __syncthreads();
  qkt(pA0, pA1, K_lds, qr, ka0); partialSM(pA0, pA1, m_reg, mnA, alA, false, 0, hi);
  SLOAD(SO, 1);
  SWAIT(); SWRITE(1, SO); __syncthreads();
  for (int j = 1; j + 1 < NT; j += 2) {
    SBAR(); qkt(pB0, pB1, K_lds + SHM_K, qr, ka0);
    finishSM(pA0, pA1, alA, l_reg, pa0, pa1, pa2, pa3); SBAR();
    SLOAD(SO, j + 1); SBAR();
    pv_d0(o, vb0, pa0, pa1, pa2, pa3); partialSM(pB0, pB1, m_reg, mnB, alB, maskon && j >= 4, DQ(j), hi);
    __syncthreads(); SWAIT(); SWRITE(0, SE);
    RESC(alB); __syncthreads();
    SBAR(); qkt(pA0, pA1, K_lds, qr, ka0);
    finishSM(pB0, pB1, alB, l_reg, pa0, pa1, pa2, pa3); SBAR();
    SLOAD(SE, j + 2); SBAR();
    pv_d0(o, vb0 + (int)SHM_V, pa0, pa1, pa2, pa3); partialSM(pA0, pA1, m_reg, mnA, alA, maskon && j + 1 >= 4, DQ(j + 1), hi);
    __syncthreads(); SWAIT(); SWRITE(1, SO);
    RESC(alA); __syncthreads();
  }
  SBAR(); qkt(pB0, pB1, K_lds + SHM_K, qr, ka0);
  finishSM(pA0, pA1, alA, l_reg, pa0, pa1, pa2, pa3); SBAR();
  pv_d0(o, vb0, pa0, pa1, pa2, pa3); partialSM(pB0, pB1, m_reg, mnB, alB, maskon && NT - 1 >= 4, DQ(NT - 1), hi);
  __syncthreads(); RESC(alB);
  finishSM(pB0, pB1, alB, l_reg, pa0, pa1, pa2, pa3); SBAR();
  pv_d0(o, vb0 + (int)SHM_V, pa0, pa1, pa2, pa3);
  if (hi == 0) li_l[r32] = l_reg; asm volatile("s_waitcnt lgkmcnt(0)" ::: "memory");
  float rli[16];
#pragma unroll
  for (int r = 0; r < 16; ++r) rli[r] = __builtin_amdgcn_rcpf(li_l[crow(r, hi)]);
  bf16_t* Ow = Ob + (long)(wid * QBLK) * LDO;
#pragma unroll
  for (int r = 0; r < 16; ++r) { int orow = crow(r, hi);
    for (int d0 = 0; d0 < 4; ++d0) Ow[(long)orow * LDO + d0 * 32 + r32] = (bf16_t)f2bf(o[d0][r] * rli[r]); }
#undef TROW
#undef SLOAD
#undef SWRITE
#undef SWAIT
#undef RESC
#undef DQ
}
}

struct Args { const float* in[23]; float* out; unsigned char* ws; int ph_lo, ph_hi; };
enum { IN_X = 0, IN_C, IN_CTX, IN_CCTX, IN_WMOD, IN_BMOD, IN_N1G, IN_N2G, IN_WIN, IN_QNA, IN_KNA, IN_SINK, IN_VNB, IN_WS, IN_BS, IN_QNC, IN_KNC, IN_OUTG, IN_WOUT, IN_WR, IN_WG, IN_WU, IN_WDN };

#define PHASE_IDS(F) const int tid = opaque_tid(), lane = tid & 63, wave = __builtin_amdgcn_readfirstlane(tid >> 6), gw = (int)blockIdx.x * 8 + wave, NGW = (F).G * 8; (void)lane; (void)wave; (void)gw; (void)NGW
constexpr int ARGTAB_OFF = LDSCTL_OFF + 1024;
#define INP(F, i) ld_inp((F).lds, (i))
__device__ __forceinline__ const float* ld_inp(LAS unsigned char* lds, int i) {
    unsigned a = (unsigned)(uintptr_t)(lds + ARGTAB_OFF) + 8u * (unsigned)i;
    asm volatile("" : "+v"(a));
    const volatile LAS unsigned* t = (const volatile LAS unsigned*)(uintptr_t)a;
    const unsigned lo = __builtin_amdgcn_readfirstlane(t[0]), hi = __builtin_amdgcn_readfirstlane(t[1]);
    return (const float*)(const GAS float*)(((unsigned long long)hi << 32) | lo);
}
struct Frame {
    LAS unsigned char* lds; char* ldsg;
    volatile LAS unsigned* MISC;
    unsigned* ctl;
    int G;
    float* out; unsigned char* ws;
};

__host__ __device__ __forceinline__ int headpos(int d) { return 32 * (2 * (d >> 6) + ((d >> 4) & 1)) + 8 * ((d >> 2) & 3) + 4 * ((d >> 5) & 1) + (d & 3); }
template <bool HEADPERM = false>
__device__ __forceinline__ void transpose_item(const float* W, int N, bf16_t* WT, int k0, int n0, int drow0, LAS float* scr, int lane) {
    { float t[32]; const float* wp = W + (size_t)(k0 + (lane >> 5)) * N + n0 + (lane & 31);
#pragma unroll
      for (int i = 0; i < 32; ++i) t[i] = wp[(size_t)(2 * i) * N];
#pragma unroll
      for (int i = 0; i < 32; ++i) scr[(2 * i + (lane >> 5)) * 33 + (lane & 31)] = t[i]; }
    LDS_WAIT(); asm volatile("" ::: "memory");
    const int c = lane & 7;
#pragma unroll
    for (int j = 0; j < 4; ++j) { const int n = (lane >> 3) + 8 * j; const LAS float* s = scr + (8 * c) * 33 + n;
        u32x4 o; o.x = pk2(s[0 * 33], s[1 * 33]); o.y = pk2(s[2 * 33], s[3 * 33]); o.z = pk2(s[4 * 33], s[5 * 33]); o.w = pk2(s[6 * 33], s[7 * 33]);
        const int drow = HEADPERM ? ((drow0 + n) & ~127) + headpos((drow0 + n) & 127) : drow0 + n;
        *(u32x4*)(WT + (size_t)drow * DM + k0 + 8 * c) = o; }
    LDS_WAIT(); asm volatile("" ::: "memory");
}

__device__ __forceinline__ void transpose_item8(const float* W, int N, unsigned char* WT, int k0, int n0, int drow0, LAS float* scr, int lane) {
    { float t[32]; const float* wp = W + (size_t)(k0 + (lane >> 5)) * N + n0 + (lane & 31);
#pragma unroll
      for (int i = 0; i < 32; ++i) t[i] = wp[(size_t)(2 * i) * N];
#pragma unroll
      for (int i = 0; i < 32; ++i) scr[(2 * i + (lane >> 5)) * 33 + (lane & 31)] = t[i]; }
    LDS_WAIT(); asm volatile("" ::: "memory");
    const int c = lane & 7;
#pragma unroll
    for (int j = 0; j < 4; ++j) { const int n = (lane >> 3) + 8 * j; const LAS float* s = scr + (8 * c) * 33 + n;
        u32x2 o; o.x = pk4_fp8(s[0 * 33] * W8_SCALE, s[1 * 33] * W8_SCALE, s[2 * 33] * W8_SCALE, s[3 * 33] * W8_SCALE); o.y = pk4_fp8(s[4 * 33] * W8_SCALE, s[5 * 33] * W8_SCALE, s[6 * 33] * W8_SCALE, s[7 * 33] * W8_SCALE);
        *(u32x2*)(WT + (size_t)(drow0 + n) * DM + k0 + 8 * c) = o; }
    LDS_WAIT(); asm volatile("" ::: "memory");
}
__device__ __forceinline__ void phase_prologue(Frame& F) {
    PHASE_IDS(F);
    LAS float* scr = (LAS float*)(F.lds + wave * 16384);
    static_assert(FP8_L0 && FP8_L1, "the prologue writes the experts' weights as fp8");
    constexpr int I_IN = 32 * (INW / 32), I_SQ = 32 * (DM / 32);
    constexpr int NIT = 2 * I_IN + 2 * I_SQ + 2 * NE * 3 * I_SQ;
    struct TItem { const float* src; unsigned char* dst; int N, drow0, mode; };
#define P0_DESC(d, itv) do { int r = (itv); \
        if (r < 2 * I_IN) { const int l = r / I_IN; r %= I_IN; const int kb = r / (INW / 32), nb = r % (INW / 32); \
            d.src = INP(F, IN_WIN) + (size_t)l * DM * INW + (size_t)(64 * kb) * INW + 32 * nb; d.dst = F.ws + WS_WIN + (size_t)l * INW * DM * 2 + 128 * kb; d.N = INW; d.drow0 = 32 * nb; d.mode = 1; } \
        else if (r < 2 * I_IN + 2 * I_SQ) { r -= 2 * I_IN; const int l = r / I_SQ; r %= I_SQ; const int kb = r / 64, nb = r % 64; \
            d.src = INP(F, IN_WOUT) + (size_t)l * DM * DM + (size_t)(64 * kb) * DM + 32 * nb; d.dst = F.ws + WS_WOUT + (size_t)l * DM * DM * 2 + 128 * kb; d.N = DM; d.drow0 = 32 * nb; d.mode = 0; } \
        else { r -= 2 * I_IN + 2 * I_SQ; const int mat = r / I_SQ; r %= I_SQ; const int kb = r / 64, nb = r % 64, le = mat / 3, which = mat % 3, n0 = 32 * nb; \
            d.src = INP(F, which == 0 ? IN_WG : which == 1 ? IN_WU : IN_WDN) + (size_t)le * DM * DM + (size_t)(64 * kb) * DM + n0; d.N = DM; d.mode = 2; \
            if (which < 2) { d.dst = F.ws + WS_WGU + (size_t)(le / NE) * NE * 4096 * DM * 2 + (size_t)(le % NE) * 4096 * DM + 64 * kb; d.drow0 = (n0 >> 7) * 256 + which * 128 + (n0 & 127); } \
            else { d.dst = F.ws + WS_WD + (size_t)(le / NE) * NE * DM * DM * 2 + (size_t)(le % NE) * DM * DM + 64 * kb; d.drow0 = n0; } } } while (0)
#define P0_LOAD(d, t) do { const float* wp = d.src + (size_t)(lane >> 3) * d.N + (lane & 7) * 4; _Pragma("unroll") for (int i = 0; i < 8; ++i) t[i] = *(const f32x4*)(wp + (size_t)(8 * i) * d.N); } while (0)
    TItem cur, nxt; f32x4 t0[8], t1[8];
    int it = gw;
    if (it < NIT) { P0_DESC(cur, it); P0_LOAD(cur, t0); }
    for (; it < NIT; it += NGW) {
        const bool has = it + NGW < NIT;
        if (has) { P0_DESC(nxt, it + NGW); P0_LOAD(nxt, t1); }
#pragma unroll
        for (int i = 0; i < 8; ++i) { LAS float* sp = scr + (8 * i + (lane >> 3)) * 33 + (lane & 7) * 4; sp[0] = t0[i].x; sp[1] = t0[i].y; sp[2] = t0[i].z; sp[3] = t0[i].w; }
        LDS_WAIT(); asm volatile("" ::: "memory");
        const int c = lane & 7;
#pragma unroll
        for (int j = 0; j < 4; ++j) { const int n = (lane >> 3) + 8 * j; const LAS float* sp = scr + (8 * c) * 33 + n;
            float v[8];
#pragma unroll
            for (int q = 0; q < 8; ++q) v[q] = sp[q * 33];
            int drow = cur.drow0 + n; if (cur.mode == 1) drow = (drow & ~127) + headpos(drow & 127);
            if (cur.mode == 2) { u32x2 o; o.x = pk4_fp8(v[0] * W8_SCALE, v[1] * W8_SCALE, v[2] * W8_SCALE, v[3] * W8_SCALE); o.y = pk4_fp8(v[4] * W8_SCALE, v[5] * W8_SCALE, v[6] * W8_SCALE, v[7] * W8_SCALE);
                *(u32x2*)(cur.dst + (size_t)drow * DM + 8 * c) = o; }
            else { u32x4 o; o.x = pk2(v[0], v[1]); o.y = pk2(v[2], v[3]); o.z = pk2(v[4], v[5]); o.w = pk2(v[6], v[7]); *(u32x4*)(cur.dst + (size_t)drow * DM * 2 + 16 * c) = o; } }
        LDS_WAIT(); asm volatile("" ::: "memory");
        if (has) { cur = nxt;
#pragma unroll
            for (int i = 0; i < 8; ++i) t0[i] = t1[i]; }
    }
#undef P0_DESC
#undef P0_LOAD
    __syncthreads();
    {
        LAS float* sil = (LAS float*)F.lds;
        LAS float* red = (LAS float*)(F.lds + 40960);
        bool have = false;
        for (int it = blockIdx.x; it < 2 * 96; it += F.G) {
            if (!have) {
                { const float* cp = INP(F, IN_C); const float* ccp = INP(F, IN_CCTX);
                for (int i = tid; i < 5 * DM; i += 512) { const int s = i / DM, k = i % DM; const float cv = (s < 4) ? cp[s * DM + k] : ccp[k]; sil[i] = cv / (1.f + __expf(-cv)); } }
                have = true; __syncthreads();
            }
            const int l = it / 96, cb = it % 96, c4 = tid & 31, kr = tid >> 5;
            const float* wp = INP(F, IN_WMOD) + (size_t)l * DM * NMOD + (size_t)cb * 128 + c4 * 4;
            f32x4 a[5];
#pragma unroll
            for (int s = 0; s < 5; ++s) a[s] = (f32x4){0.f, 0.f, 0.f, 0.f};
#pragma unroll 8
            for (int k = kr; k < DM; k += 16) { const f32x4 w = *(const f32x4*)(wp + (size_t)k * NMOD);
#pragma unroll
                for (int s = 0; s < 5; ++s) a[s] += w * sil[s * DM + k]; }
#pragma unroll
            for (int s = 0; s < 5; ++s) *(LAS f32x4*)(red + (kr * 5 + s) * 128 + c4 * 4) = a[s];
            __syncthreads();
            const float* bmod = INP(F, IN_BMOD);
            for (int i = tid; i < 5 * 128; i += 512) { const int s = i / 128, cc = i % 128; float sum = 0.f;
#pragma unroll
                for (int q = 0; q < 16; ++q) sum += red[(q * 5 + s) * 128 + cc];
                ((float*)(F.ws + WS_MOD))[(size_t)(l * 5 + s) * NMOD + cb * 128 + cc] = sum + bmod[l * NMOD + cb * 128 + cc]; }
            __syncthreads();
        }
    }
    if ((int)blockIdx.x >= F.G - 9 && (int)blockIdx.x < F.G - 1) {
        const float* wr = INP(F, IN_WR); bf16_t* wf = (bf16_t*)(F.ws + WS_WRS); const int part = (int)blockIdx.x - (F.G - 9);
        for (int i = part * 512 + tid; i < 2 * DM * NE; i += 8 * 512) { const int l = i / (DM * NE), rem = i % (DM * NE), k = rem >> 4, e = rem & 15;
            const float w = wr[i]; const unsigned hi = f2bf(w); const unsigned lo = f2bf(w - __builtin_bit_cast(float, hi << 16));
            const int sidx = k >> 5, q = (k >> 3) & 3, j = k & 7; bf16_t* dst = wf + ((size_t)(l * 64 + sidx) * 2 * 64 + (q * 16 + e)) * 8 + j;
            dst[0] = (bf16_t)hi; dst[64 * 8] = (bf16_t)lo; }
    }
    if (blockIdx.x == F.G - 1) {
        for (int i = tid; i < 64 * 32; i += 512) {
            const int pos = i >> 5, f = i & 31;
            double inv = 1.0; for (int q = 0; q < f; ++q) inv *= 0.7498942093324559;
            const double a = (double)pos * inv;
            const double n = __builtin_rint(a * 0.6366197723675814);
            const double r = (a - n * 1.5707963267948966) - n * 6.123233995736766e-17;
            const double r2 = r * r;
            double sn = r * (1.0 + r2 * (-1.0 / 6 + r2 * (1.0 / 120 + r2 * (-1.0 / 5040 + r2 * (1.0 / 362880 + r2 * (-1.0 / 39916800 + r2 * (1.0 / 6227020800.0)))))));
            double cn = 1.0 + r2 * (-0.5 + r2 * (1.0 / 24 + r2 * (-1.0 / 720 + r2 * (1.0 / 40320 + r2 * (-1.0 / 3628800 + r2 * (1.0 / 479001600 + r2 * (-1.0 / 87178291200.0)))))));
            const int q = ((int)n) & 3; double cs, ss;
            if (q == 0) { cs = cn; ss = sn; } else if (q == 1) { cs = -sn; ss = cn; } else if (q == 2) { cs = -cn; ss = -sn; } else { cs = sn; ss = -cn; }
            ((float*)(F.ws + WS_ROPE))[2 * i] = (float)cs; ((float*)(F.ws + WS_ROPE))[2 * i + 1] = (float)ss;
        }
    }
}

__device__ __forceinline__ void load_row(const float* row, int lane, f32x4 (&v)[8]) {
#pragma unroll
    for (int j = 0; j < 8; ++j) v[j] = *(const f32x4*)(row + 4 * lane + 256 * j);
}
__device__ __forceinline__ void norm_mod_store(const f32x4 (&v)[8], const float* g, const float* shift, const float* scale, bf16_t* dst, int lane) {
    float ss = 0.f;
#pragma unroll
    for (int j = 0; j < 8; ++j) ss += (v[j].x * v[j].x + v[j].y * v[j].y) + (v[j].z * v[j].z + v[j].w * v[j].w);
    const float rinv = rsqrt_fast(wave_sum(ss) * (1.f / DM) + EPS);
#pragma unroll
    for (int j = 0; j < 8; ++j) { const int c = 4 * lane + 256 * j;
        const f32x4 gg = *(const f32x4*)(g + c), sh = *(const f32x4*)(shift + c), sc = *(const f32x4*)(scale + c);
        const f32x4 y = (v[j] * rinv) * gg * (sc + 1.f) + sh;
        u32x2 w; w.x = pk2(y.x, y.y); w.y = pk2(y.z, y.w); *(u32x2*)(dst + c) = w; }
}

__device__ __forceinline__ void phase_rowpass1_l0(Frame& F) {
    PHASE_IDS(F);
    const float* mod = (const float*)(F.ws + WS_MOD);
    { const float* n2 = INP(F, IN_N2G); float* gs = (float*)(F.ws + WS_GS2);
      for (int i = (int)blockIdx.x * 512 + tid; i < 2 * 5 * DM; i += F.G * 512) { const int l = i / (5 * DM), sv = (i / DM) % 5, k = i % DM;
          const float* m = mod + (size_t)(l * 5 + sv) * NMOD; gs[2 * i] = n2[l * DM + k] * (1.f + m[4 * DM + k]); gs[2 * i + 1] = m[3 * DM + k]; } }
    for (int r = gw; r < NTOK; r += NGW) {
        const int b = r / TPB, t = r % TPB, s = (t < CTXL) ? 4 : b;
        const float* src = (t < CTXL) ? INP(F, IN_CTX) + ((size_t)b * CTXL + t) * DM : INP(F, IN_X) + ((size_t)b * SEQ + (t - CTXL)) * DM;
        f32x4 v[8]; load_row(src, lane, v);
        norm_mod_store(v, INP(F, IN_N1G), mod + (size_t)s * NMOD, mod + (size_t)s * NMOD + DM, (bf16_t*)(F.ws + WS_HN) + (size_t)r * DM, lane);
    }
}

__device__ __forceinline__ void post_unpack(const u32x4 x, float (&v)[8]) {
    v[0] = bflo(x.x); v[1] = bfhi(x.x); v[2] = bflo(x.y); v[3] = bfhi(x.y); v[4] = bflo(x.z); v[5] = bfhi(x.z); v[6] = bflo(x.w); v[7] = bfhi(x.w); }
__device__ __forceinline__ float sum16(float v) { return row16_sum(v); }
__device__ __forceinline__ void phase_post(Frame& F, int l) {
    PHASE_IDS(F);
    bf16_t* P = (bf16_t*)(F.ws + WS_P);
    const float* rope = (const float*)(F.ws + WS_ROPE);
    const int i16 = lane & 15, hq = lane >> 4; const bool hi2 = hq >= 2;
    const float* qna = INP(F, IN_QNA) + l * 128 + 8 * i16; const float* kna = INP(F, IN_KNA) + l * 128 + 8 * i16;
    const float* qnc = INP(F, IN_QNC) + l * 128 + 8 * i16; const float* knc = INP(F, IN_KNC) + l * 128 + 8 * i16;
    const float* vnb = INP(F, IN_VNB) + l * 512 + 8 * i16;
    for (int r = gw; r < NTOK; r += NGW) {
        const int t = r % TPB; const bool lat = t >= CTXL;
        u32x4* rp = (u32x4*)(P + (size_t)r * INW) + lane;
        u32x4 x[7];
#pragma unroll
        for (int j = 0; j < 7; ++j) x[j] = rp[64 * j];
        const int pos = lat ? t - CTXL : 0, pp = (i16 < 8) ? (pos >> 6) : (pos & 63);
        const f32x4* cs = (const f32x4*)(rope + 2 * (pp * 32 + 8 * (i16 & 3)));
        const f32x4 c0 = cs[0], c1 = cs[1], c2 = cs[2], c3 = cs[3];
        const float cosv[8] = {c0.x, c0.z, c1.x, c1.z, c2.x, c2.z, c3.x, c3.z}, sinv[8] = {c0.y, c0.w, c1.y, c1.w, c2.y, c2.w, c3.y, c3.w};
        const float sgn = (i16 & 4) ? 1.f : -1.f;
#pragma unroll
        for (int j = 0; j < 7; ++j) {
            const bool gelu_lo = (j == 3 || j == 4), gelu_hi = (j == 2 || j == 3);
            const bool norm_lo = (j != 2 && j != 3), norm_hi = (j != 2 && j != 6);
            const bool rope_lo = (j == 0 || j == 1 || j == 5 || j == 6), rope_hi = (j == 0 || j == 1 || j == 4 || j == 5);
            const bool dg = hi2 ? gelu_hi : gelu_lo, dn = hi2 ? norm_hi : norm_lo, dr = (hi2 ? rope_hi : rope_lo) && lat;
            if (!(gelu_lo || gelu_hi || norm_lo || norm_hi)) continue;
            float v[8]; post_unpack(x[j], v);
            if (gelu_lo || gelu_hi) {
#pragma unroll
                for (int e = 0; e < 8; ++e) { const float gv = gelu_tanh(v[e]); v[e] = dg ? gv : v[e]; } }
            if (norm_lo || norm_hi) {
                float ss = 0.f;
#pragma unroll
                for (int e = 0; e < 8; ++e) ss += v[e] * v[e];
                const float rinv = rsqrt_fast(sum16(ss) * (1.f / 128) + EPS);
                const float* gp;
                if (j == 0) gp = qna; else if (j == 1) gp = hi2 ? kna : qna; else if (j == 3) gp = vnb + (hi2 ? hq - 2 : 0) * 128; else if (j == 4) gp = hi2 ? qnc : vnb + (2 + hq) * 128;
                else if (j == 5) gp = qnc; else gp = knc;
                const f32x4 g0 = *(const f32x4*)gp, g1 = *(const f32x4*)(gp + 4);
                const float gg[8] = {g0.x, g0.y, g0.z, g0.w, g1.x, g1.y, g1.z, g1.w};
#pragma unroll
                for (int e = 0; e < 8; ++e) v[e] = dn ? v[e] * rinv * gg[e] : v[e];
            }
            if (rope_lo || rope_hi) {
#pragma unroll
                for (int e = 0; e < 8; ++e) { const float o = __builtin_bit_cast(float, __builtin_amdgcn_ds_swizzle(__builtin_bit_cast(int, v[e]), 0x101F)); const float rv = v[e] * cosv[e] + sgn * o * sinv[e]; v[e] = dr ? rv : v[e]; } }
            u32x4 w; w.x = pk2(v[0], v[1]); w.y = pk2(v[2], v[3]); w.z = pk2(v[4], v[5]); w.w = pk2(v[6], v[7]);
            rp[64 * j] = w;
        }
    }
}

__device__ __forceinline__ void mixer_b_unit(Frame& F, int l, int b, int ch, int g) {
    PHASE_IDS(F);
    const bf16_t* P = (const bf16_t*)(F.ws + WS_P); bf16_t* O = (bf16_t*)(F.ws + WS_O);
    const int row0 = b * TPB + ch * 128, w = wave;
    LAS bf16_t* VT = (LAS bf16_t*)F.lds;
    { const int q = tid >> 2, dp = (tid & 3) * 32; const bf16_t* src = P + (size_t)(row0 + q) * INW + C_VB + g * 128 + dp;
#pragma unroll
      for (int i = 0; i < 4; ++i) { const u32x4 x = *(const u32x4*)(src + 8 * i); const unsigned xs[4] = {x.x, x.y, x.z, x.w};
#pragma unroll
          for (int j = 0; j < 4; ++j) { VT[(dp + 8 * i + 2 * j) * 136 + q] = (bf16_t)(xs[j] & 0xffffu); VT[(dp + 8 * i + 2 * j + 1) * 136 + q] = (bf16_t)(xs[j] >> 16); } } }
    __syncthreads();
    const int i15 = lane & 15, kq = lane >> 4;
    f32x4 acc[8];
#pragma unroll
    for (int n = 0; n < 8; ++n) acc[n] = (f32x4){0.f, 0.f, 0.f, 0.f};
    const float* wsr = INP(F, IN_WS) + ((size_t)(l * 4 + g) * 128 + 16 * w + i15) * 128;
#pragma unroll
    for (int s = 0; s < 4; ++s) {
        const f32x4 a0 = *(const f32x4*)(wsr + 32 * s + 8 * kq), a1 = *(const f32x4*)(wsr + 32 * s + 8 * kq + 4);
        u32x4 aw; aw.x = pk2(a0.x, a0.y); aw.y = pk2(a0.z, a0.w); aw.z = pk2(a1.x, a1.y); aw.w = pk2(a1.z, a1.w);
        const bf16x8 af = *reinterpret_cast<bf16x8*>(&aw);
#pragma unroll
        for (int n = 0; n < 8; ++n) { const bf16x8 bfr = *(const LAS bf16x8*)(VT + (16 * n + i15) * 136 + 32 * s + 8 * kq);
            acc[n] = __builtin_amdgcn_mfma_f32_16x16x32_bf16(af, bfr, acc[n], 0, 0, 0); }
    }
#pragma unroll
    for (int j = 0; j < 4; ++j) { const int p = 16 * w + kq * 4 + j; const float bias = INP(F, IN_BS)[(l * 4 + g) * 128 + p];
        const bf16_t* up = P + (size_t)(row0 + p) * INW + C_UB + g * 128; bf16_t* op = O + (size_t)(row0 + p) * DM + O_B + g * 128;
#pragma unroll
        for (int n = 0; n < 8; ++n) { const int d = 16 * n + i15; op[d] = (bf16_t)f2bf(bf2f(up[d]) * (acc[n][j] + bias)); } }
    __syncthreads();
}
__device__ __forceinline__ void phase_mixers(Frame& F, int l) {
    PHASE_IDS(F);
    const bf16_t* P = (const bf16_t*)(F.ws + WS_P); bf16_t* O = (bf16_t*)(F.ws + WS_O);
    const bool ctx = (l == 0);
    const int nC = 384, nA = 384, nCc = ctx ? 24 : 0, nAc = ctx ? 24 : 0, nB = 4 * 4 * 34;
    const int total = nC + nA + nCc + nAc + nB;
    unsigned* qctr = F.ctl + CW_QUEUE + 64 * l;
    for (;;) {
        if (tid == 0) F.MISC[0] = xb_add(qctr, 1u);
        __syncthreads();
        int u = (int)F.MISC[0];
        __syncthreads();
        if (u >= total) break;
        if (u < nC + nA + nCc + nAc) {
            int kind, b, h, qb = 0;
            if (u < nC) { kind = 0; b = u / 96; h = (u % 96) / 16; qb = u % 16; }
            else if (u < nC + nA) { const int v = u - nC; kind = 1; b = v / 96; h = (v % 96) / 16; qb = v % 16; }
            else if (u < nC + nA + nCc) { const int v = u - nC - nA; kind = 2; b = v / 6; h = v % 6; }
            else { const int v = u - nC - nA - nCc; kind = 3; b = v / 6; h = v % 6; }
            const int kv = h / 3, isA = kind & 1, lat = (kind < 2);
            const size_t r0 = (size_t)b * TPB, rq = r0 + (lat ? CTXL + qb * 256 : 0);
            const int q0 = qb * 256, ks = (kind == 1) ? ((q0 - 128 < 0) ? 0 : q0 - 128) : 0, ke = (q0 + 384 > SEQ) ? SEQ : q0 + 384;
            const int NT = (kind == 0) ? 68 : (kind == 1) ? 4 + (ke - ks) / 64 : 4;
            const float sink = INP(F, IN_SINK)[l * 6 + h];
            const int cq = (isA ? C_QA : C_QC) + h * 128, ck = (isA ? C_KA : C_KC) + kv * 128, cv = (isA ? C_VA : C_VC) + kv * 128, co = (isA ? O_A : O_C) + h * 128;
            at::attn_body(P + rq * INW + cq, P + r0 * INW + ck, P + r0 * INW + cv, O + rq * DM + co, NT, ks, q0, isA ? sink / at::SCALE : -1e30f, isA ? 1.f : 0.f, kind == 1, F.ldsg);
            continue; }
        u -= nC + nA + nCc;
        u -= nAc;
        { const int b = u / 136, ch = (u % 136) / 4, g = u % 4;
          if (!ctx && ch < 2) continue;
          mixer_b_unit(F, l, b, ch, g); }
    }
}

__device__ __forceinline__ void phase_groupnorm(Frame& F, int l) {
    PHASE_IDS(F);
    bf16_t* O = (bf16_t*)(F.ws + WS_O); const float* og = INP(F, IN_OUTG) + l * DM;
    for (int r = gw; r < NTOK; r += NGW) {
        if (l == 1 && (r % TPB) < CTXL) continue;
        bf16_t* row = O + (size_t)r * DM;
        u32x2 x[8];
#pragma unroll
        for (int i = 0; i < 3; ++i) { x[i] = *(const u32x2*)(row + O_A + 12 * lane + 4 * i); x[5 + i] = *(const u32x2*)(row + O_C + 12 * lane + 4 * i); }
#pragma unroll
        for (int i = 0; i < 2; ++i) x[3 + i] = *(const u32x2*)(row + O_B + 8 * lane + 4 * i);
        float v[8][4]; float ss[3] = {0.f, 0.f, 0.f};
#pragma unroll
        for (int i = 0; i < 8; ++i) { v[i][0] = bflo(x[i].x); v[i][1] = bfhi(x[i].x); v[i][2] = bflo(x[i].y); v[i][3] = bfhi(x[i].y);
            const int grp = (i < 3) ? 0 : (i < 5) ? 1 : 2; ss[grp] += (v[i][0] * v[i][0] + v[i][1] * v[i][1]) + (v[i][2] * v[i][2] + v[i][3] * v[i][3]); }
        float rinv[3];
        rinv[0] = rsqrt_fast(wave_sum(ss[0]) * (1.f / 768) + EPS); rinv[1] = rsqrt_fast(wave_sum(ss[1]) * (1.f / 512) + EPS); rinv[2] = rsqrt_fast(wave_sum(ss[2]) * (1.f / 768) + EPS);
#pragma unroll
        for (int i = 0; i < 8; ++i) { const int grp = (i < 3) ? 0 : (i < 5) ? 1 : 2;
            const int c = (grp == 0) ? O_A + 12 * lane + 4 * i : (grp == 1) ? O_B + 8 * lane + 4 * (i - 3) : O_C + 12 * lane + 4 * (i - 5);
            const f32x4 gg = *(const f32x4*)(og + c); const float ri = rinv[grp];
            u32x2 w; w.x = pk2(v[i][0] * ri * gg.x, v[i][1] * ri * gg.y); w.y = pk2(v[i][2] * ri * gg.z, v[i][3] * ri * gg.w); *(u32x2*)(row + c) = w; }
    }
}

__device__ __forceinline__ float row16_max(float v) {
    v = fmaxf(v, __builtin_bit_cast(float, __builtin_amdgcn_update_dpp(0, __builtin_bit_cast(int, v), 0xB1, 0xF, 0xF, true)));
    v = fmaxf(v, __builtin_bit_cast(float, __builtin_amdgcn_update_dpp(0, __builtin_bit_cast(int, v), 0x4E, 0xF, 0xF, true)));
    v = fmaxf(v, __builtin_bit_cast(float, __builtin_amdgcn_update_dpp(0, __builtin_bit_cast(int, v), 0x141, 0xF, 0xF, true)));
    v = fmaxf(v, __builtin_bit_cast(float, __builtin_amdgcn_update_dpp(0, __builtin_bit_cast(int, v), 0x140, 0xF, 0xF, true)));
    return v;
}
__device__ __forceinline__ void phase_rowpass2(Frame& F, int l) {
    PHASE_IDS(F);
    const float* xb = (const float*)(F.ws + WS_XB); const float* parts = (const float*)(F.ws + WS_PART);
    const bool f8 = (l == 0) ? (FP8_L0 != 0) : (FP8_L1 != 0);
    { const u32x4* wf = (const u32x4*)((const bf16_t*)(F.ws + WS_WRS) + (size_t)l * 64 * 2 * 64 * 8) + tid; u32x4 t[16];
#pragma unroll
      for (int i = 0; i < 16; ++i) t[i] = wf[512 * i];
#pragma unroll
      for (int i = 0; i < 16; ++i) ((LAS u32x4*)F.lds)[tid + 512 * i] = t[i]; }
    LAS f32x4* red = (LAS f32x4*)(F.lds + LDSCTL_OFF + 2048);
    __syncthreads();
    const int i16 = lane & 15, q = lane >> 4;
    for (int tile = blockIdx.x; tile < NTOK / 16; tile += F.G) {
        const int r0 = tile * 16, b = r0 / TPB, t0 = r0 % TPB, sv = (t0 < CTXL) ? 4 : b;
        if (l == 1 && t0 < CTXL) continue;
        const int row = r0 + i16;
        const float* xr = xb + (size_t)row * DM + 256 * wave + 8 * q;
        f32x4 x[8][2];
#pragma unroll
        for (int sidx = 0; sidx < 8; ++sidx) { x[sidx][0] = *(const f32x4*)(xr + 32 * sidx); x[sidx][1] = *(const f32x4*)(xr + 32 * sidx + 4); }
        const f32x4 p0 = *(const f32x4*)(parts + (size_t)row * 32 + 8 * q), p1 = *(const f32x4*)(parts + (size_t)row * 32 + 8 * q + 4);
        float ss = ((p0.x + p0.y) + (p0.z + p0.w)) + ((p1.x + p1.y) + (p1.z + p1.w));
        ss += __builtin_bit_cast(float, __builtin_amdgcn_ds_swizzle(__builtin_bit_cast(int, ss), 0x401F));
        { auto rr = __builtin_amdgcn_permlane32_swap(__float_as_uint(ss), __float_as_uint(ss), false, false); ss = __uint_as_float(rr[0]) + __uint_as_float(rr[1]); }
        const float rinv = rsqrt_fast(ss * (1.f / DM) + EPS);
        const float* gs = (const float*)(F.ws + WS_GS2) + ((size_t)(l * 5 + sv) * DM + 256 * wave + 8 * q) * 2;
        f32x4 acc = (f32x4){0.f, 0.f, 0.f, 0.f};
#pragma unroll
        for (int sidx = 0; sidx < 8; ++sidx) {
            const f32x4 g0 = *(const f32x4*)(gs + 64 * sidx), g1 = *(const f32x4*)(gs + 64 * sidx + 4), g2 = *(const f32x4*)(gs + 64 * sidx + 8), g3 = *(const f32x4*)(gs + 64 * sidx + 12);
            float h[8];
            h[0] = x[sidx][0].x * rinv * g0.x + g0.y; h[1] = x[sidx][0].y * rinv * g0.z + g0.w; h[2] = x[sidx][0].z * rinv * g1.x + g1.y; h[3] = x[sidx][0].w * rinv * g1.z + g1.w;
            h[4] = x[sidx][1].x * rinv * g2.x + g2.y; h[5] = x[sidx][1].y * rinv * g2.z + g2.w; h[6] = x[sidx][1].z * rinv * g3.x + g3.y; h[7] = x[sidx][1].w * rinv * g3.z + g3.w;
            const int col = 256 * wave + 32 * sidx + 8 * q;
            if (f8) { u32x2 w8; w8.x = pk4_fp8(h[0], h[1], h[2], h[3]); w8.y = pk4_fp8(h[4], h[5], h[6], h[7]); *(u32x2*)((unsigned char*)(F.ws + WS_HN8) + (size_t)row * DM + col) = w8; }
            else { u32x4 w16; w16.x = pk2(h[0], h[1]); w16.y = pk2(h[2], h[3]); w16.z = pk2(h[4], h[5]); w16.w = pk2(h[6], h[7]); *(u32x4*)((bf16_t*)(F.ws + WS_HN) + (size_t)row * DM + col) = w16; }
            unsigned hh[8], hl[8];
#pragma unroll
            for (int j = 0; j < 8; ++j) { hh[j] = f2bf(h[j]); hl[j] = f2bf(h[j] - __builtin_bit_cast(float, hh[j] << 16)); }
            u32x4 ah, al; ah.x = hh[0] | (hh[1] << 16); ah.y = hh[2] | (hh[3] << 16); ah.z = hh[4] | (hh[5] << 16); ah.w = hh[6] | (hh[7] << 16);
            al.x = hl[0] | (hl[1] << 16); al.y = hl[2] | (hl[3] << 16); al.z = hl[4] | (hl[5] << 16); al.w = hl[6] | (hl[7] << 16);
            const LAS unsigned char* bp = F.lds + (size_t)((wave * 8 + sidx) * 2) * 1024 + lane * 16;
            const bf16x8 bh = *(const LAS bf16x8*)bp, bl = *(const LAS bf16x8*)(bp + 1024);
            const bf16x8 fah = __builtin_bit_cast(bf16x8, ah), fal = __builtin_bit_cast(bf16x8, al);
            acc = __builtin_amdgcn_mfma_f32_16x16x32_bf16(fah, bh, acc, 0, 0, 0);
            acc = __builtin_amdgcn_mfma_f32_16x16x32_bf16(fah, bl, acc, 0, 0, 0);
            acc = __builtin_amdgcn_mfma_f32_16x16x32_bf16(fal, bh, acc, 0, 0, 0);
        }
        red[wave * 64 + lane] = acc;
        __syncthreads();
        if (wave == 0) {
            f32x4 lg = red[lane];
#pragma unroll
            for (int w = 1; w < 8; ++w) lg += red[w * 64 + lane];
#pragma unroll
            for (int reg = 0; reg < 4; ++reg) { const float mx = row16_max(lg[reg]); const float ex = __expf(lg[reg] - mx); const float a = ex / row16_sum(ex);
                const int t = t0 + 4 * q + reg;
                if (t < CTXL) ((float*)(F.ws + WS_AFFC))[((size_t)b * NE + i16) * CTXL + t] = a;
                else ((float*)(F.ws + WS_AFFL))[((size_t)b * NE + i16) * SEQ + (t - CTXL)] = a; }
        }
        __syncthreads();
    }
    __syncthreads();
}

__device__ __forceinline__ unsigned block_excl_scan(unsigned v, LAS unsigned* scr, int lane, int wave, unsigned& total) {
    unsigned inc = v;
#pragma unroll
    for (int o = 1; o < 64; o <<= 1) { const unsigned t = __shfl_up(inc, o); if (lane >= o) inc += t; }
    if (lane == 63) scr[wave] = inc;
    __syncthreads();
    unsigned base = 0, tot = 0;
#pragma unroll
    for (int w = 0; w < 8; ++w) { const unsigned x = scr[w]; base += (w < wave) ? x : 0u; tot += x; }
    __syncthreads();
    total = tot;
    return base + inc - v;
}
__device__ __forceinline__ void phase_topk(Frame& F, int l) {
    PHASE_IDS(F);
    LAS unsigned* hist = (LAS unsigned*)F.lds;
    LAS unsigned* scr = (LAS unsigned*)(F.lds + 8192);
    LAS int* rowsrc = (LAS int*)(F.lds + 8192 + 128);
    const int nunits = (l == 0) ? 128 : 64;
    const bool f8 = (l == 0) ? (FP8_L0 != 0) : (FP8_L1 != 0); const int RBg = f8 ? DM : 2 * DM;
    for (int u = blockIdx.x; u < nunits; u += F.G) {
        const bool isc = u >= 64; const int uu = isc ? u - 64 : u, b = uu / NE, e = uu % NE;
        const int N = isc ? CTXL : SEQ; const unsigned cap = isc ? CAP_C : CAP_L;
        const float* src = isc ? (const float*)(F.ws + WS_AFFC) + (size_t)uu * CTXL : (const float*)(F.ws + WS_AFFL) + (size_t)uu * SEQ;
        int* pos = isc ? (int*)(F.ws + WS_POSC) + (size_t)uu * CTXL : (int*)(F.ws + WS_POSL) + (size_t)uu * SEQ;
        const bool own = tid * 8 < N;
        unsigned key[8];
        { u32x4 k0 = (u32x4){0u, 0u, 0u, 0u}, k1 = k0; if (own) { k0 = *(const u32x4*)(src + tid * 8); k1 = *(const u32x4*)(src + tid * 8 + 4); }
          key[0] = k0.x; key[1] = k0.y; key[2] = k0.z; key[3] = k0.w; key[4] = k1.x; key[5] = k1.y; key[6] = k1.z; key[7] = k1.w; }
        unsigned prefix = 0u, remaining = cap;
#pragma unroll
        for (int p = 0; p < 3; ++p) {
            const int shift = (p == 0) ? 21 : (p == 1) ? 10 : 0, bits = (p == 2) ? 10 : 11, nb = 1 << bits;
            for (int i = tid; i < nb; i += 512) hist[i] = 0u;
            __syncthreads();
            if (own) {
#pragma unroll
                for (int q = 0; q < 8; ++q) { const bool cand = (p == 0) ? true : ((key[q] >> (shift + bits)) == prefix);
                    if (cand) (void)__hip_atomic_fetch_add(&hist[(key[q] >> shift) & (nb - 1)], 1u, __ATOMIC_RELAXED, __HIP_MEMORY_SCOPE_WORKGROUP); } }
            __syncthreads();
            unsigned c[4];
#pragma unroll
            for (int q = 0; q < 4; ++q) c[q] = (4 * tid + q < nb) ? hist[4 * tid + q] : 0u;
            const unsigned sm = (c[0] + c[1]) + (c[2] + c[3]);
            unsigned total; const unsigned ex = block_excl_scan(sm, scr, lane, wave, total);
            unsigned above = total - (ex + sm);
#pragma unroll
            for (int q = 3; q >= 0; --q) { if (above < remaining && remaining <= above + c[q]) { scr[16] = (unsigned)(4 * tid + q); scr[17] = above; } above += c[q]; }
            __syncthreads();
            const unsigned B = scr[16], ca = scr[17];
            remaining -= ca; prefix = (prefix << bits) | B;
            __syncthreads();
        }
        const unsigned T = prefix;
        unsigned ce = 0u;
#pragma unroll
        for (int q = 0; q < 8; ++q) ce += (own && key[q] == T) ? 1u : 0u;
        unsigned tot; unsigned er = block_excl_scan(ce, scr, lane, wave, tot);
        bool sel[8]; unsigned cs = 0u;
#pragma unroll
        for (int q = 0; q < 8; ++q) { const bool eq = own && key[q] == T; sel[q] = own && (key[q] > T || (eq && er < remaining)); er += eq ? 1u : 0u; cs += sel[q] ? 1u : 0u; }
        unsigned sl = block_excl_scan(cs, scr, lane, wave, tot);
        const int slotbase = e * ROWS_E + (isc ? 2048 + b * CAP_C : b * CAP_L);
        int pv[8];
#pragma unroll
        for (int q = 0; q < 8; ++q) { pv[q] = sel[q] ? (int)sl : -1;
            if (sel[q]) { rowsrc[sl] = b * TPB + (isc ? 0 : CTXL) + tid * 8 + q; ((float*)(F.ws + WS_GATE))[slotbase + sl] = __uint_as_float(key[q]); ++sl; } }
        if (own) { *(i32x4*)(pos + tid * 8) = (i32x4){pv[0], pv[1], pv[2], pv[3]}; *(i32x4*)(pos + tid * 8 + 4) = (i32x4){pv[4], pv[5], pv[6], pv[7]}; }
        __syncthreads();
        unsigned* offs = (unsigned*)(F.ws + WS_OFFS);
        int R[2], C[2];
#pragma unroll
        for (int i = 0; i < 2; ++i) pg8::stage_rc(tid * 16 + i * 8192, R[i], C[i]);
        if (!isc) {
#pragma unroll
            for (int th = 0; th < 2; ++th) { u32x4 o;
                o.x = (unsigned)rowsrc[th * 256 + R[0]] * RBg + 2 * C[0]; o.y = (unsigned)rowsrc[th * 256 + R[1]] * RBg + 2 * C[1];
                o.z = (unsigned)rowsrc[th * 256 + 128 + R[0]] * RBg + 2 * C[0]; o.w = (unsigned)rowsrc[th * 256 + 128 + R[1]] * RBg + 2 * C[1];
                *(u32x4*)(offs + ((size_t)(e * 9 + 2 * b + th) * 512 + tid) * 4) = o; }
        } else {
            unsigned* o = offs + ((size_t)(e * 9 + 8) * 512 + tid) * 4;
#pragma unroll
            for (int i = 0; i < 2; ++i) { if (R[i] >= 32 * b && R[i] < 32 * b + 32) o[i] = (unsigned)rowsrc[R[i] - 32 * b] * RBg + 2 * C[i]; if (b == 0) o[2 + i] = 2 * C[i]; }
        }
        __syncthreads();
    }
}

__device__ __forceinline__ void phase_combine(Frame& F, int l) {
    PHASE_IDS(F);
    const float* mod = (const float*)(F.ws + WS_MOD);
    float* xb = (float*)(F.ws + WS_XB); const bf16_t* Y = (const bf16_t*)(F.ws + WS_XG);
    for (int r = gw; r < NTOK; r += NGW) {
        const int b = r / TPB, t = r % TPB, s = (t < CTXL) ? 4 : b;
        if (l == 1 && t < CTXL) continue;
        int p = -1;
        if (lane < NE) p = (t < CTXL) ? ((const int*)(F.ws + WS_POSC))[((size_t)b * NE + lane) * CTXL + t] : ((const int*)(F.ws + WS_POSL))[((size_t)b * NE + lane) * SEQ + (t - CTXL)];
        float gt = 0.f;
        if (p >= 0) gt = ((const float*)(F.ws + WS_GATE))[lane * ROWS_E + ((t < CTXL) ? 2048 + b * CAP_C : b * CAP_L) + p];
        f32x4 v[8]; load_row(xb + (size_t)r * DM, lane, v);
        const float* g2 = mod + (size_t)(l * 5 + s) * NMOD + 5 * DM;
        f32x4 gv[8];
#pragma unroll
        for (int j = 0; j < 8; ++j) gv[j] = *(const f32x4*)(g2 + 4 * lane + 256 * j);
        f32x4 a[8];
#pragma unroll
        for (int j = 0; j < 8; ++j) a[j] = (f32x4){0.f, 0.f, 0.f, 0.f};
        unsigned long long m = __ballot(p >= 0);
        const int ybase = (t < CTXL) ? 2048 + b * CAP_C : b * CAP_L;
        while (m) {
            const int e0 = __builtin_ctzll(m); m &= m - 1;
            const bool two = (m != 0ull); const int e1 = two ? __builtin_ctzll(m) : e0; if (two) m &= m - 1;
            const int p0 = __builtin_amdgcn_readlane(p, e0), p1 = __builtin_amdgcn_readlane(p, e1);
            const float q0 = __builtin_bit_cast(float, __builtin_amdgcn_readlane(__builtin_bit_cast(int, gt), e0)), q1 = __builtin_bit_cast(float, __builtin_amdgcn_readlane(__builtin_bit_cast(int, gt), e1));
            const bf16_t* y0 = Y + (size_t)(e0 * ROWS_E + ybase + p0) * DM + 4 * lane; const bf16_t* y1 = Y + (size_t)(e1 * ROWS_E + ybase + p1) * DM + 4 * lane;
            u32x2 w0[8], w1[8];
#pragma unroll
            for (int j = 0; j < 8; ++j) w0[j] = *(const u32x2*)(y0 + 256 * j);
            if (two) {
#pragma unroll
                for (int j = 0; j < 8; ++j) w1[j] = *(const u32x2*)(y1 + 256 * j); }
#pragma unroll
            for (int j = 0; j < 8; ++j) a[j] += (f32x4){bflo(w0[j].x), bfhi(w0[j].x), bflo(w0[j].y), bfhi(w0[j].y)} * q0;
            if (two) {
#pragma unroll
                for (int j = 0; j < 8; ++j) a[j] += (f32x4){bflo(w1[j].x), bfhi(w1[j].x), bflo(w1[j].y), bfhi(w1[j].y)} * q1; }
        }
#pragma unroll
        for (int j = 0; j < 8; ++j) v[j] += gv[j] * a[j];
        if (l == 0) {
#pragma unroll
            for (int j = 0; j < 8; ++j) *(f32x4*)(xb + (size_t)r * DM + 4 * lane + 256 * j) = v[j];
            const float* m1 = mod + (size_t)(5 + s) * NMOD;
            norm_mod_store(v, INP(F, IN_N1G) + DM, m1, m1 + DM, (bf16_t*)(F.ws + WS_HN) + (size_t)r * DM, lane);
        } else {
            float* op = F.out + ((size_t)b * SEQ + (t - CTXL)) * DM;
#pragma unroll
            for (int j = 0; j < 8; ++j) *(f32x4*)(op + 4 * lane + 256 * j) = v[j];
        }
    }
}

__device__ __forceinline__ void phase_dump_x(Frame& F, bool from_input) {
    PHASE_IDS(F);
    const float* xb = (const float*)(F.ws + WS_XB);
    for (int r = gw; r < NTOK; r += NGW) {
        const int b = r / TPB, t = r % TPB; if (t < CTXL) continue;
        const float* src = from_input ? INP(F, IN_X) + ((size_t)b * SEQ + (t - CTXL)) * DM : xb + (size_t)r * DM;
        f32x4 v[8]; load_row(src, lane, v);
        float* op = F.out + ((size_t)b * SEQ + (t - CTXL)) * DM;
#pragma unroll
        for (int j = 0; j < 8; ++j) *(f32x4*)(op + 4 * lane + 256 * j) = v[j];
    }
}

constexpr int N_PHASES = 2 + 11 * NLAYER;
__global__ void __launch_bounds__(512, 2) fwd_kernel(Args args) {
    extern __shared__ __attribute__((aligned(16))) unsigned char lds[];
    Frame F;
    F.lds = (LAS unsigned char*)lds; F.ldsg = (char*)lds;
    F.MISC = (volatile LAS unsigned*)(F.lds + MISC_OFF);
    F.G = gridDim.x;
    F.out = args.out; F.ws = args.ws; F.ctl = (unsigned*)(args.ws + WS_CTL);
    for (int u = threadIdx.x; u < (LDS_BYTES - LDSCTL_OFF) / 4; u += 512) ((LAS unsigned*)(F.lds + LDSCTL_OFF))[u] = 0u;
    __syncthreads();
    if (threadIdx.x < 23) { const unsigned long long pv = (unsigned long long)args.in[threadIdx.x]; LAS unsigned* t = (LAS unsigned*)(F.lds + ARGTAB_OFF) + 2 * threadIdx.x; t[0] = (unsigned)pv; t[1] = (unsigned)(pv >> 32); }
    __syncthreads();
    XcdBarrier bar; bar.bar = F.ctl + CW_BAR; bar.x = 0; bar.st = nullptr;
    if (!MK_PER_PHASE) bar = xcd_barrier_post(F.ctl + CW_BAR, F.MISC + 8);
    const int lo = args.ph_lo, hi = args.ph_hi;
#define IN(k) (lo <= (k) && (k) < hi)
    unsigned long long probe_t0 = 0ull, probe_acc = 0ull;
#define PROBE_BEGIN(k) do { if (PROBE_MASK & (1u << (k))) probe_t0 = __builtin_amdgcn_s_memrealtime(); } while (0)
#define SEAM(k) do { if (IN(k) && IN((k) + 1)) xcd_barrier(bar); if (PROBE_MASK & (1u << (k))) probe_acc += __builtin_amdgcn_s_memrealtime() - probe_t0; } while (0)

    if (IN(0)) { PROBE_BEGIN(0); if (PH_ON(0)) phase_prologue(F); if (IN(1)) xcd_barrier_first(bar); if (PROBE_MASK & 1u) probe_acc += __builtin_amdgcn_s_memrealtime() - probe_t0; }
    if (IN(1)) { PROBE_BEGIN(1); if (PH_ON(1)) phase_rowpass1_l0(F); SEAM(1); }
    for (int l = 0; l < NLAYER; ++l) {
        const int pb = 2 + 11 * l;
        const bool ctx = (l == 0);
        if (IN(pb + 0)) { PROBE_BEGIN(pb + 0); if (PH_ON(2)) {
            pg8::SchedDense S; S.init(F.ws + WS_HN, F.ws + WS_WIN + (size_t)l * INW * DM * 2, NTOK / 256, INW / 256, F.G, (int)blockIdx.x, 0);
            pg8::EpiPost E{(bf16_t*)(F.ws + WS_P), (const float*)(F.ws + WS_ROPE), INP(F, IN_QNA) + l * 128, INP(F, IN_KNA) + l * 128, INP(F, IN_QNC) + l * 128, INP(F, IN_KNC) + l * 128, INP(F, IN_VNB) + l * 512, F.lds + LDSCTL_OFF + 2048};
            pg8::gemm_phase<pg8::EpiPost, pg8::SchedDense>(F.lds, S, E); }
            SEAM(pb + 0); }
        if (IN(pb + 2)) { PROBE_BEGIN(pb + 2); if (PH_ON(4)) phase_mixers(F, l); SEAM(pb + 2); }
        if (IN(pb + 3)) { PROBE_BEGIN(pb + 3); if (PH_ON(5)) phase_groupnorm(F, l); SEAM(pb + 3); }
        if (IN(pb + 4)) { PROBE_BEGIN(pb + 4); if (PH_ON(6)) {
            pg8::SchedDense S; S.init(F.ws + WS_O, F.ws + WS_WOUT + (size_t)l * DM * DM * 2, ctx ? NTOK / 256 : 64, DM / 256, F.G, (int)blockIdx.x, ctx ? 0 : 1);
            float* xb = (float*)(F.ws + WS_XB);
            pg8::EpiResid E;
            if (l == 0) { E.ctxbase = INP(F, IN_CTX); E.latbase = INP(F, IN_X); E.cbs = CTXL; E.lbs = SEQ; }
            else { E.ctxbase = xb; E.latbase = xb + (size_t)CTXL * DM; E.cbs = TPB; E.lbs = TPB; }
            E.xout = xb; E.modl = (const float*)(F.ws + WS_MOD) + (size_t)l * 5 * NMOD; E.parts = (float*)(F.ws + WS_PART);
            pg8::gemm_phase<pg8::EpiResid, pg8::SchedDense>(F.lds, S, E); }
            SEAM(pb + 4); }
        if (IN(pb + 5)) { PROBE_BEGIN(pb + 5); if (PH_ON(7)) phase_rowpass2(F, l); SEAM(pb + 5); }
        if (IN(pb + 6)) { PROBE_BEGIN(pb + 6); if (PH_ON(8)) phase_topk(F, l); SEAM(pb + 6); }
        if (IN(pb + 8)) { PROBE_BEGIN(pb + 8); if (PH_ON(10)) {
            if ((l == 0) ? (FP8_L0 != 0) : (FP8_L1 != 0)) {
                pg8::SchedGrouped<pg8::GK> S; S.init(F.ws + WS_HN8, F.ws + WS_WGU + (size_t)l * NE * 4096 * DM * 2, ctx ? 9 : 8, 16, F.G, (int)blockIdx.x);
                pg8::EpiSwiGLU8 E{(unsigned char*)(F.ws + WS_H)};
                pg8::gemm_phase<pg8::EpiSwiGLU8, pg8::SchedGrouped<pg8::GK>, true, true>(F.lds, S, E, (const unsigned*)(F.ws + WS_OFFS), F.lds + LDSCTL_OFF + 2048);
            } else {
                pg8::SchedGrouped<2 * pg8::GK> S; S.init(F.ws + WS_HN, F.ws + WS_WGU + (size_t)l * NE * 4096 * DM * 2, ctx ? 9 : 8, 16, F.G, (int)blockIdx.x);
                pg8::EpiSwiGLU E{(bf16_t*)(F.ws + WS_H)};
                pg8::gemm_phase<pg8::EpiSwiGLU, pg8::SchedGrouped<2 * pg8::GK>, false, true>(F.lds, S, E, (const unsigned*)(F.ws + WS_OFFS), F.lds + LDSCTL_OFF + 2048);
            } }
            SEAM(pb + 8); }
        if (IN(pb + 9)) { PROBE_BEGIN(pb + 9); if (PH_ON(11)) {
            pg8::EpiStoreBf16 E{(bf16_t*)(F.ws + WS_XG), DM};
            if ((l == 0) ? (FP8_L0 != 0) : (FP8_L1 != 0)) {
                pg8::SchedGrouped<pg8::GK> S; S.init(F.ws + WS_H, F.ws + WS_WD + (size_t)l * NE * DM * DM * 2, ctx ? 9 : 8, 8, F.G, (int)blockIdx.x);
                pg8::gemm_phase<pg8::EpiStoreBf16, pg8::SchedGrouped<pg8::GK>, true>(F.lds, S, E);
            } else {
                pg8::SchedGrouped<2 * pg8::GK> S; S.init(F.ws + WS_H, F.ws + WS_WD + (size_t)l * NE * DM * DM * 2, ctx ? 9 : 8, 8, F.G, (int)blockIdx.x);
                pg8::gemm_phase<pg8::EpiStoreBf16, pg8::SchedGrouped<2 * pg8::GK>, false>(F.lds, S, E);
            } }
            SEAM(pb + 9); }
        if (IN(pb + 10)) { PROBE_BEGIN(pb + 10); if (PH_ON(12)) phase_combine(F, l); if (l + 1 < NLAYER) SEAM(pb + 10); else if (PROBE_MASK & (1u << (pb + 10))) probe_acc += __builtin_amdgcn_s_memrealtime() - probe_t0; }
    }
    if (PROBE_MASK) { const unsigned long long te = __builtin_amdgcn_s_memrealtime(); while (__builtin_amdgcn_s_memrealtime() - te < probe_acc) __builtin_amdgcn_s_sleep(8); }
#undef IN
#undef SEAM
}

extern "C" void kernel_launch(void* const* d_in, const int* in_sizes, int n_in, void* d_out, int out_size, void* d_ws, size_t ws_size, hipStream_t stream) {
    static int grid = 0;
    if (grid == 0) {
        if (n_in != 23 || out_size != NB * SEQ * DM || ws_size < WS_END) { fprintf(stderr, "kernel_launch: shape mismatch: n_in %d out %d ws %zu (need %zu)\n", n_in, out_size, ws_size, (size_t)WS_END); grid = -1; return; }
        int dev = 0, cus = 0, per_cu = 0;
        if (hipGetDevice(&dev) != hipSuccess || hipDeviceGetAttribute(&cus, hipDeviceAttributeMultiprocessorCount, dev) != hipSuccess) { grid = -1; return; }
        if (hipFuncSetAttribute((const void*)fwd_kernel, hipFuncAttributeMaxDynamicSharedMemorySize, LDS_BYTES) != hipSuccess) { fprintf(stderr, "kernel_launch: hipFuncSetAttribute failed\n"); grid = -1; return; }
        if (hipOccupancyMaxActiveBlocksPerMultiprocessor(&per_cu, (const void*)fwd_kernel, 512, LDS_BYTES) != hipSuccess || per_cu < 1) { fprintf(stderr, "kernel_launch: occupancy query says %d\n", per_cu); }
        (void)hipGetLastError();
        grid = cus;
    }
    if (grid < 0) return;
    if (hipMemsetAsync((char*)d_ws + WS_CTL, 0, CTL_ZERO_BYTES, stream) != hipSuccess) return;
    Args a{};
    for (int i = 0; i < 23; ++i) a.in[i] = (const float*)d_in[i];
    a.out = (float*)d_out; a.ws = (unsigned char*)d_ws;
#if MK_PER_PHASE
    for (int p = 0; p < N_PHASES; ++p) { a.ph_lo = p; a.ph_hi = p + 1; hipLaunchKernelGGL(fwd_kernel, dim3(grid), dim3(512), LDS_BYTES, stream, a); }
#else
    a.ph_lo = 0; a.ph_hi = N_PHASES;
    hipLaunchKernelGGL(fwd_kernel, dim3(grid), dim3(512), LDS_BYTES, stream, a);
#endif
    const hipError_t le = hipPeekAtLastError();
    if (le != hipSuccess) fprintf(stderr, "kernel_launch: launch failed: %s\n", hipGetErrorName(le));
}
```

```cpp
#include <hip/hip_runtime.h>
#include <cstdio>
#include <cstdint>

#define LAS __attribute__((address_space(3)))
#define GAS __attribute__((address_space(1)))
typedef unsigned short bf16_t;
typedef short bf16x8 __attribute__((ext_vector_type(8)));
typedef short s16x4 __attribute__((ext_vector_type(4)));
typedef float f32x2 __attribute__((ext_vector_type(2)));
typedef float f32x4 __attribute__((ext_vector_type(4)));
typedef float f32x16 __attribute__((ext_vector_type(16)));
typedef unsigned u32x2 __attribute__((ext_vector_type(2)));
typedef unsigned u32x4 __attribute__((ext_vector_type(4)));
typedef int i32x4 __attribute__((ext_vector_type(4)));
typedef int i32x8 __attribute__((ext_vector_type(8)));

#ifndef MK_PER_PHASE
#define MK_PER_PHASE 0
#endif
#ifndef PHASE_MASK
#define PHASE_MASK 0x1fff
#endif
#define PH_ON(k) (((PHASE_MASK) >> (k)) & 1)
#ifndef FP8_L0
#define FP8_L0 1
#endif
#ifndef FP8_L1
#define FP8_L1 1
#endif
#ifndef PROBE_MASK
#define PROBE_MASK 0u
#endif
#ifndef DBG_STOP
#define DBG_STOP 0
#endif

constexpr int DM = 2048, NB = 4, SEQ = 4096, CTXL = 256, TPB = SEQ + CTXL, NTOK = NB * TPB;
constexpr int INW = 3584, NE = 16, NLAYER = 2, NMOD = 6 * DM;
constexpr int C_QA = 0, C_KA = 768, C_VA = 1024, C_UB = 1280, C_VB = 1792, C_QC = 2304, C_KC = 3072, C_VC = 3328;
constexpr int O_A = 0, O_B = 768, O_C = 1280;
constexpr int CAP_L = 512, CAP_C = 32, ROWS_E = 2304;
constexpr float EPS = 1e-6f;

constexpr size_t MiB = 1u << 20;
constexpr size_t WS_CTL = 0, CTL_ZERO_BYTES = 65536;
constexpr size_t WS_MOD = 1 * MiB;
constexpr size_t WS_ROPE = 2 * MiB;
constexpr size_t WS_AFFL = 3 * MiB;
constexpr size_t WS_AFFC = 4 * MiB;
constexpr size_t WS_POSL = 5 * MiB;
constexpr size_t WS_POSC = 6 * MiB;
constexpr size_t WS_OFFS = 10 * MiB;
constexpr size_t WS_GATE = 8 * MiB;
constexpr size_t WS_WRT = 9 * MiB;
constexpr size_t WS_WRS = 11 * MiB;
constexpr size_t WS_GS2 = 12 * MiB;
constexpr size_t WS_PART = 13 * MiB;
constexpr size_t WS_WIN = 16 * MiB;
constexpr size_t WS_WOUT = WS_WIN + (size_t)2 * INW * DM * 2;
constexpr size_t WS_WGU = WS_WOUT + (size_t)2 * DM * DM * 2;
constexpr size_t WS_WD = WS_WGU + (size_t)2 * NE * 4096 * DM * 2;
constexpr size_t WS_HN = WS_WD + (size_t)2 * NE * DM * DM * 2;
constexpr size_t WS_P = WS_HN + (size_t)NTOK * DM * 2;
constexpr size_t WS_O = WS_P + (size_t)NTOK * INW * 2;
constexpr size_t WS_XB = WS_O + (size_t)NTOK * DM * 2;
constexpr size_t WS_XG = WS_XB + (size_t)NTOK * DM * 4;
constexpr size_t WS_H = WS_XG + (size_t)NE * ROWS_E * DM * 2;
constexpr size_t WS_HN8 = WS_H + (size_t)NE * ROWS_E * DM * 2;
constexpr size_t WS_END = WS_HN8 + (size_t)NTOK * DM;
constexpr float W8_SCALE = 32.f; constexpr int W8_SCALE_E8M0 = 127 - 5;
constexpr int CW_BAR = 4096, CW_QUEUE = 8192;

constexpr int RING_BYTES = 131072, LDSCTL_OFF = RING_BYTES, MISC_OFF = LDSCTL_OFF + 320, LDS_BYTES = 147456;

#define LDS_WAIT() asm volatile("s_waitcnt lgkmcnt(0)" ::: "memory")
#define VM_WAIT() asm volatile("s_waitcnt vmcnt(0)" ::: "memory")
__device__ __forceinline__ unsigned f2bf(float f) { unsigned u = __builtin_bit_cast(unsigned, f); return (u + 0x7fffu + ((u >> 16) & 1u)) >> 16; }
__device__ __forceinline__ unsigned pk2(float lo, float hi) { return f2bf(lo) | (f2bf(hi) << 16); }
__device__ __forceinline__ float bf2f(unsigned short b) { return __builtin_bit_cast(float, ((unsigned)b) << 16); }
__device__ __forceinline__ float bflo(unsigned w) { return __builtin_bit_cast(float, w << 16); }
__device__ __forceinline__ float bfhi(unsigned w) { return __builtin_bit_cast(float, w & 0xffff0000u); }
__device__ __forceinline__ unsigned pk4_fp8(float a, float b, float c, float d) {
    int r = __builtin_amdgcn_cvt_pk_fp8_f32(a, b, 0, false); r = __builtin_amdgcn_cvt_pk_fp8_f32(c, d, r, true); return (unsigned)r; }
__device__ __forceinline__ int opaque_tid() { int t = threadIdx.x; asm volatile("" : "+v"(t)); return t; }
__device__ __forceinline__ float row16_sum(float v) {
    v += __builtin_bit_cast(float, __builtin_amdgcn_update_dpp(0, __builtin_bit_cast(int, v), 0xB1, 0xF, 0xF, true));
    v += __builtin_bit_cast(float, __builtin_amdgcn_update_dpp(0, __builtin_bit_cast(int, v), 0x4E, 0xF, 0xF, true));
    v += __builtin_bit_cast(float, __builtin_amdgcn_update_dpp(0, __builtin_bit_cast(int, v), 0x141, 0xF, 0xF, true));
    v += __builtin_bit_cast(float, __builtin_amdgcn_update_dpp(0, __builtin_bit_cast(int, v), 0x140, 0xF, 0xF, true));
    return v;
}
__device__ __forceinline__ float wave_sum(float v) {
    v = row16_sum(v);
    const int iv = __builtin_bit_cast(int, v);
    const float a = __builtin_bit_cast(float, __builtin_amdgcn_readlane(iv, 0)), b = __builtin_bit_cast(float, __builtin_amdgcn_readlane(iv, 16));
    const float c = __builtin_bit_cast(float, __builtin_amdgcn_readlane(iv, 32)), d = __builtin_bit_cast(float, __builtin_amdgcn_readlane(iv, 48));
    return (a + b) + (c + d);
}
__device__ __forceinline__ float rsqrt_fast(float x) { return __builtin_amdgcn_rsqf(x); }
__device__ __forceinline__ float gelu_tanh(float x) {
    const float u = 0.7978845608028654f * (x + 0.044715f * x * x * x);
    const float e = __expf(2.f * u);
    const float th = 1.f - 2.f / (e + 1.f);
    return 0.5f * x * (1.f + th);
}

#define XB_TMO      128
#define XB_XCNT(j)  (256  + 64 * (j))
#define XB_XSUB(j)  (1280 + 64 * (j))
#define XB_XGEN(j)  (2304 + 64 * (j))
#define XB_TOP      3328
#define XB_TOPGEN   3392
#define XCD_BAR_WORDS 3456
#define XB_SPIN_CAP (1u << 18)
__device__ __forceinline__ unsigned xb_ld(unsigned* p)              { return __hip_atomic_load(p, __ATOMIC_RELAXED, __HIP_MEMORY_SCOPE_AGENT); }
__device__ __forceinline__ unsigned xb_add(unsigned* p, unsigned v) { return __hip_atomic_fetch_add(p, v, __ATOMIC_RELAXED, __HIP_MEMORY_SCOPE_AGENT); }
__device__ __forceinline__ unsigned xb_xcc_id() { return (unsigned)__builtin_amdgcn_s_getreg((3 << 11) | 20) & 0xFu; }
#define XB_SPIN(cond, bar) do { unsigned _sp = 0; while (cond) { __builtin_amdgcn_s_sleep(1); \
    if ((++_sp & 255u) == 0u) { if (xb_ld(&(bar)[XB_TMO])) break; if (_sp > XB_SPIN_CAP) { atomicAdd(&(bar)[XB_TMO], 1u); break; } } } } while (0)
struct XcdBarrier { unsigned* bar; unsigned x; volatile LAS unsigned* st; };
__device__ __forceinline__ XcdBarrier xcd_barrier_post(unsigned* bar, volatile LAS unsigned* st) {
    XcdBarrier b; b.bar = bar; b.x = xb_xcc_id(); b.st = st;
    if (threadIdx.x == 0) (void)xb_add(&bar[XB_XCNT(b.x)], 1u);
    return b;
}
__device__ __forceinline__ void xcd_barrier_complete(unsigned* bar, unsigned x, unsigned& nloc, unsigned& nx) {
    const unsigned G = gridDim.x * gridDim.y * gridDim.z;
    unsigned sum, cnt, mine, sp = 0u;
    for (;;) {
        sum = 0u; cnt = 0u; mine = 0u;
#pragma unroll
        for (unsigned j = 0; j < 16; ++j) { const unsigned c = xb_ld(&bar[XB_XCNT(j)]); sum += c; cnt += (c > 0u) ? 1u : 0u; mine = (j == x) ? c : mine; }
        if (sum == G) break;
        __builtin_amdgcn_s_sleep(1);
        if ((++sp & 255u) == 0u) { if (xb_ld(&bar[XB_TMO])) break; if (sp > XB_SPIN_CAP) { atomicAdd(&bar[XB_TMO], 1u); break; } }
    }
    nloc = mine > 0u ? mine : 1u; nx = cnt > 0u ? cnt : 1u;
}
template <bool FIRST>
__device__ __forceinline__ void xcd_barrier_t(const XcdBarrier& b) {
    asm volatile("s_waitcnt vmcnt(0)" ::: "memory");
    __syncthreads();
    if (threadIdx.x == 0) {
        unsigned* bar = b.bar;
        asm volatile("" : "+s"(bar));
        __builtin_amdgcn_s_waitcnt(0);
        unsigned nloc = b.st[0], nx = b.st[1];
        if constexpr (FIRST) { if (nloc == 0u) { xcd_barrier_complete(bar, b.x, nloc, nx); b.st[0] = nloc; b.st[1] = nx; } }
        const unsigned old = xb_add(&bar[XB_XSUB(b.x)], 1u);
        const unsigned gen = old / nloc;
        if (old + 1u == (gen + 1u) * nloc) {
            __builtin_amdgcn_fence(__ATOMIC_RELEASE, "agent");
            asm volatile("s_waitcnt vmcnt(0)" ::: "memory");
            const unsigned og = xb_add(&bar[XB_TOP], 1u);
            const unsigned tg = og / nx;
            if (og + 1u == (tg + 1u) * nx) xb_add(&bar[XB_TOPGEN], 1u);
            else XB_SPIN(xb_ld(&bar[XB_TOPGEN]) == tg, bar);
            __builtin_amdgcn_fence(__ATOMIC_ACQUIRE, "agent");
            xb_add(&bar[XB_XGEN(b.x)], 1u);
            asm volatile("s_waitcnt vmcnt(0)" ::: "memory");
        } else {
            XB_SPIN(xb_ld(&bar[XB_XGEN(b.x)]) == gen, bar);
            __builtin_amdgcn_fence(__ATOMIC_ACQUIRE, "agent");
            asm volatile("s_waitcnt vmcnt(0)" ::: "memory");
        }
    }
    __syncthreads();
}
__device__ __forceinline__ void xcd_barrier(const XcdBarrier& b) { xcd_barrier_t<false>(b); }
__device__ __forceinline__ void xcd_barrier_first(const XcdBarrier& b) { xcd_barrier_t<true>(b); }

namespace pg8 {
constexpr int BM = 256, BK = 64, HALF = 128, HTB = HALF * BK * 2, STAGE_BYTES = 8 * HTB, NXCD = 8, WGM = 8;
constexpr int GK = 2048;
__host__ __device__ __forceinline__ int lds_byte(int r, int c) { const int st = (r >> 4) * 2 + (c >> 5), rr = r & 15, cc = c & 31, ob = rr * 64 + cc * 2; return st * 1024 + (ob ^ (((ob >> 9) & 1) << 5)); }
__host__ __device__ __forceinline__ void stage_rc(int b, int& R, int& C) { const int st = b / 1024, sb = b % 1024, swz = sb ^ (((sb >> 9) & 1) << 5); R = (st >> 1) * 16 + swz / 64; C = (st & 1) * 32 + (swz % 64) / 2; }
__host__ __device__ __forceinline__ int perm32(int rho) { const int n = rho >> 4, i = rho & 15; return 8 * (i >> 2) + 4 * n + (i & 3); }

struct Unit { int pm, pn, e, rowbase, colbase, oidx; const char* a; const char* b; };

struct SchedDense {
    static constexpr int RB = GK * 2;
    const char* A; const char* Bt; int nM, nN, nwg, G, c, skipctx;
    __device__ void init(const void* A_, const void* Bt_, int nM_, int nN_, int G_, int c_, int skipctx_) { A = (const char*)A_; Bt = (const char*)Bt_; nM = nM_; nN = nN_; nwg = nM * nN; G = G_; c = c_; skipctx = skipctx_; }
    __device__ bool next(int i, Unit& u) const {
        const long L = (long)i * G + c; if (L >= nwg) return false;
        int wgid = (int)L; { const int q = nwg / NXCD, r = nwg % NXCD, xcd = wgid % NXCD, off = wgid / NXCD; wgid = (xcd < r ? xcd * (q + 1) : r * (q + 1) + (xcd - r) * q) + off; }
        const int nig = WGM * nN, gid = wgid / nig, fm = gid * WGM, gsz = (nM - fm) < WGM ? (nM - fm) : WGM;
        int pm = fm + ((wgid % nig) % gsz); const int pn = (wgid % nig) / gsz;
        if (skipctx) pm = (pm >> 4) * 17 + 1 + (pm & 15);
        u.pm = pm; u.pn = pn; u.e = 0; u.rowbase = pm * BM; u.colbase = pn * BM; u.oidx = 0;
        u.a = A + (size_t)pm * (BM * GK * 2); u.b = Bt + (size_t)pn * (BM * GK * 2); return true;
    }
};
template <int RB_> struct SchedGrouped {
    static constexpr int RB = RB_;
    const char* A; const char* Bt; int nMe, nNe, nwg, G, c;
    __device__ void init(const void* A_, const void* Bt_, int nMe_, int nNe_, int G_, int c_) { A = (const char*)A_; Bt = (const char*)Bt_; nMe = nMe_; nNe = nNe_; nwg = NE * nMe * nNe; G = G_; c = c_; }
    __device__ bool next(int i, Unit& u) const {
        int e, pm, pn;
        if ((G & 255) == 0) {
            const int cpe = nNe >> 2, nchunk = NE * cpe, xcd = c & 7, slot = (c >> 3) & 31, sub = c >> 8;
            const int chunk = (i * (G >> 8) + sub) * 8 + xcd;
            if (chunk < nchunk) { e = chunk / cpe; pm = slot >> 2; pn = (chunk % cpe) * 4 + (slot & 3); }
            else { const int per = (NE * nNe) >> 3;
                if (nMe < 9 || chunk >= nchunk + 8 || slot >= per) return false; const int j = (chunk - nchunk) * per + slot; e = j / nNe; pn = j % nNe; pm = 8; }
        } else { const long L = (long)i * G + c; if (L >= nwg) return false; const int per = nMe * nNe, rem = (int)L % per; e = (int)L / per; pm = rem % nMe; pn = rem / nMe; }
        u.pm = pm; u.pn = pn; u.e = e; u.rowbase = e * ROWS_E + pm * BM; u.colbase = pn * BM; u.oidx = e * 9 + pm;
        u.a = A + (size_t)(e * ROWS_E + pm * BM) * RB; u.b = Bt + ((size_t)e * nNe + pn) * (BM * RB); return true;
    }
};

__device__ __forceinline__ unsigned cvt_pk_bf16(float lo, float hi) { unsigned r; asm volatile("v_cvt_pk_bf16_f32 %0, %1, %2" : "=v"(r) : "v"(lo), "v"(hi)); return r; }

struct EpiStoreBf16 {
    static constexpr bool PERM = true;
    bf16_t* O; int ldc;
    __device__ __forceinline__ void operator()(const f32x4 (&acc)[2][2][4][2], const Unit& u, int wr, int wc, int fr, int fq) const {
        const int row0 = u.rowbase + wr * 64 + fr, col0 = u.colbase + wc * 32 + 8 * fq;
#pragma unroll
        for (int ai = 0; ai < 2; ++ai)
#pragma unroll
            for (int m = 0; m < 4; ++m) { bf16_t* rowp = O + (size_t)(row0 + ai * HALF + m * 16) * ldc + col0;
#pragma unroll
                for (int bj = 0; bj < 2; ++bj) { const f32x4 v0 = acc[ai][bj][m][0], v1 = acc[ai][bj][m][1];
                    u32x4 w; w.x = cvt_pk_bf16(v0[0], v0[1]); w.y = cvt_pk_bf16(v0[2], v0[3]); w.z = cvt_pk_bf16(v1[0], v1[1]); w.w = cvt_pk_bf16(v1[2], v1[3]);
                    *(u32x4*)(rowp + bj * HALF) = w; } }
    }
};
struct EpiPost {
    static constexpr bool PERM = true;
    bf16_t* P; const float* rope; const float* qna; const float* kna; const float* qnc; const float* knc; const float* vnb; LAS unsigned char* tab;
    __device__ __forceinline__ void operator()(f32x4 (&acc)[2][2][4][2], const Unit& u, int wr, int wc, int fr, int fq) const {
        const int tb = u.pm % 17; const bool lat = tb != 0;
        const int d0 = 64 * (wc >> 1) + 16 * (wc & 1) + 4 * fq, rl0 = wr * 64 + fr;
        int typ[2]; const float* gain[2];
#pragma unroll
        for (int bj = 0; bj < 2; ++bj) { const int slot = 2 * u.pn + bj;
            typ[bj] = (slot < 8) ? 3 : (slot < 10) ? 0 : (slot < 14) ? 1 : (slot < 18) ? 2 : (slot < 26) ? 3 : 0;
            gain[bj] = (slot < 6) ? qna : (slot < 8) ? kna : (slot < 18) ? vnb + ((slot - 14) & 3) * 128 : (slot < 24) ? qnc : knc; }
        const bool anynorm = typ[0] >= 2 || typ[1] >= 2;
#pragma unroll
        for (int bj = 0; bj < 2; ++bj) if (typ[bj] == 1 || typ[bj] == 2) {
#pragma unroll
            for (int ai = 0; ai < 2; ++ai)
#pragma unroll
                for (int m = 0; m < 4; ++m)
#pragma unroll
                    for (int n = 0; n < 2; ++n)
#pragma unroll
                        for (int j = 0; j < 4; ++j) acc[ai][bj][m][n][j] = gelu_tanh(acc[ai][bj][m][n][j]); }
        if (anynorm) {
#pragma unroll
            for (int bj = 0; bj < 2; ++bj) if (typ[bj] >= 2) {
#pragma unroll
                for (int ai = 0; ai < 2; ++ai)
#pragma unroll
                    for (int m = 0; m < 4; ++m) { const f32x4 a = acc[ai][bj][m][0], b = acc[ai][bj][m][1];
                        float ss = ((a.x * a.x + a.y * a.y) + (a.z * a.z + a.w * a.w)) + ((b.x * b.x + b.y * b.y) + (b.z * b.z + b.w * b.w));
                        ss += __builtin_bit_cast(float, __builtin_amdgcn_ds_swizzle(__builtin_bit_cast(int, ss), 0x401F));
                        { auto rr = __builtin_amdgcn_permlane32_swap(__float_as_uint(ss), __float_as_uint(ss), false, false); ss = __uint_as_float(rr[0]) + __uint_as_float(rr[1]); }
                        if (fq == 0) *(LAS float*)(tab + (((rl0 + ai * HALF + m * 16) * 2 + bj) * 4 + wc) * 4) = ss; } }
            asm volatile("s_waitcnt lgkmcnt(0)" ::: "memory"); __builtin_amdgcn_s_barrier(); asm volatile("" ::: "memory");
        }
#pragma unroll
        for (int bj = 0; bj < 2; ++bj) {
            const int slot = 2 * u.pn + bj;
            f32x4 g0 = (f32x4){1.f, 1.f, 1.f, 1.f}, g1 = g0;
            if (typ[bj] >= 2) { g0 = *(const f32x4*)(gain[bj] + d0); g1 = *(const f32x4*)(gain[bj] + d0 + 32); }
#pragma unroll
            for (int ai = 0; ai < 2; ++ai)
#pragma unroll
                for (int m = 0; m < 4; ++m) { const int rl = rl0 + ai * HALF + m * 16;
                    f32x4 a = acc[ai][bj][m][0], b = acc[ai][bj][m][1];
                    if (typ[bj] >= 2) { const f32x4 t = *(const LAS f32x4*)(tab + ((rl * 2 + bj) * 4) * 4);
                        const float rinv = rsqrt_fast(((t.x + t.y) + (t.z + t.w)) * (1.f / 128) + EPS);
                        a = a * rinv * g0; b = b * rinv * g1; }
                    if (typ[bj] == 3 && lat) { const int pos = (tb - 1) * 256 + rl, pp = (wc >> 1) ? (pos & 63) : (pos >> 6);
                        const f32x4* cs = (const f32x4*)(rope + 2 * (pp * 32 + 16 * (wc & 1) + 4 * fq)); const f32x4 c0 = cs[0], c1 = cs[1];
                        const f32x4 cv = (f32x4){c0.x, c0.z, c1.x, c1.z}, sv = (f32x4){c0.y, c0.w, c1.y, c1.w};
                        const f32x4 ra = a * cv - b * sv, rb = b * cv + a * sv; a = ra; b = rb; }
                    bf16_t* rowp = P + (size_t)(u.rowbase + rl) * INW + slot * 128 + d0;
                    u32x2 w0, w1; w0.x = cvt_pk_bf16(a.x, a.y); w0.y = cvt_pk_bf16(a.z, a.w); w1.x = cvt_pk_bf16(b.x, b.y); w1.y = cvt_pk_bf16(b.z, b.w);
                    *(u32x2*)rowp = w0; *(u32x2*)(rowp + 32) = w1; }
        }
    }
};
struct EpiResid {
    static constexpr bool PERM = false;
    const float* ctxbase; const float* latbase; int cbs, lbs;
    float* xout; const float* modl;
    float* parts;
    __device__ __forceinline__ void operator()(const f32x4 (&acc)[2][2][4][2], const Unit& u, int wr, int wc, int fr, int fq) const {
        const int b = u.pm / 17, tb = u.pm % 17;
        const float* src = (tb == 0) ? ctxbase + (size_t)b * cbs * DM : latbase + ((size_t)b * lbs + (size_t)(tb - 1) * 256) * DM;
        const float* g1 = modl + (size_t)((tb == 0) ? 4 : b) * NMOD + 2 * DM;
        const int rl0 = wr * 64 + fr, col0 = u.colbase + wc * 32 + 4 * fq;
        f32x4 gv[2][2];
#pragma unroll
        for (int bj = 0; bj < 2; ++bj)
#pragma unroll
            for (int n = 0; n < 2; ++n) gv[bj][n] = *(const f32x4*)(g1 + col0 + bj * HALF + n * 16);
#pragma unroll
        for (int ai = 0; ai < 2; ++ai)
#pragma unroll
        for (int mh = 0; mh < 2; ++mh) {
            f32x4 xv[2][2][2];
#pragma unroll
            for (int mm = 0; mm < 2; ++mm) { const float* sp = src + (size_t)(rl0 + ai * HALF + (2 * mh + mm) * 16) * DM + col0;
#pragma unroll
                for (int bj = 0; bj < 2; ++bj)
#pragma unroll
                    for (int n = 0; n < 2; ++n) xv[mm][bj][n] = *(const f32x4*)(sp + bj * HALF + n * 16); }
#pragma unroll
            for (int mm = 0; mm < 2; ++mm) { const int m = 2 * mh + mm, rl = rl0 + ai * HALF + m * 16; float* dp = xout + (size_t)(u.rowbase + rl) * DM + col0; float ss = 0.f;
#pragma unroll
                for (int bj = 0; bj < 2; ++bj)
#pragma unroll
                    for (int n = 0; n < 2; ++n) { const f32x4 y = xv[mm][bj][n] + gv[bj][n] * acc[ai][bj][m][n]; *(f32x4*)(dp + bj * HALF + n * 16) = y;
                        ss += (y.x * y.x + y.y * y.y) + (y.z * y.z + y.w * y.w); }
                ss += __builtin_bit_cast(float, __builtin_amdgcn_ds_swizzle(__builtin_bit_cast(int, ss), 0x401F));
                { auto rr = __builtin_amdgcn_permlane32_swap(__float_as_uint(ss), __float_as_uint(ss), false, false); ss = __uint_as_float(rr[0]) + __uint_as_float(rr[1]); }
                if (fq == 0) parts[(size_t)(u.rowbase + rl) * 32 + u.pn * 4 + wc] = ss; }
            asm volatile("" ::: "memory");
        }
    }
};
struct EpiSwiGLU {
    static constexpr bool PERM = true;
    bf16_t* Hout;
    __device__ __forceinline__ void operator()(const f32x4 (&acc)[2][2][4][2], const Unit& u, int wr, int wc, int fr, int fq) const {
        const int row0 = u.rowbase + wr * 64 + fr, col0 = u.pn * HALF + wc * 32 + 8 * fq;
#pragma unroll
        for (int ai = 0; ai < 2; ++ai)
#pragma unroll
            for (int m = 0; m < 4; ++m) { bf16_t* rowp = Hout + (size_t)(row0 + ai * HALF + m * 16) * DM + col0; float h[8];
#pragma unroll
                for (int n = 0; n < 2; ++n)
#pragma unroll
                    for (int j = 0; j < 4; ++j) { const float g = acc[ai][0][m][n][j], up = acc[ai][1][m][n][j]; h[n * 4 + j] = g * __builtin_amdgcn_rcpf(1.f + __expf(-g)) * up; }
                u32x4 w; w.x = cvt_pk_bf16(h[0], h[1]); w.y = cvt_pk_bf16(h[2], h[3]); w.z = cvt_pk_bf16(h[4], h[5]); w.w = cvt_pk_bf16(h[6], h[7]);
                *(u32x4*)rowp = w; }
    }
};
struct EpiSwiGLU8 {
    static constexpr bool PERM = true;
    unsigned char* Hout;
    __device__ __forceinline__ void operator()(const f32x4 (&acc)[2][2][4][2], const Unit& u, int wr, int wc, int fr, int fq) const {
        const int row0 = u.rowbase + wr * 64 + fr, col0 = u.pn * HALF + wc * 32 + 8 * fq;
#pragma unroll
        for (int ai = 0; ai < 2; ++ai)
#pragma unroll
            for (int m = 0; m < 4; ++m) { unsigned char* rowp = Hout + (size_t)(row0 + ai * HALF + m * 16) * DM + col0; float h[8];
#pragma unroll
                for (int n = 0; n < 2; ++n)
#pragma unroll
                    for (int j = 0; j < 4; ++j) { const float g = acc[ai][0][m][n][j], up = acc[ai][1][m][n][j]; h[n * 4 + j] = g * __builtin_amdgcn_rcpf(1.f + __expf(-g)) * up; }
                u32x2 w; w.x = pk4_fp8(h[0], h[1], h[2], h[3]); w.y = pk4_fp8(h[4], h[5], h[6], h[7]);
                *(u32x2*)rowp = w; }
    }
};
struct EpiDown {
    static constexpr bool PERM = true;
    bf16_t* Y; const float* gatev;
    __device__ __forceinline__ void operator()(const f32x4 (&acc)[2][2][4][2], const Unit& u, int wr, int wc, int fr, int fq) const {
        const int row0 = u.rowbase + wr * 64 + fr, col0 = u.colbase + wc * 32 + 8 * fq;
#pragma unroll
        for (int ai = 0; ai < 2; ++ai)
#pragma unroll
            for (int m = 0; m < 4; ++m) { const int row = row0 + ai * HALF + m * 16; const float gt = gatev[row]; bf16_t* rowp = Y + (size_t)row * DM + col0;
#pragma unroll
                for (int bj = 0; bj < 2; ++bj) { const f32x4 v0 = acc[ai][bj][m][0] * gt, v1 = acc[ai][bj][m][1] * gt;
                    u32x4 w; w.x = cvt_pk_bf16(v0[0], v0[1]); w.y = cvt_pk_bf16(v0[2], v0[3]); w.z = cvt_pk_bf16(v1[0], v1[1]); w.w = cvt_pk_bf16(v1[2], v1[3]);
                    *(u32x4*)(rowp + bj * HALF) = w; } }
    }
};

template <class Epi, class Sched, bool FP8 = false, bool GATHER = false, bool ALIGN_EPI = true, bool SP2 = true>
__device__ __forceinline__ void gemm_phase(LAS unsigned char* lds, const Sched& S, const Epi& E, const unsigned* goffs = nullptr, LAS unsigned char* goffs_lds = nullptr) {
    static_assert(!GATHER || SP2, "gather mode is written for the SP2 loop");
    static_assert(Sched::RB == (FP8 ? GK : GK * 2), "operand row bytes");
    const int tid = opaque_tid(), wid = __builtin_amdgcn_readfirstlane(tid >> 6), lane = tid & 63, wr = wid >> 2, wc = wid & 3, fr = lane & 15, fq = lane >> 4;
    constexpr int RB = Sched::RB, nt = RB / 128;
    unsigned voffA[2], voffB[2];
#pragma unroll
    for (int i = 0; i < 2; ++i) { int R, C; stage_rc(tid * 16 + i * 8192, R, C); const int Rb = Epi::PERM ? ((R & ~31) + perm32(R & 31)) : R;
        voffA[i] = (unsigned)(R * RB + C * 2); voffB[i] = (unsigned)(Rb * RB + C * 2); }
    const size_t kstep = (size_t)(BK * 2);
    const size_t hstep = (size_t)HALF * RB;
    const unsigned ldsw = (unsigned)wid * 1024u;
    const int aoff = lds_byte(wr * 64 + fr, fq * 8), boff = lds_byte(wc * 32 + fr, fq * 8);
#define PG8_SA(b, h) (((b) * 2 + (h)) * HTB)
#define PG8_SB(b, h) ((4 + (b) * 2 + (h)) * HTB)
#define PG8_STAGE(bufoff, gbase, voff) do { _Pragma("unroll") for (int _i = 0; _i < 2; ++_i) \
        __builtin_amdgcn_global_load_lds((const unsigned*)((const char*)(gbase) + (voff)[_i]), (LAS unsigned*)(lds + (bufoff) + ldsw + _i * 8192), 16, 0, 0); } while (0)
#define PG8_RD8(p) __builtin_shufflevector(*(const LAS i32x4*)(p), *(const LAS i32x4*)((p) + 1024), 0, 1, 2, 3, 4, 5, 6, 7)
#define PG8_LDA(dst, b, h) do { _Pragma("unroll") for (int m = 0; m < 4; ++m) { if constexpr (FP8) dst##8[m] = PG8_RD8(lds + PG8_SA(b, h) + aoff + m * 2048); \
        else { _Pragma("unroll") for (int k = 0; k < 2; ++k) dst[m][k] = *(const LAS bf16x8*)(lds + PG8_SA(b, h) + aoff + m * 2048 + k * 1024); } } } while (0)
#define PG8_LDB(dst, b, h) do { _Pragma("unroll") for (int n = 0; n < 2; ++n) { if constexpr (FP8) dst##8[n] = PG8_RD8(lds + PG8_SB(b, h) + boff + n * 2048); \
        else { _Pragma("unroll") for (int k = 0; k < 2; ++k) dst[n][k] = *(const LAS bf16x8*)(lds + PG8_SB(b, h) + boff + n * 2048 + k * 1024); } } } while (0)
#define PG8_MMA(ai, bj, At, Bt) do { __builtin_amdgcn_s_setprio(1); _Pragma("unroll") for (int m = 0; m < 4; ++m) _Pragma("unroll") for (int n = 0; n < 2; ++n) { \
        if constexpr (FP8) asm volatile("v_mfma_scale_f32_16x16x128_f8f6f4 %0, %1, %2, %0, %3, %4 op_sel_hi:[0,0,0]" : "+v"(acc[ai][bj][m][n]) : "v"(Bt##8[n]), "v"(At##8[m]), "v"(sclW), "v"(sclX)); \
        else { _Pragma("unroll") for (int k = 0; k < 2; ++k) acc[ai][bj][m][n] = __builtin_amdgcn_mfma_f32_16x16x32_bf16(Bt[n][k], At[m][k], acc[ai][bj][m][n], 0, 0, 0); } } \
        __builtin_amdgcn_s_setprio(0); } while (0)
#define PG8_WAIT_V(n) asm volatile("s_waitcnt vmcnt(" #n ")" ::: "memory")
#define PG8_WAIT_L(n) asm volatile("s_waitcnt lgkmcnt(" #n ")" ::: "memory")
#define PG8_BAR __builtin_amdgcn_s_barrier()
#define PG8_SCHED __builtin_amdgcn_sched_barrier(0)
    Unit cur, nxt; int ui = 0;
    if (!S.next(0, cur)) return;
    u32x4 gC = (u32x4){0u, 0u, 0u, 0u}, gN = gC;
    if constexpr (GATHER) gC = *(const u32x4*)(goffs + ((size_t)cur.oidx * 512 + tid) * 4);
#define PG8_GSTAGE(bufoff, gbase, o0, o1) do { \
        __builtin_amdgcn_global_load_lds((const unsigned*)((const char*)(gbase) + (o0)), (LAS unsigned*)(lds + (bufoff) + ldsw), 16, 0, 0); \
        __builtin_amdgcn_global_load_lds((const unsigned*)((const char*)(gbase) + (o1)), (LAS unsigned*)(lds + (bufoff) + ldsw + 8192), 16, 0, 0); } while (0)
    f32x4 acc[2][2][4][2];
#pragma unroll
    for (int a = 0; a < 2; ++a)
#pragma unroll
        for (int b = 0; b < 2; ++b)
#pragma unroll
            for (int m = 0; m < 4; ++m)
#pragma unroll
                for (int n = 0; n < 2; ++n) acc[a][b][m][n] = (f32x4){0.f, 0.f, 0.f, 0.f};
    int sclW = W8_SCALE_E8M0 * 0x01010101, sclX = 0x7f7f7f7f; if constexpr (FP8) asm volatile("" : "+v"(sclW), "+v"(sclX)); (void)sclW; (void)sclX;
    bf16x8 At[4][2], B0[2][2], B1[2][2]; i32x8 At8[4], B08[2], B18[2];
    const char* cA = cur.a; const char* cB = cur.b;
    if constexpr (SP2) {
        PG8_STAGE(PG8_SB(0, 0), cB, voffB); PG8_STAGE(PG8_SB(0, 1), cB + hstep, voffB);
        if constexpr (GATHER) { PG8_GSTAGE(PG8_SA(0, 0), S.A, gC.x, gC.y); PG8_GSTAGE(PG8_SA(0, 1), S.A, gC.z, gC.w); }
        else { PG8_STAGE(PG8_SA(0, 0), cA, voffA); PG8_STAGE(PG8_SA(0, 1), cA + hstep, voffA); }
        if (wr == 1) PG8_BAR;
        PG8_WAIT_V(2); PG8_BAR;
        PG8_STAGE(PG8_SB(1, 0), cB + kstep, voffB);
        if constexpr (GATHER) PG8_GSTAGE(PG8_SA(1, 0), S.A + kstep, gC.x, gC.y); else PG8_STAGE(PG8_SA(1, 0), cA + kstep, voffA);
        PG8_STAGE(PG8_SB(1, 1), cB + hstep + kstep, voffB);
        PG8_WAIT_V(6); PG8_BAR;
    } else {
        PG8_STAGE(PG8_SB(0, 0), cB, voffB); PG8_STAGE(PG8_SA(0, 0), cA, voffA); PG8_STAGE(PG8_SB(0, 1), cB + hstep, voffB); PG8_STAGE(PG8_SA(0, 1), cA + hstep, voffA);
        if (wr == 1) PG8_BAR;
        PG8_WAIT_V(4); PG8_BAR;
        PG8_STAGE(PG8_SB(1, 0), cB + kstep, voffB); PG8_STAGE(PG8_SA(1, 0), cA + kstep, voffA); PG8_STAGE(PG8_SB(1, 1), cB + hstep + kstep, voffB);
        PG8_WAIT_V(6); PG8_BAR;
    }
    for (;;) {
        const bool has_next = S.next(ui + 1, nxt);
        const char* nA = has_next ? nxt.a : cA; const char* nB = has_next ? nxt.b : cB;
        if constexpr (GATHER) { if (has_next)
            __builtin_amdgcn_global_load_lds((const unsigned*)(goffs + ((size_t)nxt.oidx * 512 + tid) * 4), (LAS unsigned*)(goffs_lds + ldsw), 16, 0, 0); }
        for (int t = 0; t < nt; t += 2) {
            const bool last = (t == nt - 2);
            const char* a1 = cA + (size_t)(t + 1) * kstep;
            const char* a2 = last ? nA : cA + (size_t)(t + 2) * kstep; const char* b2 = last ? nB : cB + (size_t)(t + 2) * kstep;
            const char* a3 = a2 + kstep; const char* b3 = b2 + kstep;
            const char* g1 = S.A + (size_t)(t + 1) * kstep; const char* g2 = S.A + (last ? (size_t)0 : (size_t)(t + 2) * kstep); const char* g3 = g2 + kstep;
            u32x4 gX = gC;
            if constexpr (GATHER) { if (last) { if (has_next) gN = *(const LAS u32x4*)(goffs_lds + (size_t)tid * 16); else gN = gC; gX = gN; } }
            if constexpr (SP2) {
            PG8_LDB(B0, 0, 0); PG8_LDB(B1, 0, 1); PG8_SCHED; PG8_LDA(At, 0, 0);
            if constexpr (GATHER) PG8_GSTAGE(PG8_SA(1, 1), g1, gC.z, gC.w); else PG8_STAGE(PG8_SA(1, 1), a1 + hstep, voffA);
            PG8_WAIT_V(8); PG8_WAIT_L(0); PG8_BAR; PG8_MMA(0, 0, At, B0); PG8_MMA(0, 1, At, B1); PG8_BAR; PG8_SCHED;
            PG8_LDA(At, 0, 1); PG8_STAGE(PG8_SB(0, 0), b2, voffB); PG8_STAGE(PG8_SB(0, 1), b2 + hstep, voffB);
            if constexpr (GATHER) PG8_GSTAGE(PG8_SA(0, 0), g2, gX.x, gX.y); else PG8_STAGE(PG8_SA(0, 0), a2, voffA);
            PG8_WAIT_V(8); PG8_WAIT_L(0); PG8_BAR; PG8_MMA(1, 0, At, B0); PG8_MMA(1, 1, At, B1); PG8_BAR; PG8_SCHED;
            PG8_LDB(B0, 1, 0); PG8_LDB(B1, 1, 1); PG8_SCHED; PG8_LDA(At, 1, 0);
            if constexpr (GATHER) PG8_GSTAGE(PG8_SA(0, 1), g2, gX.z, gX.w); else PG8_STAGE(PG8_SA(0, 1), a2 + hstep, voffA);
            PG8_WAIT_V(8); PG8_WAIT_L(0); PG8_BAR; PG8_MMA(0, 0, At, B0); PG8_MMA(0, 1, At, B1); PG8_BAR; PG8_SCHED;
            PG8_LDA(At, 1, 1); PG8_STAGE(PG8_SB(1, 0), b3, voffB); PG8_STAGE(PG8_SB(1, 1), b3 + hstep, voffB);
            if constexpr (GATHER) PG8_GSTAGE(PG8_SA(1, 0), g3, gX.x, gX.y); else PG8_STAGE(PG8_SA(1, 0), a3, voffA);
            PG8_WAIT_V(8); PG8_WAIT_L(0); PG8_BAR; PG8_MMA(1, 0, At, B0); PG8_MMA(1, 1, At, B1); PG8_BAR; PG8_SCHED;
            } else {
            PG8_LDB(B0, 0, 0); PG8_SCHED; PG8_LDA(At, 0, 0); PG8_STAGE(PG8_SA(1, 1), a1 + hstep, voffA);
            PG8_WAIT_L(8); PG8_BAR; PG8_WAIT_L(0); PG8_MMA(0, 0, At, B0); PG8_BAR; PG8_SCHED;
            PG8_LDB(B1, 0, 1); PG8_STAGE(PG8_SB(0, 0), b2, voffB);
            PG8_BAR; PG8_WAIT_L(0); PG8_MMA(0, 1, At, B1); PG8_BAR;
            PG8_LDA(At, 0, 1); PG8_STAGE(PG8_SA(0, 0), a2, voffA);
            PG8_BAR; PG8_WAIT_L(0); PG8_MMA(1, 0, At, B0); PG8_BAR; PG8_SCHED;
            PG8_STAGE(PG8_SB(0, 1), b2 + hstep, voffB);
            PG8_WAIT_V(6); PG8_BAR; PG8_MMA(1, 1, At, B1); PG8_BAR;
            PG8_LDB(B0, 1, 0); PG8_SCHED; PG8_LDA(At, 1, 0); PG8_STAGE(PG8_SA(0, 1), a2 + hstep, voffA);
            PG8_WAIT_L(8); PG8_BAR; PG8_WAIT_L(0); PG8_MMA(0, 0, At, B0); PG8_BAR; PG8_SCHED;
            PG8_LDB(B1, 1, 1); PG8_STAGE(PG8_SB(1, 0), b3, voffB);
            PG8_BAR; PG8_WAIT_L(0); PG8_MMA(0, 1, At, B1); PG8_BAR;
            PG8_LDA(At, 1, 1); PG8_STAGE(PG8_SA(1, 0), a3, voffA);
            PG8_BAR; PG8_WAIT_L(0); PG8_MMA(1, 0, At, B0); PG8_BAR; PG8_SCHED;
            PG8_STAGE(PG8_SB(1, 1), b3 + hstep, voffB);
            PG8_WAIT_V(6); PG8_BAR; PG8_MMA(1, 1, At, B1); PG8_BAR;
            }
        }
        if constexpr (ALIGN_EPI) { if (wr == 0) PG8_BAR; }
        if constexpr (FP8) asm volatile("s_nop 15\n\ts_nop 15\n\ts_nop 7" ::: "memory");
        E(acc, cur, wr, wc, fr, fq);
        if (!has_next) break;
#pragma unroll
        for (int a = 0; a < 2; ++a)
#pragma unroll
            for (int b = 0; b < 2; ++b)
#pragma unroll
                for (int m = 0; m < 4; ++m)
#pragma unroll
                    for (int n = 0; n < 2; ++n) acc[a][b][m][n] = (f32x4){0.f, 0.f, 0.f, 0.f};
        cur = nxt; cA = nA; cB = nB; ++ui; gC = gN;
        if constexpr (ALIGN_EPI) { if (wr == 1) PG8_BAR; }
    }
    PG8_WAIT_V(0);
    if constexpr (!ALIGN_EPI) { if (wr == 0) PG8_BAR; }
    PG8_BAR;
#undef PG8_SA
#undef PG8_SB
#undef PG8_STAGE
#undef PG8_GSTAGE
#undef PG8_LDA
#undef PG8_LDB
#undef PG8_MMA
#undef PG8_RD8
#undef PG8_WAIT_V
#undef PG8_WAIT_L
#undef PG8_BAR
#undef PG8_SCHED
}
}

namespace at {
constexpr int D = 128, NW = 8, QBLK = 32, KVBLK = 64;
constexpr float SCALE = 0.088388347648318440f;
constexpr float THR = 8.f;
constexpr int LDQ = INW, LDK = INW, LDO = DM;
constexpr size_t SHM_V = KVBLK * D * 2, SHM_K = KVBLK * D * 2, SHM_ATTN = 2 * SHM_V + 2 * SHM_K + NW * 64 * 4;
#define KSWZ(row, colB) ((row) * 256 + ((colB) ^ (((row) & 7) << 4)))
#define SBAR() __builtin_amdgcn_sched_barrier(0)
__device__ __forceinline__ int crow(int r, int hi) { return (r & 3) + 8 * (r >> 2) + 4 * hi; }
__device__ __forceinline__ unsigned cvtpk(float lo, float hi) { unsigned r; asm volatile("v_cvt_pk_bf16_f32 %0, %1, %2" : "=v"(r) : "v"(lo), "v"(hi)); return r; }

__device__ __forceinline__ void partialSM(f32x16& p0, f32x16& p1, float& m_reg, float& mn, float& alpha, bool domask, int dq, int hi) {
  constexpr float C = SCALE * 1.4426950408889634f;
  {
    if (domask) {
#pragma unroll
      for (int r = 0; r < 16; ++r) { const int d0 = dq + crow(r, hi), d1 = d0 + 32;
        if (d0 > 128 || d0 < -128) p0[r] = -1e30f;
        if (d1 > 128 || d1 < -128) p1[r] = -1e30f; }
    }
  }
  float pmax = p0[0]; for (int r = 1; r < 16; ++r) pmax = fmaxf(pmax, p0[r]); for (int r = 0; r < 16; ++r) pmax = fmaxf(pmax, p1[r]);
  { auto rr = __builtin_amdgcn_permlane32_swap(__float_as_uint(pmax), __float_as_uint(pmax), false, false);
    pmax = fmaxf(__uint_as_float(rr[0]), __uint_as_float(rr[1])); }
  if (__builtin_expect(__all(pmax - m_reg <= THR / SCALE), 1)) { mn = m_reg; alpha = 1.f; }
  else { mn = fmaxf(m_reg, pmax); alpha = __builtin_amdgcn_exp2f((m_reg - mn) * C); m_reg = mn; }
  float mnC = -mn * C;
  for (int r = 0; r < 16; ++r) p0[r] = fmaf(p0[r], C, mnC); for (int r = 0; r < 16; ++r) p1[r] = fmaf(p1[r], C, mnC);
  for (int r = 0; r < 16; ++r) p0[r] = __builtin_amdgcn_exp2f(p0[r]);
}
__device__ __forceinline__ void finishSM(f32x16& p0, f32x16& p1, float alpha, float& l_reg, bf16x8& pa0, bf16x8& pa1, bf16x8& pa2, bf16x8& pa3) {
  for (int r = 0; r < 16; ++r) p1[r] = __builtin_amdgcn_exp2f(p1[r]);
  float ps = 0; for (int r = 0; r < 16; ++r) ps += p0[r]; for (int r = 0; r < 16; ++r) ps += p1[r];
  { auto rr = __builtin_amdgcn_permlane32_swap(__float_as_uint(ps), __float_as_uint(ps), false, false);
    ps = __uint_as_float(rr[0]) + __uint_as_float(rr[1]); }
  l_reg = l_reg * alpha + ps;
#define PK4(P, BASE, OUT) do { unsigned a0 = cvtpk(P[BASE + 0], P[BASE + 1]), a1 = cvtpk(P[BASE + 2], P[BASE + 3]);   \
    unsigned b0 = cvtpk(P[BASE + 4], P[BASE + 5]), b1 = cvtpk(P[BASE + 6], P[BASE + 7]);                              \
    auto r0 = __builtin_amdgcn_permlane32_swap(a0, b0, false, false); auto r1 = __builtin_amdgcn_permlane32_swap(a1, b1, false, false); \
    u32x4 w = {r0[0], r1[0], r0[1], r1[1]}; OUT = *reinterpret_cast<bf16x8*>(&w); } while (0)
  PK4(p0, 0, pa0); PK4(p0, 8, pa1); PK4(p1, 0, pa2); PK4(p1, 8, pa3);
#undef PK4
}
__device__ __forceinline__ void qkt(f32x16& p0, f32x16& p1, const char* Ks, const bf16x8* qr, int ka0) {
  p0 = f32x16{}; p1 = f32x16{};
  asm volatile("" : "+v"(ka0));
#pragma unroll
  for (int d0 = 0; d0 < 8; ++d0) { const int off = ka0 ^ (d0 * 32);
    bf16x8 b0 = *reinterpret_cast<const bf16x8*>(Ks + off);
    bf16x8 b1 = *reinterpret_cast<const bf16x8*>(Ks + off + 32 * 256);
    p0 = __builtin_amdgcn_mfma_f32_32x32x16_bf16(b0, qr[d0], p0, 0, 0, 0);
    p1 = __builtin_amdgcn_mfma_f32_32x32x16_bf16(b1, qr[d0], p1, 0, 0, 0); }
}
__device__ __forceinline__ int v_st(int k, int c) { const int kk = (k & ~0xC) | ((k & 4) << 1) | ((k & 8) >> 1); return ((kk >> 3) * 4 + (c >> 5)) * 512 + ((kk & 7) * 32 + (c & 31)) * 2; }
__device__ __forceinline__ int v_rd_base(int lane) { return ((lane & 3) << 3) | (((lane >> 2) & 3) << 6) | (((lane >> 4) & 1) << 5) | (((lane >> 5) & 1) << 8); }
constexpr int v_rd_off(int d0, int ks, int half) { return d0 * 512 + ks * 4096 + half * 2048; }
template <int OFF> __device__ __forceinline__ s16x4 tr_read(int vb) {
  s16x4 r; asm volatile("ds_read_b64_tr_b16 %0, %1 offset:%2" : "=&v"(r) : "v"(vb), "i"(OFF) : "memory"); return r;
}
template <int D0> __device__ __forceinline__ void pv_one(f32x16& od, int vb, bf16x8 pa0, bf16x8 pa1, bf16x8 pa2, bf16x8 pa3) {
  const s16x4 l0 = tr_read<v_rd_off(D0, 0, 0)>(vb), h0 = tr_read<v_rd_off(D0, 0, 1)>(vb), l1 = tr_read<v_rd_off(D0, 1, 0)>(vb), h1 = tr_read<v_rd_off(D0, 1, 1)>(vb);
  const s16x4 l2 = tr_read<v_rd_off(D0, 2, 0)>(vb), h2 = tr_read<v_rd_off(D0, 2, 1)>(vb), l3 = tr_read<v_rd_off(D0, 3, 0)>(vb), h3 = tr_read<v_rd_off(D0, 3, 1)>(vb);
  asm volatile("s_waitcnt lgkmcnt(0)" ::: "memory"); SBAR();
#define PK(L, H) (bf16x8){L[0], L[1], L[2], L[3], H[0], H[1], H[2], H[3]}
  od = __builtin_amdgcn_mfma_f32_32x32x16_bf16(pa0, PK(l0, h0), od, 0, 0, 0);
  od = __builtin_amdgcn_mfma_f32_32x32x16_bf16(pa1, PK(l1, h1), od, 0, 0, 0);
  od = __builtin_amdgcn_mfma_f32_32x32x16_bf16(pa2, PK(l2, h2), od, 0, 0, 0);
  od = __builtin_amdgcn_mfma_f32_32x32x16_bf16(pa3, PK(l3, h3), od, 0, 0, 0);
#undef PK
}
__device__ __forceinline__ void pv_d0(f32x16* o, int vb, bf16x8 pa0, bf16x8 pa1, bf16x8 pa2, bf16x8 pa3) {
  pv_one<0>(o[0], vb, pa0, pa1, pa2, pa3); pv_one<1>(o[1], vb, pa0, pa1, pa2, pa3); pv_one<2>(o[2], vb, pa0, pa1, pa2, pa3); pv_one<3>(o[3], vb, pa0, pa1, pa2, pa3);
}

__device__ __forceinline__ void attn_body(const bf16_t* __restrict__ Qb, const bf16_t* __restrict__ Kb, const bf16_t* __restrict__ Vb, bf16_t* __restrict__ Ob,
                                          int NT, int kskip, int qpos0, float m0, float l0, bool maskon, char* lds) {
  const int tid = opaque_tid(), wid = tid >> 6, lane = tid & 63, r32 = lane & 31, hi = lane >> 5;
  char* V_lds = lds; char* K_lds = lds + 2 * SHM_V;
  float* ws = (float*)(lds + 2 * SHM_V + 2 * SHM_K) + wid * 64; float* li_l = ws; float* al_l = ws + 32;
  float m_reg = m0, l_reg = l0; f32x16 o[4] = {}; bf16x8 qr[8];
  const bf16_t* Qw = Qb + (long)(wid * QBLK + r32) * LDQ + hi * 8;
#pragma unroll
  for (int d0 = 0; d0 < 8; ++d0) qr[d0] = *reinterpret_cast<const bf16x8*>(Qw + d0 * 16);
  const int sr = tid >> 4, sc = (tid & 15) * 8, vst0 = v_st(sr, sc), kst0 = KSWZ(sr, sc * 2);
  const int vb0 = (int)(uintptr_t)V_lds + v_rd_base(lane);
  const int qpos = qpos0 + wid * QBLK + r32;
  const int ka0 = r32 * 256 + ((hi * 16) ^ ((r32 & 7) << 4));
  const unsigned goff0 = (unsigned)(sr * LDK + sc) * 2u, goff1 = goff0 + 32u * LDK * 2u;
  struct { bf16x8 vs0, vs1, ks0, ks1; } sr_[1];
#define TROW(jt) ((long)(jt) * KVBLK + ((jt) >= 4 ? kskip : 0))
#define SLOAD(i, jt) do { const long _k0 = TROW(jt) * (LDK * 2); const char* _kp = (const char*)Kb + _k0; const char* _vp = (const char*)Vb + _k0; \
    sr_[i].vs0 = *reinterpret_cast<const bf16x8*>(_vp + goff0); sr_[i].vs1 = *reinterpret_cast<const bf16x8*>(_vp + goff1); \
    sr_[i].ks0 = *reinterpret_cast<const bf16x8*>(_kp + goff0); sr_[i].ks1 = *reinterpret_cast<const bf16x8*>(_kp + goff1); } while (0)
#define SWRITE(b, i) do { *(bf16x8*)(V_lds + (b) * SHM_V + vst0) = sr_[i].vs0;          \
    *(bf16x8*)(V_lds + (b) * SHM_V + vst0 + 8192) = sr_[i].vs1;                         \
    *(bf16x8*)(K_lds + (b) * SHM_K + kst0) = sr_[i].ks0;                               \
    *(bf16x8*)(K_lds + (b) * SHM_K + kst0 + 8192) = sr_[i].ks1; } while (0)
#define SWAIT() asm volatile("s_waitcnt vmcnt(0)" ::: "memory")
#define RESC(a) do { if (__any((a) < 1.f)) { if (hi == 0) al_l[r32] = (a); asm volatile("s_waitcnt lgkmcnt(0)" ::: "memory"); \
    for (int d = 0; d < 4; ++d) for (int r = 0; r < 16; ++r) o[d][r] *= al_l[crow(r, hi)]; } } while (0)
#define DQ(jt) (kskip + ((jt) - 4) * KVBLK - qpos)
  f32x16 pA0, pA1, pB0, pB1; float mnA, mnB, alA, alB; bf16x8 pa0, pa1, pa2, pa3;
  constexpr int SE = 0, SO = 0;
  SLOAD(SE, 0); asm volatile("s_waitcnt vmcnt(0)" ::: "memory"); SWRITE(0, SE); __syncthreads();
  qkt(pA0, pA1, K_lds, qr, ka0); partialSM(pA0, pA1, m_reg, mnA, alA, false, 0, hi);
  SLOAD(SO, 1);
  SWAIT(); SWRITE(1, SO); __syncthreads();
  for (int j = 1; j + 1 < NT; j += 2) {
    SBAR(); qkt(pB0, pB1, K_lds + SHM_K, qr, ka0);
    finishSM(pA0, pA1, alA, l_reg, pa0, pa1, pa2, pa3); SBAR();
    SLOAD(SO, j + 1); SBAR();
    pv_d0(o, vb0, pa0, pa1, pa2, pa3); partialSM(pB0, pB1, m_reg, mnB, alB, maskon && j >= 4, DQ(j), hi);
    __syncthreads(); SWAIT(); SWRITE(0, SE);
    RESC(alB); __syncthreads();
    SBAR(); qkt(pA0, pA1, K_lds, qr, ka0);
    finishSM(pB0, pB1, alB, l_reg, pa0, pa1, pa2, pa3); SBAR();
    SLOAD(SE, j + 2); SBAR();
    pv_d0(o, vb0 + (int)SHM_V, pa0, pa1, pa2, pa3); partialSM(pA0, pA1, m_reg, mnA, alA, maskon && j + 1 >= 4, DQ(j + 1), hi);
    __syncthreads(); SWAIT(); SWRITE(1, SO);
    RESC(alA); __syncthreads();
  }
  SBAR(); qkt(pB0, pB1, K_lds + SHM_K, qr, ka0);
  finishSM(pA0, pA1, alA, l_reg, pa0, pa1, pa2, pa3); SBAR();
  pv_d0(o, vb0, pa0, pa1, pa2, pa3); partialSM(pB0, pB1, m_reg, mnB, alB, maskon && NT - 1 >= 4, DQ(NT - 1), hi);
  __syncthreads(); RESC(alB);
  finishSM(pB0, pB1, alB, l_reg, pa0, pa1, pa2, pa3); SBAR();
  pv_d0(o, vb0 + (int)SHM_V, pa0, pa1, pa2, pa3);
  if (hi == 0) li_l[r32] = l_reg; asm volatile("s_waitcnt lgkmcnt(0)" ::: "memory");
  float rli[16];
#pragma unroll
  for (int r = 0; r < 16; ++r) rli[r] = __builtin_amdgcn_rcpf(li_l[crow(r, hi)]);
  bf16_t* Ow = Ob + (long)(wid * QBLK) * LDO;
#pragma unroll
  for (int r = 0; r < 16; ++r) { int orow = crow(r, hi);
    for (int d0 = 0; d0 < 4; ++d0) Ow[(long)orow * LDO + d0 * 32 + r32] = (bf16_t)f2bf(o[d0][r] * rli[r]); }
#undef TROW
#undef SLOAD
#undef SWRITE
#undef SWAIT
#undef RESC
#undef DQ
}
}

struct Args { const float* in[23]; float* out; unsigned char* ws; int ph_lo, ph_hi; };
enum { IN_X = 0, IN_C, IN_CTX, IN_CCTX, IN_WMOD, IN_BMOD, IN_N1G, IN_N2G, IN_WIN, IN_QNA, IN_KNA, IN_SINK, IN_VNB, IN_WS, IN_BS, IN_QNC, IN_KNC, IN_OUTG, IN_WOUT, IN_WR, IN_WG, IN_WU, IN_WDN };

#define PHASE_IDS(F) const int tid = opaque_tid(), lane = tid & 63, wave = __builtin_amdgcn_readfirstlane(tid >> 6), gw = (int)blockIdx.x * 8 + wave, NGW = (F).G * 8; (void)lane; (void)wave; (void)gw; (void)NGW
constexpr int ARGTAB_OFF = LDSCTL_OFF + 1024;
#define INP(F, i) ld_inp((F).lds, (i))
__device__ __forceinline__ const float* ld_inp(LAS unsigned char* lds, int i) {
    unsigned a = (unsigned)(uintptr_t)(lds + ARGTAB_OFF) + 8u * (unsigned)i;
    asm volatile("" : "+v"(a));
    const volatile LAS unsigned* t = (const volatile LAS unsigned*)(uintptr_t)a;
    const unsigned lo = __builtin_amdgcn_readfirstlane(t[0]), hi = __builtin_amdgcn_readfirstlane(t[1]);
    return (const float*)(const GAS float*)(((unsigned long long)hi << 32) | lo);
}
struct Frame {
    LAS unsigned char* lds; char* ldsg;
    volatile LAS unsigned* MISC;
    unsigned* ctl;
    int G;
    float* out; unsigned char* ws;
};

__host__ __device__ __forceinline__ int headpos(int d) { return 32 * (2 * (d >> 6) + ((d >> 4) & 1)) + 8 * ((d >> 2) & 3) + 4 * ((d >> 5) & 1) + (d & 3); }
template <bool HEADPERM = false>
__device__ __forceinline__ void transpose_item(const float* W, int N, bf16_t* WT, int k0, int n0, int drow0, LAS float* scr, int lane) {
    { float t[32]; const float* wp = W + (size_t)(k0 + (lane >> 5)) * N + n0 + (lane & 31);
#pragma unroll
      for (int i = 0; i < 32; ++i) t[i] = wp[(size_t)(2 * i) * N];
#pragma unroll
      for (int i = 0; i < 32; ++i) scr[(2 * i + (lane >> 5)) * 33 + (lane & 31)] = t[i]; }
    LDS_WAIT(); asm volatile("" ::: "memory");
    const int c = lane & 7;
#pragma unroll
    for (int j = 0; j < 4; ++j) { const int n = (lane >> 3) + 8 * j; const LAS float* s = scr + (8 * c) * 33 + n;
        u32x4 o; o.x = pk2(s[0 * 33], s[1 * 33]); o.y = pk2(s[2 * 33], s[3 * 33]); o.z = pk2(s[4 * 33], s[5 * 33]); o.w = pk2(s[6 * 33], s[7 * 33]);
        const int drow = HEADPERM ? ((drow0 + n) & ~127) + headpos((drow0 + n) & 127) : drow0 + n;
        *(u32x4*)(WT + (size_t)drow * DM + k0 + 8 * c) = o; }
    LDS_WAIT(); asm volatile("" ::: "memory");
}

__device__ __forceinline__ void transpose_item8(const float* W, int N, unsigned char* WT, int k0, int n0, int drow0, LAS float* scr, int lane) {
    { float t[32]; const float* wp = W + (size_t)(k0 + (lane >> 5)) * N + n0 + (lane & 31);
#pragma unroll
      for (int i = 0; i < 32; ++i) t[i] = wp[(size_t)(2 * i) * N];
#pragma unroll
      for (int i = 0; i < 32; ++i) scr[(2 * i + (lane >> 5)) * 33 + (lane & 31)] = t[i]; }
    LDS_WAIT(); asm volatile("" ::: "memory");
    const int c = lane & 7;
#pragma unroll
    for (int j = 0; j < 4; ++j) { const int n = (lane >> 3) + 8 * j; const LAS float* s = scr + (8 * c) * 33 + n;
        u32x2 o; o.x = pk4_fp8(s[0 * 33] * W8_SCALE, s[1 * 33] * W8_SCALE, s[2 * 33] * W8_SCALE, s[3 * 33] * W8_SCALE); o.y = pk4_fp8(s[4 * 33] * W8_SCALE, s[5 * 33] * W8_SCALE, s[6 * 33] * W8_SCALE, s[7 * 33] * W8_SCALE);
        *(u32x2*)(WT + (size_t)(drow0 + n) * DM + k0 + 8 * c) = o; }
    LDS_WAIT(); asm volatile("" ::: "memory");
}
__device__ __forceinline__ void phase_prologue(Frame& F) {
    PHASE_IDS(F);
    static_assert(FP8_L0 && FP8_L1, "the prologue writes the experts' weights as fp8");
    {
        constexpr int NT8 = 2 * NE * 3 * 128;
        struct T8 { const float* src; unsigned char* dst; int which; };
#define P8_DESC(d, tl) do { const int mat = (tl) >> 7, kb = ((tl) & 127) >> 3, nb = (tl) & 7, le = mat / 3, wh = mat % 3; d.which = wh; \
        d.src = INP(F, wh == 0 ? IN_WG : wh == 1 ? IN_WU : IN_WDN) + (size_t)le * DM * DM + (size_t)(128 * kb) * DM + 256 * nb; \
        d.dst = (wh < 2) ? F.ws + WS_WGU + (size_t)(le / NE) * NE * 4096 * DM * 2 + (size_t)(le % NE) * 4096 * DM + (size_t)(2 * nb) * 256 * DM + 128 * kb \
                         : F.ws + WS_WD + (size_t)(le / NE) * NE * DM * DM * 2 + (size_t)(le % NE) * DM * DM + (size_t)(256 * nb) * DM + 128 * kb; } while (0)
#define P8_LOAD(d, t) do { const float* wp = d.src + (size_t)(16 * wave) * DM + 4 * lane; _Pragma("unroll") for (int q = 0; q < 16; ++q) t[q] = *(const f32x4*)(wp + (size_t)q * DM); } while (0)
        T8 cur, nxt; f32x4 t0[16], t1[16];
        int tl = blockIdx.x, par = 0;
        if (tl < NT8) { P8_DESC(cur, tl); P8_LOAD(cur, t0); }
        for (; tl < NT8; tl += F.G, par ^= 1) {
            const bool has = tl + F.G < NT8;
            if (has) { P8_DESC(nxt, tl + F.G); P8_LOAD(nxt, t1); }
            LAS unsigned* img = (LAS unsigned*)(F.lds + par * 32768);
#pragma unroll
            for (int it = 0; it < 4; ++it)
#pragma unroll
                for (int j = 0; j < 4; ++j) { const int n = 4 * lane + j, d = 4 * wave + it;
                    img[n * 32 + (d ^ (lane & 31))] = pk4_fp8(t0[4 * it + 0][j] * W8_SCALE, t0[4 * it + 1][j] * W8_SCALE, t0[4 * it + 2][j] * W8_SCALE, t0[4 * it + 3][j] * W8_SCALE); }
            __syncthreads();
#pragma unroll
            for (int q = 0; q < 4; ++q) { const int ch = tid + 512 * q, n = ch >> 3, g = ch & 7, sw = (n >> 2) & 31;
                u32x4 o; o.x = img[n * 32 + ((4 * g + 0) ^ sw)]; o.y = img[n * 32 + ((4 * g + 1) ^ sw)]; o.z = img[n * 32 + ((4 * g + 2) ^ sw)]; o.w = img[n * 32 + ((4 * g + 3) ^ sw)];
                const int drow = (cur.which < 2) ? (n >> 7) * 256 + cur.which * 128 + (n & 127) : n;
                *(u32x4*)(cur.dst + (size_t)drow * DM + 16 * g) = o; }
            if (has) { cur = nxt;
#pragma unroll
                for (int q = 0; q < 16; ++q) t0[q] = t1[q]; }
        }
#undef P8_DESC
#undef P8_LOAD
        __syncthreads();
    }
    LAS float* scr = (LAS float*)(F.lds + wave * 16384);
    constexpr int I_IN = 32 * (INW / 32), I_SQ = 32 * (DM / 32);
    constexpr int NIT = 2 * I_IN + 2 * I_SQ;
    struct TItem { const float* src; unsigned char* dst; int N, drow0, mode; };
#define P0_DESC(d, itv) do { int r = (itv); \
        if (r < 2 * I_IN) { const int l = r / I_IN; r %= I_IN; const int kb = r / (INW / 32), nb = r % (INW / 32); \
            d.src = INP(F, IN_WIN) + (size_t)l * DM * INW + (size_t)(64 * kb) * INW + 32 * nb; d.dst = F.ws + WS_WIN + (size_t)l * INW * DM * 2 + 128 * kb; d.N = INW; d.drow0 = 32 * nb; d.mode = 1; } \
        else { r -= 2 * I_IN; const int l = r / I_SQ; r %= I_SQ; const int kb = r / 64, nb = r % 64; \
            d.src = INP(F, IN_WOUT) + (size_t)l * DM * DM + (size_t)(64 * kb) * DM + 32 * nb; d.dst = F.ws + WS_WOUT + (size_t)l * DM * DM * 2 + 128 * kb; d.N = DM; d.drow0 = 32 * nb; d.mode = 0; } } while (0)
#define P0_LOAD(d, t) do { const float* wp = d.src + (size_t)(lane >> 3) * d.N + (lane & 7) * 4; _Pragma("unroll") for (int i = 0; i < 8; ++i) t[i] = *(const f32x4*)(wp + (size_t)(8 * i) * d.N); } while (0)
    for (int it = gw; it < NIT; it += NGW) {
        TItem cur; f32x4 t0[8];
        P0_DESC(cur, it); P0_LOAD(cur, t0);
#pragma unroll
        for (int i = 0; i < 8; ++i) { LAS float* sp = scr + (8 * i + (lane >> 3)) * 33 + (lane & 7) * 4; sp[0] = t0[i].x; sp[1] = t0[i].y; sp[2] = t0[i].z; sp[3] = t0[i].w; }
        LDS_WAIT(); asm volatile("" ::: "memory");
        const int c = lane & 7;
#pragma unroll
        for (int j = 0; j < 4; ++j) { const int n = (lane >> 3) + 8 * j; const LAS float* sp = scr + (8 * c) * 33 + n;
            float v[8];
#pragma unroll
            for (int q = 0; q < 8; ++q) v[q] = sp[q * 33];
            int drow = cur.drow0 + n; if (cur.mode == 1) drow = (drow & ~127) + headpos(drow & 127);
            u32x4 o; o.x = pk2(v[0], v[1]); o.y = pk2(v[2], v[3]); o.z = pk2(v[4], v[5]); o.w = pk2(v[6], v[7]); *(u32x4*)(cur.dst + (size_t)drow * DM * 2 + 16 * c) = o; }
        LDS_WAIT(); asm volatile("" ::: "memory");
    }
#undef P0_DESC
#undef P0_LOAD
    __syncthreads();
    {
        LAS float* sil = (LAS float*)F.lds;
        LAS float* red = (LAS float*)(F.lds + 40960);
        bool have = false;
        for (int it = blockIdx.x; it < 2 * 96; it += F.G) {
            if (!have) {
                { const float* cp = INP(F, IN_C); const float* ccp = INP(F, IN_CCTX);
                for (int i = tid; i < 5 * DM; i += 512) { const int s = i / DM, k = i % DM; const float cv = (s < 4) ? cp[s * DM + k] : ccp[k]; sil[i] = cv / (1.f + __expf(-cv)); } }
                have = true; __syncthreads();
            }
            const int l = it / 96, cb = it % 96, c4 = tid & 31, kr = tid >> 5;
            const float* wp = INP(F, IN_WMOD) + (size_t)l * DM * NMOD + (size_t)cb * 128 + c4 * 4;
            f32x4 a[5];
#pragma unroll
            for (int s = 0; s < 5; ++s) a[s] = (f32x4){0.f, 0.f, 0.f, 0.f};
#pragma unroll 8
            for (int k = kr; k < DM; k += 16) { const f32x4 w = *(const f32x4*)(wp + (size_t)k * NMOD);
#pragma unroll
                for (int s = 0; s < 5; ++s) a[s] += w * sil[s * DM + k]; }
#pragma unroll
            for (int s = 0; s < 5; ++s) *(LAS f32x4*)(red + (kr * 5 + s) * 128 + c4 * 4) = a[s];
            __syncthreads();
            const float* bmod = INP(F, IN_BMOD);
            for (int i = tid; i < 5 * 128; i += 512) { const int s = i / 128, cc = i % 128; float sum = 0.f;
#pragma unroll
                for (int q = 0; q < 16; ++q) sum += red[(q * 5 + s) * 128 + cc];
                ((float*)(F.ws + WS_MOD))[(size_t)(l * 5 + s) * NMOD + cb * 128 + cc] = sum + bmod[l * NMOD + cb * 128 + cc]; }
            __syncthreads();
        }
    }
    if ((int)blockIdx.x >= F.G - 9 && (int)blockIdx.x < F.G - 1) {
        const float* wr = INP(F, IN_WR); bf16_t* wf = (bf16_t*)(F.ws + WS_WRS); const int part = (int)blockIdx.x - (F.G - 9);
        for (int i = part * 512 + tid; i < 2 * DM * NE; i += 8 * 512) { const int l = i / (DM * NE), rem = i % (DM * NE), k = rem >> 4, e = rem & 15;
            const float w = wr[i]; const unsigned hi = f2bf(w); const unsigned lo = f2bf(w - __builtin_bit_cast(float, hi << 16));
            const int sidx = k >> 5, q = (k >> 3) & 3, j = k & 7; bf16_t* dst = wf + ((size_t)(l * 64 + sidx) * 2 * 64 + (q * 16 + e)) * 8 + j;
            dst[0] = (bf16_t)hi; dst[64 * 8] = (bf16_t)lo; }
    }
    if (blockIdx.x == F.G - 1) {
        for (int i = tid; i < 64 * 32; i += 512) {
            const int pos = i >> 5, f = i & 31;
            double inv = 1.0; for (int q = 0; q < f; ++q) inv *= 0.7498942093324559;
            const double a = (double)pos * inv;
            const double n = __builtin_rint(a * 0.6366197723675814);
            const double r = (a - n * 1.5707963267948966) - n * 6.123233995736766e-17;
            const double r2 = r * r;
            double sn = r * (1.0 + r2 * (-1.0 / 6 + r2 * (1.0 / 120 + r2 * (-1.0 / 5040 + r2 * (1.0 / 362880 + r2 * (-1.0 / 39916800 + r2 * (1.0 / 6227020800.0)))))));
            double cn = 1.0 + r2 * (-0.5 + r2 * (1.0 / 24 + r2 * (-1.0 / 720 + r2 * (1.0 / 40320 + r2 * (-1.0 / 3628800 + r2 * (1.0 / 479001600 + r2 * (-1.0 / 87178291200.0)))))));
            const int q = ((int)n) & 3; double cs, ss;
            if (q == 0) { cs = cn; ss = sn; } else if (q == 1) { cs = -sn; ss = cn; } else if (q == 2) { cs = -cn; ss = -sn; } else { cs = sn; ss = -cn; }
            ((float*)(F.ws + WS_ROPE))[2 * i] = (float)cs; ((float*)(F.ws + WS_ROPE))[2 * i + 1] = (float)ss;
        }
    }
}

__device__ __forceinline__ void load_row(const float* row, int lane, f32x4 (&v)[8]) {
#pragma unroll
    for (int j = 0; j < 8; ++j) v[j] = *(const f32x4*)(row + 4 * lane + 256 * j);
}
__device__ __forceinline__ void norm_mod_store(const f32x4 (&v)[8], const float* g, const float* shift, const float* scale, bf16_t* dst, int lane) {
    float ss = 0.f;
#pragma unroll
    for (int j = 0; j < 8; ++j) ss += (v[j].x * v[j].x + v[j].y * v[j].y) + (v[j].z * v[j].z + v[j].w * v[j].w);
    const float rinv = rsqrt_fast(wave_sum(ss) * (1.f / DM) + EPS);
#pragma unroll
    for (int j = 0; j < 8; ++j) { const int c = 4 * lane + 256 * j;
        const f32x4 gg = *(const f32x4*)(g + c), sh = *(const f32x4*)(shift + c), sc = *(const f32x4*)(scale + c);
        const f32x4 y = (v[j] * rinv) * gg * (sc + 1.f) + sh;
        u32x2 w; w.x = pk2(y.x, y.y); w.y = pk2(y.z, y.w); *(u32x2*)(dst + c) = w; }
}

__device__ __forceinline__ void phase_rowpass1_l0(Frame& F) {
    PHASE_IDS(F);
    const float* mod = (const float*)(F.ws + WS_MOD);
    { const float* n2 = INP(F, IN_N2G); float* gs = (float*)(F.ws + WS_GS2);
      for (int i = (int)blockIdx.x * 512 + tid; i < 2 * 5 * DM; i += F.G * 512) { const int l = i / (5 * DM), sv = (i / DM) % 5, k = i % DM;
          const float* m = mod + (size_t)(l * 5 + sv) * NMOD; gs[2 * i] = n2[l * DM + k] * (1.f + m[4 * DM + k]); gs[2 * i + 1] = m[3 * DM + k]; } }
    for (int r = gw; r < NTOK; r += NGW) {
        const int b = r / TPB, t = r % TPB, s = (t < CTXL) ? 4 : b;
        const float* src = (t < CTXL) ? INP(F, IN_CTX) + ((size_t)b * CTXL + t) * DM : INP(F, IN_X) + ((size_t)b * SEQ + (t - CTXL)) * DM;
        f32x4 v[8]; load_row(src, lane, v);
        norm_mod_store(v, INP(F, IN_N1G), mod + (size_t)s * NMOD, mod + (size_t)s * NMOD + DM, (bf16_t*)(F.ws + WS_HN) + (size_t)r * DM, lane);
    }
}

__device__ __forceinline__ void post_unpack(const u32x4 x, float (&v)[8]) {
    v[0] = bflo(x.x); v[1] = bfhi(x.x); v[2] = bflo(x.y); v[3] = bfhi(x.y); v[4] = bflo(x.z); v[5] = bfhi(x.z); v[6] = bflo(x.w); v[7] = bfhi(x.w); }
__device__ __forceinline__ float sum16(float v) { return row16_sum(v); }
__device__ __forceinline__ void phase_post(Frame& F, int l) {
    PHASE_IDS(F);
    bf16_t* P = (bf16_t*)(F.ws + WS_P);
    const float* rope = (const float*)(F.ws + WS_ROPE);
    const int i16 = lane & 15, hq = lane >> 4; const bool hi2 = hq >= 2;
    const float* qna = INP(F, IN_QNA) + l * 128 + 8 * i16; const float* kna = INP(F, IN_KNA) + l * 128 + 8 * i16;
    const float* qnc = INP(F, IN_QNC) + l * 128 + 8 * i16; const float* knc = INP(F, IN_KNC) + l * 128 + 8 * i16;
    const float* vnb = INP(F, IN_VNB) + l * 512 + 8 * i16;
    for (int r = gw; r < NTOK; r += NGW) {
        const int t = r % TPB; const bool lat = t >= CTXL;
        u32x4* rp = (u32x4*)(P + (size_t)r * INW) + lane;
        u32x4 x[7];
#pragma unroll
        for (int j = 0; j < 7; ++j) x[j] = rp[64 * j];
        const int pos = lat ? t - CTXL : 0, pp = (i16 < 8) ? (pos >> 6) : (pos & 63);
        const f32x4* cs = (const f32x4*)(rope + 2 * (pp * 32 + 8 * (i16 & 3)));
        const f32x4 c0 = cs[0], c1 = cs[1], c2 = cs[2], c3 = cs[3];
        const float cosv[8] = {c0.x, c0.z, c1.x, c1.z, c2.x, c2.z, c3.x, c3.z}, sinv[8] = {c0.y, c0.w, c1.y, c1.w, c2.y, c2.w, c3.y, c3.w};
        const float sgn = (i16 & 4) ? 1.f : -1.f;
#pragma unroll
        for (int j = 0; j < 7; ++j) {
            const bool gelu_lo = (j == 3 || j == 4), gelu_hi = (j == 2 || j == 3);
            const bool norm_lo = (j != 2 && j != 3), norm_hi = (j != 2 && j != 6);
            const bool rope_lo = (j == 0 || j == 1 || j == 5 || j == 6), rope_hi = (j == 0 || j == 1 || j == 4 || j == 5);
            const bool dg = hi2 ? gelu_hi : gelu_lo, dn = hi2 ? norm_hi : norm_lo, dr = (hi2 ? rope_hi : rope_lo) && lat;
            if (!(gelu_lo || gelu_hi || norm_lo || norm_hi)) continue;
            float v[8]; post_unpack(x[j], v);
            if (gelu_lo || gelu_hi) {
#pragma unroll
                for (int e = 0; e < 8; ++e) { const float gv = gelu_tanh(v[e]); v[e] = dg ? gv : v[e]; } }
            if (norm_lo || norm_hi) {
                float ss = 0.f;
#pragma unroll
                for (int e = 0; e < 8; ++e) ss += v[e] * v[e];
                const float rinv = rsqrt_fast(sum16(ss) * (1.f / 128) + EPS);
                const float* gp;
                if (j == 0) gp = qna; else if (j == 1) gp = hi2 ? kna : qna; else if (j == 3) gp = vnb + (hi2 ? hq - 2 : 0) * 128; else if (j == 4) gp = hi2 ? qnc : vnb + (2 + hq) * 128;
                else if (j == 5) gp = qnc; else gp = knc;
                const f32x4 g0 = *(const f32x4*)gp, g1 = *(const f32x4*)(gp + 4);
                const float gg[8] = {g0.x, g0.y, g0.z, g0.w, g1.x, g1.y, g1.z, g1.w};
#pragma unroll
                for (int e = 0; e < 8; ++e) v[e] = dn ? v[e] * rinv * gg[e] : v[e];
            }
            if (rope_lo || rope_hi) {
#pragma unroll
                for (int e = 0; e < 8; ++e) { const float o = __builtin_bit_cast(float, __builtin_amdgcn_ds_swizzle(__builtin_bit_cast(int, v[e]), 0x101F)); const float rv = v[e] * cosv[e] + sgn * o * sinv[e]; v[e] = dr ? rv : v[e]; } }
            u32x4 w; w.x = pk2(v[0], v[1]); w.y = pk2(v[2], v[3]); w.z = pk2(v[4], v[5]); w.w = pk2(v[6], v[7]);
            rp[64 * j] = w;
        }
    }
}

__device__ __forceinline__ void mixer_b_unit(Frame& F, int l, int b, int ch, int g) {
    PHASE_IDS(F);
    const bf16_t* P = (const bf16_t*)(F.ws + WS_P); bf16_t* O = (bf16_t*)(F.ws + WS_O);
    const int row0 = b * TPB + ch * 128, w = wave;
    LAS bf16_t* VT = (LAS bf16_t*)F.lds;
    { const int q = tid >> 2, dp = (tid & 3) * 32; const bf16_t* src = P + (size_t)(row0 + q) * INW + C_VB + g * 128 + dp;
#pragma unroll
      for (int i = 0; i < 4; ++i) { const u32x4 x = *(const u32x4*)(src + 8 * i); const unsigned xs[4] = {x.x, x.y, x.z, x.w};
#pragma unroll
          for (int j = 0; j < 4; ++j) { VT[(dp + 8 * i + 2 * j) * 136 + q] = (bf16_t)(xs[j] & 0xffffu); VT[(dp + 8 * i + 2 * j + 1) * 136 + q] = (bf16_t)(xs[j] >> 16); } } }
    __syncthreads();
    const int i15 = lane & 15, kq = lane >> 4;
    f32x4 acc[8];
#pragma unroll
    for (int n = 0; n < 8; ++n) acc[n] = (f32x4){0.f, 0.f, 0.f, 0.f};
    const float* wsr = INP(F, IN_WS) + ((size_t)(l * 4 + g) * 128 + 16 * w + i15) * 128;
#pragma unroll
    for (int s = 0; s < 4; ++s) {
        const f32x4 a0 = *(const f32x4*)(wsr + 32 * s + 8 * kq), a1 = *(const f32x4*)(wsr + 32 * s + 8 * kq + 4);
        u32x4 aw; aw.x = pk2(a0.x, a0.y); aw.y = pk2(a0.z, a0.w); aw.z = pk2(a1.x, a1.y); aw.w = pk2(a1.z, a1.w);
        const bf16x8 af = *reinterpret_cast<bf16x8*>(&aw);
#pragma unroll
        for (int n = 0; n < 8; ++n) { const bf16x8 bfr = *(const LAS bf16x8*)(VT + (16 * n + i15) * 136 + 32 * s + 8 * kq);
            acc[n] = __builtin_amdgcn_mfma_f32_16x16x32_bf16(af, bfr, acc[n], 0, 0, 0); }
    }
#pragma unroll
    for (int j = 0; j < 4; ++j) { const int p = 16 * w + kq * 4 + j; const float bias = INP(F, IN_BS)[(l * 4 + g) * 128 + p];
        const bf16_t* up = P + (size_t)(row0 + p) * INW + C_UB + g * 128; bf16_t* op = O + (size_t)(row0 + p) * DM + O_B + g * 128;
#pragma unroll
        for (int n = 0; n < 8; ++n) { const int d = 16 * n + i15; op[d] = (bf16_t)f2bf(bf2f(up[d]) * (acc[n][j] + bias)); } }
    __syncthreads();
}
__device__ __forceinline__ void phase_mixers(Frame& F, int l) {
    PHASE_IDS(F);
    const bf16_t* P = (const bf16_t*)(F.ws + WS_P); bf16_t* O = (bf16_t*)(F.ws + WS_O);
    const bool ctx = (l == 0);
    const int nC = 48, nA = 48, nCc = ctx ? 3 : 0, nAc = ctx ? 3 : 0, nB = 68;
    const int total = nC + nA + nCc + nAc + nB;
    for (int kq = 0; kq < 8; ++kq) {
        const int x = ((int)blockIdx.x + kq) & 7, b = x >> 1, kv = x & 1;
        unsigned* qctr = F.ctl + CW_QUEUE + 64 * (l * 8 + x);
        for (;;) {
            if (tid == 0) F.MISC[0] = xb_add(qctr, 1u);
            __syncthreads();
            int u = (int)F.MISC[0];
            __syncthreads();
            if (u >= total) break;
            if (u < nC + nA + nCc + nAc) {
                int kind, h, qb = 0;
                if (u < nC) { kind = 0; h = kv * 3 + u / 16; qb = u % 16; }
                else if (u < nC + nA) { const int v = u - nC; kind = 1; h = kv * 3 + v / 16; qb = v % 16; }
                else if (u < nC + nA + nCc) { kind = 2; h = kv * 3 + (u - nC - nA); }
                else { kind = 3; h = kv * 3 + (u - nC - nA - nCc); }
                const int isA = kind & 1, lat = (kind < 2);
                const size_t r0 = (size_t)b * TPB, rq = r0 + (lat ? CTXL + qb * 256 : 0);
                const int q0 = qb * 256, ks = (kind == 1) ? ((q0 - 128 < 0) ? 0 : q0 - 128) : 0, ke = (q0 + 384 > SEQ) ? SEQ : q0 + 384;
                const int NT = (kind == 0) ? 68 : (kind == 1) ? 4 + (ke - ks) / 64 : 4;
                const float sink = INP(F, IN_SINK)[l * 6 + h];
                const int cq = (isA ? C_QA : C_QC) + h * 128, ck = (isA ? C_KA : C_KC) + kv * 128, cv = (isA ? C_VA : C_VC) + kv * 128, co = (isA ? O_A : O_C) + h * 128;
                at::attn_body(P + rq * INW + cq, P + r0 * INW + ck, P + r0 * INW + cv, O + rq * DM + co, NT, ks, q0, isA ? sink / at::SCALE : -1e30f, isA ? 1.f : 0.f, kind == 1, F.ldsg);
                continue; }
            u -= nC + nA + nCc + nAc;
            { const int ch = u >> 1, g = kv * 2 + (u & 1);
              if (!ctx && ch < 2) continue;
              mixer_b_unit(F, l, b, ch, g); }
        }
    }
}

__device__ __forceinline__ void phase_groupnorm(Frame& F, int l) {
    PHASE_IDS(F);
    bf16_t* O = (bf16_t*)(F.ws + WS_O); const float* og = INP(F, IN_OUTG) + l * DM;
    for (int r = gw; r < NTOK; r += NGW) {
        if (l == 1 && (r % TPB) < CTXL) continue;
        bf16_t* row = O + (size_t)r * DM;
        u32x2 x[8];
#pragma unroll
        for (int i = 0; i < 3; ++i) { x[i] = *(const u32x2*)(row + O_A + 12 * lane + 4 * i); x[5 + i] = *(const u32x2*)(row + O_C + 12 * lane + 4 * i); }
#pragma unroll
        for (int i = 0; i < 2; ++i) x[3 + i] = *(const u32x2*)(row + O_B + 8 * lane + 4 * i);
        float v[8][4]; float ss[3] = {0.f, 0.f, 0.f};
#pragma unroll
        for (int i = 0; i < 8; ++i) { v[i][0] = bflo(x[i].x); v[i][1] = bfhi(x[i].x); v[i][2] = bflo(x[i].y); v[i][3] = bfhi(x[i].y);
            const int grp = (i < 3) ? 0 : (i < 5) ? 1 : 2; ss[grp] += (v[i][0] * v[i][0] + v[i][1] * v[i][1]) + (v[i][2] * v[i][2] + v[i][3] * v[i][3]); }
        float rinv[3];
        rinv[0] = rsqrt_fast(wave_sum(ss[0]) * (1.f / 768) + EPS); rinv[1] = rsqrt_fast(wave_sum(ss[1]) * (1.f / 512) + EPS); rinv[2] = rsqrt_fast(wave_sum(ss[2]) * (1.f / 768) + EPS);
#pragma unroll
        for (int i = 0; i < 8; ++i) { const int grp = (i < 3) ? 0 : (i < 5) ? 1 : 2;
            const int c = (grp == 0) ? O_A + 12 * lane + 4 * i : (grp == 1) ? O_B + 8 * lane + 4 * (i - 3) : O_C + 12 * lane + 4 * (i - 5);
            const f32x4 gg = *(const f32x4*)(og + c); const float ri = rinv[grp];
            u32x2 w; w.x = pk2(v[i][0] * ri * gg.x, v[i][1] * ri * gg.y); w.y = pk2(v[i][2] * ri * gg.z, v[i][3] * ri * gg.w); *(u32x2*)(row + c) = w; }
    }
}

__device__ __forceinline__ float row16_max(float v) {
    v = fmaxf(v, __builtin_bit_cast(float, __builtin_amdgcn_update_dpp(0, __builtin_bit_cast(int, v), 0xB1, 0xF, 0xF, true)));
    v = fmaxf(v, __builtin_bit_cast(float, __builtin_amdgcn_update_dpp(0, __builtin_bit_cast(int, v), 0x4E, 0xF, 0xF, true)));
    v = fmaxf(v, __builtin_bit_cast(float, __builtin_amdgcn_update_dpp(0, __builtin_bit_cast(int, v), 0x141, 0xF, 0xF, true)));
    v = fmaxf(v, __builtin_bit_cast(float, __builtin_amdgcn_update_dpp(0, __builtin_bit_cast(int, v), 0x140, 0xF, 0xF, true)));
    return v;
}
__device__ __forceinline__ void phase_rowpass2(Frame& F, int l) {
    PHASE_IDS(F);
    const float* xb = (const float*)(F.ws + WS_XB); const float* parts = (const float*)(F.ws + WS_PART);
    const bool f8 = (l == 0) ? (FP8_L0 != 0) : (FP8_L1 != 0);
    { const u32x4* wf = (const u32x4*)((const bf16_t*)(F.ws + WS_WRS) + (size_t)l * 64 * 2 * 64 * 8) + tid; u32x4 t[16];
#pragma unroll
      for (int i = 0; i < 16; ++i) t[i] = wf[512 * i];
#pragma unroll
      for (int i = 0; i < 16; ++i) ((LAS u32x4*)F.lds)[tid + 512 * i] = t[i]; }
    LAS f32x4* red = (LAS f32x4*)(F.lds + LDSCTL_OFF + 2048);
    __syncthreads();
    const int i16 = lane & 15, q = lane >> 4;
    for (int tile = blockIdx.x; tile < NTOK / 16; tile += F.G) {
        const int r0 = tile * 16, b = r0 / TPB, t0 = r0 % TPB, sv = (t0 < CTXL) ? 4 : b;
        if (l == 1 && t0 < CTXL) continue;
        const int row = r0 + i16;
        const float* xr = xb + (size_t)row * DM + 256 * wave + 8 * q;
        f32x4 x[8][2];
#pragma unroll
        for (int sidx = 0; sidx < 8; ++sidx) { x[sidx][0] = *(const f32x4*)(xr + 32 * sidx); x[sidx][1] = *(const f32x4*)(xr + 32 * sidx + 4); }
        const f32x4 p0 = *(const f32x4*)(parts + (size_t)row * 32 + 8 * q), p1 = *(const f32x4*)(parts + (size_t)row * 32 + 8 * q + 4);
        float ss = ((p0.x + p0.y) + (p0.z + p0.w)) + ((p1.x + p1.y) + (p1.z + p1.w));
        ss += __builtin_bit_cast(float, __builtin_amdgcn_ds_swizzle(__builtin_bit_cast(int, ss), 0x401F));
        { auto rr = __builtin_amdgcn_permlane32_swap(__float_as_uint(ss), __float_as_uint(ss), false, false); ss = __uint_as_float(rr[0]) + __uint_as_float(rr[1]); }
        const float rinv = rsqrt_fast(ss * (1.f / DM) + EPS);
        const float* gs = (const float*)(F.ws + WS_GS2) + ((size_t)(l * 5 + sv) * DM + 256 * wave + 8 * q) * 2;
        f32x4 acc = (f32x4){0.f, 0.f, 0.f, 0.f};
#pragma unroll
        for (int sidx = 0; sidx < 8; ++sidx) {
            const f32x4 g0 = *(const f32x4*)(gs + 64 * sidx), g1 = *(const f32x4*)(gs + 64 * sidx + 4), g2 = *(const f32x4*)(gs + 64 * sidx + 8), g3 = *(const f32x4*)(gs + 64 * sidx + 12);
            float h[8];
            h[0] = x[sidx][0].x * rinv * g0.x + g0.y; h[1] = x[sidx][0].y * rinv * g0.z + g0.w; h[2] = x[sidx][0].z * rinv * g1.x + g1.y; h[3] = x[sidx][0].w * rinv * g1.z + g1.w;
            h[4] = x[sidx][1].x * rinv * g2.x + g2.y; h[5] = x[sidx][1].y * rinv * g2.z + g2.w; h[6] = x[sidx][1].z * rinv * g3.x + g3.y; h[7] = x[sidx][1].w * rinv * g3.z + g3.w;
            const int col = 256 * wave + 32 * sidx + 8 * q;
            if (f8) { u32x2 w8; w8.x = pk4_fp8(h[0], h[1], h[2], h[3]); w8.y = pk4_fp8(h[4], h[5], h[6], h[7]); *(u32x2*)((unsigned char*)(F.ws + WS_HN8) + (size_t)row * DM + col) = w8; }
            else { u32x4 w16; w16.x = pk2(h[0], h[1]); w16.y = pk2(h[2], h[3]); w16.z = pk2(h[4], h[5]); w16.w = pk2(h[6], h[7]); *(u32x4*)((bf16_t*)(F.ws + WS_HN) + (size_t)row * DM + col) = w16; }
            unsigned hh[8], hl[8];
#pragma unroll
            for (int j = 0; j < 8; ++j) { hh[j] = f2bf(h[j]); hl[j] = f2bf(h[j] - __builtin_bit_cast(float, hh[j] << 16)); }
            u32x4 ah, al; ah.x = hh[0] | (hh[1] << 16); ah.y = hh[2] | (hh[3] << 16); ah.z = hh[4] | (hh[5] << 16); ah.w = hh[6] | (hh[7] << 16);
            al.x = hl[0] | (hl[1] << 16); al.y = hl[2] | (hl[3] << 16); al.z = hl[4] | (hl[5] << 16); al.w = hl[6] | (hl[7] << 16);
            const LAS unsigned char* bp = F.lds + (size_t)((wave * 8 + sidx) * 2) * 1024 + lane * 16;
            const bf16x8 bh = *(const LAS bf16x8*)bp, bl = *(const LAS bf16x8*)(bp + 1024);
            const bf16x8 fah = __builtin_bit_cast(bf16x8, ah), fal = __builtin_bit_cast(bf16x8, al);
            acc = __builtin_amdgcn_mfma_f32_16x16x32_bf16(fah, bh, acc, 0, 0, 0);
            acc = __builtin_amdgcn_mfma_f32_16x16x32_bf16(fah, bl, acc, 0, 0, 0);
            acc = __builtin_amdgcn_mfma_f32_16x16x32_bf16(fal, bh, acc, 0, 0, 0);
        }
        red[wave * 64 + lane] = acc;
        __syncthreads();
        if (wave == 0) {
            f32x4 lg = red[lane];
#pragma unroll
            for (int w = 1; w < 8; ++w) lg += red[w * 64 + lane];
#pragma unroll
            for (int reg = 0; reg < 4; ++reg) { const float mx = row16_max(lg[reg]); const float ex = __expf(lg[reg] - mx); const float a = ex / row16_sum(ex);
                const int t = t0 + 4 * q + reg;
                if (t < CTXL) ((float*)(F.ws + WS_AFFC))[((size_t)b * NE + i16) * CTXL + t] = a;
                else ((float*)(F.ws + WS_AFFL))[((size_t)b * NE + i16) * SEQ + (t - CTXL)] = a; }
        }
        __syncthreads();
    }
    __syncthreads();
}

__device__ __forceinline__ unsigned block_excl_scan(unsigned v, LAS unsigned* scr, int lane, int wave, unsigned& total) {
    unsigned inc = v;
#pragma unroll
    for (int o = 1; o < 64; o <<= 1) { const unsigned t = __shfl_up(inc, o); if (lane >= o) inc += t; }
    if (lane == 63) scr[wave] = inc;
    __syncthreads();
    unsigned base = 0, tot = 0;
#pragma unroll
    for (int w = 0; w < 8; ++w) { const unsigned x = scr[w]; base += (w < wave) ? x : 0u; tot += x; }
    __syncthreads();
    total = tot;
    return base + inc - v;
}
__device__ __forceinline__ void phase_topk(Frame& F, int l) {
    PHASE_IDS(F);
    LAS unsigned* hist = (LAS unsigned*)F.lds;
    LAS unsigned* scr = (LAS unsigned*)(F.lds + 8192);
    LAS int* rowsrc = (LAS int*)(F.lds + 8192 + 128);
    const int nunits = (l == 0) ? 128 : 64;
    const bool f8 = (l == 0) ? (FP8_L0 != 0) : (FP8_L1 != 0); const int RBg = f8 ? DM : 2 * DM;
    for (int u = blockIdx.x; u < nunits; u += F.G) {
        const bool isc = u >= 64; const int uu = isc ? u - 64 : u, b = uu / NE, e = uu % NE;
        const int N = isc ? CTXL : SEQ; const unsigned cap = isc ? CAP_C : CAP_L;
        const float* src = isc ? (const float*)(F.ws + WS_AFFC) + (size_t)uu * CTXL : (const float*)(F.ws + WS_AFFL) + (size_t)uu * SEQ;
        int* pos = isc ? (int*)(F.ws + WS_POSC) + (size_t)uu * CTXL : (int*)(F.ws + WS_POSL) + (size_t)uu * SEQ;
        const bool own = tid * 8 < N;
        unsigned key[8];
        { u32x4 k0 = (u32x4){0u, 0u, 0u, 0u}, k1 = k0; if (own) { k0 = *(const u32x4*)(src + tid * 8); k1 = *(const u32x4*)(src + tid * 8 + 4); }
          key[0] = k0.x; key[1] = k0.y; key[2] = k0.z; key[3] = k0.w; key[4] = k1.x; key[5] = k1.y; key[6] = k1.z; key[7] = k1.w; }
        unsigned prefix = 0u, remaining = cap;
#pragma unroll
        for (int p = 0; p < 3; ++p) {
            const int shift = (p == 0) ? 21 : (p == 1) ? 10 : 0, bits = (p == 2) ? 10 : 11, nb = 1 << bits;
            for (int i = tid; i < nb; i += 512) hist[i] = 0u;
            __syncthreads();
            if (own) {
#pragma unroll
                for (int q = 0; q < 8; ++q) { const bool cand = (p == 0) ? true : ((key[q] >> (shift + bits)) == prefix);
                    if (cand) (void)__hip_atomic_fetch_add(&hist[(key[q] >> shift) & (nb - 1)], 1u, __ATOMIC_RELAXED, __HIP_MEMORY_SCOPE_WORKGROUP); } }
            __syncthreads();
            unsigned c[4];
#pragma unroll
            for (int q = 0; q < 4; ++q) c[q] = (4 * tid + q < nb) ? hist[4 * tid + q] : 0u;
            const unsigned sm = (c[0] + c[1]) + (c[2] + c[3]);
            unsigned total; const unsigned ex = block_excl_scan(sm, scr, lane, wave, total);
            unsigned above = total - (ex + sm);
#pragma unroll
            for (int q = 3; q >= 0; --q) { if (above < remaining && remaining <= above + c[q]) { scr[16] = (unsigned)(4 * tid + q); scr[17] = above; } above += c[q]; }
            __syncthreads();
            const unsigned B = scr[16], ca = scr[17];
            remaining -= ca; prefix = (prefix << bits) | B;
            __syncthreads();
        }
        const unsigned T = prefix;
        unsigned ce = 0u;
#pragma unroll
        for (int q = 0; q < 8; ++q) ce += (own && key[q] == T) ? 1u : 0u;
        unsigned tot; unsigned er = block_excl_scan(ce, scr, lane, wave, tot);
        bool sel[8]; unsigned cs = 0u;
#pragma unroll
        for (int q = 0; q < 8; ++q) { const bool eq = own && key[q] == T; sel[q] = own && (key[q] > T || (eq && er < remaining)); er += eq ? 1u : 0u; cs += sel[q] ? 1u : 0u; }
        unsigned sl = block_excl_scan(cs, scr, lane, wave, tot);
        const int slotbase = e * ROWS_E + (isc ? 2048 + b * CAP_C : b * CAP_L);
        int pv[8];
#pragma unroll
        for (int q = 0; q < 8; ++q) { pv[q] = sel[q] ? (int)sl : -1;
            if (sel[q]) { rowsrc[sl] = b * TPB + (isc ? 0 : CTXL) + tid * 8 + q; ((float*)(F.ws + WS_GATE))[slotbase + sl] = __uint_as_float(key[q]); ++sl; } }
        if (own) { *(i32x4*)(pos + tid * 8) = (i32x4){pv[0], pv[1], pv[2], pv[3]}; *(i32x4*)(pos + tid * 8 + 4) = (i32x4){pv[4], pv[5], pv[6], pv[7]}; }
        __syncthreads();
        unsigned* offs = (unsigned*)(F.ws + WS_OFFS);
        int R[2], C[2];
#pragma unroll
        for (int i = 0; i < 2; ++i) pg8::stage_rc(tid * 16 + i * 8192, R[i], C[i]);
        if (!isc) {
#pragma unroll
            for (int th = 0; th < 2; ++th) { u32x4 o;
                o.x = (unsigned)rowsrc[th * 256 + R[0]] * RBg + 2 * C[0]; o.y = (unsigned)rowsrc[th * 256 + R[1]] * RBg + 2 * C[1];
                o.z = (unsigned)rowsrc[th * 256 + 128 + R[0]] * RBg + 2 * C[0]; o.w = (unsigned)rowsrc[th * 256 + 128 + R[1]] * RBg + 2 * C[1];
                *(u32x4*)(offs + ((size_t)(e * 9 + 2 * b + th) * 512 + tid) * 4) = o; }
        } else {
            unsigned* o = offs + ((size_t)(e * 9 + 8) * 512 + tid) * 4;
#pragma unroll
            for (int i = 0; i < 2; ++i) { if (R[i] >= 32 * b && R[i] < 32 * b + 32) o[i] = (unsigned)rowsrc[R[i] - 32 * b] * RBg + 2 * C[i]; if (b == 0) o[2 + i] = 2 * C[i]; }
        }
        __syncthreads();
    }
}

__device__ __forceinline__ void phase_combine(Frame& F, int l) {
    PHASE_IDS(F);
    const float* mod = (const float*)(F.ws + WS_MOD);
    float* xb = (float*)(F.ws + WS_XB); const bf16_t* Y = (const bf16_t*)(F.ws + WS_XG);
    for (int r = gw; r < NTOK; r += NGW) {
        const int b = r / TPB, t = r % TPB, s = (t < CTXL) ? 4 : b;
        if (l == 1 && t < CTXL) continue;
        int p = -1;
        if (lane < NE) p = (t < CTXL) ? ((const int*)(F.ws + WS_POSC))[((size_t)b * NE + lane) * CTXL + t] : ((const int*)(F.ws + WS_POSL))[((size_t)b * NE + lane) * SEQ + (t - CTXL)];
        float gt = 0.f;
        if (p >= 0) gt = ((const float*)(F.ws + WS_GATE))[lane * ROWS_E + ((t < CTXL) ? 2048 + b * CAP_C : b * CAP_L) + p];
        f32x4 v[8]; load_row(xb + (size_t)r * DM, lane, v);
        const float* g2 = mod + (size_t)(l * 5 + s) * NMOD + 5 * DM;
        f32x4 gv[8];
#pragma unroll
        for (int j = 0; j < 8; ++j) gv[j] = *(const f32x4*)(g2 + 4 * lane + 256 * j);
        f32x4 a[8];
#pragma unroll
        for (int j = 0; j < 8; ++j) a[j] = (f32x4){0.f, 0.f, 0.f, 0.f};
        unsigned long long m = __ballot(p >= 0);
        const int ybase = (t < CTXL) ? 2048 + b * CAP_C : b * CAP_L;
        while (m) {
            const int e0 = __builtin_ctzll(m); m &= m - 1;
            const bool two = (m != 0ull); const int e1 = two ? __builtin_ctzll(m) : e0; if (two) m &= m - 1;
            const int p0 = __builtin_amdgcn_readlane(p, e0), p1 = __builtin_amdgcn_readlane(p, e1);
            const float q0 = __builtin_bit_cast(float, __builtin_amdgcn_readlane(__builtin_bit_cast(int, gt), e0)), q1 = __builtin_bit_cast(float, __builtin_amdgcn_readlane(__builtin_bit_cast(int, gt), e1));
            const bf16_t* y0 = Y + (size_t)(e0 * ROWS_E + ybase + p0) * DM + 4 * lane; const bf16_t* y1 = Y + (size_t)(e1 * ROWS_E + ybase + p1) * DM + 4 * lane;
            u32x2 w0[8], w1[8];
#pragma unroll
            for (int j = 0; j < 8; ++j) w0[j] = *(const u32x2*)(y0 + 256 * j);
            if (two) {
#pragma unroll
                for (int j = 0; j < 8; ++j) w1[j] = *(const u32x2*)(y1 + 256 * j); }
#pragma unroll
            for (int j = 0; j < 8; ++j) a[j] += (f32x4){bflo(w0[j].x), bfhi(w0[j].x), bflo(w0[j].y), bfhi(w0[j].y)} * q0;
            if (two) {
#pragma unroll
                for (int j = 0; j < 8; ++j) a[j] += (f32x4){bflo(w1[j].x), bfhi(w1[j].x), bflo(w1[j].y), bfhi(w1[j].y)} * q1; }
        }
#pragma unroll
        for (int j = 0; j < 8; ++j) v[j] += gv[j] * a[j];
        if (l == 0) {
#pragma unroll
            for (int j = 0; j < 8; ++j) *(f32x4*)(xb + (size_t)r * DM + 4 * lane + 256 * j) = v[j];
            const float* m1 = mod + (size_t)(5 + s) * NMOD;
            norm_mod_store(v, INP(F, IN_N1G) + DM, m1, m1 + DM, (bf16_t*)(F.ws + WS_HN) + (size_t)r * DM, lane);
        } else {
            float* op = F.out + ((size_t)b * SEQ + (t - CTXL)) * DM;
#pragma unroll
            for (int j = 0; j < 8; ++j) *(f32x4*)(op + 4 * lane + 256 * j) = v[j];
        }
    }
}

__device__ __forceinline__ void phase_dump_x(Frame& F, bool from_input) {
    PHASE_IDS(F);
    const float* xb = (const float*)(F.ws + WS_XB);
    for (int r = gw; r < NTOK; r += NGW) {
        const int b = r / TPB, t = r % TPB; if (t < CTXL) continue;
        const float* src = from_input ? INP(F, IN_X) + ((size_t)b * SEQ + (t - CTXL)) * DM : xb + (size_t)r * DM;
        f32x4 v[8]; load_row(src, lane, v);
        float* op = F.out + ((size_t)b * SEQ + (t - CTXL)) * DM;
#pragma unroll
        for (int j = 0; j < 8; ++j) *(f32x4*)(op + 4 * lane + 256 * j) = v[j];
    }
}

constexpr int N_PHASES = 2 + 11 * NLAYER;
__global__ void __launch_bounds__(512, 2) fwd_kernel(Args args) {
    extern __shared__ __attribute__((aligned(16))) unsigned char lds[];
    Frame F;
    F.lds = (LAS unsigned char*)lds; F.ldsg = (char*)lds;
    F.MISC = (volatile LAS unsigned*)(F.lds + MISC_OFF);
    F.G = gridDim.x;
    F.out = args.out; F.ws = args.ws; F.ctl = (unsigned*)(args.ws + WS_CTL);
    for (int u = threadIdx.x; u < (LDS_BYTES - LDSCTL_OFF) / 4; u += 512) ((LAS unsigned*)(F.lds + LDSCTL_OFF))[u] = 0u;
    __syncthreads();
    if (threadIdx.x < 23) { const unsigned long long pv = (unsigned long long)args.in[threadIdx.x]; LAS unsigned* t = (LAS unsigned*)(F.lds + ARGTAB_OFF) + 2 * threadIdx.x; t[0] = (unsigned)pv; t[1] = (unsigned)(pv >> 32); }
    __syncthreads();
    XcdBarrier bar; bar.bar = F.ctl + CW_BAR; bar.x = 0; bar.st = nullptr;
    if (!MK_PER_PHASE) bar = xcd_barrier_post(F.ctl + CW_BAR, F.MISC + 8);
    const int lo = args.ph_lo, hi = args.ph_hi;
#define IN(k) (lo <= (k) && (k) < hi)
    unsigned long long probe_t0 = 0ull, probe_acc = 0ull;
#define PROBE_BEGIN(k) do { if (PROBE_MASK & (1u << (k))) probe_t0 = __builtin_amdgcn_s_memrealtime(); } while (0)
#define SEAM(k) do { if (IN(k) && IN((k) + 1)) xcd_barrier(bar); if (PROBE_MASK & (1u << (k))) probe_acc += __builtin_amdgcn_s_memrealtime() - probe_t0; } while (0)

    if (IN(0)) { PROBE_BEGIN(0); if (PH_ON(0)) phase_prologue(F); if (IN(1)) xcd_barrier_first(bar); if (PROBE_MASK & 1u) probe_acc += __builtin_amdgcn_s_memrealtime() - probe_t0; }
    if (IN(1)) { PROBE_BEGIN(1); if (PH_ON(1)) phase_rowpass1_l0(F); SEAM(1); }
    for (int l = 0; l < NLAYER; ++l) {
        const int pb = 2 + 11 * l;
        const bool ctx = (l == 0);
        if (IN(pb + 0)) { PROBE_BEGIN(pb + 0); if (PH_ON(2)) {
            pg8::SchedDense S; S.init(F.ws + WS_HN, F.ws + WS_WIN + (size_t)l * INW * DM * 2, NTOK / 256, INW / 256, F.G, (int)blockIdx.x, 0);
            pg8::EpiPost E{(bf16_t*)(F.ws + WS_P), (const float*)(F.ws + WS_ROPE), INP(F, IN_QNA) + l * 128, INP(F, IN_KNA) + l * 128, INP(F, IN_QNC) + l * 128, INP(F, IN_KNC) + l * 128, INP(F, IN_VNB) + l * 512, F.lds + LDSCTL_OFF + 2048};
            pg8::gemm_phase<pg8::EpiPost, pg8::SchedDense>(F.lds, S, E); }
            SEAM(pb + 0); }
        if (IN(pb + 2)) { PROBE_BEGIN(pb + 2); if (PH_ON(4)) phase_mixers(F, l); SEAM(pb + 2); }
        if (IN(pb + 3)) { PROBE_BEGIN(pb + 3); if (PH_ON(5)) phase_groupnorm(F, l); SEAM(pb + 3); }
        if (IN(pb + 4)) { PROBE_BEGIN(pb + 4); if (PH_ON(6)) {
            pg8::SchedDense S; S.init(F.ws + WS_O, F.ws + WS_WOUT + (size_t)l * DM * DM * 2, ctx ? NTOK / 256 : 64, DM / 256, F.G, (int)blockIdx.x, ctx ? 0 : 1);
            float* xb = (float*)(F.ws + WS_XB);
            pg8::EpiResid E;
            if (l == 0) { E.ctxbase = INP(F, IN_CTX); E.latbase = INP(F, IN_X); E.cbs = CTXL; E.lbs = SEQ; }
            else { E.ctxbase = xb; E.latbase = xb + (size_t)CTXL * DM; E.cbs = TPB; E.lbs = TPB; }
            E.xout = xb; E.modl = (const float*)(F.ws + WS_MOD) + (size_t)l * 5 * NMOD; E.parts = (float*)(F.ws + WS_PART);
            pg8::gemm_phase<pg8::EpiResid, pg8::SchedDense>(F.lds, S, E); }
            SEAM(pb + 4); }
        if (IN(pb + 5)) { PROBE_BEGIN(pb + 5); if (PH_ON(7)) phase_rowpass2(F, l); SEAM(pb + 5); }
        if (IN(pb + 6)) { PROBE_BEGIN(pb + 6); if (PH_ON(8)) phase_topk(F, l); SEAM(pb + 6); }
        if (IN(pb + 8)) { PROBE_BEGIN(pb + 8); if (PH_ON(10)) {
            if ((l == 0) ? (FP8_L0 != 0) : (FP8_L1 != 0)) {
                pg8::SchedGrouped<pg8::GK> S; S.init(F.ws + WS_HN8, F.ws + WS_WGU + (size_t)l * NE * 4096 * DM * 2, ctx ? 9 : 8, 16, F.G, (int)blockIdx.x);
                pg8::EpiSwiGLU8 E{(unsigned char*)(F.ws + WS_H)};
                pg8::gemm_phase<pg8::EpiSwiGLU8, pg8::SchedGrouped<pg8::GK>, true, true>(F.lds, S, E, (const unsigned*)(F.ws + WS_OFFS), F.lds + LDSCTL_OFF + 2048);
            } else {
                pg8::SchedGrouped<2 * pg8::GK> S; S.init(F.ws + WS_HN, F.ws + WS_WGU + (size_t)l * NE * 4096 * DM * 2, ctx ? 9 : 8, 16, F.G, (int)blockIdx.x);
                pg8::EpiSwiGLU E{(bf16_t*)(F.ws + WS_H)};
                pg8::gemm_phase<pg8::EpiSwiGLU, pg8::SchedGrouped<2 * pg8::GK>, false, true>(F.lds, S, E, (const unsigned*)(F.ws + WS_OFFS), F.lds + LDSCTL_OFF + 2048);
            } }
            SEAM(pb + 8); }
        if (IN(pb + 9)) { PROBE_BEGIN(pb + 9); if (PH_ON(11)) {
            pg8::EpiStoreBf16 E{(bf16_t*)(F.ws + WS_XG), DM};
            if ((l == 0) ? (FP8_L0 != 0) : (FP8_L1 != 0)) {
                pg8::SchedGrouped<pg8::GK> S; S.init(F.ws + WS_H, F.ws + WS_WD + (size_t)l * NE * DM * DM * 2, ctx ? 9 : 8, 8, F.G, (int)blockIdx.x);
                pg8::gemm_phase<pg8::EpiStoreBf16, pg8::SchedGrouped<pg8::GK>, true>(F.lds, S, E);
            } else {
                pg8::SchedGrouped<2 * pg8::GK> S; S.init(F.ws + WS_H, F.ws + WS_WD + (size_t)l * NE * DM * DM * 2, ctx ? 9 : 8, 8, F.G, (int)blockIdx.x);
                pg8::gemm_phase<pg8::EpiStoreBf16, pg8::SchedGrouped<2 * pg8::GK>, false>(F.lds, S, E);
            } }
            SEAM(pb + 9); }
        if (IN(pb + 10)) { PROBE_BEGIN(pb + 10); if (PH_ON(12)) phase_combine(F, l); if (l + 1 < NLAYER) SEAM(pb + 10); else if (PROBE_MASK & (1u << (pb + 10))) probe_acc += __builtin_amdgcn_s_memrealtime() - probe_t0; }
    }
    if (PROBE_MASK) { const unsigned long long te = __builtin_amdgcn_s_memrealtime(); while (__builtin_amdgcn_s_memrealtime() - te < probe_acc) __builtin_amdgcn_s_sleep(8); }
#undef IN
#undef SEAM
}

extern "C" void kernel_launch(void* const* d_in, const int* in_sizes, int n_in, void* d_out, int out_size, void* d_ws, size_t ws_size, hipStream_t stream) {
    static int grid = 0;
    if (grid == 0) {
        if (n_in != 23 || out_size != NB * SEQ * DM || ws_size < WS_END) { fprintf(stderr, "kernel_launch: shape mismatch: n_in %d out %d ws %zu (need %zu)\n", n_in, out_size, ws_size, (size_t)WS_END); grid = -1; return; }
        int dev = 0, cus = 0, per_cu = 0;
        if (hipGetDevice(&dev) != hipSuccess || hipDeviceGetAttribute(&cus, hipDeviceAttributeMultiprocessorCount, dev) != hipSuccess) { grid = -1; return; }
        if (hipFuncSetAttribute((const void*)fwd_kernel, hipFuncAttributeMaxDynamicSharedMemorySize, LDS_BYTES) != hipSuccess) { fprintf(stderr, "kernel_launch: hipFuncSetAttribute failed\n"); grid = -1; return; }
        if (hipOccupancyMaxActiveBlocksPerMultiprocessor(&per_cu, (const void*)fwd_kernel, 512, LDS_BYTES) != hipSuccess || per_cu < 1) { fprintf(stderr, "kernel_launch: occupancy query says %d\n", per_cu); }
        (void)hipGetLastError();
        grid = cus;
    }
    if (grid < 0) return;
    if (hipMemsetAsync((char*)d_ws + WS_CTL, 0, CTL_ZERO_BYTES, stream) != hipSuccess) return;
    Args a{};
    for (int i = 0; i < 23; ++i) a.in[i] = (const float*)d_in[i];
    a.out = (float*)d_out; a.ws = (unsigned char*)d_ws;
#if MK_PER_PHASE
    for (int p = 0; p < N_PHASES; ++p) { a.ph_lo = p; a.ph_hi = p + 1; hipLaunchKernelGGL(fwd_kernel, dim3(grid), dim3(512), LDS_BYTES, stream, a); }
#else
    a.ph_lo = 0; a.ph_hi = N_PHASES;
    hipLaunchKernelGGL(fwd_kernel, dim3(grid), dim3(512), LDS_BYTES, stream, a);
#endif
    const hipError_t le = hipPeekAtLastError();
    if (le != hipSuccess) fprintf(stderr, "kernel_launch: launch failed: %s\n", hipGetErrorName(le));
}
```

```cpp
#include <hip/hip_runtime.h>
#include <cstdio>
#include <cstdint>

#define LAS __attribute__((address_space(3)))
#define GAS __attribute__((address_space(1)))
typedef unsigned short bf16_t;
typedef short bf16x8 __attribute__((ext_vector_type(8)));
typedef short s16x4 __attribute__((ext_vector_type(4)));
typedef float f32x2 __attribute__((ext_vector_type(2)));
typedef float f32x4 __attribute__((ext_vector_type(4)));
typedef float f32x16 __attribute__((ext_vector_type(16)));
typedef unsigned u32x2 __attribute__((ext_vector_type(2)));
typedef unsigned u32x4 __attribute__((ext_vector_type(4)));
typedef int i32x4 __attribute__((ext_vector_type(4)));
typedef int i32x8 __attribute__((ext_vector_type(8)));

#ifndef MK_PER_PHASE
#define MK_PER_PHASE 0
#endif
#ifndef PHASE_MASK
#define PHASE_MASK 0x1fff
#endif
#define PH_ON(k) (((PHASE_MASK) >> (k)) & 1)
#ifndef FP8_L0
#define FP8_L0 1
#endif
#ifndef FP8_L1
#define FP8_L1 1
#endif
#ifndef PROBE_MASK
#define PROBE_MASK 0u
#endif
#ifndef DBG_STOP
#define DBG_STOP 0
#endif

constexpr int DM = 2048, NB = 4, SEQ = 4096, CTXL = 256, TPB = SEQ + CTXL, NTOK = NB * TPB;
constexpr int INW = 3584, NE = 16, NLAYER = 2, NMOD = 6 * DM;
constexpr int C_QA = 0, C_KA = 768, C_VA = 1024, C_UB = 1280, C_VB = 1792, C_QC = 2304, C_KC = 3072, C_VC = 3328;
constexpr int O_A = 0, O_B = 768, O_C = 1280;
constexpr int CAP_L = 512, CAP_C = 32, ROWS_E = 2304;
constexpr float EPS = 1e-6f;

constexpr size_t MiB = 1u << 20;
constexpr size_t WS_CTL = 0, CTL_ZERO_BYTES = 65536;
constexpr size_t WS_MOD = 1 * MiB;
constexpr size_t WS_ROPE = 2 * MiB;
constexpr size_t WS_AFFL = 3 * MiB;
constexpr size_t WS_AFFC = 4 * MiB;
constexpr size_t WS_POSL = 5 * MiB;
constexpr size_t WS_POSC = 6 * MiB;
constexpr size_t WS_OFFS = 10 * MiB;
constexpr size_t WS_GATE = 8 * MiB;
constexpr size_t WS_WRT = 9 * MiB;
constexpr size_t WS_WRS = 11 * MiB;
constexpr size_t WS_GS2 = 12 * MiB;
constexpr size_t WS_PART = 13 * MiB;
constexpr size_t WS_WIN = 16 * MiB;
constexpr size_t WS_WOUT = WS_WIN + (size_t)2 * INW * DM * 2;
constexpr size_t WS_WGU = WS_WOUT + (size_t)2 * DM * DM * 2;
constexpr size_t WS_WD = WS_WGU + (size_t)2 * NE * 4096 * DM * 2;
constexpr size_t WS_HN = WS_WD + (size_t)2 * NE * DM * DM * 2;
constexpr size_t WS_P = WS_HN + (size_t)NTOK * DM * 2;
constexpr size_t WS_O = WS_P + (size_t)NTOK * INW * 2;
constexpr size_t WS_XB = WS_O + (size_t)NTOK * DM * 2;
constexpr size_t WS_XG = WS_XB + (size_t)NTOK * DM * 4;
constexpr size_t WS_H = WS_XG + (size_t)NE * ROWS_E * DM * 2;
constexpr size_t WS_HN8 = WS_H + (size_t)NE * ROWS_E * DM * 2;
constexpr size_t WS_END = WS_HN8 + (size_t)NTOK * DM;
constexpr float W8_SCALE = 32.f; constexpr int W8_SCALE_E8M0 = 127 - 5;
constexpr int CW_BAR = 4096, CW_QUEUE = 8192;

constexpr int RING_BYTES = 131072, LDSCTL_OFF = RING_BYTES, MISC_OFF = LDSCTL_OFF + 320, LDS_BYTES = 147456;

#define LDS_WAIT() asm volatile("s_waitcnt lgkmcnt(0)" ::: "memory")
#define VM_WAIT() asm volatile("s_waitcnt vmcnt(0)" ::: "memory")
__device__ __forceinline__ unsigned f2bf(float f) { unsigned u = __builtin_bit_cast(unsigned, f); return (u + 0x7fffu + ((u >> 16) & 1u)) >> 16; }
__device__ __forceinline__ unsigned pk2(float lo, float hi) { return f2bf(lo) | (f2bf(hi) << 16); }
__device__ __forceinline__ float bf2f(unsigned short b) { return __builtin_bit_cast(float, ((unsigned)b) << 16); }
__device__ __forceinline__ float bflo(unsigned w) { return __builtin_bit_cast(float, w << 16); }
__device__ __forceinline__ float bfhi(unsigned w) { return __builtin_bit_cast(float, w & 0xffff0000u); }
__device__ __forceinline__ unsigned pk4_fp8(float a, float b, float c, float d) {
    int r = __builtin_amdgcn_cvt_pk_fp8_f32(a, b, 0, false); r = __builtin_amdgcn_cvt_pk_fp8_f32(c, d, r, true); return (unsigned)r; }
__device__ __forceinline__ int opaque_tid() { int t = threadIdx.x; asm volatile("" : "+v"(t)); return t; }
__device__ __forceinline__ float row16_sum(float v) {
    v += __builtin_bit_cast(float, __builtin_amdgcn_update_dpp(0, __builtin_bit_cast(int, v), 0xB1, 0xF, 0xF, true));
    v += __builtin_bit_cast(float, __builtin_amdgcn_update_dpp(0, __builtin_bit_cast(int, v), 0x4E, 0xF, 0xF, true));
    v += __builtin_bit_cast(float, __builtin_amdgcn_update_dpp(0, __builtin_bit_cast(int, v), 0x141, 0xF, 0xF, true));
    v += __builtin_bit_cast(float, __builtin_amdgcn_update_dpp(0, __builtin_bit_cast(int, v), 0x140, 0xF, 0xF, true));
    return v;
}
__device__ __forceinline__ float wave_sum(float v) {
    v = row16_sum(v);
    const int iv = __builtin_bit_cast(int, v);
    const float a = __builtin_bit_cast(float, __builtin_amdgcn_readlane(iv, 0)), b = __builtin_bit_cast(float, __builtin_amdgcn_readlane(iv, 16));
    const float c = __builtin_bit_cast(float, __builtin_amdgcn_readlane(iv, 32)), d = __builtin_bit_cast(float, __builtin_amdgcn_readlane(iv, 48));
    return (a + b) + (c + d);
}
__device__ __forceinline__ float rsqrt_fast(float x) { return __builtin_amdgcn_rsqf(x); }
__device__ __forceinline__ float gelu_tanh(float x) {
    const float u = 0.7978845608028654f * (x + 0.044715f * x * x * x);
    const float e = __expf(2.f * u);
    const float th = 1.f - 2.f / (e + 1.f);
    return 0.5f * x * (1.f + th);
}

#define XB_TMO      128
#define XB_XCNT(j)  (256  + 64 * (j))
#define XB_XSUB(j)  (1280 + 64 * (j))
#define XB_XGEN(j)  (2304 + 64 * (j))
#define XB_TOP      3328
#define XB_TOPGEN   3392
#define XCD_BAR_WORDS 3456
#define XB_SPIN_CAP (1u << 18)
__device__ __forceinline__ unsigned xb_ld(unsigned* p)              { return __hip_atomic_load(p, __ATOMIC_RELAXED, __HIP_MEMORY_SCOPE_AGENT); }
__device__ __forceinline__ unsigned xb_add(unsigned* p, unsigned v) { return __hip_atomic_fetch_add(p, v, __ATOMIC_RELAXED, __HIP_MEMORY_SCOPE_AGENT); }
__device__ __forceinline__ unsigned xb_xcc_id() { return (unsigned)__builtin_amdgcn_s_getreg((3 << 11) | 20) & 0xFu; }
#define XB_SPIN(cond, bar) do { unsigned _sp = 0; while (cond) { __builtin_amdgcn_s_sleep(1); \
    if ((++_sp & 255u) == 0u) { if (xb_ld(&(bar)[XB_TMO])) break; if (_sp > XB_SPIN_CAP) { atomicAdd(&(bar)[XB_TMO], 1u); break; } } } } while (0)
struct XcdBarrier { unsigned* bar; unsigned x; volatile LAS unsigned* st; };
__device__ __forceinline__ XcdBarrier xcd_barrier_post(unsigned* bar, volatile LAS unsigned* st) {
    XcdBarrier b; b.bar = bar; b.x = xb_xcc_id(); b.st = st;
    if (threadIdx.x == 0) (void)xb_add(&bar[XB_XCNT(b.x)], 1u);
    return b;
}
__device__ __forceinline__ void xcd_barrier_complete(unsigned* bar, unsigned x, unsigned& nloc, unsigned& nx) {
    const unsigned G = gridDim.x * gridDim.y * gridDim.z;
    unsigned sum, cnt, mine, sp = 0u;
    for (;;) {
        sum = 0u; cnt = 0u; mine = 0u;
#pragma unroll
        for (unsigned j = 0; j < 16; ++j) { const unsigned c = xb_ld(&bar[XB_XCNT(j)]); sum += c; cnt += (c > 0u) ? 1u : 0u; mine = (j == x) ? c : mine; }
        if (sum == G) break;
        __builtin_amdgcn_s_sleep(1);
        if ((++sp & 255u) == 0u) { if (xb_ld(&bar[XB_TMO])) break; if (sp > XB_SPIN_CAP) { atomicAdd(&bar[XB_TMO], 1u); break; } }
    }
    nloc = mine > 0u ? mine : 1u; nx = cnt > 0u ? cnt : 1u;
}
template <bool FIRST>
__device__ __forceinline__ void xcd_barrier_t(const XcdBarrier& b) {
    asm volatile("s_waitcnt vmcnt(0)" ::: "memory");
    __syncthreads();
    if (threadIdx.x == 0) {
        unsigned* bar = b.bar;
        asm volatile("" : "+s"(bar));
        __builtin_amdgcn_s_waitcnt(0);
        unsigned nloc = b.st[0], nx = b.st[1];
        if constexpr (FIRST) { if (nloc == 0u) { xcd_barrier_complete(bar, b.x, nloc, nx); b.st[0] = nloc; b.st[1] = nx; } }
        const unsigned old = xb_add(&bar[XB_XSUB(b.x)], 1u);
        const unsigned gen = old / nloc;
        if (old + 1u == (gen + 1u) * nloc) {
            __builtin_amdgcn_fence(__ATOMIC_RELEASE, "agent");
            asm volatile("s_waitcnt vmcnt(0)" ::: "memory");
            const unsigned og = xb_add(&bar[XB_TOP], 1u);
            const unsigned tg = og / nx;
            if (og + 1u == (tg + 1u) * nx) xb_add(&bar[XB_TOPGEN], 1u);
            else XB_SPIN(xb_ld(&bar[XB_TOPGEN]) == tg, bar);
            __builtin_amdgcn_fence(__ATOMIC_ACQUIRE, "agent");
            xb_add(&bar[XB_XGEN(b.x)], 1u);
            asm volatile("s_waitcnt vmcnt(0)" ::: "memory");
        } else {
            XB_SPIN(xb_ld(&bar[XB_XGEN(b.x)]) == gen, bar);
            __builtin_amdgcn_fence(__ATOMIC_ACQUIRE, "agent");
            asm volatile("s_waitcnt vmcnt(0)" ::: "memory");
        }
    }
    __syncthreads();
}
__device__ __forceinline__ void xcd_barrier(const XcdBarrier& b) { xcd_barrier_t<false>(b); }
__device__ __forceinline__ void xcd_barrier_first(const XcdBarrier& b) { xcd_barrier_t<true>(b); }

namespace pg8 {
constexpr int BM = 256, BK = 64, HALF = 128, HTB = HALF * BK * 2, STAGE_BYTES = 8 * HTB, NXCD = 8, WGM = 8;
constexpr int GK = 2048;
__host__ __device__ __forceinline__ int lds_byte(int r, int c) { const int st = (r >> 4) * 2 + (c >> 5), rr = r & 15, cc = c & 31, ob = rr * 64 + cc * 2; return st * 1024 + (ob ^ (((ob >> 9) & 1) << 5)); }
__host__ __device__ __forceinline__ void stage_rc(int b, int& R, int& C) { const int st = b / 1024, sb = b % 1024, swz = sb ^ (((sb >> 9) & 1) << 5); R = (st >> 1) * 16 + swz / 64; C = (st & 1) * 32 + (swz % 64) / 2; }
__host__ __device__ __forceinline__ int perm32(int rho) { const int n = rho >> 4, i = rho & 15; return 8 * (i >> 2) + 4 * n + (i & 3); }

struct Unit { int pm, pn, e, rowbase, colbase, oidx; const char* a; const char* b; };

struct SchedDense {
    static constexpr int RB = GK * 2;
    const char* A; const char* Bt; int nM, nN, nwg, G, c, skipctx;
    __device__ void init(const void* A_, const void* Bt_, int nM_, int nN_, int G_, int c_, int skipctx_) { A = (const char*)A_; Bt = (const char*)Bt_; nM = nM_; nN = nN_; nwg = nM * nN; G = G_; c = c_; skipctx = skipctx_; }
    __device__ bool next(int i, Unit& u) const {
        const long L = (long)i * G + c; if (L >= nwg) return false;
        int wgid = (int)L; { const int q = nwg / NXCD, r = nwg % NXCD, xcd = wgid % NXCD, off = wgid / NXCD; wgid = (xcd < r ? xcd * (q + 1) : r * (q + 1) + (xcd - r) * q) + off; }
        const int nig = WGM * nN, gid = wgid / nig, fm = gid * WGM, gsz = (nM - fm) < WGM ? (nM - fm) : WGM;
        int pm = fm + ((wgid % nig) % gsz); const int pn = (wgid % nig) / gsz;
        if (skipctx) pm = (pm >> 4) * 17 + 1 + (pm & 15);
        u.pm = pm; u.pn = pn; u.e = 0; u.rowbase = pm * BM; u.colbase = pn * BM; u.oidx = 0;
        u.a = A + (size_t)pm * (BM * GK * 2); u.b = Bt + (size_t)pn * (BM * GK * 2); return true;
    }
};
template <int RB_> struct SchedGrouped {
    static constexpr int RB = RB_;
    const char* A; const char* Bt; int nMe, nNe, nwg, G, c;
    __device__ void init(const void* A_, const void* Bt_, int nMe_, int nNe_, int G_, int c_) { A = (const char*)A_; Bt = (const char*)Bt_; nMe = nMe_; nNe = nNe_; nwg = NE * nMe * nNe; G = G_; c = c_; }
    __device__ bool next(int i, Unit& u) const {
        int e, pm, pn;
        if ((G & 255) == 0) {
            const int cpe = nNe >> 2, nchunk = NE * cpe, xcd = c & 7, slot = (c >> 3) & 31, sub = c >> 8;
            const int chunk = (i * (G >> 8) + sub) * 8 + xcd;
            if (chunk < nchunk) { e = chunk / cpe; pm = slot >> 2; pn = (chunk % cpe) * 4 + (slot & 3); }
            else { const int per = (NE * nNe) >> 3;
                if (nMe < 9 || chunk >= nchunk + 8 || slot >= per) return false; const int j = (chunk - nchunk) * per + slot; e = j / nNe; pn = j % nNe; pm = 8; }
        } else { const long L = (long)i * G + c; if (L >= nwg) return false; const int per = nMe * nNe, rem = (int)L % per; e = (int)L / per; pm = rem % nMe; pn = rem / nMe; }
        u.pm = pm; u.pn = pn; u.e = e; u.rowbase = e * ROWS_E + pm * BM; u.colbase = pn * BM; u.oidx = e * 9 + pm;
        u.a = A + (size_t)(e * ROWS_E + pm * BM) * RB; u.b = Bt + ((size_t)e * nNe + pn) * (BM * RB); return true;
    }
};

__device__ __forceinline__ unsigned cvt_pk_bf16(float lo, float hi) { unsigned r; asm volatile("v_cvt_pk_bf16_f32 %0, %1, %2" : "=v"(r) : "v"(lo), "v"(hi)); return r; }

struct EpiStoreBf16 {
    static constexpr bool PERM = true;
    bf16_t* O; int ldc;
    __device__ __forceinline__ void operator()(const f32x4 (&acc)[2][2][4][2], const Unit& u, int wr, int wc, int fr, int fq) const {
        const int row0 = u.rowbase + wr * 64 + fr, col0 = u.colbase + wc * 32 + 8 * fq;
#pragma unroll
        for (int ai = 0; ai < 2; ++ai)
#pragma unroll
            for (int m = 0; m < 4; ++m) { bf16_t* rowp = O + (size_t)(row0 + ai * HALF + m * 16) * ldc + col0;
#pragma unroll
                for (int bj = 0; bj < 2; ++bj) { const f32x4 v0 = acc[ai][bj][m][0], v1 = acc[ai][bj][m][1];
                    u32x4 w; w.x = cvt_pk_bf16(v0[0], v0[1]); w.y = cvt_pk_bf16(v0[2], v0[3]); w.z = cvt_pk_bf16(v1[0], v1[1]); w.w = cvt_pk_bf16(v1[2], v1[3]);
                    *(u32x4*)(rowp + bj * HALF) = w; } }
    }
};
struct EpiPost {
    static constexpr bool PERM = true;
    bf16_t* P; const float* rope; const float* qna; const float* kna; const float* qnc; const float* knc; const float* vnb; LAS unsigned char* tab;
    __device__ __forceinline__ void operator()(f32x4 (&acc)[2][2][4][2], const Unit& u, int wr, int wc, int fr, int fq) const {
        const int tb = u.pm % 17; const bool lat = tb != 0;
        const int d0 = 64 * (wc >> 1) + 16 * (wc & 1) + 4 * fq, rl0 = wr * 64 + fr;
        int typ[2]; const float* gain[2];
#pragma unroll
        for (int bj = 0; bj < 2; ++bj) { const int slot = 2 * u.pn + bj;
            typ[bj] = (slot < 8) ? 3 : (slot < 10) ? 0 : (slot < 14) ? 1 : (slot < 18) ? 2 : (slot < 26) ? 3 : 0;
            gain[bj] = (slot < 6) ? qna : (slot < 8) ? kna : (slot < 18) ? vnb + ((slot - 14) & 3) * 128 : (slot < 24) ? qnc : knc; }
        const bool anynorm = typ[0] >= 2 || typ[1] >= 2;
#pragma unroll
        for (int bj = 0; bj < 2; ++bj) if (typ[bj] == 1 || typ[bj] == 2) {
#pragma unroll
            for (int ai = 0; ai < 2; ++ai)
#pragma unroll
                for (int m = 0; m < 4; ++m)
#pragma unroll
                    for (int n = 0; n < 2; ++n)
#pragma unroll
                        for (int j = 0; j < 4; ++j) acc[ai][bj][m][n][j] = gelu_tanh(acc[ai][bj][m][n][j]); }
        if (anynorm) {
#pragma unroll
            for (int bj = 0; bj < 2; ++bj) if (typ[bj] >= 2) {
#pragma unroll
                for (int ai = 0; ai < 2; ++ai)
#pragma unroll
                    for (int m = 0; m < 4; ++m) { const f32x4 a = acc[ai][bj][m][0], b = acc[ai][bj][m][1];
                        float ss = ((a.x * a.x + a.y * a.y) + (a.z * a.z + a.w * a.w)) + ((b.x * b.x + b.y * b.y) + (b.z * b.z + b.w * b.w));
                        ss += __builtin_bit_cast(float, __builtin_amdgcn_ds_swizzle(__builtin_bit_cast(int, ss), 0x401F));
                        { auto rr = __builtin_amdgcn_permlane32_swap(__float_as_uint(ss), __float_as_uint(ss), false, false); ss = __uint_as_float(rr[0]) + __uint_as_float(rr[1]); }
                        if (fq == 0) *(LAS float*)(tab + (((rl0 + ai * HALF + m * 16) * 2 + bj) * 4 + wc) * 4) = ss; } }
            asm volatile("s_waitcnt lgkmcnt(0)" ::: "memory"); __builtin_amdgcn_s_barrier(); asm volatile("" ::: "memory");
        }
#pragma unroll
        for (int bj = 0; bj < 2; ++bj) {
            const int slot = 2 * u.pn + bj;
            f32x4 g0 = (f32x4){1.f, 1.f, 1.f, 1.f}, g1 = g0;
            if (typ[bj] >= 2) { g0 = *(const f32x4*)(gain[bj] + d0); g1 = *(const f32x4*)(gain[bj] + d0 + 32); }
#pragma unroll
            for (int ai = 0; ai < 2; ++ai)
#pragma unroll
                for (int m = 0; m < 4; ++m) { const int rl = rl0 + ai * HALF + m * 16;
                    f32x4 a = acc[ai][bj][m][0], b = acc[ai][bj][m][1];
                    if (typ[bj] >= 2) { const f32x4 t = *(const LAS f32x4*)(tab + ((rl * 2 + bj) * 4) * 4);
                        const float rinv = rsqrt_fast(((t.x + t.y) + (t.z + t.w)) * (1.f / 128) + EPS);
                        a = a * rinv * g0; b = b * rinv * g1; }
                    if (typ[bj] == 3 && lat) { const int pos = (tb - 1) * 256 + rl, pp = (wc >> 1) ? (pos & 63) : (pos >> 6);
                        const f32x4* cs = (const f32x4*)(rope + 2 * (pp * 32 + 16 * (wc & 1) + 4 * fq)); const f32x4 c0 = cs[0], c1 = cs[1];
                        const f32x4 cv = (f32x4){c0.x, c0.z, c1.x, c1.z}, sv = (f32x4){c0.y, c0.w, c1.y, c1.w};
                        const f32x4 ra = a * cv - b * sv, rb = b * cv + a * sv; a = ra; b = rb; }
                    bf16_t* rowp = P + (size_t)(u.rowbase + rl) * INW + slot * 128 + d0;
                    u32x2 w0, w1; w0.x = cvt_pk_bf16(a.x, a.y); w0.y = cvt_pk_bf16(a.z, a.w); w1.x = cvt_pk_bf16(b.x, b.y); w1.y = cvt_pk_bf16(b.z, b.w);
                    *(u32x2*)rowp = w0; *(u32x2*)(rowp + 32) = w1; }
        }
    }
};
struct EpiResid {
    static constexpr bool PERM = false;
    const float* ctxbase; const float* latbase; int cbs, lbs;
    float* xout; const float* modl;
    float* parts;
    __device__ __forceinline__ void operator()(const f32x4 (&acc)[2][2][4][2], const Unit& u, int wr, int wc, int fr, int fq) const {
        const int b = u.pm / 17, tb = u.pm % 17;
        const float* src = (tb == 0) ? ctxbase + (size_t)b * cbs * DM : latbase + ((size_t)b * lbs + (size_t)(tb - 1) * 256) * DM;
        const float* g1 = modl + (size_t)((tb == 0) ? 4 : b) * NMOD + 2 * DM;
        const int rl0 = wr * 64 + fr, col0 = u.colbase + wc * 32 + 4 * fq;
        f32x4 gv[2][2];
#pragma unroll
        for (int bj = 0; bj < 2; ++bj)
#pragma unroll
            for (int n = 0; n < 2; ++n) gv[bj][n] = *(const f32x4*)(g1 + col0 + bj * HALF + n * 16);
#pragma unroll
        for (int ai = 0; ai < 2; ++ai)
#pragma unroll
        for (int mh = 0; mh < 2; ++mh) {
            f32x4 xv[2][2][2];
#pragma unroll
            for (int mm = 0; mm < 2; ++mm) { const float* sp = src + (size_t)(rl0 + ai * HALF + (2 * mh + mm) * 16) * DM + col0;
#pragma unroll
                for (int bj = 0; bj < 2; ++bj)
#pragma unroll
                    for (int n = 0; n < 2; ++n) xv[mm][bj][n] = *(const f32x4*)(sp + bj * HALF + n * 16); }
#pragma unroll
            for (int mm = 0; mm < 2; ++mm) { const int m = 2 * mh + mm, rl = rl0 + ai * HALF + m * 16; float* dp = xout + (size_t)(u.rowbase + rl) * DM + col0; float ss = 0.f;
#pragma unroll
                for (int bj = 0; bj < 2; ++bj)
#pragma unroll
                    for (int n = 0; n < 2; ++n) { const f32x4 y = xv[mm][bj][n] + gv[bj][n] * acc[ai][bj][m][n]; *(f32x4*)(dp + bj * HALF + n * 16) = y;
                        ss += (y.x * y.x + y.y * y.y) + (y.z * y.z + y.w * y.w); }
                ss += __builtin_bit_cast(float, __builtin_amdgcn_ds_swizzle(__builtin_bit_cast(int, ss), 0x401F));
                { auto rr = __builtin_amdgcn_permlane32_swap(__float_as_uint(ss), __float_as_uint(ss), false, false); ss = __uint_as_float(rr[0]) + __uint_as_float(rr[1]); }
                if (fq == 0) parts[(size_t)(u.rowbase + rl) * 32 + u.pn * 4 + wc] = ss; }
            asm volatile("" ::: "memory");
        }
    }
};
struct EpiSwiGLU {
    static constexpr bool PERM = true;
    bf16_t* Hout;
    __device__ __forceinline__ void operator()(const f32x4 (&acc)[2][2][4][2], const Unit& u, int wr, int wc, int fr, int fq) const {
        const int row0 = u.rowbase + wr * 64 + fr, col0 = u.pn * HALF + wc * 32 + 8 * fq;
#pragma unroll
        for (int ai = 0; ai < 2; ++ai)
#pragma unroll
            for (int m = 0; m < 4; ++m) { bf16_t* rowp = Hout + (size_t)(row0 + ai * HALF + m * 16) * DM + col0; float h[8];
#pragma unroll
                for (int n = 0; n < 2; ++n)
#pragma unroll
                    for (int j = 0; j < 4; ++j) { const float g = acc[ai][0][m][n][j], up = acc[ai][1][m][n][j]; h[n * 4 + j] = g * __builtin_amdgcn_rcpf(1.f + __expf(-g)) * up; }
                u32x4 w; w.x = cvt_pk_bf16(h[0], h[1]); w.y = cvt_pk_bf16(h[2], h[3]); w.z = cvt_pk_bf16(h[4], h[5]); w.w = cvt_pk_bf16(h[6], h[7]);
                *(u32x4*)rowp = w; }
    }
};
struct EpiSwiGLU8 {
    static constexpr bool PERM = true;
    unsigned char* Hout;
    __device__ __forceinline__ void operator()(const f32x4 (&acc)[2][2][4][2], const Unit& u, int wr, int wc, int fr, int fq) const {
        const int row0 = u.rowbase + wr * 64 + fr, col0 = u.pn * HALF + wc * 32 + 8 * fq;
#pragma unroll
        for (int ai = 0; ai < 2; ++ai)
#pragma unroll
            for (int m = 0; m < 4; ++m) { unsigned char* rowp = Hout + (size_t)(row0 + ai * HALF + m * 16) * DM + col0; float h[8];
#pragma unroll
                for (int n = 0; n < 2; ++n)
#pragma unroll
                    for (int j = 0; j < 4; ++j) { const float g = acc[ai][0][m][n][j], up = acc[ai][1][m][n][j]; h[n * 4 + j] = g * __builtin_amdgcn_rcpf(1.f + __expf(-g)) * up; }
                u32x2 w; w.x = pk4_fp8(h[0], h[1], h[2], h[3]); w.y = pk4_fp8(h[4], h[5], h[6], h[7]);
                *(u32x2*)rowp = w; }
    }
};
struct EpiDown {
    static constexpr bool PERM = true;
    bf16_t* Y; const float* gatev;
    __device__ __forceinline__ void operator()(const f32x4 (&acc)[2][2][4][2], const Unit& u, int wr, int wc, int fr, int fq) const {
        const int row0 = u.rowbase + wr * 64 + fr, col0 = u.colbase + wc * 32 + 8 * fq;
#pragma unroll
        for (int ai = 0; ai < 2; ++ai)
#pragma unroll
            for (int m = 0; m < 4; ++m) { const int row = row0 + ai * HALF + m * 16; const float gt = gatev[row]; bf16_t* rowp = Y + (size_t)row * DM + col0;
#pragma unroll
                for (int bj = 0; bj < 2; ++bj) { const f32x4 v0 = acc[ai][bj][m][0] * gt, v1 = acc[ai][bj][m][1] * gt;
                    u32x4 w; w.x = cvt_pk_bf16(v0[0], v0[1]); w.y = cvt_pk_bf16(v0[2], v0[3]); w.z = cvt_pk_bf16(v1[0], v1[1]); w.w = cvt_pk_bf16(v1[2], v1[3]);
                    *(u32x4*)(rowp + bj * HALF) = w; } }
    }
};

template <class Epi, class Sched, bool FP8 = false, bool GATHER = false, bool ALIGN_EPI = true, bool SP2 = true>
__device__ __forceinline__ void gemm_phase(LAS unsigned char* lds, const Sched& S, const Epi& E, const unsigned* goffs = nullptr, LAS unsigned char* goffs_lds = nullptr) {
    static_assert(!GATHER || SP2, "gather mode is written for the SP2 loop");
    static_assert(Sched::RB == (FP8 ? GK : GK * 2), "operand row bytes");
    const int tid = opaque_tid(), wid = __builtin_amdgcn_readfirstlane(tid >> 6), lane = tid & 63, wr = wid >> 2, wc = wid & 3, fr = lane & 15, fq = lane >> 4;
    constexpr int RB = Sched::RB, nt = RB / 128;
    unsigned voffA[2], voffB[2];
#pragma unroll
    for (int i = 0; i < 2; ++i) { int R, C; stage_rc(tid * 16 + i * 8192, R, C); const int Rb = Epi::PERM ? ((R & ~31) + perm32(R & 31)) : R;
        voffA[i] = (unsigned)(R * RB + C * 2); voffB[i] = (unsigned)(Rb * RB + C * 2); }
    const size_t kstep = (size_t)(BK * 2);
    const size_t hstep = (size_t)HALF * RB;
    const unsigned ldsw = (unsigned)wid * 1024u;
    const int aoff = lds_byte(wr * 64 + fr, fq * 8), boff = lds_byte(wc * 32 + fr, fq * 8);
#define PG8_SA(b, h) (((b) * 2 + (h)) * HTB)
#define PG8_SB(b, h) ((4 + (b) * 2 + (h)) * HTB)
#define PG8_STAGE(bufoff, gbase, voff) do { _Pragma("unroll") for (int _i = 0; _i < 2; ++_i) \
        __builtin_amdgcn_global_load_lds((const unsigned*)((const char*)(gbase) + (voff)[_i]), (LAS unsigned*)(lds + (bufoff) + ldsw + _i * 8192), 16, 0, 0); } while (0)
#define PG8_RD8(p) __builtin_shufflevector(*(const LAS i32x4*)(p), *(const LAS i32x4*)((p) + 1024), 0, 1, 2, 3, 4, 5, 6, 7)
#define PG8_LDA(dst, b, h) do { _Pragma("unroll") for (int m = 0; m < 4; ++m) { if constexpr (FP8) dst##8[m] = PG8_RD8(lds + PG8_SA(b, h) + aoff + m * 2048); \
        else { _Pragma("unroll") for (int k = 0; k < 2; ++k) dst[m][k] = *(const LAS bf16x8*)(lds + PG8_SA(b, h) + aoff + m * 2048 + k * 1024); } } } while (0)
#define PG8_LDB(dst, b, h) do { _Pragma("unroll") for (int n = 0; n < 2; ++n) { if constexpr (FP8) dst##8[n] = PG8_RD8(lds + PG8_SB(b, h) + boff + n * 2048); \
        else { _Pragma("unroll") for (int k = 0; k < 2; ++k) dst[n][k] = *(const LAS bf16x8*)(lds + PG8_SB(b, h) + boff + n * 2048 + k * 1024); } } } while (0)
#define PG8_MMA(ai, bj, At, Bt) do { __builtin_amdgcn_s_setprio(1); _Pragma("unroll") for (int m = 0; m < 4; ++m) _Pragma("unroll") for (int n = 0; n < 2; ++n) { \
        if constexpr (FP8) asm volatile("v_mfma_scale_f32_16x16x128_f8f6f4 %0, %1, %2, %0, %3, %4 op_sel_hi:[0,0,0]" : "+v"(acc[ai][bj][m][n]) : "v"(Bt##8[n]), "v"(At##8[m]), "v"(sclW), "v"(sclX)); \
        else { _Pragma("unroll") for (int k = 0; k < 2; ++k) acc[ai][bj][m][n] = __builtin_amdgcn_mfma_f32_16x16x32_bf16(Bt[n][k], At[m][k], acc[ai][bj][m][n], 0, 0, 0); } } \
        __builtin_amdgcn_s_setprio(0); } while (0)
#define PG8_WAIT_V(n) asm volatile("s_waitcnt vmcnt(" #n ")" ::: "memory")
#define PG8_WAIT_L(n) asm volatile("s_waitcnt lgkmcnt(" #n ")" ::: "memory")
#define PG8_BAR __builtin_amdgcn_s_barrier()
#define PG8_SCHED __builtin_amdgcn_sched_barrier(0)
    Unit cur, nxt; int ui = 0;
    if (!S.next(0, cur)) return;
    u32x4 gC = (u32x4){0u, 0u, 0u, 0u}, gN = gC;
    if constexpr (GATHER) gC = *(const u32x4*)(goffs + ((size_t)cur.oidx * 512 + tid) * 4);
#define PG8_GSTAGE(bufoff, gbase, o0, o1) do { \
        __builtin_amdgcn_global_load_lds((const unsigned*)((const char*)(gbase) + (o0)), (LAS unsigned*)(lds + (bufoff) + ldsw), 16, 0, 0); \
        __builtin_amdgcn_global_load_lds((const unsigned*)((const char*)(gbase) + (o1)), (LAS unsigned*)(lds + (bufoff) + ldsw + 8192), 16, 0, 0); } while (0)
    f32x4 acc[2][2][4][2];
#pragma unroll
    for (int a = 0; a < 2; ++a)
#pragma unroll
        for (int b = 0; b < 2; ++b)
#pragma unroll
            for (int m = 0; m < 4; ++m)
#pragma unroll
                for (int n = 0; n < 2; ++n) acc[a][b][m][n] = (f32x4){0.f, 0.f, 0.f, 0.f};
    int sclW = W8_SCALE_E8M0 * 0x01010101, sclX = 0x7f7f7f7f; if constexpr (FP8) asm volatile("" : "+v"(sclW), "+v"(sclX)); (void)sclW; (void)sclX;
    bf16x8 At[4][2], B0[2][2], B1[2][2]; i32x8 At8[4], B08[2], B18[2];
    const char* cA = cur.a; const char* cB = cur.b;
    if constexpr (SP2) {
        PG8_STAGE(PG8_SB(0, 0), cB, voffB); PG8_STAGE(PG8_SB(0, 1), cB + hstep, voffB);
        if constexpr (GATHER) { PG8_GSTAGE(PG8_SA(0, 0), S.A, gC.x, gC.y); PG8_GSTAGE(PG8_SA(0, 1), S.A, gC.z, gC.w); }
        else { PG8_STAGE(PG8_SA(0, 0), cA, voffA); PG8_STAGE(PG8_SA(0, 1), cA + hstep, voffA); }
        if (wr == 1) PG8_BAR;
        PG8_WAIT_V(2); PG8_BAR;
        PG8_STAGE(PG8_SB(1, 0), cB + kstep, voffB);
        if constexpr (GATHER) PG8_GSTAGE(PG8_SA(1, 0), S.A + kstep, gC.x, gC.y); else PG8_STAGE(PG8_SA(1, 0), cA + kstep, voffA);
        PG8_STAGE(PG8_SB(1, 1), cB + hstep + kstep, voffB);
        PG8_WAIT_V(6); PG8_BAR;
    } else {
        PG8_STAGE(PG8_SB(0, 0), cB, voffB); PG8_STAGE(PG8_SA(0, 0), cA, voffA); PG8_STAGE(PG8_SB(0, 1), cB + hstep, voffB); PG8_STAGE(PG8_SA(0, 1), cA + hstep, voffA);
        if (wr == 1) PG8_BAR;
        PG8_WAIT_V(4); PG8_BAR;
        PG8_STAGE(PG8_SB(1, 0), cB + kstep, voffB); PG8_STAGE(PG8_SA(1, 0), cA + kstep, voffA); PG8_STAGE(PG8_SB(1, 1), cB + hstep + kstep, voffB);
        PG8_WAIT_V(6); PG8_BAR;
    }
    for (;;) {
        const bool has_next = S.next(ui + 1, nxt);
        const char* nA = has_next ? nxt.a : cA; const char* nB = has_next ? nxt.b : cB;
        if constexpr (GATHER) { if (has_next)
            __builtin_amdgcn_global_load_lds((const unsigned*)(goffs + ((size_t)nxt.oidx * 512 + tid) * 4), (LAS unsigned*)(goffs_lds + ldsw), 16, 0, 0); }
        for (int t = 0; t < nt; t += 2) {
            const bool last = (t == nt - 2);
            const char* a1 = cA + (size_t)(t + 1) * kstep;
            const char* a2 = last ? nA : cA + (size_t)(t + 2) * kstep; const char* b2 = last ? nB : cB + (size_t)(t + 2) * kstep;
            const char* a3 = a2 + kstep; const char* b3 = b2 + kstep;
            const char* g1 = S.A + (size_t)(t + 1) * kstep; const char* g2 = S.A + (last ? (size_t)0 : (size_t)(t + 2) * kstep); const char* g3 = g2 + kstep;
            u32x4 gX = gC;
            if constexpr (GATHER) { if (last) { if (has_next) gN = *(const LAS u32x4*)(goffs_lds + (size_t)tid * 16); else gN = gC; gX = gN; } }
            if constexpr (SP2) {
            PG8_LDB(B0, 0, 0); PG8_LDB(B1, 0, 1); PG8_SCHED; PG8_LDA(At, 0, 0);
            if constexpr (GATHER) PG8_GSTAGE(PG8_SA(1, 1), g1, gC.z, gC.w); else PG8_STAGE(PG8_SA(1, 1), a1 + hstep, voffA);
            PG8_WAIT_V(8); PG8_WAIT_L(0); PG8_BAR; PG8_MMA(0, 0, At, B0); PG8_MMA(0, 1, At, B1); PG8_BAR; PG8_SCHED;
            PG8_LDA(At, 0, 1); PG8_STAGE(PG8_SB(0, 0), b2, voffB); PG8_STAGE(PG8_SB(0, 1), b2 + hstep, voffB);
            if constexpr (GATHER) PG8_GSTAGE(PG8_SA(0, 0), g2, gX.x, gX.y); else PG8_STAGE(PG8_SA(0, 0), a2, voffA);
            PG8_WAIT_V(8); PG8_WAIT_L(0); PG8_BAR; PG8_MMA(1, 0, At, B0); PG8_MMA(1, 1, At, B1); PG8_BAR; PG8_SCHED;
            PG8_LDB(B0, 1, 0); PG8_LDB(B1, 1, 1); PG8_SCHED; PG8_LDA(At, 1, 0);
            if constexpr (GATHER) PG8_GSTAGE(PG8_SA(0, 1), g2, gX.z, gX.w); else PG8_STAGE(PG8_SA(0, 1), a2 + hstep, voffA);
            PG8_WAIT_V(8); PG8_WAIT_L(0); PG8_BAR; PG8_MMA(0, 0, At, B0); PG8_MMA(0, 1, At, B1); PG8_BAR; PG8_SCHED;
            PG8_LDA(At, 1, 1); PG8_STAGE(PG8_SB(1, 0), b3, voffB); PG8_STAGE(PG8_SB(1, 1), b3 + hstep, voffB);
            if constexpr (GATHER) PG8_GSTAGE(PG8_SA(1, 0), g3, gX.x, gX.y); else PG8_STAGE(PG8_SA(1, 0), a3, voffA);
            PG8_WAIT_V(8); PG8_WAIT_L(0); PG8_BAR; PG8_MMA(1, 0, At, B0); PG8_MMA(1, 1, At, B1); PG8_BAR; PG8_SCHED;
            } else {
            PG8_LDB(B0, 0, 0); PG8_SCHED; PG8_LDA(At, 0, 0); PG8_STAGE(PG8_SA(1, 1), a1 + hstep, voffA);
            PG8_WAIT_L(8); PG8_BAR; PG8_WAIT_L(0); PG8_MMA(0, 0, At, B0); PG8_BAR; PG8_SCHED;
            PG8_LDB(B1, 0, 1); PG8_STAGE(PG8_SB(0, 0), b2, voffB);
            PG8_BAR; PG8_WAIT_L(0); PG8_MMA(0, 1, At, B1); PG8_BAR;
            PG8_LDA(At, 0, 1); PG8_STAGE(PG8_SA(0, 0), a2, voffA);
            PG8_BAR; PG8_WAIT_L(0); PG8_MMA(1, 0, At, B0); PG8_BAR; PG8_SCHED;
            PG8_STAGE(PG8_SB(0, 1), b2 + hstep, voffB);
            PG8_WAIT_V(6); PG8_BAR; PG8_MMA(1, 1, At, B1); PG8_BAR;
            PG8_LDB(B0, 1, 0); PG8_SCHED; PG8_LDA(At, 1, 0); PG8_STAGE(PG8_SA(0, 1), a2 + hstep, voffA);
            PG8_WAIT_L(8); PG8_BAR; PG8_WAIT_L(0); PG8_MMA(0, 0, At, B0); PG8_BAR; PG8_SCHED;
            PG8_LDB(B1, 1, 1); PG8_STAGE(PG8_SB(1, 0), b3, voffB);
            PG8_BAR; PG8_WAIT_L(0); PG8_MMA(0, 1, At, B1); PG8_BAR;
            PG8_LDA(At, 1, 1); PG8_STAGE(PG8_SA(1, 0), a3, voffA);
            PG8_BAR; PG8_WAIT_L(0); PG8_MMA(1, 0, At, B0); PG8_BAR; PG8_SCHED;
            PG8_STAGE(PG8_SB(1, 1), b3 + hstep, voffB);
            PG8_WAIT_V(6); PG8_BAR; PG8_MMA(1, 1, At, B1); PG8_BAR;
            }
        }
        if constexpr (ALIGN_EPI) { if (wr == 0) PG8_BAR; }
        if constexpr (FP8) asm volatile("s_nop 15\n\ts_nop 15\n\ts_nop 7" ::: "memory");
        E(acc, cur, wr, wc, fr, fq);
        if (!has_next) break;
#pragma unroll
        for (int a = 0; a < 2; ++a)
#pragma unroll
            for (int b = 0; b < 2; ++b)
#pragma unroll
                for (int m = 0; m < 4; ++m)
#pragma unroll
                    for (int n = 0; n < 2; ++n) acc[a][b][m][n] = (f32x4){0.f, 0.f, 0.f, 0.f};
        cur = nxt; cA = nA; cB = nB; ++ui; gC = gN;
        if constexpr (ALIGN_EPI) { if (wr == 1) PG8_BAR; }
    }
    PG8_WAIT_V(0);
    if constexpr (!ALIGN_EPI) { if (wr == 0) PG8_BAR; }
    PG8_BAR;
#undef PG8_SA
#undef PG8_SB
#undef PG8_STAGE
#undef PG8_GSTAGE
#undef PG8_LDA
#undef PG8_LDB
#undef PG8_MMA
#undef PG8_RD8
#undef PG8_WAIT_V
#undef PG8_WAIT_L
#undef PG8_BAR
#undef PG8_SCHED
}
}

namespace at {
constexpr int D = 128, NW = 8, QBLK = 32, KVBLK = 64;
constexpr float SCALE = 0.088388347648318440f;
constexpr float THR = 8.f;
constexpr int LDQ = INW, LDK = INW, LDO = DM;
constexpr size_t SHM_V = KVBLK * D * 2, SHM_K = KVBLK * D * 2, SHM_ATTN = 2 * SHM_V + 2 * SHM_K + NW * 64 * 4;
#define KSWZ(row, colB) ((row) * 256 + ((colB) ^ (((row) & 7) << 4)))
#define SBAR() __builtin_amdgcn_sched_barrier(0)
__device__ __forceinline__ int crow(int r, int hi) { return (r & 3) + 8 * (r >> 2) + 4 * hi; }
__device__ __forceinline__ unsigned cvtpk(float lo, float hi) { unsigned r; asm volatile("v_cvt_pk_bf16_f32 %0, %1, %2" : "=v"(r) : "v"(lo), "v"(hi)); return r; }

__device__ __forceinline__ void partialSM(f32x16& p0, f32x16& p1, float& m_reg, float& mn, float& alpha, bool domask, int dq, int hi) {
  constexpr float C = SCALE * 1.4426950408889634f;
  {
    if (domask) {
#pragma unroll
      for (int r = 0; r < 16; ++r) { const int d0 = dq + crow(r, hi), d1 = d0 + 32;
        if (d0 > 128 || d0 < -128) p0[r] = -1e30f;
        if (d1 > 128 || d1 < -128) p1[r] = -1e30f; }
    }
  }
  float pmax = p0[0]; for (int r = 1; r < 16; ++r) pmax = fmaxf(pmax, p0[r]); for (int r = 0; r < 16; ++r) pmax = fmaxf(pmax, p1[r]);
  { auto rr = __builtin_amdgcn_permlane32_swap(__float_as_uint(pmax), __float_as_uint(pmax), false, false);
    pmax = fmaxf(__uint_as_float(rr[0]), __uint_as_float(rr[1])); }
  if (__builtin_expect(__all(pmax - m_reg <= THR / SCALE), 1)) { mn = m_reg; alpha = 1.f; }
  else { mn = fmaxf(m_reg, pmax); alpha = __builtin_amdgcn_exp2f((m_reg - mn) * C); m_reg = mn; }
  float mnC = -mn * C;
  for (int r = 0; r < 16; ++r) p0[r] = fmaf(p0[r], C, mnC); for (int r = 0; r < 16; ++r) p1[r] = fmaf(p1[r], C, mnC);
  for (int r = 0; r < 16; ++r) p0[r] = __builtin_amdgcn_exp2f(p0[r]);
}
__device__ __forceinline__ void finishSM(f32x16& p0, f32x16& p1, float alpha, float& l_reg, bf16x8& pa0, bf16x8& pa1, bf16x8& pa2, bf16x8& pa3) {
  for (int r = 0; r < 16; ++r) p1[r] = __builtin_amdgcn_exp2f(p1[r]);
  float ps = 0; for (int r = 0; r < 16; ++r) ps += p0[r]; for (int r = 0; r < 16; ++r) ps += p1[r];
  { auto rr = __builtin_amdgcn_permlane32_swap(__float_as_uint(ps), __float_as_uint(ps), false, false);
    ps = __uint_as_float(rr[0]) + __uint_as_float(rr[1]); }
  l_reg = l_reg * alpha + ps;
#define PK4(P, BASE, OUT) do { unsigned a0 = cvtpk(P[BASE + 0], P[BASE + 1]), a1 = cvtpk(P[BASE + 2], P[BASE + 3]);   \
    unsigned b0 = cvtpk(P[BASE + 4], P[BASE + 5]), b1 = cvtpk(P[BASE + 6], P[BASE + 7]);                              \
    auto r0 = __builtin_amdgcn_permlane32_swap(a0, b0, false, false); auto r1 = __builtin_amdgcn_permlane32_swap(a1, b1, false, false); \
    u32x4 w = {r0[0], r1[0], r0[1], r1[1]}; OUT = *reinterpret_cast<bf16x8*>(&w); } while (0)
  PK4(p0, 0, pa0); PK4(p0, 8, pa1); PK4(p1, 0, pa2); PK4(p1, 8, pa3);
#undef PK4
}
__device__ __forceinline__ void qkt(f32x16& p0, f32x16& p1, const char* Ks, const bf16x8* qr, int ka0) {
  p0 = f32x16{}; p1 = f32x16{};
  asm volatile("" : "+v"(ka0));
#pragma unroll
  for (int d0 = 0; d0 < 8; ++d0) { const int off = ka0 ^ (d0 * 32);
    bf16x8 b0 = *reinterpret_cast<const bf16x8*>(Ks + off);
    bf16x8 b1 = *reinterpret_cast<const bf16x8*>(Ks + off + 32 * 256);
    p0 = __builtin_amdgcn_mfma_f32_32x32x16_bf16(b0, qr[d0], p0, 0, 0, 0);
    p1 = __builtin_amdgcn_mfma_f32_32x32x16_bf16(b1, qr[d0], p1, 0, 0, 0); }
}
__device__ __forceinline__ int v_st(int k, int c) { const int kk = (k & ~0xC) | ((k & 4) << 1) | ((k & 8) >> 1); return ((kk >> 3) * 4 + (c >> 5)) * 512 + ((kk & 7) * 32 + (c & 31)) * 2; }
__device__ __forceinline__ int v_rd_base(int lane) { return ((lane & 3) << 3) | (((lane >> 2) & 3) << 6) | (((lane >> 4) & 1) << 5) | (((lane >> 5) & 1) << 8); }
constexpr int v_rd_off(int d0, int ks, int half) { return d0 * 512 + ks * 4096 + half * 2048; }
template <int OFF> __device__ __forceinline__ s16x4 tr_read(int vb) {
  s16x4 r; asm volatile("ds_read_b64_tr_b16 %0, %1 offset:%2" : "=&v"(r) : "v"(vb), "i"(OFF) : "memory"); return r;
}
template <int D0> __device__ __forceinline__ void pv_one(f32x16& od, int vb, bf16x8 pa0, bf16x8 pa1, bf16x8 pa2, bf16x8 pa3) {
  const s16x4 l0 = tr_read<v_rd_off(D0, 0, 0)>(vb), h0 = tr_read<v_rd_off(D0, 0, 1)>(vb), l1 = tr_read<v_rd_off(D0, 1, 0)>(vb), h1 = tr_read<v_rd_off(D0, 1, 1)>(vb);
  const s16x4 l2 = tr_read<v_rd_off(D0, 2, 0)>(vb), h2 = tr_read<v_rd_off(D0, 2, 1)>(vb), l3 = tr_read<v_rd_off(D0, 3, 0)>(vb), h3 = tr_read<v_rd_off(D0, 3, 1)>(vb);
  asm volatile("s_waitcnt lgkmcnt(0)" ::: "memory"); SBAR();
#define PK(L, H) (bf16x8){L[0], L[1], L[2], L[3], H[0], H[1], H[2], H[3]}
  od = __builtin_amdgcn_mfma_f32_32x32x16_bf16(pa0, PK(l0, h0), od, 0, 0, 0);
  od = __builtin_amdgcn_mfma_f32_32x32x16_bf16(pa1, PK(l1, h1), od, 0, 0, 0);
  od = __builtin_amdgcn_mfma_f32_32x32x16_bf16(pa2, PK(l2, h2), od, 0, 0, 0);
  od = __builtin_amdgcn_mfma_f32_32x32x16_bf16(pa3, PK(l3, h3), od, 0, 0, 0);
#undef PK
}
__device__ __forceinline__ void pv_d0(f32x16* o, int vb, bf16x8 pa0, bf16x8 pa1, bf16x8 pa2, bf16x8 pa3) {
  pv_one<0>(o[0], vb, pa0, pa1, pa2, pa3); pv_one<1>(o[1], vb, pa0, pa1, pa2, pa3); pv_one<2>(o[2], vb, pa0, pa1, pa2, pa3); pv_one<3>(o[3], vb, pa0, pa1, pa2, pa3);
}

__device__ __forceinline__ void attn_body(const bf16_t* __restrict__ Qb, const bf16_t* __restrict__ Kb, const bf16_t* __restrict__ Vb, bf16_t* __restrict__ Ob,
                                          int NT, int kskip, int qpos0, float m0, float l0, bool maskon, char* lds) {
  const int tid = opaque_tid(), wid = tid >> 6, lane = tid & 63, r32 = lane & 31, hi = lane >> 5;
  char* V_lds = lds; char* K_lds = lds + 2 * SHM_V;
  float* ws = (float*)(lds + 2 * SHM_V + 2 * SHM_K) + wid * 64; float* li_l = ws; float* al_l = ws + 32;
  float m_reg = m0, l_reg = l0; f32x16 o[4] = {}; bf16x8 qr[8];
  const bf16_t* Qw = Qb + (long)(wid * QBLK + r32) * LDQ + hi * 8;
#pragma unroll
  for (int d0 = 0; d0 < 8; ++d0) qr[d0] = *reinterpret_cast<const bf16x8*>(Qw + d0 * 16);
  const int sr = tid >> 4, sc = (tid & 15) * 8, vst0 = v_st(sr, sc), kst0 = KSWZ(sr, sc * 2);
  const int vb0 = (int)(uintptr_t)V_lds + v_rd_base(lane);
  const int qpos = qpos0 + wid * QBLK + r32;
  const int ka0 = r32 * 256 + ((hi * 16) ^ ((r32 & 7) << 4));
  const unsigned goff0 = (unsigned)(sr * LDK + sc) * 2u, goff1 = goff0 + 32u * LDK * 2u;
  struct { bf16x8 vs0, vs1, ks0, ks1; } sr_[1];
#define TROW(jt) ((long)(jt) * KVBLK + ((jt) >= 4 ? kskip : 0))
#define SLOAD(i, jt) do { const long _k0 = TROW(jt) * (LDK * 2); const char* _kp = (const char*)Kb + _k0; const char* _vp = (const char*)Vb + _k0; \
    sr_[i].vs0 = *reinterpret_cast<const bf16x8*>(_vp + goff0); sr_[i].vs1 = *reinterpret_cast<const bf16x8*>(_vp + goff1); \
    sr_[i].ks0 = *reinterpret_cast<const bf16x8*>(_kp + goff0); sr_[i].ks1 = *reinterpret_cast<const bf16x8*>(_kp + goff1); } while (0)
#define SWRITE(b, i) do { *(bf16x8*)(V_lds + (b) * SHM_V + vst0) = sr_[i].vs0;          \
    *(bf16x8*)(V_lds + (b) * SHM_V + vst0 + 8192) = sr_[i].vs1;                         \
    *(bf16x8*)(K_lds + (b) * SHM_K + kst0) = sr_[i].ks0;                               \
    *(bf16x8*)(K_lds + (b) * SHM_K + kst0 + 8192) = sr_[i].ks1; } while (0)
#define SWAIT() asm volatile("s_waitcnt vmcnt(0)" ::: "memory")
#define RESC(a) do { if (__any((a) < 1.f)) { if (hi == 0) al_l[r32] = (a); asm volatile("s_waitcnt lgkmcnt(0)" ::: "memory"); \
    for (int d = 0; d < 4; ++d) for (int r = 0; r < 16; ++r) o[d][r] *= al_l[crow(r, hi)]; } } while (0)
#define DQ(jt) (kskip + ((jt) - 4) * KVBLK - qpos)
  f32x16 pA0, pA1, pB0, pB1; float mnA, mnB, alA, alB; bf16x8 pa0, pa1, pa2, pa3;
  constexpr int SE = 0, SO = 0;
  SLOAD(SE, 0); asm volatile("s_waitcnt vmcnt(0)" ::: "memory"); SWRITE(0, SE); __syncthreads();
  qkt(pA0, pA1, K_lds, qr, ka0); partialSM(pA0, pA1, m_reg, mnA, alA, false, 0, hi);
  SLOAD(SO, 1);
  SWAIT(); SWRITE(1, SO); __syncthreads();
  for (int j = 1; j + 1 < NT; j += 2) {
    SBAR(); qkt(pB0, pB1, K_lds + SHM_K, qr, ka0);
    finishSM(pA0, pA1, alA, l_reg, pa0, pa1, pa2, pa3); SBAR();
    SLOAD(SO, j + 1); SBAR();
    pv_d0(o, vb0, pa0, pa1, pa2, pa3); partialSM(pB0, pB1, m_reg, mnB, alB, maskon && j >= 4, DQ(j), hi);
    __syncthreads(); SWAIT(); SWRITE(0, SE);
    RESC(alB); __syncthreads();
    SBAR(); qkt(pA0, pA1, K_lds, qr, ka0);
    finishSM(pB0, pB1, alB, l_reg, pa0, pa1, pa2, pa3); SBAR();
    SLOAD(SE, j + 2); SBAR();
    pv_d0(o, vb0 + (int)SHM_V, pa0, pa1, pa2, pa3); partialSM(pA0, pA1, m_reg, mnA, alA, maskon && j + 1 >= 4, DQ(j + 1), hi);
    __syncthreads(); SWAIT(); SWRITE(1, SO);
    RESC(alA); __syncthreads();
  }
  SBAR(); qkt(pB0, pB1, K_lds + SHM_K, qr, ka0);
  finishSM(pA0, pA1, alA, l_reg, pa0, pa1, pa2, pa3); SBAR();
  pv_d0(o, vb0, pa0, pa1, pa2, pa3); partialSM(pB0, pB1, m_reg, mnB, alB, maskon && NT - 1 >= 4, DQ(NT - 1), hi);
  __syncthreads(); RESC(alB);
  finishSM(pB0, pB1, alB, l_reg, pa0, pa1, pa2, pa3); SBAR();
  pv_d0(o, vb0 + (int)SHM_V, pa0, pa1, pa2, pa3);
  if (hi == 0) li_l[r32] = l_reg; asm volatile("s_waitcnt lgkmcnt(0)" ::: "memory");
  float rli[16];
#pragma unroll
  for (int r = 0; r < 16; ++r) rli[r] = __builtin_amdgcn_rcpf(li_l[crow(r, hi)]);
  bf16_t* Ow = Ob + (long)(wid * QBLK) * LDO;
#pragma unroll
  for (int r = 0; r < 16; ++r) { int orow = crow(r, hi);
    for (int d0 = 0; d0 < 4; ++d0) Ow[(long)orow * LDO + d0 * 32 + r32] = (bf16_t)f2bf(o[d0][r] * rli[r]); }
#undef TROW
#undef SLOAD
#undef SWRITE
#undef SWAIT
#undef RESC
#undef DQ
}
}

struct Args { const float* in[23]; float* out; unsigned char* ws; int ph_lo, ph_hi; };
enum { IN_X = 0, IN_C, IN_CTX, IN_CCTX, IN_WMOD, IN_BMOD, IN_N1G, IN_N2G, IN_WIN, IN_QNA, IN_KNA, IN_SINK, IN_VNB, IN_WS, IN_BS, IN_QNC, IN_KNC, IN_OUTG, IN_WOUT, IN_WR, IN_WG, IN_WU, IN_WDN };

#define PHASE_IDS(F) const int tid = opaque_tid(), lane = tid & 63, wave = __builtin_amdgcn_readfirstlane(tid >> 6), gw = (int)blockIdx.x * 8 + wave, NGW = (F).G * 8; (void)lane; (void)wave; (void)gw; (void)NGW
constexpr int ARGTAB_OFF = LDSCTL_OFF + 1024;
#define INP(F, i) ld_inp((F).lds, (i))
__device__ __forceinline__ const float* ld_inp(LAS unsigned char* lds, int i) {
    unsigned a = (unsigned)(uintptr_t)(lds + ARGTAB_OFF) + 8u * (unsigned)i;
    asm volatile("" : "+v"(a));
    const volatile LAS unsigned* t = (const volatile LAS unsigned*)(uintptr_t)a;
    const unsigned lo = __builtin_amdgcn_readfirstlane(t[0]), hi = __builtin_amdgcn_readfirstlane(t[1]);
    return (const float*)(const GAS float*)(((unsigned long long)hi << 32) | lo);
}
struct Frame {
    LAS unsigned char* lds; char* ldsg;
    volatile LAS unsigned* MISC;
    unsigned* ctl;
    int G;
    float* out; unsigned char* ws;
};

__host__ __device__ __forceinline__ int headpos(int d) { return 32 * (2 * (d >> 6) + ((d >> 4) & 1)) + 8 * ((d >> 2) & 3) + 4 * ((d >> 5) & 1) + (d & 3); }
template <bool HEADPERM = false>
__device__ __forceinline__ void transpose_item(const float* W, int N, bf16_t* WT, int k0, int n0, int drow0, LAS float* scr, int lane) {
    { float t[32]; const float* wp = W + (size_t)(k0 + (lane >> 5)) * N + n0 + (lane & 31);
#pragma unroll
      for (int i = 0; i < 32; ++i) t[i] = wp[(size_t)(2 * i) * N];
#pragma unroll
      for (int i = 0; i < 32; ++i) scr[(2 * i + (lane >> 5)) * 33 + (lane & 31)] = t[i]; }
    LDS_WAIT(); asm volatile("" ::: "memory");
    const int c = lane & 7;
#pragma unroll
    for (int j = 0; j < 4; ++j) { const int n = (lane >> 3) + 8 * j; const LAS float* s = scr + (8 * c) * 33 + n;
        u32x4 o; o.x = pk2(s[0 * 33], s[1 * 33]); o.y = pk2(s[2 * 33], s[3 * 33]); o.z = pk2(s[4 * 33], s[5 * 33]); o.w = pk2(s[6 * 33], s[7 * 33]);
        const int drow = HEADPERM ? ((drow0 + n) & ~127) + headpos((drow0 + n) & 127) : drow0 + n;
        *(u32x4*)(WT + (size_t)drow * DM + k0 + 8 * c) = o; }
    LDS_WAIT(); asm volatile("" ::: "memory");
}

__device__ __forceinline__ void transpose_item8(const float* W, int N, unsigned char* WT, int k0, int n0, int drow0, LAS float* scr, int lane) {
    { float t[32]; const float* wp = W + (size_t)(k0 + (lane >> 5)) * N + n0 + (lane & 31);
#pragma unroll
      for (int i = 0; i < 32; ++i) t[i] = wp[(size_t)(2 * i) * N];
#pragma unroll
      for (int i = 0; i < 32; ++i) scr[(2 * i + (lane >> 5)) * 33 + (lane & 31)] = t[i]; }
    LDS_WAIT(); asm volatile("" ::: "memory");
    const int c = lane & 7;
#pragma unroll
    for (int j = 0; j < 4; ++j) { const int n = (lane >> 3) + 8 * j; const LAS float* s = scr + (8 * c) * 33 + n;
        u32x2 o; o.x = pk4_fp8(s[0 * 33] * W8_SCALE, s[1 * 33] * W8_SCALE, s[2 * 33] * W8_SCALE, s[3 * 33] * W8_SCALE); o.y = pk4_fp8(s[4 * 33] * W8_SCALE, s[5 * 33] * W8_SCALE, s[6 * 33] * W8_SCALE, s[7 * 33] * W8_SCALE);
        *(u32x2*)(WT + (size_t)(drow0 + n) * DM + k0 + 8 * c) = o; }
    LDS_WAIT(); asm volatile("" ::: "memory");
}
__device__ __forceinline__ void phase_prologue(Frame& F) {
    PHASE_IDS(F);
    static_assert(FP8_L0 && FP8_L1, "the prologue writes the experts' weights as fp8");
    {
        constexpr int NT8 = 2 * NE * 3 * 128;
        struct T8 { const float* src; unsigned char* dst; int which; };
#define P8_DESC(d, tl) do { const int mat = (tl) >> 7, kb = ((tl) & 127) >> 3, nb = (tl) & 7, le = mat / 3, wh = mat % 3; d.which = wh; \
        d.src = INP(F, wh == 0 ? IN_WG : wh == 1 ? IN_WU : IN_WDN) + (size_t)le * DM * DM + (size_t)(128 * kb) * DM + 256 * nb; \
        d.dst = (wh < 2) ? F.ws + WS_WGU + (size_t)(le / NE) * NE * 4096 * DM * 2 + (size_t)(le % NE) * 4096 * DM + (size_t)(2 * nb) * 256 * DM + 128 * kb \
                         : F.ws + WS_WD + (size_t)(le / NE) * NE * DM * DM * 2 + (size_t)(le % NE) * DM * DM + (size_t)(256 * nb) * DM + 128 * kb; } while (0)
#define P8_LOAD(d, t) do { const float* wp = d.src + (size_t)(16 * wave) * DM + 4 * lane; _Pragma("unroll") for (int q = 0; q < 16; ++q) t[q] = __builtin_nontemporal_load((const f32x4*)(wp + (size_t)q * DM)); } while (0)
        T8 cur, nxt; f32x4 t0[16], t1[16];
        int tl = blockIdx.x, par = 0;
        if (tl < NT8) { P8_DESC(cur, tl); P8_LOAD(cur, t0); }
        for (; tl < NT8; tl += F.G, par ^= 1) {
            const bool has = tl + F.G < NT8;
            if (has) { P8_DESC(nxt, tl + F.G); P8_LOAD(nxt, t1); }
            LAS unsigned* img = (LAS unsigned*)(F.lds + par * 32768);
#pragma unroll
            for (int it = 0; it < 4; ++it)
#pragma unroll
                for (int j = 0; j < 4; ++j) { const int n = 4 * lane + j, d = 4 * wave + it;
                    img[n * 32 + (d ^ (lane & 31))] = pk4_fp8(t0[4 * it + 0][j] * W8_SCALE, t0[4 * it + 1][j] * W8_SCALE, t0[4 * it + 2][j] * W8_SCALE, t0[4 * it + 3][j] * W8_SCALE); }
            __syncthreads();
#pragma unroll
            for (int q = 0; q < 4; ++q) { const int ch = tid + 512 * q, n = ch >> 3, g = ch & 7, sw = (n >> 2) & 31;
                u32x4 o; o.x = img[n * 32 + ((4 * g + 0) ^ sw)]; o.y = img[n * 32 + ((4 * g + 1) ^ sw)]; o.z = img[n * 32 + ((4 * g + 2) ^ sw)]; o.w = img[n * 32 + ((4 * g + 3) ^ sw)];
                const int drow = (cur.which < 2) ? (n >> 7) * 256 + cur.which * 128 + (n & 127) : n;
                *(u32x4*)(cur.dst + (size_t)drow * DM + 16 * g) = o; }
            if (has) { cur = nxt;
#pragma unroll
                for (int q = 0; q < 16; ++q) t0[q] = t1[q]; }
        }
#undef P8_DESC
#undef P8_LOAD
        __syncthreads();
    }
    LAS float* scr = (LAS float*)(F.lds + wave * 16384);
    constexpr int I_IN = 32 * (INW / 32), I_SQ = 32 * (DM / 32);
    constexpr int NIT = 2 * I_IN + 2 * I_SQ;
    struct TItem { const float* src; unsigned char* dst; int N, drow0, mode; };
#define P0_DESC(d, itv) do { int r = (itv); \
        if (r < 2 * I_IN) { const int l = r / I_IN; r %= I_IN; const int kb = r / (INW / 32), nb = r % (INW / 32); \
            d.src = INP(F, IN_WIN) + (size_t)l * DM * INW + (size_t)(64 * kb) * INW + 32 * nb; d.dst = F.ws + WS_WIN + (size_t)l * INW * DM * 2 + 128 * kb; d.N = INW; d.drow0 = 32 * nb; d.mode = 1; } \
        else { r -= 2 * I_IN; const int l = r / I_SQ; r %= I_SQ; const int kb = r / 64, nb = r % 64; \
            d.src = INP(F, IN_WOUT) + (size_t)l * DM * DM + (size_t)(64 * kb) * DM + 32 * nb; d.dst = F.ws + WS_WOUT + (size_t)l * DM * DM * 2 + 128 * kb; d.N = DM; d.drow0 = 32 * nb; d.mode = 0; } } while (0)
#define P0_LOAD(d, t) do { const float* wp = d.src + (size_t)(lane >> 3) * d.N + (lane & 7) * 4; _Pragma("unroll") for (int i = 0; i < 8; ++i) t[i] = *(const f32x4*)(wp + (size_t)(8 * i) * d.N); } while (0)
    for (int it = gw; it < NIT; it += NGW) {
        TItem cur; f32x4 t0[8];
        P0_DESC(cur, it); P0_LOAD(cur, t0);
#pragma unroll
        for (int i = 0; i < 8; ++i) { LAS float* sp = scr + (8 * i + (lane >> 3)) * 33 + (lane & 7) * 4; sp[0] = t0[i].x; sp[1] = t0[i].y; sp[2] = t0[i].z; sp[3] = t0[i].w; }
        LDS_WAIT(); asm volatile("" ::: "memory");
        const int c = lane & 7;
#pragma unroll
        for (int j = 0; j < 4; ++j) { const int n = (lane >> 3) + 8 * j; const LAS float* sp = scr + (8 * c) * 33 + n;
            float v[8];
#pragma unroll
            for (int q = 0; q < 8; ++q) v[q] = sp[q * 33];
            int drow = cur.drow0 + n; if (cur.mode == 1) drow = (drow & ~127) + headpos(drow & 127);
            u32x4 o; o.x = pk2(v[0], v[1]); o.y = pk2(v[2], v[3]); o.z = pk2(v[4], v[5]); o.w = pk2(v[6], v[7]); *(u32x4*)(cur.dst + (size_t)drow * DM * 2 + 16 * c) = o; }
        LDS_WAIT(); asm volatile("" ::: "memory");
    }
#undef P0_DESC
#undef P0_LOAD
    __syncthreads();
    {
        LAS float* sil = (LAS float*)F.lds;
        LAS float* red = (LAS float*)(F.lds + 40960);
        bool have = false;
        for (int it = blockIdx.x; it < 2 * 96; it += F.G) {
            if (!have) {
                { const float* cp = INP(F, IN_C); const float* ccp = INP(F, IN_CCTX);
                for (int i = tid; i < 5 * DM; i += 512) { const int s = i / DM, k = i % DM; const float cv = (s < 4) ? cp[s * DM + k] : ccp[k]; sil[i] = cv / (1.f + __expf(-cv)); } }
                have = true; __syncthreads();
            }
            const int l = it / 96, cb = it % 96, c4 = tid & 31, kr = tid >> 5;
            const float* wp = INP(F, IN_WMOD) + (size_t)l * DM * NMOD + (size_t)cb * 128 + c4 * 4;
            f32x4 a[5];
#pragma unroll
            for (int s = 0; s < 5; ++s) a[s] = (f32x4){0.f, 0.f, 0.f, 0.f};
#pragma unroll 8
            for (int k = kr; k < DM; k += 16) { const f32x4 w = *(const f32x4*)(wp + (size_t)k * NMOD);
#pragma unroll
                for (int s = 0; s < 5; ++s) a[s] += w * sil[s * DM + k]; }
#pragma unroll
            for (int s = 0; s < 5; ++s) *(LAS f32x4*)(red + (kr * 5 + s) * 128 + c4 * 4) = a[s];
            __syncthreads();
            const float* bmod = INP(F, IN_BMOD);
            for (int i = tid; i < 5 * 128; i += 512) { const int s = i / 128, cc = i % 128; float sum = 0.f;
#pragma unroll
                for (int q = 0; q < 16; ++q) sum += red[(q * 5 + s) * 128 + cc];
                ((float*)(F.ws + WS_MOD))[(size_t)(l * 5 + s) * NMOD + cb * 128 + cc] = sum + bmod[l * NMOD + cb * 128 + cc]; }
            __syncthreads();
        }
    }
    if ((int)blockIdx.x >= F.G - 9 && (int)blockIdx.x < F.G - 1) {
        const float* wr = INP(F, IN_WR); bf16_t* wf = (bf16_t*)(F.ws + WS_WRS); const int part = (int)blockIdx.x - (F.G - 9);
        for (int i = part * 512 + tid; i < 2 * DM * NE; i += 8 * 512) { const int l = i / (DM * NE), rem = i % (DM * NE), k = rem >> 4, e = rem & 15;
            const float w = wr[i]; const unsigned hi = f2bf(w); const unsigned lo = f2bf(w - __builtin_bit_cast(float, hi << 16));
            const int sidx = k >> 5, q = (k >> 3) & 3, j = k & 7; bf16_t* dst = wf + ((size_t)(l * 64 + sidx) * 2 * 64 + (q * 16 + e)) * 8 + j;
            dst[0] = (bf16_t)hi; dst[64 * 8] = (bf16_t)lo; }
    }
    if (blockIdx.x == F.G - 1) {
        for (int i = tid; i < 64 * 32; i += 512) {
            const int pos = i >> 5, f = i & 31;
            double inv = 1.0; for (int q = 0; q < f; ++q) inv *= 0.7498942093324559;
            const double a = (double)pos * inv;
            const double n = __builtin_rint(a * 0.6366197723675814);
            const double r = (a - n * 1.5707963267948966) - n * 6.123233995736766e-17;
            const double r2 = r * r;
            double sn = r * (1.0 + r2 * (-1.0 / 6 + r2 * (1.0 / 120 + r2 * (-1.0 / 5040 + r2 * (1.0 / 362880 + r2 * (-1.0 / 39916800 + r2 * (1.0 / 6227020800.0)))))));
            double cn = 1.0 + r2 * (-0.5 + r2 * (1.0 / 24 + r2 * (-1.0 / 720 + r2 * (1.0 / 40320 + r2 * (-1.0 / 3628800 + r2 * (1.0 / 479001600 + r2 * (-1.0 / 87178291200.0)))))));
            const int q = ((int)n) & 3; double cs, ss;
            if (q == 0) { cs = cn; ss = sn; } else if (q == 1) { cs = -sn; ss = cn; } else if (q == 2) { cs = -cn; ss = -sn; } else { cs = sn; ss = -cn; }
            ((float*)(F.ws + WS_ROPE))[2 * i] = (float)cs; ((float*)(F.ws + WS_ROPE))[2 * i + 1] = (float)ss;
        }
    }
}

__device__ __forceinline__ void load_row(const float* row, int lane, f32x4 (&v)[8]) {
#pragma unroll
    for (int j = 0; j < 8; ++j) v[j] = *(const f32x4*)(row + 4 * lane + 256 * j);
}
__device__ __forceinline__ void norm_mod_store(const f32x4 (&v)[8], const float* g, const float* shift, const float* scale, bf16_t* dst, int lane) {
    float ss = 0.f;
#pragma unroll
    for (int j = 0; j < 8; ++j) ss += (v[j].x * v[j].x + v[j].y * v[j].y) + (v[j].z * v[j].z + v[j].w * v[j].w);
    const float rinv = rsqrt_fast(wave_sum(ss) * (1.f / DM) + EPS);
#pragma unroll
    for (int j = 0; j < 8; ++j) { const int c = 4 * lane + 256 * j;
        const f32x4 gg = *(const f32x4*)(g + c), sh = *(const f32x4*)(shift + c), sc = *(const f32x4*)(scale + c);
        const f32x4 y = (v[j] * rinv) * gg * (sc + 1.f) + sh;
        u32x2 w; w.x = pk2(y.x, y.y); w.y = pk2(y.z, y.w); *(u32x2*)(dst + c) = w; }
}

__device__ __forceinline__ void phase_rowpass1_l0(Frame& F) {
    PHASE_IDS(F);
    const float* mod = (const float*)(F.ws + WS_MOD);
    { const float* n2 = INP(F, IN_N2G); float* gs = (float*)(F.ws + WS_GS2);
      for (int i = (int)blockIdx.x * 512 + tid; i < 2 * 5 * DM; i += F.G * 512) { const int l = i / (5 * DM), sv = (i / DM) % 5, k = i % DM;
          const float* m = mod + (size_t)(l * 5 + sv) * NMOD; gs[2 * i] = n2[l * DM + k] * (1.f + m[4 * DM + k]); gs[2 * i + 1] = m[3 * DM + k]; } }
    const float* xin = INP(F, IN_X); const float* cin = INP(F, IN_CTX); const float* n1g = INP(F, IN_N1G);
#define P1_SRC(rr) ((((rr) % TPB) < CTXL) ? cin + ((size_t)((rr) / TPB) * CTXL + ((rr) % TPB)) * DM : xin + ((size_t)((rr) / TPB) * SEQ + (((rr) % TPB) - CTXL)) * DM)
    f32x4 v[8], vn[8];
    int r = gw;
    if (r < NTOK) load_row(P1_SRC(r), lane, v);
    while (r < NTOK) {
        const int rn = r + NGW;
        if (rn < NTOK) load_row(P1_SRC(rn), lane, vn);
        const int b = r / TPB, t = r % TPB, s = (t < CTXL) ? 4 : b;
        norm_mod_store(v, n1g, mod + (size_t)s * NMOD, mod + (size_t)s * NMOD + DM, (bf16_t*)(F.ws + WS_HN) + (size_t)r * DM, lane);
#pragma unroll
        for (int j = 0; j < 8; ++j) v[j] = vn[j];
        r = rn;
    }
#undef P1_SRC
}

__device__ __forceinline__ void post_unpack(const u32x4 x, float (&v)[8]) {
    v[0] = bflo(x.x); v[1] = bfhi(x.x); v[2] = bflo(x.y); v[3] = bfhi(x.y); v[4] = bflo(x.z); v[5] = bfhi(x.z); v[6] = bflo(x.w); v[7] = bfhi(x.w); }
__device__ __forceinline__ float sum16(float v) { return row16_sum(v); }
__device__ __forceinline__ void phase_post(Frame& F, int l) {
    PHASE_IDS(F);
    bf16_t* P = (bf16_t*)(F.ws + WS_P);
    const float* rope = (const float*)(F.ws + WS_ROPE);
    const int i16 = lane & 15, hq = lane >> 4; const bool hi2 = hq >= 2;
    const float* qna = INP(F, IN_QNA) + l * 128 + 8 * i16; const float* kna = INP(F, IN_KNA) + l * 128 + 8 * i16;
    const float* qnc = INP(F, IN_QNC) + l * 128 + 8 * i16; const float* knc = INP(F, IN_KNC) + l * 128 + 8 * i16;
    const float* vnb = INP(F, IN_VNB) + l * 512 + 8 * i16;
    for (int r = gw; r < NTOK; r += NGW) {
        const int t = r % TPB; const bool lat = t >= CTXL;
        u32x4* rp = (u32x4*)(P + (size_t)r * INW) + lane;
        u32x4 x[7];
#pragma unroll
        for (int j = 0; j < 7; ++j) x[j] = rp[64 * j];
        const int pos = lat ? t - CTXL : 0, pp = (i16 < 8) ? (pos >> 6) : (pos & 63);
        const f32x4* cs = (const f32x4*)(rope + 2 * (pp * 32 + 8 * (i16 & 3)));
        const f32x4 c0 = cs[0], c1 = cs[1], c2 = cs[2], c3 = cs[3];
        const float cosv[8] = {c0.x, c0.z, c1.x, c1.z, c2.x, c2.z, c3.x, c3.z}, sinv[8] = {c0.y, c0.w, c1.y, c1.w, c2.y, c2.w, c3.y, c3.w};
        const float sgn = (i16 & 4) ? 1.f : -1.f;
#pragma unroll
        for (int j = 0; j < 7; ++j) {
            const bool gelu_lo = (j == 3 || j == 4), gelu_hi = (j == 2 || j == 3);
            const bool norm_lo = (j != 2 && j != 3), norm_hi = (j != 2 && j != 6);
            const bool rope_lo = (j == 0 || j == 1 || j == 5 || j == 6), rope_hi = (j == 0 || j == 1 || j == 4 || j == 5);
            const bool dg = hi2 ? gelu_hi : gelu_lo, dn = hi2 ? norm_hi : norm_lo, dr = (hi2 ? rope_hi : rope_lo) && lat;
            if (!(gelu_lo || gelu_hi || norm_lo || norm_hi)) continue;
            float v[8]; post_unpack(x[j], v);
            if (gelu_lo || gelu_hi) {
#pragma unroll
                for (int e = 0; e < 8; ++e) { const float gv = gelu_tanh(v[e]); v[e] = dg ? gv : v[e]; } }
            if (norm_lo || norm_hi) {
                float ss = 0.f;
#pragma unroll
                for (int e = 0; e < 8; ++e) ss += v[e] * v[e];
                const float rinv = rsqrt_fast(sum16(ss) * (1.f / 128) + EPS);
                const float* gp;
                if (j == 0) gp = qna; else if (j == 1) gp = hi2 ? kna : qna; else if (j == 3) gp = vnb + (hi2 ? hq - 2 : 0) * 128; else if (j == 4) gp = hi2 ? qnc : vnb + (2 + hq) * 128;
                else if (j == 5) gp = qnc; else gp = knc;
                const f32x4 g0 = *(const f32x4*)gp, g1 = *(const f32x4*)(gp + 4);
                const float gg[8] = {g0.x, g0.y, g0.z, g0.w, g1.x, g1.y, g1.z, g1.w};
#pragma unroll
                for (int e = 0; e < 8; ++e) v[e] = dn ? v[e] * rinv * gg[e] : v[e];
            }
            if (rope_lo || rope_hi) {
#pragma unroll
                for (int e = 0; e < 8; ++e) { const float o = __builtin_bit_cast(float, __builtin_amdgcn_ds_swizzle(__builtin_bit_cast(int, v[e]), 0x101F)); const float rv = v[e] * cosv[e] + sgn * o * sinv[e]; v[e] = dr ? rv : v[e]; } }
            u32x4 w; w.x = pk2(v[0], v[1]); w.y = pk2(v[2], v[3]); w.z = pk2(v[4], v[5]); w.w = pk2(v[6], v[7]);
            rp[64 * j] = w;
        }
    }
}

__device__ __forceinline__ void mixer_b_unit(Frame& F, int l, int b, int ch, int g) {
    PHASE_IDS(F);
    const bf16_t* P = (const bf16_t*)(F.ws + WS_P); bf16_t* O = (bf16_t*)(F.ws + WS_O);
    const int row0 = b * TPB + ch * 128, w = wave;
    LAS bf16_t* VT = (LAS bf16_t*)F.lds;
    { const int q = tid >> 2, dp = (tid & 3) * 32; const bf16_t* src = P + (size_t)(row0 + q) * INW + C_VB + g * 128 + dp;
#pragma unroll
      for (int i = 0; i < 4; ++i) { const u32x4 x = *(const u32x4*)(src + 8 * i); const unsigned xs[4] = {x.x, x.y, x.z, x.w};
#pragma unroll
          for (int j = 0; j < 4; ++j) { VT[(dp + 8 * i + 2 * j) * 136 + q] = (bf16_t)(xs[j] & 0xffffu); VT[(dp + 8 * i + 2 * j + 1) * 136 + q] = (bf16_t)(xs[j] >> 16); } } }
    __syncthreads();
    const int i15 = lane & 15, kq = lane >> 4;
    f32x4 acc[8];
#pragma unroll
    for (int n = 0; n < 8; ++n) acc[n] = (f32x4){0.f, 0.f, 0.f, 0.f};
    const float* wsr = INP(F, IN_WS) + ((size_t)(l * 4 + g) * 128 + 16 * w + i15) * 128;
#pragma unroll
    for (int s = 0; s < 4; ++s) {
        const f32x4 a0 = *(const f32x4*)(wsr + 32 * s + 8 * kq), a1 = *(const f32x4*)(wsr + 32 * s + 8 * kq + 4);
        u32x4 aw; aw.x = pk2(a0.x, a0.y); aw.y = pk2(a0.z, a0.w); aw.z = pk2(a1.x, a1.y); aw.w = pk2(a1.z, a1.w);
        const bf16x8 af = *reinterpret_cast<bf16x8*>(&aw);
#pragma unroll
        for (int n = 0; n < 8; ++n) { const bf16x8 bfr = *(const LAS bf16x8*)(VT + (16 * n + i15) * 136 + 32 * s + 8 * kq);
            acc[n] = __builtin_amdgcn_mfma_f32_16x16x32_bf16(af, bfr, acc[n], 0, 0, 0); }
    }
#pragma unroll
    for (int j = 0; j < 4; ++j) { const int p = 16 * w + kq * 4 + j; const float bias = INP(F, IN_BS)[(l * 4 + g) * 128 + p];
        const bf16_t* up = P + (size_t)(row0 + p) * INW + C_UB + g * 128; bf16_t* op = O + (size_t)(row0 + p) * DM + O_B + g * 128;
#pragma unroll
        for (int n = 0; n < 8; ++n) { const int d = 16 * n + i15; op[d] = (bf16_t)f2bf(bf2f(up[d]) * (acc[n][j] + bias)); } }
    __syncthreads();
}
__device__ __forceinline__ void phase_mixers(Frame& F, int l) {
    PHASE_IDS(F);
    const bf16_t* P = (const bf16_t*)(F.ws + WS_P); bf16_t* O = (bf16_t*)(F.ws + WS_O);
    const bool ctx = (l == 0);
    const int nC = 48, nA = 48, nCc = ctx ? 3 : 0, nAc = ctx ? 3 : 0, nB = 68;
    const int total = nC + nA + nCc + nAc + nB;
    for (int kq = 0; kq < 8; ++kq) {
        const int x = ((int)blockIdx.x + kq) & 7, b = x >> 1, kv = x & 1;
        unsigned* qctr = F.ctl + CW_QUEUE + 64 * (l * 8 + x);
        for (;;) {
            if (tid == 0) F.MISC[0] = xb_add(qctr, 1u);
            __syncthreads();
            int u = (int)F.MISC[0];
            __syncthreads();
            if (u >= total) break;
            if (u < nC + nA + nCc + nAc) {
                int kind, h, qb = 0;
                if (u < nC) { kind = 0; h = kv * 3 + u / 16; qb = u % 16; }
                else if (u < nC + nA) { const int v = u - nC; kind = 1; h = kv * 3 + v / 16; qb = v % 16; }
                else if (u < nC + nA + nCc) { kind = 2; h = kv * 3 + (u - nC - nA); }
                else { kind = 3; h = kv * 3 + (u - nC - nA - nCc); }
                const int isA = kind & 1, lat = (kind < 2);
                const size_t r0 = (size_t)b * TPB, rq = r0 + (lat ? CTXL + qb * 256 : 0);
                const int q0 = qb * 256, ks = (kind == 1) ? ((q0 - 128 < 0) ? 0 : q0 - 128) : 0, ke = (q0 + 384 > SEQ) ? SEQ : q0 + 384;
                const int NT = (kind == 0) ? 68 : (kind == 1) ? 4 + (ke - ks) / 64 : 4;
                const float sink = INP(F, IN_SINK)[l * 6 + h];
                const int cq = (isA ? C_QA : C_QC) + h * 128, ck = (isA ? C_KA : C_KC) + kv * 128, cv = (isA ? C_VA : C_VC) + kv * 128, co = (isA ? O_A : O_C) + h * 128;
                at::attn_body(P + rq * INW + cq, P + r0 * INW + ck, P + r0 * INW + cv, O + rq * DM + co, NT, ks, q0, isA ? sink / at::SCALE : -1e30f, isA ? 1.f : 0.f, kind == 1, F.ldsg);
                continue; }
            u -= nC + nA + nCc + nAc;
            { const int ch = u >> 1, g = kv * 2 + (u & 1);
              if (!ctx && ch < 2) continue;
              mixer_b_unit(F, l, b, ch, g); }
        }
    }
}

__device__ __forceinline__ void phase_groupnorm(Frame& F, int l) {
    PHASE_IDS(F);
    bf16_t* O = (bf16_t*)(F.ws + WS_O); const float* og = INP(F, IN_OUTG) + l * DM;
#define GN_SKIP(rr) (l == 1 && ((rr) % TPB) < CTXL)
#define GN_LOAD(rr, xx) do { const bf16_t* _row = O + (size_t)(rr) * DM; \
        _Pragma("unroll") for (int i = 0; i < 3; ++i) { xx[i] = *(const u32x2*)(_row + O_A + 12 * lane + 4 * i); xx[5 + i] = *(const u32x2*)(_row + O_C + 12 * lane + 4 * i); } \
        _Pragma("unroll") for (int i = 0; i < 2; ++i) xx[3 + i] = *(const u32x2*)(_row + O_B + 8 * lane + 4 * i); } while (0)
    int r = gw; while (r < NTOK && GN_SKIP(r)) r += NGW;
    u32x2 x[8], xn[8];
    if (r < NTOK) GN_LOAD(r, x);
    while (r < NTOK) {
        int rn = r + NGW; while (rn < NTOK && GN_SKIP(rn)) rn += NGW;
        if (rn < NTOK) GN_LOAD(rn, xn);
        bf16_t* row = O + (size_t)r * DM;
        float v[8][4]; float ss[3] = {0.f, 0.f, 0.f};
#pragma unroll
        for (int i = 0; i < 8; ++i) { v[i][0] = bflo(x[i].x); v[i][1] = bfhi(x[i].x); v[i][2] = bflo(x[i].y); v[i][3] = bfhi(x[i].y);
            const int grp = (i < 3) ? 0 : (i < 5) ? 1 : 2; ss[grp] += (v[i][0] * v[i][0] + v[i][1] * v[i][1]) + (v[i][2] * v[i][2] + v[i][3] * v[i][3]); }
        float rinv[3];
        rinv[0] = rsqrt_fast(wave_sum(ss[0]) * (1.f / 768) + EPS); rinv[1] = rsqrt_fast(wave_sum(ss[1]) * (1.f / 512) + EPS); rinv[2] = rsqrt_fast(wave_sum(ss[2]) * (1.f / 768) + EPS);
#pragma unroll
        for (int i = 0; i < 8; ++i) { const int grp = (i < 3) ? 0 : (i < 5) ? 1 : 2;
            const int c = (grp == 0) ? O_A + 12 * lane + 4 * i : (grp == 1) ? O_B + 8 * lane + 4 * (i - 3) : O_C + 12 * lane + 4 * (i - 5);
            const f32x4 gg = *(const f32x4*)(og + c); const float ri = rinv[grp];
            u32x2 w; w.x = pk2(v[i][0] * ri * gg.x, v[i][1] * ri * gg.y); w.y = pk2(v[i][2] * ri * gg.z, v[i][3] * ri * gg.w); *(u32x2*)(row + c) = w; }
#pragma unroll
        for (int i = 0; i < 8; ++i) x[i] = xn[i];
        r = rn;
    }
#undef GN_SKIP
#undef GN_LOAD
}

__device__ __forceinline__ float row16_max(float v) {
    v = fmaxf(v, __builtin_bit_cast(float, __builtin_amdgcn_update_dpp(0, __builtin_bit_cast(int, v), 0xB1, 0xF, 0xF, true)));
    v = fmaxf(v, __builtin_bit_cast(float, __builtin_amdgcn_update_dpp(0, __builtin_bit_cast(int, v), 0x4E, 0xF, 0xF, true)));
    v = fmaxf(v, __builtin_bit_cast(float, __builtin_amdgcn_update_dpp(0, __builtin_bit_cast(int, v), 0x141, 0xF, 0xF, true)));
    v = fmaxf(v, __builtin_bit_cast(float, __builtin_amdgcn_update_dpp(0, __builtin_bit_cast(int, v), 0x140, 0xF, 0xF, true)));
    return v;
}
__device__ __forceinline__ void phase_rowpass2(Frame& F, int l) {
    PHASE_IDS(F);
    const float* xb = (const float*)(F.ws + WS_XB); const float* parts = (const float*)(F.ws + WS_PART);
    const bool f8 = (l == 0) ? (FP8_L0 != 0) : (FP8_L1 != 0);
    { const u32x4* wf = (const u32x4*)((const bf16_t*)(F.ws + WS_WRS) + (size_t)l * 64 * 2 * 64 * 8) + tid; u32x4 t[16];
#pragma unroll
      for (int i = 0; i < 16; ++i) t[i] = wf[512 * i];
#pragma unroll
      for (int i = 0; i < 16; ++i) ((LAS u32x4*)F.lds)[tid + 512 * i] = t[i]; }
    LAS f32x4* red = (LAS f32x4*)(F.lds + LDSCTL_OFF + 2048);
    __syncthreads();
    const int i16 = lane & 15, q = lane >> 4;
#define RP2_SKIP(tl) (l == 1 && ((tl) * 16) % TPB < CTXL)
#define RP2_LOAD(tl, xx, pp0, pp1) do { const int _row = (tl) * 16 + i16; const float* _xr = xb + (size_t)_row * DM + 256 * wave + 8 * q; \
        _Pragma("unroll") for (int sidx = 0; sidx < 8; ++sidx) { xx[sidx][0] = *(const f32x4*)(_xr + 32 * sidx); xx[sidx][1] = *(const f32x4*)(_xr + 32 * sidx + 4); } \
        pp0 = *(const f32x4*)(parts + (size_t)_row * 32 + 8 * q); pp1 = *(const f32x4*)(parts + (size_t)_row * 32 + 8 * q + 4); } while (0)
    int tile = blockIdx.x; while (tile < NTOK / 16 && RP2_SKIP(tile)) tile += F.G;
    f32x4 x[8][2], xn[8][2], p0, p1, p0n, p1n;
    if (tile < NTOK / 16) RP2_LOAD(tile, x, p0, p1);
    while (tile < NTOK / 16) {
        int ntile = tile + F.G; while (ntile < NTOK / 16 && RP2_SKIP(ntile)) ntile += F.G;
        if (ntile < NTOK / 16) RP2_LOAD(ntile, xn, p0n, p1n);
        const int r0 = tile * 16, b = r0 / TPB, t0 = r0 % TPB, sv = (t0 < CTXL) ? 4 : b;
        const int row = r0 + i16;
        float ss = ((p0.x + p0.y) + (p0.z + p0.w)) + ((p1.x + p1.y) + (p1.z + p1.w));
        ss += __builtin_bit_cast(float, __builtin_amdgcn_ds_swizzle(__builtin_bit_cast(int, ss), 0x401F));
        { auto rr = __builtin_amdgcn_permlane32_swap(__float_as_uint(ss), __float_as_uint(ss), false, false); ss = __uint_as_float(rr[0]) + __uint_as_float(rr[1]); }
        const float rinv = rsqrt_fast(ss * (1.f / DM) + EPS);
        const float* gs = (const float*)(F.ws + WS_GS2) + ((size_t)(l * 5 + sv) * DM + 256 * wave + 8 * q) * 2;
        f32x4 acc = (f32x4){0.f, 0.f, 0.f, 0.f};
#pragma unroll
        for (int sidx = 0; sidx < 8; ++sidx) {
            const f32x4 g0 = *(const f32x4*)(gs + 64 * sidx), g1 = *(const f32x4*)(gs + 64 * sidx + 4), g2 = *(const f32x4*)(gs + 64 * sidx + 8), g3 = *(const f32x4*)(gs + 64 * sidx + 12);
            float h[8];
            h[0] = x[sidx][0].x * rinv * g0.x + g0.y; h[1] = x[sidx][0].y * rinv * g0.z + g0.w; h[2] = x[sidx][0].z * rinv * g1.x + g1.y; h[3] = x[sidx][0].w * rinv * g1.z + g1.w;
            h[4] = x[sidx][1].x * rinv * g2.x + g2.y; h[5] = x[sidx][1].y * rinv * g2.z + g2.w; h[6] = x[sidx][1].z * rinv * g3.x + g3.y; h[7] = x[sidx][1].w * rinv * g3.z + g3.w;
            const int col = 256 * wave + 32 * sidx + 8 * q;
            if (f8) { u32x2 w8; w8.x = pk4_fp8(h[0], h[1], h[2], h[3]); w8.y = pk4_fp8(h[4], h[5], h[6], h[7]); *(u32x2*)((unsigned char*)(F.ws + WS_HN8) + (size_t)row * DM + col) = w8; }
            else { u32x4 w16; w16.x = pk2(h[0], h[1]); w16.y = pk2(h[2], h[3]); w16.z = pk2(h[4], h[5]); w16.w = pk2(h[6], h[7]); *(u32x4*)((bf16_t*)(F.ws + WS_HN) + (size_t)row * DM + col) = w16; }
            unsigned hh[8], hl[8];
#pragma unroll
            for (int j = 0; j < 8; ++j) { hh[j] = f2bf(h[j]); hl[j] = f2bf(h[j] - __builtin_bit_cast(float, hh[j] << 16)); }
            u32x4 ah, al; ah.x = hh[0] | (hh[1] << 16); ah.y = hh[2] | (hh[3] << 16); ah.z = hh[4] | (hh[5] << 16); ah.w = hh[6] | (hh[7] << 16);
            al.x = hl[0] | (hl[1] << 16); al.y = hl[2] | (hl[3] << 16); al.z = hl[4] | (hl[5] << 16); al.w = hl[6] | (hl[7] << 16);
            const LAS unsigned char* bp = F.lds + (size_t)((wave * 8 + sidx) * 2) * 1024 + lane * 16;
            const bf16x8 bh = *(const LAS bf16x8*)bp, bl = *(const LAS bf16x8*)(bp + 1024);
            const bf16x8 fah = __builtin_bit_cast(bf16x8, ah), fal = __builtin_bit_cast(bf16x8, al);
            acc = __builtin_amdgcn_mfma_f32_16x16x32_bf16(fah, bh, acc, 0, 0, 0);
            acc = __builtin_amdgcn_mfma_f32_16x16x32_bf16(fah, bl, acc, 0, 0, 0);
            acc = __builtin_amdgcn_mfma_f32_16x16x32_bf16(fal, bh, acc, 0, 0, 0);
        }
        red[wave * 64 + lane] = acc;
        __syncthreads();
        if (wave == 0) {
            f32x4 lg = red[lane];
#pragma unroll
            for (int w = 1; w < 8; ++w) lg += red[w * 64 + lane];
#pragma unroll
            for (int reg = 0; reg < 4; ++reg) { const float mx = row16_max(lg[reg]); const float ex = __expf(lg[reg] - mx); const float a = ex / row16_sum(ex);
                const int t = t0 + 4 * q + reg;
                if (t < CTXL) ((float*)(F.ws + WS_AFFC))[((size_t)b * NE + i16) * CTXL + t] = a;
                else ((float*)(F.ws + WS_AFFL))[((size_t)b * NE + i16) * SEQ + (t - CTXL)] = a; }
        }
        __syncthreads();
#pragma unroll
        for (int sidx = 0; sidx < 8; ++sidx) { x[sidx][0] = xn[sidx][0]; x[sidx][1] = xn[sidx][1]; }
        p0 = p0n; p1 = p1n; tile = ntile;
    }
#undef RP2_SKIP
#undef RP2_LOAD
    __syncthreads();
}

__device__ __forceinline__ unsigned block_excl_scan(unsigned v, LAS unsigned* scr, int lane, int wave, unsigned& total) {
    unsigned inc = v;
#pragma unroll
    for (int o = 1; o < 64; o <<= 1) { const unsigned t = __shfl_up(inc, o); if (lane >= o) inc += t; }
    if (lane == 63) scr[wave] = inc;
    __syncthreads();
    unsigned base = 0, tot = 0;
#pragma unroll
    for (int w = 0; w < 8; ++w) { const unsigned x = scr[w]; base += (w < wave) ? x : 0u; tot += x; }
    __syncthreads();
    total = tot;
    return base + inc - v;
}
__device__ __forceinline__ void phase_topk(Frame& F, int l) {
    PHASE_IDS(F);
    LAS unsigned* hist = (LAS unsigned*)F.lds;
    LAS unsigned* scr = (LAS unsigned*)(F.lds + 8192);
    LAS int* rowsrc = (LAS int*)(F.lds + 8192 + 128);
    const int nunits = (l == 0) ? 128 : 64;
    const bool f8 = (l == 0) ? (FP8_L0 != 0) : (FP8_L1 != 0); const int RBg = f8 ? DM : 2 * DM;
    for (int u = blockIdx.x; u < nunits; u += F.G) {
        const bool isc = u >= 64; const int uu = isc ? u - 64 : u, b = uu / NE, e = uu % NE;
        const int N = isc ? CTXL : SEQ; const unsigned cap = isc ? CAP_C : CAP_L;
        const float* src = isc ? (const float*)(F.ws + WS_AFFC) + (size_t)uu * CTXL : (const float*)(F.ws + WS_AFFL) + (size_t)uu * SEQ;
        int* pos = isc ? (int*)(F.ws + WS_POSC) + (size_t)uu * CTXL : (int*)(F.ws + WS_POSL) + (size_t)uu * SEQ;
        const bool own = tid * 8 < N;
        unsigned key[8];
        { u32x4 k0 = (u32x4){0u, 0u, 0u, 0u}, k1 = k0; if (own) { k0 = *(const u32x4*)(src + tid * 8); k1 = *(const u32x4*)(src + tid * 8 + 4); }
          key[0] = k0.x; key[1] = k0.y; key[2] = k0.z; key[3] = k0.w; key[4] = k1.x; key[5] = k1.y; key[6] = k1.z; key[7] = k1.w; }
        unsigned prefix = 0u, remaining = cap;
#pragma unroll
        for (int p = 0; p < 3; ++p) {
            const int shift = (p == 0) ? 21 : (p == 1) ? 10 : 0, bits = (p == 2) ? 10 : 11, nb = 1 << bits;
            for (int i = tid; i < nb; i += 512) hist[i] = 0u;
            __syncthreads();
            if (own) {
#pragma unroll
                for (int q = 0; q < 8; ++q) { const bool cand = (p == 0) ? true : ((key[q] >> (shift + bits)) == prefix);
                    if (cand) (void)__hip_atomic_fetch_add(&hist[(key[q] >> shift) & (nb - 1)], 1u, __ATOMIC_RELAXED, __HIP_MEMORY_SCOPE_WORKGROUP); } }
            __syncthreads();
            unsigned c[4];
#pragma unroll
            for (int q = 0; q < 4; ++q) c[q] = (4 * tid + q < nb) ? hist[4 * tid + q] : 0u;
            const unsigned sm = (c[0] + c[1]) + (c[2] + c[3]);
            unsigned total; const unsigned ex = block_excl_scan(sm, scr, lane, wave, total);
            unsigned above = total - (ex + sm);
#pragma unroll
            for (int q = 3; q >= 0; --q) { if (above < remaining && remaining <= above + c[q]) { scr[16] = (unsigned)(4 * tid + q); scr[17] = above; } above += c[q]; }
            __syncthreads();
            const unsigned B = scr[16], ca = scr[17];
            remaining -= ca; prefix = (prefix << bits) | B;
            __syncthreads();
        }
        const unsigned T = prefix;
        unsigned ce = 0u;
#pragma unroll
        for (int q = 0; q < 8; ++q) ce += (own && key[q] == T) ? 1u : 0u;
        unsigned tot; unsigned er = block_excl_scan(ce, scr, lane, wave, tot);
        bool sel[8]; unsigned cs = 0u;
#pragma unroll
        for (int q = 0; q < 8; ++q) { const bool eq = own && key[q] == T; sel[q] = own && (key[q] > T || (eq && er < remaining)); er += eq ? 1u : 0u; cs += sel[q] ? 1u : 0u; }
        unsigned sl = block_excl_scan(cs, scr, lane, wave, tot);
        const int slotbase = e * ROWS_E + (isc ? 2048 + b * CAP_C : b * CAP_L);
        int pv[8];
#pragma unroll
        for (int q = 0; q < 8; ++q) { pv[q] = sel[q] ? (int)sl : -1;
            if (sel[q]) { rowsrc[sl] = b * TPB + (isc ? 0 : CTXL) + tid * 8 + q; ((float*)(F.ws + WS_GATE))[slotbase + sl] = __uint_as_float(key[q]); ++sl; } }
        if (own) { *(i32x4*)(pos + tid * 8) = (i32x4){pv[0], pv[1], pv[2], pv[3]}; *(i32x4*)(pos + tid * 8 + 4) = (i32x4){pv[4], pv[5], pv[6], pv[7]}; }
        __syncthreads();
        unsigned* offs = (unsigned*)(F.ws + WS_OFFS);
        int R[2], C[2];
#pragma unroll
        for (int i = 0; i < 2; ++i) pg8::stage_rc(tid * 16 + i * 8192, R[i], C[i]);
        if (!isc) {
#pragma unroll
            for (int th = 0; th < 2; ++th) { u32x4 o;
                o.x = (unsigned)rowsrc[th * 256 + R[0]] * RBg + 2 * C[0]; o.y = (unsigned)rowsrc[th * 256 + R[1]] * RBg + 2 * C[1];
                o.z = (unsigned)rowsrc[th * 256 + 128 + R[0]] * RBg + 2 * C[0]; o.w = (unsigned)rowsrc[th * 256 + 128 + R[1]] * RBg + 2 * C[1];
                *(u32x4*)(offs + ((size_t)(e * 9 + 2 * b + th) * 512 + tid) * 4) = o; }
        } else {
            unsigned* o = offs + ((size_t)(e * 9 + 8) * 512 + tid) * 4;
#pragma unroll
            for (int i = 0; i < 2; ++i) { if (R[i] >= 32 * b && R[i] < 32 * b + 32) o[i] = (unsigned)rowsrc[R[i] - 32 * b] * RBg + 2 * C[i]; if (b == 0) o[2 + i] = 2 * C[i]; }
        }
        __syncthreads();
    }
}

__device__ __forceinline__ void phase_combine(Frame& F, int l) {
    PHASE_IDS(F);
    const float* mod = (const float*)(F.ws + WS_MOD);
    float* xb = (float*)(F.ws + WS_XB); const bf16_t* Y = (const bf16_t*)(F.ws + WS_XG);
    for (int r = gw; r < NTOK; r += NGW) {
        const int b = r / TPB, t = r % TPB, s = (t < CTXL) ? 4 : b;
        if (l == 1 && t < CTXL) continue;
        int p = -1;
        if (lane < NE) p = (t < CTXL) ? ((const int*)(F.ws + WS_POSC))[((size_t)b * NE + lane) * CTXL + t] : ((const int*)(F.ws + WS_POSL))[((size_t)b * NE + lane) * SEQ + (t - CTXL)];
        float gt = 0.f;
        if (p >= 0) gt = ((const float*)(F.ws + WS_GATE))[lane * ROWS_E + ((t < CTXL) ? 2048 + b * CAP_C : b * CAP_L) + p];
        f32x4 v[8]; load_row(xb + (size_t)r * DM, lane, v);
        const float* g2 = mod + (size_t)(l * 5 + s) * NMOD + 5 * DM;
        f32x4 gv[8];
#pragma unroll
        for (int j = 0; j < 8; ++j) gv[j] = *(const f32x4*)(g2 + 4 * lane + 256 * j);
        f32x4 a[8];
#pragma unroll
        for (int j = 0; j < 8; ++j) a[j] = (f32x4){0.f, 0.f, 0.f, 0.f};
        unsigned long long m = __ballot(p >= 0);
        const int ybase = (t < CTXL) ? 2048 + b * CAP_C : b * CAP_L;
        while (m) {
            const int e0 = __builtin_ctzll(m); m &= m - 1;
            const bool two = (m != 0ull); const int e1 = two ? __builtin_ctzll(m) : e0; if (two) m &= m - 1;
            const int p0 = __builtin_amdgcn_readlane(p, e0), p1 = __builtin_amdgcn_readlane(p, e1);
            const float q0 = __builtin_bit_cast(float, __builtin_amdgcn_readlane(__builtin_bit_cast(int, gt), e0)), q1 = __builtin_bit_cast(float, __builtin_amdgcn_readlane(__builtin_bit_cast(int, gt), e1));
            const bf16_t* y0 = Y + (size_t)(e0 * ROWS_E + ybase + p0) * DM + 4 * lane; const bf16_t* y1 = Y + (size_t)(e1 * ROWS_E + ybase + p1) * DM + 4 * lane;
            u32x2 w0[8], w1[8];
#pragma unroll
            for (int j = 0; j < 8; ++j) w0[j] = *(const u32x2*)(y0 + 256 * j);
            if (two) {
#pragma unroll
                for (int j = 0; j < 8; ++j) w1[j] = *(const u32x2*)(y1 + 256 * j); }
#pragma unroll
            for (int j = 0; j < 8; ++j) a[j] += (f32x4){bflo(w0[j].x), bfhi(w0[j].x), bflo(w0[j].y), bfhi(w0[j].y)} * q0;
            if (two) {
#pragma unroll
                for (int j = 0; j < 8; ++j) a[j] += (f32x4){bflo(w1[j].x), bfhi(w1[j].x), bflo(w1[j].y), bfhi(w1[j].y)} * q1; }
        }
#pragma unroll
        for (int j = 0; j < 8; ++j) v[j] += gv[j] * a[j];
        if (l == 0) {
#pragma unroll
            for (int j = 0; j < 8; ++j) *(f32x4*)(xb + (size_t)r * DM + 4 * lane + 256 * j) = v[j];
            const float* m1 = mod + (size_t)(5 + s) * NMOD;
            norm_mod_store(v, INP(F, IN_N1G) + DM, m1, m1 + DM, (bf16_t*)(F.ws + WS_HN) + (size_t)r * DM, lane);
        } else {
            float* op = F.out + ((size_t)b * SEQ + (t - CTXL)) * DM;
#pragma unroll
            for (int j = 0; j < 8; ++j) *(f32x4*)(op + 4 * lane + 256 * j) = v[j];
        }
    }
}

__device__ __forceinline__ void phase_dump_x(Frame& F, bool from_input) {
    PHASE_IDS(F);
    const float* xb = (const float*)(F.ws + WS_XB);
    for (int r = gw; r < NTOK; r += NGW) {
        const int b = r / TPB, t = r % TPB; if (t < CTXL) continue;
        const float* src = from_input ? INP(F, IN_X) + ((size_t)b * SEQ + (t - CTXL)) * DM : xb + (size_t)r * DM;
        f32x4 v[8]; load_row(src, lane, v);
        float* op = F.out + ((size_t)b * SEQ + (t - CTXL)) * DM;
#pragma unroll
        for (int j = 0; j < 8; ++j) *(f32x4*)(op + 4 * lane + 256 * j) = v[j];
    }
}

constexpr int N_PHASES = 2 + 11 * NLAYER;
__global__ void __launch_bounds__(512, 2) fwd_kernel(Args args) {
    extern __shared__ __attribute__((aligned(16))) unsigned char lds[];
    Frame F;
    F.lds = (LAS unsigned char*)lds; F.ldsg = (char*)lds;
    F.MISC = (volatile LAS unsigned*)(F.lds + MISC_OFF);
    F.G = gridDim.x;
    F.out = args.out; F.ws = args.ws; F.ctl = (unsigned*)(args.ws + WS_CTL);
    for (int u = threadIdx.x; u < (LDS_BYTES - LDSCTL_OFF) / 4; u += 512) ((LAS unsigned*)(F.lds + LDSCTL_OFF))[u] = 0u;
    __syncthreads();
    if (threadIdx.x < 23) { const unsigned long long pv = (unsigned long long)args.in[threadIdx.x]; LAS unsigned* t = (LAS unsigned*)(F.lds + ARGTAB_OFF) + 2 * threadIdx.x; t[0] = (unsigned)pv; t[1] = (unsigned)(pv >> 32); }
    __syncthreads();
    XcdBarrier bar; bar.bar = F.ctl + CW_BAR; bar.x = 0; bar.st = nullptr;
    if (!MK_PER_PHASE) bar = xcd_barrier_post(F.ctl + CW_BAR, F.MISC + 8);
    const int lo = args.ph_lo, hi = args.ph_hi;
#define IN(k) (lo <= (k) && (k) < hi)
    unsigned long long probe_t0 = 0ull, probe_acc = 0ull;
#define PROBE_BEGIN(k) do { if (PROBE_MASK & (1u << (k))) probe_t0 = __builtin_amdgcn_s_memrealtime(); } while (0)
#define SEAM(k) do { if (IN(k) && IN((k) + 1)) xcd_barrier(bar); if (PROBE_MASK & (1u << (k))) probe_acc += __builtin_amdgcn_s_memrealtime() - probe_t0; } while (0)

    if (IN(0)) { PROBE_BEGIN(0); if (PH_ON(0)) phase_prologue(F); if (IN(1)) xcd_barrier_first(bar); if (PROBE_MASK & 1u) probe_acc += __builtin_amdgcn_s_memrealtime() - probe_t0; }
    if (IN(1)) { PROBE_BEGIN(1); if (PH_ON(1)) phase_rowpass1_l0(F); SEAM(1); }
    for (int l = 0; l < NLAYER; ++l) {
        const int pb = 2 + 11 * l;
        const bool ctx = (l == 0);
        if (IN(pb + 0)) { PROBE_BEGIN(pb + 0); if (PH_ON(2)) {
            pg8::SchedDense S; S.init(F.ws + WS_HN, F.ws + WS_WIN + (size_t)l * INW * DM * 2, NTOK / 256, INW / 256, F.G, (int)blockIdx.x, 0);
            pg8::EpiPost E{(bf16_t*)(F.ws + WS_P), (const float*)(F.ws + WS_ROPE), INP(F, IN_QNA) + l * 128, INP(F, IN_KNA) + l * 128, INP(F, IN_QNC) + l * 128, INP(F, IN_KNC) + l * 128, INP(F, IN_VNB) + l * 512, F.lds + LDSCTL_OFF + 2048};
            pg8::gemm_phase<pg8::EpiPost, pg8::SchedDense>(F.lds, S, E); }
            SEAM(pb + 0); }
        if (IN(pb + 2)) { PROBE_BEGIN(pb + 2); if (PH_ON(4)) phase_mixers(F, l); SEAM(pb + 2); }
        if (IN(pb + 3)) { PROBE_BEGIN(pb + 3); if (PH_ON(5)) phase_groupnorm(F, l); SEAM(pb + 3); }
        if (IN(pb + 4)) { PROBE_BEGIN(pb + 4); if (PH_ON(6)) {
            pg8::SchedDense S; S.init(F.ws + WS_O, F.ws + WS_WOUT + (size_t)l * DM * DM * 2, ctx ? NTOK / 256 : 64, DM / 256, F.G, (int)blockIdx.x, ctx ? 0 : 1);
            float* xb = (float*)(F.ws + WS_XB);
            pg8::EpiResid E;
            if (l == 0) { E.ctxbase = INP(F, IN_CTX); E.latbase = INP(F, IN_X); E.cbs = CTXL; E.lbs = SEQ; }
            else { E.ctxbase = xb; E.latbase = xb + (size_t)CTXL * DM; E.cbs = TPB; E.lbs = TPB; }
            E.xout = xb; E.modl = (const float*)(F.ws + WS_MOD) + (size_t)l * 5 * NMOD; E.parts = (float*)(F.ws + WS_PART);
            pg8::gemm_phase<pg8::EpiResid, pg8::SchedDense>(F.lds, S, E); }
            SEAM(pb + 4); }
        if (IN(pb + 5)) { PROBE_BEGIN(pb + 5); if (PH_ON(7)) phase_rowpass2(F, l); SEAM(pb + 5); }
        if (IN(pb + 6)) { PROBE_BEGIN(pb + 6); if (PH_ON(8)) phase_topk(F, l); SEAM(pb + 6); }
        if (IN(pb + 8)) { PROBE_BEGIN(pb + 8); if (PH_ON(10)) {
            if ((l == 0) ? (FP8_L0 != 0) : (FP8_L1 != 0)) {
                pg8::SchedGrouped<pg8::GK> S; S.init(F.ws + WS_HN8, F.ws + WS_WGU + (size_t)l * NE * 4096 * DM * 2, ctx ? 9 : 8, 16, F.G, (int)blockIdx.x);
                pg8::EpiSwiGLU8 E{(unsigned char*)(F.ws + WS_H)};
                pg8::gemm_phase<pg8::EpiSwiGLU8, pg8::SchedGrouped<pg8::GK>, true, true>(F.lds, S, E, (const unsigned*)(F.ws + WS_OFFS), F.lds + LDSCTL_OFF + 2048);
            } else {
                pg8::SchedGrouped<2 * pg8::GK> S; S.init(F.ws + WS_HN, F.ws + WS_WGU + (size_t)l * NE * 4096 * DM * 2, ctx ? 9 : 8, 16, F.G, (int)blockIdx.x);
                pg8::EpiSwiGLU E{(bf16_t*)(F.ws + WS_H)};
                pg8::gemm_phase<pg8::EpiSwiGLU, pg8::SchedGrouped<2 * pg8::GK>, false, true>(F.lds, S, E, (const unsigned*)(F.ws + WS_OFFS), F.lds + LDSCTL_OFF + 2048);
            } }
            SEAM(pb + 8); }
        if (IN(pb + 9)) { PROBE_BEGIN(pb + 9); if (PH_ON(11)) {
            pg8::EpiStoreBf16 E{(bf16_t*)(F.ws + WS_XG), DM};
            if ((l == 0) ? (FP8_L0 != 0) : (FP8_L1 != 0)) {
                pg8::SchedGrouped<pg8::GK> S; S.init(F.ws + WS_H, F.ws + WS_WD + (size_t)l * NE * DM * DM * 2, ctx ? 9 : 8, 8, F.G, (int)blockIdx.x);
                pg8::gemm_phase<pg8::EpiStoreBf16, pg8::SchedGrouped<pg8::GK>, true>(F.lds, S, E);
            } else {
                pg8::SchedGrouped<2 * pg8::GK> S; S.init(F.ws + WS_H, F.ws + WS_WD + (size_t)l * NE * DM * DM * 2, ctx ? 9 : 8, 8, F.G, (int)blockIdx.x);
                pg8::gemm_phase<pg8::EpiStoreBf16, pg8::SchedGrouped<2 * pg8::GK>, false>(F.lds, S, E);
            } }
            SEAM(pb + 9); }
        if (IN(pb + 10)) { PROBE_BEGIN(pb + 10); if (PH_ON(12)) phase_combine(F, l); if (l + 1 < NLAYER) SEAM(pb + 10); else if (PROBE_MASK & (1u << (pb + 10))) probe_acc += __builtin_amdgcn_s_memrealtime() - probe_t0; }
    }
    if (PROBE_MASK) { const unsigned long long te = __builtin_amdgcn_s_memrealtime(); while (__builtin_amdgcn_s_memrealtime() - te < probe_acc) __builtin_amdgcn_s_sleep(8); }
#undef IN
#undef SEAM
}

extern "C" void kernel_launch(void* const* d_in, const int* in_sizes, int n_in, void* d_out, int out_size, void* d_ws, size_t ws_size, hipStream_t stream) {
    static int grid = 0;
    if (grid == 0) {
        if (n_in != 23 || out_size != NB * SEQ * DM || ws_size < WS_END) { fprintf(stderr, "kernel_launch: shape mismatch: n_in %d out %d ws %zu (need %zu)\n", n_in, out_size, ws_size, (size_t)WS_END); grid = -1; return; }
        int dev = 0, cus = 0, per_cu = 0;
        if (hipGetDevice(&dev) != hipSuccess || hipDeviceGetAttribute(&cus, hipDeviceAttributeMultiprocessorCount, dev) != hipSuccess) { grid = -1; return; }
        if (hipFuncSetAttribute((const void*)fwd_kernel, hipFuncAttributeMaxDynamicSharedMemorySize, LDS_BYTES) != hipSuccess) { fprintf(stderr, "kernel_launch: hipFuncSetAttribute failed\n"); grid = -1; return; }
        if (hipOccupancyMaxActiveBlocksPerMultiprocessor(&per_cu, (const void*)fwd_kernel, 512, LDS_BYTES) != hipSuccess || per_cu < 1) { fprintf(stderr, "kernel_launch: occupancy query says %d\n", per_cu); }
        (void)hipGetLastError();
        grid = cus;
    }
    if (grid < 0) return;
    if (hipMemsetAsync((char*)d_ws + WS_CTL, 0, CTL_ZERO_BYTES, stream) != hipSuccess) return;
    Args a{};
    for (int i = 0; i < 23; ++i) a.in[i] = (const float*)d_in[i];
    a.out = (float*)d_out; a.ws = (unsigned char*)d_ws;
#if MK_PER_PHASE
    for (int p = 0; p < N_PHASES; ++p) { a.ph_lo = p; a.ph_hi = p + 1; hipLaunchKernelGGL(fwd_kernel, dim3(grid), dim3(512), LDS_BYTES, stream, a); }
#else
    a.ph_lo = 0; a.ph_hi = N_PHASES;
    hipLaunchKernelGGL(fwd_kernel, dim3(grid), dim3(512), LDS_BYTES, stream, a);
#endif
    const hipError_t le = hipPeekAtLastError();
    if (le != hipSuccess) fprintf(stderr, "kernel_launch: launch failed: %s\n", hipGetErrorName(le));
}
```

```cpp
#include <hip/hip_runtime.h>
#include <cstdio>
#include <cstdint>

#define LAS __attribute__((address_space(3)))
#define GAS __attribute__((address_space(1)))
typedef unsigned short bf16_t;
typedef short bf16x8 __attribute__((ext_vector_type(8)));
typedef short s16x4 __attribute__((ext_vector_type(4)));
typedef float f32x2 __attribute__((ext_vector_type(2)));
typedef float f32x4 __attribute__((ext_vector_type(4)));
typedef float f32x16 __attribute__((ext_vector_type(16)));
typedef unsigned u32x2 __attribute__((ext_vector_type(2)));
typedef unsigned u32x4 __attribute__((ext_vector_type(4)));
typedef int i32x4 __attribute__((ext_vector_type(4)));
typedef int i32x8 __attribute__((ext_vector_type(8)));

#ifndef MK_PER_PHASE
#define MK_PER_PHASE 0
#endif
#ifndef PHASE_MASK
#define PHASE_MASK 0x1fff
#endif
#define PH_ON(k) (((PHASE_MASK) >> (k)) & 1)
#ifndef FP8_L0
#define FP8_L0 1
#endif
#ifndef FP8_L1
#define FP8_L1 1
#endif
#ifndef PROBE_MASK
#define PROBE_MASK 0u
#endif
#ifndef DBG_STOP
#define DBG_STOP 0
#endif

constexpr int DM = 2048, NB = 4, SEQ = 4096, CTXL = 256, TPB = SEQ + CTXL, NTOK = NB * TPB;
constexpr int INW = 3584, NE = 16, NLAYER = 2, NMOD = 6 * DM;
constexpr int C_QA = 0, C_KA = 768, C_VA = 1024, C_UB = 1280, C_VB = 1792, C_QC = 2304, C_KC = 3072, C_VC = 3328;
constexpr int O_A = 0, O_B = 768, O_C = 1280;
constexpr int CAP_L = 512, CAP_C = 32, ROWS_E = 2304;
constexpr float EPS = 1e-6f;

constexpr size_t MiB = 1u << 20;
constexpr size_t WS_CTL = 0, CTL_ZERO_BYTES = 65536;
constexpr size_t WS_MOD = 1 * MiB;
constexpr size_t WS_ROPE = 2 * MiB;
constexpr size_t WS_AFFL = 3 * MiB;
constexpr size_t WS_AFFC = 4 * MiB;
constexpr size_t WS_POSL = 5 * MiB;
constexpr size_t WS_POSC = 6 * MiB;
constexpr size_t WS_OFFS = 10 * MiB;
constexpr size_t WS_GATE = 8 * MiB;
constexpr size_t WS_WRT = 9 * MiB;
constexpr size_t WS_WRS = 11 * MiB;
constexpr size_t WS_GS2 = 12 * MiB;
constexpr size_t WS_PART = 13 * MiB;
constexpr size_t WS_WIN = 16 * MiB;
constexpr size_t WS_WOUT = WS_WIN + (size_t)2 * INW * DM * 2;
constexpr size_t WS_WGU = WS_WOUT + (size_t)2 * DM * DM * 2;
constexpr size_t WS_WD = WS_WGU + (size_t)2 * NE * 4096 * DM * 2;
constexpr size_t WS_HN = WS_WD + (size_t)2 * NE * DM * DM * 2;
constexpr size_t WS_P = WS_HN + (size_t)NTOK * DM * 2;
constexpr size_t WS_O = WS_P + (size_t)NTOK * INW * 2;
constexpr size_t WS_XB = WS_O + (size_t)NTOK * DM * 2;
constexpr size_t WS_XG = WS_XB + (size_t)NTOK * DM * 4;
constexpr size_t WS_H = WS_XG + (size_t)NE * ROWS_E * DM * 2;
constexpr size_t WS_HN8 = WS_H + (size_t)NE * ROWS_E * DM * 2;
constexpr size_t WS_END = WS_HN8 + (size_t)NTOK * DM;
constexpr float W8_SCALE = 32.f; constexpr int W8_SCALE_E8M0 = 127 - 5;
constexpr int CW_BAR = 4096, CW_QUEUE = 8192;
constexpr int CW_CONV = 10240, CW_MIXDONE = 10304;
constexpr int NT8_ALL = 2 * NE * 3 * 128, NT8_L0 = NT8_ALL / 2;
#ifndef CONV_HOOKS
#define CONV_HOOKS 0x1f
#endif
#ifndef CONV_IDLE
#define CONV_IDLE 1
#endif

constexpr int RING_BYTES = 131072, LDSCTL_OFF = RING_BYTES, MISC_OFF = LDSCTL_OFF + 320, LDS_BYTES = 147456;

#define LDS_WAIT() asm volatile("s_waitcnt lgkmcnt(0)" ::: "memory")
#define VM_WAIT() asm volatile("s_waitcnt vmcnt(0)" ::: "memory")
__device__ __forceinline__ unsigned f2bf(float f) { unsigned u = __builtin_bit_cast(unsigned, f); return (u + 0x7fffu + ((u >> 16) & 1u)) >> 16; }
__device__ __forceinline__ unsigned pk2(float lo, float hi) { return f2bf(lo) | (f2bf(hi) << 16); }
__device__ __forceinline__ float bf2f(unsigned short b) { return __builtin_bit_cast(float, ((unsigned)b) << 16); }
__device__ __forceinline__ float bflo(unsigned w) { return __builtin_bit_cast(float, w << 16); }
__device__ __forceinline__ float bfhi(unsigned w) { return __builtin_bit_cast(float, w & 0xffff0000u); }
__device__ __forceinline__ unsigned pk4_fp8(float a, float b, float c, float d) {
    int r = __builtin_amdgcn_cvt_pk_fp8_f32(a, b, 0, false); r = __builtin_amdgcn_cvt_pk_fp8_f32(c, d, r, true); return (unsigned)r; }
__device__ __forceinline__ int opaque_tid() { int t = threadIdx.x; asm volatile("" : "+v"(t)); return t; }
__device__ __forceinline__ float row16_sum(float v) {
    v += __builtin_bit_cast(float, __builtin_amdgcn_update_dpp(0, __builtin_bit_cast(int, v), 0xB1, 0xF, 0xF, true));
    v += __builtin_bit_cast(float, __builtin_amdgcn_update_dpp(0, __builtin_bit_cast(int, v), 0x4E, 0xF, 0xF, true));
    v += __builtin_bit_cast(float, __builtin_amdgcn_update_dpp(0, __builtin_bit_cast(int, v), 0x141, 0xF, 0xF, true));
    v += __builtin_bit_cast(float, __builtin_amdgcn_update_dpp(0, __builtin_bit_cast(int, v), 0x140, 0xF, 0xF, true));
    return v;
}
__device__ __forceinline__ float wave_sum(float v) {
    v = row16_sum(v);
    const int iv = __builtin_bit_cast(int, v);
    const float a = __builtin_bit_cast(float, __builtin_amdgcn_readlane(iv, 0)), b = __builtin_bit_cast(float, __builtin_amdgcn_readlane(iv, 16));
    const float c = __builtin_bit_cast(float, __builtin_amdgcn_readlane(iv, 32)), d = __builtin_bit_cast(float, __builtin_amdgcn_readlane(iv, 48));
    return (a + b) + (c + d);
}
__device__ __forceinline__ float rsqrt_fast(float x) { return __builtin_amdgcn_rsqf(x); }
__device__ __forceinline__ float gelu_tanh(float x) {
    const float u = 0.7978845608028654f * (x + 0.044715f * x * x * x);
    const float e = __expf(2.f * u);
    const float th = 1.f - 2.f / (e + 1.f);
    return 0.5f * x * (1.f + th);
}

#define XB_TMO      128
#define XB_XCNT(j)  (256  + 64 * (j))
#define XB_XSUB(j)  (1280 + 64 * (j))
#define XB_XGEN(j)  (2304 + 64 * (j))
#define XB_TOP      3328
#define XB_TOPGEN   3392
#define XCD_BAR_WORDS 3456
#define XB_SPIN_CAP (1u << 18)
__device__ __forceinline__ unsigned xb_ld(unsigned* p)              { return __hip_atomic_load(p, __ATOMIC_RELAXED, __HIP_MEMORY_SCOPE_AGENT); }
__device__ __forceinline__ unsigned xb_add(unsigned* p, unsigned v) { return __hip_atomic_fetch_add(p, v, __ATOMIC_RELAXED, __HIP_MEMORY_SCOPE_AGENT); }
__device__ __forceinline__ unsigned xb_xcc_id() { return (unsigned)__builtin_amdgcn_s_getreg((3 << 11) | 20) & 0xFu; }
#define XB_SPIN(cond, bar) do { unsigned _sp = 0; while (cond) { __builtin_amdgcn_s_sleep(1); \
    if ((++_sp & 255u) == 0u) { if (xb_ld(&(bar)[XB_TMO])) break; if (_sp > XB_SPIN_CAP) { atomicAdd(&(bar)[XB_TMO], 1u); break; } } } } while (0)
struct XcdBarrier { unsigned* bar; unsigned x; volatile LAS unsigned* st; };
__device__ __forceinline__ XcdBarrier xcd_barrier_post(unsigned* bar, volatile LAS unsigned* st) {
    XcdBarrier b; b.bar = bar; b.x = xb_xcc_id(); b.st = st;
    if (threadIdx.x == 0) (void)xb_add(&bar[XB_XCNT(b.x)], 1u);
    return b;
}
__device__ __forceinline__ void xcd_barrier_complete(unsigned* bar, unsigned x, unsigned& nloc, unsigned& nx) {
    const unsigned G = gridDim.x * gridDim.y * gridDim.z;
    unsigned sum, cnt, mine, sp = 0u;
    for (;;) {
        sum = 0u; cnt = 0u; mine = 0u;
#pragma unroll
        for (unsigned j = 0; j < 16; ++j) { const unsigned c = xb_ld(&bar[XB_XCNT(j)]); sum += c; cnt += (c > 0u) ? 1u : 0u; mine = (j == x) ? c : mine; }
        if (sum == G) break;
        __builtin_amdgcn_s_sleep(1);
        if ((++sp & 255u) == 0u) { if (xb_ld(&bar[XB_TMO])) break; if (sp > XB_SPIN_CAP) { atomicAdd(&bar[XB_TMO], 1u); break; } }
    }
    nloc = mine > 0u ? mine : 1u; nx = cnt > 0u ? cnt : 1u;
}
template <bool FIRST>
__device__ __forceinline__ void xcd_barrier_t(const XcdBarrier& b) {
    asm volatile("s_waitcnt vmcnt(0)" ::: "memory");
    __syncthreads();
    if (threadIdx.x == 0) {
        unsigned* bar = b.bar;
        asm volatile("" : "+s"(bar));
        __builtin_amdgcn_s_waitcnt(0);
        unsigned nloc = b.st[0], nx = b.st[1];
        if constexpr (FIRST) { if (nloc == 0u) { xcd_barrier_complete(bar, b.x, nloc, nx); b.st[0] = nloc; b.st[1] = nx; } }
        const unsigned old = xb_add(&bar[XB_XSUB(b.x)], 1u);
        const unsigned gen = old / nloc;
        if (old + 1u == (gen + 1u) * nloc) {
            __builtin_amdgcn_fence(__ATOMIC_RELEASE, "agent");
            asm volatile("s_waitcnt vmcnt(0)" ::: "memory");
            const unsigned og = xb_add(&bar[XB_TOP], 1u);
            const unsigned tg = og / nx;
            if (og + 1u == (tg + 1u) * nx) xb_add(&bar[XB_TOPGEN], 1u);
            else XB_SPIN(xb_ld(&bar[XB_TOPGEN]) == tg, bar);
            __builtin_amdgcn_fence(__ATOMIC_ACQUIRE, "agent");
            xb_add(&bar[XB_XGEN(b.x)], 1u);
            asm volatile("s_waitcnt vmcnt(0)" ::: "memory");
        } else {
            XB_SPIN(xb_ld(&bar[XB_XGEN(b.x)]) == gen, bar);
            __builtin_amdgcn_fence(__ATOMIC_ACQUIRE, "agent");
            asm volatile("s_waitcnt vmcnt(0)" ::: "memory");
        }
    }
    __syncthreads();
}
__device__ __forceinline__ void xcd_barrier(const XcdBarrier& b) { xcd_barrier_t<false>(b); }
__device__ __forceinline__ void xcd_barrier_first(const XcdBarrier& b) { xcd_barrier_t<true>(b); }

namespace pg8 {
constexpr int BM = 256, BK = 64, HALF = 128, HTB = HALF * BK * 2, STAGE_BYTES = 8 * HTB, NXCD = 8, WGM = 8;
constexpr int GK = 2048;
__host__ __device__ __forceinline__ int lds_byte(int r, int c) { const int st = (r >> 4) * 2 + (c >> 5), rr = r & 15, cc = c & 31, ob = rr * 64 + cc * 2; return st * 1024 + (ob ^ (((ob >> 9) & 1) << 5)); }
__host__ __device__ __forceinline__ void stage_rc(int b, int& R, int& C) { const int st = b / 1024, sb = b % 1024, swz = sb ^ (((sb >> 9) & 1) << 5); R = (st >> 1) * 16 + swz / 64; C = (st & 1) * 32 + (swz % 64) / 2; }
__host__ __device__ __forceinline__ int perm32(int rho) { const int n = rho >> 4, i = rho & 15; return 8 * (i >> 2) + 4 * n + (i & 3); }

struct Unit { int pm, pn, e, rowbase, colbase, oidx; const char* a; const char* b; };

struct SchedDense {
    static constexpr int RB = GK * 2;
    const char* A; const char* Bt; int nM, nN, nwg, G, c, skipctx;
    __device__ void init(const void* A_, const void* Bt_, int nM_, int nN_, int G_, int c_, int skipctx_) { A = (const char*)A_; Bt = (const char*)Bt_; nM = nM_; nN = nN_; nwg = nM * nN; G = G_; c = c_; skipctx = skipctx_; }
    __device__ bool next(int i, Unit& u) const {
        const long L = (long)i * G + c; if (L >= nwg) return false;
        int wgid = (int)L; { const int q = nwg / NXCD, r = nwg % NXCD, xcd = wgid % NXCD, off = wgid / NXCD; wgid = (xcd < r ? xcd * (q + 1) : r * (q + 1) + (xcd - r) * q) + off; }
        const int nig = WGM * nN, gid = wgid / nig, fm = gid * WGM, gsz = (nM - fm) < WGM ? (nM - fm) : WGM;
        int pm = fm + ((wgid % nig) % gsz); const int pn = (wgid % nig) / gsz;
        if (skipctx) pm = (pm >> 4) * 17 + 1 + (pm & 15);
        u.pm = pm; u.pn = pn; u.e = 0; u.rowbase = pm * BM; u.colbase = pn * BM; u.oidx = 0;
        u.a = A + (size_t)pm * (BM * GK * 2); u.b = Bt + (size_t)pn * (BM * GK * 2); return true;
    }
};
template <int RB_> struct SchedGrouped {
    static constexpr int RB = RB_;
    const char* A; const char* Bt; int nMe, nNe, nwg, G, c;
    __device__ void init(const void* A_, const void* Bt_, int nMe_, int nNe_, int G_, int c_) { A = (const char*)A_; Bt = (const char*)Bt_; nMe = nMe_; nNe = nNe_; nwg = NE * nMe * nNe; G = G_; c = c_; }
    __device__ bool next(int i, Unit& u) const {
        int e, pm, pn;
        if ((G & 255) == 0) {
            const int cpe = nNe >> 2, nchunk = NE * cpe, xcd = c & 7, slot = (c >> 3) & 31, sub = c >> 8;
            const int chunk = (i * (G >> 8) + sub) * 8 + xcd;
            if (chunk < nchunk) { e = chunk / cpe; pm = slot >> 2; pn = (chunk % cpe) * 4 + (slot & 3); }
            else { const int per = (NE * nNe) >> 3;
                if (nMe < 9 || chunk >= nchunk + 8 || slot >= per) return false; const int j = (chunk - nchunk) * per + slot; e = j / nNe; pn = j % nNe; pm = 8; }
        } else { const long L = (long)i * G + c; if (L >= nwg) return false; const int per = nMe * nNe, rem = (int)L % per; e = (int)L / per; pm = rem % nMe; pn = rem / nMe; }
        u.pm = pm; u.pn = pn; u.e = e; u.rowbase = e * ROWS_E + pm * BM; u.colbase = pn * BM; u.oidx = e * 9 + pm;
        u.a = A + (size_t)(e * ROWS_E + pm * BM) * RB; u.b = Bt + ((size_t)e * nNe + pn) * (BM * RB); return true;
    }
};

__device__ __forceinline__ unsigned cvt_pk_bf16(float lo, float hi) { unsigned r; asm volatile("v_cvt_pk_bf16_f32 %0, %1, %2" : "=v"(r) : "v"(lo), "v"(hi)); return r; }

struct EpiStoreBf16 {
    static constexpr bool PERM = true;
    bf16_t* O; int ldc;
    __device__ __forceinline__ void operator()(const f32x4 (&acc)[2][2][4][2], const Unit& u, int wr, int wc, int fr, int fq) const {
        const int row0 = u.rowbase + wr * 64 + fr, col0 = u.colbase + wc * 32 + 8 * fq;
#pragma unroll
        for (int ai = 0; ai < 2; ++ai)
#pragma unroll
            for (int m = 0; m < 4; ++m) { bf16_t* rowp = O + (size_t)(row0 + ai * HALF + m * 16) * ldc + col0;
#pragma unroll
                for (int bj = 0; bj < 2; ++bj) { const f32x4 v0 = acc[ai][bj][m][0], v1 = acc[ai][bj][m][1];
                    u32x4 w; w.x = cvt_pk_bf16(v0[0], v0[1]); w.y = cvt_pk_bf16(v0[2], v0[3]); w.z = cvt_pk_bf16(v1[0], v1[1]); w.w = cvt_pk_bf16(v1[2], v1[3]);
                    *(u32x4*)(rowp + bj * HALF) = w; } }
    }
};
struct EpiPost {
    static constexpr bool PERM = true;
    bf16_t* P; const float* rope; const float* qna; const float* kna; const float* qnc; const float* knc; const float* vnb; LAS unsigned char* tab;
    __device__ __forceinline__ void operator()(f32x4 (&acc)[2][2][4][2], const Unit& u, int wr, int wc, int fr, int fq) const {
        const int tb = u.pm % 17; const bool lat = tb != 0;
        const int d0 = 64 * (wc >> 1) + 16 * (wc & 1) + 4 * fq, rl0 = wr * 64 + fr;
        int typ[2]; const float* gain[2];
#pragma unroll
        for (int bj = 0; bj < 2; ++bj) { const int slot = 2 * u.pn + bj;
            typ[bj] = (slot < 8) ? 3 : (slot < 10) ? 0 : (slot < 14) ? 1 : (slot < 18) ? 2 : (slot < 26) ? 3 : 0;
            gain[bj] = (slot < 6) ? qna : (slot < 8) ? kna : (slot < 18) ? vnb + ((slot - 14) & 3) * 128 : (slot < 24) ? qnc : knc; }
        const bool anynorm = typ[0] >= 2 || typ[1] >= 2;
#pragma unroll
        for (int bj = 0; bj < 2; ++bj) if (typ[bj] == 1 || typ[bj] == 2) {
#pragma unroll
            for (int ai = 0; ai < 2; ++ai)
#pragma unroll
                for (int m = 0; m < 4; ++m)
#pragma unroll
                    for (int n = 0; n < 2; ++n)
#pragma unroll
                        for (int j = 0; j < 4; ++j) acc[ai][bj][m][n][j] = gelu_tanh(acc[ai][bj][m][n][j]); }
        if (anynorm) {
#pragma unroll
            for (int bj = 0; bj < 2; ++bj) if (typ[bj] >= 2) {
#pragma unroll
                for (int ai = 0; ai < 2; ++ai)
#pragma unroll
                    for (int m = 0; m < 4; ++m) { const f32x4 a = acc[ai][bj][m][0], b = acc[ai][bj][m][1];
                        float ss = ((a.x * a.x + a.y * a.y) + (a.z * a.z + a.w * a.w)) + ((b.x * b.x + b.y * b.y) + (b.z * b.z + b.w * b.w));
                        ss += __builtin_bit_cast(float, __builtin_amdgcn_ds_swizzle(__builtin_bit_cast(int, ss), 0x401F));
                        { auto rr = __builtin_amdgcn_permlane32_swap(__float_as_uint(ss), __float_as_uint(ss), false, false); ss = __uint_as_float(rr[0]) + __uint_as_float(rr[1]); }
                        if (fq == 0) *(LAS float*)(tab + (((rl0 + ai * HALF + m * 16) * 2 + bj) * 4 + wc) * 4) = ss; } }
            asm volatile("s_waitcnt lgkmcnt(0)" ::: "memory"); __builtin_amdgcn_s_barrier(); asm volatile("" ::: "memory");
        }
#pragma unroll
        for (int bj = 0; bj < 2; ++bj) {
            const int slot = 2 * u.pn + bj;
            f32x4 g0 = (f32x4){1.f, 1.f, 1.f, 1.f}, g1 = g0;
            if (typ[bj] >= 2) { g0 = *(const f32x4*)(gain[bj] + d0); g1 = *(const f32x4*)(gain[bj] + d0 + 32); }
#pragma unroll
            for (int ai = 0; ai < 2; ++ai)
#pragma unroll
                for (int m = 0; m < 4; ++m) { const int rl = rl0 + ai * HALF + m * 16;
                    f32x4 a = acc[ai][bj][m][0], b = acc[ai][bj][m][1];
                    if (typ[bj] >= 2) { const f32x4 t = *(const LAS f32x4*)(tab + ((rl * 2 + bj) * 4) * 4);
                        const float rinv = rsqrt_fast(((t.x + t.y) + (t.z + t.w)) * (1.f / 128) + EPS);
                        a = a * rinv * g0; b = b * rinv * g1; }
                    if (typ[bj] == 3 && lat) { const int pos = (tb - 1) * 256 + rl, pp = (wc >> 1) ? (pos & 63) : (pos >> 6);
                        const f32x4* cs = (const f32x4*)(rope + 2 * (pp * 32 + 16 * (wc & 1) + 4 * fq)); const f32x4 c0 = cs[0], c1 = cs[1];
                        const f32x4 cv = (f32x4){c0.x, c0.z, c1.x, c1.z}, sv = (f32x4){c0.y, c0.w, c1.y, c1.w};
                        const f32x4 ra = a * cv - b * sv, rb = b * cv + a * sv; a = ra; b = rb; }
                    bf16_t* rowp = P + (size_t)(u.rowbase + rl) * INW + slot * 128 + d0;
                    u32x2 w0, w1; w0.x = cvt_pk_bf16(a.x, a.y); w0.y = cvt_pk_bf16(a.z, a.w); w1.x = cvt_pk_bf16(b.x, b.y); w1.y = cvt_pk_bf16(b.z, b.w);
                    *(u32x2*)rowp = w0; *(u32x2*)(rowp + 32) = w1; }
        }
    }
};
struct EpiResid {
    static constexpr bool PERM = false;
    const float* ctxbase; const float* latbase; int cbs, lbs;
    float* xout; const float* modl;
    float* parts;
    __device__ __forceinline__ void operator()(const f32x4 (&acc)[2][2][4][2], const Unit& u, int wr, int wc, int fr, int fq) const {
        const int b = u.pm / 17, tb = u.pm % 17;
        const float* src = (tb == 0) ? ctxbase + (size_t)b * cbs * DM : latbase + ((size_t)b * lbs + (size_t)(tb - 1) * 256) * DM;
        const float* g1 = modl + (size_t)((tb == 0) ? 4 : b) * NMOD + 2 * DM;
        const int rl0 = wr * 64 + fr, col0 = u.colbase + wc * 32 + 4 * fq;
        f32x4 gv[2][2];
#pragma unroll
        for (int bj = 0; bj < 2; ++bj)
#pragma unroll
            for (int n = 0; n < 2; ++n) gv[bj][n] = *(const f32x4*)(g1 + col0 + bj * HALF + n * 16);
#pragma unroll
        for (int ai = 0; ai < 2; ++ai)
#pragma unroll
        for (int mh = 0; mh < 2; ++mh) {
            f32x4 xv[2][2][2];
#pragma unroll
            for (int mm = 0; mm < 2; ++mm) { const float* sp = src + (size_t)(rl0 + ai * HALF + (2 * mh + mm) * 16) * DM + col0;
#pragma unroll
                for (int bj = 0; bj < 2; ++bj)
#pragma unroll
                    for (int n = 0; n < 2; ++n) xv[mm][bj][n] = *(const f32x4*)(sp + bj * HALF + n * 16); }
#pragma unroll
            for (int mm = 0; mm < 2; ++mm) { const int m = 2 * mh + mm, rl = rl0 + ai * HALF + m * 16; float* dp = xout + (size_t)(u.rowbase + rl) * DM + col0; float ss = 0.f;
#pragma unroll
                for (int bj = 0; bj < 2; ++bj)
#pragma unroll
                    for (int n = 0; n < 2; ++n) { const f32x4 y = xv[mm][bj][n] + gv[bj][n] * acc[ai][bj][m][n]; *(f32x4*)(dp + bj * HALF + n * 16) = y;
                        ss += (y.x * y.x + y.y * y.y) + (y.z * y.z + y.w * y.w); }
                ss += __builtin_bit_cast(float, __builtin_amdgcn_ds_swizzle(__builtin_bit_cast(int, ss), 0x401F));
                { auto rr = __builtin_amdgcn_permlane32_swap(__float_as_uint(ss), __float_as_uint(ss), false, false); ss = __uint_as_float(rr[0]) + __uint_as_float(rr[1]); }
                if (fq == 0) parts[(size_t)(u.rowbase + rl) * 32 + u.pn * 4 + wc] = ss; }
            asm volatile("" ::: "memory");
        }
    }
};
struct EpiSwiGLU {
    static constexpr bool PERM = true;
    bf16_t* Hout;
    __device__ __forceinline__ void operator()(const f32x4 (&acc)[2][2][4][2], const Unit& u, int wr, int wc, int fr, int fq) const {
        const int row0 = u.rowbase + wr * 64 + fr, col0 = u.pn * HALF + wc * 32 + 8 * fq;
#pragma unroll
        for (int ai = 0; ai < 2; ++ai)
#pragma unroll
            for (int m = 0; m < 4; ++m) { bf16_t* rowp = Hout + (size_t)(row0 + ai * HALF + m * 16) * DM + col0; float h[8];
#pragma unroll
                for (int n = 0; n < 2; ++n)
#pragma unroll
                    for (int j = 0; j < 4; ++j) { const float g = acc[ai][0][m][n][j], up = acc[ai][1][m][n][j]; h[n * 4 + j] = g * __builtin_amdgcn_rcpf(1.f + __expf(-g)) * up; }
                u32x4 w; w.x = cvt_pk_bf16(h[0], h[1]); w.y = cvt_pk_bf16(h[2], h[3]); w.z = cvt_pk_bf16(h[4], h[5]); w.w = cvt_pk_bf16(h[6], h[7]);
                *(u32x4*)rowp = w; }
    }
};
struct EpiSwiGLU8 {
    static constexpr bool PERM = true;
    unsigned char* Hout;
    __device__ __forceinline__ void operator()(const f32x4 (&acc)[2][2][4][2], const Unit& u, int wr, int wc, int fr, int fq) const {
        const int row0 = u.rowbase + wr * 64 + fr, col0 = u.pn * HALF + wc * 32 + 8 * fq;
#pragma unroll
        for (int ai = 0; ai < 2; ++ai)
#pragma unroll
            for (int m = 0; m < 4; ++m) { unsigned char* rowp = Hout + (size_t)(row0 + ai * HALF + m * 16) * DM + col0; float h[8];
#pragma unroll
                for (int n = 0; n < 2; ++n)
#pragma unroll
                    for (int j = 0; j < 4; ++j) { const float g = acc[ai][0][m][n][j], up = acc[ai][1][m][n][j]; h[n * 4 + j] = g * __builtin_amdgcn_rcpf(1.f + __expf(-g)) * up; }
                u32x2 w; w.x = pk4_fp8(h[0], h[1], h[2], h[3]); w.y = pk4_fp8(h[4], h[5], h[6], h[7]);
                *(u32x2*)rowp = w; }
    }
};
struct EpiDown {
    static constexpr bool PERM = true;
    bf16_t* Y; const float* gatev;
    __device__ __forceinline__ void operator()(const f32x4 (&acc)[2][2][4][2], const Unit& u, int wr, int wc, int fr, int fq) const {
        const int row0 = u.rowbase + wr * 64 + fr, col0 = u.colbase + wc * 32 + 8 * fq;
#pragma unroll
        for (int ai = 0; ai < 2; ++ai)
#pragma unroll
            for (int m = 0; m < 4; ++m) { const int row = row0 + ai * HALF + m * 16; const float gt = gatev[row]; bf16_t* rowp = Y + (size_t)row * DM + col0;
#pragma unroll
                for (int bj = 0; bj < 2; ++bj) { const f32x4 v0 = acc[ai][bj][m][0] * gt, v1 = acc[ai][bj][m][1] * gt;
                    u32x4 w; w.x = cvt_pk_bf16(v0[0], v0[1]); w.y = cvt_pk_bf16(v0[2], v0[3]); w.z = cvt_pk_bf16(v1[0], v1[1]); w.w = cvt_pk_bf16(v1[2], v1[3]);
                    *(u32x4*)(rowp + bj * HALF) = w; } }
    }
};

template <class Epi, class Sched, bool FP8 = false, bool GATHER = false, bool ALIGN_EPI = true, bool SP2 = true>
__device__ __forceinline__ void gemm_phase(LAS unsigned char* lds, const Sched& S, const Epi& E, const unsigned* goffs = nullptr, LAS unsigned char* goffs_lds = nullptr) {
    static_assert(!GATHER || SP2, "gather mode is written for the SP2 loop");
    static_assert(Sched::RB == (FP8 ? GK : GK * 2), "operand row bytes");
    const int tid = opaque_tid(), wid = __builtin_amdgcn_readfirstlane(tid >> 6), lane = tid & 63, wr = wid >> 2, wc = wid & 3, fr = lane & 15, fq = lane >> 4;
    constexpr int RB = Sched::RB, nt = RB / 128;
    unsigned voffA[2], voffB[2];
#pragma unroll
    for (int i = 0; i < 2; ++i) { int R, C; stage_rc(tid * 16 + i * 8192, R, C); const int Rb = Epi::PERM ? ((R & ~31) + perm32(R & 31)) : R;
        voffA[i] = (unsigned)(R * RB + C * 2); voffB[i] = (unsigned)(Rb * RB + C * 2); }
    const size_t kstep = (size_t)(BK * 2);
    const size_t hstep = (size_t)HALF * RB;
    const unsigned ldsw = (unsigned)wid * 1024u;
    const int aoff = lds_byte(wr * 64 + fr, fq * 8), boff = lds_byte(wc * 32 + fr, fq * 8);
#define PG8_SA(b, h) (((b) * 2 + (h)) * HTB)
#define PG8_SB(b, h) ((4 + (b) * 2 + (h)) * HTB)
#define PG8_STAGE(bufoff, gbase, voff) do { _Pragma("unroll") for (int _i = 0; _i < 2; ++_i) \
        __builtin_amdgcn_global_load_lds((const unsigned*)((const char*)(gbase) + (voff)[_i]), (LAS unsigned*)(lds + (bufoff) + ldsw + _i * 8192), 16, 0, 0); } while (0)
#define PG8_RD8(p) __builtin_shufflevector(*(const LAS i32x4*)(p), *(const LAS i32x4*)((p) + 1024), 0, 1, 2, 3, 4, 5, 6, 7)
#define PG8_LDA(dst, b, h) do { _Pragma("unroll") for (int m = 0; m < 4; ++m) { if constexpr (FP8) dst##8[m] = PG8_RD8(lds + PG8_SA(b, h) + aoff + m * 2048); \
        else { _Pragma("unroll") for (int k = 0; k < 2; ++k) dst[m][k] = *(const LAS bf16x8*)(lds + PG8_SA(b, h) + aoff + m * 2048 + k * 1024); } } } while (0)
#define PG8_LDB(dst, b, h) do { _Pragma("unroll") for (int n = 0; n < 2; ++n) { if constexpr (FP8) dst##8[n] = PG8_RD8(lds + PG8_SB(b, h) + boff + n * 2048); \
        else { _Pragma("unroll") for (int k = 0; k < 2; ++k) dst[n][k] = *(const LAS bf16x8*)(lds + PG8_SB(b, h) + boff + n * 2048 + k * 1024); } } } while (0)
#define PG8_MMA(ai, bj, At, Bt) do { __builtin_amdgcn_s_setprio(1); _Pragma("unroll") for (int m = 0; m < 4; ++m) _Pragma("unroll") for (int n = 0; n < 2; ++n) { \
        if constexpr (FP8) asm volatile("v_mfma_scale_f32_16x16x128_f8f6f4 %0, %1, %2, %0, %3, %4 op_sel_hi:[0,0,0]" : "+v"(acc[ai][bj][m][n]) : "v"(Bt##8[n]), "v"(At##8[m]), "v"(sclW), "v"(sclX)); \
        else { _Pragma("unroll") for (int k = 0; k < 2; ++k) acc[ai][bj][m][n] = __builtin_amdgcn_mfma_f32_16x16x32_bf16(Bt[n][k], At[m][k], acc[ai][bj][m][n], 0, 0, 0); } } \
        __builtin_amdgcn_s_setprio(0); } while (0)
#define PG8_WAIT_V(n) asm volatile("s_waitcnt vmcnt(" #n ")" ::: "memory")
#define PG8_WAIT_L(n) asm volatile("s_waitcnt lgkmcnt(" #n ")" ::: "memory")
#define PG8_BAR __builtin_amdgcn_s_barrier()
#define PG8_SCHED __builtin_amdgcn_sched_barrier(0)
    Unit cur, nxt; int ui = 0;
    if (!S.next(0, cur)) return;
    u32x4 gC = (u32x4){0u, 0u, 0u, 0u}, gN = gC;
    if constexpr (GATHER) gC = *(const u32x4*)(goffs + ((size_t)cur.oidx * 512 + tid) * 4);
#define PG8_GSTAGE(bufoff, gbase, o0, o1) do { \
        __builtin_amdgcn_global_load_lds((const unsigned*)((const char*)(gbase) + (o0)), (LAS unsigned*)(lds + (bufoff) + ldsw), 16, 0, 0); \
        __builtin_amdgcn_global_load_lds((const unsigned*)((const char*)(gbase) + (o1)), (LAS unsigned*)(lds + (bufoff) + ldsw + 8192), 16, 0, 0); } while (0)
    f32x4 acc[2][2][4][2];
#pragma unroll
    for (int a = 0; a < 2; ++a)
#pragma unroll
        for (int b = 0; b < 2; ++b)
#pragma unroll
            for (int m = 0; m < 4; ++m)
#pragma unroll
                for (int n = 0; n < 2; ++n) acc[a][b][m][n] = (f32x4){0.f, 0.f, 0.f, 0.f};
    int sclW = W8_SCALE_E8M0 * 0x01010101, sclX = 0x7f7f7f7f; if constexpr (FP8) asm volatile("" : "+v"(sclW), "+v"(sclX)); (void)sclW; (void)sclX;
    bf16x8 At[4][2], B0[2][2], B1[2][2]; i32x8 At8[4], B08[2], B18[2];
    const char* cA = cur.a; const char* cB = cur.b;
    if constexpr (SP2) {
        PG8_STAGE(PG8_SB(0, 0), cB, voffB); PG8_STAGE(PG8_SB(0, 1), cB + hstep, voffB);
        if constexpr (GATHER) { PG8_GSTAGE(PG8_SA(0, 0), S.A, gC.x, gC.y); PG8_GSTAGE(PG8_SA(0, 1), S.A, gC.z, gC.w); }
        else { PG8_STAGE(PG8_SA(0, 0), cA, voffA); PG8_STAGE(PG8_SA(0, 1), cA + hstep, voffA); }
        if (wr == 1) PG8_BAR;
        PG8_WAIT_V(2); PG8_BAR;
        PG8_STAGE(PG8_SB(1, 0), cB + kstep, voffB);
        if constexpr (GATHER) PG8_GSTAGE(PG8_SA(1, 0), S.A + kstep, gC.x, gC.y); else PG8_STAGE(PG8_SA(1, 0), cA + kstep, voffA);
        PG8_STAGE(PG8_SB(1, 1), cB + hstep + kstep, voffB);
        PG8_WAIT_V(6); PG8_BAR;
    } else {
        PG8_STAGE(PG8_SB(0, 0), cB, voffB); PG8_STAGE(PG8_SA(0, 0), cA, voffA); PG8_STAGE(PG8_SB(0, 1), cB + hstep, voffB); PG8_STAGE(PG8_SA(0, 1), cA + hstep, voffA);
        if (wr == 1) PG8_BAR;
        PG8_WAIT_V(4); PG8_BAR;
        PG8_STAGE(PG8_SB(1, 0), cB + kstep, voffB); PG8_STAGE(PG8_SA(1, 0), cA + kstep, voffA); PG8_STAGE(PG8_SB(1, 1), cB + hstep + kstep, voffB);
        PG8_WAIT_V(6); PG8_BAR;
    }
    for (;;) {
        const bool has_next = S.next(ui + 1, nxt);
        const char* nA = has_next ? nxt.a : cA; const char* nB = has_next ? nxt.b : cB;
        if constexpr (GATHER) { if (has_next)
            __builtin_amdgcn_global_load_lds((const unsigned*)(goffs + ((size_t)nxt.oidx * 512 + tid) * 4), (LAS unsigned*)(goffs_lds + ldsw), 16, 0, 0); }
        for (int t = 0; t < nt; t += 2) {
            const bool last = (t == nt - 2);
            const char* a1 = cA + (size_t)(t + 1) * kstep;
            const char* a2 = last ? nA : cA + (size_t)(t + 2) * kstep; const char* b2 = last ? nB : cB + (size_t)(t + 2) * kstep;
            const char* a3 = a2 + kstep; const char* b3 = b2 + kstep;
            const char* g1 = S.A + (size_t)(t + 1) * kstep; const char* g2 = S.A + (last ? (size_t)0 : (size_t)(t + 2) * kstep); const char* g3 = g2 + kstep;
            u32x4 gX = gC;
            if constexpr (GATHER) { if (last) { if (has_next) gN = *(const LAS u32x4*)(goffs_lds + (size_t)tid * 16); else gN = gC; gX = gN; } }
            if constexpr (SP2) {
            PG8_LDB(B0, 0, 0); PG8_LDB(B1, 0, 1); PG8_SCHED; PG8_LDA(At, 0, 0);
            if constexpr (GATHER) PG8_GSTAGE(PG8_SA(1, 1), g1, gC.z, gC.w); else PG8_STAGE(PG8_SA(1, 1), a1 + hstep, voffA);
            PG8_WAIT_V(8); PG8_WAIT_L(0); PG8_BAR; PG8_MMA(0, 0, At, B0); PG8_MMA(0, 1, At, B1); PG8_BAR; PG8_SCHED;
            PG8_LDA(At, 0, 1); PG8_STAGE(PG8_SB(0, 0), b2, voffB); PG8_STAGE(PG8_SB(0, 1), b2 + hstep, voffB);
            if constexpr (GATHER) PG8_GSTAGE(PG8_SA(0, 0), g2, gX.x, gX.y); else PG8_STAGE(PG8_SA(0, 0), a2, voffA);
            PG8_WAIT_V(8); PG8_WAIT_L(0); PG8_BAR; PG8_MMA(1, 0, At, B0); PG8_MMA(1, 1, At, B1); PG8_BAR; PG8_SCHED;
            PG8_LDB(B0, 1, 0); PG8_LDB(B1, 1, 1); PG8_SCHED; PG8_LDA(At, 1, 0);
            if constexpr (GATHER) PG8_GSTAGE(PG8_SA(0, 1), g2, gX.z, gX.w); else PG8_STAGE(PG8_SA(0, 1), a2 + hstep, voffA);
            PG8_WAIT_V(8); PG8_WAIT_L(0); PG8_BAR; PG8_MMA(0, 0, At, B0); PG8_MMA(0, 1, At, B1); PG8_BAR; PG8_SCHED;
            PG8_LDA(At, 1, 1); PG8_STAGE(PG8_SB(1, 0), b3, voffB); PG8_STAGE(PG8_SB(1, 1), b3 + hstep, voffB);
            if constexpr (GATHER) PG8_GSTAGE(PG8_SA(1, 0), g3, gX.x, gX.y); else PG8_STAGE(PG8_SA(1, 0), a3, voffA);
            PG8_WAIT_V(8); PG8_WAIT_L(0); PG8_BAR; PG8_MMA(1, 0, At, B0); PG8_MMA(1, 1, At, B1); PG8_BAR; PG8_SCHED;
            } else {
            PG8_LDB(B0, 0, 0); PG8_SCHED; PG8_LDA(At, 0, 0); PG8_STAGE(PG8_SA(1, 1), a1 + hstep, voffA);
            PG8_WAIT_L(8); PG8_BAR; PG8_WAIT_L(0); PG8_MMA(0, 0, At, B0); PG8_BAR; PG8_SCHED;
            PG8_LDB(B1, 0, 1); PG8_STAGE(PG8_SB(0, 0), b2, voffB);
            PG8_BAR; PG8_WAIT_L(0); PG8_MMA(0, 1, At, B1); PG8_BAR;
            PG8_LDA(At, 0, 1); PG8_STAGE(PG8_SA(0, 0), a2, voffA);
            PG8_BAR; PG8_WAIT_L(0); PG8_MMA(1, 0, At, B0); PG8_BAR; PG8_SCHED;
            PG8_STAGE(PG8_SB(0, 1), b2 + hstep, voffB);
            PG8_WAIT_V(6); PG8_BAR; PG8_MMA(1, 1, At, B1); PG8_BAR;
            PG8_LDB(B0, 1, 0); PG8_SCHED; PG8_LDA(At, 1, 0); PG8_STAGE(PG8_SA(0, 1), a2 + hstep, voffA);
            PG8_WAIT_L(8); PG8_BAR; PG8_WAIT_L(0); PG8_MMA(0, 0, At, B0); PG8_BAR; PG8_SCHED;
            PG8_LDB(B1, 1, 1); PG8_STAGE(PG8_SB(1, 0), b3, voffB);
            PG8_BAR; PG8_WAIT_L(0); PG8_MMA(0, 1, At, B1); PG8_BAR;
            PG8_LDA(At, 1, 1); PG8_STAGE(PG8_SA(1, 0), a3, voffA);
            PG8_BAR; PG8_WAIT_L(0); PG8_MMA(1, 0, At, B0); PG8_BAR; PG8_SCHED;
            PG8_STAGE(PG8_SB(1, 1), b3 + hstep, voffB);
            PG8_WAIT_V(6); PG8_BAR; PG8_MMA(1, 1, At, B1); PG8_BAR;
            }
        }
        if constexpr (ALIGN_EPI) { if (wr == 0) PG8_BAR; }
        if constexpr (FP8) asm volatile("s_nop 15\n\ts_nop 15\n\ts_nop 7" ::: "memory");
        E(acc, cur, wr, wc, fr, fq);
        if (!has_next) break;
#pragma unroll
        for (int a = 0; a < 2; ++a)
#pragma unroll
            for (int b = 0; b < 2; ++b)
#pragma unroll
                for (int m = 0; m < 4; ++m)
#pragma unroll
                    for (int n = 0; n < 2; ++n) acc[a][b][m][n] = (f32x4){0.f, 0.f, 0.f, 0.f};
        cur = nxt; cA = nA; cB = nB; ++ui; gC = gN;
        if constexpr (ALIGN_EPI) { if (wr == 1) PG8_BAR; }
    }
    PG8_WAIT_V(0);
    if constexpr (!ALIGN_EPI) { if (wr == 0) PG8_BAR; }
    PG8_BAR;
#undef PG8_SA
#undef PG8_SB
#undef PG8_STAGE
#undef PG8_GSTAGE
#undef PG8_LDA
#undef PG8_LDB
#undef PG8_MMA
#undef PG8_RD8
#undef PG8_WAIT_V
#undef PG8_WAIT_L
#undef PG8_BAR
#undef PG8_SCHED
}
}

namespace at {
constexpr int D = 128, NW = 8, QBLK = 32, KVBLK = 64;
constexpr float SCALE = 0.088388347648318440f;
constexpr float THR = 8.f;
constexpr int LDQ = INW, LDK = INW, LDO = DM;
constexpr size_t SHM_V = KVBLK * D * 2, SHM_K = KVBLK * D * 2, SHM_ATTN = 2 * SHM_V + 2 * SHM_K + NW * 64 * 4;
#define KSWZ(row, colB) ((row) * 256 + ((colB) ^ (((row) & 7) << 4)))
#define SBAR() __builtin_amdgcn_sched_barrier(0)
__device__ __forceinline__ int crow(int r, int hi) { return (r & 3) + 8 * (r >> 2) + 4 * hi; }
__device__ __forceinline__ unsigned cvtpk(float lo, float hi) { unsigned r; asm volatile("v_cvt_pk_bf16_f32 %0, %1, %2" : "=v"(r) : "v"(lo), "v"(hi)); return r; }

__device__ __forceinline__ void partialSM(f32x16& p0, f32x16& p1, float& m_reg, float& mn, float& alpha, bool domask, int dq, int hi) {
  constexpr float C = SCALE * 1.4426950408889634f;
  {
    if (domask) {
#pragma unroll
      for (int r = 0; r < 16; ++r) { const int d0 = dq + crow(r, hi), d1 = d0 + 32;
        if (d0 > 128 || d0 < -128) p0[r] = -1e30f;
        if (d1 > 128 || d1 < -128) p1[r] = -1e30f; }
    }
  }
  float pmax = p0[0]; for (int r = 1; r < 16; ++r) pmax = fmaxf(pmax, p0[r]); for (int r = 0; r < 16; ++r) pmax = fmaxf(pmax, p1[r]);
  { auto rr = __builtin_amdgcn_permlane32_swap(__float_as_uint(pmax), __float_as_uint(pmax), false, false);
    pmax = fmaxf(__uint_as_float(rr[0]), __uint_as_float(rr[1])); }
  if (__builtin_expect(__all(pmax - m_reg <= THR / SCALE), 1)) { mn = m_reg; alpha = 1.f; }
  else { mn = fmaxf(m_reg, pmax); alpha = __builtin_amdgcn_exp2f((m_reg - mn) * C); m_reg = mn; }
  float mnC = -mn * C;
  for (int r = 0; r < 16; ++r) p0[r] = fmaf(p0[r], C, mnC); for (int r = 0; r < 16; ++r) p1[r] = fmaf(p1[r], C, mnC);
  for (int r = 0; r < 16; ++r) p0[r] = __builtin_amdgcn_exp2f(p0[r]);
}
__device__ __forceinline__ void finishSM(f32x16& p0, f32x16& p1, float alpha, float& l_reg, bf16x8& pa0, bf16x8& pa1, bf16x8& pa2, bf16x8& pa3) {
  for (int r = 0; r < 16; ++r) p1[r] = __builtin_amdgcn_exp2f(p1[r]);
  float ps = 0; for (int r = 0; r < 16; ++r) ps += p0[r]; for (int r = 0; r < 16; ++r) ps += p1[r];
  { auto rr = __builtin_amdgcn_permlane32_swap(__float_as_uint(ps), __float_as_uint(ps), false, false);
    ps = __uint_as_float(rr[0]) + __uint_as_float(rr[1]); }
  l_reg = l_reg * alpha + ps;
#define PK4(P, BASE, OUT) do { unsigned a0 = cvtpk(P[BASE + 0], P[BASE + 1]), a1 = cvtpk(P[BASE + 2], P[BASE + 3]);   \
    unsigned b0 = cvtpk(P[BASE + 4], P[BASE + 5]), b1 = cvtpk(P[BASE + 6], P[BASE + 7]);                              \
    auto r0 = __builtin_amdgcn_permlane32_swap(a0, b0, false, false); auto r1 = __builtin_amdgcn_permlane32_swap(a1, b1, false, false); \
    u32x4 w = {r0[0], r1[0], r0[1], r1[1]}; OUT = *reinterpret_cast<bf16x8*>(&w); } while (0)
  PK4(p0, 0, pa0); PK4(p0, 8, pa1); PK4(p1, 0, pa2); PK4(p1, 8, pa3);
#undef PK4
}
__device__ __forceinline__ void qkt(f32x16& p0, f32x16& p1, const char* Ks, const bf16x8* qr, int ka0) {
  p0 = f32x16{}; p1 = f32x16{};
  asm volatile("" : "+v"(ka0));
#pragma unroll
  for (int d0 = 0; d0 < 8; ++d0) { const int off = ka0 ^ (d0 * 32);
    bf16x8 b0 = *reinterpret_cast<const bf16x8*>(Ks + off);
    bf16x8 b1 = *reinterpret_cast<const bf16x8*>(Ks + off + 32 * 256);
    p0 = __builtin_amdgcn_mfma_f32_32x32x16_bf16(b0, qr[d0], p0, 0, 0, 0);
    p1 = __builtin_amdgcn_mfma_f32_32x32x16_bf16(b1, qr[d0], p1, 0, 0, 0); }
}
__device__ __forceinline__ int v_st(int k, int c) { const int kk = (k & ~0xC) | ((k & 4) << 1) | ((k & 8) >> 1); return ((kk >> 3) * 4 + (c >> 5)) * 512 + ((kk & 7) * 32 + (c & 31)) * 2; }
__device__ __forceinline__ int v_rd_base(int lane) { return ((lane & 3) << 3) | (((lane >> 2) & 3) << 6) | (((lane >> 4) & 1) << 5) | (((lane >> 5) & 1) << 8); }
constexpr int v_rd_off(int d0, int ks, int half) { return d0 * 512 + ks * 4096 + half * 2048; }
template <int OFF> __device__ __forceinline__ s16x4 tr_read(int vb) {
  s16x4 r; asm volatile("ds_read_b64_tr_b16 %0, %1 offset:%2" : "=&v"(r) : "v"(vb), "i"(OFF) : "memory"); return r;
}
template <int D0> __device__ __forceinline__ void pv_one(f32x16& od, int vb, bf16x8 pa0, bf16x8 pa1, bf16x8 pa2, bf16x8 pa3) {
  const s16x4 l0 = tr_read<v_rd_off(D0, 0, 0)>(vb), h0 = tr_read<v_rd_off(D0, 0, 1)>(vb), l1 = tr_read<v_rd_off(D0, 1, 0)>(vb), h1 = tr_read<v_rd_off(D0, 1, 1)>(vb);
  const s16x4 l2 = tr_read<v_rd_off(D0, 2, 0)>(vb), h2 = tr_read<v_rd_off(D0, 2, 1)>(vb), l3 = tr_read<v_rd_off(D0, 3, 0)>(vb), h3 = tr_read<v_rd_off(D0, 3, 1)>(vb);
  asm volatile("s_waitcnt lgkmcnt(0)" ::: "memory"); SBAR();
#define PK(L, H) (bf16x8){L[0], L[1], L[2], L[3], H[0], H[1], H[2], H[3]}
  od = __builtin_amdgcn_mfma_f32_32x32x16_bf16(pa0, PK(l0, h0), od, 0, 0, 0);
  od = __builtin_amdgcn_mfma_f32_32x32x16_bf16(pa1, PK(l1, h1), od, 0, 0, 0);
  od = __builtin_amdgcn_mfma_f32_32x32x16_bf16(pa2, PK(l2, h2), od, 0, 0, 0);
  od = __builtin_amdgcn_mfma_f32_32x32x16_bf16(pa3, PK(l3, h3), od, 0, 0, 0);
#undef PK
}
__device__ __forceinline__ void pv_d0(f32x16* o, int vb, bf16x8 pa0, bf16x8 pa1, bf16x8 pa2, bf16x8 pa3) {
  pv_one<0>(o[0], vb, pa0, pa1, pa2, pa3); pv_one<1>(o[1], vb, pa0, pa1, pa2, pa3); pv_one<2>(o[2], vb, pa0, pa1, pa2, pa3); pv_one<3>(o[3], vb, pa0, pa1, pa2, pa3);
}

__device__ __forceinline__ void attn_body(const bf16_t* __restrict__ Qb, const bf16_t* __restrict__ Kb, const bf16_t* __restrict__ Vb, bf16_t* __restrict__ Ob,
                                          int NT, int kskip, int qpos0, float m0, float l0, bool maskon, char* lds) {
  const int tid = opaque_tid(), wid = tid >> 6, lane = tid & 63, r32 = lane & 31, hi = lane >> 5;
  char* V_lds = lds; char* K_lds = lds + 2 * SHM_V;
  float* ws = (float*)(lds + 2 * SHM_V + 2 * SHM_K) + wid * 64; float* li_l = ws; float* al_l = ws + 32;
  float m_reg = m0, l_reg = l0; f32x16 o[4] = {}; bf16x8 qr[8];
  const bf16_t* Qw = Qb + (long)(wid * QBLK + r32) * LDQ + hi * 8;
#pragma unroll
  for (int d0 = 0; d0 < 8; ++d0) qr[d0] = *reinterpret_cast<const bf16x8*>(Qw + d0 * 16);
  const int sr = tid >> 4, sc = (tid & 15) * 8, vst0 = v_st(sr, sc), kst0 = KSWZ(sr, sc * 2);
  const int vb0 = (int)(uintptr_t)V_lds + v_rd_base(lane);
  const int qpos = qpos0 + wid * QBLK + r32;
  const int ka0 = r32 * 256 + ((hi * 16) ^ ((r32 & 7) << 4));
  const unsigned goff0 = (unsigned)(sr * LDK + sc) * 2u, goff1 = goff0 + 32u * LDK * 2u;
  struct { bf16x8 vs0, vs1, ks0, ks1; } sr_[1];
#define TROW(jt) ((long)(jt) * KVBLK + ((jt) >= 4 ? kskip : 0))
#define SLOAD(i, jt) do { const long _k0 = TROW(jt) * (LDK * 2); const char* _kp = (const char*)Kb + _k0; const char* _vp = (const char*)Vb + _k0; \
    sr_[i].vs0 = *reinterpret_cast<const bf16x8*>(_vp + goff0); sr_[i].vs1 = *reinterpret_cast<const bf16x8*>(_vp + goff1); \
    sr_[i].ks0 = *reinterpret_cast<const bf16x8*>(_kp + goff0); sr_[i].ks1 = *reinterpret_cast<const bf16x8*>(_kp + goff1); } while (0)
#define SWRITE(b, i) do { *(bf16x8*)(V_lds + (b) * SHM_V + vst0) = sr_[i].vs0;          \
    *(bf16x8*)(V_lds + (b) * SHM_V + vst0 + 8192) = sr_[i].vs1;                         \
    *(bf16x8*)(K_lds + (b) * SHM_K + kst0) = sr_[i].ks0;                               \
    *(bf16x8*)(K_lds + (b) * SHM_K + kst0 + 8192) = sr_[i].ks1; } while (0)
#define SWAIT() asm volatile("s_waitcnt vmcnt(0)" ::: "memory")
#define RESC(a) do { if (__any((a) < 1.f)) { if (hi == 0) al_l[r32] = (a); asm volatile("s_waitcnt lgkmcnt(0)" ::: "memory"); \
    for (int d = 0; d < 4; ++d) for (int r = 0; r < 16; ++r) o[d][r] *= al_l[crow(r, hi)]; } } while (0)
#define DQ(jt) (kskip + ((jt) - 4) * KVBLK - qpos)
  f32x16 pA0, pA1, pB0, pB1; float mnA, mnB, alA, alB; bf16x8 pa0, pa1, pa2, pa3;
  constexpr int SE = 0, SO = 0;
  SLOAD(SE, 0); asm volatile("s_waitcnt vmcnt(0)" ::: "memory"); SWRITE(0, SE); __syncthreads();
  qkt(pA0, pA1, K_lds, qr, ka0); partialSM(pA0, pA1, m_reg, mnA, alA, false, 0, hi);
  SLOAD(SO, 1);
  SWAIT(); SWRITE(1, SO); __syncthreads();
  for (int j = 1; j + 1 < NT; j += 2) {
    SBAR(); qkt(pB0, pB1, K_lds + SHM_K, qr, ka0);
    finishSM(pA0, pA1, alA, l_reg, pa0, pa1, pa2, pa3); SBAR();
    SLOAD(SO, j + 1); SBAR();
    pv_d0(o, vb0, pa0, pa1, pa2, pa3); partialSM(pB0, pB1, m_reg, mnB, alB, maskon && j >= 4, DQ(j), hi);
    __syncthreads(); SWAIT(); SWRITE(0, SE);
    RESC(alB); __syncthreads();
    SBAR(); qkt(pA0, pA1, K_lds, qr, ka0);
    finishSM(pB0, pB1, alB, l_reg, pa0, pa1, pa2, pa3); SBAR();
    SLOAD(SE, j + 2); SBAR();
    pv_d0(o, vb0 + (int)SHM_V, pa0, pa1, pa2, pa3); partialSM(pA0, pA1, m_reg, mnA, alA, maskon && j + 1 >= 4, DQ(j + 1), hi);
    __syncthreads(); SWAIT(); SWRITE(1, SO);
    RESC(alA); __syncthreads();
  }
  SBAR(); qkt(pB0, pB1, K_lds + SHM_K, qr, ka0);
  finishSM(pA0, pA1, alA, l_reg, pa0, pa1, pa2, pa3); SBAR();
  pv_d0(o, vb0, pa0, pa1, pa2, pa3); partialSM(pB0, pB1, m_reg, mnB, alB, maskon && NT - 1 >= 4, DQ(NT - 1), hi);
  __syncthreads(); RESC(alB);
  finishSM(pB0, pB1, alB, l_reg, pa0, pa1, pa2, pa3); SBAR();
  pv_d0(o, vb0 + (int)SHM_V, pa0, pa1, pa2, pa3);
  if (hi == 0) li_l[r32] = l_reg; asm volatile("s_waitcnt lgkmcnt(0)" ::: "memory");
  float rli[16];
#pragma unroll
  for (int r = 0; r < 16; ++r) rli[r] = __builtin_amdgcn_rcpf(li_l[crow(r, hi)]);
  bf16_t* Ow = Ob + (long)(wid * QBLK) * LDO;
#pragma unroll
  for (int r = 0; r < 16; ++r) { int orow = crow(r, hi);
    for (int d0 = 0; d0 < 4; ++d0) Ow[(long)orow * LDO + d0 * 32 + r32] = (bf16_t)f2bf(o[d0][r] * rli[r]); }
#undef TROW
#undef SLOAD
#undef SWRITE
#undef SWAIT
#undef RESC
#undef DQ
}
}

struct Args { const float* in[23]; float* out; unsigned char* ws; int ph_lo, ph_hi; };
enum { IN_X = 0, IN_C, IN_CTX, IN_CCTX, IN_WMOD, IN_BMOD, IN_N1G, IN_N2G, IN_WIN, IN_QNA, IN_KNA, IN_SINK, IN_VNB, IN_WS, IN_BS, IN_QNC, IN_KNC, IN_OUTG, IN_WOUT, IN_WR, IN_WG, IN_WU, IN_WDN };

#define PHASE_IDS(F) const int tid = opaque_tid(), lane = tid & 63, wave = __builtin_amdgcn_readfirstlane(tid >> 6), gw = (int)blockIdx.x * 8 + wave, NGW = (F).G * 8; (void)lane; (void)wave; (void)gw; (void)NGW
constexpr int ARGTAB_OFF = LDSCTL_OFF + 1024;
#define INP(F, i) ld_inp((F).lds, (i))
__device__ __forceinline__ const float* ld_inp(LAS unsigned char* lds, int i) {
    unsigned a = (unsigned)(uintptr_t)(lds + ARGTAB_OFF) + 8u * (unsigned)i;
    asm volatile("" : "+v"(a));
    const volatile LAS unsigned* t = (const volatile LAS unsigned*)(uintptr_t)a;
    const unsigned lo = __builtin_amdgcn_readfirstlane(t[0]), hi = __builtin_amdgcn_readfirstlane(t[1]);
    return (const float*)(const GAS float*)(((unsigned long long)hi << 32) | lo);
}
struct Frame {
    LAS unsigned char* lds; char* ldsg;
    volatile LAS unsigned* MISC;
    unsigned* ctl;
    int G;
    float* out; unsigned char* ws;
};

__host__ __device__ __forceinline__ int headpos(int d) { return 32 * (2 * (d >> 6) + ((d >> 4) & 1)) + 8 * ((d >> 2) & 3) + 4 * ((d >> 5) & 1) + (d & 3); }
template <bool HEADPERM = false>
__device__ __forceinline__ void transpose_item(const float* W, int N, bf16_t* WT, int k0, int n0, int drow0, LAS float* scr, int lane) {
    { float t[32]; const float* wp = W + (size_t)(k0 + (lane >> 5)) * N + n0 + (lane & 31);
#pragma unroll
      for (int i = 0; i < 32; ++i) t[i] = wp[(size_t)(2 * i) * N];
#pragma unroll
      for (int i = 0; i < 32; ++i) scr[(2 * i + (lane >> 5)) * 33 + (lane & 31)] = t[i]; }
    LDS_WAIT(); asm volatile("" ::: "memory");
    const int c = lane & 7;
#pragma unroll
    for (int j = 0; j < 4; ++j) { const int n = (lane >> 3) + 8 * j; const LAS float* s = scr + (8 * c) * 33 + n;
        u32x4 o; o.x = pk2(s[0 * 33], s[1 * 33]); o.y = pk2(s[2 * 33], s[3 * 33]); o.z = pk2(s[4 * 33], s[5 * 33]); o.w = pk2(s[6 * 33], s[7 * 33]);
        const int drow = HEADPERM ? ((drow0 + n) & ~127) + headpos((drow0 + n) & 127) : drow0 + n;
        *(u32x4*)(WT + (size_t)drow * DM + k0 + 8 * c) = o; }
    LDS_WAIT(); asm volatile("" ::: "memory");
}

__device__ __forceinline__ void transpose_item8(const float* W, int N, unsigned char* WT, int k0, int n0, int drow0, LAS float* scr, int lane) {
    { float t[32]; const float* wp = W + (size_t)(k0 + (lane >> 5)) * N + n0 + (lane & 31);
#pragma unroll
      for (int i = 0; i < 32; ++i) t[i] = wp[(size_t)(2 * i) * N];
#pragma unroll
      for (int i = 0; i < 32; ++i) scr[(2 * i + (lane >> 5)) * 33 + (lane & 31)] = t[i]; }
    LDS_WAIT(); asm volatile("" ::: "memory");
    const int c = lane & 7;
#pragma unroll
    for (int j = 0; j < 4; ++j) { const int n = (lane >> 3) + 8 * j; const LAS float* s = scr + (8 * c) * 33 + n;
        u32x2 o; o.x = pk4_fp8(s[0 * 33] * W8_SCALE, s[1 * 33] * W8_SCALE, s[2 * 33] * W8_SCALE, s[3 * 33] * W8_SCALE); o.y = pk4_fp8(s[4 * 33] * W8_SCALE, s[5 * 33] * W8_SCALE, s[6 * 33] * W8_SCALE, s[7 * 33] * W8_SCALE);
        *(u32x2*)(WT + (size_t)(drow0 + n) * DM + k0 + 8 * c) = o; }
    LDS_WAIT(); asm volatile("" ::: "memory");
}
__device__ __forceinline__ void conv_tile(Frame& F, int tl, int tid, int lane, int wave) {
    const int mat = tl >> 7, kb = (tl & 127) >> 3, nb = tl & 7, le = mat / 3, wh = mat % 3;
    const float* src = INP(F, wh == 0 ? IN_WG : wh == 1 ? IN_WU : IN_WDN) + (size_t)le * DM * DM + (size_t)(128 * kb) * DM + 256 * nb;
    unsigned char* dst = (wh < 2) ? F.ws + WS_WGU + (size_t)(le / NE) * NE * 4096 * DM * 2 + (size_t)(le % NE) * 4096 * DM + (size_t)(2 * nb) * 256 * DM + 128 * kb
                                  : F.ws + WS_WD + (size_t)(le / NE) * NE * DM * DM * 2 + (size_t)(le % NE) * DM * DM + (size_t)(256 * nb) * DM + 128 * kb;
    f32x4 t[16];
    { const float* wp = src + (size_t)(16 * wave) * DM + 4 * lane;
#pragma unroll
      for (int q = 0; q < 16; ++q) t[q] = __builtin_nontemporal_load((const f32x4*)(wp + (size_t)q * DM)); }
    LAS unsigned* img = (LAS unsigned*)F.lds;
#pragma unroll
    for (int it = 0; it < 4; ++it)
#pragma unroll
        for (int j = 0; j < 4; ++j) { const int n = 4 * lane + j, d = 4 * wave + it;
            img[n * 32 + (d ^ (lane & 31))] = pk4_fp8(t[4 * it + 0][j] * W8_SCALE, t[4 * it + 1][j] * W8_SCALE, t[4 * it + 2][j] * W8_SCALE, t[4 * it + 3][j] * W8_SCALE); }
    __syncthreads();
#pragma unroll
    for (int q = 0; q < 4; ++q) { const int ch = tid + 512 * q, n = ch >> 3, g = ch & 7, sw = (n >> 2) & 31;
        u32x4 o; o.x = img[n * 32 + ((4 * g + 0) ^ sw)]; o.y = img[n * 32 + ((4 * g + 1) ^ sw)]; o.z = img[n * 32 + ((4 * g + 2) ^ sw)]; o.w = img[n * 32 + ((4 * g + 3) ^ sw)];
        const int drow = (wh < 2) ? (n >> 7) * 256 + wh * 128 + (n & 127) : n;
        *(u32x4*)(dst + (size_t)drow * DM + 16 * g) = o; }
    __syncthreads();
}
__device__ __forceinline__ void conv_help(Frame& F, int budget, unsigned* done, unsigned done_total) {
    if (!CONV_IDLE) return;
    PHASE_IDS(F);
    for (int n = 0; n < budget; ++n) {
        if (tid == 0) { unsigned t = 0xffffffffu;
            if (done == nullptr || xb_ld(done) < done_total) t = xb_add(F.ctl + CW_CONV, 1u);
            F.MISC[1] = t; }
        __syncthreads();
        const unsigned t = F.MISC[1];
        __syncthreads();
        if (t >= (unsigned)(NT8_ALL - NT8_L0)) break;
        conv_tile(F, NT8_L0 + (int)t, tid, lane, wave);
    }
}
__device__ __forceinline__ void phase_prologue(Frame& F) {
    PHASE_IDS(F);
    static_assert(FP8_L0 && FP8_L1, "the prologue writes the experts' weights as fp8");
    {
        constexpr int NT8 = CONV_IDLE ? NT8_L0 : NT8_ALL;
        struct T8 { const float* src; unsigned char* dst; int which; };
#define P8_DESC(d, tl) do { const int mat = (tl) >> 7, kb = ((tl) & 127) >> 3, nb = (tl) & 7, le = mat / 3, wh = mat % 3; d.which = wh; \
        d.src = INP(F, wh == 0 ? IN_WG : wh == 1 ? IN_WU : IN_WDN) + (size_t)le * DM * DM + (size_t)(128 * kb) * DM + 256 * nb; \
        d.dst = (wh < 2) ? F.ws + WS_WGU + (size_t)(le / NE) * NE * 4096 * DM * 2 + (size_t)(le % NE) * 4096 * DM + (size_t)(2 * nb) * 256 * DM + 128 * kb \
                         : F.ws + WS_WD + (size_t)(le / NE) * NE * DM * DM * 2 + (size_t)(le % NE) * DM * DM + (size_t)(256 * nb) * DM + 128 * kb; } while (0)
#define P8_LOAD(d, t) do { const float* wp = d.src + (size_t)(16 * wave) * DM + 4 * lane; _Pragma("unroll") for (int q = 0; q < 16; ++q) t[q] = __builtin_nontemporal_load((const f32x4*)(wp + (size_t)q * DM)); } while (0)
        T8 cur, nxt; f32x4 t0[16], t1[16];
        int tl = blockIdx.x, par = 0;
        if (tl < NT8) { P8_DESC(cur, tl); P8_LOAD(cur, t0); }
        for (; tl < NT8; tl += F.G, par ^= 1) {
            const bool has = tl + F.G < NT8;
            if (has) { P8_DESC(nxt, tl + F.G); P8_LOAD(nxt, t1); }
            LAS unsigned* img = (LAS unsigned*)(F.lds + par * 32768);
#pragma unroll
            for (int it = 0; it < 4; ++it)
#pragma unroll
                for (int j = 0; j < 4; ++j) { const int n = 4 * lane + j, d = 4 * wave + it;
                    img[n * 32 + (d ^ (lane & 31))] = pk4_fp8(t0[4 * it + 0][j] * W8_SCALE, t0[4 * it + 1][j] * W8_SCALE, t0[4 * it + 2][j] * W8_SCALE, t0[4 * it + 3][j] * W8_SCALE); }
            __syncthreads();
#pragma unroll
            for (int q = 0; q < 4; ++q) { const int ch = tid + 512 * q, n = ch >> 3, g = ch & 7, sw = (n >> 2) & 31;
                u32x4 o; o.x = img[n * 32 + ((4 * g + 0) ^ sw)]; o.y = img[n * 32 + ((4 * g + 1) ^ sw)]; o.z = img[n * 32 + ((4 * g + 2) ^ sw)]; o.w = img[n * 32 + ((4 * g + 3) ^ sw)];
                const int drow = (cur.which < 2) ? (n >> 7) * 256 + cur.which * 128 + (n & 127) : n;
                *(u32x4*)(cur.dst + (size_t)drow * DM + 16 * g) = o; }
            if (has) { cur = nxt;
#pragma unroll
                for (int q = 0; q < 16; ++q) t0[q] = t1[q]; }
        }
#undef P8_DESC
#undef P8_LOAD
        __syncthreads();
    }
    LAS float* scr = (LAS float*)(F.lds + wave * 16384);
    constexpr int I_IN = 32 * (INW / 32), I_SQ = 32 * (DM / 32);
    constexpr int NIT = 2 * I_IN + 2 * I_SQ;
    struct TItem { const float* src; unsigned char* dst; int N, drow0, mode; };
#define P0_DESC(d, itv) do { int r = (itv); \
        if (r < 2 * I_IN) { const int l = r / I_IN; r %= I_IN; const int kb = r / (INW / 32), nb = r % (INW / 32); \
            d.src = INP(F, IN_WIN) + (size_t)l * DM * INW + (size_t)(64 * kb) * INW + 32 * nb; d.dst = F.ws + WS_WIN + (size_t)l * INW * DM * 2 + 128 * kb; d.N = INW; d.drow0 = 32 * nb; d.mode = 1; } \
        else { r -= 2 * I_IN; const int l = r / I_SQ; r %= I_SQ; const int kb = r / 64, nb = r % 64; \
            d.src = INP(F, IN_WOUT) + (size_t)l * DM * DM + (size_t)(64 * kb) * DM + 32 * nb; d.dst = F.ws + WS_WOUT + (size_t)l * DM * DM * 2 + 128 * kb; d.N = DM; d.drow0 = 32 * nb; d.mode = 0; } } while (0)
#define P0_LOAD(d, t) do { const float* wp = d.src + (size_t)(lane >> 3) * d.N + (lane & 7) * 4; _Pragma("unroll") for (int i = 0; i < 8; ++i) t[i] = *(const f32x4*)(wp + (size_t)(8 * i) * d.N); } while (0)
    for (int it = gw; it < NIT; it += NGW) {
        TItem cur; f32x4 t0[8];
        P0_DESC(cur, it); P0_LOAD(cur, t0);
#pragma unroll
        for (int i = 0; i < 8; ++i) { LAS float* sp = scr + (8 * i + (lane >> 3)) * 33 + (lane & 7) * 4; sp[0] = t0[i].x; sp[1] = t0[i].y; sp[2] = t0[i].z; sp[3] = t0[i].w; }
        LDS_WAIT(); asm volatile("" ::: "memory");
        const int c = lane & 7;
#pragma unroll
        for (int j = 0; j < 4; ++j) { const int n = (lane >> 3) + 8 * j; const LAS float* sp = scr + (8 * c) * 33 + n;
            float v[8];
#pragma unroll
            for (int q = 0; q < 8; ++q) v[q] = sp[q * 33];
            int drow = cur.drow0 + n; if (cur.mode == 1) drow = (drow & ~127) + headpos(drow & 127);
            u32x4 o; o.x = pk2(v[0], v[1]); o.y = pk2(v[2], v[3]); o.z = pk2(v[4], v[5]); o.w = pk2(v[6], v[7]); *(u32x4*)(cur.dst + (size_t)drow * DM * 2 + 16 * c) = o; }
        LDS_WAIT(); asm volatile("" ::: "memory");
    }
#undef P0_DESC
#undef P0_LOAD
    __syncthreads();
    {
        LAS float* sil = (LAS float*)F.lds;
        LAS float* red = (LAS float*)(F.lds + 40960);
        bool have = false;
        for (int it = blockIdx.x; it < 2 * 96; it += F.G) {
            if (!have) {
                { const float* cp = INP(F, IN_C); const float* ccp = INP(F, IN_CCTX);
                for (int i = tid; i < 5 * DM; i += 512) { const int s = i / DM, k = i % DM; const float cv = (s < 4) ? cp[s * DM + k] : ccp[k]; sil[i] = cv / (1.f + __expf(-cv)); } }
                have = true; __syncthreads();
            }
            const int l = it / 96, cb = it % 96, c4 = tid & 31, kr = tid >> 5;
            const float* wp = INP(F, IN_WMOD) + (size_t)l * DM * NMOD + (size_t)cb * 128 + c4 * 4;
            f32x4 a[5];
#pragma unroll
            for (int s = 0; s < 5; ++s) a[s] = (f32x4){0.f, 0.f, 0.f, 0.f};
#pragma unroll 8
            for (int k = kr; k < DM; k += 16) { const f32x4 w = *(const f32x4*)(wp + (size_t)k * NMOD);
#pragma unroll
                for (int s = 0; s < 5; ++s) a[s] += w * sil[s * DM + k]; }
#pragma unroll
            for (int s = 0; s < 5; ++s) *(LAS f32x4*)(red + (kr * 5 + s) * 128 + c4 * 4) = a[s];
            __syncthreads();
            const float* bmod = INP(F, IN_BMOD);
            for (int i = tid; i < 5 * 128; i += 512) { const int s = i / 128, cc = i % 128; float sum = 0.f;
#pragma unroll
                for (int q = 0; q < 16; ++q) sum += red[(q * 5 + s) * 128 + cc];
                ((float*)(F.ws + WS_MOD))[(size_t)(l * 5 + s) * NMOD + cb * 128 + cc] = sum + bmod[l * NMOD + cb * 128 + cc]; }
            __syncthreads();
        }
    }
    if ((int)blockIdx.x >= F.G - 9 && (int)blockIdx.x < F.G - 1) {
        const float* wr = INP(F, IN_WR); bf16_t* wf = (bf16_t*)(F.ws + WS_WRS); const int part = (int)blockIdx.x - (F.G - 9);
        for (int i = part * 512 + tid; i < 2 * DM * NE; i += 8 * 512) { const int l = i / (DM * NE), rem = i % (DM * NE), k = rem >> 4, e = rem & 15;
            const float w = wr[i]; const unsigned hi = f2bf(w); const unsigned lo = f2bf(w - __builtin_bit_cast(float, hi << 16));
            const int sidx = k >> 5, q = (k >> 3) & 3, j = k & 7; bf16_t* dst = wf + ((size_t)(l * 64 + sidx) * 2 * 64 + (q * 16 + e)) * 8 + j;
            dst[0] = (bf16_t)hi; dst[64 * 8] = (bf16_t)lo; }
    }
    if (blockIdx.x == F.G - 1) {
        for (int i = tid; i < 64 * 32; i += 512) {
            const int pos = i >> 5, f = i & 31;
            double inv = 1.0; for (int q = 0; q < f; ++q) inv *= 0.7498942093324559;
            const double a = (double)pos * inv;
            const double n = __builtin_rint(a * 0.6366197723675814);
            const double r = (a - n * 1.5707963267948966) - n * 6.123233995736766e-17;
            const double r2 = r * r;
            double sn = r * (1.0 + r2 * (-1.0 / 6 + r2 * (1.0 / 120 + r2 * (-1.0 / 5040 + r2 * (1.0 / 362880 + r2 * (-1.0 / 39916800 + r2 * (1.0 / 6227020800.0)))))));
            double cn = 1.0 + r2 * (-0.5 + r2 * (1.0 / 24 + r2 * (-1.0 / 720 + r2 * (1.0 / 40320 + r2 * (-1.0 / 3628800 + r2 * (1.0 / 479001600 + r2 * (-1.0 / 87178291200.0)))))));
            const int q = ((int)n) & 3; double cs, ss;
            if (q == 0) { cs = cn; ss = sn; } else if (q == 1) { cs = -sn; ss = cn; } else if (q == 2) { cs = -cn; ss = -sn; } else { cs = sn; ss = -cn; }
            ((float*)(F.ws + WS_ROPE))[2 * i] = (float)cs; ((float*)(F.ws + WS_ROPE))[2 * i + 1] = (float)ss;
        }
    }
}

__device__ __forceinline__ void load_row(const float* row, int lane, f32x4 (&v)[8]) {
#pragma unroll
    for (int j = 0; j < 8; ++j) v[j] = *(const f32x4*)(row + 4 * lane + 256 * j);
}
__device__ __forceinline__ void norm_mod_store(const f32x4 (&v)[8], const float* g, const float* shift, const float* scale, bf16_t* dst, int lane) {
    float ss = 0.f;
#pragma unroll
    for (int j = 0; j < 8; ++j) ss += (v[j].x * v[j].x + v[j].y * v[j].y) + (v[j].z * v[j].z + v[j].w * v[j].w);
    const float rinv = rsqrt_fast(wave_sum(ss) * (1.f / DM) + EPS);
#pragma unroll
    for (int j = 0; j < 8; ++j) { const int c = 4 * lane + 256 * j;
        const f32x4 gg = *(const f32x4*)(g + c), sh = *(const f32x4*)(shift + c), sc = *(const f32x4*)(scale + c);
        const f32x4 y = (v[j] * rinv) * gg * (sc + 1.f) + sh;
        u32x2 w; w.x = pk2(y.x, y.y); w.y = pk2(y.z, y.w); *(u32x2*)(dst + c) = w; }
}

__device__ __forceinline__ void phase_rowpass1_l0(Frame& F) {
    PHASE_IDS(F);
    const float* mod = (const float*)(F.ws + WS_MOD);
    { const float* n2 = INP(F, IN_N2G); float* gs = (float*)(F.ws + WS_GS2);
      for (int i = (int)blockIdx.x * 512 + tid; i < 2 * 5 * DM; i += F.G * 512) { const int l = i / (5 * DM), sv = (i / DM) % 5, k = i % DM;
          const float* m = mod + (size_t)(l * 5 + sv) * NMOD; gs[2 * i] = n2[l * DM + k] * (1.f + m[4 * DM + k]); gs[2 * i + 1] = m[3 * DM + k]; } }
    const float* xin = INP(F, IN_X); const float* cin = INP(F, IN_CTX); const float* n1g = INP(F, IN_N1G);
#define P1_SRC(rr) ((((rr) % TPB) < CTXL) ? cin + ((size_t)((rr) / TPB) * CTXL + ((rr) % TPB)) * DM : xin + ((size_t)((rr) / TPB) * SEQ + (((rr) % TPB) - CTXL)) * DM)
    f32x4 v[8], vn[8];
    int r = gw;
    if (r < NTOK) load_row(P1_SRC(r), lane, v);
    while (r < NTOK) {
        const int rn = r + NGW;
        if (rn < NTOK) load_row(P1_SRC(rn), lane, vn);
        const int b = r / TPB, t = r % TPB, s = (t < CTXL) ? 4 : b;
        norm_mod_store(v, n1g, mod + (size_t)s * NMOD, mod + (size_t)s * NMOD + DM, (bf16_t*)(F.ws + WS_HN) + (size_t)r * DM, lane);
#pragma unroll
        for (int j = 0; j < 8; ++j) v[j] = vn[j];
        r = rn;
    }
#undef P1_SRC
}

__device__ __forceinline__ void post_unpack(const u32x4 x, float (&v)[8]) {
    v[0] = bflo(x.x); v[1] = bfhi(x.x); v[2] = bflo(x.y); v[3] = bfhi(x.y); v[4] = bflo(x.z); v[5] = bfhi(x.z); v[6] = bflo(x.w); v[7] = bfhi(x.w); }
__device__ __forceinline__ float sum16(float v) { return row16_sum(v); }
__device__ __forceinline__ void phase_post(Frame& F, int l) {
    PHASE_IDS(F);
    bf16_t* P = (bf16_t*)(F.ws + WS_P);
    const float* rope = (const float*)(F.ws + WS_ROPE);
    const int i16 = lane & 15, hq = lane >> 4; const bool hi2 = hq >= 2;
    const float* qna = INP(F, IN_QNA) + l * 128 + 8 * i16; const float* kna = INP(F, IN_KNA) + l * 128 + 8 * i16;
    const float* qnc = INP(F, IN_QNC) + l * 128 + 8 * i16; const float* knc = INP(F, IN_KNC) + l * 128 + 8 * i16;
    const float* vnb = INP(F, IN_VNB) + l * 512 + 8 * i16;
    for (int r = gw; r < NTOK; r += NGW) {
        const int t = r % TPB; const bool lat = t >= CTXL;
        u32x4* rp = (u32x4*)(P + (size_t)r * INW) + lane;
        u32x4 x[7];
#pragma unroll
        for (int j = 0; j < 7; ++j) x[j] = rp[64 * j];
        const int pos = lat ? t - CTXL : 0, pp = (i16 < 8) ? (pos >> 6) : (pos & 63);
        const f32x4* cs = (const f32x4*)(rope + 2 * (pp * 32 + 8 * (i16 & 3)));
        const f32x4 c0 = cs[0], c1 = cs[1], c2 = cs[2], c3 = cs[3];
        const float cosv[8] = {c0.x, c0.z, c1.x, c1.z, c2.x, c2.z, c3.x, c3.z}, sinv[8] = {c0.y, c0.w, c1.y, c1.w, c2.y, c2.w, c3.y, c3.w};
        const float sgn = (i16 & 4) ? 1.f : -1.f;
#pragma unroll
        for (int j = 0; j < 7; ++j) {
            const bool gelu_lo = (j == 3 || j == 4), gelu_hi = (j == 2 || j == 3);
            const bool norm_lo = (j != 2 && j != 3), norm_hi = (j != 2 && j != 6);
            const bool rope_lo = (j == 0 || j == 1 || j == 5 || j == 6), rope_hi = (j == 0 || j == 1 || j == 4 || j == 5);
            const bool dg = hi2 ? gelu_hi : gelu_lo, dn = hi2 ? norm_hi : norm_lo, dr = (hi2 ? rope_hi : rope_lo) && lat;
            if (!(gelu_lo || gelu_hi || norm_lo || norm_hi)) continue;
            float v[8]; post_unpack(x[j], v);
            if (gelu_lo || gelu_hi) {
#pragma unroll
                for (int e = 0; e < 8; ++e) { const float gv = gelu_tanh(v[e]); v[e] = dg ? gv : v[e]; } }
            if (norm_lo || norm_hi) {
                float ss = 0.f;
#pragma unroll
                for (int e = 0; e < 8; ++e) ss += v[e] * v[e];
                const float rinv = rsqrt_fast(sum16(ss) * (1.f / 128) + EPS);
                const float* gp;
                if (j == 0) gp = qna; else if (j == 1) gp = hi2 ? kna : qna; else if (j == 3) gp = vnb + (hi2 ? hq - 2 : 0) * 128; else if (j == 4) gp = hi2 ? qnc : vnb + (2 + hq) * 128;
                else if (j == 5) gp = qnc; else gp = knc;
                const f32x4 g0 = *(const f32x4*)gp, g1 = *(const f32x4*)(gp + 4);
                const float gg[8] = {g0.x, g0.y, g0.z, g0.w, g1.x, g1.y, g1.z, g1.w};
#pragma unroll
                for (int e = 0; e < 8; ++e) v[e] = dn ? v[e] * rinv * gg[e] : v[e];
            }
            if (rope_lo || rope_hi) {
#pragma unroll
                for (int e = 0; e < 8; ++e) { const float o = __builtin_bit_cast(float, __builtin_amdgcn_ds_swizzle(__builtin_bit_cast(int, v[e]), 0x101F)); const float rv = v[e] * cosv[e] + sgn * o * sinv[e]; v[e] = dr ? rv : v[e]; } }
            u32x4 w; w.x = pk2(v[0], v[1]); w.y = pk2(v[2], v[3]); w.z = pk2(v[4], v[5]); w.w = pk2(v[6], v[7]);
            rp[64 * j] = w;
        }
    }
}

__device__ __forceinline__ void mixer_b_unit(Frame& F, int l, int b, int ch, int g) {
    PHASE_IDS(F);
    const bf16_t* P = (const bf16_t*)(F.ws + WS_P); bf16_t* O = (bf16_t*)(F.ws + WS_O);
    const int row0 = b * TPB + ch * 128, w = wave;
    LAS bf16_t* VT = (LAS bf16_t*)F.lds;
    { const int q = tid >> 2, dp = (tid & 3) * 32; const bf16_t* src = P + (size_t)(row0 + q) * INW + C_VB + g * 128 + dp;
#pragma unroll
      for (int i = 0; i < 4; ++i) { const u32x4 x = *(const u32x4*)(src + 8 * i); const unsigned xs[4] = {x.x, x.y, x.z, x.w};
#pragma unroll
          for (int j = 0; j < 4; ++j) { VT[(dp + 8 * i + 2 * j) * 136 + q] = (bf16_t)(xs[j] & 0xffffu); VT[(dp + 8 * i + 2 * j + 1) * 136 + q] = (bf16_t)(xs[j] >> 16); } } }
    __syncthreads();
    const int i15 = lane & 15, kq = lane >> 4;
    f32x4 acc[8];
#pragma unroll
    for (int n = 0; n < 8; ++n) acc[n] = (f32x4){0.f, 0.f, 0.f, 0.f};
    const float* wsr = INP(F, IN_WS) + ((size_t)(l * 4 + g) * 128 + 16 * w + i15) * 128;
#pragma unroll
    for (int s = 0; s < 4; ++s) {
        const f32x4 a0 = *(const f32x4*)(wsr + 32 * s + 8 * kq), a1 = *(const f32x4*)(wsr + 32 * s + 8 * kq + 4);
        u32x4 aw; aw.x = pk2(a0.x, a0.y); aw.y = pk2(a0.z, a0.w); aw.z = pk2(a1.x, a1.y); aw.w = pk2(a1.z, a1.w);
        const bf16x8 af = *reinterpret_cast<bf16x8*>(&aw);
#pragma unroll
        for (int n = 0; n < 8; ++n) { const bf16x8 bfr = *(const LAS bf16x8*)(VT + (16 * n + i15) * 136 + 32 * s + 8 * kq);
            acc[n] = __builtin_amdgcn_mfma_f32_16x16x32_bf16(af, bfr, acc[n], 0, 0, 0); }
    }
#pragma unroll
    for (int j = 0; j < 4; ++j) { const int p = 16 * w + kq * 4 + j; const float bias = INP(F, IN_BS)[(l * 4 + g) * 128 + p];
        const bf16_t* up = P + (size_t)(row0 + p) * INW + C_UB + g * 128; bf16_t* op = O + (size_t)(row0 + p) * DM + O_B + g * 128;
#pragma unroll
        for (int n = 0; n < 8; ++n) { const int d = 16 * n + i15; op[d] = (bf16_t)f2bf(bf2f(up[d]) * (acc[n][j] + bias)); } }
    __syncthreads();
}
__device__ __forceinline__ void phase_mixers(Frame& F, int l) {
    PHASE_IDS(F);
    const bf16_t* P = (const bf16_t*)(F.ws + WS_P); bf16_t* O = (bf16_t*)(F.ws + WS_O);
    const bool ctx = (l == 0);
    const int nC = 48, nA = 48, nCc = ctx ? 3 : 0, nAc = ctx ? 3 : 0, nB = 68;
    const int total = nC + nA + nCc + nAc + nB;
    for (int kq = 0; kq < 8; ++kq) {
        const int x = ((int)blockIdx.x + kq) & 7, b = x >> 1, kv = x & 1;
        unsigned* qctr = F.ctl + CW_QUEUE + 64 * (l * 8 + x);
        for (;;) {
            if (tid == 0) F.MISC[0] = xb_add(qctr, 1u);
            __syncthreads();
            int u = (int)F.MISC[0];
            __syncthreads();
            if (u >= total) break;
            if (u < nC + nA + nCc + nAc) {
                int kind, h, qb = 0;
                if (u < nC) { kind = 0; h = kv * 3 + u / 16; qb = u % 16; }
                else if (u < nC + nA) { const int v = u - nC; kind = 1; h = kv * 3 + v / 16; qb = v % 16; }
                else if (u < nC + nA + nCc) { kind = 2; h = kv * 3 + (u - nC - nA); }
                else { kind = 3; h = kv * 3 + (u - nC - nA - nCc); }
                const int isA = kind & 1, lat = (kind < 2);
                const size_t r0 = (size_t)b * TPB, rq = r0 + (lat ? CTXL + qb * 256 : 0);
                const int q0 = qb * 256, ks = (kind == 1) ? ((q0 - 128 < 0) ? 0 : q0 - 128) : 0, ke = (q0 + 384 > SEQ) ? SEQ : q0 + 384;
                const int NT = (kind == 0) ? 68 : (kind == 1) ? 4 + (ke - ks) / 64 : 4;
                const float sink = INP(F, IN_SINK)[l * 6 + h];
                const int cq = (isA ? C_QA : C_QC) + h * 128, ck = (isA ? C_KA : C_KC) + kv * 128, cv = (isA ? C_VA : C_VC) + kv * 128, co = (isA ? O_A : O_C) + h * 128;
                at::attn_body(P + rq * INW + cq, P + r0 * INW + ck, P + r0 * INW + cv, O + rq * DM + co, NT, ks, q0, isA ? sink / at::SCALE : -1e30f, isA ? 1.f : 0.f, kind == 1, F.ldsg);
                continue; }
            u -= nC + nA + nCc + nAc;
            { const int ch = u >> 1, g = kv * 2 + (u & 1);
              if (!ctx && ch < 2) continue;
              mixer_b_unit(F, l, b, ch, g); }
        }
    }
    if (CONV_IDLE && (CONV_HOOKS & 1)) {
        __syncthreads();
        if (tid == 0) (void)xb_add(F.ctl + CW_MIXDONE + 64 * l, 1u);
        conv_help(F, 64, F.ctl + CW_MIXDONE + 64 * l, (unsigned)F.G);
    }
}

__device__ __forceinline__ void phase_groupnorm(Frame& F, int l) {
    PHASE_IDS(F);
    bf16_t* O = (bf16_t*)(F.ws + WS_O); const float* og = INP(F, IN_OUTG) + l * DM;
#define GN_SKIP(rr) (l == 1 && ((rr) % TPB) < CTXL)
#define GN_LOAD(rr, xx) do { const bf16_t* _row = O + (size_t)(rr) * DM; \
        _Pragma("unroll") for (int i = 0; i < 3; ++i) { xx[i] = *(const u32x2*)(_row + O_A + 12 * lane + 4 * i); xx[5 + i] = *(const u32x2*)(_row + O_C + 12 * lane + 4 * i); } \
        _Pragma("unroll") for (int i = 0; i < 2; ++i) xx[3 + i] = *(const u32x2*)(_row + O_B + 8 * lane + 4 * i); } while (0)
    int r = gw; while (r < NTOK && GN_SKIP(r)) r += NGW;
    u32x2 x[8], xn[8];
    if (r < NTOK) GN_LOAD(r, x);
    while (r < NTOK) {
        int rn = r + NGW; while (rn < NTOK && GN_SKIP(rn)) rn += NGW;
        if (rn < NTOK) GN_LOAD(rn, xn);
        bf16_t* row = O + (size_t)r * DM;
        float v[8][4]; float ss[3] = {0.f, 0.f, 0.f};
#pragma unroll
        for (int i = 0; i < 8; ++i) { v[i][0] = bflo(x[i].x); v[i][1] = bfhi(x[i].x); v[i][2] = bflo(x[i].y); v[i][3] = bfhi(x[i].y);
            const int grp = (i < 3) ? 0 : (i < 5) ? 1 : 2; ss[grp] += (v[i][0] * v[i][0] + v[i][1] * v[i][1]) + (v[i][2] * v[i][2] + v[i][3] * v[i][3]); }
        float rinv[3];
        rinv[0] = rsqrt_fast(wave_sum(ss[0]) * (1.f / 768) + EPS); rinv[1] = rsqrt_fast(wave_sum(ss[1]) * (1.f / 512) + EPS); rinv[2] = rsqrt_fast(wave_sum(ss[2]) * (1.f / 768) + EPS);
#pragma unroll
        for (int i = 0; i < 8; ++i) { const int grp = (i < 3) ? 0 : (i < 5) ? 1 : 2;
            const int c = (grp == 0) ? O_A + 12 * lane + 4 * i : (grp == 1) ? O_B + 8 * lane + 4 * (i - 3) : O_C + 12 * lane + 4 * (i - 5);
            const f32x4 gg = *(const f32x4*)(og + c); const float ri = rinv[grp];
            u32x2 w; w.x = pk2(v[i][0] * ri * gg.x, v[i][1] * ri * gg.y); w.y = pk2(v[i][2] * ri * gg.z, v[i][3] * ri * gg.w); *(u32x2*)(row + c) = w; }
#pragma unroll
        for (int i = 0; i < 8; ++i) x[i] = xn[i];
        r = rn;
    }
#undef GN_SKIP
#undef GN_LOAD
}

__device__ __forceinline__ float row16_max(float v) {
    v = fmaxf(v, __builtin_bit_cast(float, __builtin_amdgcn_update_dpp(0, __builtin_bit_cast(int, v), 0xB1, 0xF, 0xF, true)));
    v = fmaxf(v, __builtin_bit_cast(float, __builtin_amdgcn_update_dpp(0, __builtin_bit_cast(int, v), 0x4E, 0xF, 0xF, true)));
    v = fmaxf(v, __builtin_bit_cast(float, __builtin_amdgcn_update_dpp(0, __builtin_bit_cast(int, v), 0x141, 0xF, 0xF, true)));
    v = fmaxf(v, __builtin_bit_cast(float, __builtin_amdgcn_update_dpp(0, __builtin_bit_cast(int, v), 0x140, 0xF, 0xF, true)));
    return v;
}
__device__ __forceinline__ void phase_rowpass2(Frame& F, int l) {
    PHASE_IDS(F);
    const float* xb = (const float*)(F.ws + WS_XB); const float* parts = (const float*)(F.ws + WS_PART);
    const bool f8 = (l == 0) ? (FP8_L0 != 0) : (FP8_L1 != 0);
    { const u32x4* wf = (const u32x4*)((const bf16_t*)(F.ws + WS_WRS) + (size_t)l * 64 * 2 * 64 * 8) + tid; u32x4 t[16];
#pragma unroll
      for (int i = 0; i < 16; ++i) t[i] = wf[512 * i];
#pragma unroll
      for (int i = 0; i < 16; ++i) ((LAS u32x4*)F.lds)[tid + 512 * i] = t[i]; }
    LAS f32x4* red = (LAS f32x4*)(F.lds + LDSCTL_OFF + 2048);
    __syncthreads();
    const int i16 = lane & 15, q = lane >> 4;
#define RP2_SKIP(tl) (l == 1 && ((tl) * 16) % TPB < CTXL)
#define RP2_LOAD(tl, xx, pp0, pp1) do { const int _row = (tl) * 16 + i16; const float* _xr = xb + (size_t)_row * DM + 256 * wave + 8 * q; \
        _Pragma("unroll") for (int sidx = 0; sidx < 8; ++sidx) { xx[sidx][0] = *(const f32x4*)(_xr + 32 * sidx); xx[sidx][1] = *(const f32x4*)(_xr + 32 * sidx + 4); } \
        pp0 = *(const f32x4*)(parts + (size_t)_row * 32 + 8 * q); pp1 = *(const f32x4*)(parts + (size_t)_row * 32 + 8 * q + 4); } while (0)
    int tile = blockIdx.x; while (tile < NTOK / 16 && RP2_SKIP(tile)) tile += F.G;
    f32x4 x[8][2], xn[8][2], p0, p1, p0n, p1n;
    if (tile < NTOK / 16) RP2_LOAD(tile, x, p0, p1);
    while (tile < NTOK / 16) {
        int ntile = tile + F.G; while (ntile < NTOK / 16 && RP2_SKIP(ntile)) ntile += F.G;
        if (ntile < NTOK / 16) RP2_LOAD(ntile, xn, p0n, p1n);
        const int r0 = tile * 16, b = r0 / TPB, t0 = r0 % TPB, sv = (t0 < CTXL) ? 4 : b;
        const int row = r0 + i16;
        float ss = ((p0.x + p0.y) + (p0.z + p0.w)) + ((p1.x + p1.y) + (p1.z + p1.w));
        ss += __builtin_bit_cast(float, __builtin_amdgcn_ds_swizzle(__builtin_bit_cast(int, ss), 0x401F));
        { auto rr = __builtin_amdgcn_permlane32_swap(__float_as_uint(ss), __float_as_uint(ss), false, false); ss = __uint_as_float(rr[0]) + __uint_as_float(rr[1]); }
        const float rinv = rsqrt_fast(ss * (1.f / DM) + EPS);
        const float* gs = (const float*)(F.ws + WS_GS2) + ((size_t)(l * 5 + sv) * DM + 256 * wave + 8 * q) * 2;
        f32x4 acc = (f32x4){0.f, 0.f, 0.f, 0.f};
#pragma unroll
        for (int sidx = 0; sidx < 8; ++sidx) {
            const f32x4 g0 = *(const f32x4*)(gs + 64 * sidx), g1 = *(const f32x4*)(gs + 64 * sidx + 4), g2 = *(const f32x4*)(gs + 64 * sidx + 8), g3 = *(const f32x4*)(gs + 64 * sidx + 12);
            float h[8];
            h[0] = x[sidx][0].x * rinv * g0.x + g0.y; h[1] = x[sidx][0].y * rinv * g0.z + g0.w; h[2] = x[sidx][0].z * rinv * g1.x + g1.y; h[3] = x[sidx][0].w * rinv * g1.z + g1.w;
            h[4] = x[sidx][1].x * rinv * g2.x + g2.y; h[5] = x[sidx][1].y * rinv * g2.z + g2.w; h[6] = x[sidx][1].z * rinv * g3.x + g3.y; h[7] = x[sidx][1].w * rinv * g3.z + g3.w;
            const int col = 256 * wave + 32 * sidx + 8 * q;
            if (f8) { u32x2 w8; w8.x = pk4_fp8(h[0], h[1], h[2], h[3]); w8.y = pk4_fp8(h[4], h[5], h[6], h[7]); *(u32x2*)((unsigned char*)(F.ws + WS_HN8) + (size_t)row * DM + col) = w8; }
            else { u32x4 w16; w16.x = pk2(h[0], h[1]); w16.y = pk2(h[2], h[3]); w16.z = pk2(h[4], h[5]); w16.w = pk2(h[6], h[7]); *(u32x4*)((bf16_t*)(F.ws + WS_HN) + (size_t)row * DM + col) = w16; }
            unsigned hh[8], hl[8];
#pragma unroll
            for (int j = 0; j < 8; ++j) { hh[j] = f2bf(h[j]); hl[j] = f2bf(h[j] - __builtin_bit_cast(float, hh[j] << 16)); }
            u32x4 ah, al; ah.x = hh[0] | (hh[1] << 16); ah.y = hh[2] | (hh[3] << 16); ah.z = hh[4] | (hh[5] << 16); ah.w = hh[6] | (hh[7] << 16);
            al.x = hl[0] | (hl[1] << 16); al.y = hl[2] | (hl[3] << 16); al.z = hl[4] | (hl[5] << 16); al.w = hl[6] | (hl[7] << 16);
            const LAS unsigned char* bp = F.lds + (size_t)((wave * 8 + sidx) * 2) * 1024 + lane * 16;
            const bf16x8 bh = *(const LAS bf16x8*)bp, bl = *(const LAS bf16x8*)(bp + 1024);
            const bf16x8 fah = __builtin_bit_cast(bf16x8, ah), fal = __builtin_bit_cast(bf16x8, al);
            acc = __builtin_amdgcn_mfma_f32_16x16x32_bf16(fah, bh, acc, 0, 0, 0);
            acc = __builtin_amdgcn_mfma_f32_16x16x32_bf16(fah, bl, acc, 0, 0, 0);
            acc = __builtin_amdgcn_mfma_f32_16x16x32_bf16(fal, bh, acc, 0, 0, 0);
        }
        red[wave * 64 + lane] = acc;
        __syncthreads();
        if (wave == 0) {
            f32x4 lg = red[lane];
#pragma unroll
            for (int w = 1; w < 8; ++w) lg += red[w * 64 + lane];
#pragma unroll
            for (int reg = 0; reg < 4; ++reg) { const float mx = row16_max(lg[reg]); const float ex = __expf(lg[reg] - mx); const float a = ex / row16_sum(ex);
                const int t = t0 + 4 * q + reg;
                if (t < CTXL) ((float*)(F.ws + WS_AFFC))[((size_t)b * NE + i16) * CTXL + t] = a;
                else ((float*)(F.ws + WS_AFFL))[((size_t)b * NE + i16) * SEQ + (t - CTXL)] = a; }
        }
        __syncthreads();
#pragma unroll
        for (int sidx = 0; sidx < 8; ++sidx) { x[sidx][0] = xn[sidx][0]; x[sidx][1] = xn[sidx][1]; }
        p0 = p0n; p1 = p1n; tile = ntile;
    }
#undef RP2_SKIP
#undef RP2_LOAD
    __syncthreads();
}

__device__ __forceinline__ unsigned block_excl_scan(unsigned v, LAS unsigned* scr, int lane, int wave, unsigned& total) {
    unsigned inc = v;
#pragma unroll
    for (int o = 1; o < 64; o <<= 1) { const unsigned t = __shfl_up(inc, o); if (lane >= o) inc += t; }
    if (lane == 63) scr[wave] = inc;
    __syncthreads();
    unsigned base = 0, tot = 0;
#pragma unroll
    for (int w = 0; w < 8; ++w) { const unsigned x = scr[w]; base += (w < wave) ? x : 0u; tot += x; }
    __syncthreads();
    total = tot;
    return base + inc - v;
}
__device__ __forceinline__ void phase_topk(Frame& F, int l) {
    PHASE_IDS(F);
    LAS unsigned* hist = (LAS unsigned*)F.lds;
    LAS unsigned* scr = (LAS unsigned*)(F.lds + 8192);
    LAS int* rowsrc = (LAS int*)(F.lds + 8192 + 128);
    const int nunits = (l == 0) ? 128 : 64;
    const bool f8 = (l == 0) ? (FP8_L0 != 0) : (FP8_L1 != 0); const int RBg = f8 ? DM : 2 * DM;
    for (int u = blockIdx.x; u < nunits; u += F.G) {
        const bool isc = u >= 64; const int uu = isc ? u - 64 : u, b = uu / NE, e = uu % NE;
        const int N = isc ? CTXL : SEQ; const unsigned cap = isc ? CAP_C : CAP_L;
        const float* src = isc ? (const float*)(F.ws + WS_AFFC) + (size_t)uu * CTXL : (const float*)(F.ws + WS_AFFL) + (size_t)uu * SEQ;
        int* pos = isc ? (int*)(F.ws + WS_POSC) + (size_t)uu * CTXL : (int*)(F.ws + WS_POSL) + (size_t)uu * SEQ;
        const bool own = tid * 8 < N;
        unsigned key[8];
        { u32x4 k0 = (u32x4){0u, 0u, 0u, 0u}, k1 = k0; if (own) { k0 = *(const u32x4*)(src + tid * 8); k1 = *(const u32x4*)(src + tid * 8 + 4); }
          key[0] = k0.x; key[1] = k0.y; key[2] = k0.z; key[3] = k0.w; key[4] = k1.x; key[5] = k1.y; key[6] = k1.z; key[7] = k1.w; }
        unsigned prefix = 0u, remaining = cap;
#pragma unroll
        for (int p = 0; p < 3; ++p) {
            const int shift = (p == 0) ? 21 : (p == 1) ? 10 : 0, bits = (p == 2) ? 10 : 11, nb = 1 << bits;
            for (int i = tid; i < nb; i += 512) hist[i] = 0u;
            __syncthreads();
            if (own) {
#pragma unroll
                for (int q = 0; q < 8; ++q) { const bool cand = (p == 0) ? true : ((key[q] >> (shift + bits)) == prefix);
                    if (cand) (void)__hip_atomic_fetch_add(&hist[(key[q] >> shift) & (nb - 1)], 1u, __ATOMIC_RELAXED, __HIP_MEMORY_SCOPE_WORKGROUP); } }
            __syncthreads();
            unsigned c[4];
#pragma unroll
            for (int q = 0; q < 4; ++q) c[q] = (4 * tid + q < nb) ? hist[4 * tid + q] : 0u;
            const unsigned sm = (c[0] + c[1]) + (c[2] + c[3]);
            unsigned total; const unsigned ex = block_excl_scan(sm, scr, lane, wave, total);
            unsigned above = total - (ex + sm);
#pragma unroll
            for (int q = 3; q >= 0; --q) { if (above < remaining && remaining <= above + c[q]) { scr[16] = (unsigned)(4 * tid + q); scr[17] = above; } above += c[q]; }
            __syncthreads();
            const unsigned B = scr[16], ca = scr[17];
            remaining -= ca; prefix = (prefix << bits) | B;
            __syncthreads();
        }
        const unsigned T = prefix;
        unsigned ce = 0u;
#pragma unroll
        for (int q = 0; q < 8; ++q) ce += (own && key[q] == T) ? 1u : 0u;
        unsigned tot; unsigned er = block_excl_scan(ce, scr, lane, wave, tot);
        bool sel[8]; unsigned cs = 0u;
#pragma unroll
        for (int q = 0; q < 8; ++q) { const bool eq = own && key[q] == T; sel[q] = own && (key[q] > T || (eq && er < remaining)); er += eq ? 1u : 0u; cs += sel[q] ? 1u : 0u; }
        unsigned sl = block_excl_scan(cs, scr, lane, wave, tot);
        const int slotbase = e * ROWS_E + (isc ? 2048 + b * CAP_C : b * CAP_L);
        int pv[8];
#pragma unroll
        for (int q = 0; q < 8; ++q) { pv[q] = sel[q] ? (int)sl : -1;
            if (sel[q]) { rowsrc[sl] = b * TPB + (isc ? 0 : CTXL) + tid * 8 + q; ((float*)(F.ws + WS_GATE))[slotbase + sl] = __uint_as_float(key[q]); ++sl; } }
        if (own) { *(i32x4*)(pos + tid * 8) = (i32x4){pv[0], pv[1], pv[2], pv[3]}; *(i32x4*)(pos + tid * 8 + 4) = (i32x4){pv[4], pv[5], pv[6], pv[7]}; }
        __syncthreads();
        unsigned* offs = (unsigned*)(F.ws + WS_OFFS);
        int R[2], C[2];
#pragma unroll
        for (int i = 0; i < 2; ++i) pg8::stage_rc(tid * 16 + i * 8192, R[i], C[i]);
        if (!isc) {
#pragma unroll
            for (int th = 0; th < 2; ++th) { u32x4 o;
                o.x = (unsigned)rowsrc[th * 256 + R[0]] * RBg + 2 * C[0]; o.y = (unsigned)rowsrc[th * 256 + R[1]] * RBg + 2 * C[1];
                o.z = (unsigned)rowsrc[th * 256 + 128 + R[0]] * RBg + 2 * C[0]; o.w = (unsigned)rowsrc[th * 256 + 128 + R[1]] * RBg + 2 * C[1];
                *(u32x4*)(offs + ((size_t)(e * 9 + 2 * b + th) * 512 + tid) * 4) = o; }
        } else {
            unsigned* o = offs + ((size_t)(e * 9 + 8) * 512 + tid) * 4;
#pragma unroll
            for (int i = 0; i < 2; ++i) { if (R[i] >= 32 * b && R[i] < 32 * b + 32) o[i] = (unsigned)rowsrc[R[i] - 32 * b] * RBg + 2 * C[i]; if (b == 0) o[2 + i] = 2 * C[i]; }
        }
        __syncthreads();
    }
}

__device__ __forceinline__ void phase_combine(Frame& F, int l) {
    PHASE_IDS(F);
    const float* mod = (const float*)(F.ws + WS_MOD);
    float* xb = (float*)(F.ws + WS_XB); const bf16_t* Y = (const bf16_t*)(F.ws + WS_XG);
    for (int r = gw; r < NTOK; r += NGW) {
        const int b = r / TPB, t = r % TPB, s = (t < CTXL) ? 4 : b;
        if (l == 1 && t < CTXL) continue;
        int p = -1;
        if (lane < NE) p = (t < CTXL) ? ((const int*)(F.ws + WS_POSC))[((size_t)b * NE + lane) * CTXL + t] : ((const int*)(F.ws + WS_POSL))[((size_t)b * NE + lane) * SEQ + (t - CTXL)];
        float gt = 0.f;
        if (p >= 0) gt = ((const float*)(F.ws + WS_GATE))[lane * ROWS_E + ((t < CTXL) ? 2048 + b * CAP_C : b * CAP_L) + p];
        f32x4 v[8]; load_row(xb + (size_t)r * DM, lane, v);
        const float* g2 = mod + (size_t)(l * 5 + s) * NMOD + 5 * DM;
        f32x4 gv[8];
#pragma unroll
        for (int j = 0; j < 8; ++j) gv[j] = *(const f32x4*)(g2 + 4 * lane + 256 * j);
        f32x4 a[8];
#pragma unroll
        for (int j = 0; j < 8; ++j) a[j] = (f32x4){0.f, 0.f, 0.f, 0.f};
        unsigned long long m = __ballot(p >= 0);
        const int ybase = (t < CTXL) ? 2048 + b * CAP_C : b * CAP_L;
        while (m) {
            const int e0 = __builtin_ctzll(m); m &= m - 1;
            const bool two = (m != 0ull); const int e1 = two ? __builtin_ctzll(m) : e0; if (two) m &= m - 1;
            const int p0 = __builtin_amdgcn_readlane(p, e0), p1 = __builtin_amdgcn_readlane(p, e1);
            const float q0 = __builtin_bit_cast(float, __builtin_amdgcn_readlane(__builtin_bit_cast(int, gt), e0)), q1 = __builtin_bit_cast(float, __builtin_amdgcn_readlane(__builtin_bit_cast(int, gt), e1));
            const bf16_t* y0 = Y + (size_t)(e0 * ROWS_E + ybase + p0) * DM + 4 * lane; const bf16_t* y1 = Y + (size_t)(e1 * ROWS_E + ybase + p1) * DM + 4 * lane;
            u32x2 w0[8], w1[8];
#pragma unroll
            for (int j = 0; j < 8; ++j) w0[j] = *(const u32x2*)(y0 + 256 * j);
            if (two) {
#pragma unroll
                for (int j = 0; j < 8; ++j) w1[j] = *(const u32x2*)(y1 + 256 * j); }
#pragma unroll
            for (int j = 0; j < 8; ++j) a[j] += (f32x4){bflo(w0[j].x), bfhi(w0[j].x), bflo(w0[j].y), bfhi(w0[j].y)} * q0;
            if (two) {
#pragma unroll
                for (int j = 0; j < 8; ++j) a[j] += (f32x4){bflo(w1[j].x), bfhi(w1[j].x), bflo(w1[j].y), bfhi(w1[j].y)} * q1; }
        }
#pragma unroll
        for (int j = 0; j < 8; ++j) v[j] += gv[j] * a[j];
        if (l == 0) {
#pragma unroll
            for (int j = 0; j < 8; ++j) *(f32x4*)(xb + (size_t)r * DM + 4 * lane + 256 * j) = v[j];
            const float* m1 = mod + (size_t)(5 + s) * NMOD;
            norm_mod_store(v, INP(F, IN_N1G) + DM, m1, m1 + DM, (bf16_t*)(F.ws + WS_HN) + (size_t)r * DM, lane);
        } else {
            float* op = F.out + ((size_t)b * SEQ + (t - CTXL)) * DM;
#pragma unroll
            for (int j = 0; j < 8; ++j) *(f32x4*)(op + 4 * lane + 256 * j) = v[j];
        }
    }
}

__device__ __forceinline__ void phase_dump_x(Frame& F, bool from_input) {
    PHASE_IDS(F);
    const float* xb = (const float*)(F.ws + WS_XB);
    for (int r = gw; r < NTOK; r += NGW) {
        const int b = r / TPB, t = r % TPB; if (t < CTXL) continue;
        const float* src = from_input ? INP(F, IN_X) + ((size_t)b * SEQ + (t - CTXL)) * DM : xb + (size_t)r * DM;
        f32x4 v[8]; load_row(src, lane, v);
        float* op = F.out + ((size_t)b * SEQ + (t - CTXL)) * DM;
#pragma unroll
        for (int j = 0; j < 8; ++j) *(f32x4*)(op + 4 * lane + 256 * j) = v[j];
    }
}

constexpr int N_PHASES = 2 + 11 * NLAYER;
__global__ void __launch_bounds__(512, 2) fwd_kernel(Args args) {
    extern __shared__ __attribute__((aligned(16))) unsigned char lds[];
    Frame F;
    F.lds = (LAS unsigned char*)lds; F.ldsg = (char*)lds;
    F.MISC = (volatile LAS unsigned*)(F.lds + MISC_OFF);
    F.G = gridDim.x;
    F.out = args.out; F.ws = args.ws; F.ctl = (unsigned*)(args.ws + WS_CTL);
    for (int u = threadIdx.x; u < (LDS_BYTES - LDSCTL_OFF) / 4; u += 512) ((LAS unsigned*)(F.lds + LDSCTL_OFF))[u] = 0u;
    __syncthreads();
    if (threadIdx.x < 23) { const unsigned long long pv = (unsigned long long)args.in[threadIdx.x]; LAS unsigned* t = (LAS unsigned*)(F.lds + ARGTAB_OFF) + 2 * threadIdx.x; t[0] = (unsigned)pv; t[1] = (unsigned)(pv >> 32); }
    __syncthreads();
    XcdBarrier bar; bar.bar = F.ctl + CW_BAR; bar.x = 0; bar.st = nullptr;
    if (!MK_PER_PHASE) bar = xcd_barrier_post(F.ctl + CW_BAR, F.MISC + 8);
    const int lo = args.ph_lo, hi = args.ph_hi;
#define IN(k) (lo <= (k) && (k) < hi)
    unsigned long long probe_t0 = 0ull, probe_acc = 0ull;
#define PROBE_BEGIN(k) do { if (PROBE_MASK & (1u << (k))) probe_t0 = __builtin_amdgcn_s_memrealtime(); } while (0)
#define SEAM(k) do { if (IN(k) && IN((k) + 1)) xcd_barrier(bar); if (PROBE_MASK & (1u << (k))) probe_acc += __builtin_amdgcn_s_memrealtime() - probe_t0; } while (0)

    if (IN(0)) { PROBE_BEGIN(0); if (PH_ON(0)) phase_prologue(F); if (IN(1)) xcd_barrier_first(bar); if (PROBE_MASK & 1u) probe_acc += __builtin_amdgcn_s_memrealtime() - probe_t0; }
    if (IN(1)) { PROBE_BEGIN(1); if (PH_ON(1)) phase_rowpass1_l0(F); SEAM(1); }
    for (int l = 0; l < NLAYER; ++l) {
        const int pb = 2 + 11 * l;
        const bool ctx = (l == 0);
        if (IN(pb + 0)) { PROBE_BEGIN(pb + 0); if (PH_ON(2)) {
            pg8::SchedDense S; S.init(F.ws + WS_HN, F.ws + WS_WIN + (size_t)l * INW * DM * 2, NTOK / 256, INW / 256, F.G, (int)blockIdx.x, 0);
            pg8::EpiPost E{(bf16_t*)(F.ws + WS_P), (const float*)(F.ws + WS_ROPE), INP(F, IN_QNA) + l * 128, INP(F, IN_KNA) + l * 128, INP(F, IN_QNC) + l * 128, INP(F, IN_KNC) + l * 128, INP(F, IN_VNB) + l * 512, F.lds + LDSCTL_OFF + 2048};
            pg8::gemm_phase<pg8::EpiPost, pg8::SchedDense>(F.lds, S, E);
            if ((CONV_HOOKS & 2) && (int)blockIdx.x >= (NTOK / 256) * (INW / 256) - 3 * F.G) conv_help(F, 10, nullptr, 0u); }
            SEAM(pb + 0); }
        if (IN(pb + 2)) { PROBE_BEGIN(pb + 2); if (PH_ON(4)) phase_mixers(F, l); SEAM(pb + 2); }
        if (IN(pb + 3)) { PROBE_BEGIN(pb + 3); if (PH_ON(5)) phase_groupnorm(F, l); SEAM(pb + 3); }
        if (IN(pb + 4)) { PROBE_BEGIN(pb + 4); if (PH_ON(6)) {
            pg8::SchedDense S; S.init(F.ws + WS_O, F.ws + WS_WOUT + (size_t)l * DM * DM * 2, ctx ? NTOK / 256 : 64, DM / 256, F.G, (int)blockIdx.x, ctx ? 0 : 1);
            float* xb = (float*)(F.ws + WS_XB);
            pg8::EpiResid E;
            if (l == 0) { E.ctxbase = INP(F, IN_CTX); E.latbase = INP(F, IN_X); E.cbs = CTXL; E.lbs = SEQ; }
            else { E.ctxbase = xb; E.latbase = xb + (size_t)CTXL * DM; E.cbs = TPB; E.lbs = TPB; }
            E.xout = xb; E.modl = (const float*)(F.ws + WS_MOD) + (size_t)l * 5 * NMOD; E.parts = (float*)(F.ws + WS_PART);
            pg8::gemm_phase<pg8::EpiResid, pg8::SchedDense>(F.lds, S, E);
            if ((CONV_HOOKS & 4) && ctx && (int)blockIdx.x >= (NTOK / 256) * (DM / 256) - 2 * F.G) conv_help(F, 9, nullptr, 0u); }
            SEAM(pb + 4); }
        if (IN(pb + 5)) { PROBE_BEGIN(pb + 5); if (PH_ON(7)) phase_rowpass2(F, l); SEAM(pb + 5); }
        if (IN(pb + 6)) { PROBE_BEGIN(pb + 6); if (PH_ON(8)) { phase_topk(F, l);
            if (l == 0) { if ((CONV_HOOKS & 8) && (int)blockIdx.x >= 128) conv_help(F, 2, nullptr, 0u); } else conv_help(F, 1 << 20, nullptr, 0u); }
            SEAM(pb + 6); }
        if (IN(pb + 8)) { PROBE_BEGIN(pb + 8); if (PH_ON(10)) {
            if ((l == 0) ? (FP8_L0 != 0) : (FP8_L1 != 0)) {
                pg8::SchedGrouped<pg8::GK> S; S.init(F.ws + WS_HN8, F.ws + WS_WGU + (size_t)l * NE * 4096 * DM * 2, ctx ? 9 : 8, 16, F.G, (int)blockIdx.x);
                pg8::EpiSwiGLU8 E{(unsigned char*)(F.ws + WS_H)};
                pg8::gemm_phase<pg8::EpiSwiGLU8, pg8::SchedGrouped<pg8::GK>, true, true>(F.lds, S, E, (const unsigned*)(F.ws + WS_OFFS), F.lds + LDSCTL_OFF + 2048);
            } else {
                pg8::SchedGrouped<2 * pg8::GK> S; S.init(F.ws + WS_HN, F.ws + WS_WGU + (size_t)l * NE * 4096 * DM * 2, ctx ? 9 : 8, 16, F.G, (int)blockIdx.x);
                pg8::EpiSwiGLU E{(bf16_t*)(F.ws + WS_H)};
                pg8::gemm_phase<pg8::EpiSwiGLU, pg8::SchedGrouped<2 * pg8::GK>, false, true>(F.lds, S, E, (const unsigned*)(F.ws + WS_OFFS), F.lds + LDSCTL_OFF + 2048);
            } }
            SEAM(pb + 8); }
        if (IN(pb + 9)) { PROBE_BEGIN(pb + 9); if (PH_ON(11)) {
            pg8::EpiStoreBf16 E{(bf16_t*)(F.ws + WS_XG), DM};
            if ((l == 0) ? (FP8_L0 != 0) : (FP8_L1 != 0)) {
                pg8::SchedGrouped<pg8::GK> S; S.init(F.ws + WS_H, F.ws + WS_WD + (size_t)l * NE * DM * DM * 2, ctx ? 9 : 8, 8, F.G, (int)blockIdx.x);
                pg8::gemm_phase<pg8::EpiStoreBf16, pg8::SchedGrouped<pg8::GK>, true>(F.lds, S, E);
                if ((CONV_HOOKS & 16) && ctx && (((int)blockIdx.x >> 3) & 31) >= 16) conv_help(F, 3, nullptr, 0u);
            } else {
                pg8::SchedGrouped<2 * pg8::GK> S; S.init(F.ws + WS_H, F.ws + WS_WD + (size_t)l * NE * DM * DM * 2, ctx ? 9 : 8, 8, F.G, (int)blockIdx.x);
                pg8::gemm_phase<pg8::EpiStoreBf16, pg8::SchedGrouped<2 * pg8::GK>, false>(F.lds, S, E);
            } }
            SEAM(pb + 9); }
        if (IN(pb + 10)) { PROBE_BEGIN(pb + 10); if (PH_ON(12)) phase_combine(F, l); if (l + 1 < NLAYER) SEAM(pb + 10); else if (PROBE_MASK & (1u << (pb + 10))) probe_acc += __builtin_amdgcn_s_memrealtime() - probe_t0; }
    }
    if (PROBE_MASK) { const unsigned long long te = __builtin_amdgcn_s_memrealtime(); while (__builtin_amdgcn_s_memrealtime() - te < probe_acc) __builtin_amdgcn_s_sleep(8); }
#undef IN
#undef SEAM
}

extern "C" void kernel_launch(void* const* d_in, const int* in_sizes, int n_in, void* d_out, int out_size, void* d_ws, size_t ws_size, hipStream_t stream) {
    static int grid = 0;
    if (grid == 0) {
        if (n_in != 23 || out_size != NB * SEQ * DM || ws_size < WS_END) { fprintf(stderr, "kernel_launch: shape mismatch: n_in %d out %d ws %zu (need %zu)\n", n_in, out_size, ws_size, (size_t)WS_END); grid = -1; return; }
        int dev = 0, cus = 0, per_cu = 0;
        if (hipGetDevice(&dev) != hipSuccess || hipDeviceGetAttribute(&cus, hipDeviceAttributeMultiprocessorCount, dev) != hipSuccess) { grid = -1; return; }
        if (hipFuncSetAttribute((const void*)fwd_kernel, hipFuncAttributeMaxDynamicSharedMemorySize, LDS_BYTES) != hipSuccess) { fprintf(stderr, "kernel_launch: hipFuncSetAttribute failed\n"); grid = -1; return; }
        if (hipOccupancyMaxActiveBlocksPerMultiprocessor(&per_cu, (const void*)fwd_kernel, 512, LDS_BYTES) != hipSuccess || per_cu < 1) { fprintf(stderr, "kernel_launch: occupancy query says %d\n", per_cu); }
        (void)hipGetLastError();
        grid = cus;
    }
    if (grid < 0) return;
    if (hipMemsetAsync((char*)d_ws + WS_CTL, 0, CTL_ZERO_BYTES, stream) != hipSuccess) return;
    Args a{};
    for (int i = 0; i < 23; ++i) a.in[i] = (const float*)d_in[i];
    a.out = (float*)d_out; a.ws = (unsigned char*)d_ws;
#if MK_PER_PHASE
    for (int p = 0; p < N_PHASES; ++p) { a.ph_lo = p; a.ph_hi = p + 1; hipLaunchKernelGGL(fwd_kernel, dim3(grid), dim3(512), LDS_BYTES, stream, a); }
#else
    a.ph_lo = 0; a.ph_hi = N_PHASES;
    hipLaunchKernelGGL(fwd_kernel, dim3(grid), dim3(512), LDS_BYTES, stream, a);
#endif
    const hipError_t le = hipPeekAtLastError();
    if (le != hipSuccess) fprintf(stderr, "kernel_launch: launch failed: %s\n", hipGetErrorName(le));
}
```

```cpp
#include <hip/hip_runtime.h>
#include <cstdio>
#include <cstdint>

#define LAS __attribute__((address_space(3)))
#define GAS __attribute__((address_space(1)))
typedef unsigned short bf16_t;
typedef short bf16x8 __attribute__((ext_vector_type(8)));
typedef short s16x4 __attribute__((ext_vector_type(4)));
typedef float f32x2 __attribute__((ext_vector_type(2)));
typedef float f32x4 __attribute__((ext_vector_type(4)));
typedef float f32x16 __attribute__((ext_vector_type(16)));
typedef unsigned u32x2 __attribute__((ext_vector_type(2)));
typedef unsigned u32x4 __attribute__((ext_vector_type(4)));
typedef int i32x4 __attribute__((ext_vector_type(4)));
typedef int i32x8 __attribute__((ext_vector_type(8)));

#ifndef MK_PER_PHASE
#define MK_PER_PHASE 0
#endif
#ifndef PHASE_MASK
#define PHASE_MASK 0x1fff
#endif
#define PH_ON(k) (((PHASE_MASK) >> (k)) & 1)
#ifndef FP8_L0
#define FP8_L0 1
#endif
#ifndef FP8_L1
#define FP8_L1 1
#endif
#ifndef PROBE_MASK
#define PROBE_MASK 0u
#endif
#ifndef DBG_STOP
#define DBG_STOP 0
#endif

constexpr int DM = 2048, NB = 4, SEQ = 4096, CTXL = 256, TPB = SEQ + CTXL, NTOK = NB * TPB;
constexpr int INW = 3584, NE = 16, NLAYER = 2, NMOD = 6 * DM;
constexpr int C_QA = 0, C_KA = 768, C_VA = 1024, C_UB = 1280, C_VB = 1792, C_QC = 2304, C_KC = 3072, C_VC = 3328;
constexpr int O_A = 0, O_B = 768, O_C = 1280;
constexpr int CAP_L = 512, CAP_C = 32, ROWS_E = 2304;
constexpr float EPS = 1e-6f;

constexpr size_t MiB = 1u << 20;
constexpr size_t WS_CTL = 0, CTL_ZERO_BYTES = 65536;
constexpr size_t WS_MOD = 1 * MiB;
constexpr size_t WS_ROPE = 2 * MiB;
constexpr size_t WS_AFFL = 3 * MiB;
constexpr size_t WS_AFFC = 4 * MiB;
constexpr size_t WS_POSL = 5 * MiB;
constexpr size_t WS_POSC = 6 * MiB;
constexpr size_t WS_OFFS = 10 * MiB;
constexpr size_t WS_GATE = 8 * MiB;
constexpr size_t WS_WRT = 9 * MiB;
constexpr size_t WS_WRS = 11 * MiB;
constexpr size_t WS_GS2 = 12 * MiB;
constexpr size_t WS_PART = 13 * MiB + 0;
constexpr size_t WS_SSQ = 14 * MiB;
constexpr size_t WS_WIN = 16 * MiB;
constexpr size_t WS_WOUT = WS_WIN + (size_t)2 * INW * DM * 2;
constexpr size_t WS_WGU = WS_WOUT + (size_t)2 * DM * DM * 2;
constexpr size_t WS_WD = WS_WGU + (size_t)2 * NE * 4096 * DM * 2;
constexpr size_t WS_HN = WS_WD + (size_t)2 * NE * DM * DM * 2;
constexpr size_t WS_P = WS_HN + (size_t)NTOK * DM * 2;
constexpr size_t WS_O = WS_P + (size_t)NTOK * INW * 2;
constexpr size_t WS_XB = WS_O + (size_t)NTOK * DM * 2;
constexpr size_t WS_XG = WS_XB + (size_t)NTOK * DM * 4;
constexpr size_t WS_H = WS_XG + (size_t)NE * ROWS_E * DM * 2;
constexpr size_t WS_HN8 = WS_H + (size_t)NE * ROWS_E * DM * 2;
constexpr size_t WS_END = WS_HN8 + (size_t)NTOK * DM;
constexpr float W8_SCALE = 32.f; constexpr int W8_SCALE_E8M0 = 127 - 5;
constexpr int CW_BAR = 4096, CW_QUEUE = 8192;
constexpr int CW_CONV = 10240, CW_MIXDONE = 10304;
constexpr int NT8_ALL = 2 * NE * 3 * 128, NT8_L0 = NT8_ALL / 2;
#ifndef CONV_HOOKS
#define CONV_HOOKS 0x1f
#endif
#ifndef CONV_IDLE
#define CONV_IDLE 1
#endif

constexpr int RING_BYTES = 131072, LDSCTL_OFF = RING_BYTES, MISC_OFF = LDSCTL_OFF + 320, LDS_BYTES = 147456;

#define LDS_WAIT() asm volatile("s_waitcnt lgkmcnt(0)" ::: "memory")
#define VM_WAIT() asm volatile("s_waitcnt vmcnt(0)" ::: "memory")
__device__ __forceinline__ unsigned f2bf(float f) { unsigned u = __builtin_bit_cast(unsigned, f); return (u + 0x7fffu + ((u >> 16) & 1u)) >> 16; }
__device__ __forceinline__ unsigned pk2(float lo, float hi) { return f2bf(lo) | (f2bf(hi) << 16); }
__device__ __forceinline__ float bf2f(unsigned short b) { return __builtin_bit_cast(float, ((unsigned)b) << 16); }
__device__ __forceinline__ float bflo(unsigned w) { return __builtin_bit_cast(float, w << 16); }
__device__ __forceinline__ float bfhi(unsigned w) { return __builtin_bit_cast(float, w & 0xffff0000u); }
__device__ __forceinline__ unsigned pk4_fp8(float a, float b, float c, float d) {
    int r = __builtin_amdgcn_cvt_pk_fp8_f32(a, b, 0, false); r = __builtin_amdgcn_cvt_pk_fp8_f32(c, d, r, true); return (unsigned)r; }
__device__ __forceinline__ int opaque_tid() { int t = threadIdx.x; asm volatile("" : "+v"(t)); return t; }
__device__ __forceinline__ float row16_sum(float v) {
    v += __builtin_bit_cast(float, __builtin_amdgcn_update_dpp(0, __builtin_bit_cast(int, v), 0xB1, 0xF, 0xF, true));
    v += __builtin_bit_cast(float, __builtin_amdgcn_update_dpp(0, __builtin_bit_cast(int, v), 0x4E, 0xF, 0xF, true));
    v += __builtin_bit_cast(float, __builtin_amdgcn_update_dpp(0, __builtin_bit_cast(int, v), 0x141, 0xF, 0xF, true));
    v += __builtin_bit_cast(float, __builtin_amdgcn_update_dpp(0, __builtin_bit_cast(int, v), 0x140, 0xF, 0xF, true));
    return v;
}
__device__ __forceinline__ float wave_sum(float v) {
    v = row16_sum(v);
    const int iv = __builtin_bit_cast(int, v);
    const float a = __builtin_bit_cast(float, __builtin_amdgcn_readlane(iv, 0)), b = __builtin_bit_cast(float, __builtin_amdgcn_readlane(iv, 16));
    const float c = __builtin_bit_cast(float, __builtin_amdgcn_readlane(iv, 32)), d = __builtin_bit_cast(float, __builtin_amdgcn_readlane(iv, 48));
    return (a + b) + (c + d);
}
__device__ __forceinline__ float rsqrt_fast(float x) { return __builtin_amdgcn_rsqf(x); }
__device__ __forceinline__ float gelu_tanh(float x) {
    const float u = 0.7978845608028654f * (x + 0.044715f * x * x * x);
    const float e = __expf(2.f * u);
    const float th = 1.f - 2.f / (e + 1.f);
    return 0.5f * x * (1.f + th);
}

#define XB_TMO      128
#define XB_XCNT(j)  (256  + 64 * (j))
#define XB_XSUB(j)  (1280 + 64 * (j))
#define XB_XGEN(j)  (2304 + 64 * (j))
#define XB_TOP      3328
#define XB_TOPGEN   3392
#define XCD_BAR_WORDS 3456
#define XB_SPIN_CAP (1u << 18)
__device__ __forceinline__ unsigned xb_ld(unsigned* p)              { return __hip_atomic_load(p, __ATOMIC_RELAXED, __HIP_MEMORY_SCOPE_AGENT); }
__device__ __forceinline__ unsigned xb_add(unsigned* p, unsigned v) { return __hip_atomic_fetch_add(p, v, __ATOMIC_RELAXED, __HIP_MEMORY_SCOPE_AGENT); }
__device__ __forceinline__ unsigned xb_xcc_id() { return (unsigned)__builtin_amdgcn_s_getreg((3 << 11) | 20) & 0xFu; }
#define XB_SPIN(cond, bar) do { unsigned _sp = 0; while (cond) { __builtin_amdgcn_s_sleep(1); \
    if ((++_sp & 255u) == 0u) { if (xb_ld(&(bar)[XB_TMO])) break; if (_sp > XB_SPIN_CAP) { atomicAdd(&(bar)[XB_TMO], 1u); break; } } } } while (0)
struct XcdBarrier { unsigned* bar; unsigned x; volatile LAS unsigned* st; };
__device__ __forceinline__ XcdBarrier xcd_barrier_post(unsigned* bar, volatile LAS unsigned* st) {
    XcdBarrier b; b.bar = bar; b.x = xb_xcc_id(); b.st = st;
    if (threadIdx.x == 0) (void)xb_add(&bar[XB_XCNT(b.x)], 1u);
    return b;
}
__device__ __forceinline__ void xcd_barrier_complete(unsigned* bar, unsigned x, unsigned& nloc, unsigned& nx) {
    const unsigned G = gridDim.x * gridDim.y * gridDim.z;
    unsigned sum, cnt, mine, sp = 0u;
    for (;;) {
        sum = 0u; cnt = 0u; mine = 0u;
#pragma unroll
        for (unsigned j = 0; j < 16; ++j) { const unsigned c = xb_ld(&bar[XB_XCNT(j)]); sum += c; cnt += (c > 0u) ? 1u : 0u; mine = (j == x) ? c : mine; }
        if (sum == G) break;
        __builtin_amdgcn_s_sleep(1);
        if ((++sp & 255u) == 0u) { if (xb_ld(&bar[XB_TMO])) break; if (sp > XB_SPIN_CAP) { atomicAdd(&bar[XB_TMO], 1u); break; } }
    }
    nloc = mine > 0u ? mine : 1u; nx = cnt > 0u ? cnt : 1u;
}
template <bool FIRST>
__device__ __forceinline__ void xcd_barrier_t(const XcdBarrier& b) {
    asm volatile("s_waitcnt vmcnt(0)" ::: "memory");
    __syncthreads();
    if (threadIdx.x == 0) {
        unsigned* bar = b.bar;
        asm volatile("" : "+s"(bar));
        __builtin_amdgcn_s_waitcnt(0);
        unsigned nloc = b.st[0], nx = b.st[1];
        if constexpr (FIRST) { if (nloc == 0u) { xcd_barrier_complete(bar, b.x, nloc, nx); b.st[0] = nloc; b.st[1] = nx; } }
        const unsigned old = xb_add(&bar[XB_XSUB(b.x)], 1u);
        const unsigned gen = old / nloc;
        if (old + 1u == (gen + 1u) * nloc) {
            __builtin_amdgcn_fence(__ATOMIC_RELEASE, "agent");
            asm volatile("s_waitcnt vmcnt(0)" ::: "memory");
            const unsigned og = xb_add(&bar[XB_TOP], 1u);
            const unsigned tg = og / nx;
            if (og + 1u == (tg + 1u) * nx) xb_add(&bar[XB_TOPGEN], 1u);
            else XB_SPIN(xb_ld(&bar[XB_TOPGEN]) == tg, bar);
            __builtin_amdgcn_fence(__ATOMIC_ACQUIRE, "agent");
            xb_add(&bar[XB_XGEN(b.x)], 1u);
            asm volatile("s_waitcnt vmcnt(0)" ::: "memory");
        } else {
            XB_SPIN(xb_ld(&bar[XB_XGEN(b.x)]) == gen, bar);
            __builtin_amdgcn_fence(__ATOMIC_ACQUIRE, "agent");
            asm volatile("s_waitcnt vmcnt(0)" ::: "memory");
        }
    }
    __syncthreads();
}
__device__ __forceinline__ void xcd_barrier(const XcdBarrier& b) { xcd_barrier_t<false>(b); }
__device__ __forceinline__ void xcd_barrier_first(const XcdBarrier& b) { xcd_barrier_t<true>(b); }

namespace pg8 {
constexpr int BM = 256, BK = 64, HALF = 128, HTB = HALF * BK * 2, STAGE_BYTES = 8 * HTB, NXCD = 8, WGM = 8;
constexpr int GK = 2048;
__host__ __device__ __forceinline__ int lds_byte(int r, int c) { const int st = (r >> 4) * 2 + (c >> 5), rr = r & 15, cc = c & 31, ob = rr * 64 + cc * 2; return st * 1024 + (ob ^ (((ob >> 9) & 1) << 5)); }
__host__ __device__ __forceinline__ void stage_rc(int b, int& R, int& C) { const int st = b / 1024, sb = b % 1024, swz = sb ^ (((sb >> 9) & 1) << 5); R = (st >> 1) * 16 + swz / 64; C = (st & 1) * 32 + (swz % 64) / 2; }
__host__ __device__ __forceinline__ int perm32(int rho) { const int n = rho >> 4, i = rho & 15; return 8 * (i >> 2) + 4 * n + (i & 3); }

struct Unit { int pm, pn, e, rowbase, colbase, oidx, slot; const char* a; const char* b; };

struct SchedDense {
    static constexpr int RB = GK * 2;
    const char* A; const char* Bt; int nM, nN, nwg, G, c, skipctx;
    __device__ void init(const void* A_, const void* Bt_, int nM_, int nN_, int G_, int c_, int skipctx_) { A = (const char*)A_; Bt = (const char*)Bt_; nM = nM_; nN = nN_; nwg = nM * nN; G = G_; c = c_; skipctx = skipctx_; }
    __device__ bool next(int i, Unit& u) const {
        const long L = (long)i * G + c; if (L >= nwg) return false;
        int wgid = (int)L; { const int q = nwg / NXCD, r = nwg % NXCD, xcd = wgid % NXCD, off = wgid / NXCD; wgid = (xcd < r ? xcd * (q + 1) : r * (q + 1) + (xcd - r) * q) + off; }
        const int nig = WGM * nN, gid = wgid / nig, fm = gid * WGM, gsz = (nM - fm) < WGM ? (nM - fm) : WGM;
        int pm = fm + ((wgid % nig) % gsz); const int pn = (wgid % nig) / gsz;
        if (skipctx) pm = (pm >> 4) * 17 + 1 + (pm & 15);
        u.pm = pm; u.pn = pn; u.e = 0; u.rowbase = pm * BM; u.colbase = pn * BM; u.oidx = 0;
        u.a = A + (size_t)pm * (BM * GK * 2); u.b = Bt + (size_t)pn * (BM * GK * 2); return true;
    }
};
template <int RB_> struct SchedGrouped {
    static constexpr int RB = RB_;
    const char* A; const char* Bt; int nMe, nNe, nwg, G, c;
    __device__ void init(const void* A_, const void* Bt_, int nMe_, int nNe_, int G_, int c_) { A = (const char*)A_; Bt = (const char*)Bt_; nMe = nMe_; nNe = nNe_; nwg = NE * nMe * nNe; G = G_; c = c_; }
    __device__ bool next(int i, Unit& u) const {
        int e, pm, pn;
        if ((G & 255) == 0) {
            const int cpe = nNe >> 2, nchunk = NE * cpe, xcd = c & 7, slot = (c >> 3) & 31, sub = c >> 8;
            const int chunk = (i * (G >> 8) + sub) * 8 + xcd;
            if (chunk < nchunk) { e = chunk / cpe; pm = slot >> 2; pn = (chunk % cpe) * 4 + (slot & 3); }
            else { const int per = (NE * nNe) >> 3;
                if (nMe < 9 || chunk >= nchunk + 8 || slot >= per) return false; const int j = (chunk - nchunk) * per + slot; e = j / nNe; pn = j % nNe; pm = 8; }
        } else { const long L = (long)i * G + c; if (L >= nwg) return false; const int per = nMe * nNe, rem = (int)L % per; e = (int)L / per; pm = rem % nMe; pn = rem / nMe; }
        u.pm = pm; u.pn = pn; u.e = e; u.rowbase = e * ROWS_E + pm * BM; u.colbase = pn * BM; u.oidx = e * 9 + pm;
        u.a = A + (size_t)(e * ROWS_E + pm * BM) * RB; u.b = Bt + ((size_t)e * nNe + pn) * (BM * RB); return true;
    }
};

__device__ __forceinline__ unsigned cvt_pk_bf16(float lo, float hi) { unsigned r; asm volatile("v_cvt_pk_bf16_f32 %0, %1, %2" : "=v"(r) : "v"(lo), "v"(hi)); return r; }

struct EpiStoreBf16 {
    static constexpr bool PERM = true;
    bf16_t* O; int ldc;
    __device__ __forceinline__ void operator()(const f32x4 (&acc)[2][2][4][2], const Unit& u, int wr, int wc, int fr, int fq) const {
        const int row0 = u.rowbase + wr * 64 + fr, col0 = u.colbase + wc * 32 + 8 * fq;
#pragma unroll
        for (int ai = 0; ai < 2; ++ai)
#pragma unroll
            for (int m = 0; m < 4; ++m) { bf16_t* rowp = O + (size_t)(row0 + ai * HALF + m * 16) * ldc + col0;
#pragma unroll
                for (int bj = 0; bj < 2; ++bj) { const f32x4 v0 = acc[ai][bj][m][0], v1 = acc[ai][bj][m][1];
                    u32x4 w; w.x = cvt_pk_bf16(v0[0], v0[1]); w.y = cvt_pk_bf16(v0[2], v0[3]); w.z = cvt_pk_bf16(v1[0], v1[1]); w.w = cvt_pk_bf16(v1[2], v1[3]);
                    *(u32x4*)(rowp + bj * HALF) = w; } }
    }
};
struct EpiPost {
    static constexpr bool PERM = true;
    bf16_t* P; const float* rope; const float* qna; const float* kna; const float* qnc; const float* knc; const float* vnb; LAS unsigned char* tab;
    __device__ __forceinline__ void operator()(f32x4 (&acc)[2][2][4][2], const Unit& u, int wr, int wc, int fr, int fq) const {
        const int tb = u.pm % 17; const bool lat = tb != 0;
        const int d0 = 64 * (wc >> 1) + 16 * (wc & 1) + 4 * fq, rl0 = wr * 64 + fr;
        int typ[2]; const float* gain[2];
#pragma unroll
        for (int bj = 0; bj < 2; ++bj) { const int slot = 2 * u.pn + bj;
            typ[bj] = (slot < 8) ? 3 : (slot < 10) ? 0 : (slot < 14) ? 1 : (slot < 18) ? 2 : (slot < 26) ? 3 : 0;
            gain[bj] = (slot < 6) ? qna : (slot < 8) ? kna : (slot < 18) ? vnb + ((slot - 14) & 3) * 128 : (slot < 24) ? qnc : knc; }
        const bool anynorm = typ[0] >= 2 || typ[1] >= 2;
#pragma unroll
        for (int bj = 0; bj < 2; ++bj) if (typ[bj] == 1 || typ[bj] == 2) {
#pragma unroll
            for (int ai = 0; ai < 2; ++ai)
#pragma unroll
                for (int m = 0; m < 4; ++m)
#pragma unroll
                    for (int n = 0; n < 2; ++n)
#pragma unroll
                        for (int j = 0; j < 4; ++j) acc[ai][bj][m][n][j] = gelu_tanh(acc[ai][bj][m][n][j]); }
        if (anynorm) {
#pragma unroll
            for (int bj = 0; bj < 2; ++bj) if (typ[bj] >= 2) {
#pragma unroll
                for (int ai = 0; ai < 2; ++ai)
#pragma unroll
                    for (int m = 0; m < 4; ++m) { const f32x4 a = acc[ai][bj][m][0], b = acc[ai][bj][m][1];
                        float ss = ((a.x * a.x + a.y * a.y) + (a.z * a.z + a.w * a.w)) + ((b.x * b.x + b.y * b.y) + (b.z * b.z + b.w * b.w));
                        ss += __builtin_bit_cast(float, __builtin_amdgcn_ds_swizzle(__builtin_bit_cast(int, ss), 0x401F));
                        { auto rr = __builtin_amdgcn_permlane32_swap(__float_as_uint(ss), __float_as_uint(ss), false, false); ss = __uint_as_float(rr[0]) + __uint_as_float(rr[1]); }
                        if (fq == 0) *(LAS float*)(tab + (((rl0 + ai * HALF + m * 16) * 2 + bj) * 4 + wc) * 4) = ss; } }
            asm volatile("s_waitcnt lgkmcnt(0)" ::: "memory"); __builtin_amdgcn_s_barrier(); asm volatile("" ::: "memory");
        }
#pragma unroll
        for (int bj = 0; bj < 2; ++bj) {
            const int slot = 2 * u.pn + bj;
            f32x4 g0 = (f32x4){1.f, 1.f, 1.f, 1.f}, g1 = g0;
            if (typ[bj] >= 2) { g0 = *(const f32x4*)(gain[bj] + d0); g1 = *(const f32x4*)(gain[bj] + d0 + 32); }
#pragma unroll
            for (int ai = 0; ai < 2; ++ai)
#pragma unroll
                for (int m = 0; m < 4; ++m) { const int rl = rl0 + ai * HALF + m * 16;
                    f32x4 a = acc[ai][bj][m][0], b = acc[ai][bj][m][1];
                    if (typ[bj] >= 2) { const f32x4 t = *(const LAS f32x4*)(tab + ((rl * 2 + bj) * 4) * 4);
                        const float rinv = rsqrt_fast(((t.x + t.y) + (t.z + t.w)) * (1.f / 128) + EPS);
                        a = a * rinv * g0; b = b * rinv * g1; }
                    if (typ[bj] == 3 && lat) { const int pos = (tb - 1) * 256 + rl, pp = (wc >> 1) ? (pos & 63) : (pos >> 6);
                        const f32x4* cs = (const f32x4*)(rope + 2 * (pp * 32 + 16 * (wc & 1) + 4 * fq)); const f32x4 c0 = cs[0], c1 = cs[1];
                        const f32x4 cv = (f32x4){c0.x, c0.z, c1.x, c1.z}, sv = (f32x4){c0.y, c0.w, c1.y, c1.w};
                        const f32x4 ra = a * cv - b * sv, rb = b * cv + a * sv; a = ra; b = rb; }
                    bf16_t* rowp = P + (size_t)(u.rowbase + rl) * INW + slot * 128 + d0;
                    u32x2 w0, w1; w0.x = cvt_pk_bf16(a.x, a.y); w0.y = cvt_pk_bf16(a.z, a.w); w1.x = cvt_pk_bf16(b.x, b.y); w1.y = cvt_pk_bf16(b.z, b.w);
                    *(u32x2*)rowp = w0; *(u32x2*)(rowp + 32) = w1; }
        }
    }
};
struct EpiResid {
    static constexpr bool PERM = false;
    const float* ctxbase; const float* latbase; int cbs, lbs;
    float* xout; const float* modl;
    float* parts;
    LAS unsigned char* ktab;
    __device__ __forceinline__ void operator()(const f32x4 (&acc)[2][2][4][2], const Unit& u, int wr, int wc, int fr, int fq) const {
        const int b = u.pm / 17, tb = u.pm % 17;
        const float* src = (tb == 0) ? ctxbase + (size_t)b * cbs * DM : latbase + ((size_t)b * lbs + (size_t)(tb - 1) * 256) * DM;
        const float* g1 = modl + (size_t)((tb == 0) ? 4 : b) * NMOD + 2 * DM;
        const int rl0 = wr * 64 + fr, col0 = u.colbase + wc * 32 + 4 * fq;
#pragma unroll
        for (int ai = 0; ai < 2; ++ai)
#pragma unroll
        for (int mh = 0; mh < 2; ++mh) {
            f32x4 gv[2][2];
#pragma unroll
            for (int bj = 0; bj < 2; ++bj)
#pragma unroll
                for (int n = 0; n < 2; ++n) gv[bj][n] = *(const f32x4*)(g1 + col0 + bj * HALF + n * 16);
            f32x4 xv[2][2][2];
#pragma unroll
            for (int mm = 0; mm < 2; ++mm) { const float* sp = src + (size_t)(rl0 + ai * HALF + (2 * mh + mm) * 16) * DM + col0;
#pragma unroll
                for (int bj = 0; bj < 2; ++bj)
#pragma unroll
                    for (int n = 0; n < 2; ++n) xv[mm][bj][n] = *(const f32x4*)(sp + bj * HALF + n * 16); }
#pragma unroll
            for (int mm = 0; mm < 2; ++mm) { const int m = 2 * mh + mm, rl = rl0 + ai * HALF + m * 16; float* dp = xout + (size_t)(u.rowbase + rl) * DM + col0; float ss = 0.f;
                const float fz = *(const LAS float*)(ktab + ((size_t)u.slot * 256 + rl) * 16 + 8);
#pragma unroll
                for (int bj = 0; bj < 2; ++bj)
#pragma unroll
                    for (int n = 0; n < 2; ++n) { const f32x4 y = xv[mm][bj][n] + (gv[bj][n] * fz) * acc[ai][bj][m][n]; *(f32x4*)(dp + bj * HALF + n * 16) = y;
                        ss += (y.x * y.x + y.y * y.y) + (y.z * y.z + y.w * y.w); }
                ss += __builtin_bit_cast(float, __builtin_amdgcn_ds_swizzle(__builtin_bit_cast(int, ss), 0x401F));
                { auto rr = __builtin_amdgcn_permlane32_swap(__float_as_uint(ss), __float_as_uint(ss), false, false); ss = __uint_as_float(rr[0]) + __uint_as_float(rr[1]); }
                if (fq == 0) parts[(size_t)(u.rowbase + rl) * 32 + u.pn * 4 + wc] = ss; }
            asm volatile("" ::: "memory");
        }
    }
};
struct EpiSwiGLU {
    static constexpr bool PERM = true;
    bf16_t* Hout;
    __device__ __forceinline__ void operator()(const f32x4 (&acc)[2][2][4][2], const Unit& u, int wr, int wc, int fr, int fq) const {
        const int row0 = u.rowbase + wr * 64 + fr, col0 = u.pn * HALF + wc * 32 + 8 * fq;
#pragma unroll
        for (int ai = 0; ai < 2; ++ai)
#pragma unroll
            for (int m = 0; m < 4; ++m) { bf16_t* rowp = Hout + (size_t)(row0 + ai * HALF + m * 16) * DM + col0; float h[8];
#pragma unroll
                for (int n = 0; n < 2; ++n)
#pragma unroll
                    for (int j = 0; j < 4; ++j) { const float g = acc[ai][0][m][n][j], up = acc[ai][1][m][n][j]; h[n * 4 + j] = g * __builtin_amdgcn_rcpf(1.f + __expf(-g)) * up; }
                u32x4 w; w.x = cvt_pk_bf16(h[0], h[1]); w.y = cvt_pk_bf16(h[2], h[3]); w.z = cvt_pk_bf16(h[4], h[5]); w.w = cvt_pk_bf16(h[6], h[7]);
                *(u32x4*)rowp = w; }
    }
};
struct EpiSwiGLU8 {
    static constexpr bool PERM = true;
    unsigned char* Hout;
    __device__ __forceinline__ void operator()(const f32x4 (&acc)[2][2][4][2], const Unit& u, int wr, int wc, int fr, int fq) const {
        const int row0 = u.rowbase + wr * 64 + fr, col0 = u.pn * HALF + wc * 32 + 8 * fq;
#pragma unroll
        for (int ai = 0; ai < 2; ++ai)
#pragma unroll
            for (int m = 0; m < 4; ++m) { unsigned char* rowp = Hout + (size_t)(row0 + ai * HALF + m * 16) * DM + col0; float h[8];
#pragma unroll
                for (int n = 0; n < 2; ++n)
#pragma unroll
                    for (int j = 0; j < 4; ++j) { const float g = acc[ai][0][m][n][j], up = acc[ai][1][m][n][j]; h[n * 4 + j] = g * __builtin_amdgcn_rcpf(1.f + __expf(-g)) * up; }
                u32x2 w; w.x = pk4_fp8(h[0], h[1], h[2], h[3]); w.y = pk4_fp8(h[4], h[5], h[6], h[7]);
                *(u32x2*)rowp = w; }
    }
};
struct EpiDown {
    static constexpr bool PERM = true;
    bf16_t* Y; const float* gatev;
    __device__ __forceinline__ void operator()(const f32x4 (&acc)[2][2][4][2], const Unit& u, int wr, int wc, int fr, int fq) const {
        const int row0 = u.rowbase + wr * 64 + fr, col0 = u.colbase + wc * 32 + 8 * fq;
#pragma unroll
        for (int ai = 0; ai < 2; ++ai)
#pragma unroll
            for (int m = 0; m < 4; ++m) { const int row = row0 + ai * HALF + m * 16; const float gt = gatev[row]; bf16_t* rowp = Y + (size_t)row * DM + col0;
#pragma unroll
                for (int bj = 0; bj < 2; ++bj) { const f32x4 v0 = acc[ai][bj][m][0] * gt, v1 = acc[ai][bj][m][1] * gt;
                    u32x4 w; w.x = cvt_pk_bf16(v0[0], v0[1]); w.y = cvt_pk_bf16(v0[2], v0[3]); w.z = cvt_pk_bf16(v1[0], v1[1]); w.w = cvt_pk_bf16(v1[2], v1[3]);
                    *(u32x4*)(rowp + bj * HALF) = w; } }
    }
};

template <class Epi, class Sched, bool FP8 = false, bool GATHER = false, bool KSCALE = false, bool ALIGN_EPI = true, bool SP2 = true>
__device__ __forceinline__ void gemm_phase(LAS unsigned char* lds, const Sched& S, const Epi& E, const unsigned* goffs = nullptr, LAS unsigned char* goffs_lds = nullptr) {
    static_assert(!GATHER || SP2, "gather mode is written for the SP2 loop");
    static_assert(Sched::RB == (FP8 ? GK : GK * 2), "operand row bytes");
    const int tid = opaque_tid(), wid = __builtin_amdgcn_readfirstlane(tid >> 6), lane = tid & 63, wr = wid >> 2, wc = wid & 3, fr = lane & 15, fq = lane >> 4;
    constexpr int RB = Sched::RB, nt = RB / 128;
    unsigned voffA[2], voffB[2];
#pragma unroll
    for (int i = 0; i < 2; ++i) { int R, C; stage_rc(tid * 16 + i * 8192, R, C); const int Rb = Epi::PERM ? ((R & ~31) + perm32(R & 31)) : R;
        voffA[i] = (unsigned)(R * RB + C * 2); voffB[i] = (unsigned)(Rb * RB + C * 2); }
    const size_t kstep = (size_t)(BK * 2);
    const size_t hstep = (size_t)HALF * RB;
    const unsigned ldsw = (unsigned)wid * 1024u;
    const int aoff = lds_byte(wr * 64 + fr, fq * 8), boff = lds_byte(wc * 32 + fr, fq * 8);
#define PG8_SA(b, h) (((b) * 2 + (h)) * HTB)
#define PG8_SB(b, h) ((4 + (b) * 2 + (h)) * HTB)
#define PG8_STAGE(bufoff, gbase, voff) do { _Pragma("unroll") for (int _i = 0; _i < 2; ++_i) \
        __builtin_amdgcn_global_load_lds((const unsigned*)((const char*)(gbase) + (voff)[_i]), (LAS unsigned*)(lds + (bufoff) + ldsw + _i * 8192), 16, 0, 0); } while (0)
#define PG8_RD8(p) __builtin_shufflevector(*(const LAS i32x4*)(p), *(const LAS i32x4*)((p) + 1024), 0, 1, 2, 3, 4, 5, 6, 7)
#define PG8_LDA(dst, b, h) do { _Pragma("unroll") for (int m = 0; m < 4; ++m) { if constexpr (FP8) dst##8[m] = PG8_RD8(lds + PG8_SA(b, h) + aoff + m * 2048); \
        else { _Pragma("unroll") for (int k = 0; k < 2; ++k) dst[m][k] = *(const LAS bf16x8*)(lds + PG8_SA(b, h) + aoff + m * 2048 + k * 1024); } } } while (0)
#define PG8_LDB(dst, b, h) do { _Pragma("unroll") for (int n = 0; n < 2; ++n) { if constexpr (FP8) dst##8[n] = PG8_RD8(lds + PG8_SB(b, h) + boff + n * 2048); \
        else { _Pragma("unroll") for (int k = 0; k < 2; ++k) dst[n][k] = *(const LAS bf16x8*)(lds + PG8_SB(b, h) + boff + n * 2048 + k * 1024); } } } while (0)
#define PG8_MMA(ai, bj, At, Bt) do { __builtin_amdgcn_s_setprio(1); _Pragma("unroll") for (int m = 0; m < 4; ++m) _Pragma("unroll") for (int n = 0; n < 2; ++n) { \
        if constexpr (FP8) asm volatile("v_mfma_scale_f32_16x16x128_f8f6f4 %0, %1, %2, %0, %3, %4 op_sel_hi:[0,0,0]" : "+v"(acc[ai][bj][m][n]) : "v"(Bt##8[n]), "v"(At##8[m]), "v"(sclW), "v"(sclX)); \
        else { _Pragma("unroll") for (int k = 0; k < 2; ++k) acc[ai][bj][m][n] = __builtin_amdgcn_mfma_f32_16x16x32_bf16(Bt[n][k], At[m][k], acc[ai][bj][m][n], 0, 0, 0); } } \
        __builtin_amdgcn_s_setprio(0); } while (0)
#define PG8_WAIT_V(n) asm volatile("s_waitcnt vmcnt(" #n ")" ::: "memory")
#define PG8_WAIT_L(n) asm volatile("s_waitcnt lgkmcnt(" #n ")" ::: "memory")
#define PG8_BAR __builtin_amdgcn_s_barrier()
#define PG8_SCHED __builtin_amdgcn_sched_barrier(0)
    Unit cur, nxt; int ui = 0;
    if (!S.next(0, cur)) return;
    u32x4 gC = (u32x4){0u, 0u, 0u, 0u}, gN = gC;
    if constexpr (GATHER) gC = *(const u32x4*)(goffs + ((size_t)cur.oidx * 512 + tid) * 4);
#define PG8_GSTAGE(bufoff, gbase, o0, o1) do { \
        __builtin_amdgcn_global_load_lds((const unsigned*)((const char*)(gbase) + (o0)), (LAS unsigned*)(lds + (bufoff) + ldsw), 16, 0, 0); \
        __builtin_amdgcn_global_load_lds((const unsigned*)((const char*)(gbase) + (o1)), (LAS unsigned*)(lds + (bufoff) + ldsw + 8192), 16, 0, 0); } while (0)
    f32x4 acc[2][2][4][2];
#pragma unroll
    for (int a = 0; a < 2; ++a)
#pragma unroll
        for (int b = 0; b < 2; ++b)
#pragma unroll
            for (int m = 0; m < 4; ++m)
#pragma unroll
                for (int n = 0; n < 2; ++n) acc[a][b][m][n] = (f32x4){0.f, 0.f, 0.f, 0.f};
    int sclW = W8_SCALE_E8M0 * 0x01010101, sclX = 0x7f7f7f7f; if constexpr (FP8) asm volatile("" : "+v"(sclW), "+v"(sclX)); (void)sclW; (void)sclX;
    bf16x8 At[4][2], B0[2][2], B1[2][2]; i32x8 At8[4], B08[2], B18[2];
    const char* cA = cur.a; const char* cB = cur.b;
    if constexpr (SP2) {
        PG8_STAGE(PG8_SB(0, 0), cB, voffB); PG8_STAGE(PG8_SB(0, 1), cB + hstep, voffB);
        if constexpr (GATHER) { PG8_GSTAGE(PG8_SA(0, 0), S.A, gC.x, gC.y); PG8_GSTAGE(PG8_SA(0, 1), S.A, gC.z, gC.w); }
        else { PG8_STAGE(PG8_SA(0, 0), cA, voffA); PG8_STAGE(PG8_SA(0, 1), cA + hstep, voffA); }
        if (wr == 1) PG8_BAR;
        PG8_WAIT_V(2); PG8_BAR;
        PG8_STAGE(PG8_SB(1, 0), cB + kstep, voffB);
        if constexpr (GATHER) PG8_GSTAGE(PG8_SA(1, 0), S.A + kstep, gC.x, gC.y); else PG8_STAGE(PG8_SA(1, 0), cA + kstep, voffA);
        PG8_STAGE(PG8_SB(1, 1), cB + hstep + kstep, voffB);
        PG8_WAIT_V(6); PG8_BAR;
    } else {
        PG8_STAGE(PG8_SB(0, 0), cB, voffB); PG8_STAGE(PG8_SA(0, 0), cA, voffA); PG8_STAGE(PG8_SB(0, 1), cB + hstep, voffB); PG8_STAGE(PG8_SA(0, 1), cA + hstep, voffA);
        if (wr == 1) PG8_BAR;
        PG8_WAIT_V(4); PG8_BAR;
        PG8_STAGE(PG8_SB(1, 0), cB + kstep, voffB); PG8_STAGE(PG8_SA(1, 0), cA + kstep, voffA); PG8_STAGE(PG8_SB(1, 1), cB + hstep + kstep, voffB);
        PG8_WAIT_V(6); PG8_BAR;
    }
    for (;;) {
        const bool has_next = S.next(ui + 1, nxt);
        const char* nA = has_next ? nxt.a : cA; const char* nB = has_next ? nxt.b : cB;
        if constexpr (GATHER) { if (has_next)
            __builtin_amdgcn_global_load_lds((const unsigned*)(goffs + ((size_t)nxt.oidx * 512 + tid) * 4), (LAS unsigned*)(goffs_lds + ldsw), 16, 0, 0); }
        for (int seg = 0; seg < (KSCALE ? 3 : 1); ++seg) {
        const int tbeg = !KSCALE ? 0 : (seg == 0 ? 0 : seg == 1 ? 12 : 20), tend = !KSCALE ? nt : (seg == 0 ? 12 : seg == 1 ? 20 : nt);
        for (int t = tbeg; t < tend; t += 2) {
            const bool last = (t == nt - 2);
            const char* a1 = cA + (size_t)(t + 1) * kstep;
            const char* a2 = last ? nA : cA + (size_t)(t + 2) * kstep; const char* b2 = last ? nB : cB + (size_t)(t + 2) * kstep;
            const char* a3 = a2 + kstep; const char* b3 = b2 + kstep;
            const char* g1 = S.A + (size_t)(t + 1) * kstep; const char* g2 = S.A + (last ? (size_t)0 : (size_t)(t + 2) * kstep); const char* g3 = g2 + kstep;
            u32x4 gX = gC;
            if constexpr (GATHER) { if (last) { if (has_next) gN = *(const LAS u32x4*)(goffs_lds + (size_t)tid * 16); else gN = gC; gX = gN; } }
            if constexpr (SP2) {
            PG8_LDB(B0, 0, 0); PG8_LDB(B1, 0, 1); PG8_SCHED; PG8_LDA(At, 0, 0);
            if constexpr (GATHER) PG8_GSTAGE(PG8_SA(1, 1), g1, gC.z, gC.w); else PG8_STAGE(PG8_SA(1, 1), a1 + hstep, voffA);
            PG8_WAIT_V(8); PG8_WAIT_L(0); PG8_BAR; PG8_MMA(0, 0, At, B0); PG8_MMA(0, 1, At, B1); PG8_BAR; PG8_SCHED;
            PG8_LDA(At, 0, 1); PG8_STAGE(PG8_SB(0, 0), b2, voffB); PG8_STAGE(PG8_SB(0, 1), b2 + hstep, voffB);
            if constexpr (GATHER) PG8_GSTAGE(PG8_SA(0, 0), g2, gX.x, gX.y); else PG8_STAGE(PG8_SA(0, 0), a2, voffA);
            PG8_WAIT_V(8); PG8_WAIT_L(0); PG8_BAR; PG8_MMA(1, 0, At, B0); PG8_MMA(1, 1, At, B1); PG8_BAR; PG8_SCHED;
            PG8_LDB(B0, 1, 0); PG8_LDB(B1, 1, 1); PG8_SCHED; PG8_LDA(At, 1, 0);
            if constexpr (GATHER) PG8_GSTAGE(PG8_SA(0, 1), g2, gX.z, gX.w); else PG8_STAGE(PG8_SA(0, 1), a2 + hstep, voffA);
            PG8_WAIT_V(8); PG8_WAIT_L(0); PG8_BAR; PG8_MMA(0, 0, At, B0); PG8_MMA(0, 1, At, B1); PG8_BAR; PG8_SCHED;
            PG8_LDA(At, 1, 1); PG8_STAGE(PG8_SB(1, 0), b3, voffB); PG8_STAGE(PG8_SB(1, 1), b3 + hstep, voffB);
            if constexpr (GATHER) PG8_GSTAGE(PG8_SA(1, 0), g3, gX.x, gX.y); else PG8_STAGE(PG8_SA(1, 0), a3, voffA);
            PG8_WAIT_V(8); PG8_WAIT_L(0); PG8_BAR; PG8_MMA(1, 0, At, B0); PG8_MMA(1, 1, At, B1); PG8_BAR; PG8_SCHED;
            } else {
            PG8_LDB(B0, 0, 0); PG8_SCHED; PG8_LDA(At, 0, 0); PG8_STAGE(PG8_SA(1, 1), a1 + hstep, voffA);
            PG8_WAIT_L(8); PG8_BAR; PG8_WAIT_L(0); PG8_MMA(0, 0, At, B0); PG8_BAR; PG8_SCHED;
            PG8_LDB(B1, 0, 1); PG8_STAGE(PG8_SB(0, 0), b2, voffB);
            PG8_BAR; PG8_WAIT_L(0); PG8_MMA(0, 1, At, B1); PG8_BAR;
            PG8_LDA(At, 0, 1); PG8_STAGE(PG8_SA(0, 0), a2, voffA);
            PG8_BAR; PG8_WAIT_L(0); PG8_MMA(1, 0, At, B0); PG8_BAR; PG8_SCHED;
            PG8_STAGE(PG8_SB(0, 1), b2 + hstep, voffB);
            PG8_WAIT_V(6); PG8_BAR; PG8_MMA(1, 1, At, B1); PG8_BAR;
            PG8_LDB(B0, 1, 0); PG8_SCHED; PG8_LDA(At, 1, 0); PG8_STAGE(PG8_SA(0, 1), a2 + hstep, voffA);
            PG8_WAIT_L(8); PG8_BAR; PG8_WAIT_L(0); PG8_MMA(0, 0, At, B0); PG8_BAR; PG8_SCHED;
            PG8_LDB(B1, 1, 1); PG8_STAGE(PG8_SB(1, 0), b3, voffB);
            PG8_BAR; PG8_WAIT_L(0); PG8_MMA(0, 1, At, B1); PG8_BAR;
            PG8_LDA(At, 1, 1); PG8_STAGE(PG8_SA(1, 0), a3, voffA);
            PG8_BAR; PG8_WAIT_L(0); PG8_MMA(1, 0, At, B0); PG8_BAR; PG8_SCHED;
            PG8_STAGE(PG8_SB(1, 1), b3 + hstep, voffB);
            PG8_WAIT_V(6); PG8_BAR; PG8_MMA(1, 1, At, B1); PG8_BAR;
            }
        }
        if constexpr (KSCALE) { if (seg < 2) {
            unsigned ka = (unsigned)(uintptr_t)goffs_lds + (unsigned)((ui * 256 + wr * 64 + fr) * 16 + seg * 4); asm volatile("" : "+v"(ka));
#pragma unroll
            for (int ai = 0; ai < 2; ++ai)
#pragma unroll
                for (int m = 0; m < 4; ++m) { const float f = *(const LAS float*)(uintptr_t)(ka + (unsigned)((ai * HALF + m * 16) * 16));
#pragma unroll
                    for (int bj = 0; bj < 2; ++bj)
#pragma unroll
                        for (int n = 0; n < 2; ++n) acc[ai][bj][m][n] *= f;
                    asm volatile("" : "+v"(acc[ai][0][m][0]), "+v"(acc[ai][0][m][1]), "+v"(acc[ai][1][m][0]), "+v"(acc[ai][1][m][1])); } } }
        }
        cur.slot = ui;
        if constexpr (ALIGN_EPI) { if (wr == 0) PG8_BAR; }
        if constexpr (FP8) asm volatile("s_nop 15\n\ts_nop 15\n\ts_nop 7" ::: "memory");
        { const int tz = opaque_tid(), wz = __builtin_amdgcn_readfirstlane(tz >> 6), lz = tz & 63;
          E(acc, cur, wz >> 2, wz & 3, lz & 15, lz >> 4); }
        if (!has_next) break;
#pragma unroll
        for (int a = 0; a < 2; ++a)
#pragma unroll
            for (int b = 0; b < 2; ++b)
#pragma unroll
                for (int m = 0; m < 4; ++m)
#pragma unroll
                    for (int n = 0; n < 2; ++n) acc[a][b][m][n] = (f32x4){0.f, 0.f, 0.f, 0.f};
        cur = nxt; cA = nA; cB = nB; ++ui; gC = gN;
        if constexpr (ALIGN_EPI) { if (wr == 1) PG8_BAR; }
    }
    PG8_WAIT_V(0);
    if constexpr (!ALIGN_EPI) { if (wr == 0) PG8_BAR; }
    PG8_BAR;
#undef PG8_SA
#undef PG8_SB
#undef PG8_STAGE
#undef PG8_GSTAGE
#undef PG8_LDA
#undef PG8_LDB
#undef PG8_MMA
#undef PG8_RD8
#undef PG8_WAIT_V
#undef PG8_WAIT_L
#undef PG8_BAR
#undef PG8_SCHED
}
}

namespace at {
constexpr int D = 128, NW = 8, QBLK = 32, KVBLK = 64;
constexpr float SCALE = 0.088388347648318440f;
constexpr float THR = 8.f;
constexpr int LDQ = INW, LDK = INW, LDO = DM;
constexpr size_t SHM_V = KVBLK * D * 2, SHM_K = KVBLK * D * 2, SHM_ATTN = 2 * SHM_V + 2 * SHM_K + NW * 64 * 4;
#define KSWZ(row, colB) ((row) * 256 + ((colB) ^ (((row) & 7) << 4)))
#define SBAR() __builtin_amdgcn_sched_barrier(0)
__device__ __forceinline__ int crow(int r, int hi) { return (r & 3) + 8 * (r >> 2) + 4 * hi; }
__device__ __forceinline__ unsigned cvtpk(float lo, float hi) { unsigned r; asm volatile("v_cvt_pk_bf16_f32 %0, %1, %2" : "=v"(r) : "v"(lo), "v"(hi)); return r; }

__device__ __forceinline__ void partialSM(f32x16& p0, f32x16& p1, float& m_reg, float& mn, float& alpha, bool domask, int dq, int hi) {
  constexpr float C = SCALE * 1.4426950408889634f;
  {
    if (domask) {
#pragma unroll
      for (int r = 0; r < 16; ++r) { const int d0 = dq + crow(r, hi), d1 = d0 + 32;
        if (d0 > 128 || d0 < -128) p0[r] = -1e30f;
        if (d1 > 128 || d1 < -128) p1[r] = -1e30f; }
    }
  }
  float pmax = p0[0]; for (int r = 1; r < 16; ++r) pmax = fmaxf(pmax, p0[r]); for (int r = 0; r < 16; ++r) pmax = fmaxf(pmax, p1[r]);
  { auto rr = __builtin_amdgcn_permlane32_swap(__float_as_uint(pmax), __float_as_uint(pmax), false, false);
    pmax = fmaxf(__uint_as_float(rr[0]), __uint_as_float(rr[1])); }
  if (__builtin_expect(__all(pmax - m_reg <= THR / SCALE), 1)) { mn = m_reg; alpha = 1.f; }
  else { mn = fmaxf(m_reg, pmax); alpha = __builtin_amdgcn_exp2f((m_reg - mn) * C); m_reg = mn; }
  float mnC = -mn * C;
  for (int r = 0; r < 16; ++r) p0[r] = fmaf(p0[r], C, mnC); for (int r = 0; r < 16; ++r) p1[r] = fmaf(p1[r], C, mnC);
  for (int r = 0; r < 16; ++r) p0[r] = __builtin_amdgcn_exp2f(p0[r]);
}
__device__ __forceinline__ void finishSM(f32x16& p0, f32x16& p1, float alpha, float& l_reg, bf16x8& pa0, bf16x8& pa1, bf16x8& pa2, bf16x8& pa3) {
  for (int r = 0; r < 16; ++r) p1[r] = __builtin_amdgcn_exp2f(p1[r]);
  float ps = 0; for (int r = 0; r < 16; ++r) ps += p0[r]; for (int r = 0; r < 16; ++r) ps += p1[r];
  { auto rr = __builtin_amdgcn_permlane32_swap(__float_as_uint(ps), __float_as_uint(ps), false, false);
    ps = __uint_as_float(rr[0]) + __uint_as_float(rr[1]); }
  l_reg = l_reg * alpha + ps;
#define PK4(P, BASE, OUT) do { unsigned a0 = cvtpk(P[BASE + 0], P[BASE + 1]), a1 = cvtpk(P[BASE + 2], P[BASE + 3]);   \
    unsigned b0 = cvtpk(P[BASE + 4], P[BASE + 5]), b1 = cvtpk(P[BASE + 6], P[BASE + 7]);                              \
    auto r0 = __builtin_amdgcn_permlane32_swap(a0, b0, false, false); auto r1 = __builtin_amdgcn_permlane32_swap(a1, b1, false, false); \
    u32x4 w = {r0[0], r1[0], r0[1], r1[1]}; OUT = *reinterpret_cast<bf16x8*>(&w); } while (0)
  PK4(p0, 0, pa0); PK4(p0, 8, pa1); PK4(p1, 0, pa2); PK4(p1, 8, pa3);
#undef PK4
}
__device__ __forceinline__ void qkt(f32x16& p0, f32x16& p1, const char* Ks, const bf16x8* qr, int ka0) {
  p0 = f32x16{}; p1 = f32x16{};
  asm volatile("" : "+v"(ka0));
#pragma unroll
  for (int d0 = 0; d0 < 8; ++d0) { const int off = ka0 ^ (d0 * 32);
    bf16x8 b0 = *reinterpret_cast<const bf16x8*>(Ks + off);
    bf16x8 b1 = *reinterpret_cast<const bf16x8*>(Ks + off + 32 * 256);
    p0 = __builtin_amdgcn_mfma_f32_32x32x16_bf16(b0, qr[d0], p0, 0, 0, 0);
    p1 = __builtin_amdgcn_mfma_f32_32x32x16_bf16(b1, qr[d0], p1, 0, 0, 0); }
}
__device__ __forceinline__ int v_st(int k, int c) { const int kk = (k & ~0xC) | ((k & 4) << 1) | ((k & 8) >> 1); return ((kk >> 3) * 4 + (c >> 5)) * 512 + ((kk & 7) * 32 + (c & 31)) * 2; }
__device__ __forceinline__ int v_rd_base(int lane) { return ((lane & 3) << 3) | (((lane >> 2) & 3) << 6) | (((lane >> 4) & 1) << 5) | (((lane >> 5) & 1) << 8); }
constexpr int v_rd_off(int d0, int ks, int half) { return d0 * 512 + ks * 4096 + half * 2048; }
template <int OFF> __device__ __forceinline__ s16x4 tr_read(int vb) {
  s16x4 r; asm volatile("ds_read_b64_tr_b16 %0, %1 offset:%2" : "=&v"(r) : "v"(vb), "i"(OFF) : "memory"); return r;
}
template <int D0> __device__ __forceinline__ void pv_one(f32x16& od, int vb, bf16x8 pa0, bf16x8 pa1, bf16x8 pa2, bf16x8 pa3) {
  const s16x4 l0 = tr_read<v_rd_off(D0, 0, 0)>(vb), h0 = tr_read<v_rd_off(D0, 0, 1)>(vb), l1 = tr_read<v_rd_off(D0, 1, 0)>(vb), h1 = tr_read<v_rd_off(D0, 1, 1)>(vb);
  const s16x4 l2 = tr_read<v_rd_off(D0, 2, 0)>(vb), h2 = tr_read<v_rd_off(D0, 2, 1)>(vb), l3 = tr_read<v_rd_off(D0, 3, 0)>(vb), h3 = tr_read<v_rd_off(D0, 3, 1)>(vb);
  asm volatile("s_waitcnt lgkmcnt(0)" ::: "memory"); SBAR();
#define PK(L, H) (bf16x8){L[0], L[1], L[2], L[3], H[0], H[1], H[2], H[3]}
  od = __builtin_amdgcn_mfma_f32_32x32x16_bf16(pa0, PK(l0, h0), od, 0, 0, 0);
  od = __builtin_amdgcn_mfma_f32_32x32x16_bf16(pa1, PK(l1, h1), od, 0, 0, 0);
  od = __builtin_amdgcn_mfma_f32_32x32x16_bf16(pa2, PK(l2, h2), od, 0, 0, 0);
  od = __builtin_amdgcn_mfma_f32_32x32x16_bf16(pa3, PK(l3, h3), od, 0, 0, 0);
#undef PK
}
__device__ __forceinline__ void pv_d0(f32x16* o, int vb, bf16x8 pa0, bf16x8 pa1, bf16x8 pa2, bf16x8 pa3) {
  pv_one<0>(o[0], vb, pa0, pa1, pa2, pa3); pv_one<1>(o[1], vb, pa0, pa1, pa2, pa3); pv_one<2>(o[2], vb, pa0, pa1, pa2, pa3); pv_one<3>(o[3], vb, pa0, pa1, pa2, pa3);
}

__device__ __forceinline__ void attn_body(const bf16_t* __restrict__ Qb, const bf16_t* __restrict__ Kb, const bf16_t* __restrict__ Vb, bf16_t* __restrict__ Ob,
                                          int NT, int kskip, int qpos0, float m0, float l0, bool maskon, char* lds, float* ssq_out) {
  const int tid = opaque_tid(), wid = tid >> 6, lane = tid & 63, r32 = lane & 31, hi = lane >> 5;
  char* V_lds = lds; char* K_lds = lds + 2 * SHM_V;
  float* ws = (float*)(lds + 2 * SHM_V + 2 * SHM_K) + wid * 64; float* li_l = ws; float* al_l = ws + 32;
  float m_reg = m0, l_reg = l0; f32x16 o[4] = {}; bf16x8 qr[8];
  const bf16_t* Qw = Qb + (long)(wid * QBLK + r32) * LDQ + hi * 8;
#pragma unroll
  for (int d0 = 0; d0 < 8; ++d0) qr[d0] = *reinterpret_cast<const bf16x8*>(Qw + d0 * 16);
  const int sr = tid >> 4, sc = (tid & 15) * 8, vst0 = v_st(sr, sc), kst0 = KSWZ(sr, sc * 2);
  const int vb0 = (int)(uintptr_t)V_lds + v_rd_base(lane);
  const int qpos = qpos0 + wid * QBLK + r32;
  const int ka0 = r32 * 256 + ((hi * 16) ^ ((r32 & 7) << 4));
  const unsigned goff0 = (unsigned)(sr * LDK + sc) * 2u, goff1 = goff0 + 32u * LDK * 2u;
  struct { bf16x8 vs0, vs1, ks0, ks1; } sr_[1];
#define TROW(jt) ((long)(jt) * KVBLK + ((jt) >= 4 ? kskip : 0))
#define SLOAD(i, jt) do { const long _k0 = TROW(jt) * (LDK * 2); const char* _kp = (const char*)Kb + _k0; const char* _vp = (const char*)Vb + _k0; \
    sr_[i].vs0 = *reinterpret_cast<const bf16x8*>(_vp + goff0); sr_[i].vs1 = *reinterpret_cast<const bf16x8*>(_vp + goff1); \
    sr_[i].ks0 = *reinterpret_cast<const bf16x8*>(_kp + goff0); sr_[i].ks1 = *reinterpret_cast<const bf16x8*>(_kp + goff1); } while (0)
#define SWRITE(b, i) do { *(bf16x8*)(V_lds + (b) * SHM_V + vst0) = sr_[i].vs0;          \
    *(bf16x8*)(V_lds + (b) * SHM_V + vst0 + 8192) = sr_[i].vs1;                         \
    *(bf16x8*)(K_lds + (b) * SHM_K + kst0) = sr_[i].ks0;                               \
    *(bf16x8*)(K_lds + (b) * SHM_K + kst0 + 8192) = sr_[i].ks1; } while (0)
#define SWAIT() asm volatile("s_waitcnt vmcnt(0)" ::: "memory")
#define RESC(a) do { if (__any((a) < 1.f)) { if (hi == 0) al_l[r32] = (a); asm volatile("s_waitcnt lgkmcnt(0)" ::: "memory"); \
    for (int d = 0; d < 4; ++d) for (int r = 0; r < 16; ++r) o[d][r] *= al_l[crow(r, hi)]; } } while (0)
#define DQ(jt) (kskip + ((jt) - 4) * KVBLK - qpos)
  f32x16 pA0, pA1, pB0, pB1; float mnA, mnB, alA, alB; bf16x8 pa0, pa1, pa2, pa3;
  constexpr int SE = 0, SO = 0;
  SLOAD(SE, 0); asm volatile("s_waitcnt vmcnt(0)" ::: "memory"); SWRITE(0, SE); __syncthreads();
  qkt(pA0, pA1, K_lds, qr, ka0); partialSM(pA0, pA1, m_reg, mnA, alA, false, 0, hi);
  SLOAD(SO, 1);
  SWAIT(); SWRITE(1, SO); __syncthreads();
  for (int j = 1; j + 1 < NT; j += 2) {
    SBAR(); qkt(pB0, pB1, K_lds + SHM_K, qr, ka0);
    finishSM(pA0, pA1, alA, l_reg, pa0, pa1, pa2, pa3); SBAR();
    SLOAD(SO, j + 1); SBAR();
    pv_d0(o, vb0, pa0, pa1, pa2, pa3); partialSM(pB0, pB1, m_reg, mnB, alB, maskon && j >= 4, DQ(j), hi);
    __syncthreads(); SWAIT(); SWRITE(0, SE);
    RESC(alB); __syncthreads();
    SBAR(); qkt(pA0, pA1, K_lds, qr, ka0);
    finishSM(pB0, pB1, alB, l_reg, pa0, pa1, pa2, pa3); SBAR();
    SLOAD(SE, j + 2); SBAR();
    pv_d0(o, vb0 + (int)SHM_V, pa0, pa1, pa2, pa3); partialSM(pA0, pA1, m_reg, mnA, alA, maskon && j + 1 >= 4, DQ(j + 1), hi);
    __syncthreads(); SWAIT(); SWRITE(1, SO);
    RESC(alA); __syncthreads();
  }
  SBAR(); qkt(pB0, pB1, K_lds + SHM_K, qr, ka0);
  finishSM(pA0, pA1, alA, l_reg, pa0, pa1, pa2, pa3); SBAR();
  pv_d0(o, vb0, pa0, pa1, pa2, pa3); partialSM(pB0, pB1, m_reg, mnB, alB, maskon && NT - 1 >= 4, DQ(NT - 1), hi);
  __syncthreads(); RESC(alB);
  finishSM(pB0, pB1, alB, l_reg, pa0, pa1, pa2, pa3); SBAR();
  pv_d0(o, vb0 + (int)SHM_V, pa0, pa1, pa2, pa3);
  if (hi == 0) li_l[r32] = l_reg; asm volatile("s_waitcnt lgkmcnt(0)" ::: "memory");
  float rli[16];
#pragma unroll
  for (int r = 0; r < 16; ++r) rli[r] = __builtin_amdgcn_rcpf(li_l[crow(r, hi)]);
  bf16_t* Ow = Ob + (long)(wid * QBLK) * LDO;
#pragma unroll
  for (int r = 0; r < 16; ++r) { int orow = crow(r, hi); float sq = 0.f;
    for (int d0 = 0; d0 < 4; ++d0) { const float ov = o[d0][r] * rli[r]; sq += ov * ov; Ow[(long)orow * LDO + d0 * 32 + r32] = (bf16_t)f2bf(ov); }
    sq = row16_sum(sq); sq += __builtin_bit_cast(float, __builtin_amdgcn_ds_swizzle(__builtin_bit_cast(int, sq), 0x401F));
    if (r32 == 0) ssq_out[(size_t)(wid * QBLK + orow) * 16] = sq; }
#undef TROW
#undef SLOAD
#undef SWRITE
#undef SWAIT
#undef RESC
#undef DQ
}
}

struct Args { const float* in[23]; float* out; unsigned char* ws; int ph_lo, ph_hi; };
enum { IN_X = 0, IN_C, IN_CTX, IN_CCTX, IN_WMOD, IN_BMOD, IN_N1G, IN_N2G, IN_WIN, IN_QNA, IN_KNA, IN_SINK, IN_VNB, IN_WS, IN_BS, IN_QNC, IN_KNC, IN_OUTG, IN_WOUT, IN_WR, IN_WG, IN_WU, IN_WDN };

#define PHASE_IDS(F) const int tid = opaque_tid(), lane = tid & 63, wave = __builtin_amdgcn_readfirstlane(tid >> 6), gw = (int)blockIdx.x * 8 + wave, NGW = (F).G * 8; (void)lane; (void)wave; (void)gw; (void)NGW
constexpr int ARGTAB_OFF = LDSCTL_OFF + 1024;
#define INP(F, i) ld_inp((F).lds, (i))
__device__ __forceinline__ const float* ld_inp(LAS unsigned char* lds, int i) {
    unsigned a = (unsigned)(uintptr_t)(lds + ARGTAB_OFF) + 8u * (unsigned)i;
    asm volatile("" : "+v"(a));
    const volatile LAS unsigned* t = (const volatile LAS unsigned*)(uintptr_t)a;
    const unsigned lo = __builtin_amdgcn_readfirstlane(t[0]), hi = __builtin_amdgcn_readfirstlane(t[1]);
    return (const float*)(const GAS float*)(((unsigned long long)hi << 32) | lo);
}
struct Frame {
    LAS unsigned char* lds; char* ldsg;
    volatile LAS unsigned* MISC;
    unsigned* ctl;
    int G;
    float* out; unsigned char* ws;
};

__host__ __device__ __forceinline__ int headpos(int d) { return 32 * (2 * (d >> 6) + ((d >> 4) & 1)) + 8 * ((d >> 2) & 3) + 4 * ((d >> 5) & 1) + (d & 3); }
template <bool HEADPERM = false>
__device__ __forceinline__ void transpose_item(const float* W, int N, bf16_t* WT, int k0, int n0, int drow0, LAS float* scr, int lane) {
    { float t[32]; const float* wp = W + (size_t)(k0 + (lane >> 5)) * N + n0 + (lane & 31);
#pragma unroll
      for (int i = 0; i < 32; ++i) t[i] = wp[(size_t)(2 * i) * N];
#pragma unroll
      for (int i = 0; i < 32; ++i) scr[(2 * i + (lane >> 5)) * 33 + (lane & 31)] = t[i]; }
    LDS_WAIT(); asm volatile("" ::: "memory");
    const int c = lane & 7;
#pragma unroll
    for (int j = 0; j < 4; ++j) { const int n = (lane >> 3) + 8 * j; const LAS float* s = scr + (8 * c) * 33 + n;
        u32x4 o; o.x = pk2(s[0 * 33], s[1 * 33]); o.y = pk2(s[2 * 33], s[3 * 33]); o.z = pk2(s[4 * 33], s[5 * 33]); o.w = pk2(s[6 * 33], s[7 * 33]);
        const int drow = HEADPERM ? ((drow0 + n) & ~127) + headpos((drow0 + n) & 127) : drow0 + n;
        *(u32x4*)(WT + (size_t)drow * DM + k0 + 8 * c) = o; }
    LDS_WAIT(); asm volatile("" ::: "memory");
}

__device__ __forceinline__ void transpose_item8(const float* W, int N, unsigned char* WT, int k0, int n0, int drow0, LAS float* scr, int lane) {
    { float t[32]; const float* wp = W + (size_t)(k0 + (lane >> 5)) * N + n0 + (lane & 31);
#pragma unroll
      for (int i = 0; i < 32; ++i) t[i] = wp[(size_t)(2 * i) * N];
#pragma unroll
      for (int i = 0; i < 32; ++i) scr[(2 * i + (lane >> 5)) * 33 + (lane & 31)] = t[i]; }
    LDS_WAIT(); asm volatile("" ::: "memory");
    const int c = lane & 7;
#pragma unroll
    for (int j = 0; j < 4; ++j) { const int n = (lane >> 3) + 8 * j; const LAS float* s = scr + (8 * c) * 33 + n;
        u32x2 o; o.x = pk4_fp8(s[0 * 33] * W8_SCALE, s[1 * 33] * W8_SCALE, s[2 * 33] * W8_SCALE, s[3 * 33] * W8_SCALE); o.y = pk4_fp8(s[4 * 33] * W8_SCALE, s[5 * 33] * W8_SCALE, s[6 * 33] * W8_SCALE, s[7 * 33] * W8_SCALE);
        *(u32x2*)(WT + (size_t)(drow0 + n) * DM + k0 + 8 * c) = o; }
    LDS_WAIT(); asm volatile("" ::: "memory");
}
__device__ __forceinline__ void conv_tile(Frame& F, int tl, int tid, int lane, int wave) {
    const int mat = tl >> 7, kb = (tl & 127) >> 3, nb = tl & 7, le = mat / 3, wh = mat % 3;
    const float* src = INP(F, wh == 0 ? IN_WG : wh == 1 ? IN_WU : IN_WDN) + (size_t)le * DM * DM + (size_t)(128 * kb) * DM + 256 * nb;
    unsigned char* dst = (wh < 2) ? F.ws + WS_WGU + (size_t)(le / NE) * NE * 4096 * DM * 2 + (size_t)(le % NE) * 4096 * DM + (size_t)(2 * nb) * 256 * DM + 128 * kb
                                  : F.ws + WS_WD + (size_t)(le / NE) * NE * DM * DM * 2 + (size_t)(le % NE) * DM * DM + (size_t)(256 * nb) * DM + 128 * kb;
    f32x4 t[16];
    { const float* wp = src + (size_t)(16 * wave) * DM + 4 * lane;
#pragma unroll
      for (int q = 0; q < 16; ++q) t[q] = __builtin_nontemporal_load((const f32x4*)(wp + (size_t)q * DM)); }
    LAS unsigned* img = (LAS unsigned*)F.lds;
#pragma unroll
    for (int it = 0; it < 4; ++it)
#pragma unroll
        for (int j = 0; j < 4; ++j) { const int n = 4 * lane + j, d = 4 * wave + it;
            img[n * 32 + (d ^ (lane & 31))] = pk4_fp8(t[4 * it + 0][j] * W8_SCALE, t[4 * it + 1][j] * W8_SCALE, t[4 * it + 2][j] * W8_SCALE, t[4 * it + 3][j] * W8_SCALE); }
    __syncthreads();
#pragma unroll
    for (int q = 0; q < 4; ++q) { const int ch = tid + 512 * q, n = ch >> 3, g = ch & 7, sw = (n >> 2) & 31;
        u32x4 o; o.x = img[n * 32 + ((4 * g + 0) ^ sw)]; o.y = img[n * 32 + ((4 * g + 1) ^ sw)]; o.z = img[n * 32 + ((4 * g + 2) ^ sw)]; o.w = img[n * 32 + ((4 * g + 3) ^ sw)];
        const int drow = (wh < 2) ? (n >> 7) * 256 + wh * 128 + (n & 127) : n;
        *(u32x4*)(dst + (size_t)drow * DM + 16 * g) = o; }
    __syncthreads();
}
__device__ __forceinline__ void conv_help(Frame& F, int budget, unsigned* done, unsigned done_total) {
    if (!CONV_IDLE) return;
    PHASE_IDS(F);
    for (int n = 0; n < budget; ++n) {
        if (tid == 0) { unsigned t = 0xffffffffu;
            if (done == nullptr || xb_ld(done) < done_total) t = xb_add(F.ctl + CW_CONV, 1u);
            F.MISC[1] = t; }
        __syncthreads();
        const unsigned t = F.MISC[1];
        __syncthreads();
        if (t >= (unsigned)(NT8_ALL - NT8_L0)) break;
        conv_tile(F, NT8_L0 + (int)t, tid, lane, wave);
    }
}
__device__ __forceinline__ void phase_prologue(Frame& F) {
    PHASE_IDS(F);
    static_assert(FP8_L0 && FP8_L1, "the prologue writes the experts' weights as fp8");
    {
        constexpr int NT8 = CONV_IDLE ? NT8_L0 : NT8_ALL;
        struct T8 { const float* src; unsigned char* dst; int which; };
#define P8_DESC(d, tl) do { const int mat = (tl) >> 7, kb = ((tl) & 127) >> 3, nb = (tl) & 7, le = mat / 3, wh = mat % 3; d.which = wh; \
        d.src = INP(F, wh == 0 ? IN_WG : wh == 1 ? IN_WU : IN_WDN) + (size_t)le * DM * DM + (size_t)(128 * kb) * DM + 256 * nb; \
        d.dst = (wh < 2) ? F.ws + WS_WGU + (size_t)(le / NE) * NE * 4096 * DM * 2 + (size_t)(le % NE) * 4096 * DM + (size_t)(2 * nb) * 256 * DM + 128 * kb \
                         : F.ws + WS_WD + (size_t)(le / NE) * NE * DM * DM * 2 + (size_t)(le % NE) * DM * DM + (size_t)(256 * nb) * DM + 128 * kb; } while (0)
#define P8_LOAD(d, t) do { const float* wp = d.src + (size_t)(16 * wave) * DM + 4 * lane; _Pragma("unroll") for (int q = 0; q < 16; ++q) t[q] = __builtin_nontemporal_load((const f32x4*)(wp + (size_t)q * DM)); } while (0)
        T8 cur, nxt; f32x4 t0[16], t1[16];
        int tl = blockIdx.x, par = 0;
        if (tl < NT8) { P8_DESC(cur, tl); P8_LOAD(cur, t0); }
        for (; tl < NT8; tl += F.G, par ^= 1) {
            const bool has = tl + F.G < NT8;
            if (has) { P8_DESC(nxt, tl + F.G); P8_LOAD(nxt, t1); }
            LAS unsigned* img = (LAS unsigned*)(F.lds + par * 32768);
#pragma unroll
            for (int it = 0; it < 4; ++it)
#pragma unroll
                for (int j = 0; j < 4; ++j) { const int n = 4 * lane + j, d = 4 * wave + it;
                    img[n * 32 + (d ^ (lane & 31))] = pk4_fp8(t0[4 * it + 0][j] * W8_SCALE, t0[4 * it + 1][j] * W8_SCALE, t0[4 * it + 2][j] * W8_SCALE, t0[4 * it + 3][j] * W8_SCALE); }
            __syncthreads();
#pragma unroll
            for (int q = 0; q < 4; ++q) { const int ch = tid + 512 * q, n = ch >> 3, g = ch & 7, sw = (n >> 2) & 31;
                u32x4 o; o.x = img[n * 32 + ((4 * g + 0) ^ sw)]; o.y = img[n * 32 + ((4 * g + 1) ^ sw)]; o.z = img[n * 32 + ((4 * g + 2) ^ sw)]; o.w = img[n * 32 + ((4 * g + 3) ^ sw)];
                const int drow = (cur.which < 2) ? (n >> 7) * 256 + cur.which * 128 + (n & 127) : n;
                *(u32x4*)(cur.dst + (size_t)drow * DM + 16 * g) = o; }
            if (has) { cur = nxt;
#pragma unroll
                for (int q = 0; q < 16; ++q) t0[q] = t1[q]; }
        }
#undef P8_DESC
#undef P8_LOAD
        __syncthreads();
    }
    LAS float* scr = (LAS float*)(F.lds + wave * 16384);
    constexpr int I_IN = 32 * (INW / 32), I_SQ = 32 * (DM / 32);
    constexpr int NIT = 2 * I_IN + 2 * I_SQ;
    struct TItem { const float* src; unsigned char* dst; const float* og; int N, drow0, mode; };
#define P0_DESC(d, itv) do { int r = (itv); \
        if (r < 2 * I_IN) { const int l = r / I_IN; r %= I_IN; const int kb = r / (INW / 32), nb = r % (INW / 32); \
            d.src = INP(F, IN_WIN) + (size_t)l * DM * INW + (size_t)(64 * kb) * INW + 32 * nb; d.dst = F.ws + WS_WIN + (size_t)l * INW * DM * 2 + 128 * kb; d.N = INW; d.drow0 = 32 * nb; d.mode = 1; d.og = nullptr; } \
        else { r -= 2 * I_IN; const int l = r / I_SQ; r %= I_SQ; const int kb = r / 64, nb = r % 64; \
            d.src = INP(F, IN_WOUT) + (size_t)l * DM * DM + (size_t)(64 * kb) * DM + 32 * nb; d.dst = F.ws + WS_WOUT + (size_t)l * DM * DM * 2 + 128 * kb; d.N = DM; d.drow0 = 32 * nb; d.mode = 0; d.og = INP(F, IN_OUTG) + l * DM + 64 * kb; } } while (0)
#define P0_LOAD(d, t) do { const float* wp = d.src + (size_t)(lane >> 3) * d.N + (lane & 7) * 4; _Pragma("unroll") for (int i = 0; i < 8; ++i) t[i] = *(const f32x4*)(wp + (size_t)(8 * i) * d.N); } while (0)
    for (int it = gw; it < NIT; it += NGW) {
        TItem cur; f32x4 t0[8];
        P0_DESC(cur, it); P0_LOAD(cur, t0);
#pragma unroll
        for (int i = 0; i < 8; ++i) { LAS float* sp = scr + (8 * i + (lane >> 3)) * 33 + (lane & 7) * 4; sp[0] = t0[i].x; sp[1] = t0[i].y; sp[2] = t0[i].z; sp[3] = t0[i].w; }
        LDS_WAIT(); asm volatile("" ::: "memory");
        const int c = lane & 7;
#pragma unroll
        for (int j = 0; j < 4; ++j) { const int n = (lane >> 3) + 8 * j; const LAS float* sp = scr + (8 * c) * 33 + n;
            float v[8];
#pragma unroll
            for (int q = 0; q < 8; ++q) v[q] = sp[q * 33];
            if (cur.mode == 0) { const f32x4 g0 = *(const f32x4*)(cur.og + 8 * c), g1 = *(const f32x4*)(cur.og + 8 * c + 4);
                v[0] *= g0.x; v[1] *= g0.y; v[2] *= g0.z; v[3] *= g0.w; v[4] *= g1.x; v[5] *= g1.y; v[6] *= g1.z; v[7] *= g1.w; }
            int drow = cur.drow0 + n; if (cur.mode == 1) drow = (drow & ~127) + headpos(drow & 127);
            u32x4 o; o.x = pk2(v[0], v[1]); o.y = pk2(v[2], v[3]); o.z = pk2(v[4], v[5]); o.w = pk2(v[6], v[7]); *(u32x4*)(cur.dst + (size_t)drow * DM * 2 + 16 * c) = o; }
        LDS_WAIT(); asm volatile("" ::: "memory");
    }
#undef P0_DESC
#undef P0_LOAD
    __syncthreads();
    {
        LAS float* sil = (LAS float*)F.lds;
        LAS float* red = (LAS float*)(F.lds + 40960);
        bool have = false;
        for (int it = blockIdx.x; it < 2 * 96; it += F.G) {
            if (!have) {
                { const float* cp = INP(F, IN_C); const float* ccp = INP(F, IN_CCTX);
                for (int i = tid; i < 5 * DM; i += 512) { const int s = i / DM, k = i % DM; const float cv = (s < 4) ? cp[s * DM + k] : ccp[k]; sil[i] = cv / (1.f + __expf(-cv)); } }
                have = true; __syncthreads();
            }
            const int l = it / 96, cb = it % 96, c4 = tid & 31, kr = tid >> 5;
            const float* wp = INP(F, IN_WMOD) + (size_t)l * DM * NMOD + (size_t)cb * 128 + c4 * 4;
            f32x4 a[5];
#pragma unroll
            for (int s = 0; s < 5; ++s) a[s] = (f32x4){0.f, 0.f, 0.f, 0.f};
#pragma unroll 8
            for (int k = kr; k < DM; k += 16) { const f32x4 w = *(const f32x4*)(wp + (size_t)k * NMOD);
#pragma unroll
                for (int s = 0; s < 5; ++s) a[s] += w * sil[s * DM + k]; }
#pragma unroll
            for (int s = 0; s < 5; ++s) *(LAS f32x4*)(red + (kr * 5 + s) * 128 + c4 * 4) = a[s];
            __syncthreads();
            const float* bmod = INP(F, IN_BMOD);
            for (int i = tid; i < 5 * 128; i += 512) { const int s = i / 128, cc = i % 128; float sum = 0.f;
#pragma unroll
                for (int q = 0; q < 16; ++q) sum += red[(q * 5 + s) * 128 + cc];
                ((float*)(F.ws + WS_MOD))[(size_t)(l * 5 + s) * NMOD + cb * 128 + cc] = sum + bmod[l * NMOD + cb * 128 + cc]; }
            __syncthreads();
        }
    }
    if ((int)blockIdx.x >= F.G - 9 && (int)blockIdx.x < F.G - 1) {
        const float* wr = INP(F, IN_WR); bf16_t* wf = (bf16_t*)(F.ws + WS_WRS); const int part = (int)blockIdx.x - (F.G - 9);
        for (int i = part * 512 + tid; i < 2 * DM * NE; i += 8 * 512) { const int l = i / (DM * NE), rem = i % (DM * NE), k = rem >> 4, e = rem & 15;
            const float w = wr[i]; const unsigned hi = f2bf(w); const unsigned lo = f2bf(w - __builtin_bit_cast(float, hi << 16));
            const int sidx = k >> 5, q = (k >> 3) & 3, j = k & 7; bf16_t* dst = wf + ((size_t)(l * 64 + sidx) * 2 * 64 + (q * 16 + e)) * 8 + j;
            dst[0] = (bf16_t)hi; dst[64 * 8] = (bf16_t)lo; }
    }
    if (blockIdx.x == F.G - 1) {
        for (int i = tid; i < 64 * 32; i += 512) {
            const int pos = i >> 5, f = i & 31;
            double inv = 1.0; for (int q = 0; q < f; ++q) inv *= 0.7498942093324559;
            const double a = (double)pos * inv;
            const double n = __builtin_rint(a * 0.6366197723675814);
            const double r = (a - n * 1.5707963267948966) - n * 6.123233995736766e-17;
            const double r2 = r * r;
            double sn = r * (1.0 + r2 * (-1.0 / 6 + r2 * (1.0 / 120 + r2 * (-1.0 / 5040 + r2 * (1.0 / 362880 + r2 * (-1.0 / 39916800 + r2 * (1.0 / 6227020800.0)))))));
            double cn = 1.0 + r2 * (-0.5 + r2 * (1.0 / 24 + r2 * (-1.0 / 720 + r2 * (1.0 / 40320 + r2 * (-1.0 / 3628800 + r2 * (1.0 / 479001600 + r2 * (-1.0 / 87178291200.0)))))));
            const int q = ((int)n) & 3; double cs, ss;
            if (q == 0) { cs = cn; ss = sn; } else if (q == 1) { cs = -sn; ss = cn; } else if (q == 2) { cs = -cn; ss = -sn; } else { cs = sn; ss = -cn; }
            ((float*)(F.ws + WS_ROPE))[2 * i] = (float)cs; ((float*)(F.ws + WS_ROPE))[2 * i + 1] = (float)ss;
        }
    }
}

__device__ __forceinline__ void load_row(const float* row, int lane, f32x4 (&v)[8]) {
#pragma unroll
    for (int j = 0; j < 8; ++j) v[j] = *(const f32x4*)(row + 4 * lane + 256 * j);
}
__device__ __forceinline__ void norm_mod_store(const f32x4 (&v)[8], const float* g, const float* shift, const float* scale, bf16_t* dst, int lane) {
    float ss = 0.f;
#pragma unroll
    for (int j = 0; j < 8; ++j) ss += (v[j].x * v[j].x + v[j].y * v[j].y) + (v[j].z * v[j].z + v[j].w * v[j].w);
    const float rinv = rsqrt_fast(wave_sum(ss) * (1.f / DM) + EPS);
#pragma unroll
    for (int j = 0; j < 8; ++j) { const int c = 4 * lane + 256 * j;
        const f32x4 gg = *(const f32x4*)(g + c), sh = *(const f32x4*)(shift + c), sc = *(const f32x4*)(scale + c);
        const f32x4 y = (v[j] * rinv) * gg * (sc + 1.f) + sh;
        u32x2 w; w.x = pk2(y.x, y.y); w.y = pk2(y.z, y.w); *(u32x2*)(dst + c) = w; }
}

__device__ __forceinline__ void phase_rowpass1_l0(Frame& F) {
    PHASE_IDS(F);
    const float* mod = (const float*)(F.ws + WS_MOD);
    { const float* n2 = INP(F, IN_N2G); float* gs = (float*)(F.ws + WS_GS2);
      for (int i = (int)blockIdx.x * 512 + tid; i < 2 * 5 * DM; i += F.G * 512) { const int l = i / (5 * DM), sv = (i / DM) % 5, k = i % DM;
          const float* m = mod + (size_t)(l * 5 + sv) * NMOD; gs[2 * i] = n2[l * DM + k] * (1.f + m[4 * DM + k]); gs[2 * i + 1] = m[3 * DM + k]; } }
    const float* xin = INP(F, IN_X); const float* cin = INP(F, IN_CTX); const float* n1g = INP(F, IN_N1G);
#define P1_SRC(rr) ((((rr) % TPB) < CTXL) ? cin + ((size_t)((rr) / TPB) * CTXL + ((rr) % TPB)) * DM : xin + ((size_t)((rr) / TPB) * SEQ + (((rr) % TPB) - CTXL)) * DM)
    f32x4 v[8], vn[8];
    int r = gw;
    if (r < NTOK) load_row(P1_SRC(r), lane, v);
    while (r < NTOK) {
        const int rn = r + NGW;
        if (rn < NTOK) load_row(P1_SRC(rn), lane, vn);
        const int b = r / TPB, t = r % TPB, s = (t < CTXL) ? 4 : b;
        norm_mod_store(v, n1g, mod + (size_t)s * NMOD, mod + (size_t)s * NMOD + DM, (bf16_t*)(F.ws + WS_HN) + (size_t)r * DM, lane);
#pragma unroll
        for (int j = 0; j < 8; ++j) v[j] = vn[j];
        r = rn;
    }
#undef P1_SRC
}

__device__ __forceinline__ void post_unpack(const u32x4 x, float (&v)[8]) {
    v[0] = bflo(x.x); v[1] = bfhi(x.x); v[2] = bflo(x.y); v[3] = bfhi(x.y); v[4] = bflo(x.z); v[5] = bfhi(x.z); v[6] = bflo(x.w); v[7] = bfhi(x.w); }
__device__ __forceinline__ float sum16(float v) { return row16_sum(v); }
__device__ __forceinline__ void phase_post(Frame& F, int l) {
    PHASE_IDS(F);
    bf16_t* P = (bf16_t*)(F.ws + WS_P);
    const float* rope = (const float*)(F.ws + WS_ROPE);
    const int i16 = lane & 15, hq = lane >> 4; const bool hi2 = hq >= 2;
    const float* qna = INP(F, IN_QNA) + l * 128 + 8 * i16; const float* kna = INP(F, IN_KNA) + l * 128 + 8 * i16;
    const float* qnc = INP(F, IN_QNC) + l * 128 + 8 * i16; const float* knc = INP(F, IN_KNC) + l * 128 + 8 * i16;
    const float* vnb = INP(F, IN_VNB) + l * 512 + 8 * i16;
    for (int r = gw; r < NTOK; r += NGW) {
        const int t = r % TPB; const bool lat = t >= CTXL;
        u32x4* rp = (u32x4*)(P + (size_t)r * INW) + lane;
        u32x4 x[7];
#pragma unroll
        for (int j = 0; j < 7; ++j) x[j] = rp[64 * j];
        const int pos = lat ? t - CTXL : 0, pp = (i16 < 8) ? (pos >> 6) : (pos & 63);
        const f32x4* cs = (const f32x4*)(rope + 2 * (pp * 32 + 8 * (i16 & 3)));
        const f32x4 c0 = cs[0], c1 = cs[1], c2 = cs[2], c3 = cs[3];
        const float cosv[8] = {c0.x, c0.z, c1.x, c1.z, c2.x, c2.z, c3.x, c3.z}, sinv[8] = {c0.y, c0.w, c1.y, c1.w, c2.y, c2.w, c3.y, c3.w};
        const float sgn = (i16 & 4) ? 1.f : -1.f;
#pragma unroll
        for (int j = 0; j < 7; ++j) {
            const bool gelu_lo = (j == 3 || j == 4), gelu_hi = (j == 2 || j == 3);
            const bool norm_lo = (j != 2 && j != 3), norm_hi = (j != 2 && j != 6);
            const bool rope_lo = (j == 0 || j == 1 || j == 5 || j == 6), rope_hi = (j == 0 || j == 1 || j == 4 || j == 5);
            const bool dg = hi2 ? gelu_hi : gelu_lo, dn = hi2 ? norm_hi : norm_lo, dr = (hi2 ? rope_hi : rope_lo) && lat;
            if (!(gelu_lo || gelu_hi || norm_lo || norm_hi)) continue;
            float v[8]; post_unpack(x[j], v);
            if (gelu_lo || gelu_hi) {
#pragma unroll
                for (int e = 0; e < 8; ++e) { const float gv = gelu_tanh(v[e]); v[e] = dg ? gv : v[e]; } }
            if (norm_lo || norm_hi) {
                float ss = 0.f;
#pragma unroll
                for (int e = 0; e < 8; ++e) ss += v[e] * v[e];
                const float rinv = rsqrt_fast(sum16(ss) * (1.f / 128) + EPS);
                const float* gp;
                if (j == 0) gp = qna; else if (j == 1) gp = hi2 ? kna : qna; else if (j == 3) gp = vnb + (hi2 ? hq - 2 : 0) * 128; else if (j == 4) gp = hi2 ? qnc : vnb + (2 + hq) * 128;
                else if (j == 5) gp = qnc; else gp = knc;
                const f32x4 g0 = *(const f32x4*)gp, g1 = *(const f32x4*)(gp + 4);
                const float gg[8] = {g0.x, g0.y, g0.z, g0.w, g1.x, g1.y, g1.z, g1.w};
#pragma unroll
                for (int e = 0; e < 8; ++e) v[e] = dn ? v[e] * rinv * gg[e] : v[e];
            }
            if (rope_lo || rope_hi) {
#pragma unroll
                for (int e = 0; e < 8; ++e) { const float o = __builtin_bit_cast(float, __builtin_amdgcn_ds_swizzle(__builtin_bit_cast(int, v[e]), 0x101F)); const float rv = v[e] * cosv[e] + sgn * o * sinv[e]; v[e] = dr ? rv : v[e]; } }
            u32x4 w; w.x = pk2(v[0], v[1]); w.y = pk2(v[2], v[3]); w.z = pk2(v[4], v[5]); w.w = pk2(v[6], v[7]);
            rp[64 * j] = w;
        }
    }
}

__device__ __forceinline__ void mixer_b_unit(Frame& F, int l, int b, int ch, int g) {
    PHASE_IDS(F);
    const bf16_t* P = (const bf16_t*)(F.ws + WS_P); bf16_t* O = (bf16_t*)(F.ws + WS_O);
    const int row0 = b * TPB + ch * 128, w = wave;
    LAS bf16_t* VT = (LAS bf16_t*)F.lds;
    { const int q = tid >> 2, dp = (tid & 3) * 32; const bf16_t* src = P + (size_t)(row0 + q) * INW + C_VB + g * 128 + dp;
#pragma unroll
      for (int i = 0; i < 4; ++i) { const u32x4 x = *(const u32x4*)(src + 8 * i); const unsigned xs[4] = {x.x, x.y, x.z, x.w};
#pragma unroll
          for (int j = 0; j < 4; ++j) { VT[(dp + 8 * i + 2 * j) * 136 + q] = (bf16_t)(xs[j] & 0xffffu); VT[(dp + 8 * i + 2 * j + 1) * 136 + q] = (bf16_t)(xs[j] >> 16); } } }
    __syncthreads();
    const int i15 = lane & 15, kq = lane >> 4;
    f32x4 acc[8];
#pragma unroll
    for (int n = 0; n < 8; ++n) acc[n] = (f32x4){0.f, 0.f, 0.f, 0.f};
    const float* wsr = INP(F, IN_WS) + ((size_t)(l * 4 + g) * 128 + 16 * w + i15) * 128;
#pragma unroll
    for (int s = 0; s < 4; ++s) {
        const f32x4 a0 = *(const f32x4*)(wsr + 32 * s + 8 * kq), a1 = *(const f32x4*)(wsr + 32 * s + 8 * kq + 4);
        u32x4 aw; aw.x = pk2(a0.x, a0.y); aw.y = pk2(a0.z, a0.w); aw.z = pk2(a1.x, a1.y); aw.w = pk2(a1.z, a1.w);
        const bf16x8 af = *reinterpret_cast<bf16x8*>(&aw);
#pragma unroll
        for (int n = 0; n < 8; ++n) { const bf16x8 bfr = *(const LAS bf16x8*)(VT + (16 * n + i15) * 136 + 32 * s + 8 * kq);
            acc[n] = __builtin_amdgcn_mfma_f32_16x16x32_bf16(af, bfr, acc[n], 0, 0, 0); }
    }
#pragma unroll
    for (int j = 0; j < 4; ++j) { const int p = 16 * w + kq * 4 + j; const float bias = INP(F, IN_BS)[(l * 4 + g) * 128 + p];
        const bf16_t* up = P + (size_t)(row0 + p) * INW + C_UB + g * 128; bf16_t* op = O + (size_t)(row0 + p) * DM + O_B + g * 128;
        float sq = 0.f;
#pragma unroll
        for (int n = 0; n < 8; ++n) { const int d = 16 * n + i15; const float ov = bf2f(up[d]) * (acc[n][j] + bias); sq += ov * ov; op[d] = (bf16_t)f2bf(ov); }
        sq = row16_sum(sq);
        if (i15 == 0) ((float*)(F.ws + WS_SSQ))[(size_t)(row0 + p) * 16 + 6 + g] = sq; }
    __syncthreads();
}
__device__ __forceinline__ void phase_mixers(Frame& F, int l) {
    PHASE_IDS(F);
    const bf16_t* P = (const bf16_t*)(F.ws + WS_P); bf16_t* O = (bf16_t*)(F.ws + WS_O);
    const bool ctx = (l == 0);
    const int nC = 48, nA = 48, nCc = ctx ? 3 : 0, nAc = ctx ? 3 : 0, nB = 68;
    const int total = nC + nA + nCc + nAc + nB;
    for (int kq = 0; kq < 8; ++kq) {
        const int x = ((int)blockIdx.x + kq) & 7, b = x >> 1, kv = x & 1;
        unsigned* qctr = F.ctl + CW_QUEUE + 64 * (l * 8 + x);
        for (;;) {
            if (tid == 0) F.MISC[0] = xb_add(qctr, 1u);
            __syncthreads();
            int u = (int)F.MISC[0];
            __syncthreads();
            if (u >= total) break;
            if (u < nC + nA + nCc + nAc) {
                int kind, h, qb = 0;
                if (u < nC) { kind = 0; h = kv * 3 + u / 16; qb = u % 16; }
                else if (u < nC + nA) { const int v = u - nC; kind = 1; h = kv * 3 + v / 16; qb = v % 16; }
                else if (u < nC + nA + nCc) { kind = 2; h = kv * 3 + (u - nC - nA); }
                else { kind = 3; h = kv * 3 + (u - nC - nA - nCc); }
                const int isA = kind & 1, lat = (kind < 2);
                const size_t r0 = (size_t)b * TPB, rq = r0 + (lat ? CTXL + qb * 256 : 0);
                const int q0 = qb * 256, ks = (kind == 1) ? ((q0 - 128 < 0) ? 0 : q0 - 128) : 0, ke = (q0 + 384 > SEQ) ? SEQ : q0 + 384;
                const int NT = (kind == 0) ? 68 : (kind == 1) ? 4 + (ke - ks) / 64 : 4;
                const float sink = INP(F, IN_SINK)[l * 6 + h];
                const int cq = (isA ? C_QA : C_QC) + h * 128, ck = (isA ? C_KA : C_KC) + kv * 128, cv = (isA ? C_VA : C_VC) + kv * 128, co = (isA ? O_A : O_C) + h * 128;
                at::attn_body(P + rq * INW + cq, P + r0 * INW + ck, P + r0 * INW + cv, O + rq * DM + co, NT, ks, q0, isA ? sink / at::SCALE : -1e30f, isA ? 1.f : 0.f, kind == 1, F.ldsg,
                              (float*)(F.ws + WS_SSQ) + rq * 16 + (isA ? h : 10 + h));
                continue; }
            u -= nC + nA + nCc + nAc;
            { const int ch = u >> 1, g = kv * 2 + (u & 1);
              if (!ctx && ch < 2) continue;
              mixer_b_unit(F, l, b, ch, g); }
        }
    }
    if (CONV_IDLE && (CONV_HOOKS & 1)) {
        __syncthreads();
        if (tid == 0) (void)xb_add(F.ctl + CW_MIXDONE + 64 * l, 1u);
        conv_help(F, 64, F.ctl + CW_MIXDONE + 64 * l, (unsigned)F.G);
    }
}

__device__ __forceinline__ void phase_groupnorm(Frame& F, int l) {
    PHASE_IDS(F);
    bf16_t* O = (bf16_t*)(F.ws + WS_O); const float* og = INP(F, IN_OUTG) + l * DM;
#define GN_SKIP(rr) (l == 1 && ((rr) % TPB) < CTXL)
#define GN_LOAD(rr, xx) do { const bf16_t* _row = O + (size_t)(rr) * DM; \
        _Pragma("unroll") for (int i = 0; i < 3; ++i) { xx[i] = *(const u32x2*)(_row + O_A + 12 * lane + 4 * i); xx[5 + i] = *(const u32x2*)(_row + O_C + 12 * lane + 4 * i); } \
        _Pragma("unroll") for (int i = 0; i < 2; ++i) xx[3 + i] = *(const u32x2*)(_row + O_B + 8 * lane + 4 * i); } while (0)
    int r = gw; while (r < NTOK && GN_SKIP(r)) r += NGW;
    u32x2 x[8], xn[8];
    if (r < NTOK) GN_LOAD(r, x);
    while (r < NTOK) {
        int rn = r + NGW; while (rn < NTOK && GN_SKIP(rn)) rn += NGW;
        if (rn < NTOK) GN_LOAD(rn, xn);
        bf16_t* row = O + (size_t)r * DM;
        float v[8][4]; float ss[3] = {0.f, 0.f, 0.f};
#pragma unroll
        for (int i = 0; i < 8; ++i) { v[i][0] = bflo(x[i].x); v[i][1] = bfhi(x[i].x); v[i][2] = bflo(x[i].y); v[i][3] = bfhi(x[i].y);
            const int grp = (i < 3) ? 0 : (i < 5) ? 1 : 2; ss[grp] += (v[i][0] * v[i][0] + v[i][1] * v[i][1]) + (v[i][2] * v[i][2] + v[i][3] * v[i][3]); }
        float rinv[3];
        rinv[0] = rsqrt_fast(wave_sum(ss[0]) * (1.f / 768) + EPS); rinv[1] = rsqrt_fast(wave_sum(ss[1]) * (1.f / 512) + EPS); rinv[2] = rsqrt_fast(wave_sum(ss[2]) * (1.f / 768) + EPS);
#pragma unroll
        for (int i = 0; i < 8; ++i) { const int grp = (i < 3) ? 0 : (i < 5) ? 1 : 2;
            const int c = (grp == 0) ? O_A + 12 * lane + 4 * i : (grp == 1) ? O_B + 8 * lane + 4 * (i - 3) : O_C + 12 * lane + 4 * (i - 5);
            const f32x4 gg = *(const f32x4*)(og + c); const float ri = rinv[grp];
            u32x2 w; w.x = pk2(v[i][0] * ri * gg.x, v[i][1] * ri * gg.y); w.y = pk2(v[i][2] * ri * gg.z, v[i][3] * ri * gg.w); *(u32x2*)(row + c) = w; }
#pragma unroll
        for (int i = 0; i < 8; ++i) x[i] = xn[i];
        r = rn;
    }
#undef GN_SKIP
#undef GN_LOAD
}

__device__ __forceinline__ float row16_max(float v) {
    v = fmaxf(v, __builtin_bit_cast(float, __builtin_amdgcn_update_dpp(0, __builtin_bit_cast(int, v), 0xB1, 0xF, 0xF, true)));
    v = fmaxf(v, __builtin_bit_cast(float, __builtin_amdgcn_update_dpp(0, __builtin_bit_cast(int, v), 0x4E, 0xF, 0xF, true)));
    v = fmaxf(v, __builtin_bit_cast(float, __builtin_amdgcn_update_dpp(0, __builtin_bit_cast(int, v), 0x141, 0xF, 0xF, true)));
    v = fmaxf(v, __builtin_bit_cast(float, __builtin_amdgcn_update_dpp(0, __builtin_bit_cast(int, v), 0x140, 0xF, 0xF, true)));
    return v;
}
__device__ __forceinline__ void phase_rowpass2(Frame& F, int l) {
    PHASE_IDS(F);
    const float* xb = (const float*)(F.ws + WS_XB); const float* parts = (const float*)(F.ws + WS_PART);
    const bool f8 = (l == 0) ? (FP8_L0 != 0) : (FP8_L1 != 0);
    { const u32x4* wf = (const u32x4*)((const bf16_t*)(F.ws + WS_WRS) + (size_t)l * 64 * 2 * 64 * 8) + tid; u32x4 t[16];
#pragma unroll
      for (int i = 0; i < 16; ++i) t[i] = wf[512 * i];
#pragma unroll
      for (int i = 0; i < 16; ++i) ((LAS u32x4*)F.lds)[tid + 512 * i] = t[i]; }
    LAS f32x4* red = (LAS f32x4*)(F.lds + LDSCTL_OFF + 2048);
    __syncthreads();
    const int i16 = lane & 15, q = lane >> 4;
#define RP2_SKIP(tl) (l == 1 && ((tl) * 16) % TPB < CTXL)
#define RP2_LOAD(tl, xx, pp0, pp1) do { const int _row = (tl) * 16 + i16; const float* _xr = xb + (size_t)_row * DM + 256 * wave + 8 * q; \
        _Pragma("unroll") for (int sidx = 0; sidx < 8; ++sidx) { xx[sidx][0] = *(const f32x4*)(_xr + 32 * sidx); xx[sidx][1] = *(const f32x4*)(_xr + 32 * sidx + 4); } \
        pp0 = *(const f32x4*)(parts + (size_t)_row * 32 + 8 * q); pp1 = *(const f32x4*)(parts + (size_t)_row * 32 + 8 * q + 4); } while (0)
    int tile = blockIdx.x; while (tile < NTOK / 16 && RP2_SKIP(tile)) tile += F.G;
    f32x4 x[8][2], xn[8][2], p0, p1, p0n, p1n;
    if (tile < NTOK / 16) RP2_LOAD(tile, x, p0, p1);
    while (tile < NTOK / 16) {
        int ntile = tile + F.G; while (ntile < NTOK / 16 && RP2_SKIP(ntile)) ntile += F.G;
        if (ntile < NTOK / 16) RP2_LOAD(ntile, xn, p0n, p1n);
        const int r0 = tile * 16, b = r0 / TPB, t0 = r0 % TPB, sv = (t0 < CTXL) ? 4 : b;
        const int row = r0 + i16;
        float ss = ((p0.x + p0.y) + (p0.z + p0.w)) + ((p1.x + p1.y) + (p1.z + p1.w));
        ss += __builtin_bit_cast(float, __builtin_amdgcn_ds_swizzle(__builtin_bit_cast(int, ss), 0x401F));
        { auto rr = __builtin_amdgcn_permlane32_swap(__float_as_uint(ss), __float_as_uint(ss), false, false); ss = __uint_as_float(rr[0]) + __uint_as_float(rr[1]); }
        const float rinv = rsqrt_fast(ss * (1.f / DM) + EPS);
        const float* gs = (const float*)(F.ws + WS_GS2) + ((size_t)(l * 5 + sv) * DM + 256 * wave + 8 * q) * 2;
        f32x4 acc = (f32x4){0.f, 0.f, 0.f, 0.f};
#pragma unroll
        for (int sidx = 0; sidx < 8; ++sidx) {
            const f32x4 g0 = *(const f32x4*)(gs + 64 * sidx), g1 = *(const f32x4*)(gs + 64 * sidx + 4), g2 = *(const f32x4*)(gs + 64 * sidx + 8), g3 = *(const f32x4*)(gs + 64 * sidx + 12);
            float h[8];
            h[0] = x[sidx][0].x * rinv * g0.x + g0.y; h[1] = x[sidx][0].y * rinv * g0.z + g0.w; h[2] = x[sidx][0].z * rinv * g1.x + g1.y; h[3] = x[sidx][0].w * rinv * g1.z + g1.w;
            h[4] = x[sidx][1].x * rinv * g2.x + g2.y; h[5] = x[sidx][1].y * rinv * g2.z + g2.w; h[6] = x[sidx][1].z * rinv * g3.x + g3.y; h[7] = x[sidx][1].w * rinv * g3.z + g3.w;
            const int col = 256 * wave + 32 * sidx + 8 * q;
            if (f8) { u32x2 w8; w8.x = pk4_fp8(h[0], h[1], h[2], h[3]); w8.y = pk4_fp8(h[4], h[5], h[6], h[7]); *(u32x2*)((unsigned char*)(F.ws + WS_HN8) + (size_t)row * DM + col) = w8; }
            else { u32x4 w16; w16.x = pk2(h[0], h[1]); w16.y = pk2(h[2], h[3]); w16.z = pk2(h[4], h[5]); w16.w = pk2(h[6], h[7]); *(u32x4*)((bf16_t*)(F.ws + WS_HN) + (size_t)row * DM + col) = w16; }
            unsigned hh[8], hl[8];
#pragma unroll
            for (int j = 0; j < 8; ++j) { hh[j] = f2bf(h[j]); hl[j] = f2bf(h[j] - __builtin_bit_cast(float, hh[j] << 16)); }
            u32x4 ah, al; ah.x = hh[0] | (hh[1] << 16); ah.y = hh[2] | (hh[3] << 16); ah.z = hh[4] | (hh[5] << 16); ah.w = hh[6] | (hh[7] << 16);
            al.x = hl[0] | (hl[1] << 16); al.y = hl[2] | (hl[3] << 16); al.z = hl[4] | (hl[5] << 16); al.w = hl[6] | (hl[7] << 16);
            const LAS unsigned char* bp = F.lds + (size_t)((wave * 8 + sidx) * 2) * 1024 + lane * 16;
            const bf16x8 bh = *(const LAS bf16x8*)bp, bl = *(const LAS bf16x8*)(bp + 1024);
            const bf16x8 fah = __builtin_bit_cast(bf16x8, ah), fal = __builtin_bit_cast(bf16x8, al);
            acc = __builtin_amdgcn_mfma_f32_16x16x32_bf16(fah, bh, acc, 0, 0, 0);
            acc = __builtin_amdgcn_mfma_f32_16x16x32_bf16(fah, bl, acc, 0, 0, 0);
            acc = __builtin_amdgcn_mfma_f32_16x16x32_bf16(fal, bh, acc, 0, 0, 0);
        }
        red[wave * 64 + lane] = acc;
        __syncthreads();
        if (wave == 0) {
            f32x4 lg = red[lane];
#pragma unroll
            for (int w = 1; w < 8; ++w) lg += red[w * 64 + lane];
#pragma unroll
            for (int reg = 0; reg < 4; ++reg) { const float mx = row16_max(lg[reg]); const float ex = __expf(lg[reg] - mx); const float a = ex / row16_sum(ex);
                const int t = t0 + 4 * q + reg;
                if (t < CTXL) ((float*)(F.ws + WS_AFFC))[((size_t)b * NE + i16) * CTXL + t] = a;
                else ((float*)(F.ws + WS_AFFL))[((size_t)b * NE + i16) * SEQ + (t - CTXL)] = a; }
        }
        __syncthreads();
#pragma unroll
        for (int sidx = 0; sidx < 8; ++sidx) { x[sidx][0] = xn[sidx][0]; x[sidx][1] = xn[sidx][1]; }
        p0 = p0n; p1 = p1n; tile = ntile;
    }
#undef RP2_SKIP
#undef RP2_LOAD
    __syncthreads();
}

__device__ __forceinline__ unsigned block_excl_scan(unsigned v, LAS unsigned* scr, int lane, int wave, unsigned& total) {
    unsigned inc = v;
#pragma unroll
    for (int o = 1; o < 64; o <<= 1) { const unsigned t = __shfl_up(inc, o); if (lane >= o) inc += t; }
    if (lane == 63) scr[wave] = inc;
    __syncthreads();
    unsigned base = 0, tot = 0;
#pragma unroll
    for (int w = 0; w < 8; ++w) { const unsigned x = scr[w]; base += (w < wave) ? x : 0u; tot += x; }
    __syncthreads();
    total = tot;
    return base + inc - v;
}
__device__ __forceinline__ void phase_topk(Frame& F, int l) {
    PHASE_IDS(F);
    LAS unsigned* hist = (LAS unsigned*)F.lds;
    LAS unsigned* scr = (LAS unsigned*)(F.lds + 8192);
    LAS int* rowsrc = (LAS int*)(F.lds + 8192 + 128);
    const int nunits = (l == 0) ? 128 : 64;
    const bool f8 = (l == 0) ? (FP8_L0 != 0) : (FP8_L1 != 0); const int RBg = f8 ? DM : 2 * DM;
    for (int u = blockIdx.x; u < nunits; u += F.G) {
        const bool isc = u >= 64; const int uu = isc ? u - 64 : u, b = uu / NE, e = uu % NE;
        const int N = isc ? CTXL : SEQ; const unsigned cap = isc ? CAP_C : CAP_L;
        const float* src = isc ? (const float*)(F.ws + WS_AFFC) + (size_t)uu * CTXL : (const float*)(F.ws + WS_AFFL) + (size_t)uu * SEQ;
        int* pos = isc ? (int*)(F.ws + WS_POSC) + (size_t)uu * CTXL : (int*)(F.ws + WS_POSL) + (size_t)uu * SEQ;
        const bool own = tid * 8 < N;
        unsigned key[8];
        { u32x4 k0 = (u32x4){0u, 0u, 0u, 0u}, k1 = k0; if (own) { k0 = *(const u32x4*)(src + tid * 8); k1 = *(const u32x4*)(src + tid * 8 + 4); }
          key[0] = k0.x; key[1] = k0.y; key[2] = k0.z; key[3] = k0.w; key[4] = k1.x; key[5] = k1.y; key[6] = k1.z; key[7] = k1.w; }
        unsigned prefix = 0u, remaining = cap;
#pragma unroll
        for (int p = 0; p < 3; ++p) {
            const int shift = (p == 0) ? 21 : (p == 1) ? 10 : 0, bits = (p == 2) ? 10 : 11, nb = 1 << bits;
            for (int i = tid; i < nb; i += 512) hist[i] = 0u;
            __syncthreads();
            if (own) {
#pragma unroll
                for (int q = 0; q < 8; ++q) { const bool cand = (p == 0) ? true : ((key[q] >> (shift + bits)) == prefix);
                    if (cand) (void)__hip_atomic_fetch_add(&hist[(key[q] >> shift) & (nb - 1)], 1u, __ATOMIC_RELAXED, __HIP_MEMORY_SCOPE_WORKGROUP); } }
            __syncthreads();
            unsigned c[4];
#pragma unroll
            for (int q = 0; q < 4; ++q) c[q] = (4 * tid + q < nb) ? hist[4 * tid + q] : 0u;
            const unsigned sm = (c[0] + c[1]) + (c[2] + c[3]);
            unsigned total; const unsigned ex = block_excl_scan(sm, scr, lane, wave, total);
            unsigned above = total - (ex + sm);
#pragma unroll
            for (int q = 3; q >= 0; --q) { if (above < remaining && remaining <= above + c[q]) { scr[16] = (unsigned)(4 * tid + q); scr[17] = above; } above += c[q]; }
            __syncthreads();
            const unsigned B = scr[16], ca = scr[17];
            remaining -= ca; prefix = (prefix << bits) | B;
            __syncthreads();
        }
        const unsigned T = prefix;
        unsigned ce = 0u;
#pragma unroll
        for (int q = 0; q < 8; ++q) ce += (own && key[q] == T) ? 1u : 0u;
        unsigned tot; unsigned er = block_excl_scan(ce, scr, lane, wave, tot);
        bool sel[8]; unsigned cs = 0u;
#pragma unroll
        for (int q = 0; q < 8; ++q) { const bool eq = own && key[q] == T; sel[q] = own && (key[q] > T || (eq && er < remaining)); er += eq ? 1u : 0u; cs += sel[q] ? 1u : 0u; }
        unsigned sl = block_excl_scan(cs, scr, lane, wave, tot);
        const int slotbase = e * ROWS_E + (isc ? 2048 + b * CAP_C : b * CAP_L);
        int pv[8];
#pragma unroll
        for (int q = 0; q < 8; ++q) { pv[q] = sel[q] ? (int)sl : -1;
            if (sel[q]) { rowsrc[sl] = b * TPB + (isc ? 0 : CTXL) + tid * 8 + q; ((float*)(F.ws + WS_GATE))[slotbase + sl] = __uint_as_float(key[q]); ++sl; } }
        if (own) { *(i32x4*)(pos + tid * 8) = (i32x4){pv[0], pv[1], pv[2], pv[3]}; *(i32x4*)(pos + tid * 8 + 4) = (i32x4){pv[4], pv[5], pv[6], pv[7]}; }
        __syncthreads();
        unsigned* offs = (unsigned*)(F.ws + WS_OFFS);
        int R[2], C[2];
#pragma unroll
        for (int i = 0; i < 2; ++i) pg8::stage_rc(tid * 16 + i * 8192, R[i], C[i]);
        if (!isc) {
#pragma unroll
            for (int th = 0; th < 2; ++th) { u32x4 o;
                o.x = (unsigned)rowsrc[th * 256 + R[0]] * RBg + 2 * C[0]; o.y = (unsigned)rowsrc[th * 256 + R[1]] * RBg + 2 * C[1];
                o.z = (unsigned)rowsrc[th * 256 + 128 + R[0]] * RBg + 2 * C[0]; o.w = (unsigned)rowsrc[th * 256 + 128 + R[1]] * RBg + 2 * C[1];
                *(u32x4*)(offs + ((size_t)(e * 9 + 2 * b + th) * 512 + tid) * 4) = o; }
        } else {
            unsigned* o = offs + ((size_t)(e * 9 + 8) * 512 + tid) * 4;
#pragma unroll
            for (int i = 0; i < 2; ++i) { if (R[i] >= 32 * b && R[i] < 32 * b + 32) o[i] = (unsigned)rowsrc[R[i] - 32 * b] * RBg + 2 * C[i]; if (b == 0) o[2 + i] = 2 * C[i]; }
        }
        __syncthreads();
    }
}

__device__ __forceinline__ void phase_combine(Frame& F, int l) {
    PHASE_IDS(F);
    const float* mod = (const float*)(F.ws + WS_MOD);
    float* xb = (float*)(F.ws + WS_XB); const bf16_t* Y = (const bf16_t*)(F.ws + WS_XG);
    for (int r = gw; r < NTOK; r += NGW) {
        const int b = r / TPB, t = r % TPB, s = (t < CTXL) ? 4 : b;
        if (l == 1 && t < CTXL) continue;
        int p = -1;
        if (lane < NE) p = (t < CTXL) ? ((const int*)(F.ws + WS_POSC))[((size_t)b * NE + lane) * CTXL + t] : ((const int*)(F.ws + WS_POSL))[((size_t)b * NE + lane) * SEQ + (t - CTXL)];
        float gt = 0.f;
        if (p >= 0) gt = ((const float*)(F.ws + WS_GATE))[lane * ROWS_E + ((t < CTXL) ? 2048 + b * CAP_C : b * CAP_L) + p];
        f32x4 v[8]; load_row(xb + (size_t)r * DM, lane, v);
        const float* g2 = mod + (size_t)(l * 5 + s) * NMOD + 5 * DM;
        f32x4 gv[8];
#pragma unroll
        for (int j = 0; j < 8; ++j) gv[j] = *(const f32x4*)(g2 + 4 * lane + 256 * j);
        f32x4 a[8];
#pragma unroll
        for (int j = 0; j < 8; ++j) a[j] = (f32x4){0.f, 0.f, 0.f, 0.f};
        unsigned long long m = __ballot(p >= 0);
        const int ybase = (t < CTXL) ? 2048 + b * CAP_C : b * CAP_L;
        while (m) {
            const int e0 = __builtin_ctzll(m); m &= m - 1;
            const bool two = (m != 0ull); const int e1 = two ? __builtin_ctzll(m) : e0; if (two) m &= m - 1;
            const int p0 = __builtin_amdgcn_readlane(p, e0), p1 = __builtin_amdgcn_readlane(p, e1);
            const float q0 = __builtin_bit_cast(float, __builtin_amdgcn_readlane(__builtin_bit_cast(int, gt), e0)), q1 = __builtin_bit_cast(float, __builtin_amdgcn_readlane(__builtin_bit_cast(int, gt), e1));
            const bf16_t* y0 = Y + (size_t)(e0 * ROWS_E + ybase + p0) * DM + 4 * lane; const bf16_t* y1 = Y + (size_t)(e1 * ROWS_E + ybase + p1) * DM + 4 * lane;
            u32x2 w0[8], w1[8];
#pragma unroll
            for (int j = 0; j < 8; ++j) w0[j] = *(const u32x2*)(y0 + 256 * j);
            if (two) {
#pragma unroll
                for (int j = 0; j < 8; ++j) w1[j] = *(const u32x2*)(y1 + 256 * j); }
#pragma unroll
            for (int j = 0; j < 8; ++j) a[j] += (f32x4){bflo(w0[j].x), bfhi(w0[j].x), bflo(w0[j].y), bfhi(w0[j].y)} * q0;
            if (two) {
#pragma unroll
                for (int j = 0; j < 8; ++j) a[j] += (f32x4){bflo(w1[j].x), bfhi(w1[j].x), bflo(w1[j].y), bfhi(w1[j].y)} * q1; }
        }
#pragma unroll
        for (int j = 0; j < 8; ++j) v[j] += gv[j] * a[j];
        if (l == 0) {
#pragma unroll
            for (int j = 0; j < 8; ++j) *(f32x4*)(xb + (size_t)r * DM + 4 * lane + 256 * j) = v[j];
            const float* m1 = mod + (size_t)(5 + s) * NMOD;
            norm_mod_store(v, INP(F, IN_N1G) + DM, m1, m1 + DM, (bf16_t*)(F.ws + WS_HN) + (size_t)r * DM, lane);
        } else {
            float* op = F.out + ((size_t)b * SEQ + (t - CTXL)) * DM;
#pragma unroll
            for (int j = 0; j < 8; ++j) *(f32x4*)(op + 4 * lane + 256 * j) = v[j];
        }
    }
}

__device__ __forceinline__ void phase_dump_x(Frame& F, bool from_input) {
    PHASE_IDS(F);
    const float* xb = (const float*)(F.ws + WS_XB);
    for (int r = gw; r < NTOK; r += NGW) {
        const int b = r / TPB, t = r % TPB; if (t < CTXL) continue;
        const float* src = from_input ? INP(F, IN_X) + ((size_t)b * SEQ + (t - CTXL)) * DM : xb + (size_t)r * DM;
        f32x4 v[8]; load_row(src, lane, v);
        float* op = F.out + ((size_t)b * SEQ + (t - CTXL)) * DM;
#pragma unroll
        for (int j = 0; j < 8; ++j) *(f32x4*)(op + 4 * lane + 256 * j) = v[j];
    }
}

constexpr int N_PHASES = 2 + 11 * NLAYER;
__global__ void __launch_bounds__(512, 2) fwd_kernel(Args args) {
    extern __shared__ __attribute__((aligned(16))) unsigned char lds[];
    Frame F;
    F.lds = (LAS unsigned char*)lds; F.ldsg = (char*)lds;
    F.MISC = (volatile LAS unsigned*)(F.lds + MISC_OFF);
    F.G = gridDim.x;
    F.out = args.out; F.ws = args.ws; F.ctl = (unsigned*)(args.ws + WS_CTL);
    for (int u = threadIdx.x; u < (LDS_BYTES - LDSCTL_OFF) / 4; u += 512) ((LAS unsigned*)(F.lds + LDSCTL_OFF))[u] = 0u;
    __syncthreads();
    if (threadIdx.x < 23) { const unsigned long long pv = (unsigned long long)args.in[threadIdx.x]; LAS unsigned* t = (LAS unsigned*)(F.lds + ARGTAB_OFF) + 2 * threadIdx.x; t[0] = (unsigned)pv; t[1] = (unsigned)(pv >> 32); }
    __syncthreads();
    XcdBarrier bar; bar.bar = F.ctl + CW_BAR; bar.x = 0; bar.st = nullptr;
    if (!MK_PER_PHASE) bar = xcd_barrier_post(F.ctl + CW_BAR, F.MISC + 8);
    const int lo = args.ph_lo, hi = args.ph_hi;
#define IN(k) (lo <= (k) && (k) < hi)
    unsigned long long probe_t0 = 0ull, probe_acc = 0ull;
#define PROBE_BEGIN(k) do { if (PROBE_MASK & (1u << (k))) probe_t0 = __builtin_amdgcn_s_memrealtime(); } while (0)
#define SEAM(k) do { if (IN(k) && IN((k) + 1)) xcd_barrier(bar); if (PROBE_MASK & (1u << (k))) probe_acc += __builtin_amdgcn_s_memrealtime() - probe_t0; } while (0)

    if (IN(0)) { PROBE_BEGIN(0); if (PH_ON(0)) phase_prologue(F); if (IN(1)) xcd_barrier_first(bar); if (PROBE_MASK & 1u) probe_acc += __builtin_amdgcn_s_memrealtime() - probe_t0; }
    if (IN(1)) { PROBE_BEGIN(1); if (PH_ON(1)) phase_rowpass1_l0(F); SEAM(1); }
    for (int l = 0; l < NLAYER; ++l) {
        const int pb = 2 + 11 * l;
        const bool ctx = (l == 0);
        if (IN(pb + 0)) { PROBE_BEGIN(pb + 0); if (PH_ON(2)) {
            pg8::SchedDense S; S.init(F.ws + WS_HN, F.ws + WS_WIN + (size_t)l * INW * DM * 2, NTOK / 256, INW / 256, F.G, (int)blockIdx.x, 0);
            pg8::EpiPost E{(bf16_t*)(F.ws + WS_P), (const float*)(F.ws + WS_ROPE), INP(F, IN_QNA) + l * 128, INP(F, IN_KNA) + l * 128, INP(F, IN_QNC) + l * 128, INP(F, IN_KNC) + l * 128, INP(F, IN_VNB) + l * 512, F.lds + LDSCTL_OFF + 2048};
            pg8::gemm_phase<pg8::EpiPost, pg8::SchedDense>(F.lds, S, E);
            if ((CONV_HOOKS & 2) && (int)blockIdx.x >= (NTOK / 256) * (INW / 256) - 3 * F.G) conv_help(F, 10, nullptr, 0u); }
            SEAM(pb + 0); }
        if (IN(pb + 2)) { PROBE_BEGIN(pb + 2); if (PH_ON(4)) phase_mixers(F, l); SEAM(pb + 2); }
        if (IN(pb + 4)) { PROBE_BEGIN(pb + 4); if (PH_ON(6)) {
            pg8::SchedDense S; S.init(F.ws + WS_O, F.ws + WS_WOUT + (size_t)l * DM * DM * 2, ctx ? NTOK / 256 : 64, DM / 256, F.G, (int)blockIdx.x, ctx ? 0 : 1);
            float* xb = (float*)(F.ws + WS_XB);
            pg8::EpiResid E;
            if (l == 0) { E.ctxbase = INP(F, IN_CTX); E.latbase = INP(F, IN_X); E.cbs = CTXL; E.lbs = SEQ; }
            else { E.ctxbase = xb; E.latbase = xb + (size_t)CTXL * DM; E.cbs = TPB; E.lbs = TPB; }
            E.xout = xb; E.modl = (const float*)(F.ws + WS_MOD) + (size_t)l * 5 * NMOD; E.parts = (float*)(F.ws + WS_PART); E.ktab = F.lds + LDSCTL_OFF + 2048;
            { const float* ssq = (const float*)(F.ws + WS_SSQ); LAS f32x4* kt = (LAS f32x4*)(F.lds + LDSCTL_OFF + 2048); const int tz = opaque_tid();
              for (int i = 0; i < 3; ++i) { pg8::Unit uu; if (!S.next(i, uu)) break;
                  if (tz < 256) { const f32x4* sp = (const f32x4*)(ssq + (size_t)(uu.rowbase + tz) * 16); const f32x4 s0 = sp[0], s1 = sp[1], s2 = sp[2], s3 = sp[3];
                      const float qa = ((s0.x + s0.y) + (s0.z + s0.w)) + (s1.x + s1.y), qb = (s1.z + s1.w) + (s2.x + s2.y), qc = ((s2.z + s2.w) + (s3.x + s3.y)) + (s3.z + s3.w);
                      const float ra = rsqrt_fast(qa * (1.f / 768) + EPS), rb = rsqrt_fast(qb * (1.f / 512) + EPS), rc = rsqrt_fast(qc * (1.f / 768) + EPS);
                      kt[i * 256 + tz] = (f32x4){ra / rb, rb / rc, rc, 0.f}; } }
              __syncthreads(); }
            pg8::gemm_phase<pg8::EpiResid, pg8::SchedDense, false, false, true>(F.lds, S, E, nullptr, F.lds + LDSCTL_OFF + 2048);
            if ((CONV_HOOKS & 4) && ctx && (int)blockIdx.x >= (NTOK / 256) * (DM / 256) - 2 * F.G) conv_help(F, 9, nullptr, 0u); }
            SEAM(pb + 4); }
        if (IN(pb + 5)) { PROBE_BEGIN(pb + 5); if (PH_ON(7)) phase_rowpass2(F, l); SEAM(pb + 5); }
        if (IN(pb + 6)) { PROBE_BEGIN(pb + 6); if (PH_ON(8)) { phase_topk(F, l);
            if (l == 0) { if ((CONV_HOOKS & 8) && (int)blockIdx.x >= 128) conv_help(F, 2, nullptr, 0u); } else conv_help(F, 1 << 20, nullptr, 0u); }
            SEAM(pb + 6); }
        if (IN(pb + 8)) { PROBE_BEGIN(pb + 8); if (PH_ON(10)) {
            if ((l == 0) ? (FP8_L0 != 0) : (FP8_L1 != 0)) {
                pg8::SchedGrouped<pg8::GK> S; S.init(F.ws + WS_HN8, F.ws + WS_WGU + (size_t)l * NE * 4096 * DM * 2, ctx ? 9 : 8, 16, F.G, (int)blockIdx.x);
                pg8::EpiSwiGLU8 E{(unsigned char*)(F.ws + WS_H)};
                pg8::gemm_phase<pg8::EpiSwiGLU8, pg8::SchedGrouped<pg8::GK>, true, true>(F.lds, S, E, (const unsigned*)(F.ws + WS_OFFS), F.lds + LDSCTL_OFF + 2048);
            } else {
                pg8::SchedGrouped<2 * pg8::GK> S; S.init(F.ws + WS_HN, F.ws + WS_WGU + (size_t)l * NE * 4096 * DM * 2, ctx ? 9 : 8, 16, F.G, (int)blockIdx.x);
                pg8::EpiSwiGLU E{(bf16_t*)(F.ws + WS_H)};
                pg8::gemm_phase<pg8::EpiSwiGLU, pg8::SchedGrouped<2 * pg8::GK>, false, true>(F.lds, S, E, (const unsigned*)(F.ws + WS_OFFS), F.lds + LDSCTL_OFF + 2048);
            } }
            SEAM(pb + 8); }
        if (IN(pb + 9)) { PROBE_BEGIN(pb + 9); if (PH_ON(11)) {
            pg8::EpiStoreBf16 E{(bf16_t*)(F.ws + WS_XG), DM};
            if ((l == 0) ? (FP8_L0 != 0) : (FP8_L1 != 0)) {
                pg8::SchedGrouped<pg8::GK> S; S.init(F.ws + WS_H, F.ws + WS_WD + (size_t)l * NE * DM * DM * 2, ctx ? 9 : 8, 8, F.G, (int)blockIdx.x);
                pg8::gemm_phase<pg8::EpiStoreBf16, pg8::SchedGrouped<pg8::GK>, true>(F.lds, S, E);
                if ((CONV_HOOKS & 16) && ctx && (((int)blockIdx.x >> 3) & 31) >= 16) conv_help(F, 3, nullptr, 0u);
            } else {
                pg8::SchedGrouped<2 * pg8::GK> S; S.init(F.ws + WS_H, F.ws + WS_WD + (size_t)l * NE * DM * DM * 2, ctx ? 9 : 8, 8, F.G, (int)blockIdx.x);
                pg8::gemm_phase<pg8::EpiStoreBf16, pg8::SchedGrouped<2 * pg8::GK>, false>(F.lds, S, E);
            } }
            SEAM(pb + 9); }
        if (IN(pb + 10)) { PROBE_BEGIN(pb + 10); if (PH_ON(12)) phase_combine(F, l); if (l + 1 < NLAYER) SEAM(pb + 10); else if (PROBE_MASK & (1u << (pb + 10))) probe_acc += __builtin_amdgcn_s_memrealtime() - probe_t0; }
    }
    if (PROBE_MASK) { const unsigned long long te = __builtin_amdgcn_s_memrealtime(); while (__builtin_amdgcn_s_memrealtime() - te < probe_acc) __builtin_amdgcn_s_sleep(8); }
#undef IN
#undef SEAM
}

extern "C" void kernel_launch(void* const* d_in, const int* in_sizes, int n_in, void* d_out, int out_size, void* d_ws, size_t ws_size, hipStream_t stream) {
    static int grid = 0;
    if (grid == 0) {
        if (n_in != 23 || out_size != NB * SEQ * DM || ws_size < WS_END) { fprintf(stderr, "kernel_launch: shape mismatch: n_in %d out %d ws %zu (need %zu)\n", n_in, out_size, ws_size, (size_t)WS_END); grid = -1; return; }
        int dev = 0, cus = 0, per_cu = 0;
        if (hipGetDevice(&dev) != hipSuccess || hipDeviceGetAttribute(&cus, hipDeviceAttributeMultiprocessorCount, dev) != hipSuccess) { grid = -1; return; }
        if (hipFuncSetAttribute((const void*)fwd_kernel, hipFuncAttributeMaxDynamicSharedMemorySize, LDS_BYTES) != hipSuccess) { fprintf(stderr, "kernel_launch: hipFuncSetAttribute failed\n"); grid = -1; return; }
        if (hipOccupancyMaxActiveBlocksPerMultiprocessor(&per_cu, (const void*)fwd_kernel, 512, LDS_BYTES) != hipSuccess || per_cu < 1) { fprintf(stderr, "kernel_launch: occupancy query says %d\n", per_cu); }
        (void)hipGetLastError();
        grid = cus;
    }
    if (grid < 0) return;
    if (hipMemsetAsync((char*)d_ws + WS_CTL, 0, CTL_ZERO_BYTES, stream) != hipSuccess) return;
    Args a{};
    for (int i = 0; i < 23; ++i) a.in[i] = (const float*)d_in[i];
    a.out = (float*)d_out; a.ws = (unsigned char*)d_ws;
#if MK_PER_PHASE
    for (int p = 0; p < N_PHASES; ++p) { a.ph_lo = p; a.ph_hi = p + 1; hipLaunchKernelGGL(fwd_kernel, dim3(grid), dim3(512), LDS_BYTES, stream, a); }
#else
    a.ph_lo = 0; a.ph_hi = N_PHASES;
    hipLaunchKernelGGL(fwd_kernel, dim3(grid), dim3(512), LDS_BYTES, stream, a);
#endif
    const hipError_t le = hipPeekAtLastError();
    if (le != hipSuccess) fprintf(stderr, "kernel_launch: launch failed: %s\n", hipGetErrorName(le));
}
```

```cpp
#include <hip/hip_runtime.h>
#include <cstdio>
#include <cstdint>

#define LAS __attribute__((address_space(3)))
#define GAS __attribute__((address_space(1)))
typedef unsigned short bf16_t;
typedef short bf16x8 __attribute__((ext_vector_type(8)));
typedef short s16x4 __attribute__((ext_vector_type(4)));
typedef float f32x2 __attribute__((ext_vector_type(2)));
typedef float f32x4 __attribute__((ext_vector_type(4)));
typedef float f32x16 __attribute__((ext_vector_type(16)));
typedef unsigned u32x2 __attribute__((ext_vector_type(2)));
typedef unsigned u32x4 __attribute__((ext_vector_type(4)));
typedef int i32x4 __attribute__((ext_vector_type(4)));
typedef int i32x8 __attribute__((ext_vector_type(8)));

#ifndef MK_PER_PHASE
#define MK_PER_PHASE 0
#endif
#ifndef PHASE_MASK
#define PHASE_MASK 0x1fff
#endif
#define PH_ON(k) (((PHASE_MASK) >> (k)) & 1)
#ifndef FP8_L0
#define FP8_L0 1
#endif
#ifndef FP8_L1
#define FP8_L1 1
#endif
#ifndef PROBE_MASK
#define PROBE_MASK 0u
#endif
#ifndef DBG_STOP
#define DBG_STOP 0
#endif

constexpr int DM = 2048, NB = 4, SEQ = 4096, CTXL = 256, TPB = SEQ + CTXL, NTOK = NB * TPB;
constexpr int INW = 3584, NE = 16, NLAYER = 2, NMOD = 6 * DM;
constexpr int C_QA = 0, C_KA = 768, C_VA = 1024, C_UB = 1280, C_VB = 1792, C_QC = 2304, C_KC = 3072, C_VC = 3328;
constexpr int O_A = 0, O_B = 768, O_C = 1280;
constexpr int CAP_L = 512, CAP_C = 32, ROWS_E = 2304;
constexpr float EPS = 1e-6f;

constexpr size_t MiB = 1u << 20;
constexpr size_t WS_CTL = 0, CTL_ZERO_BYTES = 65536;
constexpr size_t WS_MOD = 1 * MiB;
constexpr size_t WS_ROPE = 2 * MiB;
constexpr size_t WS_AFFL = 3 * MiB;
constexpr size_t WS_AFFC = 4 * MiB;
constexpr size_t WS_POSL = 5 * MiB;
constexpr size_t WS_POSC = 6 * MiB;
constexpr size_t WS_OFFS = 10 * MiB;
constexpr size_t WS_GATE = 8 * MiB;
constexpr size_t WS_WRT = 9 * MiB;
constexpr size_t WS_WRS = 11 * MiB;
constexpr size_t WS_GS2 = 12 * MiB;
constexpr size_t WS_PART = 13 * MiB + 0;
constexpr size_t WS_SSQ = 14 * MiB;
constexpr size_t WS_WIN = 16 * MiB;
constexpr size_t WS_WOUT = WS_WIN + (size_t)2 * INW * DM * 2;
constexpr size_t WS_WGU = WS_WOUT + (size_t)2 * DM * DM * 2;
constexpr size_t WS_WD = WS_WGU + (size_t)2 * NE * 4096 * DM * 2;
constexpr size_t WS_HN = WS_WD + (size_t)2 * NE * DM * DM * 2;
constexpr size_t WS_P = WS_HN + (size_t)NTOK * DM * 2;
constexpr size_t WS_O = WS_P + (size_t)NTOK * INW * 2;
constexpr size_t WS_XB = WS_O + (size_t)NTOK * DM * 2;
constexpr size_t WS_XG = WS_XB + (size_t)NTOK * DM * 4;
constexpr size_t WS_H = WS_XG + (size_t)NE * ROWS_E * DM * 2;
constexpr size_t WS_HN8 = WS_H + (size_t)NE * ROWS_E * DM * 2;
constexpr size_t WS_END = WS_HN8 + (size_t)NTOK * DM;
constexpr float W8_SCALE = 32.f; constexpr int W8_SCALE_E8M0 = 127 - 5;
constexpr int CW_BAR = 4096, CW_QUEUE = 8192;
constexpr int CW_CONV = 10240, CW_MIXDONE = 10304;
constexpr int NT8_ALL = 2 * NE * 3 * 128, NT8_L0 = NT8_ALL / 2;
#ifndef CONV_HOOKS
#define CONV_HOOKS 0x1f
#endif
#ifndef CONV_IDLE
#define CONV_IDLE 1
#endif

constexpr int RING_BYTES = 131072, LDSCTL_OFF = RING_BYTES, MISC_OFF = LDSCTL_OFF + 320, LDS_BYTES = 147456;

#define LDS_WAIT() asm volatile("s_waitcnt lgkmcnt(0)" ::: "memory")
#define VM_WAIT() asm volatile("s_waitcnt vmcnt(0)" ::: "memory")
__device__ __forceinline__ unsigned f2bf(float f) { unsigned u = __builtin_bit_cast(unsigned, f); return (u + 0x7fffu + ((u >> 16) & 1u)) >> 16; }
__device__ __forceinline__ unsigned pk2(float lo, float hi) { return f2bf(lo) | (f2bf(hi) << 16); }
__device__ __forceinline__ float bf2f(unsigned short b) { return __builtin_bit_cast(float, ((unsigned)b) << 16); }
__device__ __forceinline__ float bflo(unsigned w) { return __builtin_bit_cast(float, w << 16); }
__device__ __forceinline__ float bfhi(unsigned w) { return __builtin_bit_cast(float, w & 0xffff0000u); }
__device__ __forceinline__ unsigned pk4_fp8(float a, float b, float c, float d) {
    int r = __builtin_amdgcn_cvt_pk_fp8_f32(a, b, 0, false); r = __builtin_amdgcn_cvt_pk_fp8_f32(c, d, r, true); return (unsigned)r; }
__device__ __forceinline__ int opaque_tid() { int t = threadIdx.x; asm volatile("" : "+v"(t)); return t; }
__device__ __forceinline__ float row16_sum(float v) {
    v += __builtin_bit_cast(float, __builtin_amdgcn_update_dpp(0, __builtin_bit_cast(int, v), 0xB1, 0xF, 0xF, true));
    v += __builtin_bit_cast(float, __builtin_amdgcn_update_dpp(0, __builtin_bit_cast(int, v), 0x4E, 0xF, 0xF, true));
    v += __builtin_bit_cast(float, __builtin_amdgcn_update_dpp(0, __builtin_bit_cast(int, v), 0x141, 0xF, 0xF, true));
    v += __builtin_bit_cast(float, __builtin_amdgcn_update_dpp(0, __builtin_bit_cast(int, v), 0x140, 0xF, 0xF, true));
    return v;
}
__device__ __forceinline__ float wave_sum(float v) {
    v = row16_sum(v);
    const int iv = __builtin_bit_cast(int, v);
    const float a = __builtin_bit_cast(float, __builtin_amdgcn_readlane(iv, 0)), b = __builtin_bit_cast(float, __builtin_amdgcn_readlane(iv, 16));
    const float c = __builtin_bit_cast(float, __builtin_amdgcn_readlane(iv, 32)), d = __builtin_bit_cast(float, __builtin_amdgcn_readlane(iv, 48));
    return (a + b) + (c + d);
}
__device__ __forceinline__ float rsqrt_fast(float x) { return __builtin_amdgcn_rsqf(x); }
__device__ __forceinline__ float gelu_tanh(float x) {
    const float u = 0.7978845608028654f * (x + 0.044715f * x * x * x);
    const float e = __expf(2.f * u);
    const float th = 1.f - 2.f / (e + 1.f);
    return 0.5f * x * (1.f + th);
}

#define XB_TMO      128
#define XB_XCNT(j)  (256  + 64 * (j))
#define XB_XSUB(j)  (1280 + 64 * (j))
#define XB_XGEN(j)  (2304 + 64 * (j))
#define XB_TOP      3328
#define XB_TOPGEN   3392
#define XCD_BAR_WORDS 3456
#define XB_SPIN_CAP (1u << 18)
__device__ __forceinline__ unsigned xb_ld(unsigned* p)              { return __hip_atomic_load(p, __ATOMIC_RELAXED, __HIP_MEMORY_SCOPE_AGENT); }
__device__ __forceinline__ unsigned xb_add(unsigned* p, unsigned v) { return __hip_atomic_fetch_add(p, v, __ATOMIC_RELAXED, __HIP_MEMORY_SCOPE_AGENT); }
__device__ __forceinline__ unsigned xb_xcc_id() { return (unsigned)__builtin_amdgcn_s_getreg((3 << 11) | 20) & 0xFu; }
#define XB_SPIN(cond, bar) do { unsigned _sp = 0; while (cond) { __builtin_amdgcn_s_sleep(1); \
    if ((++_sp & 255u) == 0u) { if (xb_ld(&(bar)[XB_TMO])) break; if (_sp > XB_SPIN_CAP) { atomicAdd(&(bar)[XB_TMO], 1u); break; } } } } while (0)
struct XcdBarrier { unsigned* bar; unsigned x; volatile LAS unsigned* st; };
__device__ __forceinline__ XcdBarrier xcd_barrier_post(unsigned* bar, volatile LAS unsigned* st) {
    XcdBarrier b; b.bar = bar; b.x = xb_xcc_id(); b.st = st;
    if (threadIdx.x == 0) (void)xb_add(&bar[XB_XCNT(b.x)], 1u);
    return b;
}
__device__ __forceinline__ void xcd_barrier_complete(unsigned* bar, unsigned x, unsigned& nloc, unsigned& nx) {
    const unsigned G = gridDim.x * gridDim.y * gridDim.z;
    unsigned sum, cnt, mine, sp = 0u;
    for (;;) {
        sum = 0u; cnt = 0u; mine = 0u;
#pragma unroll
        for (unsigned j = 0; j < 16; ++j) { const unsigned c = xb_ld(&bar[XB_XCNT(j)]); sum += c; cnt += (c > 0u) ? 1u : 0u; mine = (j == x) ? c : mine; }
        if (sum == G) break;
        __builtin_amdgcn_s_sleep(1);
        if ((++sp & 255u) == 0u) { if (xb_ld(&bar[XB_TMO])) break; if (sp > XB_SPIN_CAP) { atomicAdd(&bar[XB_TMO], 1u); break; } }
    }
    nloc = mine > 0u ? mine : 1u; nx = cnt > 0u ? cnt : 1u;
}
template <bool FIRST>
__device__ __forceinline__ void xcd_barrier_t(const XcdBarrier& b) {
    asm volatile("s_waitcnt vmcnt(0)" ::: "memory");
    __syncthreads();
    if (threadIdx.x == 0) {
        unsigned* bar = b.bar;
        asm volatile("" : "+s"(bar));
        __builtin_amdgcn_s_waitcnt(0);
        unsigned nloc = b.st[0], nx = b.st[1];
        if constexpr (FIRST) { if (nloc == 0u) { xcd_barrier_complete(bar, b.x, nloc, nx); b.st[0] = nloc; b.st[1] = nx; } }
        const unsigned old = xb_add(&bar[XB_XSUB(b.x)], 1u);
        const unsigned gen = old / nloc;
        if (old + 1u == (gen + 1u) * nloc) {
            __builtin_amdgcn_fence(__ATOMIC_RELEASE, "agent");
            asm volatile("s_waitcnt vmcnt(0)" ::: "memory");
            const unsigned og = xb_add(&bar[XB_TOP], 1u);
            const unsigned tg = og / nx;
            if (og + 1u == (tg + 1u) * nx) xb_add(&bar[XB_TOPGEN], 1u);
            else XB_SPIN(xb_ld(&bar[XB_TOPGEN]) == tg, bar);
            __builtin_amdgcn_fence(__ATOMIC_ACQUIRE, "agent");
            xb_add(&bar[XB_XGEN(b.x)], 1u);
            asm volatile("s_waitcnt vmcnt(0)" ::: "memory");
        } else {
            XB_SPIN(xb_ld(&bar[XB_XGEN(b.x)]) == gen, bar);
            __builtin_amdgcn_fence(__ATOMIC_ACQUIRE, "agent");
            asm volatile("s_waitcnt vmcnt(0)" ::: "memory");
        }
    }
    __syncthreads();
}
__device__ __forceinline__ void xcd_barrier(const XcdBarrier& b) { xcd_barrier_t<false>(b); }
__device__ __forceinline__ void xcd_barrier_first(const XcdBarrier& b) { xcd_barrier_t<true>(b); }

namespace pg8 {
constexpr int BM = 256, BK = 64, HALF = 128, HTB = HALF * BK * 2, STAGE_BYTES = 8 * HTB, NXCD = 8, WGM = 8;
constexpr int GK = 2048;
__host__ __device__ __forceinline__ int lds_byte(int r, int c) { const int st = (r >> 4) * 2 + (c >> 5), rr = r & 15, cc = c & 31, ob = rr * 64 + cc * 2; return st * 1024 + (ob ^ (((ob >> 9) & 1) << 5)); }
__host__ __device__ __forceinline__ void stage_rc(int b, int& R, int& C) { const int st = b / 1024, sb = b % 1024, swz = sb ^ (((sb >> 9) & 1) << 5); R = (st >> 1) * 16 + swz / 64; C = (st & 1) * 32 + (swz % 64) / 2; }
__host__ __device__ __forceinline__ int perm32(int rho) { const int n = rho >> 4, i = rho & 15; return 8 * (i >> 2) + 4 * n + (i & 3); }

struct Unit { int pm, pn, e, rowbase, colbase, oidx, slot; const char* a; const char* b; };

struct SchedDense {
    static constexpr int RB = GK * 2;
    const char* A; const char* Bt; int nM, nN, nwg, G, c, skipctx;
    __device__ void init(const void* A_, const void* Bt_, int nM_, int nN_, int G_, int c_, int skipctx_) { A = (const char*)A_; Bt = (const char*)Bt_; nM = nM_; nN = nN_; nwg = nM * nN; G = G_; c = c_; skipctx = skipctx_; }
    __device__ bool next(int i, Unit& u) const {
        const long L = (long)i * G + c; if (L >= nwg) return false;
        int wgid = (int)L; { const int q = nwg / NXCD, r = nwg % NXCD, xcd = wgid % NXCD, off = wgid / NXCD; wgid = (xcd < r ? xcd * (q + 1) : r * (q + 1) + (xcd - r) * q) + off; }
        const int nig = WGM * nN, gid = wgid / nig, fm = gid * WGM, gsz = (nM - fm) < WGM ? (nM - fm) : WGM;
        int pm = fm + ((wgid % nig) % gsz); const int pn = (wgid % nig) / gsz;
        if (skipctx) pm = (pm >> 4) * 17 + 1 + (pm & 15);
        u.pm = pm; u.pn = pn; u.e = 0; u.rowbase = pm * BM; u.colbase = pn * BM; u.oidx = 0;
        u.a = A + (size_t)pm * (BM * GK * 2); u.b = Bt + (size_t)pn * (BM * GK * 2); return true;
    }
};
template <int RB_> struct SchedGrouped {
    static constexpr int RB = RB_;
    const char* A; const char* Bt; int nMe, nNe, nwg, G, c;
    __device__ void init(const void* A_, const void* Bt_, int nMe_, int nNe_, int G_, int c_) { A = (const char*)A_; Bt = (const char*)Bt_; nMe = nMe_; nNe = nNe_; nwg = NE * nMe * nNe; G = G_; c = c_; }
    __device__ bool next(int i, Unit& u) const {
        int e, pm, pn;
        if ((G & 255) == 0) {
            const int cpe = nNe >> 2, nchunk = NE * cpe, xcd = c & 7, slot = (c >> 3) & 31, sub = c >> 8;
            const int chunk = (i * (G >> 8) + sub) * 8 + xcd;
            if (chunk < nchunk) { e = chunk / cpe; pm = slot >> 2; pn = (chunk % cpe) * 4 + (slot & 3); }
            else { const int per = (NE * nNe) >> 3;
                if (nMe < 9 || chunk >= nchunk + 8 || slot >= per) return false; const int j = (chunk - nchunk) * per + slot; e = j / nNe; pn = j % nNe; pm = 8; }
        } else { const long L = (long)i * G + c; if (L >= nwg) return false; const int per = nMe * nNe, rem = (int)L % per; e = (int)L / per; pm = rem % nMe; pn = rem / nMe; }
        u.pm = pm; u.pn = pn; u.e = e; u.rowbase = e * ROWS_E + pm * BM; u.colbase = pn * BM; u.oidx = e * 9 + pm;
        u.a = A + (size_t)(e * ROWS_E + pm * BM) * RB; u.b = Bt + ((size_t)e * nNe + pn) * (BM * RB); return true;
    }
};

__device__ __forceinline__ unsigned cvt_pk_bf16(float lo, float hi) { unsigned r; asm volatile("v_cvt_pk_bf16_f32 %0, %1, %2" : "=v"(r) : "v"(lo), "v"(hi)); return r; }

struct EpiStoreBf16 {
    static constexpr bool PERM = true;
    bf16_t* O; int ldc;
    __device__ __forceinline__ void operator()(const f32x4 (&acc)[2][2][4][2], const Unit& u, int wr, int wc, int fr, int fq) const {
        const int row0 = u.rowbase + wr * 64 + fr, col0 = u.colbase + wc * 32 + 8 * fq;
#pragma unroll
        for (int ai = 0; ai < 2; ++ai)
#pragma unroll
            for (int m = 0; m < 4; ++m) { bf16_t* rowp = O + (size_t)(row0 + ai * HALF + m * 16) * ldc + col0;
#pragma unroll
                for (int bj = 0; bj < 2; ++bj) { const f32x4 v0 = acc[ai][bj][m][0], v1 = acc[ai][bj][m][1];
                    u32x4 w; w.x = cvt_pk_bf16(v0[0], v0[1]); w.y = cvt_pk_bf16(v0[2], v0[3]); w.z = cvt_pk_bf16(v1[0], v1[1]); w.w = cvt_pk_bf16(v1[2], v1[3]);
                    *(u32x4*)(rowp + bj * HALF) = w; } }
    }
};
struct EpiPost {
    static constexpr bool PERM = true;
    bf16_t* P; const float* rope; const float* qna; const float* kna; const float* qnc; const float* knc; const float* vnb; LAS unsigned char* tab;
    __device__ __forceinline__ void operator()(f32x4 (&acc)[2][2][4][2], const Unit& u, int wr, int wc, int fr, int fq) const {
        const int tb = u.pm % 17; const bool lat = tb != 0;
        const int d0 = 64 * (wc >> 1) + 16 * (wc & 1) + 4 * fq, rl0 = wr * 64 + fr;
        int typ[2]; const float* gain[2];
#pragma unroll
        for (int bj = 0; bj < 2; ++bj) { const int slot = 2 * u.pn + bj;
            typ[bj] = (slot < 8) ? 3 : (slot < 10) ? 0 : (slot < 14) ? 1 : (slot < 18) ? 2 : (slot < 26) ? 3 : 0;
            gain[bj] = (slot < 6) ? qna : (slot < 8) ? kna : (slot < 18) ? vnb + ((slot - 14) & 3) * 128 : (slot < 24) ? qnc : knc; }
        const bool anynorm = typ[0] >= 2 || typ[1] >= 2;
#pragma unroll
        for (int bj = 0; bj < 2; ++bj) if (typ[bj] == 1 || typ[bj] == 2) {
#pragma unroll
            for (int ai = 0; ai < 2; ++ai)
#pragma unroll
                for (int m = 0; m < 4; ++m)
#pragma unroll
                    for (int n = 0; n < 2; ++n)
#pragma unroll
                        for (int j = 0; j < 4; ++j) acc[ai][bj][m][n][j] = gelu_tanh(acc[ai][bj][m][n][j]); }
        if (anynorm) {
#pragma unroll
            for (int bj = 0; bj < 2; ++bj) if (typ[bj] >= 2) {
#pragma unroll
                for (int ai = 0; ai < 2; ++ai)
#pragma unroll
                    for (int m = 0; m < 4; ++m) { const f32x4 a = acc[ai][bj][m][0], b = acc[ai][bj][m][1];
                        float ss = ((a.x * a.x + a.y * a.y) + (a.z * a.z + a.w * a.w)) + ((b.x * b.x + b.y * b.y) + (b.z * b.z + b.w * b.w));
                        ss += __builtin_bit_cast(float, __builtin_amdgcn_ds_swizzle(__builtin_bit_cast(int, ss), 0x401F));
                        { auto rr = __builtin_amdgcn_permlane32_swap(__float_as_uint(ss), __float_as_uint(ss), false, false); ss = __uint_as_float(rr[0]) + __uint_as_float(rr[1]); }
                        if (fq == 0) *(LAS float*)(tab + (((rl0 + ai * HALF + m * 16) * 2 + bj) * 4 + wc) * 4) = ss; } }
            asm volatile("s_waitcnt lgkmcnt(0)" ::: "memory"); __builtin_amdgcn_s_barrier(); asm volatile("" ::: "memory");
        }
#pragma unroll
        for (int bj = 0; bj < 2; ++bj) {
            const int slot = 2 * u.pn + bj;
            f32x4 g0 = (f32x4){1.f, 1.f, 1.f, 1.f}, g1 = g0;
            if (typ[bj] >= 2) { g0 = *(const f32x4*)(gain[bj] + d0); g1 = *(const f32x4*)(gain[bj] + d0 + 32); }
#pragma unroll
            for (int ai = 0; ai < 2; ++ai)
#pragma unroll
                for (int m = 0; m < 4; ++m) { const int rl = rl0 + ai * HALF + m * 16;
                    f32x4 a = acc[ai][bj][m][0], b = acc[ai][bj][m][1];
                    if (typ[bj] >= 2) { const f32x4 t = *(const LAS f32x4*)(tab + ((rl * 2 + bj) * 4) * 4);
                        const float rinv = rsqrt_fast(((t.x + t.y) + (t.z + t.w)) * (1.f / 128) + EPS);
                        a = a * rinv * g0; b = b * rinv * g1; }
                    if (typ[bj] == 3 && lat) { const int pos = (tb - 1) * 256 + rl, pp = (wc >> 1) ? (pos & 63) : (pos >> 6);
                        const f32x4* cs = (const f32x4*)(rope + 2 * (pp * 32 + 16 * (wc & 1) + 4 * fq)); const f32x4 c0 = cs[0], c1 = cs[1];
                        const f32x4 cv = (f32x4){c0.x, c0.z, c1.x, c1.z}, sv = (f32x4){c0.y, c0.w, c1.y, c1.w};
                        const f32x4 ra = a * cv - b * sv, rb = b * cv + a * sv; a = ra; b = rb; }
                    bf16_t* rowp = P + (size_t)(u.rowbase + rl) * INW + slot * 128 + d0;
                    u32x2 w0, w1; w0.x = cvt_pk_bf16(a.x, a.y); w0.y = cvt_pk_bf16(a.z, a.w); w1.x = cvt_pk_bf16(b.x, b.y); w1.y = cvt_pk_bf16(b.z, b.w);
                    *(u32x2*)rowp = w0; *(u32x2*)(rowp + 32) = w1; }
        }
    }
};
struct EpiStoreFp8 {
    static constexpr bool PERM = true;
    unsigned char* O; int ldc;
    __device__ __forceinline__ void operator()(const f32x4 (&acc)[2][2][4][2], const Unit& u, int wr, int wc, int fr, int fq) const {
        const int row0 = u.rowbase + wr * 64 + fr, col0 = u.colbase + wc * 32 + 8 * fq;
#pragma unroll
        for (int ai = 0; ai < 2; ++ai)
#pragma unroll
            for (int m = 0; m < 4; ++m) { unsigned char* rowp = O + (size_t)(row0 + ai * HALF + m * 16) * ldc + col0;
#pragma unroll
                for (int bj = 0; bj < 2; ++bj) { const f32x4 v0 = acc[ai][bj][m][0], v1 = acc[ai][bj][m][1];
                    u32x2 w; w.x = pk4_fp8(v0[0], v0[1], v0[2], v0[3]); w.y = pk4_fp8(v1[0], v1[1], v1[2], v1[3]);
                    *(u32x2*)(rowp + bj * HALF) = w; } }
    }
};
struct EpiResid {
    static constexpr bool PERM = false;
    const float* ctxbase; const float* latbase; int cbs, lbs;
    float* xout; const float* modl;
    float* parts;
    LAS unsigned char* ktab;
    __device__ __forceinline__ void operator()(const f32x4 (&acc)[2][2][4][2], const Unit& u, int wr, int wc, int fr, int fq) const {
        const int b = u.pm / 17, tb = u.pm % 17;
        const float* src = (tb == 0) ? ctxbase + (size_t)b * cbs * DM : latbase + ((size_t)b * lbs + (size_t)(tb - 1) * 256) * DM;
        const float* g1 = modl + (size_t)((tb == 0) ? 4 : b) * NMOD + 2 * DM;
        const int rl0 = wr * 64 + fr, col0 = u.colbase + wc * 32 + 4 * fq;
#pragma unroll
        for (int ai = 0; ai < 2; ++ai)
#pragma unroll
        for (int mh = 0; mh < 2; ++mh) {
            f32x4 gv[2][2];
#pragma unroll
            for (int bj = 0; bj < 2; ++bj)
#pragma unroll
                for (int n = 0; n < 2; ++n) gv[bj][n] = *(const f32x4*)(g1 + col0 + bj * HALF + n * 16);
            f32x4 xv[2][2][2];
#pragma unroll
            for (int mm = 0; mm < 2; ++mm) { const float* sp = src + (size_t)(rl0 + ai * HALF + (2 * mh + mm) * 16) * DM + col0;
#pragma unroll
                for (int bj = 0; bj < 2; ++bj)
#pragma unroll
                    for (int n = 0; n < 2; ++n) xv[mm][bj][n] = *(const f32x4*)(sp + bj * HALF + n * 16); }
#pragma unroll
            for (int mm = 0; mm < 2; ++mm) { const int m = 2 * mh + mm, rl = rl0 + ai * HALF + m * 16; float* dp = xout + (size_t)(u.rowbase + rl) * DM + col0; float ss = 0.f;
                const float fz = *(const LAS float*)(ktab + ((size_t)u.slot * 256 + rl) * 16 + 8);
#pragma unroll
                for (int bj = 0; bj < 2; ++bj)
#pragma unroll
                    for (int n = 0; n < 2; ++n) { const f32x4 y = xv[mm][bj][n] + (gv[bj][n] * fz) * acc[ai][bj][m][n]; *(f32x4*)(dp + bj * HALF + n * 16) = y;
                        ss += (y.x * y.x + y.y * y.y) + (y.z * y.z + y.w * y.w); }
                ss += __builtin_bit_cast(float, __builtin_amdgcn_ds_swizzle(__builtin_bit_cast(int, ss), 0x401F));
                { auto rr = __builtin_amdgcn_permlane32_swap(__float_as_uint(ss), __float_as_uint(ss), false, false); ss = __uint_as_float(rr[0]) + __uint_as_float(rr[1]); }
                if (fq == 0) parts[(size_t)(u.rowbase + rl) * 32 + u.pn * 4 + wc] = ss; }
            asm volatile("" ::: "memory");
        }
    }
};
struct EpiSwiGLU {
    static constexpr bool PERM = true;
    bf16_t* Hout;
    __device__ __forceinline__ void operator()(const f32x4 (&acc)[2][2][4][2], const Unit& u, int wr, int wc, int fr, int fq) const {
        const int row0 = u.rowbase + wr * 64 + fr, col0 = u.pn * HALF + wc * 32 + 8 * fq;
#pragma unroll
        for (int ai = 0; ai < 2; ++ai)
#pragma unroll
            for (int m = 0; m < 4; ++m) { bf16_t* rowp = Hout + (size_t)(row0 + ai * HALF + m * 16) * DM + col0; float h[8];
#pragma unroll
                for (int n = 0; n < 2; ++n)
#pragma unroll
                    for (int j = 0; j < 4; ++j) { const float g = acc[ai][0][m][n][j], up = acc[ai][1][m][n][j]; h[n * 4 + j] = g * __builtin_amdgcn_rcpf(1.f + __expf(-g)) * up; }
                u32x4 w; w.x = cvt_pk_bf16(h[0], h[1]); w.y = cvt_pk_bf16(h[2], h[3]); w.z = cvt_pk_bf16(h[4], h[5]); w.w = cvt_pk_bf16(h[6], h[7]);
                *(u32x4*)rowp = w; }
    }
};
struct EpiSwiGLU8 {
    static constexpr bool PERM = true;
    unsigned char* Hout;
    __device__ __forceinline__ void operator()(const f32x4 (&acc)[2][2][4][2], const Unit& u, int wr, int wc, int fr, int fq) const {
        const int row0 = u.rowbase + wr * 64 + fr, col0 = u.pn * HALF + wc * 32 + 8 * fq;
#pragma unroll
        for (int ai = 0; ai < 2; ++ai)
#pragma unroll
            for (int m = 0; m < 4; ++m) { unsigned char* rowp = Hout + (size_t)(row0 + ai * HALF + m * 16) * DM + col0; float h[8];
#pragma unroll
                for (int n = 0; n < 2; ++n)
#pragma unroll
                    for (int j = 0; j < 4; ++j) { const float g = acc[ai][0][m][n][j], up = acc[ai][1][m][n][j]; h[n * 4 + j] = g * __builtin_amdgcn_rcpf(1.f + __expf(-g)) * up; }
                u32x2 w; w.x = pk4_fp8(h[0], h[1], h[2], h[3]); w.y = pk4_fp8(h[4], h[5], h[6], h[7]);
                *(u32x2*)rowp = w; }
    }
};
struct EpiDown {
    static constexpr bool PERM = true;
    bf16_t* Y; const float* gatev;
    __device__ __forceinline__ void operator()(const f32x4 (&acc)[2][2][4][2], const Unit& u, int wr, int wc, int fr, int fq) const {
        const int row0 = u.rowbase + wr * 64 + fr, col0 = u.colbase + wc * 32 + 8 * fq;
#pragma unroll
        for (int ai = 0; ai < 2; ++ai)
#pragma unroll
            for (int m = 0; m < 4; ++m) { const int row = row0 + ai * HALF + m * 16; const float gt = gatev[row]; bf16_t* rowp = Y + (size_t)row * DM + col0;
#pragma unroll
                for (int bj = 0; bj < 2; ++bj) { const f32x4 v0 = acc[ai][bj][m][0] * gt, v1 = acc[ai][bj][m][1] * gt;
                    u32x4 w; w.x = cvt_pk_bf16(v0[0], v0[1]); w.y = cvt_pk_bf16(v0[2], v0[3]); w.z = cvt_pk_bf16(v1[0], v1[1]); w.w = cvt_pk_bf16(v1[2], v1[3]);
                    *(u32x4*)(rowp + bj * HALF) = w; } }
    }
};

template <class Epi, class Sched, bool FP8 = false, bool GATHER = false, bool KSCALE = false, bool ALIGN_EPI = true, bool SP2 = true>
__device__ __forceinline__ void gemm_phase(LAS unsigned char* lds, const Sched& S, const Epi& E, const unsigned* goffs = nullptr, LAS unsigned char* goffs_lds = nullptr) {
    static_assert(!GATHER || SP2, "gather mode is written for the SP2 loop");
    static_assert(Sched::RB == (FP8 ? GK : GK * 2), "operand row bytes");
    const int tid = opaque_tid(), wid = __builtin_amdgcn_readfirstlane(tid >> 6), lane = tid & 63, wr = wid >> 2, wc = wid & 3, fr = lane & 15, fq = lane >> 4;
    constexpr int RB = Sched::RB, nt = RB / 128;
    unsigned voffA[2], voffB[2];
#pragma unroll
    for (int i = 0; i < 2; ++i) { int R, C; stage_rc(tid * 16 + i * 8192, R, C); const int Rb = Epi::PERM ? ((R & ~31) + perm32(R & 31)) : R;
        voffA[i] = (unsigned)(R * RB + C * 2); voffB[i] = (unsigned)(Rb * RB + C * 2); }
    const size_t kstep = (size_t)(BK * 2);
    const size_t hstep = (size_t)HALF * RB;
    const unsigned ldsw = (unsigned)wid * 1024u;
    const int aoff = lds_byte(wr * 64 + fr, fq * 8), boff = lds_byte(wc * 32 + fr, fq * 8);
#define PG8_SA(b, h) (((b) * 2 + (h)) * HTB)
#define PG8_SB(b, h) ((4 + (b) * 2 + (h)) * HTB)
#define PG8_STAGE(bufoff, gbase, voff) do { _Pragma("unroll") for (int _i = 0; _i < 2; ++_i) \
        __builtin_amdgcn_global_load_lds((const unsigned*)((const char*)(gbase) + (voff)[_i]), (LAS unsigned*)(lds + (bufoff) + ldsw + _i * 8192), 16, 0, 0); } while (0)
#define PG8_RD8(p) __builtin_shufflevector(*(const LAS i32x4*)(p), *(const LAS i32x4*)((p) + 1024), 0, 1, 2, 3, 4, 5, 6, 7)
#define PG8_LDA(dst, b, h) do { _Pragma("unroll") for (int m = 0; m < 4; ++m) { if constexpr (FP8) dst##8[m] = PG8_RD8(lds + PG8_SA(b, h) + aoff + m * 2048); \
        else { _Pragma("unroll") for (int k = 0; k < 2; ++k) dst[m][k] = *(const LAS bf16x8*)(lds + PG8_SA(b, h) + aoff + m * 2048 + k * 1024); } } } while (0)
#define PG8_LDB(dst, b, h) do { _Pragma("unroll") for (int n = 0; n < 2; ++n) { if constexpr (FP8) dst##8[n] = PG8_RD8(lds + PG8_SB(b, h) + boff + n * 2048); \
        else { _Pragma("unroll") for (int k = 0; k < 2; ++k) dst[n][k] = *(const LAS bf16x8*)(lds + PG8_SB(b, h) + boff + n * 2048 + k * 1024); } } } while (0)
#define PG8_MMA(ai, bj, At, Bt) do { __builtin_amdgcn_s_setprio(1); _Pragma("unroll") for (int m = 0; m < 4; ++m) _Pragma("unroll") for (int n = 0; n < 2; ++n) { \
        if constexpr (FP8) asm volatile("v_mfma_scale_f32_16x16x128_f8f6f4 %0, %1, %2, %0, %3, %4 op_sel_hi:[0,0,0]" : "+v"(acc[ai][bj][m][n]) : "v"(Bt##8[n]), "v"(At##8[m]), "v"(sclW), "v"(sclX)); \
        else { _Pragma("unroll") for (int k = 0; k < 2; ++k) acc[ai][bj][m][n] = __builtin_amdgcn_mfma_f32_16x16x32_bf16(Bt[n][k], At[m][k], acc[ai][bj][m][n], 0, 0, 0); } } \
        __builtin_amdgcn_s_setprio(0); } while (0)
#define PG8_WAIT_V(n) asm volatile("s_waitcnt vmcnt(" #n ")" ::: "memory")
#define PG8_WAIT_L(n) asm volatile("s_waitcnt lgkmcnt(" #n ")" ::: "memory")
#define PG8_BAR __builtin_amdgcn_s_barrier()
#define PG8_SCHED __builtin_amdgcn_sched_barrier(0)
    Unit cur, nxt; int ui = 0;
    if (!S.next(0, cur)) return;
    u32x4 gC = (u32x4){0u, 0u, 0u, 0u}, gN = gC;
    if constexpr (GATHER) gC = *(const u32x4*)(goffs + ((size_t)cur.oidx * 512 + tid) * 4);
#define PG8_GSTAGE(bufoff, gbase, o0, o1) do { \
        __builtin_amdgcn_global_load_lds((const unsigned*)((const char*)(gbase) + (o0)), (LAS unsigned*)(lds + (bufoff) + ldsw), 16, 0, 0); \
        __builtin_amdgcn_global_load_lds((const unsigned*)((const char*)(gbase) + (o1)), (LAS unsigned*)(lds + (bufoff) + ldsw + 8192), 16, 0, 0); } while (0)
    f32x4 acc[2][2][4][2];
#pragma unroll
    for (int a = 0; a < 2; ++a)
#pragma unroll
        for (int b = 0; b < 2; ++b)
#pragma unroll
            for (int m = 0; m < 4; ++m)
#pragma unroll
                for (int n = 0; n < 2; ++n) acc[a][b][m][n] = (f32x4){0.f, 0.f, 0.f, 0.f};
    int sclW = W8_SCALE_E8M0 * 0x01010101, sclX = 0x7f7f7f7f; if constexpr (FP8) asm volatile("" : "+v"(sclW), "+v"(sclX)); (void)sclW; (void)sclX;
    bf16x8 At[4][2], B0[2][2], B1[2][2]; i32x8 At8[4], B08[2], B18[2];
    const char* cA = cur.a; const char* cB = cur.b;
    if constexpr (SP2) {
        PG8_STAGE(PG8_SB(0, 0), cB, voffB); PG8_STAGE(PG8_SB(0, 1), cB + hstep, voffB);
        if constexpr (GATHER) { PG8_GSTAGE(PG8_SA(0, 0), S.A, gC.x, gC.y); PG8_GSTAGE(PG8_SA(0, 1), S.A, gC.z, gC.w); }
        else { PG8_STAGE(PG8_SA(0, 0), cA, voffA); PG8_STAGE(PG8_SA(0, 1), cA + hstep, voffA); }
        if (wr == 1) PG8_BAR;
        PG8_WAIT_V(2); PG8_BAR;
        PG8_STAGE(PG8_SB(1, 0), cB + kstep, voffB);
        if constexpr (GATHER) PG8_GSTAGE(PG8_SA(1, 0), S.A + kstep, gC.x, gC.y); else PG8_STAGE(PG8_SA(1, 0), cA + kstep, voffA);
        PG8_STAGE(PG8_SB(1, 1), cB + hstep + kstep, voffB);
        PG8_WAIT_V(6); PG8_BAR;
    } else {
        PG8_STAGE(PG8_SB(0, 0), cB, voffB); PG8_STAGE(PG8_SA(0, 0), cA, voffA); PG8_STAGE(PG8_SB(0, 1), cB + hstep, voffB); PG8_STAGE(PG8_SA(0, 1), cA + hstep, voffA);
        if (wr == 1) PG8_BAR;
        PG8_WAIT_V(4); PG8_BAR;
        PG8_STAGE(PG8_SB(1, 0), cB + kstep, voffB); PG8_STAGE(PG8_SA(1, 0), cA + kstep, voffA); PG8_STAGE(PG8_SB(1, 1), cB + hstep + kstep, voffB);
        PG8_WAIT_V(6); PG8_BAR;
    }
    for (;;) {
        const bool has_next = S.next(ui + 1, nxt);
        const char* nA = has_next ? nxt.a : cA; const char* nB = has_next ? nxt.b : cB;
        if constexpr (GATHER) { if (has_next)
            __builtin_amdgcn_global_load_lds((const unsigned*)(goffs + ((size_t)nxt.oidx * 512 + tid) * 4), (LAS unsigned*)(goffs_lds + ldsw), 16, 0, 0); }
        for (int seg = 0; seg < (KSCALE ? 3 : 1); ++seg) {
        const int tbeg = !KSCALE ? 0 : (seg == 0 ? 0 : seg == 1 ? 12 : 20), tend = !KSCALE ? nt : (seg == 0 ? 12 : seg == 1 ? 20 : nt);
        for (int t = tbeg; t < tend; t += 2) {
            const bool last = (t == nt - 2);
            const char* a1 = cA + (size_t)(t + 1) * kstep;
            const char* a2 = last ? nA : cA + (size_t)(t + 2) * kstep; const char* b2 = last ? nB : cB + (size_t)(t + 2) * kstep;
            const char* a3 = a2 + kstep; const char* b3 = b2 + kstep;
            const char* g1 = S.A + (size_t)(t + 1) * kstep; const char* g2 = S.A + (last ? (size_t)0 : (size_t)(t + 2) * kstep); const char* g3 = g2 + kstep;
            u32x4 gX = gC;
            if constexpr (GATHER) { if (last) { if (has_next) gN = *(const LAS u32x4*)(goffs_lds + (size_t)tid * 16); else gN = gC; gX = gN; } }
            if constexpr (SP2) {
            PG8_LDB(B0, 0, 0); PG8_LDB(B1, 0, 1); PG8_SCHED; PG8_LDA(At, 0, 0);
            if constexpr (GATHER) PG8_GSTAGE(PG8_SA(1, 1), g1, gC.z, gC.w); else PG8_STAGE(PG8_SA(1, 1), a1 + hstep, voffA);
            PG8_WAIT_V(8); PG8_WAIT_L(0); PG8_BAR; PG8_MMA(0, 0, At, B0); PG8_MMA(0, 1, At, B1); PG8_BAR; PG8_SCHED;
            PG8_LDA(At, 0, 1); PG8_STAGE(PG8_SB(0, 0), b2, voffB); PG8_STAGE(PG8_SB(0, 1), b2 + hstep, voffB);
            if constexpr (GATHER) PG8_GSTAGE(PG8_SA(0, 0), g2, gX.x, gX.y); else PG8_STAGE(PG8_SA(0, 0), a2, voffA);
            PG8_WAIT_V(8); PG8_WAIT_L(0); PG8_BAR; PG8_MMA(1, 0, At, B0); PG8_MMA(1, 1, At, B1); PG8_BAR; PG8_SCHED;
            PG8_LDB(B0, 1, 0); PG8_LDB(B1, 1, 1); PG8_SCHED; PG8_LDA(At, 1, 0);
            if constexpr (GATHER) PG8_GSTAGE(PG8_SA(0, 1), g2, gX.z, gX.w); else PG8_STAGE(PG8_SA(0, 1), a2 + hstep, voffA);
            PG8_WAIT_V(8); PG8_WAIT_L(0); PG8_BAR; PG8_MMA(0, 0, At, B0); PG8_MMA(0, 1, At, B1); PG8_BAR; PG8_SCHED;
            PG8_LDA(At, 1, 1); PG8_STAGE(PG8_SB(1, 0), b3, voffB); PG8_STAGE(PG8_SB(1, 1), b3 + hstep, voffB);
            if constexpr (GATHER) PG8_GSTAGE(PG8_SA(1, 0), g3, gX.x, gX.y); else PG8_STAGE(PG8_SA(1, 0), a3, voffA);
            PG8_WAIT_V(8); PG8_WAIT_L(0); PG8_BAR; PG8_MMA(1, 0, At, B0); PG8_MMA(1, 1, At, B1); PG8_BAR; PG8_SCHED;
            } else {
            PG8_LDB(B0, 0, 0); PG8_SCHED; PG8_LDA(At, 0, 0); PG8_STAGE(PG8_SA(1, 1), a1 + hstep, voffA);
            PG8_WAIT_L(8); PG8_BAR; PG8_WAIT_L(0); PG8_MMA(0, 0, At, B0); PG8_BAR; PG8_SCHED;
            PG8_LDB(B1, 0, 1); PG8_STAGE(PG8_SB(0, 0), b2, voffB);
            PG8_BAR; PG8_WAIT_L(0); PG8_MMA(0, 1, At, B1); PG8_BAR;
            PG8_LDA(At, 0, 1); PG8_STAGE(PG8_SA(0, 0), a2, voffA);
            PG8_BAR; PG8_WAIT_L(0); PG8_MMA(1, 0, At, B0); PG8_BAR; PG8_SCHED;
            PG8_STAGE(PG8_SB(0, 1), b2 + hstep, voffB);
            PG8_WAIT_V(6); PG8_BAR; PG8_MMA(1, 1, At, B1); PG8_BAR;
            PG8_LDB(B0, 1, 0); PG8_SCHED; PG8_LDA(At, 1, 0); PG8_STAGE(PG8_SA(0, 1), a2 + hstep, voffA);
            PG8_WAIT_L(8); PG8_BAR; PG8_WAIT_L(0); PG8_MMA(0, 0, At, B0); PG8_BAR; PG8_SCHED;
            PG8_LDB(B1, 1, 1); PG8_STAGE(PG8_SB(1, 0), b3, voffB);
            PG8_BAR; PG8_WAIT_L(0); PG8_MMA(0, 1, At, B1); PG8_BAR;
            PG8_LDA(At, 1, 1); PG8_STAGE(PG8_SA(1, 0), a3, voffA);
            PG8_BAR; PG8_WAIT_L(0); PG8_MMA(1, 0, At, B0); PG8_BAR; PG8_SCHED;
            PG8_STAGE(PG8_SB(1, 1), b3 + hstep, voffB);
            PG8_WAIT_V(6); PG8_BAR; PG8_MMA(1, 1, At, B1); PG8_BAR;
            }
        }
        if constexpr (KSCALE) { if (seg < 2) {
            unsigned ka = (unsigned)(uintptr_t)goffs_lds + (unsigned)((ui * 256 + wr * 64 + fr) * 16 + seg * 4); asm volatile("" : "+v"(ka));
#pragma unroll
            for (int ai = 0; ai < 2; ++ai)
#pragma unroll
                for (int m = 0; m < 4; ++m) { const float f = *(const LAS float*)(uintptr_t)(ka + (unsigned)((ai * HALF + m * 16) * 16));
#pragma unroll
                    for (int bj = 0; bj < 2; ++bj)
#pragma unroll
                        for (int n = 0; n < 2; ++n) acc[ai][bj][m][n] *= f;
                    asm volatile("" : "+v"(acc[ai][0][m][0]), "+v"(acc[ai][0][m][1]), "+v"(acc[ai][1][m][0]), "+v"(acc[ai][1][m][1])); } } }
        }
        cur.slot = ui;
        if constexpr (ALIGN_EPI) { if (wr == 0) PG8_BAR; }
        if constexpr (FP8) asm volatile("s_nop 15\n\ts_nop 15\n\ts_nop 7" ::: "memory");
        { const int tz = opaque_tid(), wz = __builtin_amdgcn_readfirstlane(tz >> 6), lz = tz & 63;
          E(acc, cur, wz >> 2, wz & 3, lz & 15, lz >> 4); }
        if (!has_next) break;
#pragma unroll
        for (int a = 0; a < 2; ++a)
#pragma unroll
            for (int b = 0; b < 2; ++b)
#pragma unroll
                for (int m = 0; m < 4; ++m)
#pragma unroll
                    for (int n = 0; n < 2; ++n) acc[a][b][m][n] = (f32x4){0.f, 0.f, 0.f, 0.f};
        cur = nxt; cA = nA; cB = nB; ++ui; gC = gN;
        if constexpr (ALIGN_EPI) { if (wr == 1) PG8_BAR; }
    }
    PG8_WAIT_V(0);
    if constexpr (!ALIGN_EPI) { if (wr == 0) PG8_BAR; }
    PG8_BAR;
#undef PG8_SA
#undef PG8_SB
#undef PG8_STAGE
#undef PG8_GSTAGE
#undef PG8_LDA
#undef PG8_LDB
#undef PG8_MMA
#undef PG8_RD8
#undef PG8_WAIT_V
#undef PG8_WAIT_L
#undef PG8_BAR
#undef PG8_SCHED
}
}

namespace at {
constexpr int D = 128, NW = 8, QBLK = 32, KVBLK = 64;
constexpr float SCALE = 0.088388347648318440f;
constexpr float THR = 8.f;
constexpr int LDQ = INW, LDK = INW, LDO = DM;
constexpr size_t SHM_V = KVBLK * D * 2, SHM_K = KVBLK * D * 2, SHM_ATTN = 2 * SHM_V + 2 * SHM_K + NW * 64 * 4;
#define KSWZ(row, colB) ((row) * 256 + ((colB) ^ (((row) & 7) << 4)))
#define SBAR() __builtin_amdgcn_sched_barrier(0)
__device__ __forceinline__ int crow(int r, int hi) { return (r & 3) + 8 * (r >> 2) + 4 * hi; }
__device__ __forceinline__ unsigned cvtpk(float lo, float hi) { unsigned r; asm volatile("v_cvt_pk_bf16_f32 %0, %1, %2" : "=v"(r) : "v"(lo), "v"(hi)); return r; }

__device__ __forceinline__ void partialSM(f32x16& p0, f32x16& p1, float& m_reg, float& mn, float& alpha, bool domask, int dq, int hi) {
  constexpr float C = SCALE * 1.4426950408889634f;
  {
    if (domask) {
#pragma unroll
      for (int r = 0; r < 16; ++r) { const int d0 = dq + crow(r, hi), d1 = d0 + 32;
        if (d0 > 128 || d0 < -128) p0[r] = -1e30f;
        if (d1 > 128 || d1 < -128) p1[r] = -1e30f; }
    }
  }
  float pmax = p0[0]; for (int r = 1; r < 16; ++r) pmax = fmaxf(pmax, p0[r]); for (int r = 0; r < 16; ++r) pmax = fmaxf(pmax, p1[r]);
  { auto rr = __builtin_amdgcn_permlane32_swap(__float_as_uint(pmax), __float_as_uint(pmax), false, false);
    pmax = fmaxf(__uint_as_float(rr[0]), __uint_as_float(rr[1])); }
  if (__builtin_expect(__all(pmax - m_reg <= THR / SCALE), 1)) { mn = m_reg; alpha = 1.f; }
  else { mn = fmaxf(m_reg, pmax); alpha = __builtin_amdgcn_exp2f((m_reg - mn) * C); m_reg = mn; }
  float mnC = -mn * C;
  for (int r = 0; r < 16; ++r) p0[r] = fmaf(p0[r], C, mnC); for (int r = 0; r < 16; ++r) p1[r] = fmaf(p1[r], C, mnC);
  for (int r = 0; r < 16; ++r) p0[r] = __builtin_amdgcn_exp2f(p0[r]);
}
__device__ __forceinline__ void finishSM(f32x16& p0, f32x16& p1, float alpha, float& l_reg, bf16x8& pa0, bf16x8& pa1, bf16x8& pa2, bf16x8& pa3) {
  for (int r = 0; r < 16; ++r) p1[r] = __builtin_amdgcn_exp2f(p1[r]);
  float ps = 0; for (int r = 0; r < 16; ++r) ps += p0[r]; for (int r = 0; r < 16; ++r) ps += p1[r];
  { auto rr = __builtin_amdgcn_permlane32_swap(__float_as_uint(ps), __float_as_uint(ps), false, false);
    ps = __uint_as_float(rr[0]) + __uint_as_float(rr[1]); }
  l_reg = l_reg * alpha + ps;
#define PK4(P, BASE, OUT) do { unsigned a0 = cvtpk(P[BASE + 0], P[BASE + 1]), a1 = cvtpk(P[BASE + 2], P[BASE + 3]);   \
    unsigned b0 = cvtpk(P[BASE + 4], P[BASE + 5]), b1 = cvtpk(P[BASE + 6], P[BASE + 7]);                              \
    auto r0 = __builtin_amdgcn_permlane32_swap(a0, b0, false, false); auto r1 = __builtin_amdgcn_permlane32_swap(a1, b1, false, false); \
    u32x4 w = {r0[0], r1[0], r0[1], r1[1]}; OUT = *reinterpret_cast<bf16x8*>(&w); } while (0)
  PK4(p0, 0, pa0); PK4(p0, 8, pa1); PK4(p1, 0, pa2); PK4(p1, 8, pa3);
#undef PK4
}
__device__ __forceinline__ void qkt(f32x16& p0, f32x16& p1, const char* Ks, const bf16x8* qr, int ka0) {
  p0 = f32x16{}; p1 = f32x16{};
  asm volatile("" : "+v"(ka0));
#pragma unroll
  for (int d0 = 0; d0 < 8; ++d0) { const int off = ka0 ^ (d0 * 32);
    bf16x8 b0 = *reinterpret_cast<const bf16x8*>(Ks + off);
    bf16x8 b1 = *reinterpret_cast<const bf16x8*>(Ks + off + 32 * 256);
    p0 = __builtin_amdgcn_mfma_f32_32x32x16_bf16(b0, qr[d0], p0, 0, 0, 0);
    p1 = __builtin_amdgcn_mfma_f32_32x32x16_bf16(b1, qr[d0], p1, 0, 0, 0); }
}
__device__ __forceinline__ int v_st(int k, int c) { const int kk = (k & ~0xC) | ((k & 4) << 1) | ((k & 8) >> 1); return ((kk >> 3) * 4 + (c >> 5)) * 512 + ((kk & 7) * 32 + (c & 31)) * 2; }
__device__ __forceinline__ int v_rd_base(int lane) { return ((lane & 3) << 3) | (((lane >> 2) & 3) << 6) | (((lane >> 4) & 1) << 5) | (((lane >> 5) & 1) << 8); }
constexpr int v_rd_off(int d0, int ks, int half) { return d0 * 512 + ks * 4096 + half * 2048; }
template <int OFF> __device__ __forceinline__ s16x4 tr_read(int vb) {
  s16x4 r; asm volatile("ds_read_b64_tr_b16 %0, %1 offset:%2" : "=&v"(r) : "v"(vb), "i"(OFF) : "memory"); return r;
}
template <int D0> __device__ __forceinline__ void pv_one(f32x16& od, int vb, bf16x8 pa0, bf16x8 pa1, bf16x8 pa2, bf16x8 pa3) {
  const s16x4 l0 = tr_read<v_rd_off(D0, 0, 0)>(vb), h0 = tr_read<v_rd_off(D0, 0, 1)>(vb), l1 = tr_read<v_rd_off(D0, 1, 0)>(vb), h1 = tr_read<v_rd_off(D0, 1, 1)>(vb);
  const s16x4 l2 = tr_read<v_rd_off(D0, 2, 0)>(vb), h2 = tr_read<v_rd_off(D0, 2, 1)>(vb), l3 = tr_read<v_rd_off(D0, 3, 0)>(vb), h3 = tr_read<v_rd_off(D0, 3, 1)>(vb);
  asm volatile("s_waitcnt lgkmcnt(0)" ::: "memory"); SBAR();
#define PK(L, H) (bf16x8){L[0], L[1], L[2], L[3], H[0], H[1], H[2], H[3]}
  od = __builtin_amdgcn_mfma_f32_32x32x16_bf16(pa0, PK(l0, h0), od, 0, 0, 0);
  od = __builtin_amdgcn_mfma_f32_32x32x16_bf16(pa1, PK(l1, h1), od, 0, 0, 0);
  od = __builtin_amdgcn_mfma_f32_32x32x16_bf16(pa2, PK(l2, h2), od, 0, 0, 0);
  od = __builtin_amdgcn_mfma_f32_32x32x16_bf16(pa3, PK(l3, h3), od, 0, 0, 0);
#undef PK
}
__device__ __forceinline__ void pv_d0(f32x16* o, int vb, bf16x8 pa0, bf16x8 pa1, bf16x8 pa2, bf16x8 pa3) {
  pv_one<0>(o[0], vb, pa0, pa1, pa2, pa3); pv_one<1>(o[1], vb, pa0, pa1, pa2, pa3); pv_one<2>(o[2], vb, pa0, pa1, pa2, pa3); pv_one<3>(o[3], vb, pa0, pa1, pa2, pa3);
}

__device__ __forceinline__ void attn_body(const bf16_t* __restrict__ Qb, const bf16_t* __restrict__ Kb, const bf16_t* __restrict__ Vb, bf16_t* __restrict__ Ob,
                                          int NT, int kskip, int qpos0, float m0, float l0, bool maskon, char* lds, float* ssq_out) {
  const int tid = opaque_tid(), wid = tid >> 6, lane = tid & 63, r32 = lane & 31, hi = lane >> 5;
  char* V_lds = lds; char* K_lds = lds + 2 * SHM_V;
  float* ws = (float*)(lds + 2 * SHM_V + 2 * SHM_K) + wid * 64; float* li_l = ws; float* al_l = ws + 32;
  float m_reg = m0, l_reg = l0; f32x16 o[4] = {}; bf16x8 qr[8];
  const bf16_t* Qw = Qb + (long)(wid * QBLK + r32) * LDQ + hi * 8;
#pragma unroll
  for (int d0 = 0; d0 < 8; ++d0) qr[d0] = *reinterpret_cast<const bf16x8*>(Qw + d0 * 16);
  const int sr = tid >> 4, sc = (tid & 15) * 8, vst0 = v_st(sr, sc), kst0 = KSWZ(sr, sc * 2);
  const int vb0 = (int)(uintptr_t)V_lds + v_rd_base(lane);
  const int qpos = qpos0 + wid * QBLK + r32;
  const int ka0 = r32 * 256 + ((hi * 16) ^ ((r32 & 7) << 4));
  const unsigned goff0 = (unsigned)(sr * LDK + sc) * 2u, goff1 = goff0 + 32u * LDK * 2u;
  struct { bf16x8 vs0, vs1, ks0, ks1; } sr_[1];
#define TROW(jt) ((long)(jt) * KVBLK + ((jt) >= 4 ? kskip : 0))
#define SLOAD(i, jt) do { const long _k0 = TROW(jt) * (LDK * 2); const char* _kp = (const char*)Kb + _k0; const char* _vp = (const char*)Vb + _k0; \
    sr_[i].vs0 = *reinterpret_cast<const bf16x8*>(_vp + goff0); sr_[i].vs1 = *reinterpret_cast<const bf16x8*>(_vp + goff1); \
    sr_[i].ks0 = *reinterpret_cast<const bf16x8*>(_kp + goff0); sr_[i].ks1 = *reinterpret_cast<const bf16x8*>(_kp + goff1); } while (0)
#define SWRITE(b, i) do { *(bf16x8*)(V_lds + (b) * SHM_V + vst0) = sr_[i].vs0;          \
    *(bf16x8*)(V_lds + (b) * SHM_V + vst0 + 8192) = sr_[i].vs1;                         \
    *(bf16x8*)(K_lds + (b) * SHM_K + kst0) = sr_[i].ks0;                               \
    *(bf16x8*)(K_lds + (b) * SHM_K + kst0 + 8192) = sr_[i].ks1; } while (0)
#define SWAIT() asm volatile("s_waitcnt vmcnt(0)" ::: "memory")
#define RESC(a) do { if (__any((a) < 1.f)) { if (hi == 0) al_l[r32] = (a); asm volatile("s_waitcnt lgkmcnt(0)" ::: "memory"); \
    for (int d = 0; d < 4; ++d) for (int r = 0; r < 16; ++r) o[d][r] *= al_l[crow(r, hi)]; } } while (0)
#define DQ(jt) (kskip + ((jt) - 4) * KVBLK - qpos)
  f32x16 pA0, pA1, pB0, pB1; float mnA, mnB, alA, alB; bf16x8 pa0, pa1, pa2, pa3;
  constexpr int SE = 0, SO = 0;
  SLOAD(SE, 0); asm volatile("s_waitcnt vmcnt(0)" ::: "memory"); SWRITE(0, SE); __syncthreads();
  qkt(pA0, pA1, K_lds, qr, ka0); partialSM(pA0, pA1, m_reg, mnA, alA, false, 0, hi);
  SLOAD(SO, 1);
  SWAIT(); SWRITE(1, SO); __syncthreads();
  for (int j = 1; j + 1 < NT; j += 2) {
    SBAR(); qkt(pB0, pB1, K_lds + SHM_K, qr, ka0);
    finishSM(pA0, pA1, alA, l_reg, pa0, pa1, pa2, pa3); SBAR();
    SLOAD(SO, j + 1); SBAR();
    pv_d0(o, vb0, pa0, pa1, pa2, pa3); partialSM(pB0, pB1, m_reg, mnB, alB, maskon && j >= 4, DQ(j), hi);
    __syncthreads(); SWAIT(); SWRITE(0, SE);
    RESC(alB); __syncthreads();
    SBAR(); qkt(pA0, pA1, K_lds, qr, ka0);
    finishSM(pB0, pB1, alB, l_reg, pa0, pa1, pa2, pa3); SBAR();
    SLOAD(SE, j + 2); SBAR();
    pv_d0(o, vb0 + (int)SHM_V, pa0, pa1, pa2, pa3); partialSM(pA0, pA1, m_reg, mnA, alA, maskon && j + 1 >= 4, DQ(j + 1), hi);
    __syncthreads(); SWAIT(); SWRITE(1, SO);
    RESC(alA); __syncthreads();
  }
  SBAR(); qkt(pB0, pB1, K_lds + SHM_K, qr, ka0);
  finishSM(pA0, pA1, alA, l_reg, pa0, pa1, pa2, pa3); SBAR();
  pv_d0(o, vb0, pa0, pa1, pa2, pa3); partialSM(pB0, pB1, m_reg, mnB, alB, maskon && NT - 1 >= 4, DQ(NT - 1), hi);
  __syncthreads(); RESC(alB);
  finishSM(pB0, pB1, alB, l_reg, pa0, pa1, pa2, pa3); SBAR();
  pv_d0(o, vb0 + (int)SHM_V, pa0, pa1, pa2, pa3);
  if (hi == 0) li_l[r32] = l_reg; asm volatile("s_waitcnt lgkmcnt(0)" ::: "memory");
  float rli[16];
#pragma unroll
  for (int r = 0; r < 16; ++r) rli[r] = __builtin_amdgcn_rcpf(li_l[crow(r, hi)]);
  bf16_t* Ow = Ob + (long)(wid * QBLK) * LDO;
#pragma unroll
  for (int r = 0; r < 16; ++r) { int orow = crow(r, hi); float sq = 0.f;
    for (int d0 = 0; d0 < 4; ++d0) { const float ov = o[d0][r] * rli[r]; sq += ov * ov; Ow[(long)orow * LDO + d0 * 32 + r32] = (bf16_t)f2bf(ov); }
    sq = row16_sum(sq); sq += __builtin_bit_cast(float, __builtin_amdgcn_ds_swizzle(__builtin_bit_cast(int, sq), 0x401F));
    if (r32 == 0) ssq_out[(size_t)(wid * QBLK + orow) * 16] = sq; }
#undef TROW
#undef SLOAD
#undef SWRITE
#undef SWAIT
#undef RESC
#undef DQ
}
}

struct Args { const float* in[23]; float* out; unsigned char* ws; int ph_lo, ph_hi; };
enum { IN_X = 0, IN_C, IN_CTX, IN_CCTX, IN_WMOD, IN_BMOD, IN_N1G, IN_N2G, IN_WIN, IN_QNA, IN_KNA, IN_SINK, IN_VNB, IN_WS, IN_BS, IN_QNC, IN_KNC, IN_OUTG, IN_WOUT, IN_WR, IN_WG, IN_WU, IN_WDN };

#define PHASE_IDS(F) const int tid = opaque_tid(), lane = tid & 63, wave = __builtin_amdgcn_readfirstlane(tid >> 6), gw = (int)blockIdx.x * 8 + wave, NGW = (F).G * 8; (void)lane; (void)wave; (void)gw; (void)NGW
constexpr int ARGTAB_OFF = LDSCTL_OFF + 1024;
#define INP(F, i) ld_inp((F).lds, (i))
__device__ __forceinline__ const float* ld_inp(LAS unsigned char* lds, int i) {
    unsigned a = (unsigned)(uintptr_t)(lds + ARGTAB_OFF) + 8u * (unsigned)i;
    asm volatile("" : "+v"(a));
    const volatile LAS unsigned* t = (const volatile LAS unsigned*)(uintptr_t)a;
    const unsigned lo = __builtin_amdgcn_readfirstlane(t[0]), hi = __builtin_amdgcn_readfirstlane(t[1]);
    return (const float*)(const GAS float*)(((unsigned long long)hi << 32) | lo);
}
struct Frame {
    LAS unsigned char* lds; char* ldsg;
    volatile LAS unsigned* MISC;
    unsigned* ctl;
    int G;
    float* out; unsigned char* ws;
};

__host__ __device__ __forceinline__ int headpos(int d) { return 32 * (2 * (d >> 6) + ((d >> 4) & 1)) + 8 * ((d >> 2) & 3) + 4 * ((d >> 5) & 1) + (d & 3); }
template <bool HEADPERM = false>
__device__ __forceinline__ void transpose_item(const float* W, int N, bf16_t* WT, int k0, int n0, int drow0, LAS float* scr, int lane) {
    { float t[32]; const float* wp = W + (size_t)(k0 + (lane >> 5)) * N + n0 + (lane & 31);
#pragma unroll
      for (int i = 0; i < 32; ++i) t[i] = wp[(size_t)(2 * i) * N];
#pragma unroll
      for (int i = 0; i < 32; ++i) scr[(2 * i + (lane >> 5)) * 33 + (lane & 31)] = t[i]; }
    LDS_WAIT(); asm volatile("" ::: "memory");
    const int c = lane & 7;
#pragma unroll
    for (int j = 0; j < 4; ++j) { const int n = (lane >> 3) + 8 * j; const LAS float* s = scr + (8 * c) * 33 + n;
        u32x4 o; o.x = pk2(s[0 * 33], s[1 * 33]); o.y = pk2(s[2 * 33], s[3 * 33]); o.z = pk2(s[4 * 33], s[5 * 33]); o.w = pk2(s[6 * 33], s[7 * 33]);
        const int drow = HEADPERM ? ((drow0 + n) & ~127) + headpos((drow0 + n) & 127) : drow0 + n;
        *(u32x4*)(WT + (size_t)drow * DM + k0 + 8 * c) = o; }
    LDS_WAIT(); asm volatile("" ::: "memory");
}

__device__ __forceinline__ void transpose_item8(const float* W, int N, unsigned char* WT, int k0, int n0, int drow0, LAS float* scr, int lane) {
    { float t[32]; const float* wp = W + (size_t)(k0 + (lane >> 5)) * N + n0 + (lane & 31);
#pragma unroll
      for (int i = 0; i < 32; ++i) t[i] = wp[(size_t)(2 * i) * N];
#pragma unroll
      for (int i = 0; i < 32; ++i) scr[(2 * i + (lane >> 5)) * 33 + (lane & 31)] = t[i]; }
    LDS_WAIT(); asm volatile("" ::: "memory");
    const int c = lane & 7;
#pragma unroll
    for (int j = 0; j < 4; ++j) { const int n = (lane >> 3) + 8 * j; const LAS float* s = scr + (8 * c) * 33 + n;
        u32x2 o; o.x = pk4_fp8(s[0 * 33] * W8_SCALE, s[1 * 33] * W8_SCALE, s[2 * 33] * W8_SCALE, s[3 * 33] * W8_SCALE); o.y = pk4_fp8(s[4 * 33] * W8_SCALE, s[5 * 33] * W8_SCALE, s[6 * 33] * W8_SCALE, s[7 * 33] * W8_SCALE);
        *(u32x2*)(WT + (size_t)(drow0 + n) * DM + k0 + 8 * c) = o; }
    LDS_WAIT(); asm volatile("" ::: "memory");
}
__device__ __forceinline__ void conv_tile(Frame& F, int tl, int tid, int lane, int wave) {
    const int mat = tl >> 7, kb = (tl & 127) >> 3, nb = tl & 7, le = mat / 3, wh = mat % 3;
    const float* src = INP(F, wh == 0 ? IN_WG : wh == 1 ? IN_WU : IN_WDN) + (size_t)le * DM * DM + (size_t)(128 * kb) * DM + 256 * nb;
    unsigned char* dst = (wh < 2) ? F.ws + WS_WGU + (size_t)(le / NE) * NE * 4096 * DM * 2 + (size_t)(le % NE) * 4096 * DM + (size_t)(2 * nb) * 256 * DM + 128 * kb
                                  : F.ws + WS_WD + (size_t)(le / NE) * NE * DM * DM * 2 + (size_t)(le % NE) * DM * DM + (size_t)(256 * nb) * DM + 128 * kb;
    f32x4 t[16];
    { const float* wp = src + (size_t)(16 * wave) * DM + 4 * lane;
#pragma unroll
      for (int q = 0; q < 16; ++q) t[q] = __builtin_nontemporal_load((const f32x4*)(wp + (size_t)q * DM)); }
    LAS unsigned* img = (LAS unsigned*)F.lds;
#pragma unroll
    for (int it = 0; it < 4; ++it)
#pragma unroll
        for (int j = 0; j < 4; ++j) { const int n = 4 * lane + j, d = 4 * wave + it;
            img[n * 32 + (d ^ (lane & 31))] = pk4_fp8(t[4 * it + 0][j] * W8_SCALE, t[4 * it + 1][j] * W8_SCALE, t[4 * it + 2][j] * W8_SCALE, t[4 * it + 3][j] * W8_SCALE); }
    __syncthreads();
#pragma unroll
    for (int q = 0; q < 4; ++q) { const int ch = tid + 512 * q, n = ch >> 3, g = ch & 7, sw = (n >> 2) & 31;
        u32x4 o; o.x = img[n * 32 + ((4 * g + 0) ^ sw)]; o.y = img[n * 32 + ((4 * g + 1) ^ sw)]; o.z = img[n * 32 + ((4 * g + 2) ^ sw)]; o.w = img[n * 32 + ((4 * g + 3) ^ sw)];
        const int drow = (wh < 2) ? (n >> 7) * 256 + wh * 128 + (n & 127) : n;
        *(u32x4*)(dst + (size_t)drow * DM + 16 * g) = o; }
    __syncthreads();
}
__device__ __forceinline__ void conv_help(Frame& F, int budget, unsigned* done, unsigned done_total) {
    if (!CONV_IDLE) return;
    PHASE_IDS(F);
    for (int n = 0; n < budget; ++n) {
        if (tid == 0) { unsigned t = 0xffffffffu;
            if (done == nullptr || xb_ld(done) < done_total) t = xb_add(F.ctl + CW_CONV, 1u);
            F.MISC[1] = t; }
        __syncthreads();
        const unsigned t = F.MISC[1];
        __syncthreads();
        if (t >= (unsigned)(NT8_ALL - NT8_L0)) break;
        conv_tile(F, NT8_L0 + (int)t, tid, lane, wave);
    }
}
__device__ __forceinline__ void phase_prologue(Frame& F) {
    PHASE_IDS(F);
    static_assert(FP8_L0 && FP8_L1, "the prologue writes the experts' weights as fp8");
    {
        constexpr int NT8 = CONV_IDLE ? NT8_L0 : NT8_ALL;
        struct T8 { const float* src; unsigned char* dst; int which; };
#define P8_DESC(d, tl) do { const int mat = (tl) >> 7, kb = ((tl) & 127) >> 3, nb = (tl) & 7, le = mat / 3, wh = mat % 3; d.which = wh; \
        d.src = INP(F, wh == 0 ? IN_WG : wh == 1 ? IN_WU : IN_WDN) + (size_t)le * DM * DM + (size_t)(128 * kb) * DM + 256 * nb; \
        d.dst = (wh < 2) ? F.ws + WS_WGU + (size_t)(le / NE) * NE * 4096 * DM * 2 + (size_t)(le % NE) * 4096 * DM + (size_t)(2 * nb) * 256 * DM + 128 * kb \
                         : F.ws + WS_WD + (size_t)(le / NE) * NE * DM * DM * 2 + (size_t)(le % NE) * DM * DM + (size_t)(256 * nb) * DM + 128 * kb; } while (0)
#define P8_LOAD(d, t) do { const float* wp = d.src + (size_t)(16 * wave) * DM + 4 * lane; _Pragma("unroll") for (int q = 0; q < 16; ++q) t[q] = __builtin_nontemporal_load((const f32x4*)(wp + (size_t)q * DM)); } while (0)
        T8 cur, nxt; f32x4 t0[16], t1[16];
        int tl = blockIdx.x, par = 0;
        if (tl < NT8) { P8_DESC(cur, tl); P8_LOAD(cur, t0); }
        for (; tl < NT8; tl += F.G, par ^= 1) {
            const bool has = tl + F.G < NT8;
            if (has) { P8_DESC(nxt, tl + F.G); P8_LOAD(nxt, t1); }
            LAS unsigned* img = (LAS unsigned*)(F.lds + par * 32768);
#pragma unroll
            for (int it = 0; it < 4; ++it)
#pragma unroll
                for (int j = 0; j < 4; ++j) { const int n = 4 * lane + j, d = 4 * wave + it;
                    img[n * 32 + (d ^ (lane & 31))] = pk4_fp8(t0[4 * it + 0][j] * W8_SCALE, t0[4 * it + 1][j] * W8_SCALE, t0[4 * it + 2][j] * W8_SCALE, t0[4 * it + 3][j] * W8_SCALE); }
            __syncthreads();
#pragma unroll
            for (int q = 0; q < 4; ++q) { const int ch = tid + 512 * q, n = ch >> 3, g = ch & 7, sw = (n >> 2) & 31;
                u32x4 o; o.x = img[n * 32 + ((4 * g + 0) ^ sw)]; o.y = img[n * 32 + ((4 * g + 1) ^ sw)]; o.z = img[n * 32 + ((4 * g + 2) ^ sw)]; o.w = img[n * 32 + ((4 * g + 3) ^ sw)];
                const int drow = (cur.which < 2) ? (n >> 7) * 256 + cur.which * 128 + (n & 127) : n;
                *(u32x4*)(cur.dst + (size_t)drow * DM + 16 * g) = o; }
            if (has) { cur = nxt;
#pragma unroll
                for (int q = 0; q < 16; ++q) t0[q] = t1[q]; }
        }
#undef P8_DESC
#undef P8_LOAD
        __syncthreads();
    }
    LAS float* scr = (LAS float*)(F.lds + wave * 16384);
    constexpr int I_IN = 32 * (INW / 32), I_SQ = 32 * (DM / 32);
    constexpr int NIT = 2 * I_IN + 2 * I_SQ;
    struct TItem { const float* src; unsigned char* dst; const float* og; int N, drow0, mode; };
#define P0_DESC(d, itv) do { int r = (itv); \
        if (r < 2 * I_IN) { const int l = r / I_IN; r %= I_IN; const int kb = r / (INW / 32), nb = r % (INW / 32); \
            d.src = INP(F, IN_WIN) + (size_t)l * DM * INW + (size_t)(64 * kb) * INW + 32 * nb; d.dst = F.ws + WS_WIN + (size_t)l * INW * DM * 2 + 128 * kb; d.N = INW; d.drow0 = 32 * nb; d.mode = 1; d.og = nullptr; } \
        else { r -= 2 * I_IN; const int l = r / I_SQ; r %= I_SQ; const int kb = r / 64, nb = r % 64; \
            d.src = INP(F, IN_WOUT) + (size_t)l * DM * DM + (size_t)(64 * kb) * DM + 32 * nb; d.dst = F.ws + WS_WOUT + (size_t)l * DM * DM * 2 + 128 * kb; d.N = DM; d.drow0 = 32 * nb; d.mode = 0; d.og = INP(F, IN_OUTG) + l * DM + 64 * kb; } } while (0)
#define P0_LOAD(d, t) do { const float* wp = d.src + (size_t)(lane >> 3) * d.N + (lane & 7) * 4; _Pragma("unroll") for (int i = 0; i < 8; ++i) t[i] = *(const f32x4*)(wp + (size_t)(8 * i) * d.N); } while (0)
    for (int it = gw; it < NIT; it += NGW) {
        TItem cur; f32x4 t0[8];
        P0_DESC(cur, it); P0_LOAD(cur, t0);
#pragma unroll
        for (int i = 0; i < 8; ++i) { LAS float* sp = scr + (8 * i + (lane >> 3)) * 33 + (lane & 7) * 4; sp[0] = t0[i].x; sp[1] = t0[i].y; sp[2] = t0[i].z; sp[3] = t0[i].w; }
        LDS_WAIT(); asm volatile("" ::: "memory");
        const int c = lane & 7;
#pragma unroll
        for (int j = 0; j < 4; ++j) { const int n = (lane >> 3) + 8 * j; const LAS float* sp = scr + (8 * c) * 33 + n;
            float v[8];
#pragma unroll
            for (int q = 0; q < 8; ++q) v[q] = sp[q * 33];
            if (cur.mode == 0) { const f32x4 g0 = *(const f32x4*)(cur.og + 8 * c), g1 = *(const f32x4*)(cur.og + 8 * c + 4);
                v[0] *= g0.x; v[1] *= g0.y; v[2] *= g0.z; v[3] *= g0.w; v[4] *= g1.x; v[5] *= g1.y; v[6] *= g1.z; v[7] *= g1.w; }
            int drow = cur.drow0 + n; if (cur.mode == 1) drow = (drow & ~127) + headpos(drow & 127);
            u32x4 o; o.x = pk2(v[0], v[1]); o.y = pk2(v[2], v[3]); o.z = pk2(v[4], v[5]); o.w = pk2(v[6], v[7]); *(u32x4*)(cur.dst + (size_t)drow * DM * 2 + 16 * c) = o; }
        LDS_WAIT(); asm volatile("" ::: "memory");
    }
#undef P0_DESC
#undef P0_LOAD
    __syncthreads();
    {
        LAS float* sil = (LAS float*)F.lds;
        LAS float* red = (LAS float*)(F.lds + 40960);
        bool have = false;
        for (int it = blockIdx.x; it < 2 * 96; it += F.G) {
            if (!have) {
                { const float* cp = INP(F, IN_C); const float* ccp = INP(F, IN_CCTX);
                for (int i = tid; i < 5 * DM; i += 512) { const int s = i / DM, k = i % DM; const float cv = (s < 4) ? cp[s * DM + k] : ccp[k]; sil[i] = cv / (1.f + __expf(-cv)); } }
                have = true; __syncthreads();
            }
            const int l = it / 96, cb = it % 96, c4 = tid & 31, kr = tid >> 5;
            const float* wp = INP(F, IN_WMOD) + (size_t)l * DM * NMOD + (size_t)cb * 128 + c4 * 4;
            f32x4 a[5];
#pragma unroll
            for (int s = 0; s < 5; ++s) a[s] = (f32x4){0.f, 0.f, 0.f, 0.f};
#pragma unroll 8
            for (int k = kr; k < DM; k += 16) { const f32x4 w = *(const f32x4*)(wp + (size_t)k * NMOD);
#pragma unroll
                for (int s = 0; s < 5; ++s) a[s] += w * sil[s * DM + k]; }
#pragma unroll
            for (int s = 0; s < 5; ++s) *(LAS f32x4*)(red + (kr * 5 + s) * 128 + c4 * 4) = a[s];
            __syncthreads();
            const float* bmod = INP(F, IN_BMOD);
            for (int i = tid; i < 5 * 128; i += 512) { const int s = i / 128, cc = i % 128; float sum = 0.f;
#pragma unroll
                for (int q = 0; q < 16; ++q) sum += red[(q * 5 + s) * 128 + cc];
                ((float*)(F.ws + WS_MOD))[(size_t)(l * 5 + s) * NMOD + cb * 128 + cc] = sum + bmod[l * NMOD + cb * 128 + cc]; }
            __syncthreads();
        }
    }
    if ((int)blockIdx.x >= F.G - 9 && (int)blockIdx.x < F.G - 1) {
        const float* wr = INP(F, IN_WR); bf16_t* wf = (bf16_t*)(F.ws + WS_WRS); const int part = (int)blockIdx.x - (F.G - 9);
        for (int i = part * 512 + tid; i < 2 * DM * NE; i += 8 * 512) { const int l = i / (DM * NE), rem = i % (DM * NE), k = rem >> 4, e = rem & 15;
            const float w = wr[i]; const unsigned hi = f2bf(w); const unsigned lo = f2bf(w - __builtin_bit_cast(float, hi << 16));
            const int sidx = k >> 5, q = (k >> 3) & 3, j = k & 7; bf16_t* dst = wf + ((size_t)(l * 64 + sidx) * 2 * 64 + (q * 16 + e)) * 8 + j;
            dst[0] = (bf16_t)hi; dst[64 * 8] = (bf16_t)lo; }
    }
    if (blockIdx.x == F.G - 1) {
        for (int i = tid; i < 64 * 32; i += 512) {
            const int pos = i >> 5, f = i & 31;
            double inv = 1.0; for (int q = 0; q < f; ++q) inv *= 0.7498942093324559;
            const double a = (double)pos * inv;
            const double n = __builtin_rint(a * 0.6366197723675814);
            const double r = (a - n * 1.5707963267948966) - n * 6.123233995736766e-17;
            const double r2 = r * r;
            double sn = r * (1.0 + r2 * (-1.0 / 6 + r2 * (1.0 / 120 + r2 * (-1.0 / 5040 + r2 * (1.0 / 362880 + r2 * (-1.0 / 39916800 + r2 * (1.0 / 6227020800.0)))))));
            double cn = 1.0 + r2 * (-0.5 + r2 * (1.0 / 24 + r2 * (-1.0 / 720 + r2 * (1.0 / 40320 + r2 * (-1.0 / 3628800 + r2 * (1.0 / 479001600 + r2 * (-1.0 / 87178291200.0)))))));
            const int q = ((int)n) & 3; double cs, ss;
            if (q == 0) { cs = cn; ss = sn; } else if (q == 1) { cs = -sn; ss = cn; } else if (q == 2) { cs = -cn; ss = -sn; } else { cs = sn; ss = -cn; }
            ((float*)(F.ws + WS_ROPE))[2 * i] = (float)cs; ((float*)(F.ws + WS_ROPE))[2 * i + 1] = (float)ss;
        }
    }
}

__device__ __forceinline__ void load_row(const float* row, int lane, f32x4 (&v)[8]) {
#pragma unroll
    for (int j = 0; j < 8; ++j) v[j] = *(const f32x4*)(row + 4 * lane + 256 * j);
}
__device__ __forceinline__ void norm_mod_store(const f32x4 (&v)[8], const float* g, const float* shift, const float* scale, bf16_t* dst, int lane) {
    float ss = 0.f;
#pragma unroll
    for (int j = 0; j < 8; ++j) ss += (v[j].x * v[j].x + v[j].y * v[j].y) + (v[j].z * v[j].z + v[j].w * v[j].w);
    const float rinv = rsqrt_fast(wave_sum(ss) * (1.f / DM) + EPS);
#pragma unroll
    for (int j = 0; j < 8; ++j) { const int c = 4 * lane + 256 * j;
        const f32x4 gg = *(const f32x4*)(g + c), sh = *(const f32x4*)(shift + c), sc = *(const f32x4*)(scale + c);
        const f32x4 y = (v[j] * rinv) * gg * (sc + 1.f) + sh;
        u32x2 w; w.x = pk2(y.x, y.y); w.y = pk2(y.z, y.w); *(u32x2*)(dst + c) = w; }
}

__device__ __forceinline__ void phase_rowpass1_l0(Frame& F) {
    PHASE_IDS(F);
    const float* mod = (const float*)(F.ws + WS_MOD);
    { const float* n2 = INP(F, IN_N2G); float* gs = (float*)(F.ws + WS_GS2);
      for (int i = (int)blockIdx.x * 512 + tid; i < 2 * 5 * DM; i += F.G * 512) { const int l = i / (5 * DM), sv = (i / DM) % 5, k = i % DM;
          const float* m = mod + (size_t)(l * 5 + sv) * NMOD; gs[2 * i] = n2[l * DM + k] * (1.f + m[4 * DM + k]); gs[2 * i + 1] = m[3 * DM + k]; } }
    const float* xin = INP(F, IN_X); const float* cin = INP(F, IN_CTX); const float* n1g = INP(F, IN_N1G);
#define P1_SRC(rr) ((((rr) % TPB) < CTXL) ? cin + ((size_t)((rr) / TPB) * CTXL + ((rr) % TPB)) * DM : xin + ((size_t)((rr) / TPB) * SEQ + (((rr) % TPB) - CTXL)) * DM)
    f32x4 v[8], vn[8];
    int r = gw;
    if (r < NTOK) load_row(P1_SRC(r), lane, v);
    while (r < NTOK) {
        const int rn = r + NGW;
        if (rn < NTOK) load_row(P1_SRC(rn), lane, vn);
        const int b = r / TPB, t = r % TPB, s = (t < CTXL) ? 4 : b;
        norm_mod_store(v, n1g, mod + (size_t)s * NMOD, mod + (size_t)s * NMOD + DM, (bf16_t*)(F.ws + WS_HN) + (size_t)r * DM, lane);
#pragma unroll
        for (int j = 0; j < 8; ++j) v[j] = vn[j];
        r = rn;
    }
#undef P1_SRC
}

__device__ __forceinline__ void post_unpack(const u32x4 x, float (&v)[8]) {
    v[0] = bflo(x.x); v[1] = bfhi(x.x); v[2] = bflo(x.y); v[3] = bfhi(x.y); v[4] = bflo(x.z); v[5] = bfhi(x.z); v[6] = bflo(x.w); v[7] = bfhi(x.w); }
__device__ __forceinline__ float sum16(float v) { return row16_sum(v); }
__device__ __forceinline__ void phase_post(Frame& F, int l) {
    PHASE_IDS(F);
    bf16_t* P = (bf16_t*)(F.ws + WS_P);
    const float* rope = (const float*)(F.ws + WS_ROPE);
    const int i16 = lane & 15, hq = lane >> 4; const bool hi2 = hq >= 2;
    const float* qna = INP(F, IN_QNA) + l * 128 + 8 * i16; const float* kna = INP(F, IN_KNA) + l * 128 + 8 * i16;
    const float* qnc = INP(F, IN_QNC) + l * 128 + 8 * i16; const float* knc = INP(F, IN_KNC) + l * 128 + 8 * i16;
    const float* vnb = INP(F, IN_VNB) + l * 512 + 8 * i16;
    for (int r = gw; r < NTOK; r += NGW) {
        const int t = r % TPB; const bool lat = t >= CTXL;
        u32x4* rp = (u32x4*)(P + (size_t)r * INW) + lane;
        u32x4 x[7];
#pragma unroll
        for (int j = 0; j < 7; ++j) x[j] = rp[64 * j];
        const int pos = lat ? t - CTXL : 0, pp = (i16 < 8) ? (pos >> 6) : (pos & 63);
        const f32x4* cs = (const f32x4*)(rope + 2 * (pp * 32 + 8 * (i16 & 3)));
        const f32x4 c0 = cs[0], c1 = cs[1], c2 = cs[2], c3 = cs[3];
        const float cosv[8] = {c0.x, c0.z, c1.x, c1.z, c2.x, c2.z, c3.x, c3.z}, sinv[8] = {c0.y, c0.w, c1.y, c1.w, c2.y, c2.w, c3.y, c3.w};
        const float sgn = (i16 & 4) ? 1.f : -1.f;
#pragma unroll
        for (int j = 0; j < 7; ++j) {
            const bool gelu_lo = (j == 3 || j == 4), gelu_hi = (j == 2 || j == 3);
            const bool norm_lo = (j != 2 && j != 3), norm_hi = (j != 2 && j != 6);
            const bool rope_lo = (j == 0 || j == 1 || j == 5 || j == 6), rope_hi = (j == 0 || j == 1 || j == 4 || j == 5);
            const bool dg = hi2 ? gelu_hi : gelu_lo, dn = hi2 ? norm_hi : norm_lo, dr = (hi2 ? rope_hi : rope_lo) && lat;
            if (!(gelu_lo || gelu_hi || norm_lo || norm_hi)) continue;
            float v[8]; post_unpack(x[j], v);
            if (gelu_lo || gelu_hi) {
#pragma unroll
                for (int e = 0; e < 8; ++e) { const float gv = gelu_tanh(v[e]); v[e] = dg ? gv : v[e]; } }
            if (norm_lo || norm_hi) {
                float ss = 0.f;
#pragma unroll
                for (int e = 0; e < 8; ++e) ss += v[e] * v[e];
                const float rinv = rsqrt_fast(sum16(ss) * (1.f / 128) + EPS);
                const float* gp;
                if (j == 0) gp = qna; else if (j == 1) gp = hi2 ? kna : qna; else if (j == 3) gp = vnb + (hi2 ? hq - 2 : 0) * 128; else if (j == 4) gp = hi2 ? qnc : vnb + (2 + hq) * 128;
                else if (j == 5) gp = qnc; else gp = knc;
                const f32x4 g0 = *(const f32x4*)gp, g1 = *(const f32x4*)(gp + 4);
                const float gg[8] = {g0.x, g0.y, g0.z, g0.w, g1.x, g1.y, g1.z, g1.w};
#pragma unroll
                for (int e = 0; e < 8; ++e) v[e] = dn ? v[e] * rinv * gg[e] : v[e];
            }
            if (rope_lo || rope_hi) {
#pragma unroll
                for (int e = 0; e < 8; ++e) { const float o = __builtin_bit_cast(float, __builtin_amdgcn_ds_swizzle(__builtin_bit_cast(int, v[e]), 0x101F)); const float rv = v[e] * cosv[e] + sgn * o * sinv[e]; v[e] = dr ? rv : v[e]; } }
            u32x4 w; w.x = pk2(v[0], v[1]); w.y = pk2(v[2], v[3]); w.z = pk2(v[4], v[5]); w.w = pk2(v[6], v[7]);
            rp[64 * j] = w;
        }
    }
}

__device__ __forceinline__ void mixer_b_unit(Frame& F, int l, int b, int ch, int g) {
    PHASE_IDS(F);
    const bf16_t* P = (const bf16_t*)(F.ws + WS_P); bf16_t* O = (bf16_t*)(F.ws + WS_O);
    const int row0 = b * TPB + ch * 128, w = wave;
    LAS bf16_t* VT = (LAS bf16_t*)F.lds;
    { const int q = tid >> 2, dp = (tid & 3) * 32; const bf16_t* src = P + (size_t)(row0 + q) * INW + C_VB + g * 128 + dp;
#pragma unroll
      for (int i = 0; i < 4; ++i) { const u32x4 x = *(const u32x4*)(src + 8 * i); const unsigned xs[4] = {x.x, x.y, x.z, x.w};
#pragma unroll
          for (int j = 0; j < 4; ++j) { VT[(dp + 8 * i + 2 * j) * 136 + q] = (bf16_t)(xs[j] & 0xffffu); VT[(dp + 8 * i + 2 * j + 1) * 136 + q] = (bf16_t)(xs[j] >> 16); } } }
    __syncthreads();
    const int i15 = lane & 15, kq = lane >> 4;
    f32x4 acc[8];
#pragma unroll
    for (int n = 0; n < 8; ++n) acc[n] = (f32x4){0.f, 0.f, 0.f, 0.f};
    const float* wsr = INP(F, IN_WS) + ((size_t)(l * 4 + g) * 128 + 16 * w + i15) * 128;
#pragma unroll
    for (int s = 0; s < 4; ++s) {
        const f32x4 a0 = *(const f32x4*)(wsr + 32 * s + 8 * kq), a1 = *(const f32x4*)(wsr + 32 * s + 8 * kq + 4);
        u32x4 aw; aw.x = pk2(a0.x, a0.y); aw.y = pk2(a0.z, a0.w); aw.z = pk2(a1.x, a1.y); aw.w = pk2(a1.z, a1.w);
        const bf16x8 af = *reinterpret_cast<bf16x8*>(&aw);
#pragma unroll
        for (int n = 0; n < 8; ++n) { const bf16x8 bfr = *(const LAS bf16x8*)(VT + (16 * n + i15) * 136 + 32 * s + 8 * kq);
            acc[n] = __builtin_amdgcn_mfma_f32_16x16x32_bf16(af, bfr, acc[n], 0, 0, 0); }
    }
#pragma unroll
    for (int j = 0; j < 4; ++j) { const int p = 16 * w + kq * 4 + j; const float bias = INP(F, IN_BS)[(l * 4 + g) * 128 + p];
        const bf16_t* up = P + (size_t)(row0 + p) * INW + C_UB + g * 128; bf16_t* op = O + (size_t)(row0 + p) * DM + O_B + g * 128;
        float sq = 0.f;
#pragma unroll
        for (int n = 0; n < 8; ++n) { const int d = 16 * n + i15; const float ov = bf2f(up[d]) * (acc[n][j] + bias); sq += ov * ov; op[d] = (bf16_t)f2bf(ov); }
        sq = row16_sum(sq);
        if (i15 == 0) ((float*)(F.ws + WS_SSQ))[(size_t)(row0 + p) * 16 + 6 + g] = sq; }
    __syncthreads();
}
__device__ __forceinline__ void phase_mixers(Frame& F, int l) {
    PHASE_IDS(F);
    const bf16_t* P = (const bf16_t*)(F.ws + WS_P); bf16_t* O = (bf16_t*)(F.ws + WS_O);
    const bool ctx = (l == 0);
    const int nC = 48, nA = 48, nCc = ctx ? 3 : 0, nAc = ctx ? 3 : 0, nB = 68;
    const int total = nC + nA + nCc + nAc + nB;
    for (int kq = 0; kq < 8; ++kq) {
        const int x = ((int)blockIdx.x + kq) & 7, b = x >> 1, kv = x & 1;
        unsigned* qctr = F.ctl + CW_QUEUE + 64 * (l * 8 + x);
        for (;;) {
            if (tid == 0) F.MISC[0] = xb_add(qctr, 1u);
            __syncthreads();
            int u = (int)F.MISC[0];
            __syncthreads();
            if (u >= total) break;
            if (u < nC + nA + nCc + nAc) {
                int kind, h, qb = 0;
                if (u < nC) { kind = 0; h = kv * 3 + u / 16; qb = u % 16; }
                else if (u < nC + nA) { const int v = u - nC; kind = 1; h = kv * 3 + v / 16; qb = v % 16; }
                else if (u < nC + nA + nCc) { kind = 2; h = kv * 3 + (u - nC - nA); }
                else { kind = 3; h = kv * 3 + (u - nC - nA - nCc); }
                const int isA = kind & 1, lat = (kind < 2);
                const size_t r0 = (size_t)b * TPB, rq = r0 + (lat ? CTXL + qb * 256 : 0);
                const int q0 = qb * 256, ks = (kind == 1) ? ((q0 - 128 < 0) ? 0 : q0 - 128) : 0, ke = (q0 + 384 > SEQ) ? SEQ : q0 + 384;
                const int NT = (kind == 0) ? 68 : (kind == 1) ? 4 + (ke - ks) / 64 : 4;
                const float sink = INP(F, IN_SINK)[l * 6 + h];
                const int cq = (isA ? C_QA : C_QC) + h * 128, ck = (isA ? C_KA : C_KC) + kv * 128, cv = (isA ? C_VA : C_VC) + kv * 128, co = (isA ? O_A : O_C) + h * 128;
                at::attn_body(P + rq * INW + cq, P + r0 * INW + ck, P + r0 * INW + cv, O + rq * DM + co, NT, ks, q0, isA ? sink / at::SCALE : -1e30f, isA ? 1.f : 0.f, kind == 1, F.ldsg,
                              (float*)(F.ws + WS_SSQ) + rq * 16 + (isA ? h : 10 + h));
                continue; }
            u -= nC + nA + nCc + nAc;
            { const int ch = u >> 1, g = kv * 2 + (u & 1);
              if (!ctx && ch < 2) continue;
              mixer_b_unit(F, l, b, ch, g); }
        }
    }
    if (CONV_IDLE && (CONV_HOOKS & 1)) {
        __syncthreads();
        if (tid == 0) (void)xb_add(F.ctl + CW_MIXDONE + 64 * l, 1u);
        conv_help(F, 64, F.ctl + CW_MIXDONE + 64 * l, (unsigned)F.G);
    }
}

__device__ __forceinline__ void phase_groupnorm(Frame& F, int l) {
    PHASE_IDS(F);
    bf16_t* O = (bf16_t*)(F.ws + WS_O); const float* og = INP(F, IN_OUTG) + l * DM;
#define GN_SKIP(rr) (l == 1 && ((rr) % TPB) < CTXL)
#define GN_LOAD(rr, xx) do { const bf16_t* _row = O + (size_t)(rr) * DM; \
        _Pragma("unroll") for (int i = 0; i < 3; ++i) { xx[i] = *(const u32x2*)(_row + O_A + 12 * lane + 4 * i); xx[5 + i] = *(const u32x2*)(_row + O_C + 12 * lane + 4 * i); } \
        _Pragma("unroll") for (int i = 0; i < 2; ++i) xx[3 + i] = *(const u32x2*)(_row + O_B + 8 * lane + 4 * i); } while (0)
    int r = gw; while (r < NTOK && GN_SKIP(r)) r += NGW;
    u32x2 x[8], xn[8];
    if (r < NTOK) GN_LOAD(r, x);
    while (r < NTOK) {
        int rn = r + NGW; while (rn < NTOK && GN_SKIP(rn)) rn += NGW;
        if (rn < NTOK) GN_LOAD(rn, xn);
        bf16_t* row = O + (size_t)r * DM;
        float v[8][4]; float ss[3] = {0.f, 0.f, 0.f};
#pragma unroll
        for (int i = 0; i < 8; ++i) { v[i][0] = bflo(x[i].x); v[i][1] = bfhi(x[i].x); v[i][2] = bflo(x[i].y); v[i][3] = bfhi(x[i].y);
            const int grp = (i < 3) ? 0 : (i < 5) ? 1 : 2; ss[grp] += (v[i][0] * v[i][0] + v[i][1] * v[i][1]) + (v[i][2] * v[i][2] + v[i][3] * v[i][3]); }
        float rinv[3];
        rinv[0] = rsqrt_fast(wave_sum(ss[0]) * (1.f / 768) + EPS); rinv[1] = rsqrt_fast(wave_sum(ss[1]) * (1.f / 512) + EPS); rinv[2] = rsqrt_fast(wave_sum(ss[2]) * (1.f / 768) + EPS);
#pragma unroll
        for (int i = 0; i < 8; ++i) { const int grp = (i < 3) ? 0 : (i < 5) ? 1 : 2;
            const int c = (grp == 0) ? O_A + 12 * lane + 4 * i : (grp == 1) ? O_B + 8 * lane + 4 * (i - 3) : O_C + 12 * lane + 4 * (i - 5);
            const f32x4 gg = *(const f32x4*)(og + c); const float ri = rinv[grp];
            u32x2 w; w.x = pk2(v[i][0] * ri * gg.x, v[i][1] * ri * gg.y); w.y = pk2(v[i][2] * ri * gg.z, v[i][3] * ri * gg.w); *(u32x2*)(row + c) = w; }
#pragma unroll
        for (int i = 0; i < 8; ++i) x[i] = xn[i];
        r = rn;
    }
#undef GN_SKIP
#undef GN_LOAD
}

__device__ __forceinline__ float row16_max(float v) {
    v = fmaxf(v, __builtin_bit_cast(float, __builtin_amdgcn_update_dpp(0, __builtin_bit_cast(int, v), 0xB1, 0xF, 0xF, true)));
    v = fmaxf(v, __builtin_bit_cast(float, __builtin_amdgcn_update_dpp(0, __builtin_bit_cast(int, v), 0x4E, 0xF, 0xF, true)));
    v = fmaxf(v, __builtin_bit_cast(float, __builtin_amdgcn_update_dpp(0, __builtin_bit_cast(int, v), 0x141, 0xF, 0xF, true)));
    v = fmaxf(v, __builtin_bit_cast(float, __builtin_amdgcn_update_dpp(0, __builtin_bit_cast(int, v), 0x140, 0xF, 0xF, true)));
    return v;
}
__device__ __forceinline__ void phase_rowpass2(Frame& F, int l) {
    PHASE_IDS(F);
    const float* xb = (const float*)(F.ws + WS_XB); const float* parts = (const float*)(F.ws + WS_PART);
    const bool f8 = (l == 0) ? (FP8_L0 != 0) : (FP8_L1 != 0);
    { const u32x4* wf = (const u32x4*)((const bf16_t*)(F.ws + WS_WRS) + (size_t)l * 64 * 2 * 64 * 8) + tid; u32x4 t[16];
#pragma unroll
      for (int i = 0; i < 16; ++i) t[i] = wf[512 * i];
#pragma unroll
      for (int i = 0; i < 16; ++i) ((LAS u32x4*)F.lds)[tid + 512 * i] = t[i]; }
    LAS f32x4* red = (LAS f32x4*)(F.lds + LDSCTL_OFF + 2048);
    __syncthreads();
    const int i16 = lane & 15, q = lane >> 4;
#define RP2_SKIP(tl) (l == 1 && ((tl) * 16) % TPB < CTXL)
#define RP2_LOAD(tl, xx, pp0, pp1) do { const int _row = (tl) * 16 + i16; const float* _xr = xb + (size_t)_row * DM + 256 * wave + 8 * q; \
        _Pragma("unroll") for (int sidx = 0; sidx < 8; ++sidx) { xx[sidx][0] = *(const f32x4*)(_xr + 32 * sidx); xx[sidx][1] = *(const f32x4*)(_xr + 32 * sidx + 4); } \
        pp0 = *(const f32x4*)(parts + (size_t)_row * 32 + 8 * q); pp1 = *(const f32x4*)(parts + (size_t)_row * 32 + 8 * q + 4); } while (0)
    int tile = blockIdx.x; while (tile < NTOK / 16 && RP2_SKIP(tile)) tile += F.G;
    f32x4 x[8][2], xn[8][2], p0, p1, p0n, p1n;
    if (tile < NTOK / 16) RP2_LOAD(tile, x, p0, p1);
    while (tile < NTOK / 16) {
        int ntile = tile + F.G; while (ntile < NTOK / 16 && RP2_SKIP(ntile)) ntile += F.G;
        if (ntile < NTOK / 16) RP2_LOAD(ntile, xn, p0n, p1n);
        const int r0 = tile * 16, b = r0 / TPB, t0 = r0 % TPB, sv = (t0 < CTXL) ? 4 : b;
        const int row = r0 + i16;
        float ss = ((p0.x + p0.y) + (p0.z + p0.w)) + ((p1.x + p1.y) + (p1.z + p1.w));
        ss += __builtin_bit_cast(float, __builtin_amdgcn_ds_swizzle(__builtin_bit_cast(int, ss), 0x401F));
        { auto rr = __builtin_amdgcn_permlane32_swap(__float_as_uint(ss), __float_as_uint(ss), false, false); ss = __uint_as_float(rr[0]) + __uint_as_float(rr[1]); }
        const float rinv = rsqrt_fast(ss * (1.f / DM) + EPS);
        const float* gs = (const float*)(F.ws + WS_GS2) + ((size_t)(l * 5 + sv) * DM + 256 * wave + 8 * q) * 2;
        f32x4 acc = (f32x4){0.f, 0.f, 0.f, 0.f};
#pragma unroll
        for (int sidx = 0; sidx < 8; ++sidx) {
            const f32x4 g0 = *(const f32x4*)(gs + 64 * sidx), g1 = *(const f32x4*)(gs + 64 * sidx + 4), g2 = *(const f32x4*)(gs + 64 * sidx + 8), g3 = *(const f32x4*)(gs + 64 * sidx + 12);
            float h[8];
            h[0] = x[sidx][0].x * rinv * g0.x + g0.y; h[1] = x[sidx][0].y * rinv * g0.z + g0.w; h[2] = x[sidx][0].z * rinv * g1.x + g1.y; h[3] = x[sidx][0].w * rinv * g1.z + g1.w;
            h[4] = x[sidx][1].x * rinv * g2.x + g2.y; h[5] = x[sidx][1].y * rinv * g2.z + g2.w; h[6] = x[sidx][1].z * rinv * g3.x + g3.y; h[7] = x[sidx][1].w * rinv * g3.z + g3.w;
            const int col = 256 * wave + 32 * sidx + 8 * q;
            if (f8) { u32x2 w8; w8.x = pk4_fp8(h[0], h[1], h[2], h[3]); w8.y = pk4_fp8(h[4], h[5], h[6], h[7]); *(u32x2*)((unsigned char*)(F.ws + WS_HN8) + (size_t)row * DM + col) = w8; }
            else { u32x4 w16; w16.x = pk2(h[0], h[1]); w16.y = pk2(h[2], h[3]); w16.z = pk2(h[4], h[5]); w16.w = pk2(h[6], h[7]); *(u32x4*)((bf16_t*)(F.ws + WS_HN) + (size_t)row * DM + col) = w16; }
            unsigned hh[8], hl[8];
#pragma unroll
            for (int j = 0; j < 8; ++j) { hh[j] = f2bf(h[j]); hl[j] = f2bf(h[j] - __builtin_bit_cast(float, hh[j] << 16)); }
            u32x4 ah, al; ah.x = hh[0] | (hh[1] << 16); ah.y = hh[2] | (hh[3] << 16); ah.z = hh[4] | (hh[5] << 16); ah.w = hh[6] | (hh[7] << 16);
            al.x = hl[0] | (hl[1] << 16); al.y = hl[2] | (hl[3] << 16); al.z = hl[4] | (hl[5] << 16); al.w = hl[6] | (hl[7] << 16);
            const LAS unsigned char* bp = F.lds + (size_t)((wave * 8 + sidx) * 2) * 1024 + lane * 16;
            const bf16x8 bh = *(const LAS bf16x8*)bp, bl = *(const LAS bf16x8*)(bp + 1024);
            const bf16x8 fah = __builtin_bit_cast(bf16x8, ah), fal = __builtin_bit_cast(bf16x8, al);
            acc = __builtin_amdgcn_mfma_f32_16x16x32_bf16(fah, bh, acc, 0, 0, 0);
            acc = __builtin_amdgcn_mfma_f32_16x16x32_bf16(fah, bl, acc, 0, 0, 0);
            acc = __builtin_amdgcn_mfma_f32_16x16x32_bf16(fal, bh, acc, 0, 0, 0);
        }
        red[wave * 64 + lane] = acc;
        __syncthreads();
        if (wave == 0) {
            f32x4 lg = red[lane];
#pragma unroll
            for (int w = 1; w < 8; ++w) lg += red[w * 64 + lane];
#pragma unroll
            for (int reg = 0; reg < 4; ++reg) { const float mx = row16_max(lg[reg]); const float ex = __expf(lg[reg] - mx); const float a = ex / row16_sum(ex);
                const int t = t0 + 4 * q + reg;
                if (t < CTXL) ((float*)(F.ws + WS_AFFC))[((size_t)b * NE + i16) * CTXL + t] = a;
                else ((float*)(F.ws + WS_AFFL))[((size_t)b * NE + i16) * SEQ + (t - CTXL)] = a; }
        }
        __syncthreads();
#pragma unroll
        for (int sidx = 0; sidx < 8; ++sidx) { x[sidx][0] = xn[sidx][0]; x[sidx][1] = xn[sidx][1]; }
        p0 = p0n; p1 = p1n; tile = ntile;
    }
#undef RP2_SKIP
#undef RP2_LOAD
    __syncthreads();
}

__device__ __forceinline__ unsigned block_excl_scan(unsigned v, LAS unsigned* scr, int lane, int wave, unsigned& total) {
    unsigned inc = v;
#pragma unroll
    for (int o = 1; o < 64; o <<= 1) { const unsigned t = __shfl_up(inc, o); if (lane >= o) inc += t; }
    if (lane == 63) scr[wave] = inc;
    __syncthreads();
    unsigned base = 0, tot = 0;
#pragma unroll
    for (int w = 0; w < 8; ++w) { const unsigned x = scr[w]; base += (w < wave) ? x : 0u; tot += x; }
    __syncthreads();
    total = tot;
    return base + inc - v;
}
__device__ __forceinline__ void phase_topk(Frame& F, int l) {
    PHASE_IDS(F);
    LAS unsigned* hist = (LAS unsigned*)F.lds;
    LAS unsigned* scr = (LAS unsigned*)(F.lds + 8192);
    LAS int* rowsrc = (LAS int*)(F.lds + 8192 + 128);
    const int nunits = (l == 0) ? 128 : 64;
    const bool f8 = (l == 0) ? (FP8_L0 != 0) : (FP8_L1 != 0); const int RBg = f8 ? DM : 2 * DM;
    for (int u = blockIdx.x; u < nunits; u += F.G) {
        const bool isc = u >= 64; const int uu = isc ? u - 64 : u, b = uu / NE, e = uu % NE;
        const int N = isc ? CTXL : SEQ; const unsigned cap = isc ? CAP_C : CAP_L;
        const float* src = isc ? (const float*)(F.ws + WS_AFFC) + (size_t)uu * CTXL : (const float*)(F.ws + WS_AFFL) + (size_t)uu * SEQ;
        int* pos = isc ? (int*)(F.ws + WS_POSC) + (size_t)uu * CTXL : (int*)(F.ws + WS_POSL) + (size_t)uu * SEQ;
        const bool own = tid * 8 < N;
        unsigned key[8];
        { u32x4 k0 = (u32x4){0u, 0u, 0u, 0u}, k1 = k0; if (own) { k0 = *(const u32x4*)(src + tid * 8); k1 = *(const u32x4*)(src + tid * 8 + 4); }
          key[0] = k0.x; key[1] = k0.y; key[2] = k0.z; key[3] = k0.w; key[4] = k1.x; key[5] = k1.y; key[6] = k1.z; key[7] = k1.w; }
        unsigned prefix = 0u, remaining = cap;
#pragma unroll
        for (int p = 0; p < 3; ++p) {
            const int shift = (p == 0) ? 21 : (p == 1) ? 10 : 0, bits = (p == 2) ? 10 : 11, nb = 1 << bits;
            for (int i = tid; i < nb; i += 512) hist[i] = 0u;
            __syncthreads();
            if (own) {
#pragma unroll
                for (int q = 0; q < 8; ++q) { const bool cand = (p == 0) ? true : ((key[q] >> (shift + bits)) == prefix);
                    if (cand) (void)__hip_atomic_fetch_add(&hist[(key[q] >> shift) & (nb - 1)], 1u, __ATOMIC_RELAXED, __HIP_MEMORY_SCOPE_WORKGROUP); } }
            __syncthreads();
            unsigned c[4];
#pragma unroll
            for (int q = 0; q < 4; ++q) c[q] = (4 * tid + q < nb) ? hist[4 * tid + q] : 0u;
            const unsigned sm = (c[0] + c[1]) + (c[2] + c[3]);
            unsigned total; const unsigned ex = block_excl_scan(sm, scr, lane, wave, total);
            unsigned above = total - (ex + sm);
#pragma unroll
            for (int q = 3; q >= 0; --q) { if (above < remaining && remaining <= above + c[q]) { scr[16] = (unsigned)(4 * tid + q); scr[17] = above; } above += c[q]; }
            __syncthreads();
            const unsigned B = scr[16], ca = scr[17];
            remaining -= ca; prefix = (prefix << bits) | B;
            __syncthreads();
        }
        const unsigned T = prefix;
        unsigned ce = 0u;
#pragma unroll
        for (int q = 0; q < 8; ++q) ce += (own && key[q] == T) ? 1u : 0u;
        unsigned tot; unsigned er = block_excl_scan(ce, scr, lane, wave, tot);
        bool sel[8]; unsigned cs = 0u;
#pragma unroll
        for (int q = 0; q < 8; ++q) { const bool eq = own && key[q] == T; sel[q] = own && (key[q] > T || (eq && er < remaining)); er += eq ? 1u : 0u; cs += sel[q] ? 1u : 0u; }
        unsigned sl = block_excl_scan(cs, scr, lane, wave, tot);
        const int slotbase = e * ROWS_E + (isc ? 2048 + b * CAP_C : b * CAP_L);
        int pv[8];
#pragma unroll
        for (int q = 0; q < 8; ++q) { pv[q] = sel[q] ? (int)sl : -1;
            if (sel[q]) { rowsrc[sl] = b * TPB + (isc ? 0 : CTXL) + tid * 8 + q; ((float*)(F.ws + WS_GATE))[slotbase + sl] = __uint_as_float(key[q]); ++sl; } }
        if (own) { *(i32x4*)(pos + tid * 8) = (i32x4){pv[0], pv[1], pv[2], pv[3]}; *(i32x4*)(pos + tid * 8 + 4) = (i32x4){pv[4], pv[5], pv[6], pv[7]}; }
        __syncthreads();
        unsigned* offs = (unsigned*)(F.ws + WS_OFFS);
        int R[2], C[2];
#pragma unroll
        for (int i = 0; i < 2; ++i) pg8::stage_rc(tid * 16 + i * 8192, R[i], C[i]);
        if (!isc) {
#pragma unroll
            for (int th = 0; th < 2; ++th) { u32x4 o;
                o.x = (unsigned)rowsrc[th * 256 + R[0]] * RBg + 2 * C[0]; o.y = (unsigned)rowsrc[th * 256 + R[1]] * RBg + 2 * C[1];
                o.z = (unsigned)rowsrc[th * 256 + 128 + R[0]] * RBg + 2 * C[0]; o.w = (unsigned)rowsrc[th * 256 + 128 + R[1]] * RBg + 2 * C[1];
                *(u32x4*)(offs + ((size_t)(e * 9 + 2 * b + th) * 512 + tid) * 4) = o; }
        } else {
            unsigned* o = offs + ((size_t)(e * 9 + 8) * 512 + tid) * 4;
#pragma unroll
            for (int i = 0; i < 2; ++i) { if (R[i] >= 32 * b && R[i] < 32 * b + 32) o[i] = (unsigned)rowsrc[R[i] - 32 * b] * RBg + 2 * C[i]; if (b == 0) o[2 + i] = 2 * C[i]; }
        }
        __syncthreads();
    }
}

__device__ __forceinline__ void phase_combine(Frame& F, int l) {
    PHASE_IDS(F);
    const float* mod = (const float*)(F.ws + WS_MOD);
    float* xb = (float*)(F.ws + WS_XB); const bf16_t* Y = (const bf16_t*)(F.ws + WS_XG);
    const bool y8 = (l == 0) ? (FP8_L0 != 0) : (FP8_L1 != 0);
    for (int r = gw; r < NTOK; r += NGW) {
        const int b = r / TPB, t = r % TPB, s = (t < CTXL) ? 4 : b;
        if (l == 1 && t < CTXL) continue;
        int p = -1;
        if (lane < NE) p = (t < CTXL) ? ((const int*)(F.ws + WS_POSC))[((size_t)b * NE + lane) * CTXL + t] : ((const int*)(F.ws + WS_POSL))[((size_t)b * NE + lane) * SEQ + (t - CTXL)];
        float gt = 0.f;
        if (p >= 0) gt = ((const float*)(F.ws + WS_GATE))[lane * ROWS_E + ((t < CTXL) ? 2048 + b * CAP_C : b * CAP_L) + p];
        f32x4 v[8]; load_row(xb + (size_t)r * DM, lane, v);
        const float* g2 = mod + (size_t)(l * 5 + s) * NMOD + 5 * DM;
        f32x4 gv[8];
#pragma unroll
        for (int j = 0; j < 8; ++j) gv[j] = *(const f32x4*)(g2 + 4 * lane + 256 * j);
        f32x4 a[8];
#pragma unroll
        for (int j = 0; j < 8; ++j) a[j] = (f32x4){0.f, 0.f, 0.f, 0.f};
        unsigned long long m = __ballot(p >= 0);
        const int ybase = (t < CTXL) ? 2048 + b * CAP_C : b * CAP_L;
        while (m) {
            const int e0 = __builtin_ctzll(m); m &= m - 1;
            const bool two = (m != 0ull); const int e1 = two ? __builtin_ctzll(m) : e0; if (two) m &= m - 1;
            const int p0 = __builtin_amdgcn_readlane(p, e0), p1 = __builtin_amdgcn_readlane(p, e1);
            const float q0 = __builtin_bit_cast(float, __builtin_amdgcn_readlane(__builtin_bit_cast(int, gt), e0)), q1 = __builtin_bit_cast(float, __builtin_amdgcn_readlane(__builtin_bit_cast(int, gt), e1));
            if (y8) {
                const unsigned char* y0 = (const unsigned char*)Y + (size_t)(e0 * ROWS_E + ybase + p0) * DM + 4 * lane; const unsigned char* y1 = (const unsigned char*)Y + (size_t)(e1 * ROWS_E + ybase + p1) * DM + 4 * lane;
                unsigned w0[8], w1[8];
#pragma unroll
                for (int j = 0; j < 8; ++j) w0[j] = *(const unsigned*)(y0 + 256 * j);
                if (two) {
#pragma unroll
                    for (int j = 0; j < 8; ++j) w1[j] = *(const unsigned*)(y1 + 256 * j); }
#pragma unroll
                for (int j = 0; j < 8; ++j) { const f32x2 lo = __builtin_amdgcn_cvt_pk_f32_fp8((int)w0[j], false), hi = __builtin_amdgcn_cvt_pk_f32_fp8((int)w0[j], true); a[j] += (f32x4){lo.x, lo.y, hi.x, hi.y} * q0; }
                if (two) {
#pragma unroll
                    for (int j = 0; j < 8; ++j) { const f32x2 lo = __builtin_amdgcn_cvt_pk_f32_fp8((int)w1[j], false), hi = __builtin_amdgcn_cvt_pk_f32_fp8((int)w1[j], true); a[j] += (f32x4){lo.x, lo.y, hi.x, hi.y} * q1; } }
            } else {
            const bf16_t* y0 = Y + (size_t)(e0 * ROWS_E + ybase + p0) * DM + 4 * lane; const bf16_t* y1 = Y + (size_t)(e1 * ROWS_E + ybase + p1) * DM + 4 * lane;
            u32x2 w0[8], w1[8];
#pragma unroll
            for (int j = 0; j < 8; ++j) w0[j] = *(const u32x2*)(y0 + 256 * j);
            if (two) {
#pragma unroll
                for (int j = 0; j < 8; ++j) w1[j] = *(const u32x2*)(y1 + 256 * j); }
#pragma unroll
            for (int j = 0; j < 8; ++j) a[j] += (f32x4){bflo(w0[j].x), bfhi(w0[j].x), bflo(w0[j].y), bfhi(w0[j].y)} * q0;
            if (two) {
#pragma unroll
                for (int j = 0; j < 8; ++j) a[j] += (f32x4){bflo(w1[j].x), bfhi(w1[j].x), bflo(w1[j].y), bfhi(w1[j].y)} * q1; }
            }
        }
#pragma unroll
        for (int j = 0; j < 8; ++j) v[j] += gv[j] * a[j];
        if (l == 0) {
#pragma unroll
            for (int j = 0; j < 8; ++j) *(f32x4*)(xb + (size_t)r * DM + 4 * lane + 256 * j) = v[j];
            const float* m1 = mod + (size_t)(5 + s) * NMOD;
            norm_mod_store(v, INP(F, IN_N1G) + DM, m1, m1 + DM, (bf16_t*)(F.ws + WS_HN) + (size_t)r * DM, lane);
        } else {
            float* op = F.out + ((size_t)b * SEQ + (t - CTXL)) * DM;
#pragma unroll
            for (int j = 0; j < 8; ++j) *(f32x4*)(op + 4 * lane + 256 * j) = v[j];
        }
    }
}

__device__ __forceinline__ void phase_dump_x(Frame& F, bool from_input) {
    PHASE_IDS(F);
    const float* xb = (const float*)(F.ws + WS_XB);
    for (int r = gw; r < NTOK; r += NGW) {
        const int b = r / TPB, t = r % TPB; if (t < CTXL) continue;
        const float* src = from_input ? INP(F, IN_X) + ((size_t)b * SEQ + (t - CTXL)) * DM : xb + (size_t)r * DM;
        f32x4 v[8]; load_row(src, lane, v);
        float* op = F.out + ((size_t)b * SEQ + (t - CTXL)) * DM;
#pragma unroll
        for (int j = 0; j < 8; ++j) *(f32x4*)(op + 4 * lane + 256 * j) = v[j];
    }
}

constexpr int N_PHASES = 2 + 11 * NLAYER;
__global__ void __launch_bounds__(512, 2) fwd_kernel(Args args) {
    extern __shared__ __attribute__((aligned(16))) unsigned char lds[];
    Frame F;
    F.lds = (LAS unsigned char*)lds; F.ldsg = (char*)lds;
    F.MISC = (volatile LAS unsigned*)(F.lds + MISC_OFF);
    F.G = gridDim.x;
    F.out = args.out; F.ws = args.ws; F.ctl = (unsigned*)(args.ws + WS_CTL);
    for (int u = threadIdx.x; u < (LDS_BYTES - LDSCTL_OFF) / 4; u += 512) ((LAS unsigned*)(F.lds + LDSCTL_OFF))[u] = 0u;
    __syncthreads();
    if (threadIdx.x < 23) { const unsigned long long pv = (unsigned long long)args.in[threadIdx.x]; LAS unsigned* t = (LAS unsigned*)(F.lds + ARGTAB_OFF) + 2 * threadIdx.x; t[0] = (unsigned)pv; t[1] = (unsigned)(pv >> 32); }
    __syncthreads();
    XcdBarrier bar; bar.bar = F.ctl + CW_BAR; bar.x = 0; bar.st = nullptr;
    if (!MK_PER_PHASE) bar = xcd_barrier_post(F.ctl + CW_BAR, F.MISC + 8);
    const int lo = args.ph_lo, hi = args.ph_hi;
#define IN(k) (lo <= (k) && (k) < hi)
    unsigned long long probe_t0 = 0ull, probe_acc = 0ull;
#define PROBE_BEGIN(k) do { if (PROBE_MASK & (1u << (k))) probe_t0 = __builtin_amdgcn_s_memrealtime(); } while (0)
#define SEAM(k) do { if (IN(k) && IN((k) + 1)) xcd_barrier(bar); if (PROBE_MASK & (1u << (k))) probe_acc += __builtin_amdgcn_s_memrealtime() - probe_t0; } while (0)

    if (IN(0)) { PROBE_BEGIN(0); if (PH_ON(0)) phase_prologue(F); if (IN(1)) xcd_barrier_first(bar); if (PROBE_MASK & 1u) probe_acc += __builtin_amdgcn_s_memrealtime() - probe_t0; }
    if (IN(1)) { PROBE_BEGIN(1); if (PH_ON(1)) phase_rowpass1_l0(F); SEAM(1); }
    for (int l = 0; l < NLAYER; ++l) {
        const int pb = 2 + 11 * l;
        const bool ctx = (l == 0);
        if (IN(pb + 0)) { PROBE_BEGIN(pb + 0); if (PH_ON(2)) {
            pg8::SchedDense S; S.init(F.ws + WS_HN, F.ws + WS_WIN + (size_t)l * INW * DM * 2, NTOK / 256, INW / 256, F.G, (int)blockIdx.x, 0);
            pg8::EpiPost E{(bf16_t*)(F.ws + WS_P), (const float*)(F.ws + WS_ROPE), INP(F, IN_QNA) + l * 128, INP(F, IN_KNA) + l * 128, INP(F, IN_QNC) + l * 128, INP(F, IN_KNC) + l * 128, INP(F, IN_VNB) + l * 512, F.lds + LDSCTL_OFF + 2048};
            pg8::gemm_phase<pg8::EpiPost, pg8::SchedDense>(F.lds, S, E);
            if ((CONV_HOOKS & 2) && (int)blockIdx.x >= (NTOK / 256) * (INW / 256) - 3 * F.G) conv_help(F, 10, nullptr, 0u); }
            SEAM(pb + 0); }
        if (IN(pb + 2)) { PROBE_BEGIN(pb + 2); if (PH_ON(4)) phase_mixers(F, l); SEAM(pb + 2); }
        if (IN(pb + 4)) { PROBE_BEGIN(pb + 4); if (PH_ON(6)) {
            pg8::SchedDense S; S.init(F.ws + WS_O, F.ws + WS_WOUT + (size_t)l * DM * DM * 2, ctx ? NTOK / 256 : 64, DM / 256, F.G, (int)blockIdx.x, ctx ? 0 : 1);
            float* xb = (float*)(F.ws + WS_XB);
            pg8::EpiResid E;
            if (l == 0) { E.ctxbase = INP(F, IN_CTX); E.latbase = INP(F, IN_X); E.cbs = CTXL; E.lbs = SEQ; }
            else { E.ctxbase = xb; E.latbase = xb + (size_t)CTXL * DM; E.cbs = TPB; E.lbs = TPB; }
            E.xout = xb; E.modl = (const float*)(F.ws + WS_MOD) + (size_t)l * 5 * NMOD; E.parts = (float*)(F.ws + WS_PART); E.ktab = F.lds + LDSCTL_OFF + 2048;
            { const float* ssq = (const float*)(F.ws + WS_SSQ); LAS f32x4* kt = (LAS f32x4*)(F.lds + LDSCTL_OFF + 2048); const int tz = opaque_tid();
              for (int i = 0; i < 3; ++i) { pg8::Unit uu; if (!S.next(i, uu)) break;
                  if (tz < 256) { const f32x4* sp = (const f32x4*)(ssq + (size_t)(uu.rowbase + tz) * 16); const f32x4 s0 = sp[0], s1 = sp[1], s2 = sp[2], s3 = sp[3];
                      const float qa = ((s0.x + s0.y) + (s0.z + s0.w)) + (s1.x + s1.y), qb = (s1.z + s1.w) + (s2.x + s2.y), qc = ((s2.z + s2.w) + (s3.x + s3.y)) + (s3.z + s3.w);
                      const float ra = rsqrt_fast(qa * (1.f / 768) + EPS), rb = rsqrt_fast(qb * (1.f / 512) + EPS), rc = rsqrt_fast(qc * (1.f / 768) + EPS);
                      kt[i * 256 + tz] = (f32x4){ra / rb, rb / rc, rc, 0.f}; } }
              __syncthreads(); }
            pg8::gemm_phase<pg8::EpiResid, pg8::SchedDense, false, false, true>(F.lds, S, E, nullptr, F.lds + LDSCTL_OFF + 2048);
            if ((CONV_HOOKS & 4) && ctx && (int)blockIdx.x >= (NTOK / 256) * (DM / 256) - 2 * F.G) conv_help(F, 9, nullptr, 0u); }
            SEAM(pb + 4); }
        if (IN(pb + 5)) { PROBE_BEGIN(pb + 5); if (PH_ON(7)) phase_rowpass2(F, l); SEAM(pb + 5); }
        if (IN(pb + 6)) { PROBE_BEGIN(pb + 6); if (PH_ON(8)) { phase_topk(F, l);
            if (l == 0) { if ((CONV_HOOKS & 8) && (int)blockIdx.x >= 128) conv_help(F, 2, nullptr, 0u); } else conv_help(F, 1 << 20, nullptr, 0u); }
            SEAM(pb + 6); }
        if (IN(pb + 8)) { PROBE_BEGIN(pb + 8); if (PH_ON(10)) {
            if ((l == 0) ? (FP8_L0 != 0) : (FP8_L1 != 0)) {
                pg8::SchedGrouped<pg8::GK> S; S.init(F.ws + WS_HN8, F.ws + WS_WGU + (size_t)l * NE * 4096 * DM * 2, ctx ? 9 : 8, 16, F.G, (int)blockIdx.x);
                pg8::EpiSwiGLU8 E{(unsigned char*)(F.ws + WS_H)};
                pg8::gemm_phase<pg8::EpiSwiGLU8, pg8::SchedGrouped<pg8::GK>, true, true>(F.lds, S, E, (const unsigned*)(F.ws + WS_OFFS), F.lds + LDSCTL_OFF + 2048);
            } else {
                pg8::SchedGrouped<2 * pg8::GK> S; S.init(F.ws + WS_HN, F.ws + WS_WGU + (size_t)l * NE * 4096 * DM * 2, ctx ? 9 : 8, 16, F.G, (int)blockIdx.x);
                pg8::EpiSwiGLU E{(bf16_t*)(F.ws + WS_H)};
                pg8::gemm_phase<pg8::EpiSwiGLU, pg8::SchedGrouped<2 * pg8::GK>, false, true>(F.lds, S, E, (const unsigned*)(F.ws + WS_OFFS), F.lds + LDSCTL_OFF + 2048);
            } }
            SEAM(pb + 8); }
        if (IN(pb + 9)) { PROBE_BEGIN(pb + 9); if (PH_ON(11)) {
            pg8::EpiStoreBf16 E{(bf16_t*)(F.ws + WS_XG), DM};
            if ((l == 0) ? (FP8_L0 != 0) : (FP8_L1 != 0)) {
                pg8::SchedGrouped<pg8::GK> S; S.init(F.ws + WS_H, F.ws + WS_WD + (size_t)l * NE * DM * DM * 2, ctx ? 9 : 8, 8, F.G, (int)blockIdx.x);
                pg8::EpiStoreFp8 E8{(unsigned char*)(F.ws + WS_XG), DM};
                pg8::gemm_phase<pg8::EpiStoreFp8, pg8::SchedGrouped<pg8::GK>, true>(F.lds, S, E8);
                if ((CONV_HOOKS & 16) && ctx && (((int)blockIdx.x >> 3) & 31) >= 16) conv_help(F, 3, nullptr, 0u);
            } else {
                pg8::SchedGrouped<2 * pg8::GK> S; S.init(F.ws + WS_H, F.ws + WS_WD + (size_t)l * NE * DM * DM * 2, ctx ? 9 : 8, 8, F.G, (int)blockIdx.x);
                pg8::gemm_phase<pg8::EpiStoreBf16, pg8::SchedGrouped<2 * pg8::GK>, false>(F.lds, S, E);
            } }
            SEAM(pb + 9); }
        if (IN(pb + 10)) { PROBE_BEGIN(pb + 10); if (PH_ON(12)) phase_combine(F, l); if (l + 1 < NLAYER) SEAM(pb + 10); else if (PROBE_MASK & (1u << (pb + 10))) probe_acc += __builtin_amdgcn_s_memrealtime() - probe_t0; }
    }
    if (PROBE_MASK) { const unsigned long long te = __builtin_amdgcn_s_memrealtime(); while (__builtin_amdgcn_s_memrealtime() - te < probe_acc) __builtin_amdgcn_s_sleep(8); }
#undef IN
#undef SEAM
}

extern "C" void kernel_launch(void* const* d_in, const int* in_sizes, int n_in, void* d_out, int out_size, void* d_ws, size_t ws_size, hipStream_t stream) {
    static int grid = 0;
    if (grid == 0) {
        if (n_in != 23 || out_size != NB * SEQ * DM || ws_size < WS_END) { fprintf(stderr, "kernel_launch: shape mismatch: n_in %d out %d ws %zu (need %zu)\n", n_in, out_size, ws_size, (size_t)WS_END); grid = -1; return; }
        int dev = 0, cus = 0, per_cu = 0;
        if (hipGetDevice(&dev) != hipSuccess || hipDeviceGetAttribute(&cus, hipDeviceAttributeMultiprocessorCount, dev) != hipSuccess) { grid = -1; return; }
        if (hipFuncSetAttribute((const void*)fwd_kernel, hipFuncAttributeMaxDynamicSharedMemorySize, LDS_BYTES) != hipSuccess) { fprintf(stderr, "kernel_launch: hipFuncSetAttribute failed\n"); grid = -1; return; }
        if (hipOccupancyMaxActiveBlocksPerMultiprocessor(&per_cu, (const void*)fwd_kernel, 512, LDS_BYTES) != hipSuccess || per_cu < 1) { fprintf(stderr, "kernel_launch: occupancy query says %d\n", per_cu); }
        (void)hipGetLastError();
        grid = cus;
    }
    if (grid < 0) return;
    if (hipMemsetAsync((char*)d_ws + WS_CTL, 0, CTL_ZERO_BYTES, stream) != hipSuccess) return;
    Args a{};
    for (int i = 0; i < 23; ++i) a.in[i] = (const float*)d_in[i];
    a.out = (float*)d_out; a.ws = (unsigned char*)d_ws;
#if MK_PER_PHASE
    for (int p = 0; p < N_PHASES; ++p) { a.ph_lo = p; a.ph_hi = p + 1; hipLaunchKernelGGL(fwd_kernel, dim3(grid), dim3(512), LDS_BYTES, stream, a); }
#else
    a.ph_lo = 0; a.ph_hi = N_PHASES;
    hipLaunchKernelGGL(fwd_kernel, dim3(grid), dim3(512), LDS_BYTES, stream, a);
#endif
    const hipError_t le = hipPeekAtLastError();
    if (le != hipSuccess) fprintf(stderr, "kernel_launch: launch failed: %s\n", hipGetErrorName(le));
}
```

```cpp
#include <hip/hip_runtime.h>
#include <cstdio>
#include <cstdint>

#define LAS __attribute__((address_space(3)))
#define GAS __attribute__((address_space(1)))
typedef unsigned short bf16_t;
typedef short bf16x8 __attribute__((ext_vector_type(8)));
typedef short s16x4 __attribute__((ext_vector_type(4)));
typedef float f32x2 __attribute__((ext_vector_type(2)));
typedef float f32x4 __attribute__((ext_vector_type(4)));
typedef float f32x16 __attribute__((ext_vector_type(16)));
typedef unsigned u32x2 __attribute__((ext_vector_type(2)));
typedef unsigned u32x4 __attribute__((ext_vector_type(4)));
typedef int i32x4 __attribute__((ext_vector_type(4)));
typedef int i32x8 __attribute__((ext_vector_type(8)));

#ifndef MK_PER_PHASE
#define MK_PER_PHASE 0
#endif
#ifndef PHASE_MASK
#define PHASE_MASK 0x1fff
#endif
#define PH_ON(k) (((PHASE_MASK) >> (k)) & 1)
#ifndef FP8_L0
#define FP8_L0 1
#endif
#ifndef FP8_L1
#define FP8_L1 1
#endif
#ifndef PROBE_MASK
#define PROBE_MASK 0u
#endif
#ifndef DBG_STOP
#define DBG_STOP 0
#endif

constexpr int DM = 2048, NB = 4, SEQ = 4096, CTXL = 256, TPB = SEQ + CTXL, NTOK = NB * TPB;
constexpr int INW = 3584, NE = 16, NLAYER = 2, NMOD = 6 * DM;
constexpr int C_QA = 0, C_KA = 768, C_VA = 1024, C_UB = 1280, C_VB = 1792, C_QC = 2304, C_KC = 3072, C_VC = 3328;
constexpr int O_A = 0, O_B = 768, O_C = 1280;
constexpr int CAP_L = 512, CAP_C = 32, ROWS_E = 2304;
constexpr float EPS = 1e-6f;

constexpr size_t MiB = 1u << 20;
constexpr size_t WS_CTL = 0, CTL_ZERO_BYTES = 65536;
constexpr size_t WS_MOD = 1 * MiB;
constexpr size_t WS_ROPE = 2 * MiB;
constexpr size_t WS_AFFL = 3 * MiB;
constexpr size_t WS_AFFC = 4 * MiB;
constexpr size_t WS_POSL = 5 * MiB;
constexpr size_t WS_POSC = 6 * MiB;
constexpr size_t WS_OFFS = 10 * MiB;
constexpr size_t WS_GATE = 8 * MiB;
constexpr size_t WS_WRT = 9 * MiB;
constexpr size_t WS_WRS = 11 * MiB;
constexpr size_t WS_GS2 = 12 * MiB;
constexpr size_t WS_PART = 13 * MiB + 0;
constexpr size_t WS_SSQ = 14 * MiB;
constexpr size_t WS_WIN = 16 * MiB;
constexpr size_t WS_WOUT = WS_WIN + (size_t)2 * INW * DM * 2;
constexpr size_t WS_WGU = WS_WOUT + (size_t)2 * DM * DM * 2;
constexpr size_t WS_WD = WS_WGU + (size_t)2 * NE * 4096 * DM * 2;
constexpr size_t WS_HN = WS_WD + (size_t)2 * NE * DM * DM * 2;
constexpr size_t WS_P = WS_HN + (size_t)NTOK * DM * 2;
constexpr size_t WS_O = WS_P + (size_t)NTOK * INW * 2;
constexpr size_t WS_XB = WS_O + (size_t)NTOK * DM * 2;
constexpr size_t WS_XG = WS_XB + (size_t)NTOK * DM * 4;
constexpr size_t WS_H = WS_XG + (size_t)NE * ROWS_E * DM * 2;
constexpr size_t WS_HN8 = WS_H + (size_t)NE * ROWS_E * DM * 2;
constexpr size_t WS_END = WS_HN8 + (size_t)NTOK * DM;
constexpr float W8_SCALE = 32.f; constexpr int W8_SCALE_E8M0 = 127 - 5;
constexpr int CW_BAR = 4096, CW_QUEUE = 8192;
constexpr int CW_CONV = 10240, CW_MIXDONE = 10304;
constexpr int NT8_ALL = 2 * NE * 3 * 128, NT8_L0 = NT8_ALL / 2;
#ifndef CONV_HOOKS
#define CONV_HOOKS 0x1f
#endif
#ifndef CONV_IDLE
#define CONV_IDLE 1
#endif

constexpr int RING_BYTES = 131072, LDSCTL_OFF = RING_BYTES, MISC_OFF = LDSCTL_OFF + 320, LDS_BYTES = 147456;

#define LDS_WAIT() asm volatile("s_waitcnt lgkmcnt(0)" ::: "memory")
#define VM_WAIT() asm volatile("s_waitcnt vmcnt(0)" ::: "memory")
__device__ __forceinline__ unsigned f2bf(float f) { unsigned u = __builtin_bit_cast(unsigned, f); return (u + 0x7fffu + ((u >> 16) & 1u)) >> 16; }
__device__ __forceinline__ unsigned pk2(float lo, float hi) { return f2bf(lo) | (f2bf(hi) << 16); }
__device__ __forceinline__ float bf2f(unsigned short b) { return __builtin_bit_cast(float, ((unsigned)b) << 16); }
__device__ __forceinline__ float bflo(unsigned w) { return __builtin_bit_cast(float, w << 16); }
__device__ __forceinline__ float bfhi(unsigned w) { return __builtin_bit_cast(float, w & 0xffff0000u); }
__device__ __forceinline__ unsigned pk4_fp8(float a, float b, float c, float d) {
    int r = __builtin_amdgcn_cvt_pk_fp8_f32(a, b, 0, false); r = __builtin_amdgcn_cvt_pk_fp8_f32(c, d, r, true); return (unsigned)r; }
__device__ __forceinline__ int opaque_tid() { int t = threadIdx.x; asm volatile("" : "+v"(t)); return t; }
__device__ __forceinline__ float row16_sum(float v) {
    v += __builtin_bit_cast(float, __builtin_amdgcn_update_dpp(0, __builtin_bit_cast(int, v), 0xB1, 0xF, 0xF, true));
    v += __builtin_bit_cast(float, __builtin_amdgcn_update_dpp(0, __builtin_bit_cast(int, v), 0x4E, 0xF, 0xF, true));
    v += __builtin_bit_cast(float, __builtin_amdgcn_update_dpp(0, __builtin_bit_cast(int, v), 0x141, 0xF, 0xF, true));
    v += __builtin_bit_cast(float, __builtin_amdgcn_update_dpp(0, __builtin_bit_cast(int, v), 0x140, 0xF, 0xF, true));
    return v;
}
__device__ __forceinline__ float wave_sum(float v) {
    v = row16_sum(v);
    const int iv = __builtin_bit_cast(int, v);
    const float a = __builtin_bit_cast(float, __builtin_amdgcn_readlane(iv, 0)), b = __builtin_bit_cast(float, __builtin_amdgcn_readlane(iv, 16));
    const float c = __builtin_bit_cast(float, __builtin_amdgcn_readlane(iv, 32)), d = __builtin_bit_cast(float, __builtin_amdgcn_readlane(iv, 48));
    return (a + b) + (c + d);
}
__device__ __forceinline__ float rsqrt_fast(float x) { return __builtin_amdgcn_rsqf(x); }
__device__ __forceinline__ float gelu_tanh(float x) {
    const float u = 0.7978845608028654f * (x + 0.044715f * x * x * x);
    const float e = __expf(2.f * u);
    const float th = 1.f - 2.f / (e + 1.f);
    return 0.5f * x * (1.f + th);
}

#define XB_TMO      128
#define XB_XCNT(j)  (256  + 64 * (j))
#define XB_XSUB(j)  (1280 + 64 * (j))
#define XB_XGEN(j)  (2304 + 64 * (j))
#define XB_TOP      3328
#define XB_TOPGEN   3392
#define XCD_BAR_WORDS 3456
#define XB_SPIN_CAP (1u << 18)
__device__ __forceinline__ unsigned xb_ld(unsigned* p)              { return __hip_atomic_load(p, __ATOMIC_RELAXED, __HIP_MEMORY_SCOPE_AGENT); }
__device__ __forceinline__ unsigned xb_add(unsigned* p, unsigned v) { return __hip_atomic_fetch_add(p, v, __ATOMIC_RELAXED, __HIP_MEMORY_SCOPE_AGENT); }
__device__ __forceinline__ unsigned xb_xcc_id() { return (unsigned)__builtin_amdgcn_s_getreg((3 << 11) | 20) & 0xFu; }
#define XB_SPIN(cond, bar) do { unsigned _sp = 0; while (cond) { __builtin_amdgcn_s_sleep(1); \
    if ((++_sp & 255u) == 0u) { if (xb_ld(&(bar)[XB_TMO])) break; if (_sp > XB_SPIN_CAP) { atomicAdd(&(bar)[XB_TMO], 1u); break; } } } } while (0)
struct XcdBarrier { unsigned* bar; unsigned x; volatile LAS unsigned* st; };
__device__ __forceinline__ XcdBarrier xcd_barrier_post(unsigned* bar, volatile LAS unsigned* st) {
    XcdBarrier b; b.bar = bar; b.x = xb_xcc_id(); b.st = st;
    if (threadIdx.x == 0) (void)xb_add(&bar[XB_XCNT(b.x)], 1u);
    return b;
}
__device__ __forceinline__ void xcd_barrier_complete(unsigned* bar, unsigned x, unsigned& nloc, unsigned& nx) {
    const unsigned G = gridDim.x * gridDim.y * gridDim.z;
    unsigned sum, cnt, mine, sp = 0u;
    for (;;) {
        sum = 0u; cnt = 0u; mine = 0u;
#pragma unroll
        for (unsigned j = 0; j < 16; ++j) { const unsigned c = xb_ld(&bar[XB_XCNT(j)]); sum += c; cnt += (c > 0u) ? 1u : 0u; mine = (j == x) ? c : mine; }
        if (sum == G) break;
        __builtin_amdgcn_s_sleep(1);
        if ((++sp & 255u) == 0u) { if (xb_ld(&bar[XB_TMO])) break; if (sp > XB_SPIN_CAP) { atomicAdd(&bar[XB_TMO], 1u); break; } }
    }
    nloc = mine > 0u ? mine : 1u; nx = cnt > 0u ? cnt : 1u;
}
template <bool FIRST>
__device__ __forceinline__ void xcd_barrier_t(const XcdBarrier& b) {
    asm volatile("s_waitcnt vmcnt(0)" ::: "memory");
    __syncthreads();
    if (threadIdx.x == 0) {
        unsigned* bar = b.bar;
        asm volatile("" : "+s"(bar));
        __builtin_amdgcn_s_waitcnt(0);
        unsigned nloc = b.st[0], nx = b.st[1];
        if constexpr (FIRST) { if (nloc == 0u) { xcd_barrier_complete(bar, b.x, nloc, nx); b.st[0] = nloc; b.st[1] = nx; } }
        const unsigned old = xb_add(&bar[XB_XSUB(b.x)], 1u);
        const unsigned gen = old / nloc;
        if (old + 1u == (gen + 1u) * nloc) {
            __builtin_amdgcn_fence(__ATOMIC_RELEASE, "agent");
            asm volatile("s_waitcnt vmcnt(0)" ::: "memory");
            const unsigned og = xb_add(&bar[XB_TOP], 1u);
            const unsigned tg = og / nx;
            if (og + 1u == (tg + 1u) * nx) xb_add(&bar[XB_TOPGEN], 1u);
            else XB_SPIN(xb_ld(&bar[XB_TOPGEN]) == tg, bar);
            __builtin_amdgcn_fence(__ATOMIC_ACQUIRE, "agent");
            xb_add(&bar[XB_XGEN(b.x)], 1u);
            asm volatile("s_waitcnt vmcnt(0)" ::: "memory");
        } else {
            XB_SPIN(xb_ld(&bar[XB_XGEN(b.x)]) == gen, bar);
            __builtin_amdgcn_fence(__ATOMIC_ACQUIRE, "agent");
            asm volatile("s_waitcnt vmcnt(0)" ::: "memory");
        }
    }
    __syncthreads();
}
__device__ __forceinline__ void xcd_barrier(const XcdBarrier& b) { xcd_barrier_t<false>(b); }
__device__ __forceinline__ void xcd_barrier_first(const XcdBarrier& b) { xcd_barrier_t<true>(b); }

namespace pg8 {
constexpr int BM = 256, BK = 64, HALF = 128, HTB = HALF * BK * 2, STAGE_BYTES = 8 * HTB, NXCD = 8, WGM = 8;
constexpr int GK = 2048;
__host__ __device__ __forceinline__ int lds_byte(int r, int c) { const int st = (r >> 4) * 2 + (c >> 5), rr = r & 15, cc = c & 31, ob = rr * 64 + cc * 2; return st * 1024 + (ob ^ (((ob >> 9) & 1) << 5)); }
__host__ __device__ __forceinline__ void stage_rc(int b, int& R, int& C) { const int st = b / 1024, sb = b % 1024, swz = sb ^ (((sb >> 9) & 1) << 5); R = (st >> 1) * 16 + swz / 64; C = (st & 1) * 32 + (swz % 64) / 2; }
__host__ __device__ __forceinline__ int perm32(int rho) { const int n = rho >> 4, i = rho & 15; return 8 * (i >> 2) + 4 * n + (i & 3); }

struct Unit { int pm, pn, e, rowbase, colbase, oidx, slot; const char* a; const char* b; };

struct SchedDense {
    static constexpr int RB = GK * 2;
    const char* A; const char* Bt; int nM, nN, nwg, G, c, skipctx;
    __device__ void init(const void* A_, const void* Bt_, int nM_, int nN_, int G_, int c_, int skipctx_) { A = (const char*)A_; Bt = (const char*)Bt_; nM = nM_; nN = nN_; nwg = nM * nN; G = G_; c = c_; skipctx = skipctx_; }
    __device__ bool next(int i, Unit& u) const {
        const long L = (long)i * G + c; if (L >= nwg) return false;
        int wgid = (int)L; { const int q = nwg / NXCD, r = nwg % NXCD, xcd = wgid % NXCD, off = wgid / NXCD; wgid = (xcd < r ? xcd * (q + 1) : r * (q + 1) + (xcd - r) * q) + off; }
        const int nig = WGM * nN, gid = wgid / nig, fm = gid * WGM, gsz = (nM - fm) < WGM ? (nM - fm) : WGM;
        int pm = fm + ((wgid % nig) % gsz); const int pn = (wgid % nig) / gsz;
        if (skipctx) pm = (pm >> 4) * 17 + 1 + (pm & 15);
        u.pm = pm; u.pn = pn; u.e = 0; u.rowbase = pm * BM; u.colbase = pn * BM; u.oidx = 0;
        u.a = A + (size_t)pm * (BM * GK * 2); u.b = Bt + (size_t)pn * (BM * GK * 2); return true;
    }
};
template <int RB_> struct SchedGrouped {
    static constexpr int RB = RB_;
    const char* A; const char* Bt; int nMe, nNe, nwg, G, c;
    __device__ void init(const void* A_, const void* Bt_, int nMe_, int nNe_, int G_, int c_) { A = (const char*)A_; Bt = (const char*)Bt_; nMe = nMe_; nNe = nNe_; nwg = NE * nMe * nNe; G = G_; c = c_; }
    __device__ bool next(int i, Unit& u) const {
        int e, pm, pn;
        if ((G & 255) == 0) {
            const int cpe = nNe >> 2, nchunk = NE * cpe, xcd = c & 7, slot = (c >> 3) & 31, sub = c >> 8;
            const int chunk = (i * (G >> 8) + sub) * 8 + xcd;
            if (chunk < nchunk) { e = chunk / cpe; pm = slot >> 2; pn = (chunk % cpe) * 4 + (slot & 3); }
            else { const int per = (NE * nNe) >> 3;
                if (nMe < 9 || chunk >= nchunk + 8 || slot >= per) return false; const int j = (chunk - nchunk) * per + slot; e = j / nNe; pn = j % nNe; pm = 8; }
        } else { const long L = (long)i * G + c; if (L >= nwg) return false; const int per = nMe * nNe, rem = (int)L % per; e = (int)L / per; pm = rem % nMe; pn = rem / nMe; }
        u.pm = pm; u.pn = pn; u.e = e; u.rowbase = e * ROWS_E + pm * BM; u.colbase = pn * BM; u.oidx = e * 9 + pm;
        u.a = A + (size_t)(e * ROWS_E + pm * BM) * RB; u.b = Bt + ((size_t)e * nNe + pn) * (BM * RB); return true;
    }
};

__device__ __forceinline__ unsigned cvt_pk_bf16(float lo, float hi) { unsigned r; asm volatile("v_cvt_pk_bf16_f32 %0, %1, %2" : "=v"(r) : "v"(lo), "v"(hi)); return r; }

struct EpiStoreBf16 {
    static constexpr bool PERM = true;
    bf16_t* O; int ldc;
    __device__ __forceinline__ void operator()(const f32x4 (&acc)[2][2][4][2], const Unit& u, int wr, int wc, int fr, int fq) const {
        const int row0 = u.rowbase + wr * 64 + fr, col0 = u.colbase + wc * 32 + 8 * fq;
#pragma unroll
        for (int ai = 0; ai < 2; ++ai)
#pragma unroll
            for (int m = 0; m < 4; ++m) { bf16_t* rowp = O + (size_t)(row0 + ai * HALF + m * 16) * ldc + col0;
#pragma unroll
                for (int bj = 0; bj < 2; ++bj) { const f32x4 v0 = acc[ai][bj][m][0], v1 = acc[ai][bj][m][1];
                    u32x4 w; w.x = cvt_pk_bf16(v0[0], v0[1]); w.y = cvt_pk_bf16(v0[2], v0[3]); w.z = cvt_pk_bf16(v1[0], v1[1]); w.w = cvt_pk_bf16(v1[2], v1[3]);
                    *(u32x4*)(rowp + bj * HALF) = w; } }
    }
};
struct EpiPost {
    static constexpr bool PERM = true;
    bf16_t* P; const float* rope; const float* qna; const float* kna; const float* qnc; const float* knc; const float* vnb; LAS unsigned char* tab;
    __device__ __forceinline__ void operator()(f32x4 (&acc)[2][2][4][2], const Unit& u, int wr, int wc, int fr, int fq) const {
        const int tb = u.pm % 17; const bool lat = tb != 0;
        const int d0 = 64 * (wc >> 1) + 16 * (wc & 1) + 4 * fq, rl0 = wr * 64 + fr;
        int typ[2]; const float* gain[2];
#pragma unroll
        for (int bj = 0; bj < 2; ++bj) { const int slot = 2 * u.pn + bj;
            typ[bj] = (slot < 8) ? 3 : (slot < 10) ? 0 : (slot < 14) ? 1 : (slot < 18) ? 2 : (slot < 26) ? 3 : 0;
            gain[bj] = (slot < 6) ? qna : (slot < 8) ? kna : (slot < 18) ? vnb + ((slot - 14) & 3) * 128 : (slot < 24) ? qnc : knc; }
        const bool anynorm = typ[0] >= 2 || typ[1] >= 2;
#pragma unroll
        for (int bj = 0; bj < 2; ++bj) if (typ[bj] == 1 || typ[bj] == 2) {
#pragma unroll
            for (int ai = 0; ai < 2; ++ai)
#pragma unroll
                for (int m = 0; m < 4; ++m)
#pragma unroll
                    for (int n = 0; n < 2; ++n)
#pragma unroll
                        for (int j = 0; j < 4; ++j) acc[ai][bj][m][n][j] = gelu_tanh(acc[ai][bj][m][n][j]); }
        if (anynorm) {
#pragma unroll
            for (int bj = 0; bj < 2; ++bj) if (typ[bj] >= 2) {
#pragma unroll
                for (int ai = 0; ai < 2; ++ai)
#pragma unroll
                    for (int m = 0; m < 4; ++m) { const f32x4 a = acc[ai][bj][m][0], b = acc[ai][bj][m][1];
                        float ss = ((a.x * a.x + a.y * a.y) + (a.z * a.z + a.w * a.w)) + ((b.x * b.x + b.y * b.y) + (b.z * b.z + b.w * b.w));
                        ss += __builtin_bit_cast(float, __builtin_amdgcn_ds_swizzle(__builtin_bit_cast(int, ss), 0x401F));
                        { auto rr = __builtin_amdgcn_permlane32_swap(__float_as_uint(ss), __float_as_uint(ss), false, false); ss = __uint_as_float(rr[0]) + __uint_as_float(rr[1]); }
                        if (fq == 0) *(LAS float*)(tab + (((rl0 + ai * HALF + m * 16) * 2 + bj) * 4 + wc) * 4) = ss; } }
            asm volatile("s_waitcnt lgkmcnt(0)" ::: "memory"); __builtin_amdgcn_s_barrier(); asm volatile("" ::: "memory");
        }
#pragma unroll
        for (int bj = 0; bj < 2; ++bj) {
            const int slot = 2 * u.pn + bj;
            f32x4 g0 = (f32x4){1.f, 1.f, 1.f, 1.f}, g1 = g0;
            if (typ[bj] >= 2) { g0 = *(const f32x4*)(gain[bj] + d0); g1 = *(const f32x4*)(gain[bj] + d0 + 32); }
#pragma unroll
            for (int ai = 0; ai < 2; ++ai)
#pragma unroll
                for (int m = 0; m < 4; ++m) { const int rl = rl0 + ai * HALF + m * 16;
                    f32x4 a = acc[ai][bj][m][0], b = acc[ai][bj][m][1];
                    if (typ[bj] >= 2) { const f32x4 t = *(const LAS f32x4*)(tab + ((rl * 2 + bj) * 4) * 4);
                        const float rinv = rsqrt_fast(((t.x + t.y) + (t.z + t.w)) * (1.f / 128) + EPS);
                        a = a * rinv * g0; b = b * rinv * g1; }
                    if (typ[bj] == 3 && lat) { const int pos = (tb - 1) * 256 + rl, pp = (wc >> 1) ? (pos & 63) : (pos >> 6);
                        const f32x4* cs = (const f32x4*)(rope + 2 * (pp * 32 + 16 * (wc & 1) + 4 * fq)); const f32x4 c0 = cs[0], c1 = cs[1];
                        const f32x4 cv = (f32x4){c0.x, c0.z, c1.x, c1.z}, sv = (f32x4){c0.y, c0.w, c1.y, c1.w};
                        const f32x4 ra = a * cv - b * sv, rb = b * cv + a * sv; a = ra; b = rb; }
                    bf16_t* rowp = P + (size_t)(u.rowbase + rl) * INW + slot * 128 + d0;
                    u32x2 w0, w1; w0.x = cvt_pk_bf16(a.x, a.y); w0.y = cvt_pk_bf16(a.z, a.w); w1.x = cvt_pk_bf16(b.x, b.y); w1.y = cvt_pk_bf16(b.z, b.w);
                    *(u32x2*)rowp = w0; *(u32x2*)(rowp + 32) = w1; }
        }
    }
};
struct EpiStoreFp8 {
    static constexpr bool PERM = true;
    unsigned char* O; int ldc;
    __device__ __forceinline__ void operator()(const f32x4 (&acc)[2][2][4][2], const Unit& u, int wr, int wc, int fr, int fq) const {
        const int row0 = u.rowbase + wr * 64 + fr, col0 = u.colbase + wc * 32 + 8 * fq;
#pragma unroll
        for (int ai = 0; ai < 2; ++ai)
#pragma unroll
            for (int m = 0; m < 4; ++m) { unsigned char* rowp = O + (size_t)(row0 + ai * HALF + m * 16) * ldc + col0;
#pragma unroll
                for (int bj = 0; bj < 2; ++bj) { const f32x4 v0 = acc[ai][bj][m][0], v1 = acc[ai][bj][m][1];
                    u32x2 w; w.x = pk4_fp8(v0[0], v0[1], v0[2], v0[3]); w.y = pk4_fp8(v1[0], v1[1], v1[2], v1[3]);
                    *(u32x2*)(rowp + bj * HALF) = w; } }
    }
};
struct EpiResid {
    static constexpr bool PERM = false;
    const float* ctxbase; const float* latbase; int cbs, lbs;
    const bf16_t* src16;
    bf16_t* xout; const float* modl;
    float* parts;
    LAS unsigned char* ktab;
    __device__ __forceinline__ void operator()(const f32x4 (&acc)[2][2][4][2], const Unit& u, int wr, int wc, int fr, int fq) const {
        const int b = u.pm / 17, tb = u.pm % 17;
        const float* src = (tb == 0) ? ctxbase + (size_t)b * cbs * DM : latbase + ((size_t)b * lbs + (size_t)(tb - 1) * 256) * DM;
        const float* g1 = modl + (size_t)((tb == 0) ? 4 : b) * NMOD + 2 * DM;
        const int rl0 = wr * 64 + fr, col0 = u.colbase + wc * 32 + 4 * fq;
#pragma unroll
        for (int ai = 0; ai < 2; ++ai)
#pragma unroll
        for (int mh = 0; mh < 2; ++mh) {
            f32x4 gv[2][2];
#pragma unroll
            for (int bj = 0; bj < 2; ++bj)
#pragma unroll
                for (int n = 0; n < 2; ++n) gv[bj][n] = *(const f32x4*)(g1 + col0 + bj * HALF + n * 16);
            f32x4 xv[2][2][2];
            if (src16 != nullptr) {
                u32x2 xr[2][2][2];
#pragma unroll
                for (int mm = 0; mm < 2; ++mm) { const bf16_t* sp = src16 + (size_t)(u.rowbase + rl0 + ai * HALF + (2 * mh + mm) * 16) * DM + col0;
#pragma unroll
                    for (int bj = 0; bj < 2; ++bj)
#pragma unroll
                        for (int n = 0; n < 2; ++n) xr[mm][bj][n] = *(const u32x2*)(sp + bj * HALF + n * 16); }
#pragma unroll
                for (int mm = 0; mm < 2; ++mm)
#pragma unroll
                    for (int bj = 0; bj < 2; ++bj)
#pragma unroll
                        for (int n = 0; n < 2; ++n) xv[mm][bj][n] = (f32x4){bflo(xr[mm][bj][n].x), bfhi(xr[mm][bj][n].x), bflo(xr[mm][bj][n].y), bfhi(xr[mm][bj][n].y)};
            } else {
#pragma unroll
                for (int mm = 0; mm < 2; ++mm) { const float* sp = src + (size_t)(rl0 + ai * HALF + (2 * mh + mm) * 16) * DM + col0;
#pragma unroll
                    for (int bj = 0; bj < 2; ++bj)
#pragma unroll
                        for (int n = 0; n < 2; ++n) xv[mm][bj][n] = *(const f32x4*)(sp + bj * HALF + n * 16); }
            }
#pragma unroll
            for (int mm = 0; mm < 2; ++mm) { const int m = 2 * mh + mm, rl = rl0 + ai * HALF + m * 16; bf16_t* dp = xout + (size_t)(u.rowbase + rl) * DM + col0; float ss = 0.f;
                const float fz = *(const LAS float*)(ktab + ((size_t)u.slot * 256 + rl) * 16 + 8);
#pragma unroll
                for (int bj = 0; bj < 2; ++bj)
#pragma unroll
                    for (int n = 0; n < 2; ++n) { const f32x4 y = xv[mm][bj][n] + (gv[bj][n] * fz) * acc[ai][bj][m][n];
                        u32x2 w; w.x = cvt_pk_bf16(y.x, y.y); w.y = cvt_pk_bf16(y.z, y.w); *(u32x2*)(dp + bj * HALF + n * 16) = w;
                        ss += (y.x * y.x + y.y * y.y) + (y.z * y.z + y.w * y.w); }
                ss += __builtin_bit_cast(float, __builtin_amdgcn_ds_swizzle(__builtin_bit_cast(int, ss), 0x401F));
                { auto rr = __builtin_amdgcn_permlane32_swap(__float_as_uint(ss), __float_as_uint(ss), false, false); ss = __uint_as_float(rr[0]) + __uint_as_float(rr[1]); }
                if (fq == 0) parts[(size_t)(u.rowbase + rl) * 32 + u.pn * 4 + wc] = ss; }
            asm volatile("" ::: "memory");
        }
    }
};
struct EpiSwiGLU {
    static constexpr bool PERM = true;
    bf16_t* Hout;
    __device__ __forceinline__ void operator()(const f32x4 (&acc)[2][2][4][2], const Unit& u, int wr, int wc, int fr, int fq) const {
        const int row0 = u.rowbase + wr * 64 + fr, col0 = u.pn * HALF + wc * 32 + 8 * fq;
#pragma unroll
        for (int ai = 0; ai < 2; ++ai)
#pragma unroll
            for (int m = 0; m < 4; ++m) { bf16_t* rowp = Hout + (size_t)(row0 + ai * HALF + m * 16) * DM + col0; float h[8];
#pragma unroll
                for (int n = 0; n < 2; ++n)
#pragma unroll
                    for (int j = 0; j < 4; ++j) { const float g = acc[ai][0][m][n][j], up = acc[ai][1][m][n][j]; h[n * 4 + j] = g * __builtin_amdgcn_rcpf(1.f + __expf(-g)) * up; }
                u32x4 w; w.x = cvt_pk_bf16(h[0], h[1]); w.y = cvt_pk_bf16(h[2], h[3]); w.z = cvt_pk_bf16(h[4], h[5]); w.w = cvt_pk_bf16(h[6], h[7]);
                *(u32x4*)rowp = w; }
    }
};
struct EpiSwiGLU8 {
    static constexpr bool PERM = true;
    unsigned char* Hout;
    __device__ __forceinline__ void operator()(const f32x4 (&acc)[2][2][4][2], const Unit& u, int wr, int wc, int fr, int fq) const {
        const int row0 = u.rowbase + wr * 64 + fr, col0 = u.pn * HALF + wc * 32 + 8 * fq;
#pragma unroll
        for (int ai = 0; ai < 2; ++ai)
#pragma unroll
            for (int m = 0; m < 4; ++m) { unsigned char* rowp = Hout + (size_t)(row0 + ai * HALF + m * 16) * DM + col0; float h[8];
#pragma unroll
                for (int n = 0; n < 2; ++n)
#pragma unroll
                    for (int j = 0; j < 4; ++j) { const float g = acc[ai][0][m][n][j], up = acc[ai][1][m][n][j]; h[n * 4 + j] = g * __builtin_amdgcn_rcpf(1.f + __expf(-g)) * up; }
                u32x2 w; w.x = pk4_fp8(h[0], h[1], h[2], h[3]); w.y = pk4_fp8(h[4], h[5], h[6], h[7]);
                *(u32x2*)rowp = w; }
    }
};
struct EpiDown {
    static constexpr bool PERM = true;
    bf16_t* Y; const float* gatev;
    __device__ __forceinline__ void operator()(const f32x4 (&acc)[2][2][4][2], const Unit& u, int wr, int wc, int fr, int fq) const {
        const int row0 = u.rowbase + wr * 64 + fr, col0 = u.colbase + wc * 32 + 8 * fq;
#pragma unroll
        for (int ai = 0; ai < 2; ++ai)
#pragma unroll
            for (int m = 0; m < 4; ++m) { const int row = row0 + ai * HALF + m * 16; const float gt = gatev[row]; bf16_t* rowp = Y + (size_t)row * DM + col0;
#pragma unroll
                for (int bj = 0; bj < 2; ++bj) { const f32x4 v0 = acc[ai][bj][m][0] * gt, v1 = acc[ai][bj][m][1] * gt;
                    u32x4 w; w.x = cvt_pk_bf16(v0[0], v0[1]); w.y = cvt_pk_bf16(v0[2], v0[3]); w.z = cvt_pk_bf16(v1[0], v1[1]); w.w = cvt_pk_bf16(v1[2], v1[3]);
                    *(u32x4*)(rowp + bj * HALF) = w; } }
    }
};

template <class Epi, class Sched, bool FP8 = false, bool GATHER = false, bool KSCALE = false, bool ALIGN_EPI = true, bool SP2 = true>
__device__ __forceinline__ void gemm_phase(LAS unsigned char* lds, const Sched& S, const Epi& E, const unsigned* goffs = nullptr, LAS unsigned char* goffs_lds = nullptr) {
    static_assert(!GATHER || SP2, "gather mode is written for the SP2 loop");
    static_assert(Sched::RB == (FP8 ? GK : GK * 2), "operand row bytes");
    const int tid = opaque_tid(), wid = __builtin_amdgcn_readfirstlane(tid >> 6), lane = tid & 63, wr = wid >> 2, wc = wid & 3, fr = lane & 15, fq = lane >> 4;
    constexpr int RB = Sched::RB, nt = RB / 128;
    unsigned voffA[2], voffB[2];
#pragma unroll
    for (int i = 0; i < 2; ++i) { int R, C; stage_rc(tid * 16 + i * 8192, R, C); const int Rb = Epi::PERM ? ((R & ~31) + perm32(R & 31)) : R;
        voffA[i] = (unsigned)(R * RB + C * 2); voffB[i] = (unsigned)(Rb * RB + C * 2); }
    const size_t kstep = (size_t)(BK * 2);
    const size_t hstep = (size_t)HALF * RB;
    const unsigned ldsw = (unsigned)wid * 1024u;
    const int aoff = lds_byte(wr * 64 + fr, fq * 8), boff = lds_byte(wc * 32 + fr, fq * 8);
#define PG8_SA(b, h) (((b) * 2 + (h)) * HTB)
#define PG8_SB(b, h) ((4 + (b) * 2 + (h)) * HTB)
#define PG8_STAGE(bufoff, gbase, voff) do { _Pragma("unroll") for (int _i = 0; _i < 2; ++_i) \
        __builtin_amdgcn_global_load_lds((const unsigned*)((const char*)(gbase) + (voff)[_i]), (LAS unsigned*)(lds + (bufoff) + ldsw + _i * 8192), 16, 0, 0); } while (0)
#define PG8_RD8(p) __builtin_shufflevector(*(const LAS i32x4*)(p), *(const LAS i32x4*)((p) + 1024), 0, 1, 2, 3, 4, 5, 6, 7)
#define PG8_LDA(dst, b, h) do { _Pragma("unroll") for (int m = 0; m < 4; ++m) { if constexpr (FP8) dst##8[m] = PG8_RD8(lds + PG8_SA(b, h) + aoff + m * 2048); \
        else { _Pragma("unroll") for (int k = 0; k < 2; ++k) dst[m][k] = *(const LAS bf16x8*)(lds + PG8_SA(b, h) + aoff + m * 2048 + k * 1024); } } } while (0)
#define PG8_LDB(dst, b, h) do { _Pragma("unroll") for (int n = 0; n < 2; ++n) { if constexpr (FP8) dst##8[n] = PG8_RD8(lds + PG8_SB(b, h) + boff + n * 2048); \
        else { _Pragma("unroll") for (int k = 0; k < 2; ++k) dst[n][k] = *(const LAS bf16x8*)(lds + PG8_SB(b, h) + boff + n * 2048 + k * 1024); } } } while (0)
#define PG8_MMA(ai, bj, At, Bt) do { __builtin_amdgcn_s_setprio(1); _Pragma("unroll") for (int m = 0; m < 4; ++m) _Pragma("unroll") for (int n = 0; n < 2; ++n) { \
        if constexpr (FP8) asm volatile("v_mfma_scale_f32_16x16x128_f8f6f4 %0, %1, %2, %0, %3, %4 op_sel_hi:[0,0,0]" : "+v"(acc[ai][bj][m][n]) : "v"(Bt##8[n]), "v"(At##8[m]), "v"(sclW), "v"(sclX)); \
        else { _Pragma("unroll") for (int k = 0; k < 2; ++k) acc[ai][bj][m][n] = __builtin_amdgcn_mfma_f32_16x16x32_bf16(Bt[n][k], At[m][k], acc[ai][bj][m][n], 0, 0, 0); } } \
        __builtin_amdgcn_s_setprio(0); } while (0)
#define PG8_WAIT_V(n) asm volatile("s_waitcnt vmcnt(" #n ")" ::: "memory")
#define PG8_WAIT_L(n) asm volatile("s_waitcnt lgkmcnt(" #n ")" ::: "memory")
#define PG8_BAR __builtin_amdgcn_s_barrier()
#define PG8_SCHED __builtin_amdgcn_sched_barrier(0)
    Unit cur, nxt; int ui = 0;
    if (!S.next(0, cur)) return;
    u32x4 gC = (u32x4){0u, 0u, 0u, 0u}, gN = gC;
    if constexpr (GATHER) gC = *(const u32x4*)(goffs + ((size_t)cur.oidx * 512 + tid) * 4);
#define PG8_GSTAGE(bufoff, gbase, o0, o1) do { \
        __builtin_amdgcn_global_load_lds((const unsigned*)((const char*)(gbase) + (o0)), (LAS unsigned*)(lds + (bufoff) + ldsw), 16, 0, 0); \
        __builtin_amdgcn_global_load_lds((const unsigned*)((const char*)(gbase) + (o1)), (LAS unsigned*)(lds + (bufoff) + ldsw + 8192), 16, 0, 0); } while (0)
    f32x4 acc[2][2][4][2];
#pragma unroll
    for (int a = 0; a < 2; ++a)
#pragma unroll
        for (int b = 0; b < 2; ++b)
#pragma unroll
            for (int m = 0; m < 4; ++m)
#pragma unroll
                for (int n = 0; n < 2; ++n) acc[a][b][m][n] = (f32x4){0.f, 0.f, 0.f, 0.f};
    int sclW = W8_SCALE_E8M0 * 0x01010101, sclX = 0x7f7f7f7f; if constexpr (FP8) asm volatile("" : "+v"(sclW), "+v"(sclX)); (void)sclW; (void)sclX;
    bf16x8 At[4][2], B0[2][2], B1[2][2]; i32x8 At8[4], B08[2], B18[2];
    const char* cA = cur.a; const char* cB = cur.b;
    if constexpr (SP2) {
        PG8_STAGE(PG8_SB(0, 0), cB, voffB); PG8_STAGE(PG8_SB(0, 1), cB + hstep, voffB);
        if constexpr (GATHER) { PG8_GSTAGE(PG8_SA(0, 0), S.A, gC.x, gC.y); PG8_GSTAGE(PG8_SA(0, 1), S.A, gC.z, gC.w); }
        else { PG8_STAGE(PG8_SA(0, 0), cA, voffA); PG8_STAGE(PG8_SA(0, 1), cA + hstep, voffA); }
        if (wr == 1) PG8_BAR;
        PG8_WAIT_V(2); PG8_BAR;
        PG8_STAGE(PG8_SB(1, 0), cB + kstep, voffB);
        if constexpr (GATHER) PG8_GSTAGE(PG8_SA(1, 0), S.A + kstep, gC.x, gC.y); else PG8_STAGE(PG8_SA(1, 0), cA + kstep, voffA);
        PG8_STAGE(PG8_SB(1, 1), cB + hstep + kstep, voffB);
        PG8_WAIT_V(6); PG8_BAR;
    } else {
        PG8_STAGE(PG8_SB(0, 0), cB, voffB); PG8_STAGE(PG8_SA(0, 0), cA, voffA); PG8_STAGE(PG8_SB(0, 1), cB + hstep, voffB); PG8_STAGE(PG8_SA(0, 1), cA + hstep, voffA);
        if (wr == 1) PG8_BAR;
        PG8_WAIT_V(4); PG8_BAR;
        PG8_STAGE(PG8_SB(1, 0), cB + kstep, voffB); PG8_STAGE(PG8_SA(1, 0), cA + kstep, voffA); PG8_STAGE(PG8_SB(1, 1), cB + hstep + kstep, voffB);
        PG8_WAIT_V(6); PG8_BAR;
    }
    for (;;) {
        const bool has_next = S.next(ui + 1, nxt);
        const char* nA = has_next ? nxt.a : cA; const char* nB = has_next ? nxt.b : cB;
        if constexpr (GATHER) { if (has_next)
            __builtin_amdgcn_global_load_lds((const unsigned*)(goffs + ((size_t)nxt.oidx * 512 + tid) * 4), (LAS unsigned*)(goffs_lds + ldsw), 16, 0, 0); }
        for (int seg = 0; seg < (KSCALE ? 3 : 1); ++seg) {
        const int tbeg = !KSCALE ? 0 : (seg == 0 ? 0 : seg == 1 ? 12 : 20), tend = !KSCALE ? nt : (seg == 0 ? 12 : seg == 1 ? 20 : nt);
        for (int t = tbeg; t < tend; t += 2) {
            const bool last = (t == nt - 2);
            const char* a1 = cA + (size_t)(t + 1) * kstep;
            const char* a2 = last ? nA : cA + (size_t)(t + 2) * kstep; const char* b2 = last ? nB : cB + (size_t)(t + 2) * kstep;
            const char* a3 = a2 + kstep; const char* b3 = b2 + kstep;
            const char* g1 = S.A + (size_t)(t + 1) * kstep; const char* g2 = S.A + (last ? (size_t)0 : (size_t)(t + 2) * kstep); const char* g3 = g2 + kstep;
            u32x4 gX = gC;
            if constexpr (GATHER) { if (last) { if (has_next) gN = *(const LAS u32x4*)(goffs_lds + (size_t)tid * 16); else gN = gC; gX = gN; } }
            if constexpr (SP2) {
            PG8_LDB(B0, 0, 0); PG8_LDB(B1, 0, 1); PG8_SCHED; PG8_LDA(At, 0, 0);
            if constexpr (GATHER) PG8_GSTAGE(PG8_SA(1, 1), g1, gC.z, gC.w); else PG8_STAGE(PG8_SA(1, 1), a1 + hstep, voffA);
            PG8_WAIT_V(8); PG8_WAIT_L(0); PG8_BAR; PG8_MMA(0, 0, At, B0); PG8_MMA(0, 1, At, B1); PG8_BAR; PG8_SCHED;
            PG8_LDA(At, 0, 1); PG8_STAGE(PG8_SB(0, 0), b2, voffB); PG8_STAGE(PG8_SB(0, 1), b2 + hstep, voffB);
            if constexpr (GATHER) PG8_GSTAGE(PG8_SA(0, 0), g2, gX.x, gX.y); else PG8_STAGE(PG8_SA(0, 0), a2, voffA);
            PG8_WAIT_V(8); PG8_WAIT_L(0); PG8_BAR; PG8_MMA(1, 0, At, B0); PG8_MMA(1, 1, At, B1); PG8_BAR; PG8_SCHED;
            PG8_LDB(B0, 1, 0); PG8_LDB(B1, 1, 1); PG8_SCHED; PG8_LDA(At, 1, 0);
            if constexpr (GATHER) PG8_GSTAGE(PG8_SA(0, 1), g2, gX.z, gX.w); else PG8_STAGE(PG8_SA(0, 1), a2 + hstep, voffA);
            PG8_WAIT_V(8); PG8_WAIT_L(0); PG8_BAR; PG8_MMA(0, 0, At, B0); PG8_MMA(0, 1, At, B1); PG8_BAR; PG8_SCHED;
            PG8_LDA(At, 1, 1); PG8_STAGE(PG8_SB(1, 0), b3, voffB); PG8_STAGE(PG8_SB(1, 1), b3 + hstep, voffB);
            if constexpr (GATHER) PG8_GSTAGE(PG8_SA(1, 0), g3, gX.x, gX.y); else PG8_STAGE(PG8_SA(1, 0), a3, voffA);
            PG8_WAIT_V(8); PG8_WAIT_L(0); PG8_BAR; PG8_MMA(1, 0, At, B0); PG8_MMA(1, 1, At, B1); PG8_BAR; PG8_SCHED;
            } else {
            PG8_LDB(B0, 0, 0); PG8_SCHED; PG8_LDA(At, 0, 0); PG8_STAGE(PG8_SA(1, 1), a1 + hstep, voffA);
            PG8_WAIT_L(8); PG8_BAR; PG8_WAIT_L(0); PG8_MMA(0, 0, At, B0); PG8_BAR; PG8_SCHED;
            PG8_LDB(B1, 0, 1); PG8_STAGE(PG8_SB(0, 0), b2, voffB);
            PG8_BAR; PG8_WAIT_L(0); PG8_MMA(0, 1, At, B1); PG8_BAR;
            PG8_LDA(At, 0, 1); PG8_STAGE(PG8_SA(0, 0), a2, voffA);
            PG8_BAR; PG8_WAIT_L(0); PG8_MMA(1, 0, At, B0); PG8_BAR; PG8_SCHED;
            PG8_STAGE(PG8_SB(0, 1), b2 + hstep, voffB);
            PG8_WAIT_V(6); PG8_BAR; PG8_MMA(1, 1, At, B1); PG8_BAR;
            PG8_LDB(B0, 1, 0); PG8_SCHED; PG8_LDA(At, 1, 0); PG8_STAGE(PG8_SA(0, 1), a2 + hstep, voffA);
            PG8_WAIT_L(8); PG8_BAR; PG8_WAIT_L(0); PG8_MMA(0, 0, At, B0); PG8_BAR; PG8_SCHED;
            PG8_LDB(B1, 1, 1); PG8_STAGE(PG8_SB(1, 0), b3, voffB);
            PG8_BAR; PG8_WAIT_L(0); PG8_MMA(0, 1, At, B1); PG8_BAR;
            PG8_LDA(At, 1, 1); PG8_STAGE(PG8_SA(1, 0), a3, voffA);
            PG8_BAR; PG8_WAIT_L(0); PG8_MMA(1, 0, At, B0); PG8_BAR; PG8_SCHED;
            PG8_STAGE(PG8_SB(1, 1), b3 + hstep, voffB);
            PG8_WAIT_V(6); PG8_BAR; PG8_MMA(1, 1, At, B1); PG8_BAR;
            }
        }
        if constexpr (KSCALE) { if (seg < 2) {
            unsigned ka = (unsigned)(uintptr_t)goffs_lds + (unsigned)((ui * 256 + wr * 64 + fr) * 16 + seg * 4); asm volatile("" : "+v"(ka));
#pragma unroll
            for (int ai = 0; ai < 2; ++ai)
#pragma unroll
                for (int m = 0; m < 4; ++m) { const float f = *(const LAS float*)(uintptr_t)(ka + (unsigned)((ai * HALF + m * 16) * 16));
#pragma unroll
                    for (int bj = 0; bj < 2; ++bj)
#pragma unroll
                        for (int n = 0; n < 2; ++n) acc[ai][bj][m][n] *= f;
                    asm volatile("" : "+v"(acc[ai][0][m][0]), "+v"(acc[ai][0][m][1]), "+v"(acc[ai][1][m][0]), "+v"(acc[ai][1][m][1])); } } }
        }
        cur.slot = ui;
        if constexpr (ALIGN_EPI) { if (wr == 0) PG8_BAR; }
        if constexpr (FP8) asm volatile("s_nop 15\n\ts_nop 15\n\ts_nop 7" ::: "memory");
        { const int tz = opaque_tid(), wz = __builtin_amdgcn_readfirstlane(tz >> 6), lz = tz & 63;
          E(acc, cur, wz >> 2, wz & 3, lz & 15, lz >> 4); }
        if (!has_next) break;
#pragma unroll
        for (int a = 0; a < 2; ++a)
#pragma unroll
            for (int b = 0; b < 2; ++b)
#pragma unroll
                for (int m = 0; m < 4; ++m)
#pragma unroll
                    for (int n = 0; n < 2; ++n) acc[a][b][m][n] = (f32x4){0.f, 0.f, 0.f, 0.f};
        cur = nxt; cA = nA; cB = nB; ++ui; gC = gN;
        if constexpr (ALIGN_EPI) { if (wr == 1) PG8_BAR; }
    }
    PG8_WAIT_V(0);
    if constexpr (!ALIGN_EPI) { if (wr == 0) PG8_BAR; }
    PG8_BAR;
#undef PG8_SA
#undef PG8_SB
#undef PG8_STAGE
#undef PG8_GSTAGE
#undef PG8_LDA
#undef PG8_LDB
#undef PG8_MMA
#undef PG8_RD8
#undef PG8_WAIT_V
#undef PG8_WAIT_L
#undef PG8_BAR
#undef PG8_SCHED
}
}

namespace at {
constexpr int D = 128, NW = 8, QBLK = 32, KVBLK = 64;
constexpr float SCALE = 0.088388347648318440f;
constexpr float THR = 8.f;
constexpr int LDQ = INW, LDK = INW, LDO = DM;
constexpr size_t SHM_V = KVBLK * D * 2, SHM_K = KVBLK * D * 2, SHM_ATTN = 2 * SHM_V + 2 * SHM_K + NW * 64 * 4;
#define KSWZ(row, colB) ((row) * 256 + ((colB) ^ (((row) & 7) << 4)))
#define SBAR() __builtin_amdgcn_sched_barrier(0)
__device__ __forceinline__ int crow(int r, int hi) { return (r & 3) + 8 * (r >> 2) + 4 * hi; }
__device__ __forceinline__ unsigned cvtpk(float lo, float hi) { unsigned r; asm volatile("v_cvt_pk_bf16_f32 %0, %1, %2" : "=v"(r) : "v"(lo), "v"(hi)); return r; }

__device__ __forceinline__ void partialSM(f32x16& p0, f32x16& p1, float& m_reg, float& mn, float& alpha, bool domask, int dq, int hi) {
  constexpr float C = SCALE * 1.4426950408889634f;
  {
    if (domask) {
#pragma unroll
      for (int r = 0; r < 16; ++r) { const int d0 = dq + crow(r, hi), d1 = d0 + 32;
        if (d0 > 128 || d0 < -128) p0[r] = -1e30f;
        if (d1 > 128 || d1 < -128) p1[r] = -1e30f; }
    }
  }
  float pmax = p0[0]; for (int r = 1; r < 16; ++r) pmax = fmaxf(pmax, p0[r]); for (int r = 0; r < 16; ++r) pmax = fmaxf(pmax, p1[r]);
  { auto rr = __builtin_amdgcn_permlane32_swap(__float_as_uint(pmax), __float_as_uint(pmax), false, false);
    pmax = fmaxf(__uint_as_float(rr[0]), __uint_as_float(rr[1])); }
  if (__builtin_expect(__all(pmax - m_reg <= THR / SCALE), 1)) { mn = m_reg; alpha = 1.f; }
  else { mn = fmaxf(m_reg, pmax); alpha = __builtin_amdgcn_exp2f((m_reg - mn) * C); m_reg = mn; }
  float mnC = -mn * C;
  for (int r = 0; r < 16; ++r) p0[r] = fmaf(p0[r], C, mnC); for (int r = 0; r < 16; ++r) p1[r] = fmaf(p1[r], C, mnC);
  for (int r = 0; r < 16; ++r) p0[r] = __builtin_amdgcn_exp2f(p0[r]);
}
__device__ __forceinline__ void finishSM(f32x16& p0, f32x16& p1, float alpha, float& l_reg, bf16x8& pa0, bf16x8& pa1, bf16x8& pa2, bf16x8& pa3) {
  for (int r = 0; r < 16; ++r) p1[r] = __builtin_amdgcn_exp2f(p1[r]);
  float ps = 0; for (int r = 0; r < 16; ++r) ps += p0[r]; for (int r = 0; r < 16; ++r) ps += p1[r];
  { auto rr = __builtin_amdgcn_permlane32_swap(__float_as_uint(ps), __float_as_uint(ps), false, false);
    ps = __uint_as_float(rr[0]) + __uint_as_float(rr[1]); }
  l_reg = l_reg * alpha + ps;
#define PK4(P, BASE, OUT) do { unsigned a0 = cvtpk(P[BASE + 0], P[BASE + 1]), a1 = cvtpk(P[BASE + 2], P[BASE + 3]);   \
    unsigned b0 = cvtpk(P[BASE + 4], P[BASE + 5]), b1 = cvtpk(P[BASE + 6], P[BASE + 7]);                              \
    auto r0 = __builtin_amdgcn_permlane32_swap(a0, b0, false, false); auto r1 = __builtin_amdgcn_permlane32_swap(a1, b1, false, false); \
    u32x4 w = {r0[0], r1[0], r0[1], r1[1]}; OUT = *reinterpret_cast<bf16x8*>(&w); } while (0)
  PK4(p0, 0, pa0); PK4(p0, 8, pa1); PK4(p1, 0, pa2); PK4(p1, 8, pa3);
#undef PK4
}
__device__ __forceinline__ void qkt(f32x16& p0, f32x16& p1, const char* Ks, const bf16x8* qr, int ka0) {
  p0 = f32x16{}; p1 = f32x16{};
  asm volatile("" : "+v"(ka0));
#pragma unroll
  for (int d0 = 0; d0 < 8; ++d0) { const int off = ka0 ^ (d0 * 32);
    bf16x8 b0 = *reinterpret_cast<const bf16x8*>(Ks + off);
    bf16x8 b1 = *reinterpret_cast<const bf16x8*>(Ks + off + 32 * 256);
    p0 = __builtin_amdgcn_mfma_f32_32x32x16_bf16(b0, qr[d0], p0, 0, 0, 0);
    p1 = __builtin_amdgcn_mfma_f32_32x32x16_bf16(b1, qr[d0], p1, 0, 0, 0); }
}
__device__ __forceinline__ int v_st(int k, int c) { const int kk = (k & ~0xC) | ((k & 4) << 1) | ((k & 8) >> 1); return ((kk >> 3) * 4 + (c >> 5)) * 512 + ((kk & 7) * 32 + (c & 31)) * 2; }
__device__ __forceinline__ int v_rd_base(int lane) { return ((lane & 3) << 3) | (((lane >> 2) & 3) << 6) | (((lane >> 4) & 1) << 5) | (((lane >> 5) & 1) << 8); }
constexpr int v_rd_off(int d0, int ks, int half) { return d0 * 512 + ks * 4096 + half * 2048; }
template <int OFF> __device__ __forceinline__ s16x4 tr_read(int vb) {
  s16x4 r; asm volatile("ds_read_b64_tr_b16 %0, %1 offset:%2" : "=&v"(r) : "v"(vb), "i"(OFF) : "memory"); return r;
}
template <int D0> __device__ __forceinline__ void pv_one(f32x16& od, int vb, bf16x8 pa0, bf16x8 pa1, bf16x8 pa2, bf16x8 pa3) {
  const s16x4 l0 = tr_read<v_rd_off(D0, 0, 0)>(vb), h0 = tr_read<v_rd_off(D0, 0, 1)>(vb), l1 = tr_read<v_rd_off(D0, 1, 0)>(vb), h1 = tr_read<v_rd_off(D0, 1, 1)>(vb);
  const s16x4 l2 = tr_read<v_rd_off(D0, 2, 0)>(vb), h2 = tr_read<v_rd_off(D0, 2, 1)>(vb), l3 = tr_read<v_rd_off(D0, 3, 0)>(vb), h3 = tr_read<v_rd_off(D0, 3, 1)>(vb);
  asm volatile("s_waitcnt lgkmcnt(0)" ::: "memory"); SBAR();
#define PK(L, H) (bf16x8){L[0], L[1], L[2], L[3], H[0], H[1], H[2], H[3]}
  od = __builtin_amdgcn_mfma_f32_32x32x16_bf16(pa0, PK(l0, h0), od, 0, 0, 0);
  od = __builtin_amdgcn_mfma_f32_32x32x16_bf16(pa1, PK(l1, h1), od, 0, 0, 0);
  od = __builtin_amdgcn_mfma_f32_32x32x16_bf16(pa2, PK(l2, h2), od, 0, 0, 0);
  od = __builtin_amdgcn_mfma_f32_32x32x16_bf16(pa3, PK(l3, h3), od, 0, 0, 0);
#undef PK
}
__device__ __forceinline__ void pv_d0(f32x16* o, int vb, bf16x8 pa0, bf16x8 pa1, bf16x8 pa2, bf16x8 pa3) {
  pv_one<0>(o[0], vb, pa0, pa1, pa2, pa3); pv_one<1>(o[1], vb, pa0, pa1, pa2, pa3); pv_one<2>(o[2], vb, pa0, pa1, pa2, pa3); pv_one<3>(o[3], vb, pa0, pa1, pa2, pa3);
}

__device__ __forceinline__ void attn_body(const bf16_t* __restrict__ Qb, const bf16_t* __restrict__ Kb, const bf16_t* __restrict__ Vb, bf16_t* __restrict__ Ob,
                                          int NT, int kskip, int qpos0, float m0, float l0, bool maskon, char* lds, float* ssq_out) {
  const int tid = opaque_tid(), wid = tid >> 6, lane = tid & 63, r32 = lane & 31, hi = lane >> 5;
  char* V_lds = lds; char* K_lds = lds + 2 * SHM_V;
  float* ws = (float*)(lds + 2 * SHM_V + 2 * SHM_K) + wid * 64; float* li_l = ws; float* al_l = ws + 32;
  float m_reg = m0, l_reg = l0; f32x16 o[4] = {}; bf16x8 qr[8];
  const bf16_t* Qw = Qb + (long)(wid * QBLK + r32) * LDQ + hi * 8;
#pragma unroll
  for (int d0 = 0; d0 < 8; ++d0) qr[d0] = *reinterpret_cast<const bf16x8*>(Qw + d0 * 16);
  const int sr = tid >> 4, sc = (tid & 15) * 8, vst0 = v_st(sr, sc), kst0 = KSWZ(sr, sc * 2);
  const int vb0 = (int)(uintptr_t)V_lds + v_rd_base(lane);
  const int qpos = qpos0 + wid * QBLK + r32;
  const int ka0 = r32 * 256 + ((hi * 16) ^ ((r32 & 7) << 4));
  const unsigned goff0 = (unsigned)(sr * LDK + sc) * 2u, goff1 = goff0 + 32u * LDK * 2u;
  struct { bf16x8 vs0, vs1, ks0, ks1; } sr_[1];
#define TROW(jt) ((long)(jt) * KVBLK + ((jt) >= 4 ? kskip : 0))
#define SLOAD(i, jt) do { const long _k0 = TROW(jt) * (LDK * 2); const char* _kp = (const char*)Kb + _k0; const char* _vp = (const char*)Vb + _k0; \
    sr_[i].vs0 = *reinterpret_cast<const bf16x8*>(_vp + goff0); sr_[i].vs1 = *reinterpret_cast<const bf16x8*>(_vp + goff1); \
    sr_[i].ks0 = *reinterpret_cast<const bf16x8*>(_kp + goff0); sr_[i].ks1 = *reinterpret_cast<const bf16x8*>(_kp + goff1); } while (0)
#define SWRITE(b, i) do { *(bf16x8*)(V_lds + (b) * SHM_V + vst0) = sr_[i].vs0;          \
    *(bf16x8*)(V_lds + (b) * SHM_V + vst0 + 8192) = sr_[i].vs1;                         \
    *(bf16x8*)(K_lds + (b) * SHM_K + kst0) = sr_[i].ks0;                               \
    *(bf16x8*)(K_lds + (b) * SHM_K + kst0 + 8192) = sr_[i].ks1; } while (0)
#define SWAIT() asm volatile("s_waitcnt vmcnt(0)" ::: "memory")
#define RESC(a) do { if (__any((a) < 1.f)) { if (hi == 0) al_l[r32] = (a); asm volatile("s_waitcnt lgkmcnt(0)" ::: "memory"); \
    for (int d = 0; d < 4; ++d) for (int r = 0; r < 16; ++r) o[d][r] *= al_l[crow(r, hi)]; } } while (0)
#define DQ(jt) (kskip + ((jt) - 4) * KVBLK - qpos)
  f32x16 pA0, pA1, pB0, pB1; float mnA, mnB, alA, alB; bf16x8 pa0, pa1, pa2, pa3;
  constexpr int SE = 0, SO = 0;
  SLOAD(SE, 0); asm volatile("s_waitcnt vmcnt(0)" ::: "memory"); SWRITE(0, SE); __syncthreads();
  qkt(pA0, pA1, K_lds, qr, ka0); partialSM(pA0, pA1, m_reg, mnA, alA, false, 0, hi);
  SLOAD(SO, 1);
  SWAIT(); SWRITE(1, SO); __syncthreads();
  for (int j = 1; j + 1 < NT; j += 2) {
    SBAR(); qkt(pB0, pB1, K_lds + SHM_K, qr, ka0);
    finishSM(pA0, pA1, alA, l_reg, pa0, pa1, pa2, pa3); SBAR();
    SLOAD(SO, j + 1); SBAR();
    pv_d0(o, vb0, pa0, pa1, pa2, pa3); partialSM(pB0, pB1, m_reg, mnB, alB, maskon && j >= 4, DQ(j), hi);
    __syncthreads(); SWAIT(); SWRITE(0, SE);
    RESC(alB); __syncthreads();
    SBAR(); qkt(pA0, pA1, K_lds, qr, ka0);
    finishSM(pB0, pB1, alB, l_reg, pa0, pa1, pa2, pa3); SBAR();
    SLOAD(SE, j + 2); SBAR();
    pv_d0(o, vb0 + (int)SHM_V, pa0, pa1, pa2, pa3); partialSM(pA0, pA1, m_reg, mnA, alA, maskon && j + 1 >= 4, DQ(j + 1), hi);
    __syncthreads(); SWAIT(); SWRITE(1, SO);
    RESC(alA); __syncthreads();
  }
  SBAR(); qkt(pB0, pB1, K_lds + SHM_K, qr, ka0);
  finishSM(pA0, pA1, alA, l_reg, pa0, pa1, pa2, pa3); SBAR();
  pv_d0(o, vb0, pa0, pa1, pa2, pa3); partialSM(pB0, pB1, m_reg, mnB, alB, maskon && NT - 1 >= 4, DQ(NT - 1), hi);
  __syncthreads(); RESC(alB);
  finishSM(pB0, pB1, alB, l_reg, pa0, pa1, pa2, pa3); SBAR();
  pv_d0(o, vb0 + (int)SHM_V, pa0, pa1, pa2, pa3);
  if (hi == 0) li_l[r32] = l_reg; asm volatile("s_waitcnt lgkmcnt(0)" ::: "memory");
  float rli[16];
#pragma unroll
  for (int r = 0; r < 16; ++r) rli[r] = __builtin_amdgcn_rcpf(li_l[crow(r, hi)]);
  bf16_t* Ow = Ob + (long)(wid * QBLK) * LDO;
#pragma unroll
  for (int r = 0; r < 16; ++r) { int orow = crow(r, hi); float sq = 0.f;
    for (int d0 = 0; d0 < 4; ++d0) { const float ov = o[d0][r] * rli[r]; sq += ov * ov; Ow[(long)orow * LDO + d0 * 32 + r32] = (bf16_t)f2bf(ov); }
    sq = row16_sum(sq); sq += __builtin_bit_cast(float, __builtin_amdgcn_ds_swizzle(__builtin_bit_cast(int, sq), 0x401F));
    if (r32 == 0) ssq_out[(size_t)(wid * QBLK + orow) * 16] = sq; }
#undef TROW
#undef SLOAD
#undef SWRITE
#undef SWAIT
#undef RESC
#undef DQ
}
}

struct Args { const float* in[23]; float* out; unsigned char* ws; int ph_lo, ph_hi; };
enum { IN_X = 0, IN_C, IN_CTX, IN_CCTX, IN_WMOD, IN_BMOD, IN_N1G, IN_N2G, IN_WIN, IN_QNA, IN_KNA, IN_SINK, IN_VNB, IN_WS, IN_BS, IN_QNC, IN_KNC, IN_OUTG, IN_WOUT, IN_WR, IN_WG, IN_WU, IN_WDN };

#define PHASE_IDS(F) const int tid = opaque_tid(), lane = tid & 63, wave = __builtin_amdgcn_readfirstlane(tid >> 6), gw = (int)blockIdx.x * 8 + wave, NGW = (F).G * 8; (void)lane; (void)wave; (void)gw; (void)NGW
constexpr int ARGTAB_OFF = LDSCTL_OFF + 1024;
#define INP(F, i) ld_inp((F).lds, (i))
__device__ __forceinline__ const float* ld_inp(LAS unsigned char* lds, int i) {
    unsigned a = (unsigned)(uintptr_t)(lds + ARGTAB_OFF) + 8u * (unsigned)i;
    asm volatile("" : "+v"(a));
    const volatile LAS unsigned* t = (const volatile LAS unsigned*)(uintptr_t)a;
    const unsigned lo = __builtin_amdgcn_readfirstlane(t[0]), hi = __builtin_amdgcn_readfirstlane(t[1]);
    return (const float*)(const GAS float*)(((unsigned long long)hi << 32) | lo);
}
struct Frame {
    LAS unsigned char* lds; char* ldsg;
    volatile LAS unsigned* MISC;
    unsigned* ctl;
    int G;
    float* out; unsigned char* ws;
};

__host__ __device__ __forceinline__ int headpos(int d) { return 32 * (2 * (d >> 6) + ((d >> 4) & 1)) + 8 * ((d >> 2) & 3) + 4 * ((d >> 5) & 1) + (d & 3); }
template <bool HEADPERM = false>
__device__ __forceinline__ void transpose_item(const float* W, int N, bf16_t* WT, int k0, int n0, int drow0, LAS float* scr, int lane) {
    { float t[32]; const float* wp = W + (size_t)(k0 + (lane >> 5)) * N + n0 + (lane & 31);
#pragma unroll
      for (int i = 0; i < 32; ++i) t[i] = wp[(size_t)(2 * i) * N];
#pragma unroll
      for (int i = 0; i < 32; ++i) scr[(2 * i + (lane >> 5)) * 33 + (lane & 31)] = t[i]; }
    LDS_WAIT(); asm volatile("" ::: "memory");
    const int c = lane & 7;
#pragma unroll
    for (int j = 0; j < 4; ++j) { const int n = (lane >> 3) + 8 * j; const LAS float* s = scr + (8 * c) * 33 + n;
        u32x4 o; o.x = pk2(s[0 * 33], s[1 * 33]); o.y = pk2(s[2 * 33], s[3 * 33]); o.z = pk2(s[4 * 33], s[5 * 33]); o.w = pk2(s[6 * 33], s[7 * 33]);
        const int drow = HEADPERM ? ((drow0 + n) & ~127) + headpos((drow0 + n) & 127) : drow0 + n;
        *(u32x4*)(WT + (size_t)drow * DM + k0 + 8 * c) = o; }
    LDS_WAIT(); asm volatile("" ::: "memory");
}

__device__ __forceinline__ void transpose_item8(const float* W, int N, unsigned char* WT, int k0, int n0, int drow0, LAS float* scr, int lane) {
    { float t[32]; const float* wp = W + (size_t)(k0 + (lane >> 5)) * N + n0 + (lane & 31);
#pragma unroll
      for (int i = 0; i < 32; ++i) t[i] = wp[(size_t)(2 * i) * N];
#pragma unroll
      for (int i = 0; i < 32; ++i) scr[(2 * i + (lane >> 5)) * 33 + (lane & 31)] = t[i]; }
    LDS_WAIT(); asm volatile("" ::: "memory");
    const int c = lane & 7;
#pragma unroll
    for (int j = 0; j < 4; ++j) { const int n = (lane >> 3) + 8 * j; const LAS float* s = scr + (8 * c) * 33 + n;
        u32x2 o; o.x = pk4_fp8(s[0 * 33] * W8_SCALE, s[1 * 33] * W8_SCALE, s[2 * 33] * W8_SCALE, s[3 * 33] * W8_SCALE); o.y = pk4_fp8(s[4 * 33] * W8_SCALE, s[5 * 33] * W8_SCALE, s[6 * 33] * W8_SCALE, s[7 * 33] * W8_SCALE);
        *(u32x2*)(WT + (size_t)(drow0 + n) * DM + k0 + 8 * c) = o; }
    LDS_WAIT(); asm volatile("" ::: "memory");
}
__device__ __forceinline__ void conv_tile(Frame& F, int tl, int tid, int lane, int wave) {
    const int mat = tl >> 7, kb = (tl & 127) >> 3, nb = tl & 7, le = mat / 3, wh = mat % 3;
    const float* src = INP(F, wh == 0 ? IN_WG : wh == 1 ? IN_WU : IN_WDN) + (size_t)le * DM * DM + (size_t)(128 * kb) * DM + 256 * nb;
    unsigned char* dst = (wh < 2) ? F.ws + WS_WGU + (size_t)(le / NE) * NE * 4096 * DM * 2 + (size_t)(le % NE) * 4096 * DM + (size_t)(2 * nb) * 256 * DM + 128 * kb
                                  : F.ws + WS_WD + (size_t)(le / NE) * NE * DM * DM * 2 + (size_t)(le % NE) * DM * DM + (size_t)(256 * nb) * DM + 128 * kb;
    f32x4 t[16];
    { const float* wp = src + (size_t)(16 * wave) * DM + 4 * lane;
#pragma unroll
      for (int q = 0; q < 16; ++q) t[q] = __builtin_nontemporal_load((const f32x4*)(wp + (size_t)q * DM)); }
    LAS unsigned* img = (LAS unsigned*)F.lds;
#pragma unroll
    for (int it = 0; it < 4; ++it)
#pragma unroll
        for (int j = 0; j < 4; ++j) { const int n = 4 * lane + j, d = 4 * wave + it;
            img[n * 32 + (d ^ (lane & 31))] = pk4_fp8(t[4 * it + 0][j] * W8_SCALE, t[4 * it + 1][j] * W8_SCALE, t[4 * it + 2][j] * W8_SCALE, t[4 * it + 3][j] * W8_SCALE); }
    __syncthreads();
#pragma unroll
    for (int q = 0; q < 4; ++q) { const int ch = tid + 512 * q, n = ch >> 3, g = ch & 7, sw = (n >> 2) & 31;
        u32x4 o; o.x = img[n * 32 + ((4 * g + 0) ^ sw)]; o.y = img[n * 32 + ((4 * g + 1) ^ sw)]; o.z = img[n * 32 + ((4 * g + 2) ^ sw)]; o.w = img[n * 32 + ((4 * g + 3) ^ sw)];
        const int drow = (wh < 2) ? (n >> 7) * 256 + wh * 128 + (n & 127) : n;
        *(u32x4*)(dst + (size_t)drow * DM + 16 * g) = o; }
    __syncthreads();
}
__device__ __forceinline__ void conv_help(Frame& F, int budget, unsigned* done, unsigned done_total) {
    if (!CONV_IDLE) return;
    PHASE_IDS(F);
    for (int n = 0; n < budget; ++n) {
        if (tid == 0) { unsigned t = 0xffffffffu;
            if (done == nullptr || xb_ld(done) < done_total) t = xb_add(F.ctl + CW_CONV, 1u);
            F.MISC[1] = t; }
        __syncthreads();
        const unsigned t = F.MISC[1];
        __syncthreads();
        if (t >= (unsigned)(NT8_ALL - NT8_L0)) break;
        conv_tile(F, NT8_L0 + (int)t, tid, lane, wave);
    }
}
__device__ __forceinline__ void phase_prologue(Frame& F) {
    PHASE_IDS(F);
    static_assert(FP8_L0 && FP8_L1, "the prologue writes the experts' weights as fp8");
    {
        constexpr int NT8 = CONV_IDLE ? NT8_L0 : NT8_ALL;
        struct T8 { const float* src; unsigned char* dst; int which; };
#define P8_DESC(d, tl) do { const int mat = (tl) >> 7, kb = ((tl) & 127) >> 3, nb = (tl) & 7, le = mat / 3, wh = mat % 3; d.which = wh; \
        d.src = INP(F, wh == 0 ? IN_WG : wh == 1 ? IN_WU : IN_WDN) + (size_t)le * DM * DM + (size_t)(128 * kb) * DM + 256 * nb; \
        d.dst = (wh < 2) ? F.ws + WS_WGU + (size_t)(le / NE) * NE * 4096 * DM * 2 + (size_t)(le % NE) * 4096 * DM + (size_t)(2 * nb) * 256 * DM + 128 * kb \
                         : F.ws + WS_WD + (size_t)(le / NE) * NE * DM * DM * 2 + (size_t)(le % NE) * DM * DM + (size_t)(256 * nb) * DM + 128 * kb; } while (0)
#define P8_LOAD(d, t) do { const float* wp = d.src + (size_t)(16 * wave) * DM + 4 * lane; _Pragma("unroll") for (int q = 0; q < 16; ++q) t[q] = __builtin_nontemporal_load((const f32x4*)(wp + (size_t)q * DM)); } while (0)
        T8 cur, nxt; f32x4 t0[16], t1[16];
        int tl = blockIdx.x, par = 0;
        if (tl < NT8) { P8_DESC(cur, tl); P8_LOAD(cur, t0); }
        for (; tl < NT8; tl += F.G, par ^= 1) {
            const bool has = tl + F.G < NT8;
            if (has) { P8_DESC(nxt, tl + F.G); P8_LOAD(nxt, t1); }
            LAS unsigned* img = (LAS unsigned*)(F.lds + par * 32768);
#pragma unroll
            for (int it = 0; it < 4; ++it)
#pragma unroll
                for (int j = 0; j < 4; ++j) { const int n = 4 * lane + j, d = 4 * wave + it;
                    img[n * 32 + (d ^ (lane & 31))] = pk4_fp8(t0[4 * it + 0][j] * W8_SCALE, t0[4 * it + 1][j] * W8_SCALE, t0[4 * it + 2][j] * W8_SCALE, t0[4 * it + 3][j] * W8_SCALE); }
            __syncthreads();
#pragma unroll
            for (int q = 0; q < 4; ++q) { const int ch = tid + 512 * q, n = ch >> 3, g = ch & 7, sw = (n >> 2) & 31;
                u32x4 o; o.x = img[n * 32 + ((4 * g + 0) ^ sw)]; o.y = img[n * 32 + ((4 * g + 1) ^ sw)]; o.z = img[n * 32 + ((4 * g + 2) ^ sw)]; o.w = img[n * 32 + ((4 * g + 3) ^ sw)];
                const int drow = (cur.which < 2) ? (n >> 7) * 256 + cur.which * 128 + (n & 127) : n;
                *(u32x4*)(cur.dst + (size_t)drow * DM + 16 * g) = o; }
            if (has) { cur = nxt;
#pragma unroll
                for (int q = 0; q < 16; ++q) t0[q] = t1[q]; }
        }
#undef P8_DESC
#undef P8_LOAD
        __syncthreads();
    }
    LAS float* scr = (LAS float*)(F.lds + wave * 16384);
    constexpr int I_IN = 32 * (INW / 32), I_SQ = 32 * (DM / 32);
    constexpr int NIT = 2 * I_IN + 2 * I_SQ;
    struct TItem { const float* src; unsigned char* dst; const float* og; int N, drow0, mode; };
#define P0_DESC(d, itv) do { int r = (itv); \
        if (r < 2 * I_IN) { const int l = r / I_IN; r %= I_IN; const int kb = r / (INW / 32), nb = r % (INW / 32); \
            d.src = INP(F, IN_WIN) + (size_t)l * DM * INW + (size_t)(64 * kb) * INW + 32 * nb; d.dst = F.ws + WS_WIN + (size_t)l * INW * DM * 2 + 128 * kb; d.N = INW; d.drow0 = 32 * nb; d.mode = 1; d.og = nullptr; } \
        else { r -= 2 * I_IN; const int l = r / I_SQ; r %= I_SQ; const int kb = r / 64, nb = r % 64; \
            d.src = INP(F, IN_WOUT) + (size_t)l * DM * DM + (size_t)(64 * kb) * DM + 32 * nb; d.dst = F.ws + WS_WOUT + (size_t)l * DM * DM * 2 + 128 * kb; d.N = DM; d.drow0 = 32 * nb; d.mode = 0; d.og = INP(F, IN_OUTG) + l * DM + 64 * kb; } } while (0)
#define P0_LOAD(d, t) do { const float* wp = d.src + (size_t)(lane >> 3) * d.N + (lane & 7) * 4; _Pragma("unroll") for (int i = 0; i < 8; ++i) t[i] = *(const f32x4*)(wp + (size_t)(8 * i) * d.N); } while (0)
    for (int it = gw; it < NIT; it += NGW) {
        TItem cur; f32x4 t0[8];
        P0_DESC(cur, it); P0_LOAD(cur, t0);
#pragma unroll
        for (int i = 0; i < 8; ++i) { LAS float* sp = scr + (8 * i + (lane >> 3)) * 33 + (lane & 7) * 4; sp[0] = t0[i].x; sp[1] = t0[i].y; sp[2] = t0[i].z; sp[3] = t0[i].w; }
        LDS_WAIT(); asm volatile("" ::: "memory");
        const int c = lane & 7;
#pragma unroll
        for (int j = 0; j < 4; ++j) { const int n = (lane >> 3) + 8 * j; const LAS float* sp = scr + (8 * c) * 33 + n;
            float v[8];
#pragma unroll
            for (int q = 0; q < 8; ++q) v[q] = sp[q * 33];
            if (cur.mode == 0) { const f32x4 g0 = *(const f32x4*)(cur.og + 8 * c), g1 = *(const f32x4*)(cur.og + 8 * c + 4);
                v[0] *= g0.x; v[1] *= g0.y; v[2] *= g0.z; v[3] *= g0.w; v[4] *= g1.x; v[5] *= g1.y; v[6] *= g1.z; v[7] *= g1.w; }
            int drow = cur.drow0 + n; if (cur.mode == 1) drow = (drow & ~127) + headpos(drow & 127);
            u32x4 o; o.x = pk2(v[0], v[1]); o.y = pk2(v[2], v[3]); o.z = pk2(v[4], v[5]); o.w = pk2(v[6], v[7]); *(u32x4*)(cur.dst + (size_t)drow * DM * 2 + 16 * c) = o; }
        LDS_WAIT(); asm volatile("" ::: "memory");
    }
#undef P0_DESC
#undef P0_LOAD
    __syncthreads();
    {
        LAS float* sil = (LAS float*)F.lds;
        LAS float* red = (LAS float*)(F.lds + 40960);
        bool have = false;
        for (int it = blockIdx.x; it < 2 * 96; it += F.G) {
            if (!have) {
                { const float* cp = INP(F, IN_C); const float* ccp = INP(F, IN_CCTX);
                for (int i = tid; i < 5 * DM; i += 512) { const int s = i / DM, k = i % DM; const float cv = (s < 4) ? cp[s * DM + k] : ccp[k]; sil[i] = cv / (1.f + __expf(-cv)); } }
                have = true; __syncthreads();
            }
            const int l = it / 96, cb = it % 96, c4 = tid & 31, kr = tid >> 5;
            const float* wp = INP(F, IN_WMOD) + (size_t)l * DM * NMOD + (size_t)cb * 128 + c4 * 4;
            f32x4 a[5];
#pragma unroll
            for (int s = 0; s < 5; ++s) a[s] = (f32x4){0.f, 0.f, 0.f, 0.f};
#pragma unroll 8
            for (int k = kr; k < DM; k += 16) { const f32x4 w = *(const f32x4*)(wp + (size_t)k * NMOD);
#pragma unroll
                for (int s = 0; s < 5; ++s) a[s] += w * sil[s * DM + k]; }
#pragma unroll
            for (int s = 0; s < 5; ++s) *(LAS f32x4*)(red + (kr * 5 + s) * 128 + c4 * 4) = a[s];
            __syncthreads();
            const float* bmod = INP(F, IN_BMOD);
            for (int i = tid; i < 5 * 128; i += 512) { const int s = i / 128, cc = i % 128; float sum = 0.f;
#pragma unroll
                for (int q = 0; q < 16; ++q) sum += red[(q * 5 + s) * 128 + cc];
                ((float*)(F.ws + WS_MOD))[(size_t)(l * 5 + s) * NMOD + cb * 128 + cc] = sum + bmod[l * NMOD + cb * 128 + cc]; }
            __syncthreads();
        }
    }
    if ((int)blockIdx.x >= F.G - 9 && (int)blockIdx.x < F.G - 1) {
        const float* wr = INP(F, IN_WR); bf16_t* wf = (bf16_t*)(F.ws + WS_WRS); const int part = (int)blockIdx.x - (F.G - 9);
        for (int i = part * 512 + tid; i < 2 * DM * NE; i += 8 * 512) { const int l = i / (DM * NE), rem = i % (DM * NE), k = rem >> 4, e = rem & 15;
            const float w = wr[i]; const unsigned hi = f2bf(w); const unsigned lo = f2bf(w - __builtin_bit_cast(float, hi << 16));
            const int sidx = k >> 5, q = (k >> 3) & 3, j = k & 7; bf16_t* dst = wf + ((size_t)(l * 64 + sidx) * 2 * 64 + (q * 16 + e)) * 8 + j;
            dst[0] = (bf16_t)hi; dst[64 * 8] = (bf16_t)lo; }
    }
    if (blockIdx.x == F.G - 1) {
        for (int i = tid; i < 64 * 32; i += 512) {
            const int pos = i >> 5, f = i & 31;
            double inv = 1.0; for (int q = 0; q < f; ++q) inv *= 0.7498942093324559;
            const double a = (double)pos * inv;
            const double n = __builtin_rint(a * 0.6366197723675814);
            const double r = (a - n * 1.5707963267948966) - n * 6.123233995736766e-17;
            const double r2 = r * r;
            double sn = r * (1.0 + r2 * (-1.0 / 6 + r2 * (1.0 / 120 + r2 * (-1.0 / 5040 + r2 * (1.0 / 362880 + r2 * (-1.0 / 39916800 + r2 * (1.0 / 6227020800.0)))))));
            double cn = 1.0 + r2 * (-0.5 + r2 * (1.0 / 24 + r2 * (-1.0 / 720 + r2 * (1.0 / 40320 + r2 * (-1.0 / 3628800 + r2 * (1.0 / 479001600 + r2 * (-1.0 / 87178291200.0)))))));
            const int q = ((int)n) & 3; double cs, ss;
            if (q == 0) { cs = cn; ss = sn; } else if (q == 1) { cs = -sn; ss = cn; } else if (q == 2) { cs = -cn; ss = -sn; } else { cs = sn; ss = -cn; }
            ((float*)(F.ws + WS_ROPE))[2 * i] = (float)cs; ((float*)(F.ws + WS_ROPE))[2 * i + 1] = (float)ss;
        }
    }
}

__device__ __forceinline__ void load_row(const float* row, int lane, f32x4 (&v)[8]) {
#pragma unroll
    for (int j = 0; j < 8; ++j) v[j] = *(const f32x4*)(row + 4 * lane + 256 * j);
}
__device__ __forceinline__ void norm_mod_store(const f32x4 (&v)[8], const float* g, const float* shift, const float* scale, bf16_t* dst, int lane) {
    float ss = 0.f;
#pragma unroll
    for (int j = 0; j < 8; ++j) ss += (v[j].x * v[j].x + v[j].y * v[j].y) + (v[j].z * v[j].z + v[j].w * v[j].w);
    const float rinv = rsqrt_fast(wave_sum(ss) * (1.f / DM) + EPS);
#pragma unroll
    for (int j = 0; j < 8; ++j) { const int c = 4 * lane + 256 * j;
        const f32x4 gg = *(const f32x4*)(g + c), sh = *(const f32x4*)(shift + c), sc = *(const f32x4*)(scale + c);
        const f32x4 y = (v[j] * rinv) * gg * (sc + 1.f) + sh;
        u32x2 w; w.x = pk2(y.x, y.y); w.y = pk2(y.z, y.w); *(u32x2*)(dst + c) = w; }
}

__device__ __forceinline__ void phase_rowpass1_l0(Frame& F) {
    PHASE_IDS(F);
    const float* mod = (const float*)(F.ws + WS_MOD);
    { const float* n2 = INP(F, IN_N2G); float* gs = (float*)(F.ws + WS_GS2);
      for (int i = (int)blockIdx.x * 512 + tid; i < 2 * 5 * DM; i += F.G * 512) { const int l = i / (5 * DM), sv = (i / DM) % 5, k = i % DM;
          const float* m = mod + (size_t)(l * 5 + sv) * NMOD; gs[2 * i] = n2[l * DM + k] * (1.f + m[4 * DM + k]); gs[2 * i + 1] = m[3 * DM + k]; } }
    const float* xin = INP(F, IN_X); const float* cin = INP(F, IN_CTX); const float* n1g = INP(F, IN_N1G);
#define P1_SRC(rr) ((((rr) % TPB) < CTXL) ? cin + ((size_t)((rr) / TPB) * CTXL + ((rr) % TPB)) * DM : xin + ((size_t)((rr) / TPB) * SEQ + (((rr) % TPB) - CTXL)) * DM)
    f32x4 v[8], vn[8];
    int r = gw;
    if (r < NTOK) load_row(P1_SRC(r), lane, v);
    while (r < NTOK) {
        const int rn = r + NGW;
        if (rn < NTOK) load_row(P1_SRC(rn), lane, vn);
        const int b = r / TPB, t = r % TPB, s = (t < CTXL) ? 4 : b;
        norm_mod_store(v, n1g, mod + (size_t)s * NMOD, mod + (size_t)s * NMOD + DM, (bf16_t*)(F.ws + WS_HN) + (size_t)r * DM, lane);
#pragma unroll
        for (int j = 0; j < 8; ++j) v[j] = vn[j];
        r = rn;
    }
#undef P1_SRC
}

__device__ __forceinline__ void post_unpack(const u32x4 x, float (&v)[8]) {
    v[0] = bflo(x.x); v[1] = bfhi(x.x); v[2] = bflo(x.y); v[3] = bfhi(x.y); v[4] = bflo(x.z); v[5] = bfhi(x.z); v[6] = bflo(x.w); v[7] = bfhi(x.w); }
__device__ __forceinline__ float sum16(float v) { return row16_sum(v); }
__device__ __forceinline__ void phase_post(Frame& F, int l) {
    PHASE_IDS(F);
    bf16_t* P = (bf16_t*)(F.ws + WS_P);
    const float* rope = (const float*)(F.ws + WS_ROPE);
    const int i16 = lane & 15, hq = lane >> 4; const bool hi2 = hq >= 2;
    const float* qna = INP(F, IN_QNA) + l * 128 + 8 * i16; const float* kna = INP(F, IN_KNA) + l * 128 + 8 * i16;
    const float* qnc = INP(F, IN_QNC) + l * 128 + 8 * i16; const float* knc = INP(F, IN_KNC) + l * 128 + 8 * i16;
    const float* vnb = INP(F, IN_VNB) + l * 512 + 8 * i16;
    for (int r = gw; r < NTOK; r += NGW) {
        const int t = r % TPB; const bool lat = t >= CTXL;
        u32x4* rp = (u32x4*)(P + (size_t)r * INW) + lane;
        u32x4 x[7];
#pragma unroll
        for (int j = 0; j < 7; ++j) x[j] = rp[64 * j];
        const int pos = lat ? t - CTXL : 0, pp = (i16 < 8) ? (pos >> 6) : (pos & 63);
        const f32x4* cs = (const f32x4*)(rope + 2 * (pp * 32 + 8 * (i16 & 3)));
        const f32x4 c0 = cs[0], c1 = cs[1], c2 = cs[2], c3 = cs[3];
        const float cosv[8] = {c0.x, c0.z, c1.x, c1.z, c2.x, c2.z, c3.x, c3.z}, sinv[8] = {c0.y, c0.w, c1.y, c1.w, c2.y, c2.w, c3.y, c3.w};
        const float sgn = (i16 & 4) ? 1.f : -1.f;
#pragma unroll
        for (int j = 0; j < 7; ++j) {
            const bool gelu_lo = (j == 3 || j == 4), gelu_hi = (j == 2 || j == 3);
            const bool norm_lo = (j != 2 && j != 3), norm_hi = (j != 2 && j != 6);
            const bool rope_lo = (j == 0 || j == 1 || j == 5 || j == 6), rope_hi = (j == 0 || j == 1 || j == 4 || j == 5);
            const bool dg = hi2 ? gelu_hi : gelu_lo, dn = hi2 ? norm_hi : norm_lo, dr = (hi2 ? rope_hi : rope_lo) && lat;
            if (!(gelu_lo || gelu_hi || norm_lo || norm_hi)) continue;
            float v[8]; post_unpack(x[j], v);
            if (gelu_lo || gelu_hi) {
#pragma unroll
                for (int e = 0; e < 8; ++e) { const float gv = gelu_tanh(v[e]); v[e] = dg ? gv : v[e]; } }
            if (norm_lo || norm_hi) {
                float ss = 0.f;
#pragma unroll
                for (int e = 0; e < 8; ++e) ss += v[e] * v[e];
                const float rinv = rsqrt_fast(sum16(ss) * (1.f / 128) + EPS);
                const float* gp;
                if (j == 0) gp = qna; else if (j == 1) gp = hi2 ? kna : qna; else if (j == 3) gp = vnb + (hi2 ? hq - 2 : 0) * 128; else if (j == 4) gp = hi2 ? qnc : vnb + (2 + hq) * 128;
                else if (j == 5) gp = qnc; else gp = knc;
                const f32x4 g0 = *(const f32x4*)gp, g1 = *(const f32x4*)(gp + 4);
                const float gg[8] = {g0.x, g0.y, g0.z, g0.w, g1.x, g1.y, g1.z, g1.w};
#pragma unroll
                for (int e = 0; e < 8; ++e) v[e] = dn ? v[e] * rinv * gg[e] : v[e];
            }
            if (rope_lo || rope_hi) {
#pragma unroll
                for (int e = 0; e < 8; ++e) { const float o = __builtin_bit_cast(float, __builtin_amdgcn_ds_swizzle(__builtin_bit_cast(int, v[e]), 0x101F)); const float rv = v[e] * cosv[e] + sgn * o * sinv[e]; v[e] = dr ? rv : v[e]; } }
            u32x4 w; w.x = pk2(v[0], v[1]); w.y = pk2(v[2], v[3]); w.z = pk2(v[4], v[5]); w.w = pk2(v[6], v[7]);
            rp[64 * j] = w;
        }
    }
}

__device__ __forceinline__ void mixer_b_unit(Frame& F, int l, int b, int ch, int g) {
    PHASE_IDS(F);
    const bf16_t* P = (const bf16_t*)(F.ws + WS_P); bf16_t* O = (bf16_t*)(F.ws + WS_O);
    const int row0 = b * TPB + ch * 128, w = wave;
    LAS bf16_t* VT = (LAS bf16_t*)F.lds;
    { const int q = tid >> 2, dp = (tid & 3) * 32; const bf16_t* src = P + (size_t)(row0 + q) * INW + C_VB + g * 128 + dp;
#pragma unroll
      for (int i = 0; i < 4; ++i) { const u32x4 x = *(const u32x4*)(src + 8 * i); const unsigned xs[4] = {x.x, x.y, x.z, x.w};
#pragma unroll
          for (int j = 0; j < 4; ++j) { VT[(dp + 8 * i + 2 * j) * 136 + q] = (bf16_t)(xs[j] & 0xffffu); VT[(dp + 8 * i + 2 * j + 1) * 136 + q] = (bf16_t)(xs[j] >> 16); } } }
    __syncthreads();
    const int i15 = lane & 15, kq = lane >> 4;
    f32x4 acc[8];
#pragma unroll
    for (int n = 0; n < 8; ++n) acc[n] = (f32x4){0.f, 0.f, 0.f, 0.f};
    const float* wsr = INP(F, IN_WS) + ((size_t)(l * 4 + g) * 128 + 16 * w + i15) * 128;
#pragma unroll
    for (int s = 0; s < 4; ++s) {
        const f32x4 a0 = *(const f32x4*)(wsr + 32 * s + 8 * kq), a1 = *(const f32x4*)(wsr + 32 * s + 8 * kq + 4);
        u32x4 aw; aw.x = pk2(a0.x, a0.y); aw.y = pk2(a0.z, a0.w); aw.z = pk2(a1.x, a1.y); aw.w = pk2(a1.z, a1.w);
        const bf16x8 af = *reinterpret_cast<bf16x8*>(&aw);
#pragma unroll
        for (int n = 0; n < 8; ++n) { const bf16x8 bfr = *(const LAS bf16x8*)(VT + (16 * n + i15) * 136 + 32 * s + 8 * kq);
            acc[n] = __builtin_amdgcn_mfma_f32_16x16x32_bf16(af, bfr, acc[n], 0, 0, 0); }
    }
#pragma unroll
    for (int j = 0; j < 4; ++j) { const int p = 16 * w + kq * 4 + j; const float bias = INP(F, IN_BS)[(l * 4 + g) * 128 + p];
        const bf16_t* up = P + (size_t)(row0 + p) * INW + C_UB + g * 128; bf16_t* op = O + (size_t)(row0 + p) * DM + O_B + g * 128;
        float sq = 0.f;
#pragma unroll
        for (int n = 0; n < 8; ++n) { const int d = 16 * n + i15; const float ov = bf2f(up[d]) * (acc[n][j] + bias); sq += ov * ov; op[d] = (bf16_t)f2bf(ov); }
        sq = row16_sum(sq);
        if (i15 == 0) ((float*)(F.ws + WS_SSQ))[(size_t)(row0 + p) * 16 + 6 + g] = sq; }
    __syncthreads();
}
__device__ __forceinline__ void phase_mixers(Frame& F, int l) {
    PHASE_IDS(F);
    const bf16_t* P = (const bf16_t*)(F.ws + WS_P); bf16_t* O = (bf16_t*)(F.ws + WS_O);
    const bool ctx = (l == 0);
    const int nC = 48, nA = 48, nCc = ctx ? 3 : 0, nAc = ctx ? 3 : 0, nB = 68;
    const int total = nC + nA + nCc + nAc + nB;
    for (int kq = 0; kq < 8; ++kq) {
        const int x = ((int)blockIdx.x + kq) & 7, b = x >> 1, kv = x & 1;
        unsigned* qctr = F.ctl + CW_QUEUE + 64 * (l * 8 + x);
        for (;;) {
            if (tid == 0) F.MISC[0] = xb_add(qctr, 1u);
            __syncthreads();
            int u = (int)F.MISC[0];
            __syncthreads();
            if (u >= total) break;
            if (u < nC + nA + nCc + nAc) {
                int kind, h, qb = 0;
                if (u < nC) { kind = 0; h = kv * 3 + u / 16; qb = u % 16; }
                else if (u < nC + nA) { const int v = u - nC; kind = 1; h = kv * 3 + v / 16; qb = v % 16; }
                else if (u < nC + nA + nCc) { kind = 2; h = kv * 3 + (u - nC - nA); }
                else { kind = 3; h = kv * 3 + (u - nC - nA - nCc); }
                const int isA = kind & 1, lat = (kind < 2);
                const size_t r0 = (size_t)b * TPB, rq = r0 + (lat ? CTXL + qb * 256 : 0);
                const int q0 = qb * 256, ks = (kind == 1) ? ((q0 - 128 < 0) ? 0 : q0 - 128) : 0, ke = (q0 + 384 > SEQ) ? SEQ : q0 + 384;
                const int NT = (kind == 0) ? 68 : (kind == 1) ? 4 + (ke - ks) / 64 : 4;
                const float sink = INP(F, IN_SINK)[l * 6 + h];
                const int cq = (isA ? C_QA : C_QC) + h * 128, ck = (isA ? C_KA : C_KC) + kv * 128, cv = (isA ? C_VA : C_VC) + kv * 128, co = (isA ? O_A : O_C) + h * 128;
                at::attn_body(P + rq * INW + cq, P + r0 * INW + ck, P + r0 * INW + cv, O + rq * DM + co, NT, ks, q0, isA ? sink / at::SCALE : -1e30f, isA ? 1.f : 0.f, kind == 1, F.ldsg,
                              (float*)(F.ws + WS_SSQ) + rq * 16 + (isA ? h : 10 + h));
                continue; }
            u -= nC + nA + nCc + nAc;
            { const int ch = u >> 1, g = kv * 2 + (u & 1);
              if (!ctx && ch < 2) continue;
              mixer_b_unit(F, l, b, ch, g); }
        }
    }
    if (CONV_IDLE && (CONV_HOOKS & 1)) {
        __syncthreads();
        if (tid == 0) (void)xb_add(F.ctl + CW_MIXDONE + 64 * l, 1u);
        conv_help(F, 64, F.ctl + CW_MIXDONE + 64 * l, (unsigned)F.G);
    }
}

__device__ __forceinline__ void phase_groupnorm(Frame& F, int l) {
    PHASE_IDS(F);
    bf16_t* O = (bf16_t*)(F.ws + WS_O); const float* og = INP(F, IN_OUTG) + l * DM;
#define GN_SKIP(rr) (l == 1 && ((rr) % TPB) < CTXL)
#define GN_LOAD(rr, xx) do { const bf16_t* _row = O + (size_t)(rr) * DM; \
        _Pragma("unroll") for (int i = 0; i < 3; ++i) { xx[i] = *(const u32x2*)(_row + O_A + 12 * lane + 4 * i); xx[5 + i] = *(const u32x2*)(_row + O_C + 12 * lane + 4 * i); } \
        _Pragma("unroll") for (int i = 0; i < 2; ++i) xx[3 + i] = *(const u32x2*)(_row + O_B + 8 * lane + 4 * i); } while (0)
    int r = gw; while (r < NTOK && GN_SKIP(r)) r += NGW;
    u32x2 x[8], xn[8];
    if (r < NTOK) GN_LOAD(r, x);
    while (r < NTOK) {
        int rn = r + NGW; while (rn < NTOK && GN_SKIP(rn)) rn += NGW;
        if (rn < NTOK) GN_LOAD(rn, xn);
        bf16_t* row = O + (size_t)r * DM;
        float v[8][4]; float ss[3] = {0.f, 0.f, 0.f};
#pragma unroll
        for (int i = 0; i < 8; ++i) { v[i][0] = bflo(x[i].x); v[i][1] = bfhi(x[i].x); v[i][2] = bflo(x[i].y); v[i][3] = bfhi(x[i].y);
            const int grp = (i < 3) ? 0 : (i < 5) ? 1 : 2; ss[grp] += (v[i][0] * v[i][0] + v[i][1] * v[i][1]) + (v[i][2] * v[i][2] + v[i][3] * v[i][3]); }
        float rinv[3];
        rinv[0] = rsqrt_fast(wave_sum(ss[0]) * (1.f / 768) + EPS); rinv[1] = rsqrt_fast(wave_sum(ss[1]) * (1.f / 512) + EPS); rinv[2] = rsqrt_fast(wave_sum(ss[2]) * (1.f / 768) + EPS);
#pragma unroll
        for (int i = 0; i < 8; ++i) { const int grp = (i < 3) ? 0 : (i < 5) ? 1 : 2;
            const int c = (grp == 0) ? O_A + 12 * lane + 4 * i : (grp == 1) ? O_B + 8 * lane + 4 * (i - 3) : O_C + 12 * lane + 4 * (i - 5);
            const f32x4 gg = *(const f32x4*)(og + c); const float ri = rinv[grp];
            u32x2 w; w.x = pk2(v[i][0] * ri * gg.x, v[i][1] * ri * gg.y); w.y = pk2(v[i][2] * ri * gg.z, v[i][3] * ri * gg.w); *(u32x2*)(row + c) = w; }
#pragma unroll
        for (int i = 0; i < 8; ++i) x[i] = xn[i];
        r = rn;
    }
#undef GN_SKIP
#undef GN_LOAD
}

__device__ __forceinline__ float row16_max(float v) {
    v = fmaxf(v, __builtin_bit_cast(float, __builtin_amdgcn_update_dpp(0, __builtin_bit_cast(int, v), 0xB1, 0xF, 0xF, true)));
    v = fmaxf(v, __builtin_bit_cast(float, __builtin_amdgcn_update_dpp(0, __builtin_bit_cast(int, v), 0x4E, 0xF, 0xF, true)));
    v = fmaxf(v, __builtin_bit_cast(float, __builtin_amdgcn_update_dpp(0, __builtin_bit_cast(int, v), 0x141, 0xF, 0xF, true)));
    v = fmaxf(v, __builtin_bit_cast(float, __builtin_amdgcn_update_dpp(0, __builtin_bit_cast(int, v), 0x140, 0xF, 0xF, true)));
    return v;
}
__device__ __forceinline__ void phase_rowpass2(Frame& F, int l) {
    PHASE_IDS(F);
    const bf16_t* xb = (const bf16_t*)(F.ws + WS_XB); const float* parts = (const float*)(F.ws + WS_PART);
    const bool f8 = (l == 0) ? (FP8_L0 != 0) : (FP8_L1 != 0);
    { const u32x4* wf = (const u32x4*)((const bf16_t*)(F.ws + WS_WRS) + (size_t)l * 64 * 2 * 64 * 8) + tid; u32x4 t[16];
#pragma unroll
      for (int i = 0; i < 16; ++i) t[i] = wf[512 * i];
#pragma unroll
      for (int i = 0; i < 16; ++i) ((LAS u32x4*)F.lds)[tid + 512 * i] = t[i]; }
    LAS f32x4* red = (LAS f32x4*)(F.lds + LDSCTL_OFF + 2048);
    __syncthreads();
    const int i16 = lane & 15, q = lane >> 4;
#define RP2_SKIP(tl) (l == 1 && ((tl) * 16) % TPB < CTXL)
#define RP2_LOAD(tl, xx, pp0, pp1) do { const int _row = (tl) * 16 + i16; const bf16_t* _xr = xb + (size_t)_row * DM + 256 * wave + 8 * q; \
        _Pragma("unroll") for (int sidx = 0; sidx < 8; ++sidx) xx[sidx] = *(const u32x4*)(_xr + 32 * sidx); \
        pp0 = *(const f32x4*)(parts + (size_t)_row * 32 + 8 * q); pp1 = *(const f32x4*)(parts + (size_t)_row * 32 + 8 * q + 4); } while (0)
    int tile = blockIdx.x; while (tile < NTOK / 16 && RP2_SKIP(tile)) tile += F.G;
    u32x4 x[8], xn[8]; f32x4 p0, p1, p0n, p1n;
    if (tile < NTOK / 16) RP2_LOAD(tile, x, p0, p1);
    while (tile < NTOK / 16) {
        int ntile = tile + F.G; while (ntile < NTOK / 16 && RP2_SKIP(ntile)) ntile += F.G;
        if (ntile < NTOK / 16) RP2_LOAD(ntile, xn, p0n, p1n);
        const int r0 = tile * 16, b = r0 / TPB, t0 = r0 % TPB, sv = (t0 < CTXL) ? 4 : b;
        const int row = r0 + i16;
        float ss = ((p0.x + p0.y) + (p0.z + p0.w)) + ((p1.x + p1.y) + (p1.z + p1.w));
        ss += __builtin_bit_cast(float, __builtin_amdgcn_ds_swizzle(__builtin_bit_cast(int, ss), 0x401F));
        { auto rr = __builtin_amdgcn_permlane32_swap(__float_as_uint(ss), __float_as_uint(ss), false, false); ss = __uint_as_float(rr[0]) + __uint_as_float(rr[1]); }
        const float rinv = rsqrt_fast(ss * (1.f / DM) + EPS);
        const float* gs = (const float*)(F.ws + WS_GS2) + ((size_t)(l * 5 + sv) * DM + 256 * wave + 8 * q) * 2;
        f32x4 acc = (f32x4){0.f, 0.f, 0.f, 0.f};
#pragma unroll
        for (int sidx = 0; sidx < 8; ++sidx) {
            const f32x4 g0 = *(const f32x4*)(gs + 64 * sidx), g1 = *(const f32x4*)(gs + 64 * sidx + 4), g2 = *(const f32x4*)(gs + 64 * sidx + 8), g3 = *(const f32x4*)(gs + 64 * sidx + 12);
            float h[8];
            h[0] = bflo(x[sidx].x) * rinv * g0.x + g0.y; h[1] = bfhi(x[sidx].x) * rinv * g0.z + g0.w; h[2] = bflo(x[sidx].y) * rinv * g1.x + g1.y; h[3] = bfhi(x[sidx].y) * rinv * g1.z + g1.w;
            h[4] = bflo(x[sidx].z) * rinv * g2.x + g2.y; h[5] = bfhi(x[sidx].z) * rinv * g2.z + g2.w; h[6] = bflo(x[sidx].w) * rinv * g3.x + g3.y; h[7] = bfhi(x[sidx].w) * rinv * g3.z + g3.w;
            const int col = 256 * wave + 32 * sidx + 8 * q;
            if (f8) { u32x2 w8; w8.x = pk4_fp8(h[0], h[1], h[2], h[3]); w8.y = pk4_fp8(h[4], h[5], h[6], h[7]); *(u32x2*)((unsigned char*)(F.ws + WS_HN8) + (size_t)row * DM + col) = w8; }
            else { u32x4 w16; w16.x = pk2(h[0], h[1]); w16.y = pk2(h[2], h[3]); w16.z = pk2(h[4], h[5]); w16.w = pk2(h[6], h[7]); *(u32x4*)((bf16_t*)(F.ws + WS_HN) + (size_t)row * DM + col) = w16; }
            unsigned hh[8], hl[8];
#pragma unroll
            for (int j = 0; j < 8; ++j) { hh[j] = f2bf(h[j]); hl[j] = f2bf(h[j] - __builtin_bit_cast(float, hh[j] << 16)); }
            u32x4 ah, al; ah.x = hh[0] | (hh[1] << 16); ah.y = hh[2] | (hh[3] << 16); ah.z = hh[4] | (hh[5] << 16); ah.w = hh[6] | (hh[7] << 16);
            al.x = hl[0] | (hl[1] << 16); al.y = hl[2] | (hl[3] << 16); al.z = hl[4] | (hl[5] << 16); al.w = hl[6] | (hl[7] << 16);
            const LAS unsigned char* bp = F.lds + (size_t)((wave * 8 + sidx) * 2) * 1024 + lane * 16;
            const bf16x8 bh = *(const LAS bf16x8*)bp, bl = *(const LAS bf16x8*)(bp + 1024);
            const bf16x8 fah = __builtin_bit_cast(bf16x8, ah), fal = __builtin_bit_cast(bf16x8, al);
            acc = __builtin_amdgcn_mfma_f32_16x16x32_bf16(fah, bh, acc, 0, 0, 0);
            acc = __builtin_amdgcn_mfma_f32_16x16x32_bf16(fah, bl, acc, 0, 0, 0);
            acc = __builtin_amdgcn_mfma_f32_16x16x32_bf16(fal, bh, acc, 0, 0, 0);
        }
        red[wave * 64 + lane] = acc;
        __syncthreads();
        if (wave == 0) {
            f32x4 lg = red[lane];
#pragma unroll
            for (int w = 1; w < 8; ++w) lg += red[w * 64 + lane];
#pragma unroll
            for (int reg = 0; reg < 4; ++reg) { const float mx = row16_max(lg[reg]); const float ex = __expf(lg[reg] - mx); const float a = ex / row16_sum(ex);
                const int t = t0 + 4 * q + reg;
                if (t < CTXL) ((float*)(F.ws + WS_AFFC))[((size_t)b * NE + i16) * CTXL + t] = a;
                else ((float*)(F.ws + WS_AFFL))[((size_t)b * NE + i16) * SEQ + (t - CTXL)] = a; }
        }
        __syncthreads();
#pragma unroll
        for (int sidx = 0; sidx < 8; ++sidx) x[sidx] = xn[sidx];
        p0 = p0n; p1 = p1n; tile = ntile;
    }
#undef RP2_SKIP
#undef RP2_LOAD
    __syncthreads();
}

__device__ __forceinline__ unsigned block_excl_scan(unsigned v, LAS unsigned* scr, int lane, int wave, unsigned& total) {
    unsigned inc = v;
#pragma unroll
    for (int o = 1; o < 64; o <<= 1) { const unsigned t = __shfl_up(inc, o); if (lane >= o) inc += t; }
    if (lane == 63) scr[wave] = inc;
    __syncthreads();
    unsigned base = 0, tot = 0;
#pragma unroll
    for (int w = 0; w < 8; ++w) { const unsigned x = scr[w]; base += (w < wave) ? x : 0u; tot += x; }
    __syncthreads();
    total = tot;
    return base + inc - v;
}
__device__ __forceinline__ void phase_topk(Frame& F, int l) {
    PHASE_IDS(F);
    LAS unsigned* hist = (LAS unsigned*)F.lds;
    LAS unsigned* scr = (LAS unsigned*)(F.lds + 8192);
    LAS int* rowsrc = (LAS int*)(F.lds + 8192 + 128);
    const int nunits = (l == 0) ? 128 : 64;
    const bool f8 = (l == 0) ? (FP8_L0 != 0) : (FP8_L1 != 0); const int RBg = f8 ? DM : 2 * DM;
    for (int u = blockIdx.x; u < nunits; u += F.G) {
        const bool isc = u >= 64; const int uu = isc ? u - 64 : u, b = uu / NE, e = uu % NE;
        const int N = isc ? CTXL : SEQ; const unsigned cap = isc ? CAP_C : CAP_L;
        const float* src = isc ? (const float*)(F.ws + WS_AFFC) + (size_t)uu * CTXL : (const float*)(F.ws + WS_AFFL) + (size_t)uu * SEQ;
        int* pos = isc ? (int*)(F.ws + WS_POSC) + (size_t)uu * CTXL : (int*)(F.ws + WS_POSL) + (size_t)uu * SEQ;
        const bool own = tid * 8 < N;
        unsigned key[8];
        { u32x4 k0 = (u32x4){0u, 0u, 0u, 0u}, k1 = k0; if (own) { k0 = *(const u32x4*)(src + tid * 8); k1 = *(const u32x4*)(src + tid * 8 + 4); }
          key[0] = k0.x; key[1] = k0.y; key[2] = k0.z; key[3] = k0.w; key[4] = k1.x; key[5] = k1.y; key[6] = k1.z; key[7] = k1.w; }
        unsigned prefix = 0u, remaining = cap;
#pragma unroll
        for (int p = 0; p < 3; ++p) {
            const int shift = (p == 0) ? 21 : (p == 1) ? 10 : 0, bits = (p == 2) ? 10 : 11, nb = 1 << bits;
            for (int i = tid; i < nb; i += 512) hist[i] = 0u;
            __syncthreads();
            if (own) {
#pragma unroll
                for (int q = 0; q < 8; ++q) { const bool cand = (p == 0) ? true : ((key[q] >> (shift + bits)) == prefix);
                    if (cand) (void)__hip_atomic_fetch_add(&hist[(key[q] >> shift) & (nb - 1)], 1u, __ATOMIC_RELAXED, __HIP_MEMORY_SCOPE_WORKGROUP); } }
            __syncthreads();
            unsigned c[4];
#pragma unroll
            for (int q = 0; q < 4; ++q) c[q] = (4 * tid + q < nb) ? hist[4 * tid + q] : 0u;
            const unsigned sm = (c[0] + c[1]) + (c[2] + c[3]);
            unsigned total; const unsigned ex = block_excl_scan(sm, scr, lane, wave, total);
            unsigned above = total - (ex + sm);
#pragma unroll
            for (int q = 3; q >= 0; --q) { if (above < remaining && remaining <= above + c[q]) { scr[16] = (unsigned)(4 * tid + q); scr[17] = above; } above += c[q]; }
            __syncthreads();
            const unsigned B = scr[16], ca = scr[17];
            remaining -= ca; prefix = (prefix << bits) | B;
            __syncthreads();
        }
        const unsigned T = prefix;
        unsigned ce = 0u;
#pragma unroll
        for (int q = 0; q < 8; ++q) ce += (own && key[q] == T) ? 1u : 0u;
        unsigned tot; unsigned er = block_excl_scan(ce, scr, lane, wave, tot);
        bool sel[8]; unsigned cs = 0u;
#pragma unroll
        for (int q = 0; q < 8; ++q) { const bool eq = own && key[q] == T; sel[q] = own && (key[q] > T || (eq && er < remaining)); er += eq ? 1u : 0u; cs += sel[q] ? 1u : 0u; }
        unsigned sl = block_excl_scan(cs, scr, lane, wave, tot);
        const int slotbase = e * ROWS_E + (isc ? 2048 + b * CAP_C : b * CAP_L);
        int pv[8];
#pragma unroll
        for (int q = 0; q < 8; ++q) { pv[q] = sel[q] ? (int)sl : -1;
            if (sel[q]) { rowsrc[sl] = b * TPB + (isc ? 0 : CTXL) + tid * 8 + q; ((float*)(F.ws + WS_GATE))[slotbase + sl] = __uint_as_float(key[q]); ++sl; } }
        if (own) { *(i32x4*)(pos + tid * 8) = (i32x4){pv[0], pv[1], pv[2], pv[3]}; *(i32x4*)(pos + tid * 8 + 4) = (i32x4){pv[4], pv[5], pv[6], pv[7]}; }
        __syncthreads();
        unsigned* offs = (unsigned*)(F.ws + WS_OFFS);
        int R[2], C[2];
#pragma unroll
        for (int i = 0; i < 2; ++i) pg8::stage_rc(tid * 16 + i * 8192, R[i], C[i]);
        if (!isc) {
#pragma unroll
            for (int th = 0; th < 2; ++th) { u32x4 o;
                o.x = (unsigned)rowsrc[th * 256 + R[0]] * RBg + 2 * C[0]; o.y = (unsigned)rowsrc[th * 256 + R[1]] * RBg + 2 * C[1];
                o.z = (unsigned)rowsrc[th * 256 + 128 + R[0]] * RBg + 2 * C[0]; o.w = (unsigned)rowsrc[th * 256 + 128 + R[1]] * RBg + 2 * C[1];
                *(u32x4*)(offs + ((size_t)(e * 9 + 2 * b + th) * 512 + tid) * 4) = o; }
        } else {
            unsigned* o = offs + ((size_t)(e * 9 + 8) * 512 + tid) * 4;
#pragma unroll
            for (int i = 0; i < 2; ++i) { if (R[i] >= 32 * b && R[i] < 32 * b + 32) o[i] = (unsigned)rowsrc[R[i] - 32 * b] * RBg + 2 * C[i]; if (b == 0) o[2 + i] = 2 * C[i]; }
        }
        __syncthreads();
    }
}

__device__ __forceinline__ void phase_combine(Frame& F, int l) {
    PHASE_IDS(F);
    const float* mod = (const float*)(F.ws + WS_MOD);
    bf16_t* xb = (bf16_t*)(F.ws + WS_XB); const bf16_t* Y = (const bf16_t*)(F.ws + WS_XG);
    const bool y8 = (l == 0) ? (FP8_L0 != 0) : (FP8_L1 != 0);
    for (int r = gw; r < NTOK; r += NGW) {
        const int b = r / TPB, t = r % TPB, s = (t < CTXL) ? 4 : b;
        if (l == 1 && t < CTXL) continue;
        int p = -1;
        if (lane < NE) p = (t < CTXL) ? ((const int*)(F.ws + WS_POSC))[((size_t)b * NE + lane) * CTXL + t] : ((const int*)(F.ws + WS_POSL))[((size_t)b * NE + lane) * SEQ + (t - CTXL)];
        float gt = 0.f;
        if (p >= 0) gt = ((const float*)(F.ws + WS_GATE))[lane * ROWS_E + ((t < CTXL) ? 2048 + b * CAP_C : b * CAP_L) + p];
        f32x4 v[8];
        { const bf16_t* xr = xb + (size_t)r * DM + 4 * lane; u32x2 xw[8];
#pragma unroll
          for (int j = 0; j < 8; ++j) xw[j] = *(const u32x2*)(xr + 256 * j);
#pragma unroll
          for (int j = 0; j < 8; ++j) v[j] = (f32x4){bflo(xw[j].x), bfhi(xw[j].x), bflo(xw[j].y), bfhi(xw[j].y)}; }
        const float* g2 = mod + (size_t)(l * 5 + s) * NMOD + 5 * DM;
        f32x4 gv[8];
#pragma unroll
        for (int j = 0; j < 8; ++j) gv[j] = *(const f32x4*)(g2 + 4 * lane + 256 * j);
        f32x4 a[8];
#pragma unroll
        for (int j = 0; j < 8; ++j) a[j] = (f32x4){0.f, 0.f, 0.f, 0.f};
        unsigned long long m = __ballot(p >= 0);
        const int ybase = (t < CTXL) ? 2048 + b * CAP_C : b * CAP_L;
        while (m) {
            const int e0 = __builtin_ctzll(m); m &= m - 1;
            const bool two = (m != 0ull); const int e1 = two ? __builtin_ctzll(m) : e0; if (two) m &= m - 1;
            const int p0 = __builtin_amdgcn_readlane(p, e0), p1 = __builtin_amdgcn_readlane(p, e1);
            const float q0 = __builtin_bit_cast(float, __builtin_amdgcn_readlane(__builtin_bit_cast(int, gt), e0)), q1 = __builtin_bit_cast(float, __builtin_amdgcn_readlane(__builtin_bit_cast(int, gt), e1));
            if (y8) {
                const unsigned char* y0 = (const unsigned char*)Y + (size_t)(e0 * ROWS_E + ybase + p0) * DM + 4 * lane; const unsigned char* y1 = (const unsigned char*)Y + (size_t)(e1 * ROWS_E + ybase + p1) * DM + 4 * lane;
                unsigned w0[8], w1[8];
#pragma unroll
                for (int j = 0; j < 8; ++j) w0[j] = *(const unsigned*)(y0 + 256 * j);
                if (two) {
#pragma unroll
                    for (int j = 0; j < 8; ++j) w1[j] = *(const unsigned*)(y1 + 256 * j); }
#pragma unroll
                for (int j = 0; j < 8; ++j) { const f32x2 lo = __builtin_amdgcn_cvt_pk_f32_fp8((int)w0[j], false), hi = __builtin_amdgcn_cvt_pk_f32_fp8((int)w0[j], true); a[j] += (f32x4){lo.x, lo.y, hi.x, hi.y} * q0; }
                if (two) {
#pragma unroll
                    for (int j = 0; j < 8; ++j) { const f32x2 lo = __builtin_amdgcn_cvt_pk_f32_fp8((int)w1[j], false), hi = __builtin_amdgcn_cvt_pk_f32_fp8((int)w1[j], true); a[j] += (f32x4){lo.x, lo.y, hi.x, hi.y} * q1; } }
            } else {
            const bf16_t* y0 = Y + (size_t)(e0 * ROWS_E + ybase + p0) * DM + 4 * lane; const bf16_t* y1 = Y + (size_t)(e1 * ROWS_E + ybase + p1) * DM + 4 * lane;
            u32x2 w0[8], w1[8];
#pragma unroll
            for (int j = 0; j < 8; ++j) w0[j] = *(const u32x2*)(y0 + 256 * j);
            if (two) {
#pragma unroll
                for (int j = 0; j < 8; ++j) w1[j] = *(const u32x2*)(y1 + 256 * j); }
#pragma unroll
            for (int j = 0; j < 8; ++j) a[j] += (f32x4){bflo(w0[j].x), bfhi(w0[j].x), bflo(w0[j].y), bfhi(w0[j].y)} * q0;
            if (two) {
#pragma unroll
                for (int j = 0; j < 8; ++j) a[j] += (f32x4){bflo(w1[j].x), bfhi(w1[j].x), bflo(w1[j].y), bfhi(w1[j].y)} * q1; }
            }
        }
#pragma unroll
        for (int j = 0; j < 8; ++j) v[j] += gv[j] * a[j];
        if (l == 0) {
#pragma unroll
            for (int j = 0; j < 8; ++j) { u32x2 w; w.x = pk2(v[j].x, v[j].y); w.y = pk2(v[j].z, v[j].w); *(u32x2*)(xb + (size_t)r * DM + 4 * lane + 256 * j) = w; }
            const float* m1 = mod + (size_t)(5 + s) * NMOD;
            norm_mod_store(v, INP(F, IN_N1G) + DM, m1, m1 + DM, (bf16_t*)(F.ws + WS_HN) + (size_t)r * DM, lane);
        } else {
            float* op = F.out + ((size_t)b * SEQ + (t - CTXL)) * DM;
#pragma unroll
            for (int j = 0; j < 8; ++j) *(f32x4*)(op + 4 * lane + 256 * j) = v[j];
        }
    }
}

__device__ __forceinline__ void phase_dump_x(Frame& F, bool from_input) {
    PHASE_IDS(F);
    for (int r = gw; r < NTOK; r += NGW) {
        const int b = r / TPB, t = r % TPB; if (t < CTXL) continue;
        const float* src = INP(F, IN_X) + ((size_t)b * SEQ + (t - CTXL)) * DM; (void)from_input;
        f32x4 v[8]; load_row(src, lane, v);
        float* op = F.out + ((size_t)b * SEQ + (t - CTXL)) * DM;
#pragma unroll
        for (int j = 0; j < 8; ++j) *(f32x4*)(op + 4 * lane + 256 * j) = v[j];
    }
}

constexpr int N_PHASES = 2 + 11 * NLAYER;
__global__ void __launch_bounds__(512, 2) fwd_kernel(Args args) {
    extern __shared__ __attribute__((aligned(16))) unsigned char lds[];
    Frame F;
    F.lds = (LAS unsigned char*)lds; F.ldsg = (char*)lds;
    F.MISC = (volatile LAS unsigned*)(F.lds + MISC_OFF);
    F.G = gridDim.x;
    F.out = args.out; F.ws = args.ws; F.ctl = (unsigned*)(args.ws + WS_CTL);
    for (int u = threadIdx.x; u < (LDS_BYTES - LDSCTL_OFF) / 4; u += 512) ((LAS unsigned*)(F.lds + LDSCTL_OFF))[u] = 0u;
    __syncthreads();
    if (threadIdx.x < 23) { const unsigned long long pv = (unsigned long long)args.in[threadIdx.x]; LAS unsigned* t = (LAS unsigned*)(F.lds + ARGTAB_OFF) + 2 * threadIdx.x; t[0] = (unsigned)pv; t[1] = (unsigned)(pv >> 32); }
    __syncthreads();
    XcdBarrier bar; bar.bar = F.ctl + CW_BAR; bar.x = 0; bar.st = nullptr;
    if (!MK_PER_PHASE) bar = xcd_barrier_post(F.ctl + CW_BAR, F.MISC + 8);
    const int lo = args.ph_lo, hi = args.ph_hi;
#define IN(k) (lo <= (k) && (k) < hi)
    unsigned long long probe_t0 = 0ull, probe_acc = 0ull;
#define PROBE_BEGIN(k) do { if (PROBE_MASK & (1u << (k))) probe_t0 = __builtin_amdgcn_s_memrealtime(); } while (0)
#define SEAM(k) do { if (IN(k) && IN((k) + 1)) xcd_barrier(bar); if (PROBE_MASK & (1u << (k))) probe_acc += __builtin_amdgcn_s_memrealtime() - probe_t0; } while (0)

    if (IN(0)) { PROBE_BEGIN(0); if (PH_ON(0)) phase_prologue(F); if (IN(1)) xcd_barrier_first(bar); if (PROBE_MASK & 1u) probe_acc += __builtin_amdgcn_s_memrealtime() - probe_t0; }
    if (IN(1)) { PROBE_BEGIN(1); if (PH_ON(1)) phase_rowpass1_l0(F); SEAM(1); }
    for (int l = 0; l < NLAYER; ++l) {
        const int pb = 2 + 11 * l;
        const bool ctx = (l == 0);
        if (IN(pb + 0)) { PROBE_BEGIN(pb + 0); if (PH_ON(2)) {
            pg8::SchedDense S; S.init(F.ws + WS_HN, F.ws + WS_WIN + (size_t)l * INW * DM * 2, NTOK / 256, INW / 256, F.G, (int)blockIdx.x, 0);
            pg8::EpiPost E{(bf16_t*)(F.ws + WS_P), (const float*)(F.ws + WS_ROPE), INP(F, IN_QNA) + l * 128, INP(F, IN_KNA) + l * 128, INP(F, IN_QNC) + l * 128, INP(F, IN_KNC) + l * 128, INP(F, IN_VNB) + l * 512, F.lds + LDSCTL_OFF + 2048};
            pg8::gemm_phase<pg8::EpiPost, pg8::SchedDense>(F.lds, S, E);
            if ((CONV_HOOKS & 2) && (int)blockIdx.x >= (NTOK / 256) * (INW / 256) - 3 * F.G) conv_help(F, 10, nullptr, 0u); }
            SEAM(pb + 0); }
        if (IN(pb + 2)) { PROBE_BEGIN(pb + 2); if (PH_ON(4)) phase_mixers(F, l); SEAM(pb + 2); }
        if (IN(pb + 4)) { PROBE_BEGIN(pb + 4); if (PH_ON(6)) {
            pg8::SchedDense S; S.init(F.ws + WS_O, F.ws + WS_WOUT + (size_t)l * DM * DM * 2, ctx ? NTOK / 256 : 64, DM / 256, F.G, (int)blockIdx.x, ctx ? 0 : 1);
            bf16_t* xb = (bf16_t*)(F.ws + WS_XB);
            pg8::EpiResid E;
            E.ctxbase = INP(F, IN_CTX); E.latbase = INP(F, IN_X); E.cbs = CTXL; E.lbs = SEQ; E.src16 = (l == 0) ? nullptr : xb;
            E.xout = xb; E.modl = (const float*)(F.ws + WS_MOD) + (size_t)l * 5 * NMOD; E.parts = (float*)(F.ws + WS_PART); E.ktab = F.lds + LDSCTL_OFF + 2048;
            { const float* ssq = (const float*)(F.ws + WS_SSQ); LAS f32x4* kt = (LAS f32x4*)(F.lds + LDSCTL_OFF + 2048); const int tz = opaque_tid();
              for (int i = 0; i < 3; ++i) { pg8::Unit uu; if (!S.next(i, uu)) break;
                  if (tz < 256) { const f32x4* sp = (const f32x4*)(ssq + (size_t)(uu.rowbase + tz) * 16); const f32x4 s0 = sp[0], s1 = sp[1], s2 = sp[2], s3 = sp[3];
                      const float qa = ((s0.x + s0.y) + (s0.z + s0.w)) + (s1.x + s1.y), qb = (s1.z + s1.w) + (s2.x + s2.y), qc = ((s2.z + s2.w) + (s3.x + s3.y)) + (s3.z + s3.w);
                      const float ra = rsqrt_fast(qa * (1.f / 768) + EPS), rb = rsqrt_fast(qb * (1.f / 512) + EPS), rc = rsqrt_fast(qc * (1.f / 768) + EPS);
                      kt[i * 256 + tz] = (f32x4){ra / rb, rb / rc, rc, 0.f}; } }
              __syncthreads(); }
            pg8::gemm_phase<pg8::EpiResid, pg8::SchedDense, false, false, true>(F.lds, S, E, nullptr, F.lds + LDSCTL_OFF + 2048);
            if ((CONV_HOOKS & 4) && ctx && (int)blockIdx.x >= (NTOK / 256) * (DM / 256) - 2 * F.G) conv_help(F, 9, nullptr, 0u); }
            SEAM(pb + 4); }
        if (IN(pb + 5)) { PROBE_BEGIN(pb + 5); if (PH_ON(7)) phase_rowpass2(F, l); SEAM(pb + 5); }
        if (IN(pb + 6)) { PROBE_BEGIN(pb + 6); if (PH_ON(8)) { phase_topk(F, l);
            if (l == 0) { if ((CONV_HOOKS & 8) && (int)blockIdx.x >= 128) conv_help(F, 2, nullptr, 0u); } else conv_help(F, 1 << 20, nullptr, 0u); }
            SEAM(pb + 6); }
        if (IN(pb + 8)) { PROBE_BEGIN(pb + 8); if (PH_ON(10)) {
            if ((l == 0) ? (FP8_L0 != 0) : (FP8_L1 != 0)) {
                pg8::SchedGrouped<pg8::GK> S; S.init(F.ws + WS_HN8, F.ws + WS_WGU + (size_t)l * NE * 4096 * DM * 2, ctx ? 9 : 8, 16, F.G, (int)blockIdx.x);
                pg8::EpiSwiGLU8 E{(unsigned char*)(F.ws + WS_H)};
                pg8::gemm_phase<pg8::EpiSwiGLU8, pg8::SchedGrouped<pg8::GK>, true, true>(F.lds, S, E, (const unsigned*)(F.ws + WS_OFFS), F.lds + LDSCTL_OFF + 2048);
            } else {
                pg8::SchedGrouped<2 * pg8::GK> S; S.init(F.ws + WS_HN, F.ws + WS_WGU + (size_t)l * NE * 4096 * DM * 2, ctx ? 9 : 8, 16, F.G, (int)blockIdx.x);
                pg8::EpiSwiGLU E{(bf16_t*)(F.ws + WS_H)};
                pg8::gemm_phase<pg8::EpiSwiGLU, pg8::SchedGrouped<2 * pg8::GK>, false, true>(F.lds, S, E, (const unsigned*)(F.ws + WS_OFFS), F.lds + LDSCTL_OFF + 2048);
            } }
            SEAM(pb + 8); }
        if (IN(pb + 9)) { PROBE_BEGIN(pb + 9); if (PH_ON(11)) {
            pg8::EpiStoreBf16 E{(bf16_t*)(F.ws + WS_XG), DM};
            if ((l == 0) ? (FP8_L0 != 0) : (FP8_L1 != 0)) {
                pg8::SchedGrouped<pg8::GK> S; S.init(F.ws + WS_H, F.ws + WS_WD + (size_t)l * NE * DM * DM * 2, ctx ? 9 : 8, 8, F.G, (int)blockIdx.x);
                pg8::EpiStoreFp8 E8{(unsigned char*)(F.ws + WS_XG), DM};
                pg8::gemm_phase<pg8::EpiStoreFp8, pg8::SchedGrouped<pg8::GK>, true>(F.lds, S, E8);
                if ((CONV_HOOKS & 16) && ctx && (((int)blockIdx.x >> 3) & 31) >= 16) conv_help(F, 3, nullptr, 0u);
            } else {
                pg8::SchedGrouped<2 * pg8::GK> S; S.init(F.ws + WS_H, F.ws + WS_WD + (size_t)l * NE * DM * DM * 2, ctx ? 9 : 8, 8, F.G, (int)blockIdx.x);
                pg8::gemm_phase<pg8::EpiStoreBf16, pg8::SchedGrouped<2 * pg8::GK>, false>(F.lds, S, E);
            } }
            SEAM(pb + 9); }
        if (IN(pb + 10)) { PROBE_BEGIN(pb + 10); if (PH_ON(12)) phase_combine(F, l); if (l + 1 < NLAYER) SEAM(pb + 10); else if (PROBE_MASK & (1u << (pb + 10))) probe_acc += __builtin_amdgcn_s_memrealtime() - probe_t0; }
    }
    if (PROBE_MASK) { const unsigned long long te = __builtin_amdgcn_s_memrealtime(); while (__builtin_amdgcn_s_memrealtime() - te < probe_acc) __builtin_amdgcn_s_sleep(8); }
#undef IN
#undef SEAM
}

extern "C" void kernel_launch(void* const* d_in, const int* in_sizes, int n_in, void* d_out, int out_size, void* d_ws, size_t ws_size, hipStream_t stream) {
    static int grid = 0;
    if (grid == 0) {
        if (n_in != 23 || out_size != NB * SEQ * DM || ws_size < WS_END) { fprintf(stderr, "kernel_launch: shape mismatch: n_in %d out %d ws %zu (need %zu)\n", n_in, out_size, ws_size, (size_t)WS_END); grid = -1; return; }
        int dev = 0, cus = 0, per_cu = 0;
        if (hipGetDevice(&dev) != hipSuccess || hipDeviceGetAttribute(&cus, hipDeviceAttributeMultiprocessorCount, dev) != hipSuccess) { grid = -1; return; }
        if (hipFuncSetAttribute((const void*)fwd_kernel, hipFuncAttributeMaxDynamicSharedMemorySize, LDS_BYTES) != hipSuccess) { fprintf(stderr, "kernel_launch: hipFuncSetAttribute failed\n"); grid = -1; return; }
        if (hipOccupancyMaxActiveBlocksPerMultiprocessor(&per_cu, (const void*)fwd_kernel, 512, LDS_BYTES) != hipSuccess || per_cu < 1) { fprintf(stderr, "kernel_launch: occupancy query says %d\n", per_cu); }
        (void)hipGetLastError();
        grid = cus;
    }
    if (grid < 0) return;
    if (hipMemsetAsync((char*)d_ws + WS_CTL, 0, CTL_ZERO_BYTES, stream) != hipSuccess) return;
    Args a{};
    for (int i = 0; i < 23; ++i) a.in[i] = (const float*)d_in[i];
    a.out = (float*)d_out; a.ws = (unsigned char*)d_ws;
#if MK_PER_PHASE
    for (int p = 0; p < N_PHASES; ++p) { a.ph_lo = p; a.ph_hi = p + 1; hipLaunchKernelGGL(fwd_kernel, dim3(grid), dim3(512), LDS_BYTES, stream, a); }
#else
    a.ph_lo = 0; a.ph_hi = N_PHASES;
    hipLaunchKernelGGL(fwd_kernel, dim3(grid), dim3(512), LDS_BYTES, stream, a);
#endif
    const hipError_t le = hipPeekAtLastError();
    if (le != hipSuccess) fprintf(stderr, "kernel_launch: launch failed: %s\n", hipGetErrorName(le));
}
```

```cpp
#include <hip/hip_runtime.h>
#include <cstdio>
#include <cstdint>

#define LAS __attribute__((address_space(3)))
#define GAS __attribute__((address_space(1)))
typedef unsigned short bf16_t;
typedef short bf16x8 __attribute__((ext_vector_type(8)));
typedef short s16x4 __attribute__((ext_vector_type(4)));
typedef float f32x2 __attribute__((ext_vector_type(2)));
typedef float f32x4 __attribute__((ext_vector_type(4)));
typedef float f32x16 __attribute__((ext_vector_type(16)));
typedef unsigned u32x2 __attribute__((ext_vector_type(2)));
typedef unsigned u32x4 __attribute__((ext_vector_type(4)));
typedef int i32x4 __attribute__((ext_vector_type(4)));
typedef int i32x8 __attribute__((ext_vector_type(8)));

#ifndef MK_PER_PHASE
#define MK_PER_PHASE 0
#endif
#ifndef PHASE_MASK
#define PHASE_MASK 0x1fff
#endif
#define PH_ON(k) (((PHASE_MASK) >> (k)) & 1)
#ifndef FP8_L0
#define FP8_L0 1
#endif
#ifndef FP8_L1
#define FP8_L1 1
#endif
#ifndef PROBE_MASK
#define PROBE_MASK 0u
#endif
#ifndef DBG_STOP
#define DBG_STOP 0
#endif

constexpr int DM = 2048, NB = 4, SEQ = 4096, CTXL = 256, TPB = SEQ + CTXL, NTOK = NB * TPB;
constexpr int INW = 3584, NE = 16, NLAYER = 2, NMOD = 6 * DM;
constexpr int C_QA = 0, C_KA = 768, C_VA = 1024, C_UB = 1280, C_VB = 1792, C_QC = 2304, C_KC = 3072, C_VC = 3328;
constexpr int O_A = 0, O_B = 768, O_C = 1280;
constexpr int CAP_L = 512, CAP_C = 32, ROWS_E = 2304;
constexpr float EPS = 1e-6f;

constexpr size_t MiB = 1u << 20;
constexpr size_t WS_CTL = 0, CTL_ZERO_BYTES = 65536;
constexpr size_t WS_MOD = 1 * MiB;
constexpr size_t WS_ROPE = 2 * MiB;
constexpr size_t WS_AFFL = 3 * MiB;
constexpr size_t WS_AFFC = 4 * MiB;
constexpr size_t WS_POSL = 5 * MiB;
constexpr size_t WS_POSC = 6 * MiB;
constexpr size_t WS_OFFS = 10 * MiB;
constexpr size_t WS_GATE = 8 * MiB;
constexpr size_t WS_WRT = 9 * MiB;
constexpr size_t WS_WRS = 11 * MiB;
constexpr size_t WS_GS2 = 12 * MiB;
constexpr size_t WS_PART = 13 * MiB + 0;
constexpr size_t WS_SSQ = 14 * MiB;
constexpr size_t WS_WIN = 16 * MiB;
constexpr size_t WS_WOUT = WS_WIN + (size_t)2 * INW * DM * 2;
constexpr size_t WS_WGU = WS_WOUT + (size_t)2 * DM * DM * 2;
constexpr size_t WS_WD = WS_WGU + (size_t)2 * NE * 4096 * DM * 2;
constexpr size_t WS_HN = WS_WD + (size_t)2 * NE * DM * DM * 2;
constexpr size_t WS_P = WS_HN + (size_t)NTOK * DM * 2;
constexpr size_t WS_O = WS_P + (size_t)NTOK * INW * 2;
constexpr size_t WS_XB = WS_O + (size_t)NTOK * DM * 2;
constexpr size_t WS_XG = WS_XB + (size_t)NTOK * DM * 4;
constexpr size_t WS_H = WS_XG + (size_t)NE * ROWS_E * DM * 2;
constexpr size_t WS_HN8 = WS_H + (size_t)NE * ROWS_E * DM * 2;
constexpr size_t WS_END = WS_HN8 + (size_t)NTOK * DM;
constexpr float W8_SCALE = 32.f; constexpr int W8_SCALE_E8M0 = 127 - 5;
constexpr int CW_BAR = 4096, CW_QUEUE = 8192;
constexpr int CW_CONV = 10240, CW_MIXDONE = 10304;
constexpr int NT8_ALL = 2 * NE * 3 * 128, NT8_L0 = NT8_ALL / 2;
#ifndef CONV_HOOKS
#define CONV_HOOKS 0x1f
#endif
#ifndef CONV_IDLE
#define CONV_IDLE 1
#endif

constexpr int RING_BYTES = 131072, LDSCTL_OFF = RING_BYTES, MISC_OFF = LDSCTL_OFF + 320, LDS_BYTES = 147456;

#define LDS_WAIT() asm volatile("s_waitcnt lgkmcnt(0)" ::: "memory")
#define VM_WAIT() asm volatile("s_waitcnt vmcnt(0)" ::: "memory")
__device__ __forceinline__ unsigned f2bf(float f) { unsigned u = __builtin_bit_cast(unsigned, f); return (u + 0x7fffu + ((u >> 16) & 1u)) >> 16; }
__device__ __forceinline__ unsigned pk2(float lo, float hi) { return f2bf(lo) | (f2bf(hi) << 16); }
__device__ __forceinline__ float bf2f(unsigned short b) { return __builtin_bit_cast(float, ((unsigned)b) << 16); }
__device__ __forceinline__ float bflo(unsigned w) { return __builtin_bit_cast(float, w << 16); }
__device__ __forceinline__ float bfhi(unsigned w) { return __builtin_bit_cast(float, w & 0xffff0000u); }
__device__ __forceinline__ unsigned pk4_fp8(float a, float b, float c, float d) {
    int r = __builtin_amdgcn_cvt_pk_fp8_f32(a, b, 0, false); r = __builtin_amdgcn_cvt_pk_fp8_f32(c, d, r, true); return (unsigned)r; }
__device__ __forceinline__ int opaque_tid() { int t = threadIdx.x; asm volatile("" : "+v"(t)); return t; }
__device__ __forceinline__ float row16_sum(float v) {
    v += __builtin_bit_cast(float, __builtin_amdgcn_update_dpp(0, __builtin_bit_cast(int, v), 0xB1, 0xF, 0xF, true));
    v += __builtin_bit_cast(float, __builtin_amdgcn_update_dpp(0, __builtin_bit_cast(int, v), 0x4E, 0xF, 0xF, true));
    v += __builtin_bit_cast(float, __builtin_amdgcn_update_dpp(0, __builtin_bit_cast(int, v), 0x141, 0xF, 0xF, true));
    v += __builtin_bit_cast(float, __builtin_amdgcn_update_dpp(0, __builtin_bit_cast(int, v), 0x140, 0xF, 0xF, true));
    return v;
}
__device__ __forceinline__ float wave_sum(float v) {
    v = row16_sum(v);
    const int iv = __builtin_bit_cast(int, v);
    const float a = __builtin_bit_cast(float, __builtin_amdgcn_readlane(iv, 0)), b = __builtin_bit_cast(float, __builtin_amdgcn_readlane(iv, 16));
    const float c = __builtin_bit_cast(float, __builtin_amdgcn_readlane(iv, 32)), d = __builtin_bit_cast(float, __builtin_amdgcn_readlane(iv, 48));
    return (a + b) + (c + d);
}
__device__ __forceinline__ float rsqrt_fast(float x) { return __builtin_amdgcn_rsqf(x); }
__device__ __forceinline__ float gelu_tanh(float x) {
    const float u = 0.7978845608028654f * (x + 0.044715f * x * x * x);
    const float e = __expf(2.f * u);
    const float th = 1.f - 2.f / (e + 1.f);
    return 0.5f * x * (1.f + th);
}

#define XB_TMO      128
#define XB_XCNT(j)  (256  + 64 * (j))
#define XB_XSUB(j)  (1280 + 64 * (j))
#define XB_XGEN(j)  (2304 + 64 * (j))
#define XB_TOP      3328
#define XB_TOPGEN   3392
#define XCD_BAR_WORDS 3456
#define XB_SPIN_CAP (1u << 18)
__device__ __forceinline__ unsigned xb_ld(unsigned* p)              { return __hip_atomic_load(p, __ATOMIC_RELAXED, __HIP_MEMORY_SCOPE_AGENT); }
__device__ __forceinline__ unsigned xb_add(unsigned* p, unsigned v) { return __hip_atomic_fetch_add(p, v, __ATOMIC_RELAXED, __HIP_MEMORY_SCOPE_AGENT); }
__device__ __forceinline__ unsigned xb_xcc_id() { return (unsigned)__builtin_amdgcn_s_getreg((3 << 11) | 20) & 0xFu; }
#define XB_SPIN(cond, bar) do { unsigned _sp = 0; while (cond) { __builtin_amdgcn_s_sleep(1); \
    if ((++_sp & 255u) == 0u) { if (xb_ld(&(bar)[XB_TMO])) break; if (_sp > XB_SPIN_CAP) { atomicAdd(&(bar)[XB_TMO], 1u); break; } } } } while (0)
struct XcdBarrier { unsigned* bar; unsigned x; volatile LAS unsigned* st; };
__device__ __forceinline__ XcdBarrier xcd_barrier_post(unsigned* bar, volatile LAS unsigned* st) {
    XcdBarrier b; b.bar = bar; b.x = xb_xcc_id(); b.st = st;
    if (threadIdx.x == 0) (void)xb_add(&bar[XB_XCNT(b.x)], 1u);
    return b;
}
__device__ __forceinline__ void xcd_barrier_complete(unsigned* bar, unsigned x, unsigned& nloc, unsigned& nx) {
    const unsigned G = gridDim.x * gridDim.y * gridDim.z;
    unsigned sum, cnt, mine, sp = 0u;
    for (;;) {
        sum = 0u; cnt = 0u; mine = 0u;
#pragma unroll
        for (unsigned j = 0; j < 16; ++j) { const unsigned c = xb_ld(&bar[XB_XCNT(j)]); sum += c; cnt += (c > 0u) ? 1u : 0u; mine = (j == x) ? c : mine; }
        if (sum == G) break;
        __builtin_amdgcn_s_sleep(1);
        if ((++sp & 255u) == 0u) { if (xb_ld(&bar[XB_TMO])) break; if (sp > XB_SPIN_CAP) { atomicAdd(&bar[XB_TMO], 1u); break; } }
    }
    nloc = mine > 0u ? mine : 1u; nx = cnt > 0u ? cnt : 1u;
}
template <bool FIRST>
__device__ __forceinline__ void xcd_barrier_t(const XcdBarrier& b) {
    asm volatile("s_waitcnt vmcnt(0)" ::: "memory");
    __syncthreads();
    if (threadIdx.x == 0) {
        unsigned* bar = b.bar;
        asm volatile("" : "+s"(bar));
        __builtin_amdgcn_s_waitcnt(0);
        unsigned nloc = b.st[0], nx = b.st[1];
        if constexpr (FIRST) { if (nloc == 0u) { xcd_barrier_complete(bar, b.x, nloc, nx); b.st[0] = nloc; b.st[1] = nx; } }
        const unsigned old = xb_add(&bar[XB_XSUB(b.x)], 1u);
        const unsigned gen = old / nloc;
        if (old + 1u == (gen + 1u) * nloc) {
            __builtin_amdgcn_fence(__ATOMIC_RELEASE, "agent");
            asm volatile("s_waitcnt vmcnt(0)" ::: "memory");
            const unsigned og = xb_add(&bar[XB_TOP], 1u);
            const unsigned tg = og / nx;
            if (og + 1u == (tg + 1u) * nx) xb_add(&bar[XB_TOPGEN], 1u);
            else XB_SPIN(xb_ld(&bar[XB_TOPGEN]) == tg, bar);
            __builtin_amdgcn_fence(__ATOMIC_ACQUIRE, "agent");
            xb_add(&bar[XB_XGEN(b.x)], 1u);
            asm volatile("s_waitcnt vmcnt(0)" ::: "memory");
        } else {
            XB_SPIN(xb_ld(&bar[XB_XGEN(b.x)]) == gen, bar);
            __builtin_amdgcn_fence(__ATOMIC_ACQUIRE, "agent");
            asm volatile("s_waitcnt vmcnt(0)" ::: "memory");
        }
    }
    __syncthreads();
}
__device__ __forceinline__ void xcd_barrier(const XcdBarrier& b) { xcd_barrier_t<false>(b); }
__device__ __forceinline__ void xcd_barrier_first(const XcdBarrier& b) { xcd_barrier_t<true>(b); }

namespace pg8 {
constexpr int BM = 256, BK = 64, HALF = 128, HTB = HALF * BK * 2, STAGE_BYTES = 8 * HTB, NXCD = 8, WGM = 8;
constexpr int GK = 2048;
__host__ __device__ __forceinline__ int lds_byte(int r, int c) { const int st = (r >> 4) * 2 + (c >> 5), rr = r & 15, cc = c & 31, ob = rr * 64 + cc * 2; return st * 1024 + (ob ^ (((ob >> 9) & 1) << 5)); }
__host__ __device__ __forceinline__ void stage_rc(int b, int& R, int& C) { const int st = b / 1024, sb = b % 1024, swz = sb ^ (((sb >> 9) & 1) << 5); R = (st >> 1) * 16 + swz / 64; C = (st & 1) * 32 + (swz % 64) / 2; }
__host__ __device__ __forceinline__ int perm32(int rho) { const int n = rho >> 4, i = rho & 15; return 8 * (i >> 2) + 4 * n + (i & 3); }

struct Unit { int pm, pn, e, rowbase, colbase, oidx, slot; const char* a; const char* b; };

struct SchedDense {
    static constexpr int RB = GK * 2;
    const char* A; const char* Bt; int nM, nN, nwg, G, c, skipctx;
    __device__ void init(const void* A_, const void* Bt_, int nM_, int nN_, int G_, int c_, int skipctx_) { A = (const char*)A_; Bt = (const char*)Bt_; nM = nM_; nN = nN_; nwg = nM * nN; G = G_; c = c_; skipctx = skipctx_; }
    __device__ bool next(int i, Unit& u) const {
        const long L = (long)i * G + c; if (L >= nwg) return false;
        int wgid = (int)L; { const int q = nwg / NXCD, r = nwg % NXCD, xcd = wgid % NXCD, off = wgid / NXCD; wgid = (xcd < r ? xcd * (q + 1) : r * (q + 1) + (xcd - r) * q) + off; }
        const int nig = WGM * nN, gid = wgid / nig, fm = gid * WGM, gsz = (nM - fm) < WGM ? (nM - fm) : WGM;
        int pm = fm + ((wgid % nig) % gsz); const int pn = (wgid % nig) / gsz;
        if (skipctx) pm = (pm >> 4) * 17 + 1 + (pm & 15);
        u.pm = pm; u.pn = pn; u.e = 0; u.rowbase = pm * BM; u.colbase = pn * BM; u.oidx = 0;
        u.a = A + (size_t)pm * (BM * GK * 2); u.b = Bt + (size_t)pn * (BM * GK * 2); return true;
    }
};
template <int RB_> struct SchedGrouped {
    static constexpr int RB = RB_;
    const char* A; const char* Bt; int nMe, nNe, nwg, G, c;
    __device__ void init(const void* A_, const void* Bt_, int nMe_, int nNe_, int G_, int c_) { A = (const char*)A_; Bt = (const char*)Bt_; nMe = nMe_; nNe = nNe_; nwg = NE * nMe * nNe; G = G_; c = c_; }
    __device__ bool next(int i, Unit& u) const {
        int e, pm, pn;
        if ((G & 255) == 0) {
            const int cpe = nNe >> 2, nchunk = NE * cpe, xcd = c & 7, slot = (c >> 3) & 31, sub = c >> 8;
            const int chunk = (i * (G >> 8) + sub) * 8 + xcd;
            if (chunk < nchunk) { e = chunk / cpe; pm = slot >> 2; pn = (chunk % cpe) * 4 + (slot & 3); }
            else { const int per = (NE * nNe) >> 3;
                if (nMe < 9 || chunk >= nchunk + 8 || slot >= per) return false; const int j = (chunk - nchunk) * per + slot; e = j / nNe; pn = j % nNe; pm = 8; }
        } else { const long L = (long)i * G + c; if (L >= nwg) return false; const int per = nMe * nNe, rem = (int)L % per; e = (int)L / per; pm = rem % nMe; pn = rem / nMe; }
        u.pm = pm; u.pn = pn; u.e = e; u.rowbase = e * ROWS_E + pm * BM; u.colbase = pn * BM; u.oidx = e * 9 + pm;
        u.a = A + (size_t)(e * ROWS_E + pm * BM) * RB; u.b = Bt + ((size_t)e * nNe + pn) * (BM * RB); return true;
    }
};

__device__ __forceinline__ unsigned cvt_pk_bf16(float lo, float hi) { unsigned r; asm volatile("v_cvt_pk_bf16_f32 %0, %1, %2" : "=v"(r) : "v"(lo), "v"(hi)); return r; }

struct EpiStoreBf16 {
    static constexpr bool PERM = true;
    bf16_t* O; int ldc;
    __device__ __forceinline__ void operator()(const f32x4 (&acc)[2][2][4][2], const Unit& u, int wr, int wc, int fr, int fq) const {
        const int row0 = u.rowbase + wr * 64 + fr, col0 = u.colbase + wc * 32 + 8 * fq;
#pragma unroll
        for (int ai = 0; ai < 2; ++ai)
#pragma unroll
            for (int m = 0; m < 4; ++m) { bf16_t* rowp = O + (size_t)(row0 + ai * HALF + m * 16) * ldc + col0;
#pragma unroll
                for (int bj = 0; bj < 2; ++bj) { const f32x4 v0 = acc[ai][bj][m][0], v1 = acc[ai][bj][m][1];
                    u32x4 w; w.x = cvt_pk_bf16(v0[0], v0[1]); w.y = cvt_pk_bf16(v0[2], v0[3]); w.z = cvt_pk_bf16(v1[0], v1[1]); w.w = cvt_pk_bf16(v1[2], v1[3]);
                    *(u32x4*)(rowp + bj * HALF) = w; } }
    }
};
struct EpiPost {
    static constexpr bool PERM = true;
    bf16_t* P; const float* rope; const float* qna; const float* kna; const float* qnc; const float* knc; const float* vnb; LAS unsigned char* tab;
    __device__ __forceinline__ void operator()(f32x4 (&acc)[2][2][4][2], const Unit& u, int wr, int wc, int fr, int fq) const {
        const int tb = u.pm % 17; const bool lat = tb != 0;
        const int d0 = 64 * (wc >> 1) + 16 * (wc & 1) + 4 * fq, rl0 = wr * 64 + fr;
        int typ[2]; const float* gain[2];
#pragma unroll
        for (int bj = 0; bj < 2; ++bj) { const int slot = 2 * u.pn + bj;
            typ[bj] = (slot < 8) ? 3 : (slot < 10) ? 0 : (slot < 14) ? 1 : (slot < 18) ? 2 : (slot < 26) ? 3 : 0;
            gain[bj] = (slot < 6) ? qna : (slot < 8) ? kna : (slot < 18) ? vnb + ((slot - 14) & 3) * 128 : (slot < 24) ? qnc : knc; }
        const bool anynorm = typ[0] >= 2 || typ[1] >= 2;
        f32x4 csv[4][2], gq0[2], gq1[2];
#pragma unroll
        for (int k = 0; k < 4; ++k) { csv[k][0] = (f32x4){1.f, 0.f, 1.f, 0.f}; csv[k][1] = csv[k][0]; }
        if ((typ[0] == 3 || typ[1] == 3) && lat) {
#pragma unroll
            for (int k = 0; k < 4; ++k) { const int pp = (wc >> 1) ? (fr + 16 * k) : ((tb - 1) * 4 + wr + 2 * (k & 1));
                const f32x4* cs = (const f32x4*)(rope + 2 * (pp * 32 + 16 * (wc & 1) + 4 * fq)); csv[k][0] = cs[0]; csv[k][1] = cs[1]; } }
#pragma unroll
        for (int bj = 0; bj < 2; ++bj) { gq0[bj] = (f32x4){1.f, 1.f, 1.f, 1.f}; gq1[bj] = gq0[bj];
            if (typ[bj] >= 2) { gq0[bj] = *(const f32x4*)(gain[bj] + d0); gq1[bj] = *(const f32x4*)(gain[bj] + d0 + 32); } }
#pragma unroll
        for (int bj = 0; bj < 2; ++bj) if (typ[bj] == 1 || typ[bj] == 2) {
#pragma unroll
            for (int ai = 0; ai < 2; ++ai)
#pragma unroll
                for (int m = 0; m < 4; ++m)
#pragma unroll
                    for (int n = 0; n < 2; ++n)
#pragma unroll
                        for (int j = 0; j < 4; ++j) acc[ai][bj][m][n][j] = gelu_tanh(acc[ai][bj][m][n][j]); }
        if (anynorm) {
#pragma unroll
            for (int bj = 0; bj < 2; ++bj) if (typ[bj] >= 2) {
#pragma unroll
                for (int ai = 0; ai < 2; ++ai)
#pragma unroll
                    for (int m = 0; m < 4; ++m) { const f32x4 a = acc[ai][bj][m][0], b = acc[ai][bj][m][1];
                        float ss = ((a.x * a.x + a.y * a.y) + (a.z * a.z + a.w * a.w)) + ((b.x * b.x + b.y * b.y) + (b.z * b.z + b.w * b.w));
                        ss += __builtin_bit_cast(float, __builtin_amdgcn_ds_swizzle(__builtin_bit_cast(int, ss), 0x401F));
                        { auto rr = __builtin_amdgcn_permlane32_swap(__float_as_uint(ss), __float_as_uint(ss), false, false); ss = __uint_as_float(rr[0]) + __uint_as_float(rr[1]); }
                        if (fq == 0) *(LAS float*)(tab + (((rl0 + ai * HALF + m * 16) * 2 + bj) * 4 + wc) * 4) = ss; } }
            asm volatile("s_waitcnt lgkmcnt(0)" ::: "memory"); __builtin_amdgcn_s_barrier(); asm volatile("" ::: "memory");
        }
#pragma unroll
        for (int bj = 0; bj < 2; ++bj) {
            const int slot = 2 * u.pn + bj;
            const f32x4 g0 = gq0[bj], g1 = gq1[bj];
#pragma unroll
            for (int ai = 0; ai < 2; ++ai)
#pragma unroll
                for (int m = 0; m < 4; ++m) { const int rl = rl0 + ai * HALF + m * 16;
                    f32x4 a = acc[ai][bj][m][0], b = acc[ai][bj][m][1];
                    if (typ[bj] >= 2) { const f32x4 t = *(const LAS f32x4*)(tab + ((rl * 2 + bj) * 4) * 4);
                        const float rinv = rsqrt_fast(((t.x + t.y) + (t.z + t.w)) * (1.f / 128) + EPS);
                        a = a * rinv * g0; b = b * rinv * g1; }
                    if (typ[bj] == 3 && lat) { const f32x4 c0 = (wc >> 1) ? csv[m][0] : csv[ai][0], c1 = (wc >> 1) ? csv[m][1] : csv[ai][1];
                        const f32x4 cv = (f32x4){c0.x, c0.z, c1.x, c1.z}, sv = (f32x4){c0.y, c0.w, c1.y, c1.w};
                        const f32x4 ra = a * cv - b * sv, rb = b * cv + a * sv; a = ra; b = rb; }
                    bf16_t* rowp = P + (size_t)(u.rowbase + rl) * INW + slot * 128 + d0;
                    u32x2 w0, w1; w0.x = cvt_pk_bf16(a.x, a.y); w0.y = cvt_pk_bf16(a.z, a.w); w1.x = cvt_pk_bf16(b.x, b.y); w1.y = cvt_pk_bf16(b.z, b.w);
                    *(u32x2*)rowp = w0; *(u32x2*)(rowp + 32) = w1; }
        }
    }
};
struct EpiStoreFp8 {
    static constexpr bool PERM = true;
    unsigned char* O; int ldc;
    __device__ __forceinline__ void operator()(const f32x4 (&acc)[2][2][4][2], const Unit& u, int wr, int wc, int fr, int fq) const {
        const int row0 = u.rowbase + wr * 64 + fr, col0 = u.colbase + wc * 32 + 8 * fq;
#pragma unroll
        for (int ai = 0; ai < 2; ++ai)
#pragma unroll
            for (int m = 0; m < 4; ++m) { unsigned char* rowp = O + (size_t)(row0 + ai * HALF + m * 16) * ldc + col0;
#pragma unroll
                for (int bj = 0; bj < 2; ++bj) { const f32x4 v0 = acc[ai][bj][m][0], v1 = acc[ai][bj][m][1];
                    u32x2 w; w.x = pk4_fp8(v0[0], v0[1], v0[2], v0[3]); w.y = pk4_fp8(v1[0], v1[1], v1[2], v1[3]);
                    *(u32x2*)(rowp + bj * HALF) = w; } }
    }
};
struct EpiResid {
    static constexpr bool PERM = false;
    const float* ctxbase; const float* latbase; int cbs, lbs;
    const bf16_t* src16;
    bf16_t* xout; const float* modl;
    float* parts;
    LAS unsigned char* ktab;
    __device__ __forceinline__ void operator()(const f32x4 (&acc)[2][2][4][2], const Unit& u, int wr, int wc, int fr, int fq) const {
        const int b = u.pm / 17, tb = u.pm % 17;
        const float* src = (tb == 0) ? ctxbase + (size_t)b * cbs * DM : latbase + ((size_t)b * lbs + (size_t)(tb - 1) * 256) * DM;
        const float* g1 = modl + (size_t)((tb == 0) ? 4 : b) * NMOD + 2 * DM;
        const int rl0 = wr * 64 + fr, col0 = u.colbase + wc * 32 + 4 * fq;
#pragma unroll
        for (int ai = 0; ai < 2; ++ai)
#pragma unroll
        for (int mh = 0; mh < 2; ++mh) {
            f32x4 gv[2][2];
#pragma unroll
            for (int bj = 0; bj < 2; ++bj)
#pragma unroll
                for (int n = 0; n < 2; ++n) gv[bj][n] = *(const f32x4*)(g1 + col0 + bj * HALF + n * 16);
            f32x4 xv[2][2][2];
            if (src16 != nullptr) {
                u32x2 xr[2][2][2];
#pragma unroll
                for (int mm = 0; mm < 2; ++mm) { const bf16_t* sp = src16 + (size_t)(u.rowbase + rl0 + ai * HALF + (2 * mh + mm) * 16) * DM + col0;
#pragma unroll
                    for (int bj = 0; bj < 2; ++bj)
#pragma unroll
                        for (int n = 0; n < 2; ++n) xr[mm][bj][n] = *(const u32x2*)(sp + bj * HALF + n * 16); }
#pragma unroll
                for (int mm = 0; mm < 2; ++mm)
#pragma unroll
                    for (int bj = 0; bj < 2; ++bj)
#pragma unroll
                        for (int n = 0; n < 2; ++n) xv[mm][bj][n] = (f32x4){bflo(xr[mm][bj][n].x), bfhi(xr[mm][bj][n].x), bflo(xr[mm][bj][n].y), bfhi(xr[mm][bj][n].y)};
            } else {
#pragma unroll
                for (int mm = 0; mm < 2; ++mm) { const float* sp = src + (size_t)(rl0 + ai * HALF + (2 * mh + mm) * 16) * DM + col0;
#pragma unroll
                    for (int bj = 0; bj < 2; ++bj)
#pragma unroll
                        for (int n = 0; n < 2; ++n) xv[mm][bj][n] = *(const f32x4*)(sp + bj * HALF + n * 16); }
            }
#pragma unroll
            for (int mm = 0; mm < 2; ++mm) { const int m = 2 * mh + mm, rl = rl0 + ai * HALF + m * 16; bf16_t* dp = xout + (size_t)(u.rowbase + rl) * DM + col0; float ss = 0.f;
                const float fz = *(const LAS float*)(ktab + ((size_t)u.slot * 256 + rl) * 16 + 8);
#pragma unroll
                for (int bj = 0; bj < 2; ++bj)
#pragma unroll
                    for (int n = 0; n < 2; ++n) { const f32x4 y = xv[mm][bj][n] + (gv[bj][n] * fz) * acc[ai][bj][m][n];
                        u32x2 w; w.x = cvt_pk_bf16(y.x, y.y); w.y = cvt_pk_bf16(y.z, y.w); *(u32x2*)(dp + bj * HALF + n * 16) = w;
                        ss += (y.x * y.x + y.y * y.y) + (y.z * y.z + y.w * y.w); }
                ss += __builtin_bit_cast(float, __builtin_amdgcn_ds_swizzle(__builtin_bit_cast(int, ss), 0x401F));
                { auto rr = __builtin_amdgcn_permlane32_swap(__float_as_uint(ss), __float_as_uint(ss), false, false); ss = __uint_as_float(rr[0]) + __uint_as_float(rr[1]); }
                if (fq == 0) parts[(size_t)(u.rowbase + rl) * 32 + u.pn * 4 + wc] = ss; }
            asm volatile("" ::: "memory");
        }
    }
};
struct EpiSwiGLU {
    static constexpr bool PERM = true;
    bf16_t* Hout;
    __device__ __forceinline__ void operator()(const f32x4 (&acc)[2][2][4][2], const Unit& u, int wr, int wc, int fr, int fq) const {
        const int row0 = u.rowbase + wr * 64 + fr, col0 = u.pn * HALF + wc * 32 + 8 * fq;
#pragma unroll
        for (int ai = 0; ai < 2; ++ai)
#pragma unroll
            for (int m = 0; m < 4; ++m) { bf16_t* rowp = Hout + (size_t)(row0 + ai * HALF + m * 16) * DM + col0; float h[8];
#pragma unroll
                for (int n = 0; n < 2; ++n)
#pragma unroll
                    for (int j = 0; j < 4; ++j) { const float g = acc[ai][0][m][n][j], up = acc[ai][1][m][n][j]; h[n * 4 + j] = g * __builtin_amdgcn_rcpf(1.f + __expf(-g)) * up; }
                u32x4 w; w.x = cvt_pk_bf16(h[0], h[1]); w.y = cvt_pk_bf16(h[2], h[3]); w.z = cvt_pk_bf16(h[4], h[5]); w.w = cvt_pk_bf16(h[6], h[7]);
                *(u32x4*)rowp = w; }
    }
};
struct EpiSwiGLU8 {
    static constexpr bool PERM = true;
    unsigned char* Hout;
    __device__ __forceinline__ void operator()(const f32x4 (&acc)[2][2][4][2], const Unit& u, int wr, int wc, int fr, int fq) const {
        const int row0 = u.rowbase + wr * 64 + fr, col0 = u.pn * HALF + wc * 32 + 8 * fq;
#pragma unroll
        for (int ai = 0; ai < 2; ++ai)
#pragma unroll
            for (int m = 0; m < 4; ++m) { unsigned char* rowp = Hout + (size_t)(row0 + ai * HALF + m * 16) * DM + col0; float h[8];
#pragma unroll
                for (int n = 0; n < 2; ++n)
#pragma unroll
                    for (int j = 0; j < 4; ++j) { const float g = acc[ai][0][m][n][j], up = acc[ai][1][m][n][j]; h[n * 4 + j] = g * __builtin_amdgcn_rcpf(1.f + __expf(-g)) * up; }
                u32x2 w; w.x = pk4_fp8(h[0], h[1], h[2], h[3]); w.y = pk4_fp8(h[4], h[5], h[6], h[7]);
                *(u32x2*)rowp = w; }
    }
};
struct EpiDown {
    static constexpr bool PERM = true;
    bf16_t* Y; const float* gatev;
    __device__ __forceinline__ void operator()(const f32x4 (&acc)[2][2][4][2], const Unit& u, int wr, int wc, int fr, int fq) const {
        const int row0 = u.rowbase + wr * 64 + fr, col0 = u.colbase + wc * 32 + 8 * fq;
#pragma unroll
        for (int ai = 0; ai < 2; ++ai)
#pragma unroll
            for (int m = 0; m < 4; ++m) { const int row = row0 + ai * HALF + m * 16; const float gt = gatev[row]; bf16_t* rowp = Y + (size_t)row * DM + col0;
#pragma unroll
                for (int bj = 0; bj < 2; ++bj) { const f32x4 v0 = acc[ai][bj][m][0] * gt, v1 = acc[ai][bj][m][1] * gt;
                    u32x4 w; w.x = cvt_pk_bf16(v0[0], v0[1]); w.y = cvt_pk_bf16(v0[2], v0[3]); w.z = cvt_pk_bf16(v1[0], v1[1]); w.w = cvt_pk_bf16(v1[2], v1[3]);
                    *(u32x4*)(rowp + bj * HALF) = w; } }
    }
};

template <class Epi, class Sched, bool FP8 = false, bool GATHER = false, bool KSCALE = false, bool ALIGN_EPI = true, bool SP2 = true>
__device__ __forceinline__ void gemm_phase(LAS unsigned char* lds, const Sched& S, const Epi& E, const unsigned* goffs = nullptr, LAS unsigned char* goffs_lds = nullptr) {
    static_assert(!GATHER || SP2, "gather mode is written for the SP2 loop");
    static_assert(Sched::RB == (FP8 ? GK : GK * 2), "operand row bytes");
    const int tid = opaque_tid(), wid = __builtin_amdgcn_readfirstlane(tid >> 6), lane = tid & 63, wr = wid >> 2, wc = wid & 3, fr = lane & 15, fq = lane >> 4;
    constexpr int RB = Sched::RB, nt = RB / 128;
    unsigned voffA[2], voffB[2];
#pragma unroll
    for (int i = 0; i < 2; ++i) { int R, C; stage_rc(tid * 16 + i * 8192, R, C); const int Rb = Epi::PERM ? ((R & ~31) + perm32(R & 31)) : R;
        voffA[i] = (unsigned)(R * RB + C * 2); voffB[i] = (unsigned)(Rb * RB + C * 2); }
    const size_t kstep = (size_t)(BK * 2);
    const size_t hstep = (size_t)HALF * RB;
    const unsigned ldsw = (unsigned)wid * 1024u;
    const int aoff = lds_byte(wr * 64 + fr, fq * 8), boff = lds_byte(wc * 32 + fr, fq * 8);
#define PG8_SA(b, h) (((b) * 2 + (h)) * HTB)
#define PG8_SB(b, h) ((4 + (b) * 2 + (h)) * HTB)
#define PG8_STAGE(bufoff, gbase, voff) do { _Pragma("unroll") for (int _i = 0; _i < 2; ++_i) \
        __builtin_amdgcn_global_load_lds((const unsigned*)((const char*)(gbase) + (voff)[_i]), (LAS unsigned*)(lds + (bufoff) + ldsw + _i * 8192), 16, 0, 0); } while (0)
#define PG8_RD8(p) __builtin_shufflevector(*(const LAS i32x4*)(p), *(const LAS i32x4*)((p) + 1024), 0, 1, 2, 3, 4, 5, 6, 7)
#define PG8_LDA(dst, b, h) do { _Pragma("unroll") for (int m = 0; m < 4; ++m) { if constexpr (FP8) dst##8[m] = PG8_RD8(lds + PG8_SA(b, h) + aoff + m * 2048); \
        else { _Pragma("unroll") for (int k = 0; k < 2; ++k) dst[m][k] = *(const LAS bf16x8*)(lds + PG8_SA(b, h) + aoff + m * 2048 + k * 1024); } } } while (0)
#define PG8_LDB(dst, b, h) do { _Pragma("unroll") for (int n = 0; n < 2; ++n) { if constexpr (FP8) dst##8[n] = PG8_RD8(lds + PG8_SB(b, h) + boff + n * 2048); \
        else { _Pragma("unroll") for (int k = 0; k < 2; ++k) dst[n][k] = *(const LAS bf16x8*)(lds + PG8_SB(b, h) + boff + n * 2048 + k * 1024); } } } while (0)
#define PG8_MMA(ai, bj, At, Bt) do { __builtin_amdgcn_s_setprio(1); _Pragma("unroll") for (int m = 0; m < 4; ++m) _Pragma("unroll") for (int n = 0; n < 2; ++n) { \
        if constexpr (FP8) asm volatile("v_mfma_scale_f32_16x16x128_f8f6f4 %0, %1, %2, %0, %3, %4 op_sel_hi:[0,0,0]" : "+v"(acc[ai][bj][m][n]) : "v"(Bt##8[n]), "v"(At##8[m]), "v"(sclW), "v"(sclX)); \
        else { _Pragma("unroll") for (int k = 0; k < 2; ++k) acc[ai][bj][m][n] = __builtin_amdgcn_mfma_f32_16x16x32_bf16(Bt[n][k], At[m][k], acc[ai][bj][m][n], 0, 0, 0); } } \
        __builtin_amdgcn_s_setprio(0); } while (0)
#define PG8_WAIT_V(n) asm volatile("s_waitcnt vmcnt(" #n ")" ::: "memory")
#define PG8_WAIT_L(n) asm volatile("s_waitcnt lgkmcnt(" #n ")" ::: "memory")
#define PG8_BAR __builtin_amdgcn_s_barrier()
#define PG8_SCHED __builtin_amdgcn_sched_barrier(0)
    Unit cur, nxt; int ui = 0;
    if (!S.next(0, cur)) return;
    u32x4 gC = (u32x4){0u, 0u, 0u, 0u}, gN = gC;
    if constexpr (GATHER) gC = *(const u32x4*)(goffs + ((size_t)cur.oidx * 512 + tid) * 4);
#define PG8_GSTAGE(bufoff, gbase, o0, o1) do { \
        __builtin_amdgcn_global_load_lds((const unsigned*)((const char*)(gbase) + (o0)), (LAS unsigned*)(lds + (bufoff) + ldsw), 16, 0, 0); \
        __builtin_amdgcn_global_load_lds((const unsigned*)((const char*)(gbase) + (o1)), (LAS unsigned*)(lds + (bufoff) + ldsw + 8192), 16, 0, 0); } while (0)
    f32x4 acc[2][2][4][2];
#pragma unroll
    for (int a = 0; a < 2; ++a)
#pragma unroll
        for (int b = 0; b < 2; ++b)
#pragma unroll
            for (int m = 0; m < 4; ++m)
#pragma unroll
                for (int n = 0; n < 2; ++n) acc[a][b][m][n] = (f32x4){0.f, 0.f, 0.f, 0.f};
    int sclW = W8_SCALE_E8M0 * 0x01010101, sclX = 0x7f7f7f7f; if constexpr (FP8) asm volatile("" : "+v"(sclW), "+v"(sclX)); (void)sclW; (void)sclX;
    bf16x8 At[4][2], B0[2][2], B1[2][2]; i32x8 At8[4], B08[2], B18[2];
    const char* cA = cur.a; const char* cB = cur.b;
    if constexpr (SP2) {
        PG8_STAGE(PG8_SB(0, 0), cB, voffB); PG8_STAGE(PG8_SB(0, 1), cB + hstep, voffB);
        if constexpr (GATHER) { PG8_GSTAGE(PG8_SA(0, 0), S.A, gC.x, gC.y); PG8_GSTAGE(PG8_SA(0, 1), S.A, gC.z, gC.w); }
        else { PG8_STAGE(PG8_SA(0, 0), cA, voffA); PG8_STAGE(PG8_SA(0, 1), cA + hstep, voffA); }
        if (wr == 1) PG8_BAR;
        PG8_WAIT_V(2); PG8_BAR;
        PG8_STAGE(PG8_SB(1, 0), cB + kstep, voffB);
        if constexpr (GATHER) PG8_GSTAGE(PG8_SA(1, 0), S.A + kstep, gC.x, gC.y); else PG8_STAGE(PG8_SA(1, 0), cA + kstep, voffA);
        PG8_STAGE(PG8_SB(1, 1), cB + hstep + kstep, voffB);
        PG8_WAIT_V(6); PG8_BAR;
    } else {
        PG8_STAGE(PG8_SB(0, 0), cB, voffB); PG8_STAGE(PG8_SA(0, 0), cA, voffA); PG8_STAGE(PG8_SB(0, 1), cB + hstep, voffB); PG8_STAGE(PG8_SA(0, 1), cA + hstep, voffA);
        if (wr == 1) PG8_BAR;
        PG8_WAIT_V(4); PG8_BAR;
        PG8_STAGE(PG8_SB(1, 0), cB + kstep, voffB); PG8_STAGE(PG8_SA(1, 0), cA + kstep, voffA); PG8_STAGE(PG8_SB(1, 1), cB + hstep + kstep, voffB);
        PG8_WAIT_V(6); PG8_BAR;
    }
    for (;;) {
        const bool has_next = S.next(ui + 1, nxt);
        const char* nA = has_next ? nxt.a : cA; const char* nB = has_next ? nxt.b : cB;
        if constexpr (GATHER) { if (has_next)
            __builtin_amdgcn_global_load_lds((const unsigned*)(goffs + ((size_t)nxt.oidx * 512 + tid) * 4), (LAS unsigned*)(goffs_lds + ldsw), 16, 0, 0); }
        for (int seg = 0; seg < (KSCALE ? 3 : 1); ++seg) {
        const int tbeg = !KSCALE ? 0 : (seg == 0 ? 0 : seg == 1 ? 12 : 20), tend = !KSCALE ? nt : (seg == 0 ? 12 : seg == 1 ? 20 : nt);
        for (int t = tbeg; t < tend; t += 2) {
            const bool last = (t == nt - 2);
            const char* a1 = cA + (size_t)(t + 1) * kstep;
            const char* a2 = last ? nA : cA + (size_t)(t + 2) * kstep; const char* b2 = last ? nB : cB + (size_t)(t + 2) * kstep;
            const char* a3 = a2 + kstep; const char* b3 = b2 + kstep;
            const char* g1 = S.A + (size_t)(t + 1) * kstep; const char* g2 = S.A + (last ? (size_t)0 : (size_t)(t + 2) * kstep); const char* g3 = g2 + kstep;
            u32x4 gX = gC;
            if constexpr (GATHER) { if (last) { if (has_next) gN = *(const LAS u32x4*)(goffs_lds + (size_t)tid * 16); else gN = gC; gX = gN; } }
            if constexpr (SP2) {
            PG8_LDB(B0, 0, 0); PG8_LDB(B1, 0, 1); PG8_SCHED; PG8_LDA(At, 0, 0);
            if constexpr (GATHER) PG8_GSTAGE(PG8_SA(1, 1), g1, gC.z, gC.w); else PG8_STAGE(PG8_SA(1, 1), a1 + hstep, voffA);
            PG8_WAIT_V(8); PG8_WAIT_L(0); PG8_BAR; PG8_MMA(0, 0, At, B0); PG8_MMA(0, 1, At, B1); PG8_BAR; PG8_SCHED;
            PG8_LDA(At, 0, 1); PG8_STAGE(PG8_SB(0, 0), b2, voffB); PG8_STAGE(PG8_SB(0, 1), b2 + hstep, voffB);
            if constexpr (GATHER) PG8_GSTAGE(PG8_SA(0, 0), g2, gX.x, gX.y); else PG8_STAGE(PG8_SA(0, 0), a2, voffA);
            PG8_WAIT_V(8); PG8_WAIT_L(0); PG8_BAR; PG8_MMA(1, 0, At, B0); PG8_MMA(1, 1, At, B1); PG8_BAR; PG8_SCHED;
            PG8_LDB(B0, 1, 0); PG8_LDB(B1, 1, 1); PG8_SCHED; PG8_LDA(At, 1, 0);
            if constexpr (GATHER) PG8_GSTAGE(PG8_SA(0, 1), g2, gX.z, gX.w); else PG8_STAGE(PG8_SA(0, 1), a2 + hstep, voffA);
            PG8_WAIT_V(8); PG8_WAIT_L(0); PG8_BAR; PG8_MMA(0, 0, At, B0); PG8_MMA(0, 1, At, B1); PG8_BAR; PG8_SCHED;
            PG8_LDA(At, 1, 1); PG8_STAGE(PG8_SB(1, 0), b3, voffB); PG8_STAGE(PG8_SB(1, 1), b3 + hstep, voffB);
            if constexpr (GATHER) PG8_GSTAGE(PG8_SA(1, 0), g3, gX.x, gX.y); else PG8_STAGE(PG8_SA(1, 0), a3, voffA);
            PG8_WAIT_V(8); PG8_WAIT_L(0); PG8_BAR; PG8_MMA(1, 0, At, B0); PG8_MMA(1, 1, At, B1); PG8_BAR; PG8_SCHED;
            } else {
            PG8_LDB(B0, 0, 0); PG8_SCHED; PG8_LDA(At, 0, 0); PG8_STAGE(PG8_SA(1, 1), a1 + hstep, voffA);
            PG8_WAIT_L(8); PG8_BAR; PG8_WAIT_L(0); PG8_MMA(0, 0, At, B0); PG8_BAR; PG8_SCHED;
            PG8_LDB(B1, 0, 1); PG8_STAGE(PG8_SB(0, 0), b2, voffB);
            PG8_BAR; PG8_WAIT_L(0); PG8_MMA(0, 1, At, B1); PG8_BAR;
            PG8_LDA(At, 0, 1); PG8_STAGE(PG8_SA(0, 0), a2, voffA);
            PG8_BAR; PG8_WAIT_L(0); PG8_MMA(1, 0, At, B0); PG8_BAR; PG8_SCHED;
            PG8_STAGE(PG8_SB(0, 1), b2 + hstep, voffB);
            PG8_WAIT_V(6); PG8_BAR; PG8_MMA(1, 1, At, B1); PG8_BAR;
            PG8_LDB(B0, 1, 0); PG8_SCHED; PG8_LDA(At, 1, 0); PG8_STAGE(PG8_SA(0, 1), a2 + hstep, voffA);
            PG8_WAIT_L(8); PG8_BAR; PG8_WAIT_L(0); PG8_MMA(0, 0, At, B0); PG8_BAR; PG8_SCHED;
            PG8_LDB(B1, 1, 1); PG8_STAGE(PG8_SB(1, 0), b3, voffB);
            PG8_BAR; PG8_WAIT_L(0); PG8_MMA(0, 1, At, B1); PG8_BAR;
            PG8_LDA(At, 1, 1); PG8_STAGE(PG8_SA(1, 0), a3, voffA);
            PG8_BAR; PG8_WAIT_L(0); PG8_MMA(1, 0, At, B0); PG8_BAR; PG8_SCHED;
            PG8_STAGE(PG8_SB(1, 1), b3 + hstep, voffB);
            PG8_WAIT_V(6); PG8_BAR; PG8_MMA(1, 1, At, B1); PG8_BAR;
            }
        }
        if constexpr (KSCALE) { if (seg < 2) {
            unsigned ka = (unsigned)(uintptr_t)goffs_lds + (unsigned)((ui * 256 + wr * 64 + fr) * 16 + seg * 4); asm volatile("" : "+v"(ka));
#pragma unroll
            for (int ai = 0; ai < 2; ++ai)
#pragma unroll
                for (int m = 0; m < 4; ++m) { const float f = *(const LAS float*)(uintptr_t)(ka + (unsigned)((ai * HALF + m * 16) * 16));
#pragma unroll
                    for (int bj = 0; bj < 2; ++bj)
#pragma unroll
                        for (int n = 0; n < 2; ++n) acc[ai][bj][m][n] *= f;
                    asm volatile("" : "+v"(acc[ai][0][m][0]), "+v"(acc[ai][0][m][1]), "+v"(acc[ai][1][m][0]), "+v"(acc[ai][1][m][1])); } } }
        }
        cur.slot = ui;
        if constexpr (ALIGN_EPI) { if (wr == 0) PG8_BAR; }
        if constexpr (FP8) asm volatile("s_nop 15\n\ts_nop 15\n\ts_nop 7" ::: "memory");
        { const int tz = opaque_tid(), wz = __builtin_amdgcn_readfirstlane(tz >> 6), lz = tz & 63;
          E(acc, cur, wz >> 2, wz & 3, lz & 15, lz >> 4); }
        if (!has_next) break;
#pragma unroll
        for (int a = 0; a < 2; ++a)
#pragma unroll
            for (int b = 0; b < 2; ++b)
#pragma unroll
                for (int m = 0; m < 4; ++m)
#pragma unroll
                    for (int n = 0; n < 2; ++n) acc[a][b][m][n] = (f32x4){0.f, 0.f, 0.f, 0.f};
        cur = nxt; cA = nA; cB = nB; ++ui; gC = gN;
        if constexpr (ALIGN_EPI) { if (wr == 1) PG8_BAR; }
    }
    PG8_WAIT_V(0);
    if constexpr (!ALIGN_EPI) { if (wr == 0) PG8_BAR; }
    PG8_BAR;
#undef PG8_SA
#undef PG8_SB
#undef PG8_STAGE
#undef PG8_GSTAGE
#undef PG8_LDA
#undef PG8_LDB
#undef PG8_MMA
#undef PG8_RD8
#undef PG8_WAIT_V
#undef PG8_WAIT_L
#undef PG8_BAR
#undef PG8_SCHED
}
}

namespace at {
constexpr int D = 128, NW = 8, QBLK = 32, KVBLK = 64;
constexpr float SCALE = 0.088388347648318440f;
constexpr float THR = 8.f;
constexpr int LDQ = INW, LDK = INW, LDO = DM;
constexpr size_t SHM_V = KVBLK * D * 2, SHM_K = KVBLK * D * 2, SHM_ATTN = 2 * SHM_V + 2 * SHM_K + NW * 64 * 4;
#define KSWZ(row, colB) ((row) * 256 + ((colB) ^ (((row) & 7) << 4)))
#define SBAR() __builtin_amdgcn_sched_barrier(0)
__device__ __forceinline__ int crow(int r, int hi) { return (r & 3) + 8 * (r >> 2) + 4 * hi; }
__device__ __forceinline__ unsigned cvtpk(float lo, float hi) { unsigned r; asm volatile("v_cvt_pk_bf16_f32 %0, %1, %2" : "=v"(r) : "v"(lo), "v"(hi)); return r; }

__device__ __forceinline__ void partialSM(f32x16& p0, f32x16& p1, float& m_reg, float& mn, float& alpha, bool domask, int dq, int hi) {
  constexpr float C = SCALE * 1.4426950408889634f;
  {
    if (domask) {
#pragma unroll
      for (int r = 0; r < 16; ++r) { const int d0 = dq + crow(r, hi), d1 = d0 + 32;
        if (d0 > 128 || d0 < -128) p0[r] = -1e30f;
        if (d1 > 128 || d1 < -128) p1[r] = -1e30f; }
    }
  }
  float pmax = p0[0]; for (int r = 1; r < 16; ++r) pmax = fmaxf(pmax, p0[r]); for (int r = 0; r < 16; ++r) pmax = fmaxf(pmax, p1[r]);
  { auto rr = __builtin_amdgcn_permlane32_swap(__float_as_uint(pmax), __float_as_uint(pmax), false, false);
    pmax = fmaxf(__uint_as_float(rr[0]), __uint_as_float(rr[1])); }
  if (__builtin_expect(__all(pmax - m_reg <= THR / SCALE), 1)) { mn = m_reg; alpha = 1.f; }
  else { mn = fmaxf(m_reg, pmax); alpha = __builtin_amdgcn_exp2f((m_reg - mn) * C); m_reg = mn; }
  float mnC = -mn * C;
  for (int r = 0; r < 16; ++r) p0[r] = fmaf(p0[r], C, mnC); for (int r = 0; r < 16; ++r) p1[r] = fmaf(p1[r], C, mnC);
  for (int r = 0; r < 16; ++r) p0[r] = __builtin_amdgcn_exp2f(p0[r]);
}
__device__ __forceinline__ void finishSM(f32x16& p0, f32x16& p1, float alpha, float& l_reg, bf16x8& pa0, bf16x8& pa1, bf16x8& pa2, bf16x8& pa3) {
  for (int r = 0; r < 16; ++r) p1[r] = __builtin_amdgcn_exp2f(p1[r]);
  float ps = 0; for (int r = 0; r < 16; ++r) ps += p0[r]; for (int r = 0; r < 16; ++r) ps += p1[r];
  { auto rr = __builtin_amdgcn_permlane32_swap(__float_as_uint(ps), __float_as_uint(ps), false, false);
    ps = __uint_as_float(rr[0]) + __uint_as_float(rr[1]); }
  l_reg = l_reg * alpha + ps;
#define PK4(P, BASE, OUT) do { unsigned a0 = cvtpk(P[BASE + 0], P[BASE + 1]), a1 = cvtpk(P[BASE + 2], P[BASE + 3]);   \
    unsigned b0 = cvtpk(P[BASE + 4], P[BASE + 5]), b1 = cvtpk(P[BASE + 6], P[BASE + 7]);                              \
    auto r0 = __builtin_amdgcn_permlane32_swap(a0, b0, false, false); auto r1 = __builtin_amdgcn_permlane32_swap(a1, b1, false, false); \
    u32x4 w = {r0[0], r1[0], r0[1], r1[1]}; OUT = *reinterpret_cast<bf16x8*>(&w); } while (0)
  PK4(p0, 0, pa0); PK4(p0, 8, pa1); PK4(p1, 0, pa2); PK4(p1, 8, pa3);
#undef PK4
}
__device__ __forceinline__ void qkt(f32x16& p0, f32x16& p1, const char* Ks, const bf16x8* qr, int ka0) {
  p0 = f32x16{}; p1 = f32x16{};
  asm volatile("" : "+v"(ka0));
#pragma unroll
  for (int d0 = 0; d0 < 8; ++d0) { const int off = ka0 ^ (d0 * 32);
    bf16x8 b0 = *reinterpret_cast<const bf16x8*>(Ks + off);
    bf16x8 b1 = *reinterpret_cast<const bf16x8*>(Ks + off + 32 * 256);
    p0 = __builtin_amdgcn_mfma_f32_32x32x16_bf16(b0, qr[d0], p0, 0, 0, 0);
    p1 = __builtin_amdgcn_mfma_f32_32x32x16_bf16(b1, qr[d0], p1, 0, 0, 0); }
}
__device__ __forceinline__ int v_st(int k, int c) { const int kk = (k & ~0xC) | ((k & 4) << 1) | ((k & 8) >> 1); return ((kk >> 3) * 4 + (c >> 5)) * 512 + ((kk & 7) * 32 + (c & 31)) * 2; }
__device__ __forceinline__ int v_rd_base(int lane) { return ((lane & 3) << 3) | (((lane >> 2) & 3) << 6) | (((lane >> 4) & 1) << 5) | (((lane >> 5) & 1) << 8); }
constexpr int v_rd_off(int d0, int ks, int half) { return d0 * 512 + ks * 4096 + half * 2048; }
template <int OFF> __device__ __forceinline__ s16x4 tr_read(int vb) {
  s16x4 r; asm volatile("ds_read_b64_tr_b16 %0, %1 offset:%2" : "=&v"(r) : "v"(vb), "i"(OFF) : "memory"); return r;
}
template <int D0> __device__ __forceinline__ void pv_one(f32x16& od, int vb, bf16x8 pa0, bf16x8 pa1, bf16x8 pa2, bf16x8 pa3) {
  const s16x4 l0 = tr_read<v_rd_off(D0, 0, 0)>(vb), h0 = tr_read<v_rd_off(D0, 0, 1)>(vb), l1 = tr_read<v_rd_off(D0, 1, 0)>(vb), h1 = tr_read<v_rd_off(D0, 1, 1)>(vb);
  const s16x4 l2 = tr_read<v_rd_off(D0, 2, 0)>(vb), h2 = tr_read<v_rd_off(D0, 2, 1)>(vb), l3 = tr_read<v_rd_off(D0, 3, 0)>(vb), h3 = tr_read<v_rd_off(D0, 3, 1)>(vb);
  asm volatile("s_waitcnt lgkmcnt(0)" ::: "memory"); SBAR();
#define PK(L, H) (bf16x8){L[0], L[1], L[2], L[3], H[0], H[1], H[2], H[3]}
  od = __builtin_amdgcn_mfma_f32_32x32x16_bf16(pa0, PK(l0, h0), od, 0, 0, 0);
  od = __builtin_amdgcn_mfma_f32_32x32x16_bf16(pa1, PK(l1, h1), od, 0, 0, 0);
  od = __builtin_amdgcn_mfma_f32_32x32x16_bf16(pa2, PK(l2, h2), od, 0, 0, 0);
  od = __builtin_amdgcn_mfma_f32_32x32x16_bf16(pa3, PK(l3, h3), od, 0, 0, 0);
#undef PK
}
__device__ __forceinline__ void pv_d0(f32x16* o, int vb, bf16x8 pa0, bf16x8 pa1, bf16x8 pa2, bf16x8 pa3) {
  pv_one<0>(o[0], vb, pa0, pa1, pa2, pa3); pv_one<1>(o[1], vb, pa0, pa1, pa2, pa3); pv_one<2>(o[2], vb, pa0, pa1, pa2, pa3); pv_one<3>(o[3], vb, pa0, pa1, pa2, pa3);
}

__device__ __forceinline__ void attn_body(const bf16_t* __restrict__ Qb, const bf16_t* __restrict__ Kb, const bf16_t* __restrict__ Vb, bf16_t* __restrict__ Ob,
                                          int NT, int kskip, int qpos0, float m0, float l0, bool maskon, char* lds, float* ssq_out) {
  const int tid = opaque_tid(), wid = tid >> 6, lane = tid & 63, r32 = lane & 31, hi = lane >> 5;
  char* V_lds = lds; char* K_lds = lds + 2 * SHM_V;
  float* ws = (float*)(lds + 2 * SHM_V + 2 * SHM_K) + wid * 64; float* li_l = ws; float* al_l = ws + 32;
  float m_reg = m0, l_reg = l0; f32x16 o[4] = {}; bf16x8 qr[8];
  const bf16_t* Qw = Qb + (long)(wid * QBLK + r32) * LDQ + hi * 8;
#pragma unroll
  for (int d0 = 0; d0 < 8; ++d0) qr[d0] = *reinterpret_cast<const bf16x8*>(Qw + d0 * 16);
  const int sr = tid >> 4, sc = (tid & 15) * 8, vst0 = v_st(sr, sc), kst0 = KSWZ(sr, sc * 2);
  const int vb0 = (int)(uintptr_t)V_lds + v_rd_base(lane);
  const int qpos = qpos0 + wid * QBLK + r32;
  const int ka0 = r32 * 256 + ((hi * 16) ^ ((r32 & 7) << 4));
  const unsigned goff0 = (unsigned)(sr * LDK + sc) * 2u, goff1 = goff0 + 32u * LDK * 2u;
  struct { bf16x8 vs0, vs1, ks0, ks1; } sr_[1];
#define TROW(jt) ((long)(jt) * KVBLK + ((jt) >= 4 ? kskip : 0))
#define SLOAD(i, jt) do { const long _k0 = TROW(jt) * (LDK * 2); const char* _kp = (const char*)Kb + _k0; const char* _vp = (const char*)Vb + _k0; \
    sr_[i].vs0 = *reinterpret_cast<const bf16x8*>(_vp + goff0); sr_[i].vs1 = *reinterpret_cast<const bf16x8*>(_vp + goff1); \
    sr_[i].ks0 = *reinterpret_cast<const bf16x8*>(_kp + goff0); sr_[i].ks1 = *reinterpret_cast<const bf16x8*>(_kp + goff1); } while (0)
#define SWRITE(b, i) do { *(bf16x8*)(V_lds + (b) * SHM_V + vst0) = sr_[i].vs0;          \
    *(bf16x8*)(V_lds + (b) * SHM_V + vst0 + 8192) = sr_[i].vs1;                         \
    *(bf16x8*)(K_lds + (b) * SHM_K + kst0) = sr_[i].ks0;                               \
    *(bf16x8*)(K_lds + (b) * SHM_K + kst0 + 8192) = sr_[i].ks1; } while (0)
#define SWAIT() asm volatile("s_waitcnt vmcnt(0)" ::: "memory")
#define RESC(a) do { if (__any((a) < 1.f)) { if (hi == 0) al_l[r32] = (a); asm volatile("s_waitcnt lgkmcnt(0)" ::: "memory"); \
    for (int d = 0; d < 4; ++d) for (int r = 0; r < 16; ++r) o[d][r] *= al_l[crow(r, hi)]; } } while (0)
#define DQ(jt) (kskip + ((jt) - 4) * KVBLK - qpos)
  f32x16 pA0, pA1, pB0, pB1; float mnA, mnB, alA, alB; bf16x8 pa0, pa1, pa2, pa3;
  constexpr int SE = 0, SO = 0;
  SLOAD(SE, 0); asm volatile("s_waitcnt vmcnt(0)" ::: "memory"); SWRITE(0, SE); __syncthreads();
  qkt(pA0, pA1, K_lds, qr, ka0); partialSM(pA0, pA1, m_reg, mnA, alA, false, 0, hi);
  SLOAD(SO, 1);
  SWAIT(); SWRITE(1, SO); __syncthreads();
  for (int j = 1; j + 1 < NT; j += 2) {
    SBAR(); qkt(pB0, pB1, K_lds + SHM_K, qr, ka0);
    finishSM(pA0, pA1, alA, l_reg, pa0, pa1, pa2, pa3); SBAR();
    SLOAD(SO, j + 1); SBAR();
    pv_d0(o, vb0, pa0, pa1, pa2, pa3); partialSM(pB0, pB1, m_reg, mnB, alB, maskon && j >= 4, DQ(j), hi);
    __syncthreads(); SWAIT(); SWRITE(0, SE);
    RESC(alB); __syncthreads();
    SBAR(); qkt(pA0, pA1, K_lds, qr, ka0);
    finishSM(pB0, pB1, alB, l_reg, pa0, pa1, pa2, pa3); SBAR();
    SLOAD(SE, j + 2); SBAR();
    pv_d0(o, vb0 + (int)SHM_V, pa0, pa1, pa2, pa3); partialSM(pA0, pA1, m_reg, mnA, alA, maskon && j + 1 >= 4, DQ(j + 1), hi);
    __syncthreads(); SWAIT(); SWRITE(1, SO);
    RESC(alA); __syncthreads();
  }
  SBAR(); qkt(pB0, pB1, K_lds + SHM_K, qr, ka0);
  finishSM(pA0, pA1, alA, l_reg, pa0, pa1, pa2, pa3); SBAR();
  pv_d0(o, vb0, pa0, pa1, pa2, pa3); partialSM(pB0, pB1, m_reg, mnB, alB, maskon && NT - 1 >= 4, DQ(NT - 1), hi);
  __syncthreads(); RESC(alB);
  finishSM(pB0, pB1, alB, l_reg, pa0, pa1, pa2, pa3); SBAR();
  pv_d0(o, vb0 + (int)SHM_V, pa0, pa1, pa2, pa3);
  if (hi == 0) li_l[r32] = l_reg; asm volatile("s_waitcnt lgkmcnt(0)" ::: "memory");
  float rli[16];
#pragma unroll
  for (int r = 0; r < 16; ++r) rli[r] = __builtin_amdgcn_rcpf(li_l[crow(r, hi)]);
  bf16_t* Ow = Ob + (long)(wid * QBLK) * LDO;
#pragma unroll
  for (int r = 0; r < 16; ++r) { int orow = crow(r, hi); float sq = 0.f;
    for (int d0 = 0; d0 < 4; ++d0) { const float ov = o[d0][r] * rli[r]; sq += ov * ov; Ow[(long)orow * LDO + d0 * 32 + r32] = (bf16_t)f2bf(ov); }
    sq = row16_sum(sq); sq += __builtin_bit_cast(float, __builtin_amdgcn_ds_swizzle(__builtin_bit_cast(int, sq), 0x401F));
    if (r32 == 0) ssq_out[(size_t)(wid * QBLK + orow) * 16] = sq; }
#undef TROW
#undef SLOAD
#undef SWRITE
#undef SWAIT
#undef RESC
#undef DQ
}
}

struct Args { const float* in[23]; float* out; unsigned char* ws; int ph_lo, ph_hi; };
enum { IN_X = 0, IN_C, IN_CTX, IN_CCTX, IN_WMOD, IN_BMOD, IN_N1G, IN_N2G, IN_WIN, IN_QNA, IN_KNA, IN_SINK, IN_VNB, IN_WS, IN_BS, IN_QNC, IN_KNC, IN_OUTG, IN_WOUT, IN_WR, IN_WG, IN_WU, IN_WDN };

#define PHASE_IDS(F) const int tid = opaque_tid(), lane = tid & 63, wave = __builtin_amdgcn_readfirstlane(tid >> 6), gw = (int)blockIdx.x * 8 + wave, NGW = (F).G * 8; (void)lane; (void)wave; (void)gw; (void)NGW
constexpr int ARGTAB_OFF = LDSCTL_OFF + 1024;
#define INP(F, i) ld_inp((F).lds, (i))
__device__ __forceinline__ const float* ld_inp(LAS unsigned char* lds, int i) {
    unsigned a = (unsigned)(uintptr_t)(lds + ARGTAB_OFF) + 8u * (unsigned)i;
    asm volatile("" : "+v"(a));
    const volatile LAS unsigned* t = (const volatile LAS unsigned*)(uintptr_t)a;
    const unsigned lo = __builtin_amdgcn_readfirstlane(t[0]), hi = __builtin_amdgcn_readfirstlane(t[1]);
    return (const float*)(const GAS float*)(((unsigned long long)hi << 32) | lo);
}
struct Frame {
    LAS unsigned char* lds; char* ldsg;
    volatile LAS unsigned* MISC;
    unsigned* ctl;
    int G;
    float* out; unsigned char* ws;
};

__host__ __device__ __forceinline__ int headpos(int d) { return 32 * (2 * (d >> 6) + ((d >> 4) & 1)) + 8 * ((d >> 2) & 3) + 4 * ((d >> 5) & 1) + (d & 3); }
template <bool HEADPERM = false>
__device__ __forceinline__ void transpose_item(const float* W, int N, bf16_t* WT, int k0, int n0, int drow0, LAS float* scr, int lane) {
    { float t[32]; const float* wp = W + (size_t)(k0 + (lane >> 5)) * N + n0 + (lane & 31);
#pragma unroll
      for (int i = 0; i < 32; ++i) t[i] = wp[(size_t)(2 * i) * N];
#pragma unroll
      for (int i = 0; i < 32; ++i) scr[(2 * i + (lane >> 5)) * 33 + (lane & 31)] = t[i]; }
    LDS_WAIT(); asm volatile("" ::: "memory");
    const int c = lane & 7;
#pragma unroll
    for (int j = 0; j < 4; ++j) { const int n = (lane >> 3) + 8 * j; const LAS float* s = scr + (8 * c) * 33 + n;
        u32x4 o; o.x = pk2(s[0 * 33], s[1 * 33]); o.y = pk2(s[2 * 33], s[3 * 33]); o.z = pk2(s[4 * 33], s[5 * 33]); o.w = pk2(s[6 * 33], s[7 * 33]);
        const int drow = HEADPERM ? ((drow0 + n) & ~127) + headpos((drow0 + n) & 127) : drow0 + n;
        *(u32x4*)(WT + (size_t)drow * DM + k0 + 8 * c) = o; }
    LDS_WAIT(); asm volatile("" ::: "memory");
}

__device__ __forceinline__ void transpose_item8(const float* W, int N, unsigned char* WT, int k0, int n0, int drow0, LAS float* scr, int lane) {
    { float t[32]; const float* wp = W + (size_t)(k0 + (lane >> 5)) * N + n0 + (lane & 31);
#pragma unroll
      for (int i = 0; i < 32; ++i) t[i] = wp[(size_t)(2 * i) * N];
#pragma unroll
      for (int i = 0; i < 32; ++i) scr[(2 * i + (lane >> 5)) * 33 + (lane & 31)] = t[i]; }
    LDS_WAIT(); asm volatile("" ::: "memory");
    const int c = lane & 7;
#pragma unroll
    for (int j = 0; j < 4; ++j) { const int n = (lane >> 3) + 8 * j; const LAS float* s = scr + (8 * c) * 33 + n;
        u32x2 o; o.x = pk4_fp8(s[0 * 33] * W8_SCALE, s[1 * 33] * W8_SCALE, s[2 * 33] * W8_SCALE, s[3 * 33] * W8_SCALE); o.y = pk4_fp8(s[4 * 33] * W8_SCALE, s[5 * 33] * W8_SCALE, s[6 * 33] * W8_SCALE, s[7 * 33] * W8_SCALE);
        *(u32x2*)(WT + (size_t)(drow0 + n) * DM + k0 + 8 * c) = o; }
    LDS_WAIT(); asm volatile("" ::: "memory");
}
__device__ __forceinline__ void conv_tile(Frame& F, int tl, int tid, int lane, int wave) {
    const int mat = tl >> 7, kb = (tl & 127) >> 3, nb = tl & 7, le = mat / 3, wh = mat % 3;
    const float* src = INP(F, wh == 0 ? IN_WG : wh == 1 ? IN_WU : IN_WDN) + (size_t)le * DM * DM + (size_t)(128 * kb) * DM + 256 * nb;
    unsigned char* dst = (wh < 2) ? F.ws + WS_WGU + (size_t)(le / NE) * NE * 4096 * DM * 2 + (size_t)(le % NE) * 4096 * DM + (size_t)(2 * nb) * 256 * DM + 128 * kb
                                  : F.ws + WS_WD + (size_t)(le / NE) * NE * DM * DM * 2 + (size_t)(le % NE) * DM * DM + (size_t)(256 * nb) * DM + 128 * kb;
    f32x4 t[16];
    { const float* wp = src + (size_t)(16 * wave) * DM + 4 * lane;
#pragma unroll
      for (int q = 0; q < 16; ++q) t[q] = __builtin_nontemporal_load((const f32x4*)(wp + (size_t)q * DM)); }
    LAS unsigned* img = (LAS unsigned*)F.lds;
#pragma unroll
    for (int it = 0; it < 4; ++it)
#pragma unroll
        for (int j = 0; j < 4; ++j) { const int n = 4 * lane + j, d = 4 * wave + it;
            img[n * 32 + (d ^ (lane & 31))] = pk4_fp8(t[4 * it + 0][j] * W8_SCALE, t[4 * it + 1][j] * W8_SCALE, t[4 * it + 2][j] * W8_SCALE, t[4 * it + 3][j] * W8_SCALE); }
    __syncthreads();
#pragma unroll
    for (int q = 0; q < 4; ++q) { const int ch = tid + 512 * q, n = ch >> 3, g = ch & 7, sw = (n >> 2) & 31;
        u32x4 o; o.x = img[n * 32 + ((4 * g + 0) ^ sw)]; o.y = img[n * 32 + ((4 * g + 1) ^ sw)]; o.z = img[n * 32 + ((4 * g + 2) ^ sw)]; o.w = img[n * 32 + ((4 * g + 3) ^ sw)];
        const int drow = (wh < 2) ? (n >> 7) * 256 + wh * 128 + (n & 127) : n;
        *(u32x4*)(dst + (size_t)drow * DM + 16 * g) = o; }
    __syncthreads();
}
__device__ __forceinline__ void conv_help(Frame& F, int budget, unsigned* done, unsigned done_total) {
    if (!CONV_IDLE) return;
    PHASE_IDS(F);
    for (int n = 0; n < budget; ++n) {
        if (tid == 0) { unsigned t = 0xffffffffu;
            if (done == nullptr || xb_ld(done) < done_total) t = xb_add(F.ctl + CW_CONV, 1u);
            F.MISC[1] = t; }
        __syncthreads();
        const unsigned t = F.MISC[1];
        __syncthreads();
        if (t >= (unsigned)(NT8_ALL - NT8_L0)) break;
        conv_tile(F, NT8_L0 + (int)t, tid, lane, wave);
    }
}
__device__ __forceinline__ void phase_prologue(Frame& F) {
    PHASE_IDS(F);
    static_assert(FP8_L0 && FP8_L1, "the prologue writes the experts' weights as fp8");
    {
        constexpr int NT8 = CONV_IDLE ? NT8_L0 : NT8_ALL;
        struct T8 { const float* src; unsigned char* dst; int which; };
#define P8_DESC(d, tl) do { const int mat = (tl) >> 7, kb = ((tl) & 127) >> 3, nb = (tl) & 7, le = mat / 3, wh = mat % 3; d.which = wh; \
        d.src = INP(F, wh == 0 ? IN_WG : wh == 1 ? IN_WU : IN_WDN) + (size_t)le * DM * DM + (size_t)(128 * kb) * DM + 256 * nb; \
        d.dst = (wh < 2) ? F.ws + WS_WGU + (size_t)(le / NE) * NE * 4096 * DM * 2 + (size_t)(le % NE) * 4096 * DM + (size_t)(2 * nb) * 256 * DM + 128 * kb \
                         : F.ws + WS_WD + (size_t)(le / NE) * NE * DM * DM * 2 + (size_t)(le % NE) * DM * DM + (size_t)(256 * nb) * DM + 128 * kb; } while (0)
#define P8_LOAD(d, t) do { const float* wp = d.src + (size_t)(16 * wave) * DM + 4 * lane; _Pragma("unroll") for (int q = 0; q < 16; ++q) t[q] = __builtin_nontemporal_load((const f32x4*)(wp + (size_t)q * DM)); } while (0)
        T8 cur, nxt; f32x4 t0[16], t1[16];
        int tl = blockIdx.x, par = 0;
        if (tl < NT8) { P8_DESC(cur, tl); P8_LOAD(cur, t0); }
        for (; tl < NT8; tl += F.G, par ^= 1) {
            const bool has = tl + F.G < NT8;
            if (has) { P8_DESC(nxt, tl + F.G); P8_LOAD(nxt, t1); }
            LAS unsigned* img = (LAS unsigned*)(F.lds + par * 32768);
#pragma unroll
            for (int it = 0; it < 4; ++it)
#pragma unroll
                for (int j = 0; j < 4; ++j) { const int n = 4 * lane + j, d = 4 * wave + it;
                    img[n * 32 + (d ^ (lane & 31))] = pk4_fp8(t0[4 * it + 0][j] * W8_SCALE, t0[4 * it + 1][j] * W8_SCALE, t0[4 * it + 2][j] * W8_SCALE, t0[4 * it + 3][j] * W8_SCALE); }
            __syncthreads();
#pragma unroll
            for (int q = 0; q < 4; ++q) { const int ch = tid + 512 * q, n = ch >> 3, g = ch & 7, sw = (n >> 2) & 31;
                u32x4 o; o.x = img[n * 32 + ((4 * g + 0) ^ sw)]; o.y = img[n * 32 + ((4 * g + 1) ^ sw)]; o.z = img[n * 32 + ((4 * g + 2) ^ sw)]; o.w = img[n * 32 + ((4 * g + 3) ^ sw)];
                const int drow = (cur.which < 2) ? (n >> 7) * 256 + cur.which * 128 + (n & 127) : n;
                *(u32x4*)(cur.dst + (size_t)drow * DM + 16 * g) = o; }
            if (has) { cur = nxt;
#pragma unroll
                for (int q = 0; q < 16; ++q) t0[q] = t1[q]; }
        }
#undef P8_DESC
#undef P8_LOAD
        __syncthreads();
    }
    LAS float* scr = (LAS float*)(F.lds + wave * 16384);
    constexpr int I_IN = 32 * (INW / 32), I_SQ = 32 * (DM / 32);
    constexpr int NIT = 2 * I_IN + 2 * I_SQ;
    struct TItem { const float* src; unsigned char* dst; const float* og; int N, drow0, mode; };
#define P0_DESC(d, itv) do { int r = (itv); \
        if (r < 2 * I_IN) { const int l = r / I_IN; r %= I_IN; const int kb = r / (INW / 32), nb = r % (INW / 32); \
            d.src = INP(F, IN_WIN) + (size_t)l * DM * INW + (size_t)(64 * kb) * INW + 32 * nb; d.dst = F.ws + WS_WIN + (size_t)l * INW * DM * 2 + 128 * kb; d.N = INW; d.drow0 = 32 * nb; d.mode = 1; d.og = nullptr; } \
        else { r -= 2 * I_IN; const int l = r / I_SQ; r %= I_SQ; const int kb = r / 64, nb = r % 64; \
            d.src = INP(F, IN_WOUT) + (size_t)l * DM * DM + (size_t)(64 * kb) * DM + 32 * nb; d.dst = F.ws + WS_WOUT + (size_t)l * DM * DM * 2 + 128 * kb; d.N = DM; d.drow0 = 32 * nb; d.mode = 0; d.og = INP(F, IN_OUTG) + l * DM + 64 * kb; } } while (0)
#define P0_LOAD(d, t) do { const float* wp = d.src + (size_t)(lane >> 3) * d.N + (lane & 7) * 4; _Pragma("unroll") for (int i = 0; i < 8; ++i) t[i] = *(const f32x4*)(wp + (size_t)(8 * i) * d.N); } while (0)
    for (int it = gw; it < NIT; it += NGW) {
        TItem cur; f32x4 t0[8];
        P0_DESC(cur, it); P0_LOAD(cur, t0);
#pragma unroll
        for (int i = 0; i < 8; ++i) { LAS float* sp = scr + (8 * i + (lane >> 3)) * 33 + (lane & 7) * 4; sp[0] = t0[i].x; sp[1] = t0[i].y; sp[2] = t0[i].z; sp[3] = t0[i].w; }
        LDS_WAIT(); asm volatile("" ::: "memory");
        const int c = lane & 7;
#pragma unroll
        for (int j = 0; j < 4; ++j) { const int n = (lane >> 3) + 8 * j; const LAS float* sp = scr + (8 * c) * 33 + n;
            float v[8];
#pragma unroll
            for (int q = 0; q < 8; ++q) v[q] = sp[q * 33];
            if (cur.mode == 0) { const f32x4 g0 = *(const f32x4*)(cur.og + 8 * c), g1 = *(const f32x4*)(cur.og + 8 * c + 4);
                v[0] *= g0.x; v[1] *= g0.y; v[2] *= g0.z; v[3] *= g0.w; v[4] *= g1.x; v[5] *= g1.y; v[6] *= g1.z; v[7] *= g1.w; }
            int drow = cur.drow0 + n; if (cur.mode == 1) drow = (drow & ~127) + headpos(drow & 127);
            u32x4 o; o.x = pk2(v[0], v[1]); o.y = pk2(v[2], v[3]); o.z = pk2(v[4], v[5]); o.w = pk2(v[6], v[7]); *(u32x4*)(cur.dst + (size_t)drow * DM * 2 + 16 * c) = o; }
        LDS_WAIT(); asm volatile("" ::: "memory");
    }
#undef P0_DESC
#undef P0_LOAD
    __syncthreads();
    {
        LAS float* sil = (LAS float*)F.lds;
        LAS float* red = (LAS float*)(F.lds + 40960);
        bool have = false;
        for (int it = blockIdx.x; it < 2 * 96; it += F.G) {
            if (!have) {
                { const float* cp = INP(F, IN_C); const float* ccp = INP(F, IN_CCTX);
                for (int i = tid; i < 5 * DM; i += 512) { const int s = i / DM, k = i % DM; const float cv = (s < 4) ? cp[s * DM + k] : ccp[k]; sil[i] = cv / (1.f + __expf(-cv)); } }
                have = true; __syncthreads();
            }
            const int l = it / 96, cb = it % 96, c4 = tid & 31, kr = tid >> 5;
            const float* wp = INP(F, IN_WMOD) + (size_t)l * DM * NMOD + (size_t)cb * 128 + c4 * 4;
            f32x4 a[5];
#pragma unroll
            for (int s = 0; s < 5; ++s) a[s] = (f32x4){0.f, 0.f, 0.f, 0.f};
#pragma unroll 8
            for (int k = kr; k < DM; k += 16) { const f32x4 w = *(const f32x4*)(wp + (size_t)k * NMOD);
#pragma unroll
                for (int s = 0; s < 5; ++s) a[s] += w * sil[s * DM + k]; }
#pragma unroll
            for (int s = 0; s < 5; ++s) *(LAS f32x4*)(red + (kr * 5 + s) * 128 + c4 * 4) = a[s];
            __syncthreads();
            const float* bmod = INP(F, IN_BMOD);
            for (int i = tid; i < 5 * 128; i += 512) { const int s = i / 128, cc = i % 128; float sum = 0.f;
#pragma unroll
                for (int q = 0; q < 16; ++q) sum += red[(q * 5 + s) * 128 + cc];
                ((float*)(F.ws + WS_MOD))[(size_t)(l * 5 + s) * NMOD + cb * 128 + cc] = sum + bmod[l * NMOD + cb * 128 + cc]; }
            __syncthreads();
        }
    }
    if ((int)blockIdx.x >= F.G - 9 && (int)blockIdx.x < F.G - 1) {
        const float* wr = INP(F, IN_WR); bf16_t* wf = (bf16_t*)(F.ws + WS_WRS); const int part = (int)blockIdx.x - (F.G - 9);
        for (int i = part * 512 + tid; i < 2 * DM * NE; i += 8 * 512) { const int l = i / (DM * NE), rem = i % (DM * NE), k = rem >> 4, e = rem & 15;
            const float w = wr[i]; const unsigned hi = f2bf(w); const unsigned lo = f2bf(w - __builtin_bit_cast(float, hi << 16));
            const int sidx = k >> 5, q = (k >> 3) & 3, j = k & 7; bf16_t* dst = wf + ((size_t)(l * 64 + sidx) * 2 * 64 + (q * 16 + e)) * 8 + j;
            dst[0] = (bf16_t)hi; dst[64 * 8] = (bf16_t)lo; }
    }
    if (blockIdx.x == F.G - 1) {
        for (int i = tid; i < 64 * 32; i += 512) {
            const int pos = i >> 5, f = i & 31;
            double inv = 1.0; for (int q = 0; q < f; ++q) inv *= 0.7498942093324559;
            const double a = (double)pos * inv;
            const double n = __builtin_rint(a * 0.6366197723675814);
            const double r = (a - n * 1.5707963267948966) - n * 6.123233995736766e-17;
            const double r2 = r * r;
            double sn = r * (1.0 + r2 * (-1.0 / 6 + r2 * (1.0 / 120 + r2 * (-1.0 / 5040 + r2 * (1.0 / 362880 + r2 * (-1.0 / 39916800 + r2 * (1.0 / 6227020800.0)))))));
            double cn = 1.0 + r2 * (-0.5 + r2 * (1.0 / 24 + r2 * (-1.0 / 720 + r2 * (1.0 / 40320 + r2 * (-1.0 / 3628800 + r2 * (1.0 / 479001600 + r2 * (-1.0 / 87178291200.0)))))));
            const int q = ((int)n) & 3; double cs, ss;
            if (q == 0) { cs = cn; ss = sn; } else if (q == 1) { cs = -sn; ss = cn; } else if (q == 2) { cs = -cn; ss = -sn; } else { cs = sn; ss = -cn; }
            ((float*)(F.ws + WS_ROPE))[2 * i] = (float)cs; ((float*)(F.ws + WS_ROPE))[2 * i + 1] = (float)ss;
        }
    }
}

__device__ __forceinline__ void load_row(const float* row, int lane, f32x4 (&v)[8]) {
#pragma unroll
    for (int j = 0; j < 8; ++j) v[j] = *(const f32x4*)(row + 4 * lane + 256 * j);
}
__device__ __forceinline__ void norm_mod_store(const f32x4 (&v)[8], const float* g, const float* shift, const float* scale, bf16_t* dst, int lane) {
    float ss = 0.f;
#pragma unroll
    for (int j = 0; j < 8; ++j) ss += (v[j].x * v[j].x + v[j].y * v[j].y) + (v[j].z * v[j].z + v[j].w * v[j].w);
    const float rinv = rsqrt_fast(wave_sum(ss) * (1.f / DM) + EPS);
#pragma unroll
    for (int j = 0; j < 8; ++j) { const int c = 4 * lane + 256 * j;
        const f32x4 gg = *(const f32x4*)(g + c), sh = *(const f32x4*)(shift + c), sc = *(const f32x4*)(scale + c);
        const f32x4 y = (v[j] * rinv) * gg * (sc + 1.f) + sh;
        u32x2 w; w.x = pk2(y.x, y.y); w.y = pk2(y.z, y.w); *(u32x2*)(dst + c) = w; }
}

__device__ __forceinline__ void phase_rowpass1_l0(Frame& F) {
    PHASE_IDS(F);
    const float* mod = (const float*)(F.ws + WS_MOD);
    { const float* n2 = INP(F, IN_N2G); float* gs = (float*)(F.ws + WS_GS2);
      for (int i = (int)blockIdx.x * 512 + tid; i < 2 * 5 * DM; i += F.G * 512) { const int l = i / (5 * DM), sv = (i / DM) % 5, k = i % DM;
          const float* m = mod + (size_t)(l * 5 + sv) * NMOD; gs[2 * i] = n2[l * DM + k] * (1.f + m[4 * DM + k]); gs[2 * i + 1] = m[3 * DM + k]; } }
    const float* xin = INP(F, IN_X); const float* cin = INP(F, IN_CTX); const float* n1g = INP(F, IN_N1G);
#define P1_SRC(rr) ((((rr) % TPB) < CTXL) ? cin + ((size_t)((rr) / TPB) * CTXL + ((rr) % TPB)) * DM : xin + ((size_t)((rr) / TPB) * SEQ + (((rr) % TPB) - CTXL)) * DM)
    f32x4 v[8], vn[8];
    int r = gw;
    if (r < NTOK) load_row(P1_SRC(r), lane, v);
    while (r < NTOK) {
        const int rn = r + NGW;
        if (rn < NTOK) load_row(P1_SRC(rn), lane, vn);
        const int b = r / TPB, t = r % TPB, s = (t < CTXL) ? 4 : b;
        norm_mod_store(v, n1g, mod + (size_t)s * NMOD, mod + (size_t)s * NMOD + DM, (bf16_t*)(F.ws + WS_HN) + (size_t)r * DM, lane);
#pragma unroll
        for (int j = 0; j < 8; ++j) v[j] = vn[j];
        r = rn;
    }
#undef P1_SRC
}

__device__ __forceinline__ void post_unpack(const u32x4 x, float (&v)[8]) {
    v[0] = bflo(x.x); v[1] = bfhi(x.x); v[2] = bflo(x.y); v[3] = bfhi(x.y); v[4] = bflo(x.z); v[5] = bfhi(x.z); v[6] = bflo(x.w); v[7] = bfhi(x.w); }
__device__ __forceinline__ float sum16(float v) { return row16_sum(v); }
__device__ __forceinline__ void phase_post(Frame& F, int l) {
    PHASE_IDS(F);
    bf16_t* P = (bf16_t*)(F.ws + WS_P);
    const float* rope = (const float*)(F.ws + WS_ROPE);
    const int i16 = lane & 15, hq = lane >> 4; const bool hi2 = hq >= 2;
    const float* qna = INP(F, IN_QNA) + l * 128 + 8 * i16; const float* kna = INP(F, IN_KNA) + l * 128 + 8 * i16;
    const float* qnc = INP(F, IN_QNC) + l * 128 + 8 * i16; const float* knc = INP(F, IN_KNC) + l * 128 + 8 * i16;
    const float* vnb = INP(F, IN_VNB) + l * 512 + 8 * i16;
    for (int r = gw; r < NTOK; r += NGW) {
        const int t = r % TPB; const bool lat = t >= CTXL;
        u32x4* rp = (u32x4*)(P + (size_t)r * INW) + lane;
        u32x4 x[7];
#pragma unroll
        for (int j = 0; j < 7; ++j) x[j] = rp[64 * j];
        const int pos = lat ? t - CTXL : 0, pp = (i16 < 8) ? (pos >> 6) : (pos & 63);
        const f32x4* cs = (const f32x4*)(rope + 2 * (pp * 32 + 8 * (i16 & 3)));
        const f32x4 c0 = cs[0], c1 = cs[1], c2 = cs[2], c3 = cs[3];
        const float cosv[8] = {c0.x, c0.z, c1.x, c1.z, c2.x, c2.z, c3.x, c3.z}, sinv[8] = {c0.y, c0.w, c1.y, c1.w, c2.y, c2.w, c3.y, c3.w};
        const float sgn = (i16 & 4) ? 1.f : -1.f;
#pragma unroll
        for (int j = 0; j < 7; ++j) {
            const bool gelu_lo = (j == 3 || j == 4), gelu_hi = (j == 2 || j == 3);
            const bool norm_lo = (j != 2 && j != 3), norm_hi = (j != 2 && j != 6);
            const bool rope_lo = (j == 0 || j == 1 || j == 5 || j == 6), rope_hi = (j == 0 || j == 1 || j == 4 || j == 5);
            const bool dg = hi2 ? gelu_hi : gelu_lo, dn = hi2 ? norm_hi : norm_lo, dr = (hi2 ? rope_hi : rope_lo) && lat;
            if (!(gelu_lo || gelu_hi || norm_lo || norm_hi)) continue;
            float v[8]; post_unpack(x[j], v);
            if (gelu_lo || gelu_hi) {
#pragma unroll
                for (int e = 0; e < 8; ++e) { const float gv = gelu_tanh(v[e]); v[e] = dg ? gv : v[e]; } }
            if (norm_lo || norm_hi) {
                float ss = 0.f;
#pragma unroll
                for (int e = 0; e < 8; ++e) ss += v[e] * v[e];
                const float rinv = rsqrt_fast(sum16(ss) * (1.f / 128) + EPS);
                const float* gp;
                if (j == 0) gp = qna; else if (j == 1) gp = hi2 ? kna : qna; else if (j == 3) gp = vnb + (hi2 ? hq - 2 : 0) * 128; else if (j == 4) gp = hi2 ? qnc : vnb + (2 + hq) * 128;
                else if (j == 5) gp = qnc; else gp = knc;
                const f32x4 g0 = *(const f32x4*)gp, g1 = *(const f32x4*)(gp + 4);
                const float gg[8] = {g0.x, g0.y, g0.z, g0.w, g1.x, g1.y, g1.z, g1.w};
#pragma unroll
                for (int e = 0; e < 8; ++e) v[e] = dn ? v[e] * rinv * gg[e] : v[e];
            }
            if (rope_lo || rope_hi) {
#pragma unroll
                for (int e = 0; e < 8; ++e) { const float o = __builtin_bit_cast(float, __builtin_amdgcn_ds_swizzle(__builtin_bit_cast(int, v[e]), 0x101F)); const float rv = v[e] * cosv[e] + sgn * o * sinv[e]; v[e] = dr ? rv : v[e]; } }
            u32x4 w; w.x = pk2(v[0], v[1]); w.y = pk2(v[2], v[3]); w.z = pk2(v[4], v[5]); w.w = pk2(v[6], v[7]);
            rp[64 * j] = w;
        }
    }
}

__device__ __forceinline__ void mixer_b_unit(Frame& F, int l, int b, int ch, int g) {
    PHASE_IDS(F);
    const bf16_t* P = (const bf16_t*)(F.ws + WS_P); bf16_t* O = (bf16_t*)(F.ws + WS_O);
    const int row0 = b * TPB + ch * 128, w = wave;
    LAS bf16_t* VT = (LAS bf16_t*)F.lds;
    { const int q = tid >> 2, dp = (tid & 3) * 32; const bf16_t* src = P + (size_t)(row0 + q) * INW + C_VB + g * 128 + dp;
#pragma unroll
      for (int i = 0; i < 4; ++i) { const u32x4 x = *(const u32x4*)(src + 8 * i); const unsigned xs[4] = {x.x, x.y, x.z, x.w};
#pragma unroll
          for (int j = 0; j < 4; ++j) { VT[(dp + 8 * i + 2 * j) * 136 + q] = (bf16_t)(xs[j] & 0xffffu); VT[(dp + 8 * i + 2 * j + 1) * 136 + q] = (bf16_t)(xs[j] >> 16); } } }
    __syncthreads();
    const int i15 = lane & 15, kq = lane >> 4;
    f32x4 acc[8];
#pragma unroll
    for (int n = 0; n < 8; ++n) acc[n] = (f32x4){0.f, 0.f, 0.f, 0.f};
    const float* wsr = INP(F, IN_WS) + ((size_t)(l * 4 + g) * 128 + 16 * w + i15) * 128;
#pragma unroll
    for (int s = 0; s < 4; ++s) {
        const f32x4 a0 = *(const f32x4*)(wsr + 32 * s + 8 * kq), a1 = *(const f32x4*)(wsr + 32 * s + 8 * kq + 4);
        u32x4 aw; aw.x = pk2(a0.x, a0.y); aw.y = pk2(a0.z, a0.w); aw.z = pk2(a1.x, a1.y); aw.w = pk2(a1.z, a1.w);
        const bf16x8 af = *reinterpret_cast<bf16x8*>(&aw);
#pragma unroll
        for (int n = 0; n < 8; ++n) { const bf16x8 bfr = *(const LAS bf16x8*)(VT + (16 * n + i15) * 136 + 32 * s + 8 * kq);
            acc[n] = __builtin_amdgcn_mfma_f32_16x16x32_bf16(af, bfr, acc[n], 0, 0, 0); }
    }
#pragma unroll
    for (int j = 0; j < 4; ++j) { const int p = 16 * w + kq * 4 + j; const float bias = INP(F, IN_BS)[(l * 4 + g) * 128 + p];
        const bf16_t* up = P + (size_t)(row0 + p) * INW + C_UB + g * 128; bf16_t* op = O + (size_t)(row0 + p) * DM + O_B + g * 128;
        float sq = 0.f;
#pragma unroll
        for (int n = 0; n < 8; ++n) { const int d = 16 * n + i15; const float ov = bf2f(up[d]) * (acc[n][j] + bias); sq += ov * ov; op[d] = (bf16_t)f2bf(ov); }
        sq = row16_sum(sq);
        if (i15 == 0) ((float*)(F.ws + WS_SSQ))[(size_t)(row0 + p) * 16 + 6 + g] = sq; }
    __syncthreads();
}
__device__ __forceinline__ void phase_mixers(Frame& F, int l) {
    PHASE_IDS(F);
    const bf16_t* P = (const bf16_t*)(F.ws + WS_P); bf16_t* O = (bf16_t*)(F.ws + WS_O);
    const bool ctx = (l == 0);
    const int nC = 48, nA = 48, nCc = ctx ? 3 : 0, nAc = ctx ? 3 : 0, nB = 68;
    const int total = nC + nA + nCc + nAc + nB;
    for (int kq = 0; kq < 8; ++kq) {
        const int x = ((int)blockIdx.x + kq) & 7, b = x >> 1, kv = x & 1;
        unsigned* qctr = F.ctl + CW_QUEUE + 64 * (l * 8 + x);
        for (;;) {
            if (tid == 0) F.MISC[0] = xb_add(qctr, 1u);
            __syncthreads();
            int u = (int)F.MISC[0];
            __syncthreads();
            if (u >= total) break;
            if (u < nC + nA + nCc + nAc) {
                int kind, h, qb = 0;
                if (u < nC) { kind = 0; h = kv * 3 + u / 16; qb = u % 16; }
                else if (u < nC + nA) { const int v = u - nC; kind = 1; h = kv * 3 + v / 16; qb = v % 16; }
                else if (u < nC + nA + nCc) { kind = 2; h = kv * 3 + (u - nC - nA); }
                else { kind = 3; h = kv * 3 + (u - nC - nA - nCc); }
                const int isA = kind & 1, lat = (kind < 2);
                const size_t r0 = (size_t)b * TPB, rq = r0 + (lat ? CTXL + qb * 256 : 0);
                const int q0 = qb * 256, ks = (kind == 1) ? ((q0 - 128 < 0) ? 0 : q0 - 128) : 0, ke = (q0 + 384 > SEQ) ? SEQ : q0 + 384;
                const int NT = (kind == 0) ? 68 : (kind == 1) ? 4 + (ke - ks) / 64 : 4;
                const float sink = INP(F, IN_SINK)[l * 6 + h];
                const int cq = (isA ? C_QA : C_QC) + h * 128, ck = (isA ? C_KA : C_KC) + kv * 128, cv = (isA ? C_VA : C_VC) + kv * 128, co = (isA ? O_A : O_C) + h * 128;
                at::attn_body(P + rq * INW + cq, P + r0 * INW + ck, P + r0 * INW + cv, O + rq * DM + co, NT, ks, q0, isA ? sink / at::SCALE : -1e30f, isA ? 1.f : 0.f, kind == 1, F.ldsg,
                              (float*)(F.ws + WS_SSQ) + rq * 16 + (isA ? h : 10 + h));
                continue; }
            u -= nC + nA + nCc + nAc;
            { const int ch = u >> 1, g = kv * 2 + (u & 1);
              if (!ctx && ch < 2) continue;
              mixer_b_unit(F, l, b, ch, g); }
        }
    }
    if (CONV_IDLE && (CONV_HOOKS & 1)) {
        __syncthreads();
        if (tid == 0) (void)xb_add(F.ctl + CW_MIXDONE + 64 * l, 1u);
        conv_help(F, 64, F.ctl + CW_MIXDONE + 64 * l, (unsigned)F.G);
    }
}

__device__ __forceinline__ void phase_groupnorm(Frame& F, int l) {
    PHASE_IDS(F);
    bf16_t* O = (bf16_t*)(F.ws + WS_O); const float* og = INP(F, IN_OUTG) + l * DM;
#define GN_SKIP(rr) (l == 1 && ((rr) % TPB) < CTXL)
#define GN_LOAD(rr, xx) do { const bf16_t* _row = O + (size_t)(rr) * DM; \
        _Pragma("unroll") for (int i = 0; i < 3; ++i) { xx[i] = *(const u32x2*)(_row + O_A + 12 * lane + 4 * i); xx[5 + i] = *(const u32x2*)(_row + O_C + 12 * lane + 4 * i); } \
        _Pragma("unroll") for (int i = 0; i < 2; ++i) xx[3 + i] = *(const u32x2*)(_row + O_B + 8 * lane + 4 * i); } while (0)
    int r = gw; while (r < NTOK && GN_SKIP(r)) r += NGW;
    u32x2 x[8], xn[8];
    if (r < NTOK) GN_LOAD(r, x);
    while (r < NTOK) {
        int rn = r + NGW; while (rn < NTOK && GN_SKIP(rn)) rn += NGW;
        if (rn < NTOK) GN_LOAD(rn, xn);
        bf16_t* row = O + (size_t)r * DM;
        float v[8][4]; float ss[3] = {0.f, 0.f, 0.f};
#pragma unroll
        for (int i = 0; i < 8; ++i) { v[i][0] = bflo(x[i].x); v[i][1] = bfhi(x[i].x); v[i][2] = bflo(x[i].y); v[i][3] = bfhi(x[i].y);
            const int grp = (i < 3) ? 0 : (i < 5) ? 1 : 2; ss[grp] += (v[i][0] * v[i][0] + v[i][1] * v[i][1]) + (v[i][2] * v[i][2] + v[i][3] * v[i][3]); }
        float rinv[3];
        rinv[0] = rsqrt_fast(wave_sum(ss[0]) * (1.f / 768) + EPS); rinv[1] = rsqrt_fast(wave_sum(ss[1]) * (1.f / 512) + EPS); rinv[2] = rsqrt_fast(wave_sum(ss[2]) * (1.f / 768) + EPS);
#pragma unroll
        for (int i = 0; i < 8; ++i) { const int grp = (i < 3) ? 0 : (i < 5) ? 1 : 2;
            const int c = (grp == 0) ? O_A + 12 * lane + 4 * i : (grp == 1) ? O_B + 8 * lane + 4 * (i - 3) : O_C + 12 * lane + 4 * (i - 5);
            const f32x4 gg = *(const f32x4*)(og + c); const float ri = rinv[grp];
            u32x2 w; w.x = pk2(v[i][0] * ri * gg.x, v[i][1] * ri * gg.y); w.y = pk2(v[i][2] * ri * gg.z, v[i][3] * ri * gg.w); *(u32x2*)(row + c) = w; }
#pragma unroll
        for (int i = 0; i < 8; ++i) x[i] = xn[i];
        r = rn;
    }
#undef GN_SKIP
#undef GN_LOAD
}

__device__ __forceinline__ float row16_max(float v) {
    v = fmaxf(v, __builtin_bit_cast(float, __builtin_amdgcn_update_dpp(0, __builtin_bit_cast(int, v), 0xB1, 0xF, 0xF, true)));
    v = fmaxf(v, __builtin_bit_cast(float, __builtin_amdgcn_update_dpp(0, __builtin_bit_cast(int, v), 0x4E, 0xF, 0xF, true)));
    v = fmaxf(v, __builtin_bit_cast(float, __builtin_amdgcn_update_dpp(0, __builtin_bit_cast(int, v), 0x141, 0xF, 0xF, true)));
    v = fmaxf(v, __builtin_bit_cast(float, __builtin_amdgcn_update_dpp(0, __builtin_bit_cast(int, v), 0x140, 0xF, 0xF, true)));
    return v;
}
__device__ __forceinline__ void phase_rowpass2(Frame& F, int l) {
    PHASE_IDS(F);
    const bf16_t* xb = (const bf16_t*)(F.ws + WS_XB); const float* parts = (const float*)(F.ws + WS_PART);
    const bool f8 = (l == 0) ? (FP8_L0 != 0) : (FP8_L1 != 0);
    bf16x8 bh[8], bl[8];
    { const bf16x8* wf = (const bf16x8*)((const bf16_t*)(F.ws + WS_WRS) + (size_t)l * 64 * 2 * 64 * 8);
#pragma unroll
      for (int sidx = 0; sidx < 8; ++sidx) { bh[sidx] = wf[((wave * 8 + sidx) * 2 + 0) * 64 + lane]; bl[sidx] = wf[((wave * 8 + sidx) * 2 + 1) * 64 + lane]; } }
    LAS f32x4* red = (LAS f32x4*)(F.lds + LDSCTL_OFF + 2048);
    { const u32x4* gsrc = (const u32x4*)((const float*)(F.ws + WS_GS2) + (size_t)l * 5 * DM * 2) + tid; u32x4 t[10];
#pragma unroll
      for (int i = 0; i < 10; ++i) t[i] = gsrc[512 * i];
#pragma unroll
      for (int i = 0; i < 10; ++i) ((LAS u32x4*)F.lds)[tid + 512 * i] = t[i]; }
    __syncthreads();
    const int i16 = lane & 15, q = lane >> 4;
#define RP2_SKIP(tl) (l == 1 && ((tl) * 16) % TPB < CTXL)
#define RP2_LOAD(tl, xx, pp0, pp1) do { const int _row = (tl) * 16 + i16; const bf16_t* _xr = xb + (size_t)_row * DM + 256 * wave + 8 * q; \
        _Pragma("unroll") for (int sidx = 0; sidx < 8; ++sidx) xx[sidx] = *(const u32x4*)(_xr + 32 * sidx); \
        pp0 = *(const f32x4*)(parts + (size_t)_row * 32 + 8 * q); pp1 = *(const f32x4*)(parts + (size_t)_row * 32 + 8 * q + 4); } while (0)
    int tile = blockIdx.x; while (tile < NTOK / 16 && RP2_SKIP(tile)) tile += F.G;
    u32x4 x[8], xn[8]; f32x4 p0, p1, p0n, p1n;
    if (tile < NTOK / 16) RP2_LOAD(tile, x, p0, p1);
    while (tile < NTOK / 16) {
        int ntile = tile + F.G; while (ntile < NTOK / 16 && RP2_SKIP(ntile)) ntile += F.G;
        const int r0 = tile * 16, b = r0 / TPB, t0 = r0 % TPB, sv = (t0 < CTXL) ? 4 : b;
        const int row = r0 + i16;
        float ss = ((p0.x + p0.y) + (p0.z + p0.w)) + ((p1.x + p1.y) + (p1.z + p1.w));
        ss += __builtin_bit_cast(float, __builtin_amdgcn_ds_swizzle(__builtin_bit_cast(int, ss), 0x401F));
        { auto rr = __builtin_amdgcn_permlane32_swap(__float_as_uint(ss), __float_as_uint(ss), false, false); ss = __uint_as_float(rr[0]) + __uint_as_float(rr[1]); }
        const float rinv = rsqrt_fast(ss * (1.f / DM) + EPS);
        const LAS float* gs = (const LAS float*)F.lds + ((size_t)sv * DM + 256 * wave + 8 * q) * 2;
        f32x4 acc = (f32x4){0.f, 0.f, 0.f, 0.f};
#pragma unroll
        for (int sidx = 0; sidx < 8; ++sidx) {
            const f32x4 g0 = *(const LAS f32x4*)(gs + 64 * sidx), g1 = *(const LAS f32x4*)(gs + 64 * sidx + 4), g2 = *(const LAS f32x4*)(gs + 64 * sidx + 8), g3 = *(const LAS f32x4*)(gs + 64 * sidx + 12);
            float h[8];
            h[0] = bflo(x[sidx].x) * rinv * g0.x + g0.y; h[1] = bfhi(x[sidx].x) * rinv * g0.z + g0.w; h[2] = bflo(x[sidx].y) * rinv * g1.x + g1.y; h[3] = bfhi(x[sidx].y) * rinv * g1.z + g1.w;
            h[4] = bflo(x[sidx].z) * rinv * g2.x + g2.y; h[5] = bfhi(x[sidx].z) * rinv * g2.z + g2.w; h[6] = bflo(x[sidx].w) * rinv * g3.x + g3.y; h[7] = bfhi(x[sidx].w) * rinv * g3.z + g3.w;
            const int col = 256 * wave + 32 * sidx + 8 * q;
            if (f8) { u32x2 w8; w8.x = pk4_fp8(h[0], h[1], h[2], h[3]); w8.y = pk4_fp8(h[4], h[5], h[6], h[7]); *(u32x2*)((unsigned char*)(F.ws + WS_HN8) + (size_t)row * DM + col) = w8; }
            else { u32x4 w16; w16.x = pk2(h[0], h[1]); w16.y = pk2(h[2], h[3]); w16.z = pk2(h[4], h[5]); w16.w = pk2(h[6], h[7]); *(u32x4*)((bf16_t*)(F.ws + WS_HN) + (size_t)row * DM + col) = w16; }
            unsigned hh[8], hl[8];
#pragma unroll
            for (int j = 0; j < 8; ++j) { hh[j] = f2bf(h[j]); hl[j] = f2bf(h[j] - __builtin_bit_cast(float, hh[j] << 16)); }
            u32x4 ah, al; ah.x = hh[0] | (hh[1] << 16); ah.y = hh[2] | (hh[3] << 16); ah.z = hh[4] | (hh[5] << 16); ah.w = hh[6] | (hh[7] << 16);
            al.x = hl[0] | (hl[1] << 16); al.y = hl[2] | (hl[3] << 16); al.z = hl[4] | (hl[5] << 16); al.w = hl[6] | (hl[7] << 16);
            const bf16x8 fah = __builtin_bit_cast(bf16x8, ah), fal = __builtin_bit_cast(bf16x8, al);
            acc = __builtin_amdgcn_mfma_f32_16x16x32_bf16(fah, bh[sidx], acc, 0, 0, 0);
            acc = __builtin_amdgcn_mfma_f32_16x16x32_bf16(fah, bl[sidx], acc, 0, 0, 0);
            acc = __builtin_amdgcn_mfma_f32_16x16x32_bf16(fal, bh[sidx], acc, 0, 0, 0);
        }
        if (ntile < NTOK / 16) RP2_LOAD(ntile, xn, p0n, p1n);
        red[wave * 64 + lane] = acc;
        __syncthreads();
        if (wave == 0) {
            f32x4 lg = red[lane];
#pragma unroll
            for (int w = 1; w < 8; ++w) lg += red[w * 64 + lane];
#pragma unroll
            for (int reg = 0; reg < 4; ++reg) { const float mx = row16_max(lg[reg]); const float ex = __expf(lg[reg] - mx); const float a = ex / row16_sum(ex);
                const int t = t0 + 4 * q + reg;
                if (t < CTXL) ((float*)(F.ws + WS_AFFC))[((size_t)b * NE + i16) * CTXL + t] = a;
                else ((float*)(F.ws + WS_AFFL))[((size_t)b * NE + i16) * SEQ + (t - CTXL)] = a; }
        }
        __syncthreads();
#pragma unroll
        for (int sidx = 0; sidx < 8; ++sidx) x[sidx] = xn[sidx];
        p0 = p0n; p1 = p1n; tile = ntile;
    }
#undef RP2_SKIP
#undef RP2_LOAD
    __syncthreads();
}

__device__ __forceinline__ unsigned block_excl_scan(unsigned v, LAS unsigned* scr, int lane, int wave, unsigned& total) {
    unsigned inc = v;
#pragma unroll
    for (int o = 1; o < 64; o <<= 1) { const unsigned t = __shfl_up(inc, o); if (lane >= o) inc += t; }
    if (lane == 63) scr[wave] = inc;
    __syncthreads();
    unsigned base = 0, tot = 0;
#pragma unroll
    for (int w = 0; w < 8; ++w) { const unsigned x = scr[w]; base += (w < wave) ? x : 0u; tot += x; }
    __syncthreads();
    total = tot;
    return base + inc - v;
}
__device__ __forceinline__ void phase_topk(Frame& F, int l) {
    PHASE_IDS(F);
    LAS unsigned* hist = (LAS unsigned*)F.lds;
    LAS unsigned* scr = (LAS unsigned*)(F.lds + 8192);
    LAS int* rowsrc = (LAS int*)(F.lds + 8192 + 128);
    const int nunits = (l == 0) ? 128 : 64;
    const bool f8 = (l == 0) ? (FP8_L0 != 0) : (FP8_L1 != 0); const int RBg = f8 ? DM : 2 * DM;
    for (int u = blockIdx.x; u < nunits; u += F.G) {
        const bool isc = u >= 64; const int uu = isc ? u - 64 : u, b = uu / NE, e = uu % NE;
        const int N = isc ? CTXL : SEQ; const unsigned cap = isc ? CAP_C : CAP_L;
        const float* src = isc ? (const float*)(F.ws + WS_AFFC) + (size_t)uu * CTXL : (const float*)(F.ws + WS_AFFL) + (size_t)uu * SEQ;
        int* pos = isc ? (int*)(F.ws + WS_POSC) + (size_t)uu * CTXL : (int*)(F.ws + WS_POSL) + (size_t)uu * SEQ;
        const bool own = tid * 8 < N;
        unsigned key[8];
        { u32x4 k0 = (u32x4){0u, 0u, 0u, 0u}, k1 = k0; if (own) { k0 = *(const u32x4*)(src + tid * 8); k1 = *(const u32x4*)(src + tid * 8 + 4); }
          key[0] = k0.x; key[1] = k0.y; key[2] = k0.z; key[3] = k0.w; key[4] = k1.x; key[5] = k1.y; key[6] = k1.z; key[7] = k1.w; }
        unsigned prefix = 0u, remaining = cap;
#pragma unroll
        for (int p = 0; p < 3; ++p) {
            const int shift = (p == 0) ? 21 : (p == 1) ? 10 : 0, bits = (p == 2) ? 10 : 11, nb = 1 << bits;
            for (int i = tid; i < nb; i += 512) hist[i] = 0u;
            __syncthreads();
            if (own) {
#pragma unroll
                for (int q = 0; q < 8; ++q) { const bool cand = (p == 0) ? true : ((key[q] >> (shift + bits)) == prefix);
                    if (cand) (void)__hip_atomic_fetch_add(&hist[(key[q] >> shift) & (nb - 1)], 1u, __ATOMIC_RELAXED, __HIP_MEMORY_SCOPE_WORKGROUP); } }
            __syncthreads();
            unsigned c[4];
#pragma unroll
            for (int q = 0; q < 4; ++q) c[q] = (4 * tid + q < nb) ? hist[4 * tid + q] : 0u;
            const unsigned sm = (c[0] + c[1]) + (c[2] + c[3]);
            unsigned total; const unsigned ex = block_excl_scan(sm, scr, lane, wave, total);
            unsigned above = total - (ex + sm);
#pragma unroll
            for (int q = 3; q >= 0; --q) { if (above < remaining && remaining <= above + c[q]) { scr[16] = (unsigned)(4 * tid + q); scr[17] = above; } above += c[q]; }
            __syncthreads();
            const unsigned B = scr[16], ca = scr[17];
            remaining -= ca; prefix = (prefix << bits) | B;
            __syncthreads();
        }
        const unsigned T = prefix;
        unsigned ce = 0u;
#pragma unroll
        for (int q = 0; q < 8; ++q) ce += (own && key[q] == T) ? 1u : 0u;
        unsigned tot; unsigned er = block_excl_scan(ce, scr, lane, wave, tot);
        bool sel[8]; unsigned cs = 0u;
#pragma unroll
        for (int q = 0; q < 8; ++q) { const bool eq = own && key[q] == T; sel[q] = own && (key[q] > T || (eq && er < remaining)); er += eq ? 1u : 0u; cs += sel[q] ? 1u : 0u; }
        unsigned sl = block_excl_scan(cs, scr, lane, wave, tot);
        const int slotbase = e * ROWS_E + (isc ? 2048 + b * CAP_C : b * CAP_L);
        int pv[8];
#pragma unroll
        for (int q = 0; q < 8; ++q) { pv[q] = sel[q] ? (int)sl : -1;
            if (sel[q]) { rowsrc[sl] = b * TPB + (isc ? 0 : CTXL) + tid * 8 + q; ((float*)(F.ws + WS_GATE))[slotbase + sl] = __uint_as_float(key[q]); ++sl; } }
        if (own) { *(i32x4*)(pos + tid * 8) = (i32x4){pv[0], pv[1], pv[2], pv[3]}; *(i32x4*)(pos + tid * 8 + 4) = (i32x4){pv[4], pv[5], pv[6], pv[7]}; }
        __syncthreads();
        unsigned* offs = (unsigned*)(F.ws + WS_OFFS);
        int R[2], C[2];
#pragma unroll
        for (int i = 0; i < 2; ++i) pg8::stage_rc(tid * 16 + i * 8192, R[i], C[i]);
        if (!isc) {
#pragma unroll
            for (int th = 0; th < 2; ++th) { u32x4 o;
                o.x = (unsigned)rowsrc[th * 256 + R[0]] * RBg + 2 * C[0]; o.y = (unsigned)rowsrc[th * 256 + R[1]] * RBg + 2 * C[1];
                o.z = (unsigned)rowsrc[th * 256 + 128 + R[0]] * RBg + 2 * C[0]; o.w = (unsigned)rowsrc[th * 256 + 128 + R[1]] * RBg + 2 * C[1];
                *(u32x4*)(offs + ((size_t)(e * 9 + 2 * b + th) * 512 + tid) * 4) = o; }
        } else {
            unsigned* o = offs + ((size_t)(e * 9 + 8) * 512 + tid) * 4;
#pragma unroll
            for (int i = 0; i < 2; ++i) { if (R[i] >= 32 * b && R[i] < 32 * b + 32) o[i] = (unsigned)rowsrc[R[i] - 32 * b] * RBg + 2 * C[i]; if (b == 0) o[2 + i] = 2 * C[i]; }
        }
        __syncthreads();
    }
}

__device__ __forceinline__ void phase_combine(Frame& F, int l) {
    PHASE_IDS(F);
    const float* mod = (const float*)(F.ws + WS_MOD);
    bf16_t* xb = (bf16_t*)(F.ws + WS_XB); const bf16_t* Y = (const bf16_t*)(F.ws + WS_XG);
    const bool y8 = (l == 0) ? (FP8_L0 != 0) : (FP8_L1 != 0);
    for (int r = gw; r < NTOK; r += NGW) {
        const int b = r / TPB, t = r % TPB, s = (t < CTXL) ? 4 : b;
        if (l == 1 && t < CTXL) continue;
        int p = -1;
        if (lane < NE) p = (t < CTXL) ? ((const int*)(F.ws + WS_POSC))[((size_t)b * NE + lane) * CTXL + t] : ((const int*)(F.ws + WS_POSL))[((size_t)b * NE + lane) * SEQ + (t - CTXL)];
        float gt = 0.f;
        if (p >= 0) gt = ((const float*)(F.ws + WS_GATE))[lane * ROWS_E + ((t < CTXL) ? 2048 + b * CAP_C : b * CAP_L) + p];
        f32x4 v[8];
        { const bf16_t* xr = xb + (size_t)r * DM + 4 * lane; u32x2 xw[8];
#pragma unroll
          for (int j = 0; j < 8; ++j) xw[j] = *(const u32x2*)(xr + 256 * j);
#pragma unroll
          for (int j = 0; j < 8; ++j) v[j] = (f32x4){bflo(xw[j].x), bfhi(xw[j].x), bflo(xw[j].y), bfhi(xw[j].y)}; }
        const float* g2 = mod + (size_t)(l * 5 + s) * NMOD + 5 * DM;
        f32x4 gv[8];
#pragma unroll
        for (int j = 0; j < 8; ++j) gv[j] = *(const f32x4*)(g2 + 4 * lane + 256 * j);
        f32x4 a[8];
#pragma unroll
        for (int j = 0; j < 8; ++j) a[j] = (f32x4){0.f, 0.f, 0.f, 0.f};
        unsigned long long m = __ballot(p >= 0);
        const int ybase = (t < CTXL) ? 2048 + b * CAP_C : b * CAP_L;
        while (m) {
            const int e0 = __builtin_ctzll(m); m &= m - 1;
            const bool two = (m != 0ull); const int e1 = two ? __builtin_ctzll(m) : e0; if (two) m &= m - 1;
            const int p0 = __builtin_amdgcn_readlane(p, e0), p1 = __builtin_amdgcn_readlane(p, e1);
            const float q0 = __builtin_bit_cast(float, __builtin_amdgcn_readlane(__builtin_bit_cast(int, gt), e0)), q1 = __builtin_bit_cast(float, __builtin_amdgcn_readlane(__builtin_bit_cast(int, gt), e1));
            if (y8) {
                const unsigned char* y0 = (const unsigned char*)Y + (size_t)(e0 * ROWS_E + ybase + p0) * DM + 4 * lane; const unsigned char* y1 = (const unsigned char*)Y + (size_t)(e1 * ROWS_E + ybase + p1) * DM + 4 * lane;
                unsigned w0[8], w1[8];
#pragma unroll
                for (int j = 0; j < 8; ++j) w0[j] = *(const unsigned*)(y0 + 256 * j);
                if (two) {
#pragma unroll
                    for (int j = 0; j < 8; ++j) w1[j] = *(const unsigned*)(y1 + 256 * j); }
#pragma unroll
                for (int j = 0; j < 8; ++j) { const f32x2 lo = __builtin_amdgcn_cvt_pk_f32_fp8((int)w0[j], false), hi = __builtin_amdgcn_cvt_pk_f32_fp8((int)w0[j], true); a[j] += (f32x4){lo.x, lo.y, hi.x, hi.y} * q0; }
                if (two) {
#pragma unroll
                    for (int j = 0; j < 8; ++j) { const f32x2 lo = __builtin_amdgcn_cvt_pk_f32_fp8((int)w1[j], false), hi = __builtin_amdgcn_cvt_pk_f32_fp8((int)w1[j], true); a[j] += (f32x4){lo.x, lo.y, hi.x, hi.y} * q1; } }
            } else {
            const bf16_t* y0 = Y + (size_t)(e0 * ROWS_E + ybase + p0) * DM + 4 * lane; const bf16_t* y1 = Y + (size_t)(e1 * ROWS_E + ybase + p1) * DM + 4 * lane;
            u32x2 w0[8], w1[8];
#pragma unroll
            for (int j = 0; j < 8; ++j) w0[j] = *(const u32x2*)(y0 + 256 * j);
            if (two) {
#pragma unroll
                for (int j = 0; j < 8; ++j) w1[j] = *(const u32x2*)(y1 + 256 * j); }
#pragma unroll
            for (int j = 0; j < 8; ++j) a[j] += (f32x4){bflo(w0[j].x), bfhi(w0[j].x), bflo(w0[j].y), bfhi(w0[j].y)} * q0;
            if (two) {
#pragma unroll
                for (int j = 0; j < 8; ++j) a[j] += (f32x4){bflo(w1[j].x), bfhi(w1[j].x), bflo(w1[j].y), bfhi(w1[j].y)} * q1; }
            }
        }
#pragma unroll
        for (int j = 0; j < 8; ++j) v[j] += gv[j] * a[j];
        if (l == 0) {
#pragma unroll
            for (int j = 0; j < 8; ++j) { u32x2 w; w.x = pk2(v[j].x, v[j].y); w.y = pk2(v[j].z, v[j].w); *(u32x2*)(xb + (size_t)r * DM + 4 * lane + 256 * j) = w; }
            const float* m1 = mod + (size_t)(5 + s) * NMOD;
            norm_mod_store(v, INP(F, IN_N1G) + DM, m1, m1 + DM, (bf16_t*)(F.ws + WS_HN) + (size_t)r * DM, lane);
        } else {
            float* op = F.out + ((size_t)b * SEQ + (t - CTXL)) * DM;
#pragma unroll
            for (int j = 0; j < 8; ++j) *(f32x4*)(op + 4 * lane + 256 * j) = v[j];
        }
    }
}

__device__ __forceinline__ void phase_dump_x(Frame& F, bool from_input) {
    PHASE_IDS(F);
    for (int r = gw; r < NTOK; r += NGW) {
        const int b = r / TPB, t = r % TPB; if (t < CTXL) continue;
        const float* src = INP(F, IN_X) + ((size_t)b * SEQ + (t - CTXL)) * DM; (void)from_input;
        f32x4 v[8]; load_row(src, lane, v);
        float* op = F.out + ((size_t)b * SEQ + (t - CTXL)) * DM;
#pragma unroll
        for (int j = 0; j < 8; ++j) *(f32x4*)(op + 4 * lane + 256 * j) = v[j];
    }
}

constexpr int N_PHASES = 2 + 11 * NLAYER;
__global__ void __launch_bounds__(512, 2) fwd_kernel(Args args) {
    extern __shared__ __attribute__((aligned(16))) unsigned char lds[];
    Frame F;
    F.lds = (LAS unsigned char*)lds; F.ldsg = (char*)lds;
    F.MISC = (volatile LAS unsigned*)(F.lds + MISC_OFF);
    F.G = gridDim.x;
    F.out = args.out; F.ws = args.ws; F.ctl = (unsigned*)(args.ws + WS_CTL);
    for (int u = threadIdx.x; u < (LDS_BYTES - LDSCTL_OFF) / 4; u += 512) ((LAS unsigned*)(F.lds + LDSCTL_OFF))[u] = 0u;
    __syncthreads();
    if (threadIdx.x < 23) { const unsigned long long pv = (unsigned long long)args.in[threadIdx.x]; LAS unsigned* t = (LAS unsigned*)(F.lds + ARGTAB_OFF) + 2 * threadIdx.x; t[0] = (unsigned)pv; t[1] = (unsigned)(pv >> 32); }
    __syncthreads();
    XcdBarrier bar; bar.bar = F.ctl + CW_BAR; bar.x = 0; bar.st = nullptr;
    if (!MK_PER_PHASE) bar = xcd_barrier_post(F.ctl + CW_BAR, F.MISC + 8);
    const int lo = args.ph_lo, hi = args.ph_hi;
#define IN(k) (lo <= (k) && (k) < hi)
    unsigned long long probe_t0 = 0ull, probe_acc = 0ull;
#define PROBE_BEGIN(k) do { if (PROBE_MASK & (1u << (k))) probe_t0 = __builtin_amdgcn_s_memrealtime(); } while (0)
#define SEAM(k) do { if (IN(k) && IN((k) + 1)) xcd_barrier(bar); if (PROBE_MASK & (1u << (k))) probe_acc += __builtin_amdgcn_s_memrealtime() - probe_t0; } while (0)

    if (IN(0)) { PROBE_BEGIN(0); if (PH_ON(0)) phase_prologue(F); if (IN(1)) xcd_barrier_first(bar); if (PROBE_MASK & 1u) probe_acc += __builtin_amdgcn_s_memrealtime() - probe_t0; }
    if (IN(1)) { PROBE_BEGIN(1); if (PH_ON(1)) phase_rowpass1_l0(F); SEAM(1); }
    for (int l = 0; l < NLAYER; ++l) {
        const int pb = 2 + 11 * l;
        const bool ctx = (l == 0);
        if (IN(pb + 0)) { PROBE_BEGIN(pb + 0); if (PH_ON(2)) {
            pg8::SchedDense S; S.init(F.ws + WS_HN, F.ws + WS_WIN + (size_t)l * INW * DM * 2, NTOK / 256, INW / 256, F.G, (int)blockIdx.x, 0);
            pg8::EpiPost E{(bf16_t*)(F.ws + WS_P), (const float*)(F.ws + WS_ROPE), INP(F, IN_QNA) + l * 128, INP(F, IN_KNA) + l * 128, INP(F, IN_QNC) + l * 128, INP(F, IN_KNC) + l * 128, INP(F, IN_VNB) + l * 512, F.lds + LDSCTL_OFF + 2048};
            pg8::gemm_phase<pg8::EpiPost, pg8::SchedDense>(F.lds, S, E);
            if ((CONV_HOOKS & 2) && (int)blockIdx.x >= (NTOK / 256) * (INW / 256) - 3 * F.G) conv_help(F, 10, nullptr, 0u); }
            SEAM(pb + 0); }
        if (IN(pb + 2)) { PROBE_BEGIN(pb + 2); if (PH_ON(4)) phase_mixers(F, l); SEAM(pb + 2); }
        if (IN(pb + 4)) { PROBE_BEGIN(pb + 4); if (PH_ON(6)) {
            pg8::SchedDense S; S.init(F.ws + WS_O, F.ws + WS_WOUT + (size_t)l * DM * DM * 2, ctx ? NTOK / 256 : 64, DM / 256, F.G, (int)blockIdx.x, ctx ? 0 : 1);
            bf16_t* xb = (bf16_t*)(F.ws + WS_XB);
            pg8::EpiResid E;
            E.ctxbase = INP(F, IN_CTX); E.latbase = INP(F, IN_X); E.cbs = CTXL; E.lbs = SEQ; E.src16 = (l == 0) ? nullptr : xb;
            E.xout = xb; E.modl = (const float*)(F.ws + WS_MOD) + (size_t)l * 5 * NMOD; E.parts = (float*)(F.ws + WS_PART); E.ktab = F.lds + LDSCTL_OFF + 2048;
            { const float* ssq = (const float*)(F.ws + WS_SSQ); LAS f32x4* kt = (LAS f32x4*)(F.lds + LDSCTL_OFF + 2048); const int tz = opaque_tid();
              for (int i = 0; i < 3; ++i) { pg8::Unit uu; if (!S.next(i, uu)) break;
                  if (tz < 256) { const f32x4* sp = (const f32x4*)(ssq + (size_t)(uu.rowbase + tz) * 16); const f32x4 s0 = sp[0], s1 = sp[1], s2 = sp[2], s3 = sp[3];
                      const float qa = ((s0.x + s0.y) + (s0.z + s0.w)) + (s1.x + s1.y), qb = (s1.z + s1.w) + (s2.x + s2.y), qc = ((s2.z + s2.w) + (s3.x + s3.y)) + (s3.z + s3.w);
                      const float ra = rsqrt_fast(qa * (1.f / 768) + EPS), rb = rsqrt_fast(qb * (1.f / 512) + EPS), rc = rsqrt_fast(qc * (1.f / 768) + EPS);
                      kt[i * 256 + tz] = (f32x4){ra / rb, rb / rc, rc, 0.f}; } }
              __syncthreads(); }
            pg8::gemm_phase<pg8::EpiResid, pg8::SchedDense, false, false, true>(F.lds, S, E, nullptr, F.lds + LDSCTL_OFF + 2048);
            if ((CONV_HOOKS & 4) && ctx && (int)blockIdx.x >= (NTOK / 256) * (DM / 256) - 2 * F.G) conv_help(F, 9, nullptr, 0u); }
            SEAM(pb + 4); }
        if (IN(pb + 5)) { PROBE_BEGIN(pb + 5); if (PH_ON(7)) phase_rowpass2(F, l); SEAM(pb + 5); }
        if (IN(pb + 6)) { PROBE_BEGIN(pb + 6); if (PH_ON(8)) { phase_topk(F, l);
            if (l == 0) { if ((CONV_HOOKS & 8) && (int)blockIdx.x >= 128) conv_help(F, 2, nullptr, 0u); } else conv_help(F, 1 << 20, nullptr, 0u); }
            SEAM(pb + 6); }
        if (IN(pb + 8)) { PROBE_BEGIN(pb + 8); if (PH_ON(10)) {
            if ((l == 0) ? (FP8_L0 != 0) : (FP8_L1 != 0)) {
                pg8::SchedGrouped<pg8::GK> S; S.init(F.ws + WS_HN8, F.ws + WS_WGU + (size_t)l * NE * 4096 * DM * 2, ctx ? 9 : 8, 16, F.G, (int)blockIdx.x);
                pg8::EpiSwiGLU8 E{(unsigned char*)(F.ws + WS_H)};
                pg8::gemm_phase<pg8::EpiSwiGLU8, pg8::SchedGrouped<pg8::GK>, true, true>(F.lds, S, E, (const unsigned*)(F.ws + WS_OFFS), F.lds + LDSCTL_OFF + 2048);
            } else {
                pg8::SchedGrouped<2 * pg8::GK> S; S.init(F.ws + WS_HN, F.ws + WS_WGU + (size_t)l * NE * 4096 * DM * 2, ctx ? 9 : 8, 16, F.G, (int)blockIdx.x);
                pg8::EpiSwiGLU E{(bf16_t*)(F.ws + WS_H)};
                pg8::gemm_phase<pg8::EpiSwiGLU, pg8::SchedGrouped<2 * pg8::GK>, false, true>(F.lds, S, E, (const unsigned*)(F.ws + WS_OFFS), F.lds + LDSCTL_OFF + 2048);
            } }
            SEAM(pb + 8); }
        if (IN(pb + 9)) { PROBE_BEGIN(pb + 9); if (PH_ON(11)) {
            pg8::EpiStoreBf16 E{(bf16_t*)(F.ws + WS_XG), DM};
            if ((l == 0) ? (FP8_L0 != 0) : (FP8_L1 != 0)) {
                pg8::SchedGrouped<pg8::GK> S; S.init(F.ws + WS_H, F.ws + WS_WD + (size_t)l * NE * DM * DM * 2, ctx ? 9 : 8, 8, F.G, (int)blockIdx.x);
                pg8::EpiStoreFp8 E8{(unsigned char*)(F.ws + WS_XG), DM};
                pg8::gemm_phase<pg8::EpiStoreFp8, pg8::SchedGrouped<pg8::GK>, true>(F.lds, S, E8);
                if ((CONV_HOOKS & 16) && ctx && (((int)blockIdx.x >> 3) & 31) >= 16) conv_help(F, 3, nullptr, 0u);
            } else {
                pg8::SchedGrouped<2 * pg8::GK> S; S.init(F.ws + WS_H, F.ws + WS_WD + (size_t)l * NE * DM * DM * 2, ctx ? 9 : 8, 8, F.G, (int)blockIdx.x);
                pg8::gemm_phase<pg8::EpiStoreBf16, pg8::SchedGrouped<2 * pg8::GK>, false>(F.lds, S, E);
            } }
            SEAM(pb + 9); }
        if (IN(pb + 10)) { PROBE_BEGIN(pb + 10); if (PH_ON(12)) phase_combine(F, l); if (l + 1 < NLAYER) SEAM(pb + 10); else if (PROBE_MASK & (1u << (pb + 10))) probe_acc += __builtin_amdgcn_s_memrealtime() - probe_t0; }
    }
    if (PROBE_MASK) { const unsigned long long te = __builtin_amdgcn_s_memrealtime(); while (__builtin_amdgcn_s_memrealtime() - te < probe_acc) __builtin_amdgcn_s_sleep(8); }
#undef IN
#undef SEAM
}

extern "C" void kernel_launch(void* const* d_in, const int* in_sizes, int n_in, void* d_out, int out_size, void* d_ws, size_t ws_size, hipStream_t stream) {
    static int grid = 0;
    if (grid == 0) {
        if (n_in != 23 || out_size != NB * SEQ * DM || ws_size < WS_END) { fprintf(stderr, "kernel_launch: shape mismatch: n_in %d out %d ws %zu (need %zu)\n", n_in, out_size, ws_size, (size_t)WS_END); grid = -1; return; }
        int dev = 0, cus = 0, per_cu = 0;
        if (hipGetDevice(&dev) != hipSuccess || hipDeviceGetAttribute(&cus, hipDeviceAttributeMultiprocessorCount, dev) != hipSuccess) { grid = -1; return; }
        if (hipFuncSetAttribute((const void*)fwd_kernel, hipFuncAttributeMaxDynamicSharedMemorySize, LDS_BYTES) != hipSuccess) { fprintf(stderr, "kernel_launch: hipFuncSetAttribute failed\n"); grid = -1; return; }
        if (hipOccupancyMaxActiveBlocksPerMultiprocessor(&per_cu, (const void*)fwd_kernel, 512, LDS_BYTES) != hipSuccess || per_cu < 1) { fprintf(stderr, "kernel_launch: occupancy query says %d\n", per_cu); }
        (void)hipGetLastError();
        grid = cus;
    }
    if (grid < 0) return;
    if (hipMemsetAsync((char*)d_ws + WS_CTL, 0, CTL_ZERO_BYTES, stream) != hipSuccess) return;
    Args a{};
    for (int i = 0; i < 23; ++i) a.in[i] = (const float*)d_in[i];
    a.out = (float*)d_out; a.ws = (unsigned char*)d_ws;
#if MK_PER_PHASE
    for (int p = 0; p < N_PHASES; ++p) { a.ph_lo = p; a.ph_hi = p + 1; hipLaunchKernelGGL(fwd_kernel, dim3(grid), dim3(512), LDS_BYTES, stream, a); }
#else
    a.ph_lo = 0; a.ph_hi = N_PHASES;
    hipLaunchKernelGGL(fwd_kernel, dim3(grid), dim3(512), LDS_BYTES, stream, a);
#endif
    const hipError_t le = hipPeekAtLastError();
    if (le != hipSuccess) fprintf(stderr, "kernel_launch: launch failed: %s\n", hipGetErrorName(le));
}
```

```cpp
#include <hip/hip_runtime.h>
#include <cstdio>
#include <cstdint>

#define LAS __attribute__((address_space(3)))
#define GAS __attribute__((address_space(1)))
typedef unsigned short bf16_t;
typedef short bf16x8 __attribute__((ext_vector_type(8)));
typedef short s16x4 __attribute__((ext_vector_type(4)));
typedef float f32x2 __attribute__((ext_vector_type(2)));
typedef float f32x4 __attribute__((ext_vector_type(4)));
typedef float f32x16 __attribute__((ext_vector_type(16)));
typedef unsigned u32x2 __attribute__((ext_vector_type(2)));
typedef unsigned u32x4 __attribute__((ext_vector_type(4)));
typedef int i32x4 __attribute__((ext_vector_type(4)));
typedef int i32x8 __attribute__((ext_vector_type(8)));

#ifndef MK_PER_PHASE
#define MK_PER_PHASE 0
#endif
#ifndef PHASE_MASK
#define PHASE_MASK 0x1fff
#endif
#define PH_ON(k) (((PHASE_MASK) >> (k)) & 1)
#ifndef FP8_L0
#define FP8_L0 1
#endif
#ifndef FP8_L1
#define FP8_L1 1
#endif
#ifndef PROBE_MASK
#define PROBE_MASK 0u
#endif
#ifndef DBG_STOP
#define DBG_STOP 0
#endif

constexpr int DM = 2048, NB = 4, SEQ = 4096, CTXL = 256, TPB = SEQ + CTXL, NTOK = NB * TPB;
constexpr int INW = 3584, NE = 16, NLAYER = 2, NMOD = 6 * DM;
constexpr int C_QA = 0, C_KA = 768, C_VA = 1024, C_UB = 1280, C_VB = 1792, C_QC = 2304, C_KC = 3072, C_VC = 3328;
constexpr int O_A = 0, O_B = 768, O_C = 1280;
constexpr int CAP_L = 512, CAP_C = 32, ROWS_E = 2304;
constexpr float EPS = 1e-6f;

constexpr size_t MiB = 1u << 20;
constexpr size_t WS_CTL = 0, CTL_ZERO_BYTES = 65536;
constexpr size_t WS_MOD = 1 * MiB;
constexpr size_t WS_ROPE = 2 * MiB;
constexpr size_t WS_AFFL = 3 * MiB;
constexpr size_t WS_AFFC = 4 * MiB;
constexpr size_t WS_POSL = 5 * MiB;
constexpr size_t WS_POSC = 6 * MiB;
constexpr size_t WS_OFFS = 10 * MiB;
constexpr size_t WS_GATE = 8 * MiB;
constexpr size_t WS_WRT = 9 * MiB;
constexpr size_t WS_WRS = 11 * MiB;
constexpr size_t WS_GS2 = 12 * MiB;
constexpr size_t WS_PART = 13 * MiB + 0;
constexpr size_t WS_SSQ = 14 * MiB;
constexpr size_t WS_WIN = 16 * MiB;
constexpr size_t WS_WOUT = WS_WIN + (size_t)2 * INW * DM * 2;
constexpr size_t WS_WGU = WS_WOUT + (size_t)2 * DM * DM * 2;
constexpr size_t WS_WD = WS_WGU + (size_t)2 * NE * 4096 * DM * 2;
constexpr size_t WS_HN = WS_WD + (size_t)2 * NE * DM * DM * 2;
constexpr size_t WS_P = WS_HN + (size_t)NTOK * DM * 2;
constexpr size_t WS_O = WS_P + (size_t)NTOK * INW * 2;
constexpr size_t WS_XB = WS_O + (size_t)NTOK * DM * 2;
constexpr size_t WS_XG = WS_XB + (size_t)NTOK * DM * 4;
constexpr size_t WS_H = WS_XG + (size_t)NE * ROWS_E * DM * 2;
constexpr size_t WS_HN8 = WS_H + (size_t)NE * ROWS_E * DM * 2;
constexpr size_t WS_END = WS_HN8 + (size_t)NTOK * DM;
constexpr float W8_SCALE = 32.f; constexpr int W8_SCALE_E8M0 = 127 - 5;
constexpr int CW_BAR = 4096, CW_QUEUE = 8192;
constexpr int CW_CONV = 10240, CW_MIXDONE = 10304;
constexpr int NT8_ALL = 2 * NE * 3 * 128, NT8_L0 = NT8_ALL / 2;
#ifndef CONV_HOOKS
#define CONV_HOOKS 0x1f
#endif
#ifndef CONV_IDLE
#define CONV_IDLE 1
#endif

constexpr int RING_BYTES = 131072, LDSCTL_OFF = RING_BYTES, MISC_OFF = LDSCTL_OFF + 320, LDS_BYTES = 147456;

#define LDS_WAIT() asm volatile("s_waitcnt lgkmcnt(0)" ::: "memory")
#define VM_WAIT() asm volatile("s_waitcnt vmcnt(0)" ::: "memory")
__device__ __forceinline__ unsigned f2bf(float f) { unsigned u = __builtin_bit_cast(unsigned, f); return (u + 0x7fffu + ((u >> 16) & 1u)) >> 16; }
__device__ __forceinline__ unsigned pk2(float lo, float hi) { return f2bf(lo) | (f2bf(hi) << 16); }
__device__ __forceinline__ float bf2f(unsigned short b) { return __builtin_bit_cast(float, ((unsigned)b) << 16); }
__device__ __forceinline__ float bflo(unsigned w) { return __builtin_bit_cast(float, w << 16); }
__device__ __forceinline__ float bfhi(unsigned w) { return __builtin_bit_cast(float, w & 0xffff0000u); }
__device__ __forceinline__ unsigned pk4_fp8(float a, float b, float c, float d) {
    int r = __builtin_amdgcn_cvt_pk_fp8_f32(a, b, 0, false); r = __builtin_amdgcn_cvt_pk_fp8_f32(c, d, r, true); return (unsigned)r; }
__device__ __forceinline__ int opaque_tid() { int t = threadIdx.x; asm volatile("" : "+v"(t)); return t; }
__device__ __forceinline__ float row16_sum(float v) {
    v += __builtin_bit_cast(float, __builtin_amdgcn_update_dpp(0, __builtin_bit_cast(int, v), 0xB1, 0xF, 0xF, true));
    v += __builtin_bit_cast(float, __builtin_amdgcn_update_dpp(0, __builtin_bit_cast(int, v), 0x4E, 0xF, 0xF, true));
    v += __builtin_bit_cast(float, __builtin_amdgcn_update_dpp(0, __builtin_bit_cast(int, v), 0x141, 0xF, 0xF, true));
    v += __builtin_bit_cast(float, __builtin_amdgcn_update_dpp(0, __builtin_bit_cast(int, v), 0x140, 0xF, 0xF, true));
    return v;
}
__device__ __forceinline__ float wave_sum(float v) {
    v = row16_sum(v);
    const int iv = __builtin_bit_cast(int, v);
    const float a = __builtin_bit_cast(float, __builtin_amdgcn_readlane(iv, 0)), b = __builtin_bit_cast(float, __builtin_amdgcn_readlane(iv, 16));
    const float c = __builtin_bit_cast(float, __builtin_amdgcn_readlane(iv, 32)), d = __builtin_bit_cast(float, __builtin_amdgcn_readlane(iv, 48));
    return (a + b) + (c + d);
}
__device__ __forceinline__ float rsqrt_fast(float x) { return __builtin_amdgcn_rsqf(x); }
__device__ __forceinline__ float gelu_tanh(float x) {
    const float u = 0.7978845608028654f * (x + 0.044715f * x * x * x);
    const float e = __expf(2.f * u);
    const float th = 1.f - 2.f / (e + 1.f);
    return 0.5f * x * (1.f + th);
}

#define XB_TMO      128
#define XB_XCNT(j)  (256  + 64 * (j))
#define XB_XSUB(j)  (1280 + 64 * (j))
#define XB_XGEN(j)  (2304 + 64 * (j))
#define XB_TOP      3328
#define XB_TOPGEN   3392
#define XCD_BAR_WORDS 3456
#define XB_SPIN_CAP (1u << 18)
__device__ __forceinline__ unsigned xb_ld(unsigned* p)              { return __hip_atomic_load(p, __ATOMIC_RELAXED, __HIP_MEMORY_SCOPE_AGENT); }
__device__ __forceinline__ unsigned xb_add(unsigned* p, unsigned v) { return __hip_atomic_fetch_add(p, v, __ATOMIC_RELAXED, __HIP_MEMORY_SCOPE_AGENT); }
__device__ __forceinline__ unsigned xb_xcc_id() { return (unsigned)__builtin_amdgcn_s_getreg((3 << 11) | 20) & 0xFu; }
#define XB_SPIN(cond, bar) do { unsigned _sp = 0; while (cond) { __builtin_amdgcn_s_sleep(1); \
    if ((++_sp & 255u) == 0u) { if (xb_ld(&(bar)[XB_TMO])) break; if (_sp > XB_SPIN_CAP) { atomicAdd(&(bar)[XB_TMO], 1u); break; } } } } while (0)
struct XcdBarrier { unsigned* bar; unsigned x; volatile LAS unsigned* st; };
__device__ __forceinline__ XcdBarrier xcd_barrier_post(unsigned* bar, volatile LAS unsigned* st) {
    XcdBarrier b; b.bar = bar; b.x = xb_xcc_id(); b.st = st;
    if (threadIdx.x == 0) (void)xb_add(&bar[XB_XCNT(b.x)], 1u);
    return b;
}
__device__ __forceinline__ void xcd_barrier_complete(unsigned* bar, unsigned x, unsigned& nloc, unsigned& nx) {
    const unsigned G = gridDim.x * gridDim.y * gridDim.z;
    unsigned sum, cnt, mine, sp = 0u;
    for (;;) {
        sum = 0u; cnt = 0u; mine = 0u;
#pragma unroll
        for (unsigned j = 0; j < 16; ++j) { const unsigned c = xb_ld(&bar[XB_XCNT(j)]); sum += c; cnt += (c > 0u) ? 1u : 0u; mine = (j == x) ? c : mine; }
        if (sum == G) break;
        __builtin_amdgcn_s_sleep(1);
        if ((++sp & 255u) == 0u) { if (xb_ld(&bar[XB_TMO])) break; if (sp > XB_SPIN_CAP) { atomicAdd(&bar[XB_TMO], 1u); break; } }
    }
    nloc = mine > 0u ? mine : 1u; nx = cnt > 0u ? cnt : 1u;
}
template <bool FIRST>
__device__ __forceinline__ void xcd_barrier_t(const XcdBarrier& b) {
    asm volatile("s_waitcnt vmcnt(0)" ::: "memory");
    __syncthreads();
    if (threadIdx.x == 0) {
        unsigned* bar = b.bar;
        asm volatile("" : "+s"(bar));
        __builtin_amdgcn_s_waitcnt(0);
        unsigned nloc = b.st[0], nx = b.st[1];
        if constexpr (FIRST) { if (nloc == 0u) { xcd_barrier_complete(bar, b.x, nloc, nx); b.st[0] = nloc; b.st[1] = nx; } }
        const unsigned old = xb_add(&bar[XB_XSUB(b.x)], 1u);
        const unsigned gen = old / nloc;
        if (old + 1u == (gen + 1u) * nloc) {
            __builtin_amdgcn_fence(__ATOMIC_RELEASE, "agent");
            asm volatile("s_waitcnt vmcnt(0)" ::: "memory");
            const unsigned og = xb_add(&bar[XB_TOP], 1u);
            const unsigned tg = og / nx;
            if (og + 1u == (tg + 1u) * nx) xb_add(&bar[XB_TOPGEN], 1u);
            else XB_SPIN(xb_ld(&bar[XB_TOPGEN]) == tg, bar);
            __builtin_amdgcn_fence(__ATOMIC_ACQUIRE, "agent");
            xb_add(&bar[XB_XGEN(b.x)], 1u);
            asm volatile("s_waitcnt vmcnt(0)" ::: "memory");
        } else {
            XB_SPIN(xb_ld(&bar[XB_XGEN(b.x)]) == gen, bar);
            __builtin_amdgcn_fence(__ATOMIC_ACQUIRE, "agent");
            asm volatile("s_waitcnt vmcnt(0)" ::: "memory");
        }
    }
    __syncthreads();
}
__device__ __forceinline__ void xcd_barrier(const XcdBarrier& b) { xcd_barrier_t<false>(b); }
__device__ __forceinline__ void xcd_barrier_first(const XcdBarrier& b) { xcd_barrier_t<true>(b); }

namespace pg8 {
constexpr int BM = 256, BK = 64, HALF = 128, HTB = HALF * BK * 2, STAGE_BYTES = 8 * HTB, NXCD = 8, WGM = 8;
constexpr int GK = 2048;
__host__ __device__ __forceinline__ int lds_byte(int r, int c) { const int st = (r >> 4) * 2 + (c >> 5), rr = r & 15, cc = c & 31, ob = rr * 64 + cc * 2; return st * 1024 + (ob ^ (((ob >> 9) & 1) << 5)); }
__host__ __device__ __forceinline__ void stage_rc(int b, int& R, int& C) { const int st = b / 1024, sb = b % 1024, swz = sb ^ (((sb >> 9) & 1) << 5); R = (st >> 1) * 16 + swz / 64; C = (st & 1) * 32 + (swz % 64) / 2; }
__host__ __device__ __forceinline__ int perm32(int rho) { const int n = rho >> 4, i = rho & 15; return 8 * (i >> 2) + 4 * n + (i & 3); }

struct Unit { int pm, pn, e, rowbase, colbase, oidx, slot; const char* a; const char* b; };

struct SchedDense {
    static constexpr int RB = GK * 2;
    const char* A; const char* Bt; int nM, nN, nwg, G, c, skipctx;
    __device__ void init(const void* A_, const void* Bt_, int nM_, int nN_, int G_, int c_, int skipctx_) { A = (const char*)A_; Bt = (const char*)Bt_; nM = nM_; nN = nN_; nwg = nM * nN; G = G_; c = c_; skipctx = skipctx_; }
    __device__ bool next(int i, Unit& u) const {
        const long L = (long)i * G + c;
        if (skipctx == 2 && L >= nwg) { const int j = (int)(L - nwg); if (j >= 16) return false;
            const int pm = (j >> 2) * 17, jj = j & 3, pn = (jj == 0) ? C_KA / 256 : (jj == 1) ? C_VA / 256 : (jj == 2) ? C_KC / 256 : C_VC / 256;
            u.pm = pm; u.pn = pn; u.e = 0; u.rowbase = pm * BM; u.colbase = pn * BM; u.oidx = 0;
            u.a = A + (size_t)pm * (BM * GK * 2); u.b = Bt + (size_t)pn * (BM * GK * 2); return true; }
        if (L >= nwg) return false;
        int wgid = (int)L; { const int q = nwg / NXCD, r = nwg % NXCD, xcd = wgid % NXCD, off = wgid / NXCD; wgid = (xcd < r ? xcd * (q + 1) : r * (q + 1) + (xcd - r) * q) + off; }
        const int nig = WGM * nN, gid = wgid / nig, fm = gid * WGM, gsz = (nM - fm) < WGM ? (nM - fm) : WGM;
        int pm = fm + ((wgid % nig) % gsz); const int pn = (wgid % nig) / gsz;
        if (skipctx) pm = (pm >> 4) * 17 + 1 + (pm & 15);
        u.pm = pm; u.pn = pn; u.e = 0; u.rowbase = pm * BM; u.colbase = pn * BM; u.oidx = 0;
        u.a = A + (size_t)pm * (BM * GK * 2); u.b = Bt + (size_t)pn * (BM * GK * 2); return true;
    }
};
template <int RB_> struct SchedGrouped {
    static constexpr int RB = RB_;
    const char* A; const char* Bt; int nMe, nNe, nwg, G, c;
    __device__ void init(const void* A_, const void* Bt_, int nMe_, int nNe_, int G_, int c_) { A = (const char*)A_; Bt = (const char*)Bt_; nMe = nMe_; nNe = nNe_; nwg = NE * nMe * nNe; G = G_; c = c_; }
    __device__ bool next(int i, Unit& u) const {
        int e, pm, pn;
        if ((G & 255) == 0) {
            const int cpe = nNe >> 2, nchunk = NE * cpe, xcd = c & 7, slot = (c >> 3) & 31, sub = c >> 8;
            const int chunk = (i * (G >> 8) + sub) * 8 + xcd;
            if (chunk < nchunk) { e = chunk / cpe; pm = slot >> 2; pn = (chunk % cpe) * 4 + (slot & 3); }
            else { const int per = (NE * nNe) >> 3;
                if (nMe < 9 || chunk >= nchunk + 8 || slot >= per) return false; const int j = (chunk - nchunk) * per + slot; e = j / nNe; pn = j % nNe; pm = 8; }
        } else { const long L = (long)i * G + c; if (L >= nwg) return false; const int per = nMe * nNe, rem = (int)L % per; e = (int)L / per; pm = rem % nMe; pn = rem / nMe; }
        u.pm = pm; u.pn = pn; u.e = e; u.rowbase = e * ROWS_E + pm * BM; u.colbase = pn * BM; u.oidx = e * 9 + pm;
        u.a = A + (size_t)(e * ROWS_E + pm * BM) * RB; u.b = Bt + ((size_t)e * nNe + pn) * (BM * RB); return true;
    }
};

__device__ __forceinline__ unsigned cvt_pk_bf16(float lo, float hi) { unsigned r; asm volatile("v_cvt_pk_bf16_f32 %0, %1, %2" : "=v"(r) : "v"(lo), "v"(hi)); return r; }

struct EpiStoreBf16 {
    static constexpr bool PERM = true;
    bf16_t* O; int ldc;
    __device__ __forceinline__ void operator()(const f32x4 (&acc)[2][2][4][2], const Unit& u, int wr, int wc, int fr, int fq) const {
        const int row0 = u.rowbase + wr * 64 + fr, col0 = u.colbase + wc * 32 + 8 * fq;
#pragma unroll
        for (int ai = 0; ai < 2; ++ai)
#pragma unroll
            for (int m = 0; m < 4; ++m) { bf16_t* rowp = O + (size_t)(row0 + ai * HALF + m * 16) * ldc + col0;
#pragma unroll
                for (int bj = 0; bj < 2; ++bj) { const f32x4 v0 = acc[ai][bj][m][0], v1 = acc[ai][bj][m][1];
                    u32x4 w; w.x = cvt_pk_bf16(v0[0], v0[1]); w.y = cvt_pk_bf16(v0[2], v0[3]); w.z = cvt_pk_bf16(v1[0], v1[1]); w.w = cvt_pk_bf16(v1[2], v1[3]);
                    *(u32x4*)(rowp + bj * HALF) = w; } }
    }
};
struct EpiPost {
    static constexpr bool PERM = true;
    bf16_t* P; const float* rope; const float* qna; const float* kna; const float* qnc; const float* knc; const float* vnb; LAS unsigned char* tab;
    __device__ __forceinline__ void operator()(f32x4 (&acc)[2][2][4][2], const Unit& u, int wr, int wc, int fr, int fq) const {
        const int tb = u.pm % 17; const bool lat = tb != 0;
        const int d0 = 64 * (wc >> 1) + 16 * (wc & 1) + 4 * fq, rl0 = wr * 64 + fr;
        int typ[2]; const float* gain[2];
#pragma unroll
        for (int bj = 0; bj < 2; ++bj) { const int slot = 2 * u.pn + bj;
            typ[bj] = (slot < 8) ? 3 : (slot < 10) ? 0 : (slot < 14) ? 1 : (slot < 18) ? 2 : (slot < 26) ? 3 : 0;
            gain[bj] = (slot < 6) ? qna : (slot < 8) ? kna : (slot < 18) ? vnb + ((slot - 14) & 3) * 128 : (slot < 24) ? qnc : knc; }
        const bool anynorm = typ[0] >= 2 || typ[1] >= 2;
        f32x4 csv[4][2], gq0[2], gq1[2];
#pragma unroll
        for (int k = 0; k < 4; ++k) { csv[k][0] = (f32x4){1.f, 0.f, 1.f, 0.f}; csv[k][1] = csv[k][0]; }
        if ((typ[0] == 3 || typ[1] == 3) && lat) {
#pragma unroll
            for (int k = 0; k < 4; ++k) { const int pp = (wc >> 1) ? (fr + 16 * k) : ((tb - 1) * 4 + wr + 2 * (k & 1));
                const f32x4* cs = (const f32x4*)(rope + 2 * (pp * 32 + 16 * (wc & 1) + 4 * fq)); csv[k][0] = cs[0]; csv[k][1] = cs[1]; } }
#pragma unroll
        for (int bj = 0; bj < 2; ++bj) { gq0[bj] = (f32x4){1.f, 1.f, 1.f, 1.f}; gq1[bj] = gq0[bj];
            if (typ[bj] >= 2) { gq0[bj] = *(const f32x4*)(gain[bj] + d0); gq1[bj] = *(const f32x4*)(gain[bj] + d0 + 32); } }
#pragma unroll
        for (int bj = 0; bj < 2; ++bj) if (typ[bj] == 1 || typ[bj] == 2) {
#pragma unroll
            for (int ai = 0; ai < 2; ++ai)
#pragma unroll
                for (int m = 0; m < 4; ++m)
#pragma unroll
                    for (int n = 0; n < 2; ++n)
#pragma unroll
                        for (int j = 0; j < 4; ++j) acc[ai][bj][m][n][j] = gelu_tanh(acc[ai][bj][m][n][j]); }
        if (anynorm) {
#pragma unroll
            for (int bj = 0; bj < 2; ++bj) if (typ[bj] >= 2) {
#pragma unroll
                for (int ai = 0; ai < 2; ++ai)
#pragma unroll
                    for (int m = 0; m < 4; ++m) { const f32x4 a = acc[ai][bj][m][0], b = acc[ai][bj][m][1];
                        float ss = ((a.x * a.x + a.y * a.y) + (a.z * a.z + a.w * a.w)) + ((b.x * b.x + b.y * b.y) + (b.z * b.z + b.w * b.w));
                        ss += __builtin_bit_cast(float, __builtin_amdgcn_ds_swizzle(__builtin_bit_cast(int, ss), 0x401F));
                        { auto rr = __builtin_amdgcn_permlane32_swap(__float_as_uint(ss), __float_as_uint(ss), false, false); ss = __uint_as_float(rr[0]) + __uint_as_float(rr[1]); }
                        if (fq == 0) *(LAS float*)(tab + (((rl0 + ai * HALF + m * 16) * 2 + bj) * 4 + wc) * 4) = ss; } }
            asm volatile("s_waitcnt lgkmcnt(0)" ::: "memory"); __builtin_amdgcn_s_barrier(); asm volatile("" ::: "memory");
        }
#pragma unroll
        for (int bj = 0; bj < 2; ++bj) {
            const int slot = 2 * u.pn + bj;
            const f32x4 g0 = gq0[bj], g1 = gq1[bj];
#pragma unroll
            for (int ai = 0; ai < 2; ++ai)
#pragma unroll
                for (int m = 0; m < 4; ++m) { const int rl = rl0 + ai * HALF + m * 16;
                    f32x4 a = acc[ai][bj][m][0], b = acc[ai][bj][m][1];
                    if (typ[bj] >= 2) { const f32x4 t = *(const LAS f32x4*)(tab + ((rl * 2 + bj) * 4) * 4);
                        const float rinv = rsqrt_fast(((t.x + t.y) + (t.z + t.w)) * (1.f / 128) + EPS);
                        a = a * rinv * g0; b = b * rinv * g1; }
                    if (typ[bj] == 3 && lat) { const f32x4 c0 = (wc >> 1) ? csv[m][0] : csv[ai][0], c1 = (wc >> 1) ? csv[m][1] : csv[ai][1];
                        const f32x4 cv = (f32x4){c0.x, c0.z, c1.x, c1.z}, sv = (f32x4){c0.y, c0.w, c1.y, c1.w};
                        const f32x4 ra = a * cv - b * sv, rb = b * cv + a * sv; a = ra; b = rb; }
                    bf16_t* rowp = P + (size_t)(u.rowbase + rl) * INW + slot * 128 + d0;
                    u32x2 w0, w1; w0.x = cvt_pk_bf16(a.x, a.y); w0.y = cvt_pk_bf16(a.z, a.w); w1.x = cvt_pk_bf16(b.x, b.y); w1.y = cvt_pk_bf16(b.z, b.w);
                    *(u32x2*)rowp = w0; *(u32x2*)(rowp + 32) = w1; }
        }
    }
};
struct EpiStoreFp8 {
    static constexpr bool PERM = true;
    unsigned char* O; int ldc;
    __device__ __forceinline__ void operator()(const f32x4 (&acc)[2][2][4][2], const Unit& u, int wr, int wc, int fr, int fq) const {
        const int row0 = u.rowbase + wr * 64 + fr, col0 = u.colbase + wc * 32 + 8 * fq;
#pragma unroll
        for (int ai = 0; ai < 2; ++ai)
#pragma unroll
            for (int m = 0; m < 4; ++m) { unsigned char* rowp = O + (size_t)(row0 + ai * HALF + m * 16) * ldc + col0;
#pragma unroll
                for (int bj = 0; bj < 2; ++bj) { const f32x4 v0 = acc[ai][bj][m][0], v1 = acc[ai][bj][m][1];
                    u32x2 w; w.x = pk4_fp8(v0[0], v0[1], v0[2], v0[3]); w.y = pk4_fp8(v1[0], v1[1], v1[2], v1[3]);
                    *(u32x2*)(rowp + bj * HALF) = w; } }
    }
};
struct EpiResid {
    static constexpr bool PERM = false;
    const float* ctxbase; const float* latbase; int cbs, lbs;
    const bf16_t* src16;
    bf16_t* xout; const float* modl;
    float* parts;
    LAS unsigned char* ktab;
    __device__ __forceinline__ void operator()(const f32x4 (&acc)[2][2][4][2], const Unit& u, int wr, int wc, int fr, int fq) const {
        const int b = u.pm / 17, tb = u.pm % 17;
        const float* src = (tb == 0) ? ctxbase + (size_t)b * cbs * DM : latbase + ((size_t)b * lbs + (size_t)(tb - 1) * 256) * DM;
        const float* g1 = modl + (size_t)((tb == 0) ? 4 : b) * NMOD + 2 * DM;
        const int rl0 = wr * 64 + fr, col0 = u.colbase + wc * 32 + 4 * fq;
#pragma unroll
        for (int ai = 0; ai < 2; ++ai)
#pragma unroll
        for (int mh = 0; mh < 2; ++mh) {
            f32x4 gv[2][2];
#pragma unroll
            for (int bj = 0; bj < 2; ++bj)
#pragma unroll
                for (int n = 0; n < 2; ++n) gv[bj][n] = *(const f32x4*)(g1 + col0 + bj * HALF + n * 16);
            f32x4 xv[2][2][2];
            if (src16 != nullptr) {
                u32x2 xr[2][2][2];
#pragma unroll
                for (int mm = 0; mm < 2; ++mm) { const bf16_t* sp = src16 + (size_t)(u.rowbase + rl0 + ai * HALF + (2 * mh + mm) * 16) * DM + col0;
#pragma unroll
                    for (int bj = 0; bj < 2; ++bj)
#pragma unroll
                        for (int n = 0; n < 2; ++n) xr[mm][bj][n] = *(const u32x2*)(sp + bj * HALF + n * 16); }
#pragma unroll
                for (int mm = 0; mm < 2; ++mm)
#pragma unroll
                    for (int bj = 0; bj < 2; ++bj)
#pragma unroll
                        for (int n = 0; n < 2; ++n) xv[mm][bj][n] = (f32x4){bflo(xr[mm][bj][n].x), bfhi(xr[mm][bj][n].x), bflo(xr[mm][bj][n].y), bfhi(xr[mm][bj][n].y)};
            } else {
#pragma unroll
                for (int mm = 0; mm < 2; ++mm) { const float* sp = src + (size_t)(rl0 + ai * HALF + (2 * mh + mm) * 16) * DM + col0;
#pragma unroll
                    for (int bj = 0; bj < 2; ++bj)
#pragma unroll
                        for (int n = 0; n < 2; ++n) xv[mm][bj][n] = *(const f32x4*)(sp + bj * HALF + n * 16); }
            }
#pragma unroll
            for (int mm = 0; mm < 2; ++mm) { const int m = 2 * mh + mm, rl = rl0 + ai * HALF + m * 16; bf16_t* dp = xout + (size_t)(u.rowbase + rl) * DM + col0; float ss = 0.f;
                const float fz = *(const LAS float*)(ktab + ((size_t)u.slot * 256 + rl) * 16 + 8);
#pragma unroll
                for (int bj = 0; bj < 2; ++bj)
#pragma unroll
                    for (int n = 0; n < 2; ++n) { const f32x4 y = xv[mm][bj][n] + (gv[bj][n] * fz) * acc[ai][bj][m][n];
                        u32x2 w; w.x = cvt_pk_bf16(y.x, y.y); w.y = cvt_pk_bf16(y.z, y.w); *(u32x2*)(dp + bj * HALF + n * 16) = w;
                        ss += (y.x * y.x + y.y * y.y) + (y.z * y.z + y.w * y.w); }
                ss += __builtin_bit_cast(float, __builtin_amdgcn_ds_swizzle(__builtin_bit_cast(int, ss), 0x401F));
                { auto rr = __builtin_amdgcn_permlane32_swap(__float_as_uint(ss), __float_as_uint(ss), false, false); ss = __uint_as_float(rr[0]) + __uint_as_float(rr[1]); }
                if (fq == 0) parts[(size_t)(u.rowbase + rl) * 32 + u.pn * 4 + wc] = ss; }
            asm volatile("" ::: "memory");
        }
    }
};
struct EpiSwiGLU {
    static constexpr bool PERM = true;
    bf16_t* Hout;
    __device__ __forceinline__ void operator()(const f32x4 (&acc)[2][2][4][2], const Unit& u, int wr, int wc, int fr, int fq) const {
        const int row0 = u.rowbase + wr * 64 + fr, col0 = u.pn * HALF + wc * 32 + 8 * fq;
#pragma unroll
        for (int ai = 0; ai < 2; ++ai)
#pragma unroll
            for (int m = 0; m < 4; ++m) { bf16_t* rowp = Hout + (size_t)(row0 + ai * HALF + m * 16) * DM + col0; float h[8];
#pragma unroll
                for (int n = 0; n < 2; ++n)
#pragma unroll
                    for (int j = 0; j < 4; ++j) { const float g = acc[ai][0][m][n][j], up = acc[ai][1][m][n][j]; h[n * 4 + j] = g * __builtin_amdgcn_rcpf(1.f + __expf(-g)) * up; }
                u32x4 w; w.x = cvt_pk_bf16(h[0], h[1]); w.y = cvt_pk_bf16(h[2], h[3]); w.z = cvt_pk_bf16(h[4], h[5]); w.w = cvt_pk_bf16(h[6], h[7]);
                *(u32x4*)rowp = w; }
    }
};
struct EpiSwiGLU8 {
    static constexpr bool PERM = true;
    unsigned char* Hout;
    __device__ __forceinline__ void operator()(const f32x4 (&acc)[2][2][4][2], const Unit& u, int wr, int wc, int fr, int fq) const {
        const int row0 = u.rowbase + wr * 64 + fr, col0 = u.pn * HALF + wc * 32 + 8 * fq;
#pragma unroll
        for (int ai = 0; ai < 2; ++ai)
#pragma unroll
            for (int m = 0; m < 4; ++m) { unsigned char* rowp = Hout + (size_t)(row0 + ai * HALF + m * 16) * DM + col0; float h[8];
#pragma unroll
                for (int n = 0; n < 2; ++n)
#pragma unroll
                    for (int j = 0; j < 4; ++j) { const float g = acc[ai][0][m][n][j], up = acc[ai][1][m][n][j]; h[n * 4 + j] = g * __builtin_amdgcn_rcpf(1.f + __expf(-g)) * up; }
                u32x2 w; w.x = pk4_fp8(h[0], h[1], h[2], h[3]); w.y = pk4_fp8(h[4], h[5], h[6], h[7]);
                *(u32x2*)rowp = w; }
    }
};
struct EpiDown {
    static constexpr bool PERM = true;
    bf16_t* Y; const float* gatev;
    __device__ __forceinline__ void operator()(const f32x4 (&acc)[2][2][4][2], const Unit& u, int wr, int wc, int fr, int fq) const {
        const int row0 = u.rowbase + wr * 64 + fr, col0 = u.colbase + wc * 32 + 8 * fq;
#pragma unroll
        for (int ai = 0; ai < 2; ++ai)
#pragma unroll
            for (int m = 0; m < 4; ++m) { const int row = row0 + ai * HALF + m * 16; const float gt = gatev[row]; bf16_t* rowp = Y + (size_t)row * DM + col0;
#pragma unroll
                for (int bj = 0; bj < 2; ++bj) { const f32x4 v0 = acc[ai][bj][m][0] * gt, v1 = acc[ai][bj][m][1] * gt;
                    u32x4 w; w.x = cvt_pk_bf16(v0[0], v0[1]); w.y = cvt_pk_bf16(v0[2], v0[3]); w.z = cvt_pk_bf16(v1[0], v1[1]); w.w = cvt_pk_bf16(v1[2], v1[3]);
                    *(u32x4*)(rowp + bj * HALF) = w; } }
    }
};

template <class Epi, class Sched, bool FP8 = false, bool GATHER = false, bool KSCALE = false, bool ALIGN_EPI = true, bool SP2 = true>
__device__ __forceinline__ void gemm_phase(LAS unsigned char* lds, const Sched& S, const Epi& E, const unsigned* goffs = nullptr, LAS unsigned char* goffs_lds = nullptr) {
    static_assert(!GATHER || SP2, "gather mode is written for the SP2 loop");
    static_assert(Sched::RB == (FP8 ? GK : GK * 2), "operand row bytes");
    const int tid = opaque_tid(), wid = __builtin_amdgcn_readfirstlane(tid >> 6), lane = tid & 63, wr = wid >> 2, wc = wid & 3, fr = lane & 15, fq = lane >> 4;
    constexpr int RB = Sched::RB, nt = RB / 128;
    unsigned voffA[2], voffB[2];
#pragma unroll
    for (int i = 0; i < 2; ++i) { int R, C; stage_rc(tid * 16 + i * 8192, R, C); const int Rb = Epi::PERM ? ((R & ~31) + perm32(R & 31)) : R;
        voffA[i] = (unsigned)(R * RB + C * 2); voffB[i] = (unsigned)(Rb * RB + C * 2); }
    const size_t kstep = (size_t)(BK * 2);
    const size_t hstep = (size_t)HALF * RB;
    const unsigned ldsw = (unsigned)wid * 1024u;
    const int aoff = lds_byte(wr * 64 + fr, fq * 8), boff = lds_byte(wc * 32 + fr, fq * 8);
#define PG8_SA(b, h) (((b) * 2 + (h)) * HTB)
#define PG8_SB(b, h) ((4 + (b) * 2 + (h)) * HTB)
#define PG8_STAGE(bufoff, gbase, voff) do { _Pragma("unroll") for (int _i = 0; _i < 2; ++_i) \
        __builtin_amdgcn_global_load_lds((const unsigned*)((const char*)(gbase) + (voff)[_i]), (LAS unsigned*)(lds + (bufoff) + ldsw + _i * 8192), 16, 0, 0); } while (0)
#define PG8_RD8(p) __builtin_shufflevector(*(const LAS i32x4*)(p), *(const LAS i32x4*)((p) + 1024), 0, 1, 2, 3, 4, 5, 6, 7)
#define PG8_LDA(dst, b, h) do { _Pragma("unroll") for (int m = 0; m < 4; ++m) { if constexpr (FP8) dst##8[m] = PG8_RD8(lds + PG8_SA(b, h) + aoff + m * 2048); \
        else { _Pragma("unroll") for (int k = 0; k < 2; ++k) dst[m][k] = *(const LAS bf16x8*)(lds + PG8_SA(b, h) + aoff + m * 2048 + k * 1024); } } } while (0)
#define PG8_LDB(dst, b, h) do { _Pragma("unroll") for (int n = 0; n < 2; ++n) { if constexpr (FP8) dst##8[n] = PG8_RD8(lds + PG8_SB(b, h) + boff + n * 2048); \
        else { _Pragma("unroll") for (int k = 0; k < 2; ++k) dst[n][k] = *(const LAS bf16x8*)(lds + PG8_SB(b, h) + boff + n * 2048 + k * 1024); } } } while (0)
#define PG8_MMA(ai, bj, At, Bt) do { __builtin_amdgcn_s_setprio(1); _Pragma("unroll") for (int m = 0; m < 4; ++m) _Pragma("unroll") for (int n = 0; n < 2; ++n) { \
        if constexpr (FP8) asm volatile("v_mfma_scale_f32_16x16x128_f8f6f4 %0, %1, %2, %0, %3, %4 op_sel_hi:[0,0,0]" : "+v"(acc[ai][bj][m][n]) : "v"(Bt##8[n]), "v"(At##8[m]), "v"(sclW), "v"(sclX)); \
        else { _Pragma("unroll") for (int k = 0; k < 2; ++k) acc[ai][bj][m][n] = __builtin_amdgcn_mfma_f32_16x16x32_bf16(Bt[n][k], At[m][k], acc[ai][bj][m][n], 0, 0, 0); } } \
        __builtin_amdgcn_s_setprio(0); } while (0)
#define PG8_WAIT_V(n) asm volatile("s_waitcnt vmcnt(" #n ")" ::: "memory")
#define PG8_WAIT_L(n) asm volatile("s_waitcnt lgkmcnt(" #n ")" ::: "memory")
#define PG8_BAR __builtin_amdgcn_s_barrier()
#define PG8_SCHED __builtin_amdgcn_sched_barrier(0)
    Unit cur, nxt; int ui = 0;
    if (!S.next(0, cur)) return;
    u32x4 gC = (u32x4){0u, 0u, 0u, 0u}, gN = gC;
    if constexpr (GATHER) gC = *(const u32x4*)(goffs + ((size_t)cur.oidx * 512 + tid) * 4);
#define PG8_GSTAGE(bufoff, gbase, o0, o1) do { \
        __builtin_amdgcn_global_load_lds((const unsigned*)((const char*)(gbase) + (o0)), (LAS unsigned*)(lds + (bufoff) + ldsw), 16, 0, 0); \
        __builtin_amdgcn_global_load_lds((const unsigned*)((const char*)(gbase) + (o1)), (LAS unsigned*)(lds + (bufoff) + ldsw + 8192), 16, 0, 0); } while (0)
    f32x4 acc[2][2][4][2];
#pragma unroll
    for (int a = 0; a < 2; ++a)
#pragma unroll
        for (int b = 0; b < 2; ++b)
#pragma unroll
            for (int m = 0; m < 4; ++m)
#pragma unroll
                for (int n = 0; n < 2; ++n) acc[a][b][m][n] = (f32x4){0.f, 0.f, 0.f, 0.f};
    int sclW = W8_SCALE_E8M0 * 0x01010101, sclX = 0x7f7f7f7f; if constexpr (FP8) asm volatile("" : "+v"(sclW), "+v"(sclX)); (void)sclW; (void)sclX;
    bf16x8 At[4][2], B0[2][2], B1[2][2]; i32x8 At8[4], B08[2], B18[2];
    const char* cA = cur.a; const char* cB = cur.b;
    if constexpr (SP2) {
        PG8_STAGE(PG8_SB(0, 0), cB, voffB); PG8_STAGE(PG8_SB(0, 1), cB + hstep, voffB);
        if constexpr (GATHER) { PG8_GSTAGE(PG8_SA(0, 0), S.A, gC.x, gC.y); PG8_GSTAGE(PG8_SA(0, 1), S.A, gC.z, gC.w); }
        else { PG8_STAGE(PG8_SA(0, 0), cA, voffA); PG8_STAGE(PG8_SA(0, 1), cA + hstep, voffA); }
        if (wr == 1) PG8_BAR;
        PG8_WAIT_V(2); PG8_BAR;
        PG8_STAGE(PG8_SB(1, 0), cB + kstep, voffB);
        if constexpr (GATHER) PG8_GSTAGE(PG8_SA(1, 0), S.A + kstep, gC.x, gC.y); else PG8_STAGE(PG8_SA(1, 0), cA + kstep, voffA);
        PG8_STAGE(PG8_SB(1, 1), cB + hstep + kstep, voffB);
        PG8_WAIT_V(6); PG8_BAR;
    } else {
        PG8_STAGE(PG8_SB(0, 0), cB, voffB); PG8_STAGE(PG8_SA(0, 0), cA, voffA); PG8_STAGE(PG8_SB(0, 1), cB + hstep, voffB); PG8_STAGE(PG8_SA(0, 1), cA + hstep, voffA);
        if (wr == 1) PG8_BAR;
        PG8_WAIT_V(4); PG8_BAR;
        PG8_STAGE(PG8_SB(1, 0), cB + kstep, voffB); PG8_STAGE(PG8_SA(1, 0), cA + kstep, voffA); PG8_STAGE(PG8_SB(1, 1), cB + hstep + kstep, voffB);
        PG8_WAIT_V(6); PG8_BAR;
    }
    for (;;) {
        const bool has_next = S.next(ui + 1, nxt);
        const char* nA = has_next ? nxt.a : cA; const char* nB = has_next ? nxt.b : cB;
        if constexpr (GATHER) { if (has_next)
            __builtin_amdgcn_global_load_lds((const unsigned*)(goffs + ((size_t)nxt.oidx * 512 + tid) * 4), (LAS unsigned*)(goffs_lds + ldsw), 16, 0, 0); }
        for (int seg = 0; seg < (KSCALE ? 3 : 1); ++seg) {
        const int tbeg = !KSCALE ? 0 : (seg == 0 ? 0 : seg == 1 ? 12 : 20), tend = !KSCALE ? nt : (seg == 0 ? 12 : seg == 1 ? 20 : nt);
        for (int t = tbeg; t < tend; t += 2) {
            const bool last = (t == nt - 2);
            const char* a1 = cA + (size_t)(t + 1) * kstep;
            const char* a2 = last ? nA : cA + (size_t)(t + 2) * kstep; const char* b2 = last ? nB : cB + (size_t)(t + 2) * kstep;
            const char* a3 = a2 + kstep; const char* b3 = b2 + kstep;
            const char* g1 = S.A + (size_t)(t + 1) * kstep; const char* g2 = S.A + (last ? (size_t)0 : (size_t)(t + 2) * kstep); const char* g3 = g2 + kstep;
            u32x4 gX = gC;
            if constexpr (GATHER) { if (last) { if (has_next) gN = *(const LAS u32x4*)(goffs_lds + (size_t)tid * 16); else gN = gC; gX = gN; } }
            if constexpr (SP2) {
            PG8_LDB(B0, 0, 0); PG8_LDB(B1, 0, 1); PG8_SCHED; PG8_LDA(At, 0, 0);
            if constexpr (GATHER) PG8_GSTAGE(PG8_SA(1, 1), g1, gC.z, gC.w); else PG8_STAGE(PG8_SA(1, 1), a1 + hstep, voffA);
            PG8_WAIT_V(8); PG8_WAIT_L(0); PG8_BAR; PG8_MMA(0, 0, At, B0); PG8_MMA(0, 1, At, B1); PG8_BAR; PG8_SCHED;
            PG8_LDA(At, 0, 1); PG8_STAGE(PG8_SB(0, 0), b2, voffB); PG8_STAGE(PG8_SB(0, 1), b2 + hstep, voffB);
            if constexpr (GATHER) PG8_GSTAGE(PG8_SA(0, 0), g2, gX.x, gX.y); else PG8_STAGE(PG8_SA(0, 0), a2, voffA);
            PG8_WAIT_V(8); PG8_WAIT_L(0); PG8_BAR; PG8_MMA(1, 0, At, B0); PG8_MMA(1, 1, At, B1); PG8_BAR; PG8_SCHED;
            PG8_LDB(B0, 1, 0); PG8_LDB(B1, 1, 1); PG8_SCHED; PG8_LDA(At, 1, 0);
            if constexpr (GATHER) PG8_GSTAGE(PG8_SA(0, 1), g2, gX.z, gX.w); else PG8_STAGE(PG8_SA(0, 1), a2 + hstep, voffA);
            PG8_WAIT_V(8); PG8_WAIT_L(0); PG8_BAR; PG8_MMA(0, 0, At, B0); PG8_MMA(0, 1, At, B1); PG8_BAR; PG8_SCHED;
            PG8_LDA(At, 1, 1); PG8_STAGE(PG8_SB(1, 0), b3, voffB); PG8_STAGE(PG8_SB(1, 1), b3 + hstep, voffB);
            if constexpr (GATHER) PG8_GSTAGE(PG8_SA(1, 0), g3, gX.x, gX.y); else PG8_STAGE(PG8_SA(1, 0), a3, voffA);
            PG8_WAIT_V(8); PG8_WAIT_L(0); PG8_BAR; PG8_MMA(1, 0, At, B0); PG8_MMA(1, 1, At, B1); PG8_BAR; PG8_SCHED;
            } else {
            PG8_LDB(B0, 0, 0); PG8_SCHED; PG8_LDA(At, 0, 0); PG8_STAGE(PG8_SA(1, 1), a1 + hstep, voffA);
            PG8_WAIT_L(8); PG8_BAR; PG8_WAIT_L(0); PG8_MMA(0, 0, At, B0); PG8_BAR; PG8_SCHED;
            PG8_LDB(B1, 0, 1); PG8_STAGE(PG8_SB(0, 0), b2, voffB);
            PG8_BAR; PG8_WAIT_L(0); PG8_MMA(0, 1, At, B1); PG8_BAR;
            PG8_LDA(At, 0, 1); PG8_STAGE(PG8_SA(0, 0), a2, voffA);
            PG8_BAR; PG8_WAIT_L(0); PG8_MMA(1, 0, At, B0); PG8_BAR; PG8_SCHED;
            PG8_STAGE(PG8_SB(0, 1), b2 + hstep, voffB);
            PG8_WAIT_V(6); PG8_BAR; PG8_MMA(1, 1, At, B1); PG8_BAR;
            PG8_LDB(B0, 1, 0); PG8_SCHED; PG8_LDA(At, 1, 0); PG8_STAGE(PG8_SA(0, 1), a2 + hstep, voffA);
            PG8_WAIT_L(8); PG8_BAR; PG8_WAIT_L(0); PG8_MMA(0, 0, At, B0); PG8_BAR; PG8_SCHED;
            PG8_LDB(B1, 1, 1); PG8_STAGE(PG8_SB(1, 0), b3, voffB);
            PG8_BAR; PG8_WAIT_L(0); PG8_MMA(0, 1, At, B1); PG8_BAR;
            PG8_LDA(At, 1, 1); PG8_STAGE(PG8_SA(1, 0), a3, voffA);
            PG8_BAR; PG8_WAIT_L(0); PG8_MMA(1, 0, At, B0); PG8_BAR; PG8_SCHED;
            PG8_STAGE(PG8_SB(1, 1), b3 + hstep, voffB);
            PG8_WAIT_V(6); PG8_BAR; PG8_MMA(1, 1, At, B1); PG8_BAR;
            }
        }
        if constexpr (KSCALE) { if (seg < 2) {
            unsigned ka = (unsigned)(uintptr_t)goffs_lds + (unsigned)((ui * 256 + wr * 64 + fr) * 16 + seg * 4); asm volatile("" : "+v"(ka));
#pragma unroll
            for (int ai = 0; ai < 2; ++ai)
#pragma unroll
                for (int m = 0; m < 4; ++m) { const float f = *(const LAS float*)(uintptr_t)(ka + (unsigned)((ai * HALF + m * 16) * 16));
#pragma unroll
                    for (int bj = 0; bj < 2; ++bj)
#pragma unroll
                        for (int n = 0; n < 2; ++n) acc[ai][bj][m][n] *= f;
                    asm volatile("" : "+v"(acc[ai][0][m][0]), "+v"(acc[ai][0][m][1]), "+v"(acc[ai][1][m][0]), "+v"(acc[ai][1][m][1])); } } }
        }
        cur.slot = ui;
        if constexpr (ALIGN_EPI) { if (wr == 0) PG8_BAR; }
        if constexpr (FP8) asm volatile("s_nop 15\n\ts_nop 15\n\ts_nop 7" ::: "memory");
        { const int tz = opaque_tid(), wz = __builtin_amdgcn_readfirstlane(tz >> 6), lz = tz & 63;
          E(acc, cur, wz >> 2, wz & 3, lz & 15, lz >> 4); }
        if (!has_next) break;
#pragma unroll
        for (int a = 0; a < 2; ++a)
#pragma unroll
            for (int b = 0; b < 2; ++b)
#pragma unroll
                for (int m = 0; m < 4; ++m)
#pragma unroll
                    for (int n = 0; n < 2; ++n) acc[a][b][m][n] = (f32x4){0.f, 0.f, 0.f, 0.f};
        cur = nxt; cA = nA; cB = nB; ++ui; gC = gN;
        if constexpr (ALIGN_EPI) { if (wr == 1) PG8_BAR; }
    }
    PG8_WAIT_V(0);
    if constexpr (!ALIGN_EPI) { if (wr == 0) PG8_BAR; }
    PG8_BAR;
#undef PG8_SA
#undef PG8_SB
#undef PG8_STAGE
#undef PG8_GSTAGE
#undef PG8_LDA
#undef PG8_LDB
#undef PG8_MMA
#undef PG8_RD8
#undef PG8_WAIT_V
#undef PG8_WAIT_L
#undef PG8_BAR
#undef PG8_SCHED
}
}

namespace at {
constexpr int D = 128, NW = 8, QBLK = 32, KVBLK = 64;
constexpr float SCALE = 0.088388347648318440f;
constexpr float THR = 8.f;
constexpr int LDQ = INW, LDK = INW, LDO = DM;
constexpr size_t SHM_V = KVBLK * D * 2, SHM_K = KVBLK * D * 2, SHM_ATTN = 2 * SHM_V + 2 * SHM_K + NW * 64 * 4;
#define KSWZ(row, colB) ((row) * 256 + ((colB) ^ (((row) & 7) << 4)))
#define SBAR() __builtin_amdgcn_sched_barrier(0)
__device__ __forceinline__ int crow(int r, int hi) { return (r & 3) + 8 * (r >> 2) + 4 * hi; }
__device__ __forceinline__ unsigned cvtpk(float lo, float hi) { unsigned r; asm volatile("v_cvt_pk_bf16_f32 %0, %1, %2" : "=v"(r) : "v"(lo), "v"(hi)); return r; }

__device__ __forceinline__ void partialSM(f32x16& p0, f32x16& p1, float& m_reg, float& mn, float& alpha, bool domask, int dq, int hi) {
  constexpr float C = SCALE * 1.4426950408889634f;
  {
    if (domask) {
#pragma unroll
      for (int r = 0; r < 16; ++r) { const int d0 = dq + crow(r, hi), d1 = d0 + 32;
        if (d0 > 128 || d0 < -128) p0[r] = -1e30f;
        if (d1 > 128 || d1 < -128) p1[r] = -1e30f; }
    }
  }
  float pmax = p0[0]; for (int r = 1; r < 16; ++r) pmax = fmaxf(pmax, p0[r]); for (int r = 0; r < 16; ++r) pmax = fmaxf(pmax, p1[r]);
  { auto rr = __builtin_amdgcn_permlane32_swap(__float_as_uint(pmax), __float_as_uint(pmax), false, false);
    pmax = fmaxf(__uint_as_float(rr[0]), __uint_as_float(rr[1])); }
  if (__builtin_expect(__all(pmax - m_reg <= THR / SCALE), 1)) { mn = m_reg; alpha = 1.f; }
  else { mn = fmaxf(m_reg, pmax); alpha = __builtin_amdgcn_exp2f((m_reg - mn) * C); m_reg = mn; }
  float mnC = -mn * C;
  for (int r = 0; r < 16; ++r) p0[r] = fmaf(p0[r], C, mnC); for (int r = 0; r < 16; ++r) p1[r] = fmaf(p1[r], C, mnC);
  for (int r = 0; r < 16; ++r) p0[r] = __builtin_amdgcn_exp2f(p0[r]);
}
__device__ __forceinline__ void finishSM(f32x16& p0, f32x16& p1, float alpha, float& l_reg, bf16x8& pa0, bf16x8& pa1, bf16x8& pa2, bf16x8& pa3) {
  for (int r = 0; r < 16; ++r) p1[r] = __builtin_amdgcn_exp2f(p1[r]);
  float ps = 0; for (int r = 0; r < 16; ++r) ps += p0[r]; for (int r = 0; r < 16; ++r) ps += p1[r];
  { auto rr = __builtin_amdgcn_permlane32_swap(__float_as_uint(ps), __float_as_uint(ps), false, false);
    ps = __uint_as_float(rr[0]) + __uint_as_float(rr[1]); }
  l_reg = l_reg * alpha + ps;
#define PK4(P, BASE, OUT) do { unsigned a0 = cvtpk(P[BASE + 0], P[BASE + 1]), a1 = cvtpk(P[BASE + 2], P[BASE + 3]);   \
    unsigned b0 = cvtpk(P[BASE + 4], P[BASE + 5]), b1 = cvtpk(P[BASE + 6], P[BASE + 7]);                              \
    auto r0 = __builtin_amdgcn_permlane32_swap(a0, b0, false, false); auto r1 = __builtin_amdgcn_permlane32_swap(a1, b1, false, false); \
    u32x4 w = {r0[0], r1[0], r0[1], r1[1]}; OUT = *reinterpret_cast<bf16x8*>(&w); } while (0)
  PK4(p0, 0, pa0); PK4(p0, 8, pa1); PK4(p1, 0, pa2); PK4(p1, 8, pa3);
#undef PK4
}
__device__ __forceinline__ void qkt(f32x16& p0, f32x16& p1, const char* Ks, const bf16x8* qr, int ka0) {
  p0 = f32x16{}; p1 = f32x16{};
  asm volatile("" : "+v"(ka0));
#pragma unroll
  for (int d0 = 0; d0 < 8; ++d0) { const int off = ka0 ^ (d0 * 32);
    bf16x8 b0 = *reinterpret_cast<const bf16x8*>(Ks + off);
    bf16x8 b1 = *reinterpret_cast<const bf16x8*>(Ks + off + 32 * 256);
    p0 = __builtin_amdgcn_mfma_f32_32x32x16_bf16(b0, qr[d0], p0, 0, 0, 0);
    p1 = __builtin_amdgcn_mfma_f32_32x32x16_bf16(b1, qr[d0], p1, 0, 0, 0); }
}
__device__ __forceinline__ int v_st(int k, int c) { const int kk = (k & ~0xC) | ((k & 4) << 1) | ((k & 8) >> 1); return ((kk >> 3) * 4 + (c >> 5)) * 512 + ((kk & 7) * 32 + (c & 31)) * 2; }
__device__ __forceinline__ int v_rd_base(int lane) { return ((lane & 3) << 3) | (((lane >> 2) & 3) << 6) | (((lane >> 4) & 1) << 5) | (((lane >> 5) & 1) << 8); }
constexpr int v_rd_off(int d0, int ks, int half) { return d0 * 512 + ks * 4096 + half * 2048; }
template <int OFF> __device__ __forceinline__ s16x4 tr_read(int vb) {
  s16x4 r; asm volatile("ds_read_b64_tr_b16 %0, %1 offset:%2" : "=&v"(r) : "v"(vb), "i"(OFF) : "memory"); return r;
}
template <int D0> __device__ __forceinline__ void pv_one(f32x16& od, int vb, bf16x8 pa0, bf16x8 pa1, bf16x8 pa2, bf16x8 pa3) {
  const s16x4 l0 = tr_read<v_rd_off(D0, 0, 0)>(vb), h0 = tr_read<v_rd_off(D0, 0, 1)>(vb), l1 = tr_read<v_rd_off(D0, 1, 0)>(vb), h1 = tr_read<v_rd_off(D0, 1, 1)>(vb);
  const s16x4 l2 = tr_read<v_rd_off(D0, 2, 0)>(vb), h2 = tr_read<v_rd_off(D0, 2, 1)>(vb), l3 = tr_read<v_rd_off(D0, 3, 0)>(vb), h3 = tr_read<v_rd_off(D0, 3, 1)>(vb);
  asm volatile("s_waitcnt lgkmcnt(0)" ::: "memory"); SBAR();
#define PK(L, H) (bf16x8){L[0], L[1], L[2], L[3], H[0], H[1], H[2], H[3]}
  od = __builtin_amdgcn_mfma_f32_32x32x16_bf16(pa0, PK(l0, h0), od, 0, 0, 0);
  od = __builtin_amdgcn_mfma_f32_32x32x16_bf16(pa1, PK(l1, h1), od, 0, 0, 0);
  od = __builtin_amdgcn_mfma_f32_32x32x16_bf16(pa2, PK(l2, h2), od, 0, 0, 0);
  od = __builtin_amdgcn_mfma_f32_32x32x16_bf16(pa3, PK(l3, h3), od, 0, 0, 0);
#undef PK
}
__device__ __forceinline__ void pv_d0(f32x16* o, int vb, bf16x8 pa0, bf16x8 pa1, bf16x8 pa2, bf16x8 pa3) {
  pv_one<0>(o[0], vb, pa0, pa1, pa2, pa3); pv_one<1>(o[1], vb, pa0, pa1, pa2, pa3); pv_one<2>(o[2], vb, pa0, pa1, pa2, pa3); pv_one<3>(o[3], vb, pa0, pa1, pa2, pa3);
}

__device__ __forceinline__ void attn_body(const bf16_t* __restrict__ Qb, const bf16_t* __restrict__ Kb, const bf16_t* __restrict__ Vb, bf16_t* __restrict__ Ob,
                                          int NT, int kskip, int qpos0, float m0, float l0, bool maskon, char* lds, float* ssq_out) {
  const int tid = opaque_tid(), wid = tid >> 6, lane = tid & 63, r32 = lane & 31, hi = lane >> 5;
  char* V_lds = lds; char* K_lds = lds + 2 * SHM_V;
  float* ws = (float*)(lds + 2 * SHM_V + 2 * SHM_K) + wid * 64; float* li_l = ws; float* al_l = ws + 32;
  float m_reg = m0, l_reg = l0; f32x16 o[4] = {}; bf16x8 qr[8];
  const bf16_t* Qw = Qb + (long)(wid * QBLK + r32) * LDQ + hi * 8;
#pragma unroll
  for (int d0 = 0; d0 < 8; ++d0) qr[d0] = *reinterpret_cast<const bf16x8*>(Qw + d0 * 16);
  const int sr = tid >> 4, sc = (tid & 15) * 8, vst0 = v_st(sr, sc), kst0 = KSWZ(sr, sc * 2);
  const int vb0 = (int)(uintptr_t)V_lds + v_rd_base(lane);
  const int qpos = qpos0 + wid * QBLK + r32;
  const int ka0 = r32 * 256 + ((hi * 16) ^ ((r32 & 7) << 4));
  const unsigned goff0 = (unsigned)(sr * LDK + sc) * 2u, goff1 = goff0 + 32u * LDK * 2u;
  struct { bf16x8 vs0, vs1, ks0, ks1; } sr_[1];
#define TROW(jt) ((long)(jt) * KVBLK + ((jt) >= 4 ? kskip : 0))
#define SLOAD(i, jt) do { const long _k0 = TROW(jt) * (LDK * 2); const char* _kp = (const char*)Kb + _k0; const char* _vp = (const char*)Vb + _k0; \
    sr_[i].vs0 = *reinterpret_cast<const bf16x8*>(_vp + goff0); sr_[i].vs1 = *reinterpret_cast<const bf16x8*>(_vp + goff1); \
    sr_[i].ks0 = *reinterpret_cast<const bf16x8*>(_kp + goff0); sr_[i].ks1 = *reinterpret_cast<const bf16x8*>(_kp + goff1); } while (0)
#define SWRITE(b, i) do { *(bf16x8*)(V_lds + (b) * SHM_V + vst0) = sr_[i].vs0;          \
    *(bf16x8*)(V_lds + (b) * SHM_V + vst0 + 8192) = sr_[i].vs1;                         \
    *(bf16x8*)(K_lds + (b) * SHM_K + kst0) = sr_[i].ks0;                               \
    *(bf16x8*)(K_lds + (b) * SHM_K + kst0 + 8192) = sr_[i].ks1; } while (0)
#define SWAIT() asm volatile("s_waitcnt vmcnt(0)" ::: "memory")
#define RESC(a) do { if (__any((a) < 1.f)) { if (hi == 0) al_l[r32] = (a); asm volatile("s_waitcnt lgkmcnt(0)" ::: "memory"); \
    for (int d = 0; d < 4; ++d) for (int r = 0; r < 16; ++r) o[d][r] *= al_l[crow(r, hi)]; } } while (0)
#define DQ(jt) (kskip + ((jt) - 4) * KVBLK - qpos)
  f32x16 pA0, pA1, pB0, pB1; float mnA, mnB, alA, alB; bf16x8 pa0, pa1, pa2, pa3;
  constexpr int SE = 0, SO = 0;
  SLOAD(SE, 0); asm volatile("s_waitcnt vmcnt(0)" ::: "memory"); SWRITE(0, SE); __syncthreads();
  qkt(pA0, pA1, K_lds, qr, ka0); partialSM(pA0, pA1, m_reg, mnA, alA, false, 0, hi);
  SLOAD(SO, 1);
  SWAIT(); SWRITE(1, SO); __syncthreads();
  for (int j = 1; j + 1 < NT; j += 2) {
    SBAR(); qkt(pB0, pB1, K_lds + SHM_K, qr, ka0);
    finishSM(pA0, pA1, alA, l_reg, pa0, pa1, pa2, pa3); SBAR();
    SLOAD(SO, j + 1); SBAR();
    pv_d0(o, vb0, pa0, pa1, pa2, pa3); partialSM(pB0, pB1, m_reg, mnB, alB, maskon && j >= 4, DQ(j), hi);
    __syncthreads(); SWAIT(); SWRITE(0, SE);
    RESC(alB); __syncthreads();
    SBAR(); qkt(pA0, pA1, K_lds, qr, ka0);
    finishSM(pB0, pB1, alB, l_reg, pa0, pa1, pa2, pa3); SBAR();
    SLOAD(SE, j + 2); SBAR();
    pv_d0(o, vb0 + (int)SHM_V, pa0, pa1, pa2, pa3); partialSM(pA0, pA1, m_reg, mnA, alA, maskon && j + 1 >= 4, DQ(j + 1), hi);
    __syncthreads(); SWAIT(); SWRITE(1, SO);
    RESC(alA); __syncthreads();
  }
  SBAR(); qkt(pB0, pB1, K_lds + SHM_K, qr, ka0);
  finishSM(pA0, pA1, alA, l_reg, pa0, pa1, pa2, pa3); SBAR();
  pv_d0(o, vb0, pa0, pa1, pa2, pa3); partialSM(pB0, pB1, m_reg, mnB, alB, maskon && NT - 1 >= 4, DQ(NT - 1), hi);
  __syncthreads(); RESC(alB);
  finishSM(pB0, pB1, alB, l_reg, pa0, pa1, pa2, pa3); SBAR();
  pv_d0(o, vb0 + (int)SHM_V, pa0, pa1, pa2, pa3);
  if (hi == 0) li_l[r32] = l_reg; asm volatile("s_waitcnt lgkmcnt(0)" ::: "memory");
  float rli[16];
#pragma unroll
  for (int r = 0; r < 16; ++r) rli[r] = __builtin_amdgcn_rcpf(li_l[crow(r, hi)]);
  bf16_t* Ow = Ob + (long)(wid * QBLK) * LDO;
#pragma unroll
  for (int r = 0; r < 16; ++r) { int orow = crow(r, hi); float sq = 0.f;
    for (int d0 = 0; d0 < 4; ++d0) { const float ov = o[d0][r] * rli[r]; sq += ov * ov; Ow[(long)orow * LDO + d0 * 32 + r32] = (bf16_t)f2bf(ov); }
    sq = row16_sum(sq); sq += __builtin_bit_cast(float, __builtin_amdgcn_ds_swizzle(__builtin_bit_cast(int, sq), 0x401F));
    if (r32 == 0) ssq_out[(size_t)(wid * QBLK + orow) * 16] = sq; }
#undef TROW
#undef SLOAD
#undef SWRITE
#undef SWAIT
#undef RESC
#undef DQ
}
}

struct Args { const float* in[23]; float* out; unsigned char* ws; int ph_lo, ph_hi; };
enum { IN_X = 0, IN_C, IN_CTX, IN_CCTX, IN_WMOD, IN_BMOD, IN_N1G, IN_N2G, IN_WIN, IN_QNA, IN_KNA, IN_SINK, IN_VNB, IN_WS, IN_BS, IN_QNC, IN_KNC, IN_OUTG, IN_WOUT, IN_WR, IN_WG, IN_WU, IN_WDN };

#define PHASE_IDS(F) const int tid = opaque_tid(), lane = tid & 63, wave = __builtin_amdgcn_readfirstlane(tid >> 6), gw = (int)blockIdx.x * 8 + wave, NGW = (F).G * 8; (void)lane; (void)wave; (void)gw; (void)NGW
constexpr int ARGTAB_OFF = LDSCTL_OFF + 1024;
#define INP(F, i) ld_inp((F).lds, (i))
__device__ __forceinline__ const float* ld_inp(LAS unsigned char* lds, int i) {
    unsigned a = (unsigned)(uintptr_t)(lds + ARGTAB_OFF) + 8u * (unsigned)i;
    asm volatile("" : "+v"(a));
    const volatile LAS unsigned* t = (const volatile LAS unsigned*)(uintptr_t)a;
    const unsigned lo = __builtin_amdgcn_readfirstlane(t[0]), hi = __builtin_amdgcn_readfirstlane(t[1]);
    return (const float*)(const GAS float*)(((unsigned long long)hi << 32) | lo);
}
struct Frame {
    LAS unsigned char* lds; char* ldsg;
    volatile LAS unsigned* MISC;
    unsigned* ctl;
    int G;
    float* out; unsigned char* ws;
};

__host__ __device__ __forceinline__ int headpos(int d) { return 32 * (2 * (d >> 6) + ((d >> 4) & 1)) + 8 * ((d >> 2) & 3) + 4 * ((d >> 5) & 1) + (d & 3); }
template <bool HEADPERM = false>
__device__ __forceinline__ void transpose_item(const float* W, int N, bf16_t* WT, int k0, int n0, int drow0, LAS float* scr, int lane) {
    { float t[32]; const float* wp = W + (size_t)(k0 + (lane >> 5)) * N + n0 + (lane & 31);
#pragma unroll
      for (int i = 0; i < 32; ++i) t[i] = wp[(size_t)(2 * i) * N];
#pragma unroll
      for (int i = 0; i < 32; ++i) scr[(2 * i + (lane >> 5)) * 33 + (lane & 31)] = t[i]; }
    LDS_WAIT(); asm volatile("" ::: "memory");
    const int c = lane & 7;
#pragma unroll
    for (int j = 0; j < 4; ++j) { const int n = (lane >> 3) + 8 * j; const LAS float* s = scr + (8 * c) * 33 + n;
        u32x4 o; o.x = pk2(s[0 * 33], s[1 * 33]); o.y = pk2(s[2 * 33], s[3 * 33]); o.z = pk2(s[4 * 33], s[5 * 33]); o.w = pk2(s[6 * 33], s[7 * 33]);
        const int drow = HEADPERM ? ((drow0 + n) & ~127) + headpos((drow0 + n) & 127) : drow0 + n;
        *(u32x4*)(WT + (size_t)drow * DM + k0 + 8 * c) = o; }
    LDS_WAIT(); asm volatile("" ::: "memory");
}

__device__ __forceinline__ void transpose_item8(const float* W, int N, unsigned char* WT, int k0, int n0, int drow0, LAS float* scr, int lane) {
    { float t[32]; const float* wp = W + (size_t)(k0 + (lane >> 5)) * N + n0 + (lane & 31);
#pragma unroll
      for (int i = 0; i < 32; ++i) t[i] = wp[(size_t)(2 * i) * N];
#pragma unroll
      for (int i = 0; i < 32; ++i) scr[(2 * i + (lane >> 5)) * 33 + (lane & 31)] = t[i]; }
    LDS_WAIT(); asm volatile("" ::: "memory");
    const int c = lane & 7;
#pragma unroll
    for (int j = 0; j < 4; ++j) { const int n = (lane >> 3) + 8 * j; const LAS float* s = scr + (8 * c) * 33 + n;
        u32x2 o; o.x = pk4_fp8(s[0 * 33] * W8_SCALE, s[1 * 33] * W8_SCALE, s[2 * 33] * W8_SCALE, s[3 * 33] * W8_SCALE); o.y = pk4_fp8(s[4 * 33] * W8_SCALE, s[5 * 33] * W8_SCALE, s[6 * 33] * W8_SCALE, s[7 * 33] * W8_SCALE);
        *(u32x2*)(WT + (size_t)(drow0 + n) * DM + k0 + 8 * c) = o; }
    LDS_WAIT(); asm volatile("" ::: "memory");
}
__device__ __forceinline__ void conv_tile(Frame& F, int tl, int tid, int lane, int wave) {
    const int mat = tl >> 7, kb = (tl & 127) >> 3, nb = tl & 7, le = mat / 3, wh = mat % 3;
    const float* src = INP(F, wh == 0 ? IN_WG : wh == 1 ? IN_WU : IN_WDN) + (size_t)le * DM * DM + (size_t)(128 * kb) * DM + 256 * nb;
    unsigned char* dst = (wh < 2) ? F.ws + WS_WGU + (size_t)(le / NE) * NE * 4096 * DM * 2 + (size_t)(le % NE) * 4096 * DM + (size_t)(2 * nb) * 256 * DM + 128 * kb
                                  : F.ws + WS_WD + (size_t)(le / NE) * NE * DM * DM * 2 + (size_t)(le % NE) * DM * DM + (size_t)(256 * nb) * DM + 128 * kb;
    f32x4 t[16];
    { const float* wp = src + (size_t)(16 * wave) * DM + 4 * lane;
#pragma unroll
      for (int q = 0; q < 16; ++q) t[q] = __builtin_nontemporal_load((const f32x4*)(wp + (size_t)q * DM)); }
    LAS unsigned* img = (LAS unsigned*)F.lds;
#pragma unroll
    for (int it = 0; it < 4; ++it)
#pragma unroll
        for (int j = 0; j < 4; ++j) { const int n = 4 * lane + j, d = 4 * wave + it;
            img[n * 32 + (d ^ (lane & 31))] = pk4_fp8(t[4 * it + 0][j] * W8_SCALE, t[4 * it + 1][j] * W8_SCALE, t[4 * it + 2][j] * W8_SCALE, t[4 * it + 3][j] * W8_SCALE); }
    __syncthreads();
#pragma unroll
    for (int q = 0; q < 4; ++q) { const int ch = tid + 512 * q, n = ch >> 3, g = ch & 7, sw = (n >> 2) & 31;
        u32x4 o; o.x = img[n * 32 + ((4 * g + 0) ^ sw)]; o.y = img[n * 32 + ((4 * g + 1) ^ sw)]; o.z = img[n * 32 + ((4 * g + 2) ^ sw)]; o.w = img[n * 32 + ((4 * g + 3) ^ sw)];
        const int drow = (wh < 2) ? (n >> 7) * 256 + wh * 128 + (n & 127) : n;
        *(u32x4*)(dst + (size_t)drow * DM + 16 * g) = o; }
    __syncthreads();
}
__device__ __forceinline__ void conv_help(Frame& F, int budget, unsigned* done, unsigned done_total) {
    if (!CONV_IDLE) return;
    PHASE_IDS(F);
    for (int n = 0; n < budget; ++n) {
        if (tid == 0) { unsigned t = 0xffffffffu;
            if (done == nullptr || xb_ld(done) < done_total) t = xb_add(F.ctl + CW_CONV, 1u);
            F.MISC[1] = t; }
        __syncthreads();
        const unsigned t = F.MISC[1];
        __syncthreads();
        if (t >= (unsigned)(NT8_ALL - NT8_L0)) break;
        conv_tile(F, NT8_L0 + (int)t, tid, lane, wave);
    }
}
__device__ __forceinline__ void phase_prologue(Frame& F) {
    PHASE_IDS(F);
    static_assert(FP8_L0 && FP8_L1, "the prologue writes the experts' weights as fp8");
    {
        constexpr int NT8 = CONV_IDLE ? NT8_L0 : NT8_ALL;
        struct T8 { const float* src; unsigned char* dst; int which; };
#define P8_DESC(d, tl) do { const int mat = (tl) >> 7, kb = ((tl) & 127) >> 3, nb = (tl) & 7, le = mat / 3, wh = mat % 3; d.which = wh; \
        d.src = INP(F, wh == 0 ? IN_WG : wh == 1 ? IN_WU : IN_WDN) + (size_t)le * DM * DM + (size_t)(128 * kb) * DM + 256 * nb; \
        d.dst = (wh < 2) ? F.ws + WS_WGU + (size_t)(le / NE) * NE * 4096 * DM * 2 + (size_t)(le % NE) * 4096 * DM + (size_t)(2 * nb) * 256 * DM + 128 * kb \
                         : F.ws + WS_WD + (size_t)(le / NE) * NE * DM * DM * 2 + (size_t)(le % NE) * DM * DM + (size_t)(256 * nb) * DM + 128 * kb; } while (0)
#define P8_LOAD(d, t) do { const float* wp = d.src + (size_t)(16 * wave) * DM + 4 * lane; _Pragma("unroll") for (int q = 0; q < 16; ++q) t[q] = __builtin_nontemporal_load((const f32x4*)(wp + (size_t)q * DM)); } while (0)
        T8 cur, nxt; f32x4 t0[16], t1[16];
        int tl = blockIdx.x, par = 0;
        if (tl < NT8) { P8_DESC(cur, tl); P8_LOAD(cur, t0); }
        for (; tl < NT8; tl += F.G, par ^= 1) {
            const bool has = tl + F.G < NT8;
            if (has) { P8_DESC(nxt, tl + F.G); P8_LOAD(nxt, t1); }
            LAS unsigned* img = (LAS unsigned*)(F.lds + par * 32768);
#pragma unroll
            for (int it = 0; it < 4; ++it)
#pragma unroll
                for (int j = 0; j < 4; ++j) { const int n = 4 * lane + j, d = 4 * wave + it;
                    img[n * 32 + (d ^ (lane & 31))] = pk4_fp8(t0[4 * it + 0][j] * W8_SCALE, t0[4 * it + 1][j] * W8_SCALE, t0[4 * it + 2][j] * W8_SCALE, t0[4 * it + 3][j] * W8_SCALE); }
            __syncthreads();
#pragma unroll
            for (int q = 0; q < 4; ++q) { const int ch = tid + 512 * q, n = ch >> 3, g = ch & 7, sw = (n >> 2) & 31;
                u32x4 o; o.x = img[n * 32 + ((4 * g + 0) ^ sw)]; o.y = img[n * 32 + ((4 * g + 1) ^ sw)]; o.z = img[n * 32 + ((4 * g + 2) ^ sw)]; o.w = img[n * 32 + ((4 * g + 3) ^ sw)];
                const int drow = (cur.which < 2) ? (n >> 7) * 256 + cur.which * 128 + (n & 127) : n;
                *(u32x4*)(cur.dst + (size_t)drow * DM + 16 * g) = o; }
            if (has) { cur = nxt;
#pragma unroll
                for (int q = 0; q < 16; ++q) t0[q] = t1[q]; }
        }
#undef P8_DESC
#undef P8_LOAD
        __syncthreads();
    }
    LAS float* scr = (LAS float*)(F.lds + wave * 16384);
    constexpr int I_IN = 32 * (INW / 32), I_SQ = 32 * (DM / 32);
    constexpr int NIT = 2 * I_IN + 2 * I_SQ;
    struct TItem { const float* src; unsigned char* dst; const float* og; int N, drow0, mode; };
#define P0_DESC(d, itv) do { int r = (itv); \
        if (r < 2 * I_IN) { const int l = r / I_IN; r %= I_IN; const int kb = r / (INW / 32), nb = r % (INW / 32); \
            d.src = INP(F, IN_WIN) + (size_t)l * DM * INW + (size_t)(64 * kb) * INW + 32 * nb; d.dst = F.ws + WS_WIN + (size_t)l * INW * DM * 2 + 128 * kb; d.N = INW; d.drow0 = 32 * nb; d.mode = 1; d.og = nullptr; } \
        else { r -= 2 * I_IN; const int l = r / I_SQ; r %= I_SQ; const int kb = r / 64, nb = r % 64; \
            d.src = INP(F, IN_WOUT) + (size_t)l * DM * DM + (size_t)(64 * kb) * DM + 32 * nb; d.dst = F.ws + WS_WOUT + (size_t)l * DM * DM * 2 + 128 * kb; d.N = DM; d.drow0 = 32 * nb; d.mode = 0; d.og = INP(F, IN_OUTG) + l * DM + 64 * kb; } } while (0)
#define P0_LOAD(d, t) do { const float* wp = d.src + (size_t)(lane >> 3) * d.N + (lane & 7) * 4; _Pragma("unroll") for (int i = 0; i < 8; ++i) t[i] = *(const f32x4*)(wp + (size_t)(8 * i) * d.N); } while (0)
    for (int it = gw; it < NIT; it += NGW) {
        TItem cur; f32x4 t0[8];
        P0_DESC(cur, it); P0_LOAD(cur, t0);
#pragma unroll
        for (int i = 0; i < 8; ++i) { LAS float* sp = scr + (8 * i + (lane >> 3)) * 33 + (lane & 7) * 4; sp[0] = t0[i].x; sp[1] = t0[i].y; sp[2] = t0[i].z; sp[3] = t0[i].w; }
        LDS_WAIT(); asm volatile("" ::: "memory");
        const int c = lane & 7;
#pragma unroll
        for (int j = 0; j < 4; ++j) { const int n = (lane >> 3) + 8 * j; const LAS float* sp = scr + (8 * c) * 33 + n;
            float v[8];
#pragma unroll
            for (int q = 0; q < 8; ++q) v[q] = sp[q * 33];
            if (cur.mode == 0) { const f32x4 g0 = *(const f32x4*)(cur.og + 8 * c), g1 = *(const f32x4*)(cur.og + 8 * c + 4);
                v[0] *= g0.x; v[1] *= g0.y; v[2] *= g0.z; v[3] *= g0.w; v[4] *= g1.x; v[5] *= g1.y; v[6] *= g1.z; v[7] *= g1.w; }
            int drow = cur.drow0 + n; if (cur.mode == 1) drow = (drow & ~127) + headpos(drow & 127);
            u32x4 o; o.x = pk2(v[0], v[1]); o.y = pk2(v[2], v[3]); o.z = pk2(v[4], v[5]); o.w = pk2(v[6], v[7]); *(u32x4*)(cur.dst + (size_t)drow * DM * 2 + 16 * c) = o; }
        LDS_WAIT(); asm volatile("" ::: "memory");
    }
#undef P0_DESC
#undef P0_LOAD
    __syncthreads();
    {
        LAS float* sil = (LAS float*)F.lds;
        LAS float* red = (LAS float*)(F.lds + 40960);
        bool have = false;
        for (int it = blockIdx.x; it < 2 * 96; it += F.G) {
            if (!have) {
                { const float* cp = INP(F, IN_C); const float* ccp = INP(F, IN_CCTX);
                for (int i = tid; i < 5 * DM; i += 512) { const int s = i / DM, k = i % DM; const float cv = (s < 4) ? cp[s * DM + k] : ccp[k]; sil[i] = cv / (1.f + __expf(-cv)); } }
                have = true; __syncthreads();
            }
            const int l = it / 96, cb = it % 96, c4 = tid & 31, kr = tid >> 5;
            const float* wp = INP(F, IN_WMOD) + (size_t)l * DM * NMOD + (size_t)cb * 128 + c4 * 4;
            f32x4 a[5];
#pragma unroll
            for (int s = 0; s < 5; ++s) a[s] = (f32x4){0.f, 0.f, 0.f, 0.f};
#pragma unroll 8
            for (int k = kr; k < DM; k += 16) { const f32x4 w = *(const f32x4*)(wp + (size_t)k * NMOD);
#pragma unroll
                for (int s = 0; s < 5; ++s) a[s] += w * sil[s * DM + k]; }
#pragma unroll
            for (int s = 0; s < 5; ++s) *(LAS f32x4*)(red + (kr * 5 + s) * 128 + c4 * 4) = a[s];
            __syncthreads();
            const float* bmod = INP(F, IN_BMOD);
            for (int i = tid; i < 5 * 128; i += 512) { const int s = i / 128, cc = i % 128; float sum = 0.f;
#pragma unroll
                for (int q = 0; q < 16; ++q) sum += red[(q * 5 + s) * 128 + cc];
                ((float*)(F.ws + WS_MOD))[(size_t)(l * 5 + s) * NMOD + cb * 128 + cc] = sum + bmod[l * NMOD + cb * 128 + cc]; }
            __syncthreads();
        }
    }
    if ((int)blockIdx.x >= F.G - 9 && (int)blockIdx.x < F.G - 1) {
        const float* wr = INP(F, IN_WR); bf16_t* wf = (bf16_t*)(F.ws + WS_WRS); const int part = (int)blockIdx.x - (F.G - 9);
        for (int i = part * 512 + tid; i < 2 * DM * NE; i += 8 * 512) { const int l = i / (DM * NE), rem = i % (DM * NE), k = rem >> 4, e = rem & 15;
            const float w = wr[i]; const unsigned hi = f2bf(w); const unsigned lo = f2bf(w - __builtin_bit_cast(float, hi << 16));
            const int sidx = k >> 5, q = (k >> 3) & 3, j = k & 7; bf16_t* dst = wf + ((size_t)(l * 64 + sidx) * 2 * 64 + (q * 16 + e)) * 8 + j;
            dst[0] = (bf16_t)hi; dst[64 * 8] = (bf16_t)lo; }
    }
    if (blockIdx.x == F.G - 1) {
        for (int i = tid; i < 64 * 32; i += 512) {
            const int pos = i >> 5, f = i & 31;
            double inv = 1.0; for (int q = 0; q < f; ++q) inv *= 0.7498942093324559;
            const double a = (double)pos * inv;
            const double n = __builtin_rint(a * 0.6366197723675814);
            const double r = (a - n * 1.5707963267948966) - n * 6.123233995736766e-17;
            const double r2 = r * r;
            double sn = r * (1.0 + r2 * (-1.0 / 6 + r2 * (1.0 / 120 + r2 * (-1.0 / 5040 + r2 * (1.0 / 362880 + r2 * (-1.0 / 39916800 + r2 * (1.0 / 6227020800.0)))))));
            double cn = 1.0 + r2 * (-0.5 + r2 * (1.0 / 24 + r2 * (-1.0 / 720 + r2 * (1.0 / 40320 + r2 * (-1.0 / 3628800 + r2 * (1.0 / 479001600 + r2 * (-1.0 / 87178291200.0)))))));
            const int q = ((int)n) & 3; double cs, ss;
            if (q == 0) { cs = cn; ss = sn; } else if (q == 1) { cs = -sn; ss = cn; } else if (q == 2) { cs = -cn; ss = -sn; } else { cs = sn; ss = -cn; }
            ((float*)(F.ws + WS_ROPE))[2 * i] = (float)cs; ((float*)(F.ws + WS_ROPE))[2 * i + 1] = (float)ss;
        }
    }
}

__device__ __forceinline__ void load_row(const float* row, int lane, f32x4 (&v)[8]) {
#pragma unroll
    for (int j = 0; j < 8; ++j) v[j] = *(const f32x4*)(row + 4 * lane + 256 * j);
}
__device__ __forceinline__ void norm_mod_store(const f32x4 (&v)[8], const float* g, const float* shift, const float* scale, bf16_t* dst, int lane) {
    float ss = 0.f;
#pragma unroll
    for (int j = 0; j < 8; ++j) ss += (v[j].x * v[j].x + v[j].y * v[j].y) + (v[j].z * v[j].z + v[j].w * v[j].w);
    const float rinv = rsqrt_fast(wave_sum(ss) * (1.f / DM) + EPS);
#pragma unroll
    for (int j = 0; j < 8; ++j) { const int c = 4 * lane + 256 * j;
        const f32x4 gg = *(const f32x4*)(g + c), sh = *(const f32x4*)(shift + c), sc = *(const f32x4*)(scale + c);
        const f32x4 y = (v[j] * rinv) * gg * (sc + 1.f) + sh;
        u32x2 w; w.x = pk2(y.x, y.y); w.y = pk2(y.z, y.w); *(u32x2*)(dst + c) = w; }
}

__device__ __forceinline__ void phase_rowpass1_l0(Frame& F) {
    PHASE_IDS(F);
    const float* mod = (const float*)(F.ws + WS_MOD);
    { const float* n2 = INP(F, IN_N2G); float* gs = (float*)(F.ws + WS_GS2);
      for (int i = (int)blockIdx.x * 512 + tid; i < 2 * 5 * DM; i += F.G * 512) { const int l = i / (5 * DM), sv = (i / DM) % 5, k = i % DM;
          const float* m = mod + (size_t)(l * 5 + sv) * NMOD; gs[2 * i] = n2[l * DM + k] * (1.f + m[4 * DM + k]); gs[2 * i + 1] = m[3 * DM + k]; } }
    const float* xin = INP(F, IN_X); const float* cin = INP(F, IN_CTX); const float* n1g = INP(F, IN_N1G);
#define P1_SRC(rr) ((((rr) % TPB) < CTXL) ? cin + ((size_t)((rr) / TPB) * CTXL + ((rr) % TPB)) * DM : xin + ((size_t)((rr) / TPB) * SEQ + (((rr) % TPB) - CTXL)) * DM)
    f32x4 v[8], vn[8];
    int r = gw;
    if (r < NTOK) load_row(P1_SRC(r), lane, v);
    while (r < NTOK) {
        const int rn = r + NGW;
        if (rn < NTOK) load_row(P1_SRC(rn), lane, vn);
        const int b = r / TPB, t = r % TPB, s = (t < CTXL) ? 4 : b;
        norm_mod_store(v, n1g, mod + (size_t)s * NMOD, mod + (size_t)s * NMOD + DM, (bf16_t*)(F.ws + WS_HN) + (size_t)r * DM, lane);
#pragma unroll
        for (int j = 0; j < 8; ++j) v[j] = vn[j];
        r = rn;
    }
#undef P1_SRC
}

__device__ __forceinline__ void post_unpack(const u32x4 x, float (&v)[8]) {
    v[0] = bflo(x.x); v[1] = bfhi(x.x); v[2] = bflo(x.y); v[3] = bfhi(x.y); v[4] = bflo(x.z); v[5] = bfhi(x.z); v[6] = bflo(x.w); v[7] = bfhi(x.w); }
__device__ __forceinline__ float sum16(float v) { return row16_sum(v); }
__device__ __forceinline__ void phase_post(Frame& F, int l) {
    PHASE_IDS(F);
    bf16_t* P = (bf16_t*)(F.ws + WS_P);
    const float* rope = (const float*)(F.ws + WS_ROPE);
    const int i16 = lane & 15, hq = lane >> 4; const bool hi2 = hq >= 2;
    const float* qna = INP(F, IN_QNA) + l * 128 + 8 * i16; const float* kna = INP(F, IN_KNA) + l * 128 + 8 * i16;
    const float* qnc = INP(F, IN_QNC) + l * 128 + 8 * i16; const float* knc = INP(F, IN_KNC) + l * 128 + 8 * i16;
    const float* vnb = INP(F, IN_VNB) + l * 512 + 8 * i16;
    for (int r = gw; r < NTOK; r += NGW) {
        const int t = r % TPB; const bool lat = t >= CTXL;
        u32x4* rp = (u32x4*)(P + (size_t)r * INW) + lane;
        u32x4 x[7];
#pragma unroll
        for (int j = 0; j < 7; ++j) x[j] = rp[64 * j];
        const int pos = lat ? t - CTXL : 0, pp = (i16 < 8) ? (pos >> 6) : (pos & 63);
        const f32x4* cs = (const f32x4*)(rope + 2 * (pp * 32 + 8 * (i16 & 3)));
        const f32x4 c0 = cs[0], c1 = cs[1], c2 = cs[2], c3 = cs[3];
        const float cosv[8] = {c0.x, c0.z, c1.x, c1.z, c2.x, c2.z, c3.x, c3.z}, sinv[8] = {c0.y, c0.w, c1.y, c1.w, c2.y, c2.w, c3.y, c3.w};
        const float sgn = (i16 & 4) ? 1.f : -1.f;
#pragma unroll
        for (int j = 0; j < 7; ++j) {
            const bool gelu_lo = (j == 3 || j == 4), gelu_hi = (j == 2 || j == 3);
            const bool norm_lo = (j != 2 && j != 3), norm_hi = (j != 2 && j != 6);
            const bool rope_lo = (j == 0 || j == 1 || j == 5 || j == 6), rope_hi = (j == 0 || j == 1 || j == 4 || j == 5);
            const bool dg = hi2 ? gelu_hi : gelu_lo, dn = hi2 ? norm_hi : norm_lo, dr = (hi2 ? rope_hi : rope_lo) && lat;
            if (!(gelu_lo || gelu_hi || norm_lo || norm_hi)) continue;
            float v[8]; post_unpack(x[j], v);
            if (gelu_lo || gelu_hi) {
#pragma unroll
                for (int e = 0; e < 8; ++e) { const float gv = gelu_tanh(v[e]); v[e] = dg ? gv : v[e]; } }
            if (norm_lo || norm_hi) {
                float ss = 0.f;
#pragma unroll
                for (int e = 0; e < 8; ++e) ss += v[e] * v[e];
                const float rinv = rsqrt_fast(sum16(ss) * (1.f / 128) + EPS);
                const float* gp;
                if (j == 0) gp = qna; else if (j == 1) gp = hi2 ? kna : qna; else if (j == 3) gp = vnb + (hi2 ? hq - 2 : 0) * 128; else if (j == 4) gp = hi2 ? qnc : vnb + (2 + hq) * 128;
                else if (j == 5) gp = qnc; else gp = knc;
                const f32x4 g0 = *(const f32x4*)gp, g1 = *(const f32x4*)(gp + 4);
                const float gg[8] = {g0.x, g0.y, g0.z, g0.w, g1.x, g1.y, g1.z, g1.w};
#pragma unroll
                for (int e = 0; e < 8; ++e) v[e] = dn ? v[e] * rinv * gg[e] : v[e];
            }
            if (rope_lo || rope_hi) {
#pragma unroll
                for (int e = 0; e < 8; ++e) { const float o = __builtin_bit_cast(float, __builtin_amdgcn_ds_swizzle(__builtin_bit_cast(int, v[e]), 0x101F)); const float rv = v[e] * cosv[e] + sgn * o * sinv[e]; v[e] = dr ? rv : v[e]; } }
            u32x4 w; w.x = pk2(v[0], v[1]); w.y = pk2(v[2], v[3]); w.z = pk2(v[4], v[5]); w.w = pk2(v[6], v[7]);
            rp[64 * j] = w;
        }
    }
}

__device__ __forceinline__ void mixer_b_unit(Frame& F, int l, int b, int ch, int g) {
    PHASE_IDS(F);
    const bf16_t* P = (const bf16_t*)(F.ws + WS_P); bf16_t* O = (bf16_t*)(F.ws + WS_O);
    const int row0 = b * TPB + ch * 128, w = wave;
    LAS bf16_t* VT = (LAS bf16_t*)F.lds;
    { const int q = tid >> 2, dp = (tid & 3) * 32; const bf16_t* src = P + (size_t)(row0 + q) * INW + C_VB + g * 128 + dp;
#pragma unroll
      for (int i = 0; i < 4; ++i) { const u32x4 x = *(const u32x4*)(src + 8 * i); const unsigned xs[4] = {x.x, x.y, x.z, x.w};
#pragma unroll
          for (int j = 0; j < 4; ++j) { VT[(dp + 8 * i + 2 * j) * 136 + q] = (bf16_t)(xs[j] & 0xffffu); VT[(dp + 8 * i + 2 * j + 1) * 136 + q] = (bf16_t)(xs[j] >> 16); } } }
    __syncthreads();
    const int i15 = lane & 15, kq = lane >> 4;
    f32x4 acc[8];
#pragma unroll
    for (int n = 0; n < 8; ++n) acc[n] = (f32x4){0.f, 0.f, 0.f, 0.f};
    const float* wsr = INP(F, IN_WS) + ((size_t)(l * 4 + g) * 128 + 16 * w + i15) * 128;
#pragma unroll
    for (int s = 0; s < 4; ++s) {
        const f32x4 a0 = *(const f32x4*)(wsr + 32 * s + 8 * kq), a1 = *(const f32x4*)(wsr + 32 * s + 8 * kq + 4);
        u32x4 aw; aw.x = pk2(a0.x, a0.y); aw.y = pk2(a0.z, a0.w); aw.z = pk2(a1.x, a1.y); aw.w = pk2(a1.z, a1.w);
        const bf16x8 af = *reinterpret_cast<bf16x8*>(&aw);
#pragma unroll
        for (int n = 0; n < 8; ++n) { const bf16x8 bfr = *(const LAS bf16x8*)(VT + (16 * n + i15) * 136 + 32 * s + 8 * kq);
            acc[n] = __builtin_amdgcn_mfma_f32_16x16x32_bf16(af, bfr, acc[n], 0, 0, 0); }
    }
#pragma unroll
    for (int j = 0; j < 4; ++j) { const int p = 16 * w + kq * 4 + j; const float bias = INP(F, IN_BS)[(l * 4 + g) * 128 + p];
        const bf16_t* up = P + (size_t)(row0 + p) * INW + C_UB + g * 128; bf16_t* op = O + (size_t)(row0 + p) * DM + O_B + g * 128;
        float sq = 0.f;
#pragma unroll
        for (int n = 0; n < 8; ++n) { const int d = 16 * n + i15; const float ov = bf2f(up[d]) * (acc[n][j] + bias); sq += ov * ov; op[d] = (bf16_t)f2bf(ov); }
        sq = row16_sum(sq);
        if (i15 == 0) ((float*)(F.ws + WS_SSQ))[(size_t)(row0 + p) * 16 + 6 + g] = sq; }
    __syncthreads();
}
__device__ __forceinline__ void phase_mixers(Frame& F, int l) {
    PHASE_IDS(F);
    const bf16_t* P = (const bf16_t*)(F.ws + WS_P); bf16_t* O = (bf16_t*)(F.ws + WS_O);
    const bool ctx = (l == 0);
    const int nC = 48, nA = 48, nCc = ctx ? 3 : 0, nAc = ctx ? 3 : 0, nB = 68;
    const int total = nC + nA + nCc + nAc + nB;
    for (int kq = 0; kq < 8; ++kq) {
        const int x = ((int)blockIdx.x + kq) & 7, b = x >> 1, kv = x & 1;
        unsigned* qctr = F.ctl + CW_QUEUE + 64 * (l * 8 + x);
        for (;;) {
            if (tid == 0) F.MISC[0] = xb_add(qctr, 1u);
            __syncthreads();
            int u = (int)F.MISC[0];
            __syncthreads();
            if (u >= total) break;
            if (u < nC + nA + nCc + nAc) {
                int kind, h, qb = 0;
                if (u < nC) { kind = 0; h = kv * 3 + u / 16; qb = u % 16; }
                else if (u < nC + nA) { const int v = u - nC; kind = 1; h = kv * 3 + v / 16; qb = v % 16; }
                else if (u < nC + nA + nCc) { kind = 2; h = kv * 3 + (u - nC - nA); }
                else { kind = 3; h = kv * 3 + (u - nC - nA - nCc); }
                const int isA = kind & 1, lat = (kind < 2);
                const size_t r0 = (size_t)b * TPB, rq = r0 + (lat ? CTXL + qb * 256 : 0);
                const int q0 = qb * 256, ks = (kind == 1) ? ((q0 - 128 < 0) ? 0 : q0 - 128) : 0, ke = (q0 + 384 > SEQ) ? SEQ : q0 + 384;
                const int NT = (kind == 0) ? 68 : (kind == 1) ? 4 + (ke - ks) / 64 : 4;
                const float sink = INP(F, IN_SINK)[l * 6 + h];
                const int cq = (isA ? C_QA : C_QC) + h * 128, ck = (isA ? C_KA : C_KC) + kv * 128, cv = (isA ? C_VA : C_VC) + kv * 128, co = (isA ? O_A : O_C) + h * 128;
                at::attn_body(P + rq * INW + cq, P + r0 * INW + ck, P + r0 * INW + cv, O + rq * DM + co, NT, ks, q0, isA ? sink / at::SCALE : -1e30f, isA ? 1.f : 0.f, kind == 1, F.ldsg,
                              (float*)(F.ws + WS_SSQ) + rq * 16 + (isA ? h : 10 + h));
                continue; }
            u -= nC + nA + nCc + nAc;
            { const int ch = u >> 1, g = kv * 2 + (u & 1);
              if (!ctx && ch < 2) continue;
              mixer_b_unit(F, l, b, ch, g); }
        }
    }
    if (CONV_IDLE && (CONV_HOOKS & 1)) {
        __syncthreads();
        if (tid == 0) (void)xb_add(F.ctl + CW_MIXDONE + 64 * l, 1u);
        conv_help(F, 64, F.ctl + CW_MIXDONE + 64 * l, (unsigned)F.G);
    }
}

__device__ __forceinline__ void phase_groupnorm(Frame& F, int l) {
    PHASE_IDS(F);
    bf16_t* O = (bf16_t*)(F.ws + WS_O); const float* og = INP(F, IN_OUTG) + l * DM;
#define GN_SKIP(rr) (l == 1 && ((rr) % TPB) < CTXL)
#define GN_LOAD(rr, xx) do { const bf16_t* _row = O + (size_t)(rr) * DM; \
        _Pragma("unroll") for (int i = 0; i < 3; ++i) { xx[i] = *(const u32x2*)(_row + O_A + 12 * lane + 4 * i); xx[5 + i] = *(const u32x2*)(_row + O_C + 12 * lane + 4 * i); } \
        _Pragma("unroll") for (int i = 0; i < 2; ++i) xx[3 + i] = *(const u32x2*)(_row + O_B + 8 * lane + 4 * i); } while (0)
    int r = gw; while (r < NTOK && GN_SKIP(r)) r += NGW;
    u32x2 x[8], xn[8];
    if (r < NTOK) GN_LOAD(r, x);
    while (r < NTOK) {
        int rn = r + NGW; while (rn < NTOK && GN_SKIP(rn)) rn += NGW;
        if (rn < NTOK) GN_LOAD(rn, xn);
        bf16_t* row = O + (size_t)r * DM;
        float v[8][4]; float ss[3] = {0.f, 0.f, 0.f};
#pragma unroll
        for (int i = 0; i < 8; ++i) { v[i][0] = bflo(x[i].x); v[i][1] = bfhi(x[i].x); v[i][2] = bflo(x[i].y); v[i][3] = bfhi(x[i].y);
            const int grp = (i < 3) ? 0 : (i < 5) ? 1 : 2; ss[grp] += (v[i][0] * v[i][0] + v[i][1] * v[i][1]) + (v[i][2] * v[i][2] + v[i][3] * v[i][3]); }
        float rinv[3];
        rinv[0] = rsqrt_fast(wave_sum(ss[0]) * (1.f / 768) + EPS); rinv[1] = rsqrt_fast(wave_sum(ss[1]) * (1.f / 512) + EPS); rinv[2] = rsqrt_fast(wave_sum(ss[2]) * (1.f / 768) + EPS);
#pragma unroll
        for (int i = 0; i < 8; ++i) { const int grp = (i < 3) ? 0 : (i < 5) ? 1 : 2;
            const int c = (grp == 0) ? O_A + 12 * lane + 4 * i : (grp == 1) ? O_B + 8 * lane + 4 * (i - 3) : O_C + 12 * lane + 4 * (i - 5);
            const f32x4 gg = *(const f32x4*)(og + c); const float ri = rinv[grp];
            u32x2 w; w.x = pk2(v[i][0] * ri * gg.x, v[i][1] * ri * gg.y); w.y = pk2(v[i][2] * ri * gg.z, v[i][3] * ri * gg.w); *(u32x2*)(row + c) = w; }
#pragma unroll
        for (int i = 0; i < 8; ++i) x[i] = xn[i];
        r = rn;
    }
#undef GN_SKIP
#undef GN_LOAD
}

__device__ __forceinline__ float row16_max(float v) {
    v = fmaxf(v, __builtin_bit_cast(float, __builtin_amdgcn_update_dpp(0, __builtin_bit_cast(int, v), 0xB1, 0xF, 0xF, true)));
    v = fmaxf(v, __builtin_bit_cast(float, __builtin_amdgcn_update_dpp(0, __builtin_bit_cast(int, v), 0x4E, 0xF, 0xF, true)));
    v = fmaxf(v, __builtin_bit_cast(float, __builtin_amdgcn_update_dpp(0, __builtin_bit_cast(int, v), 0x141, 0xF, 0xF, true)));
    v = fmaxf(v, __builtin_bit_cast(float, __builtin_amdgcn_update_dpp(0, __builtin_bit_cast(int, v), 0x140, 0xF, 0xF, true)));
    return v;
}
__device__ __forceinline__ void phase_rowpass2(Frame& F, int l) {
    PHASE_IDS(F);
    const bf16_t* xb = (const bf16_t*)(F.ws + WS_XB); const float* parts = (const float*)(F.ws + WS_PART);
    const bool f8 = (l == 0) ? (FP8_L0 != 0) : (FP8_L1 != 0);
    bf16x8 bh[8], bl[8];
    { const bf16x8* wf = (const bf16x8*)((const bf16_t*)(F.ws + WS_WRS) + (size_t)l * 64 * 2 * 64 * 8);
#pragma unroll
      for (int sidx = 0; sidx < 8; ++sidx) { bh[sidx] = wf[((wave * 8 + sidx) * 2 + 0) * 64 + lane]; bl[sidx] = wf[((wave * 8 + sidx) * 2 + 1) * 64 + lane]; } }
    LAS f32x4* red = (LAS f32x4*)(F.lds + LDSCTL_OFF + 2048);
    { const u32x4* gsrc = (const u32x4*)((const float*)(F.ws + WS_GS2) + (size_t)l * 5 * DM * 2) + tid; u32x4 t[10];
#pragma unroll
      for (int i = 0; i < 10; ++i) t[i] = gsrc[512 * i];
#pragma unroll
      for (int i = 0; i < 10; ++i) ((LAS u32x4*)F.lds)[tid + 512 * i] = t[i]; }
    __syncthreads();
    const int i16 = lane & 15, q = lane >> 4;
#define RP2_SKIP(tl) (l == 1 && ((tl) * 16) % TPB < CTXL)
#define RP2_LOAD(tl, xx, pp0, pp1) do { const int _row = (tl) * 16 + i16; const bf16_t* _xr = xb + (size_t)_row * DM + 256 * wave + 8 * q; \
        _Pragma("unroll") for (int sidx = 0; sidx < 8; ++sidx) xx[sidx] = *(const u32x4*)(_xr + 32 * sidx); \
        pp0 = *(const f32x4*)(parts + (size_t)_row * 32 + 8 * q); pp1 = *(const f32x4*)(parts + (size_t)_row * 32 + 8 * q + 4); } while (0)
    int tile = blockIdx.x; while (tile < NTOK / 16 && RP2_SKIP(tile)) tile += F.G;
    u32x4 x[8], xn[8]; f32x4 p0, p1, p0n, p1n;
    if (tile < NTOK / 16) RP2_LOAD(tile, x, p0, p1);
    while (tile < NTOK / 16) {
        int ntile = tile + F.G; while (ntile < NTOK / 16 && RP2_SKIP(ntile)) ntile += F.G;
        const int r0 = tile * 16, b = r0 / TPB, t0 = r0 % TPB, sv = (t0 < CTXL) ? 4 : b;
        const int row = r0 + i16;
        float ss = ((p0.x + p0.y) + (p0.z + p0.w)) + ((p1.x + p1.y) + (p1.z + p1.w));
        ss += __builtin_bit_cast(float, __builtin_amdgcn_ds_swizzle(__builtin_bit_cast(int, ss), 0x401F));
        { auto rr = __builtin_amdgcn_permlane32_swap(__float_as_uint(ss), __float_as_uint(ss), false, false); ss = __uint_as_float(rr[0]) + __uint_as_float(rr[1]); }
        const float rinv = rsqrt_fast(ss * (1.f / DM) + EPS);
        const LAS float* gs = (const LAS float*)F.lds + ((size_t)sv * DM + 256 * wave + 8 * q) * 2;
        f32x4 acc = (f32x4){0.f, 0.f, 0.f, 0.f};
#pragma unroll
        for (int sidx = 0; sidx < 8; ++sidx) {
            const f32x4 g0 = *(const LAS f32x4*)(gs + 64 * sidx), g1 = *(const LAS f32x4*)(gs + 64 * sidx + 4), g2 = *(const LAS f32x4*)(gs + 64 * sidx + 8), g3 = *(const LAS f32x4*)(gs + 64 * sidx + 12);
            float h[8];
            h[0] = bflo(x[sidx].x) * rinv * g0.x + g0.y; h[1] = bfhi(x[sidx].x) * rinv * g0.z + g0.w; h[2] = bflo(x[sidx].y) * rinv * g1.x + g1.y; h[3] = bfhi(x[sidx].y) * rinv * g1.z + g1.w;
            h[4] = bflo(x[sidx].z) * rinv * g2.x + g2.y; h[5] = bfhi(x[sidx].z) * rinv * g2.z + g2.w; h[6] = bflo(x[sidx].w) * rinv * g3.x + g3.y; h[7] = bfhi(x[sidx].w) * rinv * g3.z + g3.w;
            const int col = 256 * wave + 32 * sidx + 8 * q;
            if (f8) { u32x2 w8; w8.x = pk4_fp8(h[0], h[1], h[2], h[3]); w8.y = pk4_fp8(h[4], h[5], h[6], h[7]); *(u32x2*)((unsigned char*)(F.ws + WS_HN8) + (size_t)row * DM + col) = w8; }
            else { u32x4 w16; w16.x = pk2(h[0], h[1]); w16.y = pk2(h[2], h[3]); w16.z = pk2(h[4], h[5]); w16.w = pk2(h[6], h[7]); *(u32x4*)((bf16_t*)(F.ws + WS_HN) + (size_t)row * DM + col) = w16; }
            unsigned hh[8], hl[8];
#pragma unroll
            for (int j = 0; j < 8; ++j) { hh[j] = f2bf(h[j]); hl[j] = f2bf(h[j] - __builtin_bit_cast(float, hh[j] << 16)); }
            u32x4 ah, al; ah.x = hh[0] | (hh[1] << 16); ah.y = hh[2] | (hh[3] << 16); ah.z = hh[4] | (hh[5] << 16); ah.w = hh[6] | (hh[7] << 16);
            al.x = hl[0] | (hl[1] << 16); al.y = hl[2] | (hl[3] << 16); al.z = hl[4] | (hl[5] << 16); al.w = hl[6] | (hl[7] << 16);
            const bf16x8 fah = __builtin_bit_cast(bf16x8, ah), fal = __builtin_bit_cast(bf16x8, al);
            acc = __builtin_amdgcn_mfma_f32_16x16x32_bf16(fah, bh[sidx], acc, 0, 0, 0);
            acc = __builtin_amdgcn_mfma_f32_16x16x32_bf16(fah, bl[sidx], acc, 0, 0, 0);
            acc = __builtin_amdgcn_mfma_f32_16x16x32_bf16(fal, bh[sidx], acc, 0, 0, 0);
        }
        if (ntile < NTOK / 16) RP2_LOAD(ntile, xn, p0n, p1n);
        red[wave * 64 + lane] = acc;
        __syncthreads();
        if (wave == 0) {
            f32x4 lg = red[lane];
#pragma unroll
            for (int w = 1; w < 8; ++w) lg += red[w * 64 + lane];
#pragma unroll
            for (int reg = 0; reg < 4; ++reg) { const float mx = row16_max(lg[reg]); const float ex = __expf(lg[reg] - mx); const float a = ex / row16_sum(ex);
                const int t = t0 + 4 * q + reg;
                if (t < CTXL) ((float*)(F.ws + WS_AFFC))[((size_t)b * NE + i16) * CTXL + t] = a;
                else ((float*)(F.ws + WS_AFFL))[((size_t)b * NE + i16) * SEQ + (t - CTXL)] = a; }
        }
        __syncthreads();
#pragma unroll
        for (int sidx = 0; sidx < 8; ++sidx) x[sidx] = xn[sidx];
        p0 = p0n; p1 = p1n; tile = ntile;
    }
#undef RP2_SKIP
#undef RP2_LOAD
    __syncthreads();
}

__device__ __forceinline__ unsigned block_excl_scan(unsigned v, LAS unsigned* scr, int lane, int wave, unsigned& total) {
    unsigned inc = v;
#pragma unroll
    for (int o = 1; o < 64; o <<= 1) { const unsigned t = __shfl_up(inc, o); if (lane >= o) inc += t; }
    if (lane == 63) scr[wave] = inc;
    __syncthreads();
    unsigned base = 0, tot = 0;
#pragma unroll
    for (int w = 0; w < 8; ++w) { const unsigned x = scr[w]; base += (w < wave) ? x : 0u; tot += x; }
    __syncthreads();
    total = tot;
    return base + inc - v;
}
__device__ __forceinline__ void phase_topk(Frame& F, int l) {
    PHASE_IDS(F);
    LAS unsigned* hist = (LAS unsigned*)F.lds;
    LAS unsigned* scr = (LAS unsigned*)(F.lds + 8192);
    LAS int* rowsrc = (LAS int*)(F.lds + 8192 + 128);
    const int nunits = (l == 0) ? 128 : 64;
    const bool f8 = (l == 0) ? (FP8_L0 != 0) : (FP8_L1 != 0); const int RBg = f8 ? DM : 2 * DM;
    for (int u = blockIdx.x; u < nunits; u += F.G) {
        const bool isc = u >= 64; const int uu = isc ? u - 64 : u, b = uu / NE, e = uu % NE;
        const int N = isc ? CTXL : SEQ; const unsigned cap = isc ? CAP_C : CAP_L;
        const float* src = isc ? (const float*)(F.ws + WS_AFFC) + (size_t)uu * CTXL : (const float*)(F.ws + WS_AFFL) + (size_t)uu * SEQ;
        int* pos = isc ? (int*)(F.ws + WS_POSC) + (size_t)uu * CTXL : (int*)(F.ws + WS_POSL) + (size_t)uu * SEQ;
        const bool own = tid * 8 < N;
        unsigned key[8];
        { u32x4 k0 = (u32x4){0u, 0u, 0u, 0u}, k1 = k0; if (own) { k0 = *(const u32x4*)(src + tid * 8); k1 = *(const u32x4*)(src + tid * 8 + 4); }
          key[0] = k0.x; key[1] = k0.y; key[2] = k0.z; key[3] = k0.w; key[4] = k1.x; key[5] = k1.y; key[6] = k1.z; key[7] = k1.w; }
        unsigned prefix = 0u, remaining = cap;
#pragma unroll
        for (int p = 0; p < 3; ++p) {
            const int shift = (p == 0) ? 21 : (p == 1) ? 10 : 0, bits = (p == 2) ? 10 : 11, nb = 1 << bits;
            for (int i = tid; i < nb; i += 512) hist[i] = 0u;
            __syncthreads();
            if (own) {
#pragma unroll
                for (int q = 0; q < 8; ++q) { const bool cand = (p == 0) ? true : ((key[q] >> (shift + bits)) == prefix);
                    if (cand) (void)__hip_atomic_fetch_add(&hist[(key[q] >> shift) & (nb - 1)], 1u, __ATOMIC_RELAXED, __HIP_MEMORY_SCOPE_WORKGROUP); } }
            __syncthreads();
            unsigned c[4];
#pragma unroll
            for (int q = 0; q < 4; ++q) c[q] = (4 * tid + q < nb) ? hist[4 * tid + q] : 0u;
            const unsigned sm = (c[0] + c[1]) + (c[2] + c[3]);
            unsigned total; const unsigned ex = block_excl_scan(sm, scr, lane, wave, total);
            unsigned above = total - (ex + sm);
#pragma unroll
            for (int q = 3; q >= 0; --q) { if (above < remaining && remaining <= above + c[q]) { scr[16] = (unsigned)(4 * tid + q); scr[17] = above; } above += c[q]; }
            __syncthreads();
            const unsigned B = scr[16], ca = scr[17];
            remaining -= ca; prefix = (prefix << bits) | B;
            __syncthreads();
        }
        const unsigned T = prefix;
        unsigned ce = 0u;
#pragma unroll
        for (int q = 0; q < 8; ++q) ce += (own && key[q] == T) ? 1u : 0u;
        unsigned tot; unsigned er = block_excl_scan(ce, scr, lane, wave, tot);
        bool sel[8]; unsigned cs = 0u;
#pragma unroll
        for (int q = 0; q < 8; ++q) { const bool eq = own && key[q] == T; sel[q] = own && (key[q] > T || (eq && er < remaining)); er += eq ? 1u : 0u; cs += sel[q] ? 1u : 0u; }
        unsigned sl = block_excl_scan(cs, scr, lane, wave, tot);
        const int slotbase = e * ROWS_E + (isc ? 2048 + b * CAP_C : b * CAP_L);
        int pv[8];
#pragma unroll
        for (int q = 0; q < 8; ++q) { pv[q] = sel[q] ? (int)sl : -1;
            if (sel[q]) { rowsrc[sl] = b * TPB + (isc ? 0 : CTXL) + tid * 8 + q; ((float*)(F.ws + WS_GATE))[slotbase + sl] = __uint_as_float(key[q]); ++sl; } }
        if (own) { *(i32x4*)(pos + tid * 8) = (i32x4){pv[0], pv[1], pv[2], pv[3]}; *(i32x4*)(pos + tid * 8 + 4) = (i32x4){pv[4], pv[5], pv[6], pv[7]}; }
        __syncthreads();
        unsigned* offs = (unsigned*)(F.ws + WS_OFFS);
        int R[2], C[2];
#pragma unroll
        for (int i = 0; i < 2; ++i) pg8::stage_rc(tid * 16 + i * 8192, R[i], C[i]);
        if (!isc) {
#pragma unroll
            for (int th = 0; th < 2; ++th) { u32x4 o;
                o.x = (unsigned)rowsrc[th * 256 + R[0]] * RBg + 2 * C[0]; o.y = (unsigned)rowsrc[th * 256 + R[1]] * RBg + 2 * C[1];
                o.z = (unsigned)rowsrc[th * 256 + 128 + R[0]] * RBg + 2 * C[0]; o.w = (unsigned)rowsrc[th * 256 + 128 + R[1]] * RBg + 2 * C[1];
                *(u32x4*)(offs + ((size_t)(e * 9 + 2 * b + th) * 512 + tid) * 4) = o; }
        } else {
            unsigned* o = offs + ((size_t)(e * 9 + 8) * 512 + tid) * 4;
#pragma unroll
            for (int i = 0; i < 2; ++i) { if (R[i] >= 32 * b && R[i] < 32 * b + 32) o[i] = (unsigned)rowsrc[R[i] - 32 * b] * RBg + 2 * C[i]; if (b == 0) o[2 + i] = 2 * C[i]; }
        }
        __syncthreads();
    }
}

__device__ __forceinline__ void phase_combine(Frame& F, int l) {
    PHASE_IDS(F);
    const float* mod = (const float*)(F.ws + WS_MOD);
    bf16_t* xb = (bf16_t*)(F.ws + WS_XB); const bf16_t* Y = (const bf16_t*)(F.ws + WS_XG);
    const bool y8 = (l == 0) ? (FP8_L0 != 0) : (FP8_L1 != 0);
    for (int r = gw; r < NTOK; r += NGW) {
        const int b = r / TPB, t = r % TPB, s = (t < CTXL) ? 4 : b;
        if (l == 1 && t < CTXL) continue;
        int p = -1;
        if (lane < NE) p = (t < CTXL) ? ((const int*)(F.ws + WS_POSC))[((size_t)b * NE + lane) * CTXL + t] : ((const int*)(F.ws + WS_POSL))[((size_t)b * NE + lane) * SEQ + (t - CTXL)];
        float gt = 0.f;
        if (p >= 0) gt = ((const float*)(F.ws + WS_GATE))[lane * ROWS_E + ((t < CTXL) ? 2048 + b * CAP_C : b * CAP_L) + p];
        f32x4 v[8];
        { const bf16_t* xr = xb + (size_t)r * DM + 4 * lane; u32x2 xw[8];
#pragma unroll
          for (int j = 0; j < 8; ++j) xw[j] = *(const u32x2*)(xr + 256 * j);
#pragma unroll
          for (int j = 0; j < 8; ++j) v[j] = (f32x4){bflo(xw[j].x), bfhi(xw[j].x), bflo(xw[j].y), bfhi(xw[j].y)}; }
        const float* g2 = mod + (size_t)(l * 5 + s) * NMOD + 5 * DM;
        f32x4 gv[8];
#pragma unroll
        for (int j = 0; j < 8; ++j) gv[j] = *(const f32x4*)(g2 + 4 * lane + 256 * j);
        f32x4 a[8];
#pragma unroll
        for (int j = 0; j < 8; ++j) a[j] = (f32x4){0.f, 0.f, 0.f, 0.f};
        unsigned long long m = __ballot(p >= 0);
        const int ybase = (t < CTXL) ? 2048 + b * CAP_C : b * CAP_L;
        while (m) {
            const int e0 = __builtin_ctzll(m); m &= m - 1;
            const bool two = (m != 0ull); const int e1 = two ? __builtin_ctzll(m) : e0; if (two) m &= m - 1;
            const int p0 = __builtin_amdgcn_readlane(p, e0), p1 = __builtin_amdgcn_readlane(p, e1);
            const float q0 = __builtin_bit_cast(float, __builtin_amdgcn_readlane(__builtin_bit_cast(int, gt), e0)), q1 = __builtin_bit_cast(float, __builtin_amdgcn_readlane(__builtin_bit_cast(int, gt), e1));
            if (y8) {
                const unsigned char* y0 = (const unsigned char*)Y + (size_t)(e0 * ROWS_E + ybase + p0) * DM + 4 * lane; const unsigned char* y1 = (const unsigned char*)Y + (size_t)(e1 * ROWS_E + ybase + p1) * DM + 4 * lane;
                unsigned w0[8], w1[8];
#pragma unroll
                for (int j = 0; j < 8; ++j) w0[j] = *(const unsigned*)(y0 + 256 * j);
                if (two) {
#pragma unroll
                    for (int j = 0; j < 8; ++j) w1[j] = *(const unsigned*)(y1 + 256 * j); }
#pragma unroll
                for (int j = 0; j < 8; ++j) { const f32x2 lo = __builtin_amdgcn_cvt_pk_f32_fp8((int)w0[j], false), hi = __builtin_amdgcn_cvt_pk_f32_fp8((int)w0[j], true); a[j] += (f32x4){lo.x, lo.y, hi.x, hi.y} * q0; }
                if (two) {
#pragma unroll
                    for (int j = 0; j < 8; ++j) { const f32x2 lo = __builtin_amdgcn_cvt_pk_f32_fp8((int)w1[j], false), hi = __builtin_amdgcn_cvt_pk_f32_fp8((int)w1[j], true); a[j] += (f32x4){lo.x, lo.y, hi.x, hi.y} * q1; } }
            } else {
            const bf16_t* y0 = Y + (size_t)(e0 * ROWS_E + ybase + p0) * DM + 4 * lane; const bf16_t* y1 = Y + (size_t)(e1 * ROWS_E + ybase + p1) * DM + 4 * lane;
            u32x2 w0[8], w1[8];
#pragma unroll
            for (int j = 0; j < 8; ++j) w0[j] = *(const u32x2*)(y0 + 256 * j);
            if (two) {
#pragma unroll
                for (int j = 0; j < 8; ++j) w1[j] = *(const u32x2*)(y1 + 256 * j); }
#pragma unroll
            for (int j = 0; j < 8; ++j) a[j] += (f32x4){bflo(w0[j].x), bfhi(w0[j].x), bflo(w0[j].y), bfhi(w0[j].y)} * q0;
            if (two) {
#pragma unroll
                for (int j = 0; j < 8; ++j) a[j] += (f32x4){bflo(w1[j].x), bfhi(w1[j].x), bflo(w1[j].y), bfhi(w1[j].y)} * q1; }
            }
        }
#pragma unroll
        for (int j = 0; j < 8; ++j) v[j] += gv[j] * a[j];
        if (l == 0) {
#pragma unroll
            for (int j = 0; j < 8; ++j) { u32x2 w; w.x = pk2(v[j].x, v[j].y); w.y = pk2(v[j].z, v[j].w); *(u32x2*)(xb + (size_t)r * DM + 4 * lane + 256 * j) = w; }
            const float* m1 = mod + (size_t)(5 + s) * NMOD;
            norm_mod_store(v, INP(F, IN_N1G) + DM, m1, m1 + DM, (bf16_t*)(F.ws + WS_HN) + (size_t)r * DM, lane);
        } else {
            float* op = F.out + ((size_t)b * SEQ + (t - CTXL)) * DM;
#pragma unroll
            for (int j = 0; j < 8; ++j) *(f32x4*)(op + 4 * lane + 256 * j) = v[j];
        }
    }
}

__device__ __forceinline__ void phase_dump_x(Frame& F, bool from_input) {
    PHASE_IDS(F);
    for (int r = gw; r < NTOK; r += NGW) {
        const int b = r / TPB, t = r % TPB; if (t < CTXL) continue;
        const float* src = INP(F, IN_X) + ((size_t)b * SEQ + (t - CTXL)) * DM; (void)from_input;
        f32x4 v[8]; load_row(src, lane, v);
        float* op = F.out + ((size_t)b * SEQ + (t - CTXL)) * DM;
#pragma unroll
        for (int j = 0; j < 8; ++j) *(f32x4*)(op + 4 * lane + 256 * j) = v[j];
    }
}

constexpr int N_PHASES = 2 + 11 * NLAYER;
__global__ void __launch_bounds__(512, 2) fwd_kernel(Args args) {
    extern __shared__ __attribute__((aligned(16))) unsigned char lds[];
    Frame F;
    F.lds = (LAS unsigned char*)lds; F.ldsg = (char*)lds;
    F.MISC = (volatile LAS unsigned*)(F.lds + MISC_OFF);
    F.G = gridDim.x;
    F.out = args.out; F.ws = args.ws; F.ctl = (unsigned*)(args.ws + WS_CTL);
    for (int u = threadIdx.x; u < (LDS_BYTES - LDSCTL_OFF) / 4; u += 512) ((LAS unsigned*)(F.lds + LDSCTL_OFF))[u] = 0u;
    __syncthreads();
    if (threadIdx.x < 23) { const unsigned long long pv = (unsigned long long)args.in[threadIdx.x]; LAS unsigned* t = (LAS unsigned*)(F.lds + ARGTAB_OFF) + 2 * threadIdx.x; t[0] = (unsigned)pv; t[1] = (unsigned)(pv >> 32); }
    __syncthreads();
    XcdBarrier bar; bar.bar = F.ctl + CW_BAR; bar.x = 0; bar.st = nullptr;
    if (!MK_PER_PHASE) bar = xcd_barrier_post(F.ctl + CW_BAR, F.MISC + 8);
    const int lo = args.ph_lo, hi = args.ph_hi;
#define IN(k) (lo <= (k) && (k) < hi)
    unsigned long long probe_t0 = 0ull, probe_acc = 0ull;
#define PROBE_BEGIN(k) do { if (PROBE_MASK & (1u << (k))) probe_t0 = __builtin_amdgcn_s_memrealtime(); } while (0)
#define SEAM(k) do { if (IN(k) && IN((k) + 1)) xcd_barrier(bar); if (PROBE_MASK & (1u << (k))) probe_acc += __builtin_amdgcn_s_memrealtime() - probe_t0; } while (0)

    if (IN(0)) { PROBE_BEGIN(0); if (PH_ON(0)) phase_prologue(F); if (IN(1)) xcd_barrier_first(bar); if (PROBE_MASK & 1u) probe_acc += __builtin_amdgcn_s_memrealtime() - probe_t0; }
    if (IN(1)) { PROBE_BEGIN(1); if (PH_ON(1)) phase_rowpass1_l0(F); SEAM(1); }
    for (int l = 0; l < NLAYER; ++l) {
        const int pb = 2 + 11 * l;
        const bool ctx = (l == 0);
        if (IN(pb + 0)) { PROBE_BEGIN(pb + 0); if (PH_ON(2)) {
            pg8::SchedDense S; S.init(F.ws + WS_HN, F.ws + WS_WIN + (size_t)l * INW * DM * 2, ctx ? NTOK / 256 : 64, INW / 256, F.G, (int)blockIdx.x, ctx ? 0 : 2);
            pg8::EpiPost E{(bf16_t*)(F.ws + WS_P), (const float*)(F.ws + WS_ROPE), INP(F, IN_QNA) + l * 128, INP(F, IN_KNA) + l * 128, INP(F, IN_QNC) + l * 128, INP(F, IN_KNC) + l * 128, INP(F, IN_VNB) + l * 512, F.lds + LDSCTL_OFF + 2048};
            pg8::gemm_phase<pg8::EpiPost, pg8::SchedDense>(F.lds, S, E);
            if ((CONV_HOOKS & 2) && (int)blockIdx.x >= (NTOK / 256) * (INW / 256) - 3 * F.G) conv_help(F, 10, nullptr, 0u); }
            SEAM(pb + 0); }
        if (IN(pb + 2)) { PROBE_BEGIN(pb + 2); if (PH_ON(4)) phase_mixers(F, l); SEAM(pb + 2); }
        if (IN(pb + 4)) { PROBE_BEGIN(pb + 4); if (PH_ON(6)) {
            pg8::SchedDense S; S.init(F.ws + WS_O, F.ws + WS_WOUT + (size_t)l * DM * DM * 2, ctx ? NTOK / 256 : 64, DM / 256, F.G, (int)blockIdx.x, ctx ? 0 : 1);
            bf16_t* xb = (bf16_t*)(F.ws + WS_XB);
            pg8::EpiResid E;
            E.ctxbase = INP(F, IN_CTX); E.latbase = INP(F, IN_X); E.cbs = CTXL; E.lbs = SEQ; E.src16 = (l == 0) ? nullptr : xb;
            E.xout = xb; E.modl = (const float*)(F.ws + WS_MOD) + (size_t)l * 5 * NMOD; E.parts = (float*)(F.ws + WS_PART); E.ktab = F.lds + LDSCTL_OFF + 2048;
            { const float* ssq = (const float*)(F.ws + WS_SSQ); LAS f32x4* kt = (LAS f32x4*)(F.lds + LDSCTL_OFF + 2048); const int tz = opaque_tid();
              for (int i = 0; i < 3; ++i) { pg8::Unit uu; if (!S.next(i, uu)) break;
                  if (tz < 256) { const f32x4* sp = (const f32x4*)(ssq + (size_t)(uu.rowbase + tz) * 16); const f32x4 s0 = sp[0], s1 = sp[1], s2 = sp[2], s3 = sp[3];
                      const float qa = ((s0.x + s0.y) + (s0.z + s0.w)) + (s1.x + s1.y), qb = (s1.z + s1.w) + (s2.x + s2.y), qc = ((s2.z + s2.w) + (s3.x + s3.y)) + (s3.z + s3.w);
                      const float ra = rsqrt_fast(qa * (1.f / 768) + EPS), rb = rsqrt_fast(qb * (1.f / 512) + EPS), rc = rsqrt_fast(qc * (1.f / 768) + EPS);
                      kt[i * 256 + tz] = (f32x4){ra / rb, rb / rc, rc, 0.f}; } }
              __syncthreads(); }
            pg8::gemm_phase<pg8::EpiResid, pg8::SchedDense, false, false, true>(F.lds, S, E, nullptr, F.lds + LDSCTL_OFF + 2048);
            if ((CONV_HOOKS & 4) && ctx && (int)blockIdx.x >= (NTOK / 256) * (DM / 256) - 2 * F.G) conv_help(F, 9, nullptr, 0u); }
            SEAM(pb + 4); }
        if (IN(pb + 5)) { PROBE_BEGIN(pb + 5); if (PH_ON(7)) phase_rowpass2(F, l); SEAM(pb + 5); }
        if (IN(pb + 6)) { PROBE_BEGIN(pb + 6); if (PH_ON(8)) { phase_topk(F, l);
            if (l == 0) { if ((CONV_HOOKS & 8) && (int)blockIdx.x >= 128) conv_help(F, 2, nullptr, 0u); } else conv_help(F, 1 << 20, nullptr, 0u); }
            SEAM(pb + 6); }
        if (IN(pb + 8)) { PROBE_BEGIN(pb + 8); if (PH_ON(10)) {
            if ((l == 0) ? (FP8_L0 != 0) : (FP8_L1 != 0)) {
                pg8::SchedGrouped<pg8::GK> S; S.init(F.ws + WS_HN8, F.ws + WS_WGU + (size_t)l * NE * 4096 * DM * 2, ctx ? 9 : 8, 16, F.G, (int)blockIdx.x);
                pg8::EpiSwiGLU8 E{(unsigned char*)(F.ws + WS_H)};
                pg8::gemm_phase<pg8::EpiSwiGLU8, pg8::SchedGrouped<pg8::GK>, true, true>(F.lds, S, E, (const unsigned*)(F.ws + WS_OFFS), F.lds + LDSCTL_OFF + 2048);
            } else {
                pg8::SchedGrouped<2 * pg8::GK> S; S.init(F.ws + WS_HN, F.ws + WS_WGU + (size_t)l * NE * 4096 * DM * 2, ctx ? 9 : 8, 16, F.G, (int)blockIdx.x);
                pg8::EpiSwiGLU E{(bf16_t*)(F.ws + WS_H)};
                pg8::gemm_phase<pg8::EpiSwiGLU, pg8::SchedGrouped<2 * pg8::GK>, false, true>(F.lds, S, E, (const unsigned*)(F.ws + WS_OFFS), F.lds + LDSCTL_OFF + 2048);
            } }
            SEAM(pb + 8); }
        if (IN(pb + 9)) { PROBE_BEGIN(pb + 9); if (PH_ON(11)) {
            pg8::EpiStoreBf16 E{(bf16_t*)(F.ws + WS_XG), DM};
            if ((l == 0) ? (FP8_L0 != 0) : (FP8_L1 != 0)) {
                pg8::SchedGrouped<pg8::GK> S; S.init(F.ws + WS_H, F.ws + WS_WD + (size_t)l * NE * DM * DM * 2, ctx ? 9 : 8, 8, F.G, (int)blockIdx.x);
                pg8::EpiStoreFp8 E8{(unsigned char*)(F.ws + WS_XG), DM};
                pg8::gemm_phase<pg8::EpiStoreFp8, pg8::SchedGrouped<pg8::GK>, true>(F.lds, S, E8);
                if ((CONV_HOOKS & 16) && ctx && (((int)blockIdx.x >> 3) & 31) >= 16) conv_help(F, 3, nullptr, 0u);
            } else {
                pg8::SchedGrouped<2 * pg8::GK> S; S.init(F.ws + WS_H, F.ws + WS_WD + (size_t)l * NE * DM * DM * 2, ctx ? 9 : 8, 8, F.G, (int)blockIdx.x);
                pg8::gemm_phase<pg8::EpiStoreBf16, pg8::SchedGrouped<2 * pg8::GK>, false>(F.lds, S, E);
            } }
            SEAM(pb + 9); }
        if (IN(pb + 10)) { PROBE_BEGIN(pb + 10); if (PH_ON(12)) phase_combine(F, l); if (l + 1 < NLAYER) SEAM(pb + 10); else if (PROBE_MASK & (1u << (pb + 10))) probe_acc += __builtin_amdgcn_s_memrealtime() - probe_t0; }
    }
    if (PROBE_MASK) { const unsigned long long te = __builtin_amdgcn_s_memrealtime(); while (__builtin_amdgcn_s_memrealtime() - te < probe_acc) __builtin_amdgcn_s_sleep(8); }
#undef IN
#undef SEAM
}

extern "C" void kernel_launch(void* const* d_in, const int* in_sizes, int n_in, void* d_out, int out_size, void* d_ws, size_t ws_size, hipStream_t stream) {
    static int grid = 0;
    if (grid == 0) {
        if (n_in != 23 || out_size != NB * SEQ * DM || ws_size < WS_END) { fprintf(stderr, "kernel_launch: shape mismatch: n_in %d out %d ws %zu (need %zu)\n", n_in, out_size, ws_size, (size_t)WS_END); grid = -1; return; }
        int dev = 0, cus = 0, per_cu = 0;
        if (hipGetDevice(&dev) != hipSuccess || hipDeviceGetAttribute(&cus, hipDeviceAttributeMultiprocessorCount, dev) != hipSuccess) { grid = -1; return; }
        if (hipFuncSetAttribute((const void*)fwd_kernel, hipFuncAttributeMaxDynamicSharedMemorySize, LDS_BYTES) != hipSuccess) { fprintf(stderr, "kernel_launch: hipFuncSetAttribute failed\n"); grid = -1; return; }
        if (hipOccupancyMaxActiveBlocksPerMultiprocessor(&per_cu, (const void*)fwd_kernel, 512, LDS_BYTES) != hipSuccess || per_cu < 1) { fprintf(stderr, "kernel_launch: occupancy query says %d\n", per_cu); }
        (void)hipGetLastError();
        grid = cus;
    }
    if (grid < 0) return;
    if (hipMemsetAsync((char*)d_ws + WS_CTL, 0, CTL_ZERO_BYTES, stream) != hipSuccess) return;
    Args a{};
    for (int i = 0; i < 23; ++i) a.in[i] = (const float*)d_in[i];
    a.out = (float*)d_out; a.ws = (unsigned char*)d_ws;
#if MK_PER_PHASE
    for (int p = 0; p < N_PHASES; ++p) { a.ph_lo = p; a.ph_hi = p + 1; hipLaunchKernelGGL(fwd_kernel, dim3(grid), dim3(512), LDS_BYTES, stream, a); }
#else
    a.ph_lo = 0; a.ph_hi = N_PHASES;
    hipLaunchKernelGGL(fwd_kernel, dim3(grid), dim3(512), LDS_BYTES, stream, a);
#endif
    const hipError_t le = hipPeekAtLastError();
    if (le != hipSuccess) fprintf(stderr, "kernel_launch: launch failed: %s\n", hipGetErrorName(le));
}
```
